# Optimizing an MI355X kernel written in HIP

```python
import math
import jax, jax.numpy as jnp
from jax import lax
import numpy as np

D_MODEL = 1024
BATCH = 16
SEQ = 2048
DEPTH = 4

N_MIXERS = 2
N_HEADS = 16
HEAD_DIM = 64
KV_RANK = 256
IDX_HEADS = 8
IDX_DIM = 64
INDEX_TOPK = 256
Q_BLOCK = 128
KV_HEADS = 2
WINDOW = 128
N_BUCKETS = 32
MAX_DISTANCE = 128
D_FF = -(-8 * D_MODEL // (3 * 256)) * 256
N_A = (DEPTH + 1) // 2
N_B = DEPTH // 2
RMS_EPS = 1e-6
NEG = -1e30

A_SPLITS = (N_HEADS * HEAD_DIM,
            N_HEADS * HEAD_DIM + KV_RANK,
            N_HEADS * HEAD_DIM + KV_RANK + IDX_HEADS * IDX_DIM,
            N_HEADS * HEAD_DIM + KV_RANK + IDX_HEADS * IDX_DIM + IDX_DIM)
A_IN = A_SPLITS[-1] + IDX_HEADS
B_IN = (N_HEADS + 2 * KV_HEADS) * HEAD_DIM

kernel_name = 'hybrid_dsa_swa_sink_adaln_trunk'


def rms_norm(x, g):
    xf = x.astype(jnp.float32)
    y = xf * lax.rsqrt(jnp.mean(xf * xf, axis=-1, keepdims=True) + RMS_EPS)
    return (y * g.astype(jnp.float32)).astype(x.dtype)


def layer_norm(x, g, b):
    xf = x.astype(jnp.float32)
    mu = jnp.mean(xf, axis=-1, keepdims=True)
    var = jnp.mean(jnp.square(xf - mu), axis=-1, keepdims=True)
    y = (xf - mu) * lax.rsqrt(var + RMS_EPS)
    return (y * g.astype(jnp.float32) + b.astype(jnp.float32)).astype(x.dtype)


def t5_bucket(dist):
    max_exact = N_BUCKETS // 2
    d = jnp.maximum(dist, 0)
    large = max_exact + (jnp.log(jnp.maximum(d, 1).astype(jnp.float32) / max_exact)
                         / math.log(MAX_DISTANCE / max_exact)
                         * (N_BUCKETS - max_exact)).astype(jnp.int32)
    large = jnp.minimum(large, N_BUCKETS - 1)
    return jnp.where(d < max_exact, d, large)


def modulate(h, shift, scale):
    return h * (1 + scale[:, None, :]) + shift[:, None, :]


def dsa_mla_mixer(h, w_in, kv_norm_g, w_uk, w_uv, idx_k_g, idx_k_b, w_out, rel_bias):
    B, L, _ = h.shape
    proj = h @ w_in
    q, ckv, qi, ki, wi = jnp.split(proj, A_SPLITS, axis=-1)
    q = q.reshape(B, L, N_HEADS, HEAD_DIM)
    ckv = rms_norm(ckv, kv_norm_g)
    qi = qi.reshape(B, L, IDX_HEADS, IDX_DIM)
    ki = layer_norm(ki, idx_k_g, idx_k_b)
    wi = wi * (IDX_HEADS ** -0.5 * IDX_DIM ** -0.5)
    topk = min(INDEX_TOPK, L // 4)
    nblk = L // Q_BLOCK
    key_pos = jnp.arange(L)

    def blocks(a):
        return a.reshape(B, nblk, Q_BLOCK, *a.shape[2:]).swapaxes(0, 1)

    def one_block(args):
        q_b, qi_b, wi_b, t_b = args
        rel = jax.nn.relu(jnp.einsum('bqhd,bsd->bqhs', qi_b, ki).astype(jnp.float32))
        score = jnp.einsum('bqhs,bqh->bqs', rel, wi_b.astype(jnp.float32))
        causal = key_pos[None, :] <= t_b[:, None]
        score = jnp.where(causal[None], score, NEG)
        _, sel = lax.top_k(score, topk)
        valid = sel <= t_b[None, :, None]
        kv_sel = jax.vmap(lambda cb, ib: cb[ib])(ckv, sel)
        q_abs = jnp.einsum('bqhd,hrd->bqhr', q_b, w_uk)
        logits = jnp.einsum('bqhr,bqkr->bqhk', q_abs, kv_sel).astype(jnp.float32) * HEAD_DIM ** -0.5
        bias = rel_bias[t5_bucket(t_b[None, :, None] - sel)]
        logits = logits + bias.astype(jnp.float32).transpose(0, 1, 3, 2)
        logits = jnp.where(valid[:, :, None, :], logits, NEG)
        p = jax.nn.softmax(logits, axis=-1).astype(kv_sel.dtype)
        return jnp.einsum('bqhk,bqkr->bqhr', p, kv_sel)

    t_blocks = jnp.arange(L).reshape(nblk, Q_BLOCK)
    o_lat = lax.map(one_block, (blocks(q), blocks(qi), blocks(wi), t_blocks))
    o_lat = o_lat.swapaxes(0, 1).reshape(B, L, N_HEADS, KV_RANK)
    o = jnp.einsum('blhr,hrd->blhd', o_lat, w_uv)
    return o.reshape(B, L, N_HEADS * HEAD_DIM) @ w_out


def swa_sink_mixer(h, w_in, b_in, sinks, w_out, b_out, rel_bias):
    B, L, _ = h.shape
    W = WINDOW
    nb = L // W
    G = N_HEADS // KV_HEADS
    proj = h @ w_in + b_in
    q, k, v = jnp.split(proj, (N_HEADS * HEAD_DIM, (N_HEADS + KV_HEADS) * HEAD_DIM), axis=-1)
    q = q.reshape(B, nb, W, KV_HEADS, G, HEAD_DIM)
    k = k.reshape(B, nb, W, KV_HEADS, HEAD_DIM)
    v = v.reshape(B, nb, W, KV_HEADS, HEAD_DIM)

    def with_prev(a):
        prev = jnp.pad(a[:, :-1], ((0, 0), (1, 0), (0, 0), (0, 0), (0, 0)))
        return jnp.concatenate([prev, a], axis=2)

    kb, vb = with_prev(k), with_prev(v)
    logits = jnp.einsum('bnqkgd,bnskd->bnkgqs', q, kb).astype(jnp.float32) * HEAD_DIM ** -0.5
    qpos = jnp.arange(W)
    kpos = jnp.arange(2 * W)
    dist = qpos[:, None] + W - kpos[None, :]
    allowed = (dist >= 0) & (dist < WINDOW)
    blk_valid = (jnp.arange(nb)[:, None] > 0) | (kpos[None, :] >= W)
    mask = allowed[None] & blk_valid[:, None, :]
    bias = rel_bias[t5_bucket(dist)].transpose(2, 0, 1).reshape(KV_HEADS, G, W, 2 * W)
    logits = logits + bias.astype(jnp.float32)[None, None]
    logits = jnp.where(mask[None, :, None, None], logits, NEG)
    sink = jnp.broadcast_to(sinks.astype(jnp.float32).reshape(KV_HEADS, G, 1, 1),
                            logits.shape[:-1] + (1,))
    p = jax.nn.softmax(jnp.concatenate([logits, sink], axis=-1), axis=-1)[..., :-1]
    o = jnp.einsum('bnkgqs,bnskd->bnqkgd', p.astype(vb.dtype), vb)
    return o.reshape(B, L, N_HEADS * HEAD_DIM) @ w_out + b_out


def swiglu(h, w1, w3, w2):
    return (jax.nn.silu(h @ w1) * (h @ w3)) @ w2


def setup_inputs(seed: int = 0) -> dict:
    key = jax.random.key(seed)
    ks = jax.random.split(key, 24)
    f32 = jnp.float32
    D = D_MODEL
    HD = N_HEADS * HEAD_DIM

    def nrm(k, shape, scale):
        return jax.random.normal(k, shape, f32) * scale

    return {
        'x': nrm(ks[0], (BATCH, SEQ, D), 1.0),
        'c': nrm(ks[1], (BATCH, D), 1.0),
        'rel_bias': nrm(ks[2], (N_BUCKETS, N_HEADS), 0.5),
        'w_ada': nrm(ks[3], (DEPTH, D, 6 * D), 0.5 * D ** -0.5),
        'b_ada': nrm(ks[4], (DEPTH, 6 * D), 0.02),
        'norm_mix_g': 1.0 + nrm(ks[5], (DEPTH, D), 0.02),
        'norm_ffn_g': 1.0 + nrm(ks[6], (DEPTH, D), 0.02),
        'a_w_in': nrm(ks[7], (N_A, D, A_IN), D ** -0.5),
        'a_kv_norm_g': 1.0 + nrm(ks[8], (N_A, KV_RANK), 0.02),
        'a_w_uk': nrm(ks[9], (N_A, N_HEADS, KV_RANK, HEAD_DIM), KV_RANK ** -0.5),
        'a_w_uv': nrm(ks[10], (N_A, N_HEADS, KV_RANK, HEAD_DIM), KV_RANK ** -0.5),
        'a_idx_k_g': 1.0 + nrm(ks[11], (N_A, IDX_DIM), 0.02),
        'a_idx_k_b': nrm(ks[12], (N_A, IDX_DIM), 0.02),
        'a_w_out': nrm(ks[13], (N_A, HD, D), HD ** -0.5),
        'b_w_in': nrm(ks[14], (N_B, D, B_IN), D ** -0.5),
        'b_b_in': nrm(ks[15], (N_B, B_IN), 0.02),
        'b_sinks': nrm(ks[16], (N_B, N_HEADS), 0.5),
        'b_w_out': nrm(ks[17], (N_B, HD, D), HD ** -0.5),
        'b_b_out': nrm(ks[18], (N_B, D), 0.02),
        'ffn_w1': nrm(ks[19], (DEPTH, D, D_FF), D ** -0.5),
        'ffn_w3': nrm(ks[20], (DEPTH, D, D_FF), D ** -0.5),
        'ffn_w2': nrm(ks[21], (DEPTH, D_FF, D), D_FF ** -0.5),
        'norm_final_g': 1.0 + nrm(ks[22], (D,), 0.02),
    }


def reference(x, c, rel_bias, w_ada, b_ada, norm_mix_g, norm_ffn_g,
              a_w_in, a_kv_norm_g, a_w_uk, a_w_uv, a_idx_k_g, a_idx_k_b, a_w_out,
              b_w_in, b_b_in, b_sinks, b_w_out, b_b_out,
              ffn_w1, ffn_w3, ffn_w2, norm_final_g):
    cs = jax.nn.silu(c)
    for i in range(DEPTH):
        mod = cs @ w_ada[i] + b_ada[i]
        sh1, sc1, g1, sh2, sc2, g2 = jnp.split(mod, 6, axis=-1)
        h = modulate(rms_norm(x, norm_mix_g[i]), sh1, sc1)
        j = i // N_MIXERS
        if i % N_MIXERS == 0:
            y = dsa_mla_mixer(h, a_w_in[j], a_kv_norm_g[j], a_w_uk[j], a_w_uv[j],
                              a_idx_k_g[j], a_idx_k_b[j], a_w_out[j], rel_bias)
        else:
            y = swa_sink_mixer(h, b_w_in[j], b_b_in[j], b_sinks[j], b_w_out[j],
                               b_b_out[j], rel_bias)
        x = x + g1[:, None, :] * y
        h = modulate(rms_norm(x, norm_ffn_g[i]), sh2, sc2)
        x = x + g2[:, None, :] * swiglu(h, ffn_w1[i], ffn_w3[i], ffn_w2[i])
    return rms_norm(x, norm_final_g)
```

```cpp
#include <hip/hip_runtime.h>
#include <cstdio>
#include <cstdint>

#ifndef MK_MULTI
#define MK_MULTI 0
#endif

#define GAS __attribute__((address_space(1)))
#define LAS __attribute__((address_space(3)))
typedef unsigned short bf16_t;
typedef short bf16x8 __attribute__((ext_vector_type(8)));
typedef short s16x4 __attribute__((ext_vector_type(4)));
typedef float f32x4 __attribute__((ext_vector_type(4)));
typedef float f32x2 __attribute__((ext_vector_type(2)));
typedef float f32x16 __attribute__((ext_vector_type(16)));
typedef unsigned u32x4 __attribute__((ext_vector_type(4)));
typedef unsigned u32x2 __attribute__((ext_vector_type(2)));

constexpr int D = 1024, BATCH = 16, SEQ = 2048, M = BATCH * SEQ, DEPTH = 4;
constexpr int NH = 16, HD = 64, RK = 256, IH = 8, IDIM = 64, TOPK = 256;
constexpr int KVH = 2, GQ = 8, WIN = 128, NBUCK = 32, DFF = 2816;
constexpr int A_IN = 1864, B_IN = 1280;
constexpr float EPS = 1e-6f;
constexpr float NEGF = -1e30f;
constexpr int NWAVES = 8, NTHR = 512;

constexpr size_t MiB = 1u << 20;
constexpr size_t WS_CTL = 0, CTL_ZERO_BYTES = 64 * 1024;
constexpr size_t WS_W = 4 * MiB;
constexpr size_t W_LAYER = 17301504;
constexpr size_t W13_OFF = 0, W2_OFF = 11 * MiB;
constexpr size_t WS_WA = WS_W + 4 * W_LAYER;
constexpr size_t WA_STRIDE = 10 * MiB, WINA_OFF = 0, WQA_OFF = 4 * MiB, WUV_OFF = 6 * MiB, WOUTA_OFF = 8 * MiB;
constexpr size_t WS_WB = WS_WA + 2 * WA_STRIDE;
constexpr size_t WB_STRIDE = 4718592, WINB_OFF = 0, WOUTB_OFF = 2621440;
constexpr size_t WS_MOD = 100 * MiB;
constexpr size_t WS_XG = 104 * MiB;
constexpr size_t WS_BIG = 104 * MiB;
constexpr size_t WS_HFF = 168 * MiB;
constexpr size_t WS_QO = 360 * MiB;
constexpr size_t WS_CKV = 424 * MiB;
constexpr size_t WS_QI = 440 * MiB;
constexpr size_t WS_KIN = 472 * MiB;
constexpr size_t WS_WI = 476 * MiB;
constexpr size_t WS_SEL = 477 * MiB;
constexpr size_t WS_RKV = 485 * MiB;
constexpr size_t WS_QKV = 360 * MiB;
constexpr size_t WS_OB = 440 * MiB;
constexpr size_t WS_END = 512 * MiB;

constexpr int RING_BYTES = 131072;
constexpr int LDS_MISC_OFF = 155648;
constexpr int LDS_BYTES = 156672;

#define RLX_AGENT __ATOMIC_RELAXED, __HIP_MEMORY_SCOPE_AGENT
__device__ __forceinline__ unsigned cvt_pk_bf16(float lo, float hi) { unsigned r; asm volatile("v_cvt_pk_bf16_f32 %0, %1, %2" : "=v"(r) : "v"(lo), "v"(hi)); return r; }
__device__ __forceinline__ float bf2f(bf16_t b) { return __uint_as_float(((unsigned)b) << 16); }
__device__ __forceinline__ float wave_sum(float v) {
#pragma unroll
    for (int o = 1; o < 64; o <<= 1) v += __shfl_xor(v, o);
    return v;
}
__device__ __forceinline__ float fast_exp(float x) { return __builtin_amdgcn_exp2f(x * 1.4426950408889634f); }
__device__ __forceinline__ float silu_f(float x) { return x * __builtin_amdgcn_rcpf(1.0f + fast_exp(-x)); }
__device__ __forceinline__ int t5_bucket(int d) {
    if (d < 16) return d;
    int b = 16;
    b += (d >= 19); b += (d >= 21); b += (d >= 24); b += (d >= 27); b += (d >= 31); b += (d >= 35); b += (d >= 40); b += (d >= 46);
    b += (d >= 52); b += (d >= 59); b += (d >= 67); b += (d >= 77); b += (d >= 87); b += (d >= 99); b += (d >= 113);
    return b;
}

#define XB_TMO      128
#define XB_XCNT(j)  (256  + 64 * (j))
#define XB_XSUB(j)  (1280 + 64 * (j))
#define XB_XGEN(j)  (2304 + 64 * (j))
#define XB_TOP      3328
#define XB_TOPGEN   3392
#define XCD_BAR_WORDS 3456
#define XB_SPIN_CAP (1u << 22)

__device__ __forceinline__ unsigned xb_ld(unsigned* p)              { return __hip_atomic_load(p, __ATOMIC_RELAXED, __HIP_MEMORY_SCOPE_AGENT); }
__device__ __forceinline__ unsigned xb_add(unsigned* p, unsigned v) { return __hip_atomic_fetch_add(p, v, __ATOMIC_RELAXED, __HIP_MEMORY_SCOPE_AGENT); }
__device__ __forceinline__ unsigned xb_xcc_id() { return (unsigned)__builtin_amdgcn_s_getreg((3 << 11) | 20) & 0xFu; }
#define XB_SPIN(cond, bar) do { unsigned _sp = 0; while (cond) { __builtin_amdgcn_s_sleep(1); \
    if ((++_sp & 255u) == 0u) { if (xb_ld(&(bar)[XB_TMO])) break; if (_sp > XB_SPIN_CAP) { atomicAdd(&(bar)[XB_TMO], 1u); break; } } } } while (0)

struct XcdBarrier { unsigned* bar; unsigned x; volatile LAS unsigned* st; };

__device__ __forceinline__ XcdBarrier xcd_barrier_post(unsigned* bar, volatile LAS unsigned* st) {
    XcdBarrier b; b.bar = bar; b.x = xb_xcc_id(); b.st = st;
    if (threadIdx.x == 0) (void)xb_add(&bar[XB_XCNT(b.x)], 1u);
    return b;
}
__device__ __forceinline__ void xcd_barrier_complete(unsigned* bar, unsigned x, unsigned& nloc, unsigned& nx) {
    const unsigned G = gridDim.x * gridDim.y * gridDim.z;
    unsigned sum, cnt, mine, sp = 0u;
    for (;;) {
        sum = 0u; cnt = 0u; mine = 0u;
#pragma unroll
        for (unsigned j = 0; j < 16; ++j) { const unsigned c = xb_ld(&bar[XB_XCNT(j)]); sum += c; cnt += (c > 0u) ? 1u : 0u; mine = (j == x) ? c : mine; }
        if (sum == G) break;
        __builtin_amdgcn_s_sleep(1);
        if ((++sp & 255u) == 0u) { if (xb_ld(&bar[XB_TMO])) break; if (sp > XB_SPIN_CAP) { atomicAdd(&bar[XB_TMO], 1u); break; } }
    }
    nloc = mine > 0u ? mine : 1u; nx = cnt > 0u ? cnt : 1u;
}
__device__ __forceinline__ void xcd_barrier(const XcdBarrier& b) {
    asm volatile("s_waitcnt vmcnt(0)" ::: "memory");
    __syncthreads();
    if (threadIdx.x == 0) {
        unsigned* bar = b.bar;
        __builtin_amdgcn_s_waitcnt(0);
        unsigned nloc = b.st[0], nx = b.st[1];
        if (nloc == 0u) { xcd_barrier_complete(bar, b.x, nloc, nx); b.st[0] = nloc; b.st[1] = nx; }
        const unsigned old = xb_add(&bar[XB_XSUB(b.x)], 1u);
        const unsigned gen = old / nloc;
        if (old + 1u == (gen + 1u) * nloc) {
            __builtin_amdgcn_fence(__ATOMIC_RELEASE, "agent");
            asm volatile("s_waitcnt vmcnt(0)" ::: "memory");
            const unsigned og = xb_add(&bar[XB_TOP], 1u);
            const unsigned tg = og / nx;
            if (og + 1u == (tg + 1u) * nx) xb_add(&bar[XB_TOPGEN], 1u);
            else XB_SPIN(xb_ld(&bar[XB_TOPGEN]) == tg, bar);
            __builtin_amdgcn_fence(__ATOMIC_ACQUIRE, "agent");
            xb_add(&bar[XB_XGEN(b.x)], 1u);
            asm volatile("s_waitcnt vmcnt(0)" ::: "memory");
        } else {
            XB_SPIN(xb_ld(&bar[XB_XGEN(b.x)]) == gen, bar);
            __builtin_amdgcn_fence(__ATOMIC_ACQUIRE, "agent");
            asm volatile("s_waitcnt vmcnt(0)" ::: "memory");
        }
    }
    __syncthreads();
}

namespace pg8 {
constexpr int BM = 256, BK = 64, HALF = 128, HTB = HALF * BK * 2, STAGE_BYTES = 8 * HTB, NXCD = 8, WGM = 8;
__host__ __device__ __forceinline__ int lds_byte(int r, int c) { const int st = (r >> 4) * 2 + (c >> 5), rr = r & 15, cc = c & 31, ob = rr * 64 + cc * 2; return st * 1024 + (ob ^ (((ob >> 9) & 1) << 5)); }
__host__ __device__ __forceinline__ void stage_rc(int b, int& R, int& C) { const int st = b / 1024, sb = b % 1024, swz = sb ^ (((sb >> 9) & 1) << 5); R = (st >> 1) * 16 + swz / 64; C = (st & 1) * 32 + (swz % 64) / 2; }
__host__ __device__ __forceinline__ int perm32(int rho) { const int n = rho >> 4, i = rho & 15; return 8 * (i >> 2) + 4 * n + (i & 3); }

struct Unit { int pm, pn; };
struct Gemm { const bf16_t* A; const bf16_t* Bt; int lda, ldb, K, a_shift, a_mul; };

struct StaticOrder {
    int nM, nN, nwg, G, c;
    __device__ void init(int M_, int N_, int G_, int c_) { nM = M_ / BM; nN = N_ / BM; nwg = nM * nN; G = G_; c = c_; }
    __device__ bool next(int i, Unit& u) const {
        const long L = (long)i * G + c; if (L >= nwg) return false;
        int wgid = (int)L; { const int q = nwg / NXCD, r = nwg % NXCD, xcd = wgid % NXCD, off = wgid / NXCD; wgid = (xcd < r ? xcd * (q + 1) : r * (q + 1) + (xcd - r) * q) + off; }
        const int nig = WGM * nN, gid = wgid / nig, fm = gid * WGM, gsz = (nM - fm) < WGM ? (nM - fm) : WGM;
        u.pm = fm + ((wgid % nig) % gsz); u.pn = (wgid % nig) / gsz; return true;
    }
};

template <class Epi, bool ALIGN_EPI>
__device__ __forceinline__ void gemm_phase(LAS unsigned char* lds, const Gemm g, const StaticOrder& S, const Epi& E) {
    int tid = threadIdx.x; asm volatile("" : "+v"(tid));
    const int wid = __builtin_amdgcn_readfirstlane(tid >> 6), lane = tid & 63, wr = wid >> 2, wc = wid & 3, fr = lane & 15, fq = lane >> 4;
    const int K = g.K, nt = K / BK;
    unsigned voffA[2], voffB[2];
#pragma unroll
    for (int i = 0; i < 2; ++i) { int R, C; stage_rc(tid * 16 + i * 8192, R, C); const int Rb = Epi::PERM ? ((R & ~31) + perm32(R & 31)) : R;
        voffA[i] = (unsigned)(R * g.lda + C) * 2u; voffB[i] = (unsigned)(Rb * g.ldb + C) * 2u; }
    const size_t kstep = (size_t)(BK * 2);
    const size_t hstepA = (size_t)HALF * g.lda * 2, hstepB = (size_t)HALF * g.ldb * 2;
    const unsigned ldsw = (unsigned)wid * 1024u;
    const int aoff = lds_byte(wr * 64 + fr, fq * 8), boff = lds_byte(wc * 32 + fr, fq * 8);
#define PG8_SA(b, h) (((b) * 2 + (h)) * HTB)
#define PG8_SB(b, h) ((4 + (b) * 2 + (h)) * HTB)
#define PG8_STAGE(bufoff, gbase, voff) do { _Pragma("unroll") for (int _i = 0; _i < 2; ++_i) \
        __builtin_amdgcn_global_load_lds((const unsigned*)((const char*)(gbase) + (voff)[_i]), (LAS unsigned*)(lds + (bufoff) + ldsw + _i * 8192), 16, 0, 0); } while (0)
#define PG8_LDA(dst, b, h) do { _Pragma("unroll") for (int m = 0; m < 4; ++m) _Pragma("unroll") for (int k = 0; k < 2; ++k) dst[m][k] = *(const LAS bf16x8*)(lds + PG8_SA(b, h) + aoff + m * 2048 + k * 1024); } while (0)
#define PG8_LDB(dst, b, h) do { _Pragma("unroll") for (int n = 0; n < 2; ++n) _Pragma("unroll") for (int k = 0; k < 2; ++k) dst[n][k] = *(const LAS bf16x8*)(lds + PG8_SB(b, h) + boff + n * 2048 + k * 1024); } while (0)
#define PG8_MMA(ai, bj, At, Bt) do { __builtin_amdgcn_s_setprio(1); _Pragma("unroll") for (int m = 0; m < 4; ++m) _Pragma("unroll") for (int n = 0; n < 2; ++n) _Pragma("unroll") for (int k = 0; k < 2; ++k) \
        acc[ai][bj][m][n] = __builtin_amdgcn_mfma_f32_16x16x32_bf16(Bt[n][k], At[m][k], acc[ai][bj][m][n], 0, 0, 0); __builtin_amdgcn_s_setprio(0); } while (0)
#define PG8_WAIT_V(n) asm volatile("s_waitcnt vmcnt(" #n ")" ::: "memory")
#define PG8_WAIT_L(n) asm volatile("s_waitcnt lgkmcnt(" #n ")" ::: "memory")
#define PG8_BAR __builtin_amdgcn_s_barrier()
#define PG8_SCHED __builtin_amdgcn_sched_barrier(0)
#define PG8_ABASE(u) ((const char*)g.A + ((size_t)(u).pm * BM * g.lda + (size_t)((u).pn >> g.a_shift) * g.a_mul) * 2)
#define PG8_BBASE(u) ((const char*)g.Bt + (size_t)(u).pn * BM * g.ldb * 2)
    Unit cur, nxt; int ui = 0;
    if (!S.next(0, cur)) return;
    f32x4 acc[2][2][4][2];
#pragma unroll
    for (int a = 0; a < 2; ++a)
#pragma unroll
        for (int b = 0; b < 2; ++b)
#pragma unroll
            for (int m = 0; m < 4; ++m)
#pragma unroll
                for (int n = 0; n < 2; ++n) acc[a][b][m][n] = (f32x4){0.f, 0.f, 0.f, 0.f};
    bf16x8 At[4][2], B0[2][2], B1[2][2];
    const char* cA = PG8_ABASE(cur); const char* cB = PG8_BBASE(cur);
    PG8_STAGE(PG8_SB(0, 0), cB, voffB); PG8_STAGE(PG8_SB(0, 1), cB + hstepB, voffB); PG8_STAGE(PG8_SA(0, 0), cA, voffA); PG8_STAGE(PG8_SA(0, 1), cA + hstepA, voffA);
    if (wr == 1) PG8_BAR;
    PG8_WAIT_V(2); PG8_BAR;
    PG8_STAGE(PG8_SB(1, 0), cB + kstep, voffB); PG8_STAGE(PG8_SA(1, 0), cA + kstep, voffA); PG8_STAGE(PG8_SB(1, 1), cB + hstepB + kstep, voffB);
    PG8_WAIT_V(6); PG8_BAR;
    for (;;) {
        const bool has_next = S.next(ui + 1, nxt);
        const char* nA = has_next ? PG8_ABASE(nxt) : cA; const char* nB = has_next ? PG8_BBASE(nxt) : cB;
        for (int t = 0; t < nt; t += 2) {
            const bool last = (t == nt - 2);
            const char* a1 = cA + (size_t)(t + 1) * kstep;
            const char* a2 = last ? nA : cA + (size_t)(t + 2) * kstep; const char* b2 = last ? nB : cB + (size_t)(t + 2) * kstep;
            const char* a3 = a2 + kstep; const char* b3 = b2 + kstep;
            PG8_LDB(B0, 0, 0); PG8_LDB(B1, 0, 1); PG8_SCHED; PG8_LDA(At, 0, 0); PG8_STAGE(PG8_SA(1, 1), a1 + hstepA, voffA);
            PG8_WAIT_V(8); PG8_WAIT_L(0); PG8_BAR; PG8_MMA(0, 0, At, B0); PG8_MMA(0, 1, At, B1); PG8_BAR; PG8_SCHED;
            PG8_LDA(At, 0, 1); PG8_STAGE(PG8_SB(0, 0), b2, voffB); PG8_STAGE(PG8_SB(0, 1), b2 + hstepB, voffB); PG8_STAGE(PG8_SA(0, 0), a2, voffA);
            PG8_WAIT_V(8); PG8_WAIT_L(0); PG8_BAR; PG8_MMA(1, 0, At, B0); PG8_MMA(1, 1, At, B1); PG8_BAR; PG8_SCHED;
            PG8_LDB(B0, 1, 0); PG8_LDB(B1, 1, 1); PG8_SCHED; PG8_LDA(At, 1, 0); PG8_STAGE(PG8_SA(0, 1), a2 + hstepA, voffA);
            PG8_WAIT_V(8); PG8_WAIT_L(0); PG8_BAR; PG8_MMA(0, 0, At, B0); PG8_MMA(0, 1, At, B1); PG8_BAR; PG8_SCHED;
            PG8_LDA(At, 1, 1); PG8_STAGE(PG8_SB(1, 0), b3, voffB); PG8_STAGE(PG8_SB(1, 1), b3 + hstepB, voffB); PG8_STAGE(PG8_SA(1, 0), a3, voffA);
            PG8_WAIT_V(8); PG8_WAIT_L(0); PG8_BAR; PG8_MMA(1, 0, At, B0); PG8_MMA(1, 1, At, B1); PG8_BAR; PG8_SCHED;
        }
        if constexpr (ALIGN_EPI) { if (wr == 0) PG8_BAR; }
        E(acc, cur, wr, wc, fr, fq);
        if (!has_next) break;
#pragma unroll
        for (int a = 0; a < 2; ++a)
#pragma unroll
            for (int b = 0; b < 2; ++b)
#pragma unroll
                for (int m = 0; m < 4; ++m)
#pragma unroll
                    for (int n = 0; n < 2; ++n) acc[a][b][m][n] = (f32x4){0.f, 0.f, 0.f, 0.f};
        cur = nxt; cA = nA; cB = nB; ++ui;
        if constexpr (ALIGN_EPI) { if (wr == 1) PG8_BAR; }
    }
    PG8_WAIT_V(0);
    if constexpr (!ALIGN_EPI) { if (wr == 0) PG8_BAR; }
    PG8_BAR;
#undef PG8_SA
#undef PG8_SB
#undef PG8_STAGE
#undef PG8_LDA
#undef PG8_LDB
#undef PG8_MMA
#undef PG8_WAIT_V
#undef PG8_WAIT_L
#undef PG8_BAR
#undef PG8_SCHED
#undef PG8_ABASE
#undef PG8_BBASE
}

struct EpiBf16Plain {
    static constexpr bool PERM = true;
    bf16_t* O; int ldc; const float* bias;
    __device__ __forceinline__ void operator()(const f32x4 (&acc)[2][2][4][2], const Unit& u, int wr, int wc, int fr, int fq) const {
        const int row0 = u.pm * BM + wr * 64 + fr, col0 = u.pn * BM + wc * 32 + 8 * fq;
        f32x4 bv[2][2];
#pragma unroll
        for (int bj = 0; bj < 2; ++bj)
#pragma unroll
            for (int n = 0; n < 2; ++n) bv[bj][n] = bias ? *(const f32x4*)(bias + col0 + bj * HALF + 4 * n) : (f32x4){0.f, 0.f, 0.f, 0.f};
#pragma unroll
        for (int ai = 0; ai < 2; ++ai)
#pragma unroll
            for (int m = 0; m < 4; ++m) { bf16_t* rowp = O + (size_t)(row0 + ai * HALF + m * 16) * ldc + col0;
#pragma unroll
                for (int bj = 0; bj < 2; ++bj) { const f32x4 v0 = acc[ai][bj][m][0] + bv[bj][0], v1 = acc[ai][bj][m][1] + bv[bj][1];
                    u32x4 w; w.x = cvt_pk_bf16(v0[0], v0[1]); w.y = cvt_pk_bf16(v0[2], v0[3]); w.z = cvt_pk_bf16(v1[0], v1[1]); w.w = cvt_pk_bf16(v1[2], v1[3]);
                    *(u32x4*)(rowp + bj * HALF) = w; } }
    }
};
struct EpiInA {
    static constexpr bool PERM = true;
    bf16_t* Q; bf16_t* CKV; bf16_t* QI; bf16_t* KIN; float* WI; const float* kg; const float* kb;
    __device__ __forceinline__ void operator()(const f32x4 (&acc)[2][2][4][2], const Unit& u, int wr, int wc, int fr, int fq) const {
        const int row0 = u.pm * BM + wr * 64 + fr, cl = wc * 32 + 8 * fq;
        if (u.pn < 7) {
            bf16_t* base; int ldc, c0;
            if (u.pn < 4) { base = Q; ldc = 1024; c0 = u.pn * 256; } else if (u.pn == 4) { base = CKV; ldc = 256; c0 = 0; } else { base = QI; ldc = 512; c0 = (u.pn - 5) * 256; }
#pragma unroll
            for (int ai = 0; ai < 2; ++ai)
#pragma unroll
                for (int m = 0; m < 4; ++m) { bf16_t* rowp = base + (size_t)(row0 + ai * HALF + m * 16) * ldc + c0 + cl;
#pragma unroll
                    for (int bj = 0; bj < 2; ++bj) { const f32x4 v0 = acc[ai][bj][m][0], v1 = acc[ai][bj][m][1];
                        u32x4 w; w.x = cvt_pk_bf16(v0[0], v0[1]); w.y = cvt_pk_bf16(v0[2], v0[3]); w.z = cvt_pk_bf16(v1[0], v1[1]); w.w = cvt_pk_bf16(v1[2], v1[3]);
                        *(u32x4*)(rowp + bj * HALF) = w; } }
        } else if (wc == 0) {
            f32x4 gv[2][2], bv[2][2];
#pragma unroll
            for (int bj = 0; bj < 2; ++bj)
#pragma unroll
                for (int n = 0; n < 2; ++n) { gv[bj][n] = *(const f32x4*)(kg + 32 * bj + 8 * fq + 4 * n); bv[bj][n] = *(const f32x4*)(kb + 32 * bj + 8 * fq + 4 * n); }
#pragma unroll
            for (int ai = 0; ai < 2; ++ai)
#pragma unroll
                for (int m = 0; m < 4; ++m) {
                    float s = 0.f;
#pragma unroll
                    for (int bj = 0; bj < 2; ++bj)
#pragma unroll
                        for (int n = 0; n < 2; ++n) { const f32x4 x = acc[ai][bj][m][n]; s += (x[0] + x[1]) + (x[2] + x[3]); }
                    s += __shfl_xor(s, 16); s += __shfl_xor(s, 32);
                    const float mu = s * (1.0f / 64.0f); float q = 0.f;
#pragma unroll
                    for (int bj = 0; bj < 2; ++bj)
#pragma unroll
                        for (int n = 0; n < 2; ++n) { const f32x4 d = acc[ai][bj][m][n] - mu; q += (d[0] * d[0] + d[1] * d[1]) + (d[2] * d[2] + d[3] * d[3]); }
                    q += __shfl_xor(q, 16); q += __shfl_xor(q, 32);
                    const float rs = 1.0f / sqrtf(q * (1.0f / 64.0f) + EPS);
                    bf16_t* rowp = KIN + (size_t)(row0 + ai * HALF + m * 16) * 64 + 8 * fq;
#pragma unroll
                    for (int bj = 0; bj < 2; ++bj) { const f32x4 v0 = (acc[ai][bj][m][0] - mu) * rs * gv[bj][0] + bv[bj][0], v1 = (acc[ai][bj][m][1] - mu) * rs * gv[bj][1] + bv[bj][1];
                        u32x4 w; w.x = cvt_pk_bf16(v0[0], v0[1]); w.y = cvt_pk_bf16(v0[2], v0[3]); w.z = cvt_pk_bf16(v1[0], v1[1]); w.w = cvt_pk_bf16(v1[2], v1[3]);
                        *(u32x4*)(rowp + bj * 32) = w; }
                }
        } else if (wc == 1 && fq == 0) {
            const float sc = 0.04419417382415922f;
#pragma unroll
            for (int ai = 0; ai < 2; ++ai)
#pragma unroll
                for (int m = 0; m < 4; ++m) { float* rowp = WI + (size_t)(row0 + ai * HALF + m * 16) * 8;
                    *(f32x4*)(rowp) = acc[ai][0][m][0] * sc; *(f32x4*)(rowp + 4) = acc[ai][0][m][1] * sc; }
        }
    }
};
struct EpiResid {
    static constexpr bool PERM = false;
    const float* xin; float* xout; const float* gate; const float* bias;
    __device__ __forceinline__ void operator()(const f32x4 (&acc)[2][2][4][2], const Unit& u, int wr, int wc, int fr, int fq) const {
        const int row0 = u.pm * BM + wr * 64 + fr, col0 = u.pn * BM + wc * 32 + 4 * fq;
        const float* gp = gate + (size_t)(u.pm >> 3) * 6144;
        f32x4 gv[2][2], bv[2][2];
#pragma unroll
        for (int bj = 0; bj < 2; ++bj)
#pragma unroll
            for (int n = 0; n < 2; ++n) { gv[bj][n] = *(const f32x4*)(gp + col0 + bj * HALF + n * 16); bv[bj][n] = bias ? *(const f32x4*)(bias + col0 + bj * HALF + n * 16) : (f32x4){0.f, 0.f, 0.f, 0.f}; }
#pragma unroll
        for (int ai = 0; ai < 2; ++ai)
#pragma unroll
            for (int m = 0; m < 4; ++m) { const size_t off = (size_t)(row0 + ai * HALF + m * 16) * D + col0;
#pragma unroll
                for (int bj = 0; bj < 2; ++bj)
#pragma unroll
                    for (int n = 0; n < 2; ++n) { const f32x4 xi = *(const f32x4*)(xin + off + bj * HALF + n * 16);
                        *(f32x4*)(xout + off + bj * HALF + n * 16) = xi + gv[bj][n] * (acc[ai][bj][m][n] + bv[bj][n]); }
                asm volatile("" ::: "memory"); }
    }
};
struct EpiSwiGLU {
    static constexpr bool PERM = true;
    bf16_t* H;
    __device__ __forceinline__ void operator()(const f32x4 (&acc)[2][2][4][2], const Unit& u, int wr, int wc, int fr, int fq) const {
        const int row0 = u.pm * BM + wr * 64 + fr, f0 = u.pn * 128 + wc * 32 + 8 * fq;
#pragma unroll
        for (int ai = 0; ai < 2; ++ai)
#pragma unroll
            for (int m = 0; m < 4; ++m) { bf16_t* rowp = H + (size_t)(row0 + ai * HALF + m * 16) * DFF + f0;
                float o[8];
#pragma unroll
                for (int n = 0; n < 2; ++n)
#pragma unroll
                    for (int e = 0; e < 4; ++e) o[4 * n + e] = silu_f(acc[ai][0][m][n][e]) * acc[ai][1][m][n][e];
                u32x4 w; w.x = cvt_pk_bf16(o[0], o[1]); w.y = cvt_pk_bf16(o[2], o[3]); w.z = cvt_pk_bf16(o[4], o[5]); w.w = cvt_pk_bf16(o[6], o[7]);
                *(u32x4*)(rowp) = w; }
    }
};
}

struct Ptrs {
    const float* in[23]; float* out; unsigned char* ws;
};
enum { I_X = 0, I_C, I_RELB, I_WADA, I_BADA, I_GMIX, I_GFFN, I_AWIN, I_AKVG, I_AWUK, I_AWUV, I_AIKG, I_AIKB, I_AWOUT, I_BWIN, I_BBIN, I_BSINK, I_BWOUT, I_BBOUT, I_W1, I_W3, I_W2, I_GFIN };

__device__ __forceinline__ void conv_task(const Ptrs& P, int t, int lane) {
    int kind, rb, ks, Kd; bf16_t* dst; const float* s0 = nullptr; const float* s1 = nullptr; const float* gk = nullptr; int ld = 0;
    if (t < 2112) { const int l = t / 528, r = t % 528; unsigned char* wl = P.ws + WS_W + (size_t)l * W_LAYER;
        if (r < 352) { kind = 1; rb = r >> 2; ks = r & 3; Kd = 1024; dst = (bf16_t*)(wl + W13_OFF); s0 = P.in[I_W1] + (size_t)l * D * DFF; s1 = P.in[I_W3] + (size_t)l * D * DFF; ld = DFF; }
        else { const int r2 = r - 352; kind = 0; rb = r2 / 11; ks = r2 % 11; Kd = DFF; dst = (bf16_t*)(wl + W2_OFF); s0 = P.in[I_W2] + (size_t)l * DFF * D; ld = D; }
    } else { const int t2 = t - 2112, j = t2 / 464, r = t2 % 464; unsigned char* wa = P.ws + WS_WA + (size_t)j * WA_STRIDE; unsigned char* wb = P.ws + WS_WB + (size_t)j * WB_STRIDE;
        if (r < 128) { kind = 2; rb = r >> 2; ks = r & 3; Kd = 1024; dst = (bf16_t*)(wa + WINA_OFF); s0 = P.in[I_AWIN] + (size_t)j * D * A_IN; ld = A_IN; }
        else if (r < 192) { kind = 3; rb = r - 128; ks = 0; Kd = 256; dst = (bf16_t*)(wa + WQA_OFF); s0 = P.in[I_AWUK] + (size_t)j * NH * RK * HD; gk = P.in[I_AKVG] + j * RK; }
        else if (r < 256) { const int r2 = r - 192; kind = 4; rb = r2 >> 2; ks = r2 & 3; Kd = 1024; dst = (bf16_t*)(wa + WUV_OFF); s0 = P.in[I_AWUV] + (size_t)j * NH * RK * HD; gk = P.in[I_AKVG] + j * RK; }
        else if (r < 320) { const int r2 = r - 256; kind = 0; rb = r2 >> 2; ks = r2 & 3; Kd = 1024; dst = (bf16_t*)(wa + WOUTA_OFF); s0 = P.in[I_AWOUT] + (size_t)j * D * D; ld = D; }
        else if (r < 400) { const int r2 = r - 320; kind = 0; rb = r2 >> 2; ks = r2 & 3; Kd = 1024; dst = (bf16_t*)(wb + WINB_OFF); s0 = P.in[I_BWIN] + (size_t)j * D * B_IN; ld = B_IN; }
        else { const int r2 = r - 400; kind = 0; rb = r2 >> 2; ks = r2 & 3; Kd = 1024; dst = (bf16_t*)(wb + WOUTB_OFF); s0 = P.in[I_BWOUT] + (size_t)j * D * D; ld = D; }
    }
    const int n = rb * 64 + lane, k0 = ks * 256;
    bf16_t* drow = dst + (size_t)n * Kd + k0;
    if (kind <= 2) {
        const float* src = s0; int col = n;
        if (kind == 1) { const int c = n & 255, f = (n >> 8) * 128 + (c & 127); src = (c < 128) ? s0 : s1; col = f; }
        if (kind == 2) { if (n >= 1792) { const int c = n - 1792; col = c < 32 ? 1792 + c : (c < 40 ? 1856 + (c - 32) : ((c >= 128 && c < 160) ? 1824 + (c - 128) : -1)); } }
        const float* sp = src + (size_t)k0 * ld + (col < 0 ? 0 : col);
        for (int kc = 0; kc < 32; ++kc) {
            float v[8];
#pragma unroll
            for (int e = 0; e < 8; ++e) v[e] = sp[(size_t)(kc * 8 + e) * ld];
            if (col < 0) {
#pragma unroll
                for (int e = 0; e < 8; ++e) v[e] = 0.f; }
            u32x4 w; w.x = cvt_pk_bf16(v[0], v[1]); w.y = cvt_pk_bf16(v[2], v[3]); w.z = cvt_pk_bf16(v[4], v[5]); w.w = cvt_pk_bf16(v[6], v[7]);
            *(u32x4*)(drow + kc * 8) = w;
        }
    } else if (kind == 3) {
        const int h = n >> 8, r = n & 255; const float gs = gk[r] * 0.125f; const float* sp = s0 + ((size_t)h * RK + r) * HD;
        for (int kc = 0; kc < 32; ++kc) { const int k = kc * 8; float v[8];
            if ((k >> 6) == (h & 3)) {
#pragma unroll
                for (int e = 0; e < 8; ++e) v[e] = sp[(k & 63) + e] * gs;
            } else {
#pragma unroll
                for (int e = 0; e < 8; ++e) v[e] = 0.f; }
            u32x4 w; w.x = cvt_pk_bf16(v[0], v[1]); w.y = cvt_pk_bf16(v[2], v[3]); w.z = cvt_pk_bf16(v[4], v[5]); w.w = cvt_pk_bf16(v[6], v[7]);
            *(u32x4*)(drow + kc * 8) = w; }
    } else {
        const int hh = (n >> 6) & 3, d = n & 63, h = n >> 6;
        for (int kc = 0; kc < 32; ++kc) { const int k = k0 + kc * 8; float v[8];
            if ((k >> 8) == hh) {
#pragma unroll
                for (int e = 0; e < 8; ++e) { const int r = (k & 255) + e; v[e] = s0[((size_t)h * RK + r) * HD + d] * gk[r]; }
            } else {
#pragma unroll
                for (int e = 0; e < 8; ++e) v[e] = 0.f; }
            u32x4 w; w.x = cvt_pk_bf16(v[0], v[1]); w.y = cvt_pk_bf16(v[2], v[3]); w.z = cvt_pk_bf16(v[4], v[5]); w.w = cvt_pk_bf16(v[6], v[7]);
            *(u32x4*)(drow + kc * 8) = w; }
    }
}
constexpr int N_CONV_TASKS = 3040;

__device__ __forceinline__ void p0_prologue(const Ptrs& P, LAS unsigned char* lds, int G) {
    int tid = threadIdx.x; asm volatile("" : "+v"(tid));
    const int lane = tid & 63, wave = __builtin_amdgcn_readfirstlane(tid >> 6);
    const int gw = blockIdx.x * NWAVES + wave, NGW = G * NWAVES;
    for (int t = gw; t < N_CONV_TASKS; t += NGW) conv_task(P, t, lane);
    LAS float* cs = (LAS float*)lds;
    LAS float* red = (LAS float*)(lds + 65536);
    for (int i = tid; i < BATCH * D; i += NTHR) { const int b = i >> 10, k = i & 1023; cs[k * 16 + b] = silu_f(P.in[I_C][i]); }
    __syncthreads();
    float* mod = (float*)(P.ws + WS_MOD);
    for (int task = blockIdx.x; task < 4 * 96; task += G) {
        const int l = task / 96, j0 = (task % 96) * 64, col = tid & 63, ksl = tid >> 6;
        const float* wp = P.in[I_WADA] + ((size_t)l * D + ksl * 128) * 6144 + j0 + col;
        float a[16];
#pragma unroll
        for (int b = 0; b < 16; ++b) a[b] = 0.f;
        for (int k = 0; k < 128; ++k) { const float w = wp[(size_t)k * 6144]; const LAS f32x4* c4 = (const LAS f32x4*)(cs + (ksl * 128 + k) * 16);
#pragma unroll
            for (int q = 0; q < 4; ++q) { const f32x4 c = c4[q];
#pragma unroll
                for (int e = 0; e < 4; ++e) a[4 * q + e] += w * c[e]; } }
#pragma unroll
        for (int b = 0; b < 16; ++b) red[(ksl * 64 + col) * 16 + b] = a[b];
        __syncthreads();
        for (int o = tid; o < 1024; o += NTHR) { const int c2 = o >> 4, b = o & 15; float s = 0.f;
#pragma unroll
            for (int q = 0; q < 8; ++q) s += red[(q * 64 + c2) * 16 + b];
            mod[((size_t)l * BATCH + b) * 6144 + j0 + c2] = s + P.in[I_BADA][l * 6144 + j0 + c2]; }
        __syncthreads();
    }
}

__device__ __forceinline__ void norm_phase(const float* x, bf16_t* XG, const float* g, const float* modl, int sh_off, int sc_off, int G) {
    int tid = threadIdx.x; asm volatile("" : "+v"(tid));
    const int lane = tid & 63, wave = __builtin_amdgcn_readfirstlane(tid >> 6);
    const int gw = blockIdx.x * NWAVES + wave, NGW = G * NWAVES;
    for (int row = gw; row < M; row += NGW) {
        const int b = row >> 11;
        const f32x4* xr = (const f32x4*)(x + (size_t)row * D) + lane;
        f32x4 v[4]; float s = 0.f;
#pragma unroll
        for (int j = 0; j < 4; ++j) { v[j] = xr[64 * j]; s += (v[j][0] * v[j][0] + v[j][1] * v[j][1]) + (v[j][2] * v[j][2] + v[j][3] * v[j][3]); }
        const float rstd = 1.0f / sqrtf(wave_sum(s) * (1.0f / D) + EPS);
        const float* mb = modl + (size_t)b * 6144;
        u32x2* o8 = (u32x2*)(XG + (size_t)row * D) + lane;
#pragma unroll
        for (int j = 0; j < 4; ++j) { const int c = 4 * lane + 256 * j;
            const f32x4 gg = *(const f32x4*)(g + c), sc = *(const f32x4*)(mb + sc_off + c), sh = *(const f32x4*)(mb + sh_off + c);
            const f32x4 y = v[j] * rstd * gg * (sc + 1.0f) + sh;
            u32x2 w; w.x = cvt_pk_bf16(y[0], y[1]); w.y = cvt_pk_bf16(y[2], y[3]); o8[64 * j] = w; }
    }
}
__device__ __forceinline__ void final_norm_phase(float* x, const float* g, int G) {
    int tid = threadIdx.x; asm volatile("" : "+v"(tid));
    const int lane = tid & 63, wave = __builtin_amdgcn_readfirstlane(tid >> 6);
    const int gw = blockIdx.x * NWAVES + wave, NGW = G * NWAVES;
    for (int row = gw; row < M; row += NGW) {
        f32x4* xr = (f32x4*)(x + (size_t)row * D) + lane;
        f32x4 v[4]; float s = 0.f;
#pragma unroll
        for (int j = 0; j < 4; ++j) { v[j] = xr[64 * j]; s += (v[j][0] * v[j][0] + v[j][1] * v[j][1]) + (v[j][2] * v[j][2] + v[j][3] * v[j][3]); }
        const float rstd = 1.0f / sqrtf(wave_sum(s) * (1.0f / D) + EPS);
#pragma unroll
        for (int j = 0; j < 4; ++j) { const f32x4 gg = *(const f32x4*)(g + 4 * lane + 256 * j); xr[64 * j] = v[j] * rstd * gg; }
    }
}

__device__ __forceinline__ unsigned f2key(float f) { const unsigned u = __float_as_uint(f); return (u & 0x80000000u) ? ~u : (u | 0x80000000u); }
__device__ __forceinline__ float key2f(unsigned k) { return __uint_as_float((k & 0x80000000u) ? (k & 0x7fffffffu) : ~k); }
__device__ __forceinline__ int half_sum(int v) {
#pragma unroll
    for (int o = 1; o < 32; o <<= 1) v += __shfl_xor(v, o);
    return v;
}
__device__ __forceinline__ void idx_task(const bf16_t* QI, const bf16_t* KIN, const float* WI, unsigned* SEL, int b, int tg, int lane) {
    asm volatile("" : "+v"(lane));
    const int t0 = tg * 4, h = lane >> 5, r = lane & 31;
    const int qsel = 2 * (r >> 4) + ((r >> 2) & 1), hd = (r & 3) + 4 * ((r >> 3) & 1);
    const size_t rowb = (size_t)b * SEQ;
    bf16x8 aq[4];
#pragma unroll
    for (int ks = 0; ks < 4; ++ks) aq[ks] = *(const bf16x8*)(QI + (rowb + t0 + qsel) * 512 + hd * 64 + ks * 16 + h * 8);
    float wlo[8], whi[8];
    { const f32x4 a0 = *(const f32x4*)(WI + (rowb + t0 + h) * 8), a1 = *(const f32x4*)(WI + (rowb + t0 + h) * 8 + 4);
      const f32x4 b0 = *(const f32x4*)(WI + (rowb + t0 + 2 + h) * 8), b1 = *(const f32x4*)(WI + (rowb + t0 + 2 + h) * 8 + 4);
#pragma unroll
      for (int e = 0; e < 4; ++e) { wlo[e] = a0[e]; wlo[4 + e] = a1[e]; whi[e] = b0[e]; whi[4 + e] = b1[e]; } }
    float slo[64], shi[64];
#pragma unroll
    for (int kt = 0; kt < 64; ++kt) { slo[kt] = NEGF; shi[kt] = NEGF; }
    const int ktmax = (t0 + 3) >> 5, tlo = t0 + h, thi = t0 + 2 + h;
    const bf16_t* kp = KIN + (rowb + r) * 64 + h * 8;
#pragma unroll
    for (int kt = 0; kt < 64; ++kt) {
        if (kt <= ktmax) {
            asm volatile("" : "+v"(kp));
            f32x16 acc;
#pragma unroll
            for (int i = 0; i < 16; ++i) acc[i] = 0.f;
#pragma unroll
            for (int ks = 0; ks < 4; ++ks) { const bf16x8 bk = *(const bf16x8*)(kp + ks * 16); acc = __builtin_amdgcn_mfma_f32_32x32x16_bf16(aq[ks], bk, acc, 0, 0, 0); }
            float s0 = 0.f, s1 = 0.f;
#pragma unroll
            for (int i = 0; i < 8; ++i) { s0 += wlo[i] * fmaxf(acc[i], 0.f); s1 += whi[i] * fmaxf(acc[8 + i], 0.f); }
            const int key = kt * 32 + r;
            slo[kt] = key <= tlo ? s0 : NEGF; shi[kt] = key <= thi ? s1 : NEGF;
            kp += 32 * 64;
        }
    }
    const int Ka = tlo + 1 < TOPK ? tlo + 1 : TOPK, Kb = thi + 1 < TOPK ? thi + 1 : TOPK;
    unsigned loA = 0x00800000u, hiA = 0xFF800000u, loB = 0x00800000u, hiB = 0xFF800000u;
    float TA = -1e29f, TB = -1e29f; bool doneA = (tlo + 1 <= TOPK), doneB = (thi + 1 <= TOPK);
    for (int it = 0; it < 40; ++it) {
        if (__ballot(!doneA || !doneB) == 0ull) break;
        const unsigned midA = loA + ((hiA - loA) >> 1), midB = loB + ((hiB - loB) >> 1);
        const float fA = doneA ? TA : key2f(midA), fB = doneB ? TB : key2f(midB);
        int cA = 0, cB = 0;
#pragma unroll
        for (int kt = 0; kt < 64; ++kt) { cA += (slo[kt] >= fA) ? 1 : 0; cB += (shi[kt] >= fB) ? 1 : 0; }
        cA = half_sum(cA); cB = half_sum(cB);
        if (!doneA) { if (cA == Ka) { TA = fA; doneA = true; } else if (cA > Ka) loA = midA; else hiA = midA;
            if (!doneA && hiA - loA <= 1u) { TA = key2f(loA); doneA = true; } }
        if (!doneB) { if (cB == Kb) { TB = fB; doneB = true; } else if (cB > Kb) loB = midB; else hiB = midB;
            if (!doneB && hiB - loB <= 1u) { TB = key2f(loB); doneB = true; } }
    }
    unsigned w0 = 0u, w1 = 0u, w2 = 0u, w3 = 0u;
#pragma unroll
    for (int kt = 0; kt < 64; ++kt) { const unsigned long long ma = __ballot(slo[kt] >= TA), mb = __ballot(shi[kt] >= TB);
        if (lane == kt) { w0 = (unsigned)ma; w1 = (unsigned)(ma >> 32); w2 = (unsigned)mb; w3 = (unsigned)(mb >> 32); } }
    SEL[(rowb + t0 + 0) * 64 + lane] = w0; SEL[(rowb + t0 + 1) * 64 + lane] = w1; SEL[(rowb + t0 + 2) * 64 + lane] = w2; SEL[(rowb + t0 + 3) * 64 + lane] = w3;
}

__device__ __forceinline__ s16x4 tr_read(unsigned lds_addr) { s16x4 r; asm volatile("ds_read_b64_tr_b16 %0, %1\n\ts_waitcnt lgkmcnt(0)" : "=&v"(r) : "v"(lds_addr) : "memory"); return r; }

__device__ __forceinline__ void att_query(const bf16_t* CKV, const float* RKV, const unsigned* SEL, bf16_t* BIG, LAS unsigned char* kvbuf, LAS unsigned* kmeta, LAS float* krstd,
                                          const LAS float* relb, int b, int t, int lane) {
    asm volatile("" : "+v"(lane));
    const size_t row = (size_t)b * SEQ + t, rowb = (size_t)b * SEQ;
    const int hq = lane & 15, g = lane >> 4;
    unsigned w = SEL[row * 64 + lane];
    const int pc = __popc(w); int incl = pc;
#pragma unroll
    for (int o = 1; o < 64; o <<= 1) { const int v = __shfl_up(incl, o); if (lane >= o) incl += v; }
    const int total = __shfl(incl, 63); const int cnt = total < TOPK ? total : TOPK;
    int off = incl - pc;
    while (w) { const int bit = __builtin_ctz(w); w &= w - 1u;
        if (off < TOPK) { const int idx = 32 * lane + bit; const int dd = t - idx; kmeta[off] = (unsigned)idx | ((unsigned)t5_bucket(dd < 0 ? 0 : dd) << 16); krstd[off] = RKV[rowb + idx]; }
        ++off; }
    const int nch = (cnt + 31) >> 5;
    for (int s = cnt + lane; s < nch * 32; s += 64) { kmeta[s] = 0u; krstd[s] = 0.f; }
    bf16x8 bq[8];
    { const bf16_t* qp = BIG + row * 4096 + hq * 256 + 8 * g;
#pragma unroll
      for (int ks = 0; ks < 8; ++ks) bq[ks] = *(const bf16x8*)(qp + 32 * ks); }
    f32x4 O[16];
#pragma unroll
    for (int nt = 0; nt < 16; ++nt) O[nt] = (f32x4){0.f, 0.f, 0.f, 0.f};
    float mref = NEGF, lsum = 0.f;
    const unsigned kvb = (unsigned)(size_t)kvbuf;
    const unsigned qk_base = kvb + (unsigned)(lane & 15) * 512u;
    const int swz = 2 * (lane & 7);
    const int i16 = lane & 15, tq = i16 >> 2, tp = i16 & 3, trow = 4 * g + tq;
    const unsigned tr_base = kvb + (unsigned)trow * 512u + 8u * (unsigned)(tp & 1);
    const int tswz = 2 * (trow & 7);
    for (int c = 0; c < nch; ++c) {
        const unsigned meta = kmeta[32 * c + (lane & 31)];
        asm volatile("s_waitcnt lgkmcnt(0)" ::: "memory");
#pragma unroll
        for (int i = 0; i < 16; ++i) {
            const unsigned m0 = __builtin_amdgcn_readlane(meta, 2 * i), m1 = __builtin_amdgcn_readlane(meta, 2 * i + 1);
            const unsigned idx = ((lane >> 5) ? m1 : m0) & 0xffffu;
            const int rr = (2 * i + (lane >> 5)) & 7;
            const bf16_t* src = CKV + (rowb + idx) * 256 + 8 * ((lane & 31) ^ (2 * rr));
            __builtin_amdgcn_global_load_lds((const unsigned*)src, (LAS unsigned*)(kvbuf + 1024 * i), 16, 0, 0);
        }
        asm volatile("s_waitcnt vmcnt(0)" ::: "memory");
        f32x4 st[2];
#pragma unroll
        for (int T = 0; T < 2; ++T) { st[T] = (f32x4){0.f, 0.f, 0.f, 0.f};
#pragma unroll
            for (int ks = 0; ks < 8; ++ks) { const bf16x8 a = *(const LAS bf16x8*)(size_t)(qk_base + (unsigned)T * 8192u + 16u * (unsigned)((4 * ks + g) ^ swz));
                st[T] = __builtin_amdgcn_mfma_f32_16x16x32_bf16(a, bq[ks], st[T], 0, 0, 0); } }
        float lg[8], rs[8]; float cmax = NEGF;
#pragma unroll
        for (int T = 0; T < 2; ++T) { const int s0 = 32 * c + 16 * T + 4 * g;
            const u32x4 mt = *(const LAS u32x4*)(kmeta + s0); const f32x4 rv = *(const LAS f32x4*)(krstd + s0);
#pragma unroll
            for (int i = 0; i < 4; ++i) { const float bias = relb[(mt[i] >> 16) * 16 + hq]; rs[4 * T + i] = rv[i];
                float v = st[T][i] * rv[i] + bias; v = (s0 + i < cnt) ? v : NEGF; lg[4 * T + i] = v; cmax = fmaxf(cmax, v); } }
        cmax = fmaxf(cmax, __shfl_xor(cmax, 16)); cmax = fmaxf(cmax, __shfl_xor(cmax, 32));
        if (__ballot(cmax > mref + 8.0f) != 0ull) {
            const float mnew = fmaxf(mref, cmax), sc = fast_exp(mref - mnew);
            lsum *= sc;
#pragma unroll
            for (int nt = 0; nt < 16; ++nt) O[nt] = O[nt] * sc;
            mref = mnew;
        }
        float p[8];
#pragma unroll
        for (int i = 0; i < 8; ++i) { p[i] = fast_exp(lg[i] - mref); lsum += p[i]; p[i] *= rs[i]; }
        u32x4 pkw; pkw.x = cvt_pk_bf16(p[0], p[1]); pkw.y = cvt_pk_bf16(p[2], p[3]); pkw.z = cvt_pk_bf16(p[4], p[5]); pkw.w = cvt_pk_bf16(p[6], p[7]);
        const bf16x8 pk = __builtin_bit_cast(bf16x8, pkw);
#pragma unroll
        for (int nt = 0; nt < 16; ++nt) {
            const unsigned a0 = tr_base + 16u * (unsigned)((2 * nt + (tp >> 1)) ^ tswz);
            const s16x4 lo = tr_read(a0), hi = tr_read(a0 + 8192u);
            const bf16x8 kvt = __builtin_shufflevector(lo, hi, 0, 1, 2, 3, 4, 5, 6, 7);
            O[nt] = __builtin_amdgcn_mfma_f32_16x16x32_bf16(kvt, pk, O[nt], 0, 0, 0);
        }
    }
    lsum += __shfl_xor(lsum, 16); lsum += __shfl_xor(lsum, 32);
    const float inv = 1.0f / lsum;
    bf16_t* op = BIG + row * 4096 + hq * 256 + 4 * g;
#pragma unroll
    for (int nt = 0; nt < 16; ++nt) { const f32x4 o = O[nt] * inv; u32x2 wv; wv.x = cvt_pk_bf16(o[0], o[1]); wv.y = cvt_pk_bf16(o[2], o[3]); *(u32x2*)(op + 16 * nt) = wv; }
}

constexpr int SW_KP = 144, SW_VP = 520;
constexpr int SW_K_OFF = 0, SW_V_OFF = 256 * SW_KP, SW_TB_OFF = SW_V_OFF + 64 * SW_VP;
__device__ __forceinline__ void swa_phase(const bf16_t* QKV, bf16_t* OB, const float* relb, const float* sinks, LAS unsigned char* lds, int G) {
    int tid = threadIdx.x; asm volatile("" : "+v"(tid));
    const int lane = tid & 63, wave = __builtin_amdgcn_readfirstlane(tid >> 6);
    const int h = lane >> 5, n = lane & 31;
    LAS float* tb = (LAS float*)(lds + SW_TB_OFF);
    for (int u = blockIdx.x; u < BATCH * 16 * KVH; u += G) {
        const int b = u >> 5, nb = (u >> 1) & 15, kvh = u & 1;
        const size_t rowb = (size_t)b * SEQ;
        __syncthreads();
#pragma unroll
        for (int e = 0; e < 4; ++e) { const int id = tid + NTHR * e, j = id >> 3, ch = id & 7; const int pos = (nb - 1) * WIN + j;
            u32x4 kv = (u32x4){0u, 0u, 0u, 0u}, vv = (u32x4){0u, 0u, 0u, 0u};
            if (pos >= 0) { const bf16_t* sp = QKV + (rowb + pos) * B_IN + 1024 + kvh * 64 + ch * 8; kv = *(const u32x4*)sp; vv = *(const u32x4*)(sp + 128); }
            *(LAS u32x4*)(lds + SW_K_OFF + j * SW_KP + ch * 16) = kv;
            LAS bf16_t* vt = (LAS bf16_t*)(lds + SW_V_OFF + (ch * 8) * SW_VP + j * 2);
#pragma unroll
            for (int q = 0; q < 4; ++q) { vt[(2 * q) * (SW_VP / 2)] = (bf16_t)(vv[q] & 0xffffu); vt[(2 * q + 1) * (SW_VP / 2)] = (bf16_t)(vv[q] >> 16); } }
        for (int i = tid; i < GQ * WIN; i += NTHR) { const int gg = i >> 7, dist = i & 127; tb[i] = relb[t5_bucket(dist) * NH + kvh * GQ + gg]; }
        __syncthreads();
        const int qh = kvh * GQ + wave; const float sink = sinks[qh];
        for (int rt = 0; rt < 4; ++rt) {
            const size_t qrow = rowb + nb * WIN + 32 * rt + n;
            bf16x8 bq[4];
#pragma unroll
            for (int ks = 0; ks < 4; ++ks) bq[ks] = *(const bf16x8*)(QKV + qrow * B_IN + qh * 64 + 16 * ks + 8 * h);
            f32x16 s[5];
#pragma unroll
            for (int ct = 0; ct < 5; ++ct) {
#pragma unroll
                for (int i = 0; i < 16; ++i) s[ct][i] = 0.f;
#pragma unroll
                for (int ks = 0; ks < 4; ++ks) { const bf16x8 a = *(const LAS bf16x8*)(lds + SW_K_OFF + (32 * (rt + ct) + n) * SW_KP + (2 * ks + h) * 16);
                    s[ct] = __builtin_amdgcn_mfma_f32_32x32x16_bf16(a, bq[ks], s[ct], 0, 0, 0); } }
            const int qi = 32 * rt + n;
            float mx = NEGF;
#pragma unroll
            for (int ct = 0; ct < 5; ++ct)
#pragma unroll
                for (int i = 0; i < 16; ++i) { const int j = 32 * (rt + ct) + (i & 3) + 8 * (i >> 2) + 4 * h; const int dist = qi + WIN - j;
                    const bool ok = (dist >= 0) && (dist < WIN) && (nb > 0 || j >= WIN);
                    const float v = ok ? s[ct][i] * 0.125f + tb[wave * WIN + (dist & 127)] : NEGF; s[ct][i] = v; mx = fmaxf(mx, v); }
            mx = fmaxf(mx, __shfl_xor(mx, 32)); mx = fmaxf(mx, sink);
            float sum = 0.f;
#pragma unroll
            for (int ct = 0; ct < 5; ++ct)
#pragma unroll
                for (int i = 0; i < 16; ++i) { const float p = fast_exp(s[ct][i] - mx); s[ct][i] = p; sum += p; }
            sum += __shfl_xor(sum, 32); sum += fast_exp(sink - mx);
            f32x16 o[2];
#pragma unroll
            for (int dt = 0; dt < 2; ++dt)
#pragma unroll
                for (int i = 0; i < 16; ++i) o[dt][i] = 0.f;
#pragma unroll
            for (int ct = 0; ct < 5; ++ct)
#pragma unroll
                for (int s2 = 0; s2 < 2; ++s2) {
                    u32x4 pw; pw.x = cvt_pk_bf16(s[ct][8 * s2 + 0], s[ct][8 * s2 + 1]); pw.y = cvt_pk_bf16(s[ct][8 * s2 + 2], s[ct][8 * s2 + 3]);
                    pw.z = cvt_pk_bf16(s[ct][8 * s2 + 4], s[ct][8 * s2 + 5]); pw.w = cvt_pk_bf16(s[ct][8 * s2 + 6], s[ct][8 * s2 + 7]);
                    const bf16x8 pb = __builtin_bit_cast(bf16x8, pw);
#pragma unroll
                    for (int dt = 0; dt < 2; ++dt) { const LAS unsigned char* vp = lds + SW_V_OFF + (32 * dt + n) * SW_VP + (32 * (rt + ct) + 16 * s2 + 4 * h) * 2;
                        const u32x2 v0 = *(const LAS u32x2*)vp, v1 = *(const LAS u32x2*)(vp + 16);
                        u32x4 va; va.x = v0.x; va.y = v0.y; va.z = v1.x; va.w = v1.y;
                        o[dt] = __builtin_amdgcn_mfma_f32_32x32x16_bf16(__builtin_bit_cast(bf16x8, va), pb, o[dt], 0, 0, 0); }
                }
            const float inv = 1.0f / sum;
            bf16_t* op = OB + qrow * D + qh * 64 + 4 * h;
#pragma unroll
            for (int dt = 0; dt < 2; ++dt)
#pragma unroll
                for (int i4 = 0; i4 < 4; ++i4) { u32x2 wv; wv.x = cvt_pk_bf16(o[dt][4 * i4] * inv, o[dt][4 * i4 + 1] * inv); wv.y = cvt_pk_bf16(o[dt][4 * i4 + 2] * inv, o[dt][4 * i4 + 3] * inv);
                    *(u32x2*)(op + 32 * dt + 8 * i4) = wv; }
        }
    }
}

struct Args { const float* in[23]; float* out; unsigned char* ws; int ph_lo, ph_hi; };
constexpr int PH_PER_LAYER = 9, N_PHASES = 1 + DEPTH * PH_PER_LAYER + 1;
#define CAS __attribute__((address_space(4)))
__device__ __forceinline__ const CAS Args* kargs() { const CAS Args* p = (const CAS Args*)__builtin_amdgcn_kernarg_segment_ptr(); asm volatile("" : "+s"(p)); return p; }
__device__ __forceinline__ int opaque_i(int v) { asm volatile("" : "+s"(v)); return v; }

__global__ void __launch_bounds__(NTHR, 2) trunk_fwd(Args args_by_value) {
    extern __shared__ __attribute__((aligned(16))) unsigned char lds_raw[];
    LAS unsigned char* lds = (LAS unsigned char*)lds_raw;
    const int tid = threadIdx.x;
    volatile LAS unsigned* MISC = (volatile LAS unsigned*)(lds + LDS_MISC_OFF);
    for (int u = tid; u < (LDS_BYTES - LDS_MISC_OFF) / 4; u += NTHR) MISC[u] = 0u;
    __syncthreads();
    int lo, hi;
    { const CAS Args* A = kargs(); lo = A->ph_lo; hi = A->ph_hi; }
    XcdBarrier bar;
    { const CAS Args* A = kargs(); unsigned* bw = (unsigned*)(A->ws + WS_CTL) + 4096; bar.bar = bw; bar.x = 0; bar.st = nullptr;
      if (hi - lo > 1) bar = xcd_barrier_post(bw, MISC + 8); }
#define IN(k) (lo <= (k) && (k) < hi)
#define SEAM(k) do { if (IN(k) && IN((k) + 1)) xcd_barrier(bar); } while (0)

    if (IN(0)) { const CAS Args* A = kargs(); Ptrs P;
#pragma unroll
        for (int i = 0; i < 23; ++i) P.in[i] = A->in[i];
        P.out = A->out; P.ws = A->ws;
        p0_prologue(P, lds, (int)gridDim.x); }
    SEAM(0);

    for (int l = 0; l < DEPTH; ++l) {
        const int pb = 1 + l * PH_PER_LAYER;
        const bool isA = (l & 1) == 0;

        if (IN(pb + 0)) { const CAS Args* A = kargs(); const int G = gridDim.x;
            const float* xin = (l == 0) ? A->in[I_X] : A->out;
            norm_phase(xin, (bf16_t*)(A->ws + WS_XG), A->in[I_GMIX] + l * D, (const float*)(A->ws + WS_MOD) + (size_t)l * BATCH * 6144, 0, 1024, G); }
        SEAM(pb + 0);
        if (IN(pb + 1)) {
            const CAS Args* A = kargs(); const int G = gridDim.x, j = l >> 1; unsigned char* ws = A->ws;
            if (isA) {
                unsigned char* wa = ws + WS_WA + (size_t)j * WA_STRIDE;
                pg8::Gemm g{(const bf16_t*)(ws + WS_XG), (const bf16_t*)(wa + WINA_OFF), D, D, D, 0, 0}; pg8::StaticOrder S; S.init(M, 2048, G, (int)blockIdx.x);
                pg8::EpiInA E{(bf16_t*)(ws + WS_QO), (bf16_t*)(ws + WS_CKV), (bf16_t*)(ws + WS_QI), (bf16_t*)(ws + WS_KIN), (float*)(ws + WS_WI), A->in[I_AIKG] + j * IDIM, A->in[I_AIKB] + j * IDIM};
                pg8::gemm_phase<pg8::EpiInA, true>(lds, g, S, E);
            } else {
                unsigned char* wb = ws + WS_WB + (size_t)j * WB_STRIDE;
                pg8::Gemm g{(const bf16_t*)(ws + WS_XG), (const bf16_t*)(wb + WINB_OFF), D, D, D, 0, 0}; pg8::StaticOrder S; S.init(M, B_IN, G, (int)blockIdx.x);
                pg8::EpiBf16Plain E{(bf16_t*)(ws + WS_QKV), B_IN, A->in[I_BBIN] + j * B_IN};
                pg8::gemm_phase<pg8::EpiBf16Plain, true>(lds, g, S, E);
            }
        }
        SEAM(pb + 1);
        if (IN(pb + 2)) {
            if (isA) {
                { const CAS Args* A = kargs(); const int G = gridDim.x, j = l >> 1; unsigned char* ws = A->ws;
                  unsigned char* wa = ws + WS_WA + (size_t)j * WA_STRIDE;
                  pg8::Gemm g{(const bf16_t*)(ws + WS_QO), (const bf16_t*)(wa + WQA_OFF), D, 256, 256, 2, 256}; pg8::StaticOrder S; S.init(M, 4096, G, (int)blockIdx.x);
                  pg8::EpiBf16Plain E{(bf16_t*)(ws + WS_BIG), 4096, nullptr};
                  pg8::gemm_phase<pg8::EpiBf16Plain, true>(lds, g, S, E); }
                { const CAS Args* A = kargs(); const int G = gridDim.x; unsigned char* ws = A->ws;
                  int tid2 = tid; asm volatile("" : "+v"(tid2));
                  const int lane = tid2 & 63, wave = __builtin_amdgcn_readfirstlane(tid2 >> 6);
                  const bf16_t* CKV = (const bf16_t*)(ws + WS_CKV); float* RKV = (float*)(ws + WS_RKV);
                  const int gw = blockIdx.x * NWAVES + wave, NGW = G * NWAVES;
                  for (int row = gw; row < M; row += NGW) {
                      const u32x2 v = *((const u32x2*)(CKV + (size_t)row * RK) + lane);
                      const float a0 = __uint_as_float(v.x << 16), a1 = __uint_as_float(v.x & 0xffff0000u), a2 = __uint_as_float(v.y << 16), a3 = __uint_as_float(v.y & 0xffff0000u);
                      const float ss = wave_sum((a0 * a0 + a1 * a1) + (a2 * a2 + a3 * a3));
                      if (lane == 0) RKV[row] = 1.0f / sqrtf(ss * (1.0f / RK) + EPS);
                  } }
                { const CAS Args* A = kargs(); const int G = gridDim.x; unsigned char* ws = A->ws;
                  int tid2 = tid; asm volatile("" : "+v"(tid2));
                  const int lane = tid2 & 63, wave = __builtin_amdgcn_readfirstlane(tid2 >> 6);
                  const int xcd = blockIdx.x & 7, wx = (blockIdx.x >> 3) * NWAVES + wave, nwx = (G >> 3) * NWAVES;
                  for (int q = wx; q < 1024; q += nwx) {
                      const int bl = q >> 9, r9 = q & 511, b = 2 * xcd + bl;
                      const int tg = (r9 & 1) ? 511 - (r9 >> 1) : (r9 >> 1);
                      idx_task((const bf16_t*)(ws + WS_QI), (const bf16_t*)(ws + WS_KIN), (const float*)(ws + WS_WI), (unsigned*)(ws + WS_SEL), b, tg, lane);
                  } }
            } else {
                const CAS Args* A = kargs(); const int G = gridDim.x, j = l >> 1; unsigned char* ws = A->ws;
                swa_phase((const bf16_t*)(ws + WS_QKV), (bf16_t*)(ws + WS_OB), A->in[I_RELB], A->in[I_BSINK] + j * NH, lds, G);
            }
        }
        SEAM(pb + 2);
        if (IN(pb + 3) && isA) {
            const CAS Args* A = kargs(); const int G = gridDim.x; unsigned char* ws = A->ws;
            int tid2 = tid; asm volatile("" : "+v"(tid2));
            const int lane = tid2 & 63, wave = __builtin_amdgcn_readfirstlane(tid2 >> 6);
            LAS float* relb = (LAS float*)(lds + 147456);
            for (int i = tid; i < NBUCK * NH; i += NTHR) relb[i] = A->in[I_RELB][i];
            __syncthreads();
            LAS unsigned char* kvbuf = lds + wave * 16384;
            LAS unsigned* kmeta = (LAS unsigned*)(lds + 131072 + wave * 2048);
            LAS float* krstd = (LAS float*)(lds + 131072 + wave * 2048 + 1024);
            const int xcd = blockIdx.x & 7, wx = (blockIdx.x >> 3) * NWAVES + wave, nwx = (G >> 3) * NWAVES;
            for (int q = wx; q < 2 * SEQ; q += nwx) { const int b = 2 * xcd + (q >> 11), t = q & 2047;
                att_query((const bf16_t*)(ws + WS_CKV), (const float*)(ws + WS_RKV), (const unsigned*)(ws + WS_SEL), (bf16_t*)(ws + WS_BIG), kvbuf, kmeta, krstd, relb, b, t, lane); }
        }
        if (isA) SEAM(pb + 3);
        if (IN(pb + 4) && isA) {
            const CAS Args* A = kargs(); const int G = gridDim.x, j = l >> 1; unsigned char* ws = A->ws;
            unsigned char* wa = ws + WS_WA + (size_t)j * WA_STRIDE;
            pg8::Gemm g{(const bf16_t*)(ws + WS_BIG), (const bf16_t*)(wa + WUV_OFF), 4096, D, D, 0, 1024}; pg8::StaticOrder S; S.init(M, D, G, (int)blockIdx.x);
            pg8::EpiBf16Plain E{(bf16_t*)(ws + WS_QO), D, nullptr};
            pg8::gemm_phase<pg8::EpiBf16Plain, true>(lds, g, S, E);
        }
        if (isA) SEAM(pb + 4);
        if (IN(pb + 5)) {
            const CAS Args* A = kargs(); const int G = gridDim.x, j = l >> 1; unsigned char* ws = A->ws;
            const float* xin = (l == 0) ? A->in[I_X] : A->out;
            const float* modl = (const float*)(ws + WS_MOD) + (size_t)l * BATCH * 6144;
            const bf16_t* Ain = (const bf16_t*)(ws + (isA ? WS_QO : WS_OB));
            const bf16_t* Bw = (const bf16_t*)(isA ? ws + WS_WA + (size_t)j * WA_STRIDE + WOUTA_OFF : ws + WS_WB + (size_t)j * WB_STRIDE + WOUTB_OFF);
            pg8::Gemm g{Ain, Bw, D, D, D, 0, 0}; pg8::StaticOrder S; S.init(M, D, G, (int)blockIdx.x);
            pg8::EpiResid E{xin, A->out, modl + 2048, isA ? nullptr : A->in[I_BBOUT] + j * D};
            pg8::gemm_phase<pg8::EpiResid, true>(lds, g, S, E);
        }
        SEAM(pb + 5);
        if (IN(pb + 6)) { const CAS Args* A = kargs(); const int G = gridDim.x;
            norm_phase(A->out, (bf16_t*)(A->ws + WS_XG), A->in[I_GFFN] + l * D, (const float*)(A->ws + WS_MOD) + (size_t)l * BATCH * 6144, 3072, 4096, G); }
        SEAM(pb + 6);
        if (IN(pb + 7)) {
            const CAS Args* A = kargs(); const int G = gridDim.x; unsigned char* ws = A->ws;
            unsigned char* wl = ws + WS_W + (size_t)l * W_LAYER;
            pg8::Gemm g{(const bf16_t*)(ws + WS_XG), (const bf16_t*)(wl + W13_OFF), D, D, D, 0, 0}; pg8::StaticOrder S; S.init(M, 2 * DFF, G, (int)blockIdx.x);
            pg8::EpiSwiGLU E{(bf16_t*)(ws + WS_HFF)};
            pg8::gemm_phase<pg8::EpiSwiGLU, true>(lds, g, S, E);
        }
        SEAM(pb + 7);
        if (IN(pb + 8)) {
            const CAS Args* A = kargs(); const int G = gridDim.x; unsigned char* ws = A->ws;
            unsigned char* wl = ws + WS_W + (size_t)l * W_LAYER;
            const float* modl = (const float*)(ws + WS_MOD) + (size_t)l * BATCH * 6144;
            pg8::Gemm g{(const bf16_t*)(ws + WS_HFF), (const bf16_t*)(wl + W2_OFF), DFF, DFF, DFF, 0, 0}; pg8::StaticOrder S; S.init(M, D, G, (int)blockIdx.x);
            pg8::EpiResid E{A->out, A->out, modl + 5120, nullptr};
            pg8::gemm_phase<pg8::EpiResid, true>(lds, g, S, E);
        }
        SEAM(pb + 8);
    }
    if (IN(N_PHASES - 1)) { const CAS Args* A = kargs(); final_norm_phase(A->out, A->in[I_GFIN], (int)gridDim.x); }
#undef IN
#undef SEAM
}

extern "C" void kernel_launch(void* const* d_in, const int* in_sizes, int n_in, void* d_out, int out_size, void* d_ws, size_t ws_size, hipStream_t stream) {
    static int grid = 0;
    if (grid == 0) {
        if (n_in != 23 || out_size != M * D || ws_size < WS_END) { fprintf(stderr, "kernel_launch: unexpected shapes (n_in %d out %d ws %zu)\n", n_in, out_size, ws_size); grid = -1; return; }
        int dev = 0, cus = 0, per_cu = 0;
        if (hipGetDevice(&dev) != hipSuccess || hipDeviceGetAttribute(&cus, hipDeviceAttributeMultiprocessorCount, dev) != hipSuccess) { grid = -1; return; }
        if (hipFuncSetAttribute((const void*)trunk_fwd, hipFuncAttributeMaxDynamicSharedMemorySize, LDS_BYTES) != hipSuccess) { fprintf(stderr, "kernel_launch: hipFuncSetAttribute failed\n"); grid = -1; return; }
        if (hipOccupancyMaxActiveBlocksPerMultiprocessor(&per_cu, (const void*)trunk_fwd, NTHR, LDS_BYTES) != hipSuccess || per_cu < 1) { fprintf(stderr, "kernel_launch: occupancy query says %d\n", per_cu); }
        (void)hipGetLastError();
        grid = cus;
    }
    if (grid < 0) return;
    (void)hipMemsetAsync((char*)d_ws + WS_CTL, 0, CTL_ZERO_BYTES, stream);
    Args a{};
    for (int i = 0; i < 23; ++i) a.in[i] = (const float*)d_in[i];
    a.out = (float*)d_out; a.ws = (unsigned char*)d_ws;
#if MK_MULTI
    for (int p = 0; p < N_PHASES; ++p) {
        const int l = (p - 1) / PH_PER_LAYER, r = (p - 1) % PH_PER_LAYER;
        if (p >= 1 && p < N_PHASES - 1 && (l & 1) && (r == 3 || r == 4)) continue;
        a.ph_lo = p; a.ph_hi = p + 1;
        hipLaunchKernelGGL(trunk_fwd, dim3(grid), dim3(NTHR), LDS_BYTES, stream, a);
    }
#else
    a.ph_lo = 0; a.ph_hi = N_PHASES;
    hipLaunchKernelGGL(trunk_fwd, dim3(grid), dim3(NTHR), LDS_BYTES, stream, a);
#endif
    const hipError_t le = hipPeekAtLastError();
    if (le != hipSuccess) fprintf(stderr, "kernel_launch: launch failed: %s\n", hipGetErrorName(le));
}
```

```cpp
#include <hip/hip_runtime.h>
#include <cstdio>
#include <cstdint>


#define GAS __attribute__((address_space(1)))
#define LAS __attribute__((address_space(3)))
typedef unsigned short bf16_t;
typedef short bf16x8 __attribute__((ext_vector_type(8)));
typedef short s16x4 __attribute__((ext_vector_type(4)));
typedef float f32x4 __attribute__((ext_vector_type(4)));
typedef float f32x2 __attribute__((ext_vector_type(2)));
typedef float f32x16 __attribute__((ext_vector_type(16)));
typedef unsigned u32x4 __attribute__((ext_vector_type(4)));
typedef unsigned u32x2 __attribute__((ext_vector_type(2)));

constexpr int D = 1024, BATCH = 16, SEQ = 2048, M = BATCH * SEQ, DEPTH = 4;
constexpr int NH = 16, HD = 64, RK = 256, IH = 8, IDIM = 64, TOPK = 256;
constexpr int KVH = 2, GQ = 8, WIN = 128, NBUCK = 32, DFF = 2816;
constexpr int A_IN = 1864, B_IN = 1280;
constexpr float EPS = 1e-6f;
constexpr float NEGF = -1e30f;
constexpr int NWAVES = 8, NTHR = 512;

constexpr size_t MiB = 1u << 20;
constexpr size_t WS_CTL = 0, CTL_ZERO_BYTES = 4 * MiB;
constexpr size_t WS_SS = 1 * MiB;
constexpr size_t WS_W = 4 * MiB;
constexpr size_t W_LAYER = 17301504;
constexpr size_t W13_OFF = 0, W2_OFF = 11 * MiB;
constexpr size_t WS_WA = WS_W + 4 * W_LAYER;
constexpr size_t WA_STRIDE = 10 * MiB, WINA_OFF = 0, WQA_OFF = 4 * MiB, WUV_OFF = 6 * MiB, WOUTA_OFF = 8 * MiB;
constexpr size_t WS_WB = WS_WA + 2 * WA_STRIDE;
constexpr size_t WB_STRIDE = 4718592, WINB_OFF = 0, WOUTB_OFF = 2621440;
constexpr size_t WS_MOD = 100 * MiB;
constexpr size_t WS_SHW = WS_MOD + 1536 * 1024;
constexpr size_t SHW_A = 0, SHW_B = 2 * 16 * 2048 * 4, SHW_F = SHW_B + 2 * 16 * 1280 * 4;
constexpr size_t WS_XG = 104 * MiB;
constexpr size_t WS_BIG = 104 * MiB;
constexpr size_t WS_HFF = 168 * MiB;
constexpr size_t WS_QO = 360 * MiB;
constexpr size_t WS_CKV = 424 * MiB;
constexpr size_t WS_QI = 440 * MiB;
constexpr size_t WS_KIN = 472 * MiB;
constexpr size_t WS_WI = 476 * MiB;
constexpr size_t WS_SEL = 477 * MiB;
constexpr size_t WS_RKV = 485 * MiB;
constexpr size_t WS_QKV = 360 * MiB;
constexpr size_t WS_OB = 440 * MiB;
constexpr size_t WS_END = 512 * MiB;

constexpr int RING_BYTES = 131072;
constexpr int LDS_MISC_OFF = 155648;
constexpr int LDS_BYTES = 156672;

#define RLX_AGENT __ATOMIC_RELAXED, __HIP_MEMORY_SCOPE_AGENT
__device__ __forceinline__ unsigned cvt_pk_bf16(float lo, float hi) { unsigned r; asm volatile("v_cvt_pk_bf16_f32 %0, %1, %2" : "=v"(r) : "v"(lo), "v"(hi)); return r; }
__device__ __forceinline__ float bf2f(bf16_t b) { return __uint_as_float(((unsigned)b) << 16); }
__device__ __forceinline__ float wave_sum(float v) {
#pragma unroll
    for (int o = 1; o < 64; o <<= 1) v += __shfl_xor(v, o);
    return v;
}
__device__ __forceinline__ float fast_exp(float x) { return __builtin_amdgcn_exp2f(x * 1.4426950408889634f); }
__device__ __forceinline__ float silu_f(float x) { return x * __builtin_amdgcn_rcpf(1.0f + fast_exp(-x)); }
__device__ __forceinline__ int t5_bucket(int d) {
    if (d < 16) return d;
    int b = 16;
    b += (d >= 19); b += (d >= 21); b += (d >= 24); b += (d >= 27); b += (d >= 31); b += (d >= 35); b += (d >= 40); b += (d >= 46);
    b += (d >= 52); b += (d >= 59); b += (d >= 67); b += (d >= 77); b += (d >= 87); b += (d >= 99); b += (d >= 113);
    return b;
}

#define XB_TMO      128
#define XB_XCNT(j)  (256  + 64 * (j))
#define XB_XSUB(j)  (1280 + 64 * (j))
#define XB_XGEN(j)  (2304 + 64 * (j))
#define XB_TOP      3328
#define XB_TOPGEN   3392
#define XCD_BAR_WORDS 3456
#define XB_SPIN_CAP (1u << 22)

__device__ __forceinline__ unsigned xb_ld(unsigned* p)              { return __hip_atomic_load(p, __ATOMIC_RELAXED, __HIP_MEMORY_SCOPE_AGENT); }
__device__ __forceinline__ unsigned xb_add(unsigned* p, unsigned v) { return __hip_atomic_fetch_add(p, v, __ATOMIC_RELAXED, __HIP_MEMORY_SCOPE_AGENT); }
__device__ __forceinline__ unsigned xb_xcc_id() { return (unsigned)__builtin_amdgcn_s_getreg((3 << 11) | 20) & 0xFu; }
#define XB_SPIN(cond, bar) do { unsigned _sp = 0; while (cond) { __builtin_amdgcn_s_sleep(1); \
    if ((++_sp & 255u) == 0u) { if (xb_ld(&(bar)[XB_TMO])) break; if (_sp > XB_SPIN_CAP) { atomicAdd(&(bar)[XB_TMO], 1u); break; } } } } while (0)

struct XcdBarrier { unsigned* bar; unsigned x; volatile LAS unsigned* st; };

__device__ __forceinline__ XcdBarrier xcd_barrier_post(unsigned* bar, volatile LAS unsigned* st) {
    XcdBarrier b; b.bar = bar; b.x = xb_xcc_id(); b.st = st;
    if (threadIdx.x == 0) (void)xb_add(&bar[XB_XCNT(b.x)], 1u);
    return b;
}
__device__ __forceinline__ void xcd_barrier_complete(unsigned* bar, unsigned x, unsigned& nloc, unsigned& nx) {
    const unsigned G = gridDim.x * gridDim.y * gridDim.z;
    unsigned sum, cnt, mine, sp = 0u;
    for (;;) {
        sum = 0u; cnt = 0u; mine = 0u;
#pragma unroll
        for (unsigned j = 0; j < 16; ++j) { const unsigned c = xb_ld(&bar[XB_XCNT(j)]); sum += c; cnt += (c > 0u) ? 1u : 0u; mine = (j == x) ? c : mine; }
        if (sum == G) break;
        __builtin_amdgcn_s_sleep(1);
        if ((++sp & 255u) == 0u) { if (xb_ld(&bar[XB_TMO])) break; if (sp > XB_SPIN_CAP) { atomicAdd(&bar[XB_TMO], 1u); break; } }
    }
    nloc = mine > 0u ? mine : 1u; nx = cnt > 0u ? cnt : 1u;
}
__device__ __forceinline__ void xcd_barrier(const XcdBarrier& b) {
    asm volatile("s_waitcnt vmcnt(0)" ::: "memory");
    __syncthreads();
    if (threadIdx.x == 0) {
        unsigned* bar = b.bar;
        __builtin_amdgcn_s_waitcnt(0);
        unsigned nloc = b.st[0], nx = b.st[1];
        if (nloc == 0u) { xcd_barrier_complete(bar, b.x, nloc, nx); b.st[0] = nloc; b.st[1] = nx; }
        const unsigned old = xb_add(&bar[XB_XSUB(b.x)], 1u);
        const unsigned gen = old / nloc;
        if (old + 1u == (gen + 1u) * nloc) {
            __builtin_amdgcn_fence(__ATOMIC_RELEASE, "agent");
            asm volatile("s_waitcnt vmcnt(0)" ::: "memory");
            const unsigned og = xb_add(&bar[XB_TOP], 1u);
            const unsigned tg = og / nx;
            if (og + 1u == (tg + 1u) * nx) xb_add(&bar[XB_TOPGEN], 1u);
            else XB_SPIN(xb_ld(&bar[XB_TOPGEN]) == tg, bar);
            __builtin_amdgcn_fence(__ATOMIC_ACQUIRE, "agent");
            xb_add(&bar[XB_XGEN(b.x)], 1u);
            asm volatile("s_waitcnt vmcnt(0)" ::: "memory");
        } else {
            XB_SPIN(xb_ld(&bar[XB_XGEN(b.x)]) == gen, bar);
            __builtin_amdgcn_fence(__ATOMIC_ACQUIRE, "agent");
            asm volatile("s_waitcnt vmcnt(0)" ::: "memory");
        }
    }
    __syncthreads();
}

namespace pg8 {
constexpr int BM = 256, BK = 64, HALF = 128, HTB = HALF * BK * 2, STAGE_BYTES = 8 * HTB, NXCD = 8, WGM = 8;
__host__ __device__ __forceinline__ int lds_byte(int r, int c) { const int st = (r >> 4) * 2 + (c >> 5), rr = r & 15, cc = c & 31, ob = rr * 64 + cc * 2; return st * 1024 + (ob ^ (((ob >> 9) & 1) << 5)); }
__host__ __device__ __forceinline__ void stage_rc(int b, int& R, int& C) { const int st = b / 1024, sb = b % 1024, swz = sb ^ (((sb >> 9) & 1) << 5); R = (st >> 1) * 16 + swz / 64; C = (st & 1) * 32 + (swz % 64) / 2; }
__host__ __device__ __forceinline__ int perm32(int rho) { const int n = rho >> 4, i = rho & 15; return 8 * (i >> 2) + 4 * n + (i & 3); }

struct Unit { int pm, pn; };
struct Gemm { const bf16_t* A; const bf16_t* Bt; int lda, ldb, K, a_shift, a_mul; };

struct StaticOrder {
    int nM, nN, nwg, G, c;
    __device__ void init(int M_, int N_, int G_, int c_) { nM = M_ / BM; nN = N_ / BM; nwg = nM * nN; G = G_; c = c_; }
    __device__ bool next(int i, Unit& u) const {
        const long L = (long)i * G + c; if (L >= nwg) return false;
        int wgid = (int)L; { const int q = nwg / NXCD, r = nwg % NXCD, xcd = wgid % NXCD, off = wgid / NXCD; wgid = (xcd < r ? xcd * (q + 1) : r * (q + 1) + (xcd - r) * q) + off; }
        const int nig = WGM * nN, gid = wgid / nig, fm = gid * WGM, gsz = (nM - fm) < WGM ? (nM - fm) : WGM;
        u.pm = fm + ((wgid % nig) % gsz); u.pn = (wgid % nig) / gsz; return true;
    }
};

template <class Epi, bool ALIGN_EPI>
__device__ __forceinline__ void gemm_phase(LAS unsigned char* lds, const Gemm g, const StaticOrder& S, const Epi& E) {
    int tid = threadIdx.x; asm volatile("" : "+v"(tid));
    const int wid = __builtin_amdgcn_readfirstlane(tid >> 6), lane = tid & 63, wr = wid >> 2, wc = wid & 3, fr = lane & 15, fq = lane >> 4;
    const int K = g.K, nt = K / BK;
    unsigned voffA[2], voffB[2];
#pragma unroll
    for (int i = 0; i < 2; ++i) { int R, C; stage_rc(tid * 16 + i * 8192, R, C); const int Rb = Epi::PERM ? ((R & ~31) + perm32(R & 31)) : R;
        voffA[i] = (unsigned)(R * g.lda + C) * 2u; voffB[i] = (unsigned)(Rb * g.ldb + C) * 2u; }
    const size_t kstep = (size_t)(BK * 2);
    const size_t hstepA = (size_t)HALF * g.lda * 2, hstepB = (size_t)HALF * g.ldb * 2;
    const unsigned ldsw = (unsigned)wid * 1024u;
    const int aoff = lds_byte(wr * 64 + fr, fq * 8), boff = lds_byte(wc * 32 + fr, fq * 8);
#define PG8_SA(b, h) (((b) * 2 + (h)) * HTB)
#define PG8_SB(b, h) ((4 + (b) * 2 + (h)) * HTB)
#define PG8_STAGE(bufoff, gbase, voff) do { _Pragma("unroll") for (int _i = 0; _i < 2; ++_i) \
        __builtin_amdgcn_global_load_lds((const unsigned*)((const char*)(gbase) + (voff)[_i]), (LAS unsigned*)(lds + (bufoff) + ldsw + _i * 8192), 16, 0, 0); } while (0)
#define PG8_LDA(dst, b, h) do { _Pragma("unroll") for (int m = 0; m < 4; ++m) _Pragma("unroll") for (int k = 0; k < 2; ++k) dst[m][k] = *(const LAS bf16x8*)(lds + PG8_SA(b, h) + aoff + m * 2048 + k * 1024); } while (0)
#define PG8_LDB(dst, b, h) do { _Pragma("unroll") for (int n = 0; n < 2; ++n) _Pragma("unroll") for (int k = 0; k < 2; ++k) dst[n][k] = *(const LAS bf16x8*)(lds + PG8_SB(b, h) + boff + n * 2048 + k * 1024); } while (0)
#define PG8_MMA(ai, bj, At, Bt) do { __builtin_amdgcn_s_setprio(1); _Pragma("unroll") for (int m = 0; m < 4; ++m) _Pragma("unroll") for (int n = 0; n < 2; ++n) _Pragma("unroll") for (int k = 0; k < 2; ++k) \
        acc[ai][bj][m][n] = __builtin_amdgcn_mfma_f32_16x16x32_bf16(Bt[n][k], At[m][k], acc[ai][bj][m][n], 0, 0, 0); __builtin_amdgcn_s_setprio(0); } while (0)
#define PG8_WAIT_V(n) asm volatile("s_waitcnt vmcnt(" #n ")" ::: "memory")
#define PG8_WAIT_L(n) asm volatile("s_waitcnt lgkmcnt(" #n ")" ::: "memory")
#define PG8_BAR __builtin_amdgcn_s_barrier()
#define PG8_SCHED __builtin_amdgcn_sched_barrier(0)
#define PG8_ABASE(u) ((const char*)g.A + ((size_t)(u).pm * BM * g.lda + (size_t)((u).pn >> g.a_shift) * g.a_mul) * 2)
#define PG8_BBASE(u) ((const char*)g.Bt + (size_t)(u).pn * BM * g.ldb * 2)
    Unit cur, nxt; int ui = 0;
    if (!S.next(0, cur)) return;
    f32x4 acc[2][2][4][2];
#pragma unroll
    for (int a = 0; a < 2; ++a)
#pragma unroll
        for (int b = 0; b < 2; ++b)
#pragma unroll
            for (int m = 0; m < 4; ++m)
#pragma unroll
                for (int n = 0; n < 2; ++n) acc[a][b][m][n] = (f32x4){0.f, 0.f, 0.f, 0.f};
    bf16x8 At[4][2], B0[2][2], B1[2][2];
    const char* cA = PG8_ABASE(cur); const char* cB = PG8_BBASE(cur);
    PG8_STAGE(PG8_SB(0, 0), cB, voffB); PG8_STAGE(PG8_SB(0, 1), cB + hstepB, voffB); PG8_STAGE(PG8_SA(0, 0), cA, voffA); PG8_STAGE(PG8_SA(0, 1), cA + hstepA, voffA);
    if (wr == 1) PG8_BAR;
    PG8_WAIT_V(2); PG8_BAR;
    PG8_STAGE(PG8_SB(1, 0), cB + kstep, voffB); PG8_STAGE(PG8_SA(1, 0), cA + kstep, voffA); PG8_STAGE(PG8_SB(1, 1), cB + hstepB + kstep, voffB);
    PG8_WAIT_V(6); PG8_BAR;
    for (;;) {
        const bool has_next = S.next(ui + 1, nxt);
        const char* nA = has_next ? PG8_ABASE(nxt) : cA; const char* nB = has_next ? PG8_BBASE(nxt) : cB;
        for (int t = 0; t < nt; t += 2) {
            const bool last = (t == nt - 2);
            const char* a1 = cA + (size_t)(t + 1) * kstep;
            const char* a2 = last ? nA : cA + (size_t)(t + 2) * kstep; const char* b2 = last ? nB : cB + (size_t)(t + 2) * kstep;
            const char* a3 = a2 + kstep; const char* b3 = b2 + kstep;
            PG8_LDB(B0, 0, 0); PG8_LDB(B1, 0, 1); PG8_SCHED; PG8_LDA(At, 0, 0); PG8_STAGE(PG8_SA(1, 1), a1 + hstepA, voffA);
            PG8_WAIT_V(8); PG8_WAIT_L(0); PG8_BAR; PG8_MMA(0, 0, At, B0); PG8_MMA(0, 1, At, B1); PG8_BAR; PG8_SCHED;
            PG8_LDA(At, 0, 1); PG8_STAGE(PG8_SB(0, 0), b2, voffB); PG8_STAGE(PG8_SB(0, 1), b2 + hstepB, voffB); PG8_STAGE(PG8_SA(0, 0), a2, voffA);
            PG8_WAIT_V(8); PG8_WAIT_L(0); PG8_BAR; PG8_MMA(1, 0, At, B0); PG8_MMA(1, 1, At, B1); PG8_BAR; PG8_SCHED;
            PG8_LDB(B0, 1, 0); PG8_LDB(B1, 1, 1); PG8_SCHED; PG8_LDA(At, 1, 0); PG8_STAGE(PG8_SA(0, 1), a2 + hstepA, voffA);
            PG8_WAIT_V(8); PG8_WAIT_L(0); PG8_BAR; PG8_MMA(0, 0, At, B0); PG8_MMA(0, 1, At, B1); PG8_BAR; PG8_SCHED;
            PG8_LDA(At, 1, 1); PG8_STAGE(PG8_SB(1, 0), b3, voffB); PG8_STAGE(PG8_SB(1, 1), b3 + hstepB, voffB); PG8_STAGE(PG8_SA(1, 0), a3, voffA);
            PG8_WAIT_V(8); PG8_WAIT_L(0); PG8_BAR; PG8_MMA(1, 0, At, B0); PG8_MMA(1, 1, At, B1); PG8_BAR; PG8_SCHED;
        }
        if constexpr (ALIGN_EPI) { if (wr == 0) PG8_BAR; }
        E(acc, cur, wr, wc, fr, fq);
        if (!has_next) break;
#pragma unroll
        for (int a = 0; a < 2; ++a)
#pragma unroll
            for (int b = 0; b < 2; ++b)
#pragma unroll
                for (int m = 0; m < 4; ++m)
#pragma unroll
                    for (int n = 0; n < 2; ++n) acc[a][b][m][n] = (f32x4){0.f, 0.f, 0.f, 0.f};
        cur = nxt; cA = nA; cB = nB; ++ui;
        if constexpr (ALIGN_EPI) { if (wr == 1) PG8_BAR; }
    }
    PG8_WAIT_V(0);
    if constexpr (!ALIGN_EPI) { if (wr == 0) PG8_BAR; }
    PG8_BAR;
#undef PG8_SA
#undef PG8_SB
#undef PG8_STAGE
#undef PG8_LDA
#undef PG8_LDB
#undef PG8_MMA
#undef PG8_WAIT_V
#undef PG8_WAIT_L
#undef PG8_BAR
#undef PG8_SCHED
#undef PG8_ABASE
#undef PG8_BBASE
}

template <bool NORM> struct EpiBf16Plain {
    static constexpr bool PERM = true;
    bf16_t* O; int ldc; const float* shw; int shw_stride; const unsigned long long* SS;
    __device__ __forceinline__ void operator()(const f32x4 (&acc)[2][2][4][2], const Unit& u, int wr, int wc, int fr, int fq) const {
        const int row0 = u.pm * BM + wr * 64 + fr, col0 = u.pn * BM + wc * 32 + 8 * fq;
        f32x4 bv[2][2];
#pragma unroll
        for (int bj = 0; bj < 2; ++bj)
#pragma unroll
            for (int n = 0; n < 2; ++n) bv[bj][n] = NORM ? *(const f32x4*)(shw + (size_t)(u.pm >> 3) * shw_stride + col0 + bj * HALF + 4 * n) : (f32x4){0.f, 0.f, 0.f, 0.f};
#pragma unroll
        for (int ai = 0; ai < 2; ++ai)
#pragma unroll
            for (int m = 0; m < 4; ++m) { const int row = row0 + ai * HALF + m * 16; bf16_t* rowp = O + (size_t)row * ldc + col0;
                float rs = 1.0f; if (NORM) rs = 1.0f / sqrtf((float)SS[row] * (1.0f / (16777216.0f * D)) + EPS);
#pragma unroll
                for (int bj = 0; bj < 2; ++bj) { const f32x4 v0 = acc[ai][bj][m][0] * rs + bv[bj][0], v1 = acc[ai][bj][m][1] * rs + bv[bj][1];
                    u32x4 w; w.x = cvt_pk_bf16(v0[0], v0[1]); w.y = cvt_pk_bf16(v0[2], v0[3]); w.z = cvt_pk_bf16(v1[0], v1[1]); w.w = cvt_pk_bf16(v1[2], v1[3]);
                    *(u32x4*)(rowp + bj * HALF) = w; } }
    }
};
struct EpiInA {
    static constexpr bool PERM = true;
    bf16_t* Q; bf16_t* CKV; bf16_t* QI; bf16_t* KIN; float* WI; const float* kg; const float* kb; const float* shw; const unsigned long long* SS;
    __device__ __forceinline__ void operator()(f32x4 (&acc)[2][2][4][2], const Unit& u, int wr, int wc, int fr, int fq) const {
        const int row0 = u.pm * BM + wr * 64 + fr, cl = wc * 32 + 8 * fq;
        {
            const float* sp = shw + (size_t)(u.pm >> 3) * 2048 + u.pn * BM + cl;
            f32x4 bv[2][2];
#pragma unroll
            for (int bj = 0; bj < 2; ++bj)
#pragma unroll
                for (int n = 0; n < 2; ++n) bv[bj][n] = *(const f32x4*)(sp + bj * HALF + 4 * n);
#pragma unroll
            for (int ai = 0; ai < 2; ++ai)
#pragma unroll
                for (int m = 0; m < 4; ++m) { const float rs = 1.0f / sqrtf((float)SS[row0 + ai * HALF + m * 16] * (1.0f / (16777216.0f * D)) + EPS);
#pragma unroll
                    for (int bj = 0; bj < 2; ++bj)
#pragma unroll
                        for (int n = 0; n < 2; ++n) acc[ai][bj][m][n] = acc[ai][bj][m][n] * rs + bv[bj][n]; }
        }
        if (u.pn < 7) {
            bf16_t* base; int ldc, c0;
            if (u.pn < 4) { base = Q; ldc = 1024; c0 = u.pn * 256; } else if (u.pn == 4) { base = CKV; ldc = 256; c0 = 0; } else { base = QI; ldc = 512; c0 = (u.pn - 5) * 256; }
#pragma unroll
            for (int ai = 0; ai < 2; ++ai)
#pragma unroll
                for (int m = 0; m < 4; ++m) { bf16_t* rowp = base + (size_t)(row0 + ai * HALF + m * 16) * ldc + c0 + cl;
#pragma unroll
                    for (int bj = 0; bj < 2; ++bj) { const f32x4 v0 = acc[ai][bj][m][0], v1 = acc[ai][bj][m][1];
                        u32x4 w; w.x = cvt_pk_bf16(v0[0], v0[1]); w.y = cvt_pk_bf16(v0[2], v0[3]); w.z = cvt_pk_bf16(v1[0], v1[1]); w.w = cvt_pk_bf16(v1[2], v1[3]);
                        *(u32x4*)(rowp + bj * HALF) = w; } }
        } else if (wc == 0) {
            f32x4 gv[2][2], bv[2][2];
#pragma unroll
            for (int bj = 0; bj < 2; ++bj)
#pragma unroll
                for (int n = 0; n < 2; ++n) { gv[bj][n] = *(const f32x4*)(kg + 32 * bj + 8 * fq + 4 * n); bv[bj][n] = *(const f32x4*)(kb + 32 * bj + 8 * fq + 4 * n); }
#pragma unroll
            for (int ai = 0; ai < 2; ++ai)
#pragma unroll
                for (int m = 0; m < 4; ++m) {
                    float s = 0.f;
#pragma unroll
                    for (int bj = 0; bj < 2; ++bj)
#pragma unroll
                        for (int n = 0; n < 2; ++n) { const f32x4 x = acc[ai][bj][m][n]; s += (x[0] + x[1]) + (x[2] + x[3]); }
                    s += __shfl_xor(s, 16); s += __shfl_xor(s, 32);
                    const float mu = s * (1.0f / 64.0f); float q = 0.f;
#pragma unroll
                    for (int bj = 0; bj < 2; ++bj)
#pragma unroll
                        for (int n = 0; n < 2; ++n) { const f32x4 d = acc[ai][bj][m][n] - mu; q += (d[0] * d[0] + d[1] * d[1]) + (d[2] * d[2] + d[3] * d[3]); }
                    q += __shfl_xor(q, 16); q += __shfl_xor(q, 32);
                    const float rs = 1.0f / sqrtf(q * (1.0f / 64.0f) + EPS);
                    bf16_t* rowp = KIN + (size_t)(row0 + ai * HALF + m * 16) * 64 + 8 * fq;
#pragma unroll
                    for (int bj = 0; bj < 2; ++bj) { const f32x4 v0 = (acc[ai][bj][m][0] - mu) * rs * gv[bj][0] + bv[bj][0], v1 = (acc[ai][bj][m][1] - mu) * rs * gv[bj][1] + bv[bj][1];
                        u32x4 w; w.x = cvt_pk_bf16(v0[0], v0[1]); w.y = cvt_pk_bf16(v0[2], v0[3]); w.z = cvt_pk_bf16(v1[0], v1[1]); w.w = cvt_pk_bf16(v1[2], v1[3]);
                        *(u32x4*)(rowp + bj * 32) = w; }
                }
        } else if (wc == 1 && fq == 0) {
            const float sc = 0.04419417382415922f;
#pragma unroll
            for (int ai = 0; ai < 2; ++ai)
#pragma unroll
                for (int m = 0; m < 4; ++m) { float* rowp = WI + (size_t)(row0 + ai * HALF + m * 16) * 8;
                    *(f32x4*)(rowp) = acc[ai][0][m][0] * sc; *(f32x4*)(rowp + 4) = acc[ai][0][m][1] * sc; }
        }
    }
};
struct EpiResid {
    static constexpr bool PERM = true;
    const float* xin; float* xout; const float* gate; const float* bias;
    bf16_t* XG; const float* gn; const float* scn; unsigned long long* SSo;
    __device__ __forceinline__ void operator()(const f32x4 (&acc)[2][2][4][2], const Unit& u, int wr, int wc, int fr, int fq) const {
        const int row0 = u.pm * BM + wr * 64 + fr, col0 = u.pn * BM + wc * 32 + 8 * fq, b = u.pm >> 3;
        float ssum[2][4];
#pragma unroll
        for (int ai = 0; ai < 2; ++ai)
#pragma unroll
            for (int m = 0; m < 4; ++m) ssum[ai][m] = 0.f;
#pragma unroll
        for (int bj = 0; bj < 2; ++bj) {
            const int c = col0 + bj * HALF;
            const f32x4 gv0 = *(const f32x4*)(gate + (size_t)b * 6144 + c), gv1 = *(const f32x4*)(gate + (size_t)b * 6144 + c + 4);
            f32x4 bv0 = (f32x4){0.f, 0.f, 0.f, 0.f}, bv1 = bv0, gm0 = bv0, gm1 = bv0;
            if (bias) { bv0 = *(const f32x4*)(bias + c); bv1 = *(const f32x4*)(bias + c + 4); }
            if (XG) { gm0 = *(const f32x4*)(gn + c) * (*(const f32x4*)(scn + (size_t)b * 6144 + c) + 1.0f); gm1 = *(const f32x4*)(gn + c + 4) * (*(const f32x4*)(scn + (size_t)b * 6144 + c + 4) + 1.0f); }
#pragma unroll
            for (int ai = 0; ai < 2; ++ai)
#pragma unroll
                for (int m = 0; m < 4; ++m) { const size_t off = (size_t)(row0 + ai * HALF + m * 16) * D + c;
                    const f32x4 xi0 = *(const f32x4*)(xin + off), xi1 = *(const f32x4*)(xin + off + 4);
                    const f32x4 xo0 = xi0 + gv0 * (acc[ai][bj][m][0] + bv0), xo1 = xi1 + gv1 * (acc[ai][bj][m][1] + bv1);
                    *(f32x4*)(xout + off) = xo0; *(f32x4*)(xout + off + 4) = xo1;
                    if (XG) {
                        ssum[ai][m] += ((xo0[0] * xo0[0] + xo0[1] * xo0[1]) + (xo0[2] * xo0[2] + xo0[3] * xo0[3])) + ((xo1[0] * xo1[0] + xo1[1] * xo1[1]) + (xo1[2] * xo1[2] + xo1[3] * xo1[3]));
                        const f32x4 y0 = xo0 * gm0, y1 = xo1 * gm1;
                        u32x4 w; w.x = cvt_pk_bf16(y0[0], y0[1]); w.y = cvt_pk_bf16(y0[2], y0[3]); w.z = cvt_pk_bf16(y1[0], y1[1]); w.w = cvt_pk_bf16(y1[2], y1[3]);
                        *(u32x4*)(XG + off) = w; }
                    if (m & 1) asm volatile("" ::: "memory"); }
        }
        if (XG) {
#pragma unroll
            for (int ai = 0; ai < 2; ++ai)
#pragma unroll
                for (int m = 0; m < 4; ++m) { float q = ssum[ai][m]; q += __shfl_xor(q, 16); q += __shfl_xor(q, 32);
                    if (fq == 0) atomicAdd(SSo + row0 + ai * HALF + m * 16, (unsigned long long)(q * 16777216.0f)); }
        }
    }
};
struct EpiSwiGLU {
    static constexpr bool PERM = true;
    bf16_t* H; const float* shw; const unsigned long long* SS;
    __device__ __forceinline__ void operator()(const f32x4 (&acc)[2][2][4][2], const Unit& u, int wr, int wc, int fr, int fq) const {
        const int row0 = u.pm * BM + wr * 64 + fr, f0 = u.pn * 128 + wc * 32 + 8 * fq;
        f32x4 bv[2][2];
        { const float* sp = shw + (size_t)(u.pm >> 3) * (2 * DFF) + u.pn * BM + wc * 32 + 8 * fq;
#pragma unroll
          for (int bj = 0; bj < 2; ++bj)
#pragma unroll
              for (int n = 0; n < 2; ++n) bv[bj][n] = *(const f32x4*)(sp + bj * HALF + 4 * n); }
#pragma unroll
        for (int ai = 0; ai < 2; ++ai)
#pragma unroll
            for (int m = 0; m < 4; ++m) { bf16_t* rowp = H + (size_t)(row0 + ai * HALF + m * 16) * DFF + f0;
                const float rs = 1.0f / sqrtf((float)SS[row0 + ai * HALF + m * 16] * (1.0f / (16777216.0f * D)) + EPS);
                float o[8];
#pragma unroll
                for (int n = 0; n < 2; ++n)
#pragma unroll
                    for (int e = 0; e < 4; ++e) o[4 * n + e] = silu_f(acc[ai][0][m][n][e] * rs + bv[0][n][e]) * (acc[ai][1][m][n][e] * rs + bv[1][n][e]);
                u32x4 w; w.x = cvt_pk_bf16(o[0], o[1]); w.y = cvt_pk_bf16(o[2], o[3]); w.z = cvt_pk_bf16(o[4], o[5]); w.w = cvt_pk_bf16(o[6], o[7]);
                *(u32x4*)(rowp) = w; }
    }
};
}

struct Ptrs {
    const float* in[23]; float* out; unsigned char* ws;
};
enum { I_X = 0, I_C, I_RELB, I_WADA, I_BADA, I_GMIX, I_GFFN, I_AWIN, I_AKVG, I_AWUK, I_AWUV, I_AIKG, I_AIKB, I_AWOUT, I_BWIN, I_BBIN, I_BSINK, I_BWOUT, I_BBOUT, I_W1, I_W3, I_W2, I_GFIN };

__device__ __forceinline__ void conv_task(const Ptrs& P, int t, int lane) {
    int kind, rb, ks, Kd; bf16_t* dst; const float* s0 = nullptr; const float* s1 = nullptr; const float* gk = nullptr; int ld = 0;
    if (t < 2112) { const int l = t / 528, r = t % 528; unsigned char* wl = P.ws + WS_W + (size_t)l * W_LAYER;
        if (r < 352) { kind = 1; rb = r >> 2; ks = r & 3; Kd = 1024; dst = (bf16_t*)(wl + W13_OFF); s0 = P.in[I_W1] + (size_t)l * D * DFF; s1 = P.in[I_W3] + (size_t)l * D * DFF; ld = DFF; }
        else { const int r2 = r - 352; kind = 0; rb = r2 / 11; ks = r2 % 11; Kd = DFF; dst = (bf16_t*)(wl + W2_OFF); s0 = P.in[I_W2] + (size_t)l * DFF * D; ld = D; }
    } else { const int t2 = t - 2112, j = t2 / 464, r = t2 % 464; unsigned char* wa = P.ws + WS_WA + (size_t)j * WA_STRIDE; unsigned char* wb = P.ws + WS_WB + (size_t)j * WB_STRIDE;
        if (r < 128) { kind = 2; rb = r >> 2; ks = r & 3; Kd = 1024; dst = (bf16_t*)(wa + WINA_OFF); s0 = P.in[I_AWIN] + (size_t)j * D * A_IN; ld = A_IN; }
        else if (r < 192) { kind = 3; rb = r - 128; ks = 0; Kd = 256; dst = (bf16_t*)(wa + WQA_OFF); s0 = P.in[I_AWUK] + (size_t)j * NH * RK * HD; gk = P.in[I_AKVG] + j * RK; }
        else if (r < 256) { const int r2 = r - 192; kind = 4; rb = r2 >> 2; ks = r2 & 3; Kd = 1024; dst = (bf16_t*)(wa + WUV_OFF); s0 = P.in[I_AWUV] + (size_t)j * NH * RK * HD; gk = P.in[I_AKVG] + j * RK; }
        else if (r < 320) { const int r2 = r - 256; kind = 0; rb = r2 >> 2; ks = r2 & 3; Kd = 1024; dst = (bf16_t*)(wa + WOUTA_OFF); s0 = P.in[I_AWOUT] + (size_t)j * D * D; ld = D; }
        else if (r < 400) { const int r2 = r - 320; kind = 0; rb = r2 >> 2; ks = r2 & 3; Kd = 1024; dst = (bf16_t*)(wb + WINB_OFF); s0 = P.in[I_BWIN] + (size_t)j * D * B_IN; ld = B_IN; }
        else { const int r2 = r - 400; kind = 0; rb = r2 >> 2; ks = r2 & 3; Kd = 1024; dst = (bf16_t*)(wb + WOUTB_OFF); s0 = P.in[I_BWOUT] + (size_t)j * D * D; ld = D; }
    }
    const int n = rb * 64 + lane, k0 = ks * 256;
    bf16_t* drow = dst + (size_t)n * Kd + k0;
    if (kind <= 2) {
        const float* src = s0; int col = n;
        if (kind == 1) { const int c = n & 255, f = (n >> 8) * 128 + (c & 127); src = (c < 128) ? s0 : s1; col = f; }
        if (kind == 2) { if (n >= 1792) { const int c = n - 1792; col = c < 32 ? 1792 + c : (c < 40 ? 1856 + (c - 32) : ((c >= 128 && c < 160) ? 1824 + (c - 128) : -1)); } }
        const float* sp = src + (size_t)k0 * ld + (col < 0 ? 0 : col);
        for (int kc = 0; kc < 32; ++kc) {
            float v[8];
#pragma unroll
            for (int e = 0; e < 8; ++e) v[e] = sp[(size_t)(kc * 8 + e) * ld];
            if (col < 0) {
#pragma unroll
                for (int e = 0; e < 8; ++e) v[e] = 0.f; }
            u32x4 w; w.x = cvt_pk_bf16(v[0], v[1]); w.y = cvt_pk_bf16(v[2], v[3]); w.z = cvt_pk_bf16(v[4], v[5]); w.w = cvt_pk_bf16(v[6], v[7]);
            *(u32x4*)(drow + kc * 8) = w;
        }
    } else if (kind == 3) {
        const int h = n >> 8, r = n & 255; const float gs = gk[r] * 0.125f; const float* sp = s0 + ((size_t)h * RK + r) * HD;
        for (int kc = 0; kc < 32; ++kc) { const int k = kc * 8; float v[8];
            if ((k >> 6) == (h & 3)) {
#pragma unroll
                for (int e = 0; e < 8; ++e) v[e] = sp[(k & 63) + e] * gs;
            } else {
#pragma unroll
                for (int e = 0; e < 8; ++e) v[e] = 0.f; }
            u32x4 w; w.x = cvt_pk_bf16(v[0], v[1]); w.y = cvt_pk_bf16(v[2], v[3]); w.z = cvt_pk_bf16(v[4], v[5]); w.w = cvt_pk_bf16(v[6], v[7]);
            *(u32x4*)(drow + kc * 8) = w; }
    } else {
        const int hh = (n >> 6) & 3, d = n & 63, h = n >> 6;
        for (int kc = 0; kc < 32; ++kc) { const int k = k0 + kc * 8; float v[8];
            if ((k >> 8) == hh) {
#pragma unroll
                for (int e = 0; e < 8; ++e) { const int r = (k & 255) + e; v[e] = s0[((size_t)h * RK + r) * HD + d] * gk[r]; }
            } else {
#pragma unroll
                for (int e = 0; e < 8; ++e) v[e] = 0.f; }
            u32x4 w; w.x = cvt_pk_bf16(v[0], v[1]); w.y = cvt_pk_bf16(v[2], v[3]); w.z = cvt_pk_bf16(v[4], v[5]); w.w = cvt_pk_bf16(v[6], v[7]);
            *(u32x4*)(drow + kc * 8) = w; }
    }
}
constexpr int N_CONV_TASKS = 3040;

__device__ __forceinline__ void p0_prologue(const Ptrs& P, LAS unsigned char* lds, int G) {
    int tid = threadIdx.x; asm volatile("" : "+v"(tid));
    const int lane = tid & 63, wave = __builtin_amdgcn_readfirstlane(tid >> 6);
    const int gw = blockIdx.x * NWAVES + wave, NGW = G * NWAVES;
    for (int t = gw; t < N_CONV_TASKS; t += NGW) conv_task(P, t, lane);
    LAS float* cs = (LAS float*)lds;
    LAS float* red = (LAS float*)(lds + 65536);
    for (int i = tid; i < BATCH * D; i += NTHR) { const int b = i >> 10, k = i & 1023; cs[k * 16 + b] = silu_f(P.in[I_C][i]); }
    __syncthreads();
    float* mod = (float*)(P.ws + WS_MOD);
    for (int task = blockIdx.x; task < 4 * 96; task += G) {
        const int l = task / 96, j0 = (task % 96) * 64, col = tid & 63, ksl = tid >> 6;
        const float* wp = P.in[I_WADA] + ((size_t)l * D + ksl * 128) * 6144 + j0 + col;
        float a[16];
#pragma unroll
        for (int b = 0; b < 16; ++b) a[b] = 0.f;
        for (int k = 0; k < 128; ++k) { const float w = wp[(size_t)k * 6144]; const LAS f32x4* c4 = (const LAS f32x4*)(cs + (ksl * 128 + k) * 16);
#pragma unroll
            for (int q = 0; q < 4; ++q) { const f32x4 c = c4[q];
#pragma unroll
                for (int e = 0; e < 4; ++e) a[4 * q + e] += w * c[e]; } }
#pragma unroll
        for (int b = 0; b < 16; ++b) red[(ksl * 64 + col) * 16 + b] = a[b];
        __syncthreads();
        for (int o = tid; o < 1024; o += NTHR) { const int c2 = o >> 4, b = o & 15; float s = 0.f;
#pragma unroll
            for (int q = 0; q < 8; ++q) s += red[(q * 64 + c2) * 16 + b];
            mod[((size_t)l * BATCH + b) * 6144 + j0 + c2] = s + P.in[I_BADA][l * 6144 + j0 + c2]; }
        __syncthreads();
    }
}

__device__ __forceinline__ void pre_phase(const Ptrs& P, LAS unsigned char* lds, int G) {
    int tid = threadIdx.x; asm volatile("" : "+v"(tid));
    const int lane = tid & 63, wave = __builtin_amdgcn_readfirstlane(tid >> 6);
    const float* mod = (const float*)(P.ws + WS_MOD);
    {
        const int grp = blockIdx.x & 7, l = grp >> 1, kind = grp & 1, j = l >> 1;
        const float* shsrc = mod + (size_t)l * BATCH * 6144 + (kind ? 3072 : 0);
        constexpr int SP = 2064;
        for (int i = tid; i < BATCH * D / 2; i += NTHR) { const int b = i >> 9, k2 = (i & 511) * 2;
            const float a0 = shsrc[(size_t)b * 6144 + k2], a1 = shsrc[(size_t)b * 6144 + k2 + 1];
            *(LAS unsigned*)(lds + b * SP + k2 * 2) = cvt_pk_bf16(a0, a1); }
        __syncthreads();
        const bf16_t* W; int nrows; float* dst; const float* bias = nullptr;
        if (kind) { W = (const bf16_t*)(P.ws + WS_W + (size_t)l * W_LAYER + W13_OFF); nrows = 2 * DFF; dst = (float*)(P.ws + WS_SHW + SHW_F) + (size_t)l * BATCH * 2 * DFF; }
        else if ((l & 1) == 0) { W = (const bf16_t*)(P.ws + WS_WA + (size_t)j * WA_STRIDE + WINA_OFF); nrows = 2048; dst = (float*)(P.ws + WS_SHW + SHW_A) + (size_t)j * BATCH * 2048; }
        else { W = (const bf16_t*)(P.ws + WS_WB + (size_t)j * WB_STRIDE + WINB_OFF); nrows = B_IN; dst = (float*)(P.ws + WS_SHW + SHW_B) + (size_t)j * BATCH * B_IN; bias = P.in[I_BBIN] + j * B_IN; }
        const int nblk = nrows >> 4, wq = (blockIdx.x >> 3) * NWAVES + wave, nwq = (G >> 3) * NWAVES;
        const int nn = lane & 15, g = lane >> 4;
        for (int blk = wq; blk < nblk; blk += nwq) {
            f32x4 acc = (f32x4){0.f, 0.f, 0.f, 0.f};
            const bf16_t* wp = W + (size_t)(blk * 16 + nn) * D + 8 * g;
#pragma unroll 8
            for (int ks = 0; ks < 32; ++ks) { const bf16x8 a = *(const LAS bf16x8*)(lds + nn * SP + (32 * ks + 8 * g) * 2); const bf16x8 bw = *(const bf16x8*)(wp + 32 * ks);
                acc = __builtin_amdgcn_mfma_f32_16x16x32_bf16(a, bw, acc, 0, 0, 0); }
            const int n = blk * 16 + nn; const float bb = bias ? bias[n] : 0.f;
#pragma unroll
            for (int i = 0; i < 4; ++i) dst[(size_t)(4 * g + i) * nrows + n] = acc[i] + bb;
        }
    }
    {
        const int gw = blockIdx.x * NWAVES + wave, NGW = G * NWAVES;
        const float* x = P.in[I_X]; const float* gmix = P.in[I_GMIX]; bf16_t* XG = (bf16_t*)(P.ws + WS_XG); unsigned long long* SS0 = (unsigned long long*)(P.ws + WS_SS);
        for (int row = gw; row < M; row += NGW) {
            const int b = row >> 11;
            const f32x4* xr = (const f32x4*)(x + (size_t)row * D) + lane;
            f32x4 v[4]; float sq = 0.f;
#pragma unroll
            for (int jj = 0; jj < 4; ++jj) { v[jj] = xr[64 * jj]; sq += (v[jj][0] * v[jj][0] + v[jj][1] * v[jj][1]) + (v[jj][2] * v[jj][2] + v[jj][3] * v[jj][3]); }
            const float ss = wave_sum(sq);
            if (lane == 0) SS0[row] = (unsigned long long)(ss * 16777216.0f);
            const float* mb = mod + (size_t)b * 6144;
            u32x2* o8 = (u32x2*)(XG + (size_t)row * D) + lane;
#pragma unroll
            for (int jj = 0; jj < 4; ++jj) { const int c = 4 * lane + 256 * jj;
                const f32x4 y = v[jj] * *(const f32x4*)(gmix + c) * (*(const f32x4*)(mb + 1024 + c) + 1.0f);
                u32x2 w; w.x = cvt_pk_bf16(y[0], y[1]); w.y = cvt_pk_bf16(y[2], y[3]); o8[64 * jj] = w; }
        }
    }
}
__device__ __forceinline__ void final_norm_phase(float* x, const float* g, int G) {
    int tid = threadIdx.x; asm volatile("" : "+v"(tid));
    const int lane = tid & 63, wave = __builtin_amdgcn_readfirstlane(tid >> 6);
    const int gw = blockIdx.x * NWAVES + wave, NGW = G * NWAVES;
    for (int row = gw; row < M; row += NGW) {
        f32x4* xr = (f32x4*)(x + (size_t)row * D) + lane;
        f32x4 v[4]; float s = 0.f;
#pragma unroll
        for (int j = 0; j < 4; ++j) { v[j] = xr[64 * j]; s += (v[j][0] * v[j][0] + v[j][1] * v[j][1]) + (v[j][2] * v[j][2] + v[j][3] * v[j][3]); }
        const float rstd = 1.0f / sqrtf(wave_sum(s) * (1.0f / D) + EPS);
#pragma unroll
        for (int j = 0; j < 4; ++j) { const f32x4 gg = *(const f32x4*)(g + 4 * lane + 256 * j); xr[64 * j] = v[j] * rstd * gg; }
    }
}

__device__ __forceinline__ unsigned f2key(float f) { const unsigned u = __float_as_uint(f); return (u & 0x80000000u) ? ~u : (u | 0x80000000u); }
__device__ __forceinline__ float key2f(unsigned k) { return __uint_as_float((k & 0x80000000u) ? (k & 0x7fffffffu) : ~k); }
__device__ __forceinline__ int half_sum(int v) {
#pragma unroll
    for (int o = 1; o < 32; o <<= 1) v += __shfl_xor(v, o);
    return v;
}
__device__ __forceinline__ void idx_task(const bf16_t* QI, const bf16_t* KIN, const float* WI, unsigned* SEL, int b, int tg, int lane) {
    asm volatile("" : "+v"(lane));
    const int t0 = tg * 4, h = lane >> 5, r = lane & 31;
    const int qsel = 2 * (r >> 4) + ((r >> 2) & 1), hd = (r & 3) + 4 * ((r >> 3) & 1);
    const size_t rowb = (size_t)b * SEQ;
    bf16x8 aq[4];
#pragma unroll
    for (int ks = 0; ks < 4; ++ks) aq[ks] = *(const bf16x8*)(QI + (rowb + t0 + qsel) * 512 + hd * 64 + ks * 16 + h * 8);
    float wlo[8], whi[8];
    { const f32x4 a0 = *(const f32x4*)(WI + (rowb + t0 + h) * 8), a1 = *(const f32x4*)(WI + (rowb + t0 + h) * 8 + 4);
      const f32x4 b0 = *(const f32x4*)(WI + (rowb + t0 + 2 + h) * 8), b1 = *(const f32x4*)(WI + (rowb + t0 + 2 + h) * 8 + 4);
#pragma unroll
      for (int e = 0; e < 4; ++e) { wlo[e] = a0[e]; wlo[4 + e] = a1[e]; whi[e] = b0[e]; whi[4 + e] = b1[e]; } }
    float slo[64], shi[64];
#pragma unroll
    for (int kt = 0; kt < 64; ++kt) { slo[kt] = NEGF; shi[kt] = NEGF; }
    const int ktmax = (t0 + 3) >> 5, tlo = t0 + h, thi = t0 + 2 + h;
    const bf16_t* kp = KIN + (rowb + r) * 64 + h * 8;
#pragma unroll
    for (int kt = 0; kt < 64; ++kt) {
        if (kt <= ktmax) {
            asm volatile("" : "+v"(kp));
            f32x16 acc;
#pragma unroll
            for (int i = 0; i < 16; ++i) acc[i] = 0.f;
#pragma unroll
            for (int ks = 0; ks < 4; ++ks) { const bf16x8 bk = *(const bf16x8*)(kp + ks * 16); acc = __builtin_amdgcn_mfma_f32_32x32x16_bf16(aq[ks], bk, acc, 0, 0, 0); }
            float s0 = 0.f, s1 = 0.f;
#pragma unroll
            for (int i = 0; i < 8; ++i) { s0 += wlo[i] * fmaxf(acc[i], 0.f); s1 += whi[i] * fmaxf(acc[8 + i], 0.f); }
            const int key = kt * 32 + r;
            slo[kt] = key <= tlo ? s0 : NEGF; shi[kt] = key <= thi ? s1 : NEGF;
            kp += 32 * 64;
        }
    }
    const int Ka = tlo + 1 < TOPK ? tlo + 1 : TOPK, Kb = thi + 1 < TOPK ? thi + 1 : TOPK;
    unsigned loA = 0x00800000u, hiA = 0xFF800000u, loB = 0x00800000u, hiB = 0xFF800000u;
    float TA = -1e29f, TB = -1e29f; bool doneA = (tlo + 1 <= TOPK), doneB = (thi + 1 <= TOPK);
    for (int it = 0; it < 40; ++it) {
        if (__ballot(!doneA || !doneB) == 0ull) break;
        const unsigned midA = loA + ((hiA - loA) >> 1), midB = loB + ((hiB - loB) >> 1);
        const float fA = doneA ? TA : key2f(midA), fB = doneB ? TB : key2f(midB);
        int cA = 0, cB = 0;
#pragma unroll
        for (int kt = 0; kt < 64; ++kt) { cA += (slo[kt] >= fA) ? 1 : 0; cB += (shi[kt] >= fB) ? 1 : 0; }
        cA = half_sum(cA); cB = half_sum(cB);
        if (!doneA) { if (cA == Ka) { TA = fA; doneA = true; } else if (cA > Ka) loA = midA; else hiA = midA;
            if (!doneA && hiA - loA <= 1u) { TA = key2f(loA); doneA = true; } }
        if (!doneB) { if (cB == Kb) { TB = fB; doneB = true; } else if (cB > Kb) loB = midB; else hiB = midB;
            if (!doneB && hiB - loB <= 1u) { TB = key2f(loB); doneB = true; } }
    }
    unsigned w0 = 0u, w1 = 0u, w2 = 0u, w3 = 0u;
#pragma unroll
    for (int kt = 0; kt < 64; ++kt) { const unsigned long long ma = __ballot(slo[kt] >= TA), mb = __ballot(shi[kt] >= TB);
        if (lane == kt) { w0 = (unsigned)ma; w1 = (unsigned)(ma >> 32); w2 = (unsigned)mb; w3 = (unsigned)(mb >> 32); } }
    SEL[(rowb + t0 + 0) * 64 + lane] = w0; SEL[(rowb + t0 + 1) * 64 + lane] = w1; SEL[(rowb + t0 + 2) * 64 + lane] = w2; SEL[(rowb + t0 + 3) * 64 + lane] = w3;
}

__device__ __forceinline__ s16x4 tr_read(unsigned lds_addr) { s16x4 r; asm volatile("ds_read_b64_tr_b16 %0, %1\n\ts_waitcnt lgkmcnt(0)" : "=&v"(r) : "v"(lds_addr) : "memory"); return r; }

__device__ __forceinline__ void att_query(const bf16_t* CKV, const float* RKV, const unsigned* SEL, bf16_t* BIG, LAS unsigned char* kvbuf, LAS unsigned* kmeta, LAS float* krstd,
                                          const LAS float* relb, int b, int t, int lane) {
    asm volatile("" : "+v"(lane));
    const size_t row = (size_t)b * SEQ + t, rowb = (size_t)b * SEQ;
    const int hq = lane & 15, g = lane >> 4;
    unsigned w = SEL[row * 64 + lane];
    const int pc = __popc(w); int incl = pc;
#pragma unroll
    for (int o = 1; o < 64; o <<= 1) { const int v = __shfl_up(incl, o); if (lane >= o) incl += v; }
    const int total = __shfl(incl, 63); const int cnt = total < TOPK ? total : TOPK;
    int off = incl - pc;
    while (w) { const int bit = __builtin_ctz(w); w &= w - 1u;
        if (off < TOPK) { const int idx = 32 * lane + bit; const int dd = t - idx; kmeta[off] = (unsigned)idx | ((unsigned)t5_bucket(dd < 0 ? 0 : dd) << 16); krstd[off] = RKV[rowb + idx]; }
        ++off; }
    const int nch = (cnt + 31) >> 5;
    for (int s = cnt + lane; s < nch * 32; s += 64) { kmeta[s] = 0u; krstd[s] = 0.f; }
    bf16x8 bq[8];
    { const bf16_t* qp = BIG + row * 4096 + hq * 256 + 8 * g;
#pragma unroll
      for (int ks = 0; ks < 8; ++ks) bq[ks] = *(const bf16x8*)(qp + 32 * ks); }
    f32x4 O[16];
#pragma unroll
    for (int nt = 0; nt < 16; ++nt) O[nt] = (f32x4){0.f, 0.f, 0.f, 0.f};
    float mref = NEGF, lsum = 0.f;
    const unsigned kvb = (unsigned)(size_t)kvbuf;
    const unsigned qk_base = kvb + (unsigned)(lane & 15) * 512u;
    const int swz = 2 * (lane & 7);
    const int i16 = lane & 15, tq = i16 >> 2, tp = i16 & 3, trow = 4 * g + tq;
    const unsigned tr_base = kvb + (unsigned)trow * 512u + 8u * (unsigned)(tp & 1);
    const int tswz = 2 * (trow & 7);
    for (int c = 0; c < nch; ++c) {
        const unsigned meta = kmeta[32 * c + (lane & 31)];
        asm volatile("s_waitcnt lgkmcnt(0)" ::: "memory");
#pragma unroll
        for (int i = 0; i < 16; ++i) {
            const unsigned m0 = __builtin_amdgcn_readlane(meta, 2 * i), m1 = __builtin_amdgcn_readlane(meta, 2 * i + 1);
            const unsigned idx = ((lane >> 5) ? m1 : m0) & 0xffffu;
            const int rr = (2 * i + (lane >> 5)) & 7;
            const bf16_t* src = CKV + (rowb + idx) * 256 + 8 * ((lane & 31) ^ (2 * rr));
            __builtin_amdgcn_global_load_lds((const unsigned*)src, (LAS unsigned*)(kvbuf + 1024 * i), 16, 0, 0);
        }
        asm volatile("s_waitcnt vmcnt(0)" ::: "memory");
        f32x4 st[2];
#pragma unroll
        for (int T = 0; T < 2; ++T) { st[T] = (f32x4){0.f, 0.f, 0.f, 0.f};
#pragma unroll
            for (int ks = 0; ks < 8; ++ks) { const bf16x8 a = *(const LAS bf16x8*)(size_t)(qk_base + (unsigned)T * 8192u + 16u * (unsigned)((4 * ks + g) ^ swz));
                st[T] = __builtin_amdgcn_mfma_f32_16x16x32_bf16(a, bq[ks], st[T], 0, 0, 0); } }
        float lg[8], rs[8]; float cmax = NEGF;
#pragma unroll
        for (int T = 0; T < 2; ++T) { const int s0 = 32 * c + 16 * T + 4 * g;
            const u32x4 mt = *(const LAS u32x4*)(kmeta + s0); const f32x4 rv = *(const LAS f32x4*)(krstd + s0);
#pragma unroll
            for (int i = 0; i < 4; ++i) { const float bias = relb[(mt[i] >> 16) * 16 + hq]; rs[4 * T + i] = rv[i];
                float v = st[T][i] * rv[i] + bias; v = (s0 + i < cnt) ? v : NEGF; lg[4 * T + i] = v; cmax = fmaxf(cmax, v); } }
        cmax = fmaxf(cmax, __shfl_xor(cmax, 16)); cmax = fmaxf(cmax, __shfl_xor(cmax, 32));
        if (__ballot(cmax > mref + 8.0f) != 0ull) {
            const float mnew = fmaxf(mref, cmax), sc = fast_exp(mref - mnew);
            lsum *= sc;
#pragma unroll
            for (int nt = 0; nt < 16; ++nt) O[nt] = O[nt] * sc;
            mref = mnew;
        }
        float p[8];
#pragma unroll
        for (int i = 0; i < 8; ++i) { p[i] = fast_exp(lg[i] - mref); lsum += p[i]; p[i] *= rs[i]; }
        u32x4 pkw; pkw.x = cvt_pk_bf16(p[0], p[1]); pkw.y = cvt_pk_bf16(p[2], p[3]); pkw.z = cvt_pk_bf16(p[4], p[5]); pkw.w = cvt_pk_bf16(p[6], p[7]);
        const bf16x8 pk = __builtin_bit_cast(bf16x8, pkw);
#pragma unroll
        for (int nt = 0; nt < 16; ++nt) {
            const unsigned a0 = tr_base + 16u * (unsigned)((2 * nt + (tp >> 1)) ^ tswz);
            const s16x4 lo = tr_read(a0), hi = tr_read(a0 + 8192u);
            const bf16x8 kvt = __builtin_shufflevector(lo, hi, 0, 1, 2, 3, 4, 5, 6, 7);
            O[nt] = __builtin_amdgcn_mfma_f32_16x16x32_bf16(kvt, pk, O[nt], 0, 0, 0);
        }
    }
    lsum += __shfl_xor(lsum, 16); lsum += __shfl_xor(lsum, 32);
    const float inv = 1.0f / lsum;
    bf16_t* op = BIG + row * 4096 + hq * 256 + 4 * g;
#pragma unroll
    for (int nt = 0; nt < 16; ++nt) { const f32x4 o = O[nt] * inv; u32x2 wv; wv.x = cvt_pk_bf16(o[0], o[1]); wv.y = cvt_pk_bf16(o[2], o[3]); *(u32x2*)(op + 16 * nt) = wv; }
}

constexpr int SW_KP = 144, SW_VP = 520;
constexpr int SW_K_OFF = 0, SW_V_OFF = 256 * SW_KP, SW_TB_OFF = SW_V_OFF + 64 * SW_VP;
__device__ __forceinline__ void swa_phase(const bf16_t* QKV, bf16_t* OB, const float* relb, const float* sinks, LAS unsigned char* lds, int G) {
    int tid = threadIdx.x; asm volatile("" : "+v"(tid));
    const int lane = tid & 63, wave = __builtin_amdgcn_readfirstlane(tid >> 6);
    const int h = lane >> 5, n = lane & 31;
    LAS float* tb = (LAS float*)(lds + SW_TB_OFF);
    for (int u = blockIdx.x; u < BATCH * 16 * KVH; u += G) {
        const int b = u >> 5, nb = (u >> 1) & 15, kvh = u & 1;
        const size_t rowb = (size_t)b * SEQ;
        __syncthreads();
#pragma unroll
        for (int e = 0; e < 4; ++e) { const int id = tid + NTHR * e, j = id >> 3, ch = id & 7; const int pos = (nb - 1) * WIN + j;
            u32x4 kv = (u32x4){0u, 0u, 0u, 0u}, vv = (u32x4){0u, 0u, 0u, 0u};
            if (pos >= 0) { const bf16_t* sp = QKV + (rowb + pos) * B_IN + 1024 + kvh * 64 + ch * 8; kv = *(const u32x4*)sp; vv = *(const u32x4*)(sp + 128); }
            *(LAS u32x4*)(lds + SW_K_OFF + j * SW_KP + ch * 16) = kv;
            LAS bf16_t* vt = (LAS bf16_t*)(lds + SW_V_OFF + (ch * 8) * SW_VP + j * 2);
#pragma unroll
            for (int q = 0; q < 4; ++q) { vt[(2 * q) * (SW_VP / 2)] = (bf16_t)(vv[q] & 0xffffu); vt[(2 * q + 1) * (SW_VP / 2)] = (bf16_t)(vv[q] >> 16); } }
        for (int i = tid; i < GQ * WIN; i += NTHR) { const int gg = i >> 7, dist = i & 127; tb[i] = relb[t5_bucket(dist) * NH + kvh * GQ + gg]; }
        __syncthreads();
        const int qh = kvh * GQ + wave; const float sink = sinks[qh];
        for (int rt = 0; rt < 4; ++rt) {
            const size_t qrow = rowb + nb * WIN + 32 * rt + n;
            bf16x8 bq[4];
#pragma unroll
            for (int ks = 0; ks < 4; ++ks) bq[ks] = *(const bf16x8*)(QKV + qrow * B_IN + qh * 64 + 16 * ks + 8 * h);
            f32x16 s[5];
#pragma unroll
            for (int ct = 0; ct < 5; ++ct) {
#pragma unroll
                for (int i = 0; i < 16; ++i) s[ct][i] = 0.f;
#pragma unroll
                for (int ks = 0; ks < 4; ++ks) { const bf16x8 a = *(const LAS bf16x8*)(lds + SW_K_OFF + (32 * (rt + ct) + n) * SW_KP + (2 * ks + h) * 16);
                    s[ct] = __builtin_amdgcn_mfma_f32_32x32x16_bf16(a, bq[ks], s[ct], 0, 0, 0); } }
            const int qi = 32 * rt + n;
            float mx = NEGF;
#pragma unroll
            for (int ct = 0; ct < 5; ++ct)
#pragma unroll
                for (int i = 0; i < 16; ++i) { const int j = 32 * (rt + ct) + (i & 3) + 8 * (i >> 2) + 4 * h; const int dist = qi + WIN - j;
                    const bool ok = (dist >= 0) && (dist < WIN) && (nb > 0 || j >= WIN);
                    const float v = ok ? s[ct][i] * 0.125f + tb[wave * WIN + (dist & 127)] : NEGF; s[ct][i] = v; mx = fmaxf(mx, v); }
            mx = fmaxf(mx, __shfl_xor(mx, 32)); mx = fmaxf(mx, sink);
            float sum = 0.f;
#pragma unroll
            for (int ct = 0; ct < 5; ++ct)
#pragma unroll
                for (int i = 0; i < 16; ++i) { const float p = fast_exp(s[ct][i] - mx); s[ct][i] = p; sum += p; }
            sum += __shfl_xor(sum, 32); sum += fast_exp(sink - mx);
            f32x16 o[2];
#pragma unroll
            for (int dt = 0; dt < 2; ++dt)
#pragma unroll
                for (int i = 0; i < 16; ++i) o[dt][i] = 0.f;
#pragma unroll
            for (int ct = 0; ct < 5; ++ct)
#pragma unroll
                for (int s2 = 0; s2 < 2; ++s2) {
                    u32x4 pw; pw.x = cvt_pk_bf16(s[ct][8 * s2 + 0], s[ct][8 * s2 + 1]); pw.y = cvt_pk_bf16(s[ct][8 * s2 + 2], s[ct][8 * s2 + 3]);
                    pw.z = cvt_pk_bf16(s[ct][8 * s2 + 4], s[ct][8 * s2 + 5]); pw.w = cvt_pk_bf16(s[ct][8 * s2 + 6], s[ct][8 * s2 + 7]);
                    const bf16x8 pb = __builtin_bit_cast(bf16x8, pw);
#pragma unroll
                    for (int dt = 0; dt < 2; ++dt) { const LAS unsigned char* vp = lds + SW_V_OFF + (32 * dt + n) * SW_VP + (32 * (rt + ct) + 16 * s2 + 4 * h) * 2;
                        const u32x2 v0 = *(const LAS u32x2*)vp, v1 = *(const LAS u32x2*)(vp + 16);
                        u32x4 va; va.x = v0.x; va.y = v0.y; va.z = v1.x; va.w = v1.y;
                        o[dt] = __builtin_amdgcn_mfma_f32_32x32x16_bf16(__builtin_bit_cast(bf16x8, va), pb, o[dt], 0, 0, 0); }
                }
            const float inv = 1.0f / sum;
            bf16_t* op = OB + qrow * D + qh * 64 + 4 * h;
#pragma unroll
            for (int dt = 0; dt < 2; ++dt)
#pragma unroll
                for (int i4 = 0; i4 < 4; ++i4) { u32x2 wv; wv.x = cvt_pk_bf16(o[dt][4 * i4] * inv, o[dt][4 * i4 + 1] * inv); wv.y = cvt_pk_bf16(o[dt][4 * i4 + 2] * inv, o[dt][4 * i4 + 3] * inv);
                    *(u32x2*)(op + 32 * dt + 8 * i4) = wv; }
        }
    }
}

struct Args { const float* in[23]; float* out; unsigned char* ws; };
#define CAS __attribute__((address_space(4)))
__device__ __forceinline__ const CAS Args* kargs() { const CAS Args* p = (const CAS Args*)__builtin_amdgcn_kernarg_segment_ptr(); asm volatile("" : "+s"(p)); return p; }

__global__ void __launch_bounds__(NTHR, 2) trunk_fwd(Args args_by_value) {
    extern __shared__ __attribute__((aligned(16))) unsigned char lds_raw[];
    LAS unsigned char* lds = (LAS unsigned char*)lds_raw;
    const int tid = threadIdx.x;
    volatile LAS unsigned* MISC = (volatile LAS unsigned*)(lds + LDS_MISC_OFF);
    for (int u = tid; u < (LDS_BYTES - LDS_MISC_OFF) / 4; u += NTHR) MISC[u] = 0u;
    __syncthreads();
    { const CAS Args* A = kargs(); (void)xcd_barrier_post((unsigned*)(A->ws + WS_CTL) + 4096, MISC + 8); }
#define GB() do { const CAS Args* A_ = kargs(); XcdBarrier b_; b_.bar = (unsigned*)(A_->ws + WS_CTL) + 4096; b_.x = xb_xcc_id(); b_.st = MISC + 8; xcd_barrier(b_); } while (0)

    { const CAS Args* A = kargs(); Ptrs P;
#pragma unroll
      for (int i = 0; i < 23; ++i) P.in[i] = A->in[i];
      P.out = A->out; P.ws = A->ws;
      p0_prologue(P, lds, (int)gridDim.x); }
    GB();
    { const CAS Args* A = kargs(); Ptrs P;
#pragma unroll
      for (int i = 0; i < 23; ++i) P.in[i] = A->in[i];
      P.out = A->out; P.ws = A->ws;
      pre_phase(P, lds, (int)gridDim.x); }
    GB();

    for (int l = 0; l < DEPTH; ++l) {
        const bool isA = (l & 1) == 0;
        {
            const CAS Args* A = kargs(); const int G = gridDim.x, j = l >> 1; unsigned char* ws = A->ws;
            const unsigned long long* SS = (const unsigned long long*)(ws + WS_SS) + (size_t)(2 * l) * M;
            if (isA) {
                unsigned char* wa = ws + WS_WA + (size_t)j * WA_STRIDE;
                pg8::Gemm g{(const bf16_t*)(ws + WS_XG), (const bf16_t*)(wa + WINA_OFF), D, D, D, 0, 0}; pg8::StaticOrder S; S.init(M, 2048, G, (int)blockIdx.x);
                pg8::EpiInA E{(bf16_t*)(ws + WS_QO), (bf16_t*)(ws + WS_CKV), (bf16_t*)(ws + WS_QI), (bf16_t*)(ws + WS_KIN), (float*)(ws + WS_WI), A->in[I_AIKG] + j * IDIM, A->in[I_AIKB] + j * IDIM,
                                (const float*)(ws + WS_SHW + SHW_A) + (size_t)j * BATCH * 2048, SS};
                pg8::gemm_phase<pg8::EpiInA, true>(lds, g, S, E);
            } else {
                unsigned char* wb = ws + WS_WB + (size_t)j * WB_STRIDE;
                pg8::Gemm g{(const bf16_t*)(ws + WS_XG), (const bf16_t*)(wb + WINB_OFF), D, D, D, 0, 0}; pg8::StaticOrder S; S.init(M, B_IN, G, (int)blockIdx.x);
                pg8::EpiBf16Plain<true> E{(bf16_t*)(ws + WS_QKV), B_IN, (const float*)(ws + WS_SHW + SHW_B) + (size_t)j * BATCH * B_IN, B_IN, SS};
                pg8::gemm_phase<pg8::EpiBf16Plain<true>, true>(lds, g, S, E);
            }
        }
        GB();
        if (isA) {
            { const CAS Args* A = kargs(); const int G = gridDim.x, j = l >> 1; unsigned char* ws = A->ws;
              unsigned char* wa = ws + WS_WA + (size_t)j * WA_STRIDE;
              pg8::Gemm g{(const bf16_t*)(ws + WS_QO), (const bf16_t*)(wa + WQA_OFF), D, 256, 256, 2, 256}; pg8::StaticOrder S; S.init(M, 4096, G, (int)blockIdx.x);
              pg8::EpiBf16Plain<false> E{(bf16_t*)(ws + WS_BIG), 4096, nullptr, 0, nullptr};
              pg8::gemm_phase<pg8::EpiBf16Plain<false>, true>(lds, g, S, E); }
            { const CAS Args* A = kargs(); const int G = gridDim.x; unsigned char* ws = A->ws;
              int tid2 = tid; asm volatile("" : "+v"(tid2));
              const int lane = tid2 & 63, wave = __builtin_amdgcn_readfirstlane(tid2 >> 6);
              const bf16_t* CKV = (const bf16_t*)(ws + WS_CKV); float* RKV = (float*)(ws + WS_RKV);
              const int gw = blockIdx.x * NWAVES + wave, NGW = G * NWAVES;
              for (int row = gw; row < M; row += NGW) {
                  const u32x2 v = *((const u32x2*)(CKV + (size_t)row * RK) + lane);
                  const float a0 = __uint_as_float(v.x << 16), a1 = __uint_as_float(v.x & 0xffff0000u), a2 = __uint_as_float(v.y << 16), a3 = __uint_as_float(v.y & 0xffff0000u);
                  const float ss = wave_sum((a0 * a0 + a1 * a1) + (a2 * a2 + a3 * a3));
                  if (lane == 0) RKV[row] = 1.0f / sqrtf(ss * (1.0f / RK) + EPS);
              } }
            { const CAS Args* A = kargs(); const int G = gridDim.x; unsigned char* ws = A->ws;
              int tid2 = tid; asm volatile("" : "+v"(tid2));
              const int lane = tid2 & 63, wave = __builtin_amdgcn_readfirstlane(tid2 >> 6);
              const int xcd = blockIdx.x & 7, wx = (blockIdx.x >> 3) * NWAVES + wave, nwx = (G >> 3) * NWAVES;
              for (int q = wx; q < 1024; q += nwx) {
                  const int bl = q >> 9, r9 = q & 511, b = 2 * xcd + bl;
                  const int tg = (r9 & 1) ? 511 - (r9 >> 1) : (r9 >> 1);
                  idx_task((const bf16_t*)(ws + WS_QI), (const bf16_t*)(ws + WS_KIN), (const float*)(ws + WS_WI), (unsigned*)(ws + WS_SEL), b, tg, lane);
              } }
        } else {
            const CAS Args* A = kargs(); const int G = gridDim.x, j = l >> 1; unsigned char* ws = A->ws;
            swa_phase((const bf16_t*)(ws + WS_QKV), (bf16_t*)(ws + WS_OB), A->in[I_RELB], A->in[I_BSINK] + j * NH, lds, G);
        }
        GB();
        if (isA) {
            { const CAS Args* A = kargs(); const int G = gridDim.x; unsigned char* ws = A->ws;
              int tid2 = tid; asm volatile("" : "+v"(tid2));
              const int lane = tid2 & 63, wave = __builtin_amdgcn_readfirstlane(tid2 >> 6);
              LAS float* relb = (LAS float*)(lds + 147456);
              for (int i = tid2; i < NBUCK * NH; i += NTHR) relb[i] = A->in[I_RELB][i];
              __syncthreads();
              LAS unsigned char* kvbuf = lds + wave * 16384;
              LAS unsigned* kmeta = (LAS unsigned*)(lds + 131072 + wave * 2048);
              LAS float* krstd = (LAS float*)(lds + 131072 + wave * 2048 + 1024);
              const int xcd = blockIdx.x & 7, wx = (blockIdx.x >> 3) * NWAVES + wave, nwx = (G >> 3) * NWAVES;
              for (int q = wx; q < 2 * SEQ; q += nwx) { const int b = 2 * xcd + (q >> 11), t = q & 2047;
                  att_query((const bf16_t*)(ws + WS_CKV), (const float*)(ws + WS_RKV), (const unsigned*)(ws + WS_SEL), (bf16_t*)(ws + WS_BIG), kvbuf, kmeta, krstd, relb, b, t, lane); } }
            GB();
            { const CAS Args* A = kargs(); const int G = gridDim.x, j = l >> 1; unsigned char* ws = A->ws;
              unsigned char* wa = ws + WS_WA + (size_t)j * WA_STRIDE;
              pg8::Gemm g{(const bf16_t*)(ws + WS_BIG), (const bf16_t*)(wa + WUV_OFF), 4096, D, D, 0, 1024}; pg8::StaticOrder S; S.init(M, D, G, (int)blockIdx.x);
              pg8::EpiBf16Plain<false> E{(bf16_t*)(ws + WS_QO), D, nullptr, 0, nullptr};
              pg8::gemm_phase<pg8::EpiBf16Plain<false>, true>(lds, g, S, E); }
            GB();
        }
        {
            const CAS Args* A = kargs(); const int G = gridDim.x, j = l >> 1; unsigned char* ws = A->ws;
            const float* xin = (l == 0) ? A->in[I_X] : A->out;
            const float* modl = (const float*)(ws + WS_MOD) + (size_t)l * BATCH * 6144;
            const bf16_t* Ain = (const bf16_t*)(ws + (isA ? WS_QO : WS_OB));
            const bf16_t* Bw = (const bf16_t*)(isA ? ws + WS_WA + (size_t)j * WA_STRIDE + WOUTA_OFF : ws + WS_WB + (size_t)j * WB_STRIDE + WOUTB_OFF);
            pg8::Gemm g{Ain, Bw, D, D, D, 0, 0}; pg8::StaticOrder S; S.init(M, D, G, (int)blockIdx.x);
            pg8::EpiResid E{xin, A->out, modl + 2048, isA ? nullptr : A->in[I_BBOUT] + j * D,
                            (bf16_t*)(ws + WS_XG), A->in[I_GFFN] + l * D, modl + 4096, (unsigned long long*)(ws + WS_SS) + (size_t)(2 * l + 1) * M};
            pg8::gemm_phase<pg8::EpiResid, true>(lds, g, S, E);
        }
        GB();
        {
            const CAS Args* A = kargs(); const int G = gridDim.x; unsigned char* ws = A->ws;
            unsigned char* wl = ws + WS_W + (size_t)l * W_LAYER;
            pg8::Gemm g{(const bf16_t*)(ws + WS_XG), (const bf16_t*)(wl + W13_OFF), D, D, D, 0, 0}; pg8::StaticOrder S; S.init(M, 2 * DFF, G, (int)blockIdx.x);
            pg8::EpiSwiGLU E{(bf16_t*)(ws + WS_HFF), (const float*)(ws + WS_SHW + SHW_F) + (size_t)l * BATCH * 2 * DFF, (const unsigned long long*)(ws + WS_SS) + (size_t)(2 * l + 1) * M};
            pg8::gemm_phase<pg8::EpiSwiGLU, true>(lds, g, S, E);
        }
        GB();
        {
            const CAS Args* A = kargs(); const int G = gridDim.x; unsigned char* ws = A->ws;
            unsigned char* wl = ws + WS_W + (size_t)l * W_LAYER;
            const float* modl = (const float*)(ws + WS_MOD) + (size_t)l * BATCH * 6144;
            const int ln = l + 1 < DEPTH ? l + 1 : l;
            pg8::Gemm g{(const bf16_t*)(ws + WS_HFF), (const bf16_t*)(wl + W2_OFF), DFF, DFF, DFF, 0, 0}; pg8::StaticOrder S; S.init(M, D, G, (int)blockIdx.x);
            pg8::EpiResid E{A->out, A->out, modl + 5120, nullptr,
                            l + 1 < DEPTH ? (bf16_t*)(ws + WS_XG) : nullptr, A->in[I_GMIX] + ln * D, (const float*)(ws + WS_MOD) + (size_t)ln * BATCH * 6144 + 1024, (unsigned long long*)(ws + WS_SS) + (size_t)(2 * l + 2) * M};
            pg8::gemm_phase<pg8::EpiResid, true>(lds, g, S, E);
        }
        GB();
    }
    { const CAS Args* A = kargs(); final_norm_phase(A->out, A->in[I_GFIN], (int)gridDim.x); }
#undef GB
}

extern "C" void kernel_launch(void* const* d_in, const int* in_sizes, int n_in, void* d_out, int out_size, void* d_ws, size_t ws_size, hipStream_t stream) {
    static int grid = 0;
    if (grid == 0) {
        if (n_in != 23 || out_size != M * D || ws_size < WS_END) { fprintf(stderr, "kernel_launch: unexpected shapes (n_in %d out %d ws %zu)\n", n_in, out_size, ws_size); grid = -1; return; }
        int dev = 0, cus = 0, per_cu = 0;
        if (hipGetDevice(&dev) != hipSuccess || hipDeviceGetAttribute(&cus, hipDeviceAttributeMultiprocessorCount, dev) != hipSuccess) { grid = -1; return; }
        if (hipFuncSetAttribute((const void*)trunk_fwd, hipFuncAttributeMaxDynamicSharedMemorySize, LDS_BYTES) != hipSuccess) { fprintf(stderr, "kernel_launch: hipFuncSetAttribute failed\n"); grid = -1; return; }
        if (hipOccupancyMaxActiveBlocksPerMultiprocessor(&per_cu, (const void*)trunk_fwd, NTHR, LDS_BYTES) != hipSuccess || per_cu < 1) { fprintf(stderr, "kernel_launch: occupancy query says %d\n", per_cu); }
        (void)hipGetLastError();
        grid = cus;
    }
    if (grid < 0) return;
    (void)hipMemsetAsync((char*)d_ws + WS_CTL, 0, CTL_ZERO_BYTES, stream);
    Args a{};
    for (int i = 0; i < 23; ++i) a.in[i] = (const float*)d_in[i];
    a.out = (float*)d_out; a.ws = (unsigned char*)d_ws;
    hipLaunchKernelGGL(trunk_fwd, dim3(grid), dim3(NTHR), LDS_BYTES, stream, a);
    const hipError_t le = hipPeekAtLastError();
    if (le != hipSuccess) fprintf(stderr, "kernel_launch: launch failed: %s\n", hipGetErrorName(le));
}
```

```cpp
#include <hip/hip_runtime.h>
#include <cstdio>
#include <cstdint>


#define GAS __attribute__((address_space(1)))
#define LAS __attribute__((address_space(3)))
typedef unsigned short bf16_t;
typedef short bf16x8 __attribute__((ext_vector_type(8)));
typedef short s16x4 __attribute__((ext_vector_type(4)));
typedef float f32x4 __attribute__((ext_vector_type(4)));
typedef float f32x2 __attribute__((ext_vector_type(2)));
typedef float f32x16 __attribute__((ext_vector_type(16)));
typedef unsigned u32x4 __attribute__((ext_vector_type(4)));
typedef unsigned u32x2 __attribute__((ext_vector_type(2)));

constexpr int D = 1024, BATCH = 16, SEQ = 2048, M = BATCH * SEQ, DEPTH = 4;
constexpr int NH = 16, HD = 64, RK = 256, IH = 8, IDIM = 64, TOPK = 256;
constexpr int KVH = 2, GQ = 8, WIN = 128, NBUCK = 32, DFF = 2816;
constexpr int A_IN = 1864, B_IN = 1280;
constexpr float EPS = 1e-6f;
constexpr float NEGF = -1e30f;
constexpr int NWAVES = 8, NTHR = 512;

constexpr size_t MiB = 1u << 20;
constexpr size_t WS_CTL = 0, CTL_ZERO_BYTES = 4 * MiB;
constexpr size_t WS_SS = 1 * MiB;
constexpr size_t WS_W = 4 * MiB;
constexpr size_t W_LAYER = 17301504;
constexpr size_t W13_OFF = 0, W2_OFF = 11 * MiB;
constexpr size_t WS_WA = WS_W + 4 * W_LAYER;
constexpr size_t WA_STRIDE = 10 * MiB, WINA_OFF = 0, WQA_OFF = 4 * MiB, WUV_OFF = 6 * MiB, WOUTA_OFF = 8 * MiB;
constexpr size_t WS_WB = WS_WA + 2 * WA_STRIDE;
constexpr size_t WB_STRIDE = 4718592, WINB_OFF = 0, WOUTB_OFF = 2621440;
constexpr size_t WS_MOD = 100 * MiB;
constexpr size_t WS_SHW = WS_MOD + 1536 * 1024;
constexpr size_t SHW_A = 0, SHW_B = 2 * 16 * 2048 * 4, SHW_F = SHW_B + 2 * 16 * 1280 * 4;
constexpr size_t WS_XG = 104 * MiB;
constexpr size_t WS_BIG = 104 * MiB;
constexpr size_t WS_HFF = 168 * MiB;
constexpr size_t WS_QO = 360 * MiB;
constexpr size_t WS_CKV = 424 * MiB;
constexpr size_t WS_QI = 440 * MiB;
constexpr size_t WS_KIN = 472 * MiB;
constexpr size_t WS_WI = 476 * MiB;
constexpr size_t WS_SEL = 477 * MiB;
constexpr size_t WS_RKV = 485 * MiB;
constexpr size_t WS_QKV = 360 * MiB;
constexpr size_t WS_OB = 440 * MiB;
constexpr size_t WS_END = 512 * MiB;

constexpr int RING_BYTES = 131072;
constexpr int LDS_MISC_OFF = 155648;
constexpr int LDS_BYTES = 156672;

#define RLX_AGENT __ATOMIC_RELAXED, __HIP_MEMORY_SCOPE_AGENT
__device__ __forceinline__ unsigned cvt_pk_bf16(float lo, float hi) { unsigned r; asm volatile("v_cvt_pk_bf16_f32 %0, %1, %2" : "=v"(r) : "v"(lo), "v"(hi)); return r; }
__device__ __forceinline__ float bf2f(bf16_t b) { return __uint_as_float(((unsigned)b) << 16); }
__device__ __forceinline__ float wave_sum(float v) {
#pragma unroll
    for (int o = 1; o < 64; o <<= 1) v += __shfl_xor(v, o);
    return v;
}
__device__ __forceinline__ float fast_exp(float x) { return __builtin_amdgcn_exp2f(x * 1.4426950408889634f); }
__device__ __forceinline__ float silu_f(float x) { return x * __builtin_amdgcn_rcpf(1.0f + fast_exp(-x)); }
__device__ __forceinline__ int t5_bucket(int d) {
    if (d < 16) return d;
    int b = 16;
    b += (d >= 19); b += (d >= 21); b += (d >= 24); b += (d >= 27); b += (d >= 31); b += (d >= 35); b += (d >= 40); b += (d >= 46);
    b += (d >= 52); b += (d >= 59); b += (d >= 67); b += (d >= 77); b += (d >= 87); b += (d >= 99); b += (d >= 113);
    return b;
}

#define XB_TMO      128
#define XB_XCNT(j)  (256  + 64 * (j))
#define XB_XSUB(j)  (1280 + 64 * (j))
#define XB_XGEN(j)  (2304 + 64 * (j))
#define XB_TOP      3328
#define XB_TOPGEN   3392
#define XCD_BAR_WORDS 3456
#define XB_SPIN_CAP (1u << 22)

__device__ __forceinline__ unsigned xb_ld(unsigned* p)              { return __hip_atomic_load(p, __ATOMIC_RELAXED, __HIP_MEMORY_SCOPE_AGENT); }
__device__ __forceinline__ unsigned xb_add(unsigned* p, unsigned v) { return __hip_atomic_fetch_add(p, v, __ATOMIC_RELAXED, __HIP_MEMORY_SCOPE_AGENT); }
__device__ __forceinline__ unsigned xb_xcc_id() { return (unsigned)__builtin_amdgcn_s_getreg((3 << 11) | 20) & 0xFu; }
#define XB_SPIN(cond, bar) do { unsigned _sp = 0; while (cond) { __builtin_amdgcn_s_sleep(1); \
    if ((++_sp & 255u) == 0u) { if (xb_ld(&(bar)[XB_TMO])) break; if (_sp > XB_SPIN_CAP) { atomicAdd(&(bar)[XB_TMO], 1u); break; } } } } while (0)

struct XcdBarrier { unsigned* bar; unsigned x; volatile LAS unsigned* st; };

__device__ __forceinline__ XcdBarrier xcd_barrier_post(unsigned* bar, volatile LAS unsigned* st) {
    XcdBarrier b; b.bar = bar; b.x = xb_xcc_id(); b.st = st;
    if (threadIdx.x == 0) (void)xb_add(&bar[XB_XCNT(b.x)], 1u);
    return b;
}
__device__ __forceinline__ void xcd_barrier_complete(unsigned* bar, unsigned x, unsigned& nloc, unsigned& nx) {
    const unsigned G = gridDim.x * gridDim.y * gridDim.z;
    unsigned sum, cnt, mine, sp = 0u;
    for (;;) {
        sum = 0u; cnt = 0u; mine = 0u;
#pragma unroll
        for (unsigned j = 0; j < 16; ++j) { const unsigned c = xb_ld(&bar[XB_XCNT(j)]); sum += c; cnt += (c > 0u) ? 1u : 0u; mine = (j == x) ? c : mine; }
        if (sum == G) break;
        __builtin_amdgcn_s_sleep(1);
        if ((++sp & 255u) == 0u) { if (xb_ld(&bar[XB_TMO])) break; if (sp > XB_SPIN_CAP) { atomicAdd(&bar[XB_TMO], 1u); break; } }
    }
    nloc = mine > 0u ? mine : 1u; nx = cnt > 0u ? cnt : 1u;
}
__device__ __forceinline__ void xcd_barrier(const XcdBarrier& b) {
    asm volatile("s_waitcnt vmcnt(0)" ::: "memory");
    __syncthreads();
    if (threadIdx.x == 0) {
        unsigned* bar = b.bar;
        __builtin_amdgcn_s_waitcnt(0);
        unsigned nloc = b.st[0], nx = b.st[1];
        if (nloc == 0u) { xcd_barrier_complete(bar, b.x, nloc, nx); b.st[0] = nloc; b.st[1] = nx; }
        const unsigned old = xb_add(&bar[XB_XSUB(b.x)], 1u);
        const unsigned gen = old / nloc;
        if (old + 1u == (gen + 1u) * nloc) {
            __builtin_amdgcn_fence(__ATOMIC_RELEASE, "agent");
            asm volatile("s_waitcnt vmcnt(0)" ::: "memory");
            const unsigned og = xb_add(&bar[XB_TOP], 1u);
            const unsigned tg = og / nx;
            if (og + 1u == (tg + 1u) * nx) xb_add(&bar[XB_TOPGEN], 1u);
            else XB_SPIN(xb_ld(&bar[XB_TOPGEN]) == tg, bar);
            __builtin_amdgcn_fence(__ATOMIC_ACQUIRE, "agent");
            xb_add(&bar[XB_XGEN(b.x)], 1u);
            asm volatile("s_waitcnt vmcnt(0)" ::: "memory");
        } else {
            XB_SPIN(xb_ld(&bar[XB_XGEN(b.x)]) == gen, bar);
            __builtin_amdgcn_fence(__ATOMIC_ACQUIRE, "agent");
            asm volatile("s_waitcnt vmcnt(0)" ::: "memory");
        }
    }
    __syncthreads();
}

namespace pg8 {
constexpr int BM = 256, BK = 64, HALF = 128, HTB = HALF * BK * 2, STAGE_BYTES = 8 * HTB, NXCD = 8, WGM = 8;
__host__ __device__ __forceinline__ int lds_byte(int r, int c) { const int st = (r >> 4) * 2 + (c >> 5), rr = r & 15, cc = c & 31, ob = rr * 64 + cc * 2; return st * 1024 + (ob ^ (((ob >> 9) & 1) << 5)); }
__host__ __device__ __forceinline__ void stage_rc(int b, int& R, int& C) { const int st = b / 1024, sb = b % 1024, swz = sb ^ (((sb >> 9) & 1) << 5); R = (st >> 1) * 16 + swz / 64; C = (st & 1) * 32 + (swz % 64) / 2; }
__host__ __device__ __forceinline__ int perm32(int rho) { const int n = rho >> 4, i = rho & 15; return 8 * (i >> 2) + 4 * n + (i & 3); }

struct Unit { int pm, pn; };
struct Gemm { const bf16_t* A; const bf16_t* Bt; int lda, ldb, K, a_shift, a_mul; };

struct StaticOrder {
    int nM, nN, nwg, G, c;
    __device__ void init(int M_, int N_, int G_, int c_) { nM = M_ / BM; nN = N_ / BM; nwg = nM * nN; G = G_; c = c_; }
    __device__ bool next(int i, Unit& u) const {
        const long L = (long)i * G + c; if (L >= nwg) return false;
        int wgid = (int)L; { const int q = nwg / NXCD, r = nwg % NXCD, xcd = wgid % NXCD, off = wgid / NXCD; wgid = (xcd < r ? xcd * (q + 1) : r * (q + 1) + (xcd - r) * q) + off; }
        const int nig = WGM * nN, gid = wgid / nig, fm = gid * WGM, gsz = (nM - fm) < WGM ? (nM - fm) : WGM;
        u.pm = fm + ((wgid % nig) % gsz); u.pn = (wgid % nig) / gsz; return true;
    }
};

template <class Epi, bool ALIGN_EPI>
__device__ __forceinline__ void gemm_phase(LAS unsigned char* lds, const Gemm g, const StaticOrder& S, const Epi& E) {
    int tid = threadIdx.x; asm volatile("" : "+v"(tid));
    const int wid = __builtin_amdgcn_readfirstlane(tid >> 6), lane = tid & 63, wr = wid >> 2, wc = wid & 3, fr = lane & 15, fq = lane >> 4;
    const int K = g.K, nt = K / BK;
    unsigned voffA[2], voffB[2];
#pragma unroll
    for (int i = 0; i < 2; ++i) { int R, C; stage_rc(tid * 16 + i * 8192, R, C); const int Rb = Epi::PERM ? ((R & ~31) + perm32(R & 31)) : R;
        voffA[i] = (unsigned)(R * g.lda + C) * 2u; voffB[i] = (unsigned)(Rb * g.ldb + C) * 2u; }
    const size_t kstep = (size_t)(BK * 2);
    const size_t hstepA = (size_t)HALF * g.lda * 2, hstepB = (size_t)HALF * g.ldb * 2;
    const unsigned ldsw = (unsigned)wid * 1024u;
    const int aoff = lds_byte(wr * 64 + fr, fq * 8), boff = lds_byte(wc * 32 + fr, fq * 8);
#define PG8_SA(b, h) (((b) * 2 + (h)) * HTB)
#define PG8_SB(b, h) ((4 + (b) * 2 + (h)) * HTB)
#define PG8_STAGE(bufoff, gbase, voff) do { _Pragma("unroll") for (int _i = 0; _i < 2; ++_i) \
        __builtin_amdgcn_global_load_lds((const unsigned*)((const char*)(gbase) + (voff)[_i]), (LAS unsigned*)(lds + (bufoff) + ldsw + _i * 8192), 16, 0, 0); } while (0)
#define PG8_LDA(dst, b, h) do { _Pragma("unroll") for (int m = 0; m < 4; ++m) _Pragma("unroll") for (int k = 0; k < 2; ++k) dst[m][k] = *(const LAS bf16x8*)(lds + PG8_SA(b, h) + aoff + m * 2048 + k * 1024); } while (0)
#define PG8_LDB(dst, b, h) do { _Pragma("unroll") for (int n = 0; n < 2; ++n) _Pragma("unroll") for (int k = 0; k < 2; ++k) dst[n][k] = *(const LAS bf16x8*)(lds + PG8_SB(b, h) + boff + n * 2048 + k * 1024); } while (0)
#define PG8_MMA(ai, bj, At, Bt) do { __builtin_amdgcn_s_setprio(1); _Pragma("unroll") for (int m = 0; m < 4; ++m) _Pragma("unroll") for (int n = 0; n < 2; ++n) _Pragma("unroll") for (int k = 0; k < 2; ++k) \
        acc[ai][bj][m][n] = __builtin_amdgcn_mfma_f32_16x16x32_bf16(Bt[n][k], At[m][k], acc[ai][bj][m][n], 0, 0, 0); __builtin_amdgcn_s_setprio(0); } while (0)
#define PG8_WAIT_V(n) asm volatile("s_waitcnt vmcnt(" #n ")" ::: "memory")
#define PG8_WAIT_L(n) asm volatile("s_waitcnt lgkmcnt(" #n ")" ::: "memory")
#define PG8_BAR __builtin_amdgcn_s_barrier()
#define PG8_SCHED __builtin_amdgcn_sched_barrier(0)
#define PG8_ABASE(u) ((const char*)g.A + ((size_t)(u).pm * BM * g.lda + (size_t)((u).pn >> g.a_shift) * g.a_mul) * 2)
#define PG8_BBASE(u) ((const char*)g.Bt + (size_t)(u).pn * BM * g.ldb * 2)
    Unit cur, nxt; int ui = 0;
    if (!S.next(0, cur)) return;
    f32x4 acc[2][2][4][2];
#pragma unroll
    for (int a = 0; a < 2; ++a)
#pragma unroll
        for (int b = 0; b < 2; ++b)
#pragma unroll
            for (int m = 0; m < 4; ++m)
#pragma unroll
                for (int n = 0; n < 2; ++n) acc[a][b][m][n] = (f32x4){0.f, 0.f, 0.f, 0.f};
    bf16x8 At[4][2], B0[2][2], B1[2][2];
    const char* cA = PG8_ABASE(cur); const char* cB = PG8_BBASE(cur);
    PG8_STAGE(PG8_SB(0, 0), cB, voffB); PG8_STAGE(PG8_SB(0, 1), cB + hstepB, voffB); PG8_STAGE(PG8_SA(0, 0), cA, voffA); PG8_STAGE(PG8_SA(0, 1), cA + hstepA, voffA);
    if (wr == 1) PG8_BAR;
    PG8_WAIT_V(2); PG8_BAR;
    PG8_STAGE(PG8_SB(1, 0), cB + kstep, voffB); PG8_STAGE(PG8_SA(1, 0), cA + kstep, voffA); PG8_STAGE(PG8_SB(1, 1), cB + hstepB + kstep, voffB);
    PG8_WAIT_V(6); PG8_BAR;
    for (;;) {
        const bool has_next = S.next(ui + 1, nxt);
        const char* nA = has_next ? PG8_ABASE(nxt) : cA; const char* nB = has_next ? PG8_BBASE(nxt) : cB;
        for (int t = 0; t < nt; t += 2) {
            const bool last = (t == nt - 2);
            const char* a1 = cA + (size_t)(t + 1) * kstep;
            const char* a2 = last ? nA : cA + (size_t)(t + 2) * kstep; const char* b2 = last ? nB : cB + (size_t)(t + 2) * kstep;
            const char* a3 = a2 + kstep; const char* b3 = b2 + kstep;
            PG8_LDB(B0, 0, 0); PG8_LDB(B1, 0, 1); PG8_SCHED; PG8_LDA(At, 0, 0); PG8_STAGE(PG8_SA(1, 1), a1 + hstepA, voffA);
            PG8_WAIT_V(8); PG8_WAIT_L(0); PG8_BAR; PG8_MMA(0, 0, At, B0); PG8_MMA(0, 1, At, B1); PG8_BAR; PG8_SCHED;
            PG8_LDA(At, 0, 1); PG8_STAGE(PG8_SB(0, 0), b2, voffB); PG8_STAGE(PG8_SB(0, 1), b2 + hstepB, voffB); PG8_STAGE(PG8_SA(0, 0), a2, voffA);
            PG8_WAIT_V(8); PG8_WAIT_L(0); PG8_BAR; PG8_MMA(1, 0, At, B0); PG8_MMA(1, 1, At, B1); PG8_BAR; PG8_SCHED;
            PG8_LDB(B0, 1, 0); PG8_LDB(B1, 1, 1); PG8_SCHED; PG8_LDA(At, 1, 0); PG8_STAGE(PG8_SA(0, 1), a2 + hstepA, voffA);
            PG8_WAIT_V(8); PG8_WAIT_L(0); PG8_BAR; PG8_MMA(0, 0, At, B0); PG8_MMA(0, 1, At, B1); PG8_BAR; PG8_SCHED;
            PG8_LDA(At, 1, 1); PG8_STAGE(PG8_SB(1, 0), b3, voffB); PG8_STAGE(PG8_SB(1, 1), b3 + hstepB, voffB); PG8_STAGE(PG8_SA(1, 0), a3, voffA);
            PG8_WAIT_V(8); PG8_WAIT_L(0); PG8_BAR; PG8_MMA(1, 0, At, B0); PG8_MMA(1, 1, At, B1); PG8_BAR; PG8_SCHED;
        }
        if constexpr (ALIGN_EPI) { if (wr == 0) PG8_BAR; }
        E(acc, cur, wr, wc, fr, fq);
        if (!has_next) break;
#pragma unroll
        for (int a = 0; a < 2; ++a)
#pragma unroll
            for (int b = 0; b < 2; ++b)
#pragma unroll
                for (int m = 0; m < 4; ++m)
#pragma unroll
                    for (int n = 0; n < 2; ++n) acc[a][b][m][n] = (f32x4){0.f, 0.f, 0.f, 0.f};
        cur = nxt; cA = nA; cB = nB; ++ui;
        if constexpr (ALIGN_EPI) { if (wr == 1) PG8_BAR; }
    }
    PG8_WAIT_V(0);
    if constexpr (!ALIGN_EPI) { if (wr == 0) PG8_BAR; }
    PG8_BAR;
#undef PG8_SA
#undef PG8_SB
#undef PG8_STAGE
#undef PG8_LDA
#undef PG8_LDB
#undef PG8_MMA
#undef PG8_WAIT_V
#undef PG8_WAIT_L
#undef PG8_BAR
#undef PG8_SCHED
#undef PG8_ABASE
#undef PG8_BBASE
}

template <bool NORM> struct EpiBf16Plain {
    static constexpr bool PERM = true;
    bf16_t* O; int ldc; const float* shw; int shw_stride; const unsigned long long* SS;
    __device__ __forceinline__ void operator()(const f32x4 (&acc)[2][2][4][2], const Unit& u, int wr, int wc, int fr, int fq) const {
        const int row0 = u.pm * BM + wr * 64 + fr, col0 = u.pn * BM + wc * 32 + 8 * fq;
        f32x4 bv[2][2];
#pragma unroll
        for (int bj = 0; bj < 2; ++bj)
#pragma unroll
            for (int n = 0; n < 2; ++n) bv[bj][n] = NORM ? *(const f32x4*)(shw + (size_t)(u.pm >> 3) * shw_stride + col0 + bj * HALF + 4 * n) : (f32x4){0.f, 0.f, 0.f, 0.f};
#pragma unroll
        for (int ai = 0; ai < 2; ++ai)
#pragma unroll
            for (int m = 0; m < 4; ++m) { const int row = row0 + ai * HALF + m * 16; bf16_t* rowp = O + (size_t)row * ldc + col0;
                float rs = 1.0f; if (NORM) rs = 1.0f / sqrtf((float)SS[row] * (1.0f / (16777216.0f * D)) + EPS);
#pragma unroll
                for (int bj = 0; bj < 2; ++bj) { const f32x4 v0 = acc[ai][bj][m][0] * rs + bv[bj][0], v1 = acc[ai][bj][m][1] * rs + bv[bj][1];
                    u32x4 w; w.x = cvt_pk_bf16(v0[0], v0[1]); w.y = cvt_pk_bf16(v0[2], v0[3]); w.z = cvt_pk_bf16(v1[0], v1[1]); w.w = cvt_pk_bf16(v1[2], v1[3]);
                    *(u32x4*)(rowp + bj * HALF) = w; } }
    }
};
struct EpiInA {
    static constexpr bool PERM = true;
    bf16_t* Q; bf16_t* CKV; bf16_t* QI; bf16_t* KIN; float* WI; const float* kg; const float* kb; const float* shw; const unsigned long long* SS;
    __device__ __forceinline__ void operator()(f32x4 (&acc)[2][2][4][2], const Unit& u, int wr, int wc, int fr, int fq) const {
        const int row0 = u.pm * BM + wr * 64 + fr, cl = wc * 32 + 8 * fq;
        {
            const float* sp = shw + (size_t)(u.pm >> 3) * 2048 + u.pn * BM + cl;
            f32x4 bv[2][2];
#pragma unroll
            for (int bj = 0; bj < 2; ++bj)
#pragma unroll
                for (int n = 0; n < 2; ++n) bv[bj][n] = *(const f32x4*)(sp + bj * HALF + 4 * n);
#pragma unroll
            for (int ai = 0; ai < 2; ++ai)
#pragma unroll
                for (int m = 0; m < 4; ++m) { const float rs = 1.0f / sqrtf((float)SS[row0 + ai * HALF + m * 16] * (1.0f / (16777216.0f * D)) + EPS);
#pragma unroll
                    for (int bj = 0; bj < 2; ++bj)
#pragma unroll
                        for (int n = 0; n < 2; ++n) acc[ai][bj][m][n] = acc[ai][bj][m][n] * rs + bv[bj][n]; }
        }
        if (u.pn < 7) {
            bf16_t* base; int ldc, c0;
            if (u.pn < 4) { base = Q; ldc = 1024; c0 = u.pn * 256; } else if (u.pn == 4) { base = CKV; ldc = 256; c0 = 0; } else { base = QI; ldc = 512; c0 = (u.pn - 5) * 256; }
#pragma unroll
            for (int ai = 0; ai < 2; ++ai)
#pragma unroll
                for (int m = 0; m < 4; ++m) { bf16_t* rowp = base + (size_t)(row0 + ai * HALF + m * 16) * ldc + c0 + cl;
#pragma unroll
                    for (int bj = 0; bj < 2; ++bj) { const f32x4 v0 = acc[ai][bj][m][0], v1 = acc[ai][bj][m][1];
                        u32x4 w; w.x = cvt_pk_bf16(v0[0], v0[1]); w.y = cvt_pk_bf16(v0[2], v0[3]); w.z = cvt_pk_bf16(v1[0], v1[1]); w.w = cvt_pk_bf16(v1[2], v1[3]);
                        *(u32x4*)(rowp + bj * HALF) = w; } }
        } else if (wc == 0) {
            f32x4 gv[2][2], bv[2][2];
#pragma unroll
            for (int bj = 0; bj < 2; ++bj)
#pragma unroll
                for (int n = 0; n < 2; ++n) { gv[bj][n] = *(const f32x4*)(kg + 32 * bj + 8 * fq + 4 * n); bv[bj][n] = *(const f32x4*)(kb + 32 * bj + 8 * fq + 4 * n); }
#pragma unroll
            for (int ai = 0; ai < 2; ++ai)
#pragma unroll
                for (int m = 0; m < 4; ++m) {
                    float s = 0.f;
#pragma unroll
                    for (int bj = 0; bj < 2; ++bj)
#pragma unroll
                        for (int n = 0; n < 2; ++n) { const f32x4 x = acc[ai][bj][m][n]; s += (x[0] + x[1]) + (x[2] + x[3]); }
                    s += __shfl_xor(s, 16); s += __shfl_xor(s, 32);
                    const float mu = s * (1.0f / 64.0f); float q = 0.f;
#pragma unroll
                    for (int bj = 0; bj < 2; ++bj)
#pragma unroll
                        for (int n = 0; n < 2; ++n) { const f32x4 d = acc[ai][bj][m][n] - mu; q += (d[0] * d[0] + d[1] * d[1]) + (d[2] * d[2] + d[3] * d[3]); }
                    q += __shfl_xor(q, 16); q += __shfl_xor(q, 32);
                    const float rs = 1.0f / sqrtf(q * (1.0f / 64.0f) + EPS);
                    bf16_t* rowp = KIN + (size_t)(row0 + ai * HALF + m * 16) * 64 + 8 * fq;
#pragma unroll
                    for (int bj = 0; bj < 2; ++bj) { const f32x4 v0 = (acc[ai][bj][m][0] - mu) * rs * gv[bj][0] + bv[bj][0], v1 = (acc[ai][bj][m][1] - mu) * rs * gv[bj][1] + bv[bj][1];
                        u32x4 w; w.x = cvt_pk_bf16(v0[0], v0[1]); w.y = cvt_pk_bf16(v0[2], v0[3]); w.z = cvt_pk_bf16(v1[0], v1[1]); w.w = cvt_pk_bf16(v1[2], v1[3]);
                        *(u32x4*)(rowp + bj * 32) = w; }
                }
        } else if (wc == 1 && fq == 0) {
            const float sc = 0.04419417382415922f;
#pragma unroll
            for (int ai = 0; ai < 2; ++ai)
#pragma unroll
                for (int m = 0; m < 4; ++m) { float* rowp = WI + (size_t)(row0 + ai * HALF + m * 16) * 8;
                    *(f32x4*)(rowp) = acc[ai][0][m][0] * sc; *(f32x4*)(rowp + 4) = acc[ai][0][m][1] * sc; }
        }
    }
};
struct EpiResid {
    static constexpr bool PERM = true;
    const float* xin; float* xout; const float* gate; const float* bias;
    bf16_t* XG; const float* gn; const float* scn; unsigned long long* SSo;
    __device__ __forceinline__ void operator()(const f32x4 (&acc)[2][2][4][2], const Unit& u, int wr, int wc, int fr, int fq) const {
        const int row0 = u.pm * BM + wr * 64 + fr, col0 = u.pn * BM + wc * 32 + 8 * fq, b = u.pm >> 3;
        float ssum[2][4];
#pragma unroll
        for (int ai = 0; ai < 2; ++ai)
#pragma unroll
            for (int m = 0; m < 4; ++m) ssum[ai][m] = 0.f;
#pragma unroll
        for (int bj = 0; bj < 2; ++bj) {
            const int c = col0 + bj * HALF;
            const f32x4 gv0 = *(const f32x4*)(gate + (size_t)b * 6144 + c), gv1 = *(const f32x4*)(gate + (size_t)b * 6144 + c + 4);
            f32x4 bv0 = (f32x4){0.f, 0.f, 0.f, 0.f}, bv1 = bv0, gm0 = bv0, gm1 = bv0;
            if (bias) { bv0 = *(const f32x4*)(bias + c); bv1 = *(const f32x4*)(bias + c + 4); }
            if (XG) { gm0 = *(const f32x4*)(gn + c) * (*(const f32x4*)(scn + (size_t)b * 6144 + c) + 1.0f); gm1 = *(const f32x4*)(gn + c + 4) * (*(const f32x4*)(scn + (size_t)b * 6144 + c + 4) + 1.0f); }
#pragma unroll
            for (int ai = 0; ai < 2; ++ai)
#pragma unroll
                for (int m = 0; m < 4; ++m) { const size_t off = (size_t)(row0 + ai * HALF + m * 16) * D + c;
                    const f32x4 xi0 = *(const f32x4*)(xin + off), xi1 = *(const f32x4*)(xin + off + 4);
                    const f32x4 xo0 = xi0 + gv0 * (acc[ai][bj][m][0] + bv0), xo1 = xi1 + gv1 * (acc[ai][bj][m][1] + bv1);
                    *(f32x4*)(xout + off) = xo0; *(f32x4*)(xout + off + 4) = xo1;
                    if (XG) {
                        ssum[ai][m] += ((xo0[0] * xo0[0] + xo0[1] * xo0[1]) + (xo0[2] * xo0[2] + xo0[3] * xo0[3])) + ((xo1[0] * xo1[0] + xo1[1] * xo1[1]) + (xo1[2] * xo1[2] + xo1[3] * xo1[3]));
                        const f32x4 y0 = xo0 * gm0, y1 = xo1 * gm1;
                        u32x4 w; w.x = cvt_pk_bf16(y0[0], y0[1]); w.y = cvt_pk_bf16(y0[2], y0[3]); w.z = cvt_pk_bf16(y1[0], y1[1]); w.w = cvt_pk_bf16(y1[2], y1[3]);
                        *(u32x4*)(XG + off) = w; }
                    if (m & 1) asm volatile("" ::: "memory"); }
        }
        if (XG) {
#pragma unroll
            for (int ai = 0; ai < 2; ++ai)
#pragma unroll
                for (int m = 0; m < 4; ++m) { float q = ssum[ai][m]; q += __shfl_xor(q, 16); q += __shfl_xor(q, 32);
                    if (fq == 0) atomicAdd(SSo + row0 + ai * HALF + m * 16, (unsigned long long)(q * 16777216.0f)); }
        }
    }
};
struct EpiSwiGLU {
    static constexpr bool PERM = true;
    bf16_t* H; const float* shw; const unsigned long long* SS;
    __device__ __forceinline__ void operator()(const f32x4 (&acc)[2][2][4][2], const Unit& u, int wr, int wc, int fr, int fq) const {
        const int row0 = u.pm * BM + wr * 64 + fr, f0 = u.pn * 128 + wc * 32 + 8 * fq;
        f32x4 bv[2][2];
        { const float* sp = shw + (size_t)(u.pm >> 3) * (2 * DFF) + u.pn * BM + wc * 32 + 8 * fq;
#pragma unroll
          for (int bj = 0; bj < 2; ++bj)
#pragma unroll
              for (int n = 0; n < 2; ++n) bv[bj][n] = *(const f32x4*)(sp + bj * HALF + 4 * n); }
#pragma unroll
        for (int ai = 0; ai < 2; ++ai)
#pragma unroll
            for (int m = 0; m < 4; ++m) { bf16_t* rowp = H + (size_t)(row0 + ai * HALF + m * 16) * DFF + f0;
                const float rs = 1.0f / sqrtf((float)SS[row0 + ai * HALF + m * 16] * (1.0f / (16777216.0f * D)) + EPS);
                float o[8];
#pragma unroll
                for (int n = 0; n < 2; ++n)
#pragma unroll
                    for (int e = 0; e < 4; ++e) o[4 * n + e] = silu_f(acc[ai][0][m][n][e] * rs + bv[0][n][e]) * (acc[ai][1][m][n][e] * rs + bv[1][n][e]);
                u32x4 w; w.x = cvt_pk_bf16(o[0], o[1]); w.y = cvt_pk_bf16(o[2], o[3]); w.z = cvt_pk_bf16(o[4], o[5]); w.w = cvt_pk_bf16(o[6], o[7]);
                *(u32x4*)(rowp) = w; }
    }
};
}

struct Ptrs {
    const float* in[23]; float* out; unsigned char* ws;
};
enum { I_X = 0, I_C, I_RELB, I_WADA, I_BADA, I_GMIX, I_GFFN, I_AWIN, I_AKVG, I_AWUK, I_AWUV, I_AIKG, I_AIKB, I_AWOUT, I_BWIN, I_BBIN, I_BSINK, I_BWOUT, I_BBOUT, I_W1, I_W3, I_W2, I_GFIN };

__device__ __forceinline__ void conv_task(const Ptrs& P, int t, int lane) {
    int kind, rb, ks, Kd; bf16_t* dst; const float* s0 = nullptr; const float* s1 = nullptr; const float* gk = nullptr; int ld = 0;
    if (t < 2112) { const int l = t / 528, r = t % 528; unsigned char* wl = P.ws + WS_W + (size_t)l * W_LAYER;
        if (r < 352) { kind = 1; rb = r >> 2; ks = r & 3; Kd = 1024; dst = (bf16_t*)(wl + W13_OFF); s0 = P.in[I_W1] + (size_t)l * D * DFF; s1 = P.in[I_W3] + (size_t)l * D * DFF; ld = DFF; }
        else { const int r2 = r - 352; kind = 0; rb = r2 / 11; ks = r2 % 11; Kd = DFF; dst = (bf16_t*)(wl + W2_OFF); s0 = P.in[I_W2] + (size_t)l * DFF * D; ld = D; }
    } else { const int t2 = t - 2112, j = t2 / 464, r = t2 % 464; unsigned char* wa = P.ws + WS_WA + (size_t)j * WA_STRIDE; unsigned char* wb = P.ws + WS_WB + (size_t)j * WB_STRIDE;
        if (r < 128) { kind = 2; rb = r >> 2; ks = r & 3; Kd = 1024; dst = (bf16_t*)(wa + WINA_OFF); s0 = P.in[I_AWIN] + (size_t)j * D * A_IN; ld = A_IN; }
        else if (r < 192) { kind = 3; rb = r - 128; ks = 0; Kd = 256; dst = (bf16_t*)(wa + WQA_OFF); s0 = P.in[I_AWUK] + (size_t)j * NH * RK * HD; gk = P.in[I_AKVG] + j * RK; }
        else if (r < 256) { const int r2 = r - 192; kind = 4; rb = r2 >> 2; ks = r2 & 3; Kd = 1024; dst = (bf16_t*)(wa + WUV_OFF); s0 = P.in[I_AWUV] + (size_t)j * NH * RK * HD; gk = P.in[I_AKVG] + j * RK; }
        else if (r < 320) { const int r2 = r - 256; kind = 0; rb = r2 >> 2; ks = r2 & 3; Kd = 1024; dst = (bf16_t*)(wa + WOUTA_OFF); s0 = P.in[I_AWOUT] + (size_t)j * D * D; ld = D; }
        else if (r < 400) { const int r2 = r - 320; kind = 0; rb = r2 >> 2; ks = r2 & 3; Kd = 1024; dst = (bf16_t*)(wb + WINB_OFF); s0 = P.in[I_BWIN] + (size_t)j * D * B_IN; ld = B_IN; }
        else { const int r2 = r - 400; kind = 0; rb = r2 >> 2; ks = r2 & 3; Kd = 1024; dst = (bf16_t*)(wb + WOUTB_OFF); s0 = P.in[I_BWOUT] + (size_t)j * D * D; ld = D; }
    }
    const int n = rb * 64 + lane, k0 = ks * 256;
    bf16_t* drow = dst + (size_t)n * Kd + k0;
    if (kind <= 2) {
        const float* src = s0; int col = n;
        if (kind == 1) { const int c = n & 255, f = (n >> 8) * 128 + (c & 127); src = (c < 128) ? s0 : s1; col = f; }
        if (kind == 2) { if (n >= 1792) { const int c = n - 1792; col = c < 32 ? 1792 + c : (c < 40 ? 1856 + (c - 32) : ((c >= 128 && c < 160) ? 1824 + (c - 128) : -1)); } }
        const float* sp = src + (size_t)k0 * ld + (col < 0 ? 0 : col);
        for (int kc = 0; kc < 32; ++kc) {
            float v[8];
#pragma unroll
            for (int e = 0; e < 8; ++e) v[e] = sp[(size_t)(kc * 8 + e) * ld];
            if (col < 0) {
#pragma unroll
                for (int e = 0; e < 8; ++e) v[e] = 0.f; }
            u32x4 w; w.x = cvt_pk_bf16(v[0], v[1]); w.y = cvt_pk_bf16(v[2], v[3]); w.z = cvt_pk_bf16(v[4], v[5]); w.w = cvt_pk_bf16(v[6], v[7]);
            *(u32x4*)(drow + kc * 8) = w;
        }
    } else if (kind == 3) {
        const int h = n >> 8, r = n & 255; const float gs = gk[r] * 0.125f; const float* sp = s0 + ((size_t)h * RK + r) * HD;
        for (int kc = 0; kc < 32; ++kc) { const int k = kc * 8; float v[8];
            if ((k >> 6) == (h & 3)) {
#pragma unroll
                for (int e = 0; e < 8; ++e) v[e] = sp[(k & 63) + e] * gs;
            } else {
#pragma unroll
                for (int e = 0; e < 8; ++e) v[e] = 0.f; }
            u32x4 w; w.x = cvt_pk_bf16(v[0], v[1]); w.y = cvt_pk_bf16(v[2], v[3]); w.z = cvt_pk_bf16(v[4], v[5]); w.w = cvt_pk_bf16(v[6], v[7]);
            *(u32x4*)(drow + kc * 8) = w; }
    } else {
        const int hh = (n >> 6) & 3, d = n & 63, h = n >> 6;
        for (int kc = 0; kc < 32; ++kc) { const int k = k0 + kc * 8; float v[8];
            if ((k >> 8) == hh) {
#pragma unroll
                for (int e = 0; e < 8; ++e) { const int r = (k & 255) + e; v[e] = s0[((size_t)h * RK + r) * HD + d] * gk[r]; }
            } else {
#pragma unroll
                for (int e = 0; e < 8; ++e) v[e] = 0.f; }
            u32x4 w; w.x = cvt_pk_bf16(v[0], v[1]); w.y = cvt_pk_bf16(v[2], v[3]); w.z = cvt_pk_bf16(v[4], v[5]); w.w = cvt_pk_bf16(v[6], v[7]);
            *(u32x4*)(drow + kc * 8) = w; }
    }
}
constexpr int N_CONV_TASKS = 3040;

__device__ __forceinline__ void p0_prologue(const Ptrs& P, LAS unsigned char* lds, int G) {
    int tid = threadIdx.x; asm volatile("" : "+v"(tid));
    const int lane = tid & 63, wave = __builtin_amdgcn_readfirstlane(tid >> 6);
    const int gw = blockIdx.x * NWAVES + wave, NGW = G * NWAVES;
    for (int t = gw; t < N_CONV_TASKS; t += NGW) conv_task(P, t, lane);
    LAS float* cs = (LAS float*)lds;
    LAS float* red = (LAS float*)(lds + 65536);
    for (int i = tid; i < BATCH * D; i += NTHR) { const int b = i >> 10, k = i & 1023; cs[k * 16 + b] = silu_f(P.in[I_C][i]); }
    __syncthreads();
    float* mod = (float*)(P.ws + WS_MOD);
    for (int task = blockIdx.x; task < 4 * 96; task += G) {
        const int l = task / 96, j0 = (task % 96) * 64, col = tid & 63, ksl = tid >> 6;
        const float* wp = P.in[I_WADA] + ((size_t)l * D + ksl * 128) * 6144 + j0 + col;
        float a[16];
#pragma unroll
        for (int b = 0; b < 16; ++b) a[b] = 0.f;
        for (int k = 0; k < 128; ++k) { const float w = wp[(size_t)k * 6144]; const LAS f32x4* c4 = (const LAS f32x4*)(cs + (ksl * 128 + k) * 16);
#pragma unroll
            for (int q = 0; q < 4; ++q) { const f32x4 c = c4[q];
#pragma unroll
                for (int e = 0; e < 4; ++e) a[4 * q + e] += w * c[e]; } }
#pragma unroll
        for (int b = 0; b < 16; ++b) red[(ksl * 64 + col) * 16 + b] = a[b];
        __syncthreads();
        for (int o = tid; o < 1024; o += NTHR) { const int c2 = o >> 4, b = o & 15; float s = 0.f;
#pragma unroll
            for (int q = 0; q < 8; ++q) s += red[(q * 64 + c2) * 16 + b];
            mod[((size_t)l * BATCH + b) * 6144 + j0 + c2] = s + P.in[I_BADA][l * 6144 + j0 + c2]; }
        __syncthreads();
    }
}

__device__ __forceinline__ void pre_phase(const Ptrs& P, LAS unsigned char* lds, int G) {
    int tid = threadIdx.x; asm volatile("" : "+v"(tid));
    const int lane = tid & 63, wave = __builtin_amdgcn_readfirstlane(tid >> 6);
    const float* mod = (const float*)(P.ws + WS_MOD);
    {
        const int grp = blockIdx.x & 7, l = grp >> 1, kind = grp & 1, j = l >> 1;
        const float* shsrc = mod + (size_t)l * BATCH * 6144 + (kind ? 3072 : 0);
        constexpr int SP = 2064;
        for (int i = tid; i < BATCH * D / 2; i += NTHR) { const int b = i >> 9, k2 = (i & 511) * 2;
            const float a0 = shsrc[(size_t)b * 6144 + k2], a1 = shsrc[(size_t)b * 6144 + k2 + 1];
            *(LAS unsigned*)(lds + b * SP + k2 * 2) = cvt_pk_bf16(a0, a1); }
        __syncthreads();
        const bf16_t* W; int nrows; float* dst; const float* bias = nullptr;
        if (kind) { W = (const bf16_t*)(P.ws + WS_W + (size_t)l * W_LAYER + W13_OFF); nrows = 2 * DFF; dst = (float*)(P.ws + WS_SHW + SHW_F) + (size_t)l * BATCH * 2 * DFF; }
        else if ((l & 1) == 0) { W = (const bf16_t*)(P.ws + WS_WA + (size_t)j * WA_STRIDE + WINA_OFF); nrows = 2048; dst = (float*)(P.ws + WS_SHW + SHW_A) + (size_t)j * BATCH * 2048; }
        else { W = (const bf16_t*)(P.ws + WS_WB + (size_t)j * WB_STRIDE + WINB_OFF); nrows = B_IN; dst = (float*)(P.ws + WS_SHW + SHW_B) + (size_t)j * BATCH * B_IN; bias = P.in[I_BBIN] + j * B_IN; }
        const int nblk = nrows >> 4, wq = (blockIdx.x >> 3) * NWAVES + wave, nwq = (G >> 3) * NWAVES;
        const int nn = lane & 15, g = lane >> 4;
        for (int blk = wq; blk < nblk; blk += nwq) {
            f32x4 acc = (f32x4){0.f, 0.f, 0.f, 0.f};
            const bf16_t* wp = W + (size_t)(blk * 16 + nn) * D + 8 * g;
#pragma unroll 8
            for (int ks = 0; ks < 32; ++ks) { const bf16x8 a = *(const LAS bf16x8*)(lds + nn * SP + (32 * ks + 8 * g) * 2); const bf16x8 bw = *(const bf16x8*)(wp + 32 * ks);
                acc = __builtin_amdgcn_mfma_f32_16x16x32_bf16(a, bw, acc, 0, 0, 0); }
            const int n = blk * 16 + nn; const float bb = bias ? bias[n] : 0.f;
#pragma unroll
            for (int i = 0; i < 4; ++i) dst[(size_t)(4 * g + i) * nrows + n] = acc[i] + bb;
        }
    }
    {
        const int gw = blockIdx.x * NWAVES + wave, NGW = G * NWAVES;
        const float* x = P.in[I_X]; const float* gmix = P.in[I_GMIX]; bf16_t* XG = (bf16_t*)(P.ws + WS_XG); unsigned long long* SS0 = (unsigned long long*)(P.ws + WS_SS);
        for (int row = gw; row < M; row += NGW) {
            const int b = row >> 11;
            const f32x4* xr = (const f32x4*)(x + (size_t)row * D) + lane;
            f32x4 v[4]; float sq = 0.f;
#pragma unroll
            for (int jj = 0; jj < 4; ++jj) { v[jj] = xr[64 * jj]; sq += (v[jj][0] * v[jj][0] + v[jj][1] * v[jj][1]) + (v[jj][2] * v[jj][2] + v[jj][3] * v[jj][3]); }
            const float ss = wave_sum(sq);
            if (lane == 0) SS0[row] = (unsigned long long)(ss * 16777216.0f);
            const float* mb = mod + (size_t)b * 6144;
            u32x2* o8 = (u32x2*)(XG + (size_t)row * D) + lane;
#pragma unroll
            for (int jj = 0; jj < 4; ++jj) { const int c = 4 * lane + 256 * jj;
                const f32x4 y = v[jj] * *(const f32x4*)(gmix + c) * (*(const f32x4*)(mb + 1024 + c) + 1.0f);
                u32x2 w; w.x = cvt_pk_bf16(y[0], y[1]); w.y = cvt_pk_bf16(y[2], y[3]); o8[64 * jj] = w; }
        }
    }
}
__device__ __forceinline__ void final_norm_phase(float* x, const float* g, int G) {
    int tid = threadIdx.x; asm volatile("" : "+v"(tid));
    const int lane = tid & 63, wave = __builtin_amdgcn_readfirstlane(tid >> 6);
    const int gw = blockIdx.x * NWAVES + wave, NGW = G * NWAVES;
    for (int row = gw; row < M; row += NGW) {
        f32x4* xr = (f32x4*)(x + (size_t)row * D) + lane;
        f32x4 v[4]; float s = 0.f;
#pragma unroll
        for (int j = 0; j < 4; ++j) { v[j] = xr[64 * j]; s += (v[j][0] * v[j][0] + v[j][1] * v[j][1]) + (v[j][2] * v[j][2] + v[j][3] * v[j][3]); }
        const float rstd = 1.0f / sqrtf(wave_sum(s) * (1.0f / D) + EPS);
#pragma unroll
        for (int j = 0; j < 4; ++j) { const f32x4 gg = *(const f32x4*)(g + 4 * lane + 256 * j); xr[64 * j] = v[j] * rstd * gg; }
    }
}

__device__ __forceinline__ unsigned f2key(float f) { const unsigned u = __float_as_uint(f); return (u & 0x80000000u) ? ~u : (u | 0x80000000u); }
__device__ __forceinline__ float key2f(unsigned k) { return __uint_as_float((k & 0x80000000u) ? (k & 0x7fffffffu) : ~k); }
__device__ __forceinline__ float half_max(float x) {
    int u = __float_as_int(x);
    u = __float_as_int(fmaxf(__int_as_float(u), __int_as_float(__builtin_amdgcn_update_dpp(u, u, 0x128, 0xf, 0xf, false))));
    u = __float_as_int(fmaxf(__int_as_float(u), __int_as_float(__builtin_amdgcn_update_dpp(u, u, 0x124, 0xf, 0xf, false))));
    u = __float_as_int(fmaxf(__int_as_float(u), __int_as_float(__builtin_amdgcn_update_dpp(u, u, 0x122, 0xf, 0xf, false))));
    u = __float_as_int(fmaxf(__int_as_float(u), __int_as_float(__builtin_amdgcn_update_dpp(u, u, 0x121, 0xf, 0xf, false))));
    const u32x2 r = __builtin_amdgcn_permlane16_swap((unsigned)u, (unsigned)u, false, false);
    return fmaxf(__uint_as_float(r.x), __uint_as_float(r.y));
}
__device__ __forceinline__ int half_sum(int v) {
    v += __builtin_amdgcn_update_dpp(v, v, 0x128, 0xf, 0xf, false);
    v += __builtin_amdgcn_update_dpp(v, v, 0x124, 0xf, 0xf, false);
    v += __builtin_amdgcn_update_dpp(v, v, 0x122, 0xf, 0xf, false);
    v += __builtin_amdgcn_update_dpp(v, v, 0x121, 0xf, 0xf, false);
    const u32x2 r = __builtin_amdgcn_permlane16_swap((unsigned)v, (unsigned)v, false, false);
    return (int)(r.x + r.y);
}
__device__ __forceinline__ void idx_task(const bf16_t* QI, const bf16_t* KIN, const float* WI, unsigned* SEL, int b, int tg, int lane) {
    asm volatile("" : "+v"(lane));
    const int t0 = tg * 4, h = lane >> 5, r = lane & 31;
    const int qsel = 2 * (r >> 4) + ((r >> 2) & 1), hd = (r & 3) + 4 * ((r >> 3) & 1);
    const size_t rowb = (size_t)b * SEQ;
    bf16x8 aq[4];
#pragma unroll
    for (int ks = 0; ks < 4; ++ks) aq[ks] = *(const bf16x8*)(QI + (rowb + t0 + qsel) * 512 + hd * 64 + ks * 16 + h * 8);
    float wlo[8], whi[8];
    { const f32x4 a0 = *(const f32x4*)(WI + (rowb + t0 + h) * 8), a1 = *(const f32x4*)(WI + (rowb + t0 + h) * 8 + 4);
      const f32x4 b0 = *(const f32x4*)(WI + (rowb + t0 + 2 + h) * 8), b1 = *(const f32x4*)(WI + (rowb + t0 + 2 + h) * 8 + 4);
#pragma unroll
      for (int e = 0; e < 4; ++e) { wlo[e] = a0[e]; wlo[4 + e] = a1[e]; whi[e] = b0[e]; whi[4 + e] = b1[e]; } }
    float slo[64], shi[64];
#pragma unroll
    for (int kt = 0; kt < 64; ++kt) { slo[kt] = NEGF; shi[kt] = NEGF; }
    const int ktmax = (t0 + 3) >> 5, tlo = t0 + h, thi = t0 + 2 + h;
    const GAS bf16_t* kp = (const GAS bf16_t*)(KIN + (rowb + r) * 64 + h * 8);
#define IDX_LOAD4(R0, R1, R2, R3) asm volatile("global_load_dwordx4 %0, %4, off\n\tglobal_load_dwordx4 %1, %4, off offset:32\n\tglobal_load_dwordx4 %2, %4, off offset:64\n\tglobal_load_dwordx4 %3, %4, off offset:96" \
                                               : "=&v"(R0), "=&v"(R1), "=&v"(R2), "=&v"(R3) : "v"(kp) : "memory")
    bf16x8 ta0, ta1, ta2, ta3, tb0, tb1, tb2, tb3;
    IDX_LOAD4(ta0, ta1, ta2, ta3);
#define IDX_TILE(KT, C0, C1, C2, C3, N0, N1, N2, N3) \
        if ((KT) > ktmax) goto idx_tiles_done; \
        { \
            if ((KT) < 63) kp += 32 * 64; \
            IDX_LOAD4(N0, N1, N2, N3);                         \
            asm volatile("s_waitcnt vmcnt(4)" : "+v"(C0), "+v"(C1), "+v"(C2), "+v"(C3) :: "memory");     \
            f32x16 acc; \
            _Pragma("unroll") for (int i = 0; i < 16; ++i) acc[i] = 0.f; \
            acc = __builtin_amdgcn_mfma_f32_32x32x16_bf16(aq[0], C0, acc, 0, 0, 0); acc = __builtin_amdgcn_mfma_f32_32x32x16_bf16(aq[1], C1, acc, 0, 0, 0); \
            acc = __builtin_amdgcn_mfma_f32_32x32x16_bf16(aq[2], C2, acc, 0, 0, 0); acc = __builtin_amdgcn_mfma_f32_32x32x16_bf16(aq[3], C3, acc, 0, 0, 0); \
            float s0 = 0.f, s1 = 0.f; \
            _Pragma("unroll") for (int i = 0; i < 8; ++i) { s0 += wlo[i] * __builtin_amdgcn_fmed3f(acc[i], 0.f, 3.0e38f); s1 += whi[i] * __builtin_amdgcn_fmed3f(acc[8 + i], 0.f, 3.0e38f); }     \
            const int key = (KT) * 32 + r; \
            const bool okA = key <= tlo, okB = key <= thi; \
            slo[KT] = okA ? s0 : NEGF; shi[KT] = okB ? s1 : NEGF; \
            asm volatile("" : "+v"(slo[KT]), "+v"(shi[KT]));     \
        }
#pragma unroll
    for (int kt2 = 0; kt2 < 32; ++kt2) {
        IDX_TILE(2 * kt2, ta0, ta1, ta2, ta3, tb0, tb1, tb2, tb3)
        IDX_TILE(2 * kt2 + 1, tb0, tb1, tb2, tb3, ta0, ta1, ta2, ta3)
    }
idx_tiles_done:
    asm volatile("s_waitcnt vmcnt(0)" : "+v"(ta0), "+v"(ta1), "+v"(ta2), "+v"(ta3), "+v"(tb0), "+v"(tb1), "+v"(tb2), "+v"(tb3) :: "memory");
#undef IDX_TILE
#undef IDX_LOAD4
    const int nblk = (ktmax >> 3) + 1;
    float mxA = NEGF, mxB = NEGF, mnA = -NEGF, mnB = -NEGF;
#pragma unroll
    for (int blk = 0; blk < 8; ++blk) {
        if (blk < nblk) {
#pragma unroll
            for (int e = 0; e < 8; ++e) { const float a = slo[8 * blk + e], bb = shi[8 * blk + e];
                mxA = fmaxf(mxA, a); mxB = fmaxf(mxB, bb); mnA = fminf(mnA, a > -1e29f ? a : -NEGF); mnB = fminf(mnB, bb > -1e29f ? bb : -NEGF); }
        }
    }
    mxA = half_max(mxA); mxB = half_max(mxB); mnA = -half_max(-mnA); mnB = -half_max(-mnB);
    const int Ka = tlo + 1 < TOPK ? tlo + 1 : TOPK, Kb = thi + 1 < TOPK ? thi + 1 : TOPK;
    float loA = mnA, hiA = mxA, loB = mnB, hiB = mxB;
    float TA = -1e29f, TB = -1e29f; bool doneA = (tlo + 1 <= TOPK), doneB = (thi + 1 <= TOPK);
#pragma nounroll
    for (int it = 0; it < 40; ++it) {
        if (__ballot(!doneA || !doneB) == 0ull) break;
        const float midA = 0.5f * loA + 0.5f * hiA, midB = 0.5f * loB + 0.5f * hiB;
        const float fA = doneA ? TA : midA, fB = doneB ? TB : midB;
        int cA = 0, cB = 0;
#pragma unroll
        for (int blk = 0; blk < 8; ++blk) {
            if (blk < nblk) {
#pragma unroll
                for (int e = 0; e < 8; ++e) { cA += (slo[8 * blk + e] >= fA) ? 1 : 0; cB += (shi[8 * blk + e] >= fB) ? 1 : 0; }
            }
        }
        cA = half_sum(cA); cB = half_sum(cB);
        const bool stuckA = !(midA > loA && midA < hiA), stuckB = !(midB > loB && midB < hiB);
        if (!doneA) { if (cA == Ka) { TA = fA; doneA = true; } else if (stuckA) { TA = loA; doneA = true; } else if (cA > Ka) loA = midA; else hiA = midA; }
        if (!doneB) { if (cB == Kb) { TB = fB; doneB = true; } else if (stuckB) { TB = loB; doneB = true; } else if (cB > Kb) loB = midB; else hiB = midB; }
    }
    if (!doneA) TA = loA;
    if (!doneB) TB = loB;
    unsigned w0 = 0u, w1 = 0u, w2 = 0u, w3 = 0u;
#pragma unroll
    for (int blk = 0; blk < 8; ++blk) {
        if (blk < nblk) {
#pragma unroll
            for (int e = 0; e < 8; ++e) { const int kt = 8 * blk + e; const unsigned long long ma = __ballot(slo[kt] >= TA), mb = __ballot(shi[kt] >= TB);
                if (lane == kt) { w0 = (unsigned)ma; w1 = (unsigned)(ma >> 32); w2 = (unsigned)mb; w3 = (unsigned)(mb >> 32); } }
        }
    }
    SEL[(rowb + t0 + 0) * 64 + lane] = w0; SEL[(rowb + t0 + 1) * 64 + lane] = w1; SEL[(rowb + t0 + 2) * 64 + lane] = w2; SEL[(rowb + t0 + 3) * 64 + lane] = w3;
}

typedef short bf16x4 __attribute__((ext_vector_type(4)));
#define TRB8(OFS, r0, r1, r2, r3, r4, r5, r6, r7, a0, a1, a2, a3, a4, a5, a6, a7) \
    asm volatile("ds_read_b64_tr_b16 %0, %8 offset:" OFS "\n\tds_read_b64_tr_b16 %1, %9 offset:" OFS "\n\tds_read_b64_tr_b16 %2, %10 offset:" OFS "\n\tds_read_b64_tr_b16 %3, %11 offset:" OFS "\n\t" \
                 "ds_read_b64_tr_b16 %4, %12 offset:" OFS "\n\tds_read_b64_tr_b16 %5, %13 offset:" OFS "\n\tds_read_b64_tr_b16 %6, %14 offset:" OFS "\n\tds_read_b64_tr_b16 %7, %15 offset:" OFS "\n\ts_waitcnt lgkmcnt(0)" \
                 : "=&v"(r0), "=&v"(r1), "=&v"(r2), "=&v"(r3), "=&v"(r4), "=&v"(r5), "=&v"(r6), "=&v"(r7) \
                 : "v"(a0), "v"(a1), "v"(a2), "v"(a3), "v"(a4), "v"(a5), "v"(a6), "v"(a7) : "memory")
#define RDQ8(r0, r1, r2, r3, r4, r5, r6, r7, a0, a1, a2, a3) \
    asm volatile("ds_read_b128 %0, %8\n\tds_read_b128 %1, %9\n\tds_read_b128 %2, %10\n\tds_read_b128 %3, %11\n\t" \
                 "ds_read_b128 %4, %8 offset:256\n\tds_read_b128 %5, %9 offset:256\n\tds_read_b128 %6, %10 offset:256\n\tds_read_b128 %7, %11 offset:256\n\ts_waitcnt lgkmcnt(0)" \
                 : "=&v"(r0), "=&v"(r1), "=&v"(r2), "=&v"(r3), "=&v"(r4), "=&v"(r5), "=&v"(r6), "=&v"(r7) \
                 : "v"(a0), "v"(a1), "v"(a2), "v"(a3) : "memory")
__device__ __forceinline__ float rows_max(float x) {
    unsigned u = __float_as_uint(x);
    u32x2 r = __builtin_amdgcn_permlane16_swap(u, u, false, false);
    u = __float_as_uint(fmaxf(__uint_as_float(r.x), __uint_as_float(r.y)));
    r = __builtin_amdgcn_permlane32_swap(u, u, false, false);
    return fmaxf(__uint_as_float(r.x), __uint_as_float(r.y));
}
__device__ __forceinline__ float rows_sum(float x) {
    unsigned u = __float_as_uint(x);
    u32x2 r = __builtin_amdgcn_permlane16_swap(u, u, false, false);
    u = __float_as_uint(__uint_as_float(r.x) + __uint_as_float(r.y));
    r = __builtin_amdgcn_permlane32_swap(u, u, false, false);
    return __uint_as_float(r.x) + __uint_as_float(r.y);
}

__device__ __forceinline__ int att_build_list(LAS unsigned* list, const LAS unsigned* btab, unsigned w, int t, int lane) {
    const int pc = __popc(w); int incl = pc;
#pragma unroll
    for (int o = 1; o < 64; o <<= 1) { const int v = __shfl_up(incl, o); if (lane >= o) incl += v; }
    const int total = __shfl(incl, 63); const int cnt = total < TOPK ? total : TOPK;
    int off = incl - pc;
    while (w) { const int bit = __builtin_ctz(w); w &= w - 1u;
        if (off < TOPK) { const int idx = 32 * lane + bit; int dd = t - idx; dd = dd < 0 ? 0 : (dd > 128 ? 128 : dd); list[off] = (unsigned)idx | (btab[dd] << 16); }
        ++off; }
    for (int sl = cnt + lane; sl < ((cnt + 15) & ~15); sl += 64) list[sl] = 0u;
    return cnt;
}
__device__ __forceinline__ void att_gather16(const bf16_t* CKVb, const LAS unsigned* list16, LAS unsigned char* slot, int lane) {
    const LAS unsigned* lp = list16 + (lane >> 5);
    unsigned idx[8];
#pragma unroll
    for (int i = 0; i < 8; ++i) idx[i] = lp[2 * i] & 0xffffu;
#pragma unroll
    for (int i = 0; i < 8; ++i) {
        const int rr = (2 * i + (lane >> 5)) & 7;
        const bf16_t* src = CKVb + (size_t)idx[i] * RK + 8 * ((lane & 31) ^ (2 * rr));
        __builtin_amdgcn_global_load_lds((const unsigned*)src, (LAS unsigned*)(slot + 1024 * i), 16, 0, 0);
    }
}

__device__ __forceinline__ void att_wave(const bf16_t* CKV, const unsigned* SEL, bf16_t* BIG, LAS unsigned char* kvbuf, LAS unsigned* lists, const LAS float* relb, const LAS unsigned* btab,
                                         int xcd, int wx, int nwx, int lane) {
    asm volatile("" : "+v"(lane));
    const int hq = lane & 15, g = lane >> 4;
    const int nq = (2 * SEQ - wx + nwx - 1) / nwx;
    if (nq <= 0) return;
    const unsigned kvb = (unsigned)(size_t)kvbuf;
    const int swz = 2 * (lane & 7);
    unsigned qa[4];
#pragma unroll
    for (int j = 0; j < 4; ++j) qa[j] = kvb + (unsigned)hq * 512u + 16u * (unsigned)(g ^ (swz & 3)) + 64u * (unsigned)(j ^ (swz >> 2));
    const int tq = hq >> 2, tp = hq & 3, trow = 4 * g + tq, tswz = 2 * (trow & 7);
    unsigned ta[8];
#pragma unroll
    for (int j = 0; j < 8; ++j) ta[j] = kvb + (unsigned)trow * 512u + 8u * (unsigned)(tp & 1) + 16u * (unsigned)(tp >> 1) + 32u * (unsigned)(j ^ (tswz >> 1));

    int q = wx, b = 2 * xcd + (q >> 11), t = q & 2047;
    size_t row = (size_t)b * SEQ + t;
    unsigned wsel = SEL[row * 64 + lane];
    int cnt = att_build_list(lists, btab, wsel, t, lane);
    unsigned wnext = 0u;
    if (nq > 1) { const int q1 = wx + nwx; wnext = SEL[((size_t)(2 * xcd + (q1 >> 11)) * SEQ + (q1 & 2047)) * 64 + lane]; }
    bf16x8 bq[8];
    { const bf16_t* qp = BIG + row * 4096 + hq * 256 + 8 * g;
#pragma unroll
      for (int ks = 0; ks < 8; ++ks) bq[ks] = *(const bf16x8*)(qp + 32 * ks); }
    int par = 0;
    asm volatile("s_waitcnt lgkmcnt(0)" ::: "memory");
    att_gather16(CKV + (size_t)b * SEQ * RK, lists, kvbuf, lane);
    for (int k = 0; k < nq; ++k) {
        const int cur = k & 1;
        LAS unsigned* list = lists + cur * 256;
        const bool has_next = (k + 1 < nq);
        const int qn = q + nwx, bn = 2 * xcd + (qn >> 11), tn = qn & 2047;
        const size_t rown = (size_t)bn * SEQ + tn;
        int cntn = 0;
        if (has_next) { cntn = att_build_list(lists + (cur ^ 1) * 256, btab, wnext, tn, lane);
            if (k + 2 < nq) { const int q2 = qn + nwx; wnext = SEL[((size_t)(2 * xcd + (q2 >> 11)) * SEQ + (q2 & 2047)) * 64 + lane]; } }
        f32x4 O[16];
#pragma unroll
        for (int nt = 0; nt < 16; ++nt) O[nt] = (f32x4){0.f, 0.f, 0.f, 0.f};
        float mref = NEGF, lsum = 0.f;
        const int nsub = (cnt + 15) >> 4;
        for (int sc = 0; sc < nsub; ++sc) {
            const bool lastc = (sc + 1 == nsub);
            const unsigned so = (unsigned)par * 8192u;
            const int s0 = 16 * sc + 4 * g;
            float bias[4];
            { const u32x4 mt = *(const LAS u32x4*)(list + s0);
#pragma unroll
              for (int i = 0; i < 4; ++i) bias[i] = relb[(mt[i] >> 16) * 16 + hq]; }
            if (!lastc) { att_gather16(CKV + (size_t)b * SEQ * RK, list + 16 * (sc + 1), kvbuf + (par ^ 1) * 8192, lane); asm volatile("s_waitcnt vmcnt(8)" ::: "memory"); }
            else if (has_next) { att_gather16(CKV + (size_t)bn * SEQ * RK, lists + (cur ^ 1) * 256, kvbuf + (par ^ 1) * 8192, lane); asm volatile("s_waitcnt vmcnt(8)" ::: "memory"); }
            else { asm volatile("s_waitcnt vmcnt(0)" ::: "memory"); }
            f32x4 st = (f32x4){0.f, 0.f, 0.f, 0.f};
            { bf16x8 a0, a1, a2, a3, a4, a5, a6, a7;
              RDQ8(a0, a1, a2, a3, a4, a5, a6, a7, qa[0] + so, qa[1] + so, qa[2] + so, qa[3] + so);
              st = __builtin_amdgcn_mfma_f32_16x16x32_bf16(a0, bq[0], st, 0, 0, 0); st = __builtin_amdgcn_mfma_f32_16x16x32_bf16(a1, bq[1], st, 0, 0, 0);
              st = __builtin_amdgcn_mfma_f32_16x16x32_bf16(a2, bq[2], st, 0, 0, 0); st = __builtin_amdgcn_mfma_f32_16x16x32_bf16(a3, bq[3], st, 0, 0, 0);
              st = __builtin_amdgcn_mfma_f32_16x16x32_bf16(a4, bq[4], st, 0, 0, 0); st = __builtin_amdgcn_mfma_f32_16x16x32_bf16(a5, bq[5], st, 0, 0, 0);
              st = __builtin_amdgcn_mfma_f32_16x16x32_bf16(a6, bq[6], st, 0, 0, 0); st = __builtin_amdgcn_mfma_f32_16x16x32_bf16(a7, bq[7], st, 0, 0, 0); }
            if (lastc && has_next) { const bf16_t* qp = BIG + rown * 4096 + hq * 256 + 8 * g;
#pragma unroll
                for (int ks = 0; ks < 8; ++ks) bq[ks] = *(const bf16x8*)(qp + 32 * ks); }
            float lg[4]; float cmax = NEGF;
#pragma unroll
            for (int i = 0; i < 4; ++i) { float v = st[i] + bias[i]; v = (s0 + i < cnt) ? v : NEGF; lg[i] = v; cmax = fmaxf(cmax, v); }
            cmax = rows_max(cmax);
            if (__ballot(cmax > mref + 8.0f) != 0ull) {
                const float mnew = fmaxf(mref, cmax), scl = fast_exp(mref - mnew);
                lsum *= scl;
#pragma unroll
                for (int nt = 0; nt < 16; ++nt) O[nt] = O[nt] * scl;
                mref = mnew;
            }
            float p[4];
#pragma unroll
            for (int i = 0; i < 4; ++i) { p[i] = fast_exp(lg[i] - mref); lsum += p[i]; }
            u32x2 pkw; pkw.x = cvt_pk_bf16(p[0], p[1]); pkw.y = cvt_pk_bf16(p[2], p[3]);
            const bf16x4 pk = __builtin_bit_cast(bf16x4, pkw);
            {
                s16x4 r0, r1, r2, r3, r4, r5, r6, r7;
                const unsigned t0 = ta[0] + so, t1 = ta[1] + so, t2 = ta[2] + so, t3 = ta[3] + so, t4 = ta[4] + so, t5 = ta[5] + so, t6 = ta[6] + so, t7 = ta[7] + so;
                TRB8("0", r0, r1, r2, r3, r4, r5, r6, r7, t0, t1, t2, t3, t4, t5, t6, t7);
                O[0] = __builtin_amdgcn_mfma_f32_16x16x16bf16_1k(r0, pk, O[0], 0, 0, 0); O[1] = __builtin_amdgcn_mfma_f32_16x16x16bf16_1k(r1, pk, O[1], 0, 0, 0);
                O[2] = __builtin_amdgcn_mfma_f32_16x16x16bf16_1k(r2, pk, O[2], 0, 0, 0); O[3] = __builtin_amdgcn_mfma_f32_16x16x16bf16_1k(r3, pk, O[3], 0, 0, 0);
                O[4] = __builtin_amdgcn_mfma_f32_16x16x16bf16_1k(r4, pk, O[4], 0, 0, 0); O[5] = __builtin_amdgcn_mfma_f32_16x16x16bf16_1k(r5, pk, O[5], 0, 0, 0);
                O[6] = __builtin_amdgcn_mfma_f32_16x16x16bf16_1k(r6, pk, O[6], 0, 0, 0); O[7] = __builtin_amdgcn_mfma_f32_16x16x16bf16_1k(r7, pk, O[7], 0, 0, 0);
                TRB8("256", r0, r1, r2, r3, r4, r5, r6, r7, t0, t1, t2, t3, t4, t5, t6, t7);
                O[8] = __builtin_amdgcn_mfma_f32_16x16x16bf16_1k(r0, pk, O[8], 0, 0, 0); O[9] = __builtin_amdgcn_mfma_f32_16x16x16bf16_1k(r1, pk, O[9], 0, 0, 0);
                O[10] = __builtin_amdgcn_mfma_f32_16x16x16bf16_1k(r2, pk, O[10], 0, 0, 0); O[11] = __builtin_amdgcn_mfma_f32_16x16x16bf16_1k(r3, pk, O[11], 0, 0, 0);
                O[12] = __builtin_amdgcn_mfma_f32_16x16x16bf16_1k(r4, pk, O[12], 0, 0, 0); O[13] = __builtin_amdgcn_mfma_f32_16x16x16bf16_1k(r5, pk, O[13], 0, 0, 0);
                O[14] = __builtin_amdgcn_mfma_f32_16x16x16bf16_1k(r6, pk, O[14], 0, 0, 0); O[15] = __builtin_amdgcn_mfma_f32_16x16x16bf16_1k(r7, pk, O[15], 0, 0, 0);
            }
            par ^= 1;
        }
        lsum = rows_sum(lsum);
        const float inv = 1.0f / lsum;
        bf16_t* op = BIG + row * 4096 + hq * 256 + 4 * g;
#pragma unroll
        for (int nt = 0; nt < 16; ++nt) { const f32x4 o = O[nt] * inv; u32x2 wv; wv.x = cvt_pk_bf16(o[0], o[1]); wv.y = cvt_pk_bf16(o[2], o[3]); *(u32x2*)(op + 16 * nt) = wv; }
        q = qn; b = bn; t = tn; row = rown; cnt = cntn;
    }
}

constexpr int SW_KP = 144, SW_VP = 520;
constexpr int SW_K_OFF = 0, SW_V_OFF = 256 * SW_KP, SW_TB_OFF = SW_V_OFF + 64 * SW_VP;
__device__ __forceinline__ void swa_phase(const bf16_t* QKV, bf16_t* OB, const float* relb, const float* sinks, LAS unsigned char* lds, int G) {
    int tid = threadIdx.x; asm volatile("" : "+v"(tid));
    const int lane = tid & 63, wave = __builtin_amdgcn_readfirstlane(tid >> 6);
    const int h = lane >> 5, n = lane & 31;
    LAS float* tb = (LAS float*)(lds + SW_TB_OFF);
    for (int u = blockIdx.x; u < BATCH * 16 * KVH; u += G) {
        const int b = u >> 5, nb = (u >> 1) & 15, kvh = u & 1;
        const size_t rowb = (size_t)b * SEQ;
        __syncthreads();
#pragma unroll
        for (int e = 0; e < 4; ++e) { const int id = tid + NTHR * e, j = id >> 3, ch = id & 7; const int pos = (nb - 1) * WIN + j;
            u32x4 kv = (u32x4){0u, 0u, 0u, 0u}, vv = (u32x4){0u, 0u, 0u, 0u};
            if (pos >= 0) { const bf16_t* sp = QKV + (rowb + pos) * B_IN + 1024 + kvh * 64 + ch * 8; kv = *(const u32x4*)sp; vv = *(const u32x4*)(sp + 128); }
            *(LAS u32x4*)(lds + SW_K_OFF + j * SW_KP + ch * 16) = kv;
            LAS bf16_t* vt = (LAS bf16_t*)(lds + SW_V_OFF + (ch * 8) * SW_VP + j * 2);
#pragma unroll
            for (int q = 0; q < 4; ++q) { vt[(2 * q) * (SW_VP / 2)] = (bf16_t)(vv[q] & 0xffffu); vt[(2 * q + 1) * (SW_VP / 2)] = (bf16_t)(vv[q] >> 16); } }
        for (int i = tid; i < GQ * WIN; i += NTHR) { const int gg = i >> 7, dist = i & 127; tb[i] = relb[t5_bucket(dist) * NH + kvh * GQ + gg]; }
        __syncthreads();
        const int qh = kvh * GQ + wave; const float sink = sinks[qh];
        for (int rt = 0; rt < 4; ++rt) {
            const size_t qrow = rowb + nb * WIN + 32 * rt + n;
            bf16x8 bq[4];
#pragma unroll
            for (int ks = 0; ks < 4; ++ks) bq[ks] = *(const bf16x8*)(QKV + qrow * B_IN + qh * 64 + 16 * ks + 8 * h);
            f32x16 s[5];
#pragma unroll
            for (int ct = 0; ct < 5; ++ct) {
#pragma unroll
                for (int i = 0; i < 16; ++i) s[ct][i] = 0.f;
#pragma unroll
                for (int ks = 0; ks < 4; ++ks) { const bf16x8 a = *(const LAS bf16x8*)(lds + SW_K_OFF + (32 * (rt + ct) + n) * SW_KP + (2 * ks + h) * 16);
                    s[ct] = __builtin_amdgcn_mfma_f32_32x32x16_bf16(a, bq[ks], s[ct], 0, 0, 0); } }
            const int qi = 32 * rt + n;
            float mx = NEGF;
#pragma unroll
            for (int ct = 0; ct < 5; ++ct)
#pragma unroll
                for (int i = 0; i < 16; ++i) { const int j = 32 * (rt + ct) + (i & 3) + 8 * (i >> 2) + 4 * h; const int dist = qi + WIN - j;
                    const bool ok = (dist >= 0) && (dist < WIN) && (nb > 0 || j >= WIN);
                    const float v = ok ? s[ct][i] * 0.125f + tb[wave * WIN + (dist & 127)] : NEGF; s[ct][i] = v; mx = fmaxf(mx, v); }
            mx = fmaxf(mx, __shfl_xor(mx, 32)); mx = fmaxf(mx, sink);
            float sum = 0.f;
#pragma unroll
            for (int ct = 0; ct < 5; ++ct)
#pragma unroll
                for (int i = 0; i < 16; ++i) { const float p = fast_exp(s[ct][i] - mx); s[ct][i] = p; sum += p; }
            sum += __shfl_xor(sum, 32); sum += fast_exp(sink - mx);
            f32x16 o[2];
#pragma unroll
            for (int dt = 0; dt < 2; ++dt)
#pragma unroll
                for (int i = 0; i < 16; ++i) o[dt][i] = 0.f;
#pragma unroll
            for (int ct = 0; ct < 5; ++ct)
#pragma unroll
                for (int s2 = 0; s2 < 2; ++s2) {
                    u32x4 pw; pw.x = cvt_pk_bf16(s[ct][8 * s2 + 0], s[ct][8 * s2 + 1]); pw.y = cvt_pk_bf16(s[ct][8 * s2 + 2], s[ct][8 * s2 + 3]);
                    pw.z = cvt_pk_bf16(s[ct][8 * s2 + 4], s[ct][8 * s2 + 5]); pw.w = cvt_pk_bf16(s[ct][8 * s2 + 6], s[ct][8 * s2 + 7]);
                    const bf16x8 pb = __builtin_bit_cast(bf16x8, pw);
#pragma unroll
                    for (int dt = 0; dt < 2; ++dt) { const LAS unsigned char* vp = lds + SW_V_OFF + (32 * dt + n) * SW_VP + (32 * (rt + ct) + 16 * s2 + 4 * h) * 2;
                        const u32x2 v0 = *(const LAS u32x2*)vp, v1 = *(const LAS u32x2*)(vp + 16);
                        u32x4 va; va.x = v0.x; va.y = v0.y; va.z = v1.x; va.w = v1.y;
                        o[dt] = __builtin_amdgcn_mfma_f32_32x32x16_bf16(__builtin_bit_cast(bf16x8, va), pb, o[dt], 0, 0, 0); }
                }
            const float inv = 1.0f / sum;
            bf16_t* op = OB + qrow * D + qh * 64 + 4 * h;
#pragma unroll
            for (int dt = 0; dt < 2; ++dt)
#pragma unroll
                for (int i4 = 0; i4 < 4; ++i4) { u32x2 wv; wv.x = cvt_pk_bf16(o[dt][4 * i4] * inv, o[dt][4 * i4 + 1] * inv); wv.y = cvt_pk_bf16(o[dt][4 * i4 + 2] * inv, o[dt][4 * i4 + 3] * inv);
                    *(u32x2*)(op + 32 * dt + 8 * i4) = wv; }
        }
    }
}

struct Args { const float* in[23]; float* out; unsigned char* ws; };
#define CAS __attribute__((address_space(4)))
__device__ __forceinline__ const CAS Args* kargs() { const CAS Args* p = (const CAS Args*)__builtin_amdgcn_kernarg_segment_ptr(); asm volatile("" : "+s"(p)); return p; }

__global__ void __launch_bounds__(NTHR, 2) trunk_fwd(Args args_by_value) {
    extern __shared__ __attribute__((aligned(16))) unsigned char lds_raw[];
    LAS unsigned char* lds = (LAS unsigned char*)lds_raw;
    const int tid = threadIdx.x;
    volatile LAS unsigned* MISC = (volatile LAS unsigned*)(lds + LDS_MISC_OFF);
    for (int u = tid; u < (LDS_BYTES - LDS_MISC_OFF) / 4; u += NTHR) MISC[u] = 0u;
    __syncthreads();
    { const CAS Args* A = kargs(); (void)xcd_barrier_post((unsigned*)(A->ws + WS_CTL) + 4096, MISC + 8);
      if (tid == 0) { const unsigned x = xb_xcc_id(); MISC[16] = x; MISC[17] = xb_add((unsigned*)(A->ws + WS_CTL) + 8192 + 64 * x, 1u); } }
#define XCD_RANK(xcd, rank) do { const CAS Args* A_ = kargs(); const unsigned* cw_ = (const unsigned*)(A_->ws + WS_CTL) + 4096; bool ok_ = (gridDim.x & 7) == 0; \
        for (int j_ = 0; j_ < 16; ++j_) { const unsigned c_ = __hip_atomic_load(cw_ + XB_XCNT(j_), __ATOMIC_RELAXED, __HIP_MEMORY_SCOPE_AGENT); ok_ = ok_ && (c_ == (j_ < 8 ? gridDim.x >> 3 : 0u)); } \
        const unsigned hx_ = MISC[16], hr_ = MISC[17]; ok_ = ok_ && hx_ < 8u && hr_ < (gridDim.x >> 3); \
        xcd = ok_ ? (int)hx_ : (int)(blockIdx.x & 7); rank = ok_ ? (int)hr_ : (int)(blockIdx.x >> 3); } while (0)
#define GB() do { const CAS Args* A_ = kargs(); XcdBarrier b_; b_.bar = (unsigned*)(A_->ws + WS_CTL) + 4096; b_.x = xb_xcc_id(); b_.st = MISC + 8; xcd_barrier(b_); } while (0)

    { const CAS Args* A = kargs(); Ptrs P;
#pragma unroll
      for (int i = 0; i < 23; ++i) P.in[i] = A->in[i];
      P.out = A->out; P.ws = A->ws;
      p0_prologue(P, lds, (int)gridDim.x); }
    GB();
    { const CAS Args* A = kargs(); Ptrs P;
#pragma unroll
      for (int i = 0; i < 23; ++i) P.in[i] = A->in[i];
      P.out = A->out; P.ws = A->ws;
      pre_phase(P, lds, (int)gridDim.x); }
    GB();

    for (int l = 0; l < DEPTH; ++l) {
        const bool isA = (l & 1) == 0;
        {
            const CAS Args* A = kargs(); const int G = gridDim.x, j = l >> 1; unsigned char* ws = A->ws;
            const unsigned long long* SS = (const unsigned long long*)(ws + WS_SS) + (size_t)(2 * l) * M;
            if (isA) {
                unsigned char* wa = ws + WS_WA + (size_t)j * WA_STRIDE;
                pg8::Gemm g{(const bf16_t*)(ws + WS_XG), (const bf16_t*)(wa + WINA_OFF), D, D, D, 0, 0}; pg8::StaticOrder S; S.init(M, 2048, G, (int)blockIdx.x);
                pg8::EpiInA E{(bf16_t*)(ws + WS_QO), (bf16_t*)(ws + WS_CKV), (bf16_t*)(ws + WS_QI), (bf16_t*)(ws + WS_KIN), (float*)(ws + WS_WI), A->in[I_AIKG] + j * IDIM, A->in[I_AIKB] + j * IDIM,
                                (const float*)(ws + WS_SHW + SHW_A) + (size_t)j * BATCH * 2048, SS};
                pg8::gemm_phase<pg8::EpiInA, true>(lds, g, S, E);
            } else {
                unsigned char* wb = ws + WS_WB + (size_t)j * WB_STRIDE;
                pg8::Gemm g{(const bf16_t*)(ws + WS_XG), (const bf16_t*)(wb + WINB_OFF), D, D, D, 0, 0}; pg8::StaticOrder S; S.init(M, B_IN, G, (int)blockIdx.x);
                pg8::EpiBf16Plain<true> E{(bf16_t*)(ws + WS_QKV), B_IN, (const float*)(ws + WS_SHW + SHW_B) + (size_t)j * BATCH * B_IN, B_IN, SS};
                pg8::gemm_phase<pg8::EpiBf16Plain<true>, true>(lds, g, S, E);
            }
        }
        GB();
        if (isA) {
            { const CAS Args* A = kargs(); const int G = gridDim.x, j = l >> 1; unsigned char* ws = A->ws;
              unsigned char* wa = ws + WS_WA + (size_t)j * WA_STRIDE;
              pg8::Gemm g{(const bf16_t*)(ws + WS_QO), (const bf16_t*)(wa + WQA_OFF), D, 256, 256, 2, 256}; pg8::StaticOrder S; S.init(M, 4096, G, (int)blockIdx.x);
              pg8::EpiBf16Plain<false> E{(bf16_t*)(ws + WS_BIG), 4096, nullptr, 0, nullptr};
              pg8::gemm_phase<pg8::EpiBf16Plain<false>, true>(lds, g, S, E); }
            { const CAS Args* A = kargs(); const int G = gridDim.x; unsigned char* ws = A->ws;
              int tid2 = tid; asm volatile("" : "+v"(tid2));
              const int lane = tid2 & 63, wave = __builtin_amdgcn_readfirstlane(tid2 >> 6);
              bf16_t* CKV = (bf16_t*)(ws + WS_CKV);
              const int gw = blockIdx.x * NWAVES + wave, NGW = G * NWAVES;
              for (int row = gw; row < M; row += NGW) {
                  u32x2* pr = (u32x2*)(CKV + (size_t)row * RK) + lane;
                  const u32x2 v = *pr;
                  const float a0 = __uint_as_float(v.x << 16), a1 = __uint_as_float(v.x & 0xffff0000u), a2 = __uint_as_float(v.y << 16), a3 = __uint_as_float(v.y & 0xffff0000u);
                  const float ss = wave_sum((a0 * a0 + a1 * a1) + (a2 * a2 + a3 * a3));
                  const float rs = 1.0f / sqrtf(ss * (1.0f / RK) + EPS);
                  u32x2 o; o.x = cvt_pk_bf16(a0 * rs, a1 * rs); o.y = cvt_pk_bf16(a2 * rs, a3 * rs); *pr = o;
              } }
            { const CAS Args* A = kargs(); const int G = gridDim.x; unsigned char* ws = A->ws;
              int tid2 = tid; asm volatile("" : "+v"(tid2));
              const int lane = tid2 & 63, wave = __builtin_amdgcn_readfirstlane(tid2 >> 6);
              int xcd, rank; XCD_RANK(xcd, rank); xcd = __builtin_amdgcn_readfirstlane(xcd); rank = __builtin_amdgcn_readfirstlane(rank);
              const int wx = rank * NWAVES + wave, nwx = (G >> 3) * NWAVES;
              for (int q = wx; q < 1024; q += nwx) {
                  const int bl = q >> 9, r9 = q & 511, b = 2 * xcd + bl;
                  const int tg = (r9 & 1) ? 511 - (r9 >> 1) : (r9 >> 1);
                  idx_task((const bf16_t*)(ws + WS_QI), (const bf16_t*)(ws + WS_KIN), (const float*)(ws + WS_WI), (unsigned*)(ws + WS_SEL), b, tg, lane);
              } }
        } else {
            const CAS Args* A = kargs(); const int G = gridDim.x, j = l >> 1; unsigned char* ws = A->ws;
            swa_phase((const bf16_t*)(ws + WS_QKV), (bf16_t*)(ws + WS_OB), A->in[I_RELB], A->in[I_BSINK] + j * NH, lds, G);
        }
        GB();
        if (isA) {
            { const CAS Args* A = kargs(); const int G = gridDim.x; unsigned char* ws = A->ws;
              int tid2 = tid; asm volatile("" : "+v"(tid2));
              const int lane = tid2 & 63, wave = __builtin_amdgcn_readfirstlane(tid2 >> 6);
              LAS float* relb = (LAS float*)(lds + 147456);
              LAS unsigned* btab = (LAS unsigned*)(lds + 147456 + 2048);
              for (int i = tid2; i < NBUCK * NH; i += NTHR) relb[i] = A->in[I_RELB][i];
              for (int i = tid2; i < 132; i += NTHR) btab[i] = (unsigned)t5_bucket(i);
              __syncthreads();
              int xcd, rank; XCD_RANK(xcd, rank); xcd = __builtin_amdgcn_readfirstlane(xcd); rank = __builtin_amdgcn_readfirstlane(rank);
              const int wx = rank * NWAVES + wave, nwx = (G >> 3) * NWAVES;
              att_wave((const bf16_t*)(ws + WS_CKV), (const unsigned*)(ws + WS_SEL), (bf16_t*)(ws + WS_BIG), lds + wave * 16384, (LAS unsigned*)(lds + 131072 + wave * 2048), relb, btab, xcd, wx, nwx, lane); }
            GB();
            { const CAS Args* A = kargs(); const int G = gridDim.x, j = l >> 1; unsigned char* ws = A->ws;
              unsigned char* wa = ws + WS_WA + (size_t)j * WA_STRIDE;
              pg8::Gemm g{(const bf16_t*)(ws + WS_BIG), (const bf16_t*)(wa + WUV_OFF), 4096, D, D, 0, 1024}; pg8::StaticOrder S; S.init(M, D, G, (int)blockIdx.x);
              pg8::EpiBf16Plain<false> E{(bf16_t*)(ws + WS_QO), D, nullptr, 0, nullptr};
              pg8::gemm_phase<pg8::EpiBf16Plain<false>, true>(lds, g, S, E); }
            GB();
        }
        {
            const CAS Args* A = kargs(); const int G = gridDim.x, j = l >> 1; unsigned char* ws = A->ws;
            const float* xin = (l == 0) ? A->in[I_X] : A->out;
            const float* modl = (const float*)(ws + WS_MOD) + (size_t)l * BATCH * 6144;
            const bf16_t* Ain = (const bf16_t*)(ws + (isA ? WS_QO : WS_OB));
            const bf16_t* Bw = (const bf16_t*)(isA ? ws + WS_WA + (size_t)j * WA_STRIDE + WOUTA_OFF : ws + WS_WB + (size_t)j * WB_STRIDE + WOUTB_OFF);
            pg8::Gemm g{Ain, Bw, D, D, D, 0, 0}; pg8::StaticOrder S; S.init(M, D, G, (int)blockIdx.x);
            pg8::EpiResid E{xin, A->out, modl + 2048, isA ? nullptr : A->in[I_BBOUT] + j * D,
                            (bf16_t*)(ws + WS_XG), A->in[I_GFFN] + l * D, modl + 4096, (unsigned long long*)(ws + WS_SS) + (size_t)(2 * l + 1) * M};
            pg8::gemm_phase<pg8::EpiResid, true>(lds, g, S, E);
        }
        GB();
        {
            const CAS Args* A = kargs(); const int G = gridDim.x; unsigned char* ws = A->ws;
            unsigned char* wl = ws + WS_W + (size_t)l * W_LAYER;
            pg8::Gemm g{(const bf16_t*)(ws + WS_XG), (const bf16_t*)(wl + W13_OFF), D, D, D, 0, 0}; pg8::StaticOrder S; S.init(M, 2 * DFF, G, (int)blockIdx.x);
            pg8::EpiSwiGLU E{(bf16_t*)(ws + WS_HFF), (const float*)(ws + WS_SHW + SHW_F) + (size_t)l * BATCH * 2 * DFF, (const unsigned long long*)(ws + WS_SS) + (size_t)(2 * l + 1) * M};
            pg8::gemm_phase<pg8::EpiSwiGLU, true>(lds, g, S, E);
        }
        GB();
        {
            const CAS Args* A = kargs(); const int G = gridDim.x; unsigned char* ws = A->ws;
            unsigned char* wl = ws + WS_W + (size_t)l * W_LAYER;
            const float* modl = (const float*)(ws + WS_MOD) + (size_t)l * BATCH * 6144;
            const int ln = l + 1 < DEPTH ? l + 1 : l;
            pg8::Gemm g{(const bf16_t*)(ws + WS_HFF), (const bf16_t*)(wl + W2_OFF), DFF, DFF, DFF, 0, 0}; pg8::StaticOrder S; S.init(M, D, G, (int)blockIdx.x);
            pg8::EpiResid E{A->out, A->out, modl + 5120, nullptr,
                            l + 1 < DEPTH ? (bf16_t*)(ws + WS_XG) : nullptr, A->in[I_GMIX] + ln * D, (const float*)(ws + WS_MOD) + (size_t)ln * BATCH * 6144 + 1024, (unsigned long long*)(ws + WS_SS) + (size_t)(2 * l + 2) * M};
            pg8::gemm_phase<pg8::EpiResid, true>(lds, g, S, E);
        }
        GB();
    }
    { const CAS Args* A = kargs(); final_norm_phase(A->out, A->in[I_GFIN], (int)gridDim.x); }
#undef GB
}

extern "C" void kernel_launch(void* const* d_in, const int* in_sizes, int n_in, void* d_out, int out_size, void* d_ws, size_t ws_size, hipStream_t stream) {
    static int grid = 0;
    if (grid == 0) {
        if (n_in != 23 || out_size != M * D || ws_size < WS_END) { fprintf(stderr, "kernel_launch: unexpected shapes (n_in %d out %d ws %zu)\n", n_in, out_size, ws_size); grid = -1; return; }
        int dev = 0, cus = 0, per_cu = 0;
        if (hipGetDevice(&dev) != hipSuccess || hipDeviceGetAttribute(&cus, hipDeviceAttributeMultiprocessorCount, dev) != hipSuccess) { grid = -1; return; }
        if (hipFuncSetAttribute((const void*)trunk_fwd, hipFuncAttributeMaxDynamicSharedMemorySize, LDS_BYTES) != hipSuccess) { fprintf(stderr, "kernel_launch: hipFuncSetAttribute failed\n"); grid = -1; return; }
        if (hipOccupancyMaxActiveBlocksPerMultiprocessor(&per_cu, (const void*)trunk_fwd, NTHR, LDS_BYTES) != hipSuccess || per_cu < 1) { fprintf(stderr, "kernel_launch: occupancy query says %d\n", per_cu); }
        (void)hipGetLastError();
        grid = cus;
    }
    if (grid < 0) return;
    (void)hipMemsetAsync((char*)d_ws + WS_CTL, 0, CTL_ZERO_BYTES, stream);
    Args a{};
    for (int i = 0; i < 23; ++i) a.in[i] = (const float*)d_in[i];
    a.out = (float*)d_out; a.ws = (unsigned char*)d_ws;
    hipLaunchKernelGGL(trunk_fwd, dim3(grid), dim3(NTHR), LDS_BYTES, stream, a);
    const hipError_t le = hipPeekAtLastError();
    if (le != hipSuccess) fprintf(stderr, "kernel_launch: launch failed: %s\n", hipGetErrorName(le));
}
```

```cpp
#include <hip/hip_runtime.h>
#include <cstdio>
#include <cstdint>


#define GAS __attribute__((address_space(1)))
#define LAS __attribute__((address_space(3)))
typedef unsigned short bf16_t;
typedef short bf16x8 __attribute__((ext_vector_type(8)));
typedef short s16x4 __attribute__((ext_vector_type(4)));
typedef float f32x4 __attribute__((ext_vector_type(4)));
typedef float f32x2 __attribute__((ext_vector_type(2)));
typedef float f32x16 __attribute__((ext_vector_type(16)));
typedef unsigned u32x4 __attribute__((ext_vector_type(4)));
typedef unsigned u32x2 __attribute__((ext_vector_type(2)));

constexpr int D = 1024, BATCH = 16, SEQ = 2048, M = BATCH * SEQ, DEPTH = 4;
constexpr int NH = 16, HD = 64, RK = 256, IH = 8, IDIM = 64, TOPK = 256;
constexpr int KVH = 2, GQ = 8, WIN = 128, NBUCK = 32, DFF = 2816;
constexpr int A_IN = 1864, B_IN = 1280;
constexpr float EPS = 1e-6f;
constexpr float NEGF = -1e30f;
constexpr int NWAVES = 8, NTHR = 512;

constexpr size_t MiB = 1u << 20;
constexpr size_t WS_CTL = 0, CTL_ZERO_BYTES = 4 * MiB;
constexpr size_t WS_SS = 1 * MiB;
constexpr size_t WS_W = 4 * MiB;
constexpr size_t W_LAYER = 17301504;
constexpr size_t W13_OFF = 0, W2_OFF = 11 * MiB;
constexpr size_t WS_WA = WS_W + 4 * W_LAYER;
constexpr size_t WA_STRIDE = 10 * MiB, WINA_OFF = 0, WQA_OFF = 4 * MiB, WUV_OFF = 6 * MiB, WOUTA_OFF = 8 * MiB;
constexpr size_t WS_WB = WS_WA + 2 * WA_STRIDE;
constexpr size_t WB_STRIDE = 4718592, WINB_OFF = 0, WOUTB_OFF = 2621440;
constexpr size_t WS_MOD = 100 * MiB;
constexpr size_t WS_SHW = WS_MOD + 1536 * 1024;
constexpr size_t SHW_A = 0, SHW_B = 2 * 16 * 2048 * 4, SHW_F = SHW_B + 2 * 16 * 1280 * 4;
constexpr size_t WS_XG = 104 * MiB;
constexpr size_t WS_BIG = 104 * MiB;
constexpr size_t WS_HFF = 168 * MiB;
constexpr size_t WS_QO = 360 * MiB;
constexpr size_t WS_CKV = 424 * MiB;
constexpr size_t WS_QI = 440 * MiB;
constexpr size_t WS_KIN = 472 * MiB;
constexpr size_t WS_WI = 476 * MiB;
constexpr size_t WS_SEL = 477 * MiB;
constexpr size_t WS_RKV = 485 * MiB;
constexpr size_t WS_QKV = 360 * MiB;
constexpr size_t WS_OB = 440 * MiB;
constexpr size_t WS_END = 512 * MiB;

constexpr int RING_BYTES = 131072;
constexpr int LDS_MISC_OFF = 155648;
constexpr int LDS_BYTES = 156672;

#define RLX_AGENT __ATOMIC_RELAXED, __HIP_MEMORY_SCOPE_AGENT
__device__ __forceinline__ unsigned cvt_pk_bf16(float lo, float hi) { unsigned r; asm volatile("v_cvt_pk_bf16_f32 %0, %1, %2" : "=v"(r) : "v"(lo), "v"(hi)); return r; }
__device__ __forceinline__ float bf2f(bf16_t b) { return __uint_as_float(((unsigned)b) << 16); }
__device__ __forceinline__ float wave_sum(float v) {
#pragma unroll
    for (int o = 1; o < 64; o <<= 1) v += __shfl_xor(v, o);
    return v;
}
__device__ __forceinline__ float fast_exp(float x) { return __builtin_amdgcn_exp2f(x * 1.4426950408889634f); }
__device__ __forceinline__ float silu_f(float x) { return x * __builtin_amdgcn_rcpf(1.0f + fast_exp(-x)); }
__device__ __forceinline__ int t5_bucket(int d) {
    if (d < 16) return d;
    int b = 16;
    b += (d >= 19); b += (d >= 21); b += (d >= 24); b += (d >= 27); b += (d >= 31); b += (d >= 35); b += (d >= 40); b += (d >= 46);
    b += (d >= 52); b += (d >= 59); b += (d >= 67); b += (d >= 77); b += (d >= 87); b += (d >= 99); b += (d >= 113);
    return b;
}

#define XB_TMO      128
#define XB_XCNT(j)  (256  + 64 * (j))
#define XB_XSUB(j)  (1280 + 64 * (j))
#define XB_XGEN(j)  (2304 + 64 * (j))
#define XB_TOP      3328
#define XB_TOPGEN   3392
#define XCD_BAR_WORDS 3456
#define XB_SPIN_CAP (1u << 22)

__device__ __forceinline__ unsigned xb_ld(unsigned* p)              { return __hip_atomic_load(p, __ATOMIC_RELAXED, __HIP_MEMORY_SCOPE_AGENT); }
__device__ __forceinline__ unsigned xb_add(unsigned* p, unsigned v) { return __hip_atomic_fetch_add(p, v, __ATOMIC_RELAXED, __HIP_MEMORY_SCOPE_AGENT); }
__device__ __forceinline__ unsigned xb_xcc_id() { return (unsigned)__builtin_amdgcn_s_getreg((3 << 11) | 20) & 0xFu; }
#define XB_SPIN(cond, bar) do { unsigned _sp = 0; while (cond) { __builtin_amdgcn_s_sleep(1); \
    if ((++_sp & 255u) == 0u) { if (xb_ld(&(bar)[XB_TMO])) break; if (_sp > XB_SPIN_CAP) { atomicAdd(&(bar)[XB_TMO], 1u); break; } } } } while (0)

struct XcdBarrier { unsigned* bar; unsigned x; volatile LAS unsigned* st; };

__device__ __forceinline__ XcdBarrier xcd_barrier_post(unsigned* bar, volatile LAS unsigned* st) {
    XcdBarrier b; b.bar = bar; b.x = xb_xcc_id(); b.st = st;
    if (threadIdx.x == 0) (void)xb_add(&bar[XB_XCNT(b.x)], 1u);
    return b;
}
__device__ __forceinline__ void xcd_barrier_complete(unsigned* bar, unsigned x, unsigned& nloc, unsigned& nx) {
    const unsigned G = gridDim.x * gridDim.y * gridDim.z;
    unsigned sum, cnt, mine, sp = 0u;
    for (;;) {
        sum = 0u; cnt = 0u; mine = 0u;
#pragma unroll
        for (unsigned j = 0; j < 16; ++j) { const unsigned c = xb_ld(&bar[XB_XCNT(j)]); sum += c; cnt += (c > 0u) ? 1u : 0u; mine = (j == x) ? c : mine; }
        if (sum == G) break;
        __builtin_amdgcn_s_sleep(1);
        if ((++sp & 255u) == 0u) { if (xb_ld(&bar[XB_TMO])) break; if (sp > XB_SPIN_CAP) { atomicAdd(&bar[XB_TMO], 1u); break; } }
    }
    nloc = mine > 0u ? mine : 1u; nx = cnt > 0u ? cnt : 1u;
}
__device__ __forceinline__ void xcd_barrier(const XcdBarrier& b) {
    asm volatile("s_waitcnt vmcnt(0)" ::: "memory");
    __syncthreads();
    if (threadIdx.x == 0) {
        unsigned* bar = b.bar;
        __builtin_amdgcn_s_waitcnt(0);
        unsigned nloc = b.st[0], nx = b.st[1];
        if (nloc == 0u) { xcd_barrier_complete(bar, b.x, nloc, nx); b.st[0] = nloc; b.st[1] = nx; }
        const unsigned old = xb_add(&bar[XB_XSUB(b.x)], 1u);
        const unsigned gen = old / nloc;
        if (old + 1u == (gen + 1u) * nloc) {
            __builtin_amdgcn_fence(__ATOMIC_RELEASE, "agent");
            asm volatile("s_waitcnt vmcnt(0)" ::: "memory");
            const unsigned og = xb_add(&bar[XB_TOP], 1u);
            const unsigned tg = og / nx;
            if (og + 1u == (tg + 1u) * nx) xb_add(&bar[XB_TOPGEN], 1u);
            else XB_SPIN(xb_ld(&bar[XB_TOPGEN]) == tg, bar);
            __builtin_amdgcn_fence(__ATOMIC_ACQUIRE, "agent");
            xb_add(&bar[XB_XGEN(b.x)], 1u);
            asm volatile("s_waitcnt vmcnt(0)" ::: "memory");
        } else {
            XB_SPIN(xb_ld(&bar[XB_XGEN(b.x)]) == gen, bar);
            __builtin_amdgcn_fence(__ATOMIC_ACQUIRE, "agent");
            asm volatile("s_waitcnt vmcnt(0)" ::: "memory");
        }
    }
    __syncthreads();
}

namespace pg8 {
constexpr int BM = 256, BK = 64, HALF = 128, HTB = HALF * BK * 2, STAGE_BYTES = 8 * HTB, NXCD = 8, WGM = 8;
__host__ __device__ __forceinline__ int lds_byte(int r, int c) { const int st = (r >> 4) * 2 + (c >> 5), rr = r & 15, cc = c & 31, ob = rr * 64 + cc * 2; return st * 1024 + (ob ^ (((ob >> 9) & 1) << 5)); }
__host__ __device__ __forceinline__ void stage_rc(int b, int& R, int& C) { const int st = b / 1024, sb = b % 1024, swz = sb ^ (((sb >> 9) & 1) << 5); R = (st >> 1) * 16 + swz / 64; C = (st & 1) * 32 + (swz % 64) / 2; }
__host__ __device__ __forceinline__ int perm32(int rho) { const int n = rho >> 4, i = rho & 15; return 8 * (i >> 2) + 4 * n + (i & 3); }

struct Unit { int pm, pn; };
struct Gemm { const bf16_t* A; const bf16_t* Bt; int lda, ldb, K, a_shift, a_mul; };

struct StaticOrder {
    int nM, nN, nwg, G, c;
    __device__ void init(int M_, int N_, int G_, int c_) { nM = M_ / BM; nN = N_ / BM; nwg = nM * nN; G = G_; c = c_; }
    __device__ bool next(int i, Unit& u) const {
        const long L = (long)i * G + c; if (L >= nwg) return false;
        int wgid = (int)L; { const int q = nwg / NXCD, r = nwg % NXCD, xcd = wgid % NXCD, off = wgid / NXCD; wgid = (xcd < r ? xcd * (q + 1) : r * (q + 1) + (xcd - r) * q) + off; }
        const int nig = WGM * nN, gid = wgid / nig, fm = gid * WGM, gsz = (nM - fm) < WGM ? (nM - fm) : WGM;
        u.pm = fm + ((wgid % nig) % gsz); u.pn = (wgid % nig) / gsz; return true;
    }
};

template <class Epi, bool ALIGN_EPI>
__device__ __forceinline__ void gemm_phase(LAS unsigned char* lds, const Gemm g, const StaticOrder& S, const Epi& E) {
    int tid = threadIdx.x; asm volatile("" : "+v"(tid));
    const int wid = __builtin_amdgcn_readfirstlane(tid >> 6), lane = tid & 63, wr = wid >> 2, wc = wid & 3, fr = lane & 15, fq = lane >> 4;
    const int K = g.K, nt = K / BK;
    unsigned voffA[2], voffB[2];
#pragma unroll
    for (int i = 0; i < 2; ++i) { int R, C; stage_rc(tid * 16 + i * 8192, R, C); const int Rb = Epi::PERM ? ((R & ~31) + perm32(R & 31)) : R;
        voffA[i] = (unsigned)(R * g.lda + C) * 2u; voffB[i] = (unsigned)(Rb * g.ldb + C) * 2u; }
    const size_t kstep = (size_t)(BK * 2);
    const size_t hstepA = (size_t)HALF * g.lda * 2, hstepB = (size_t)HALF * g.ldb * 2;
    const unsigned ldsw = (unsigned)wid * 1024u;
    const int aoff = lds_byte(wr * 64 + fr, fq * 8), boff = lds_byte(wc * 32 + fr, fq * 8);
#define PG8_SA(b, h) (((b) * 2 + (h)) * HTB)
#define PG8_SB(b, h) ((4 + (b) * 2 + (h)) * HTB)
#define PG8_STAGE(bufoff, gbase, voff) do { _Pragma("unroll") for (int _i = 0; _i < 2; ++_i) \
        __builtin_amdgcn_global_load_lds((const unsigned*)((const char*)(gbase) + (voff)[_i]), (LAS unsigned*)(lds + (bufoff) + ldsw + _i * 8192), 16, 0, 0); } while (0)
#define PG8_LDA(dst, b, h) do { _Pragma("unroll") for (int m = 0; m < 4; ++m) _Pragma("unroll") for (int k = 0; k < 2; ++k) dst[m][k] = *(const LAS bf16x8*)(lds + PG8_SA(b, h) + aoff + m * 2048 + k * 1024); } while (0)
#define PG8_LDB(dst, b, h) do { _Pragma("unroll") for (int n = 0; n < 2; ++n) _Pragma("unroll") for (int k = 0; k < 2; ++k) dst[n][k] = *(const LAS bf16x8*)(lds + PG8_SB(b, h) + boff + n * 2048 + k * 1024); } while (0)
#define PG8_MMA(ai, bj, At, Bt) do { __builtin_amdgcn_s_setprio(1); _Pragma("unroll") for (int m = 0; m < 4; ++m) _Pragma("unroll") for (int n = 0; n < 2; ++n) _Pragma("unroll") for (int k = 0; k < 2; ++k) \
        acc[ai][bj][m][n] = __builtin_amdgcn_mfma_f32_16x16x32_bf16(Bt[n][k], At[m][k], acc[ai][bj][m][n], 0, 0, 0); __builtin_amdgcn_s_setprio(0); } while (0)
#define PG8_WAIT_V(n) asm volatile("s_waitcnt vmcnt(" #n ")" ::: "memory")
#define PG8_WAIT_L(n) asm volatile("s_waitcnt lgkmcnt(" #n ")" ::: "memory")
#define PG8_BAR __builtin_amdgcn_s_barrier()
#define PG8_SCHED __builtin_amdgcn_sched_barrier(0)
#define PG8_ABASE(u) ((const char*)g.A + ((size_t)(u).pm * BM * g.lda + (size_t)((u).pn >> g.a_shift) * g.a_mul) * 2)
#define PG8_BBASE(u) ((const char*)g.Bt + (size_t)(u).pn * BM * g.ldb * 2)
    Unit cur, nxt; int ui = 0;
    if (!S.next(0, cur)) return;
    f32x4 acc[2][2][4][2];
#pragma unroll
    for (int a = 0; a < 2; ++a)
#pragma unroll
        for (int b = 0; b < 2; ++b)
#pragma unroll
            for (int m = 0; m < 4; ++m)
#pragma unroll
                for (int n = 0; n < 2; ++n) acc[a][b][m][n] = (f32x4){0.f, 0.f, 0.f, 0.f};
    bf16x8 At[4][2], B0[2][2], B1[2][2];
    const char* cA = PG8_ABASE(cur); const char* cB = PG8_BBASE(cur);
    PG8_STAGE(PG8_SB(0, 0), cB, voffB); PG8_STAGE(PG8_SB(0, 1), cB + hstepB, voffB); PG8_STAGE(PG8_SA(0, 0), cA, voffA); PG8_STAGE(PG8_SA(0, 1), cA + hstepA, voffA);
    if (wr == 1) PG8_BAR;
    PG8_WAIT_V(2); PG8_BAR;
    PG8_STAGE(PG8_SB(1, 0), cB + kstep, voffB); PG8_STAGE(PG8_SA(1, 0), cA + kstep, voffA); PG8_STAGE(PG8_SB(1, 1), cB + hstepB + kstep, voffB);
    PG8_WAIT_V(6); PG8_BAR;
    for (;;) {
        const bool has_next = S.next(ui + 1, nxt);
        const char* nA = has_next ? PG8_ABASE(nxt) : cA; const char* nB = has_next ? PG8_BBASE(nxt) : cB;
        for (int t = 0; t < nt; t += 2) {
            const bool last = (t == nt - 2);
            const char* a1 = cA + (size_t)(t + 1) * kstep;
            const char* a2 = last ? nA : cA + (size_t)(t + 2) * kstep; const char* b2 = last ? nB : cB + (size_t)(t + 2) * kstep;
            const char* a3 = a2 + kstep; const char* b3 = b2 + kstep;
            PG8_LDB(B0, 0, 0); PG8_LDB(B1, 0, 1); PG8_SCHED; PG8_LDA(At, 0, 0); PG8_STAGE(PG8_SA(1, 1), a1 + hstepA, voffA);
            PG8_WAIT_V(8); PG8_WAIT_L(0); PG8_BAR; PG8_MMA(0, 0, At, B0); PG8_MMA(0, 1, At, B1); PG8_BAR; PG8_SCHED;
            PG8_LDA(At, 0, 1); PG8_STAGE(PG8_SB(0, 0), b2, voffB); PG8_STAGE(PG8_SB(0, 1), b2 + hstepB, voffB); PG8_STAGE(PG8_SA(0, 0), a2, voffA);
            PG8_WAIT_V(8); PG8_WAIT_L(0); PG8_BAR; PG8_MMA(1, 0, At, B0); PG8_MMA(1, 1, At, B1); PG8_BAR; PG8_SCHED;
            PG8_LDB(B0, 1, 0); PG8_LDB(B1, 1, 1); PG8_SCHED; PG8_LDA(At, 1, 0); PG8_STAGE(PG8_SA(0, 1), a2 + hstepA, voffA);
            PG8_WAIT_V(8); PG8_WAIT_L(0); PG8_BAR; PG8_MMA(0, 0, At, B0); PG8_MMA(0, 1, At, B1); PG8_BAR; PG8_SCHED;
            PG8_LDA(At, 1, 1); PG8_STAGE(PG8_SB(1, 0), b3, voffB); PG8_STAGE(PG8_SB(1, 1), b3 + hstepB, voffB); PG8_STAGE(PG8_SA(1, 0), a3, voffA);
            PG8_WAIT_V(8); PG8_WAIT_L(0); PG8_BAR; PG8_MMA(1, 0, At, B0); PG8_MMA(1, 1, At, B1); PG8_BAR; PG8_SCHED;
        }
        if constexpr (ALIGN_EPI) { if (wr == 0) PG8_BAR; }
        E(acc, cur, wr, wc, fr, fq);
        if (!has_next) break;
#pragma unroll
        for (int a = 0; a < 2; ++a)
#pragma unroll
            for (int b = 0; b < 2; ++b)
#pragma unroll
                for (int m = 0; m < 4; ++m)
#pragma unroll
                    for (int n = 0; n < 2; ++n) acc[a][b][m][n] = (f32x4){0.f, 0.f, 0.f, 0.f};
        cur = nxt; cA = nA; cB = nB; ++ui;
        if constexpr (ALIGN_EPI) { if (wr == 1) PG8_BAR; }
    }
    PG8_WAIT_V(0);
    if constexpr (!ALIGN_EPI) { if (wr == 0) PG8_BAR; }
    PG8_BAR;
#undef PG8_SA
#undef PG8_SB
#undef PG8_STAGE
#undef PG8_LDA
#undef PG8_LDB
#undef PG8_MMA
#undef PG8_WAIT_V
#undef PG8_WAIT_L
#undef PG8_BAR
#undef PG8_SCHED
#undef PG8_ABASE
#undef PG8_BBASE
}

template <bool NORM> struct EpiBf16Plain {
    static constexpr bool PERM = true;
    bf16_t* O; int ldc; const float* shw; int shw_stride; const unsigned long long* SS;
    __device__ __forceinline__ void operator()(const f32x4 (&acc)[2][2][4][2], const Unit& u, int wr, int wc, int fr, int fq) const {
        const int row0 = u.pm * BM + wr * 64 + fr, col0 = u.pn * BM + wc * 32 + 8 * fq;
        f32x4 bv[2][2];
#pragma unroll
        for (int bj = 0; bj < 2; ++bj)
#pragma unroll
            for (int n = 0; n < 2; ++n) bv[bj][n] = NORM ? *(const f32x4*)(shw + (size_t)(u.pm >> 3) * shw_stride + col0 + bj * HALF + 4 * n) : (f32x4){0.f, 0.f, 0.f, 0.f};
#pragma unroll
        for (int ai = 0; ai < 2; ++ai)
#pragma unroll
            for (int m = 0; m < 4; ++m) { const int row = row0 + ai * HALF + m * 16; bf16_t* rowp = O + (size_t)row * ldc + col0;
                float rs = 1.0f; if (NORM) rs = 1.0f / sqrtf((float)SS[row] * (1.0f / (16777216.0f * D)) + EPS);
#pragma unroll
                for (int bj = 0; bj < 2; ++bj) { const f32x4 v0 = acc[ai][bj][m][0] * rs + bv[bj][0], v1 = acc[ai][bj][m][1] * rs + bv[bj][1];
                    u32x4 w; w.x = cvt_pk_bf16(v0[0], v0[1]); w.y = cvt_pk_bf16(v0[2], v0[3]); w.z = cvt_pk_bf16(v1[0], v1[1]); w.w = cvt_pk_bf16(v1[2], v1[3]);
                    *(u32x4*)(rowp + bj * HALF) = w; } }
    }
};
struct EpiInA {
    static constexpr bool PERM = true;
    bf16_t* Q; bf16_t* CKV; bf16_t* QI; bf16_t* KIN; float* WI; const float* kg; const float* kb; const float* shw; const unsigned long long* SS;
    __device__ __forceinline__ void operator()(f32x4 (&acc)[2][2][4][2], const Unit& u, int wr, int wc, int fr, int fq) const {
        const int row0 = u.pm * BM + wr * 64 + fr, cl = wc * 32 + 8 * fq;
        {
            const float* sp = shw + (size_t)(u.pm >> 3) * 2048 + u.pn * BM + cl;
            f32x4 bv[2][2];
#pragma unroll
            for (int bj = 0; bj < 2; ++bj)
#pragma unroll
                for (int n = 0; n < 2; ++n) bv[bj][n] = *(const f32x4*)(sp + bj * HALF + 4 * n);
#pragma unroll
            for (int ai = 0; ai < 2; ++ai)
#pragma unroll
                for (int m = 0; m < 4; ++m) { const float rs = 1.0f / sqrtf((float)SS[row0 + ai * HALF + m * 16] * (1.0f / (16777216.0f * D)) + EPS);
#pragma unroll
                    for (int bj = 0; bj < 2; ++bj)
#pragma unroll
                        for (int n = 0; n < 2; ++n) acc[ai][bj][m][n] = acc[ai][bj][m][n] * rs + bv[bj][n]; }
        }
        if (u.pn < 7) {
            bf16_t* base; int ldc, c0;
            if (u.pn < 4) { base = Q; ldc = 1024; c0 = u.pn * 256; } else if (u.pn == 4) { base = CKV; ldc = 256; c0 = 0; } else { base = QI; ldc = 512; c0 = (u.pn - 5) * 256; }
#pragma unroll
            for (int ai = 0; ai < 2; ++ai)
#pragma unroll
                for (int m = 0; m < 4; ++m) { bf16_t* rowp = base + (size_t)(row0 + ai * HALF + m * 16) * ldc + c0 + cl;
#pragma unroll
                    for (int bj = 0; bj < 2; ++bj) { const f32x4 v0 = acc[ai][bj][m][0], v1 = acc[ai][bj][m][1];
                        u32x4 w; w.x = cvt_pk_bf16(v0[0], v0[1]); w.y = cvt_pk_bf16(v0[2], v0[3]); w.z = cvt_pk_bf16(v1[0], v1[1]); w.w = cvt_pk_bf16(v1[2], v1[3]);
                        *(u32x4*)(rowp + bj * HALF) = w; } }
        } else if (wc == 0) {
            f32x4 gv[2][2], bv[2][2];
#pragma unroll
            for (int bj = 0; bj < 2; ++bj)
#pragma unroll
                for (int n = 0; n < 2; ++n) { gv[bj][n] = *(const f32x4*)(kg + 32 * bj + 8 * fq + 4 * n); bv[bj][n] = *(const f32x4*)(kb + 32 * bj + 8 * fq + 4 * n); }
#pragma unroll
            for (int ai = 0; ai < 2; ++ai)
#pragma unroll
                for (int m = 0; m < 4; ++m) {
                    float s = 0.f;
#pragma unroll
                    for (int bj = 0; bj < 2; ++bj)
#pragma unroll
                        for (int n = 0; n < 2; ++n) { const f32x4 x = acc[ai][bj][m][n]; s += (x[0] + x[1]) + (x[2] + x[3]); }
                    s += __shfl_xor(s, 16); s += __shfl_xor(s, 32);
                    const float mu = s * (1.0f / 64.0f); float q = 0.f;
#pragma unroll
                    for (int bj = 0; bj < 2; ++bj)
#pragma unroll
                        for (int n = 0; n < 2; ++n) { const f32x4 d = acc[ai][bj][m][n] - mu; q += (d[0] * d[0] + d[1] * d[1]) + (d[2] * d[2] + d[3] * d[3]); }
                    q += __shfl_xor(q, 16); q += __shfl_xor(q, 32);
                    const float rs = 1.0f / sqrtf(q * (1.0f / 64.0f) + EPS);
                    bf16_t* rowp = KIN + (size_t)(row0 + ai * HALF + m * 16) * 64 + 8 * fq;
#pragma unroll
                    for (int bj = 0; bj < 2; ++bj) { const f32x4 v0 = (acc[ai][bj][m][0] - mu) * rs * gv[bj][0] + bv[bj][0], v1 = (acc[ai][bj][m][1] - mu) * rs * gv[bj][1] + bv[bj][1];
                        u32x4 w; w.x = cvt_pk_bf16(v0[0], v0[1]); w.y = cvt_pk_bf16(v0[2], v0[3]); w.z = cvt_pk_bf16(v1[0], v1[1]); w.w = cvt_pk_bf16(v1[2], v1[3]);
                        *(u32x4*)(rowp + bj * 32) = w; }
                }
        } else if (wc == 1 && fq == 0) {
            const float sc = 0.04419417382415922f;
#pragma unroll
            for (int ai = 0; ai < 2; ++ai)
#pragma unroll
                for (int m = 0; m < 4; ++m) { float* rowp = WI + (size_t)(row0 + ai * HALF + m * 16) * 8;
                    *(f32x4*)(rowp) = acc[ai][0][m][0] * sc; *(f32x4*)(rowp + 4) = acc[ai][0][m][1] * sc; }
        }
    }
};
struct EpiResid {
    static constexpr bool PERM = true;
    const bf16_t* xin_b; bf16_t* xout_b;
    const float* gate; const float* bias;
    bf16_t* XG; const float* gn; const float* scn; unsigned long long* SSo;
    __device__ __forceinline__ void operator()(const f32x4 (&acc)[2][2][4][2], const Unit& u, int wr, int wc, int fr, int fq) const {
        const int row0 = u.pm * BM + wr * 64 + fr, col0 = u.pn * BM + wc * 32 + 8 * fq, b = u.pm >> 3;
        float ssum[2][4];
#pragma unroll
        for (int ai = 0; ai < 2; ++ai)
#pragma unroll
            for (int m = 0; m < 4; ++m) ssum[ai][m] = 0.f;
#pragma unroll
        for (int bj = 0; bj < 2; ++bj) {
            const int c = col0 + bj * HALF;
            const f32x4 gv0 = *(const f32x4*)(gate + (size_t)b * 6144 + c), gv1 = *(const f32x4*)(gate + (size_t)b * 6144 + c + 4);
            f32x4 bv0 = (f32x4){0.f, 0.f, 0.f, 0.f}, bv1 = bv0, gm0 = bv0, gm1 = bv0;
            if (bias) { bv0 = *(const f32x4*)(bias + c); bv1 = *(const f32x4*)(bias + c + 4); }
            if (XG) { gm0 = *(const f32x4*)(gn + c) * (*(const f32x4*)(scn + (size_t)b * 6144 + c) + 1.0f); gm1 = *(const f32x4*)(gn + c + 4) * (*(const f32x4*)(scn + (size_t)b * 6144 + c + 4) + 1.0f); }
#pragma unroll
            for (int ai = 0; ai < 2; ++ai)
#pragma unroll
                for (int m = 0; m < 4; ++m) { const size_t off = (size_t)(row0 + ai * HALF + m * 16) * D + c;
                    const u32x4 xv = *(const u32x4*)(xin_b + off);
                    const f32x4 xi0 = (f32x4){__uint_as_float(xv.x << 16), __uint_as_float(xv.x & 0xffff0000u), __uint_as_float(xv.y << 16), __uint_as_float(xv.y & 0xffff0000u)};
                    const f32x4 xi1 = (f32x4){__uint_as_float(xv.z << 16), __uint_as_float(xv.z & 0xffff0000u), __uint_as_float(xv.w << 16), __uint_as_float(xv.w & 0xffff0000u)};
                    const f32x4 xo0 = xi0 + gv0 * (acc[ai][bj][m][0] + bv0), xo1 = xi1 + gv1 * (acc[ai][bj][m][1] + bv1);
                    { u32x4 w; w.x = cvt_pk_bf16(xo0[0], xo0[1]); w.y = cvt_pk_bf16(xo0[2], xo0[3]); w.z = cvt_pk_bf16(xo1[0], xo1[1]); w.w = cvt_pk_bf16(xo1[2], xo1[3]); *(u32x4*)(xout_b + off) = w; }
                    if (XG) {
                        ssum[ai][m] += ((xo0[0] * xo0[0] + xo0[1] * xo0[1]) + (xo0[2] * xo0[2] + xo0[3] * xo0[3])) + ((xo1[0] * xo1[0] + xo1[1] * xo1[1]) + (xo1[2] * xo1[2] + xo1[3] * xo1[3]));
                        const f32x4 y0 = xo0 * gm0, y1 = xo1 * gm1;
                        u32x4 w; w.x = cvt_pk_bf16(y0[0], y0[1]); w.y = cvt_pk_bf16(y0[2], y0[3]); w.z = cvt_pk_bf16(y1[0], y1[1]); w.w = cvt_pk_bf16(y1[2], y1[3]);
                        *(u32x4*)(XG + off) = w; }
                    if (m & 1) asm volatile("" ::: "memory"); }
        }
        if (XG) {
#pragma unroll
            for (int ai = 0; ai < 2; ++ai)
#pragma unroll
                for (int m = 0; m < 4; ++m) { float q = ssum[ai][m]; q += __shfl_xor(q, 16); q += __shfl_xor(q, 32);
                    if (fq == 0) atomicAdd(SSo + row0 + ai * HALF + m * 16, (unsigned long long)(q * 16777216.0f)); }
        }
    }
};
struct EpiSwiGLU {
    static constexpr bool PERM = true;
    bf16_t* H; const float* shw; const unsigned long long* SS;
    __device__ __forceinline__ void operator()(const f32x4 (&acc)[2][2][4][2], const Unit& u, int wr, int wc, int fr, int fq) const {
        const int row0 = u.pm * BM + wr * 64 + fr, f0 = u.pn * 128 + wc * 32 + 8 * fq;
        f32x4 bv[2][2];
        { const float* sp = shw + (size_t)(u.pm >> 3) * (2 * DFF) + u.pn * BM + wc * 32 + 8 * fq;
#pragma unroll
          for (int bj = 0; bj < 2; ++bj)
#pragma unroll
              for (int n = 0; n < 2; ++n) bv[bj][n] = *(const f32x4*)(sp + bj * HALF + 4 * n); }
#pragma unroll
        for (int ai = 0; ai < 2; ++ai)
#pragma unroll
            for (int m = 0; m < 4; ++m) { bf16_t* rowp = H + (size_t)(row0 + ai * HALF + m * 16) * DFF + f0;
                const float rs = 1.0f / sqrtf((float)SS[row0 + ai * HALF + m * 16] * (1.0f / (16777216.0f * D)) + EPS);
                float o[8];
#pragma unroll
                for (int n = 0; n < 2; ++n)
#pragma unroll
                    for (int e = 0; e < 4; ++e) o[4 * n + e] = silu_f(acc[ai][0][m][n][e] * rs + bv[0][n][e]) * (acc[ai][1][m][n][e] * rs + bv[1][n][e]);
                u32x4 w; w.x = cvt_pk_bf16(o[0], o[1]); w.y = cvt_pk_bf16(o[2], o[3]); w.z = cvt_pk_bf16(o[4], o[5]); w.w = cvt_pk_bf16(o[6], o[7]);
                *(u32x4*)(rowp) = w; }
    }
};
}

struct Ptrs {
    const float* in[23]; float* out; unsigned char* ws;
};
enum { I_X = 0, I_C, I_RELB, I_WADA, I_BADA, I_GMIX, I_GFFN, I_AWIN, I_AKVG, I_AWUK, I_AWUV, I_AIKG, I_AIKB, I_AWOUT, I_BWIN, I_BBIN, I_BSINK, I_BWOUT, I_BBOUT, I_W1, I_W3, I_W2, I_GFIN };

__device__ __forceinline__ void conv_task(const Ptrs& P, int t, int lane) {
    int kind, rb, ks, Kd; bf16_t* dst; const float* s0 = nullptr; const float* s1 = nullptr; const float* gk = nullptr; int ld = 0;
    if (t < 2112) { const int l = t / 528, r = t % 528; unsigned char* wl = P.ws + WS_W + (size_t)l * W_LAYER;
        if (r < 352) { kind = 1; rb = r >> 2; ks = r & 3; Kd = 1024; dst = (bf16_t*)(wl + W13_OFF); s0 = P.in[I_W1] + (size_t)l * D * DFF; s1 = P.in[I_W3] + (size_t)l * D * DFF; ld = DFF; }
        else { const int r2 = r - 352; kind = 0; rb = r2 / 11; ks = r2 % 11; Kd = DFF; dst = (bf16_t*)(wl + W2_OFF); s0 = P.in[I_W2] + (size_t)l * DFF * D; ld = D; }
    } else { const int t2 = t - 2112, j = t2 / 464, r = t2 % 464; unsigned char* wa = P.ws + WS_WA + (size_t)j * WA_STRIDE; unsigned char* wb = P.ws + WS_WB + (size_t)j * WB_STRIDE;
        if (r < 128) { kind = 2; rb = r >> 2; ks = r & 3; Kd = 1024; dst = (bf16_t*)(wa + WINA_OFF); s0 = P.in[I_AWIN] + (size_t)j * D * A_IN; ld = A_IN; }
        else if (r < 192) { kind = 3; rb = r - 128; ks = 0; Kd = 256; dst = (bf16_t*)(wa + WQA_OFF); s0 = P.in[I_AWUK] + (size_t)j * NH * RK * HD; gk = P.in[I_AKVG] + j * RK; }
        else if (r < 256) { const int r2 = r - 192; kind = 4; rb = r2 >> 2; ks = r2 & 3; Kd = 1024; dst = (bf16_t*)(wa + WUV_OFF); s0 = P.in[I_AWUV] + (size_t)j * NH * RK * HD; gk = P.in[I_AKVG] + j * RK; }
        else if (r < 320) { const int r2 = r - 256; kind = 0; rb = r2 >> 2; ks = r2 & 3; Kd = 1024; dst = (bf16_t*)(wa + WOUTA_OFF); s0 = P.in[I_AWOUT] + (size_t)j * D * D; ld = D; }
        else if (r < 400) { const int r2 = r - 320; kind = 0; rb = r2 >> 2; ks = r2 & 3; Kd = 1024; dst = (bf16_t*)(wb + WINB_OFF); s0 = P.in[I_BWIN] + (size_t)j * D * B_IN; ld = B_IN; }
        else { const int r2 = r - 400; kind = 0; rb = r2 >> 2; ks = r2 & 3; Kd = 1024; dst = (bf16_t*)(wb + WOUTB_OFF); s0 = P.in[I_BWOUT] + (size_t)j * D * D; ld = D; }
    }
    const int n = rb * 64 + lane, k0 = ks * 256;
    bf16_t* drow = dst + (size_t)n * Kd + k0;
    if (kind <= 2) {
        const float* src = s0; int col = n;
        if (kind == 1) { const int c = n & 255, f = (n >> 8) * 128 + (c & 127); src = (c < 128) ? s0 : s1; col = f; }
        if (kind == 2) { if (n >= 1792) { const int c = n - 1792; col = c < 32 ? 1792 + c : (c < 40 ? 1856 + (c - 32) : ((c >= 128 && c < 160) ? 1824 + (c - 128) : -1)); } }
        const float* sp = src + (size_t)k0 * ld + (col < 0 ? 0 : col);
        for (int kc = 0; kc < 32; ++kc) {
            float v[8];
#pragma unroll
            for (int e = 0; e < 8; ++e) v[e] = sp[(size_t)(kc * 8 + e) * ld];
            if (col < 0) {
#pragma unroll
                for (int e = 0; e < 8; ++e) v[e] = 0.f; }
            u32x4 w; w.x = cvt_pk_bf16(v[0], v[1]); w.y = cvt_pk_bf16(v[2], v[3]); w.z = cvt_pk_bf16(v[4], v[5]); w.w = cvt_pk_bf16(v[6], v[7]);
            *(u32x4*)(drow + kc * 8) = w;
        }
    } else if (kind == 3) {
        const int h = n >> 8, r = n & 255; const float gs = gk[r] * 0.125f; const float* sp = s0 + ((size_t)h * RK + r) * HD;
        for (int kc = 0; kc < 32; ++kc) { const int k = kc * 8; float v[8];
            if ((k >> 6) == (h & 3)) {
#pragma unroll
                for (int e = 0; e < 8; ++e) v[e] = sp[(k & 63) + e] * gs;
            } else {
#pragma unroll
                for (int e = 0; e < 8; ++e) v[e] = 0.f; }
            u32x4 w; w.x = cvt_pk_bf16(v[0], v[1]); w.y = cvt_pk_bf16(v[2], v[3]); w.z = cvt_pk_bf16(v[4], v[5]); w.w = cvt_pk_bf16(v[6], v[7]);
            *(u32x4*)(drow + kc * 8) = w; }
    } else {
        const int hh = (n >> 6) & 3, d = n & 63, h = n >> 6;
        for (int kc = 0; kc < 32; ++kc) { const int k = k0 + kc * 8; float v[8];
            if ((k >> 8) == hh) {
#pragma unroll
                for (int e = 0; e < 8; ++e) { const int r = (k & 255) + e; v[e] = s0[((size_t)h * RK + r) * HD + d] * gk[r]; }
            } else {
#pragma unroll
                for (int e = 0; e < 8; ++e) v[e] = 0.f; }
            u32x4 w; w.x = cvt_pk_bf16(v[0], v[1]); w.y = cvt_pk_bf16(v[2], v[3]); w.z = cvt_pk_bf16(v[4], v[5]); w.w = cvt_pk_bf16(v[6], v[7]);
            *(u32x4*)(drow + kc * 8) = w; }
    }
}
constexpr int N_CONV_TASKS = 3040;

__device__ __forceinline__ void p0_prologue(const Ptrs& P, LAS unsigned char* lds, int G) {
    int tid = threadIdx.x; asm volatile("" : "+v"(tid));
    const int lane = tid & 63, wave = __builtin_amdgcn_readfirstlane(tid >> 6);
    const int gw = blockIdx.x * NWAVES + wave, NGW = G * NWAVES;
    for (int t = gw; t < N_CONV_TASKS; t += NGW) conv_task(P, t, lane);
    LAS float* cs = (LAS float*)lds;
    LAS float* red = (LAS float*)(lds + 65536);
    for (int i = tid; i < BATCH * D; i += NTHR) { const int b = i >> 10, k = i & 1023; cs[k * 16 + b] = silu_f(P.in[I_C][i]); }
    __syncthreads();
    float* mod = (float*)(P.ws + WS_MOD);
    for (int task = blockIdx.x; task < 4 * 96; task += G) {
        const int l = task / 96, j0 = (task % 96) * 64, col = tid & 63, ksl = tid >> 6;
        const float* wp = P.in[I_WADA] + ((size_t)l * D + ksl * 128) * 6144 + j0 + col;
        float a[16];
#pragma unroll
        for (int b = 0; b < 16; ++b) a[b] = 0.f;
        for (int k = 0; k < 128; ++k) { const float w = wp[(size_t)k * 6144]; const LAS f32x4* c4 = (const LAS f32x4*)(cs + (ksl * 128 + k) * 16);
#pragma unroll
            for (int q = 0; q < 4; ++q) { const f32x4 c = c4[q];
#pragma unroll
                for (int e = 0; e < 4; ++e) a[4 * q + e] += w * c[e]; } }
#pragma unroll
        for (int b = 0; b < 16; ++b) red[(ksl * 64 + col) * 16 + b] = a[b];
        __syncthreads();
        for (int o = tid; o < 1024; o += NTHR) { const int c2 = o >> 4, b = o & 15; float s = 0.f;
#pragma unroll
            for (int q = 0; q < 8; ++q) s += red[(q * 64 + c2) * 16 + b];
            mod[((size_t)l * BATCH + b) * 6144 + j0 + c2] = s + P.in[I_BADA][l * 6144 + j0 + c2]; }
        __syncthreads();
    }
}

__device__ __forceinline__ void pre_phase(const Ptrs& P, LAS unsigned char* lds, int G) {
    int tid = threadIdx.x; asm volatile("" : "+v"(tid));
    const int lane = tid & 63, wave = __builtin_amdgcn_readfirstlane(tid >> 6);
    const float* mod = (const float*)(P.ws + WS_MOD);
    {
        const int grp = blockIdx.x & 7, l = grp >> 1, kind = grp & 1, j = l >> 1;
        const float* shsrc = mod + (size_t)l * BATCH * 6144 + (kind ? 3072 : 0);
        constexpr int SP = 2064;
        for (int i = tid; i < BATCH * D / 2; i += NTHR) { const int b = i >> 9, k2 = (i & 511) * 2;
            const float a0 = shsrc[(size_t)b * 6144 + k2], a1 = shsrc[(size_t)b * 6144 + k2 + 1];
            *(LAS unsigned*)(lds + b * SP + k2 * 2) = cvt_pk_bf16(a0, a1); }
        __syncthreads();
        const bf16_t* W; int nrows; float* dst; const float* bias = nullptr;
        if (kind) { W = (const bf16_t*)(P.ws + WS_W + (size_t)l * W_LAYER + W13_OFF); nrows = 2 * DFF; dst = (float*)(P.ws + WS_SHW + SHW_F) + (size_t)l * BATCH * 2 * DFF; }
        else if ((l & 1) == 0) { W = (const bf16_t*)(P.ws + WS_WA + (size_t)j * WA_STRIDE + WINA_OFF); nrows = 2048; dst = (float*)(P.ws + WS_SHW + SHW_A) + (size_t)j * BATCH * 2048; }
        else { W = (const bf16_t*)(P.ws + WS_WB + (size_t)j * WB_STRIDE + WINB_OFF); nrows = B_IN; dst = (float*)(P.ws + WS_SHW + SHW_B) + (size_t)j * BATCH * B_IN; bias = P.in[I_BBIN] + j * B_IN; }
        const int nblk = nrows >> 4, wq = (blockIdx.x >> 3) * NWAVES + wave, nwq = (G >> 3) * NWAVES;
        const int nn = lane & 15, g = lane >> 4;
        for (int blk = wq; blk < nblk; blk += nwq) {
            f32x4 acc = (f32x4){0.f, 0.f, 0.f, 0.f};
            const bf16_t* wp = W + (size_t)(blk * 16 + nn) * D + 8 * g;
#pragma unroll 8
            for (int ks = 0; ks < 32; ++ks) { const bf16x8 a = *(const LAS bf16x8*)(lds + nn * SP + (32 * ks + 8 * g) * 2); const bf16x8 bw = *(const bf16x8*)(wp + 32 * ks);
                acc = __builtin_amdgcn_mfma_f32_16x16x32_bf16(a, bw, acc, 0, 0, 0); }
            const int n = blk * 16 + nn; const float bb = bias ? bias[n] : 0.f;
#pragma unroll
            for (int i = 0; i < 4; ++i) dst[(size_t)(4 * g + i) * nrows + n] = acc[i] + bb;
        }
    }
    {
        const int gw = blockIdx.x * NWAVES + wave, NGW = G * NWAVES;
        const float* x = P.in[I_X]; const float* gmix = P.in[I_GMIX]; bf16_t* XG = (bf16_t*)(P.ws + WS_XG); unsigned long long* SS0 = (unsigned long long*)(P.ws + WS_SS);
        for (int row = gw; row < M; row += NGW) {
            const int b = row >> 11;
            const f32x4* xr = (const f32x4*)(x + (size_t)row * D) + lane;
            f32x4 v[4]; float sq = 0.f;
#pragma unroll
            for (int jj = 0; jj < 4; ++jj) { v[jj] = xr[64 * jj]; sq += (v[jj][0] * v[jj][0] + v[jj][1] * v[jj][1]) + (v[jj][2] * v[jj][2] + v[jj][3] * v[jj][3]); }
            const float ss = wave_sum(sq);
            if (lane == 0) SS0[row] = (unsigned long long)(ss * 16777216.0f);
            const float* mb = mod + (size_t)b * 6144;
            u32x2* o8 = (u32x2*)(XG + (size_t)row * D) + lane; u32x2* x8 = (u32x2*)((bf16_t*)P.out + (size_t)row * D) + lane;
#pragma unroll
            for (int jj = 0; jj < 4; ++jj) { const int c = 4 * lane + 256 * jj;
                const f32x4 y = v[jj] * *(const f32x4*)(gmix + c) * (*(const f32x4*)(mb + 1024 + c) + 1.0f);
                u32x2 w; w.x = cvt_pk_bf16(y[0], y[1]); w.y = cvt_pk_bf16(y[2], y[3]); o8[64 * jj] = w;
                u32x2 xw; xw.x = cvt_pk_bf16(v[jj][0], v[jj][1]); xw.y = cvt_pk_bf16(v[jj][2], v[jj][3]); x8[64 * jj] = xw; }
        }
    }
}
__device__ __forceinline__ void final_norm_phase(const bf16_t* x, float* out, const float* g, int G) {
    int tid = threadIdx.x; asm volatile("" : "+v"(tid));
    const int lane = tid & 63, wave = __builtin_amdgcn_readfirstlane(tid >> 6);
    const int gw = blockIdx.x * NWAVES + wave, NGW = G * NWAVES;
    for (int row = gw; row < M; row += NGW) {
        const u32x2* xr = (const u32x2*)(x + (size_t)row * D) + lane; f32x4* orow = (f32x4*)(out + (size_t)row * D) + lane;
        f32x4 v[4]; float s = 0.f;
#pragma unroll
        for (int j = 0; j < 4; ++j) { const u32x2 p = xr[64 * j];
            v[j] = (f32x4){__uint_as_float(p.x << 16), __uint_as_float(p.x & 0xffff0000u), __uint_as_float(p.y << 16), __uint_as_float(p.y & 0xffff0000u)};
            s += (v[j][0] * v[j][0] + v[j][1] * v[j][1]) + (v[j][2] * v[j][2] + v[j][3] * v[j][3]); }
        const float rstd = 1.0f / sqrtf(wave_sum(s) * (1.0f / D) + EPS);
#pragma unroll
        for (int j = 0; j < 4; ++j) { const f32x4 gg = *(const f32x4*)(g + 4 * lane + 256 * j); orow[64 * j] = v[j] * rstd * gg; }
    }
}

__device__ __forceinline__ unsigned f2key(float f) { const unsigned u = __float_as_uint(f); return (u & 0x80000000u) ? ~u : (u | 0x80000000u); }
__device__ __forceinline__ float key2f(unsigned k) { return __uint_as_float((k & 0x80000000u) ? (k & 0x7fffffffu) : ~k); }
__device__ __forceinline__ float half_max(float x) {
    int u = __float_as_int(x);
    u = __float_as_int(fmaxf(__int_as_float(u), __int_as_float(__builtin_amdgcn_update_dpp(u, u, 0x128, 0xf, 0xf, false))));
    u = __float_as_int(fmaxf(__int_as_float(u), __int_as_float(__builtin_amdgcn_update_dpp(u, u, 0x124, 0xf, 0xf, false))));
    u = __float_as_int(fmaxf(__int_as_float(u), __int_as_float(__builtin_amdgcn_update_dpp(u, u, 0x122, 0xf, 0xf, false))));
    u = __float_as_int(fmaxf(__int_as_float(u), __int_as_float(__builtin_amdgcn_update_dpp(u, u, 0x121, 0xf, 0xf, false))));
    const u32x2 r = __builtin_amdgcn_permlane16_swap((unsigned)u, (unsigned)u, false, false);
    return fmaxf(__uint_as_float(r.x), __uint_as_float(r.y));
}
__device__ __forceinline__ int half_sum(int v) {
    v += __builtin_amdgcn_update_dpp(v, v, 0x128, 0xf, 0xf, false);
    v += __builtin_amdgcn_update_dpp(v, v, 0x124, 0xf, 0xf, false);
    v += __builtin_amdgcn_update_dpp(v, v, 0x122, 0xf, 0xf, false);
    v += __builtin_amdgcn_update_dpp(v, v, 0x121, 0xf, 0xf, false);
    const u32x2 r = __builtin_amdgcn_permlane16_swap((unsigned)v, (unsigned)v, false, false);
    return (int)(r.x + r.y);
}
__device__ __forceinline__ void idx_task(const bf16_t* QI, const bf16_t* KIN, const float* WI, unsigned* SEL, LAS unsigned char* lds, int b, int tg, int lane, int wave, bool active, int nrounds) {
    asm volatile("" : "+v"(lane));
    const int t0 = tg * 4, h = lane >> 5, r = lane & 31;
    const int qsel = 2 * (r >> 4) + ((r >> 2) & 1), hd = (r & 3) + 4 * ((r >> 3) & 1);
    const size_t rowb = (size_t)b * SEQ;
    bf16x8 aq[4];
#pragma unroll
    for (int ks = 0; ks < 4; ++ks) aq[ks] = *(const bf16x8*)(QI + (rowb + t0 + qsel) * 512 + hd * 64 + ks * 16 + h * 8);
    float wlo[8], whi[8];
    { const f32x4 a0 = *(const f32x4*)(WI + (rowb + t0 + h) * 8), a1 = *(const f32x4*)(WI + (rowb + t0 + h) * 8 + 4);
      const f32x4 b0 = *(const f32x4*)(WI + (rowb + t0 + 2 + h) * 8), b1 = *(const f32x4*)(WI + (rowb + t0 + 2 + h) * 8 + 4);
#pragma unroll
      for (int e = 0; e < 4; ++e) { wlo[e] = a0[e]; wlo[4 + e] = a1[e]; whi[e] = b0[e]; whi[4 + e] = b1[e]; } }
    float slo[64], shi[64];
#pragma unroll
    for (int kt = 0; kt < 64; ++kt) { slo[kt] = NEGF; shi[kt] = NEGF; }
    const int ktmax = (t0 + 3) >> 5, tlo = t0 + h, thi = t0 + 2 + h;
    const unsigned lb = (unsigned)(size_t)lds;
    const int sw = (r >> 1) & 7;
    unsigned a0 = lb + (unsigned)r * 128u + 16u * (unsigned)((0 + h) ^ sw), a1 = lb + (unsigned)r * 128u + 16u * (unsigned)((2 + h) ^ sw);
    unsigned a2 = lb + (unsigned)r * 128u + 16u * (unsigned)((4 + h) ^ sw), a3 = lb + (unsigned)r * 128u + 16u * (unsigned)((6 + h) ^ sw);
#define IDX_LDS4(OFS, R0, R1, R2, R3) asm volatile("ds_read_b128 %0, %4 offset:" #OFS "\n\tds_read_b128 %1, %5 offset:" #OFS "\n\tds_read_b128 %2, %6 offset:" #OFS "\n\tds_read_b128 %3, %7 offset:" #OFS \
                                                  : "=&v"(R0), "=&v"(R1), "=&v"(R2), "=&v"(R3) : "v"(a0), "v"(a1), "v"(a2), "v"(a3) : "memory")
#define IDX_TILE(KT, OFSN, C0, C1, C2, C3, N0, N1, N2, N3) \
        if ((KT) > ktmax) goto IDX_DONE_LABEL; \
        { \
            IDX_LDS4(OFSN, N0, N1, N2, N3);                    \
            asm volatile("s_waitcnt lgkmcnt(4)" : "+v"(C0), "+v"(C1), "+v"(C2), "+v"(C3) :: "memory");     \
            f32x16 acc; \
            _Pragma("unroll") for (int i = 0; i < 16; ++i) acc[i] = 0.f; \
            acc = __builtin_amdgcn_mfma_f32_32x32x16_bf16(aq[0], C0, acc, 0, 0, 0); acc = __builtin_amdgcn_mfma_f32_32x32x16_bf16(aq[1], C1, acc, 0, 0, 0); \
            acc = __builtin_amdgcn_mfma_f32_32x32x16_bf16(aq[2], C2, acc, 0, 0, 0); acc = __builtin_amdgcn_mfma_f32_32x32x16_bf16(aq[3], C3, acc, 0, 0, 0); \
            float s0 = 0.f, s1 = 0.f; \
            _Pragma("unroll") for (int i = 0; i < 8; ++i) { s0 += wlo[i] * __builtin_amdgcn_fmed3f(acc[i], 0.f, 3.0e38f); s1 += whi[i] * __builtin_amdgcn_fmed3f(acc[8 + i], 0.f, 3.0e38f); }     \
            const int key = (KT) * 32 + r; \
            const bool okA = key <= tlo, okB = key <= thi; \
            slo[KT] = okA ? s0 : NEGF; shi[KT] = okB ? s1 : NEGF; \
            asm volatile("" : "+v"(slo[KT]), "+v"(shi[KT]));     \
        }
#define IDX_QUARTER(K0) \
        IDX_TILE(K0 + 0, 4096, ta0, ta1, ta2, ta3, tb0, tb1, tb2, tb3)   IDX_TILE(K0 + 1, 8192, tb0, tb1, tb2, tb3, ta0, ta1, ta2, ta3) \
        IDX_TILE(K0 + 2, 12288, ta0, ta1, ta2, ta3, tb0, tb1, tb2, tb3)  IDX_TILE(K0 + 3, 16384, tb0, tb1, tb2, tb3, ta0, ta1, ta2, ta3) \
        IDX_TILE(K0 + 4, 20480, ta0, ta1, ta2, ta3, tb0, tb1, tb2, tb3)  IDX_TILE(K0 + 5, 24576, tb0, tb1, tb2, tb3, ta0, ta1, ta2, ta3) \
        IDX_TILE(K0 + 6, 28672, ta0, ta1, ta2, ta3, tb0, tb1, tb2, tb3)  IDX_TILE(K0 + 7, 32768, tb0, tb1, tb2, tb3, ta0, ta1, ta2, ta3) \
        IDX_TILE(K0 + 8, 36864, ta0, ta1, ta2, ta3, tb0, tb1, tb2, tb3)  IDX_TILE(K0 + 9, 40960, tb0, tb1, tb2, tb3, ta0, ta1, ta2, ta3) \
        IDX_TILE(K0 + 10, 45056, ta0, ta1, ta2, ta3, tb0, tb1, tb2, tb3) IDX_TILE(K0 + 11, 49152, tb0, tb1, tb2, tb3, ta0, ta1, ta2, ta3) \
        IDX_TILE(K0 + 12, 53248, ta0, ta1, ta2, ta3, tb0, tb1, tb2, tb3) IDX_TILE(K0 + 13, 57344, tb0, tb1, tb2, tb3, ta0, ta1, ta2, ta3) \
        IDX_TILE(K0 + 14, 61440, ta0, ta1, ta2, ta3, tb0, tb1, tb2, tb3) IDX_TILE(K0 + 15, 61440, tb0, tb1, tb2, tb3, ta0, ta1, ta2, ta3)
    bf16x8 ta0, ta1, ta2, ta3, tb0, tb1, tb2, tb3;
#pragma unroll
    for (int rnd = 0; rnd < 2; ++rnd) {
        if (rnd >= nrounds) break;
        __syncthreads();
        {
            const int rl = lane >> 3, pp = lane & 7;
#pragma unroll 4
            for (int j = 0; j < 16; ++j) { const int pi = wave * 16 + j, row = 8 * pi + rl;
                const bf16_t* src = KIN + (rowb + 1024 * rnd + row) * 64 + 8 * (pp ^ ((row >> 1) & 7));
                __builtin_amdgcn_global_load_lds((const unsigned*)src, (LAS unsigned*)(lds + 1024 * pi), 16, 0, 0); }
        }
        asm volatile("s_waitcnt vmcnt(0)" ::: "memory");
        __syncthreads();
        if (active) {
            if (rnd == 0) {
                IDX_LDS4(0, ta0, ta1, ta2, ta3);
#define IDX_DONE_LABEL idx_r0_done
                IDX_QUARTER(0)
                asm volatile("s_waitcnt lgkmcnt(0)" : "+v"(ta0), "+v"(ta1), "+v"(ta2), "+v"(ta3), "+v"(tb0), "+v"(tb1), "+v"(tb2), "+v"(tb3) :: "memory");
                a0 += 65536u; a1 += 65536u; a2 += 65536u; a3 += 65536u;
                IDX_LDS4(0, ta0, ta1, ta2, ta3);
                IDX_QUARTER(16)
idx_r0_done:
#undef IDX_DONE_LABEL
                asm volatile("s_waitcnt lgkmcnt(0)" : "+v"(ta0), "+v"(ta1), "+v"(ta2), "+v"(ta3), "+v"(tb0), "+v"(tb1), "+v"(tb2), "+v"(tb3) :: "memory");
            } else {
                a0 = lb + (unsigned)r * 128u + 16u * (unsigned)((0 + h) ^ sw); a1 = lb + (unsigned)r * 128u + 16u * (unsigned)((2 + h) ^ sw);
                a2 = lb + (unsigned)r * 128u + 16u * (unsigned)((4 + h) ^ sw); a3 = lb + (unsigned)r * 128u + 16u * (unsigned)((6 + h) ^ sw);
                IDX_LDS4(0, ta0, ta1, ta2, ta3);
#define IDX_DONE_LABEL idx_r1_done
                IDX_QUARTER(32)
                asm volatile("s_waitcnt lgkmcnt(0)" : "+v"(ta0), "+v"(ta1), "+v"(ta2), "+v"(ta3), "+v"(tb0), "+v"(tb1), "+v"(tb2), "+v"(tb3) :: "memory");
                a0 += 65536u; a1 += 65536u; a2 += 65536u; a3 += 65536u;
                IDX_LDS4(0, ta0, ta1, ta2, ta3);
                IDX_QUARTER(48)
idx_r1_done:
#undef IDX_DONE_LABEL
                asm volatile("s_waitcnt lgkmcnt(0)" : "+v"(ta0), "+v"(ta1), "+v"(ta2), "+v"(ta3), "+v"(tb0), "+v"(tb1), "+v"(tb2), "+v"(tb3) :: "memory");
            }
        }
    }
#undef IDX_QUARTER
#undef IDX_TILE
#undef IDX_LDS4
    if (!active) return;
    const int nblk = (ktmax >> 3) + 1;
    float mxA = NEGF, mxB = NEGF, mnA = -NEGF, mnB = -NEGF;
#pragma unroll
    for (int blk = 0; blk < 8; ++blk) {
        if (blk < nblk) {
#pragma unroll
            for (int e = 0; e < 8; ++e) { const float a = slo[8 * blk + e], bb = shi[8 * blk + e];
                mxA = fmaxf(mxA, a); mxB = fmaxf(mxB, bb); mnA = fminf(mnA, a > -1e29f ? a : -NEGF); mnB = fminf(mnB, bb > -1e29f ? bb : -NEGF); }
        }
    }
    mxA = half_max(mxA); mxB = half_max(mxB); mnA = -half_max(-mnA); mnB = -half_max(-mnB);
    const int Ka = tlo + 1 < TOPK ? tlo + 1 : TOPK, Kb = thi + 1 < TOPK ? thi + 1 : TOPK;
    float loA = mnA, hiA = mxA, loB = mnB, hiB = mxB;
    float cloA = (float)(tlo + 1), chiA = 1.0f, cloB = (float)(thi + 1), chiB = 1.0f;
    float TA = -1e29f, TB = -1e29f; bool doneA = (tlo + 1 <= TOPK), doneB = (thi + 1 <= TOPK);
#pragma nounroll
    for (int it = 0; it < 48; ++it) {
        if (__ballot(!doneA || !doneB) == 0ull) break;
        const bool bis = (it % 3) == 2;
        const float wA = hiA - loA, wB = hiB - loB;
        float rA = bis ? 0.5f : (cloA - (float)Ka + 0.5f) / (cloA - chiA), rB = bis ? 0.5f : (cloB - (float)Kb + 0.5f) / (cloB - chiB);
        rA = fminf(fmaxf(rA, 0.03f), 0.97f); rB = fminf(fmaxf(rB, 0.03f), 0.97f);
        const float midA = loA + wA * rA, midB = loB + wB * rB;
        const float fA = doneA ? TA : midA, fB = doneB ? TB : midB;
        int cA = 0, cB = 0;
#pragma unroll
        for (int blk = 0; blk < 8; ++blk) {
            if (blk < nblk) {
#pragma unroll
                for (int e = 0; e < 8; ++e) { cA += (slo[8 * blk + e] >= fA) ? 1 : 0; cB += (shi[8 * blk + e] >= fB) ? 1 : 0; }
            }
        }
        cA = half_sum(cA); cB = half_sum(cB);
        const bool stuckA = !(midA > loA && midA < hiA), stuckB = !(midB > loB && midB < hiB);
        if (!doneA) { if (cA == Ka) { TA = fA; doneA = true; } else if (stuckA) { TA = loA; doneA = true; } else if (cA > Ka) { loA = midA; cloA = (float)cA; } else { hiA = midA; chiA = (float)cA; } }
        if (!doneB) { if (cB == Kb) { TB = fB; doneB = true; } else if (stuckB) { TB = loB; doneB = true; } else if (cB > Kb) { loB = midB; cloB = (float)cB; } else { hiB = midB; chiB = (float)cB; } }
    }
    if (!doneA) TA = loA;
    if (!doneB) TB = loB;
    unsigned w0 = 0u, w1 = 0u, w2 = 0u, w3 = 0u;
#pragma unroll
    for (int blk = 0; blk < 8; ++blk) {
        if (blk < nblk) {
#pragma unroll
            for (int e = 0; e < 8; ++e) { const int kt = 8 * blk + e; const unsigned long long ma = __ballot(slo[kt] >= TA), mb = __ballot(shi[kt] >= TB);
                if (lane == kt) { w0 = (unsigned)ma; w1 = (unsigned)(ma >> 32); w2 = (unsigned)mb; w3 = (unsigned)(mb >> 32); } }
        }
    }
    SEL[(rowb + t0 + 0) * 64 + lane] = w0; SEL[(rowb + t0 + 1) * 64 + lane] = w1; SEL[(rowb + t0 + 2) * 64 + lane] = w2; SEL[(rowb + t0 + 3) * 64 + lane] = w3;
}

typedef short bf16x4 __attribute__((ext_vector_type(4)));
#define TRB8(OFS, r0, r1, r2, r3, r4, r5, r6, r7, a0, a1, a2, a3, a4, a5, a6, a7) \
    asm volatile("ds_read_b64_tr_b16 %0, %8 offset:" OFS "\n\tds_read_b64_tr_b16 %1, %9 offset:" OFS "\n\tds_read_b64_tr_b16 %2, %10 offset:" OFS "\n\tds_read_b64_tr_b16 %3, %11 offset:" OFS "\n\t" \
                 "ds_read_b64_tr_b16 %4, %12 offset:" OFS "\n\tds_read_b64_tr_b16 %5, %13 offset:" OFS "\n\tds_read_b64_tr_b16 %6, %14 offset:" OFS "\n\tds_read_b64_tr_b16 %7, %15 offset:" OFS "\n\ts_waitcnt lgkmcnt(0)" \
                 : "=&v"(r0), "=&v"(r1), "=&v"(r2), "=&v"(r3), "=&v"(r4), "=&v"(r5), "=&v"(r6), "=&v"(r7) \
                 : "v"(a0), "v"(a1), "v"(a2), "v"(a3), "v"(a4), "v"(a5), "v"(a6), "v"(a7) : "memory")
#define RDQ8(r0, r1, r2, r3, r4, r5, r6, r7, a0, a1, a2, a3) \
    asm volatile("ds_read_b128 %0, %8\n\tds_read_b128 %1, %9\n\tds_read_b128 %2, %10\n\tds_read_b128 %3, %11\n\t" \
                 "ds_read_b128 %4, %8 offset:256\n\tds_read_b128 %5, %9 offset:256\n\tds_read_b128 %6, %10 offset:256\n\tds_read_b128 %7, %11 offset:256\n\ts_waitcnt lgkmcnt(0)" \
                 : "=&v"(r0), "=&v"(r1), "=&v"(r2), "=&v"(r3), "=&v"(r4), "=&v"(r5), "=&v"(r6), "=&v"(r7) \
                 : "v"(a0), "v"(a1), "v"(a2), "v"(a3) : "memory")
__device__ __forceinline__ float rows_max(float x) {
    unsigned u = __float_as_uint(x);
    u32x2 r = __builtin_amdgcn_permlane16_swap(u, u, false, false);
    u = __float_as_uint(fmaxf(__uint_as_float(r.x), __uint_as_float(r.y)));
    r = __builtin_amdgcn_permlane32_swap(u, u, false, false);
    return fmaxf(__uint_as_float(r.x), __uint_as_float(r.y));
}
__device__ __forceinline__ float rows_sum(float x) {
    unsigned u = __float_as_uint(x);
    u32x2 r = __builtin_amdgcn_permlane16_swap(u, u, false, false);
    u = __float_as_uint(__uint_as_float(r.x) + __uint_as_float(r.y));
    r = __builtin_amdgcn_permlane32_swap(u, u, false, false);
    return __uint_as_float(r.x) + __uint_as_float(r.y);
}

__device__ __forceinline__ int att_build_list(LAS unsigned* list, const LAS unsigned* btab, unsigned w, int t, int lane) {
    const int pc = __popc(w); int incl = pc;
#pragma unroll
    for (int o = 1; o < 64; o <<= 1) { const int v = __shfl_up(incl, o); if (lane >= o) incl += v; }
    const int total = __shfl(incl, 63); const int cnt = total < TOPK ? total : TOPK;
    int off = incl - pc;
    while (w) { const int bit = __builtin_ctz(w); w &= w - 1u;
        if (off < TOPK) { const int idx = 32 * lane + bit; int dd = t - idx; dd = dd < 0 ? 0 : (dd > 128 ? 128 : dd); list[off] = (unsigned)idx | (btab[dd] << 16); }
        ++off; }
    for (int sl = cnt + lane; sl < ((cnt + 15) & ~15); sl += 64) list[sl] = 0u;
    return cnt;
}
__device__ __forceinline__ void att_gather16(const bf16_t* CKVb, const LAS unsigned* list16, LAS unsigned char* slot, int lane) {
    const LAS unsigned* lp = list16 + (lane >> 5);
    unsigned idx[8];
#pragma unroll
    for (int i = 0; i < 8; ++i) idx[i] = lp[2 * i] & 0xffffu;
#pragma unroll
    for (int i = 0; i < 8; ++i) {
        const int rr = (2 * i + (lane >> 5)) & 7;
        const bf16_t* src = CKVb + (size_t)idx[i] * RK + 8 * ((lane & 31) ^ (2 * rr));
        __builtin_amdgcn_global_load_lds((const unsigned*)src, (LAS unsigned*)(slot + 1024 * i), 16, 0, 0);
    }
}

#define ATT_T(q) (((q) & 2047) ^ (((q) >> 11) ? 255 : 0))
__device__ __forceinline__ void att_wave(const bf16_t* CKV, const unsigned* SEL, bf16_t* BIG, LAS unsigned char* kvbuf, LAS unsigned* lists, const LAS float* relb, const LAS unsigned* btab,
                                         int xcd, int wx, int nwx, int lane) {
    asm volatile("" : "+v"(lane));
    const int hq = lane & 15, g = lane >> 4;
    const int nq = (2 * SEQ - wx + nwx - 1) / nwx;
    if (nq <= 0) return;
    const unsigned kvb = (unsigned)(size_t)kvbuf;
    const int swz = 2 * (lane & 7);
    unsigned qa[4];
#pragma unroll
    for (int j = 0; j < 4; ++j) qa[j] = kvb + (unsigned)hq * 512u + 16u * (unsigned)(g ^ (swz & 3)) + 64u * (unsigned)(j ^ (swz >> 2));
    const int tq = hq >> 2, tp = hq & 3, trow = 4 * g + tq, tswz = 2 * (trow & 7);
    unsigned ta[8];
#pragma unroll
    for (int j = 0; j < 8; ++j) ta[j] = kvb + (unsigned)trow * 512u + 8u * (unsigned)(tp & 1) + 16u * (unsigned)(tp >> 1) + 32u * (unsigned)(j ^ (tswz >> 1));

    int q = wx, b = 2 * xcd + (q >> 11), t = ATT_T(q);
    size_t row = (size_t)b * SEQ + t;
    unsigned wsel = SEL[row * 64 + lane];
    int cnt = att_build_list(lists, btab, wsel, t, lane);
    unsigned wnext = 0u;
    if (nq > 1) { const int q1 = wx + nwx; wnext = SEL[((size_t)(2 * xcd + (q1 >> 11)) * SEQ + ATT_T(q1)) * 64 + lane]; }
    bf16x8 bq[8];
    { const bf16_t* qp = BIG + row * 4096 + hq * 256 + 8 * g;
#pragma unroll
      for (int ks = 0; ks < 8; ++ks) bq[ks] = *(const bf16x8*)(qp + 32 * ks); }
    int par = 0;
    asm volatile("s_waitcnt lgkmcnt(0)" ::: "memory");
    att_gather16(CKV + (size_t)b * SEQ * RK, lists, kvbuf, lane);
    for (int k = 0; k < nq; ++k) {
        const int cur = k & 1;
        LAS unsigned* list = lists + cur * 256;
        const bool has_next = (k + 1 < nq);
        const int qn = q + nwx, bn = 2 * xcd + (qn >> 11), tn = ATT_T(qn);
        const size_t rown = (size_t)bn * SEQ + tn;
        int cntn = 0;
        if (has_next) { cntn = att_build_list(lists + (cur ^ 1) * 256, btab, wnext, tn, lane);
            if (k + 2 < nq) { const int q2 = qn + nwx; wnext = SEL[((size_t)(2 * xcd + (q2 >> 11)) * SEQ + ATT_T(q2)) * 64 + lane]; } }
        f32x4 O[16];
#pragma unroll
        for (int nt = 0; nt < 16; ++nt) O[nt] = (f32x4){0.f, 0.f, 0.f, 0.f};
        float mref = NEGF, lsum = 0.f;
        const int nsub = (cnt + 15) >> 4;
        for (int sc = 0; sc < nsub; ++sc) {
            const bool lastc = (sc + 1 == nsub);
            const unsigned so = (unsigned)par * 8192u;
            const int s0 = 16 * sc + 4 * g;
            float bias[4];
            { const u32x4 mt = *(const LAS u32x4*)(list + s0);
#pragma unroll
              for (int i = 0; i < 4; ++i) bias[i] = relb[(mt[i] >> 16) * 16 + hq]; }
            if (!lastc) { att_gather16(CKV + (size_t)b * SEQ * RK, list + 16 * (sc + 1), kvbuf + (par ^ 1) * 8192, lane); asm volatile("s_waitcnt vmcnt(8)" ::: "memory"); }
            else if (has_next) { att_gather16(CKV + (size_t)bn * SEQ * RK, lists + (cur ^ 1) * 256, kvbuf + (par ^ 1) * 8192, lane); asm volatile("s_waitcnt vmcnt(8)" ::: "memory"); }
            else { asm volatile("s_waitcnt vmcnt(0)" ::: "memory"); }
            f32x4 st = (f32x4){0.f, 0.f, 0.f, 0.f};
            { bf16x8 a0, a1, a2, a3, a4, a5, a6, a7;
              RDQ8(a0, a1, a2, a3, a4, a5, a6, a7, qa[0] + so, qa[1] + so, qa[2] + so, qa[3] + so);
              st = __builtin_amdgcn_mfma_f32_16x16x32_bf16(a0, bq[0], st, 0, 0, 0); st = __builtin_amdgcn_mfma_f32_16x16x32_bf16(a1, bq[1], st, 0, 0, 0);
              st = __builtin_amdgcn_mfma_f32_16x16x32_bf16(a2, bq[2], st, 0, 0, 0); st = __builtin_amdgcn_mfma_f32_16x16x32_bf16(a3, bq[3], st, 0, 0, 0);
              st = __builtin_amdgcn_mfma_f32_16x16x32_bf16(a4, bq[4], st, 0, 0, 0); st = __builtin_amdgcn_mfma_f32_16x16x32_bf16(a5, bq[5], st, 0, 0, 0);
              st = __builtin_amdgcn_mfma_f32_16x16x32_bf16(a6, bq[6], st, 0, 0, 0); st = __builtin_amdgcn_mfma_f32_16x16x32_bf16(a7, bq[7], st, 0, 0, 0); }
            if (lastc && has_next) { const bf16_t* qp = BIG + rown * 4096 + hq * 256 + 8 * g;
#pragma unroll
                for (int ks = 0; ks < 8; ++ks) bq[ks] = *(const bf16x8*)(qp + 32 * ks); }
            float lg[4]; float cmax = NEGF;
#pragma unroll
            for (int i = 0; i < 4; ++i) { float v = st[i] + bias[i]; v = (s0 + i < cnt) ? v : NEGF; lg[i] = v; cmax = fmaxf(cmax, v); }
            cmax = rows_max(cmax);
            if (__ballot(cmax > mref + 8.0f) != 0ull) {
                const float mnew = fmaxf(mref, cmax), scl = fast_exp(mref - mnew);
                lsum *= scl;
#pragma unroll
                for (int nt = 0; nt < 16; ++nt) O[nt] = O[nt] * scl;
                mref = mnew;
            }
            float p[4];
#pragma unroll
            for (int i = 0; i < 4; ++i) { p[i] = fast_exp(lg[i] - mref); lsum += p[i]; }
            u32x2 pkw; pkw.x = cvt_pk_bf16(p[0], p[1]); pkw.y = cvt_pk_bf16(p[2], p[3]);
            const bf16x4 pk = __builtin_bit_cast(bf16x4, pkw);
            {
                s16x4 r0, r1, r2, r3, r4, r5, r6, r7;
                const unsigned t0 = ta[0] + so, t1 = ta[1] + so, t2 = ta[2] + so, t3 = ta[3] + so, t4 = ta[4] + so, t5 = ta[5] + so, t6 = ta[6] + so, t7 = ta[7] + so;
                TRB8("0", r0, r1, r2, r3, r4, r5, r6, r7, t0, t1, t2, t3, t4, t5, t6, t7);
                O[0] = __builtin_amdgcn_mfma_f32_16x16x16bf16_1k(r0, pk, O[0], 0, 0, 0); O[1] = __builtin_amdgcn_mfma_f32_16x16x16bf16_1k(r1, pk, O[1], 0, 0, 0);
                O[2] = __builtin_amdgcn_mfma_f32_16x16x16bf16_1k(r2, pk, O[2], 0, 0, 0); O[3] = __builtin_amdgcn_mfma_f32_16x16x16bf16_1k(r3, pk, O[3], 0, 0, 0);
                O[4] = __builtin_amdgcn_mfma_f32_16x16x16bf16_1k(r4, pk, O[4], 0, 0, 0); O[5] = __builtin_amdgcn_mfma_f32_16x16x16bf16_1k(r5, pk, O[5], 0, 0, 0);
                O[6] = __builtin_amdgcn_mfma_f32_16x16x16bf16_1k(r6, pk, O[6], 0, 0, 0); O[7] = __builtin_amdgcn_mfma_f32_16x16x16bf16_1k(r7, pk, O[7], 0, 0, 0);
                TRB8("256", r0, r1, r2, r3, r4, r5, r6, r7, t0, t1, t2, t3, t4, t5, t6, t7);
                O[8] = __builtin_amdgcn_mfma_f32_16x16x16bf16_1k(r0, pk, O[8], 0, 0, 0); O[9] = __builtin_amdgcn_mfma_f32_16x16x16bf16_1k(r1, pk, O[9], 0, 0, 0);
                O[10] = __builtin_amdgcn_mfma_f32_16x16x16bf16_1k(r2, pk, O[10], 0, 0, 0); O[11] = __builtin_amdgcn_mfma_f32_16x16x16bf16_1k(r3, pk, O[11], 0, 0, 0);
                O[12] = __builtin_amdgcn_mfma_f32_16x16x16bf16_1k(r4, pk, O[12], 0, 0, 0); O[13] = __builtin_amdgcn_mfma_f32_16x16x16bf16_1k(r5, pk, O[13], 0, 0, 0);
                O[14] = __builtin_amdgcn_mfma_f32_16x16x16bf16_1k(r6, pk, O[14], 0, 0, 0); O[15] = __builtin_amdgcn_mfma_f32_16x16x16bf16_1k(r7, pk, O[15], 0, 0, 0);
            }
            par ^= 1;
        }
        lsum = rows_sum(lsum);
        const float inv = 1.0f / lsum;
        bf16_t* op = BIG + row * 4096 + hq * 256 + 4 * g;
#pragma unroll
        for (int nt = 0; nt < 16; ++nt) { const f32x4 o = O[nt] * inv; u32x2 wv; wv.x = cvt_pk_bf16(o[0], o[1]); wv.y = cvt_pk_bf16(o[2], o[3]); *(u32x2*)(op + 16 * nt) = wv; }
        q = qn; b = bn; t = tn; row = rown; cnt = cntn;
    }
}

constexpr int SW_KP = 144, SW_VP = 520;
constexpr int SW_K_OFF = 0, SW_V_OFF = 256 * SW_KP, SW_TB_OFF = SW_V_OFF + 64 * SW_VP;
__device__ __forceinline__ void swa_phase(const bf16_t* QKV, bf16_t* OB, const float* relb, const float* sinks, LAS unsigned char* lds, int G) {
    int tid = threadIdx.x; asm volatile("" : "+v"(tid));
    const int lane = tid & 63, wave = __builtin_amdgcn_readfirstlane(tid >> 6);
    const int h = lane >> 5, n = lane & 31;
    LAS float* tb = (LAS float*)(lds + SW_TB_OFF);
    for (int u = blockIdx.x; u < BATCH * 16 * KVH; u += G) {
        const int b = u >> 5, nb = (u >> 1) & 15, kvh = u & 1;
        const size_t rowb = (size_t)b * SEQ;
        __syncthreads();
#pragma unroll
        for (int e = 0; e < 4; ++e) { const int id = tid + NTHR * e, j = id >> 3, ch = id & 7; const int pos = (nb - 1) * WIN + j;
            u32x4 kv = (u32x4){0u, 0u, 0u, 0u}, vv = (u32x4){0u, 0u, 0u, 0u};
            if (pos >= 0) { const bf16_t* sp = QKV + (rowb + pos) * B_IN + 1024 + kvh * 64 + ch * 8; kv = *(const u32x4*)sp; vv = *(const u32x4*)(sp + 128); }
            *(LAS u32x4*)(lds + SW_K_OFF + j * SW_KP + ch * 16) = kv;
            LAS bf16_t* vt = (LAS bf16_t*)(lds + SW_V_OFF + (ch * 8) * SW_VP + j * 2);
#pragma unroll
            for (int q = 0; q < 4; ++q) { vt[(2 * q) * (SW_VP / 2)] = (bf16_t)(vv[q] & 0xffffu); vt[(2 * q + 1) * (SW_VP / 2)] = (bf16_t)(vv[q] >> 16); } }
        for (int i = tid; i < GQ * WIN; i += NTHR) { const int gg = i >> 7, dist = i & 127; tb[i] = relb[t5_bucket(dist) * NH + kvh * GQ + gg]; }
        __syncthreads();
        const int qh = kvh * GQ + wave; const float sink = sinks[qh];
        for (int rt = 0; rt < 4; ++rt) {
            const size_t qrow = rowb + nb * WIN + 32 * rt + n;
            bf16x8 bq[4];
#pragma unroll
            for (int ks = 0; ks < 4; ++ks) bq[ks] = *(const bf16x8*)(QKV + qrow * B_IN + qh * 64 + 16 * ks + 8 * h);
            f32x16 s[5];
#pragma unroll
            for (int ct = 0; ct < 5; ++ct) {
#pragma unroll
                for (int i = 0; i < 16; ++i) s[ct][i] = 0.f;
#pragma unroll
                for (int ks = 0; ks < 4; ++ks) { const bf16x8 a = *(const LAS bf16x8*)(lds + SW_K_OFF + (32 * (rt + ct) + n) * SW_KP + (2 * ks + h) * 16);
                    s[ct] = __builtin_amdgcn_mfma_f32_32x32x16_bf16(a, bq[ks], s[ct], 0, 0, 0); } }
            const int qi = 32 * rt + n;
            float mx = NEGF;
#pragma unroll
            for (int ct = 0; ct < 5; ++ct)
#pragma unroll
                for (int i = 0; i < 16; ++i) { const int j = 32 * (rt + ct) + (i & 3) + 8 * (i >> 2) + 4 * h; const int dist = qi + WIN - j;
                    const bool ok = (dist >= 0) && (dist < WIN) && (nb > 0 || j >= WIN);
                    const float v = ok ? s[ct][i] * 0.125f + tb[wave * WIN + (dist & 127)] : NEGF; s[ct][i] = v; mx = fmaxf(mx, v); }
            mx = fmaxf(mx, __shfl_xor(mx, 32)); mx = fmaxf(mx, sink);
            float sum = 0.f;
#pragma unroll
            for (int ct = 0; ct < 5; ++ct)
#pragma unroll
                for (int i = 0; i < 16; ++i) { const float p = fast_exp(s[ct][i] - mx); s[ct][i] = p; sum += p; }
            sum += __shfl_xor(sum, 32); sum += fast_exp(sink - mx);
            f32x16 o[2];
#pragma unroll
            for (int dt = 0; dt < 2; ++dt)
#pragma unroll
                for (int i = 0; i < 16; ++i) o[dt][i] = 0.f;
#pragma unroll
            for (int ct = 0; ct < 5; ++ct)
#pragma unroll
                for (int s2 = 0; s2 < 2; ++s2) {
                    u32x4 pw; pw.x = cvt_pk_bf16(s[ct][8 * s2 + 0], s[ct][8 * s2 + 1]); pw.y = cvt_pk_bf16(s[ct][8 * s2 + 2], s[ct][8 * s2 + 3]);
                    pw.z = cvt_pk_bf16(s[ct][8 * s2 + 4], s[ct][8 * s2 + 5]); pw.w = cvt_pk_bf16(s[ct][8 * s2 + 6], s[ct][8 * s2 + 7]);
                    const bf16x8 pb = __builtin_bit_cast(bf16x8, pw);
#pragma unroll
                    for (int dt = 0; dt < 2; ++dt) { const LAS unsigned char* vp = lds + SW_V_OFF + (32 * dt + n) * SW_VP + (32 * (rt + ct) + 16 * s2 + 4 * h) * 2;
                        const u32x2 v0 = *(const LAS u32x2*)vp, v1 = *(const LAS u32x2*)(vp + 16);
                        u32x4 va; va.x = v0.x; va.y = v0.y; va.z = v1.x; va.w = v1.y;
                        o[dt] = __builtin_amdgcn_mfma_f32_32x32x16_bf16(__builtin_bit_cast(bf16x8, va), pb, o[dt], 0, 0, 0); }
                }
            const float inv = 1.0f / sum;
            bf16_t* op = OB + qrow * D + qh * 64 + 4 * h;
#pragma unroll
            for (int dt = 0; dt < 2; ++dt)
#pragma unroll
                for (int i4 = 0; i4 < 4; ++i4) { u32x2 wv; wv.x = cvt_pk_bf16(o[dt][4 * i4] * inv, o[dt][4 * i4 + 1] * inv); wv.y = cvt_pk_bf16(o[dt][4 * i4 + 2] * inv, o[dt][4 * i4 + 3] * inv);
                    *(u32x2*)(op + 32 * dt + 8 * i4) = wv; }
        }
    }
}

struct Args { const float* in[23]; float* out; unsigned char* ws; };
#define CAS __attribute__((address_space(4)))
__device__ __forceinline__ const CAS Args* kargs() { const CAS Args* p = (const CAS Args*)__builtin_amdgcn_kernarg_segment_ptr(); asm volatile("" : "+s"(p)); return p; }

__global__ void __launch_bounds__(NTHR, 2) trunk_fwd(Args args_by_value) {
    extern __shared__ __attribute__((aligned(16))) unsigned char lds_raw[];
    LAS unsigned char* lds = (LAS unsigned char*)lds_raw;
    const int tid = threadIdx.x;
    volatile LAS unsigned* MISC = (volatile LAS unsigned*)(lds + LDS_MISC_OFF);
    for (int u = tid; u < (LDS_BYTES - LDS_MISC_OFF) / 4; u += NTHR) MISC[u] = 0u;
    __syncthreads();
    { const CAS Args* A = kargs(); (void)xcd_barrier_post((unsigned*)(A->ws + WS_CTL) + 4096, MISC + 8);
      if (tid == 0) { const unsigned x = xb_xcc_id(); MISC[16] = x; MISC[17] = xb_add((unsigned*)(A->ws + WS_CTL) + 8192 + 64 * x, 1u); } }
#define XCD_RANK(xcd, rank) do { const CAS Args* A_ = kargs(); const unsigned* cw_ = (const unsigned*)(A_->ws + WS_CTL) + 4096; bool ok_ = (gridDim.x & 7) == 0; \
        for (int j_ = 0; j_ < 16; ++j_) { const unsigned c_ = __hip_atomic_load(cw_ + XB_XCNT(j_), __ATOMIC_RELAXED, __HIP_MEMORY_SCOPE_AGENT); ok_ = ok_ && (c_ == (j_ < 8 ? gridDim.x >> 3 : 0u)); } \
        const unsigned hx_ = MISC[16], hr_ = MISC[17]; ok_ = ok_ && hx_ < 8u && hr_ < (gridDim.x >> 3); \
        xcd = ok_ ? (int)hx_ : (int)(blockIdx.x & 7); rank = ok_ ? (int)hr_ : (int)(blockIdx.x >> 3); } while (0)
#define GB() do { const CAS Args* A_ = kargs(); XcdBarrier b_; b_.bar = (unsigned*)(A_->ws + WS_CTL) + 4096; b_.x = xb_xcc_id(); b_.st = MISC + 8; xcd_barrier(b_); } while (0)

    { const CAS Args* A = kargs(); Ptrs P;
#pragma unroll
      for (int i = 0; i < 23; ++i) P.in[i] = A->in[i];
      P.out = A->out; P.ws = A->ws;
      p0_prologue(P, lds, (int)gridDim.x); }
    GB();
    { const CAS Args* A = kargs(); Ptrs P;
#pragma unroll
      for (int i = 0; i < 23; ++i) P.in[i] = A->in[i];
      P.out = A->out; P.ws = A->ws;
      pre_phase(P, lds, (int)gridDim.x); }
    GB();

    for (int l = 0; l < DEPTH; ++l) {
        const bool isA = (l & 1) == 0;
        {
            const CAS Args* A = kargs(); const int G = gridDim.x, j = l >> 1; unsigned char* ws = A->ws;
            const unsigned long long* SS = (const unsigned long long*)(ws + WS_SS) + (size_t)(2 * l) * M;
            if (isA) {
                unsigned char* wa = ws + WS_WA + (size_t)j * WA_STRIDE;
                pg8::Gemm g{(const bf16_t*)(ws + WS_XG), (const bf16_t*)(wa + WINA_OFF), D, D, D, 0, 0}; pg8::StaticOrder S; S.init(M, 2048, G, (int)blockIdx.x);
                pg8::EpiInA E{(bf16_t*)(ws + WS_QO), (bf16_t*)(ws + WS_CKV), (bf16_t*)(ws + WS_QI), (bf16_t*)(ws + WS_KIN), (float*)(ws + WS_WI), A->in[I_AIKG] + j * IDIM, A->in[I_AIKB] + j * IDIM,
                                (const float*)(ws + WS_SHW + SHW_A) + (size_t)j * BATCH * 2048, SS};
                pg8::gemm_phase<pg8::EpiInA, true>(lds, g, S, E);
            } else {
                unsigned char* wb = ws + WS_WB + (size_t)j * WB_STRIDE;
                pg8::Gemm g{(const bf16_t*)(ws + WS_XG), (const bf16_t*)(wb + WINB_OFF), D, D, D, 0, 0}; pg8::StaticOrder S; S.init(M, B_IN, G, (int)blockIdx.x);
                pg8::EpiBf16Plain<true> E{(bf16_t*)(ws + WS_QKV), B_IN, (const float*)(ws + WS_SHW + SHW_B) + (size_t)j * BATCH * B_IN, B_IN, SS};
                pg8::gemm_phase<pg8::EpiBf16Plain<true>, true>(lds, g, S, E);
            }
        }
        GB();
        if (isA) {
            { const CAS Args* A = kargs(); const int G = gridDim.x, j = l >> 1; unsigned char* ws = A->ws;
              unsigned char* wa = ws + WS_WA + (size_t)j * WA_STRIDE;
              pg8::Gemm g{(const bf16_t*)(ws + WS_QO), (const bf16_t*)(wa + WQA_OFF), D, 256, 256, 2, 256}; pg8::StaticOrder S; S.init(M, 4096, G, (int)blockIdx.x);
              pg8::EpiBf16Plain<false> E{(bf16_t*)(ws + WS_BIG), 4096, nullptr, 0, nullptr};
              pg8::gemm_phase<pg8::EpiBf16Plain<false>, true>(lds, g, S, E); }
            { const CAS Args* A = kargs(); const int G = gridDim.x; unsigned char* ws = A->ws;
              int tid2 = tid; asm volatile("" : "+v"(tid2));
              const int lane = tid2 & 63, wave = __builtin_amdgcn_readfirstlane(tid2 >> 6);
              bf16_t* CKV = (bf16_t*)(ws + WS_CKV);
              const int gw = blockIdx.x * NWAVES + wave, NGW = G * NWAVES;
              for (int row = gw; row < M; row += NGW) {
                  u32x2* pr = (u32x2*)(CKV + (size_t)row * RK) + lane;
                  const u32x2 v = *pr;
                  const float a0 = __uint_as_float(v.x << 16), a1 = __uint_as_float(v.x & 0xffff0000u), a2 = __uint_as_float(v.y << 16), a3 = __uint_as_float(v.y & 0xffff0000u);
                  const float ss = wave_sum((a0 * a0 + a1 * a1) + (a2 * a2 + a3 * a3));
                  const float rs = 1.0f / sqrtf(ss * (1.0f / RK) + EPS);
                  u32x2 o; o.x = cvt_pk_bf16(a0 * rs, a1 * rs); o.y = cvt_pk_bf16(a2 * rs, a3 * rs); *pr = o;
              } }
            { const CAS Args* A = kargs(); const int G = gridDim.x; unsigned char* ws = A->ws;
              int tid2 = tid; asm volatile("" : "+v"(tid2));
              const int lane = tid2 & 63, wave = __builtin_amdgcn_readfirstlane(tid2 >> 6);
              int xcd, rank; XCD_RANK(xcd, rank); xcd = __builtin_amdgcn_readfirstlane(xcd); rank = __builtin_amdgcn_readfirstlane(rank);
              const int wx = rank * NWAVES + wave, nwx = (G >> 3) * NWAVES;
              const int nsteps = (1024 + nwx - 1) / nwx;
              for (int st = 0; st < nsteps; ++st) {
                  const int q = wx + st * nwx; const bool active = q < 1024;
                  const int qc = active ? q : (rank * NWAVES + st * nwx < 1024 ? rank * NWAVES + st * nwx : 1023);
                  const int bl = qc >> 9, u = qc & 255, hiq = (qc >> 8) & 1, b = 2 * xcd + bl;
                  const int tg = hiq ? 511 - u : u;
                  idx_task((const bf16_t*)(ws + WS_QI), (const bf16_t*)(ws + WS_KIN), (const float*)(ws + WS_WI), (unsigned*)(ws + WS_SEL), lds, b, tg, lane, wave, active, hiq ? 2 : 1);
              }
              __syncthreads(); }
        } else {
            const CAS Args* A = kargs(); const int G = gridDim.x, j = l >> 1; unsigned char* ws = A->ws;
            swa_phase((const bf16_t*)(ws + WS_QKV), (bf16_t*)(ws + WS_OB), A->in[I_RELB], A->in[I_BSINK] + j * NH, lds, G);
        }
        GB();
        if (isA) {
            { const CAS Args* A = kargs(); const int G = gridDim.x; unsigned char* ws = A->ws;
              int tid2 = tid; asm volatile("" : "+v"(tid2));
              const int lane = tid2 & 63, wave = __builtin_amdgcn_readfirstlane(tid2 >> 6);
              LAS float* relb = (LAS float*)(lds + 147456);
              LAS unsigned* btab = (LAS unsigned*)(lds + 147456 + 2048);
              for (int i = tid2; i < NBUCK * NH; i += NTHR) relb[i] = A->in[I_RELB][i];
              for (int i = tid2; i < 132; i += NTHR) btab[i] = (unsigned)t5_bucket(i);
              __syncthreads();
              int xcd, rank; XCD_RANK(xcd, rank); xcd = __builtin_amdgcn_readfirstlane(xcd); rank = __builtin_amdgcn_readfirstlane(rank);
              const int wx = rank * NWAVES + wave, nwx = (G >> 3) * NWAVES;
              att_wave((const bf16_t*)(ws + WS_CKV), (const unsigned*)(ws + WS_SEL), (bf16_t*)(ws + WS_BIG), lds + wave * 16384, (LAS unsigned*)(lds + 131072 + wave * 2048), relb, btab, xcd, wx, nwx, lane); }
            GB();
            { const CAS Args* A = kargs(); const int G = gridDim.x, j = l >> 1; unsigned char* ws = A->ws;
              unsigned char* wa = ws + WS_WA + (size_t)j * WA_STRIDE;
              pg8::Gemm g{(const bf16_t*)(ws + WS_BIG), (const bf16_t*)(wa + WUV_OFF), 4096, D, D, 0, 1024}; pg8::StaticOrder S; S.init(M, D, G, (int)blockIdx.x);
              pg8::EpiBf16Plain<false> E{(bf16_t*)(ws + WS_QO), D, nullptr, 0, nullptr};
              pg8::gemm_phase<pg8::EpiBf16Plain<false>, true>(lds, g, S, E); }
            GB();
        }
        {
            const CAS Args* A = kargs(); const int G = gridDim.x, j = l >> 1; unsigned char* ws = A->ws;
            const float* modl = (const float*)(ws + WS_MOD) + (size_t)l * BATCH * 6144;
            const bf16_t* Ain = (const bf16_t*)(ws + (isA ? WS_QO : WS_OB));
            const bf16_t* Bw = (const bf16_t*)(isA ? ws + WS_WA + (size_t)j * WA_STRIDE + WOUTA_OFF : ws + WS_WB + (size_t)j * WB_STRIDE + WOUTB_OFF);
            pg8::Gemm g{Ain, Bw, D, D, D, 0, 0}; pg8::StaticOrder S; S.init(M, D, G, (int)blockIdx.x);
            pg8::EpiResid E{(const bf16_t*)A->out, (bf16_t*)A->out, modl + 2048, isA ? nullptr : A->in[I_BBOUT] + j * D,
                            (bf16_t*)(ws + WS_XG), A->in[I_GFFN] + l * D, modl + 4096, (unsigned long long*)(ws + WS_SS) + (size_t)(2 * l + 1) * M};
            pg8::gemm_phase<pg8::EpiResid, true>(lds, g, S, E);
        }
        GB();
        {
            const CAS Args* A = kargs(); const int G = gridDim.x; unsigned char* ws = A->ws;
            unsigned char* wl = ws + WS_W + (size_t)l * W_LAYER;
            pg8::Gemm g{(const bf16_t*)(ws + WS_XG), (const bf16_t*)(wl + W13_OFF), D, D, D, 0, 0}; pg8::StaticOrder S; S.init(M, 2 * DFF, G, (int)blockIdx.x);
            pg8::EpiSwiGLU E{(bf16_t*)(ws + WS_HFF), (const float*)(ws + WS_SHW + SHW_F) + (size_t)l * BATCH * 2 * DFF, (const unsigned long long*)(ws + WS_SS) + (size_t)(2 * l + 1) * M};
            pg8::gemm_phase<pg8::EpiSwiGLU, true>(lds, g, S, E);
        }
        GB();
        {
            const CAS Args* A = kargs(); const int G = gridDim.x; unsigned char* ws = A->ws;
            unsigned char* wl = ws + WS_W + (size_t)l * W_LAYER;
            const float* modl = (const float*)(ws + WS_MOD) + (size_t)l * BATCH * 6144;
            const int ln = l + 1 < DEPTH ? l + 1 : l;
            pg8::Gemm g{(const bf16_t*)(ws + WS_HFF), (const bf16_t*)(wl + W2_OFF), DFF, DFF, DFF, 0, 0}; pg8::StaticOrder S; S.init(M, D, G, (int)blockIdx.x);
            const bool lastl = (l + 1 == DEPTH);
            pg8::EpiResid E{(const bf16_t*)A->out, lastl ? (bf16_t*)(ws + WS_XG) : (bf16_t*)A->out, modl + 5120, nullptr,
                            l + 1 < DEPTH ? (bf16_t*)(ws + WS_XG) : nullptr, A->in[I_GMIX] + ln * D, (const float*)(ws + WS_MOD) + (size_t)ln * BATCH * 6144 + 1024, (unsigned long long*)(ws + WS_SS) + (size_t)(2 * l + 2) * M};
            pg8::gemm_phase<pg8::EpiResid, true>(lds, g, S, E);
        }
        GB();
    }
    { const CAS Args* A = kargs(); final_norm_phase((const bf16_t*)(A->ws + WS_XG), A->out, A->in[I_GFIN], (int)gridDim.x); }
#undef GB
}

extern "C" void kernel_launch(void* const* d_in, const int* in_sizes, int n_in, void* d_out, int out_size, void* d_ws, size_t ws_size, hipStream_t stream) {
    static int grid = 0;
    if (grid == 0) {
        if (n_in != 23 || out_size != M * D || ws_size < WS_END) { fprintf(stderr, "kernel_launch: unexpected shapes (n_in %d out %d ws %zu)\n", n_in, out_size, ws_size); grid = -1; return; }
        int dev = 0, cus = 0, per_cu = 0;
        if (hipGetDevice(&dev) != hipSuccess || hipDeviceGetAttribute(&cus, hipDeviceAttributeMultiprocessorCount, dev) != hipSuccess) { grid = -1; return; }
        if (hipFuncSetAttribute((const void*)trunk_fwd, hipFuncAttributeMaxDynamicSharedMemorySize, LDS_BYTES) != hipSuccess) { fprintf(stderr, "kernel_launch: hipFuncSetAttribute failed\n"); grid = -1; return; }
        if (hipOccupancyMaxActiveBlocksPerMultiprocessor(&per_cu, (const void*)trunk_fwd, NTHR, LDS_BYTES) != hipSuccess || per_cu < 1) { fprintf(stderr, "kernel_launch: occupancy query says %d\n", per_cu); }
        (void)hipGetLastError();
        grid = cus;
    }
    if (grid < 0) return;
    (void)hipMemsetAsync((char*)d_ws + WS_CTL, 0, CTL_ZERO_BYTES, stream);
    Args a{};
    for (int i = 0; i < 23; ++i) a.in[i] = (const float*)d_in[i];
    a.out = (float*)d_out; a.ws = (unsigned char*)d_ws;
    hipLaunchKernelGGL(trunk_fwd, dim3(grid), dim3(NTHR), LDS_BYTES, stream, a);
    const hipError_t le = hipPeekAtLastError();
    if (le != hipSuccess) fprintf(stderr, "kernel_launch: launch failed: %s\n", hipGetErrorName(le));
}
```

```cpp
#include <hip/hip_runtime.h>
#include <cstdio>
#include <cstdint>


#define GAS __attribute__((address_space(1)))
#define LAS __attribute__((address_space(3)))
typedef unsigned short bf16_t;
typedef short bf16x8 __attribute__((ext_vector_type(8)));
typedef short s16x4 __attribute__((ext_vector_type(4)));
typedef float f32x4 __attribute__((ext_vector_type(4)));
typedef float f32x2 __attribute__((ext_vector_type(2)));
typedef float f32x16 __attribute__((ext_vector_type(16)));
typedef unsigned u32x4 __attribute__((ext_vector_type(4)));
typedef unsigned u32x2 __attribute__((ext_vector_type(2)));

constexpr int D = 1024, BATCH = 16, SEQ = 2048, M = BATCH * SEQ, DEPTH = 4;
constexpr int NH = 16, HD = 64, RK = 256, IH = 8, IDIM = 64, TOPK = 256;
constexpr int KVH = 2, GQ = 8, WIN = 128, NBUCK = 32, DFF = 2816;
constexpr int A_IN = 1864, B_IN = 1280;
constexpr float EPS = 1e-6f;
constexpr float NEGF = -1e30f;
constexpr int NWAVES = 8, NTHR = 512;

constexpr size_t MiB = 1u << 20;
constexpr size_t WS_CTL = 0, CTL_ZERO_BYTES = 4 * MiB;
constexpr size_t WS_SS = 1 * MiB;
constexpr size_t WS_W = 4 * MiB;
constexpr size_t W_LAYER = 17301504;
constexpr size_t W13_OFF = 0, W2_OFF = 11 * MiB;
constexpr size_t WS_WA = WS_W + 4 * W_LAYER;
constexpr size_t WA_STRIDE = 10 * MiB, WINA_OFF = 0, WQA_OFF = 4 * MiB, WUV_OFF = 6 * MiB, WOUTA_OFF = 8 * MiB;
constexpr size_t WS_WB = WS_WA + 2 * WA_STRIDE;
constexpr size_t WB_STRIDE = 4718592, WINB_OFF = 0, WOUTB_OFF = 2621440;
constexpr size_t WS_MOD = 100 * MiB;
constexpr size_t WS_SHW = WS_MOD + 1536 * 1024;
constexpr size_t SHW_A = 0, SHW_B = 2 * 16 * 2048 * 4, SHW_F = SHW_B + 2 * 16 * 1280 * 4;
constexpr size_t WS_XG = 104 * MiB;
constexpr size_t WS_BIG = 104 * MiB;
constexpr size_t WS_HFF = 168 * MiB;
constexpr size_t WS_QO = 360 * MiB;
constexpr size_t WS_CKV = 424 * MiB;
constexpr size_t WS_QI = 440 * MiB;
constexpr size_t WS_KIN = 472 * MiB;
constexpr size_t WS_WI = 476 * MiB;
constexpr size_t WS_SEL = 477 * MiB;
constexpr size_t WS_CKV8 = 486 * MiB;
constexpr size_t WS_QKV = 360 * MiB;
constexpr size_t WS_OB = 440 * MiB;
constexpr size_t WS_END = 512 * MiB;

constexpr int RING_BYTES = 131072;
constexpr int LDS_MISC_OFF = 155648;
constexpr int LDS_BYTES = 156672;

#define RLX_AGENT __ATOMIC_RELAXED, __HIP_MEMORY_SCOPE_AGENT
__device__ __forceinline__ unsigned cvt_pk_bf16(float lo, float hi) { unsigned r; asm volatile("v_cvt_pk_bf16_f32 %0, %1, %2" : "=v"(r) : "v"(lo), "v"(hi)); return r; }
__device__ __forceinline__ float bf2f(bf16_t b) { return __uint_as_float(((unsigned)b) << 16); }
__device__ __forceinline__ float wave_sum(float v) {
#pragma unroll
    for (int o = 1; o < 64; o <<= 1) v += __shfl_xor(v, o);
    return v;
}
__device__ __forceinline__ float fast_exp(float x) { return __builtin_amdgcn_exp2f(x * 1.4426950408889634f); }
__device__ __forceinline__ float silu_f(float x) { return x * __builtin_amdgcn_rcpf(1.0f + fast_exp(-x)); }
__device__ __forceinline__ int t5_bucket(int d) {
    if (d < 16) return d;
    int b = 16;
    b += (d >= 19); b += (d >= 21); b += (d >= 24); b += (d >= 27); b += (d >= 31); b += (d >= 35); b += (d >= 40); b += (d >= 46);
    b += (d >= 52); b += (d >= 59); b += (d >= 67); b += (d >= 77); b += (d >= 87); b += (d >= 99); b += (d >= 113);
    return b;
}

#define XB_TMO      128
#define XB_XCNT(j)  (256  + 64 * (j))
#define XB_XSUB(j)  (1280 + 64 * (j))
#define XB_XGEN(j)  (2304 + 64 * (j))
#define XB_TOP      3328
#define XB_TOPGEN   3392
#define XCD_BAR_WORDS 3456
#define XB_SPIN_CAP (1u << 22)

__device__ __forceinline__ unsigned xb_ld(unsigned* p)              { return __hip_atomic_load(p, __ATOMIC_RELAXED, __HIP_MEMORY_SCOPE_AGENT); }
__device__ __forceinline__ unsigned xb_add(unsigned* p, unsigned v) { return __hip_atomic_fetch_add(p, v, __ATOMIC_RELAXED, __HIP_MEMORY_SCOPE_AGENT); }
__device__ __forceinline__ unsigned xb_xcc_id() { return (unsigned)__builtin_amdgcn_s_getreg((3 << 11) | 20) & 0xFu; }
#define XB_SPIN(cond, bar) do { unsigned _sp = 0; while (cond) { __builtin_amdgcn_s_sleep(1); \
    if ((++_sp & 255u) == 0u) { if (xb_ld(&(bar)[XB_TMO])) break; if (_sp > XB_SPIN_CAP) { atomicAdd(&(bar)[XB_TMO], 1u); break; } } } } while (0)

struct XcdBarrier { unsigned* bar; unsigned x; volatile LAS unsigned* st; };

__device__ __forceinline__ XcdBarrier xcd_barrier_post(unsigned* bar, volatile LAS unsigned* st) {
    XcdBarrier b; b.bar = bar; b.x = xb_xcc_id(); b.st = st;
    if (threadIdx.x == 0) (void)xb_add(&bar[XB_XCNT(b.x)], 1u);
    return b;
}
__device__ __forceinline__ void xcd_barrier_complete(unsigned* bar, unsigned x, unsigned& nloc, unsigned& nx) {
    const unsigned G = gridDim.x * gridDim.y * gridDim.z;
    unsigned sum, cnt, mine, sp = 0u;
    for (;;) {
        sum = 0u; cnt = 0u; mine = 0u;
#pragma unroll
        for (unsigned j = 0; j < 16; ++j) { const unsigned c = xb_ld(&bar[XB_XCNT(j)]); sum += c; cnt += (c > 0u) ? 1u : 0u; mine = (j == x) ? c : mine; }
        if (sum == G) break;
        __builtin_amdgcn_s_sleep(1);
        if ((++sp & 255u) == 0u) { if (xb_ld(&bar[XB_TMO])) break; if (sp > XB_SPIN_CAP) { atomicAdd(&bar[XB_TMO], 1u); break; } }
    }
    nloc = mine > 0u ? mine : 1u; nx = cnt > 0u ? cnt : 1u;
}
__device__ __forceinline__ void xcd_barrier(const XcdBarrier& b) {
    asm volatile("s_waitcnt vmcnt(0)" ::: "memory");
    __syncthreads();
    if (threadIdx.x == 0) {
        unsigned* bar = b.bar;
        __builtin_amdgcn_s_waitcnt(0);
        unsigned nloc = b.st[0], nx = b.st[1];
        if (nloc == 0u) { xcd_barrier_complete(bar, b.x, nloc, nx); b.st[0] = nloc; b.st[1] = nx; }
        const unsigned old = xb_add(&bar[XB_XSUB(b.x)], 1u);
        const unsigned gen = old / nloc;
        if (old + 1u == (gen + 1u) * nloc) {
            __builtin_amdgcn_fence(__ATOMIC_RELEASE, "agent");
            asm volatile("s_waitcnt vmcnt(0)" ::: "memory");
            const unsigned og = xb_add(&bar[XB_TOP], 1u);
            const unsigned tg = og / nx;
            if (og + 1u == (tg + 1u) * nx) xb_add(&bar[XB_TOPGEN], 1u);
            else XB_SPIN(xb_ld(&bar[XB_TOPGEN]) == tg, bar);
            __builtin_amdgcn_fence(__ATOMIC_ACQUIRE, "agent");
            xb_add(&bar[XB_XGEN(b.x)], 1u);
            asm volatile("s_waitcnt vmcnt(0)" ::: "memory");
        } else {
            XB_SPIN(xb_ld(&bar[XB_XGEN(b.x)]) == gen, bar);
            __builtin_amdgcn_fence(__ATOMIC_ACQUIRE, "agent");
            asm volatile("s_waitcnt vmcnt(0)" ::: "memory");
        }
    }
    __syncthreads();
}

namespace pg8 {
constexpr int BM = 256, BK = 64, HALF = 128, HTB = HALF * BK * 2, STAGE_BYTES = 8 * HTB, NXCD = 8, WGM = 8;
__host__ __device__ __forceinline__ int lds_byte(int r, int c) { const int st = (r >> 4) * 2 + (c >> 5), rr = r & 15, cc = c & 31, ob = rr * 64 + cc * 2; return st * 1024 + (ob ^ (((ob >> 9) & 1) << 5)); }
__host__ __device__ __forceinline__ void stage_rc(int b, int& R, int& C) { const int st = b / 1024, sb = b % 1024, swz = sb ^ (((sb >> 9) & 1) << 5); R = (st >> 1) * 16 + swz / 64; C = (st & 1) * 32 + (swz % 64) / 2; }
__host__ __device__ __forceinline__ int perm32(int rho) { const int n = rho >> 4, i = rho & 15; return 8 * (i >> 2) + 4 * n + (i & 3); }

struct Unit { int pm, pn; };
struct Gemm { const bf16_t* A; const bf16_t* Bt; int lda, ldb, K, a_shift, a_mul; };

struct StaticOrder {
    int nM, nN, nwg, G, c;
    __device__ void init(int M_, int N_, int G_, int c_) { nM = M_ / BM; nN = N_ / BM; nwg = nM * nN; G = G_; c = c_; }
    __device__ bool next(int i, Unit& u) const {
        const long L = (long)i * G + c; if (L >= nwg) return false;
        int wgid = (int)L; { const int q = nwg / NXCD, r = nwg % NXCD, xcd = wgid % NXCD, off = wgid / NXCD; wgid = (xcd < r ? xcd * (q + 1) : r * (q + 1) + (xcd - r) * q) + off; }
        const int nig = WGM * nN, gid = wgid / nig, fm = gid * WGM, gsz = (nM - fm) < WGM ? (nM - fm) : WGM;
        u.pm = fm + ((wgid % nig) % gsz); u.pn = (wgid % nig) / gsz; return true;
    }
};

template <class Epi, bool ALIGN_EPI>
__device__ __forceinline__ void gemm_phase(LAS unsigned char* lds, const Gemm g, const StaticOrder& S, const Epi& E) {
    int tid = threadIdx.x; asm volatile("" : "+v"(tid));
    const int wid = __builtin_amdgcn_readfirstlane(tid >> 6), lane = tid & 63, wr = wid >> 2, wc = wid & 3, fr = lane & 15, fq = lane >> 4;
    const int K = g.K, nt = K / BK;
    unsigned voffA[2], voffB[2];
#pragma unroll
    for (int i = 0; i < 2; ++i) { int R, C; stage_rc(tid * 16 + i * 8192, R, C); const int Rb = Epi::PERM ? ((R & ~31) + perm32(R & 31)) : R;
        voffA[i] = (unsigned)(R * g.lda + C) * 2u; voffB[i] = (unsigned)(Rb * g.ldb + C) * 2u; }
    const size_t kstep = (size_t)(BK * 2);
    const size_t hstepA = (size_t)HALF * g.lda * 2, hstepB = (size_t)HALF * g.ldb * 2;
    const unsigned ldsw = (unsigned)wid * 1024u;
    const int aoff = lds_byte(wr * 64 + fr, fq * 8), boff = lds_byte(wc * 32 + fr, fq * 8);
#define PG8_SA(b, h) (((b) * 2 + (h)) * HTB)
#define PG8_SB(b, h) ((4 + (b) * 2 + (h)) * HTB)
#define PG8_STAGE(bufoff, gbase, voff) do { _Pragma("unroll") for (int _i = 0; _i < 2; ++_i) \
        __builtin_amdgcn_global_load_lds((const unsigned*)((const char*)(gbase) + (voff)[_i]), (LAS unsigned*)(lds + (bufoff) + ldsw + _i * 8192), 16, 0, 0); } while (0)
#define PG8_LDA(dst, b, h) do { _Pragma("unroll") for (int m = 0; m < 4; ++m) _Pragma("unroll") for (int k = 0; k < 2; ++k) dst[m][k] = *(const LAS bf16x8*)(lds + PG8_SA(b, h) + aoff + m * 2048 + k * 1024); } while (0)
#define PG8_LDB(dst, b, h) do { _Pragma("unroll") for (int n = 0; n < 2; ++n) _Pragma("unroll") for (int k = 0; k < 2; ++k) dst[n][k] = *(const LAS bf16x8*)(lds + PG8_SB(b, h) + boff + n * 2048 + k * 1024); } while (0)
#define PG8_MMA(ai, bj, At, Bt) do { __builtin_amdgcn_s_setprio(1); _Pragma("unroll") for (int m = 0; m < 4; ++m) _Pragma("unroll") for (int n = 0; n < 2; ++n) _Pragma("unroll") for (int k = 0; k < 2; ++k) \
        acc[ai][bj][m][n] = __builtin_amdgcn_mfma_f32_16x16x32_bf16(Bt[n][k], At[m][k], acc[ai][bj][m][n], 0, 0, 0); __builtin_amdgcn_s_setprio(0); } while (0)
#define PG8_WAIT_V(n) asm volatile("s_waitcnt vmcnt(" #n ")" ::: "memory")
#define PG8_WAIT_L(n) asm volatile("s_waitcnt lgkmcnt(" #n ")" ::: "memory")
#define PG8_BAR __builtin_amdgcn_s_barrier()
#define PG8_SCHED __builtin_amdgcn_sched_barrier(0)
#define PG8_ABASE(u) ((const char*)g.A + ((size_t)(u).pm * BM * g.lda + (size_t)((u).pn >> g.a_shift) * g.a_mul) * 2)
#define PG8_BBASE(u) ((const char*)g.Bt + (size_t)(u).pn * BM * g.ldb * 2)
    Unit cur, nxt; int ui = 0;
    if (!S.next(0, cur)) return;
    f32x4 acc[2][2][4][2];
#pragma unroll
    for (int a = 0; a < 2; ++a)
#pragma unroll
        for (int b = 0; b < 2; ++b)
#pragma unroll
            for (int m = 0; m < 4; ++m)
#pragma unroll
                for (int n = 0; n < 2; ++n) acc[a][b][m][n] = (f32x4){0.f, 0.f, 0.f, 0.f};
    bf16x8 At[4][2], B0[2][2], B1[2][2];
    const char* cA = PG8_ABASE(cur); const char* cB = PG8_BBASE(cur);
    PG8_STAGE(PG8_SB(0, 0), cB, voffB); PG8_STAGE(PG8_SB(0, 1), cB + hstepB, voffB); PG8_STAGE(PG8_SA(0, 0), cA, voffA); PG8_STAGE(PG8_SA(0, 1), cA + hstepA, voffA);
    if (wr == 1) PG8_BAR;
    PG8_WAIT_V(2); PG8_BAR;
    PG8_STAGE(PG8_SB(1, 0), cB + kstep, voffB); PG8_STAGE(PG8_SA(1, 0), cA + kstep, voffA); PG8_STAGE(PG8_SB(1, 1), cB + hstepB + kstep, voffB);
    PG8_WAIT_V(6); PG8_BAR;
    for (;;) {
        const bool has_next = S.next(ui + 1, nxt);
        const char* nA = has_next ? PG8_ABASE(nxt) : cA; const char* nB = has_next ? PG8_BBASE(nxt) : cB;
        for (int t = 0; t < nt; t += 2) {
            const bool last = (t == nt - 2);
            const char* a1 = cA + (size_t)(t + 1) * kstep;
            const char* a2 = last ? nA : cA + (size_t)(t + 2) * kstep; const char* b2 = last ? nB : cB + (size_t)(t + 2) * kstep;
            const char* a3 = a2 + kstep; const char* b3 = b2 + kstep;
            PG8_LDB(B0, 0, 0); PG8_LDB(B1, 0, 1); PG8_SCHED; PG8_LDA(At, 0, 0); PG8_STAGE(PG8_SA(1, 1), a1 + hstepA, voffA);
            PG8_WAIT_V(8); PG8_WAIT_L(0); PG8_BAR; PG8_MMA(0, 0, At, B0); PG8_MMA(0, 1, At, B1); PG8_BAR; PG8_SCHED;
            PG8_LDA(At, 0, 1); PG8_STAGE(PG8_SB(0, 0), b2, voffB); PG8_STAGE(PG8_SB(0, 1), b2 + hstepB, voffB); PG8_STAGE(PG8_SA(0, 0), a2, voffA);
            PG8_WAIT_V(8); PG8_WAIT_L(0); PG8_BAR; PG8_MMA(1, 0, At, B0); PG8_MMA(1, 1, At, B1); PG8_BAR; PG8_SCHED;
            PG8_LDB(B0, 1, 0); PG8_LDB(B1, 1, 1); PG8_SCHED; PG8_LDA(At, 1, 0); PG8_STAGE(PG8_SA(0, 1), a2 + hstepA, voffA);
            PG8_WAIT_V(8); PG8_WAIT_L(0); PG8_BAR; PG8_MMA(0, 0, At, B0); PG8_MMA(0, 1, At, B1); PG8_BAR; PG8_SCHED;
            PG8_LDA(At, 1, 1); PG8_STAGE(PG8_SB(1, 0), b3, voffB); PG8_STAGE(PG8_SB(1, 1), b3 + hstepB, voffB); PG8_STAGE(PG8_SA(1, 0), a3, voffA);
            PG8_WAIT_V(8); PG8_WAIT_L(0); PG8_BAR; PG8_MMA(1, 0, At, B0); PG8_MMA(1, 1, At, B1); PG8_BAR; PG8_SCHED;
        }
        if constexpr (ALIGN_EPI) { if (wr == 0) PG8_BAR; }
        { int t2 = threadIdx.x; asm volatile("" : "+v"(t2)); const int l2 = t2 & 63;
          E(acc, cur, wr, wc, l2 & 15, l2 >> 4); }
        if (!has_next) break;
#pragma unroll
        for (int a = 0; a < 2; ++a)
#pragma unroll
            for (int b = 0; b < 2; ++b)
#pragma unroll
                for (int m = 0; m < 4; ++m)
#pragma unroll
                    for (int n = 0; n < 2; ++n) acc[a][b][m][n] = (f32x4){0.f, 0.f, 0.f, 0.f};
        cur = nxt; cA = nA; cB = nB; ++ui;
        if constexpr (ALIGN_EPI) { if (wr == 1) PG8_BAR; }
    }
    PG8_WAIT_V(0);
    if constexpr (!ALIGN_EPI) { if (wr == 0) PG8_BAR; }
    PG8_BAR;
#undef PG8_SA
#undef PG8_SB
#undef PG8_STAGE
#undef PG8_LDA
#undef PG8_LDB
#undef PG8_MMA
#undef PG8_WAIT_V
#undef PG8_WAIT_L
#undef PG8_BAR
#undef PG8_SCHED
#undef PG8_ABASE
#undef PG8_BBASE
}

template <bool NORM> struct EpiBf16Plain {
    static constexpr bool PERM = true;
    bf16_t* O; int ldc; const float* shw; int shw_stride; const unsigned long long* SS;
    __device__ __forceinline__ void operator()(const f32x4 (&acc)[2][2][4][2], const Unit& u, int wr, int wc, int fr, int fq) const {
        const int row0 = u.pm * BM + wr * 64 + fr, col0 = u.pn * BM + wc * 32 + 8 * fq;
        f32x4 bv[2][2];
#pragma unroll
        for (int bj = 0; bj < 2; ++bj)
#pragma unroll
            for (int n = 0; n < 2; ++n) bv[bj][n] = NORM ? *(const f32x4*)(shw + (size_t)(u.pm >> 3) * shw_stride + col0 + bj * HALF + 4 * n) : (f32x4){0.f, 0.f, 0.f, 0.f};
#pragma unroll
        for (int ai = 0; ai < 2; ++ai)
#pragma unroll
            for (int m = 0; m < 4; ++m) { const int row = row0 + ai * HALF + m * 16; bf16_t* rowp = O + (size_t)row * ldc + col0;
                float rs = 1.0f; if (NORM) rs = 1.0f / sqrtf((float)SS[row] * (1.0f / (16777216.0f * D)) + EPS);
#pragma unroll
                for (int bj = 0; bj < 2; ++bj) { const f32x4 v0 = acc[ai][bj][m][0] * rs + bv[bj][0], v1 = acc[ai][bj][m][1] * rs + bv[bj][1];
                    u32x4 w; w.x = cvt_pk_bf16(v0[0], v0[1]); w.y = cvt_pk_bf16(v0[2], v0[3]); w.z = cvt_pk_bf16(v1[0], v1[1]); w.w = cvt_pk_bf16(v1[2], v1[3]);
                    *(u32x4*)(rowp + bj * HALF) = w; } }
    }
};
struct EpiFp8 {
    static constexpr bool PERM = true;
    unsigned char* O; int ldc;
    __device__ __forceinline__ void operator()(const f32x4 (&acc)[2][2][4][2], const Unit& u, int wr, int wc, int fr, int fq) const {
        const int row0 = u.pm * BM + wr * 64 + fr, col0 = u.pn * BM + wc * 32 + 8 * fq;
#pragma unroll
        for (int ai = 0; ai < 2; ++ai)
#pragma unroll
            for (int m = 0; m < 4; ++m) { unsigned char* rowp = O + (size_t)(row0 + ai * HALF + m * 16) * ldc + col0;
#pragma unroll
                for (int bj = 0; bj < 2; ++bj) { const f32x4 v0 = acc[ai][bj][m][0], v1 = acc[ai][bj][m][1];
                    int w0 = 0, w1 = 0;
                    w0 = __builtin_amdgcn_cvt_pk_fp8_f32(v0[0], v0[1], w0, false); w0 = __builtin_amdgcn_cvt_pk_fp8_f32(v0[2], v0[3], w0, true);
                    w1 = __builtin_amdgcn_cvt_pk_fp8_f32(v1[0], v1[1], w1, false); w1 = __builtin_amdgcn_cvt_pk_fp8_f32(v1[2], v1[3], w1, true);
                    u32x2 w; w.x = (unsigned)w0; w.y = (unsigned)w1; *(u32x2*)(rowp + bj * HALF) = w; }
                asm volatile("" ::: "memory"); }
    }
};
struct EpiInA {
    static constexpr bool PERM = true;
    bf16_t* Q; bf16_t* CKV; bf16_t* QI; bf16_t* KIN; float* WI; const float* kg; const float* kb; const float* shw; const unsigned long long* SS;
    __device__ __forceinline__ void operator()(f32x4 (&acc)[2][2][4][2], const Unit& u, int wr, int wc, int fr, int fq) const {
        const int row0 = u.pm * BM + wr * 64 + fr, cl = wc * 32 + 8 * fq;
        {
            const float* sp = shw + (size_t)(u.pm >> 3) * 2048 + u.pn * BM + cl;
            f32x4 bv[2][2];
#pragma unroll
            for (int bj = 0; bj < 2; ++bj)
#pragma unroll
                for (int n = 0; n < 2; ++n) bv[bj][n] = *(const f32x4*)(sp + bj * HALF + 4 * n);
#pragma unroll
            for (int ai = 0; ai < 2; ++ai)
#pragma unroll
                for (int m = 0; m < 4; ++m) { const float rs = 1.0f / sqrtf((float)SS[row0 + ai * HALF + m * 16] * (1.0f / (16777216.0f * D)) + EPS);
#pragma unroll
                    for (int bj = 0; bj < 2; ++bj)
#pragma unroll
                        for (int n = 0; n < 2; ++n) acc[ai][bj][m][n] = acc[ai][bj][m][n] * rs + bv[bj][n]; }
        }
        if (u.pn < 7) {
            bf16_t* base; int ldc, c0;
            if (u.pn < 4) { base = Q; ldc = 1024; c0 = u.pn * 256; } else if (u.pn == 4) { base = CKV; ldc = 256; c0 = 0; } else { base = QI; ldc = 512; c0 = (u.pn - 5) * 256; }
#pragma unroll
            for (int ai = 0; ai < 2; ++ai)
#pragma unroll
                for (int m = 0; m < 4; ++m) { bf16_t* rowp = base + (size_t)(row0 + ai * HALF + m * 16) * ldc + c0 + cl;
#pragma unroll
                    for (int bj = 0; bj < 2; ++bj) { const f32x4 v0 = acc[ai][bj][m][0], v1 = acc[ai][bj][m][1];
                        u32x4 w; w.x = cvt_pk_bf16(v0[0], v0[1]); w.y = cvt_pk_bf16(v0[2], v0[3]); w.z = cvt_pk_bf16(v1[0], v1[1]); w.w = cvt_pk_bf16(v1[2], v1[3]);
                        *(u32x4*)(rowp + bj * HALF) = w; } }
        } else if (wc == 0) {
            f32x4 gv[2][2], bv[2][2];
#pragma unroll
            for (int bj = 0; bj < 2; ++bj)
#pragma unroll
                for (int n = 0; n < 2; ++n) { gv[bj][n] = *(const f32x4*)(kg + 32 * bj + 8 * fq + 4 * n); bv[bj][n] = *(const f32x4*)(kb + 32 * bj + 8 * fq + 4 * n); }
#pragma unroll
            for (int ai = 0; ai < 2; ++ai)
#pragma unroll
                for (int m = 0; m < 4; ++m) {
                    float s = 0.f;
#pragma unroll
                    for (int bj = 0; bj < 2; ++bj)
#pragma unroll
                        for (int n = 0; n < 2; ++n) { const f32x4 x = acc[ai][bj][m][n]; s += (x[0] + x[1]) + (x[2] + x[3]); }
                    s += __shfl_xor(s, 16); s += __shfl_xor(s, 32);
                    const float mu = s * (1.0f / 64.0f); float q = 0.f;
#pragma unroll
                    for (int bj = 0; bj < 2; ++bj)
#pragma unroll
                        for (int n = 0; n < 2; ++n) { const f32x4 d = acc[ai][bj][m][n] - mu; q += (d[0] * d[0] + d[1] * d[1]) + (d[2] * d[2] + d[3] * d[3]); }
                    q += __shfl_xor(q, 16); q += __shfl_xor(q, 32);
                    const float rs = 1.0f / sqrtf(q * (1.0f / 64.0f) + EPS);
                    bf16_t* rowp = KIN + (size_t)(row0 + ai * HALF + m * 16) * 64 + 8 * fq;
#pragma unroll
                    for (int bj = 0; bj < 2; ++bj) { const f32x4 v0 = (acc[ai][bj][m][0] - mu) * rs * gv[bj][0] + bv[bj][0], v1 = (acc[ai][bj][m][1] - mu) * rs * gv[bj][1] + bv[bj][1];
                        u32x4 w; w.x = cvt_pk_bf16(v0[0], v0[1]); w.y = cvt_pk_bf16(v0[2], v0[3]); w.z = cvt_pk_bf16(v1[0], v1[1]); w.w = cvt_pk_bf16(v1[2], v1[3]);
                        *(u32x4*)(rowp + bj * 32) = w; }
                }
        } else if (wc == 1 && fq == 0) {
            const float sc = 0.04419417382415922f;
#pragma unroll
            for (int ai = 0; ai < 2; ++ai)
#pragma unroll
                for (int m = 0; m < 4; ++m) { float* rowp = WI + (size_t)(row0 + ai * HALF + m * 16) * 8;
                    *(f32x4*)(rowp) = acc[ai][0][m][0] * sc; *(f32x4*)(rowp + 4) = acc[ai][0][m][1] * sc; }
        }
    }
};
struct EpiResid {
    static constexpr bool PERM = true;
    const bf16_t* xin_b; bf16_t* xout_b;
    const float* gate; const float* bias;
    bf16_t* XG; const float* gn; const float* scn; unsigned long long* SSo;
    __device__ __forceinline__ void operator()(const f32x4 (&acc)[2][2][4][2], const Unit& u, int wr, int wc, int fr, int fq) const {
        const int row0 = u.pm * BM + wr * 64 + fr, col0 = u.pn * BM + wc * 32 + 8 * fq, b = u.pm >> 3;
        float ssum[2][4];
#pragma unroll
        for (int ai = 0; ai < 2; ++ai)
#pragma unroll
            for (int m = 0; m < 4; ++m) ssum[ai][m] = 0.f;
#pragma unroll
        for (int bj = 0; bj < 2; ++bj) {
            const int c = col0 + bj * HALF;
            const f32x4 gv0 = *(const f32x4*)(gate + (size_t)b * 6144 + c), gv1 = *(const f32x4*)(gate + (size_t)b * 6144 + c + 4);
            f32x4 bv0 = (f32x4){0.f, 0.f, 0.f, 0.f}, bv1 = bv0, gm0 = bv0, gm1 = bv0;
            if (bias) { bv0 = *(const f32x4*)(bias + c); bv1 = *(const f32x4*)(bias + c + 4); }
            if (XG) { gm0 = *(const f32x4*)(gn + c) * (*(const f32x4*)(scn + (size_t)b * 6144 + c) + 1.0f); gm1 = *(const f32x4*)(gn + c + 4) * (*(const f32x4*)(scn + (size_t)b * 6144 + c + 4) + 1.0f); }
#pragma unroll
            for (int ai = 0; ai < 2; ++ai)
#pragma unroll
                for (int m = 0; m < 4; ++m) { const size_t off = (size_t)(row0 + ai * HALF + m * 16) * D + c;
                    const u32x4 xv = *(const u32x4*)(xin_b + off);
                    const f32x4 xi0 = (f32x4){__uint_as_float(xv.x << 16), __uint_as_float(xv.x & 0xffff0000u), __uint_as_float(xv.y << 16), __uint_as_float(xv.y & 0xffff0000u)};
                    const f32x4 xi1 = (f32x4){__uint_as_float(xv.z << 16), __uint_as_float(xv.z & 0xffff0000u), __uint_as_float(xv.w << 16), __uint_as_float(xv.w & 0xffff0000u)};
                    const f32x4 xo0 = xi0 + gv0 * (acc[ai][bj][m][0] + bv0), xo1 = xi1 + gv1 * (acc[ai][bj][m][1] + bv1);
                    { u32x4 w; w.x = cvt_pk_bf16(xo0[0], xo0[1]); w.y = cvt_pk_bf16(xo0[2], xo0[3]); w.z = cvt_pk_bf16(xo1[0], xo1[1]); w.w = cvt_pk_bf16(xo1[2], xo1[3]); *(u32x4*)(xout_b + off) = w; }
                    if (XG) {
                        ssum[ai][m] += ((xo0[0] * xo0[0] + xo0[1] * xo0[1]) + (xo0[2] * xo0[2] + xo0[3] * xo0[3])) + ((xo1[0] * xo1[0] + xo1[1] * xo1[1]) + (xo1[2] * xo1[2] + xo1[3] * xo1[3]));
                        const f32x4 y0 = xo0 * gm0, y1 = xo1 * gm1;
                        u32x4 w; w.x = cvt_pk_bf16(y0[0], y0[1]); w.y = cvt_pk_bf16(y0[2], y0[3]); w.z = cvt_pk_bf16(y1[0], y1[1]); w.w = cvt_pk_bf16(y1[2], y1[3]);
                        *(u32x4*)(XG + off) = w; }
                    if (m & 1) asm volatile("" ::: "memory"); }
        }
        if (XG) {
#pragma unroll
            for (int ai = 0; ai < 2; ++ai)
#pragma unroll
                for (int m = 0; m < 4; ++m) { float q = ssum[ai][m]; q += __shfl_xor(q, 16); q += __shfl_xor(q, 32);
                    if (fq == 0) atomicAdd(SSo + row0 + ai * HALF + m * 16, (unsigned long long)(q * 16777216.0f)); }
        }
    }
};
struct EpiSwiGLU {
    static constexpr bool PERM = true;
    bf16_t* H; const float* shw; const unsigned long long* SS;
    __device__ __forceinline__ void operator()(const f32x4 (&acc)[2][2][4][2], const Unit& u, int wr, int wc, int fr, int fq) const {
        const int row0 = u.pm * BM + wr * 64 + fr, f0 = u.pn * 128 + wc * 32 + 8 * fq;
        f32x4 bv[2][2];
        { const float* sp = shw + (size_t)(u.pm >> 3) * (2 * DFF) + u.pn * BM + wc * 32 + 8 * fq;
#pragma unroll
          for (int bj = 0; bj < 2; ++bj)
#pragma unroll
              for (int n = 0; n < 2; ++n) bv[bj][n] = *(const f32x4*)(sp + bj * HALF + 4 * n); }
#pragma unroll
        for (int ai = 0; ai < 2; ++ai)
#pragma unroll
            for (int m = 0; m < 4; ++m) { bf16_t* rowp = H + (size_t)(row0 + ai * HALF + m * 16) * DFF + f0;
                const float rs = 1.0f / sqrtf((float)SS[row0 + ai * HALF + m * 16] * (1.0f / (16777216.0f * D)) + EPS);
                float o[8];
#pragma unroll
                for (int n = 0; n < 2; ++n)
#pragma unroll
                    for (int e = 0; e < 4; ++e) o[4 * n + e] = silu_f(acc[ai][0][m][n][e] * rs + bv[0][n][e]) * (acc[ai][1][m][n][e] * rs + bv[1][n][e]);
                u32x4 w; w.x = cvt_pk_bf16(o[0], o[1]); w.y = cvt_pk_bf16(o[2], o[3]); w.z = cvt_pk_bf16(o[4], o[5]); w.w = cvt_pk_bf16(o[6], o[7]);
                *(u32x4*)(rowp) = w; }
    }
};
}

struct Ptrs {
    const float* in[23]; float* out; unsigned char* ws;
};
enum { I_X = 0, I_C, I_RELB, I_WADA, I_BADA, I_GMIX, I_GFFN, I_AWIN, I_AKVG, I_AWUK, I_AWUV, I_AIKG, I_AIKB, I_AWOUT, I_BWIN, I_BBIN, I_BSINK, I_BWOUT, I_BBOUT, I_W1, I_W3, I_W2, I_GFIN };

__device__ __forceinline__ void conv_task(const Ptrs& P, int t, int lane) {
    int kind, rb, ks, Kd; bf16_t* dst; const float* s0 = nullptr; const float* s1 = nullptr; const float* gk = nullptr; int ld = 0;
    if (t < 2112) { const int l = t / 528, r = t % 528; unsigned char* wl = P.ws + WS_W + (size_t)l * W_LAYER;
        if (r < 352) { kind = 1; rb = r >> 2; ks = r & 3; Kd = 1024; dst = (bf16_t*)(wl + W13_OFF); s0 = P.in[I_W1] + (size_t)l * D * DFF; s1 = P.in[I_W3] + (size_t)l * D * DFF; ld = DFF; }
        else { const int r2 = r - 352; kind = 0; rb = r2 / 11; ks = r2 % 11; Kd = DFF; dst = (bf16_t*)(wl + W2_OFF); s0 = P.in[I_W2] + (size_t)l * DFF * D; ld = D; }
    } else { const int t2 = t - 2112, j = t2 / 464, r = t2 % 464; unsigned char* wa = P.ws + WS_WA + (size_t)j * WA_STRIDE; unsigned char* wb = P.ws + WS_WB + (size_t)j * WB_STRIDE;
        if (r < 128) { kind = 2; rb = r >> 2; ks = r & 3; Kd = 1024; dst = (bf16_t*)(wa + WINA_OFF); s0 = P.in[I_AWIN] + (size_t)j * D * A_IN; ld = A_IN; }
        else if (r < 192) { kind = 3; rb = r - 128; ks = 0; Kd = 256; dst = (bf16_t*)(wa + WQA_OFF); s0 = P.in[I_AWUK] + (size_t)j * NH * RK * HD; gk = P.in[I_AKVG] + j * RK; }
        else if (r < 256) { const int r2 = r - 192; kind = 4; rb = r2 >> 2; ks = r2 & 3; Kd = 1024; dst = (bf16_t*)(wa + WUV_OFF); s0 = P.in[I_AWUV] + (size_t)j * NH * RK * HD; gk = P.in[I_AKVG] + j * RK; }
        else if (r < 320) { const int r2 = r - 256; kind = 0; rb = r2 >> 2; ks = r2 & 3; Kd = 1024; dst = (bf16_t*)(wa + WOUTA_OFF); s0 = P.in[I_AWOUT] + (size_t)j * D * D; ld = D; }
        else if (r < 400) { const int r2 = r - 320; kind = 0; rb = r2 >> 2; ks = r2 & 3; Kd = 1024; dst = (bf16_t*)(wb + WINB_OFF); s0 = P.in[I_BWIN] + (size_t)j * D * B_IN; ld = B_IN; }
        else { const int r2 = r - 400; kind = 0; rb = r2 >> 2; ks = r2 & 3; Kd = 1024; dst = (bf16_t*)(wb + WOUTB_OFF); s0 = P.in[I_BWOUT] + (size_t)j * D * D; ld = D; }
    }
    const int n = rb * 64 + lane, k0 = ks * 256;
    bf16_t* drow = dst + (size_t)n * Kd + k0;
    if (kind <= 2) {
        const float* src = s0; int col = n;
        if (kind == 1) { const int c = n & 255, f = (n >> 8) * 128 + (c & 127); src = (c < 128) ? s0 : s1; col = f; }
        if (kind == 2) { if (n >= 1792) { const int c = n - 1792; col = c < 32 ? 1792 + c : (c < 40 ? 1856 + (c - 32) : ((c >= 128 && c < 160) ? 1824 + (c - 128) : -1)); } }
        const float* sp = src + (size_t)k0 * ld + (col < 0 ? 0 : col);
        for (int kc = 0; kc < 32; ++kc) {
            float v[8];
#pragma unroll
            for (int e = 0; e < 8; ++e) v[e] = sp[(size_t)(kc * 8 + e) * ld];
            if (col < 0) {
#pragma unroll
                for (int e = 0; e < 8; ++e) v[e] = 0.f; }
            u32x4 w; w.x = cvt_pk_bf16(v[0], v[1]); w.y = cvt_pk_bf16(v[2], v[3]); w.z = cvt_pk_bf16(v[4], v[5]); w.w = cvt_pk_bf16(v[6], v[7]);
            *(u32x4*)(drow + kc * 8) = w;
        }
    } else if (kind == 3) {
        const int h = n >> 8, r = n & 255; const float gs = gk[r] * 8.0f;       const float* sp = s0 + ((size_t)h * RK + r) * HD;
        for (int kc = 0; kc < 32; ++kc) { const int k = kc * 8; float v[8];
            if ((k >> 6) == (h & 3)) {
#pragma unroll
                for (int e = 0; e < 8; ++e) v[e] = sp[(k & 63) + e] * gs;
            } else {
#pragma unroll
                for (int e = 0; e < 8; ++e) v[e] = 0.f; }
            u32x4 w; w.x = cvt_pk_bf16(v[0], v[1]); w.y = cvt_pk_bf16(v[2], v[3]); w.z = cvt_pk_bf16(v[4], v[5]); w.w = cvt_pk_bf16(v[6], v[7]);
            *(u32x4*)(drow + kc * 8) = w; }
    } else {
        const int hh = (n >> 6) & 3, d = n & 63, h = n >> 6;
        for (int kc = 0; kc < 32; ++kc) { const int k = k0 + kc * 8; float v[8];
            if ((k >> 8) == hh) {
#pragma unroll
                for (int e = 0; e < 8; ++e) { const int r = (k & 255) + e; v[e] = s0[((size_t)h * RK + r) * HD + d] * gk[r]; }
            } else {
#pragma unroll
                for (int e = 0; e < 8; ++e) v[e] = 0.f; }
            u32x4 w; w.x = cvt_pk_bf16(v[0], v[1]); w.y = cvt_pk_bf16(v[2], v[3]); w.z = cvt_pk_bf16(v[4], v[5]); w.w = cvt_pk_bf16(v[6], v[7]);
            *(u32x4*)(drow + kc * 8) = w; }
    }
}
constexpr int N_CONV_TASKS = 3040;

__device__ __forceinline__ void p0_prologue(const Ptrs& P, LAS unsigned char* lds, int G) {
    int tid = threadIdx.x; asm volatile("" : "+v"(tid));
    const int lane = tid & 63, wave = __builtin_amdgcn_readfirstlane(tid >> 6);
    const int gw = blockIdx.x * NWAVES + wave, NGW = G * NWAVES;
    for (int t = gw; t < N_CONV_TASKS; t += NGW) conv_task(P, t, lane);
    LAS float* cs = (LAS float*)lds;
    LAS float* red = (LAS float*)(lds + 65536);
    for (int i = tid; i < BATCH * D; i += NTHR) { const int b = i >> 10, k = i & 1023; cs[k * 16 + b] = silu_f(P.in[I_C][i]); }
    __syncthreads();
    float* mod = (float*)(P.ws + WS_MOD);
    for (int task = blockIdx.x; task < 4 * 96; task += G) {
        const int l = task / 96, j0 = (task % 96) * 64, col = tid & 63, ksl = tid >> 6;
        const float* wp = P.in[I_WADA] + ((size_t)l * D + ksl * 128) * 6144 + j0 + col;
        float a[16];
#pragma unroll
        for (int b = 0; b < 16; ++b) a[b] = 0.f;
        for (int k = 0; k < 128; ++k) { const float w = wp[(size_t)k * 6144]; const LAS f32x4* c4 = (const LAS f32x4*)(cs + (ksl * 128 + k) * 16);
#pragma unroll
            for (int q = 0; q < 4; ++q) { const f32x4 c = c4[q];
#pragma unroll
                for (int e = 0; e < 4; ++e) a[4 * q + e] += w * c[e]; } }
#pragma unroll
        for (int b = 0; b < 16; ++b) red[(ksl * 64 + col) * 16 + b] = a[b];
        __syncthreads();
        for (int o = tid; o < 1024; o += NTHR) { const int c2 = o >> 4, b = o & 15; float s = 0.f;
#pragma unroll
            for (int q = 0; q < 8; ++q) s += red[(q * 64 + c2) * 16 + b];
            mod[((size_t)l * BATCH + b) * 6144 + j0 + c2] = s + P.in[I_BADA][l * 6144 + j0 + c2]; }
        __syncthreads();
    }
}

__device__ __forceinline__ void pre_phase(const Ptrs& P, LAS unsigned char* lds, int G) {
    int tid = threadIdx.x; asm volatile("" : "+v"(tid));
    const int lane = tid & 63, wave = __builtin_amdgcn_readfirstlane(tid >> 6);
    const float* mod = (const float*)(P.ws + WS_MOD);
    {
        const int grp = blockIdx.x & 7, l = grp >> 1, kind = grp & 1, j = l >> 1;
        const float* shsrc = mod + (size_t)l * BATCH * 6144 + (kind ? 3072 : 0);
        constexpr int SP = 2064;
        for (int i = tid; i < BATCH * D / 2; i += NTHR) { const int b = i >> 9, k2 = (i & 511) * 2;
            const float a0 = shsrc[(size_t)b * 6144 + k2], a1 = shsrc[(size_t)b * 6144 + k2 + 1];
            *(LAS unsigned*)(lds + b * SP + k2 * 2) = cvt_pk_bf16(a0, a1); }
        __syncthreads();
        const bf16_t* W; int nrows; float* dst; const float* bias = nullptr;
        if (kind) { W = (const bf16_t*)(P.ws + WS_W + (size_t)l * W_LAYER + W13_OFF); nrows = 2 * DFF; dst = (float*)(P.ws + WS_SHW + SHW_F) + (size_t)l * BATCH * 2 * DFF; }
        else if ((l & 1) == 0) { W = (const bf16_t*)(P.ws + WS_WA + (size_t)j * WA_STRIDE + WINA_OFF); nrows = 2048; dst = (float*)(P.ws + WS_SHW + SHW_A) + (size_t)j * BATCH * 2048; }
        else { W = (const bf16_t*)(P.ws + WS_WB + (size_t)j * WB_STRIDE + WINB_OFF); nrows = B_IN; dst = (float*)(P.ws + WS_SHW + SHW_B) + (size_t)j * BATCH * B_IN; bias = P.in[I_BBIN] + j * B_IN; }
        const int nblk = nrows >> 4, wq = (blockIdx.x >> 3) * NWAVES + wave, nwq = (G >> 3) * NWAVES;
        const int nn = lane & 15, g = lane >> 4;
        for (int blk = wq; blk < nblk; blk += nwq) {
            f32x4 acc = (f32x4){0.f, 0.f, 0.f, 0.f};
            const bf16_t* wp = W + (size_t)(blk * 16 + nn) * D + 8 * g;
#pragma unroll 8
            for (int ks = 0; ks < 32; ++ks) { const bf16x8 a = *(const LAS bf16x8*)(lds + nn * SP + (32 * ks + 8 * g) * 2); const bf16x8 bw = *(const bf16x8*)(wp + 32 * ks);
                acc = __builtin_amdgcn_mfma_f32_16x16x32_bf16(a, bw, acc, 0, 0, 0); }
            const int n = blk * 16 + nn; const float bb = bias ? bias[n] : 0.f;
#pragma unroll
            for (int i = 0; i < 4; ++i) dst[(size_t)(4 * g + i) * nrows + n] = acc[i] + bb;
        }
    }
    {
        const int gw = blockIdx.x * NWAVES + wave, NGW = G * NWAVES;
        const float* x = P.in[I_X]; const float* gmix = P.in[I_GMIX]; bf16_t* XG = (bf16_t*)(P.ws + WS_XG); unsigned long long* SS0 = (unsigned long long*)(P.ws + WS_SS);
        for (int row = gw; row < M; row += NGW) {
            const int b = row >> 11;
            const f32x4* xr = (const f32x4*)(x + (size_t)row * D) + lane;
            f32x4 v[4]; float sq = 0.f;
#pragma unroll
            for (int jj = 0; jj < 4; ++jj) { v[jj] = xr[64 * jj]; sq += (v[jj][0] * v[jj][0] + v[jj][1] * v[jj][1]) + (v[jj][2] * v[jj][2] + v[jj][3] * v[jj][3]); }
            const float ss = wave_sum(sq);
            if (lane == 0) SS0[row] = (unsigned long long)(ss * 16777216.0f);
            const float* mb = mod + (size_t)b * 6144;
            u32x2* o8 = (u32x2*)(XG + (size_t)row * D) + lane; u32x2* x8 = (u32x2*)((bf16_t*)P.out + (size_t)row * D) + lane;
#pragma unroll
            for (int jj = 0; jj < 4; ++jj) { const int c = 4 * lane + 256 * jj;
                const f32x4 y = v[jj] * *(const f32x4*)(gmix + c) * (*(const f32x4*)(mb + 1024 + c) + 1.0f);
                u32x2 w; w.x = cvt_pk_bf16(y[0], y[1]); w.y = cvt_pk_bf16(y[2], y[3]); o8[64 * jj] = w;
                u32x2 xw; xw.x = cvt_pk_bf16(v[jj][0], v[jj][1]); xw.y = cvt_pk_bf16(v[jj][2], v[jj][3]); x8[64 * jj] = xw; }
        }
    }
}
__device__ __forceinline__ void final_norm_phase(const bf16_t* x, float* out, const float* g, int G) {
    int tid = threadIdx.x; asm volatile("" : "+v"(tid));
    const int lane = tid & 63, wave = __builtin_amdgcn_readfirstlane(tid >> 6);
    const int gw = blockIdx.x * NWAVES + wave, NGW = G * NWAVES;
    for (int row = gw; row < M; row += NGW) {
        const u32x2* xr = (const u32x2*)(x + (size_t)row * D) + lane; f32x4* orow = (f32x4*)(out + (size_t)row * D) + lane;
        f32x4 v[4]; float s = 0.f;
#pragma unroll
        for (int j = 0; j < 4; ++j) { const u32x2 p = xr[64 * j];
            v[j] = (f32x4){__uint_as_float(p.x << 16), __uint_as_float(p.x & 0xffff0000u), __uint_as_float(p.y << 16), __uint_as_float(p.y & 0xffff0000u)};
            s += (v[j][0] * v[j][0] + v[j][1] * v[j][1]) + (v[j][2] * v[j][2] + v[j][3] * v[j][3]); }
        const float rstd = 1.0f / sqrtf(wave_sum(s) * (1.0f / D) + EPS);
#pragma unroll
        for (int j = 0; j < 4; ++j) { const f32x4 gg = *(const f32x4*)(g + 4 * lane + 256 * j); orow[64 * j] = v[j] * rstd * gg; }
    }
}

__device__ __forceinline__ unsigned f2key(float f) { const unsigned u = __float_as_uint(f); return (u & 0x80000000u) ? ~u : (u | 0x80000000u); }
__device__ __forceinline__ float key2f(unsigned k) { return __uint_as_float((k & 0x80000000u) ? (k & 0x7fffffffu) : ~k); }
__device__ __forceinline__ float half_max(float x) {
    int u = __float_as_int(x);
    u = __float_as_int(fmaxf(__int_as_float(u), __int_as_float(__builtin_amdgcn_update_dpp(u, u, 0x128, 0xf, 0xf, false))));
    u = __float_as_int(fmaxf(__int_as_float(u), __int_as_float(__builtin_amdgcn_update_dpp(u, u, 0x124, 0xf, 0xf, false))));
    u = __float_as_int(fmaxf(__int_as_float(u), __int_as_float(__builtin_amdgcn_update_dpp(u, u, 0x122, 0xf, 0xf, false))));
    u = __float_as_int(fmaxf(__int_as_float(u), __int_as_float(__builtin_amdgcn_update_dpp(u, u, 0x121, 0xf, 0xf, false))));
    const u32x2 r = __builtin_amdgcn_permlane16_swap((unsigned)u, (unsigned)u, false, false);
    return fmaxf(__uint_as_float(r.x), __uint_as_float(r.y));
}
__device__ __forceinline__ int half_sum(int v) {
    v += __builtin_amdgcn_update_dpp(v, v, 0x128, 0xf, 0xf, false);
    v += __builtin_amdgcn_update_dpp(v, v, 0x124, 0xf, 0xf, false);
    v += __builtin_amdgcn_update_dpp(v, v, 0x122, 0xf, 0xf, false);
    v += __builtin_amdgcn_update_dpp(v, v, 0x121, 0xf, 0xf, false);
    const u32x2 r = __builtin_amdgcn_permlane16_swap((unsigned)v, (unsigned)v, false, false);
    return (int)(r.x + r.y);
}
typedef float f32x32 __attribute__((ext_vector_type(32)));
__device__ __forceinline__ void idx_task(const bf16_t* QI, const bf16_t* KIN, const float* WI, unsigned* SEL, LAS unsigned char* lds, int b, int tg, int lane, int wave, bool active, int nrounds) {
    asm volatile("" : "+v"(lane));
    const int t0 = tg * 4, h = lane >> 5, r = lane & 31;
    const int qsel = 2 * (r >> 4) + ((r >> 2) & 1), hd = (r & 3) + 4 * ((r >> 3) & 1);
    const size_t rowb = (size_t)b * SEQ;
    bf16x8 aq[4];
#pragma unroll
    for (int ks = 0; ks < 4; ++ks) aq[ks] = *(const bf16x8*)(QI + (rowb + t0 + qsel) * 512 + hd * 64 + ks * 16 + h * 8);
    float wlo[8], whi[8];
    { const f32x4 a0 = *(const f32x4*)(WI + (rowb + t0 + h) * 8), a1 = *(const f32x4*)(WI + (rowb + t0 + h) * 8 + 4);
      const f32x4 b0 = *(const f32x4*)(WI + (rowb + t0 + 2 + h) * 8), b1 = *(const f32x4*)(WI + (rowb + t0 + 2 + h) * 8 + 4);
#pragma unroll
      for (int e = 0; e < 4; ++e) { wlo[e] = a0[e]; wlo[4 + e] = a1[e]; whi[e] = b0[e]; whi[4 + e] = b1[e]; } }
    f32x32 sA0, sA1, sB0, sB1;
#pragma unroll
    for (int i = 0; i < 32; ++i) { sA0[i] = NEGF; sA1[i] = NEGF; sB0[i] = NEGF; sB1[i] = NEGF; }
    const int ktmax = (t0 + 3) >> 5, tlo = t0 + h, thi = t0 + 2 + h;
    const unsigned lb = (unsigned)(size_t)lds;
    const int sw = (r >> 1) & 7;
#define IDX_LDS4(R0, R1, R2, R3) asm volatile("ds_read_b128 %0, %4\n\tds_read_b128 %1, %5\n\tds_read_b128 %2, %6\n\tds_read_b128 %3, %7" \
                                             : "=&v"(R0), "=&v"(R1), "=&v"(R2), "=&v"(R3) : "v"(a0), "v"(a1), "v"(a2), "v"(a3) : "memory")
#define IDX_TILE(KTL, KEY0, SA, SB, C0, C1, C2, C3, N0, N1, N2, N3) \
        { \
            a0 += 4096u; a1 += 4096u; a2 += 4096u; a3 += 4096u; \
            IDX_LDS4(N0, N1, N2, N3);                          \
            asm volatile("s_waitcnt lgkmcnt(4)" : "+v"(C0), "+v"(C1), "+v"(C2), "+v"(C3) :: "memory");     \
            f32x16 acc; \
            _Pragma("unroll") for (int i = 0; i < 16; ++i) acc[i] = 0.f; \
            acc = __builtin_amdgcn_mfma_f32_32x32x16_bf16(aq[0], C0, acc, 0, 0, 0); acc = __builtin_amdgcn_mfma_f32_32x32x16_bf16(aq[1], C1, acc, 0, 0, 0); \
            acc = __builtin_amdgcn_mfma_f32_32x32x16_bf16(aq[2], C2, acc, 0, 0, 0); acc = __builtin_amdgcn_mfma_f32_32x32x16_bf16(aq[3], C3, acc, 0, 0, 0); \
            float s0 = 0.f, s1 = 0.f; \
            _Pragma("unroll") for (int i = 0; i < 8; ++i) { s0 += wlo[i] * __builtin_amdgcn_fmed3f(acc[i], 0.f, 3.0e38f); s1 += whi[i] * __builtin_amdgcn_fmed3f(acc[8 + i], 0.f, 3.0e38f); }     \
            const int key = (KEY0) + r; \
            SA[KTL] = key <= tlo ? s0 : NEGF; SB[KTL] = key <= thi ? s1 : NEGF; \
        }
    bf16x8 ta0, ta1, ta2, ta3, tb0, tb1, tb2, tb3;
#pragma unroll
    for (int rnd = 0; rnd < 2; ++rnd) {
        if (rnd >= nrounds) break;
        __syncthreads();
        {
            const int rl = lane >> 3, pp = lane & 7;
#pragma unroll 4
            for (int j = 0; j < 16; ++j) { const int pi = wave * 16 + j, row = 8 * pi + rl;
                const bf16_t* src = KIN + (rowb + 1024 * rnd + row) * 64 + 8 * (pp ^ ((row >> 1) & 7));
                __builtin_amdgcn_global_load_lds((const unsigned*)src, (LAS unsigned*)(lds + 1024 * pi), 16, 0, 0); }
        }
        asm volatile("s_waitcnt vmcnt(0)" ::: "memory");
        __syncthreads();
        const int ntl = ktmax - 32 * rnd + 1;
        if (active && ntl > 0) {
            const int npair = ((ntl < 32 ? ntl : 32) + 1) >> 1;
            unsigned a0 = lb + (unsigned)r * 128u + 16u * (unsigned)((0 + h) ^ sw), a1 = lb + (unsigned)r * 128u + 16u * (unsigned)((2 + h) ^ sw);
            unsigned a2 = lb + (unsigned)r * 128u + 16u * (unsigned)((4 + h) ^ sw), a3 = lb + (unsigned)r * 128u + 16u * (unsigned)((6 + h) ^ sw);
            IDX_LDS4(ta0, ta1, ta2, ta3);
#pragma nounroll
            for (int kp = 0; kp < npair; ++kp) {
                if (rnd == 0) { IDX_TILE(2 * kp, 64 * kp, sA0, sB0, ta0, ta1, ta2, ta3, tb0, tb1, tb2, tb3)
                                IDX_TILE(2 * kp + 1, 64 * kp + 32, sA0, sB0, tb0, tb1, tb2, tb3, ta0, ta1, ta2, ta3) }
                else          { IDX_TILE(2 * kp, 1024 + 64 * kp, sA1, sB1, ta0, ta1, ta2, ta3, tb0, tb1, tb2, tb3)
                                IDX_TILE(2 * kp + 1, 1024 + 64 * kp + 32, sA1, sB1, tb0, tb1, tb2, tb3, ta0, ta1, ta2, ta3) }
            }
            asm volatile("s_waitcnt lgkmcnt(0)" : "+v"(ta0), "+v"(ta1), "+v"(ta2), "+v"(ta3), "+v"(tb0), "+v"(tb1), "+v"(tb2), "+v"(tb3) :: "memory");
        }
    }
#undef IDX_TILE
#undef IDX_LDS4
    if (!active) return;
    const int nt0 = ktmax < 31 ? ktmax + 1 : 32, nt1 = ktmax - 31;
    float mxA = NEGF, mxB = NEGF, mnA = -NEGF, mnB = -NEGF;
#pragma nounroll
    for (int kt = 0; kt < nt0; ++kt) { const float a = sA0[kt], bb = sB0[kt];
        mxA = fmaxf(mxA, a); mxB = fmaxf(mxB, bb); mnA = fminf(mnA, a > -1e29f ? a : -NEGF); mnB = fminf(mnB, bb > -1e29f ? bb : -NEGF); }
#pragma nounroll
    for (int kt = 0; kt < nt1; ++kt) { const float a = sA1[kt], bb = sB1[kt];
        mxA = fmaxf(mxA, a); mxB = fmaxf(mxB, bb); mnA = fminf(mnA, a > -1e29f ? a : -NEGF); mnB = fminf(mnB, bb > -1e29f ? bb : -NEGF); }
    mxA = half_max(mxA); mxB = half_max(mxB); mnA = -half_max(-mnA); mnB = -half_max(-mnB);
    const int Ka = tlo + 1 < TOPK ? tlo + 1 : TOPK, Kb = thi + 1 < TOPK ? thi + 1 : TOPK;
    float loA = mnA, hiA = mxA, loB = mnB, hiB = mxB;
    float cloA = (float)(tlo + 1), chiA = 1.0f, cloB = (float)(thi + 1), chiB = 1.0f;
    float TA = -1e29f, TB = -1e29f; bool doneA = (tlo + 1 <= TOPK), doneB = (thi + 1 <= TOPK);
    const int nblk = (ktmax >> 3) + 1;
#define SA(i) ((i) < 32 ? sA0[(i) & 31] : sA1[(i) & 31])
#define SB(i) ((i) < 32 ? sB0[(i) & 31] : sB1[(i) & 31])
#pragma nounroll
    for (int it = 0; it < 48; ++it) {
        if (__ballot(!doneA || !doneB) == 0ull) break;
        const bool bis = (it % 3) == 2;
        const float wA = hiA - loA, wB = hiB - loB;
        float rA = bis ? 0.5f : (cloA - (float)Ka + 0.5f) / (cloA - chiA), rB = bis ? 0.5f : (cloB - (float)Kb + 0.5f) / (cloB - chiB);
        rA = fminf(fmaxf(rA, 0.03f), 0.97f); rB = fminf(fmaxf(rB, 0.03f), 0.97f);
        const float midA = loA + wA * rA, midB = loB + wB * rB;
        const float fA = doneA ? TA : midA, fB = doneB ? TB : midB;
        int cA = 0, cB = 0;
#pragma unroll
        for (int blk = 0; blk < 8; ++blk) {
            if (blk < nblk) {
#pragma unroll
                for (int e = 0; e < 8; ++e) { cA += (SA(8 * blk + e) >= fA) ? 1 : 0; cB += (SB(8 * blk + e) >= fB) ? 1 : 0; }
            }
        }
        cA = half_sum(cA); cB = half_sum(cB);
        const bool stuckA = !(midA > loA && midA < hiA), stuckB = !(midB > loB && midB < hiB);
        if (!doneA) { if (cA == Ka) { TA = fA; doneA = true; } else if (stuckA) { TA = loA; doneA = true; } else if (cA > Ka) { loA = midA; cloA = (float)cA; } else { hiA = midA; chiA = (float)cA; } }
        if (!doneB) { if (cB == Kb) { TB = fB; doneB = true; } else if (stuckB) { TB = loB; doneB = true; } else if (cB > Kb) { loB = midB; cloB = (float)cB; } else { hiB = midB; chiB = (float)cB; } }
    }
#undef SA
#undef SB
    if (!doneA) TA = loA;
    if (!doneB) TB = loB;
    unsigned w0 = 0u, w1 = 0u, w2 = 0u, w3 = 0u;
#pragma nounroll
    for (int kt = 0; kt < nt0; ++kt) { const unsigned long long ma = __ballot(sA0[kt] >= TA), mb = __ballot(sB0[kt] >= TB);
        if (lane == kt) { w0 = (unsigned)ma; w1 = (unsigned)(ma >> 32); w2 = (unsigned)mb; w3 = (unsigned)(mb >> 32); } }
#pragma nounroll
    for (int kt = 0; kt < nt1; ++kt) { const unsigned long long ma = __ballot(sA1[kt] >= TA), mb = __ballot(sB1[kt] >= TB);
        if (lane == 32 + kt) { w0 = (unsigned)ma; w1 = (unsigned)(ma >> 32); w2 = (unsigned)mb; w3 = (unsigned)(mb >> 32); } }
    SEL[(rowb + t0 + 0) * 64 + lane] = w0; SEL[(rowb + t0 + 1) * 64 + lane] = w1; SEL[(rowb + t0 + 2) * 64 + lane] = w2; SEL[(rowb + t0 + 3) * 64 + lane] = w3;
}

#define ATT_F(r) ((((r) & 7) << 1) | (((r) >> 3) & 1))
#define TRB8(OFS, r0, r1, r2, r3, r4, r5, r6, r7, a0, a1, a2, a3, a4, a5, a6, a7) \
    asm volatile("ds_read_b64_tr_b16 %0, %8 offset:" OFS "\n\tds_read_b64_tr_b16 %1, %9 offset:" OFS "\n\tds_read_b64_tr_b16 %2, %10 offset:" OFS "\n\tds_read_b64_tr_b16 %3, %11 offset:" OFS "\n\t" \
                 "ds_read_b64_tr_b16 %4, %12 offset:" OFS "\n\tds_read_b64_tr_b16 %5, %13 offset:" OFS "\n\tds_read_b64_tr_b16 %6, %14 offset:" OFS "\n\tds_read_b64_tr_b16 %7, %15 offset:" OFS "\n\ts_waitcnt lgkmcnt(0)" \
                 : "=&v"(r0), "=&v"(r1), "=&v"(r2), "=&v"(r3), "=&v"(r4), "=&v"(r5), "=&v"(r6), "=&v"(r7) \
                 : "v"(a0), "v"(a1), "v"(a2), "v"(a3), "v"(a4), "v"(a5), "v"(a6), "v"(a7) : "memory")
#define RDK8(OFS, r, a) \
    asm volatile("ds_read_b64 %0, %8 offset:" OFS "\n\tds_read_b64 %1, %9 offset:" OFS "\n\tds_read_b64 %2, %10 offset:" OFS "\n\tds_read_b64 %3, %11 offset:" OFS "\n\t" \
                 "ds_read_b64 %4, %12 offset:" OFS "\n\tds_read_b64 %5, %13 offset:" OFS "\n\tds_read_b64 %6, %14 offset:" OFS "\n\tds_read_b64 %7, %15 offset:" OFS "\n\ts_waitcnt lgkmcnt(0)" \
                 : "=&v"(r[0]), "=&v"(r[1]), "=&v"(r[2]), "=&v"(r[3]), "=&v"(r[4]), "=&v"(r[5]), "=&v"(r[6]), "=&v"(r[7]) \
                 : "v"(a[0]), "v"(a[1]), "v"(a[2]), "v"(a[3]), "v"(a[4]), "v"(a[5]), "v"(a[6]), "v"(a[7]) : "memory")
__device__ __forceinline__ float rows_max(float x) {
    unsigned u = __float_as_uint(x);
    u32x2 r = __builtin_amdgcn_permlane16_swap(u, u, false, false);
    u = __float_as_uint(fmaxf(__uint_as_float(r.x), __uint_as_float(r.y)));
    r = __builtin_amdgcn_permlane32_swap(u, u, false, false);
    return fmaxf(__uint_as_float(r.x), __uint_as_float(r.y));
}
__device__ __forceinline__ float rows_sum(float x) {
    unsigned u = __float_as_uint(x);
    u32x2 r = __builtin_amdgcn_permlane16_swap(u, u, false, false);
    u = __float_as_uint(__uint_as_float(r.x) + __uint_as_float(r.y));
    r = __builtin_amdgcn_permlane32_swap(u, u, false, false);
    return __uint_as_float(r.x) + __uint_as_float(r.y);
}

__device__ __forceinline__ int att_build_list(LAS unsigned* list, const LAS unsigned* btab, unsigned w, int t, int lane) {
    const int pc = __popc(w); int incl = pc;
#pragma unroll
    for (int o = 1; o < 64; o <<= 1) { const int v = __shfl_up(incl, o); if (lane >= o) incl += v; }
    const int total = __shfl(incl, 63); const int cnt = total < TOPK ? total : TOPK;
    int off = incl - pc;
    while (w) { const int bit = __builtin_ctz(w); w &= w - 1u;
        if (off < TOPK) { const int idx = 32 * lane + bit; int dd = t - idx; dd = dd < 0 ? 0 : (dd > 128 ? 128 : dd); list[off] = (unsigned)idx | (btab[dd] << 16); }
        ++off; }
    for (int sl = cnt + lane; sl < ((cnt + 31) & ~31); sl += 64) list[sl] = 0u;
    return cnt;
}
__device__ __forceinline__ void att_gather32(const unsigned char* CKV8b, const LAS unsigned* list32, LAS unsigned char* slot, int lane) {
    const LAS unsigned* lp = list32 + (lane >> 4);
    unsigned idx[8];
#pragma unroll
    for (int i = 0; i < 8; ++i) idx[i] = lp[4 * i] & 0xffffu;
#pragma unroll
    for (int i = 0; i < 8; ++i) {
        const int rr = 4 * i + (lane >> 4);
        const unsigned char* src = CKV8b + (size_t)idx[i] * RK + 16 * ((lane & 15) ^ ATT_F(rr));
        __builtin_amdgcn_global_load_lds((const unsigned*)src, (LAS unsigned*)(slot + 1024 * i), 16, 0, 0);
    }
}

#define ATT_T(q) (((q) & 2047) ^ (((q) >> 11) ? 255 : 0))
__device__ __forceinline__ void att_wave(const unsigned char* CKV8, const unsigned* SEL, unsigned char* BIG, LAS unsigned char* kvbuf, LAS unsigned* lists, const LAS float* relb, const LAS unsigned* btab,
                                         int xcd, int wx, int nwx, int lane) {
    asm volatile("" : "+v"(lane));
    const int hq = lane & 15, g = lane >> 4;
    const int nq = (2 * SEQ - wx + nwx - 1) / nwx;
    if (nq <= 0) return;
    const unsigned kvb = (unsigned)(size_t)kvbuf;
    unsigned qa[8];
#pragma unroll
    for (int ks = 0; ks < 8; ++ks) qa[ks] = kvb + (unsigned)hq * 256u + 16u * (unsigned)((2 * ks + (g >> 1)) ^ ATT_F(hq)) + 8u * (unsigned)(g & 1);
    const int tq = hq >> 2, tp = hq & 3, trow = 4 * g + tq;
    unsigned ta[8];
#pragma unroll
    for (int nt = 0; nt < 8; ++nt) ta[nt] = kvb + (unsigned)trow * 256u + 16u * (unsigned)((2 * nt + (tp >> 1)) ^ ATT_F(trow)) + 8u * (unsigned)(tp & 1);

    int q = wx, b = 2 * xcd + (q >> 11), t = ATT_T(q);
    size_t row = (size_t)b * SEQ + t;
    unsigned wsel = SEL[row * 64 + lane];
    int cnt = att_build_list(lists, btab, wsel, t, lane);
    unsigned wnext = 0u;
    if (nq > 1) { const int q1 = wx + nwx; wnext = SEL[((size_t)(2 * xcd + (q1 >> 11)) * SEQ + ATT_T(q1)) * 64 + lane]; }
    long bq[8];
    { const unsigned char* qp = BIG + row * 8192 + hq * 256 + 8 * g;
#pragma unroll
      for (int ks = 0; ks < 8; ++ks) bq[ks] = *(const long*)(qp + 32 * ks); }
    int par = 0;
    asm volatile("s_waitcnt lgkmcnt(0)" ::: "memory");
    att_gather32(CKV8 + (size_t)b * SEQ * RK, lists, kvbuf, lane);
    for (int k = 0; k < nq; ++k) {
        const int cur = k & 1;
        LAS unsigned* list = lists + cur * 256;
        const bool has_next = (k + 1 < nq);
        const int qn = q + nwx, bn = 2 * xcd + (qn >> 11), tn = ATT_T(qn);
        const size_t rown = (size_t)bn * SEQ + tn;
        int cntn = 0;
        if (has_next) { cntn = att_build_list(lists + (cur ^ 1) * 256, btab, wnext, tn, lane);
            if (k + 2 < nq) { const int q2 = qn + nwx; wnext = SEL[((size_t)(2 * xcd + (q2 >> 11)) * SEQ + ATT_T(q2)) * 64 + lane]; } }
        f32x4 Oe[8], Oo[8];
#pragma unroll
        for (int nt = 0; nt < 8; ++nt) { Oe[nt] = (f32x4){0.f, 0.f, 0.f, 0.f}; Oo[nt] = (f32x4){0.f, 0.f, 0.f, 0.f}; }
        float mref = NEGF, lsum = 0.f;
        const int nsub = (cnt + 31) >> 5;
        for (int sc = 0; sc < nsub; ++sc) {
            const bool lastc = (sc + 1 == nsub);
            float bias[8];
#pragma unroll
            for (int T = 0; T < 2; ++T) { const u32x4 mt = *(const LAS u32x4*)(list + 32 * sc + 16 * T + 4 * g);
#pragma unroll
                for (int i = 0; i < 4; ++i) bias[4 * T + i] = relb[(mt[i] >> 16) * 16 + hq]; }
            if (!lastc) { att_gather32(CKV8 + (size_t)b * SEQ * RK, list + 32 * (sc + 1), kvbuf + (par ^ 1) * 8192, lane); asm volatile("s_waitcnt vmcnt(8)" ::: "memory"); }
            else if (has_next) { att_gather32(CKV8 + (size_t)bn * SEQ * RK, lists + (cur ^ 1) * 256, kvbuf + (par ^ 1) * 8192, lane); asm volatile("s_waitcnt vmcnt(8)" ::: "memory"); }
            else { asm volatile("s_waitcnt vmcnt(0)" ::: "memory"); }
            f32x4 st0 = (f32x4){0.f, 0.f, 0.f, 0.f}, st1 = st0;
            { long kr[8];
              RDK8("0", kr, qa);
#pragma unroll
              for (int ks = 0; ks < 8; ++ks) st0 = __builtin_amdgcn_mfma_f32_16x16x32_fp8_fp8(kr[ks], bq[ks], st0, 0, 0, 0);
              RDK8("4096", kr, qa);
#pragma unroll
              for (int ks = 0; ks < 8; ++ks) st1 = __builtin_amdgcn_mfma_f32_16x16x32_fp8_fp8(kr[ks], bq[ks], st1, 0, 0, 0); }
            if (lastc && has_next) { const unsigned char* qp = BIG + rown * 8192 + hq * 256 + 8 * g;
#pragma unroll
                for (int ks = 0; ks < 8; ++ks) bq[ks] = *(const long*)(qp + 32 * ks); }
            float lg[8]; float cmax = NEGF;
#pragma unroll
            for (int i = 0; i < 4; ++i) { const int s0 = 32 * sc + 4 * g + i;
                float v0 = st0[i] * (1.0f / 64.0f) + bias[i]; v0 = (s0 < cnt) ? v0 : NEGF; lg[i] = v0;
                float v1 = st1[i] * (1.0f / 64.0f) + bias[4 + i]; v1 = (s0 + 16 < cnt) ? v1 : NEGF; lg[4 + i] = v1; cmax = fmaxf(cmax, fmaxf(v0, v1)); }
            cmax = rows_max(cmax);
            if (__ballot(cmax > mref + 3.0f) != 0ull) {
                const float mnew = fmaxf(mref, cmax), scl = fast_exp(mref - mnew);
                lsum *= scl;
#pragma unroll
                for (int nt = 0; nt < 8; ++nt) { Oe[nt] = Oe[nt] * scl; Oo[nt] = Oo[nt] * scl; }
                mref = mnew;
            }
            float p[8];
#pragma unroll
            for (int i = 0; i < 8; ++i) { p[i] = fast_exp(lg[i] - mref); lsum += p[i]; }
            int pw0 = 0, pw1 = 0;
            pw0 = __builtin_amdgcn_cvt_pk_fp8_f32(p[0] * 16.0f, p[1] * 16.0f, pw0, false); pw0 = __builtin_amdgcn_cvt_pk_fp8_f32(p[2] * 16.0f, p[3] * 16.0f, pw0, true);
            pw1 = __builtin_amdgcn_cvt_pk_fp8_f32(p[4] * 16.0f, p[5] * 16.0f, pw1, false); pw1 = __builtin_amdgcn_cvt_pk_fp8_f32(p[6] * 16.0f, p[7] * 16.0f, pw1, true);
            const long pk = (long)(((unsigned long long)(unsigned)pw1 << 32) | (unsigned long long)(unsigned)pw0);
            {
#define TRB4(OFS, r0, r1, r2, r3, a0, a1, a2, a3) \
    asm volatile("ds_read_b64_tr_b16 %0, %4 offset:" OFS "\n\tds_read_b64_tr_b16 %1, %5 offset:" OFS "\n\tds_read_b64_tr_b16 %2, %6 offset:" OFS "\n\tds_read_b64_tr_b16 %3, %7 offset:" OFS \
                 : "=&v"(r0), "=&v"(r1), "=&v"(r2), "=&v"(r3) : "v"(a0), "v"(a1), "v"(a2), "v"(a3) : "memory")
#define ATT_PV(NT, RR, UU) { const u32x2 a = __builtin_bit_cast(u32x2, RR), c = __builtin_bit_cast(u32x2, UU); \
                    const unsigned e0 = __builtin_amdgcn_perm(a.y, a.x, 0x06040200u), o0 = __builtin_amdgcn_perm(a.y, a.x, 0x07050301u); \
                    const unsigned e1 = __builtin_amdgcn_perm(c.y, c.x, 0x06040200u), o1 = __builtin_amdgcn_perm(c.y, c.x, 0x07050301u); \
                    Oe[NT] = __builtin_amdgcn_mfma_f32_16x16x32_fp8_fp8((long)(((unsigned long long)e1 << 32) | e0), pk, Oe[NT], 0, 0, 0); \
                    Oo[NT] = __builtin_amdgcn_mfma_f32_16x16x32_fp8_fp8((long)(((unsigned long long)o1 << 32) | o0), pk, Oo[NT], 0, 0, 0); }
                s16x4 r0, r1, r2, r3, u0, u1, u2, u3;
                TRB4("0", r0, r1, r2, r3, ta[0], ta[1], ta[2], ta[3]);
                TRB4("4096", u0, u1, u2, u3, ta[0], ta[1], ta[2], ta[3]);
                asm volatile("s_waitcnt lgkmcnt(0)" : "+v"(r0), "+v"(r1), "+v"(r2), "+v"(r3), "+v"(u0), "+v"(u1), "+v"(u2), "+v"(u3) :: "memory");
                ATT_PV(0, r0, u0) ATT_PV(1, r1, u1) ATT_PV(2, r2, u2) ATT_PV(3, r3, u3)
                TRB4("0", r0, r1, r2, r3, ta[4], ta[5], ta[6], ta[7]);
                TRB4("4096", u0, u1, u2, u3, ta[4], ta[5], ta[6], ta[7]);
                asm volatile("s_waitcnt lgkmcnt(0)" : "+v"(r0), "+v"(r1), "+v"(r2), "+v"(r3), "+v"(u0), "+v"(u1), "+v"(u2), "+v"(u3) :: "memory");
                ATT_PV(4, r0, u0) ATT_PV(5, r1, u1) ATT_PV(6, r2, u2) ATT_PV(7, r3, u3)
#undef TRB4
#undef ATT_PV
            }
            par ^= 1;
#pragma unroll
            for (int e = 0; e < 8; ++e) { qa[e] ^= 8192u; ta[e] ^= 8192u; }
        }
        lsum = rows_sum(lsum);
        const float inv = 1.0f / (16.0f * lsum);
        bf16_t* op = (bf16_t*)(BIG + row * 8192) + hq * 256 + 8 * g;
#pragma unroll
        for (int nt = 0; nt < 8; ++nt) { const f32x4 e = Oe[nt] * inv, o = Oo[nt] * inv;
            u32x4 wv; wv.x = cvt_pk_bf16(e[0], o[0]); wv.y = cvt_pk_bf16(e[1], o[1]); wv.z = cvt_pk_bf16(e[2], o[2]); wv.w = cvt_pk_bf16(e[3], o[3]); *(u32x4*)(op + 32 * nt) = wv; }
        q = qn; b = bn; t = tn; row = rown; cnt = cntn;
    }
}

constexpr int SW_KP = 144, SW_VP = 520;
constexpr int SW_K_OFF = 0, SW_V_OFF = 256 * SW_KP, SW_TB_OFF = SW_V_OFF + 64 * SW_VP;
__device__ __forceinline__ void swa_phase(const bf16_t* QKV, bf16_t* OB, const float* relb, const float* sinks, LAS unsigned char* lds, int G) {
    int tid = threadIdx.x; asm volatile("" : "+v"(tid));
    const int lane = tid & 63, wave = __builtin_amdgcn_readfirstlane(tid >> 6);
    const int h = lane >> 5, n = lane & 31;
    LAS float* tb = (LAS float*)(lds + SW_TB_OFF);
    for (int u = blockIdx.x; u < BATCH * 16 * KVH; u += G) {
        const int b = u >> 5, nb = (u >> 1) & 15, kvh = u & 1;
        const size_t rowb = (size_t)b * SEQ;
        __syncthreads();
#pragma unroll
        for (int e = 0; e < 4; ++e) { const int id = tid + NTHR * e, j = id >> 3, ch = id & 7; const int pos = (nb - 1) * WIN + j;
            u32x4 kv = (u32x4){0u, 0u, 0u, 0u}, vv = (u32x4){0u, 0u, 0u, 0u};
            if (pos >= 0) { const bf16_t* sp = QKV + (rowb + pos) * B_IN + 1024 + kvh * 64 + ch * 8; kv = *(const u32x4*)sp; vv = *(const u32x4*)(sp + 128); }
            *(LAS u32x4*)(lds + SW_K_OFF + j * SW_KP + ch * 16) = kv;
            LAS bf16_t* vt = (LAS bf16_t*)(lds + SW_V_OFF + (ch * 8) * SW_VP + j * 2);
#pragma unroll
            for (int q = 0; q < 4; ++q) { vt[(2 * q) * (SW_VP / 2)] = (bf16_t)(vv[q] & 0xffffu); vt[(2 * q + 1) * (SW_VP / 2)] = (bf16_t)(vv[q] >> 16); } }
        for (int i = tid; i < GQ * WIN; i += NTHR) { const int gg = i >> 7, dist = i & 127; tb[i] = relb[t5_bucket(dist) * NH + kvh * GQ + gg]; }
        __syncthreads();
        const int qh = kvh * GQ + wave; const float sink = sinks[qh];
        for (int rt = 0; rt < 4; ++rt) {
            const size_t qrow = rowb + nb * WIN + 32 * rt + n;
            bf16x8 bq[4];
#pragma unroll
            for (int ks = 0; ks < 4; ++ks) bq[ks] = *(const bf16x8*)(QKV + qrow * B_IN + qh * 64 + 16 * ks + 8 * h);
            f32x16 s[5];
#pragma unroll
            for (int ct = 0; ct < 5; ++ct) {
#pragma unroll
                for (int i = 0; i < 16; ++i) s[ct][i] = 0.f;
#pragma unroll
                for (int ks = 0; ks < 4; ++ks) { const bf16x8 a = *(const LAS bf16x8*)(lds + SW_K_OFF + (32 * (rt + ct) + n) * SW_KP + (2 * ks + h) * 16);
                    s[ct] = __builtin_amdgcn_mfma_f32_32x32x16_bf16(a, bq[ks], s[ct], 0, 0, 0); } }
            const int qi = 32 * rt + n;
            float mx = NEGF;
#pragma unroll
            for (int ct = 0; ct < 5; ++ct)
#pragma unroll
                for (int i = 0; i < 16; ++i) { const int j = 32 * (rt + ct) + (i & 3) + 8 * (i >> 2) + 4 * h; const int dist = qi + WIN - j;
                    const bool ok = (dist >= 0) && (dist < WIN) && (nb > 0 || j >= WIN);
                    const float v = ok ? s[ct][i] * 0.125f + tb[wave * WIN + (dist & 127)] : NEGF; s[ct][i] = v; mx = fmaxf(mx, v); }
            mx = fmaxf(mx, __shfl_xor(mx, 32)); mx = fmaxf(mx, sink);
            float sum = 0.f;
#pragma unroll
            for (int ct = 0; ct < 5; ++ct)
#pragma unroll
                for (int i = 0; i < 16; ++i) { const float p = fast_exp(s[ct][i] - mx); s[ct][i] = p; sum += p; }
            sum += __shfl_xor(sum, 32); sum += fast_exp(sink - mx);
            f32x16 o[2];
#pragma unroll
            for (int dt = 0; dt < 2; ++dt)
#pragma unroll
                for (int i = 0; i < 16; ++i) o[dt][i] = 0.f;
#pragma unroll
            for (int ct = 0; ct < 5; ++ct)
#pragma unroll
                for (int s2 = 0; s2 < 2; ++s2) {
                    u32x4 pw; pw.x = cvt_pk_bf16(s[ct][8 * s2 + 0], s[ct][8 * s2 + 1]); pw.y = cvt_pk_bf16(s[ct][8 * s2 + 2], s[ct][8 * s2 + 3]);
                    pw.z = cvt_pk_bf16(s[ct][8 * s2 + 4], s[ct][8 * s2 + 5]); pw.w = cvt_pk_bf16(s[ct][8 * s2 + 6], s[ct][8 * s2 + 7]);
                    const bf16x8 pb = __builtin_bit_cast(bf16x8, pw);
#pragma unroll
                    for (int dt = 0; dt < 2; ++dt) { const LAS unsigned char* vp = lds + SW_V_OFF + (32 * dt + n) * SW_VP + (32 * (rt + ct) + 16 * s2 + 4 * h) * 2;
                        const u32x2 v0 = *(const LAS u32x2*)vp, v1 = *(const LAS u32x2*)(vp + 16);
                        u32x4 va; va.x = v0.x; va.y = v0.y; va.z = v1.x; va.w = v1.y;
                        o[dt] = __builtin_amdgcn_mfma_f32_32x32x16_bf16(__builtin_bit_cast(bf16x8, va), pb, o[dt], 0, 0, 0); }
                }
            const float inv = 1.0f / sum;
            bf16_t* op = OB + qrow * D + qh * 64 + 4 * h;
#pragma unroll
            for (int dt = 0; dt < 2; ++dt)
#pragma unroll
                for (int i4 = 0; i4 < 4; ++i4) { u32x2 wv; wv.x = cvt_pk_bf16(o[dt][4 * i4] * inv, o[dt][4 * i4 + 1] * inv); wv.y = cvt_pk_bf16(o[dt][4 * i4 + 2] * inv, o[dt][4 * i4 + 3] * inv);
                    *(u32x2*)(op + 32 * dt + 8 * i4) = wv; }
        }
    }
}

struct Args { const float* in[23]; float* out; unsigned char* ws; };
#define CAS __attribute__((address_space(4)))
__device__ __forceinline__ const CAS Args* kargs() { const CAS Args* p = (const CAS Args*)__builtin_amdgcn_kernarg_segment_ptr(); asm volatile("" : "+s"(p)); return p; }

__global__ void __launch_bounds__(NTHR, 2) trunk_fwd(Args args_by_value) {
    extern __shared__ __attribute__((aligned(16))) unsigned char lds_raw[];
    LAS unsigned char* lds = (LAS unsigned char*)lds_raw;
    const int tid = threadIdx.x;
    volatile LAS unsigned* MISC = (volatile LAS unsigned*)(lds + LDS_MISC_OFF);
    for (int u = tid; u < (LDS_BYTES - LDS_MISC_OFF) / 4; u += NTHR) MISC[u] = 0u;
    __syncthreads();
    { const CAS Args* A = kargs(); (void)xcd_barrier_post((unsigned*)(A->ws + WS_CTL) + 4096, MISC + 8);
      if (tid == 0) { const unsigned x = xb_xcc_id(); MISC[16] = x; MISC[17] = xb_add((unsigned*)(A->ws + WS_CTL) + 8192 + 64 * x, 1u); } }
#define XCD_RANK(xcd, rank) do { const CAS Args* A_ = kargs(); const unsigned* cw_ = (const unsigned*)(A_->ws + WS_CTL) + 4096; bool ok_ = (gridDim.x & 7) == 0; \
        for (int j_ = 0; j_ < 16; ++j_) { const unsigned c_ = __hip_atomic_load(cw_ + XB_XCNT(j_), __ATOMIC_RELAXED, __HIP_MEMORY_SCOPE_AGENT); ok_ = ok_ && (c_ == (j_ < 8 ? gridDim.x >> 3 : 0u)); } \
        const unsigned hx_ = MISC[16], hr_ = MISC[17]; ok_ = ok_ && hx_ < 8u && hr_ < (gridDim.x >> 3); \
        xcd = ok_ ? (int)hx_ : (int)(blockIdx.x & 7); rank = ok_ ? (int)hr_ : (int)(blockIdx.x >> 3); } while (0)
#define GB() do { const CAS Args* A_ = kargs(); XcdBarrier b_; b_.bar = (unsigned*)(A_->ws + WS_CTL) + 4096; b_.x = xb_xcc_id(); b_.st = MISC + 8; xcd_barrier(b_); } while (0)

    { const CAS Args* A = kargs(); Ptrs P;
#pragma unroll
      for (int i = 0; i < 23; ++i) P.in[i] = A->in[i];
      P.out = A->out; P.ws = A->ws;
      p0_prologue(P, lds, (int)gridDim.x); }
    GB();
    { const CAS Args* A = kargs(); Ptrs P;
#pragma unroll
      for (int i = 0; i < 23; ++i) P.in[i] = A->in[i];
      P.out = A->out; P.ws = A->ws;
      pre_phase(P, lds, (int)gridDim.x); }
    GB();

    for (int l = 0; l < DEPTH; ++l) {
        const bool isA = (l & 1) == 0;
        {
            const CAS Args* A = kargs(); const int G = gridDim.x, j = l >> 1; unsigned char* ws = A->ws;
            const unsigned long long* SS = (const unsigned long long*)(ws + WS_SS) + (size_t)(2 * l) * M;
            if (isA) {
                unsigned char* wa = ws + WS_WA + (size_t)j * WA_STRIDE;
                pg8::Gemm g{(const bf16_t*)(ws + WS_XG), (const bf16_t*)(wa + WINA_OFF), D, D, D, 0, 0}; pg8::StaticOrder S; S.init(M, 2048, G, (int)blockIdx.x);
                pg8::EpiInA E{(bf16_t*)(ws + WS_QO), (bf16_t*)(ws + WS_CKV), (bf16_t*)(ws + WS_QI), (bf16_t*)(ws + WS_KIN), (float*)(ws + WS_WI), A->in[I_AIKG] + j * IDIM, A->in[I_AIKB] + j * IDIM,
                                (const float*)(ws + WS_SHW + SHW_A) + (size_t)j * BATCH * 2048, SS};
                pg8::gemm_phase<pg8::EpiInA, true>(lds, g, S, E);
            } else {
                unsigned char* wb = ws + WS_WB + (size_t)j * WB_STRIDE;
                pg8::Gemm g{(const bf16_t*)(ws + WS_XG), (const bf16_t*)(wb + WINB_OFF), D, D, D, 0, 0}; pg8::StaticOrder S; S.init(M, B_IN, G, (int)blockIdx.x);
                pg8::EpiBf16Plain<true> E{(bf16_t*)(ws + WS_QKV), B_IN, (const float*)(ws + WS_SHW + SHW_B) + (size_t)j * BATCH * B_IN, B_IN, SS};
                pg8::gemm_phase<pg8::EpiBf16Plain<true>, true>(lds, g, S, E);
            }
        }
        GB();
        if (isA) {
            { const CAS Args* A = kargs(); const int G = gridDim.x, j = l >> 1; unsigned char* ws = A->ws;
              unsigned char* wa = ws + WS_WA + (size_t)j * WA_STRIDE;
              pg8::Gemm g{(const bf16_t*)(ws + WS_QO), (const bf16_t*)(wa + WQA_OFF), D, 256, 256, 2, 256}; pg8::StaticOrder S; S.init(M, 4096, G, (int)blockIdx.x);
              pg8::EpiFp8 E{ws + WS_BIG, 8192};
              pg8::gemm_phase<pg8::EpiFp8, true>(lds, g, S, E); }
            { const CAS Args* A = kargs(); const int G = gridDim.x; unsigned char* ws = A->ws;
              int tid2 = tid; asm volatile("" : "+v"(tid2));
              const int lane = tid2 & 63, wave = __builtin_amdgcn_readfirstlane(tid2 >> 6);
              const bf16_t* CKV = (const bf16_t*)(ws + WS_CKV); unsigned* CKV8 = (unsigned*)(ws + WS_CKV8);
              const int gw = blockIdx.x * NWAVES + wave, NGW = G * NWAVES;
              for (int row = gw; row < M; row += NGW) {
                  const u32x2 v = *((const u32x2*)(CKV + (size_t)row * RK) + lane);
                  const float a0 = __uint_as_float(v.x << 16), a1 = __uint_as_float(v.x & 0xffff0000u), a2 = __uint_as_float(v.y << 16), a3 = __uint_as_float(v.y & 0xffff0000u);
                  const float ss = wave_sum((a0 * a0 + a1 * a1) + (a2 * a2 + a3 * a3));
                  const float rs = 1.0f / sqrtf(ss * (1.0f / RK) + EPS);
                  int w = 0; w = __builtin_amdgcn_cvt_pk_fp8_f32(a0 * rs, a1 * rs, w, false); w = __builtin_amdgcn_cvt_pk_fp8_f32(a2 * rs, a3 * rs, w, true);
                  CKV8[(size_t)row * (RK / 4) + lane] = (unsigned)w;
              } }
            { const CAS Args* A = kargs(); const int G = gridDim.x; unsigned char* ws = A->ws;
              int tid2 = tid; asm volatile("" : "+v"(tid2));
              const int lane = tid2 & 63, wave = __builtin_amdgcn_readfirstlane(tid2 >> 6);
              int xcd, rank; XCD_RANK(xcd, rank); xcd = __builtin_amdgcn_readfirstlane(xcd); rank = __builtin_amdgcn_readfirstlane(rank);
              const int wx = rank * NWAVES + wave, nwx = (G >> 3) * NWAVES;
              const int nsteps = (1024 + nwx - 1) / nwx;
              for (int st = 0; st < nsteps; ++st) {
                  const int q = wx + st * nwx; const bool active = q < 1024;
                  const int qc = active ? q : (rank * NWAVES + st * nwx < 1024 ? rank * NWAVES + st * nwx : 1023);
                  const int bl = qc >> 9, u = qc & 255, hiq = (qc >> 8) & 1, b = 2 * xcd + bl;
                  const int tg = hiq ? 511 - u : u;
                  idx_task((const bf16_t*)(ws + WS_QI), (const bf16_t*)(ws + WS_KIN), (const float*)(ws + WS_WI), (unsigned*)(ws + WS_SEL), lds, b, tg, lane, wave, active, hiq ? 2 : 1);
              }
              __syncthreads(); }
        } else {
            const CAS Args* A = kargs(); const int G = gridDim.x, j = l >> 1; unsigned char* ws = A->ws;
            swa_phase((const bf16_t*)(ws + WS_QKV), (bf16_t*)(ws + WS_OB), A->in[I_RELB], A->in[I_BSINK] + j * NH, lds, G);
        }
        GB();
        if (isA) {
            { const CAS Args* A = kargs(); const int G = gridDim.x; unsigned char* ws = A->ws;
              int tid2 = tid; asm volatile("" : "+v"(tid2));
              const int lane = tid2 & 63, wave = __builtin_amdgcn_readfirstlane(tid2 >> 6);
              LAS float* relb = (LAS float*)(lds + 147456);
              LAS unsigned* btab = (LAS unsigned*)(lds + 147456 + 2048);
              for (int i = tid2; i < NBUCK * NH; i += NTHR) relb[i] = A->in[I_RELB][i];
              for (int i = tid2; i < 132; i += NTHR) btab[i] = (unsigned)t5_bucket(i);
              __syncthreads();
              int xcd, rank; XCD_RANK(xcd, rank); xcd = __builtin_amdgcn_readfirstlane(xcd); rank = __builtin_amdgcn_readfirstlane(rank);
              const int wx = rank * NWAVES + wave, nwx = (G >> 3) * NWAVES;
              att_wave(ws + WS_CKV8, (const unsigned*)(ws + WS_SEL), ws + WS_BIG, lds + wave * 16384, (LAS unsigned*)(lds + 131072 + wave * 2048), relb, btab, xcd, wx, nwx, lane); }
            GB();
            { const CAS Args* A = kargs(); const int G = gridDim.x, j = l >> 1; unsigned char* ws = A->ws;
              unsigned char* wa = ws + WS_WA + (size_t)j * WA_STRIDE;
              pg8::Gemm g{(const bf16_t*)(ws + WS_BIG), (const bf16_t*)(wa + WUV_OFF), 4096, D, D, 0, 1024}; pg8::StaticOrder S; S.init(M, D, G, (int)blockIdx.x);
              pg8::EpiBf16Plain<false> E{(bf16_t*)(ws + WS_QO), D, nullptr, 0, nullptr};
              pg8::gemm_phase<pg8::EpiBf16Plain<false>, true>(lds, g, S, E); }
            GB();
        }
        {
            const CAS Args* A = kargs(); const int G = gridDim.x, j = l >> 1; unsigned char* ws = A->ws;
            const float* modl = (const float*)(ws + WS_MOD) + (size_t)l * BATCH * 6144;
            const bf16_t* Ain = (const bf16_t*)(ws + (isA ? WS_QO : WS_OB));
            const bf16_t* Bw = (const bf16_t*)(isA ? ws + WS_WA + (size_t)j * WA_STRIDE + WOUTA_OFF : ws + WS_WB + (size_t)j * WB_STRIDE + WOUTB_OFF);
            pg8::Gemm g{Ain, Bw, D, D, D, 0, 0}; pg8::StaticOrder S; S.init(M, D, G, (int)blockIdx.x);
            pg8::EpiResid E{(const bf16_t*)A->out, (bf16_t*)A->out, modl + 2048, isA ? nullptr : A->in[I_BBOUT] + j * D,
                            (bf16_t*)(ws + WS_XG), A->in[I_GFFN] + l * D, modl + 4096, (unsigned long long*)(ws + WS_SS) + (size_t)(2 * l + 1) * M};
            pg8::gemm_phase<pg8::EpiResid, true>(lds, g, S, E);
        }
        GB();
        {
            const CAS Args* A = kargs(); const int G = gridDim.x; unsigned char* ws = A->ws;
            unsigned char* wl = ws + WS_W + (size_t)l * W_LAYER;
            pg8::Gemm g{(const bf16_t*)(ws + WS_XG), (const bf16_t*)(wl + W13_OFF), D, D, D, 0, 0}; pg8::StaticOrder S; S.init(M, 2 * DFF, G, (int)blockIdx.x);
            pg8::EpiSwiGLU E{(bf16_t*)(ws + WS_HFF), (const float*)(ws + WS_SHW + SHW_F) + (size_t)l * BATCH * 2 * DFF, (const unsigned long long*)(ws + WS_SS) + (size_t)(2 * l + 1) * M};
            pg8::gemm_phase<pg8::EpiSwiGLU, true>(lds, g, S, E);
        }
        GB();
        {
            const CAS Args* A = kargs(); const int G = gridDim.x; unsigned char* ws = A->ws;
            unsigned char* wl = ws + WS_W + (size_t)l * W_LAYER;
            const float* modl = (const float*)(ws + WS_MOD) + (size_t)l * BATCH * 6144;
            const int ln = l + 1 < DEPTH ? l + 1 : l;
            pg8::Gemm g{(const bf16_t*)(ws + WS_HFF), (const bf16_t*)(wl + W2_OFF), DFF, DFF, DFF, 0, 0}; pg8::StaticOrder S; S.init(M, D, G, (int)blockIdx.x);
            const bool lastl = (l + 1 == DEPTH);
            pg8::EpiResid E{(const bf16_t*)A->out, lastl ? (bf16_t*)(ws + WS_XG) : (bf16_t*)A->out, modl + 5120, nullptr,
                            l + 1 < DEPTH ? (bf16_t*)(ws + WS_XG) : nullptr, A->in[I_GMIX] + ln * D, (const float*)(ws + WS_MOD) + (size_t)ln * BATCH * 6144 + 1024, (unsigned long long*)(ws + WS_SS) + (size_t)(2 * l + 2) * M};
            pg8::gemm_phase<pg8::EpiResid, true>(lds, g, S, E);
        }
        GB();
    }
    { const CAS Args* A = kargs(); final_norm_phase((const bf16_t*)(A->ws + WS_XG), A->out, A->in[I_GFIN], (int)gridDim.x); }
#undef GB
}

extern "C" void kernel_launch(void* const* d_in, const int* in_sizes, int n_in, void* d_out, int out_size, void* d_ws, size_t ws_size, hipStream_t stream) {
    static int grid = 0;
    if (grid == 0) {
        if (n_in != 23 || out_size != M * D || ws_size < WS_END) { fprintf(stderr, "kernel_launch: unexpected shapes (n_in %d out %d ws %zu)\n", n_in, out_size, ws_size); grid = -1; return; }
        int dev = 0, cus = 0, per_cu = 0;
        if (hipGetDevice(&dev) != hipSuccess || hipDeviceGetAttribute(&cus, hipDeviceAttributeMultiprocessorCount, dev) != hipSuccess) { grid = -1; return; }
        if (hipFuncSetAttribute((const void*)trunk_fwd, hipFuncAttributeMaxDynamicSharedMemorySize, LDS_BYTES) != hipSuccess) { fprintf(stderr, "kernel_launch: hipFuncSetAttribute failed\n"); grid = -1; return; }
        if (hipOccupancyMaxActiveBlocksPerMultiprocessor(&per_cu, (const void*)trunk_fwd, NTHR, LDS_BYTES) != hipSuccess || per_cu < 1) { fprintf(stderr, "kernel_launch: occupancy query says %d\n", per_cu); }
        (void)hipGetLastError();
        grid = cus;
    }
    if (grid < 0) return;
    (void)hipMemsetAsync((char*)d_ws + WS_CTL, 0, CTL_ZERO_BYTES, stream);
    Args a{};
    for (int i = 0; i < 23; ++i) a.in[i] = (const float*)d_in[i];
    a.out = (float*)d_out; a.ws = (unsigned char*)d_ws;
    hipLaunchKernelGGL(trunk_fwd, dim3(grid), dim3(NTHR), LDS_BYTES, stream, a);
    const hipError_t le = hipPeekAtLastError();
    if (le != hipSuccess) fprintf(stderr, "kernel_launch: launch failed: %s\n", hipGetErrorName(le));
}
```

```cpp
#include <hip/hip_runtime.h>
#include <cstdio>
#include <cstdint>


#define GAS __attribute__((address_space(1)))
#define LAS __attribute__((address_space(3)))
typedef unsigned short bf16_t;
typedef short bf16x8 __attribute__((ext_vector_type(8)));
typedef short s16x4 __attribute__((ext_vector_type(4)));
typedef float f32x4 __attribute__((ext_vector_type(4)));
typedef float f32x2 __attribute__((ext_vector_type(2)));
typedef float f32x16 __attribute__((ext_vector_type(16)));
typedef unsigned u32x4 __attribute__((ext_vector_type(4)));
typedef unsigned u32x2 __attribute__((ext_vector_type(2)));

constexpr int D = 1024, BATCH = 16, SEQ = 2048, M = BATCH * SEQ, DEPTH = 4;
constexpr int NH = 16, HD = 64, RK = 256, IH = 8, IDIM = 64, TOPK = 256;
constexpr int KVH = 2, GQ = 8, WIN = 128, NBUCK = 32, DFF = 2816;
constexpr int A_IN = 1864, B_IN = 1280;
constexpr float EPS = 1e-6f;
constexpr float NEGF = -1e30f;
constexpr int NWAVES = 8, NTHR = 512;

constexpr size_t MiB = 1u << 20;
constexpr size_t WS_CTL = 0, CTL_ZERO_BYTES = 4 * MiB;
constexpr size_t WS_SS = 1 * MiB;
constexpr size_t WS_W = 4 * MiB;
constexpr size_t W_LAYER = 17301504;
constexpr size_t W13_OFF = 0, W2_OFF = 11 * MiB;
constexpr size_t WS_WA = WS_W + 4 * W_LAYER;
constexpr size_t WA_STRIDE = 10 * MiB, WINA_OFF = 0, WQA_OFF = 4 * MiB, WUV_OFF = 6 * MiB, WOUTA_OFF = 8 * MiB;
constexpr size_t WS_WB = WS_WA + 2 * WA_STRIDE;
constexpr size_t WB_STRIDE = 4718592, WINB_OFF = 0, WOUTB_OFF = 2621440;
constexpr size_t WS_MOD = 100 * MiB;
constexpr size_t WS_SHW = WS_MOD + 1536 * 1024;
constexpr size_t SHW_A = 0, SHW_B = 2 * 16 * 2048 * 4, SHW_F = SHW_B + 2 * 16 * 1280 * 4;
constexpr size_t WS_XG = 104 * MiB;
constexpr size_t WS_BIG = 104 * MiB;
constexpr size_t WS_HFF = 168 * MiB;
constexpr size_t WS_QO = 360 * MiB;
constexpr size_t WS_CKV = 424 * MiB;
constexpr size_t WS_QI = 440 * MiB;
constexpr size_t WS_KIN = 472 * MiB;
constexpr size_t WS_WI = 476 * MiB;
constexpr size_t WS_SEL = 477 * MiB;
constexpr size_t WS_CKV8 = 486 * MiB;
constexpr size_t WS_QKV = 360 * MiB;
constexpr size_t WS_OB = 440 * MiB;
constexpr size_t WS_END = 512 * MiB;

constexpr int RING_BYTES = 131072;
constexpr int LDS_MISC_OFF = 155648;
constexpr int LDS_BYTES = 156672;

#define RLX_AGENT __ATOMIC_RELAXED, __HIP_MEMORY_SCOPE_AGENT
__device__ __forceinline__ unsigned cvt_pk_bf16(float lo, float hi) { unsigned r; asm volatile("v_cvt_pk_bf16_f32 %0, %1, %2" : "=v"(r) : "v"(lo), "v"(hi)); return r; }
__device__ __forceinline__ float bf2f(bf16_t b) { return __uint_as_float(((unsigned)b) << 16); }
__device__ __forceinline__ float wave_sum(float v) {
#pragma unroll
    for (int o = 1; o < 64; o <<= 1) v += __shfl_xor(v, o);
    return v;
}
__device__ __forceinline__ float fast_exp(float x) { return __builtin_amdgcn_exp2f(x * 1.4426950408889634f); }
__device__ __forceinline__ float silu_f(float x) { return x * __builtin_amdgcn_rcpf(1.0f + fast_exp(-x)); }
__device__ __forceinline__ int t5_bucket(int d) {
    if (d < 16) return d;
    int b = 16;
    b += (d >= 19); b += (d >= 21); b += (d >= 24); b += (d >= 27); b += (d >= 31); b += (d >= 35); b += (d >= 40); b += (d >= 46);
    b += (d >= 52); b += (d >= 59); b += (d >= 67); b += (d >= 77); b += (d >= 87); b += (d >= 99); b += (d >= 113);
    return b;
}

#define XB_TMO      128
#define XB_XCNT(j)  (256  + 64 * (j))
#define XB_XSUB(j)  (1280 + 64 * (j))
#define XB_XGEN(j)  (2304 + 64 * (j))
#define XB_TOP      3328
#define XB_TOPGEN   3392
#define XCD_BAR_WORDS 3456
#define XB_SPIN_CAP (1u << 22)

__device__ __forceinline__ unsigned xb_ld(unsigned* p)              { return __hip_atomic_load(p, __ATOMIC_RELAXED, __HIP_MEMORY_SCOPE_AGENT); }
__device__ __forceinline__ unsigned xb_add(unsigned* p, unsigned v) { return __hip_atomic_fetch_add(p, v, __ATOMIC_RELAXED, __HIP_MEMORY_SCOPE_AGENT); }
__device__ __forceinline__ unsigned xb_xcc_id() { return (unsigned)__builtin_amdgcn_s_getreg((3 << 11) | 20) & 0xFu; }
#define XB_SPIN(cond, bar) do { unsigned _sp = 0; while (cond) { __builtin_amdgcn_s_sleep(1); \
    if ((++_sp & 255u) == 0u) { if (xb_ld(&(bar)[XB_TMO])) break; if (_sp > XB_SPIN_CAP) { atomicAdd(&(bar)[XB_TMO], 1u); break; } } } } while (0)

struct XcdBarrier { unsigned* bar; unsigned x; volatile LAS unsigned* st; };

__device__ __forceinline__ XcdBarrier xcd_barrier_post(unsigned* bar, volatile LAS unsigned* st) {
    XcdBarrier b; b.bar = bar; b.x = xb_xcc_id(); b.st = st;
    if (threadIdx.x == 0) (void)xb_add(&bar[XB_XCNT(b.x)], 1u);
    return b;
}
__device__ __forceinline__ void xcd_barrier_complete(unsigned* bar, unsigned x, unsigned& nloc, unsigned& nx) {
    const unsigned G = gridDim.x * gridDim.y * gridDim.z;
    unsigned sum, cnt, mine, sp = 0u;
    for (;;) {
        sum = 0u; cnt = 0u; mine = 0u;
#pragma unroll
        for (unsigned j = 0; j < 16; ++j) { const unsigned c = xb_ld(&bar[XB_XCNT(j)]); sum += c; cnt += (c > 0u) ? 1u : 0u; mine = (j == x) ? c : mine; }
        if (sum == G) break;
        __builtin_amdgcn_s_sleep(1);
        if ((++sp & 255u) == 0u) { if (xb_ld(&bar[XB_TMO])) break; if (sp > XB_SPIN_CAP) { atomicAdd(&bar[XB_TMO], 1u); break; } }
    }
    nloc = mine > 0u ? mine : 1u; nx = cnt > 0u ? cnt : 1u;
}
__device__ __forceinline__ void xcd_barrier(const XcdBarrier& b) {
    asm volatile("s_waitcnt vmcnt(0)" ::: "memory");
    __syncthreads();
    if (threadIdx.x == 0) {
        unsigned* bar = b.bar;
        __builtin_amdgcn_s_waitcnt(0);
        unsigned nloc = b.st[0], nx = b.st[1];
        if (nloc == 0u) { xcd_barrier_complete(bar, b.x, nloc, nx); b.st[0] = nloc; b.st[1] = nx; }
        const unsigned old = xb_add(&bar[XB_XSUB(b.x)], 1u);
        const unsigned gen = old / nloc;
        if (old + 1u == (gen + 1u) * nloc) {
            __builtin_amdgcn_fence(__ATOMIC_RELEASE, "agent");
            asm volatile("s_waitcnt vmcnt(0)" ::: "memory");
            const unsigned og = xb_add(&bar[XB_TOP], 1u);
            const unsigned tg = og / nx;
            if (og + 1u == (tg + 1u) * nx) xb_add(&bar[XB_TOPGEN], 1u);
            else XB_SPIN(xb_ld(&bar[XB_TOPGEN]) == tg, bar);
            __builtin_amdgcn_fence(__ATOMIC_ACQUIRE, "agent");
            xb_add(&bar[XB_XGEN(b.x)], 1u);
            asm volatile("s_waitcnt vmcnt(0)" ::: "memory");
        } else {
            XB_SPIN(xb_ld(&bar[XB_XGEN(b.x)]) == gen, bar);
            __builtin_amdgcn_fence(__ATOMIC_ACQUIRE, "agent");
            asm volatile("s_waitcnt vmcnt(0)" ::: "memory");
        }
    }
    __syncthreads();
}

namespace pg8 {
constexpr int BM = 256, BK = 64, HALF = 128, HTB = HALF * BK * 2, STAGE_BYTES = 8 * HTB, NXCD = 8, WGM = 8;
__host__ __device__ __forceinline__ int lds_byte(int r, int c) { const int st = (r >> 4) * 2 + (c >> 5), rr = r & 15, cc = c & 31, ob = rr * 64 + cc * 2; return st * 1024 + (ob ^ (((ob >> 9) & 1) << 5)); }
__host__ __device__ __forceinline__ void stage_rc(int b, int& R, int& C) { const int st = b / 1024, sb = b % 1024, swz = sb ^ (((sb >> 9) & 1) << 5); R = (st >> 1) * 16 + swz / 64; C = (st & 1) * 32 + (swz % 64) / 2; }
__host__ __device__ __forceinline__ int perm32(int rho) { const int n = rho >> 4, i = rho & 15; return 8 * (i >> 2) + 4 * n + (i & 3); }

struct Unit { int pm, pn; };
struct Gemm { const bf16_t* A; const bf16_t* Bt; int lda, ldb, K, a_shift, a_mul; };

struct StaticOrder {
    int nM, nN, nwg, G, c;
    __device__ void init(int M_, int N_, int G_, int c_) { nM = M_ / BM; nN = N_ / BM; nwg = nM * nN; G = G_; c = c_; }
    __device__ bool next(int i, Unit& u) const {
        const long L = (long)i * G + c; if (L >= nwg) return false;
        int wgid = (int)L; { const int q = nwg / NXCD, r = nwg % NXCD, xcd = wgid % NXCD, off = wgid / NXCD; wgid = (xcd < r ? xcd * (q + 1) : r * (q + 1) + (xcd - r) * q) + off; }
        const int nig = WGM * nN, gid = wgid / nig, fm = gid * WGM, gsz = (nM - fm) < WGM ? (nM - fm) : WGM;
        u.pm = fm + ((wgid % nig) % gsz); u.pn = (wgid % nig) / gsz; return true;
    }
};

template <class Epi, bool ALIGN_EPI>
__device__ __forceinline__ void gemm_phase(LAS unsigned char* lds, const Gemm g, const StaticOrder& S, const Epi& E) {
    int tid = threadIdx.x; asm volatile("" : "+v"(tid));
    const int wid = __builtin_amdgcn_readfirstlane(tid >> 6), lane = tid & 63, wr = wid >> 2, wc = wid & 3, fr = lane & 15, fq = lane >> 4;
    const int K = g.K, nt = K / BK;
    unsigned voffA[2], voffB[2];
#pragma unroll
    for (int i = 0; i < 2; ++i) { int R, C; stage_rc(tid * 16 + i * 8192, R, C); const int Rb = Epi::PERM ? ((R & ~31) + perm32(R & 31)) : R;
        voffA[i] = (unsigned)(R * g.lda + C) * 2u; voffB[i] = (unsigned)(Rb * g.ldb + C) * 2u; }
    const size_t kstep = (size_t)(BK * 2);
    const size_t hstepA = (size_t)HALF * g.lda * 2, hstepB = (size_t)HALF * g.ldb * 2;
    const unsigned ldsw = (unsigned)wid * 1024u;
    const int aoff = lds_byte(wr * 64 + fr, fq * 8), boff = lds_byte(wc * 32 + fr, fq * 8);
#define PG8_SA(b, h) (((b) * 2 + (h)) * HTB)
#define PG8_SB(b, h) ((4 + (b) * 2 + (h)) * HTB)
#define PG8_STAGE(bufoff, gbase, voff) do { _Pragma("unroll") for (int _i = 0; _i < 2; ++_i) \
        __builtin_amdgcn_global_load_lds((const unsigned*)((const char*)(gbase) + (voff)[_i]), (LAS unsigned*)(lds + (bufoff) + ldsw + _i * 8192), 16, 0, 0); } while (0)
#define PG8_LDA(dst, b, h) do { _Pragma("unroll") for (int m = 0; m < 4; ++m) _Pragma("unroll") for (int k = 0; k < 2; ++k) dst[m][k] = *(const LAS bf16x8*)(lds + PG8_SA(b, h) + aoff + m * 2048 + k * 1024); } while (0)
#define PG8_LDB(dst, b, h) do { _Pragma("unroll") for (int n = 0; n < 2; ++n) _Pragma("unroll") for (int k = 0; k < 2; ++k) dst[n][k] = *(const LAS bf16x8*)(lds + PG8_SB(b, h) + boff + n * 2048 + k * 1024); } while (0)
#define PG8_MMA(ai, bj, At, Bt) do { __builtin_amdgcn_s_setprio(1); _Pragma("unroll") for (int m = 0; m < 4; ++m) _Pragma("unroll") for (int n = 0; n < 2; ++n) _Pragma("unroll") for (int k = 0; k < 2; ++k) \
        acc[ai][bj][m][n] = __builtin_amdgcn_mfma_f32_16x16x32_bf16(Bt[n][k], At[m][k], acc[ai][bj][m][n], 0, 0, 0); __builtin_amdgcn_s_setprio(0); } while (0)
#define PG8_WAIT_V(n) asm volatile("s_waitcnt vmcnt(" #n ")" ::: "memory")
#define PG8_WAIT_L(n) asm volatile("s_waitcnt lgkmcnt(" #n ")" ::: "memory")
#define PG8_BAR __builtin_amdgcn_s_barrier()
#define PG8_SCHED __builtin_amdgcn_sched_barrier(0)
#define PG8_ABASE(u) ((const char*)g.A + ((size_t)(u).pm * BM * g.lda + (size_t)((u).pn >> g.a_shift) * g.a_mul) * 2)
#define PG8_BBASE(u) ((const char*)g.Bt + (size_t)(u).pn * BM * g.ldb * 2)
    Unit cur, nxt; int ui = 0;
    if (!S.next(0, cur)) return;
    f32x4 acc[2][2][4][2];
#pragma unroll
    for (int a = 0; a < 2; ++a)
#pragma unroll
        for (int b = 0; b < 2; ++b)
#pragma unroll
            for (int m = 0; m < 4; ++m)
#pragma unroll
                for (int n = 0; n < 2; ++n) acc[a][b][m][n] = (f32x4){0.f, 0.f, 0.f, 0.f};
    bf16x8 At[4][2], B0[2][2], B1[2][2];
    const char* cA = PG8_ABASE(cur); const char* cB = PG8_BBASE(cur);
    PG8_STAGE(PG8_SB(0, 0), cB, voffB); PG8_STAGE(PG8_SB(0, 1), cB + hstepB, voffB); PG8_STAGE(PG8_SA(0, 0), cA, voffA); PG8_STAGE(PG8_SA(0, 1), cA + hstepA, voffA);
    if (wr == 1) PG8_BAR;
    PG8_WAIT_V(2); PG8_BAR;
    PG8_STAGE(PG8_SB(1, 0), cB + kstep, voffB); PG8_STAGE(PG8_SA(1, 0), cA + kstep, voffA); PG8_STAGE(PG8_SB(1, 1), cB + hstepB + kstep, voffB);
    PG8_WAIT_V(6); PG8_BAR;
    for (;;) {
        const bool has_next = S.next(ui + 1, nxt);
        const char* nA = has_next ? PG8_ABASE(nxt) : cA; const char* nB = has_next ? PG8_BBASE(nxt) : cB;
        for (int t = 0; t < nt; t += 2) {
            const bool last = (t == nt - 2);
            const char* a1 = cA + (size_t)(t + 1) * kstep;
            const char* a2 = last ? nA : cA + (size_t)(t + 2) * kstep; const char* b2 = last ? nB : cB + (size_t)(t + 2) * kstep;
            const char* a3 = a2 + kstep; const char* b3 = b2 + kstep;
            PG8_LDB(B0, 0, 0); PG8_LDB(B1, 0, 1); PG8_SCHED; PG8_LDA(At, 0, 0); PG8_STAGE(PG8_SA(1, 1), a1 + hstepA, voffA);
            PG8_WAIT_V(8); PG8_WAIT_L(0); PG8_BAR; PG8_MMA(0, 0, At, B0); PG8_MMA(0, 1, At, B1); PG8_BAR; PG8_SCHED;
            PG8_LDA(At, 0, 1); PG8_STAGE(PG8_SB(0, 0), b2, voffB); PG8_STAGE(PG8_SB(0, 1), b2 + hstepB, voffB); PG8_STAGE(PG8_SA(0, 0), a2, voffA);
            PG8_WAIT_V(8); PG8_WAIT_L(0); PG8_BAR; PG8_MMA(1, 0, At, B0); PG8_MMA(1, 1, At, B1); PG8_BAR; PG8_SCHED;
            PG8_LDB(B0, 1, 0); PG8_LDB(B1, 1, 1); PG8_SCHED; PG8_LDA(At, 1, 0); PG8_STAGE(PG8_SA(0, 1), a2 + hstepA, voffA);
            PG8_WAIT_V(8); PG8_WAIT_L(0); PG8_BAR; PG8_MMA(0, 0, At, B0); PG8_MMA(0, 1, At, B1); PG8_BAR; PG8_SCHED;
            PG8_LDA(At, 1, 1); PG8_STAGE(PG8_SB(1, 0), b3, voffB); PG8_STAGE(PG8_SB(1, 1), b3 + hstepB, voffB); PG8_STAGE(PG8_SA(1, 0), a3, voffA);
            PG8_WAIT_V(8); PG8_WAIT_L(0); PG8_BAR; PG8_MMA(1, 0, At, B0); PG8_MMA(1, 1, At, B1); PG8_BAR; PG8_SCHED;
        }
        if constexpr (ALIGN_EPI) { if (wr == 0) PG8_BAR; }
        { int t2 = threadIdx.x; asm volatile("" : "+v"(t2)); const int l2 = t2 & 63;
          E(acc, cur, wr, wc, l2 & 15, l2 >> 4); }
        if (!has_next) break;
#pragma unroll
        for (int a = 0; a < 2; ++a)
#pragma unroll
            for (int b = 0; b < 2; ++b)
#pragma unroll
                for (int m = 0; m < 4; ++m)
#pragma unroll
                    for (int n = 0; n < 2; ++n) acc[a][b][m][n] = (f32x4){0.f, 0.f, 0.f, 0.f};
        cur = nxt; cA = nA; cB = nB; ++ui;
        if constexpr (ALIGN_EPI) { if (wr == 1) PG8_BAR; }
    }
    PG8_WAIT_V(0);
    if constexpr (!ALIGN_EPI) { if (wr == 0) PG8_BAR; }
    PG8_BAR;
#undef PG8_SA
#undef PG8_SB
#undef PG8_STAGE
#undef PG8_LDA
#undef PG8_LDB
#undef PG8_MMA
#undef PG8_WAIT_V
#undef PG8_WAIT_L
#undef PG8_BAR
#undef PG8_SCHED
#undef PG8_ABASE
#undef PG8_BBASE
}

template <bool NORM> struct EpiBf16Plain {
    static constexpr bool PERM = true;
    bf16_t* O; int ldc; const float* shw; int shw_stride; const unsigned long long* SS;
    __device__ __forceinline__ void operator()(const f32x4 (&acc)[2][2][4][2], const Unit& u, int wr, int wc, int fr, int fq) const {
        const int row0 = u.pm * BM + wr * 64 + fr, col0 = u.pn * BM + wc * 32 + 8 * fq;
        f32x4 bv[2][2];
#pragma unroll
        for (int bj = 0; bj < 2; ++bj)
#pragma unroll
            for (int n = 0; n < 2; ++n) bv[bj][n] = NORM ? *(const f32x4*)(shw + (size_t)(u.pm >> 3) * shw_stride + col0 + bj * HALF + 4 * n) : (f32x4){0.f, 0.f, 0.f, 0.f};
#pragma unroll
        for (int ai = 0; ai < 2; ++ai)
#pragma unroll
            for (int m = 0; m < 4; ++m) { const int row = row0 + ai * HALF + m * 16; bf16_t* rowp = O + (size_t)row * ldc + col0;
                float rs = 1.0f; if (NORM) rs = 1.0f / sqrtf((float)SS[row] * (1.0f / (16777216.0f * D)) + EPS);
#pragma unroll
                for (int bj = 0; bj < 2; ++bj) { const f32x4 v0 = acc[ai][bj][m][0] * rs + bv[bj][0], v1 = acc[ai][bj][m][1] * rs + bv[bj][1];
                    u32x4 w; w.x = cvt_pk_bf16(v0[0], v0[1]); w.y = cvt_pk_bf16(v0[2], v0[3]); w.z = cvt_pk_bf16(v1[0], v1[1]); w.w = cvt_pk_bf16(v1[2], v1[3]);
                    *(u32x4*)(rowp + bj * HALF) = w; } }
    }
};
struct EpiFp8 {
    static constexpr bool PERM = true;
    unsigned char* O; int ldc;
    __device__ __forceinline__ void operator()(const f32x4 (&acc)[2][2][4][2], const Unit& u, int wr, int wc, int fr, int fq) const {
        const int row0 = u.pm * BM + wr * 64 + fr, col0 = u.pn * BM + wc * 32 + 8 * fq;
#pragma unroll
        for (int ai = 0; ai < 2; ++ai)
#pragma unroll
            for (int m = 0; m < 4; ++m) { unsigned char* rowp = O + (size_t)(row0 + ai * HALF + m * 16) * ldc + col0;
#pragma unroll
                for (int bj = 0; bj < 2; ++bj) { const f32x4 v0 = acc[ai][bj][m][0], v1 = acc[ai][bj][m][1];
                    int w0 = 0, w1 = 0;
                    w0 = __builtin_amdgcn_cvt_pk_fp8_f32(v0[0], v0[1], w0, false); w0 = __builtin_amdgcn_cvt_pk_fp8_f32(v0[2], v0[3], w0, true);
                    w1 = __builtin_amdgcn_cvt_pk_fp8_f32(v1[0], v1[1], w1, false); w1 = __builtin_amdgcn_cvt_pk_fp8_f32(v1[2], v1[3], w1, true);
                    u32x2 w; w.x = (unsigned)w0; w.y = (unsigned)w1; *(u32x2*)(rowp + bj * HALF) = w; }
                asm volatile("" ::: "memory"); }
    }
};
struct EpiInA {
    static constexpr bool PERM = true;
    bf16_t* Q; bf16_t* CKV; bf16_t* QI; bf16_t* KIN; float* WI; const float* kg; const float* kb; const float* shw; const unsigned long long* SS;
    __device__ __forceinline__ void operator()(f32x4 (&acc)[2][2][4][2], const Unit& u, int wr, int wc, int fr, int fq) const {
        const int row0 = u.pm * BM + wr * 64 + fr, cl = wc * 32 + 8 * fq;
        {
            const float* sp = shw + (size_t)(u.pm >> 3) * 2048 + u.pn * BM + cl;
            f32x4 bv[2][2];
#pragma unroll
            for (int bj = 0; bj < 2; ++bj)
#pragma unroll
                for (int n = 0; n < 2; ++n) bv[bj][n] = *(const f32x4*)(sp + bj * HALF + 4 * n);
#pragma unroll
            for (int ai = 0; ai < 2; ++ai)
#pragma unroll
                for (int m = 0; m < 4; ++m) { const float rs = 1.0f / sqrtf((float)SS[row0 + ai * HALF + m * 16] * (1.0f / (16777216.0f * D)) + EPS);
#pragma unroll
                    for (int bj = 0; bj < 2; ++bj)
#pragma unroll
                        for (int n = 0; n < 2; ++n) acc[ai][bj][m][n] = acc[ai][bj][m][n] * rs + bv[bj][n]; }
        }
        if (u.pn < 7) {
            bf16_t* base; int ldc, c0;
            if (u.pn < 4) { base = Q; ldc = 1024; c0 = u.pn * 256; } else if (u.pn == 4) { base = CKV; ldc = 256; c0 = 0; } else { base = QI; ldc = 512; c0 = (u.pn - 5) * 256; }
#pragma unroll
            for (int ai = 0; ai < 2; ++ai)
#pragma unroll
                for (int m = 0; m < 4; ++m) { bf16_t* rowp = base + (size_t)(row0 + ai * HALF + m * 16) * ldc + c0 + cl;
#pragma unroll
                    for (int bj = 0; bj < 2; ++bj) { const f32x4 v0 = acc[ai][bj][m][0], v1 = acc[ai][bj][m][1];
                        u32x4 w; w.x = cvt_pk_bf16(v0[0], v0[1]); w.y = cvt_pk_bf16(v0[2], v0[3]); w.z = cvt_pk_bf16(v1[0], v1[1]); w.w = cvt_pk_bf16(v1[2], v1[3]);
                        *(u32x4*)(rowp + bj * HALF) = w; } }
        } else if (wc == 0) {
            f32x4 gv[2][2], bv[2][2];
#pragma unroll
            for (int bj = 0; bj < 2; ++bj)
#pragma unroll
                for (int n = 0; n < 2; ++n) { gv[bj][n] = *(const f32x4*)(kg + 32 * bj + 8 * fq + 4 * n); bv[bj][n] = *(const f32x4*)(kb + 32 * bj + 8 * fq + 4 * n); }
#pragma unroll
            for (int ai = 0; ai < 2; ++ai)
#pragma unroll
                for (int m = 0; m < 4; ++m) {
                    float s = 0.f;
#pragma unroll
                    for (int bj = 0; bj < 2; ++bj)
#pragma unroll
                        for (int n = 0; n < 2; ++n) { const f32x4 x = acc[ai][bj][m][n]; s += (x[0] + x[1]) + (x[2] + x[3]); }
                    s += __shfl_xor(s, 16); s += __shfl_xor(s, 32);
                    const float mu = s * (1.0f / 64.0f); float q = 0.f;
#pragma unroll
                    for (int bj = 0; bj < 2; ++bj)
#pragma unroll
                        for (int n = 0; n < 2; ++n) { const f32x4 d = acc[ai][bj][m][n] - mu; q += (d[0] * d[0] + d[1] * d[1]) + (d[2] * d[2] + d[3] * d[3]); }
                    q += __shfl_xor(q, 16); q += __shfl_xor(q, 32);
                    const float rs = 1.0f / sqrtf(q * (1.0f / 64.0f) + EPS);
                    bf16_t* rowp = KIN + (size_t)(row0 + ai * HALF + m * 16) * 64 + 8 * fq;
#pragma unroll
                    for (int bj = 0; bj < 2; ++bj) { const f32x4 v0 = (acc[ai][bj][m][0] - mu) * rs * gv[bj][0] + bv[bj][0], v1 = (acc[ai][bj][m][1] - mu) * rs * gv[bj][1] + bv[bj][1];
                        u32x4 w; w.x = cvt_pk_bf16(v0[0], v0[1]); w.y = cvt_pk_bf16(v0[2], v0[3]); w.z = cvt_pk_bf16(v1[0], v1[1]); w.w = cvt_pk_bf16(v1[2], v1[3]);
                        *(u32x4*)(rowp + bj * 32) = w; }
                }
        } else if (wc == 1 && fq == 0) {
            const float sc = 0.04419417382415922f;
#pragma unroll
            for (int ai = 0; ai < 2; ++ai)
#pragma unroll
                for (int m = 0; m < 4; ++m) { float* rowp = WI + (size_t)(row0 + ai * HALF + m * 16) * 8;
                    *(f32x4*)(rowp) = acc[ai][0][m][0] * sc; *(f32x4*)(rowp + 4) = acc[ai][0][m][1] * sc; }
        }
    }
};
struct EpiResid {
    static constexpr bool PERM = true;
    const bf16_t* xin_b; bf16_t* xout_b;
    const float* gate; const float* bias;
    bf16_t* XG; const float* gn; const float* scn; unsigned long long* SSo;
    __device__ __forceinline__ void operator()(const f32x4 (&acc)[2][2][4][2], const Unit& u, int wr, int wc, int fr, int fq) const {
        const int row0 = u.pm * BM + wr * 64 + fr, col0 = u.pn * BM + wc * 32 + 8 * fq, b = u.pm >> 3;
        float ssum[2][4];
#pragma unroll
        for (int ai = 0; ai < 2; ++ai)
#pragma unroll
            for (int m = 0; m < 4; ++m) ssum[ai][m] = 0.f;
#pragma unroll
        for (int bj = 0; bj < 2; ++bj) {
            const int c = col0 + bj * HALF;
            const f32x4 gv0 = *(const f32x4*)(gate + (size_t)b * 6144 + c), gv1 = *(const f32x4*)(gate + (size_t)b * 6144 + c + 4);
            f32x4 bv0 = (f32x4){0.f, 0.f, 0.f, 0.f}, bv1 = bv0, gm0 = bv0, gm1 = bv0;
            if (bias) { bv0 = *(const f32x4*)(bias + c); bv1 = *(const f32x4*)(bias + c + 4); }
            if (XG) { gm0 = *(const f32x4*)(gn + c) * (*(const f32x4*)(scn + (size_t)b * 6144 + c) + 1.0f); gm1 = *(const f32x4*)(gn + c + 4) * (*(const f32x4*)(scn + (size_t)b * 6144 + c + 4) + 1.0f); }
#pragma unroll
            for (int ai = 0; ai < 2; ++ai)
#pragma unroll
                for (int m = 0; m < 4; ++m) { const size_t off = (size_t)(row0 + ai * HALF + m * 16) * D + c;
                    const u32x4 xv = *(const u32x4*)(xin_b + off);
                    const f32x4 xi0 = (f32x4){__uint_as_float(xv.x << 16), __uint_as_float(xv.x & 0xffff0000u), __uint_as_float(xv.y << 16), __uint_as_float(xv.y & 0xffff0000u)};
                    const f32x4 xi1 = (f32x4){__uint_as_float(xv.z << 16), __uint_as_float(xv.z & 0xffff0000u), __uint_as_float(xv.w << 16), __uint_as_float(xv.w & 0xffff0000u)};
                    const f32x4 xo0 = xi0 + gv0 * (acc[ai][bj][m][0] + bv0), xo1 = xi1 + gv1 * (acc[ai][bj][m][1] + bv1);
                    { u32x4 w; w.x = cvt_pk_bf16(xo0[0], xo0[1]); w.y = cvt_pk_bf16(xo0[2], xo0[3]); w.z = cvt_pk_bf16(xo1[0], xo1[1]); w.w = cvt_pk_bf16(xo1[2], xo1[3]); *(u32x4*)(xout_b + off) = w; }
                    if (XG) {
                        ssum[ai][m] += ((xo0[0] * xo0[0] + xo0[1] * xo0[1]) + (xo0[2] * xo0[2] + xo0[3] * xo0[3])) + ((xo1[0] * xo1[0] + xo1[1] * xo1[1]) + (xo1[2] * xo1[2] + xo1[3] * xo1[3]));
                        const f32x4 y0 = xo0 * gm0, y1 = xo1 * gm1;
                        u32x4 w; w.x = cvt_pk_bf16(y0[0], y0[1]); w.y = cvt_pk_bf16(y0[2], y0[3]); w.z = cvt_pk_bf16(y1[0], y1[1]); w.w = cvt_pk_bf16(y1[2], y1[3]);
                        *(u32x4*)(XG + off) = w; }
                    if (m & 1) asm volatile("" ::: "memory"); }
        }
        if (XG) {
#pragma unroll
            for (int ai = 0; ai < 2; ++ai)
#pragma unroll
                for (int m = 0; m < 4; ++m) { float q = ssum[ai][m]; q += __shfl_xor(q, 16); q += __shfl_xor(q, 32);
                    if (fq == 0) atomicAdd(SSo + row0 + ai * HALF + m * 16, (unsigned long long)(q * 16777216.0f)); }
        }
    }
};
struct EpiSwiGLU {
    static constexpr bool PERM = true;
    bf16_t* H; const float* shw; const unsigned long long* SS;
    __device__ __forceinline__ void operator()(const f32x4 (&acc)[2][2][4][2], const Unit& u, int wr, int wc, int fr, int fq) const {
        const int row0 = u.pm * BM + wr * 64 + fr, f0 = u.pn * 128 + wc * 32 + 8 * fq;
        f32x4 bv[2][2];
        { const float* sp = shw + (size_t)(u.pm >> 3) * (2 * DFF) + u.pn * BM + wc * 32 + 8 * fq;
#pragma unroll
          for (int bj = 0; bj < 2; ++bj)
#pragma unroll
              for (int n = 0; n < 2; ++n) bv[bj][n] = *(const f32x4*)(sp + bj * HALF + 4 * n); }
#pragma unroll
        for (int ai = 0; ai < 2; ++ai)
#pragma unroll
            for (int m = 0; m < 4; ++m) { bf16_t* rowp = H + (size_t)(row0 + ai * HALF + m * 16) * DFF + f0;
                const float rs = 1.0f / sqrtf((float)SS[row0 + ai * HALF + m * 16] * (1.0f / (16777216.0f * D)) + EPS);
                float o[8];
#pragma unroll
                for (int n = 0; n < 2; ++n)
#pragma unroll
                    for (int e = 0; e < 4; ++e) o[4 * n + e] = silu_f(acc[ai][0][m][n][e] * rs + bv[0][n][e]) * (acc[ai][1][m][n][e] * rs + bv[1][n][e]);
                u32x4 w; w.x = cvt_pk_bf16(o[0], o[1]); w.y = cvt_pk_bf16(o[2], o[3]); w.z = cvt_pk_bf16(o[4], o[5]); w.w = cvt_pk_bf16(o[6], o[7]);
                *(u32x4*)(rowp) = w; }
    }
};
}

struct Ptrs {
    const float* in[23]; float* out; unsigned char* ws;
};
enum { I_X = 0, I_C, I_RELB, I_WADA, I_BADA, I_GMIX, I_GFFN, I_AWIN, I_AKVG, I_AWUK, I_AWUV, I_AIKG, I_AIKB, I_AWOUT, I_BWIN, I_BBIN, I_BSINK, I_BWOUT, I_BBOUT, I_W1, I_W3, I_W2, I_GFIN };

__device__ __forceinline__ void conv_task(const Ptrs& P, int t, int lane) {
    int kind, rb, ks, Kd; bf16_t* dst; const float* s0 = nullptr; const float* s1 = nullptr; const float* gk = nullptr; int ld = 0;
    if (t < 2112) { const int l = t / 528, r = t % 528; unsigned char* wl = P.ws + WS_W + (size_t)l * W_LAYER;
        if (r < 352) { kind = 1; rb = r >> 2; ks = r & 3; Kd = 1024; dst = (bf16_t*)(wl + W13_OFF); s0 = P.in[I_W1] + (size_t)l * D * DFF; s1 = P.in[I_W3] + (size_t)l * D * DFF; ld = DFF; }
        else { const int r2 = r - 352; kind = 0; rb = r2 / 11; ks = r2 % 11; Kd = DFF; dst = (bf16_t*)(wl + W2_OFF); s0 = P.in[I_W2] + (size_t)l * DFF * D; ld = D; }
    } else { const int t2 = t - 2112, j = t2 / 464, r = t2 % 464; unsigned char* wa = P.ws + WS_WA + (size_t)j * WA_STRIDE; unsigned char* wb = P.ws + WS_WB + (size_t)j * WB_STRIDE;
        if (r < 128) { kind = 2; rb = r >> 2; ks = r & 3; Kd = 1024; dst = (bf16_t*)(wa + WINA_OFF); s0 = P.in[I_AWIN] + (size_t)j * D * A_IN; ld = A_IN; }
        else if (r < 192) { kind = 3; rb = r - 128; ks = 0; Kd = 256; dst = (bf16_t*)(wa + WQA_OFF); s0 = P.in[I_AWUK] + (size_t)j * NH * RK * HD; gk = P.in[I_AKVG] + j * RK; }
        else if (r < 256) { const int r2 = r - 192; kind = 4; rb = r2 >> 2; ks = r2 & 3; Kd = 1024; dst = (bf16_t*)(wa + WUV_OFF); s0 = P.in[I_AWUV] + (size_t)j * NH * RK * HD; gk = P.in[I_AKVG] + j * RK; }
        else if (r < 320) { const int r2 = r - 256; kind = 0; rb = r2 >> 2; ks = r2 & 3; Kd = 1024; dst = (bf16_t*)(wa + WOUTA_OFF); s0 = P.in[I_AWOUT] + (size_t)j * D * D; ld = D; }
        else if (r < 400) { const int r2 = r - 320; kind = 0; rb = r2 >> 2; ks = r2 & 3; Kd = 1024; dst = (bf16_t*)(wb + WINB_OFF); s0 = P.in[I_BWIN] + (size_t)j * D * B_IN; ld = B_IN; }
        else { const int r2 = r - 400; kind = 0; rb = r2 >> 2; ks = r2 & 3; Kd = 1024; dst = (bf16_t*)(wb + WOUTB_OFF); s0 = P.in[I_BWOUT] + (size_t)j * D * D; ld = D; }
    }
    const int n = rb * 64 + lane, k0 = ks * 256;
    bf16_t* drow = dst + (size_t)n * Kd + k0;
    if (kind <= 2) {
        const float* src = s0; int col = n;
        if (kind == 1) { const int c = n & 255, f = (n >> 8) * 128 + (c & 127); src = (c < 128) ? s0 : s1; col = f; }
        if (kind == 2) { if (n >= 1792) { const int c = n - 1792; col = c < 32 ? 1792 + c : (c < 40 ? 1856 + (c - 32) : ((c >= 128 && c < 160) ? 1824 + (c - 128) : -1)); } }
        const float* sp = src + (size_t)k0 * ld + (col < 0 ? 0 : col);
        for (int kc = 0; kc < 32; ++kc) {
            float v[8];
#pragma unroll
            for (int e = 0; e < 8; ++e) v[e] = sp[(size_t)(kc * 8 + e) * ld];
            if (col < 0) {
#pragma unroll
                for (int e = 0; e < 8; ++e) v[e] = 0.f; }
            u32x4 w; w.x = cvt_pk_bf16(v[0], v[1]); w.y = cvt_pk_bf16(v[2], v[3]); w.z = cvt_pk_bf16(v[4], v[5]); w.w = cvt_pk_bf16(v[6], v[7]);
            *(u32x4*)(drow + kc * 8) = w;
        }
    } else if (kind == 3) {
        const int h = n >> 8, r = n & 255; const float gs = gk[r] * 8.0f;       const float* sp = s0 + ((size_t)h * RK + r) * HD;
        for (int kc = 0; kc < 32; ++kc) { const int k = kc * 8; float v[8];
            if ((k >> 6) == (h & 3)) {
#pragma unroll
                for (int e = 0; e < 8; ++e) v[e] = sp[(k & 63) + e] * gs;
            } else {
#pragma unroll
                for (int e = 0; e < 8; ++e) v[e] = 0.f; }
            u32x4 w; w.x = cvt_pk_bf16(v[0], v[1]); w.y = cvt_pk_bf16(v[2], v[3]); w.z = cvt_pk_bf16(v[4], v[5]); w.w = cvt_pk_bf16(v[6], v[7]);
            *(u32x4*)(drow + kc * 8) = w; }
    } else {
        const int hh = (n >> 6) & 3, d = n & 63, h = n >> 6;
        for (int kc = 0; kc < 32; ++kc) { const int k = k0 + kc * 8; float v[8];
            if ((k >> 8) == hh) {
#pragma unroll
                for (int e = 0; e < 8; ++e) { const int r = (k & 255) + e; v[e] = s0[((size_t)h * RK + r) * HD + d] * gk[r]; }
            } else {
#pragma unroll
                for (int e = 0; e < 8; ++e) v[e] = 0.f; }
            u32x4 w; w.x = cvt_pk_bf16(v[0], v[1]); w.y = cvt_pk_bf16(v[2], v[3]); w.z = cvt_pk_bf16(v[4], v[5]); w.w = cvt_pk_bf16(v[6], v[7]);
            *(u32x4*)(drow + kc * 8) = w; }
    }
}
constexpr int N_CONV_TASKS = 3040;

__device__ __forceinline__ void p0_prologue(const Ptrs& P, LAS unsigned char* lds, int G) {
    int tid = threadIdx.x; asm volatile("" : "+v"(tid));
    const int lane = tid & 63, wave = __builtin_amdgcn_readfirstlane(tid >> 6);
    const int gw = blockIdx.x * NWAVES + wave, NGW = G * NWAVES;
    for (int t = gw; t < N_CONV_TASKS; t += NGW) conv_task(P, t, lane);
    LAS float* cs = (LAS float*)lds;
    LAS float* red = (LAS float*)(lds + 65536);
    for (int i = tid; i < BATCH * D; i += NTHR) { const int b = i >> 10, k = i & 1023; cs[k * 16 + b] = silu_f(P.in[I_C][i]); }
    __syncthreads();
    float* mod = (float*)(P.ws + WS_MOD);
    for (int task = blockIdx.x; task < 4 * 96; task += G) {
        const int l = task / 96, j0 = (task % 96) * 64, col = tid & 63, ksl = tid >> 6;
        const float* wp = P.in[I_WADA] + ((size_t)l * D + ksl * 128) * 6144 + j0 + col;
        float a[16];
#pragma unroll
        for (int b = 0; b < 16; ++b) a[b] = 0.f;
        for (int k = 0; k < 128; ++k) { const float w = wp[(size_t)k * 6144]; const LAS f32x4* c4 = (const LAS f32x4*)(cs + (ksl * 128 + k) * 16);
#pragma unroll
            for (int q = 0; q < 4; ++q) { const f32x4 c = c4[q];
#pragma unroll
                for (int e = 0; e < 4; ++e) a[4 * q + e] += w * c[e]; } }
#pragma unroll
        for (int b = 0; b < 16; ++b) red[(ksl * 64 + col) * 16 + b] = a[b];
        __syncthreads();
        for (int o = tid; o < 1024; o += NTHR) { const int c2 = o >> 4, b = o & 15; float s = 0.f;
#pragma unroll
            for (int q = 0; q < 8; ++q) s += red[(q * 64 + c2) * 16 + b];
            mod[((size_t)l * BATCH + b) * 6144 + j0 + c2] = s + P.in[I_BADA][l * 6144 + j0 + c2]; }
        __syncthreads();
    }
}

__device__ __forceinline__ void pre_phase(const Ptrs& P, LAS unsigned char* lds, int G) {
    int tid = threadIdx.x; asm volatile("" : "+v"(tid));
    const int lane = tid & 63, wave = __builtin_amdgcn_readfirstlane(tid >> 6);
    const float* mod = (const float*)(P.ws + WS_MOD);
    {
        const int grp = blockIdx.x & 7, l = grp >> 1, kind = grp & 1, j = l >> 1;
        const float* shsrc = mod + (size_t)l * BATCH * 6144 + (kind ? 3072 : 0);
        constexpr int SP = 2064;
        for (int i = tid; i < BATCH * D / 2; i += NTHR) { const int b = i >> 9, k2 = (i & 511) * 2;
            const float a0 = shsrc[(size_t)b * 6144 + k2], a1 = shsrc[(size_t)b * 6144 + k2 + 1];
            *(LAS unsigned*)(lds + b * SP + k2 * 2) = cvt_pk_bf16(a0, a1); }
        __syncthreads();
        const bf16_t* W; int nrows; float* dst; const float* bias = nullptr;
        if (kind) { W = (const bf16_t*)(P.ws + WS_W + (size_t)l * W_LAYER + W13_OFF); nrows = 2 * DFF; dst = (float*)(P.ws + WS_SHW + SHW_F) + (size_t)l * BATCH * 2 * DFF; }
        else if ((l & 1) == 0) { W = (const bf16_t*)(P.ws + WS_WA + (size_t)j * WA_STRIDE + WINA_OFF); nrows = 2048; dst = (float*)(P.ws + WS_SHW + SHW_A) + (size_t)j * BATCH * 2048; }
        else { W = (const bf16_t*)(P.ws + WS_WB + (size_t)j * WB_STRIDE + WINB_OFF); nrows = B_IN; dst = (float*)(P.ws + WS_SHW + SHW_B) + (size_t)j * BATCH * B_IN; bias = P.in[I_BBIN] + j * B_IN; }
        const int nblk = nrows >> 4, wq = (blockIdx.x >> 3) * NWAVES + wave, nwq = (G >> 3) * NWAVES;
        const int nn = lane & 15, g = lane >> 4;
        for (int blk = wq; blk < nblk; blk += nwq) {
            f32x4 acc = (f32x4){0.f, 0.f, 0.f, 0.f};
            const bf16_t* wp = W + (size_t)(blk * 16 + nn) * D + 8 * g;
#pragma unroll 8
            for (int ks = 0; ks < 32; ++ks) { const bf16x8 a = *(const LAS bf16x8*)(lds + nn * SP + (32 * ks + 8 * g) * 2); const bf16x8 bw = *(const bf16x8*)(wp + 32 * ks);
                acc = __builtin_amdgcn_mfma_f32_16x16x32_bf16(a, bw, acc, 0, 0, 0); }
            const int n = blk * 16 + nn; const float bb = bias ? bias[n] : 0.f;
#pragma unroll
            for (int i = 0; i < 4; ++i) dst[(size_t)(4 * g + i) * nrows + n] = acc[i] + bb;
        }
    }
    {
        const int gw = blockIdx.x * NWAVES + wave, NGW = G * NWAVES;
        const float* x = P.in[I_X]; const float* gmix = P.in[I_GMIX]; bf16_t* XG = (bf16_t*)(P.ws + WS_XG); unsigned long long* SS0 = (unsigned long long*)(P.ws + WS_SS);
        for (int row = gw; row < M; row += NGW) {
            const int b = row >> 11;
            const f32x4* xr = (const f32x4*)(x + (size_t)row * D) + lane;
            f32x4 v[4]; float sq = 0.f;
#pragma unroll
            for (int jj = 0; jj < 4; ++jj) { v[jj] = xr[64 * jj]; sq += (v[jj][0] * v[jj][0] + v[jj][1] * v[jj][1]) + (v[jj][2] * v[jj][2] + v[jj][3] * v[jj][3]); }
            const float ss = wave_sum(sq);
            if (lane == 0) SS0[row] = (unsigned long long)(ss * 16777216.0f);
            const float* mb = mod + (size_t)b * 6144;
            u32x2* o8 = (u32x2*)(XG + (size_t)row * D) + lane; u32x2* x8 = (u32x2*)((bf16_t*)P.out + (size_t)row * D) + lane;
#pragma unroll
            for (int jj = 0; jj < 4; ++jj) { const int c = 4 * lane + 256 * jj;
                const f32x4 y = v[jj] * *(const f32x4*)(gmix + c) * (*(const f32x4*)(mb + 1024 + c) + 1.0f);
                u32x2 w; w.x = cvt_pk_bf16(y[0], y[1]); w.y = cvt_pk_bf16(y[2], y[3]); o8[64 * jj] = w;
                u32x2 xw; xw.x = cvt_pk_bf16(v[jj][0], v[jj][1]); xw.y = cvt_pk_bf16(v[jj][2], v[jj][3]); x8[64 * jj] = xw; }
        }
    }
}
__device__ __forceinline__ void final_norm_phase(const bf16_t* x, float* out, const float* g, int G) {
    int tid = threadIdx.x; asm volatile("" : "+v"(tid));
    const int lane = tid & 63, wave = __builtin_amdgcn_readfirstlane(tid >> 6);
    const int gw = blockIdx.x * NWAVES + wave, NGW = G * NWAVES;
    for (int row = gw; row < M; row += NGW) {
        const u32x2* xr = (const u32x2*)(x + (size_t)row * D) + lane; f32x4* orow = (f32x4*)(out + (size_t)row * D) + lane;
        f32x4 v[4]; float s = 0.f;
#pragma unroll
        for (int j = 0; j < 4; ++j) { const u32x2 p = xr[64 * j];
            v[j] = (f32x4){__uint_as_float(p.x << 16), __uint_as_float(p.x & 0xffff0000u), __uint_as_float(p.y << 16), __uint_as_float(p.y & 0xffff0000u)};
            s += (v[j][0] * v[j][0] + v[j][1] * v[j][1]) + (v[j][2] * v[j][2] + v[j][3] * v[j][3]); }
        const float rstd = 1.0f / sqrtf(wave_sum(s) * (1.0f / D) + EPS);
#pragma unroll
        for (int j = 0; j < 4; ++j) { const f32x4 gg = *(const f32x4*)(g + 4 * lane + 256 * j); orow[64 * j] = v[j] * rstd * gg; }
    }
}

__device__ __forceinline__ unsigned f2key(float f) { const unsigned u = __float_as_uint(f); return (u & 0x80000000u) ? ~u : (u | 0x80000000u); }
__device__ __forceinline__ float key2f(unsigned k) { return __uint_as_float((k & 0x80000000u) ? (k & 0x7fffffffu) : ~k); }
__device__ __forceinline__ float half_max(float x) {
    int u = __float_as_int(x);
    u = __float_as_int(fmaxf(__int_as_float(u), __int_as_float(__builtin_amdgcn_update_dpp(u, u, 0x128, 0xf, 0xf, false))));
    u = __float_as_int(fmaxf(__int_as_float(u), __int_as_float(__builtin_amdgcn_update_dpp(u, u, 0x124, 0xf, 0xf, false))));
    u = __float_as_int(fmaxf(__int_as_float(u), __int_as_float(__builtin_amdgcn_update_dpp(u, u, 0x122, 0xf, 0xf, false))));
    u = __float_as_int(fmaxf(__int_as_float(u), __int_as_float(__builtin_amdgcn_update_dpp(u, u, 0x121, 0xf, 0xf, false))));
    const u32x2 r = __builtin_amdgcn_permlane16_swap((unsigned)u, (unsigned)u, false, false);
    return fmaxf(__uint_as_float(r.x), __uint_as_float(r.y));
}
__device__ __forceinline__ float half_sum_f(float v) {
    v += __int_as_float(__builtin_amdgcn_update_dpp(__float_as_int(v), __float_as_int(v), 0x128, 0xf, 0xf, false));
    v += __int_as_float(__builtin_amdgcn_update_dpp(__float_as_int(v), __float_as_int(v), 0x124, 0xf, 0xf, false));
    v += __int_as_float(__builtin_amdgcn_update_dpp(__float_as_int(v), __float_as_int(v), 0x122, 0xf, 0xf, false));
    v += __int_as_float(__builtin_amdgcn_update_dpp(__float_as_int(v), __float_as_int(v), 0x121, 0xf, 0xf, false));
    const u32x2 r = __builtin_amdgcn_permlane16_swap(__float_as_uint(v), __float_as_uint(v), false, false);
    return __uint_as_float(r.x) + __uint_as_float(r.y);
}
__device__ __forceinline__ f32x2 pk_gt(f32x2 x, f32x2 big, f32x2 nfbig) { f32x2 d; asm("v_pk_fma_f32 %0, %1, %2, %3 clamp" : "=v"(d) : "v"(x), "v"(big), "v"(nfbig)); return d; }
__device__ __forceinline__ int half_sum(int v) {
    v += __builtin_amdgcn_update_dpp(v, v, 0x128, 0xf, 0xf, false);
    v += __builtin_amdgcn_update_dpp(v, v, 0x124, 0xf, 0xf, false);
    v += __builtin_amdgcn_update_dpp(v, v, 0x122, 0xf, 0xf, false);
    v += __builtin_amdgcn_update_dpp(v, v, 0x121, 0xf, 0xf, false);
    const u32x2 r = __builtin_amdgcn_permlane16_swap((unsigned)v, (unsigned)v, false, false);
    return (int)(r.x + r.y);
}
typedef float f32x32 __attribute__((ext_vector_type(32)));
__device__ __forceinline__ void idx_task(const bf16_t* QI, const bf16_t* KIN, const float* WI, unsigned* SEL, LAS unsigned char* lds, int b, int tg, int lane, int wave, bool active, int nrounds) {
    asm volatile("" : "+v"(lane));
    const int t0 = tg * 4, h = lane >> 5, r = lane & 31;
    const int qsel = 2 * (r >> 4) + ((r >> 2) & 1), hd = (r & 3) + 4 * ((r >> 3) & 1);
    const size_t rowb = (size_t)b * SEQ;
    bf16x8 aq[4];
#pragma unroll
    for (int ks = 0; ks < 4; ++ks) aq[ks] = *(const bf16x8*)(QI + (rowb + t0 + qsel) * 512 + hd * 64 + ks * 16 + h * 8);
    float wlo[8], whi[8];
    { const f32x4 a0 = *(const f32x4*)(WI + (rowb + t0 + h) * 8), a1 = *(const f32x4*)(WI + (rowb + t0 + h) * 8 + 4);
      const f32x4 b0 = *(const f32x4*)(WI + (rowb + t0 + 2 + h) * 8), b1 = *(const f32x4*)(WI + (rowb + t0 + 2 + h) * 8 + 4);
#pragma unroll
      for (int e = 0; e < 4; ++e) { wlo[e] = a0[e]; wlo[4 + e] = a1[e]; whi[e] = b0[e]; whi[4 + e] = b1[e]; } }
    f32x32 sA0, sA1, sB0, sB1;
#pragma unroll
    for (int i = 0; i < 32; ++i) { sA0[i] = NEGF; sA1[i] = NEGF; sB0[i] = NEGF; sB1[i] = NEGF; }
    const int ktmax = (t0 + 3) >> 5, tlo = t0 + h, thi = t0 + 2 + h;
    const unsigned lb = (unsigned)(size_t)lds;
    const int sw = (r >> 1) & 7;
#define IDX_LDS4(R0, R1, R2, R3) asm volatile("ds_read_b128 %0, %4\n\tds_read_b128 %1, %5\n\tds_read_b128 %2, %6\n\tds_read_b128 %3, %7" \
                                             : "=&v"(R0), "=&v"(R1), "=&v"(R2), "=&v"(R3) : "v"(a0), "v"(a1), "v"(a2), "v"(a3) : "memory")
#define IDX_TILE(KTL, KEY0, SA, SB, C0, C1, C2, C3, N0, N1, N2, N3) \
        { \
            a0 += 4096u; a1 += 4096u; a2 += 4096u; a3 += 4096u; \
            IDX_LDS4(N0, N1, N2, N3);                          \
            asm volatile("s_waitcnt lgkmcnt(4)" : "+v"(C0), "+v"(C1), "+v"(C2), "+v"(C3) :: "memory");     \
            f32x16 acc; \
            _Pragma("unroll") for (int i = 0; i < 16; ++i) acc[i] = 0.f; \
            acc = __builtin_amdgcn_mfma_f32_32x32x16_bf16(aq[0], C0, acc, 0, 0, 0); acc = __builtin_amdgcn_mfma_f32_32x32x16_bf16(aq[1], C1, acc, 0, 0, 0); \
            acc = __builtin_amdgcn_mfma_f32_32x32x16_bf16(aq[2], C2, acc, 0, 0, 0); acc = __builtin_amdgcn_mfma_f32_32x32x16_bf16(aq[3], C3, acc, 0, 0, 0); \
            f32x2 p0 = (f32x2){0.f, 0.f}, p1 = (f32x2){0.f, 0.f};            \
            _Pragma("unroll") for (int i = 0; i < 4; ++i) { \
                const f32x2 r0 = (f32x2){__builtin_amdgcn_fmed3f(acc[2 * i], 0.f, 3.0e38f), __builtin_amdgcn_fmed3f(acc[2 * i + 1], 0.f, 3.0e38f)}; \
                const f32x2 r1 = (f32x2){__builtin_amdgcn_fmed3f(acc[8 + 2 * i], 0.f, 3.0e38f), __builtin_amdgcn_fmed3f(acc[9 + 2 * i], 0.f, 3.0e38f)}; \
                p0 = __builtin_elementwise_fma((f32x2){wlo[2 * i], wlo[2 * i + 1]}, r0, p0); p1 = __builtin_elementwise_fma((f32x2){whi[2 * i], whi[2 * i + 1]}, r1, p1); } \
            const float s0 = p0.x + p0.y, s1 = p1.x + p1.y; \
            const int key = (KEY0) + r; \
            SA[KTL] = key <= tlo ? s0 : NEGF; SB[KTL] = key <= thi ? s1 : NEGF; \
        }
    bf16x8 ta0, ta1, ta2, ta3, tb0, tb1, tb2, tb3;
#pragma unroll
    for (int rnd = 0; rnd < 2; ++rnd) {
        if (rnd >= nrounds) break;
        __syncthreads();
        {
            const int rl = lane >> 3, pp = lane & 7;
#pragma unroll 4
            for (int j = 0; j < 16; ++j) { const int pi = wave * 16 + j, row = 8 * pi + rl;
                const bf16_t* src = KIN + (rowb + 1024 * rnd + row) * 64 + 8 * (pp ^ ((row >> 1) & 7));
                __builtin_amdgcn_global_load_lds((const unsigned*)src, (LAS unsigned*)(lds + 1024 * pi), 16, 0, 0); }
        }
        asm volatile("s_waitcnt vmcnt(0)" ::: "memory");
        __syncthreads();
        const int ntl = ktmax - 32 * rnd + 1;
        if (active && ntl > 0) {
            const int npair = ((ntl < 32 ? ntl : 32) + 1) >> 1;
            unsigned a0 = lb + (unsigned)r * 128u + 16u * (unsigned)((0 + h) ^ sw), a1 = lb + (unsigned)r * 128u + 16u * (unsigned)((2 + h) ^ sw);
            unsigned a2 = lb + (unsigned)r * 128u + 16u * (unsigned)((4 + h) ^ sw), a3 = lb + (unsigned)r * 128u + 16u * (unsigned)((6 + h) ^ sw);
            IDX_LDS4(ta0, ta1, ta2, ta3);
#pragma nounroll
            for (int kp = 0; kp < npair; ++kp) {
                if (rnd == 0) { IDX_TILE(2 * kp, 64 * kp, sA0, sB0, ta0, ta1, ta2, ta3, tb0, tb1, tb2, tb3)
                                IDX_TILE(2 * kp + 1, 64 * kp + 32, sA0, sB0, tb0, tb1, tb2, tb3, ta0, ta1, ta2, ta3) }
                else          { IDX_TILE(2 * kp, 1024 + 64 * kp, sA1, sB1, ta0, ta1, ta2, ta3, tb0, tb1, tb2, tb3)
                                IDX_TILE(2 * kp + 1, 1024 + 64 * kp + 32, sA1, sB1, tb0, tb1, tb2, tb3, ta0, ta1, ta2, ta3) }
            }
            asm volatile("s_waitcnt lgkmcnt(0)" : "+v"(ta0), "+v"(ta1), "+v"(ta2), "+v"(ta3), "+v"(tb0), "+v"(tb1), "+v"(tb2), "+v"(tb3) :: "memory");
        }
    }
#undef IDX_TILE
#undef IDX_LDS4
    if (!active) return;
    const int nt0 = ktmax < 31 ? ktmax + 1 : 32, nt1 = ktmax - 31;
    float mxA = NEGF, mxB = NEGF, mnA = -NEGF, mnB = -NEGF;
#pragma nounroll
    for (int kt = 0; kt < nt0; ++kt) { const float a = sA0[kt], bb = sB0[kt];
        mxA = fmaxf(mxA, a); mxB = fmaxf(mxB, bb); mnA = fminf(mnA, a > -1e29f ? a : -NEGF); mnB = fminf(mnB, bb > -1e29f ? bb : -NEGF); }
#pragma nounroll
    for (int kt = 0; kt < nt1; ++kt) { const float a = sA1[kt], bb = sB1[kt];
        mxA = fmaxf(mxA, a); mxB = fmaxf(mxB, bb); mnA = fminf(mnA, a > -1e29f ? a : -NEGF); mnB = fminf(mnB, bb > -1e29f ? bb : -NEGF); }
    mxA = half_max(mxA); mxB = half_max(mxB); mnA = -half_max(-mnA); mnB = -half_max(-mnB);
    const int Ka = tlo + 1 < TOPK ? tlo + 1 : TOPK, Kb = thi + 1 < TOPK ? thi + 1 : TOPK;
    float loA = mnA - (fabsf(mnA) * 1e-6f + 1e-30f), hiA = mxA, loB = mnB - (fabsf(mnB) * 1e-6f + 1e-30f), hiB = mxB;
    float cloA = (float)(tlo + 1), chiA = 0.0f, cloB = (float)(thi + 1), chiB = 0.0f;
    float TA = -1e29f, TB = -1e29f; bool doneA = (tlo + 1 <= TOPK), doneB = (thi + 1 <= TOPK);
    const int nblk = (ktmax >> 3) + 1;
    const float BIG = 1099511627776.0f;
#define SA2(i) ((i) < 32 ? (f32x2){sA0[(i) & 31], sA0[((i) & 31) + 1]} : (f32x2){sA1[(i) & 31], sA1[((i) & 31) + 1]})
#define SB2(i) ((i) < 32 ? (f32x2){sB0[(i) & 31], sB0[((i) & 31) + 1]} : (f32x2){sB1[(i) & 31], sB1[((i) & 31) + 1]})
#pragma nounroll
    for (int it = 0; it < 48; ++it) {
        if (__ballot(!doneA || !doneB) == 0ull) break;
        const bool bis = (it % 3) == 2;
        const float wA = hiA - loA, wB = hiB - loB;
        float rA = bis ? 0.5f : (cloA - (float)Ka + 0.5f) / (cloA - chiA), rB = bis ? 0.5f : (cloB - (float)Kb + 0.5f) / (cloB - chiB);
        rA = fminf(fmaxf(rA, 0.03f), 0.97f); rB = fminf(fmaxf(rB, 0.03f), 0.97f);
        const float midA = loA + wA * rA, midB = loB + wB * rB;
        const float fA = doneA ? TA : midA, fB = doneB ? TB : midB;
        const f32x2 bigp = (f32x2){BIG, BIG}, nfA = (f32x2){-fA * BIG, -fA * BIG}, nfB = (f32x2){-fB * BIG, -fB * BIG};
        f32x2 cA2 = (f32x2){0.f, 0.f}, cB2 = (f32x2){0.f, 0.f};
#pragma unroll
        for (int blk = 0; blk < 8; ++blk) {
            if (blk < nblk) {
#pragma unroll
                for (int e = 0; e < 4; ++e) { cA2 += pk_gt(SA2(8 * blk + 2 * e), bigp, nfA); cB2 += pk_gt(SB2(8 * blk + 2 * e), bigp, nfB); }
            }
        }
        const int cA = (int)half_sum_f(cA2.x + cA2.y), cB = (int)half_sum_f(cB2.x + cB2.y);
        const bool stuckA = !(midA > loA && midA < hiA), stuckB = !(midB > loB && midB < hiB);
        if (!doneA) { if (cA == Ka) { TA = fA; doneA = true; } else if (stuckA) { TA = loA; doneA = true; } else if (cA > Ka) { loA = midA; cloA = (float)cA; } else { hiA = midA; chiA = (float)cA; } }
        if (!doneB) { if (cB == Kb) { TB = fB; doneB = true; } else if (stuckB) { TB = loB; doneB = true; } else if (cB > Kb) { loB = midB; cloB = (float)cB; } else { hiB = midB; chiB = (float)cB; } }
    }
#undef SA2
#undef SB2
    if (!doneA) TA = loA;
    if (!doneB) TB = loB;
    unsigned w0 = 0u, w1 = 0u, w2 = 0u, w3 = 0u;
#pragma nounroll
    for (int kt = 0; kt < nt0; ++kt) { const unsigned long long ma = __ballot(sA0[kt] > TA), mb = __ballot(sB0[kt] > TB);
        if (lane == kt) { w0 = (unsigned)ma; w1 = (unsigned)(ma >> 32); w2 = (unsigned)mb; w3 = (unsigned)(mb >> 32); } }
#pragma nounroll
    for (int kt = 0; kt < nt1; ++kt) { const unsigned long long ma = __ballot(sA1[kt] > TA), mb = __ballot(sB1[kt] > TB);
        if (lane == 32 + kt) { w0 = (unsigned)ma; w1 = (unsigned)(ma >> 32); w2 = (unsigned)mb; w3 = (unsigned)(mb >> 32); } }
    SEL[(rowb + t0 + 0) * 64 + lane] = w0; SEL[(rowb + t0 + 1) * 64 + lane] = w1; SEL[(rowb + t0 + 2) * 64 + lane] = w2; SEL[(rowb + t0 + 3) * 64 + lane] = w3;
}

#define ATT_F(r) ((((r) & 7) << 1) | (((r) >> 3) & 1))
#define TRB8(OFS, r0, r1, r2, r3, r4, r5, r6, r7, a0, a1, a2, a3, a4, a5, a6, a7) \
    asm volatile("ds_read_b64_tr_b16 %0, %8 offset:" OFS "\n\tds_read_b64_tr_b16 %1, %9 offset:" OFS "\n\tds_read_b64_tr_b16 %2, %10 offset:" OFS "\n\tds_read_b64_tr_b16 %3, %11 offset:" OFS "\n\t" \
                 "ds_read_b64_tr_b16 %4, %12 offset:" OFS "\n\tds_read_b64_tr_b16 %5, %13 offset:" OFS "\n\tds_read_b64_tr_b16 %6, %14 offset:" OFS "\n\tds_read_b64_tr_b16 %7, %15 offset:" OFS "\n\ts_waitcnt lgkmcnt(0)" \
                 : "=&v"(r0), "=&v"(r1), "=&v"(r2), "=&v"(r3), "=&v"(r4), "=&v"(r5), "=&v"(r6), "=&v"(r7) \
                 : "v"(a0), "v"(a1), "v"(a2), "v"(a3), "v"(a4), "v"(a5), "v"(a6), "v"(a7) : "memory")
#define RDK8(OFS, r, a) \
    asm volatile("ds_read_b64 %0, %8 offset:" OFS "\n\tds_read_b64 %1, %9 offset:" OFS "\n\tds_read_b64 %2, %10 offset:" OFS "\n\tds_read_b64 %3, %11 offset:" OFS "\n\t" \
                 "ds_read_b64 %4, %12 offset:" OFS "\n\tds_read_b64 %5, %13 offset:" OFS "\n\tds_read_b64 %6, %14 offset:" OFS "\n\tds_read_b64 %7, %15 offset:" OFS "\n\ts_waitcnt lgkmcnt(0)" \
                 : "=&v"(r[0]), "=&v"(r[1]), "=&v"(r[2]), "=&v"(r[3]), "=&v"(r[4]), "=&v"(r[5]), "=&v"(r[6]), "=&v"(r[7]) \
                 : "v"(a[0]), "v"(a[1]), "v"(a[2]), "v"(a[3]), "v"(a[4]), "v"(a[5]), "v"(a[6]), "v"(a[7]) : "memory")
__device__ __forceinline__ float rows_max(float x) {
    unsigned u = __float_as_uint(x);
    u32x2 r = __builtin_amdgcn_permlane16_swap(u, u, false, false);
    u = __float_as_uint(fmaxf(__uint_as_float(r.x), __uint_as_float(r.y)));
    r = __builtin_amdgcn_permlane32_swap(u, u, false, false);
    return fmaxf(__uint_as_float(r.x), __uint_as_float(r.y));
}
__device__ __forceinline__ float rows_sum(float x) {
    unsigned u = __float_as_uint(x);
    u32x2 r = __builtin_amdgcn_permlane16_swap(u, u, false, false);
    u = __float_as_uint(__uint_as_float(r.x) + __uint_as_float(r.y));
    r = __builtin_amdgcn_permlane32_swap(u, u, false, false);
    return __uint_as_float(r.x) + __uint_as_float(r.y);
}

__device__ __forceinline__ int att_build_list(LAS unsigned* list, const LAS unsigned* btab, unsigned w, int t, int lane) {
    const int pc = __popc(w); int incl = pc;
#pragma unroll
    for (int o = 1; o < 64; o <<= 1) { const int v = __shfl_up(incl, o); if (lane >= o) incl += v; }
    const int total = __shfl(incl, 63); const int cnt = total < TOPK ? total : TOPK;
    int off = incl - pc;
    while (w) { const int bit = __builtin_ctz(w); w &= w - 1u;
        if (off < TOPK) { const int idx = 32 * lane + bit; int dd = t - idx; dd = dd < 0 ? 0 : (dd > 128 ? 128 : dd); list[off] = (unsigned)idx | (btab[dd] << 16); }
        ++off; }
    for (int sl = cnt + lane; sl < ((cnt + 31) & ~31); sl += 64) list[sl] = 0u;
    return cnt;
}
__device__ __forceinline__ void att_gather32(const unsigned char* CKV8b, const LAS unsigned* list32, LAS unsigned char* slot, int lane) {
    const LAS unsigned* lp = list32 + (lane >> 4);
    unsigned idx[8];
#pragma unroll
    for (int i = 0; i < 8; ++i) idx[i] = lp[4 * i] & 0xffffu;
#pragma unroll
    for (int i = 0; i < 8; ++i) {
        const int rr = 4 * i + (lane >> 4);
        const unsigned char* src = CKV8b + (size_t)idx[i] * RK + 16 * ((lane & 15) ^ ATT_F(rr));
        __builtin_amdgcn_global_load_lds((const unsigned*)src, (LAS unsigned*)(slot + 1024 * i), 16, 0, 0);
    }
}

#define ATT_T(q) (((q) & 2047) ^ (((q) >> 11) ? 255 : 0))
__device__ __forceinline__ void att_wave(const unsigned char* CKV8, const unsigned* SEL, unsigned char* BIG, LAS unsigned char* kvbuf, LAS unsigned* lists, const LAS float* relb, const LAS unsigned* btab,
                                         int xcd, int wx, int nwx, int lane) {
    asm volatile("" : "+v"(lane));
    const int hq = lane & 15, g = lane >> 4;
    const int nq = (2 * SEQ - wx + nwx - 1) / nwx;
    if (nq <= 0) return;
    const unsigned kvb = (unsigned)(size_t)kvbuf;
    unsigned qa[8];
#pragma unroll
    for (int ks = 0; ks < 8; ++ks) qa[ks] = kvb + (unsigned)hq * 256u + 16u * (unsigned)((2 * ks + (g >> 1)) ^ ATT_F(hq)) + 8u * (unsigned)(g & 1);
    const int tq = hq >> 2, tp = hq & 3, trow = 4 * g + tq;
    unsigned ta[8];
#pragma unroll
    for (int nt = 0; nt < 8; ++nt) ta[nt] = kvb + (unsigned)trow * 256u + 16u * (unsigned)((2 * nt + (tp >> 1)) ^ ATT_F(trow)) + 8u * (unsigned)(tp & 1);

    int q = wx, b = 2 * xcd + (q >> 11), t = ATT_T(q);
    size_t row = (size_t)b * SEQ + t;
    unsigned wsel = SEL[row * 64 + lane];
    int cnt = att_build_list(lists, btab, wsel, t, lane);
    unsigned wnext = 0u;
    if (nq > 1) { const int q1 = wx + nwx; wnext = SEL[((size_t)(2 * xcd + (q1 >> 11)) * SEQ + ATT_T(q1)) * 64 + lane]; }
    long bq[8];
    { const unsigned char* qp = BIG + row * 8192 + hq * 256 + 8 * g;
#pragma unroll
      for (int ks = 0; ks < 8; ++ks) bq[ks] = *(const long*)(qp + 32 * ks); }
    int par = 0;
    asm volatile("s_waitcnt lgkmcnt(0)" ::: "memory");
    att_gather32(CKV8 + (size_t)b * SEQ * RK, lists, kvbuf, lane);
    for (int k = 0; k < nq; ++k) {
        const int cur = k & 1;
        LAS unsigned* list = lists + cur * 256;
        const bool has_next = (k + 1 < nq);
        const int qn = q + nwx, bn = 2 * xcd + (qn >> 11), tn = ATT_T(qn);
        const size_t rown = (size_t)bn * SEQ + tn;
        int cntn = 0;
        if (has_next) { cntn = att_build_list(lists + (cur ^ 1) * 256, btab, wnext, tn, lane);
            if (k + 2 < nq) { const int q2 = qn + nwx; wnext = SEL[((size_t)(2 * xcd + (q2 >> 11)) * SEQ + ATT_T(q2)) * 64 + lane]; } }
        f32x4 Oe[8], Oo[8];
#pragma unroll
        for (int nt = 0; nt < 8; ++nt) { Oe[nt] = (f32x4){0.f, 0.f, 0.f, 0.f}; Oo[nt] = (f32x4){0.f, 0.f, 0.f, 0.f}; }
        float mref = NEGF, lsum = 0.f;
        const int nsub = (cnt + 31) >> 5;
        for (int sc = 0; sc < nsub; ++sc) {
            const bool lastc = (sc + 1 == nsub);
            float bias[8];
#pragma unroll
            for (int T = 0; T < 2; ++T) { const u32x4 mt = *(const LAS u32x4*)(list + 32 * sc + 16 * T + 4 * g);
#pragma unroll
                for (int i = 0; i < 4; ++i) bias[4 * T + i] = relb[(mt[i] >> 16) * 16 + hq]; }
            if (!lastc) { att_gather32(CKV8 + (size_t)b * SEQ * RK, list + 32 * (sc + 1), kvbuf + (par ^ 1) * 8192, lane); asm volatile("s_waitcnt vmcnt(8)" ::: "memory"); }
            else if (has_next) { att_gather32(CKV8 + (size_t)bn * SEQ * RK, lists + (cur ^ 1) * 256, kvbuf + (par ^ 1) * 8192, lane); asm volatile("s_waitcnt vmcnt(8)" ::: "memory"); }
            else { asm volatile("s_waitcnt vmcnt(0)" ::: "memory"); }
            f32x4 st0 = (f32x4){0.f, 0.f, 0.f, 0.f}, st1 = st0;
            { long kr[8];
              RDK8("0", kr, qa);
#pragma unroll
              for (int ks = 0; ks < 8; ++ks) st0 = __builtin_amdgcn_mfma_f32_16x16x32_fp8_fp8(kr[ks], bq[ks], st0, 0, 0, 0);
              RDK8("4096", kr, qa);
#pragma unroll
              for (int ks = 0; ks < 8; ++ks) st1 = __builtin_amdgcn_mfma_f32_16x16x32_fp8_fp8(kr[ks], bq[ks], st1, 0, 0, 0); }
            if (lastc && has_next) { const unsigned char* qp = BIG + rown * 8192 + hq * 256 + 8 * g;
#pragma unroll
                for (int ks = 0; ks < 8; ++ks) bq[ks] = *(const long*)(qp + 32 * ks); }
            float lg[8]; float cmax = NEGF;
#pragma unroll
            for (int i = 0; i < 4; ++i) { const int s0 = 32 * sc + 4 * g + i;
                float v0 = st0[i] * (1.0f / 64.0f) + bias[i]; v0 = (s0 < cnt) ? v0 : NEGF; lg[i] = v0;
                float v1 = st1[i] * (1.0f / 64.0f) + bias[4 + i]; v1 = (s0 + 16 < cnt) ? v1 : NEGF; lg[4 + i] = v1; cmax = fmaxf(cmax, fmaxf(v0, v1)); }
            cmax = rows_max(cmax);
            if (__ballot(cmax > mref + 3.0f) != 0ull) {
                const float mnew = fmaxf(mref, cmax), scl = fast_exp(mref - mnew);
                lsum *= scl;
#pragma unroll
                for (int nt = 0; nt < 8; ++nt) { Oe[nt] = Oe[nt] * scl; Oo[nt] = Oo[nt] * scl; }
                mref = mnew;
            }
            float p[8];
#pragma unroll
            for (int i = 0; i < 8; ++i) { p[i] = fast_exp(lg[i] - mref); lsum += p[i]; }
            int pw0 = 0, pw1 = 0;
            pw0 = __builtin_amdgcn_cvt_pk_fp8_f32(p[0] * 16.0f, p[1] * 16.0f, pw0, false); pw0 = __builtin_amdgcn_cvt_pk_fp8_f32(p[2] * 16.0f, p[3] * 16.0f, pw0, true);
            pw1 = __builtin_amdgcn_cvt_pk_fp8_f32(p[4] * 16.0f, p[5] * 16.0f, pw1, false); pw1 = __builtin_amdgcn_cvt_pk_fp8_f32(p[6] * 16.0f, p[7] * 16.0f, pw1, true);
            const long pk = (long)(((unsigned long long)(unsigned)pw1 << 32) | (unsigned long long)(unsigned)pw0);
            {
#define TRB4(OFS, r0, r1, r2, r3, a0, a1, a2, a3) \
    asm volatile("ds_read_b64_tr_b16 %0, %4 offset:" OFS "\n\tds_read_b64_tr_b16 %1, %5 offset:" OFS "\n\tds_read_b64_tr_b16 %2, %6 offset:" OFS "\n\tds_read_b64_tr_b16 %3, %7 offset:" OFS \
                 : "=&v"(r0), "=&v"(r1), "=&v"(r2), "=&v"(r3) : "v"(a0), "v"(a1), "v"(a2), "v"(a3) : "memory")
#define ATT_PV(NT, RR, UU) { const u32x2 a = __builtin_bit_cast(u32x2, RR), c = __builtin_bit_cast(u32x2, UU); \
                    const unsigned e0 = __builtin_amdgcn_perm(a.y, a.x, 0x06040200u), o0 = __builtin_amdgcn_perm(a.y, a.x, 0x07050301u); \
                    const unsigned e1 = __builtin_amdgcn_perm(c.y, c.x, 0x06040200u), o1 = __builtin_amdgcn_perm(c.y, c.x, 0x07050301u); \
                    Oe[NT] = __builtin_amdgcn_mfma_f32_16x16x32_fp8_fp8((long)(((unsigned long long)e1 << 32) | e0), pk, Oe[NT], 0, 0, 0); \
                    Oo[NT] = __builtin_amdgcn_mfma_f32_16x16x32_fp8_fp8((long)(((unsigned long long)o1 << 32) | o0), pk, Oo[NT], 0, 0, 0); }
                s16x4 r0, r1, r2, r3, u0, u1, u2, u3;
                TRB4("0", r0, r1, r2, r3, ta[0], ta[1], ta[2], ta[3]);
                TRB4("4096", u0, u1, u2, u3, ta[0], ta[1], ta[2], ta[3]);
                asm volatile("s_waitcnt lgkmcnt(0)" : "+v"(r0), "+v"(r1), "+v"(r2), "+v"(r3), "+v"(u0), "+v"(u1), "+v"(u2), "+v"(u3) :: "memory");
                ATT_PV(0, r0, u0) ATT_PV(1, r1, u1) ATT_PV(2, r2, u2) ATT_PV(3, r3, u3)
                TRB4("0", r0, r1, r2, r3, ta[4], ta[5], ta[6], ta[7]);
                TRB4("4096", u0, u1, u2, u3, ta[4], ta[5], ta[6], ta[7]);
                asm volatile("s_waitcnt lgkmcnt(0)" : "+v"(r0), "+v"(r1), "+v"(r2), "+v"(r3), "+v"(u0), "+v"(u1), "+v"(u2), "+v"(u3) :: "memory");
                ATT_PV(4, r0, u0) ATT_PV(5, r1, u1) ATT_PV(6, r2, u2) ATT_PV(7, r3, u3)
#undef TRB4
#undef ATT_PV
            }
            par ^= 1;
#pragma unroll
            for (int e = 0; e < 8; ++e) { qa[e] ^= 8192u; ta[e] ^= 8192u; }
        }
        lsum = rows_sum(lsum);
        const float inv = 1.0f / (16.0f * lsum);
        bf16_t* op = (bf16_t*)(BIG + row * 8192) + hq * 256 + 8 * g;
#pragma unroll
        for (int nt = 0; nt < 8; ++nt) { const f32x4 e = Oe[nt] * inv, o = Oo[nt] * inv;
            u32x4 wv; wv.x = cvt_pk_bf16(e[0], o[0]); wv.y = cvt_pk_bf16(e[1], o[1]); wv.z = cvt_pk_bf16(e[2], o[2]); wv.w = cvt_pk_bf16(e[3], o[3]); *(u32x4*)(op + 32 * nt) = wv; }
        q = qn; b = bn; t = tn; row = rown; cnt = cntn;
    }
}

constexpr int SW_KP = 144, SW_VP = 520;
constexpr int SW_K_OFF = 0, SW_V_OFF = 256 * SW_KP, SW_TB_OFF = SW_V_OFF + 64 * SW_VP;
__device__ __forceinline__ void swa_phase(const bf16_t* QKV, bf16_t* OB, const float* relb, const float* sinks, LAS unsigned char* lds, int G) {
    int tid = threadIdx.x; asm volatile("" : "+v"(tid));
    const int lane = tid & 63, wave = __builtin_amdgcn_readfirstlane(tid >> 6);
    const int h = lane >> 5, n = lane & 31;
    LAS float* tb = (LAS float*)(lds + SW_TB_OFF);
    for (int u = blockIdx.x; u < BATCH * 16 * KVH; u += G) {
        const int b = u >> 5, nb = (u >> 1) & 15, kvh = u & 1;
        const size_t rowb = (size_t)b * SEQ;
        __syncthreads();
#pragma unroll
        for (int e = 0; e < 4; ++e) { const int id = tid + NTHR * e, j = id >> 3, ch = id & 7; const int pos = (nb - 1) * WIN + j;
            u32x4 kv = (u32x4){0u, 0u, 0u, 0u}, vv = (u32x4){0u, 0u, 0u, 0u};
            if (pos >= 0) { const bf16_t* sp = QKV + (rowb + pos) * B_IN + 1024 + kvh * 64 + ch * 8; kv = *(const u32x4*)sp; vv = *(const u32x4*)(sp + 128); }
            *(LAS u32x4*)(lds + SW_K_OFF + j * SW_KP + ch * 16) = kv;
            LAS bf16_t* vt = (LAS bf16_t*)(lds + SW_V_OFF + (ch * 8) * SW_VP + j * 2);
#pragma unroll
            for (int q = 0; q < 4; ++q) { vt[(2 * q) * (SW_VP / 2)] = (bf16_t)(vv[q] & 0xffffu); vt[(2 * q + 1) * (SW_VP / 2)] = (bf16_t)(vv[q] >> 16); } }
        for (int i = tid; i < GQ * WIN; i += NTHR) { const int gg = i >> 7, dist = i & 127; tb[i] = relb[t5_bucket(dist) * NH + kvh * GQ + gg]; }
        __syncthreads();
        const int qh = kvh * GQ + wave; const float sink = sinks[qh];
        for (int rt = 0; rt < 4; ++rt) {
            const size_t qrow = rowb + nb * WIN + 32 * rt + n;
            bf16x8 bq[4];
#pragma unroll
            for (int ks = 0; ks < 4; ++ks) bq[ks] = *(const bf16x8*)(QKV + qrow * B_IN + qh * 64 + 16 * ks + 8 * h);
            f32x16 s[5];
#pragma unroll
            for (int ct = 0; ct < 5; ++ct) {
#pragma unroll
                for (int i = 0; i < 16; ++i) s[ct][i] = 0.f;
#pragma unroll
                for (int ks = 0; ks < 4; ++ks) { const bf16x8 a = *(const LAS bf16x8*)(lds + SW_K_OFF + (32 * (rt + ct) + n) * SW_KP + (2 * ks + h) * 16);
                    s[ct] = __builtin_amdgcn_mfma_f32_32x32x16_bf16(a, bq[ks], s[ct], 0, 0, 0); } }
            const int qi = 32 * rt + n;
            float mx = NEGF;
#pragma unroll
            for (int ct = 0; ct < 5; ++ct)
#pragma unroll
                for (int i = 0; i < 16; ++i) { const int j = 32 * (rt + ct) + (i & 3) + 8 * (i >> 2) + 4 * h; const int dist = qi + WIN - j;
                    const bool ok = (dist >= 0) && (dist < WIN) && (nb > 0 || j >= WIN);
                    const float v = ok ? s[ct][i] * 0.125f + tb[wave * WIN + (dist & 127)] : NEGF; s[ct][i] = v; mx = fmaxf(mx, v); }
            mx = fmaxf(mx, __shfl_xor(mx, 32)); mx = fmaxf(mx, sink);
            float sum = 0.f;
#pragma unroll
            for (int ct = 0; ct < 5; ++ct)
#pragma unroll
                for (int i = 0; i < 16; ++i) { const float p = fast_exp(s[ct][i] - mx); s[ct][i] = p; sum += p; }
            sum += __shfl_xor(sum, 32); sum += fast_exp(sink - mx);
            f32x16 o[2];
#pragma unroll
            for (int dt = 0; dt < 2; ++dt)
#pragma unroll
                for (int i = 0; i < 16; ++i) o[dt][i] = 0.f;
#pragma unroll
            for (int ct = 0; ct < 5; ++ct)
#pragma unroll
                for (int s2 = 0; s2 < 2; ++s2) {
                    u32x4 pw; pw.x = cvt_pk_bf16(s[ct][8 * s2 + 0], s[ct][8 * s2 + 1]); pw.y = cvt_pk_bf16(s[ct][8 * s2 + 2], s[ct][8 * s2 + 3]);
                    pw.z = cvt_pk_bf16(s[ct][8 * s2 + 4], s[ct][8 * s2 + 5]); pw.w = cvt_pk_bf16(s[ct][8 * s2 + 6], s[ct][8 * s2 + 7]);
                    const bf16x8 pb = __builtin_bit_cast(bf16x8, pw);
#pragma unroll
                    for (int dt = 0; dt < 2; ++dt) { const LAS unsigned char* vp = lds + SW_V_OFF + (32 * dt + n) * SW_VP + (32 * (rt + ct) + 16 * s2 + 4 * h) * 2;
                        const u32x2 v0 = *(const LAS u32x2*)vp, v1 = *(const LAS u32x2*)(vp + 16);
                        u32x4 va; va.x = v0.x; va.y = v0.y; va.z = v1.x; va.w = v1.y;
                        o[dt] = __builtin_amdgcn_mfma_f32_32x32x16_bf16(__builtin_bit_cast(bf16x8, va), pb, o[dt], 0, 0, 0); }
                }
            const float inv = 1.0f / sum;
            bf16_t* op = OB + qrow * D + qh * 64 + 4 * h;
#pragma unroll
            for (int dt = 0; dt < 2; ++dt)
#pragma unroll
                for (int i4 = 0; i4 < 4; ++i4) { u32x2 wv; wv.x = cvt_pk_bf16(o[dt][4 * i4] * inv, o[dt][4 * i4 + 1] * inv); wv.y = cvt_pk_bf16(o[dt][4 * i4 + 2] * inv, o[dt][4 * i4 + 3] * inv);
                    *(u32x2*)(op + 32 * dt + 8 * i4) = wv; }
        }
    }
}

struct Args { const float* in[23]; float* out; unsigned char* ws; };
#define CAS __attribute__((address_space(4)))
__device__ __forceinline__ const CAS Args* kargs() { const CAS Args* p = (const CAS Args*)__builtin_amdgcn_kernarg_segment_ptr(); asm volatile("" : "+s"(p)); return p; }

__global__ void __launch_bounds__(NTHR, 2) trunk_fwd(Args args_by_value) {
    extern __shared__ __attribute__((aligned(16))) unsigned char lds_raw[];
    LAS unsigned char* lds = (LAS unsigned char*)lds_raw;
    const int tid = threadIdx.x;
    volatile LAS unsigned* MISC = (volatile LAS unsigned*)(lds + LDS_MISC_OFF);
    for (int u = tid; u < (LDS_BYTES - LDS_MISC_OFF) / 4; u += NTHR) MISC[u] = 0u;
    __syncthreads();
    { const CAS Args* A = kargs(); (void)xcd_barrier_post((unsigned*)(A->ws + WS_CTL) + 4096, MISC + 8);
      if (tid == 0) { const unsigned x = xb_xcc_id(); MISC[16] = x; MISC[17] = xb_add((unsigned*)(A->ws + WS_CTL) + 8192 + 64 * x, 1u); } }
#define XCD_RANK(xcd, rank) do { const CAS Args* A_ = kargs(); const unsigned* cw_ = (const unsigned*)(A_->ws + WS_CTL) + 4096; bool ok_ = (gridDim.x & 7) == 0; \
        for (int j_ = 0; j_ < 16; ++j_) { const unsigned c_ = __hip_atomic_load(cw_ + XB_XCNT(j_), __ATOMIC_RELAXED, __HIP_MEMORY_SCOPE_AGENT); ok_ = ok_ && (c_ == (j_ < 8 ? gridDim.x >> 3 : 0u)); } \
        const unsigned hx_ = MISC[16], hr_ = MISC[17]; ok_ = ok_ && hx_ < 8u && hr_ < (gridDim.x >> 3); \
        xcd = ok_ ? (int)hx_ : (int)(blockIdx.x & 7); rank = ok_ ? (int)hr_ : (int)(blockIdx.x >> 3); } while (0)
#define GB() do { const CAS Args* A_ = kargs(); XcdBarrier b_; b_.bar = (unsigned*)(A_->ws + WS_CTL) + 4096; b_.x = xb_xcc_id(); b_.st = MISC + 8; xcd_barrier(b_); } while (0)

    { const CAS Args* A = kargs(); Ptrs P;
#pragma unroll
      for (int i = 0; i < 23; ++i) P.in[i] = A->in[i];
      P.out = A->out; P.ws = A->ws;
      p0_prologue(P, lds, (int)gridDim.x); }
    GB();
    { const CAS Args* A = kargs(); Ptrs P;
#pragma unroll
      for (int i = 0; i < 23; ++i) P.in[i] = A->in[i];
      P.out = A->out; P.ws = A->ws;
      pre_phase(P, lds, (int)gridDim.x); }
    GB();

    for (int l = 0; l < DEPTH; ++l) {
        const bool isA = (l & 1) == 0;
        {
            const CAS Args* A = kargs(); const int G = gridDim.x, j = l >> 1; unsigned char* ws = A->ws;
            const unsigned long long* SS = (const unsigned long long*)(ws + WS_SS) + (size_t)(2 * l) * M;
            if (isA) {
                unsigned char* wa = ws + WS_WA + (size_t)j * WA_STRIDE;
                pg8::Gemm g{(const bf16_t*)(ws + WS_XG), (const bf16_t*)(wa + WINA_OFF), D, D, D, 0, 0}; pg8::StaticOrder S; S.init(M, 2048, G, (int)blockIdx.x);
                pg8::EpiInA E{(bf16_t*)(ws + WS_QO), (bf16_t*)(ws + WS_CKV), (bf16_t*)(ws + WS_QI), (bf16_t*)(ws + WS_KIN), (float*)(ws + WS_WI), A->in[I_AIKG] + j * IDIM, A->in[I_AIKB] + j * IDIM,
                                (const float*)(ws + WS_SHW + SHW_A) + (size_t)j * BATCH * 2048, SS};
                pg8::gemm_phase<pg8::EpiInA, true>(lds, g, S, E);
            } else {
                unsigned char* wb = ws + WS_WB + (size_t)j * WB_STRIDE;
                pg8::Gemm g{(const bf16_t*)(ws + WS_XG), (const bf16_t*)(wb + WINB_OFF), D, D, D, 0, 0}; pg8::StaticOrder S; S.init(M, B_IN, G, (int)blockIdx.x);
                pg8::EpiBf16Plain<true> E{(bf16_t*)(ws + WS_QKV), B_IN, (const float*)(ws + WS_SHW + SHW_B) + (size_t)j * BATCH * B_IN, B_IN, SS};
                pg8::gemm_phase<pg8::EpiBf16Plain<true>, true>(lds, g, S, E);
            }
        }
        GB();
        if (isA) {
            { const CAS Args* A = kargs(); const int G = gridDim.x, j = l >> 1; unsigned char* ws = A->ws;
              unsigned char* wa = ws + WS_WA + (size_t)j * WA_STRIDE;
              pg8::Gemm g{(const bf16_t*)(ws + WS_QO), (const bf16_t*)(wa + WQA_OFF), D, 256, 256, 2, 256}; pg8::StaticOrder S; S.init(M, 4096, G, (int)blockIdx.x);
              pg8::EpiFp8 E{ws + WS_BIG, 8192};
              pg8::gemm_phase<pg8::EpiFp8, true>(lds, g, S, E); }
            { const CAS Args* A = kargs(); const int G = gridDim.x; unsigned char* ws = A->ws;
              int tid2 = tid; asm volatile("" : "+v"(tid2));
              const int lane = tid2 & 63, wave = __builtin_amdgcn_readfirstlane(tid2 >> 6);
              const bf16_t* CKV = (const bf16_t*)(ws + WS_CKV); unsigned* CKV8 = (unsigned*)(ws + WS_CKV8);
              const int gw = blockIdx.x * NWAVES + wave, NGW = G * NWAVES;
              for (int row = gw; row < M; row += NGW) {
                  const u32x2 v = *((const u32x2*)(CKV + (size_t)row * RK) + lane);
                  const float a0 = __uint_as_float(v.x << 16), a1 = __uint_as_float(v.x & 0xffff0000u), a2 = __uint_as_float(v.y << 16), a3 = __uint_as_float(v.y & 0xffff0000u);
                  const float ss = wave_sum((a0 * a0 + a1 * a1) + (a2 * a2 + a3 * a3));
                  const float rs = 1.0f / sqrtf(ss * (1.0f / RK) + EPS);
                  int w = 0; w = __builtin_amdgcn_cvt_pk_fp8_f32(a0 * rs, a1 * rs, w, false); w = __builtin_amdgcn_cvt_pk_fp8_f32(a2 * rs, a3 * rs, w, true);
                  CKV8[(size_t)row * (RK / 4) + lane] = (unsigned)w;
              } }
            { const CAS Args* A = kargs(); const int G = gridDim.x; unsigned char* ws = A->ws;
              int tid2 = tid; asm volatile("" : "+v"(tid2));
              const int lane = tid2 & 63, wave = __builtin_amdgcn_readfirstlane(tid2 >> 6);
              int xcd, rank; XCD_RANK(xcd, rank); xcd = __builtin_amdgcn_readfirstlane(xcd); rank = __builtin_amdgcn_readfirstlane(rank);
              const int wx = rank * NWAVES + wave, nwx = (G >> 3) * NWAVES;
              const int nsteps = (1024 + nwx - 1) / nwx;
              for (int st = 0; st < nsteps; ++st) {
                  const int q = wx + st * nwx; const bool active = q < 1024;
                  const int qc = active ? q : (rank * NWAVES + st * nwx < 1024 ? rank * NWAVES + st * nwx : 1023);
                  const int bl = qc >> 9, u = qc & 255, hiq = (qc >> 8) & 1, b = 2 * xcd + bl;
                  const int tg = hiq ? 511 - u : u;
                  idx_task((const bf16_t*)(ws + WS_QI), (const bf16_t*)(ws + WS_KIN), (const float*)(ws + WS_WI), (unsigned*)(ws + WS_SEL), lds, b, tg, lane, wave, active, hiq ? 2 : 1);
              }
              __syncthreads(); }
        } else {
            const CAS Args* A = kargs(); const int G = gridDim.x, j = l >> 1; unsigned char* ws = A->ws;
            swa_phase((const bf16_t*)(ws + WS_QKV), (bf16_t*)(ws + WS_OB), A->in[I_RELB], A->in[I_BSINK] + j * NH, lds, G);
        }
        GB();
        if (isA) {
            { const CAS Args* A = kargs(); const int G = gridDim.x; unsigned char* ws = A->ws;
              int tid2 = tid; asm volatile("" : "+v"(tid2));
              const int lane = tid2 & 63, wave = __builtin_amdgcn_readfirstlane(tid2 >> 6);
              LAS float* relb = (LAS float*)(lds + 147456);
              LAS unsigned* btab = (LAS unsigned*)(lds + 147456 + 2048);
              for (int i = tid2; i < NBUCK * NH; i += NTHR) relb[i] = A->in[I_RELB][i];
              for (int i = tid2; i < 132; i += NTHR) btab[i] = (unsigned)t5_bucket(i);
              __syncthreads();
              int xcd, rank; XCD_RANK(xcd, rank); xcd = __builtin_amdgcn_readfirstlane(xcd); rank = __builtin_amdgcn_readfirstlane(rank);
              const int wx = rank * NWAVES + wave, nwx = (G >> 3) * NWAVES;
              att_wave(ws + WS_CKV8, (const unsigned*)(ws + WS_SEL), ws + WS_BIG, lds + wave * 16384, (LAS unsigned*)(lds + 131072 + wave * 2048), relb, btab, xcd, wx, nwx, lane); }
            GB();
            { const CAS Args* A = kargs(); const int G = gridDim.x, j = l >> 1; unsigned char* ws = A->ws;
              unsigned char* wa = ws + WS_WA + (size_t)j * WA_STRIDE;
              pg8::Gemm g{(const bf16_t*)(ws + WS_BIG), (const bf16_t*)(wa + WUV_OFF), 4096, D, D, 0, 1024}; pg8::StaticOrder S; S.init(M, D, G, (int)blockIdx.x);
              pg8::EpiBf16Plain<false> E{(bf16_t*)(ws + WS_QO), D, nullptr, 0, nullptr};
              pg8::gemm_phase<pg8::EpiBf16Plain<false>, true>(lds, g, S, E); }
            GB();
        }
        {
            const CAS Args* A = kargs(); const int G = gridDim.x, j = l >> 1; unsigned char* ws = A->ws;
            const float* modl = (const float*)(ws + WS_MOD) + (size_t)l * BATCH * 6144;
            const bf16_t* Ain = (const bf16_t*)(ws + (isA ? WS_QO : WS_OB));
            const bf16_t* Bw = (const bf16_t*)(isA ? ws + WS_WA + (size_t)j * WA_STRIDE + WOUTA_OFF : ws + WS_WB + (size_t)j * WB_STRIDE + WOUTB_OFF);
            pg8::Gemm g{Ain, Bw, D, D, D, 0, 0}; pg8::StaticOrder S; S.init(M, D, G, (int)blockIdx.x);
            pg8::EpiResid E{(const bf16_t*)A->out, (bf16_t*)A->out, modl + 2048, isA ? nullptr : A->in[I_BBOUT] + j * D,
                            (bf16_t*)(ws + WS_XG), A->in[I_GFFN] + l * D, modl + 4096, (unsigned long long*)(ws + WS_SS) + (size_t)(2 * l + 1) * M};
            pg8::gemm_phase<pg8::EpiResid, true>(lds, g, S, E);
        }
        GB();
        {
            const CAS Args* A = kargs(); const int G = gridDim.x; unsigned char* ws = A->ws;
            unsigned char* wl = ws + WS_W + (size_t)l * W_LAYER;
            pg8::Gemm g{(const bf16_t*)(ws + WS_XG), (const bf16_t*)(wl + W13_OFF), D, D, D, 0, 0}; pg8::StaticOrder S; S.init(M, 2 * DFF, G, (int)blockIdx.x);
            pg8::EpiSwiGLU E{(bf16_t*)(ws + WS_HFF), (const float*)(ws + WS_SHW + SHW_F) + (size_t)l * BATCH * 2 * DFF, (const unsigned long long*)(ws + WS_SS) + (size_t)(2 * l + 1) * M};
            pg8::gemm_phase<pg8::EpiSwiGLU, true>(lds, g, S, E);
        }
        GB();
        {
            const CAS Args* A = kargs(); const int G = gridDim.x; unsigned char* ws = A->ws;
            unsigned char* wl = ws + WS_W + (size_t)l * W_LAYER;
            const float* modl = (const float*)(ws + WS_MOD) + (size_t)l * BATCH * 6144;
            const int ln = l + 1 < DEPTH ? l + 1 : l;
            pg8::Gemm g{(const bf16_t*)(ws + WS_HFF), (const bf16_t*)(wl + W2_OFF), DFF, DFF, DFF, 0, 0}; pg8::StaticOrder S; S.init(M, D, G, (int)blockIdx.x);
            const bool lastl = (l + 1 == DEPTH);
            pg8::EpiResid E{(const bf16_t*)A->out, lastl ? (bf16_t*)(ws + WS_XG) : (bf16_t*)A->out, modl + 5120, nullptr,
                            l + 1 < DEPTH ? (bf16_t*)(ws + WS_XG) : nullptr, A->in[I_GMIX] + ln * D, (const float*)(ws + WS_MOD) + (size_t)ln * BATCH * 6144 + 1024, (unsigned long long*)(ws + WS_SS) + (size_t)(2 * l + 2) * M};
            pg8::gemm_phase<pg8::EpiResid, true>(lds, g, S, E);
        }
        GB();
    }
    { const CAS Args* A = kargs(); final_norm_phase((const bf16_t*)(A->ws + WS_XG), A->out, A->in[I_GFIN], (int)gridDim.x); }
#undef GB
}

extern "C" void kernel_launch(void* const* d_in, const int* in_sizes, int n_in, void* d_out, int out_size, void* d_ws, size_t ws_size, hipStream_t stream) {
    static int grid = 0;
    if (grid == 0) {
        if (n_in != 23 || out_size != M * D || ws_size < WS_END) { fprintf(stderr, "kernel_launch: unexpected shapes (n_in %d out %d ws %zu)\n", n_in, out_size, ws_size); grid = -1; return; }
        int dev = 0, cus = 0, per_cu = 0;
        if (hipGetDevice(&dev) != hipSuccess || hipDeviceGetAttribute(&cus, hipDeviceAttributeMultiprocessorCount, dev) != hipSuccess) { grid = -1; return; }
        if (hipFuncSetAttribute((const void*)trunk_fwd, hipFuncAttributeMaxDynamicSharedMemorySize, LDS_BYTES) != hipSuccess) { fprintf(stderr, "kernel_launch: hipFuncSetAttribute failed\n"); grid = -1; return; }
        if (hipOccupancyMaxActiveBlocksPerMultiprocessor(&per_cu, (const void*)trunk_fwd, NTHR, LDS_BYTES) != hipSuccess || per_cu < 1) { fprintf(stderr, "kernel_launch: occupancy query says %d\n", per_cu); }
        (void)hipGetLastError();
        grid = cus;
    }
    if (grid < 0) return;
    (void)hipMemsetAsync((char*)d_ws + WS_CTL, 0, CTL_ZERO_BYTES, stream);
    Args a{};
    for (int i = 0; i < 23; ++i) a.in[i] = (const float*)d_in[i];
    a.out = (float*)d_out; a.ws = (unsigned char*)d_ws;
    hipLaunchKernelGGL(trunk_fwd, dim3(grid), dim3(NTHR), LDS_BYTES, stream, a);
    const hipError_t le = hipPeekAtLastError();
    if (le != hipSuccess) fprintf(stderr, "kernel_launch: launch failed: %s\n", hipGetErrorName(le));
}
```

```cpp
#include <hip/hip_runtime.h>
#include <cstdio>
#include <cstdint>


#define GAS __attribute__((address_space(1)))
#define LAS __attribute__((address_space(3)))
typedef unsigned short bf16_t;
typedef short bf16x8 __attribute__((ext_vector_type(8)));
typedef short s16x4 __attribute__((ext_vector_type(4)));
typedef float f32x4 __attribute__((ext_vector_type(4)));
typedef float f32x2 __attribute__((ext_vector_type(2)));
typedef float f32x16 __attribute__((ext_vector_type(16)));
typedef unsigned u32x4 __attribute__((ext_vector_type(4)));
typedef unsigned u32x2 __attribute__((ext_vector_type(2)));

constexpr int D = 1024, BATCH = 16, SEQ = 2048, M = BATCH * SEQ, DEPTH = 4;
constexpr int NH = 16, HD = 64, RK = 256, IH = 8, IDIM = 64, TOPK = 256;
constexpr int KVH = 2, GQ = 8, WIN = 128, NBUCK = 32, DFF = 2816;
constexpr int A_IN = 1864, B_IN = 1280;
constexpr float EPS = 1e-6f;
constexpr float NEGF = -1e30f;
constexpr int NWAVES = 8, NTHR = 512;

constexpr size_t MiB = 1u << 20;
constexpr size_t WS_CTL = 0, CTL_ZERO_BYTES = 4 * MiB;
constexpr size_t WS_SS = 1 * MiB;
constexpr size_t WS_W = 4 * MiB;
constexpr size_t W_LAYER = 17301504;
constexpr size_t W13_OFF = 0, W2_OFF = 11 * MiB;
constexpr size_t WS_WA = WS_W + 4 * W_LAYER;
constexpr size_t WA_STRIDE = 10 * MiB, WINA_OFF = 0, WQA_OFF = 4 * MiB, WUV_OFF = 6 * MiB, WOUTA_OFF = 8 * MiB;
constexpr size_t WS_WB = WS_WA + 2 * WA_STRIDE;
constexpr size_t WB_STRIDE = 4718592, WINB_OFF = 0, WOUTB_OFF = 2621440;
constexpr size_t WS_MOD = 100 * MiB;
constexpr size_t WS_SHW = WS_MOD + 1536 * 1024;
constexpr size_t SHW_A = 0, SHW_B = 2 * 16 * 2048 * 4, SHW_F = SHW_B + 2 * 16 * 1280 * 4;
constexpr size_t WS_XG = 104 * MiB;
constexpr size_t WS_BIG = 104 * MiB;
constexpr size_t WS_HFF = 168 * MiB;
constexpr size_t WS_QO = 360 * MiB;
constexpr size_t WS_CKV = 424 * MiB;
constexpr size_t WS_QI = 440 * MiB;
constexpr size_t WS_KIN = 472 * MiB;
constexpr size_t WS_WI = 476 * MiB;
constexpr size_t WS_SEL = 477 * MiB;
constexpr size_t WS_CKV8 = 486 * MiB;
constexpr size_t WS_QKV = 360 * MiB;
constexpr size_t WS_OB = 440 * MiB;
constexpr size_t WS_END = 512 * MiB;

constexpr int RING_BYTES = 131072;
constexpr int LDS_MISC_OFF = 155648;
constexpr int LDS_BYTES = 156672;

#define RLX_AGENT __ATOMIC_RELAXED, __HIP_MEMORY_SCOPE_AGENT
__device__ __forceinline__ unsigned cvt_pk_bf16(float lo, float hi) { unsigned r; asm volatile("v_cvt_pk_bf16_f32 %0, %1, %2" : "=v"(r) : "v"(lo), "v"(hi)); return r; }
__device__ __forceinline__ float bf2f(bf16_t b) { return __uint_as_float(((unsigned)b) << 16); }
__device__ __forceinline__ float wave_sum(float v) {
#pragma unroll
    for (int o = 1; o < 64; o <<= 1) v += __shfl_xor(v, o);
    return v;
}
__device__ __forceinline__ float fast_exp(float x) { return __builtin_amdgcn_exp2f(x * 1.4426950408889634f); }
__device__ __forceinline__ float silu_f(float x) { return x * __builtin_amdgcn_rcpf(1.0f + fast_exp(-x)); }
__device__ __forceinline__ int t5_bucket(int d) {
    if (d < 16) return d;
    int b = 16;
    b += (d >= 19); b += (d >= 21); b += (d >= 24); b += (d >= 27); b += (d >= 31); b += (d >= 35); b += (d >= 40); b += (d >= 46);
    b += (d >= 52); b += (d >= 59); b += (d >= 67); b += (d >= 77); b += (d >= 87); b += (d >= 99); b += (d >= 113);
    return b;
}

#define XB_TMO      128
#define XB_XCNT(j)  (256  + 64 * (j))
#define XB_XSUB(j)  (1280 + 64 * (j))
#define XB_XGEN(j)  (2304 + 64 * (j))
#define XB_TOP      3328
#define XB_TOPGEN   3392
#define XCD_BAR_WORDS 3456
#define XB_SPIN_CAP (1u << 22)

__device__ __forceinline__ unsigned xb_ld(unsigned* p)              { return __hip_atomic_load(p, __ATOMIC_RELAXED, __HIP_MEMORY_SCOPE_AGENT); }
__device__ __forceinline__ unsigned xb_add(unsigned* p, unsigned v) { return __hip_atomic_fetch_add(p, v, __ATOMIC_RELAXED, __HIP_MEMORY_SCOPE_AGENT); }
__device__ __forceinline__ unsigned xb_xcc_id() { return (unsigned)__builtin_amdgcn_s_getreg((3 << 11) | 20) & 0xFu; }
#define XB_SPIN(cond, bar) do { unsigned _sp = 0; while (cond) { __builtin_amdgcn_s_sleep(1); \
    if ((++_sp & 255u) == 0u) { if (xb_ld(&(bar)[XB_TMO])) break; if (_sp > XB_SPIN_CAP) { atomicAdd(&(bar)[XB_TMO], 1u); break; } } } } while (0)

struct XcdBarrier { unsigned* bar; unsigned x; volatile LAS unsigned* st; };

__device__ __forceinline__ XcdBarrier xcd_barrier_post(unsigned* bar, volatile LAS unsigned* st) {
    XcdBarrier b; b.bar = bar; b.x = xb_xcc_id(); b.st = st;
    if (threadIdx.x == 0) (void)xb_add(&bar[XB_XCNT(b.x)], 1u);
    return b;
}
__device__ __forceinline__ void xcd_barrier_complete(unsigned* bar, unsigned x, unsigned& nloc, unsigned& nx) {
    const unsigned G = gridDim.x * gridDim.y * gridDim.z;
    unsigned sum, cnt, mine, sp = 0u;
    for (;;) {
        sum = 0u; cnt = 0u; mine = 0u;
#pragma unroll
        for (unsigned j = 0; j < 16; ++j) { const unsigned c = xb_ld(&bar[XB_XCNT(j)]); sum += c; cnt += (c > 0u) ? 1u : 0u; mine = (j == x) ? c : mine; }
        if (sum == G) break;
        __builtin_amdgcn_s_sleep(1);
        if ((++sp & 255u) == 0u) { if (xb_ld(&bar[XB_TMO])) break; if (sp > XB_SPIN_CAP) { atomicAdd(&bar[XB_TMO], 1u); break; } }
    }
    nloc = mine > 0u ? mine : 1u; nx = cnt > 0u ? cnt : 1u;
}
__device__ __forceinline__ void xcd_barrier(const XcdBarrier& b) {
    asm volatile("s_waitcnt vmcnt(0)" ::: "memory");
    __syncthreads();
    if (threadIdx.x == 0) {
        unsigned* bar = b.bar;
        __builtin_amdgcn_s_waitcnt(0);
        unsigned nloc = b.st[0], nx = b.st[1];
        if (nloc == 0u) { xcd_barrier_complete(bar, b.x, nloc, nx); b.st[0] = nloc; b.st[1] = nx; }
        const unsigned old = xb_add(&bar[XB_XSUB(b.x)], 1u);
        const unsigned gen = old / nloc;
        if (old + 1u == (gen + 1u) * nloc) {
            __builtin_amdgcn_fence(__ATOMIC_RELEASE, "agent");
            asm volatile("s_waitcnt vmcnt(0)" ::: "memory");
            const unsigned og = xb_add(&bar[XB_TOP], 1u);
            const unsigned tg = og / nx;
            if (og + 1u == (tg + 1u) * nx) xb_add(&bar[XB_TOPGEN], 1u);
            else XB_SPIN(xb_ld(&bar[XB_TOPGEN]) == tg, bar);
            __builtin_amdgcn_fence(__ATOMIC_ACQUIRE, "agent");
            xb_add(&bar[XB_XGEN(b.x)], 1u);
            asm volatile("s_waitcnt vmcnt(0)" ::: "memory");
        } else {
            XB_SPIN(xb_ld(&bar[XB_XGEN(b.x)]) == gen, bar);
            __builtin_amdgcn_fence(__ATOMIC_ACQUIRE, "agent");
            asm volatile("s_waitcnt vmcnt(0)" ::: "memory");
        }
    }
    __syncthreads();
}

namespace pg8 {
constexpr int BM = 256, BK = 64, HALF = 128, HTB = HALF * BK * 2, STAGE_BYTES = 8 * HTB, NXCD = 8, WGM = 8;
__host__ __device__ __forceinline__ int lds_byte(int r, int c) { const int st = (r >> 4) * 2 + (c >> 5), rr = r & 15, cc = c & 31, ob = rr * 64 + cc * 2; return st * 1024 + (ob ^ (((ob >> 9) & 1) << 5)); }
__host__ __device__ __forceinline__ void stage_rc(int b, int& R, int& C) { const int st = b / 1024, sb = b % 1024, swz = sb ^ (((sb >> 9) & 1) << 5); R = (st >> 1) * 16 + swz / 64; C = (st & 1) * 32 + (swz % 64) / 2; }
__host__ __device__ __forceinline__ int perm32(int rho) { const int n = rho >> 4, i = rho & 15; return 8 * (i >> 2) + 4 * n + (i & 3); }

struct Unit { int pm, pn; };
struct Gemm { const bf16_t* A; const bf16_t* Bt; int lda, ldb, K, a_shift, a_mul; };

struct StaticOrder {
    int nM, nN, nwg, G, c;
    __device__ void init(int M_, int N_, int G_, int c_) { nM = M_ / BM; nN = N_ / BM; nwg = nM * nN; G = G_; c = c_; }
    __device__ bool next(int i, Unit& u) const {
        const long L = (long)i * G + c; if (L >= nwg) return false;
        int wgid = (int)L; { const int q = nwg / NXCD, r = nwg % NXCD, xcd = wgid % NXCD, off = wgid / NXCD; wgid = (xcd < r ? xcd * (q + 1) : r * (q + 1) + (xcd - r) * q) + off; }
        const int nig = WGM * nN, gid = wgid / nig, fm = gid * WGM, gsz = (nM - fm) < WGM ? (nM - fm) : WGM;
        u.pm = fm + ((wgid % nig) % gsz); u.pn = (wgid % nig) / gsz; return true;
    }
};

template <class Epi, bool ALIGN_EPI>
__device__ __forceinline__ void gemm_phase(LAS unsigned char* lds, const Gemm g, const StaticOrder& S, const Epi& E) {
    int tid = threadIdx.x; asm volatile("" : "+v"(tid));
    const int wid = __builtin_amdgcn_readfirstlane(tid >> 6), lane = tid & 63, wr = wid >> 2, wc = wid & 3, fr = lane & 15, fq = lane >> 4;
    const int K = g.K, nt = K / BK;
    unsigned voffA[2], voffB[2];
#pragma unroll
    for (int i = 0; i < 2; ++i) { int R, C; stage_rc(tid * 16 + i * 8192, R, C); const int Rb = Epi::PERM ? ((R & ~31) + perm32(R & 31)) : R;
        voffA[i] = (unsigned)(R * g.lda + C) * 2u; voffB[i] = (unsigned)(Rb * g.ldb + C) * 2u; }
    const size_t kstep = (size_t)(BK * 2);
    const size_t hstepA = (size_t)HALF * g.lda * 2, hstepB = (size_t)HALF * g.ldb * 2;
    const unsigned ldsw = (unsigned)wid * 1024u;
    const int aoff = lds_byte(wr * 64 + fr, fq * 8), boff = lds_byte(wc * 32 + fr, fq * 8);
#define PG8_SA(b, h) (((b) * 2 + (h)) * HTB)
#define PG8_SB(b, h) ((4 + (b) * 2 + (h)) * HTB)
#define PG8_STAGE(bufoff, gbase, voff) do { _Pragma("unroll") for (int _i = 0; _i < 2; ++_i) \
        __builtin_amdgcn_global_load_lds((const unsigned*)((const char*)(gbase) + (voff)[_i]), (LAS unsigned*)(lds + (bufoff) + ldsw + _i * 8192), 16, 0, 0); } while (0)
#define PG8_LDA(dst, b, h) do { _Pragma("unroll") for (int m = 0; m < 4; ++m) _Pragma("unroll") for (int k = 0; k < 2; ++k) dst[m][k] = *(const LAS bf16x8*)(lds + PG8_SA(b, h) + aoff + m * 2048 + k * 1024); } while (0)
#define PG8_LDB(dst, b, h) do { _Pragma("unroll") for (int n = 0; n < 2; ++n) _Pragma("unroll") for (int k = 0; k < 2; ++k) dst[n][k] = *(const LAS bf16x8*)(lds + PG8_SB(b, h) + boff + n * 2048 + k * 1024); } while (0)
#define PG8_MMA(ai, bj, At, Bt) do { __builtin_amdgcn_s_setprio(1); _Pragma("unroll") for (int m = 0; m < 4; ++m) _Pragma("unroll") for (int n = 0; n < 2; ++n) _Pragma("unroll") for (int k = 0; k < 2; ++k) \
        acc[ai][bj][m][n] = __builtin_amdgcn_mfma_f32_16x16x32_bf16(Bt[n][k], At[m][k], acc[ai][bj][m][n], 0, 0, 0); __builtin_amdgcn_s_setprio(0); } while (0)
#define PG8_WAIT_V(n) asm volatile("s_waitcnt vmcnt(" #n ")" ::: "memory")
#define PG8_WAIT_L(n) asm volatile("s_waitcnt lgkmcnt(" #n ")" ::: "memory")
#define PG8_BAR __builtin_amdgcn_s_barrier()
#define PG8_SCHED __builtin_amdgcn_sched_barrier(0)
#define PG8_ABASE(u) ((const char*)g.A + ((size_t)(u).pm * BM * g.lda + (size_t)((u).pn >> g.a_shift) * g.a_mul) * 2)
#define PG8_BBASE(u) ((const char*)g.Bt + (size_t)(u).pn * BM * g.ldb * 2)
    Unit cur, nxt; int ui = 0;
    if (!S.next(0, cur)) return;
    f32x4 acc[2][2][4][2];
#pragma unroll
    for (int a = 0; a < 2; ++a)
#pragma unroll
        for (int b = 0; b < 2; ++b)
#pragma unroll
            for (int m = 0; m < 4; ++m)
#pragma unroll
                for (int n = 0; n < 2; ++n) acc[a][b][m][n] = (f32x4){0.f, 0.f, 0.f, 0.f};
    bf16x8 At[4][2], B0[2][2], B1[2][2];
    const char* cA = PG8_ABASE(cur); const char* cB = PG8_BBASE(cur);
    PG8_STAGE(PG8_SB(0, 0), cB, voffB); PG8_STAGE(PG8_SB(0, 1), cB + hstepB, voffB); PG8_STAGE(PG8_SA(0, 0), cA, voffA); PG8_STAGE(PG8_SA(0, 1), cA + hstepA, voffA);
    if (wr == 1) PG8_BAR;
    PG8_WAIT_V(2); PG8_BAR;
    PG8_STAGE(PG8_SB(1, 0), cB + kstep, voffB); PG8_STAGE(PG8_SA(1, 0), cA + kstep, voffA); PG8_STAGE(PG8_SB(1, 1), cB + hstepB + kstep, voffB);
    PG8_WAIT_V(6); PG8_BAR;
    for (;;) {
        const bool has_next = S.next(ui + 1, nxt);
        const char* nA = has_next ? PG8_ABASE(nxt) : cA; const char* nB = has_next ? PG8_BBASE(nxt) : cB;
        for (int t = 0; t < nt; t += 2) {
            const bool last = (t == nt - 2);
            const char* a1 = cA + (size_t)(t + 1) * kstep;
            const char* a2 = last ? nA : cA + (size_t)(t + 2) * kstep; const char* b2 = last ? nB : cB + (size_t)(t + 2) * kstep;
            const char* a3 = a2 + kstep; const char* b3 = b2 + kstep;
            PG8_LDB(B0, 0, 0); PG8_LDB(B1, 0, 1); PG8_SCHED; PG8_LDA(At, 0, 0); PG8_STAGE(PG8_SA(1, 1), a1 + hstepA, voffA);
            PG8_WAIT_V(8); PG8_WAIT_L(0); PG8_BAR; PG8_MMA(0, 0, At, B0); PG8_MMA(0, 1, At, B1); PG8_BAR; PG8_SCHED;
            PG8_LDA(At, 0, 1); PG8_STAGE(PG8_SB(0, 0), b2, voffB); PG8_STAGE(PG8_SB(0, 1), b2 + hstepB, voffB); PG8_STAGE(PG8_SA(0, 0), a2, voffA);
            PG8_WAIT_V(8); PG8_WAIT_L(0); PG8_BAR; PG8_MMA(1, 0, At, B0); PG8_MMA(1, 1, At, B1); PG8_BAR; PG8_SCHED;
            PG8_LDB(B0, 1, 0); PG8_LDB(B1, 1, 1); PG8_SCHED; PG8_LDA(At, 1, 0); PG8_STAGE(PG8_SA(0, 1), a2 + hstepA, voffA);
            PG8_WAIT_V(8); PG8_WAIT_L(0); PG8_BAR; PG8_MMA(0, 0, At, B0); PG8_MMA(0, 1, At, B1); PG8_BAR; PG8_SCHED;
            PG8_LDA(At, 1, 1); PG8_STAGE(PG8_SB(1, 0), b3, voffB); PG8_STAGE(PG8_SB(1, 1), b3 + hstepB, voffB); PG8_STAGE(PG8_SA(1, 0), a3, voffA);
            PG8_WAIT_V(8); PG8_WAIT_L(0); PG8_BAR; PG8_MMA(1, 0, At, B0); PG8_MMA(1, 1, At, B1); PG8_BAR; PG8_SCHED;
        }
        if constexpr (ALIGN_EPI) { if (wr == 0) PG8_BAR; }
        { int t2 = threadIdx.x; asm volatile("" : "+v"(t2)); const int l2 = t2 & 63;
          E(acc, cur, wr, wc, l2 & 15, l2 >> 4); }
        if (!has_next) break;
#pragma unroll
        for (int a = 0; a < 2; ++a)
#pragma unroll
            for (int b = 0; b < 2; ++b)
#pragma unroll
                for (int m = 0; m < 4; ++m)
#pragma unroll
                    for (int n = 0; n < 2; ++n) acc[a][b][m][n] = (f32x4){0.f, 0.f, 0.f, 0.f};
        cur = nxt; cA = nA; cB = nB; ++ui;
        if constexpr (ALIGN_EPI) { if (wr == 1) PG8_BAR; }
    }
    PG8_WAIT_V(0);
    if constexpr (!ALIGN_EPI) { if (wr == 0) PG8_BAR; }
    PG8_BAR;
#undef PG8_SA
#undef PG8_SB
#undef PG8_STAGE
#undef PG8_LDA
#undef PG8_LDB
#undef PG8_MMA
#undef PG8_WAIT_V
#undef PG8_WAIT_L
#undef PG8_BAR
#undef PG8_SCHED
#undef PG8_ABASE
#undef PG8_BBASE
}

template <bool NORM> struct EpiBf16Plain {
    static constexpr bool PERM = true;
    bf16_t* O; int ldc; const float* shw; int shw_stride; const unsigned long long* SS;
    __device__ __forceinline__ void operator()(const f32x4 (&acc)[2][2][4][2], const Unit& u, int wr, int wc, int fr, int fq) const {
        const int row0 = u.pm * BM + wr * 64 + fr, col0 = u.pn * BM + wc * 32 + 8 * fq;
        f32x4 bv[2][2];
#pragma unroll
        for (int bj = 0; bj < 2; ++bj)
#pragma unroll
            for (int n = 0; n < 2; ++n) bv[bj][n] = NORM ? *(const f32x4*)(shw + (size_t)(u.pm >> 3) * shw_stride + col0 + bj * HALF + 4 * n) : (f32x4){0.f, 0.f, 0.f, 0.f};
#pragma unroll
        for (int ai = 0; ai < 2; ++ai)
#pragma unroll
            for (int m = 0; m < 4; ++m) { const int row = row0 + ai * HALF + m * 16; bf16_t* rowp = O + (size_t)row * ldc + col0;
                float rs = 1.0f; if (NORM) rs = 1.0f / sqrtf((float)SS[row] * (1.0f / (16777216.0f * D)) + EPS);
#pragma unroll
                for (int bj = 0; bj < 2; ++bj) { const f32x4 v0 = acc[ai][bj][m][0] * rs + bv[bj][0], v1 = acc[ai][bj][m][1] * rs + bv[bj][1];
                    u32x4 w; w.x = cvt_pk_bf16(v0[0], v0[1]); w.y = cvt_pk_bf16(v0[2], v0[3]); w.z = cvt_pk_bf16(v1[0], v1[1]); w.w = cvt_pk_bf16(v1[2], v1[3]);
                    *(u32x4*)(rowp + bj * HALF) = w; } }
    }
};
struct EpiFp8 {
    static constexpr bool PERM = true;
    unsigned char* O; int ldc;
    __device__ __forceinline__ void operator()(const f32x4 (&acc)[2][2][4][2], const Unit& u, int wr, int wc, int fr, int fq) const {
        const int row0 = u.pm * BM + wr * 64 + fr, col0 = u.pn * BM + wc * 32 + 8 * fq;
#pragma unroll
        for (int ai = 0; ai < 2; ++ai)
#pragma unroll
            for (int m = 0; m < 4; ++m) { unsigned char* rowp = O + (size_t)(row0 + ai * HALF + m * 16) * ldc + col0;
#pragma unroll
                for (int bj = 0; bj < 2; ++bj) { const f32x4 v0 = acc[ai][bj][m][0], v1 = acc[ai][bj][m][1];
                    int w0 = 0, w1 = 0;
                    w0 = __builtin_amdgcn_cvt_pk_fp8_f32(v0[0], v0[1], w0, false); w0 = __builtin_amdgcn_cvt_pk_fp8_f32(v0[2], v0[3], w0, true);
                    w1 = __builtin_amdgcn_cvt_pk_fp8_f32(v1[0], v1[1], w1, false); w1 = __builtin_amdgcn_cvt_pk_fp8_f32(v1[2], v1[3], w1, true);
                    u32x2 w; w.x = (unsigned)w0; w.y = (unsigned)w1; *(u32x2*)(rowp + bj * HALF) = w; }
                asm volatile("" ::: "memory"); }
    }
};
struct EpiInA {
    static constexpr bool PERM = true;
    bf16_t* Q; bf16_t* CKV; bf16_t* QI; bf16_t* KIN; float* WI; const float* kg; const float* kb; const float* shw; const unsigned long long* SS;
    __device__ __forceinline__ void operator()(f32x4 (&acc)[2][2][4][2], const Unit& u, int wr, int wc, int fr, int fq) const {
        const int row0 = u.pm * BM + wr * 64 + fr, cl = wc * 32 + 8 * fq;
        {
            const float* sp = shw + (size_t)(u.pm >> 3) * 2048 + u.pn * BM + cl;
            f32x4 bv[2][2];
#pragma unroll
            for (int bj = 0; bj < 2; ++bj)
#pragma unroll
                for (int n = 0; n < 2; ++n) bv[bj][n] = *(const f32x4*)(sp + bj * HALF + 4 * n);
#pragma unroll
            for (int ai = 0; ai < 2; ++ai)
#pragma unroll
                for (int m = 0; m < 4; ++m) { const float rs = 1.0f / sqrtf((float)SS[row0 + ai * HALF + m * 16] * (1.0f / (16777216.0f * D)) + EPS);
#pragma unroll
                    for (int bj = 0; bj < 2; ++bj)
#pragma unroll
                        for (int n = 0; n < 2; ++n) acc[ai][bj][m][n] = acc[ai][bj][m][n] * rs + bv[bj][n]; }
        }
        if (u.pn < 7) {
            bf16_t* base; int ldc, c0;
            if (u.pn < 4) { base = Q; ldc = 1024; c0 = u.pn * 256; } else if (u.pn == 4) { base = CKV; ldc = 256; c0 = 0; } else { base = QI; ldc = 512; c0 = (u.pn - 5) * 256; }
#pragma unroll
            for (int ai = 0; ai < 2; ++ai)
#pragma unroll
                for (int m = 0; m < 4; ++m) { bf16_t* rowp = base + (size_t)(row0 + ai * HALF + m * 16) * ldc + c0 + cl;
#pragma unroll
                    for (int bj = 0; bj < 2; ++bj) { const f32x4 v0 = acc[ai][bj][m][0], v1 = acc[ai][bj][m][1];
                        u32x4 w; w.x = cvt_pk_bf16(v0[0], v0[1]); w.y = cvt_pk_bf16(v0[2], v0[3]); w.z = cvt_pk_bf16(v1[0], v1[1]); w.w = cvt_pk_bf16(v1[2], v1[3]);
                        *(u32x4*)(rowp + bj * HALF) = w; } }
        } else if (wc == 0) {
            f32x4 gv[2][2], bv[2][2];
#pragma unroll
            for (int bj = 0; bj < 2; ++bj)
#pragma unroll
                for (int n = 0; n < 2; ++n) { gv[bj][n] = *(const f32x4*)(kg + 32 * bj + 8 * fq + 4 * n); bv[bj][n] = *(const f32x4*)(kb + 32 * bj + 8 * fq + 4 * n); }
#pragma unroll
            for (int ai = 0; ai < 2; ++ai)
#pragma unroll
                for (int m = 0; m < 4; ++m) {
                    float s = 0.f;
#pragma unroll
                    for (int bj = 0; bj < 2; ++bj)
#pragma unroll
                        for (int n = 0; n < 2; ++n) { const f32x4 x = acc[ai][bj][m][n]; s += (x[0] + x[1]) + (x[2] + x[3]); }
                    s += __shfl_xor(s, 16); s += __shfl_xor(s, 32);
                    const float mu = s * (1.0f / 64.0f); float q = 0.f;
#pragma unroll
                    for (int bj = 0; bj < 2; ++bj)
#pragma unroll
                        for (int n = 0; n < 2; ++n) { const f32x4 d = acc[ai][bj][m][n] - mu; q += (d[0] * d[0] + d[1] * d[1]) + (d[2] * d[2] + d[3] * d[3]); }
                    q += __shfl_xor(q, 16); q += __shfl_xor(q, 32);
                    const float rs = 1.0f / sqrtf(q * (1.0f / 64.0f) + EPS);
                    bf16_t* rowp = KIN + (size_t)(row0 + ai * HALF + m * 16) * 64 + 8 * fq;
#pragma unroll
                    for (int bj = 0; bj < 2; ++bj) { const f32x4 v0 = (acc[ai][bj][m][0] - mu) * rs * gv[bj][0] + bv[bj][0], v1 = (acc[ai][bj][m][1] - mu) * rs * gv[bj][1] + bv[bj][1];
                        u32x4 w; w.x = cvt_pk_bf16(v0[0], v0[1]); w.y = cvt_pk_bf16(v0[2], v0[3]); w.z = cvt_pk_bf16(v1[0], v1[1]); w.w = cvt_pk_bf16(v1[2], v1[3]);
                        *(u32x4*)(rowp + bj * 32) = w; }
                }
        } else if (wc == 1 && fq == 0) {
            const float sc = 0.04419417382415922f;
#pragma unroll
            for (int ai = 0; ai < 2; ++ai)
#pragma unroll
                for (int m = 0; m < 4; ++m) { float* rowp = WI + (size_t)(row0 + ai * HALF + m * 16) * 8;
                    *(f32x4*)(rowp) = acc[ai][0][m][0] * sc; *(f32x4*)(rowp + 4) = acc[ai][0][m][1] * sc; }
        }
    }
};
struct EpiResid {
    static constexpr bool PERM = true;
    const bf16_t* xin_b; bf16_t* xout_b;
    const float* gate; const float* bias;
    bf16_t* XG; const float* gn; const float* scn; unsigned long long* SSo;
    __device__ __forceinline__ void operator()(const f32x4 (&acc)[2][2][4][2], const Unit& u, int wr, int wc, int fr, int fq) const {
        const int row0 = u.pm * BM + wr * 64 + fr, col0 = u.pn * BM + wc * 32 + 8 * fq, b = u.pm >> 3;
        float ssum[2][4];
#pragma unroll
        for (int ai = 0; ai < 2; ++ai)
#pragma unroll
            for (int m = 0; m < 4; ++m) ssum[ai][m] = 0.f;
#pragma unroll
        for (int bj = 0; bj < 2; ++bj) {
            const int c = col0 + bj * HALF;
            const f32x4 gv0 = *(const f32x4*)(gate + (size_t)b * 6144 + c), gv1 = *(const f32x4*)(gate + (size_t)b * 6144 + c + 4);
            f32x4 bv0 = (f32x4){0.f, 0.f, 0.f, 0.f}, bv1 = bv0, gm0 = bv0, gm1 = bv0;
            if (bias) { bv0 = *(const f32x4*)(bias + c); bv1 = *(const f32x4*)(bias + c + 4); }
            if (XG) { gm0 = *(const f32x4*)(gn + c) * (*(const f32x4*)(scn + (size_t)b * 6144 + c) + 1.0f); gm1 = *(const f32x4*)(gn + c + 4) * (*(const f32x4*)(scn + (size_t)b * 6144 + c + 4) + 1.0f); }
#pragma unroll
            for (int ai = 0; ai < 2; ++ai)
#pragma unroll
                for (int m = 0; m < 4; ++m) { const size_t off = (size_t)(row0 + ai * HALF + m * 16) * D + c;
                    const u32x4 xv = *(const u32x4*)(xin_b + off);
                    const f32x4 xi0 = (f32x4){__uint_as_float(xv.x << 16), __uint_as_float(xv.x & 0xffff0000u), __uint_as_float(xv.y << 16), __uint_as_float(xv.y & 0xffff0000u)};
                    const f32x4 xi1 = (f32x4){__uint_as_float(xv.z << 16), __uint_as_float(xv.z & 0xffff0000u), __uint_as_float(xv.w << 16), __uint_as_float(xv.w & 0xffff0000u)};
                    const f32x4 xo0 = xi0 + gv0 * (acc[ai][bj][m][0] + bv0), xo1 = xi1 + gv1 * (acc[ai][bj][m][1] + bv1);
                    { u32x4 w; w.x = cvt_pk_bf16(xo0[0], xo0[1]); w.y = cvt_pk_bf16(xo0[2], xo0[3]); w.z = cvt_pk_bf16(xo1[0], xo1[1]); w.w = cvt_pk_bf16(xo1[2], xo1[3]); *(u32x4*)(xout_b + off) = w; }
                    if (XG) {
                        ssum[ai][m] += ((xo0[0] * xo0[0] + xo0[1] * xo0[1]) + (xo0[2] * xo0[2] + xo0[3] * xo0[3])) + ((xo1[0] * xo1[0] + xo1[1] * xo1[1]) + (xo1[2] * xo1[2] + xo1[3] * xo1[3]));
                        const f32x4 y0 = xo0 * gm0, y1 = xo1 * gm1;
                        u32x4 w; w.x = cvt_pk_bf16(y0[0], y0[1]); w.y = cvt_pk_bf16(y0[2], y0[3]); w.z = cvt_pk_bf16(y1[0], y1[1]); w.w = cvt_pk_bf16(y1[2], y1[3]);
                        *(u32x4*)(XG + off) = w; }
                    if (m & 1) asm volatile("" ::: "memory"); }
        }
        if (XG) {
#pragma unroll
            for (int ai = 0; ai < 2; ++ai)
#pragma unroll
                for (int m = 0; m < 4; ++m) { float q = ssum[ai][m]; q += __shfl_xor(q, 16); q += __shfl_xor(q, 32);
                    if (fq == 0) atomicAdd(SSo + row0 + ai * HALF + m * 16, (unsigned long long)(q * 16777216.0f)); }
        }
    }
};
struct EpiSwiGLU {
    static constexpr bool PERM = true;
    bf16_t* H; const float* shw; const unsigned long long* SS;
    __device__ __forceinline__ void operator()(const f32x4 (&acc)[2][2][4][2], const Unit& u, int wr, int wc, int fr, int fq) const {
        const int row0 = u.pm * BM + wr * 64 + fr, f0 = u.pn * 128 + wc * 32 + 8 * fq;
        f32x4 bv[2][2];
        { const float* sp = shw + (size_t)(u.pm >> 3) * (2 * DFF) + u.pn * BM + wc * 32 + 8 * fq;
#pragma unroll
          for (int bj = 0; bj < 2; ++bj)
#pragma unroll
              for (int n = 0; n < 2; ++n) bv[bj][n] = *(const f32x4*)(sp + bj * HALF + 4 * n); }
#pragma unroll
        for (int ai = 0; ai < 2; ++ai)
#pragma unroll
            for (int m = 0; m < 4; ++m) { bf16_t* rowp = H + (size_t)(row0 + ai * HALF + m * 16) * DFF + f0;
                const float rs = 1.0f / sqrtf((float)SS[row0 + ai * HALF + m * 16] * (1.0f / (16777216.0f * D)) + EPS);
                float o[8];
#pragma unroll
                for (int n = 0; n < 2; ++n)
#pragma unroll
                    for (int e = 0; e < 4; ++e) o[4 * n + e] = silu_f(acc[ai][0][m][n][e] * rs + bv[0][n][e]) * (acc[ai][1][m][n][e] * rs + bv[1][n][e]);
                u32x4 w; w.x = cvt_pk_bf16(o[0], o[1]); w.y = cvt_pk_bf16(o[2], o[3]); w.z = cvt_pk_bf16(o[4], o[5]); w.w = cvt_pk_bf16(o[6], o[7]);
                *(u32x4*)(rowp) = w; }
    }
};
}

struct Ptrs {
    const float* in[23]; float* out; unsigned char* ws;
};
enum { I_X = 0, I_C, I_RELB, I_WADA, I_BADA, I_GMIX, I_GFFN, I_AWIN, I_AKVG, I_AWUK, I_AWUV, I_AIKG, I_AIKB, I_AWOUT, I_BWIN, I_BBIN, I_BSINK, I_BWOUT, I_BBOUT, I_W1, I_W3, I_W2, I_GFIN };

__device__ __forceinline__ void conv_task(const Ptrs& P, int t, int lane) {
    int kind, rb, ks, Kd; bf16_t* dst; const float* s0 = nullptr; const float* s1 = nullptr; const float* gk = nullptr; int ld = 0;
    if (t < 2112) { const int l = t / 528, r = t % 528; unsigned char* wl = P.ws + WS_W + (size_t)l * W_LAYER;
        if (r < 352) { kind = 1; rb = r >> 2; ks = r & 3; Kd = 1024; dst = (bf16_t*)(wl + W13_OFF); s0 = P.in[I_W1] + (size_t)l * D * DFF; s1 = P.in[I_W3] + (size_t)l * D * DFF; ld = DFF; }
        else { const int r2 = r - 352; kind = 0; rb = r2 / 11; ks = r2 % 11; Kd = DFF; dst = (bf16_t*)(wl + W2_OFF); s0 = P.in[I_W2] + (size_t)l * DFF * D; ld = D; }
    } else { const int t2 = t - 2112, j = t2 / 464, r = t2 % 464; unsigned char* wa = P.ws + WS_WA + (size_t)j * WA_STRIDE; unsigned char* wb = P.ws + WS_WB + (size_t)j * WB_STRIDE;
        if (r < 128) { kind = 2; rb = r >> 2; ks = r & 3; Kd = 1024; dst = (bf16_t*)(wa + WINA_OFF); s0 = P.in[I_AWIN] + (size_t)j * D * A_IN; ld = A_IN; }
        else if (r < 192) { kind = 3; rb = r - 128; ks = 0; Kd = 256; dst = (bf16_t*)(wa + WQA_OFF); s0 = P.in[I_AWUK] + (size_t)j * NH * RK * HD; gk = P.in[I_AKVG] + j * RK; }
        else if (r < 256) { const int r2 = r - 192; kind = 4; rb = r2 >> 2; ks = r2 & 3; Kd = 1024; dst = (bf16_t*)(wa + WUV_OFF); s0 = P.in[I_AWUV] + (size_t)j * NH * RK * HD; gk = P.in[I_AKVG] + j * RK; }
        else if (r < 320) { const int r2 = r - 256; kind = 0; rb = r2 >> 2; ks = r2 & 3; Kd = 1024; dst = (bf16_t*)(wa + WOUTA_OFF); s0 = P.in[I_AWOUT] + (size_t)j * D * D; ld = D; }
        else if (r < 400) { const int r2 = r - 320; kind = 0; rb = r2 >> 2; ks = r2 & 3; Kd = 1024; dst = (bf16_t*)(wb + WINB_OFF); s0 = P.in[I_BWIN] + (size_t)j * D * B_IN; ld = B_IN; }
        else { const int r2 = r - 400; kind = 0; rb = r2 >> 2; ks = r2 & 3; Kd = 1024; dst = (bf16_t*)(wb + WOUTB_OFF); s0 = P.in[I_BWOUT] + (size_t)j * D * D; ld = D; }
    }
    const int n = rb * 64 + lane, k0 = ks * 256;
    bf16_t* drow = dst + (size_t)n * Kd + k0;
    if (kind <= 2) {
        const float* src = s0; int col = n;
        if (kind == 1) { const int c = n & 255, f = (n >> 8) * 128 + (c & 127); src = (c < 128) ? s0 : s1; col = f; }
        if (kind == 2) { if (n >= 1792) { const int c = n - 1792; col = c < 32 ? 1792 + c : (c < 40 ? 1856 + (c - 32) : ((c >= 128 && c < 160) ? 1824 + (c - 128) : -1)); } }
        const float* sp = src + (size_t)k0 * ld + (col < 0 ? 0 : col);
        for (int kc = 0; kc < 32; ++kc) {
            float v[8];
#pragma unroll
            for (int e = 0; e < 8; ++e) v[e] = sp[(size_t)(kc * 8 + e) * ld];
            if (col < 0) {
#pragma unroll
                for (int e = 0; e < 8; ++e) v[e] = 0.f; }
            u32x4 w; w.x = cvt_pk_bf16(v[0], v[1]); w.y = cvt_pk_bf16(v[2], v[3]); w.z = cvt_pk_bf16(v[4], v[5]); w.w = cvt_pk_bf16(v[6], v[7]);
            *(u32x4*)(drow + kc * 8) = w;
        }
    } else if (kind == 3) {
        const int h = n >> 8, r = n & 255; const float gs = gk[r] * 8.0f;       const float* sp = s0 + ((size_t)h * RK + r) * HD;
        for (int kc = 0; kc < 32; ++kc) { const int k = kc * 8; float v[8];
            if ((k >> 6) == (h & 3)) {
#pragma unroll
                for (int e = 0; e < 8; ++e) v[e] = sp[(k & 63) + e] * gs;
            } else {
#pragma unroll
                for (int e = 0; e < 8; ++e) v[e] = 0.f; }
            u32x4 w; w.x = cvt_pk_bf16(v[0], v[1]); w.y = cvt_pk_bf16(v[2], v[3]); w.z = cvt_pk_bf16(v[4], v[5]); w.w = cvt_pk_bf16(v[6], v[7]);
            *(u32x4*)(drow + kc * 8) = w; }
    } else {
        const int hh = (n >> 6) & 3, d = n & 63, h = n >> 6;
        for (int kc = 0; kc < 32; ++kc) { const int k = k0 + kc * 8; float v[8];
            if ((k >> 8) == hh) {
#pragma unroll
                for (int e = 0; e < 8; ++e) { const int r = (k & 255) + e; v[e] = s0[((size_t)h * RK + r) * HD + d] * gk[r]; }
            } else {
#pragma unroll
                for (int e = 0; e < 8; ++e) v[e] = 0.f; }
            u32x4 w; w.x = cvt_pk_bf16(v[0], v[1]); w.y = cvt_pk_bf16(v[2], v[3]); w.z = cvt_pk_bf16(v[4], v[5]); w.w = cvt_pk_bf16(v[6], v[7]);
            *(u32x4*)(drow + kc * 8) = w; }
    }
}
constexpr int N_CONV_TASKS = 3040;

__device__ __forceinline__ void p0_prologue(const Ptrs& P, LAS unsigned char* lds, int G) {
    int tid = threadIdx.x; asm volatile("" : "+v"(tid));
    const int lane = tid & 63, wave = __builtin_amdgcn_readfirstlane(tid >> 6);
    const int gw = blockIdx.x * NWAVES + wave, NGW = G * NWAVES;
    for (int t = gw; t < N_CONV_TASKS; t += NGW) conv_task(P, t, lane);
    LAS float* cs = (LAS float*)lds;
    LAS float* red = (LAS float*)(lds + 65536);
    for (int i = tid; i < BATCH * D; i += NTHR) { const int b = i >> 10, k = i & 1023; cs[k * 16 + b] = silu_f(P.in[I_C][i]); }
    __syncthreads();
    float* mod = (float*)(P.ws + WS_MOD);
    for (int task = blockIdx.x; task < 4 * 96; task += G) {
        const int l = task / 96, j0 = (task % 96) * 64, col = tid & 63, ksl = tid >> 6;
        const float* wp = P.in[I_WADA] + ((size_t)l * D + ksl * 128) * 6144 + j0 + col;
        float a[16];
#pragma unroll
        for (int b = 0; b < 16; ++b) a[b] = 0.f;
        for (int k = 0; k < 128; ++k) { const float w = wp[(size_t)k * 6144]; const LAS f32x4* c4 = (const LAS f32x4*)(cs + (ksl * 128 + k) * 16);
#pragma unroll
            for (int q = 0; q < 4; ++q) { const f32x4 c = c4[q];
#pragma unroll
                for (int e = 0; e < 4; ++e) a[4 * q + e] += w * c[e]; } }
#pragma unroll
        for (int b = 0; b < 16; ++b) red[(ksl * 64 + col) * 16 + b] = a[b];
        __syncthreads();
        for (int o = tid; o < 1024; o += NTHR) { const int c2 = o >> 4, b = o & 15; float s = 0.f;
#pragma unroll
            for (int q = 0; q < 8; ++q) s += red[(q * 64 + c2) * 16 + b];
            mod[((size_t)l * BATCH + b) * 6144 + j0 + c2] = s + P.in[I_BADA][l * 6144 + j0 + c2]; }
        __syncthreads();
    }
}

__device__ __forceinline__ void pre_phase(const Ptrs& P, LAS unsigned char* lds, int G) {
    int tid = threadIdx.x; asm volatile("" : "+v"(tid));
    const int lane = tid & 63, wave = __builtin_amdgcn_readfirstlane(tid >> 6);
    const float* mod = (const float*)(P.ws + WS_MOD);
    {
        const int grp = blockIdx.x & 7, l = grp >> 1, kind = grp & 1, j = l >> 1;
        const float* shsrc = mod + (size_t)l * BATCH * 6144 + (kind ? 3072 : 0);
        constexpr int SP = 2064;
        for (int i = tid; i < BATCH * D / 2; i += NTHR) { const int b = i >> 9, k2 = (i & 511) * 2;
            const float a0 = shsrc[(size_t)b * 6144 + k2], a1 = shsrc[(size_t)b * 6144 + k2 + 1];
            *(LAS unsigned*)(lds + b * SP + k2 * 2) = cvt_pk_bf16(a0, a1); }
        __syncthreads();
        const bf16_t* W; int nrows; float* dst; const float* bias = nullptr;
        if (kind) { W = (const bf16_t*)(P.ws + WS_W + (size_t)l * W_LAYER + W13_OFF); nrows = 2 * DFF; dst = (float*)(P.ws + WS_SHW + SHW_F) + (size_t)l * BATCH * 2 * DFF; }
        else if ((l & 1) == 0) { W = (const bf16_t*)(P.ws + WS_WA + (size_t)j * WA_STRIDE + WINA_OFF); nrows = 2048; dst = (float*)(P.ws + WS_SHW + SHW_A) + (size_t)j * BATCH * 2048; }
        else { W = (const bf16_t*)(P.ws + WS_WB + (size_t)j * WB_STRIDE + WINB_OFF); nrows = B_IN; dst = (float*)(P.ws + WS_SHW + SHW_B) + (size_t)j * BATCH * B_IN; bias = P.in[I_BBIN] + j * B_IN; }
        const int nblk = nrows >> 4, wq = (blockIdx.x >> 3) * NWAVES + wave, nwq = (G >> 3) * NWAVES;
        const int nn = lane & 15, g = lane >> 4;
        for (int blk = wq; blk < nblk; blk += nwq) {
            f32x4 acc = (f32x4){0.f, 0.f, 0.f, 0.f};
            const bf16_t* wp = W + (size_t)(blk * 16 + nn) * D + 8 * g;
#pragma unroll 8
            for (int ks = 0; ks < 32; ++ks) { const bf16x8 a = *(const LAS bf16x8*)(lds + nn * SP + (32 * ks + 8 * g) * 2); const bf16x8 bw = *(const bf16x8*)(wp + 32 * ks);
                acc = __builtin_amdgcn_mfma_f32_16x16x32_bf16(a, bw, acc, 0, 0, 0); }
            const int n = blk * 16 + nn; const float bb = bias ? bias[n] : 0.f;
#pragma unroll
            for (int i = 0; i < 4; ++i) dst[(size_t)(4 * g + i) * nrows + n] = acc[i] + bb;
        }
    }
    {
        const int gw = blockIdx.x * NWAVES + wave, NGW = G * NWAVES;
        const float* x = P.in[I_X]; const float* gmix = P.in[I_GMIX]; bf16_t* XG = (bf16_t*)(P.ws + WS_XG); unsigned long long* SS0 = (unsigned long long*)(P.ws + WS_SS);
        for (int row = gw; row < M; row += NGW) {
            const int b = row >> 11;
            const f32x4* xr = (const f32x4*)(x + (size_t)row * D) + lane;
            f32x4 v[4]; float sq = 0.f;
#pragma unroll
            for (int jj = 0; jj < 4; ++jj) { v[jj] = xr[64 * jj]; sq += (v[jj][0] * v[jj][0] + v[jj][1] * v[jj][1]) + (v[jj][2] * v[jj][2] + v[jj][3] * v[jj][3]); }
            const float ss = wave_sum(sq);
            if (lane == 0) SS0[row] = (unsigned long long)(ss * 16777216.0f);
            const float* mb = mod + (size_t)b * 6144;
            u32x2* o8 = (u32x2*)(XG + (size_t)row * D) + lane; u32x2* x8 = (u32x2*)((bf16_t*)P.out + (size_t)row * D) + lane;
#pragma unroll
            for (int jj = 0; jj < 4; ++jj) { const int c = 4 * lane + 256 * jj;
                const f32x4 y = v[jj] * *(const f32x4*)(gmix + c) * (*(const f32x4*)(mb + 1024 + c) + 1.0f);
                u32x2 w; w.x = cvt_pk_bf16(y[0], y[1]); w.y = cvt_pk_bf16(y[2], y[3]); o8[64 * jj] = w;
                u32x2 xw; xw.x = cvt_pk_bf16(v[jj][0], v[jj][1]); xw.y = cvt_pk_bf16(v[jj][2], v[jj][3]); x8[64 * jj] = xw; }
        }
    }
}
__device__ __forceinline__ void final_norm_phase(const bf16_t* x, float* out, const float* g, int G) {
    int tid = threadIdx.x; asm volatile("" : "+v"(tid));
    const int lane = tid & 63, wave = __builtin_amdgcn_readfirstlane(tid >> 6);
    const int gw = blockIdx.x * NWAVES + wave, NGW = G * NWAVES;
    for (int row = gw; row < M; row += NGW) {
        const u32x2* xr = (const u32x2*)(x + (size_t)row * D) + lane; f32x4* orow = (f32x4*)(out + (size_t)row * D) + lane;
        f32x4 v[4]; float s = 0.f;
#pragma unroll
        for (int j = 0; j < 4; ++j) { const u32x2 p = xr[64 * j];
            v[j] = (f32x4){__uint_as_float(p.x << 16), __uint_as_float(p.x & 0xffff0000u), __uint_as_float(p.y << 16), __uint_as_float(p.y & 0xffff0000u)};
            s += (v[j][0] * v[j][0] + v[j][1] * v[j][1]) + (v[j][2] * v[j][2] + v[j][3] * v[j][3]); }
        const float rstd = 1.0f / sqrtf(wave_sum(s) * (1.0f / D) + EPS);
#pragma unroll
        for (int j = 0; j < 4; ++j) { const f32x4 gg = *(const f32x4*)(g + 4 * lane + 256 * j); orow[64 * j] = v[j] * rstd * gg; }
    }
}

__device__ __forceinline__ unsigned f2key(float f) { const unsigned u = __float_as_uint(f); return (u & 0x80000000u) ? ~u : (u | 0x80000000u); }
__device__ __forceinline__ float key2f(unsigned k) { return __uint_as_float((k & 0x80000000u) ? (k & 0x7fffffffu) : ~k); }
__device__ __forceinline__ float half_max(float x) {
    int u = __float_as_int(x);
    u = __float_as_int(fmaxf(__int_as_float(u), __int_as_float(__builtin_amdgcn_update_dpp(u, u, 0x128, 0xf, 0xf, false))));
    u = __float_as_int(fmaxf(__int_as_float(u), __int_as_float(__builtin_amdgcn_update_dpp(u, u, 0x124, 0xf, 0xf, false))));
    u = __float_as_int(fmaxf(__int_as_float(u), __int_as_float(__builtin_amdgcn_update_dpp(u, u, 0x122, 0xf, 0xf, false))));
    u = __float_as_int(fmaxf(__int_as_float(u), __int_as_float(__builtin_amdgcn_update_dpp(u, u, 0x121, 0xf, 0xf, false))));
    const u32x2 r = __builtin_amdgcn_permlane16_swap((unsigned)u, (unsigned)u, false, false);
    return fmaxf(__uint_as_float(r.x), __uint_as_float(r.y));
}
__device__ __forceinline__ float half_sum_f(float v) {
    v += __int_as_float(__builtin_amdgcn_update_dpp(__float_as_int(v), __float_as_int(v), 0x128, 0xf, 0xf, false));
    v += __int_as_float(__builtin_amdgcn_update_dpp(__float_as_int(v), __float_as_int(v), 0x124, 0xf, 0xf, false));
    v += __int_as_float(__builtin_amdgcn_update_dpp(__float_as_int(v), __float_as_int(v), 0x122, 0xf, 0xf, false));
    v += __int_as_float(__builtin_amdgcn_update_dpp(__float_as_int(v), __float_as_int(v), 0x121, 0xf, 0xf, false));
    const u32x2 r = __builtin_amdgcn_permlane16_swap(__float_as_uint(v), __float_as_uint(v), false, false);
    return __uint_as_float(r.x) + __uint_as_float(r.y);
}
__device__ __forceinline__ f32x2 pk_gt(f32x2 x, f32x2 big, f32x2 nfbig) { f32x2 d; asm("v_pk_fma_f32 %0, %1, %2, %3 clamp" : "=v"(d) : "v"(x), "v"(big), "v"(nfbig)); return d; }
__device__ __forceinline__ int half_sum(int v) {
    v += __builtin_amdgcn_update_dpp(v, v, 0x128, 0xf, 0xf, false);
    v += __builtin_amdgcn_update_dpp(v, v, 0x124, 0xf, 0xf, false);
    v += __builtin_amdgcn_update_dpp(v, v, 0x122, 0xf, 0xf, false);
    v += __builtin_amdgcn_update_dpp(v, v, 0x121, 0xf, 0xf, false);
    const u32x2 r = __builtin_amdgcn_permlane16_swap((unsigned)v, (unsigned)v, false, false);
    return (int)(r.x + r.y);
}
typedef float f32x32 __attribute__((ext_vector_type(32)));
__device__ __forceinline__ void idx_task(const bf16_t* QI, const bf16_t* KIN, const float* WI, unsigned* SEL, LAS unsigned char* lds, int b, int tg, int lane, int wave, bool active, int nrounds) {
    asm volatile("" : "+v"(lane));
    const int t0 = tg * 4, h = lane >> 5, r = lane & 31;
    const int qsel = 2 * (r >> 4) + ((r >> 2) & 1), hd = (r & 3) + 4 * ((r >> 3) & 1);
    const size_t rowb = (size_t)b * SEQ;
    bf16x8 aq[4];
#pragma unroll
    for (int ks = 0; ks < 4; ++ks) aq[ks] = *(const bf16x8*)(QI + (rowb + t0 + qsel) * 512 + hd * 64 + ks * 16 + h * 8);
    float wlo[8], whi[8];
    { const f32x4 a0 = *(const f32x4*)(WI + (rowb + t0 + h) * 8), a1 = *(const f32x4*)(WI + (rowb + t0 + h) * 8 + 4);
      const f32x4 b0 = *(const f32x4*)(WI + (rowb + t0 + 2 + h) * 8), b1 = *(const f32x4*)(WI + (rowb + t0 + 2 + h) * 8 + 4);
#pragma unroll
      for (int e = 0; e < 4; ++e) { wlo[e] = a0[e]; wlo[4 + e] = a1[e]; whi[e] = b0[e]; whi[4 + e] = b1[e]; } }
    f32x32 sA0, sA1, sB0, sB1;
#pragma unroll
    for (int i = 0; i < 32; ++i) { sA0[i] = NEGF; sA1[i] = NEGF; sB0[i] = NEGF; sB1[i] = NEGF; }
    const int ktmax = (t0 + 3) >> 5, tlo = t0 + h, thi = t0 + 2 + h;
    const unsigned lb = (unsigned)(size_t)lds;
    const int sw = (r >> 1) & 7;
#define IDX_LDS4(R0, R1, R2, R3) asm volatile("ds_read_b128 %0, %4\n\tds_read_b128 %1, %5\n\tds_read_b128 %2, %6\n\tds_read_b128 %3, %7" \
                                             : "=&v"(R0), "=&v"(R1), "=&v"(R2), "=&v"(R3) : "v"(a0), "v"(a1), "v"(a2), "v"(a3) : "memory")
#define IDX_TILE(KTL, KEY0, SA, SB, C0, C1, C2, C3, N0, N1, N2, N3) \
        { \
            a0 += 4096u; a1 += 4096u; a2 += 4096u; a3 += 4096u; \
            IDX_LDS4(N0, N1, N2, N3);                          \
            asm volatile("s_waitcnt lgkmcnt(4)" : "+v"(C0), "+v"(C1), "+v"(C2), "+v"(C3) :: "memory");     \
            f32x16 acc; \
            _Pragma("unroll") for (int i = 0; i < 16; ++i) acc[i] = 0.f; \
            acc = __builtin_amdgcn_mfma_f32_32x32x16_bf16(aq[0], C0, acc, 0, 0, 0); acc = __builtin_amdgcn_mfma_f32_32x32x16_bf16(aq[1], C1, acc, 0, 0, 0); \
            acc = __builtin_amdgcn_mfma_f32_32x32x16_bf16(aq[2], C2, acc, 0, 0, 0); acc = __builtin_amdgcn_mfma_f32_32x32x16_bf16(aq[3], C3, acc, 0, 0, 0); \
            f32x2 p0 = (f32x2){0.f, 0.f}, p1 = (f32x2){0.f, 0.f};            \
            _Pragma("unroll") for (int i = 0; i < 4; ++i) { \
                const f32x2 r0 = (f32x2){__builtin_amdgcn_fmed3f(acc[2 * i], 0.f, 3.0e38f), __builtin_amdgcn_fmed3f(acc[2 * i + 1], 0.f, 3.0e38f)}; \
                const f32x2 r1 = (f32x2){__builtin_amdgcn_fmed3f(acc[8 + 2 * i], 0.f, 3.0e38f), __builtin_amdgcn_fmed3f(acc[9 + 2 * i], 0.f, 3.0e38f)}; \
                p0 = __builtin_elementwise_fma((f32x2){wlo[2 * i], wlo[2 * i + 1]}, r0, p0); p1 = __builtin_elementwise_fma((f32x2){whi[2 * i], whi[2 * i + 1]}, r1, p1); } \
            const float s0 = p0.x + p0.y, s1 = p1.x + p1.y; \
            const int key = (KEY0) + r; \
            SA[KTL] = key <= tlo ? s0 : NEGF; SB[KTL] = key <= thi ? s1 : NEGF; \
        }
    bf16x8 ta0, ta1, ta2, ta3, tb0, tb1, tb2, tb3;
#pragma unroll
    for (int rnd = 0; rnd < 2; ++rnd) {
        if (rnd >= nrounds) break;
        __syncthreads();
        {
            const int rl = lane >> 3, pp = lane & 7;
#pragma unroll 4
            for (int j = 0; j < 16; ++j) { const int pi = wave * 16 + j, row = 8 * pi + rl;
                const bf16_t* src = KIN + (rowb + 1024 * rnd + row) * 64 + 8 * (pp ^ ((row >> 1) & 7));
                __builtin_amdgcn_global_load_lds((const unsigned*)src, (LAS unsigned*)(lds + 1024 * pi), 16, 0, 0); }
        }
        asm volatile("s_waitcnt vmcnt(0)" ::: "memory");
        __syncthreads();
        const int ntl = ktmax - 32 * rnd + 1;
        if (active && ntl > 0) {
            const int npair = ((ntl < 32 ? ntl : 32) + 1) >> 1;
            unsigned a0 = lb + (unsigned)r * 128u + 16u * (unsigned)((0 + h) ^ sw), a1 = lb + (unsigned)r * 128u + 16u * (unsigned)((2 + h) ^ sw);
            unsigned a2 = lb + (unsigned)r * 128u + 16u * (unsigned)((4 + h) ^ sw), a3 = lb + (unsigned)r * 128u + 16u * (unsigned)((6 + h) ^ sw);
            IDX_LDS4(ta0, ta1, ta2, ta3);
#pragma nounroll
            for (int kp = 0; kp < npair; ++kp) {
                if (rnd == 0) { IDX_TILE(2 * kp, 64 * kp, sA0, sB0, ta0, ta1, ta2, ta3, tb0, tb1, tb2, tb3)
                                IDX_TILE(2 * kp + 1, 64 * kp + 32, sA0, sB0, tb0, tb1, tb2, tb3, ta0, ta1, ta2, ta3) }
                else          { IDX_TILE(2 * kp, 1024 + 64 * kp, sA1, sB1, ta0, ta1, ta2, ta3, tb0, tb1, tb2, tb3)
                                IDX_TILE(2 * kp + 1, 1024 + 64 * kp + 32, sA1, sB1, tb0, tb1, tb2, tb3, ta0, ta1, ta2, ta3) }
            }
            asm volatile("s_waitcnt lgkmcnt(0)" : "+v"(ta0), "+v"(ta1), "+v"(ta2), "+v"(ta3), "+v"(tb0), "+v"(tb1), "+v"(tb2), "+v"(tb3) :: "memory");
        }
    }
#undef IDX_TILE
#undef IDX_LDS4
    if (!active) return;
    const int nt0 = ktmax < 31 ? ktmax + 1 : 32, nt1 = ktmax - 31;
    float mxA = NEGF, mxB = NEGF, mnA = -NEGF, mnB = -NEGF;
#pragma nounroll
    for (int kt = 0; kt < nt0; ++kt) { const float a = sA0[kt], bb = sB0[kt];
        mxA = fmaxf(mxA, a); mxB = fmaxf(mxB, bb); mnA = fminf(mnA, a > -1e29f ? a : -NEGF); mnB = fminf(mnB, bb > -1e29f ? bb : -NEGF); }
#pragma nounroll
    for (int kt = 0; kt < nt1; ++kt) { const float a = sA1[kt], bb = sB1[kt];
        mxA = fmaxf(mxA, a); mxB = fmaxf(mxB, bb); mnA = fminf(mnA, a > -1e29f ? a : -NEGF); mnB = fminf(mnB, bb > -1e29f ? bb : -NEGF); }
    mxA = half_max(mxA); mxB = half_max(mxB); mnA = -half_max(-mnA); mnB = -half_max(-mnB);
    const int Ka = tlo + 1 < TOPK ? tlo + 1 : TOPK, Kb = thi + 1 < TOPK ? thi + 1 : TOPK;
    float loA = mnA - (fabsf(mnA) * 1e-6f + 1e-30f), hiA = mxA, loB = mnB - (fabsf(mnB) * 1e-6f + 1e-30f), hiB = mxB;
    float cloA = (float)(tlo + 1), chiA = 0.0f, cloB = (float)(thi + 1), chiB = 0.0f;
    float TA = -1e29f, TB = -1e29f; bool doneA = (tlo + 1 <= TOPK), doneB = (thi + 1 <= TOPK);
    const int nblk = (ktmax >> 3) + 1;
    const float BIG = 1099511627776.0f;
#define SA2(i) ((i) < 32 ? (f32x2){sA0[(i) & 31], sA0[((i) & 31) + 1]} : (f32x2){sA1[(i) & 31], sA1[((i) & 31) + 1]})
#define SB2(i) ((i) < 32 ? (f32x2){sB0[(i) & 31], sB0[((i) & 31) + 1]} : (f32x2){sB1[(i) & 31], sB1[((i) & 31) + 1]})
#pragma nounroll
    for (int it = 0; it < 48; ++it) {
        if (__ballot(!doneA || !doneB) == 0ull) break;
        const bool bis = (it % 3) == 2;
        const float wA = hiA - loA, wB = hiB - loB;
        float rA = bis ? 0.5f : (cloA - (float)Ka + 0.5f) / (cloA - chiA), rB = bis ? 0.5f : (cloB - (float)Kb + 0.5f) / (cloB - chiB);
        rA = fminf(fmaxf(rA, 0.03f), 0.97f); rB = fminf(fmaxf(rB, 0.03f), 0.97f);
        const float midA = loA + wA * rA, midB = loB + wB * rB;
        const float fA = doneA ? TA : midA, fB = doneB ? TB : midB;
        const f32x2 bigp = (f32x2){BIG, BIG}, nfA = (f32x2){-fA * BIG, -fA * BIG}, nfB = (f32x2){-fB * BIG, -fB * BIG};
        f32x2 cA2 = (f32x2){0.f, 0.f}, cB2 = (f32x2){0.f, 0.f};
#pragma unroll
        for (int blk = 0; blk < 8; ++blk) {
            if (blk < nblk) {
#pragma unroll
                for (int e = 0; e < 4; ++e) { cA2 += pk_gt(SA2(8 * blk + 2 * e), bigp, nfA); cB2 += pk_gt(SB2(8 * blk + 2 * e), bigp, nfB); }
            }
        }
        const int cA = (int)half_sum_f(cA2.x + cA2.y), cB = (int)half_sum_f(cB2.x + cB2.y);
        const bool stuckA = !(midA > loA && midA < hiA), stuckB = !(midB > loB && midB < hiB);
        if (!doneA) { if (cA == Ka) { TA = fA; doneA = true; } else if (stuckA) { TA = loA; doneA = true; } else if (cA > Ka) { loA = midA; cloA = (float)cA; } else { hiA = midA; chiA = (float)cA; } }
        if (!doneB) { if (cB == Kb) { TB = fB; doneB = true; } else if (stuckB) { TB = loB; doneB = true; } else if (cB > Kb) { loB = midB; cloB = (float)cB; } else { hiB = midB; chiB = (float)cB; } }
    }
#undef SA2
#undef SB2
    if (!doneA) TA = loA;
    if (!doneB) TB = loB;
    unsigned w0 = 0u, w1 = 0u, w2 = 0u, w3 = 0u;
#pragma nounroll
    for (int kt = 0; kt < nt0; ++kt) { const unsigned long long ma = __ballot(sA0[kt] > TA), mb = __ballot(sB0[kt] > TB);
        if (lane == kt) { w0 = (unsigned)ma; w1 = (unsigned)(ma >> 32); w2 = (unsigned)mb; w3 = (unsigned)(mb >> 32); } }
#pragma nounroll
    for (int kt = 0; kt < nt1; ++kt) { const unsigned long long ma = __ballot(sA1[kt] > TA), mb = __ballot(sB1[kt] > TB);
        if (lane == 32 + kt) { w0 = (unsigned)ma; w1 = (unsigned)(ma >> 32); w2 = (unsigned)mb; w3 = (unsigned)(mb >> 32); } }
    SEL[(rowb + t0 + 0) * 64 + lane] = w0; SEL[(rowb + t0 + 1) * 64 + lane] = w1; SEL[(rowb + t0 + 2) * 64 + lane] = w2; SEL[(rowb + t0 + 3) * 64 + lane] = w3;
}

#define ATT_F(r) (((r) & 3) | ((((r) >> 3) & 3) << 2))
#define TRB8(OFS, r0, r1, r2, r3, r4, r5, r6, r7, a0, a1, a2, a3, a4, a5, a6, a7) \
    asm volatile("ds_read_b64_tr_b16 %0, %8 offset:" OFS "\n\tds_read_b64_tr_b16 %1, %9 offset:" OFS "\n\tds_read_b64_tr_b16 %2, %10 offset:" OFS "\n\tds_read_b64_tr_b16 %3, %11 offset:" OFS "\n\t" \
                 "ds_read_b64_tr_b16 %4, %12 offset:" OFS "\n\tds_read_b64_tr_b16 %5, %13 offset:" OFS "\n\tds_read_b64_tr_b16 %6, %14 offset:" OFS "\n\tds_read_b64_tr_b16 %7, %15 offset:" OFS "\n\ts_waitcnt lgkmcnt(0)" \
                 : "=&v"(r0), "=&v"(r1), "=&v"(r2), "=&v"(r3), "=&v"(r4), "=&v"(r5), "=&v"(r6), "=&v"(r7) \
                 : "v"(a0), "v"(a1), "v"(a2), "v"(a3), "v"(a4), "v"(a5), "v"(a6), "v"(a7) : "memory")
#define RDK8(OFS, r, a) \
    asm volatile("ds_read_b64 %0, %8 offset:" OFS "\n\tds_read_b64 %1, %9 offset:" OFS "\n\tds_read_b64 %2, %10 offset:" OFS "\n\tds_read_b64 %3, %11 offset:" OFS "\n\t" \
                 "ds_read_b64 %4, %12 offset:" OFS "\n\tds_read_b64 %5, %13 offset:" OFS "\n\tds_read_b64 %6, %14 offset:" OFS "\n\tds_read_b64 %7, %15 offset:" OFS "\n\ts_waitcnt lgkmcnt(0)" \
                 : "=&v"(r[0]), "=&v"(r[1]), "=&v"(r[2]), "=&v"(r[3]), "=&v"(r[4]), "=&v"(r[5]), "=&v"(r[6]), "=&v"(r[7]) \
                 : "v"(a[0]), "v"(a[1]), "v"(a[2]), "v"(a[3]), "v"(a[4]), "v"(a[5]), "v"(a[6]), "v"(a[7]) : "memory")
__device__ __forceinline__ float rows_max(float x) {
    unsigned u = __float_as_uint(x);
    u32x2 r = __builtin_amdgcn_permlane16_swap(u, u, false, false);
    u = __float_as_uint(fmaxf(__uint_as_float(r.x), __uint_as_float(r.y)));
    r = __builtin_amdgcn_permlane32_swap(u, u, false, false);
    return fmaxf(__uint_as_float(r.x), __uint_as_float(r.y));
}
__device__ __forceinline__ float rows_sum(float x) {
    unsigned u = __float_as_uint(x);
    u32x2 r = __builtin_amdgcn_permlane16_swap(u, u, false, false);
    u = __float_as_uint(__uint_as_float(r.x) + __uint_as_float(r.y));
    r = __builtin_amdgcn_permlane32_swap(u, u, false, false);
    return __uint_as_float(r.x) + __uint_as_float(r.y);
}

__device__ __forceinline__ int att_build_list(LAS unsigned* list, const LAS unsigned* btab, unsigned w, int t, int lane) {
    const int pc = __popc(w); int incl = pc;
#pragma unroll
    for (int o = 1; o < 64; o <<= 1) { const int v = __shfl_up(incl, o); if (lane >= o) incl += v; }
    const int total = __shfl(incl, 63); const int cnt = total < TOPK ? total : TOPK;
    int off = incl - pc;
    while (w) { const int bit = __builtin_ctz(w); w &= w - 1u;
        if (off < TOPK) { const int idx = 32 * lane + bit; int dd = t - idx; dd = dd < 0 ? 0 : (dd > 128 ? 128 : dd); list[off] = (unsigned)idx | (btab[dd] << 16); }
        ++off; }
    for (int sl = cnt + lane; sl < ((cnt + 31) & ~31); sl += 64) list[sl] = 0u;
    return cnt;
}
__device__ __forceinline__ void att_gather32(const unsigned char* CKV8b, const LAS unsigned* list32, LAS unsigned char* slot, int lane) {
    const LAS unsigned* lp = list32 + (lane >> 4);
    unsigned idx[8];
#pragma unroll
    for (int i = 0; i < 8; ++i) idx[i] = lp[4 * i] & 0xffffu;
#pragma unroll
    for (int i = 0; i < 8; ++i) {
        const int rr = 4 * i + (lane >> 4);
        const unsigned char* src = CKV8b + (size_t)idx[i] * RK + 16 * ((lane & 15) ^ ATT_F(rr));
        __builtin_amdgcn_global_load_lds((const unsigned*)src, (LAS unsigned*)(slot + 1024 * i), 16, 0, 0);
    }
}

#define ATT_T(q) (((q) & 2047) ^ (((q) >> 11) ? 255 : 0))
__device__ __forceinline__ void att_wave(const unsigned char* CKV8, const unsigned* SEL, unsigned char* BIG, LAS unsigned char* kvbuf, LAS unsigned* lists, const LAS float* relb, const LAS unsigned* btab,
                                         int xcd, int wx, int nwx, int lane) {
    asm volatile("" : "+v"(lane));
    const int hq = lane & 15, g = lane >> 4;
    const int nq = (2 * SEQ - wx + nwx - 1) / nwx;
    if (nq <= 0) return;
    const unsigned kvb = (unsigned)(size_t)kvbuf;
    unsigned qa[8];
#pragma unroll
    for (int ks = 0; ks < 8; ++ks) qa[ks] = kvb + (unsigned)(8 * (hq >> 2) + (hq & 3)) * 256u + 16u * (unsigned)((2 * ks + (g >> 1)) ^ ATT_F(8 * (hq >> 2) + (hq & 3))) + 8u * (unsigned)(g & 1);
    const int trow = 8 * g + (hq >> 1);
    unsigned ta[16];
#pragma unroll
    for (int nt = 0; nt < 16; ++nt) ta[nt] = kvb + (unsigned)trow * 256u + 16u * (unsigned)(nt ^ ATT_F(trow)) + 8u * (unsigned)(hq & 1);

    int q = wx, b = 2 * xcd + (q >> 11), t = ATT_T(q);
    size_t row = (size_t)b * SEQ + t;
    unsigned wsel = SEL[row * 64 + lane];
    int cnt = att_build_list(lists, btab, wsel, t, lane);
    unsigned wnext = 0u;
    if (nq > 1) { const int q1 = wx + nwx; wnext = SEL[((size_t)(2 * xcd + (q1 >> 11)) * SEQ + ATT_T(q1)) * 64 + lane]; }
    long bq[8];
    { const unsigned char* qp = BIG + row * 8192 + hq * 256 + 8 * g;
#pragma unroll
      for (int ks = 0; ks < 8; ++ks) bq[ks] = *(const long*)(qp + 32 * ks); }
    int par = 0;
    asm volatile("s_waitcnt lgkmcnt(0)" ::: "memory");
    att_gather32(CKV8 + (size_t)b * SEQ * RK, lists, kvbuf, lane);
    for (int k = 0; k < nq; ++k) {
        const int cur = k & 1;
        LAS unsigned* list = lists + cur * 256;
        const bool has_next = (k + 1 < nq);
        const int qn = q + nwx, bn = 2 * xcd + (qn >> 11), tn = ATT_T(qn);
        const size_t rown = (size_t)bn * SEQ + tn;
        int cntn = 0;
        if (has_next) { cntn = att_build_list(lists + (cur ^ 1) * 256, btab, wnext, tn, lane);
            if (k + 2 < nq) { const int q2 = qn + nwx; wnext = SEL[((size_t)(2 * xcd + (q2 >> 11)) * SEQ + ATT_T(q2)) * 64 + lane]; } }
        f32x4 O[16];
#pragma unroll
        for (int nt = 0; nt < 16; ++nt) O[nt] = (f32x4){0.f, 0.f, 0.f, 0.f};
        float mref = NEGF, lsum = 0.f;
        const int nsub = (cnt + 31) >> 5;
        for (int sc = 0; sc < nsub; ++sc) {
            const bool lastc = (sc + 1 == nsub);
            float bias[8];
#pragma unroll
            for (int T = 0; T < 2; ++T) { const u32x4 mt = *(const LAS u32x4*)(list + 32 * sc + 8 * g + 4 * T);
#pragma unroll
                for (int i = 0; i < 4; ++i) bias[4 * T + i] = relb[(mt[i] >> 16) * 16 + hq]; }
            if (!lastc) { att_gather32(CKV8 + (size_t)b * SEQ * RK, list + 32 * (sc + 1), kvbuf + (par ^ 1) * 8192, lane); asm volatile("s_waitcnt vmcnt(8)" ::: "memory"); }
            else if (has_next) { att_gather32(CKV8 + (size_t)bn * SEQ * RK, lists + (cur ^ 1) * 256, kvbuf + (par ^ 1) * 8192, lane); asm volatile("s_waitcnt vmcnt(8)" ::: "memory"); }
            else { asm volatile("s_waitcnt vmcnt(0)" ::: "memory"); }
            f32x4 st0 = (f32x4){0.f, 0.f, 0.f, 0.f}, st1 = st0;
            { long kr[8];
              RDK8("0", kr, qa);
#pragma unroll
              for (int ks = 0; ks < 8; ++ks) st0 = __builtin_amdgcn_mfma_f32_16x16x32_fp8_fp8(kr[ks], bq[ks], st0, 0, 0, 0);
              RDK8("1024", kr, qa);
#pragma unroll
              for (int ks = 0; ks < 8; ++ks) st1 = __builtin_amdgcn_mfma_f32_16x16x32_fp8_fp8(kr[ks], bq[ks], st1, 0, 0, 0); }
            if (lastc && has_next) { const unsigned char* qp = BIG + rown * 8192 + hq * 256 + 8 * g;
#pragma unroll
                for (int ks = 0; ks < 8; ++ks) bq[ks] = *(const long*)(qp + 32 * ks); }
            float lg[8]; float cmax;
#pragma unroll
            for (int i = 0; i < 4; ++i) { lg[i] = st0[i] * (1.0f / 64.0f) + bias[i]; lg[4 + i] = st1[i] * (1.0f / 64.0f) + bias[4 + i]; }
            if (32 * sc + 32 > cnt) {
#pragma unroll
                for (int i = 0; i < 4; ++i) { const int s0 = 32 * sc + 8 * g + i; lg[i] = (s0 < cnt) ? lg[i] : NEGF; lg[4 + i] = (s0 + 4 < cnt) ? lg[4 + i] : NEGF; } }
            cmax = fmaxf(fmaxf(fmaxf(lg[0], lg[1]), fmaxf(lg[2], lg[3])), fmaxf(fmaxf(lg[4], lg[5]), fmaxf(lg[6], lg[7])));
            cmax = rows_max(cmax);
            if (__ballot(cmax > mref + 3.0f) != 0ull) {
                const float mnew = fmaxf(mref, cmax), scl = fast_exp(mref - mnew);
                lsum *= scl;
#pragma unroll
                for (int nt = 0; nt < 16; ++nt) O[nt] = O[nt] * scl;
                mref = mnew;
            }
            float p[8];
#pragma unroll
            for (int i = 0; i < 8; ++i) { p[i] = fast_exp(lg[i] - mref); lsum += p[i]; }
            int pw0 = 0, pw1 = 0;
            pw0 = __builtin_amdgcn_cvt_pk_fp8_f32(p[0] * 16.0f, p[1] * 16.0f, pw0, false); pw0 = __builtin_amdgcn_cvt_pk_fp8_f32(p[2] * 16.0f, p[3] * 16.0f, pw0, true);
            pw1 = __builtin_amdgcn_cvt_pk_fp8_f32(p[4] * 16.0f, p[5] * 16.0f, pw1, false); pw1 = __builtin_amdgcn_cvt_pk_fp8_f32(p[6] * 16.0f, p[7] * 16.0f, pw1, true);
            const long pk = (long)(((unsigned long long)(unsigned)pw1 << 32) | (unsigned long long)(unsigned)pw0);
            {
#define TR8B(r, a, o) asm volatile("ds_read_b64_tr_b8 %0, %8\n\tds_read_b64_tr_b8 %1, %9\n\tds_read_b64_tr_b8 %2, %10\n\tds_read_b64_tr_b8 %3, %11\n\t" \
                                   "ds_read_b64_tr_b8 %4, %12\n\tds_read_b64_tr_b8 %5, %13\n\tds_read_b64_tr_b8 %6, %14\n\tds_read_b64_tr_b8 %7, %15\n\ts_waitcnt lgkmcnt(0)" \
                                   : "=&v"(r[0]), "=&v"(r[1]), "=&v"(r[2]), "=&v"(r[3]), "=&v"(r[4]), "=&v"(r[5]), "=&v"(r[6]), "=&v"(r[7]) \
                                   : "v"(a[o + 0]), "v"(a[o + 1]), "v"(a[o + 2]), "v"(a[o + 3]), "v"(a[o + 4]), "v"(a[o + 5]), "v"(a[o + 6]), "v"(a[o + 7]) : "memory")
                long kt[8];
                TR8B(kt, ta, 0);
#pragma unroll
                for (int e = 0; e < 8; ++e) O[e] = __builtin_amdgcn_mfma_f32_16x16x32_fp8_fp8(kt[e], pk, O[e], 0, 0, 0);
                TR8B(kt, ta, 8);
#pragma unroll
                for (int e = 0; e < 8; ++e) O[8 + e] = __builtin_amdgcn_mfma_f32_16x16x32_fp8_fp8(kt[e], pk, O[8 + e], 0, 0, 0);
#undef TR8B
            }
            par ^= 1;
#pragma unroll
            for (int e = 0; e < 8; ++e) { qa[e] ^= 8192u; ta[e] ^= 8192u; ta[8 + e] ^= 8192u; }
        }
        lsum = rows_sum(lsum);
        const float inv = 1.0f / (16.0f * lsum);
        bf16_t* op = (bf16_t*)(BIG + row * 8192) + hq * 256 + 4 * g;
#pragma unroll
        for (int nt = 0; nt < 16; ++nt) { const f32x4 o = O[nt] * inv; u32x2 wv; wv.x = cvt_pk_bf16(o[0], o[1]); wv.y = cvt_pk_bf16(o[2], o[3]); *(u32x2*)(op + 16 * nt) = wv; }
        q = qn; b = bn; t = tn; row = rown; cnt = cntn;
    }
}

constexpr int SW_KP = 144, SW_VP = 520;
constexpr int SW_K_OFF = 0, SW_V_OFF = 256 * SW_KP, SW_TB_OFF = SW_V_OFF + 64 * SW_VP;
__device__ __forceinline__ void swa_phase(const bf16_t* QKV, bf16_t* OB, const float* relb, const float* sinks, LAS unsigned char* lds, int G) {
    int tid = threadIdx.x; asm volatile("" : "+v"(tid));
    const int lane = tid & 63, wave = __builtin_amdgcn_readfirstlane(tid >> 6);
    const int h = lane >> 5, n = lane & 31;
    LAS float* tb = (LAS float*)(lds + SW_TB_OFF);
    for (int u = blockIdx.x; u < BATCH * 16 * KVH; u += G) {
        const int b = u >> 5, nb = (u >> 1) & 15, kvh = u & 1;
        const size_t rowb = (size_t)b * SEQ;
        __syncthreads();
#pragma unroll
        for (int e = 0; e < 4; ++e) { const int id = tid + NTHR * e, j = id >> 3, ch = id & 7; const int pos = (nb - 1) * WIN + j;
            u32x4 kv = (u32x4){0u, 0u, 0u, 0u}, vv = (u32x4){0u, 0u, 0u, 0u};
            if (pos >= 0) { const bf16_t* sp = QKV + (rowb + pos) * B_IN + 1024 + kvh * 64 + ch * 8; kv = *(const u32x4*)sp; vv = *(const u32x4*)(sp + 128); }
            *(LAS u32x4*)(lds + SW_K_OFF + j * SW_KP + ch * 16) = kv;
            LAS bf16_t* vt = (LAS bf16_t*)(lds + SW_V_OFF + (ch * 8) * SW_VP + j * 2);
#pragma unroll
            for (int q = 0; q < 4; ++q) { vt[(2 * q) * (SW_VP / 2)] = (bf16_t)(vv[q] & 0xffffu); vt[(2 * q + 1) * (SW_VP / 2)] = (bf16_t)(vv[q] >> 16); } }
        for (int i = tid; i < GQ * WIN; i += NTHR) { const int gg = i >> 7, dist = i & 127; tb[i] = relb[t5_bucket(dist) * NH + kvh * GQ + gg]; }
        __syncthreads();
        const int qh = kvh * GQ + wave; const float sink = sinks[qh];
        for (int rt = 0; rt < 4; ++rt) {
            const size_t qrow = rowb + nb * WIN + 32 * rt + n;
            bf16x8 bq[4];
#pragma unroll
            for (int ks = 0; ks < 4; ++ks) bq[ks] = *(const bf16x8*)(QKV + qrow * B_IN + qh * 64 + 16 * ks + 8 * h);
            f32x16 s[5];
#pragma unroll
            for (int ct = 0; ct < 5; ++ct) {
#pragma unroll
                for (int i = 0; i < 16; ++i) s[ct][i] = 0.f;
#pragma unroll
                for (int ks = 0; ks < 4; ++ks) { const bf16x8 a = *(const LAS bf16x8*)(lds + SW_K_OFF + (32 * (rt + ct) + n) * SW_KP + (2 * ks + h) * 16);
                    s[ct] = __builtin_amdgcn_mfma_f32_32x32x16_bf16(a, bq[ks], s[ct], 0, 0, 0); } }
            const int qi = 32 * rt + n;
            float mx = NEGF;
#pragma unroll
            for (int ct = 0; ct < 5; ++ct)
#pragma unroll
                for (int i = 0; i < 16; ++i) { const int j = 32 * (rt + ct) + (i & 3) + 8 * (i >> 2) + 4 * h; const int dist = qi + WIN - j;
                    const bool ok = (dist >= 0) && (dist < WIN) && (nb > 0 || j >= WIN);
                    const float v = ok ? s[ct][i] * 0.125f + tb[wave * WIN + (dist & 127)] : NEGF; s[ct][i] = v; mx = fmaxf(mx, v); }
            mx = fmaxf(mx, __shfl_xor(mx, 32)); mx = fmaxf(mx, sink);
            float sum = 0.f;
#pragma unroll
            for (int ct = 0; ct < 5; ++ct)
#pragma unroll
                for (int i = 0; i < 16; ++i) { const float p = fast_exp(s[ct][i] - mx); s[ct][i] = p; sum += p; }
            sum += __shfl_xor(sum, 32); sum += fast_exp(sink - mx);
            f32x16 o[2];
#pragma unroll
            for (int dt = 0; dt < 2; ++dt)
#pragma unroll
                for (int i = 0; i < 16; ++i) o[dt][i] = 0.f;
#pragma unroll
            for (int ct = 0; ct < 5; ++ct)
#pragma unroll
                for (int s2 = 0; s2 < 2; ++s2) {
                    u32x4 pw; pw.x = cvt_pk_bf16(s[ct][8 * s2 + 0], s[ct][8 * s2 + 1]); pw.y = cvt_pk_bf16(s[ct][8 * s2 + 2], s[ct][8 * s2 + 3]);
                    pw.z = cvt_pk_bf16(s[ct][8 * s2 + 4], s[ct][8 * s2 + 5]); pw.w = cvt_pk_bf16(s[ct][8 * s2 + 6], s[ct][8 * s2 + 7]);
                    const bf16x8 pb = __builtin_bit_cast(bf16x8, pw);
#pragma unroll
                    for (int dt = 0; dt < 2; ++dt) { const LAS unsigned char* vp = lds + SW_V_OFF + (32 * dt + n) * SW_VP + (32 * (rt + ct) + 16 * s2 + 4 * h) * 2;
                        const u32x2 v0 = *(const LAS u32x2*)vp, v1 = *(const LAS u32x2*)(vp + 16);
                        u32x4 va; va.x = v0.x; va.y = v0.y; va.z = v1.x; va.w = v1.y;
                        o[dt] = __builtin_amdgcn_mfma_f32_32x32x16_bf16(__builtin_bit_cast(bf16x8, va), pb, o[dt], 0, 0, 0); }
                }
            const float inv = 1.0f / sum;
            bf16_t* op = OB + qrow * D + qh * 64 + 4 * h;
#pragma unroll
            for (int dt = 0; dt < 2; ++dt)
#pragma unroll
                for (int i4 = 0; i4 < 4; ++i4) { u32x2 wv; wv.x = cvt_pk_bf16(o[dt][4 * i4] * inv, o[dt][4 * i4 + 1] * inv); wv.y = cvt_pk_bf16(o[dt][4 * i4 + 2] * inv, o[dt][4 * i4 + 3] * inv);
                    *(u32x2*)(op + 32 * dt + 8 * i4) = wv; }
        }
    }
}

struct Args { const float* in[23]; float* out; unsigned char* ws; };
#define CAS __attribute__((address_space(4)))
__device__ __forceinline__ const CAS Args* kargs() { const CAS Args* p = (const CAS Args*)__builtin_amdgcn_kernarg_segment_ptr(); asm volatile("" : "+s"(p)); return p; }

__global__ void __launch_bounds__(NTHR, 2) trunk_fwd(Args args_by_value) {
    extern __shared__ __attribute__((aligned(16))) unsigned char lds_raw[];
    LAS unsigned char* lds = (LAS unsigned char*)lds_raw;
    const int tid = threadIdx.x;
    volatile LAS unsigned* MISC = (volatile LAS unsigned*)(lds + LDS_MISC_OFF);
    for (int u = tid; u < (LDS_BYTES - LDS_MISC_OFF) / 4; u += NTHR) MISC[u] = 0u;
    __syncthreads();
    { const CAS Args* A = kargs(); (void)xcd_barrier_post((unsigned*)(A->ws + WS_CTL) + 4096, MISC + 8);
      if (tid == 0) { const unsigned x = xb_xcc_id(); MISC[16] = x; MISC[17] = xb_add((unsigned*)(A->ws + WS_CTL) + 8192 + 64 * x, 1u); } }
#define XCD_RANK(xcd, rank) do { const CAS Args* A_ = kargs(); const unsigned* cw_ = (const unsigned*)(A_->ws + WS_CTL) + 4096; bool ok_ = (gridDim.x & 7) == 0; \
        for (int j_ = 0; j_ < 16; ++j_) { const unsigned c_ = __hip_atomic_load(cw_ + XB_XCNT(j_), __ATOMIC_RELAXED, __HIP_MEMORY_SCOPE_AGENT); ok_ = ok_ && (c_ == (j_ < 8 ? gridDim.x >> 3 : 0u)); } \
        const unsigned hx_ = MISC[16], hr_ = MISC[17]; ok_ = ok_ && hx_ < 8u && hr_ < (gridDim.x >> 3); \
        xcd = ok_ ? (int)hx_ : (int)(blockIdx.x & 7); rank = ok_ ? (int)hr_ : (int)(blockIdx.x >> 3); } while (0)
#define GB() do { const CAS Args* A_ = kargs(); XcdBarrier b_; b_.bar = (unsigned*)(A_->ws + WS_CTL) + 4096; b_.x = xb_xcc_id(); b_.st = MISC + 8; xcd_barrier(b_); } while (0)

    { const CAS Args* A = kargs(); Ptrs P;
#pragma unroll
      for (int i = 0; i < 23; ++i) P.in[i] = A->in[i];
      P.out = A->out; P.ws = A->ws;
      p0_prologue(P, lds, (int)gridDim.x); }
    GB();
    { const CAS Args* A = kargs(); Ptrs P;
#pragma unroll
      for (int i = 0; i < 23; ++i) P.in[i] = A->in[i];
      P.out = A->out; P.ws = A->ws;
      pre_phase(P, lds, (int)gridDim.x); }
    GB();

    for (int l = 0; l < DEPTH; ++l) {
        const bool isA = (l & 1) == 0;
        {
            const CAS Args* A = kargs(); const int G = gridDim.x, j = l >> 1; unsigned char* ws = A->ws;
            const unsigned long long* SS = (const unsigned long long*)(ws + WS_SS) + (size_t)(2 * l) * M;
            if (isA) {
                unsigned char* wa = ws + WS_WA + (size_t)j * WA_STRIDE;
                pg8::Gemm g{(const bf16_t*)(ws + WS_XG), (const bf16_t*)(wa + WINA_OFF), D, D, D, 0, 0}; pg8::StaticOrder S; S.init(M, 2048, G, (int)blockIdx.x);
                pg8::EpiInA E{(bf16_t*)(ws + WS_QO), (bf16_t*)(ws + WS_CKV), (bf16_t*)(ws + WS_QI), (bf16_t*)(ws + WS_KIN), (float*)(ws + WS_WI), A->in[I_AIKG] + j * IDIM, A->in[I_AIKB] + j * IDIM,
                                (const float*)(ws + WS_SHW + SHW_A) + (size_t)j * BATCH * 2048, SS};
                pg8::gemm_phase<pg8::EpiInA, true>(lds, g, S, E);
            } else {
                unsigned char* wb = ws + WS_WB + (size_t)j * WB_STRIDE;
                pg8::Gemm g{(const bf16_t*)(ws + WS_XG), (const bf16_t*)(wb + WINB_OFF), D, D, D, 0, 0}; pg8::StaticOrder S; S.init(M, B_IN, G, (int)blockIdx.x);
                pg8::EpiBf16Plain<true> E{(bf16_t*)(ws + WS_QKV), B_IN, (const float*)(ws + WS_SHW + SHW_B) + (size_t)j * BATCH * B_IN, B_IN, SS};
                pg8::gemm_phase<pg8::EpiBf16Plain<true>, true>(lds, g, S, E);
            }
        }
        GB();
        if (isA) {
            { const CAS Args* A = kargs(); const int G = gridDim.x, j = l >> 1; unsigned char* ws = A->ws;
              unsigned char* wa = ws + WS_WA + (size_t)j * WA_STRIDE;
              pg8::Gemm g{(const bf16_t*)(ws + WS_QO), (const bf16_t*)(wa + WQA_OFF), D, 256, 256, 2, 256}; pg8::StaticOrder S; S.init(M, 4096, G, (int)blockIdx.x);
              pg8::EpiFp8 E{ws + WS_BIG, 8192};
              pg8::gemm_phase<pg8::EpiFp8, true>(lds, g, S, E); }
            { const CAS Args* A = kargs(); const int G = gridDim.x; unsigned char* ws = A->ws;
              int tid2 = tid; asm volatile("" : "+v"(tid2));
              const int lane = tid2 & 63, wave = __builtin_amdgcn_readfirstlane(tid2 >> 6);
              const bf16_t* CKV = (const bf16_t*)(ws + WS_CKV); unsigned* CKV8 = (unsigned*)(ws + WS_CKV8);
              const int gw = blockIdx.x * NWAVES + wave, NGW = G * NWAVES;
              for (int row = gw; row < M; row += NGW) {
                  const u32x2 v = *((const u32x2*)(CKV + (size_t)row * RK) + lane);
                  const float a0 = __uint_as_float(v.x << 16), a1 = __uint_as_float(v.x & 0xffff0000u), a2 = __uint_as_float(v.y << 16), a3 = __uint_as_float(v.y & 0xffff0000u);
                  const float ss = wave_sum((a0 * a0 + a1 * a1) + (a2 * a2 + a3 * a3));
                  const float rs = 1.0f / sqrtf(ss * (1.0f / RK) + EPS);
                  int w = 0; w = __builtin_amdgcn_cvt_pk_fp8_f32(a0 * rs, a1 * rs, w, false); w = __builtin_amdgcn_cvt_pk_fp8_f32(a2 * rs, a3 * rs, w, true);
                  CKV8[(size_t)row * (RK / 4) + lane] = (unsigned)w;
              } }
            { const CAS Args* A = kargs(); const int G = gridDim.x; unsigned char* ws = A->ws;
              int tid2 = tid; asm volatile("" : "+v"(tid2));
              const int lane = tid2 & 63, wave = __builtin_amdgcn_readfirstlane(tid2 >> 6);
              int xcd, rank; XCD_RANK(xcd, rank); xcd = __builtin_amdgcn_readfirstlane(xcd); rank = __builtin_amdgcn_readfirstlane(rank);
              const int wx = rank * NWAVES + wave, nwx = (G >> 3) * NWAVES;
              const int nsteps = (1024 + nwx - 1) / nwx;
              for (int st = 0; st < nsteps; ++st) {
                  const int q = wx + st * nwx; const bool active = q < 1024;
                  const int qc = active ? q : (rank * NWAVES + st * nwx < 1024 ? rank * NWAVES + st * nwx : 1023);
                  const int bl = qc >> 9, u = qc & 255, hiq = (qc >> 8) & 1, b = 2 * xcd + bl;
                  const int tg = hiq ? 511 - u : u;
                  idx_task((const bf16_t*)(ws + WS_QI), (const bf16_t*)(ws + WS_KIN), (const float*)(ws + WS_WI), (unsigned*)(ws + WS_SEL), lds, b, tg, lane, wave, active, hiq ? 2 : 1);
              }
              __syncthreads(); }
        } else {
            const CAS Args* A = kargs(); const int G = gridDim.x, j = l >> 1; unsigned char* ws = A->ws;
            swa_phase((const bf16_t*)(ws + WS_QKV), (bf16_t*)(ws + WS_OB), A->in[I_RELB], A->in[I_BSINK] + j * NH, lds, G);
        }
        GB();
        if (isA) {
            { const CAS Args* A = kargs(); const int G = gridDim.x; unsigned char* ws = A->ws;
              int tid2 = tid; asm volatile("" : "+v"(tid2));
              const int lane = tid2 & 63, wave = __builtin_amdgcn_readfirstlane(tid2 >> 6);
              LAS float* relb = (LAS float*)(lds + 147456);
              LAS unsigned* btab = (LAS unsigned*)(lds + 147456 + 2048);
              for (int i = tid2; i < NBUCK * NH; i += NTHR) relb[i] = A->in[I_RELB][i];
              for (int i = tid2; i < 132; i += NTHR) btab[i] = (unsigned)t5_bucket(i);
              __syncthreads();
              int xcd, rank; XCD_RANK(xcd, rank); xcd = __builtin_amdgcn_readfirstlane(xcd); rank = __builtin_amdgcn_readfirstlane(rank);
              const int wx = rank * NWAVES + wave, nwx = (G >> 3) * NWAVES;
              att_wave(ws + WS_CKV8, (const unsigned*)(ws + WS_SEL), ws + WS_BIG, lds + wave * 16384, (LAS unsigned*)(lds + 131072 + wave * 2048), relb, btab, xcd, wx, nwx, lane); }
            GB();
            { const CAS Args* A = kargs(); const int G = gridDim.x, j = l >> 1; unsigned char* ws = A->ws;
              unsigned char* wa = ws + WS_WA + (size_t)j * WA_STRIDE;
              pg8::Gemm g{(const bf16_t*)(ws + WS_BIG), (const bf16_t*)(wa + WUV_OFF), 4096, D, D, 0, 1024}; pg8::StaticOrder S; S.init(M, D, G, (int)blockIdx.x);
              pg8::EpiBf16Plain<false> E{(bf16_t*)(ws + WS_QO), D, nullptr, 0, nullptr};
              pg8::gemm_phase<pg8::EpiBf16Plain<false>, true>(lds, g, S, E); }
            GB();
        }
        {
            const CAS Args* A = kargs(); const int G = gridDim.x, j = l >> 1; unsigned char* ws = A->ws;
            const float* modl = (const float*)(ws + WS_MOD) + (size_t)l * BATCH * 6144;
            const bf16_t* Ain = (const bf16_t*)(ws + (isA ? WS_QO : WS_OB));
            const bf16_t* Bw = (const bf16_t*)(isA ? ws + WS_WA + (size_t)j * WA_STRIDE + WOUTA_OFF : ws + WS_WB + (size_t)j * WB_STRIDE + WOUTB_OFF);
            pg8::Gemm g{Ain, Bw, D, D, D, 0, 0}; pg8::StaticOrder S; S.init(M, D, G, (int)blockIdx.x);
            pg8::EpiResid E{(const bf16_t*)A->out, (bf16_t*)A->out, modl + 2048, isA ? nullptr : A->in[I_BBOUT] + j * D,
                            (bf16_t*)(ws + WS_XG), A->in[I_GFFN] + l * D, modl + 4096, (unsigned long long*)(ws + WS_SS) + (size_t)(2 * l + 1) * M};
            pg8::gemm_phase<pg8::EpiResid, true>(lds, g, S, E);
        }
        GB();
        {
            const CAS Args* A = kargs(); const int G = gridDim.x; unsigned char* ws = A->ws;
            unsigned char* wl = ws + WS_W + (size_t)l * W_LAYER;
            pg8::Gemm g{(const bf16_t*)(ws + WS_XG), (const bf16_t*)(wl + W13_OFF), D, D, D, 0, 0}; pg8::StaticOrder S; S.init(M, 2 * DFF, G, (int)blockIdx.x);
            pg8::EpiSwiGLU E{(bf16_t*)(ws + WS_HFF), (const float*)(ws + WS_SHW + SHW_F) + (size_t)l * BATCH * 2 * DFF, (const unsigned long long*)(ws + WS_SS) + (size_t)(2 * l + 1) * M};
            pg8::gemm_phase<pg8::EpiSwiGLU, true>(lds, g, S, E);
        }
        GB();
        {
            const CAS Args* A = kargs(); const int G = gridDim.x; unsigned char* ws = A->ws;
            unsigned char* wl = ws + WS_W + (size_t)l * W_LAYER;
            const float* modl = (const float*)(ws + WS_MOD) + (size_t)l * BATCH * 6144;
            const int ln = l + 1 < DEPTH ? l + 1 : l;
            pg8::Gemm g{(const bf16_t*)(ws + WS_HFF), (const bf16_t*)(wl + W2_OFF), DFF, DFF, DFF, 0, 0}; pg8::StaticOrder S; S.init(M, D, G, (int)blockIdx.x);
            const bool lastl = (l + 1 == DEPTH);
            pg8::EpiResid E{(const bf16_t*)A->out, lastl ? (bf16_t*)(ws + WS_XG) : (bf16_t*)A->out, modl + 5120, nullptr,
                            l + 1 < DEPTH ? (bf16_t*)(ws + WS_XG) : nullptr, A->in[I_GMIX] + ln * D, (const float*)(ws + WS_MOD) + (size_t)ln * BATCH * 6144 + 1024, (unsigned long long*)(ws + WS_SS) + (size_t)(2 * l + 2) * M};
            pg8::gemm_phase<pg8::EpiResid, true>(lds, g, S, E);
        }
        GB();
    }
    { const CAS Args* A = kargs(); final_norm_phase((const bf16_t*)(A->ws + WS_XG), A->out, A->in[I_GFIN], (int)gridDim.x); }
#undef GB
}

extern "C" void kernel_launch(void* const* d_in, const int* in_sizes, int n_in, void* d_out, int out_size, void* d_ws, size_t ws_size, hipStream_t stream) {
    static int grid = 0;
    if (grid == 0) {
        if (n_in != 23 || out_size != M * D || ws_size < WS_END) { fprintf(stderr, "kernel_launch: unexpected shapes (n_in %d out %d ws %zu)\n", n_in, out_size, ws_size); grid = -1; return; }
        int dev = 0, cus = 0, per_cu = 0;
        if (hipGetDevice(&dev) != hipSuccess || hipDeviceGetAttribute(&cus, hipDeviceAttributeMultiprocessorCount, dev) != hipSuccess) { grid = -1; return; }
        if (hipFuncSetAttribute((const void*)trunk_fwd, hipFuncAttributeMaxDynamicSharedMemorySize, LDS_BYTES) != hipSuccess) { fprintf(stderr, "kernel_launch: hipFuncSetAttribute failed\n"); grid = -1; return; }
        if (hipOccupancyMaxActiveBlocksPerMultiprocessor(&per_cu, (const void*)trunk_fwd, NTHR, LDS_BYTES) != hipSuccess || per_cu < 1) { fprintf(stderr, "kernel_launch: occupancy query says %d\n", per_cu); }
        (void)hipGetLastError();
        grid = cus;
    }
    if (grid < 0) return;
    (void)hipMemsetAsync((char*)d_ws + WS_CTL, 0, CTL_ZERO_BYTES, stream);
    Args a{};
    for (int i = 0; i < 23; ++i) a.in[i] = (const float*)d_in[i];
    a.out = (float*)d_out; a.ws = (unsigned char*)d_ws;
    hipLaunchKernelGGL(trunk_fwd, dim3(grid), dim3(NTHR), LDS_BYTES, stream, a);
    const hipError_t le = hipPeekAtLastError();
    if (le != hipSuccess) fprintf(stderr, "kernel_launch: launch failed: %s\n", hipGetErrorName(le));
}
```

```cpp
#include <hip/hip_runtime.h>
#include <cstdio>
#include <cstdint>


#define GAS __attribute__((address_space(1)))
#define LAS __attribute__((address_space(3)))
typedef unsigned short bf16_t;
typedef short bf16x8 __attribute__((ext_vector_type(8)));
typedef short s16x4 __attribute__((ext_vector_type(4)));
typedef float f32x4 __attribute__((ext_vector_type(4)));
typedef float f32x2 __attribute__((ext_vector_type(2)));
typedef float f32x16 __attribute__((ext_vector_type(16)));
typedef unsigned u32x4 __attribute__((ext_vector_type(4)));
typedef unsigned u32x2 __attribute__((ext_vector_type(2)));

constexpr int D = 1024, BATCH = 16, SEQ = 2048, M = BATCH * SEQ, DEPTH = 4;
constexpr int NH = 16, HD = 64, RK = 256, IH = 8, IDIM = 64, TOPK = 256;
constexpr int KVH = 2, GQ = 8, WIN = 128, NBUCK = 32, DFF = 2816;
constexpr int A_IN = 1864, B_IN = 1280;
constexpr float EPS = 1e-6f;
constexpr float NEGF = -1e30f;
constexpr int NWAVES = 8, NTHR = 512;

constexpr size_t MiB = 1u << 20;
constexpr size_t WS_CTL = 0, CTL_ZERO_BYTES = 4 * MiB;
constexpr size_t WS_SS = 1 * MiB;
constexpr size_t WS_W = 4 * MiB;
constexpr size_t W_LAYER = 17301504;
constexpr size_t W13_OFF = 0, W2_OFF = 11 * MiB;
constexpr size_t WS_WA = WS_W + 4 * W_LAYER;
constexpr size_t WA_STRIDE = 10 * MiB, WINA_OFF = 0, WQA_OFF = 4 * MiB, WUV_OFF = 6 * MiB, WOUTA_OFF = 8 * MiB;
constexpr size_t WS_WB = WS_WA + 2 * WA_STRIDE;
constexpr size_t WB_STRIDE = 4718592, WINB_OFF = 0, WOUTB_OFF = 2621440;
constexpr size_t WS_MOD = 100 * MiB;
constexpr size_t WS_SHW = WS_MOD + 1536 * 1024;
constexpr size_t SHW_A = 0, SHW_B = 2 * 16 * 2048 * 4, SHW_F = SHW_B + 2 * 16 * 1280 * 4;
constexpr size_t WS_XG = 104 * MiB;
constexpr size_t WS_BIG = 104 * MiB;
constexpr size_t WS_HFF = 168 * MiB;
constexpr size_t WS_QO = 360 * MiB;
constexpr size_t WS_CKV = 424 * MiB;
constexpr size_t WS_QI = 440 * MiB;
constexpr size_t WS_KIN = 472 * MiB;
constexpr size_t WS_WI = 476 * MiB;
constexpr size_t WS_SEL = 477 * MiB;
constexpr size_t WS_CKV8 = 486 * MiB;
constexpr size_t WS_QKV = 360 * MiB;
constexpr size_t WS_OB = 440 * MiB;
constexpr size_t WS_END = 512 * MiB;

constexpr int RING_BYTES = 131072;
constexpr int LDS_MISC_OFF = 155648;
constexpr int LDS_BYTES = 156672;

#define RLX_AGENT __ATOMIC_RELAXED, __HIP_MEMORY_SCOPE_AGENT
__device__ __forceinline__ unsigned cvt_pk_bf16(float lo, float hi) { unsigned r; asm volatile("v_cvt_pk_bf16_f32 %0, %1, %2" : "=v"(r) : "v"(lo), "v"(hi)); return r; }
__device__ __forceinline__ float bf2f(bf16_t b) { return __uint_as_float(((unsigned)b) << 16); }
__device__ __forceinline__ float wave_sum(float v) {
#pragma unroll
    for (int o = 1; o < 64; o <<= 1) v += __shfl_xor(v, o);
    return v;
}
__device__ __forceinline__ float fast_exp(float x) { return __builtin_amdgcn_exp2f(x * 1.4426950408889634f); }
__device__ __forceinline__ float silu_f(float x) { return x * __builtin_amdgcn_rcpf(1.0f + fast_exp(-x)); }
__device__ __forceinline__ int t5_bucket(int d) {
    if (d < 16) return d;
    int b = 16;
    b += (d >= 19); b += (d >= 21); b += (d >= 24); b += (d >= 27); b += (d >= 31); b += (d >= 35); b += (d >= 40); b += (d >= 46);
    b += (d >= 52); b += (d >= 59); b += (d >= 67); b += (d >= 77); b += (d >= 87); b += (d >= 99); b += (d >= 113);
    return b;
}

#define XB_TMO      128
#define XB_XCNT(j)  (256  + 64 * (j))
#define XB_XSUB(j)  (1280 + 64 * (j))
#define XB_XGEN(j)  (2304 + 64 * (j))
#define XB_TOP      3328
#define XB_TOPGEN   3392
#define XCD_BAR_WORDS 3456
#define XB_SPIN_CAP (1u << 22)

__device__ __forceinline__ unsigned xb_ld(unsigned* p)              { return __hip_atomic_load(p, __ATOMIC_RELAXED, __HIP_MEMORY_SCOPE_AGENT); }
__device__ __forceinline__ unsigned xb_add(unsigned* p, unsigned v) { return __hip_atomic_fetch_add(p, v, __ATOMIC_RELAXED, __HIP_MEMORY_SCOPE_AGENT); }
__device__ __forceinline__ unsigned xb_xcc_id() { return (unsigned)__builtin_amdgcn_s_getreg((3 << 11) | 20) & 0xFu; }
#define XB_SPIN(cond, bar) do { unsigned _sp = 0; while (cond) { __builtin_amdgcn_s_sleep(1); \
    if ((++_sp & 255u) == 0u) { if (xb_ld(&(bar)[XB_TMO])) break; if (_sp > XB_SPIN_CAP) { atomicAdd(&(bar)[XB_TMO], 1u); break; } } } } while (0)

struct XcdBarrier { unsigned* bar; unsigned x; volatile LAS unsigned* st; };

__device__ __forceinline__ XcdBarrier xcd_barrier_post(unsigned* bar, volatile LAS unsigned* st) {
    XcdBarrier b; b.bar = bar; b.x = xb_xcc_id(); b.st = st;
    if (threadIdx.x == 0) (void)xb_add(&bar[XB_XCNT(b.x)], 1u);
    return b;
}
__device__ __forceinline__ void xcd_barrier_complete(unsigned* bar, unsigned x, unsigned& nloc, unsigned& nx) {
    const unsigned G = gridDim.x * gridDim.y * gridDim.z;
    unsigned sum, cnt, mine, sp = 0u;
    for (;;) {
        sum = 0u; cnt = 0u; mine = 0u;
#pragma unroll
        for (unsigned j = 0; j < 16; ++j) { const unsigned c = xb_ld(&bar[XB_XCNT(j)]); sum += c; cnt += (c > 0u) ? 1u : 0u; mine = (j == x) ? c : mine; }
        if (sum == G) break;
        __builtin_amdgcn_s_sleep(1);
        if ((++sp & 255u) == 0u) { if (xb_ld(&bar[XB_TMO])) break; if (sp > XB_SPIN_CAP) { atomicAdd(&bar[XB_TMO], 1u); break; } }
    }
    nloc = mine > 0u ? mine : 1u; nx = cnt > 0u ? cnt : 1u;
}
__device__ __forceinline__ void xcd_barrier(const XcdBarrier& b) {
    asm volatile("s_waitcnt vmcnt(0)" ::: "memory");
    __syncthreads();
    if (threadIdx.x == 0) {
        unsigned* bar = b.bar;
        __builtin_amdgcn_s_waitcnt(0);
        unsigned nloc = b.st[0], nx = b.st[1];
        if (nloc == 0u) { xcd_barrier_complete(bar, b.x, nloc, nx); b.st[0] = nloc; b.st[1] = nx; }
        const unsigned old = xb_add(&bar[XB_XSUB(b.x)], 1u);
        const unsigned gen = old / nloc;
        if (old + 1u == (gen + 1u) * nloc) {
            __builtin_amdgcn_fence(__ATOMIC_RELEASE, "agent");
            asm volatile("s_waitcnt vmcnt(0)" ::: "memory");
            const unsigned og = xb_add(&bar[XB_TOP], 1u);
            const unsigned tg = og / nx;
            if (og + 1u == (tg + 1u) * nx) xb_add(&bar[XB_TOPGEN], 1u);
            else XB_SPIN(xb_ld(&bar[XB_TOPGEN]) == tg, bar);
            __builtin_amdgcn_fence(__ATOMIC_ACQUIRE, "agent");
            xb_add(&bar[XB_XGEN(b.x)], 1u);
            asm volatile("s_waitcnt vmcnt(0)" ::: "memory");
        } else {
            XB_SPIN(xb_ld(&bar[XB_XGEN(b.x)]) == gen, bar);
            __builtin_amdgcn_fence(__ATOMIC_ACQUIRE, "agent");
            asm volatile("s_waitcnt vmcnt(0)" ::: "memory");
        }
    }
    __syncthreads();
}

namespace pg8 {
constexpr int BM = 256, BK = 64, HALF = 128, HTB = HALF * BK * 2, STAGE_BYTES = 8 * HTB, NXCD = 8, WGM = 8;
__host__ __device__ __forceinline__ int lds_byte(int r, int c) { const int st = (r >> 4) * 2 + (c >> 5), rr = r & 15, cc = c & 31, ob = rr * 64 + cc * 2; return st * 1024 + (ob ^ (((ob >> 9) & 1) << 5)); }
__host__ __device__ __forceinline__ void stage_rc(int b, int& R, int& C) { const int st = b / 1024, sb = b % 1024, swz = sb ^ (((sb >> 9) & 1) << 5); R = (st >> 1) * 16 + swz / 64; C = (st & 1) * 32 + (swz % 64) / 2; }
__host__ __device__ __forceinline__ int perm32(int rho) { const int n = rho >> 4, i = rho & 15; return 8 * (i >> 2) + 4 * n + (i & 3); }

struct Unit { int pm, pn; };
struct Gemm { const bf16_t* A; const bf16_t* Bt; int lda, ldb, K, a_shift, a_mul; };

struct StaticOrder {
    int nM, nN, nwg, G, c;
    __device__ void init(int M_, int N_, int G_, int c_) { nM = M_ / BM; nN = N_ / BM; nwg = nM * nN; G = G_; c = c_; }
    __device__ bool next(int i, Unit& u) const {
        const long L = (long)i * G + c; if (L >= nwg) return false;
        int wgid = (int)L; { const int q = nwg / NXCD, r = nwg % NXCD, xcd = wgid % NXCD, off = wgid / NXCD; wgid = (xcd < r ? xcd * (q + 1) : r * (q + 1) + (xcd - r) * q) + off; }
        const int nig = WGM * nN, gid = wgid / nig, fm = gid * WGM, gsz = (nM - fm) < WGM ? (nM - fm) : WGM;
        u.pm = fm + ((wgid % nig) % gsz); u.pn = (wgid % nig) / gsz; return true;
    }
};

template <class Epi, bool ALIGN_EPI>
__device__ __forceinline__ void gemm_phase(LAS unsigned char* lds, const Gemm g, const StaticOrder& S, const Epi& E) {
    int tid = threadIdx.x; asm volatile("" : "+v"(tid));
    const int wid = __builtin_amdgcn_readfirstlane(tid >> 6), lane = tid & 63, wr = wid >> 2, wc = wid & 3, fr = lane & 15, fq = lane >> 4;
    const int K = g.K, nt = K / BK;
    unsigned voffA[2], voffB[2];
#pragma unroll
    for (int i = 0; i < 2; ++i) { int R, C; stage_rc(tid * 16 + i * 8192, R, C); const int Rb = Epi::PERM ? ((R & ~31) + perm32(R & 31)) : R;
        voffA[i] = (unsigned)(R * g.lda + C) * 2u; voffB[i] = (unsigned)(Rb * g.ldb + C) * 2u; }
    const size_t kstep = (size_t)(BK * 2);
    const size_t hstepA = (size_t)HALF * g.lda * 2, hstepB = (size_t)HALF * g.ldb * 2;
    const unsigned ldsw = (unsigned)wid * 1024u;
    const int aoff = lds_byte(wr * 64 + fr, fq * 8), boff = lds_byte(wc * 32 + fr, fq * 8);
#define PG8_SA(b, h) (((b) * 2 + (h)) * HTB)
#define PG8_SB(b, h) ((4 + (b) * 2 + (h)) * HTB)
#define PG8_STAGE(bufoff, gbase, voff) do { _Pragma("unroll") for (int _i = 0; _i < 2; ++_i) \
        __builtin_amdgcn_global_load_lds((const unsigned*)((const char*)(gbase) + (voff)[_i]), (LAS unsigned*)(lds + (bufoff) + ldsw + _i * 8192), 16, 0, 0); } while (0)
#define PG8_LDA(dst, b, h) do { _Pragma("unroll") for (int m = 0; m < 4; ++m) _Pragma("unroll") for (int k = 0; k < 2; ++k) dst[m][k] = *(const LAS bf16x8*)(lds + PG8_SA(b, h) + aoff + m * 2048 + k * 1024); } while (0)
#define PG8_LDB(dst, b, h) do { _Pragma("unroll") for (int n = 0; n < 2; ++n) _Pragma("unroll") for (int k = 0; k < 2; ++k) dst[n][k] = *(const LAS bf16x8*)(lds + PG8_SB(b, h) + boff + n * 2048 + k * 1024); } while (0)
#define PG8_MMA(ai, bj, At, Bt) do { __builtin_amdgcn_s_setprio(1); _Pragma("unroll") for (int m = 0; m < 4; ++m) _Pragma("unroll") for (int n = 0; n < 2; ++n) _Pragma("unroll") for (int k = 0; k < 2; ++k) \
        acc[ai][bj][m][n] = __builtin_amdgcn_mfma_f32_16x16x32_bf16(Bt[n][k], At[m][k], acc[ai][bj][m][n], 0, 0, 0); __builtin_amdgcn_s_setprio(0); } while (0)
#define PG8_WAIT_V(n) asm volatile("s_waitcnt vmcnt(" #n ")" ::: "memory")
#define PG8_WAIT_L(n) asm volatile("s_waitcnt lgkmcnt(" #n ")" ::: "memory")
#define PG8_BAR __builtin_amdgcn_s_barrier()
#define PG8_SCHED __builtin_amdgcn_sched_barrier(0)
#define PG8_ABASE(u) ((const char*)g.A + ((size_t)(u).pm * BM * g.lda + (size_t)((u).pn >> g.a_shift) * g.a_mul) * 2)
#define PG8_BBASE(u) ((const char*)g.Bt + (size_t)(u).pn * BM * g.ldb * 2)
    Unit cur, nxt; int ui = 0;
    if (!S.next(0, cur)) return;
    f32x4 acc[2][2][4][2];
#pragma unroll
    for (int a = 0; a < 2; ++a)
#pragma unroll
        for (int b = 0; b < 2; ++b)
#pragma unroll
            for (int m = 0; m < 4; ++m)
#pragma unroll
                for (int n = 0; n < 2; ++n) acc[a][b][m][n] = (f32x4){0.f, 0.f, 0.f, 0.f};
    bf16x8 At[4][2], B0[2][2], B1[2][2];
    const char* cA = PG8_ABASE(cur); const char* cB = PG8_BBASE(cur);
    PG8_STAGE(PG8_SB(0, 0), cB, voffB); PG8_STAGE(PG8_SB(0, 1), cB + hstepB, voffB); PG8_STAGE(PG8_SA(0, 0), cA, voffA); PG8_STAGE(PG8_SA(0, 1), cA + hstepA, voffA);
    if (wr == 1) PG8_BAR;
    PG8_WAIT_V(2); PG8_BAR;
    PG8_STAGE(PG8_SB(1, 0), cB + kstep, voffB); PG8_STAGE(PG8_SA(1, 0), cA + kstep, voffA); PG8_STAGE(PG8_SB(1, 1), cB + hstepB + kstep, voffB);
    PG8_WAIT_V(6); PG8_BAR;
    for (;;) {
        const bool has_next = S.next(ui + 1, nxt);
        const char* nA = has_next ? PG8_ABASE(nxt) : cA; const char* nB = has_next ? PG8_BBASE(nxt) : cB;
        for (int t = 0; t < nt; t += 2) {
            const bool last = (t == nt - 2);
            if constexpr (Epi::PREFETCH) { if (last) E.prefetch(lds + STAGE_BYTES, cur, wid, lane); }
            const char* a1 = cA + (size_t)(t + 1) * kstep;
            const char* a2 = last ? nA : cA + (size_t)(t + 2) * kstep; const char* b2 = last ? nB : cB + (size_t)(t + 2) * kstep;
            const char* a3 = a2 + kstep; const char* b3 = b2 + kstep;
            PG8_LDB(B0, 0, 0); PG8_LDB(B1, 0, 1); PG8_SCHED; PG8_LDA(At, 0, 0); PG8_STAGE(PG8_SA(1, 1), a1 + hstepA, voffA);
            PG8_WAIT_V(8); PG8_WAIT_L(0); PG8_BAR; PG8_MMA(0, 0, At, B0); PG8_MMA(0, 1, At, B1); PG8_BAR; PG8_SCHED;
            PG8_LDA(At, 0, 1); PG8_STAGE(PG8_SB(0, 0), b2, voffB); PG8_STAGE(PG8_SB(0, 1), b2 + hstepB, voffB); PG8_STAGE(PG8_SA(0, 0), a2, voffA);
            PG8_WAIT_V(8); PG8_WAIT_L(0); PG8_BAR; PG8_MMA(1, 0, At, B0); PG8_MMA(1, 1, At, B1); PG8_BAR; PG8_SCHED;
            PG8_LDB(B0, 1, 0); PG8_LDB(B1, 1, 1); PG8_SCHED; PG8_LDA(At, 1, 0); PG8_STAGE(PG8_SA(0, 1), a2 + hstepA, voffA);
            PG8_WAIT_V(8); PG8_WAIT_L(0); PG8_BAR; PG8_MMA(0, 0, At, B0); PG8_MMA(0, 1, At, B1); PG8_BAR; PG8_SCHED;
            PG8_LDA(At, 1, 1); PG8_STAGE(PG8_SB(1, 0), b3, voffB); PG8_STAGE(PG8_SB(1, 1), b3 + hstepB, voffB); PG8_STAGE(PG8_SA(1, 0), a3, voffA);
            PG8_WAIT_V(8); PG8_WAIT_L(0); PG8_BAR; PG8_MMA(1, 0, At, B0); PG8_MMA(1, 1, At, B1); PG8_BAR; PG8_SCHED;
        }
        if constexpr (ALIGN_EPI) { if (wr == 0) PG8_BAR; }
        { int t2 = threadIdx.x; asm volatile("" : "+v"(t2)); const int l2 = t2 & 63;
          if constexpr (Epi::PREFETCH) E(acc, cur, wr, wc, l2 & 15, l2 >> 4, lds + STAGE_BYTES); else E(acc, cur, wr, wc, l2 & 15, l2 >> 4); }
        if (!has_next) break;
#pragma unroll
        for (int a = 0; a < 2; ++a)
#pragma unroll
            for (int b = 0; b < 2; ++b)
#pragma unroll
                for (int m = 0; m < 4; ++m)
#pragma unroll
                    for (int n = 0; n < 2; ++n) acc[a][b][m][n] = (f32x4){0.f, 0.f, 0.f, 0.f};
        cur = nxt; cA = nA; cB = nB; ++ui;
        if constexpr (ALIGN_EPI) { if (wr == 1) PG8_BAR; }
    }
    PG8_WAIT_V(0);
    if constexpr (!ALIGN_EPI) { if (wr == 0) PG8_BAR; }
    PG8_BAR;
#undef PG8_SA
#undef PG8_SB
#undef PG8_STAGE
#undef PG8_LDA
#undef PG8_LDB
#undef PG8_MMA
#undef PG8_WAIT_V
#undef PG8_WAIT_L
#undef PG8_BAR
#undef PG8_SCHED
#undef PG8_ABASE
#undef PG8_BBASE
}

template <bool NORM> struct EpiBf16Plain {
    static constexpr bool PERM = true, PREFETCH = NORM;
    bf16_t* O; int ldc; const float* shw; int shw_stride; const unsigned long long* SS;
    __device__ __forceinline__ void prefetch(LAS unsigned char* aux, const Unit& u, int wid, int lane) const {
        if (wid < 2) __builtin_amdgcn_global_load_lds((const unsigned*)((const char*)(SS + (size_t)u.pm * BM) + wid * 1024 + lane * 16), (LAS unsigned*)(aux + wid * 1024), 16, 0, 0);
        else if (wid == 2) __builtin_amdgcn_global_load_lds((const unsigned*)((const char*)(shw + (size_t)(u.pm >> 3) * shw_stride + u.pn * BM) + lane * 16), (LAS unsigned*)(aux + 2048), 16, 0, 0);
    }
    __device__ __forceinline__ void operator()(const f32x4 (&acc)[2][2][4][2], const Unit& u, int wr, int wc, int fr, int fq, const LAS unsigned char* aux = nullptr) const {
        const int row0 = u.pm * BM + wr * 64 + fr, col0 = u.pn * BM + wc * 32 + 8 * fq;
        f32x4 bv[2][2];
#pragma unroll
        for (int bj = 0; bj < 2; ++bj)
#pragma unroll
            for (int n = 0; n < 2; ++n) bv[bj][n] = NORM ? *(const LAS f32x4*)((const LAS float*)(aux + 2048) + wc * 32 + 8 * fq + bj * HALF + 4 * n) : (f32x4){0.f, 0.f, 0.f, 0.f};
        const LAS unsigned long long* ssl = (const LAS unsigned long long*)aux + wr * 64 + fr;
#pragma unroll
        for (int ai = 0; ai < 2; ++ai)
#pragma unroll
            for (int m = 0; m < 4; ++m) { const int row = row0 + ai * HALF + m * 16; bf16_t* rowp = O + (size_t)row * ldc + col0;
                float rs = 1.0f; if (NORM) rs = 1.0f / sqrtf((float)ssl[ai * HALF + m * 16] * (1.0f / (16777216.0f * D)) + EPS);
#pragma unroll
                for (int bj = 0; bj < 2; ++bj) { const f32x4 v0 = acc[ai][bj][m][0] * rs + bv[bj][0], v1 = acc[ai][bj][m][1] * rs + bv[bj][1];
                    u32x4 w; w.x = cvt_pk_bf16(v0[0], v0[1]); w.y = cvt_pk_bf16(v0[2], v0[3]); w.z = cvt_pk_bf16(v1[0], v1[1]); w.w = cvt_pk_bf16(v1[2], v1[3]);
                    *(u32x4*)(rowp + bj * HALF) = w; } }
    }
};
struct EpiFp8 {
    static constexpr bool PERM = true, PREFETCH = false;
    unsigned char* O; int ldc;
    __device__ __forceinline__ void operator()(const f32x4 (&acc)[2][2][4][2], const Unit& u, int wr, int wc, int fr, int fq) const {
        const int row0 = u.pm * BM + wr * 64 + fr, col0 = u.pn * BM + wc * 32 + 8 * fq;
#pragma unroll
        for (int ai = 0; ai < 2; ++ai)
#pragma unroll
            for (int m = 0; m < 4; ++m) { unsigned char* rowp = O + (size_t)(row0 + ai * HALF + m * 16) * ldc + col0;
#pragma unroll
                for (int bj = 0; bj < 2; ++bj) { const f32x4 v0 = acc[ai][bj][m][0], v1 = acc[ai][bj][m][1];
                    int w0 = 0, w1 = 0;
                    w0 = __builtin_amdgcn_cvt_pk_fp8_f32(v0[0], v0[1], w0, false); w0 = __builtin_amdgcn_cvt_pk_fp8_f32(v0[2], v0[3], w0, true);
                    w1 = __builtin_amdgcn_cvt_pk_fp8_f32(v1[0], v1[1], w1, false); w1 = __builtin_amdgcn_cvt_pk_fp8_f32(v1[2], v1[3], w1, true);
                    u32x2 w; w.x = (unsigned)w0; w.y = (unsigned)w1; *(u32x2*)(rowp + bj * HALF) = w; }
                asm volatile("" ::: "memory"); }
    }
};
struct EpiInA {
    static constexpr bool PERM = true, PREFETCH = true;
    bf16_t* Q; bf16_t* CKV; bf16_t* QI; bf16_t* KIN; float* WI; const float* kg; const float* kb; const float* shw; const unsigned long long* SS;
    __device__ __forceinline__ void prefetch(LAS unsigned char* aux, const Unit& u, int wid, int lane) const {
        if (wid < 2) __builtin_amdgcn_global_load_lds((const unsigned*)((const char*)(SS + (size_t)u.pm * BM) + wid * 1024 + lane * 16), (LAS unsigned*)(aux + wid * 1024), 16, 0, 0);
        else if (wid == 2) __builtin_amdgcn_global_load_lds((const unsigned*)((const char*)(shw + (size_t)(u.pm >> 3) * 2048 + u.pn * BM) + lane * 16), (LAS unsigned*)(aux + 2048), 16, 0, 0);
    }
    __device__ __forceinline__ void operator()(f32x4 (&acc)[2][2][4][2], const Unit& u, int wr, int wc, int fr, int fq, const LAS unsigned char* aux) const {
        const int row0 = u.pm * BM + wr * 64 + fr, cl = wc * 32 + 8 * fq;
        {
            const LAS float* sp = (const LAS float*)(aux + 2048) + cl;
            const LAS unsigned long long* ssl = (const LAS unsigned long long*)aux + wr * 64 + fr;
            f32x4 bv[2][2];
#pragma unroll
            for (int bj = 0; bj < 2; ++bj)
#pragma unroll
                for (int n = 0; n < 2; ++n) bv[bj][n] = *(const LAS f32x4*)(sp + bj * HALF + 4 * n);
#pragma unroll
            for (int ai = 0; ai < 2; ++ai)
#pragma unroll
                for (int m = 0; m < 4; ++m) { const float rs = 1.0f / sqrtf((float)ssl[ai * HALF + m * 16] * (1.0f / (16777216.0f * D)) + EPS);
#pragma unroll
                    for (int bj = 0; bj < 2; ++bj)
#pragma unroll
                        for (int n = 0; n < 2; ++n) acc[ai][bj][m][n] = acc[ai][bj][m][n] * rs + bv[bj][n]; }
        }
        if (u.pn < 7) {
            bf16_t* base; int ldc, c0;
            if (u.pn < 4) { base = Q; ldc = 1024; c0 = u.pn * 256; } else if (u.pn == 4) { base = CKV; ldc = 256; c0 = 0; } else { base = QI; ldc = 512; c0 = (u.pn - 5) * 256; }
#pragma unroll
            for (int ai = 0; ai < 2; ++ai)
#pragma unroll
                for (int m = 0; m < 4; ++m) { bf16_t* rowp = base + (size_t)(row0 + ai * HALF + m * 16) * ldc + c0 + cl;
#pragma unroll
                    for (int bj = 0; bj < 2; ++bj) { const f32x4 v0 = acc[ai][bj][m][0], v1 = acc[ai][bj][m][1];
                        u32x4 w; w.x = cvt_pk_bf16(v0[0], v0[1]); w.y = cvt_pk_bf16(v0[2], v0[3]); w.z = cvt_pk_bf16(v1[0], v1[1]); w.w = cvt_pk_bf16(v1[2], v1[3]);
                        *(u32x4*)(rowp + bj * HALF) = w; } }
        } else if (wc == 0) {
            f32x4 gv[2][2], bv[2][2];
#pragma unroll
            for (int bj = 0; bj < 2; ++bj)
#pragma unroll
                for (int n = 0; n < 2; ++n) { gv[bj][n] = *(const f32x4*)(kg + 32 * bj + 8 * fq + 4 * n); bv[bj][n] = *(const f32x4*)(kb + 32 * bj + 8 * fq + 4 * n); }
#pragma unroll
            for (int ai = 0; ai < 2; ++ai)
#pragma unroll
                for (int m = 0; m < 4; ++m) {
                    float s = 0.f;
#pragma unroll
                    for (int bj = 0; bj < 2; ++bj)
#pragma unroll
                        for (int n = 0; n < 2; ++n) { const f32x4 x = acc[ai][bj][m][n]; s += (x[0] + x[1]) + (x[2] + x[3]); }
                    s += __shfl_xor(s, 16); s += __shfl_xor(s, 32);
                    const float mu = s * (1.0f / 64.0f); float q = 0.f;
#pragma unroll
                    for (int bj = 0; bj < 2; ++bj)
#pragma unroll
                        for (int n = 0; n < 2; ++n) { const f32x4 d = acc[ai][bj][m][n] - mu; q += (d[0] * d[0] + d[1] * d[1]) + (d[2] * d[2] + d[3] * d[3]); }
                    q += __shfl_xor(q, 16); q += __shfl_xor(q, 32);
                    const float rs = 1.0f / sqrtf(q * (1.0f / 64.0f) + EPS);
                    bf16_t* rowp = KIN + (size_t)(row0 + ai * HALF + m * 16) * 64 + 8 * fq;
#pragma unroll
                    for (int bj = 0; bj < 2; ++bj) { const f32x4 v0 = (acc[ai][bj][m][0] - mu) * rs * gv[bj][0] + bv[bj][0], v1 = (acc[ai][bj][m][1] - mu) * rs * gv[bj][1] + bv[bj][1];
                        u32x4 w; w.x = cvt_pk_bf16(v0[0], v0[1]); w.y = cvt_pk_bf16(v0[2], v0[3]); w.z = cvt_pk_bf16(v1[0], v1[1]); w.w = cvt_pk_bf16(v1[2], v1[3]);
                        *(u32x4*)(rowp + bj * 32) = w; }
                }
        } else if (wc == 1 && fq == 0) {
            const float sc = 0.04419417382415922f;
#pragma unroll
            for (int ai = 0; ai < 2; ++ai)
#pragma unroll
                for (int m = 0; m < 4; ++m) { float* rowp = WI + (size_t)(row0 + ai * HALF + m * 16) * 8;
                    *(f32x4*)(rowp) = acc[ai][0][m][0] * sc; *(f32x4*)(rowp + 4) = acc[ai][0][m][1] * sc; }
        }
    }
};
struct EpiResid {
    static constexpr bool PERM = true, PREFETCH = true;
    const bf16_t* xin_b; bf16_t* xout_b;
    const float* gate; const float* bias;
    bf16_t* XG; const float* gn; const float* scn; unsigned long long* SSo;
    __device__ __forceinline__ void prefetch(LAS unsigned char* aux, const Unit& u, int wid, int lane) const {
        const int b = u.pm >> 3; const char* src = nullptr;
        if (wid == 0) src = (const char*)(gate + (size_t)b * 6144 + u.pn * BM);
        else if (wid == 1) src = bias ? (const char*)(bias + u.pn * BM) : nullptr;
        else if (wid == 2) src = XG ? (const char*)(gn + u.pn * BM) : nullptr;
        else if (wid == 3) src = XG ? (const char*)(scn + (size_t)b * 6144 + u.pn * BM) : nullptr;
        if (src) __builtin_amdgcn_global_load_lds((const unsigned*)(src + lane * 16), (LAS unsigned*)(aux + wid * 1024), 16, 0, 0);
    }
    __device__ __forceinline__ void operator()(const f32x4 (&acc)[2][2][4][2], const Unit& u, int wr, int wc, int fr, int fq, const LAS unsigned char* aux) const {
        const int row0 = u.pm * BM + wr * 64 + fr, col0 = u.pn * BM + wc * 32 + 8 * fq, b = u.pm >> 3;
        const LAS float* lv = (const LAS float*)aux + wc * 32 + 8 * fq;
        float ssum[2][4];
#pragma unroll
        for (int ai = 0; ai < 2; ++ai)
#pragma unroll
            for (int m = 0; m < 4; ++m) ssum[ai][m] = 0.f;
#pragma unroll
        for (int bj = 0; bj < 2; ++bj) {
            const int c = col0 + bj * HALF;
            const LAS float* lp = lv + bj * HALF;
            const f32x4 gv0 = *(const LAS f32x4*)(lp), gv1 = *(const LAS f32x4*)(lp + 4);
            f32x4 bv0 = (f32x4){0.f, 0.f, 0.f, 0.f}, bv1 = bv0, gm0 = bv0, gm1 = bv0;
            if (bias) { bv0 = *(const LAS f32x4*)(lp + 256); bv1 = *(const LAS f32x4*)(lp + 256 + 4); }
            if (XG) { gm0 = *(const LAS f32x4*)(lp + 512) * (*(const LAS f32x4*)(lp + 768) + 1.0f); gm1 = *(const LAS f32x4*)(lp + 512 + 4) * (*(const LAS f32x4*)(lp + 768 + 4) + 1.0f); }
#pragma unroll
            for (int ai = 0; ai < 2; ++ai)
#pragma unroll
                for (int m = 0; m < 4; ++m) { const size_t off = (size_t)(row0 + ai * HALF + m * 16) * D + c;
                    const u32x4 xv = *(const u32x4*)(xin_b + off);
                    const f32x4 xi0 = (f32x4){__uint_as_float(xv.x << 16), __uint_as_float(xv.x & 0xffff0000u), __uint_as_float(xv.y << 16), __uint_as_float(xv.y & 0xffff0000u)};
                    const f32x4 xi1 = (f32x4){__uint_as_float(xv.z << 16), __uint_as_float(xv.z & 0xffff0000u), __uint_as_float(xv.w << 16), __uint_as_float(xv.w & 0xffff0000u)};
                    const f32x4 xo0 = xi0 + gv0 * (acc[ai][bj][m][0] + bv0), xo1 = xi1 + gv1 * (acc[ai][bj][m][1] + bv1);
                    { u32x4 w; w.x = cvt_pk_bf16(xo0[0], xo0[1]); w.y = cvt_pk_bf16(xo0[2], xo0[3]); w.z = cvt_pk_bf16(xo1[0], xo1[1]); w.w = cvt_pk_bf16(xo1[2], xo1[3]); *(u32x4*)(xout_b + off) = w; }
                    if (XG) {
                        ssum[ai][m] += ((xo0[0] * xo0[0] + xo0[1] * xo0[1]) + (xo0[2] * xo0[2] + xo0[3] * xo0[3])) + ((xo1[0] * xo1[0] + xo1[1] * xo1[1]) + (xo1[2] * xo1[2] + xo1[3] * xo1[3]));
                        const f32x4 y0 = xo0 * gm0, y1 = xo1 * gm1;
                        u32x4 w; w.x = cvt_pk_bf16(y0[0], y0[1]); w.y = cvt_pk_bf16(y0[2], y0[3]); w.z = cvt_pk_bf16(y1[0], y1[1]); w.w = cvt_pk_bf16(y1[2], y1[3]);
                        *(u32x4*)(XG + off) = w; }
                    if (m & 1) asm volatile("" ::: "memory"); }
        }
        if (XG) {
#pragma unroll
            for (int ai = 0; ai < 2; ++ai)
#pragma unroll
                for (int m = 0; m < 4; ++m) { float q = ssum[ai][m]; q += __shfl_xor(q, 16); q += __shfl_xor(q, 32);
                    if (fq == 0) atomicAdd(SSo + row0 + ai * HALF + m * 16, (unsigned long long)(q * 16777216.0f)); }
        }
    }
};
struct EpiSwiGLU {
    static constexpr bool PERM = true, PREFETCH = true;
    bf16_t* H; const float* shw; const unsigned long long* SS;
    __device__ __forceinline__ void prefetch(LAS unsigned char* aux, const Unit& u, int wid, int lane) const {
        if (wid < 2) __builtin_amdgcn_global_load_lds((const unsigned*)((const char*)(SS + (size_t)u.pm * BM) + wid * 1024 + lane * 16), (LAS unsigned*)(aux + wid * 1024), 16, 0, 0);
        else if (wid == 2) __builtin_amdgcn_global_load_lds((const unsigned*)((const char*)(shw + (size_t)(u.pm >> 3) * (2 * DFF) + u.pn * BM) + lane * 16), (LAS unsigned*)(aux + 2048), 16, 0, 0);
    }
    __device__ __forceinline__ void operator()(const f32x4 (&acc)[2][2][4][2], const Unit& u, int wr, int wc, int fr, int fq, const LAS unsigned char* aux) const {
        const int row0 = u.pm * BM + wr * 64 + fr, f0 = u.pn * 128 + wc * 32 + 8 * fq;
        f32x4 bv[2][2];
        { const LAS float* sp = (const LAS float*)(aux + 2048) + wc * 32 + 8 * fq;
#pragma unroll
          for (int bj = 0; bj < 2; ++bj)
#pragma unroll
              for (int n = 0; n < 2; ++n) bv[bj][n] = *(const LAS f32x4*)(sp + bj * HALF + 4 * n); }
        const LAS unsigned long long* ssl = (const LAS unsigned long long*)aux + wr * 64 + fr;
#pragma unroll
        for (int ai = 0; ai < 2; ++ai)
#pragma unroll
            for (int m = 0; m < 4; ++m) { bf16_t* rowp = H + (size_t)(row0 + ai * HALF + m * 16) * DFF + f0;
                const float rs = 1.0f / sqrtf((float)ssl[ai * HALF + m * 16] * (1.0f / (16777216.0f * D)) + EPS);
                float o[8];
#pragma unroll
                for (int n = 0; n < 2; ++n)
#pragma unroll
                    for (int e = 0; e < 4; ++e) o[4 * n + e] = silu_f(acc[ai][0][m][n][e] * rs + bv[0][n][e]) * (acc[ai][1][m][n][e] * rs + bv[1][n][e]);
                u32x4 w; w.x = cvt_pk_bf16(o[0], o[1]); w.y = cvt_pk_bf16(o[2], o[3]); w.z = cvt_pk_bf16(o[4], o[5]); w.w = cvt_pk_bf16(o[6], o[7]);
                *(u32x4*)(rowp) = w; }
    }
};
}

struct Ptrs {
    const float* in[23]; float* out; unsigned char* ws;
};
enum { I_X = 0, I_C, I_RELB, I_WADA, I_BADA, I_GMIX, I_GFFN, I_AWIN, I_AKVG, I_AWUK, I_AWUV, I_AIKG, I_AIKB, I_AWOUT, I_BWIN, I_BBIN, I_BSINK, I_BWOUT, I_BBOUT, I_W1, I_W3, I_W2, I_GFIN };

__device__ __forceinline__ void conv_task(const Ptrs& P, int t, int lane) {
    int kind, rb, ks, Kd; bf16_t* dst; const float* s0 = nullptr; const float* s1 = nullptr; const float* gk = nullptr; int ld = 0;
    if (t < 2112) { const int l = t / 528, r = t % 528; unsigned char* wl = P.ws + WS_W + (size_t)l * W_LAYER;
        if (r < 352) { kind = 1; rb = r >> 2; ks = r & 3; Kd = 1024; dst = (bf16_t*)(wl + W13_OFF); s0 = P.in[I_W1] + (size_t)l * D * DFF; s1 = P.in[I_W3] + (size_t)l * D * DFF; ld = DFF; }
        else { const int r2 = r - 352; kind = 0; rb = r2 / 11; ks = r2 % 11; Kd = DFF; dst = (bf16_t*)(wl + W2_OFF); s0 = P.in[I_W2] + (size_t)l * DFF * D; ld = D; }
    } else { const int t2 = t - 2112, j = t2 / 464, r = t2 % 464; unsigned char* wa = P.ws + WS_WA + (size_t)j * WA_STRIDE; unsigned char* wb = P.ws + WS_WB + (size_t)j * WB_STRIDE;
        if (r < 128) { kind = 2; rb = r >> 2; ks = r & 3; Kd = 1024; dst = (bf16_t*)(wa + WINA_OFF); s0 = P.in[I_AWIN] + (size_t)j * D * A_IN; ld = A_IN; }
        else if (r < 192) { kind = 3; rb = r - 128; ks = 0; Kd = 256; dst = (bf16_t*)(wa + WQA_OFF); s0 = P.in[I_AWUK] + (size_t)j * NH * RK * HD; gk = P.in[I_AKVG] + j * RK; }
        else if (r < 256) { const int r2 = r - 192; kind = 4; rb = r2 >> 2; ks = r2 & 3; Kd = 1024; dst = (bf16_t*)(wa + WUV_OFF); s0 = P.in[I_AWUV] + (size_t)j * NH * RK * HD; gk = P.in[I_AKVG] + j * RK; }
        else if (r < 320) { const int r2 = r - 256; kind = 0; rb = r2 >> 2; ks = r2 & 3; Kd = 1024; dst = (bf16_t*)(wa + WOUTA_OFF); s0 = P.in[I_AWOUT] + (size_t)j * D * D; ld = D; }
        else if (r < 400) { const int r2 = r - 320; kind = 0; rb = r2 >> 2; ks = r2 & 3; Kd = 1024; dst = (bf16_t*)(wb + WINB_OFF); s0 = P.in[I_BWIN] + (size_t)j * D * B_IN; ld = B_IN; }
        else { const int r2 = r - 400; kind = 0; rb = r2 >> 2; ks = r2 & 3; Kd = 1024; dst = (bf16_t*)(wb + WOUTB_OFF); s0 = P.in[I_BWOUT] + (size_t)j * D * D; ld = D; }
    }
    const int n = rb * 64 + lane, k0 = ks * 256;
    bf16_t* drow = dst + (size_t)n * Kd + k0;
    if (kind <= 2) {
        const float* src = s0; int col = n;
        if (kind == 1) { const int c = n & 255, f = (n >> 8) * 128 + (c & 127); src = (c < 128) ? s0 : s1; col = f; }
        if (kind == 2) { if (n >= 1792) { const int c = n - 1792; col = c < 32 ? 1792 + c : (c < 40 ? 1856 + (c - 32) : ((c >= 128 && c < 160) ? 1824 + (c - 128) : -1)); } }
        const float* sp = src + (size_t)k0 * ld + (col < 0 ? 0 : col);
        for (int kc = 0; kc < 32; ++kc) {
            float v[8];
#pragma unroll
            for (int e = 0; e < 8; ++e) v[e] = sp[(size_t)(kc * 8 + e) * ld];
            if (col < 0) {
#pragma unroll
                for (int e = 0; e < 8; ++e) v[e] = 0.f; }
            u32x4 w; w.x = cvt_pk_bf16(v[0], v[1]); w.y = cvt_pk_bf16(v[2], v[3]); w.z = cvt_pk_bf16(v[4], v[5]); w.w = cvt_pk_bf16(v[6], v[7]);
            *(u32x4*)(drow + kc * 8) = w;
        }
    } else if (kind == 3) {
        const int h = n >> 8, r = n & 255; const float gs = gk[r] * 8.0f;       const float* sp = s0 + ((size_t)h * RK + r) * HD;
        for (int kc = 0; kc < 32; ++kc) { const int k = kc * 8; float v[8];
            if ((k >> 6) == (h & 3)) {
#pragma unroll
                for (int e = 0; e < 8; ++e) v[e] = sp[(k & 63) + e] * gs;
            } else {
#pragma unroll
                for (int e = 0; e < 8; ++e) v[e] = 0.f; }
            u32x4 w; w.x = cvt_pk_bf16(v[0], v[1]); w.y = cvt_pk_bf16(v[2], v[3]); w.z = cvt_pk_bf16(v[4], v[5]); w.w = cvt_pk_bf16(v[6], v[7]);
            *(u32x4*)(drow + kc * 8) = w; }
    } else {
        const int hh = (n >> 6) & 3, d = n & 63, h = n >> 6;
        for (int kc = 0; kc < 32; ++kc) { const int k = k0 + kc * 8; float v[8];
            if ((k >> 8) == hh) {
#pragma unroll
                for (int e = 0; e < 8; ++e) { const int r = (k & 255) + e; v[e] = s0[((size_t)h * RK + r) * HD + d] * gk[r]; }
            } else {
#pragma unroll
                for (int e = 0; e < 8; ++e) v[e] = 0.f; }
            u32x4 w; w.x = cvt_pk_bf16(v[0], v[1]); w.y = cvt_pk_bf16(v[2], v[3]); w.z = cvt_pk_bf16(v[4], v[5]); w.w = cvt_pk_bf16(v[6], v[7]);
            *(u32x4*)(drow + kc * 8) = w; }
    }
}
constexpr int N_CONV_TASKS = 3040;

__device__ __forceinline__ void p0_prologue(const Ptrs& P, LAS unsigned char* lds, int G) {
    int tid = threadIdx.x; asm volatile("" : "+v"(tid));
    const int lane = tid & 63, wave = __builtin_amdgcn_readfirstlane(tid >> 6);
    const int gw = blockIdx.x * NWAVES + wave, NGW = G * NWAVES;
    for (int t = gw; t < N_CONV_TASKS; t += NGW) conv_task(P, t, lane);
    LAS float* cs = (LAS float*)lds;
    LAS float* red = (LAS float*)(lds + 65536);
    for (int i = tid; i < BATCH * D; i += NTHR) { const int b = i >> 10, k = i & 1023; cs[k * 16 + b] = silu_f(P.in[I_C][i]); }
    __syncthreads();
    float* mod = (float*)(P.ws + WS_MOD);
    for (int task = blockIdx.x; task < 4 * 96; task += G) {
        const int l = task / 96, j0 = (task % 96) * 64, col = tid & 63, ksl = tid >> 6;
        const float* wp = P.in[I_WADA] + ((size_t)l * D + ksl * 128) * 6144 + j0 + col;
        float a[16];
#pragma unroll
        for (int b = 0; b < 16; ++b) a[b] = 0.f;
        for (int k = 0; k < 128; ++k) { const float w = wp[(size_t)k * 6144]; const LAS f32x4* c4 = (const LAS f32x4*)(cs + (ksl * 128 + k) * 16);
#pragma unroll
            for (int q = 0; q < 4; ++q) { const f32x4 c = c4[q];
#pragma unroll
                for (int e = 0; e < 4; ++e) a[4 * q + e] += w * c[e]; } }
#pragma unroll
        for (int b = 0; b < 16; ++b) red[(ksl * 64 + col) * 16 + b] = a[b];
        __syncthreads();
        for (int o = tid; o < 1024; o += NTHR) { const int c2 = o >> 4, b = o & 15; float s = 0.f;
#pragma unroll
            for (int q = 0; q < 8; ++q) s += red[(q * 64 + c2) * 16 + b];
            mod[((size_t)l * BATCH + b) * 6144 + j0 + c2] = s + P.in[I_BADA][l * 6144 + j0 + c2]; }
        __syncthreads();
    }
}

__device__ __forceinline__ void pre_phase(const Ptrs& P, LAS unsigned char* lds, int G) {
    int tid = threadIdx.x; asm volatile("" : "+v"(tid));
    const int lane = tid & 63, wave = __builtin_amdgcn_readfirstlane(tid >> 6);
    const float* mod = (const float*)(P.ws + WS_MOD);
    {
        const int grp = blockIdx.x & 7, l = grp >> 1, kind = grp & 1, j = l >> 1;
        const float* shsrc = mod + (size_t)l * BATCH * 6144 + (kind ? 3072 : 0);
        constexpr int SP = 2064;
        for (int i = tid; i < BATCH * D / 2; i += NTHR) { const int b = i >> 9, k2 = (i & 511) * 2;
            const float a0 = shsrc[(size_t)b * 6144 + k2], a1 = shsrc[(size_t)b * 6144 + k2 + 1];
            *(LAS unsigned*)(lds + b * SP + k2 * 2) = cvt_pk_bf16(a0, a1); }
        __syncthreads();
        const bf16_t* W; int nrows; float* dst; const float* bias = nullptr;
        if (kind) { W = (const bf16_t*)(P.ws + WS_W + (size_t)l * W_LAYER + W13_OFF); nrows = 2 * DFF; dst = (float*)(P.ws + WS_SHW + SHW_F) + (size_t)l * BATCH * 2 * DFF; }
        else if ((l & 1) == 0) { W = (const bf16_t*)(P.ws + WS_WA + (size_t)j * WA_STRIDE + WINA_OFF); nrows = 2048; dst = (float*)(P.ws + WS_SHW + SHW_A) + (size_t)j * BATCH * 2048; }
        else { W = (const bf16_t*)(P.ws + WS_WB + (size_t)j * WB_STRIDE + WINB_OFF); nrows = B_IN; dst = (float*)(P.ws + WS_SHW + SHW_B) + (size_t)j * BATCH * B_IN; bias = P.in[I_BBIN] + j * B_IN; }
        const int nblk = nrows >> 4, wq = (blockIdx.x >> 3) * NWAVES + wave, nwq = (G >> 3) * NWAVES;
        const int nn = lane & 15, g = lane >> 4;
        for (int blk = wq; blk < nblk; blk += nwq) {
            f32x4 acc = (f32x4){0.f, 0.f, 0.f, 0.f};
            const bf16_t* wp = W + (size_t)(blk * 16 + nn) * D + 8 * g;
#pragma unroll 8
            for (int ks = 0; ks < 32; ++ks) { const bf16x8 a = *(const LAS bf16x8*)(lds + nn * SP + (32 * ks + 8 * g) * 2); const bf16x8 bw = *(const bf16x8*)(wp + 32 * ks);
                acc = __builtin_amdgcn_mfma_f32_16x16x32_bf16(a, bw, acc, 0, 0, 0); }
            const int n = blk * 16 + nn; const float bb = bias ? bias[n] : 0.f;
#pragma unroll
            for (int i = 0; i < 4; ++i) dst[(size_t)(4 * g + i) * nrows + n] = acc[i] + bb;
        }
    }
    {
        const int gw = blockIdx.x * NWAVES + wave, NGW = G * NWAVES;
        const float* x = P.in[I_X]; const float* gmix = P.in[I_GMIX]; bf16_t* XG = (bf16_t*)(P.ws + WS_XG); unsigned long long* SS0 = (unsigned long long*)(P.ws + WS_SS);
        for (int row = gw; row < M; row += NGW) {
            const int b = row >> 11;
            const f32x4* xr = (const f32x4*)(x + (size_t)row * D) + lane;
            f32x4 v[4]; float sq = 0.f;
#pragma unroll
            for (int jj = 0; jj < 4; ++jj) { v[jj] = xr[64 * jj]; sq += (v[jj][0] * v[jj][0] + v[jj][1] * v[jj][1]) + (v[jj][2] * v[jj][2] + v[jj][3] * v[jj][3]); }
            const float ss = wave_sum(sq);
            if (lane == 0) SS0[row] = (unsigned long long)(ss * 16777216.0f);
            const float* mb = mod + (size_t)b * 6144;
            u32x2* o8 = (u32x2*)(XG + (size_t)row * D) + lane; u32x2* x8 = (u32x2*)((bf16_t*)P.out + (size_t)row * D) + lane;
#pragma unroll
            for (int jj = 0; jj < 4; ++jj) { const int c = 4 * lane + 256 * jj;
                const f32x4 y = v[jj] * *(const f32x4*)(gmix + c) * (*(const f32x4*)(mb + 1024 + c) + 1.0f);
                u32x2 w; w.x = cvt_pk_bf16(y[0], y[1]); w.y = cvt_pk_bf16(y[2], y[3]); o8[64 * jj] = w;
                u32x2 xw; xw.x = cvt_pk_bf16(v[jj][0], v[jj][1]); xw.y = cvt_pk_bf16(v[jj][2], v[jj][3]); x8[64 * jj] = xw; }
        }
    }
}
__device__ __forceinline__ void final_norm_phase(const bf16_t* x, float* out, const float* g, int G) {
    int tid = threadIdx.x; asm volatile("" : "+v"(tid));
    const int lane = tid & 63, wave = __builtin_amdgcn_readfirstlane(tid >> 6);
    const int gw = blockIdx.x * NWAVES + wave, NGW = G * NWAVES;
    for (int row = gw; row < M; row += NGW) {
        const u32x2* xr = (const u32x2*)(x + (size_t)row * D) + lane; f32x4* orow = (f32x4*)(out + (size_t)row * D) + lane;
        f32x4 v[4]; float s = 0.f;
#pragma unroll
        for (int j = 0; j < 4; ++j) { const u32x2 p = xr[64 * j];
            v[j] = (f32x4){__uint_as_float(p.x << 16), __uint_as_float(p.x & 0xffff0000u), __uint_as_float(p.y << 16), __uint_as_float(p.y & 0xffff0000u)};
            s += (v[j][0] * v[j][0] + v[j][1] * v[j][1]) + (v[j][2] * v[j][2] + v[j][3] * v[j][3]); }
        const float rstd = 1.0f / sqrtf(wave_sum(s) * (1.0f / D) + EPS);
#pragma unroll
        for (int j = 0; j < 4; ++j) { const f32x4 gg = *(const f32x4*)(g + 4 * lane + 256 * j); orow[64 * j] = v[j] * rstd * gg; }
    }
}

__device__ __forceinline__ unsigned f2key(float f) { const unsigned u = __float_as_uint(f); return (u & 0x80000000u) ? ~u : (u | 0x80000000u); }
__device__ __forceinline__ float key2f(unsigned k) { return __uint_as_float((k & 0x80000000u) ? (k & 0x7fffffffu) : ~k); }
__device__ __forceinline__ float half_max(float x) {
    int u = __float_as_int(x);
    u = __float_as_int(fmaxf(__int_as_float(u), __int_as_float(__builtin_amdgcn_update_dpp(u, u, 0x128, 0xf, 0xf, false))));
    u = __float_as_int(fmaxf(__int_as_float(u), __int_as_float(__builtin_amdgcn_update_dpp(u, u, 0x124, 0xf, 0xf, false))));
    u = __float_as_int(fmaxf(__int_as_float(u), __int_as_float(__builtin_amdgcn_update_dpp(u, u, 0x122, 0xf, 0xf, false))));
    u = __float_as_int(fmaxf(__int_as_float(u), __int_as_float(__builtin_amdgcn_update_dpp(u, u, 0x121, 0xf, 0xf, false))));
    const u32x2 r = __builtin_amdgcn_permlane16_swap((unsigned)u, (unsigned)u, false, false);
    return fmaxf(__uint_as_float(r.x), __uint_as_float(r.y));
}
__device__ __forceinline__ float half_sum_f(float v) {
    v += __int_as_float(__builtin_amdgcn_update_dpp(__float_as_int(v), __float_as_int(v), 0x128, 0xf, 0xf, false));
    v += __int_as_float(__builtin_amdgcn_update_dpp(__float_as_int(v), __float_as_int(v), 0x124, 0xf, 0xf, false));
    v += __int_as_float(__builtin_amdgcn_update_dpp(__float_as_int(v), __float_as_int(v), 0x122, 0xf, 0xf, false));
    v += __int_as_float(__builtin_amdgcn_update_dpp(__float_as_int(v), __float_as_int(v), 0x121, 0xf, 0xf, false));
    const u32x2 r = __builtin_amdgcn_permlane16_swap(__float_as_uint(v), __float_as_uint(v), false, false);
    return __uint_as_float(r.x) + __uint_as_float(r.y);
}
__device__ __forceinline__ f32x2 pk_gt(f32x2 x, f32x2 big, f32x2 nfbig) { f32x2 d; asm("v_pk_fma_f32 %0, %1, %2, %3 clamp" : "=v"(d) : "v"(x), "v"(big), "v"(nfbig)); return d; }
__device__ __forceinline__ int half_sum(int v) {
    v += __builtin_amdgcn_update_dpp(v, v, 0x128, 0xf, 0xf, false);
    v += __builtin_amdgcn_update_dpp(v, v, 0x124, 0xf, 0xf, false);
    v += __builtin_amdgcn_update_dpp(v, v, 0x122, 0xf, 0xf, false);
    v += __builtin_amdgcn_update_dpp(v, v, 0x121, 0xf, 0xf, false);
    const u32x2 r = __builtin_amdgcn_permlane16_swap((unsigned)v, (unsigned)v, false, false);
    return (int)(r.x + r.y);
}
typedef float f32x32 __attribute__((ext_vector_type(32)));
__device__ __forceinline__ void idx_task(const bf16_t* QI, const bf16_t* KIN, const float* WI, unsigned* SEL, LAS unsigned char* lds, int b, int tg, int lane, int wave, bool active, int nrounds) {
    asm volatile("" : "+v"(lane));
    const int t0 = tg * 4, h = lane >> 5, r = lane & 31;
    const int qsel = 2 * (r >> 4) + ((r >> 2) & 1), hd = (r & 3) + 4 * ((r >> 3) & 1);
    const size_t rowb = (size_t)b * SEQ;
    bf16x8 aq[4];
#pragma unroll
    for (int ks = 0; ks < 4; ++ks) aq[ks] = *(const bf16x8*)(QI + (rowb + t0 + qsel) * 512 + hd * 64 + ks * 16 + h * 8);
    float wlo[8], whi[8];
    { const f32x4 a0 = *(const f32x4*)(WI + (rowb + t0 + h) * 8), a1 = *(const f32x4*)(WI + (rowb + t0 + h) * 8 + 4);
      const f32x4 b0 = *(const f32x4*)(WI + (rowb + t0 + 2 + h) * 8), b1 = *(const f32x4*)(WI + (rowb + t0 + 2 + h) * 8 + 4);
#pragma unroll
      for (int e = 0; e < 4; ++e) { wlo[e] = a0[e]; wlo[4 + e] = a1[e]; whi[e] = b0[e]; whi[4 + e] = b1[e]; } }
    f32x32 sA0, sA1, sB0, sB1;
#pragma unroll
    for (int i = 0; i < 32; ++i) { sA0[i] = NEGF; sA1[i] = NEGF; sB0[i] = NEGF; sB1[i] = NEGF; }
    const int ktmax = (t0 + 3) >> 5, tlo = t0 + h, thi = t0 + 2 + h;
    const unsigned lb = (unsigned)(size_t)lds;
    const int sw = (r >> 1) & 7;
#define IDX_LDS4(R0, R1, R2, R3) asm volatile("ds_read_b128 %0, %4\n\tds_read_b128 %1, %5\n\tds_read_b128 %2, %6\n\tds_read_b128 %3, %7" \
                                             : "=&v"(R0), "=&v"(R1), "=&v"(R2), "=&v"(R3) : "v"(a0), "v"(a1), "v"(a2), "v"(a3) : "memory")
#define IDX_TILE(KTL, KEY0, SA, SB, C0, C1, C2, C3, N0, N1, N2, N3) \
        { \
            a0 += 4096u; a1 += 4096u; a2 += 4096u; a3 += 4096u; \
            IDX_LDS4(N0, N1, N2, N3);                          \
            asm volatile("s_waitcnt lgkmcnt(4)" : "+v"(C0), "+v"(C1), "+v"(C2), "+v"(C3) :: "memory");     \
            f32x16 acc; \
            _Pragma("unroll") for (int i = 0; i < 16; ++i) acc[i] = 0.f; \
            acc = __builtin_amdgcn_mfma_f32_32x32x16_bf16(aq[0], C0, acc, 0, 0, 0); acc = __builtin_amdgcn_mfma_f32_32x32x16_bf16(aq[1], C1, acc, 0, 0, 0); \
            acc = __builtin_amdgcn_mfma_f32_32x32x16_bf16(aq[2], C2, acc, 0, 0, 0); acc = __builtin_amdgcn_mfma_f32_32x32x16_bf16(aq[3], C3, acc, 0, 0, 0); \
            f32x2 p0 = (f32x2){0.f, 0.f}, p1 = (f32x2){0.f, 0.f};            \
            _Pragma("unroll") for (int i = 0; i < 4; ++i) { \
                const f32x2 r0 = (f32x2){__builtin_amdgcn_fmed3f(acc[2 * i], 0.f, 3.0e38f), __builtin_amdgcn_fmed3f(acc[2 * i + 1], 0.f, 3.0e38f)}; \
                const f32x2 r1 = (f32x2){__builtin_amdgcn_fmed3f(acc[8 + 2 * i], 0.f, 3.0e38f), __builtin_amdgcn_fmed3f(acc[9 + 2 * i], 0.f, 3.0e38f)}; \
                p0 = __builtin_elementwise_fma((f32x2){wlo[2 * i], wlo[2 * i + 1]}, r0, p0); p1 = __builtin_elementwise_fma((f32x2){whi[2 * i], whi[2 * i + 1]}, r1, p1); } \
            const float s0 = p0.x + p0.y, s1 = p1.x + p1.y; \
            const int key = (KEY0) + r; \
            SA[KTL] = key <= tlo ? s0 : NEGF; SB[KTL] = key <= thi ? s1 : NEGF; \
        }
    bf16x8 ta0, ta1, ta2, ta3, tb0, tb1, tb2, tb3;
#pragma unroll
    for (int rnd = 0; rnd < 2; ++rnd) {
        if (rnd >= nrounds) break;
        __syncthreads();
        {
            const int rl = lane >> 3, pp = lane & 7;
#pragma unroll 4
            for (int j = 0; j < 16; ++j) { const int pi = wave * 16 + j, row = 8 * pi + rl;
                const bf16_t* src = KIN + (rowb + 1024 * rnd + row) * 64 + 8 * (pp ^ ((row >> 1) & 7));
                __builtin_amdgcn_global_load_lds((const unsigned*)src, (LAS unsigned*)(lds + 1024 * pi), 16, 0, 0); }
        }
        asm volatile("s_waitcnt vmcnt(0)" ::: "memory");
        __syncthreads();
        const int ntl = ktmax - 32 * rnd + 1;
        if (active && ntl > 0) {
            const int npair = ((ntl < 32 ? ntl : 32) + 1) >> 1;
            unsigned a0 = lb + (unsigned)r * 128u + 16u * (unsigned)((0 + h) ^ sw), a1 = lb + (unsigned)r * 128u + 16u * (unsigned)((2 + h) ^ sw);
            unsigned a2 = lb + (unsigned)r * 128u + 16u * (unsigned)((4 + h) ^ sw), a3 = lb + (unsigned)r * 128u + 16u * (unsigned)((6 + h) ^ sw);
            IDX_LDS4(ta0, ta1, ta2, ta3);
#pragma nounroll
            for (int kp = 0; kp < npair; ++kp) {
                if (rnd == 0) { IDX_TILE(2 * kp, 64 * kp, sA0, sB0, ta0, ta1, ta2, ta3, tb0, tb1, tb2, tb3)
                                IDX_TILE(2 * kp + 1, 64 * kp + 32, sA0, sB0, tb0, tb1, tb2, tb3, ta0, ta1, ta2, ta3) }
                else          { IDX_TILE(2 * kp, 1024 + 64 * kp, sA1, sB1, ta0, ta1, ta2, ta3, tb0, tb1, tb2, tb3)
                                IDX_TILE(2 * kp + 1, 1024 + 64 * kp + 32, sA1, sB1, tb0, tb1, tb2, tb3, ta0, ta1, ta2, ta3) }
            }
            asm volatile("s_waitcnt lgkmcnt(0)" : "+v"(ta0), "+v"(ta1), "+v"(ta2), "+v"(ta3), "+v"(tb0), "+v"(tb1), "+v"(tb2), "+v"(tb3) :: "memory");
        }
    }
#undef IDX_TILE
#undef IDX_LDS4
    if (!active) return;
    const int nt0 = ktmax < 31 ? ktmax + 1 : 32, nt1 = ktmax - 31;
    float mxA = NEGF, mxB = NEGF, mnA = -NEGF, mnB = -NEGF;
#pragma nounroll
    for (int kt = 0; kt < nt0; ++kt) { const float a = sA0[kt], bb = sB0[kt];
        mxA = fmaxf(mxA, a); mxB = fmaxf(mxB, bb); mnA = fminf(mnA, a > -1e29f ? a : -NEGF); mnB = fminf(mnB, bb > -1e29f ? bb : -NEGF); }
#pragma nounroll
    for (int kt = 0; kt < nt1; ++kt) { const float a = sA1[kt], bb = sB1[kt];
        mxA = fmaxf(mxA, a); mxB = fmaxf(mxB, bb); mnA = fminf(mnA, a > -1e29f ? a : -NEGF); mnB = fminf(mnB, bb > -1e29f ? bb : -NEGF); }
    mxA = half_max(mxA); mxB = half_max(mxB); mnA = -half_max(-mnA); mnB = -half_max(-mnB);
    const int Ka = tlo + 1 < TOPK ? tlo + 1 : TOPK, Kb = thi + 1 < TOPK ? thi + 1 : TOPK;
    float loA = mnA - (fabsf(mnA) * 1e-6f + 1e-30f), hiA = mxA, loB = mnB - (fabsf(mnB) * 1e-6f + 1e-30f), hiB = mxB;
    float cloA = (float)(tlo + 1), chiA = 0.0f, cloB = (float)(thi + 1), chiB = 0.0f;
    float TA = -1e29f, TB = -1e29f; bool doneA = (tlo + 1 <= TOPK), doneB = (thi + 1 <= TOPK);
    const int nblk = (ktmax >> 3) + 1;
    const float BIG = 1099511627776.0f;
#define SA2(i) ((i) < 32 ? (f32x2){sA0[(i) & 31], sA0[((i) & 31) + 1]} : (f32x2){sA1[(i) & 31], sA1[((i) & 31) + 1]})
#define SB2(i) ((i) < 32 ? (f32x2){sB0[(i) & 31], sB0[((i) & 31) + 1]} : (f32x2){sB1[(i) & 31], sB1[((i) & 31) + 1]})
#pragma nounroll
    for (int it = 0; it < 48; ++it) {
        if (__ballot(!doneA || !doneB) == 0ull) break;
        const bool bis = (it % 3) == 2;
        const float wA = hiA - loA, wB = hiB - loB;
        float rA = bis ? 0.5f : (cloA - (float)Ka + 0.5f) / (cloA - chiA), rB = bis ? 0.5f : (cloB - (float)Kb + 0.5f) / (cloB - chiB);
        rA = fminf(fmaxf(rA, 0.03f), 0.97f); rB = fminf(fmaxf(rB, 0.03f), 0.97f);
        const float midA = loA + wA * rA, midB = loB + wB * rB;
        const float fA = doneA ? TA : midA, fB = doneB ? TB : midB;
        const f32x2 bigp = (f32x2){BIG, BIG}, nfA = (f32x2){-fA * BIG, -fA * BIG}, nfB = (f32x2){-fB * BIG, -fB * BIG};
        f32x2 cA2 = (f32x2){0.f, 0.f}, cB2 = (f32x2){0.f, 0.f};
#pragma unroll
        for (int blk = 0; blk < 8; ++blk) {
            if (blk < nblk) {
#pragma unroll
                for (int e = 0; e < 4; ++e) { cA2 += pk_gt(SA2(8 * blk + 2 * e), bigp, nfA); cB2 += pk_gt(SB2(8 * blk + 2 * e), bigp, nfB); }
            }
        }
        const int cA = (int)half_sum_f(cA2.x + cA2.y), cB = (int)half_sum_f(cB2.x + cB2.y);
        const bool stuckA = !(midA > loA && midA < hiA), stuckB = !(midB > loB && midB < hiB);
        if (!doneA) { if (cA == Ka) { TA = fA; doneA = true; } else if (stuckA) { TA = loA; doneA = true; } else if (cA > Ka) { loA = midA; cloA = (float)cA; } else { hiA = midA; chiA = (float)cA; } }
        if (!doneB) { if (cB == Kb) { TB = fB; doneB = true; } else if (stuckB) { TB = loB; doneB = true; } else if (cB > Kb) { loB = midB; cloB = (float)cB; } else { hiB = midB; chiB = (float)cB; } }
    }
#undef SA2
#undef SB2
    if (!doneA) TA = loA;
    if (!doneB) TB = loB;
    unsigned w0 = 0u, w1 = 0u, w2 = 0u, w3 = 0u;
#pragma nounroll
    for (int kt = 0; kt < nt0; ++kt) { const unsigned long long ma = __ballot(sA0[kt] > TA), mb = __ballot(sB0[kt] > TB);
        if (lane == kt) { w0 = (unsigned)ma; w1 = (unsigned)(ma >> 32); w2 = (unsigned)mb; w3 = (unsigned)(mb >> 32); } }
#pragma nounroll
    for (int kt = 0; kt < nt1; ++kt) { const unsigned long long ma = __ballot(sA1[kt] > TA), mb = __ballot(sB1[kt] > TB);
        if (lane == 32 + kt) { w0 = (unsigned)ma; w1 = (unsigned)(ma >> 32); w2 = (unsigned)mb; w3 = (unsigned)(mb >> 32); } }
    SEL[(rowb + t0 + 0) * 64 + lane] = w0; SEL[(rowb + t0 + 1) * 64 + lane] = w1; SEL[(rowb + t0 + 2) * 64 + lane] = w2; SEL[(rowb + t0 + 3) * 64 + lane] = w3;
}

#define ATT_F(r) (((r) & 3) | ((((r) >> 3) & 3) << 2))
#define TRB8(OFS, r0, r1, r2, r3, r4, r5, r6, r7, a0, a1, a2, a3, a4, a5, a6, a7) \
    asm volatile("ds_read_b64_tr_b16 %0, %8 offset:" OFS "\n\tds_read_b64_tr_b16 %1, %9 offset:" OFS "\n\tds_read_b64_tr_b16 %2, %10 offset:" OFS "\n\tds_read_b64_tr_b16 %3, %11 offset:" OFS "\n\t" \
                 "ds_read_b64_tr_b16 %4, %12 offset:" OFS "\n\tds_read_b64_tr_b16 %5, %13 offset:" OFS "\n\tds_read_b64_tr_b16 %6, %14 offset:" OFS "\n\tds_read_b64_tr_b16 %7, %15 offset:" OFS "\n\ts_waitcnt lgkmcnt(0)" \
                 : "=&v"(r0), "=&v"(r1), "=&v"(r2), "=&v"(r3), "=&v"(r4), "=&v"(r5), "=&v"(r6), "=&v"(r7) \
                 : "v"(a0), "v"(a1), "v"(a2), "v"(a3), "v"(a4), "v"(a5), "v"(a6), "v"(a7) : "memory")
#define RDK8(OFS, r, a) \
    asm volatile("ds_read_b64 %0, %8 offset:" OFS "\n\tds_read_b64 %1, %9 offset:" OFS "\n\tds_read_b64 %2, %10 offset:" OFS "\n\tds_read_b64 %3, %11 offset:" OFS "\n\t" \
                 "ds_read_b64 %4, %12 offset:" OFS "\n\tds_read_b64 %5, %13 offset:" OFS "\n\tds_read_b64 %6, %14 offset:" OFS "\n\tds_read_b64 %7, %15 offset:" OFS "\n\ts_waitcnt lgkmcnt(0)" \
                 : "=&v"(r[0]), "=&v"(r[1]), "=&v"(r[2]), "=&v"(r[3]), "=&v"(r[4]), "=&v"(r[5]), "=&v"(r[6]), "=&v"(r[7]) \
                 : "v"(a[0]), "v"(a[1]), "v"(a[2]), "v"(a[3]), "v"(a[4]), "v"(a[5]), "v"(a[6]), "v"(a[7]) : "memory")
__device__ __forceinline__ float rows_max(float x) {
    unsigned u = __float_as_uint(x);
    u32x2 r = __builtin_amdgcn_permlane16_swap(u, u, false, false);
    u = __float_as_uint(fmaxf(__uint_as_float(r.x), __uint_as_float(r.y)));
    r = __builtin_amdgcn_permlane32_swap(u, u, false, false);
    return fmaxf(__uint_as_float(r.x), __uint_as_float(r.y));
}
__device__ __forceinline__ float rows_sum(float x) {
    unsigned u = __float_as_uint(x);
    u32x2 r = __builtin_amdgcn_permlane16_swap(u, u, false, false);
    u = __float_as_uint(__uint_as_float(r.x) + __uint_as_float(r.y));
    r = __builtin_amdgcn_permlane32_swap(u, u, false, false);
    return __uint_as_float(r.x) + __uint_as_float(r.y);
}

__device__ __forceinline__ int att_build_list(LAS unsigned* list, const LAS unsigned* btab, unsigned w, int t, int lane) {
    const int pc = __popc(w); int incl = pc;
#pragma unroll
    for (int o = 1; o < 64; o <<= 1) { const int v = __shfl_up(incl, o); if (lane >= o) incl += v; }
    const int total = __shfl(incl, 63); const int cnt = total < TOPK ? total : TOPK;
    int off = incl - pc;
    while (w) { const int bit = __builtin_ctz(w); w &= w - 1u;
        if (off < TOPK) { const int idx = 32 * lane + bit; int dd = t - idx; dd = dd < 0 ? 0 : (dd > 128 ? 128 : dd); list[off] = (unsigned)idx | (btab[dd] << 16); }
        ++off; }
    for (int sl = cnt + lane; sl < ((cnt + 31) & ~31); sl += 64) list[sl] = 0u;
    return cnt;
}
__device__ __forceinline__ void att_gather32(const unsigned char* CKV8b, const LAS unsigned* list32, LAS unsigned char* slot, int lane) {
    const LAS unsigned* lp = list32 + (lane >> 4);
    unsigned idx[8];
#pragma unroll
    for (int i = 0; i < 8; ++i) idx[i] = lp[4 * i] & 0xffffu;
#pragma unroll
    for (int i = 0; i < 8; ++i) {
        const int rr = 4 * i + (lane >> 4);
        const unsigned char* src = CKV8b + (size_t)idx[i] * RK + 16 * ((lane & 15) ^ ATT_F(rr));
        __builtin_amdgcn_global_load_lds((const unsigned*)src, (LAS unsigned*)(slot + 1024 * i), 16, 0, 0);
    }
}

#define ATT_T(q) (((q) & 2047) ^ (((q) >> 11) ? 255 : 0))
__device__ __forceinline__ void att_wave(const unsigned char* CKV8, const unsigned* SEL, unsigned char* BIG, LAS unsigned char* kvbuf, LAS unsigned* lists, const LAS float* relb, const LAS unsigned* btab,
                                         int xcd, int wx, int nwx, int lane) {
    asm volatile("" : "+v"(lane));
    const int hq = lane & 15, g = lane >> 4;
    const int nq = (2 * SEQ - wx + nwx - 1) / nwx;
    if (nq <= 0) return;
    const unsigned kvb = (unsigned)(size_t)kvbuf;
    unsigned qa[8];
#pragma unroll
    for (int ks = 0; ks < 8; ++ks) qa[ks] = kvb + (unsigned)(8 * (hq >> 2) + (hq & 3)) * 256u + 16u * (unsigned)((2 * ks + (g >> 1)) ^ ATT_F(8 * (hq >> 2) + (hq & 3))) + 8u * (unsigned)(g & 1);
    const int trow = 8 * g + (hq >> 1);
    unsigned ta[16];
#pragma unroll
    for (int nt = 0; nt < 16; ++nt) ta[nt] = kvb + (unsigned)trow * 256u + 16u * (unsigned)(nt ^ ATT_F(trow)) + 8u * (unsigned)(hq & 1);

    int q = wx, b = 2 * xcd + (q >> 11), t = ATT_T(q);
    size_t row = (size_t)b * SEQ + t;
    unsigned wsel = SEL[row * 64 + lane];
    int cnt = att_build_list(lists, btab, wsel, t, lane);
    unsigned wnext = 0u;
    if (nq > 1) { const int q1 = wx + nwx; wnext = SEL[((size_t)(2 * xcd + (q1 >> 11)) * SEQ + ATT_T(q1)) * 64 + lane]; }
    long bq[8];
    { const unsigned char* qp = BIG + row * 8192 + hq * 256 + 8 * g;
#pragma unroll
      for (int ks = 0; ks < 8; ++ks) bq[ks] = *(const long*)(qp + 32 * ks); }
    int par = 0;
    asm volatile("s_waitcnt lgkmcnt(0)" ::: "memory");
    att_gather32(CKV8 + (size_t)b * SEQ * RK, lists, kvbuf, lane);
    for (int k = 0; k < nq; ++k) {
        const int cur = k & 1;
        LAS unsigned* list = lists + cur * 256;
        const bool has_next = (k + 1 < nq);
        const int qn = q + nwx, bn = 2 * xcd + (qn >> 11), tn = ATT_T(qn);
        const size_t rown = (size_t)bn * SEQ + tn;
        int cntn = 0;
        if (has_next) { cntn = att_build_list(lists + (cur ^ 1) * 256, btab, wnext, tn, lane);
            if (k + 2 < nq) { const int q2 = qn + nwx; wnext = SEL[((size_t)(2 * xcd + (q2 >> 11)) * SEQ + ATT_T(q2)) * 64 + lane]; } }
        f32x4 O[16];
#pragma unroll
        for (int nt = 0; nt < 16; ++nt) O[nt] = (f32x4){0.f, 0.f, 0.f, 0.f};
        float mref = NEGF, lsum = 0.f;
        const int nsub = (cnt + 31) >> 5;
        for (int sc = 0; sc < nsub; ++sc) {
            const bool lastc = (sc + 1 == nsub);
            float bias[8];
#pragma unroll
            for (int T = 0; T < 2; ++T) { const u32x4 mt = *(const LAS u32x4*)(list + 32 * sc + 8 * g + 4 * T);
#pragma unroll
                for (int i = 0; i < 4; ++i) bias[4 * T + i] = relb[(mt[i] >> 16) * 16 + hq]; }
            if (!lastc) { att_gather32(CKV8 + (size_t)b * SEQ * RK, list + 32 * (sc + 1), kvbuf + (par ^ 1) * 8192, lane); asm volatile("s_waitcnt vmcnt(8)" ::: "memory"); }
            else if (has_next) { att_gather32(CKV8 + (size_t)bn * SEQ * RK, lists + (cur ^ 1) * 256, kvbuf + (par ^ 1) * 8192, lane); asm volatile("s_waitcnt vmcnt(8)" ::: "memory"); }
            else { asm volatile("s_waitcnt vmcnt(0)" ::: "memory"); }
            f32x4 st0 = (f32x4){0.f, 0.f, 0.f, 0.f}, st1 = st0;
            { long kr[8];
              RDK8("0", kr, qa);
#pragma unroll
              for (int ks = 0; ks < 8; ++ks) st0 = __builtin_amdgcn_mfma_f32_16x16x32_fp8_fp8(kr[ks], bq[ks], st0, 0, 0, 0);
              RDK8("1024", kr, qa);
#pragma unroll
              for (int ks = 0; ks < 8; ++ks) st1 = __builtin_amdgcn_mfma_f32_16x16x32_fp8_fp8(kr[ks], bq[ks], st1, 0, 0, 0); }
            if (lastc && has_next) { const unsigned char* qp = BIG + rown * 8192 + hq * 256 + 8 * g;
#pragma unroll
                for (int ks = 0; ks < 8; ++ks) bq[ks] = *(const long*)(qp + 32 * ks); }
            float lg[8]; float cmax;
#pragma unroll
            for (int i = 0; i < 4; ++i) { lg[i] = st0[i] * (1.0f / 64.0f) + bias[i]; lg[4 + i] = st1[i] * (1.0f / 64.0f) + bias[4 + i]; }
            if (32 * sc + 32 > cnt) {
#pragma unroll
                for (int i = 0; i < 4; ++i) { const int s0 = 32 * sc + 8 * g + i; lg[i] = (s0 < cnt) ? lg[i] : NEGF; lg[4 + i] = (s0 + 4 < cnt) ? lg[4 + i] : NEGF; } }
            cmax = fmaxf(fmaxf(fmaxf(lg[0], lg[1]), fmaxf(lg[2], lg[3])), fmaxf(fmaxf(lg[4], lg[5]), fmaxf(lg[6], lg[7])));
            cmax = rows_max(cmax);
            if (__ballot(cmax > mref + 3.0f) != 0ull) {
                const float mnew = fmaxf(mref, cmax), scl = fast_exp(mref - mnew);
                lsum *= scl;
#pragma unroll
                for (int nt = 0; nt < 16; ++nt) O[nt] = O[nt] * scl;
                mref = mnew;
            }
            float p[8];
#pragma unroll
            for (int i = 0; i < 8; ++i) { p[i] = fast_exp(lg[i] - mref); lsum += p[i]; }
            int pw0 = 0, pw1 = 0;
            pw0 = __builtin_amdgcn_cvt_pk_fp8_f32(p[0] * 16.0f, p[1] * 16.0f, pw0, false); pw0 = __builtin_amdgcn_cvt_pk_fp8_f32(p[2] * 16.0f, p[3] * 16.0f, pw0, true);
            pw1 = __builtin_amdgcn_cvt_pk_fp8_f32(p[4] * 16.0f, p[5] * 16.0f, pw1, false); pw1 = __builtin_amdgcn_cvt_pk_fp8_f32(p[6] * 16.0f, p[7] * 16.0f, pw1, true);
            const long pk = (long)(((unsigned long long)(unsigned)pw1 << 32) | (unsigned long long)(unsigned)pw0);
            {
#define TR8B(r, a, o) asm volatile("ds_read_b64_tr_b8 %0, %8\n\tds_read_b64_tr_b8 %1, %9\n\tds_read_b64_tr_b8 %2, %10\n\tds_read_b64_tr_b8 %3, %11\n\t" \
                                   "ds_read_b64_tr_b8 %4, %12\n\tds_read_b64_tr_b8 %5, %13\n\tds_read_b64_tr_b8 %6, %14\n\tds_read_b64_tr_b8 %7, %15\n\ts_waitcnt lgkmcnt(0)" \
                                   : "=&v"(r[0]), "=&v"(r[1]), "=&v"(r[2]), "=&v"(r[3]), "=&v"(r[4]), "=&v"(r[5]), "=&v"(r[6]), "=&v"(r[7]) \
                                   : "v"(a[o + 0]), "v"(a[o + 1]), "v"(a[o + 2]), "v"(a[o + 3]), "v"(a[o + 4]), "v"(a[o + 5]), "v"(a[o + 6]), "v"(a[o + 7]) : "memory")
                long kt[8];
                TR8B(kt, ta, 0);
#pragma unroll
                for (int e = 0; e < 8; ++e) O[e] = __builtin_amdgcn_mfma_f32_16x16x32_fp8_fp8(kt[e], pk, O[e], 0, 0, 0);
                TR8B(kt, ta, 8);
#pragma unroll
                for (int e = 0; e < 8; ++e) O[8 + e] = __builtin_amdgcn_mfma_f32_16x16x32_fp8_fp8(kt[e], pk, O[8 + e], 0, 0, 0);
#undef TR8B
            }
            par ^= 1;
#pragma unroll
            for (int e = 0; e < 8; ++e) { qa[e] ^= 8192u; ta[e] ^= 8192u; ta[8 + e] ^= 8192u; }
        }
        lsum = rows_sum(lsum);
        const float inv = 1.0f / (16.0f * lsum);
        bf16_t* op = (bf16_t*)(BIG + row * 8192) + hq * 256 + 4 * g;
#pragma unroll
        for (int nt = 0; nt < 16; ++nt) { const f32x4 o = O[nt] * inv; u32x2 wv; wv.x = cvt_pk_bf16(o[0], o[1]); wv.y = cvt_pk_bf16(o[2], o[3]); *(u32x2*)(op + 16 * nt) = wv; }
        q = qn; b = bn; t = tn; row = rown; cnt = cntn;
    }
}

constexpr int SW_KP = 144, SW_VP = 520;
constexpr int SW_K_OFF = 0, SW_V_OFF = 256 * SW_KP, SW_TB_OFF = SW_V_OFF + 64 * SW_VP;
__device__ __forceinline__ void swa_phase(const bf16_t* QKV, bf16_t* OB, const float* relb, const float* sinks, LAS unsigned char* lds, int G) {
    int tid = threadIdx.x; asm volatile("" : "+v"(tid));
    const int lane = tid & 63, wave = __builtin_amdgcn_readfirstlane(tid >> 6);
    const int h = lane >> 5, n = lane & 31;
    LAS float* tb = (LAS float*)(lds + SW_TB_OFF);
    for (int u = blockIdx.x; u < BATCH * 16 * KVH; u += G) {
        const int b = u >> 5, nb = (u >> 1) & 15, kvh = u & 1;
        const size_t rowb = (size_t)b * SEQ;
        __syncthreads();
#pragma unroll
        for (int e = 0; e < 4; ++e) { const int id = tid + NTHR * e, j = id >> 3, ch = id & 7; const int pos = (nb - 1) * WIN + j;
            u32x4 kv = (u32x4){0u, 0u, 0u, 0u}, vv = (u32x4){0u, 0u, 0u, 0u};
            if (pos >= 0) { const bf16_t* sp = QKV + (rowb + pos) * B_IN + 1024 + kvh * 64 + ch * 8; kv = *(const u32x4*)sp; vv = *(const u32x4*)(sp + 128); }
            *(LAS u32x4*)(lds + SW_K_OFF + j * SW_KP + ch * 16) = kv;
            LAS bf16_t* vt = (LAS bf16_t*)(lds + SW_V_OFF + (ch * 8) * SW_VP + j * 2);
#pragma unroll
            for (int q = 0; q < 4; ++q) { vt[(2 * q) * (SW_VP / 2)] = (bf16_t)(vv[q] & 0xffffu); vt[(2 * q + 1) * (SW_VP / 2)] = (bf16_t)(vv[q] >> 16); } }
        for (int i = tid; i < GQ * WIN; i += NTHR) { const int gg = i >> 7, dist = i & 127; tb[i] = relb[t5_bucket(dist) * NH + kvh * GQ + gg]; }
        __syncthreads();
        const int qh = kvh * GQ + wave; const float sink = sinks[qh];
        for (int rt = 0; rt < 4; ++rt) {
            const size_t qrow = rowb + nb * WIN + 32 * rt + n;
            bf16x8 bq[4];
#pragma unroll
            for (int ks = 0; ks < 4; ++ks) bq[ks] = *(const bf16x8*)(QKV + qrow * B_IN + qh * 64 + 16 * ks + 8 * h);
            f32x16 s[5];
#pragma unroll
            for (int ct = 0; ct < 5; ++ct) {
#pragma unroll
                for (int i = 0; i < 16; ++i) s[ct][i] = 0.f;
#pragma unroll
                for (int ks = 0; ks < 4; ++ks) { const bf16x8 a = *(const LAS bf16x8*)(lds + SW_K_OFF + (32 * (rt + ct) + n) * SW_KP + (2 * ks + h) * 16);
                    s[ct] = __builtin_amdgcn_mfma_f32_32x32x16_bf16(a, bq[ks], s[ct], 0, 0, 0); } }
            const int qi = 32 * rt + n;
            float mx = NEGF;
#pragma unroll
            for (int ct = 0; ct < 5; ++ct)
#pragma unroll
                for (int i = 0; i < 16; ++i) { const int j = 32 * (rt + ct) + (i & 3) + 8 * (i >> 2) + 4 * h; const int dist = qi + WIN - j;
                    const bool ok = (dist >= 0) && (dist < WIN) && (nb > 0 || j >= WIN);
                    const float v = ok ? s[ct][i] * 0.125f + tb[wave * WIN + (dist & 127)] : NEGF; s[ct][i] = v; mx = fmaxf(mx, v); }
            mx = fmaxf(mx, __shfl_xor(mx, 32)); mx = fmaxf(mx, sink);
            float sum = 0.f;
#pragma unroll
            for (int ct = 0; ct < 5; ++ct)
#pragma unroll
                for (int i = 0; i < 16; ++i) { const float p = fast_exp(s[ct][i] - mx); s[ct][i] = p; sum += p; }
            sum += __shfl_xor(sum, 32); sum += fast_exp(sink - mx);
            f32x16 o[2];
#pragma unroll
            for (int dt = 0; dt < 2; ++dt)
#pragma unroll
                for (int i = 0; i < 16; ++i) o[dt][i] = 0.f;
#pragma unroll
            for (int ct = 0; ct < 5; ++ct)
#pragma unroll
                for (int s2 = 0; s2 < 2; ++s2) {
                    u32x4 pw; pw.x = cvt_pk_bf16(s[ct][8 * s2 + 0], s[ct][8 * s2 + 1]); pw.y = cvt_pk_bf16(s[ct][8 * s2 + 2], s[ct][8 * s2 + 3]);
                    pw.z = cvt_pk_bf16(s[ct][8 * s2 + 4], s[ct][8 * s2 + 5]); pw.w = cvt_pk_bf16(s[ct][8 * s2 + 6], s[ct][8 * s2 + 7]);
                    const bf16x8 pb = __builtin_bit_cast(bf16x8, pw);
#pragma unroll
                    for (int dt = 0; dt < 2; ++dt) { const LAS unsigned char* vp = lds + SW_V_OFF + (32 * dt + n) * SW_VP + (32 * (rt + ct) + 16 * s2 + 4 * h) * 2;
                        const u32x2 v0 = *(const LAS u32x2*)vp, v1 = *(const LAS u32x2*)(vp + 16);
                        u32x4 va; va.x = v0.x; va.y = v0.y; va.z = v1.x; va.w = v1.y;
                        o[dt] = __builtin_amdgcn_mfma_f32_32x32x16_bf16(__builtin_bit_cast(bf16x8, va), pb, o[dt], 0, 0, 0); }
                }
            const float inv = 1.0f / sum;
            bf16_t* op = OB + qrow * D + qh * 64 + 4 * h;
#pragma unroll
            for (int dt = 0; dt < 2; ++dt)
#pragma unroll
                for (int i4 = 0; i4 < 4; ++i4) { u32x2 wv; wv.x = cvt_pk_bf16(o[dt][4 * i4] * inv, o[dt][4 * i4 + 1] * inv); wv.y = cvt_pk_bf16(o[dt][4 * i4 + 2] * inv, o[dt][4 * i4 + 3] * inv);
                    *(u32x2*)(op + 32 * dt + 8 * i4) = wv; }
        }
    }
}

struct Args { const float* in[23]; float* out; unsigned char* ws; };
#define CAS __attribute__((address_space(4)))
__device__ __forceinline__ const CAS Args* kargs() { const CAS Args* p = (const CAS Args*)__builtin_amdgcn_kernarg_segment_ptr(); asm volatile("" : "+s"(p)); return p; }

__global__ void __launch_bounds__(NTHR, 2) trunk_fwd(Args args_by_value) {
    extern __shared__ __attribute__((aligned(16))) unsigned char lds_raw[];
    LAS unsigned char* lds = (LAS unsigned char*)lds_raw;
    const int tid = threadIdx.x;
    volatile LAS unsigned* MISC = (volatile LAS unsigned*)(lds + LDS_MISC_OFF);
    for (int u = tid; u < (LDS_BYTES - LDS_MISC_OFF) / 4; u += NTHR) MISC[u] = 0u;
    __syncthreads();
    { const CAS Args* A = kargs(); (void)xcd_barrier_post((unsigned*)(A->ws + WS_CTL) + 4096, MISC + 8);
      if (tid == 0) { const unsigned x = xb_xcc_id(); MISC[16] = x; MISC[17] = xb_add((unsigned*)(A->ws + WS_CTL) + 8192 + 64 * x, 1u); } }
#define XCD_RANK(xcd, rank) do { const CAS Args* A_ = kargs(); const unsigned* cw_ = (const unsigned*)(A_->ws + WS_CTL) + 4096; bool ok_ = (gridDim.x & 7) == 0; \
        for (int j_ = 0; j_ < 16; ++j_) { const unsigned c_ = __hip_atomic_load(cw_ + XB_XCNT(j_), __ATOMIC_RELAXED, __HIP_MEMORY_SCOPE_AGENT); ok_ = ok_ && (c_ == (j_ < 8 ? gridDim.x >> 3 : 0u)); } \
        const unsigned hx_ = MISC[16], hr_ = MISC[17]; ok_ = ok_ && hx_ < 8u && hr_ < (gridDim.x >> 3); \
        xcd = ok_ ? (int)hx_ : (int)(blockIdx.x & 7); rank = ok_ ? (int)hr_ : (int)(blockIdx.x >> 3); } while (0)
#define GB() do { const CAS Args* A_ = kargs(); XcdBarrier b_; b_.bar = (unsigned*)(A_->ws + WS_CTL) + 4096; b_.x = xb_xcc_id(); b_.st = MISC + 8; xcd_barrier(b_); } while (0)

    { const CAS Args* A = kargs(); Ptrs P;
#pragma unroll
      for (int i = 0; i < 23; ++i) P.in[i] = A->in[i];
      P.out = A->out; P.ws = A->ws;
      p0_prologue(P, lds, (int)gridDim.x); }
    GB();
    { const CAS Args* A = kargs(); Ptrs P;
#pragma unroll
      for (int i = 0; i < 23; ++i) P.in[i] = A->in[i];
      P.out = A->out; P.ws = A->ws;
      pre_phase(P, lds, (int)gridDim.x); }
    GB();

    for (int l = 0; l < DEPTH; ++l) {
        const bool isA = (l & 1) == 0;
        {
            const CAS Args* A = kargs(); const int G = gridDim.x, j = l >> 1; unsigned char* ws = A->ws;
            const unsigned long long* SS = (const unsigned long long*)(ws + WS_SS) + (size_t)(2 * l) * M;
            if (isA) {
                unsigned char* wa = ws + WS_WA + (size_t)j * WA_STRIDE;
                pg8::Gemm g{(const bf16_t*)(ws + WS_XG), (const bf16_t*)(wa + WINA_OFF), D, D, D, 0, 0}; pg8::StaticOrder S; S.init(M, 2048, G, (int)blockIdx.x);
                pg8::EpiInA E{(bf16_t*)(ws + WS_QO), (bf16_t*)(ws + WS_CKV), (bf16_t*)(ws + WS_QI), (bf16_t*)(ws + WS_KIN), (float*)(ws + WS_WI), A->in[I_AIKG] + j * IDIM, A->in[I_AIKB] + j * IDIM,
                                (const float*)(ws + WS_SHW + SHW_A) + (size_t)j * BATCH * 2048, SS};
                pg8::gemm_phase<pg8::EpiInA, true>(lds, g, S, E);
            } else {
                unsigned char* wb = ws + WS_WB + (size_t)j * WB_STRIDE;
                pg8::Gemm g{(const bf16_t*)(ws + WS_XG), (const bf16_t*)(wb + WINB_OFF), D, D, D, 0, 0}; pg8::StaticOrder S; S.init(M, B_IN, G, (int)blockIdx.x);
                pg8::EpiBf16Plain<true> E{(bf16_t*)(ws + WS_QKV), B_IN, (const float*)(ws + WS_SHW + SHW_B) + (size_t)j * BATCH * B_IN, B_IN, SS};
                pg8::gemm_phase<pg8::EpiBf16Plain<true>, true>(lds, g, S, E);
            }
        }
        GB();
        if (isA) {
            { const CAS Args* A = kargs(); const int G = gridDim.x, j = l >> 1; unsigned char* ws = A->ws;
              unsigned char* wa = ws + WS_WA + (size_t)j * WA_STRIDE;
              pg8::Gemm g{(const bf16_t*)(ws + WS_QO), (const bf16_t*)(wa + WQA_OFF), D, 256, 256, 2, 256}; pg8::StaticOrder S; S.init(M, 4096, G, (int)blockIdx.x);
              pg8::EpiFp8 E{ws + WS_BIG, 8192};
              pg8::gemm_phase<pg8::EpiFp8, true>(lds, g, S, E); }
            { const CAS Args* A = kargs(); const int G = gridDim.x; unsigned char* ws = A->ws;
              int tid2 = tid; asm volatile("" : "+v"(tid2));
              const int lane = tid2 & 63, wave = __builtin_amdgcn_readfirstlane(tid2 >> 6);
              const bf16_t* CKV = (const bf16_t*)(ws + WS_CKV); unsigned* CKV8 = (unsigned*)(ws + WS_CKV8);
              const int gw = blockIdx.x * NWAVES + wave, NGW = G * NWAVES;
              for (int row = gw; row < M; row += NGW) {
                  const u32x2 v = *((const u32x2*)(CKV + (size_t)row * RK) + lane);
                  const float a0 = __uint_as_float(v.x << 16), a1 = __uint_as_float(v.x & 0xffff0000u), a2 = __uint_as_float(v.y << 16), a3 = __uint_as_float(v.y & 0xffff0000u);
                  const float ss = wave_sum((a0 * a0 + a1 * a1) + (a2 * a2 + a3 * a3));
                  const float rs = 1.0f / sqrtf(ss * (1.0f / RK) + EPS);
                  int w = 0; w = __builtin_amdgcn_cvt_pk_fp8_f32(a0 * rs, a1 * rs, w, false); w = __builtin_amdgcn_cvt_pk_fp8_f32(a2 * rs, a3 * rs, w, true);
                  CKV8[(size_t)row * (RK / 4) + lane] = (unsigned)w;
              } }
            { const CAS Args* A = kargs(); const int G = gridDim.x; unsigned char* ws = A->ws;
              int tid2 = tid; asm volatile("" : "+v"(tid2));
              const int lane = tid2 & 63, wave = __builtin_amdgcn_readfirstlane(tid2 >> 6);
              int xcd, rank; XCD_RANK(xcd, rank); xcd = __builtin_amdgcn_readfirstlane(xcd); rank = __builtin_amdgcn_readfirstlane(rank);
              const int wx = rank * NWAVES + wave, nwx = (G >> 3) * NWAVES;
              const int nsteps = (1024 + nwx - 1) / nwx;
              for (int st = 0; st < nsteps; ++st) {
                  const int q = wx + st * nwx; const bool active = q < 1024;
                  const int qc = active ? q : (rank * NWAVES + st * nwx < 1024 ? rank * NWAVES + st * nwx : 1023);
                  const int bl = qc >> 9, u = qc & 255, hiq = (qc >> 8) & 1, b = 2 * xcd + bl;
                  const int tg = hiq ? 511 - u : u;
                  idx_task((const bf16_t*)(ws + WS_QI), (const bf16_t*)(ws + WS_KIN), (const float*)(ws + WS_WI), (unsigned*)(ws + WS_SEL), lds, b, tg, lane, wave, active, hiq ? 2 : 1);
              }
              __syncthreads(); }
        } else {
            const CAS Args* A = kargs(); const int G = gridDim.x, j = l >> 1; unsigned char* ws = A->ws;
            swa_phase((const bf16_t*)(ws + WS_QKV), (bf16_t*)(ws + WS_OB), A->in[I_RELB], A->in[I_BSINK] + j * NH, lds, G);
        }
        GB();
        if (isA) {
            { const CAS Args* A = kargs(); const int G = gridDim.x; unsigned char* ws = A->ws;
              int tid2 = tid; asm volatile("" : "+v"(tid2));
              const int lane = tid2 & 63, wave = __builtin_amdgcn_readfirstlane(tid2 >> 6);
              LAS float* relb = (LAS float*)(lds + 147456);
              LAS unsigned* btab = (LAS unsigned*)(lds + 147456 + 2048);
              for (int i = tid2; i < NBUCK * NH; i += NTHR) relb[i] = A->in[I_RELB][i];
              for (int i = tid2; i < 132; i += NTHR) btab[i] = (unsigned)t5_bucket(i);
              __syncthreads();
              int xcd, rank; XCD_RANK(xcd, rank); xcd = __builtin_amdgcn_readfirstlane(xcd); rank = __builtin_amdgcn_readfirstlane(rank);
              const int wx = rank * NWAVES + wave, nwx = (G >> 3) * NWAVES;
              att_wave(ws + WS_CKV8, (const unsigned*)(ws + WS_SEL), ws + WS_BIG, lds + wave * 16384, (LAS unsigned*)(lds + 131072 + wave * 2048), relb, btab, xcd, wx, nwx, lane); }
            GB();
            { const CAS Args* A = kargs(); const int G = gridDim.x, j = l >> 1; unsigned char* ws = A->ws;
              unsigned char* wa = ws + WS_WA + (size_t)j * WA_STRIDE;
              pg8::Gemm g{(const bf16_t*)(ws + WS_BIG), (const bf16_t*)(wa + WUV_OFF), 4096, D, D, 0, 1024}; pg8::StaticOrder S; S.init(M, D, G, (int)blockIdx.x);
              pg8::EpiBf16Plain<false> E{(bf16_t*)(ws + WS_QO), D, nullptr, 0, nullptr};
              pg8::gemm_phase<pg8::EpiBf16Plain<false>, true>(lds, g, S, E); }
            GB();
        }
        {
            const CAS Args* A = kargs(); const int G = gridDim.x, j = l >> 1; unsigned char* ws = A->ws;
            const float* modl = (const float*)(ws + WS_MOD) + (size_t)l * BATCH * 6144;
            const bf16_t* Ain = (const bf16_t*)(ws + (isA ? WS_QO : WS_OB));
            const bf16_t* Bw = (const bf16_t*)(isA ? ws + WS_WA + (size_t)j * WA_STRIDE + WOUTA_OFF : ws + WS_WB + (size_t)j * WB_STRIDE + WOUTB_OFF);
            pg8::Gemm g{Ain, Bw, D, D, D, 0, 0}; pg8::StaticOrder S; S.init(M, D, G, (int)blockIdx.x);
            pg8::EpiResid E{(const bf16_t*)A->out, (bf16_t*)A->out, modl + 2048, isA ? nullptr : A->in[I_BBOUT] + j * D,
                            (bf16_t*)(ws + WS_XG), A->in[I_GFFN] + l * D, modl + 4096, (unsigned long long*)(ws + WS_SS) + (size_t)(2 * l + 1) * M};
            pg8::gemm_phase<pg8::EpiResid, true>(lds, g, S, E);
        }
        GB();
        {
            const CAS Args* A = kargs(); const int G = gridDim.x; unsigned char* ws = A->ws;
            unsigned char* wl = ws + WS_W + (size_t)l * W_LAYER;
            pg8::Gemm g{(const bf16_t*)(ws + WS_XG), (const bf16_t*)(wl + W13_OFF), D, D, D, 0, 0}; pg8::StaticOrder S; S.init(M, 2 * DFF, G, (int)blockIdx.x);
            pg8::EpiSwiGLU E{(bf16_t*)(ws + WS_HFF), (const float*)(ws + WS_SHW + SHW_F) + (size_t)l * BATCH * 2 * DFF, (const unsigned long long*)(ws + WS_SS) + (size_t)(2 * l + 1) * M};
            pg8::gemm_phase<pg8::EpiSwiGLU, true>(lds, g, S, E);
        }
        GB();
        {
            const CAS Args* A = kargs(); const int G = gridDim.x; unsigned char* ws = A->ws;
            unsigned char* wl = ws + WS_W + (size_t)l * W_LAYER;
            const float* modl = (const float*)(ws + WS_MOD) + (size_t)l * BATCH * 6144;
            const int ln = l + 1 < DEPTH ? l + 1 : l;
            pg8::Gemm g{(const bf16_t*)(ws + WS_HFF), (const bf16_t*)(wl + W2_OFF), DFF, DFF, DFF, 0, 0}; pg8::StaticOrder S; S.init(M, D, G, (int)blockIdx.x);
            const bool lastl = (l + 1 == DEPTH);
            pg8::EpiResid E{(const bf16_t*)A->out, lastl ? (bf16_t*)(ws + WS_XG) : (bf16_t*)A->out, modl + 5120, nullptr,
                            l + 1 < DEPTH ? (bf16_t*)(ws + WS_XG) : nullptr, A->in[I_GMIX] + ln * D, (const float*)(ws + WS_MOD) + (size_t)ln * BATCH * 6144 + 1024, (unsigned long long*)(ws + WS_SS) + (size_t)(2 * l + 2) * M};
            pg8::gemm_phase<pg8::EpiResid, true>(lds, g, S, E);
        }
        GB();
    }
    { const CAS Args* A = kargs(); final_norm_phase((const bf16_t*)(A->ws + WS_XG), A->out, A->in[I_GFIN], (int)gridDim.x); }
#undef GB
}

extern "C" void kernel_launch(void* const* d_in, const int* in_sizes, int n_in, void* d_out, int out_size, void* d_ws, size_t ws_size, hipStream_t stream) {
    static int grid = 0;
    if (grid == 0) {
        if (n_in != 23 || out_size != M * D || ws_size < WS_END) { fprintf(stderr, "kernel_launch: unexpected shapes (n_in %d out %d ws %zu)\n", n_in, out_size, ws_size); grid = -1; return; }
        int dev = 0, cus = 0, per_cu = 0;
        if (hipGetDevice(&dev) != hipSuccess || hipDeviceGetAttribute(&cus, hipDeviceAttributeMultiprocessorCount, dev) != hipSuccess) { grid = -1; return; }
        if (hipFuncSetAttribute((const void*)trunk_fwd, hipFuncAttributeMaxDynamicSharedMemorySize, LDS_BYTES) != hipSuccess) { fprintf(stderr, "kernel_launch: hipFuncSetAttribute failed\n"); grid = -1; return; }
        if (hipOccupancyMaxActiveBlocksPerMultiprocessor(&per_cu, (const void*)trunk_fwd, NTHR, LDS_BYTES) != hipSuccess || per_cu < 1) { fprintf(stderr, "kernel_launch: occupancy query says %d\n", per_cu); }
        (void)hipGetLastError();
        grid = cus;
    }
    if (grid < 0) return;
    (void)hipMemsetAsync((char*)d_ws + WS_CTL, 0, CTL_ZERO_BYTES, stream);
    Args a{};
    for (int i = 0; i < 23; ++i) a.in[i] = (const float*)d_in[i];
    a.out = (float*)d_out; a.ws = (unsigned char*)d_ws;
    hipLaunchKernelGGL(trunk_fwd, dim3(grid), dim3(NTHR), LDS_BYTES, stream, a);
    const hipError_t le = hipPeekAtLastError();
    if (le != hipSuccess) fprintf(stderr, "kernel_launch: launch failed: %s\n", hipGetErrorName(le));
}
```

```cpp
#include <hip/hip_runtime.h>
#include <cstdio>
#include <cstdint>


#define GAS __attribute__((address_space(1)))
#define LAS __attribute__((address_space(3)))
typedef unsigned short bf16_t;
typedef short bf16x8 __attribute__((ext_vector_type(8)));
typedef short s16x4 __attribute__((ext_vector_type(4)));
typedef float f32x4 __attribute__((ext_vector_type(4)));
typedef float f32x2 __attribute__((ext_vector_type(2)));
typedef float f32x16 __attribute__((ext_vector_type(16)));
typedef unsigned u32x4 __attribute__((ext_vector_type(4)));
typedef unsigned u32x2 __attribute__((ext_vector_type(2)));
typedef int i32x4 __attribute__((ext_vector_type(4)));

constexpr int D = 1024, BATCH = 16, SEQ = 2048, M = BATCH * SEQ, DEPTH = 4;
constexpr int NH = 16, HD = 64, RK = 256, IH = 8, IDIM = 64, TOPK = 256;
constexpr int KVH = 2, GQ = 8, WIN = 128, NBUCK = 32, DFF = 2816;
constexpr int A_IN = 1864, B_IN = 1280;
constexpr float EPS = 1e-6f;
constexpr float NEGF = -1e30f;
constexpr int NWAVES = 8, NTHR = 512;

constexpr size_t MiB = 1u << 20;
constexpr size_t WS_CTL = 0, CTL_ZERO_BYTES = 4 * MiB;
constexpr size_t WS_SS = 1 * MiB;
constexpr size_t WS_W = 4 * MiB;
constexpr size_t W_LAYER = 17301504;
constexpr size_t W13_OFF = 0, W2_OFF = 11 * MiB;
constexpr size_t WS_WA = WS_W + 4 * W_LAYER;
constexpr size_t WA_STRIDE = 10 * MiB, WINA_OFF = 0, WQA_OFF = 4 * MiB, WUV_OFF = 6 * MiB, WOUTA_OFF = 8 * MiB;
constexpr size_t WS_WB = WS_WA + 2 * WA_STRIDE;
constexpr size_t WB_STRIDE = 4718592, WINB_OFF = 0, WOUTB_OFF = 2621440;
constexpr size_t WS_MOD = 100 * MiB;
constexpr size_t WS_SHW = WS_MOD + 1536 * 1024;
constexpr size_t SHW_A = 0, SHW_B = 2 * 16 * 2048 * 4, SHW_F = SHW_B + 2 * 16 * 1280 * 4;
constexpr size_t WS_XG = 104 * MiB;
constexpr size_t WS_BIG = 104 * MiB;
constexpr size_t WS_HFF = 168 * MiB;
constexpr size_t WS_QO = 360 * MiB;
constexpr size_t WS_CKV = 424 * MiB;
constexpr size_t WS_QI = 440 * MiB;
constexpr size_t WS_KIN = 472 * MiB;
constexpr size_t WS_WI = 476 * MiB;
constexpr size_t WS_SEL = 477 * MiB;
constexpr size_t WS_CKV8 = 486 * MiB;
constexpr size_t WS_QKV = 360 * MiB;
constexpr size_t WS_OB = 440 * MiB;
constexpr size_t WS_W8 = 344 * MiB;
constexpr size_t W8_BATCH = (size_t)2 * 2816 * 1024;
constexpr size_t WS_CW = 504 * MiB;
constexpr size_t WS_END = 512 * MiB;

constexpr int RING_BYTES = 131072;
constexpr int LDS_MISC_OFF = 155648;
constexpr int LDS_BYTES = 156672;

#define RLX_AGENT __ATOMIC_RELAXED, __HIP_MEMORY_SCOPE_AGENT
__device__ __forceinline__ unsigned cvt_pk_bf16(float lo, float hi) { unsigned r; asm volatile("v_cvt_pk_bf16_f32 %0, %1, %2" : "=v"(r) : "v"(lo), "v"(hi)); return r; }
__device__ __forceinline__ float bf2f(bf16_t b) { return __uint_as_float(((unsigned)b) << 16); }
__device__ __forceinline__ float wave_sum(float v) {
#pragma unroll
    for (int o = 1; o < 64; o <<= 1) v += __shfl_xor(v, o);
    return v;
}
__device__ __forceinline__ float fast_exp(float x) { return __builtin_amdgcn_exp2f(x * 1.4426950408889634f); }
__device__ __forceinline__ float silu_f(float x) { return x * __builtin_amdgcn_rcpf(1.0f + fast_exp(-x)); }
__device__ __forceinline__ int t5_bucket(int d) {
    if (d < 16) return d;
    int b = 16;
    b += (d >= 19); b += (d >= 21); b += (d >= 24); b += (d >= 27); b += (d >= 31); b += (d >= 35); b += (d >= 40); b += (d >= 46);
    b += (d >= 52); b += (d >= 59); b += (d >= 67); b += (d >= 77); b += (d >= 87); b += (d >= 99); b += (d >= 113);
    return b;
}

#define XB_TMO      128
#define XB_XCNT(j)  (256  + 64 * (j))
#define XB_XSUB(j)  (1280 + 64 * (j))
#define XB_XGEN(j)  (2304 + 64 * (j))
#define XB_TOP      3328
#define XB_TOPGEN   3392
#define XCD_BAR_WORDS 3456
#define XB_SPIN_CAP (1u << 22)

__device__ __forceinline__ unsigned xb_ld(unsigned* p)              { return __hip_atomic_load(p, __ATOMIC_RELAXED, __HIP_MEMORY_SCOPE_AGENT); }
__device__ __forceinline__ unsigned xb_add(unsigned* p, unsigned v) { return __hip_atomic_fetch_add(p, v, __ATOMIC_RELAXED, __HIP_MEMORY_SCOPE_AGENT); }
__device__ __forceinline__ unsigned xb_xcc_id() { return (unsigned)__builtin_amdgcn_s_getreg((3 << 11) | 20) & 0xFu; }
#define XB_SPIN(cond, bar) do { unsigned _sp = 0; while (cond) { __builtin_amdgcn_s_sleep(1); \
    if ((++_sp & 255u) == 0u) { if (xb_ld(&(bar)[XB_TMO])) break; if (_sp > XB_SPIN_CAP) { atomicAdd(&(bar)[XB_TMO], 1u); break; } } } } while (0)

struct XcdBarrier { unsigned* bar; unsigned x; volatile LAS unsigned* st; };

__device__ __forceinline__ XcdBarrier xcd_barrier_post(unsigned* bar, volatile LAS unsigned* st) {
    XcdBarrier b; b.bar = bar; b.x = xb_xcc_id(); b.st = st;
    if (threadIdx.x == 0) (void)xb_add(&bar[XB_XCNT(b.x)], 1u);
    return b;
}
__device__ __forceinline__ void xcd_barrier_complete(unsigned* bar, unsigned x, unsigned& nloc, unsigned& nx) {
    const unsigned G = gridDim.x * gridDim.y * gridDim.z;
    unsigned sum, cnt, mine, sp = 0u;
    for (;;) {
        sum = 0u; cnt = 0u; mine = 0u;
#pragma unroll
        for (unsigned j = 0; j < 16; ++j) { const unsigned c = xb_ld(&bar[XB_XCNT(j)]); sum += c; cnt += (c > 0u) ? 1u : 0u; mine = (j == x) ? c : mine; }
        if (sum == G) break;
        __builtin_amdgcn_s_sleep(1);
        if ((++sp & 255u) == 0u) { if (xb_ld(&bar[XB_TMO])) break; if (sp > XB_SPIN_CAP) { atomicAdd(&bar[XB_TMO], 1u); break; } }
    }
    nloc = mine > 0u ? mine : 1u; nx = cnt > 0u ? cnt : 1u;
}
__device__ __forceinline__ void xcd_barrier(const XcdBarrier& b) {
    asm volatile("s_waitcnt vmcnt(0)" ::: "memory");
    __syncthreads();
    if (threadIdx.x == 0) {
        unsigned* bar = b.bar;
        __builtin_amdgcn_s_waitcnt(0);
        unsigned nloc = b.st[0], nx = b.st[1];
        if (nloc == 0u) { xcd_barrier_complete(bar, b.x, nloc, nx); b.st[0] = nloc; b.st[1] = nx; }
        const unsigned old = xb_add(&bar[XB_XSUB(b.x)], 1u);
        const unsigned gen = old / nloc;
        if (old + 1u == (gen + 1u) * nloc) {
            __builtin_amdgcn_fence(__ATOMIC_RELEASE, "agent");
            asm volatile("s_waitcnt vmcnt(0)" ::: "memory");
            const unsigned og = xb_add(&bar[XB_TOP], 1u);
            const unsigned tg = og / nx;
            if (og + 1u == (tg + 1u) * nx) xb_add(&bar[XB_TOPGEN], 1u);
            else XB_SPIN(xb_ld(&bar[XB_TOPGEN]) == tg, bar);
            __builtin_amdgcn_fence(__ATOMIC_ACQUIRE, "agent");
            xb_add(&bar[XB_XGEN(b.x)], 1u);
            asm volatile("s_waitcnt vmcnt(0)" ::: "memory");
        } else {
            XB_SPIN(xb_ld(&bar[XB_XGEN(b.x)]) == gen, bar);
            __builtin_amdgcn_fence(__ATOMIC_ACQUIRE, "agent");
            asm volatile("s_waitcnt vmcnt(0)" ::: "memory");
        }
    }
    __syncthreads();
}

namespace pg8 {
constexpr int BM = 256, BK = 64, HALF = 128, HTB = HALF * BK * 2, STAGE_BYTES = 8 * HTB, NXCD = 8, WGM = 8;
__host__ __device__ __forceinline__ int lds_byte(int r, int c) { const int st = (r >> 4) * 2 + (c >> 5), rr = r & 15, cc = c & 31, ob = rr * 64 + cc * 2; return st * 1024 + (ob ^ (((ob >> 9) & 1) << 5)); }
__host__ __device__ __forceinline__ void stage_rc(int b, int& R, int& C) { const int st = b / 1024, sb = b % 1024, swz = sb ^ (((sb >> 9) & 1) << 5); R = (st >> 1) * 16 + swz / 64; C = (st & 1) * 32 + (swz % 64) / 2; }
__host__ __device__ __forceinline__ int perm32(int rho) { const int n = rho >> 4, i = rho & 15; return 8 * (i >> 2) + 4 * n + (i & 3); }

struct Unit { int pm, pn; };
struct Gemm { const bf16_t* A; const bf16_t* Bt; int lda, ldb, K, a_shift, a_mul; unsigned bb; };

struct StaticOrder {
    int nM, nN, nwg, G, c;
    __device__ void init(int M_, int N_, int G_, int c_) { nM = M_ / BM; nN = N_ / BM; nwg = nM * nN; G = G_; c = c_; }
    __device__ bool next(int i, Unit& u) const {
        const long L = (long)i * G + c; if (L >= nwg) return false;
        int wgid = (int)L; { const int q = nwg / NXCD, r = nwg % NXCD, xcd = wgid % NXCD, off = wgid / NXCD; wgid = (xcd < r ? xcd * (q + 1) : r * (q + 1) + (xcd - r) * q) + off; }
        const int nig = WGM * nN, gid = wgid / nig, fm = gid * WGM, gsz = (nM - fm) < WGM ? (nM - fm) : WGM;
        u.pm = fm + ((wgid % nig) % gsz); u.pn = (wgid % nig) / gsz; return true;
    }
};

template <class Epi, bool ALIGN_EPI, bool I8 = false>
__device__ __forceinline__ void gemm_phase(LAS unsigned char* lds, const Gemm g, const StaticOrder& S, const Epi& E) {
    int tid = threadIdx.x; asm volatile("" : "+v"(tid));
    const int wid = __builtin_amdgcn_readfirstlane(tid >> 6), lane = tid & 63, wr = wid >> 2, wc = wid & 3, fr = lane & 15, fq = lane >> 4;
    const int K = g.K, nt = K / BK;
    unsigned voffA[2], voffB[2];
#pragma unroll
    for (int i = 0; i < 2; ++i) { int R, C; stage_rc(tid * 16 + i * 8192, R, C); const int Rb = Epi::PERM ? ((R & ~31) + perm32(R & 31)) : R;
        voffA[i] = (unsigned)(R * g.lda + C) * 2u; voffB[i] = (unsigned)(Rb * g.ldb + C) * 2u; }
    const size_t kstep = (size_t)(BK * 2);
    const size_t hstepA = (size_t)HALF * g.lda * 2, hstepB = (size_t)HALF * g.ldb * 2;
    const unsigned ldsw = (unsigned)wid * 1024u;
    const int aoff = lds_byte(wr * 64 + fr, fq * 8), boff = lds_byte(wc * 32 + fr, fq * 8);
#define PG8_SA(b, h) (((b) * 2 + (h)) * HTB)
#define PG8_SB(b, h) ((4 + (b) * 2 + (h)) * HTB)
#define PG8_STAGE(bufoff, gbase, voff) do { _Pragma("unroll") for (int _i = 0; _i < 2; ++_i) \
        __builtin_amdgcn_global_load_lds((const unsigned*)((const char*)(gbase) + (voff)[_i]), (LAS unsigned*)(lds + (bufoff) + ldsw + _i * 8192), 16, 0, 0); } while (0)
#define PG8_LDA(dst, b, h) do { _Pragma("unroll") for (int m = 0; m < 4; ++m) _Pragma("unroll") for (int k = 0; k < 2; ++k) dst[m][k] = *(const LAS bf16x8*)(lds + PG8_SA(b, h) + aoff + m * 2048 + k * 1024); } while (0)
#define PG8_LDB(dst, b, h) do { _Pragma("unroll") for (int n = 0; n < 2; ++n) _Pragma("unroll") for (int k = 0; k < 2; ++k) dst[n][k] = *(const LAS bf16x8*)(lds + PG8_SB(b, h) + boff + n * 2048 + k * 1024); } while (0)
#define PG8_MMA(ai, bj, At, Bt) do { __builtin_amdgcn_s_setprio(1); _Pragma("unroll") for (int m = 0; m < 4; ++m) _Pragma("unroll") for (int n = 0; n < 2; ++n) _Pragma("unroll") for (int k = 0; k < 2; ++k) \
        { if constexpr (I8) acc[ai][bj][m][n] = __builtin_bit_cast(f32x4, __builtin_amdgcn_mfma_i32_16x16x64_i8(__builtin_bit_cast(i32x4, Bt[n][k]), __builtin_bit_cast(i32x4, At[m][k]), __builtin_bit_cast(i32x4, acc[ai][bj][m][n]), 0, 0, 0)); \
          else acc[ai][bj][m][n] = __builtin_amdgcn_mfma_f32_16x16x32_bf16(Bt[n][k], At[m][k], acc[ai][bj][m][n], 0, 0, 0); } __builtin_amdgcn_s_setprio(0); } while (0)
#define PG8_WAIT_V(n) asm volatile("s_waitcnt vmcnt(" #n ")" ::: "memory")
#define PG8_WAIT_L(n) asm volatile("s_waitcnt lgkmcnt(" #n ")" ::: "memory")
#define PG8_BAR __builtin_amdgcn_s_barrier()
#define PG8_SCHED __builtin_amdgcn_sched_barrier(0)
#define PG8_ABASE(u) ((const char*)g.A + ((size_t)(u).pm * BM * g.lda + (size_t)((u).pn >> g.a_shift) * g.a_mul) * 2)
#define PG8_BBASE(u) ((const char*)g.Bt + (size_t)(u).pn * BM * g.ldb * 2 + (size_t)((u).pm >> 3) * g.bb)
    Unit cur, nxt; int ui = 0;
    if (!S.next(0, cur)) return;
    f32x4 acc[2][2][4][2];
#pragma unroll
    for (int a = 0; a < 2; ++a)
#pragma unroll
        for (int b = 0; b < 2; ++b)
#pragma unroll
            for (int m = 0; m < 4; ++m)
#pragma unroll
                for (int n = 0; n < 2; ++n) acc[a][b][m][n] = (f32x4){0.f, 0.f, 0.f, 0.f};
    bf16x8 At[4][2], B0[2][2], B1[2][2];
    const char* cA = PG8_ABASE(cur); const char* cB = PG8_BBASE(cur);
    PG8_STAGE(PG8_SB(0, 0), cB, voffB); PG8_STAGE(PG8_SB(0, 1), cB + hstepB, voffB); PG8_STAGE(PG8_SA(0, 0), cA, voffA); PG8_STAGE(PG8_SA(0, 1), cA + hstepA, voffA);
    if (wr == 1) PG8_BAR;
    PG8_WAIT_V(2); PG8_BAR;
    PG8_STAGE(PG8_SB(1, 0), cB + kstep, voffB); PG8_STAGE(PG8_SA(1, 0), cA + kstep, voffA); PG8_STAGE(PG8_SB(1, 1), cB + hstepB + kstep, voffB);
    PG8_WAIT_V(6); PG8_BAR;
    for (;;) {
        const bool has_next = S.next(ui + 1, nxt);
        const char* nA = has_next ? PG8_ABASE(nxt) : cA; const char* nB = has_next ? PG8_BBASE(nxt) : cB;
        for (int t = 0; t < nt; t += 2) {
            const bool last = (t == nt - 2);
            if constexpr (Epi::PREFETCH) { if (last) E.prefetch(lds + STAGE_BYTES, cur, wid, lane); }
            const char* a1 = cA + (size_t)(t + 1) * kstep;
            const char* a2 = last ? nA : cA + (size_t)(t + 2) * kstep; const char* b2 = last ? nB : cB + (size_t)(t + 2) * kstep;
            const char* a3 = a2 + kstep; const char* b3 = b2 + kstep;
            PG8_LDB(B0, 0, 0); PG8_LDB(B1, 0, 1); PG8_SCHED; PG8_LDA(At, 0, 0); PG8_STAGE(PG8_SA(1, 1), a1 + hstepA, voffA);
            PG8_WAIT_V(8); PG8_WAIT_L(0); PG8_BAR; PG8_MMA(0, 0, At, B0); PG8_MMA(0, 1, At, B1); PG8_BAR; PG8_SCHED;
            PG8_LDA(At, 0, 1); PG8_STAGE(PG8_SB(0, 0), b2, voffB); PG8_STAGE(PG8_SB(0, 1), b2 + hstepB, voffB); PG8_STAGE(PG8_SA(0, 0), a2, voffA);
            PG8_WAIT_V(8); PG8_WAIT_L(0); PG8_BAR; PG8_MMA(1, 0, At, B0); PG8_MMA(1, 1, At, B1); PG8_BAR; PG8_SCHED;
            PG8_LDB(B0, 1, 0); PG8_LDB(B1, 1, 1); PG8_SCHED; PG8_LDA(At, 1, 0); PG8_STAGE(PG8_SA(0, 1), a2 + hstepA, voffA);
            PG8_WAIT_V(8); PG8_WAIT_L(0); PG8_BAR; PG8_MMA(0, 0, At, B0); PG8_MMA(0, 1, At, B1); PG8_BAR; PG8_SCHED;
            PG8_LDA(At, 1, 1); PG8_STAGE(PG8_SB(1, 0), b3, voffB); PG8_STAGE(PG8_SB(1, 1), b3 + hstepB, voffB); PG8_STAGE(PG8_SA(1, 0), a3, voffA);
            PG8_WAIT_V(8); PG8_WAIT_L(0); PG8_BAR; PG8_MMA(1, 0, At, B0); PG8_MMA(1, 1, At, B1); PG8_BAR; PG8_SCHED;
        }
        if constexpr (ALIGN_EPI) { if (wr == 0) PG8_BAR; }
        { int t2 = threadIdx.x; asm volatile("" : "+v"(t2)); const int l2 = t2 & 63;
          if constexpr (Epi::PREFETCH) E(acc, cur, wr, wc, l2 & 15, l2 >> 4, lds + STAGE_BYTES); else E(acc, cur, wr, wc, l2 & 15, l2 >> 4); }
        if (!has_next) break;
#pragma unroll
        for (int a = 0; a < 2; ++a)
#pragma unroll
            for (int b = 0; b < 2; ++b)
#pragma unroll
                for (int m = 0; m < 4; ++m)
#pragma unroll
                    for (int n = 0; n < 2; ++n) acc[a][b][m][n] = (f32x4){0.f, 0.f, 0.f, 0.f};
        cur = nxt; cA = nA; cB = nB; ++ui;
        if constexpr (ALIGN_EPI) { if (wr == 1) PG8_BAR; }
    }
    PG8_WAIT_V(0);
    if constexpr (!ALIGN_EPI) { if (wr == 0) PG8_BAR; }
    PG8_BAR;
#undef PG8_SA
#undef PG8_SB
#undef PG8_STAGE
#undef PG8_LDA
#undef PG8_LDB
#undef PG8_MMA
#undef PG8_WAIT_V
#undef PG8_WAIT_L
#undef PG8_BAR
#undef PG8_SCHED
#undef PG8_ABASE
#undef PG8_BBASE
}

template <bool NORM> struct EpiBf16Plain {
    static constexpr bool PERM = true, PREFETCH = NORM;
    bf16_t* O; int ldc; const float* shw; int shw_stride; const unsigned long long* SS;
    __device__ __forceinline__ void prefetch(LAS unsigned char* aux, const Unit& u, int wid, int lane) const {
        if (wid < 2) __builtin_amdgcn_global_load_lds((const unsigned*)((const char*)(SS + (size_t)u.pm * BM) + wid * 1024 + lane * 16), (LAS unsigned*)(aux + wid * 1024), 16, 0, 0);
        else if (wid == 2) __builtin_amdgcn_global_load_lds((const unsigned*)((const char*)(shw + (size_t)(u.pm >> 3) * shw_stride + u.pn * BM) + lane * 16), (LAS unsigned*)(aux + 2048), 16, 0, 0);
    }
    __device__ __forceinline__ void operator()(const f32x4 (&acc)[2][2][4][2], const Unit& u, int wr, int wc, int fr, int fq, const LAS unsigned char* aux = nullptr) const {
        const int row0 = u.pm * BM + wr * 64 + fr, col0 = u.pn * BM + wc * 32 + 8 * fq;
        f32x4 bv[2][2];
#pragma unroll
        for (int bj = 0; bj < 2; ++bj)
#pragma unroll
            for (int n = 0; n < 2; ++n) bv[bj][n] = NORM ? *(const LAS f32x4*)((const LAS float*)(aux + 2048) + wc * 32 + 8 * fq + bj * HALF + 4 * n) : (f32x4){0.f, 0.f, 0.f, 0.f};
        const LAS unsigned long long* ssl = (const LAS unsigned long long*)aux + wr * 64 + fr;
#pragma unroll
        for (int ai = 0; ai < 2; ++ai)
#pragma unroll
            for (int m = 0; m < 4; ++m) { const int row = row0 + ai * HALF + m * 16; bf16_t* rowp = O + (size_t)row * ldc + col0;
                float rs = 1.0f; if (NORM) rs = 1.0f / sqrtf((float)ssl[ai * HALF + m * 16] * (1.0f / (16777216.0f * D)) + EPS);
#pragma unroll
                for (int bj = 0; bj < 2; ++bj) { const f32x4 v0 = acc[ai][bj][m][0] * rs + bv[bj][0], v1 = acc[ai][bj][m][1] * rs + bv[bj][1];
                    u32x4 w; w.x = cvt_pk_bf16(v0[0], v0[1]); w.y = cvt_pk_bf16(v0[2], v0[3]); w.z = cvt_pk_bf16(v1[0], v1[1]); w.w = cvt_pk_bf16(v1[2], v1[3]);
                    *(u32x4*)(rowp + bj * HALF) = w; } }
    }
};
struct EpiFp8 {
    static constexpr bool PERM = true, PREFETCH = false;
    unsigned char* O; int ldc;
    __device__ __forceinline__ void operator()(const f32x4 (&acc)[2][2][4][2], const Unit& u, int wr, int wc, int fr, int fq) const {
        const int row0 = u.pm * BM + wr * 64 + fr, col0 = u.pn * BM + wc * 32 + 8 * fq;
#pragma unroll
        for (int ai = 0; ai < 2; ++ai)
#pragma unroll
            for (int m = 0; m < 4; ++m) { unsigned char* rowp = O + (size_t)(row0 + ai * HALF + m * 16) * ldc + col0;
#pragma unroll
                for (int bj = 0; bj < 2; ++bj) { const f32x4 v0 = acc[ai][bj][m][0], v1 = acc[ai][bj][m][1];
                    int w0 = 0, w1 = 0;
                    w0 = __builtin_amdgcn_cvt_pk_fp8_f32(v0[0], v0[1], w0, false); w0 = __builtin_amdgcn_cvt_pk_fp8_f32(v0[2], v0[3], w0, true);
                    w1 = __builtin_amdgcn_cvt_pk_fp8_f32(v1[0], v1[1], w1, false); w1 = __builtin_amdgcn_cvt_pk_fp8_f32(v1[2], v1[3], w1, true);
                    u32x2 w; w.x = (unsigned)w0; w.y = (unsigned)w1; *(u32x2*)(rowp + bj * HALF) = w; }
                asm volatile("" ::: "memory"); }
    }
};
struct EpiInA {
    static constexpr bool PERM = true, PREFETCH = true;
    bf16_t* Q; bf16_t* CKV; bf16_t* QI; bf16_t* KIN; float* WI; const float* kg; const float* kb; const float* shw; const unsigned long long* SS;
    __device__ __forceinline__ void prefetch(LAS unsigned char* aux, const Unit& u, int wid, int lane) const {
        if (wid < 2) __builtin_amdgcn_global_load_lds((const unsigned*)((const char*)(SS + (size_t)u.pm * BM) + wid * 1024 + lane * 16), (LAS unsigned*)(aux + wid * 1024), 16, 0, 0);
        else if (wid == 2) __builtin_amdgcn_global_load_lds((const unsigned*)((const char*)(shw + (size_t)(u.pm >> 3) * 2048 + u.pn * BM) + lane * 16), (LAS unsigned*)(aux + 2048), 16, 0, 0);
    }
    __device__ __forceinline__ void operator()(f32x4 (&acc)[2][2][4][2], const Unit& u, int wr, int wc, int fr, int fq, const LAS unsigned char* aux) const {
        const int row0 = u.pm * BM + wr * 64 + fr, cl = wc * 32 + 8 * fq;
        {
            const LAS float* sp = (const LAS float*)(aux + 2048) + cl;
            const LAS unsigned long long* ssl = (const LAS unsigned long long*)aux + wr * 64 + fr;
            f32x4 bv[2][2];
#pragma unroll
            for (int bj = 0; bj < 2; ++bj)
#pragma unroll
                for (int n = 0; n < 2; ++n) bv[bj][n] = *(const LAS f32x4*)(sp + bj * HALF + 4 * n);
#pragma unroll
            for (int ai = 0; ai < 2; ++ai)
#pragma unroll
                for (int m = 0; m < 4; ++m) { const float rs = 1.0f / sqrtf((float)ssl[ai * HALF + m * 16] * (1.0f / (16777216.0f * D)) + EPS);
#pragma unroll
                    for (int bj = 0; bj < 2; ++bj)
#pragma unroll
                        for (int n = 0; n < 2; ++n) acc[ai][bj][m][n] = acc[ai][bj][m][n] * rs + bv[bj][n]; }
        }
        if (u.pn < 7) {
            bf16_t* base; int ldc, c0;
            if (u.pn < 4) { base = Q; ldc = 1024; c0 = u.pn * 256; } else if (u.pn == 4) { base = CKV; ldc = 256; c0 = 0; } else { base = QI; ldc = 512; c0 = (u.pn - 5) * 256; }
#pragma unroll
            for (int ai = 0; ai < 2; ++ai)
#pragma unroll
                for (int m = 0; m < 4; ++m) { bf16_t* rowp = base + (size_t)(row0 + ai * HALF + m * 16) * ldc + c0 + cl;
#pragma unroll
                    for (int bj = 0; bj < 2; ++bj) { const f32x4 v0 = acc[ai][bj][m][0], v1 = acc[ai][bj][m][1];
                        u32x4 w; w.x = cvt_pk_bf16(v0[0], v0[1]); w.y = cvt_pk_bf16(v0[2], v0[3]); w.z = cvt_pk_bf16(v1[0], v1[1]); w.w = cvt_pk_bf16(v1[2], v1[3]);
                        *(u32x4*)(rowp + bj * HALF) = w; } }
        } else if (wc == 0) {
            f32x4 gv[2][2], bv[2][2];
#pragma unroll
            for (int bj = 0; bj < 2; ++bj)
#pragma unroll
                for (int n = 0; n < 2; ++n) { gv[bj][n] = *(const f32x4*)(kg + 32 * bj + 8 * fq + 4 * n); bv[bj][n] = *(const f32x4*)(kb + 32 * bj + 8 * fq + 4 * n); }
#pragma unroll
            for (int ai = 0; ai < 2; ++ai)
#pragma unroll
                for (int m = 0; m < 4; ++m) {
                    float s = 0.f;
#pragma unroll
                    for (int bj = 0; bj < 2; ++bj)
#pragma unroll
                        for (int n = 0; n < 2; ++n) { const f32x4 x = acc[ai][bj][m][n]; s += (x[0] + x[1]) + (x[2] + x[3]); }
                    s += __shfl_xor(s, 16); s += __shfl_xor(s, 32);
                    const float mu = s * (1.0f / 64.0f); float q = 0.f;
#pragma unroll
                    for (int bj = 0; bj < 2; ++bj)
#pragma unroll
                        for (int n = 0; n < 2; ++n) { const f32x4 d = acc[ai][bj][m][n] - mu; q += (d[0] * d[0] + d[1] * d[1]) + (d[2] * d[2] + d[3] * d[3]); }
                    q += __shfl_xor(q, 16); q += __shfl_xor(q, 32);
                    const float rs = 1.0f / sqrtf(q * (1.0f / 64.0f) + EPS);
                    bf16_t* rowp = KIN + (size_t)(row0 + ai * HALF + m * 16) * 64 + 8 * fq;
#pragma unroll
                    for (int bj = 0; bj < 2; ++bj) { const f32x4 v0 = (acc[ai][bj][m][0] - mu) * rs * gv[bj][0] + bv[bj][0], v1 = (acc[ai][bj][m][1] - mu) * rs * gv[bj][1] + bv[bj][1];
                        u32x4 w; w.x = cvt_pk_bf16(v0[0], v0[1]); w.y = cvt_pk_bf16(v0[2], v0[3]); w.z = cvt_pk_bf16(v1[0], v1[1]); w.w = cvt_pk_bf16(v1[2], v1[3]);
                        *(u32x4*)(rowp + bj * 32) = w; }
                }
        } else if (wc == 1 && fq == 0) {
            const float sc = 0.04419417382415922f;
#pragma unroll
            for (int ai = 0; ai < 2; ++ai)
#pragma unroll
                for (int m = 0; m < 4; ++m) { float* rowp = WI + (size_t)(row0 + ai * HALF + m * 16) * 8;
                    *(f32x4*)(rowp) = acc[ai][0][m][0] * sc; *(f32x4*)(rowp + 4) = acc[ai][0][m][1] * sc; }
        }
    }
};
constexpr float Q8_CLIP = 4.75f;
__device__ __forceinline__ unsigned q8_bits(float v) { return __float_as_uint(__builtin_amdgcn_fmed3f(v, -127.0f, 127.0f) + 12582912.0f); }
__device__ __forceinline__ unsigned q8_pack(unsigned a, unsigned b, unsigned c, unsigned d) { return __builtin_amdgcn_perm(b, a, 0x0c0c0400u) | __builtin_amdgcn_perm(d, c, 0x04000c0cu); }
template <bool Q8> struct EpiResid {
    static constexpr bool PERM = true, PREFETCH = true;
    const bf16_t* xin_b; bf16_t* xout_b;
    const float* gate; const float* bias;
    bf16_t* XG; const float* gn; const float* scn; unsigned long long* SSo; const unsigned long long* SSq;
    __device__ __forceinline__ void prefetch(LAS unsigned char* aux, const Unit& u, int wid, int lane) const {
        const int b = u.pm >> 3; const char* src = nullptr;
        if (wid == 0) src = (const char*)(gate + (size_t)b * 6144 + u.pn * BM);
        else if (wid == 1) src = bias ? (const char*)(bias + u.pn * BM) : nullptr;
        else if constexpr (Q8) { if (wid == 4 || wid == 5) src = (const char*)(SSq + (size_t)u.pm * BM) + (wid - 4) * 1024; }
        else { if (wid == 2) src = XG ? (const char*)(gn + u.pn * BM) : nullptr;
               else if (wid == 3) src = XG ? (const char*)(scn + (size_t)b * 6144 + u.pn * BM) : nullptr; }
        if (src) __builtin_amdgcn_global_load_lds((const unsigned*)(src + lane * 16), (LAS unsigned*)(aux + wid * 1024), 16, 0, 0);
    }
    __device__ __forceinline__ void operator()(const f32x4 (&acc)[2][2][4][2], const Unit& u, int wr, int wc, int fr, int fq, const LAS unsigned char* aux) const {
        const int row0 = u.pm * BM + wr * 64 + fr, col0 = u.pn * BM + wc * 32 + 8 * fq, b = u.pm >> 3;
        const LAS unsigned long long* sql = (const LAS unsigned long long*)(aux + 4096) + wr * 64 + fr;
        const LAS float* lv = (const LAS float*)aux + wc * 32 + 8 * fq;
        float ssum[2][4];
#pragma unroll
        for (int ai = 0; ai < 2; ++ai)
#pragma unroll
            for (int m = 0; m < 4; ++m) ssum[ai][m] = 0.f;
#pragma unroll
        for (int bj = 0; bj < 2; ++bj) {
            const int c = col0 + bj * HALF;
            const LAS float* lp = lv + bj * HALF;
            const f32x4 gv0 = *(const LAS f32x4*)(lp), gv1 = *(const LAS f32x4*)(lp + 4);
            f32x4 bv0 = (f32x4){0.f, 0.f, 0.f, 0.f}, bv1 = bv0, gm0 = bv0, gm1 = bv0;
            if (bias) { bv0 = *(const LAS f32x4*)(lp + 256); bv1 = *(const LAS f32x4*)(lp + 256 + 4); }
            if (!Q8 && XG) { gm0 = *(const LAS f32x4*)(lp + 512) * (*(const LAS f32x4*)(lp + 768) + 1.0f); gm1 = *(const LAS f32x4*)(lp + 512 + 4) * (*(const LAS f32x4*)(lp + 768 + 4) + 1.0f); }
#pragma unroll
            for (int ai = 0; ai < 2; ++ai)
#pragma unroll
                for (int m = 0; m < 4; ++m) { const size_t off = (size_t)(row0 + ai * HALF + m * 16) * D + c;
                    const u32x4 xv = *(const u32x4*)(xin_b + off);
                    const f32x4 xi0 = (f32x4){__uint_as_float(xv.x << 16), __uint_as_float(xv.x & 0xffff0000u), __uint_as_float(xv.y << 16), __uint_as_float(xv.y & 0xffff0000u)};
                    const f32x4 xi1 = (f32x4){__uint_as_float(xv.z << 16), __uint_as_float(xv.z & 0xffff0000u), __uint_as_float(xv.w << 16), __uint_as_float(xv.w & 0xffff0000u)};
                    const f32x4 xo0 = xi0 + gv0 * (acc[ai][bj][m][0] + bv0), xo1 = xi1 + gv1 * (acc[ai][bj][m][1] + bv1);
                    { u32x4 w; w.x = cvt_pk_bf16(xo0[0], xo0[1]); w.y = cvt_pk_bf16(xo0[2], xo0[3]); w.z = cvt_pk_bf16(xo1[0], xo1[1]); w.w = cvt_pk_bf16(xo1[2], xo1[3]); *(u32x4*)(xout_b + off) = w; }
                    if (XG) {
                        ssum[ai][m] += ((xo0[0] * xo0[0] + xo0[1] * xo0[1]) + (xo0[2] * xo0[2] + xo0[3] * xo0[3])) + ((xo1[0] * xo1[0] + xo1[1] * xo1[1]) + (xo1[2] * xo1[2] + xo1[3] * xo1[3]));
                        if constexpr (Q8) {
                            const float qs = (127.0f / Q8_CLIP) / sqrtf((float)sql[ai * HALF + m * 16] * (1.0f / (16777216.0f * D)) + EPS);
                            u32x2 w; w.x = q8_pack(q8_bits(xo0[0] * qs), q8_bits(xo0[1] * qs), q8_bits(xo0[2] * qs), q8_bits(xo0[3] * qs));
                            w.y = q8_pack(q8_bits(xo1[0] * qs), q8_bits(xo1[1] * qs), q8_bits(xo1[2] * qs), q8_bits(xo1[3] * qs));
                            *(u32x2*)((unsigned char*)XG + off) = w;
                        } else {
                        const f32x4 y0 = xo0 * gm0, y1 = xo1 * gm1;
                        u32x4 w; w.x = cvt_pk_bf16(y0[0], y0[1]); w.y = cvt_pk_bf16(y0[2], y0[3]); w.z = cvt_pk_bf16(y1[0], y1[1]); w.w = cvt_pk_bf16(y1[2], y1[3]);
                        *(u32x4*)(XG + off) = w; } }
                    if (m & 1) asm volatile("" ::: "memory"); }
        }
        if (XG) {
#pragma unroll
            for (int ai = 0; ai < 2; ++ai)
#pragma unroll
                for (int m = 0; m < 4; ++m) { float q = ssum[ai][m]; q += __shfl_xor(q, 16); q += __shfl_xor(q, 32);
                    if (fq == 0) atomicAdd(SSo + row0 + ai * HALF + m * 16, (unsigned long long)(q * 16777216.0f)); }
        }
    }
};
struct EpiSwiGLU {
    static constexpr bool PERM = true, PREFETCH = true;
    bf16_t* H; const float* shw; const unsigned long long* SS; const float* CW; const unsigned long long* SSq;
    __device__ __forceinline__ void prefetch(LAS unsigned char* aux, const Unit& u, int wid, int lane) const {
        if (wid < 2) __builtin_amdgcn_global_load_lds((const unsigned*)((const char*)(SS + (size_t)u.pm * BM) + wid * 1024 + lane * 16), (LAS unsigned*)(aux + wid * 1024), 16, 0, 0);
        else if (wid == 2) __builtin_amdgcn_global_load_lds((const unsigned*)((const char*)(shw + (size_t)(u.pm >> 3) * (2 * DFF) + u.pn * BM) + lane * 16), (LAS unsigned*)(aux + 2048), 16, 0, 0);
        else if (wid == 3) __builtin_amdgcn_global_load_lds((const unsigned*)((const char*)(CW + (size_t)(u.pm >> 3) * (2 * DFF) + u.pn * BM) + lane * 16), (LAS unsigned*)(aux + 3072), 16, 0, 0);
        else if (wid < 6) __builtin_amdgcn_global_load_lds((const unsigned*)((const char*)(SSq + (size_t)u.pm * BM) + (wid - 4) * 1024 + lane * 16), (LAS unsigned*)(aux + wid * 1024), 16, 0, 0);
    }
    __device__ __forceinline__ void operator()(const f32x4 (&acc)[2][2][4][2], const Unit& u, int wr, int wc, int fr, int fq, const LAS unsigned char* aux) const {
        const int row0 = u.pm * BM + wr * 64 + fr, f0 = u.pn * 128 + wc * 32 + 8 * fq;
        f32x4 bv[2][2], cv[2][2];
        { const LAS float* sp = (const LAS float*)(aux + 2048) + wc * 32 + 8 * fq;
#pragma unroll
          for (int bj = 0; bj < 2; ++bj)
#pragma unroll
              for (int n = 0; n < 2; ++n) { bv[bj][n] = *(const LAS f32x4*)(sp + bj * HALF + 4 * n); cv[bj][n] = *(const LAS f32x4*)(sp + 256 + bj * HALF + 4 * n); } }
        const LAS unsigned long long* ssl = (const LAS unsigned long long*)aux + wr * 64 + fr;
        const LAS unsigned long long* sql = (const LAS unsigned long long*)(aux + 4096) + wr * 64 + fr;
#pragma unroll
        for (int ai = 0; ai < 2; ++ai)
#pragma unroll
            for (int m = 0; m < 4; ++m) { bf16_t* rowp = H + (size_t)(row0 + ai * HALF + m * 16) * DFF + f0;
                const float rs = (Q8_CLIP / 127.0f) * sqrtf((float)sql[ai * HALF + m * 16] * (1.0f / (16777216.0f * D)) + EPS) / sqrtf((float)ssl[ai * HALF + m * 16] * (1.0f / (16777216.0f * D)) + EPS);
                float o[8];
#pragma unroll
                for (int n = 0; n < 2; ++n)
#pragma unroll
                    for (int e = 0; e < 4; ++e) { const float a0 = (float)__float_as_int(acc[ai][0][m][n][e]) * rs, a1 = (float)__float_as_int(acc[ai][1][m][n][e]) * rs;
                        o[4 * n + e] = silu_f(a0 * cv[0][n][e] + bv[0][n][e]) * (a1 * cv[1][n][e] + bv[1][n][e]); }
                u32x4 w; w.x = cvt_pk_bf16(o[0], o[1]); w.y = cvt_pk_bf16(o[2], o[3]); w.z = cvt_pk_bf16(o[4], o[5]); w.w = cvt_pk_bf16(o[6], o[7]);
                *(u32x4*)(rowp) = w; }
    }
};
}

struct Ptrs {
    const float* in[23]; float* out; unsigned char* ws;
};
enum { I_X = 0, I_C, I_RELB, I_WADA, I_BADA, I_GMIX, I_GFFN, I_AWIN, I_AKVG, I_AWUK, I_AWUV, I_AIKG, I_AIKB, I_AWOUT, I_BWIN, I_BBIN, I_BSINK, I_BWOUT, I_BBOUT, I_W1, I_W3, I_W2, I_GFIN };

__device__ __forceinline__ void conv_task(const Ptrs& P, int t, int lane) {
    int kind, rb, ks, Kd; bf16_t* dst; const float* s0 = nullptr; const float* s1 = nullptr; const float* gk = nullptr; int ld = 0;
    if (t < 2112) { const int l = t / 528, r = t % 528; unsigned char* wl = P.ws + WS_W + (size_t)l * W_LAYER;
        if (r < 352) { kind = 1; rb = r >> 2; ks = r & 3; Kd = 1024; dst = (bf16_t*)(wl + W13_OFF); s0 = P.in[I_W1] + (size_t)l * D * DFF; s1 = P.in[I_W3] + (size_t)l * D * DFF; ld = DFF; }
        else { const int r2 = r - 352; kind = 0; rb = r2 / 11; ks = r2 % 11; Kd = DFF; dst = (bf16_t*)(wl + W2_OFF); s0 = P.in[I_W2] + (size_t)l * DFF * D; ld = D; }
    } else { const int t2 = t - 2112, j = t2 / 464, r = t2 % 464; unsigned char* wa = P.ws + WS_WA + (size_t)j * WA_STRIDE; unsigned char* wb = P.ws + WS_WB + (size_t)j * WB_STRIDE;
        if (r < 128) { kind = 2; rb = r >> 2; ks = r & 3; Kd = 1024; dst = (bf16_t*)(wa + WINA_OFF); s0 = P.in[I_AWIN] + (size_t)j * D * A_IN; ld = A_IN; }
        else if (r < 192) { kind = 3; rb = r - 128; ks = 0; Kd = 256; dst = (bf16_t*)(wa + WQA_OFF); s0 = P.in[I_AWUK] + (size_t)j * NH * RK * HD; gk = P.in[I_AKVG] + j * RK; }
        else if (r < 256) { const int r2 = r - 192; kind = 4; rb = r2 >> 2; ks = r2 & 3; Kd = 1024; dst = (bf16_t*)(wa + WUV_OFF); s0 = P.in[I_AWUV] + (size_t)j * NH * RK * HD; gk = P.in[I_AKVG] + j * RK; }
        else if (r < 320) { const int r2 = r - 256; kind = 0; rb = r2 >> 2; ks = r2 & 3; Kd = 1024; dst = (bf16_t*)(wa + WOUTA_OFF); s0 = P.in[I_AWOUT] + (size_t)j * D * D; ld = D; }
        else if (r < 400) { const int r2 = r - 320; kind = 0; rb = r2 >> 2; ks = r2 & 3; Kd = 1024; dst = (bf16_t*)(wb + WINB_OFF); s0 = P.in[I_BWIN] + (size_t)j * D * B_IN; ld = B_IN; }
        else { const int r2 = r - 400; kind = 0; rb = r2 >> 2; ks = r2 & 3; Kd = 1024; dst = (bf16_t*)(wb + WOUTB_OFF); s0 = P.in[I_BWOUT] + (size_t)j * D * D; ld = D; }
    }
    const int n = rb * 64 + lane, k0 = ks * 256;
    bf16_t* drow = dst + (size_t)n * Kd + k0;
    if (kind <= 2) {
        const float* src = s0; int col = n;
        if (kind == 1) { const int c = n & 255, f = (n >> 8) * 128 + (c & 127); src = (c < 128) ? s0 : s1; col = f; }
        if (kind == 2) { if (n >= 1792) { const int c = n - 1792; col = c < 32 ? 1792 + c : (c < 40 ? 1856 + (c - 32) : ((c >= 128 && c < 160) ? 1824 + (c - 128) : -1)); } }
        const float* sp = src + (size_t)k0 * ld + (col < 0 ? 0 : col);
        for (int kc = 0; kc < 32; ++kc) {
            float v[8];
#pragma unroll
            for (int e = 0; e < 8; ++e) v[e] = sp[(size_t)(kc * 8 + e) * ld];
            if (col < 0) {
#pragma unroll
                for (int e = 0; e < 8; ++e) v[e] = 0.f; }
            u32x4 w; w.x = cvt_pk_bf16(v[0], v[1]); w.y = cvt_pk_bf16(v[2], v[3]); w.z = cvt_pk_bf16(v[4], v[5]); w.w = cvt_pk_bf16(v[6], v[7]);
            *(u32x4*)(drow + kc * 8) = w;
        }
    } else if (kind == 3) {
        const int h = n >> 8, r = n & 255; const float gs = gk[r] * 8.0f;       const float* sp = s0 + ((size_t)h * RK + r) * HD;
        for (int kc = 0; kc < 32; ++kc) { const int k = kc * 8; float v[8];
            if ((k >> 6) == (h & 3)) {
#pragma unroll
                for (int e = 0; e < 8; ++e) v[e] = sp[(k & 63) + e] * gs;
            } else {
#pragma unroll
                for (int e = 0; e < 8; ++e) v[e] = 0.f; }
            u32x4 w; w.x = cvt_pk_bf16(v[0], v[1]); w.y = cvt_pk_bf16(v[2], v[3]); w.z = cvt_pk_bf16(v[4], v[5]); w.w = cvt_pk_bf16(v[6], v[7]);
            *(u32x4*)(drow + kc * 8) = w; }
    } else {
        const int hh = (n >> 6) & 3, d = n & 63, h = n >> 6;
        for (int kc = 0; kc < 32; ++kc) { const int k = k0 + kc * 8; float v[8];
            if ((k >> 8) == hh) {
#pragma unroll
                for (int e = 0; e < 8; ++e) { const int r = (k & 255) + e; v[e] = s0[((size_t)h * RK + r) * HD + d] * gk[r]; }
            } else {
#pragma unroll
                for (int e = 0; e < 8; ++e) v[e] = 0.f; }
            u32x4 w; w.x = cvt_pk_bf16(v[0], v[1]); w.y = cvt_pk_bf16(v[2], v[3]); w.z = cvt_pk_bf16(v[4], v[5]); w.w = cvt_pk_bf16(v[6], v[7]);
            *(u32x4*)(drow + kc * 8) = w; }
    }
}
constexpr int N_CONV_TASKS = 3040;

__device__ __forceinline__ void p0_prologue(const Ptrs& P, LAS unsigned char* lds, int G) {
    int tid = threadIdx.x; asm volatile("" : "+v"(tid));
    const int lane = tid & 63, wave = __builtin_amdgcn_readfirstlane(tid >> 6);
    const int gw = blockIdx.x * NWAVES + wave, NGW = G * NWAVES;
    for (int t = gw; t < N_CONV_TASKS; t += NGW) conv_task(P, t, lane);
    LAS float* cs = (LAS float*)lds;
    LAS float* red = (LAS float*)(lds + 65536);
    for (int i = tid; i < BATCH * D; i += NTHR) { const int b = i >> 10, k = i & 1023; cs[k * 16 + b] = silu_f(P.in[I_C][i]); }
    __syncthreads();
    float* mod = (float*)(P.ws + WS_MOD);
    for (int task = blockIdx.x; task < 4 * 96; task += G) {
        const int l = task / 96, j0 = (task % 96) * 64, col = tid & 63, ksl = tid >> 6;
        const float* wp = P.in[I_WADA] + ((size_t)l * D + ksl * 128) * 6144 + j0 + col;
        float a[16];
#pragma unroll
        for (int b = 0; b < 16; ++b) a[b] = 0.f;
        for (int k = 0; k < 128; ++k) { const float w = wp[(size_t)k * 6144]; const LAS f32x4* c4 = (const LAS f32x4*)(cs + (ksl * 128 + k) * 16);
#pragma unroll
            for (int q = 0; q < 4; ++q) { const f32x4 c = c4[q];
#pragma unroll
                for (int e = 0; e < 4; ++e) a[4 * q + e] += w * c[e]; } }
#pragma unroll
        for (int b = 0; b < 16; ++b) red[(ksl * 64 + col) * 16 + b] = a[b];
        __syncthreads();
        for (int o = tid; o < 1024; o += NTHR) { const int c2 = o >> 4, b = o & 15; float s = 0.f;
#pragma unroll
            for (int q = 0; q < 8; ++q) s += red[(q * 64 + c2) * 16 + b];
            mod[((size_t)l * BATCH + b) * 6144 + j0 + c2] = s + P.in[I_BADA][l * 6144 + j0 + c2]; }
        __syncthreads();
    }
}

__device__ __forceinline__ void pre_phase(const Ptrs& P, LAS unsigned char* lds, int G) {
    int tid = threadIdx.x; asm volatile("" : "+v"(tid));
    const int lane = tid & 63, wave = __builtin_amdgcn_readfirstlane(tid >> 6);
    const float* mod = (const float*)(P.ws + WS_MOD);
    {
        const int grp = blockIdx.x & 7, l = grp >> 1, kind = grp & 1, j = l >> 1;
        const float* shsrc = mod + (size_t)l * BATCH * 6144 + (kind ? 3072 : 0);
        constexpr int SP = 2064;
        for (int i = tid; i < BATCH * D / 2; i += NTHR) { const int b = i >> 9, k2 = (i & 511) * 2;
            const float a0 = shsrc[(size_t)b * 6144 + k2], a1 = shsrc[(size_t)b * 6144 + k2 + 1];
            *(LAS unsigned*)(lds + b * SP + k2 * 2) = cvt_pk_bf16(a0, a1); }
        __syncthreads();
        const bf16_t* W; int nrows; float* dst; const float* bias = nullptr;
        if (kind) { W = (const bf16_t*)(P.ws + WS_W + (size_t)l * W_LAYER + W13_OFF); nrows = 2 * DFF; dst = (float*)(P.ws + WS_SHW + SHW_F) + (size_t)l * BATCH * 2 * DFF; }
        else if ((l & 1) == 0) { W = (const bf16_t*)(P.ws + WS_WA + (size_t)j * WA_STRIDE + WINA_OFF); nrows = 2048; dst = (float*)(P.ws + WS_SHW + SHW_A) + (size_t)j * BATCH * 2048; }
        else { W = (const bf16_t*)(P.ws + WS_WB + (size_t)j * WB_STRIDE + WINB_OFF); nrows = B_IN; dst = (float*)(P.ws + WS_SHW + SHW_B) + (size_t)j * BATCH * B_IN; bias = P.in[I_BBIN] + j * B_IN; }
        const int nblk = nrows >> 4, wq = (blockIdx.x >> 3) * NWAVES + wave, nwq = (G >> 3) * NWAVES;
        const int nn = lane & 15, g = lane >> 4;
        for (int blk = wq; blk < nblk; blk += nwq) {
            f32x4 acc = (f32x4){0.f, 0.f, 0.f, 0.f};
            const bf16_t* wp = W + (size_t)(blk * 16 + nn) * D + 8 * g;
#pragma unroll 8
            for (int ks = 0; ks < 32; ++ks) { const bf16x8 a = *(const LAS bf16x8*)(lds + nn * SP + (32 * ks + 8 * g) * 2); const bf16x8 bw = *(const bf16x8*)(wp + 32 * ks);
                acc = __builtin_amdgcn_mfma_f32_16x16x32_bf16(a, bw, acc, 0, 0, 0); }
            const int n = blk * 16 + nn; const float bb = bias ? bias[n] : 0.f;
#pragma unroll
            for (int i = 0; i < 4; ++i) dst[(size_t)(4 * g + i) * nrows + n] = acc[i] + bb;
        }
    }
    {
        const int gw = blockIdx.x * NWAVES + wave, NGW = G * NWAVES;
        const float* x = P.in[I_X]; const float* gmix = P.in[I_GMIX]; bf16_t* XG = (bf16_t*)(P.ws + WS_XG); unsigned long long* SS0 = (unsigned long long*)(P.ws + WS_SS);
        for (int row = gw; row < M; row += NGW) {
            const int b = row >> 11;
            const f32x4* xr = (const f32x4*)(x + (size_t)row * D) + lane;
            f32x4 v[4]; float sq = 0.f;
#pragma unroll
            for (int jj = 0; jj < 4; ++jj) { v[jj] = xr[64 * jj]; sq += (v[jj][0] * v[jj][0] + v[jj][1] * v[jj][1]) + (v[jj][2] * v[jj][2] + v[jj][3] * v[jj][3]); }
            const float ss = wave_sum(sq);
            if (lane == 0) SS0[row] = (unsigned long long)(ss * 16777216.0f);
            const float* mb = mod + (size_t)b * 6144;
            u32x2* o8 = (u32x2*)(XG + (size_t)row * D) + lane; u32x2* x8 = (u32x2*)((bf16_t*)P.out + (size_t)row * D) + lane;
#pragma unroll
            for (int jj = 0; jj < 4; ++jj) { const int c = 4 * lane + 256 * jj;
                const f32x4 y = v[jj] * *(const f32x4*)(gmix + c) * (*(const f32x4*)(mb + 1024 + c) + 1.0f);
                u32x2 w; w.x = cvt_pk_bf16(y[0], y[1]); w.y = cvt_pk_bf16(y[2], y[3]); o8[64 * jj] = w;
                u32x2 xw; xw.x = cvt_pk_bf16(v[jj][0], v[jj][1]); xw.y = cvt_pk_bf16(v[jj][2], v[jj][3]); x8[64 * jj] = xw; }
        }
    }
}
__device__ __forceinline__ float half_max(float x);
__device__ __forceinline__ float wave_max(float x) {
    const float h = half_max(x);
    const u32x2 r = __builtin_amdgcn_permlane32_swap(__float_as_uint(h), __float_as_uint(h), false, false);
    return fmaxf(__uint_as_float(r.x), __uint_as_float(r.y));
}
__device__ __forceinline__ void w8_build(const bf16_t* W13, const float* gffn, const float* scn, unsigned char* W8, float* CW, LAS unsigned char* lds, int G) {
    int tid = threadIdx.x; asm volatile("" : "+v"(tid));
    const int lane = tid & 63, wave = __builtin_amdgcn_readfirstlane(tid >> 6);
    LAS float* mL = (LAS float*)lds;
    for (int i = tid; i < BATCH * D / 4; i += NTHR) { const int b = i >> 8, k4 = (i & 255) * 4;
        *(LAS f32x4*)(mL + b * D + k4) = *(const f32x4*)(gffn + k4) * (*(const f32x4*)(scn + (size_t)b * 6144 + k4) + 1.0f); }
    __syncthreads();
    const int gw = blockIdx.x * NWAVES + wave, NGW = G * NWAVES;
    for (int n = gw; n < 2 * DFF; n += NGW) {
        const u32x2* wrow = (const u32x2*)(W13 + (size_t)n * D) + lane;
        float w[16];
#pragma unroll
        for (int j = 0; j < 4; ++j) { const u32x2 p = wrow[64 * j];
            w[4 * j] = __uint_as_float(p.x << 16); w[4 * j + 1] = __uint_as_float(p.x & 0xffff0000u); w[4 * j + 2] = __uint_as_float(p.y << 16); w[4 * j + 3] = __uint_as_float(p.y & 0xffff0000u); }
        unsigned* orow = (unsigned*)(W8 + (size_t)n * D) + lane;
#pragma unroll 2
        for (int b = 0; b < BATCH; ++b) {
            float v[16]; float mx = 0.f;
#pragma unroll
            for (int j = 0; j < 4; ++j) { const f32x4 mm = *(const LAS f32x4*)(mL + b * D + 256 * j + 4 * lane);
#pragma unroll
                for (int e = 0; e < 4; ++e) { v[4 * j + e] = w[4 * j + e] * mm[e]; mx = fmaxf(mx, fabsf(v[4 * j + e])); } }
            mx = fmaxf(wave_max(mx), 1e-30f);
            const float inv = 127.0f / mx;
#pragma unroll
            for (int j = 0; j < 4; ++j)
                orow[(size_t)b * (W8_BATCH / 4) + 64 * j] = pg8::q8_pack(pg8::q8_bits(v[4 * j] * inv), pg8::q8_bits(v[4 * j + 1] * inv), pg8::q8_bits(v[4 * j + 2] * inv), pg8::q8_bits(v[4 * j + 3] * inv));
            if (lane == 0) CW[(size_t)b * (2 * DFF) + n] = mx * (1.0f / 127.0f);
        }
    }
    __syncthreads();
}
__device__ __forceinline__ void final_norm_phase(const bf16_t* x, float* out, const float* g, int G) {
    int tid = threadIdx.x; asm volatile("" : "+v"(tid));
    const int lane = tid & 63, wave = __builtin_amdgcn_readfirstlane(tid >> 6);
    const int gw = blockIdx.x * NWAVES + wave, NGW = G * NWAVES;
    for (int row = gw; row < M; row += NGW) {
        const u32x2* xr = (const u32x2*)(x + (size_t)row * D) + lane; f32x4* orow = (f32x4*)(out + (size_t)row * D) + lane;
        f32x4 v[4]; float s = 0.f;
#pragma unroll
        for (int j = 0; j < 4; ++j) { const u32x2 p = xr[64 * j];
            v[j] = (f32x4){__uint_as_float(p.x << 16), __uint_as_float(p.x & 0xffff0000u), __uint_as_float(p.y << 16), __uint_as_float(p.y & 0xffff0000u)};
            s += (v[j][0] * v[j][0] + v[j][1] * v[j][1]) + (v[j][2] * v[j][2] + v[j][3] * v[j][3]); }
        const float rstd = 1.0f / sqrtf(wave_sum(s) * (1.0f / D) + EPS);
#pragma unroll
        for (int j = 0; j < 4; ++j) { const f32x4 gg = *(const f32x4*)(g + 4 * lane + 256 * j); orow[64 * j] = v[j] * rstd * gg; }
    }
}

__device__ __forceinline__ unsigned f2key(float f) { const unsigned u = __float_as_uint(f); return (u & 0x80000000u) ? ~u : (u | 0x80000000u); }
__device__ __forceinline__ float key2f(unsigned k) { return __uint_as_float((k & 0x80000000u) ? (k & 0x7fffffffu) : ~k); }
__device__ __forceinline__ float half_max(float x) {
    int u = __float_as_int(x);
    u = __float_as_int(fmaxf(__int_as_float(u), __int_as_float(__builtin_amdgcn_update_dpp(u, u, 0x128, 0xf, 0xf, false))));
    u = __float_as_int(fmaxf(__int_as_float(u), __int_as_float(__builtin_amdgcn_update_dpp(u, u, 0x124, 0xf, 0xf, false))));
    u = __float_as_int(fmaxf(__int_as_float(u), __int_as_float(__builtin_amdgcn_update_dpp(u, u, 0x122, 0xf, 0xf, false))));
    u = __float_as_int(fmaxf(__int_as_float(u), __int_as_float(__builtin_amdgcn_update_dpp(u, u, 0x121, 0xf, 0xf, false))));
    const u32x2 r = __builtin_amdgcn_permlane16_swap((unsigned)u, (unsigned)u, false, false);
    return fmaxf(__uint_as_float(r.x), __uint_as_float(r.y));
}
__device__ __forceinline__ float half_sum_f(float v) {
    v += __int_as_float(__builtin_amdgcn_update_dpp(__float_as_int(v), __float_as_int(v), 0x128, 0xf, 0xf, false));
    v += __int_as_float(__builtin_amdgcn_update_dpp(__float_as_int(v), __float_as_int(v), 0x124, 0xf, 0xf, false));
    v += __int_as_float(__builtin_amdgcn_update_dpp(__float_as_int(v), __float_as_int(v), 0x122, 0xf, 0xf, false));
    v += __int_as_float(__builtin_amdgcn_update_dpp(__float_as_int(v), __float_as_int(v), 0x121, 0xf, 0xf, false));
    const u32x2 r = __builtin_amdgcn_permlane16_swap(__float_as_uint(v), __float_as_uint(v), false, false);
    return __uint_as_float(r.x) + __uint_as_float(r.y);
}
__device__ __forceinline__ f32x2 pk_gt(f32x2 x, f32x2 big, f32x2 nfbig) { f32x2 d; asm("v_pk_fma_f32 %0, %1, %2, %3 clamp" : "=v"(d) : "v"(x), "v"(big), "v"(nfbig)); return d; }
__device__ __forceinline__ int half_sum(int v) {
    v += __builtin_amdgcn_update_dpp(v, v, 0x128, 0xf, 0xf, false);
    v += __builtin_amdgcn_update_dpp(v, v, 0x124, 0xf, 0xf, false);
    v += __builtin_amdgcn_update_dpp(v, v, 0x122, 0xf, 0xf, false);
    v += __builtin_amdgcn_update_dpp(v, v, 0x121, 0xf, 0xf, false);
    const u32x2 r = __builtin_amdgcn_permlane16_swap((unsigned)v, (unsigned)v, false, false);
    return (int)(r.x + r.y);
}
typedef float f32x32 __attribute__((ext_vector_type(32)));
__device__ __forceinline__ void idx_task(const bf16_t* QI, const bf16_t* KIN, const float* WI, unsigned* SEL, LAS unsigned char* lds, int b, int tg, int lane, int wave, bool active, int nrounds) {
    asm volatile("" : "+v"(lane));
    const int t0 = tg * 4, h = lane >> 5, r = lane & 31;
    const int qsel = 2 * (r >> 4) + ((r >> 2) & 1), hd = (r & 3) + 4 * ((r >> 3) & 1);
    const size_t rowb = (size_t)b * SEQ;
    bf16x8 aq[4];
#pragma unroll
    for (int ks = 0; ks < 4; ++ks) aq[ks] = *(const bf16x8*)(QI + (rowb + t0 + qsel) * 512 + hd * 64 + ks * 16 + h * 8);
    float wlo[8], whi[8];
    { const f32x4 a0 = *(const f32x4*)(WI + (rowb + t0 + h) * 8), a1 = *(const f32x4*)(WI + (rowb + t0 + h) * 8 + 4);
      const f32x4 b0 = *(const f32x4*)(WI + (rowb + t0 + 2 + h) * 8), b1 = *(const f32x4*)(WI + (rowb + t0 + 2 + h) * 8 + 4);
#pragma unroll
      for (int e = 0; e < 4; ++e) { wlo[e] = a0[e]; wlo[4 + e] = a1[e]; whi[e] = b0[e]; whi[4 + e] = b1[e]; } }
    f32x32 sA0, sA1, sB0, sB1;
#pragma unroll
    for (int i = 0; i < 32; ++i) { sA0[i] = NEGF; sA1[i] = NEGF; sB0[i] = NEGF; sB1[i] = NEGF; }
    const int ktmax = (t0 + 3) >> 5, tlo = t0 + h, thi = t0 + 2 + h;
    const unsigned lb = (unsigned)(size_t)lds;
    const int sw = (r >> 1) & 7;
#define IDX_LDS4(R0, R1, R2, R3) asm volatile("ds_read_b128 %0, %4\n\tds_read_b128 %1, %5\n\tds_read_b128 %2, %6\n\tds_read_b128 %3, %7" \
                                             : "=&v"(R0), "=&v"(R1), "=&v"(R2), "=&v"(R3) : "v"(a0), "v"(a1), "v"(a2), "v"(a3) : "memory")
#define IDX_TILE(KTL, KEY0, SA, SB, C0, C1, C2, C3, N0, N1, N2, N3) \
        { \
            a0 += 4096u; a1 += 4096u; a2 += 4096u; a3 += 4096u; \
            IDX_LDS4(N0, N1, N2, N3);                          \
            asm volatile("s_waitcnt lgkmcnt(4)" : "+v"(C0), "+v"(C1), "+v"(C2), "+v"(C3) :: "memory");     \
            f32x16 acc; \
            _Pragma("unroll") for (int i = 0; i < 16; ++i) acc[i] = 0.f; \
            acc = __builtin_amdgcn_mfma_f32_32x32x16_bf16(aq[0], C0, acc, 0, 0, 0); acc = __builtin_amdgcn_mfma_f32_32x32x16_bf16(aq[1], C1, acc, 0, 0, 0); \
            acc = __builtin_amdgcn_mfma_f32_32x32x16_bf16(aq[2], C2, acc, 0, 0, 0); acc = __builtin_amdgcn_mfma_f32_32x32x16_bf16(aq[3], C3, acc, 0, 0, 0); \
            f32x2 p0 = (f32x2){0.f, 0.f}, p1 = (f32x2){0.f, 0.f};            \
            _Pragma("unroll") for (int i = 0; i < 4; ++i) { \
                const f32x2 r0 = (f32x2){__builtin_amdgcn_fmed3f(acc[2 * i], 0.f, 3.0e38f), __builtin_amdgcn_fmed3f(acc[2 * i + 1], 0.f, 3.0e38f)}; \
                const f32x2 r1 = (f32x2){__builtin_amdgcn_fmed3f(acc[8 + 2 * i], 0.f, 3.0e38f), __builtin_amdgcn_fmed3f(acc[9 + 2 * i], 0.f, 3.0e38f)}; \
                p0 = __builtin_elementwise_fma((f32x2){wlo[2 * i], wlo[2 * i + 1]}, r0, p0); p1 = __builtin_elementwise_fma((f32x2){whi[2 * i], whi[2 * i + 1]}, r1, p1); } \
            const float s0 = p0.x + p0.y, s1 = p1.x + p1.y; \
            const int key = (KEY0) + r; \
            SA[KTL] = key <= tlo ? s0 : NEGF; SB[KTL] = key <= thi ? s1 : NEGF; \
        }
    bf16x8 ta0, ta1, ta2, ta3, tb0, tb1, tb2, tb3;
#pragma unroll
    for (int rnd = 0; rnd < 2; ++rnd) {
        if (rnd >= nrounds) break;
        __syncthreads();
        {
            const int rl = lane >> 3, pp = lane & 7;
#pragma unroll 4
            for (int j = 0; j < 16; ++j) { const int pi = wave * 16 + j, row = 8 * pi + rl;
                const bf16_t* src = KIN + (rowb + 1024 * rnd + row) * 64 + 8 * (pp ^ ((row >> 1) & 7));
                __builtin_amdgcn_global_load_lds((const unsigned*)src, (LAS unsigned*)(lds + 1024 * pi), 16, 0, 0); }
        }
        asm volatile("s_waitcnt vmcnt(0)" ::: "memory");
        __syncthreads();
        const int ntl = ktmax - 32 * rnd + 1;
        if (active && ntl > 0) {
            const int npair = ((ntl < 32 ? ntl : 32) + 1) >> 1;
            unsigned a0 = lb + (unsigned)r * 128u + 16u * (unsigned)((0 + h) ^ sw), a1 = lb + (unsigned)r * 128u + 16u * (unsigned)((2 + h) ^ sw);
            unsigned a2 = lb + (unsigned)r * 128u + 16u * (unsigned)((4 + h) ^ sw), a3 = lb + (unsigned)r * 128u + 16u * (unsigned)((6 + h) ^ sw);
            IDX_LDS4(ta0, ta1, ta2, ta3);
#pragma nounroll
            for (int kp = 0; kp < npair; ++kp) {
                if (rnd == 0) { IDX_TILE(2 * kp, 64 * kp, sA0, sB0, ta0, ta1, ta2, ta3, tb0, tb1, tb2, tb3)
                                IDX_TILE(2 * kp + 1, 64 * kp + 32, sA0, sB0, tb0, tb1, tb2, tb3, ta0, ta1, ta2, ta3) }
                else          { IDX_TILE(2 * kp, 1024 + 64 * kp, sA1, sB1, ta0, ta1, ta2, ta3, tb0, tb1, tb2, tb3)
                                IDX_TILE(2 * kp + 1, 1024 + 64 * kp + 32, sA1, sB1, tb0, tb1, tb2, tb3, ta0, ta1, ta2, ta3) }
            }
            asm volatile("s_waitcnt lgkmcnt(0)" : "+v"(ta0), "+v"(ta1), "+v"(ta2), "+v"(ta3), "+v"(tb0), "+v"(tb1), "+v"(tb2), "+v"(tb3) :: "memory");
        }
    }
#undef IDX_TILE
#undef IDX_LDS4
    if (!active) return;
    const int nt0 = ktmax < 31 ? ktmax + 1 : 32, nt1 = ktmax - 31;
    float mxA = NEGF, mxB = NEGF, mnA = -NEGF, mnB = -NEGF;
#pragma nounroll
    for (int kt = 0; kt < nt0; ++kt) { const float a = sA0[kt], bb = sB0[kt];
        mxA = fmaxf(mxA, a); mxB = fmaxf(mxB, bb); mnA = fminf(mnA, a > -1e29f ? a : -NEGF); mnB = fminf(mnB, bb > -1e29f ? bb : -NEGF); }
#pragma nounroll
    for (int kt = 0; kt < nt1; ++kt) { const float a = sA1[kt], bb = sB1[kt];
        mxA = fmaxf(mxA, a); mxB = fmaxf(mxB, bb); mnA = fminf(mnA, a > -1e29f ? a : -NEGF); mnB = fminf(mnB, bb > -1e29f ? bb : -NEGF); }
    mxA = half_max(mxA); mxB = half_max(mxB); mnA = -half_max(-mnA); mnB = -half_max(-mnB);
    const int Ka = tlo + 1 < TOPK ? tlo + 1 : TOPK, Kb = thi + 1 < TOPK ? thi + 1 : TOPK;
    float loA = mnA - (fabsf(mnA) * 1e-6f + 1e-30f), hiA = mxA, loB = mnB - (fabsf(mnB) * 1e-6f + 1e-30f), hiB = mxB;
    float cloA = (float)(tlo + 1), chiA = 0.0f, cloB = (float)(thi + 1), chiB = 0.0f;
    float TA = -1e29f, TB = -1e29f; bool doneA = (tlo + 1 <= TOPK), doneB = (thi + 1 <= TOPK);
    const int nblk = (ktmax >> 3) + 1;
    const float BIG = 1099511627776.0f;
#define SA2(i) ((i) < 32 ? (f32x2){sA0[(i) & 31], sA0[((i) & 31) + 1]} : (f32x2){sA1[(i) & 31], sA1[((i) & 31) + 1]})
#define SB2(i) ((i) < 32 ? (f32x2){sB0[(i) & 31], sB0[((i) & 31) + 1]} : (f32x2){sB1[(i) & 31], sB1[((i) & 31) + 1]})
#pragma nounroll
    for (int it = 0; it < 48; ++it) {
        if (__ballot(!doneA || !doneB) == 0ull) break;
        const bool bis = (it % 3) == 2;
        const float wA = hiA - loA, wB = hiB - loB;
        float rA = bis ? 0.5f : (cloA - (float)Ka + 0.5f) / (cloA - chiA), rB = bis ? 0.5f : (cloB - (float)Kb + 0.5f) / (cloB - chiB);
        rA = fminf(fmaxf(rA, 0.03f), 0.97f); rB = fminf(fmaxf(rB, 0.03f), 0.97f);
        const float midA = loA + wA * rA, midB = loB + wB * rB;
        const float fA = doneA ? TA : midA, fB = doneB ? TB : midB;
        const f32x2 bigp = (f32x2){BIG, BIG}, nfA = (f32x2){-fA * BIG, -fA * BIG}, nfB = (f32x2){-fB * BIG, -fB * BIG};
        f32x2 cA2 = (f32x2){0.f, 0.f}, cB2 = (f32x2){0.f, 0.f};
#pragma unroll
        for (int blk = 0; blk < 8; ++blk) {
            if (blk < nblk) {
#pragma unroll
                for (int e = 0; e < 4; ++e) { cA2 += pk_gt(SA2(8 * blk + 2 * e), bigp, nfA); cB2 += pk_gt(SB2(8 * blk + 2 * e), bigp, nfB); }
            }
        }
        const int cA = (int)half_sum_f(cA2.x + cA2.y), cB = (int)half_sum_f(cB2.x + cB2.y);
        const bool stuckA = !(midA > loA && midA < hiA), stuckB = !(midB > loB && midB < hiB);
        if (!doneA) { if (cA == Ka) { TA = fA; doneA = true; } else if (stuckA) { TA = loA; doneA = true; } else if (cA > Ka) { loA = midA; cloA = (float)cA; } else { hiA = midA; chiA = (float)cA; } }
        if (!doneB) { if (cB == Kb) { TB = fB; doneB = true; } else if (stuckB) { TB = loB; doneB = true; } else if (cB > Kb) { loB = midB; cloB = (float)cB; } else { hiB = midB; chiB = (float)cB; } }
    }
#undef SA2
#undef SB2
    if (!doneA) TA = loA;
    if (!doneB) TB = loB;
    unsigned w0 = 0u, w1 = 0u, w2 = 0u, w3 = 0u;
#pragma nounroll
    for (int kt = 0; kt < nt0; ++kt) { const unsigned long long ma = __ballot(sA0[kt] > TA), mb = __ballot(sB0[kt] > TB);
        if (lane == kt) { w0 = (unsigned)ma; w1 = (unsigned)(ma >> 32); w2 = (unsigned)mb; w3 = (unsigned)(mb >> 32); } }
#pragma nounroll
    for (int kt = 0; kt < nt1; ++kt) { const unsigned long long ma = __ballot(sA1[kt] > TA), mb = __ballot(sB1[kt] > TB);
        if (lane == 32 + kt) { w0 = (unsigned)ma; w1 = (unsigned)(ma >> 32); w2 = (unsigned)mb; w3 = (unsigned)(mb >> 32); } }
    SEL[(rowb + t0 + 0) * 64 + lane] = w0; SEL[(rowb + t0 + 1) * 64 + lane] = w1; SEL[(rowb + t0 + 2) * 64 + lane] = w2; SEL[(rowb + t0 + 3) * 64 + lane] = w3;
}

#define ATT_F(r) (((r) & 3) | ((((r) >> 3) & 3) << 2))
#define TRB8(OFS, r0, r1, r2, r3, r4, r5, r6, r7, a0, a1, a2, a3, a4, a5, a6, a7) \
    asm volatile("ds_read_b64_tr_b16 %0, %8 offset:" OFS "\n\tds_read_b64_tr_b16 %1, %9 offset:" OFS "\n\tds_read_b64_tr_b16 %2, %10 offset:" OFS "\n\tds_read_b64_tr_b16 %3, %11 offset:" OFS "\n\t" \
                 "ds_read_b64_tr_b16 %4, %12 offset:" OFS "\n\tds_read_b64_tr_b16 %5, %13 offset:" OFS "\n\tds_read_b64_tr_b16 %6, %14 offset:" OFS "\n\tds_read_b64_tr_b16 %7, %15 offset:" OFS "\n\ts_waitcnt lgkmcnt(0)" \
                 : "=&v"(r0), "=&v"(r1), "=&v"(r2), "=&v"(r3), "=&v"(r4), "=&v"(r5), "=&v"(r6), "=&v"(r7) \
                 : "v"(a0), "v"(a1), "v"(a2), "v"(a3), "v"(a4), "v"(a5), "v"(a6), "v"(a7) : "memory")
#define RDK8(OFS, r, a) \
    asm volatile("ds_read_b64 %0, %8 offset:" OFS "\n\tds_read_b64 %1, %9 offset:" OFS "\n\tds_read_b64 %2, %10 offset:" OFS "\n\tds_read_b64 %3, %11 offset:" OFS "\n\t" \
                 "ds_read_b64 %4, %12 offset:" OFS "\n\tds_read_b64 %5, %13 offset:" OFS "\n\tds_read_b64 %6, %14 offset:" OFS "\n\tds_read_b64 %7, %15 offset:" OFS "\n\ts_waitcnt lgkmcnt(0)" \
                 : "=&v"(r[0]), "=&v"(r[1]), "=&v"(r[2]), "=&v"(r[3]), "=&v"(r[4]), "=&v"(r[5]), "=&v"(r[6]), "=&v"(r[7]) \
                 : "v"(a[0]), "v"(a[1]), "v"(a[2]), "v"(a[3]), "v"(a[4]), "v"(a[5]), "v"(a[6]), "v"(a[7]) : "memory")
__device__ __forceinline__ float rows_max(float x) {
    unsigned u = __float_as_uint(x);
    u32x2 r = __builtin_amdgcn_permlane16_swap(u, u, false, false);
    u = __float_as_uint(fmaxf(__uint_as_float(r.x), __uint_as_float(r.y)));
    r = __builtin_amdgcn_permlane32_swap(u, u, false, false);
    return fmaxf(__uint_as_float(r.x), __uint_as_float(r.y));
}
__device__ __forceinline__ float rows_sum(float x) {
    unsigned u = __float_as_uint(x);
    u32x2 r = __builtin_amdgcn_permlane16_swap(u, u, false, false);
    u = __float_as_uint(__uint_as_float(r.x) + __uint_as_float(r.y));
    r = __builtin_amdgcn_permlane32_swap(u, u, false, false);
    return __uint_as_float(r.x) + __uint_as_float(r.y);
}

__device__ __forceinline__ int att_build_list(LAS unsigned* list, const LAS unsigned* btab, unsigned w, int t, int lane) {
    const int pc = __popc(w); int incl = pc;
#pragma unroll
    for (int o = 1; o < 64; o <<= 1) { const int v = __shfl_up(incl, o); if (lane >= o) incl += v; }
    const int total = __shfl(incl, 63); const int cnt = total < TOPK ? total : TOPK;
    int off = incl - pc;
    while (w) { const int bit = __builtin_ctz(w); w &= w - 1u;
        if (off < TOPK) { const int idx = 32 * lane + bit; int dd = t - idx; dd = dd < 0 ? 0 : (dd > 128 ? 128 : dd); list[off] = (unsigned)idx | (btab[dd] << 16); }
        ++off; }
    for (int sl = cnt + lane; sl < ((cnt + 31) & ~31); sl += 64) list[sl] = 0u;
    return cnt;
}
__device__ __forceinline__ void att_gather32(const unsigned char* CKV8b, const LAS unsigned* list32, LAS unsigned char* slot, int lane) {
    const LAS unsigned* lp = list32 + (lane >> 4);
    unsigned idx[8];
#pragma unroll
    for (int i = 0; i < 8; ++i) idx[i] = lp[4 * i] & 0xffffu;
#pragma unroll
    for (int i = 0; i < 8; ++i) {
        const int rr = 4 * i + (lane >> 4);
        const unsigned char* src = CKV8b + (size_t)idx[i] * RK + 16 * ((lane & 15) ^ ATT_F(rr));
        __builtin_amdgcn_global_load_lds((const unsigned*)src, (LAS unsigned*)(slot + 1024 * i), 16, 0, 0);
    }
}

#define ATT_T(q) (((q) & 2047) ^ (((q) >> 11) ? 255 : 0))
__device__ __forceinline__ void att_wave(const unsigned char* CKV8, const unsigned* SEL, unsigned char* BIG, LAS unsigned char* kvbuf, LAS unsigned* lists, const LAS float* relb, const LAS unsigned* btab,
                                         int xcd, int wx, int nwx, int lane) {
    asm volatile("" : "+v"(lane));
    const int hq = lane & 15, g = lane >> 4;
    const int nq = (2 * SEQ - wx + nwx - 1) / nwx;
    if (nq <= 0) return;
    const unsigned kvb = (unsigned)(size_t)kvbuf;
    unsigned qa[8];
#pragma unroll
    for (int ks = 0; ks < 8; ++ks) qa[ks] = kvb + (unsigned)(8 * (hq >> 2) + (hq & 3)) * 256u + 16u * (unsigned)((2 * ks + (g >> 1)) ^ ATT_F(8 * (hq >> 2) + (hq & 3))) + 8u * (unsigned)(g & 1);
    const int trow = 8 * g + (hq >> 1);
    unsigned ta[16];
#pragma unroll
    for (int nt = 0; nt < 16; ++nt) ta[nt] = kvb + (unsigned)trow * 256u + 16u * (unsigned)(nt ^ ATT_F(trow)) + 8u * (unsigned)(hq & 1);

    int q = wx, b = 2 * xcd + (q >> 11), t = ATT_T(q);
    size_t row = (size_t)b * SEQ + t;
    unsigned wsel = SEL[row * 64 + lane];
    int cnt = att_build_list(lists, btab, wsel, t, lane);
    unsigned wnext = 0u;
    if (nq > 1) { const int q1 = wx + nwx; wnext = SEL[((size_t)(2 * xcd + (q1 >> 11)) * SEQ + ATT_T(q1)) * 64 + lane]; }
    long bq[8];
    { const unsigned char* qp = BIG + row * 8192 + hq * 256 + 8 * g;
#pragma unroll
      for (int ks = 0; ks < 8; ++ks) bq[ks] = *(const long*)(qp + 32 * ks); }
    int par = 0;
    asm volatile("s_waitcnt lgkmcnt(0)" ::: "memory");
    att_gather32(CKV8 + (size_t)b * SEQ * RK, lists, kvbuf, lane);
    for (int k = 0; k < nq; ++k) {
        const int cur = k & 1;
        LAS unsigned* list = lists + cur * 256;
        const bool has_next = (k + 1 < nq);
        const int qn = q + nwx, bn = 2 * xcd + (qn >> 11), tn = ATT_T(qn);
        const size_t rown = (size_t)bn * SEQ + tn;
        int cntn = 0;
        if (has_next) { cntn = att_build_list(lists + (cur ^ 1) * 256, btab, wnext, tn, lane);
            if (k + 2 < nq) { const int q2 = qn + nwx; wnext = SEL[((size_t)(2 * xcd + (q2 >> 11)) * SEQ + ATT_T(q2)) * 64 + lane]; } }
        f32x4 O[16];
#pragma unroll
        for (int nt = 0; nt < 16; ++nt) O[nt] = (f32x4){0.f, 0.f, 0.f, 0.f};
        float mref = NEGF, lsum = 0.f;
        const int nsub = (cnt + 31) >> 5;
        for (int sc = 0; sc < nsub; ++sc) {
            const bool lastc = (sc + 1 == nsub);
            float bias[8];
#pragma unroll
            for (int T = 0; T < 2; ++T) { const u32x4 mt = *(const LAS u32x4*)(list + 32 * sc + 8 * g + 4 * T);
#pragma unroll
                for (int i = 0; i < 4; ++i) bias[4 * T + i] = relb[(mt[i] >> 16) * 16 + hq]; }
            if (!lastc) { att_gather32(CKV8 + (size_t)b * SEQ * RK, list + 32 * (sc + 1), kvbuf + (par ^ 1) * 8192, lane); asm volatile("s_waitcnt vmcnt(8)" ::: "memory"); }
            else if (has_next) { att_gather32(CKV8 + (size_t)bn * SEQ * RK, lists + (cur ^ 1) * 256, kvbuf + (par ^ 1) * 8192, lane); asm volatile("s_waitcnt vmcnt(8)" ::: "memory"); }
            else { asm volatile("s_waitcnt vmcnt(0)" ::: "memory"); }
            f32x4 st0 = (f32x4){0.f, 0.f, 0.f, 0.f}, st1 = st0;
            { long kr[8];
              RDK8("0", kr, qa);
#pragma unroll
              for (int ks = 0; ks < 8; ++ks) st0 = __builtin_amdgcn_mfma_f32_16x16x32_fp8_fp8(kr[ks], bq[ks], st0, 0, 0, 0);
              RDK8("1024", kr, qa);
#pragma unroll
              for (int ks = 0; ks < 8; ++ks) st1 = __builtin_amdgcn_mfma_f32_16x16x32_fp8_fp8(kr[ks], bq[ks], st1, 0, 0, 0); }
            if (lastc && has_next) { const unsigned char* qp = BIG + rown * 8192 + hq * 256 + 8 * g;
#pragma unroll
                for (int ks = 0; ks < 8; ++ks) bq[ks] = *(const long*)(qp + 32 * ks); }
            float lg[8]; float cmax;
#pragma unroll
            for (int i = 0; i < 4; ++i) { lg[i] = st0[i] * (1.0f / 64.0f) + bias[i]; lg[4 + i] = st1[i] * (1.0f / 64.0f) + bias[4 + i]; }
            if (32 * sc + 32 > cnt) {
#pragma unroll
                for (int i = 0; i < 4; ++i) { const int s0 = 32 * sc + 8 * g + i; lg[i] = (s0 < cnt) ? lg[i] : NEGF; lg[4 + i] = (s0 + 4 < cnt) ? lg[4 + i] : NEGF; } }
            cmax = fmaxf(fmaxf(fmaxf(lg[0], lg[1]), fmaxf(lg[2], lg[3])), fmaxf(fmaxf(lg[4], lg[5]), fmaxf(lg[6], lg[7])));
            cmax = rows_max(cmax);
            if (__ballot(cmax > mref + 3.0f) != 0ull) {
                const float mnew = fmaxf(mref, cmax), scl = fast_exp(mref - mnew);
                lsum *= scl;
#pragma unroll
                for (int nt = 0; nt < 16; ++nt) O[nt] = O[nt] * scl;
                mref = mnew;
            }
            float p[8];
#pragma unroll
            for (int i = 0; i < 8; ++i) { p[i] = fast_exp(lg[i] - mref); lsum += p[i]; }
            int pw0 = 0, pw1 = 0;
            pw0 = __builtin_amdgcn_cvt_pk_fp8_f32(p[0] * 16.0f, p[1] * 16.0f, pw0, false); pw0 = __builtin_amdgcn_cvt_pk_fp8_f32(p[2] * 16.0f, p[3] * 16.0f, pw0, true);
            pw1 = __builtin_amdgcn_cvt_pk_fp8_f32(p[4] * 16.0f, p[5] * 16.0f, pw1, false); pw1 = __builtin_amdgcn_cvt_pk_fp8_f32(p[6] * 16.0f, p[7] * 16.0f, pw1, true);
            const long pk = (long)(((unsigned long long)(unsigned)pw1 << 32) | (unsigned long long)(unsigned)pw0);
            {
#define TR8B(r, a, o) asm volatile("ds_read_b64_tr_b8 %0, %8\n\tds_read_b64_tr_b8 %1, %9\n\tds_read_b64_tr_b8 %2, %10\n\tds_read_b64_tr_b8 %3, %11\n\t" \
                                   "ds_read_b64_tr_b8 %4, %12\n\tds_read_b64_tr_b8 %5, %13\n\tds_read_b64_tr_b8 %6, %14\n\tds_read_b64_tr_b8 %7, %15\n\ts_waitcnt lgkmcnt(0)" \
                                   : "=&v"(r[0]), "=&v"(r[1]), "=&v"(r[2]), "=&v"(r[3]), "=&v"(r[4]), "=&v"(r[5]), "=&v"(r[6]), "=&v"(r[7]) \
                                   : "v"(a[o + 0]), "v"(a[o + 1]), "v"(a[o + 2]), "v"(a[o + 3]), "v"(a[o + 4]), "v"(a[o + 5]), "v"(a[o + 6]), "v"(a[o + 7]) : "memory")
                long kt[8];
                TR8B(kt, ta, 0);
#pragma unroll
                for (int e = 0; e < 8; ++e) O[e] = __builtin_amdgcn_mfma_f32_16x16x32_fp8_fp8(kt[e], pk, O[e], 0, 0, 0);
                TR8B(kt, ta, 8);
#pragma unroll
                for (int e = 0; e < 8; ++e) O[8 + e] = __builtin_amdgcn_mfma_f32_16x16x32_fp8_fp8(kt[e], pk, O[8 + e], 0, 0, 0);
#undef TR8B
            }
            par ^= 1;
#pragma unroll
            for (int e = 0; e < 8; ++e) { qa[e] ^= 8192u; ta[e] ^= 8192u; ta[8 + e] ^= 8192u; }
        }
        lsum = rows_sum(lsum);
        const float inv = 1.0f / (16.0f * lsum);
        bf16_t* op = (bf16_t*)(BIG + row * 8192) + hq * 256 + 4 * g;
#pragma unroll
        for (int nt = 0; nt < 16; ++nt) { const f32x4 o = O[nt] * inv; u32x2 wv; wv.x = cvt_pk_bf16(o[0], o[1]); wv.y = cvt_pk_bf16(o[2], o[3]); *(u32x2*)(op + 16 * nt) = wv; }
        q = qn; b = bn; t = tn; row = rown; cnt = cntn;
    }
}

constexpr int SW_KP = 144, SW_VP = 520;
constexpr int SW_K_OFF = 0, SW_V_OFF = 256 * SW_KP, SW_TB_OFF = SW_V_OFF + 64 * SW_VP;
__device__ __forceinline__ void swa_phase(const bf16_t* QKV, bf16_t* OB, const float* relb, const float* sinks, LAS unsigned char* lds, int G) {
    int tid = threadIdx.x; asm volatile("" : "+v"(tid));
    const int lane = tid & 63, wave = __builtin_amdgcn_readfirstlane(tid >> 6);
    const int h = lane >> 5, n = lane & 31;
    LAS float* tb = (LAS float*)(lds + SW_TB_OFF);
    for (int u = blockIdx.x; u < BATCH * 16 * KVH; u += G) {
        const int b = u >> 5, nb = (u >> 1) & 15, kvh = u & 1;
        const size_t rowb = (size_t)b * SEQ;
        __syncthreads();
#pragma unroll
        for (int e = 0; e < 4; ++e) { const int id = tid + NTHR * e, j = id >> 3, ch = id & 7; const int pos = (nb - 1) * WIN + j;
            u32x4 kv = (u32x4){0u, 0u, 0u, 0u}, vv = (u32x4){0u, 0u, 0u, 0u};
            if (pos >= 0) { const bf16_t* sp = QKV + (rowb + pos) * B_IN + 1024 + kvh * 64 + ch * 8; kv = *(const u32x4*)sp; vv = *(const u32x4*)(sp + 128); }
            *(LAS u32x4*)(lds + SW_K_OFF + j * SW_KP + ch * 16) = kv;
            LAS bf16_t* vt = (LAS bf16_t*)(lds + SW_V_OFF + (ch * 8) * SW_VP + j * 2);
#pragma unroll
            for (int q = 0; q < 4; ++q) { vt[(2 * q) * (SW_VP / 2)] = (bf16_t)(vv[q] & 0xffffu); vt[(2 * q + 1) * (SW_VP / 2)] = (bf16_t)(vv[q] >> 16); } }
        for (int i = tid; i < GQ * WIN; i += NTHR) { const int gg = i >> 7, dist = i & 127; tb[i] = relb[t5_bucket(dist) * NH + kvh * GQ + gg]; }
        __syncthreads();
        const int qh = kvh * GQ + wave; const float sink = sinks[qh];
        for (int rt = 0; rt < 4; ++rt) {
            const size_t qrow = rowb + nb * WIN + 32 * rt + n;
            bf16x8 bq[4];
#pragma unroll
            for (int ks = 0; ks < 4; ++ks) bq[ks] = *(const bf16x8*)(QKV + qrow * B_IN + qh * 64 + 16 * ks + 8 * h);
            f32x16 s[5];
#pragma unroll
            for (int ct = 0; ct < 5; ++ct) {
#pragma unroll
                for (int i = 0; i < 16; ++i) s[ct][i] = 0.f;
#pragma unroll
                for (int ks = 0; ks < 4; ++ks) { const bf16x8 a = *(const LAS bf16x8*)(lds + SW_K_OFF + (32 * (rt + ct) + n) * SW_KP + (2 * ks + h) * 16);
                    s[ct] = __builtin_amdgcn_mfma_f32_32x32x16_bf16(a, bq[ks], s[ct], 0, 0, 0); } }
            const int qi = 32 * rt + n;
            float mx = NEGF;
#pragma unroll
            for (int ct = 0; ct < 5; ++ct)
#pragma unroll
                for (int i = 0; i < 16; ++i) { const int j = 32 * (rt + ct) + (i & 3) + 8 * (i >> 2) + 4 * h; const int dist = qi + WIN - j;
                    const bool ok = (dist >= 0) && (dist < WIN) && (nb > 0 || j >= WIN);
                    const float v = ok ? s[ct][i] * 0.125f + tb[wave * WIN + (dist & 127)] : NEGF; s[ct][i] = v; mx = fmaxf(mx, v); }
            mx = fmaxf(mx, __shfl_xor(mx, 32)); mx = fmaxf(mx, sink);
            float sum = 0.f;
#pragma unroll
            for (int ct = 0; ct < 5; ++ct)
#pragma unroll
                for (int i = 0; i < 16; ++i) { const float p = fast_exp(s[ct][i] - mx); s[ct][i] = p; sum += p; }
            sum += __shfl_xor(sum, 32); sum += fast_exp(sink - mx);
            f32x16 o[2];
#pragma unroll
            for (int dt = 0; dt < 2; ++dt)
#pragma unroll
                for (int i = 0; i < 16; ++i) o[dt][i] = 0.f;
#pragma unroll
            for (int ct = 0; ct < 5; ++ct)
#pragma unroll
                for (int s2 = 0; s2 < 2; ++s2) {
                    u32x4 pw; pw.x = cvt_pk_bf16(s[ct][8 * s2 + 0], s[ct][8 * s2 + 1]); pw.y = cvt_pk_bf16(s[ct][8 * s2 + 2], s[ct][8 * s2 + 3]);
                    pw.z = cvt_pk_bf16(s[ct][8 * s2 + 4], s[ct][8 * s2 + 5]); pw.w = cvt_pk_bf16(s[ct][8 * s2 + 6], s[ct][8 * s2 + 7]);
                    const bf16x8 pb = __builtin_bit_cast(bf16x8, pw);
#pragma unroll
                    for (int dt = 0; dt < 2; ++dt) { const LAS unsigned char* vp = lds + SW_V_OFF + (32 * dt + n) * SW_VP + (32 * (rt + ct) + 16 * s2 + 4 * h) * 2;
                        const u32x2 v0 = *(const LAS u32x2*)vp, v1 = *(const LAS u32x2*)(vp + 16);
                        u32x4 va; va.x = v0.x; va.y = v0.y; va.z = v1.x; va.w = v1.y;
                        o[dt] = __builtin_amdgcn_mfma_f32_32x32x16_bf16(__builtin_bit_cast(bf16x8, va), pb, o[dt], 0, 0, 0); }
                }
            const float inv = 1.0f / sum;
            bf16_t* op = OB + qrow * D + qh * 64 + 4 * h;
#pragma unroll
            for (int dt = 0; dt < 2; ++dt)
#pragma unroll
                for (int i4 = 0; i4 < 4; ++i4) { u32x2 wv; wv.x = cvt_pk_bf16(o[dt][4 * i4] * inv, o[dt][4 * i4 + 1] * inv); wv.y = cvt_pk_bf16(o[dt][4 * i4 + 2] * inv, o[dt][4 * i4 + 3] * inv);
                    *(u32x2*)(op + 32 * dt + 8 * i4) = wv; }
        }
    }
}

struct Args { const float* in[23]; float* out; unsigned char* ws; };
#define CAS __attribute__((address_space(4)))
__device__ __forceinline__ const CAS Args* kargs() { const CAS Args* p = (const CAS Args*)__builtin_amdgcn_kernarg_segment_ptr(); asm volatile("" : "+s"(p)); return p; }

__global__ void __launch_bounds__(NTHR, 2) trunk_fwd(Args args_by_value) {
    extern __shared__ __attribute__((aligned(16))) unsigned char lds_raw[];
    LAS unsigned char* lds = (LAS unsigned char*)lds_raw;
    const int tid = threadIdx.x;
    volatile LAS unsigned* MISC = (volatile LAS unsigned*)(lds + LDS_MISC_OFF);
    for (int u = tid; u < (LDS_BYTES - LDS_MISC_OFF) / 4; u += NTHR) MISC[u] = 0u;
    __syncthreads();
    { const CAS Args* A = kargs(); (void)xcd_barrier_post((unsigned*)(A->ws + WS_CTL) + 4096, MISC + 8);
      if (tid == 0) { const unsigned x = xb_xcc_id(); MISC[16] = x; MISC[17] = xb_add((unsigned*)(A->ws + WS_CTL) + 8192 + 64 * x, 1u); } }
#define XCD_RANK(xcd, rank) do { const CAS Args* A_ = kargs(); const unsigned* cw_ = (const unsigned*)(A_->ws + WS_CTL) + 4096; bool ok_ = (gridDim.x & 7) == 0; \
        for (int j_ = 0; j_ < 16; ++j_) { const unsigned c_ = __hip_atomic_load(cw_ + XB_XCNT(j_), __ATOMIC_RELAXED, __HIP_MEMORY_SCOPE_AGENT); ok_ = ok_ && (c_ == (j_ < 8 ? gridDim.x >> 3 : 0u)); } \
        const unsigned hx_ = MISC[16], hr_ = MISC[17]; ok_ = ok_ && hx_ < 8u && hr_ < (gridDim.x >> 3); \
        xcd = ok_ ? (int)hx_ : (int)(blockIdx.x & 7); rank = ok_ ? (int)hr_ : (int)(blockIdx.x >> 3); } while (0)
#define GB() do { const CAS Args* A_ = kargs(); XcdBarrier b_; b_.bar = (unsigned*)(A_->ws + WS_CTL) + 4096; b_.x = xb_xcc_id(); b_.st = MISC + 8; xcd_barrier(b_); } while (0)

    { const CAS Args* A = kargs(); Ptrs P;
#pragma unroll
      for (int i = 0; i < 23; ++i) P.in[i] = A->in[i];
      P.out = A->out; P.ws = A->ws;
      p0_prologue(P, lds, (int)gridDim.x); }
    GB();
    { const CAS Args* A = kargs(); Ptrs P;
#pragma unroll
      for (int i = 0; i < 23; ++i) P.in[i] = A->in[i];
      P.out = A->out; P.ws = A->ws;
      pre_phase(P, lds, (int)gridDim.x); }
    GB();

    for (int l = 0; l < DEPTH; ++l) {
        const bool isA = (l & 1) == 0;
        {
            const CAS Args* A = kargs(); const int G = gridDim.x, j = l >> 1; unsigned char* ws = A->ws;
            const unsigned long long* SS = (const unsigned long long*)(ws + WS_SS) + (size_t)(2 * l) * M;
            if (isA) {
                unsigned char* wa = ws + WS_WA + (size_t)j * WA_STRIDE;
                pg8::Gemm g{(const bf16_t*)(ws + WS_XG), (const bf16_t*)(wa + WINA_OFF), D, D, D, 0, 0}; pg8::StaticOrder S; S.init(M, 2048, G, (int)blockIdx.x);
                pg8::EpiInA E{(bf16_t*)(ws + WS_QO), (bf16_t*)(ws + WS_CKV), (bf16_t*)(ws + WS_QI), (bf16_t*)(ws + WS_KIN), (float*)(ws + WS_WI), A->in[I_AIKG] + j * IDIM, A->in[I_AIKB] + j * IDIM,
                                (const float*)(ws + WS_SHW + SHW_A) + (size_t)j * BATCH * 2048, SS};
                pg8::gemm_phase<pg8::EpiInA, true>(lds, g, S, E);
            } else {
                unsigned char* wb = ws + WS_WB + (size_t)j * WB_STRIDE;
                pg8::Gemm g{(const bf16_t*)(ws + WS_XG), (const bf16_t*)(wb + WINB_OFF), D, D, D, 0, 0}; pg8::StaticOrder S; S.init(M, B_IN, G, (int)blockIdx.x);
                pg8::EpiBf16Plain<true> E{(bf16_t*)(ws + WS_QKV), B_IN, (const float*)(ws + WS_SHW + SHW_B) + (size_t)j * BATCH * B_IN, B_IN, SS};
                pg8::gemm_phase<pg8::EpiBf16Plain<true>, true>(lds, g, S, E);
            }
        }
        GB();
        if (isA) {
            { const CAS Args* A = kargs(); const int G = gridDim.x, j = l >> 1; unsigned char* ws = A->ws;
              unsigned char* wa = ws + WS_WA + (size_t)j * WA_STRIDE;
              pg8::Gemm g{(const bf16_t*)(ws + WS_QO), (const bf16_t*)(wa + WQA_OFF), D, 256, 256, 2, 256}; pg8::StaticOrder S; S.init(M, 4096, G, (int)blockIdx.x);
              pg8::EpiFp8 E{ws + WS_BIG, 8192};
              pg8::gemm_phase<pg8::EpiFp8, true>(lds, g, S, E); }
            { const CAS Args* A = kargs(); const int G = gridDim.x; unsigned char* ws = A->ws;
              int tid2 = tid; asm volatile("" : "+v"(tid2));
              const int lane = tid2 & 63, wave = __builtin_amdgcn_readfirstlane(tid2 >> 6);
              const bf16_t* CKV = (const bf16_t*)(ws + WS_CKV); unsigned* CKV8 = (unsigned*)(ws + WS_CKV8);
              const int gw = blockIdx.x * NWAVES + wave, NGW = G * NWAVES;
              for (int row = gw; row < M; row += NGW) {
                  const u32x2 v = *((const u32x2*)(CKV + (size_t)row * RK) + lane);
                  const float a0 = __uint_as_float(v.x << 16), a1 = __uint_as_float(v.x & 0xffff0000u), a2 = __uint_as_float(v.y << 16), a3 = __uint_as_float(v.y & 0xffff0000u);
                  const float ss = wave_sum((a0 * a0 + a1 * a1) + (a2 * a2 + a3 * a3));
                  const float rs = 1.0f / sqrtf(ss * (1.0f / RK) + EPS);
                  int w = 0; w = __builtin_amdgcn_cvt_pk_fp8_f32(a0 * rs, a1 * rs, w, false); w = __builtin_amdgcn_cvt_pk_fp8_f32(a2 * rs, a3 * rs, w, true);
                  CKV8[(size_t)row * (RK / 4) + lane] = (unsigned)w;
              } }
            { const CAS Args* A = kargs(); const int G = gridDim.x; unsigned char* ws = A->ws;
              int tid2 = tid; asm volatile("" : "+v"(tid2));
              const int lane = tid2 & 63, wave = __builtin_amdgcn_readfirstlane(tid2 >> 6);
              int xcd, rank; XCD_RANK(xcd, rank); xcd = __builtin_amdgcn_readfirstlane(xcd); rank = __builtin_amdgcn_readfirstlane(rank);
              const int wx = rank * NWAVES + wave, nwx = (G >> 3) * NWAVES;
              const int nsteps = (1024 + nwx - 1) / nwx;
              for (int st = 0; st < nsteps; ++st) {
                  const int q = wx + st * nwx; const bool active = q < 1024;
                  const int qc = active ? q : (rank * NWAVES + st * nwx < 1024 ? rank * NWAVES + st * nwx : 1023);
                  const int bl = qc >> 9, u = qc & 255, hiq = (qc >> 8) & 1, b = 2 * xcd + bl;
                  const int tg = hiq ? 511 - u : u;
                  idx_task((const bf16_t*)(ws + WS_QI), (const bf16_t*)(ws + WS_KIN), (const float*)(ws + WS_WI), (unsigned*)(ws + WS_SEL), lds, b, tg, lane, wave, active, hiq ? 2 : 1);
              }
              __syncthreads(); }
        } else {
            const CAS Args* A = kargs(); const int G = gridDim.x, j = l >> 1; unsigned char* ws = A->ws;
            swa_phase((const bf16_t*)(ws + WS_QKV), (bf16_t*)(ws + WS_OB), A->in[I_RELB], A->in[I_BSINK] + j * NH, lds, G);
        }
        GB();
        if (isA) {
            { const CAS Args* A = kargs(); const int G = gridDim.x; unsigned char* ws = A->ws;
              int tid2 = tid; asm volatile("" : "+v"(tid2));
              const int lane = tid2 & 63, wave = __builtin_amdgcn_readfirstlane(tid2 >> 6);
              LAS float* relb = (LAS float*)(lds + 147456);
              LAS unsigned* btab = (LAS unsigned*)(lds + 147456 + 2048);
              for (int i = tid2; i < NBUCK * NH; i += NTHR) relb[i] = A->in[I_RELB][i];
              for (int i = tid2; i < 132; i += NTHR) btab[i] = (unsigned)t5_bucket(i);
              __syncthreads();
              int xcd, rank; XCD_RANK(xcd, rank); xcd = __builtin_amdgcn_readfirstlane(xcd); rank = __builtin_amdgcn_readfirstlane(rank);
              const int wx = rank * NWAVES + wave, nwx = (G >> 3) * NWAVES;
              att_wave(ws + WS_CKV8, (const unsigned*)(ws + WS_SEL), ws + WS_BIG, lds + wave * 16384, (LAS unsigned*)(lds + 131072 + wave * 2048), relb, btab, xcd, wx, nwx, lane); }
            GB();
            { const CAS Args* A = kargs(); const int G = gridDim.x, j = l >> 1; unsigned char* ws = A->ws;
              unsigned char* wa = ws + WS_WA + (size_t)j * WA_STRIDE;
              pg8::Gemm g{(const bf16_t*)(ws + WS_BIG), (const bf16_t*)(wa + WUV_OFF), 4096, D, D, 0, 1024}; pg8::StaticOrder S; S.init(M, D, G, (int)blockIdx.x);
              pg8::EpiBf16Plain<false> E{(bf16_t*)(ws + WS_OB), D, nullptr, 0, nullptr};
              pg8::gemm_phase<pg8::EpiBf16Plain<false>, true>(lds, g, S, E); }
            GB();
        }
        {
            const CAS Args* A = kargs(); const int G = gridDim.x, j = l >> 1; unsigned char* ws = A->ws;
            const float* modl = (const float*)(ws + WS_MOD) + (size_t)l * BATCH * 6144;
            const bf16_t* Ain = (const bf16_t*)(ws + WS_OB);
            const bf16_t* Bw = (const bf16_t*)(isA ? ws + WS_WA + (size_t)j * WA_STRIDE + WOUTA_OFF : ws + WS_WB + (size_t)j * WB_STRIDE + WOUTB_OFF);
            w8_build((const bf16_t*)(ws + WS_W + (size_t)l * W_LAYER + W13_OFF), A->in[I_GFFN] + l * D, modl + 4096, ws + WS_W8, (float*)(ws + WS_CW), lds, G);
            pg8::Gemm g{Ain, Bw, D, D, D, 0, 0}; pg8::StaticOrder S; S.init(M, D, G, (int)blockIdx.x);
            pg8::EpiResid<true> E{(const bf16_t*)A->out, (bf16_t*)A->out, modl + 2048, isA ? nullptr : A->in[I_BBOUT] + j * D,
                            (bf16_t*)(ws + WS_XG), nullptr, nullptr, (unsigned long long*)(ws + WS_SS) + (size_t)(2 * l + 1) * M, (const unsigned long long*)(ws + WS_SS) + (size_t)(2 * l) * M};
            pg8::gemm_phase<pg8::EpiResid<true>, true>(lds, g, S, E);
        }
        GB();
        {
            const CAS Args* A = kargs(); const int G = gridDim.x; unsigned char* ws = A->ws;
            unsigned char* wl = ws + WS_W + (size_t)l * W_LAYER;
            pg8::Gemm g{(const bf16_t*)(ws + WS_XG), (const bf16_t*)(ws + WS_W8), D / 2, D / 2, D / 2, 0, 0, (unsigned)W8_BATCH}; pg8::StaticOrder S; S.init(M, 2 * DFF, G, (int)blockIdx.x);
            pg8::EpiSwiGLU E{(bf16_t*)(ws + WS_HFF), (const float*)(ws + WS_SHW + SHW_F) + (size_t)l * BATCH * 2 * DFF, (const unsigned long long*)(ws + WS_SS) + (size_t)(2 * l + 1) * M,
                             (const float*)(ws + WS_CW), (const unsigned long long*)(ws + WS_SS) + (size_t)(2 * l) * M};
            pg8::gemm_phase<pg8::EpiSwiGLU, true, true>(lds, g, S, E);
        }
        GB();
        {
            const CAS Args* A = kargs(); const int G = gridDim.x; unsigned char* ws = A->ws;
            unsigned char* wl = ws + WS_W + (size_t)l * W_LAYER;
            const float* modl = (const float*)(ws + WS_MOD) + (size_t)l * BATCH * 6144;
            const int ln = l + 1 < DEPTH ? l + 1 : l;
            pg8::Gemm g{(const bf16_t*)(ws + WS_HFF), (const bf16_t*)(wl + W2_OFF), DFF, DFF, DFF, 0, 0}; pg8::StaticOrder S; S.init(M, D, G, (int)blockIdx.x);
            const bool lastl = (l + 1 == DEPTH);
            pg8::EpiResid<false> E{(const bf16_t*)A->out, lastl ? (bf16_t*)(ws + WS_XG) : (bf16_t*)A->out, modl + 5120, nullptr,
                            l + 1 < DEPTH ? (bf16_t*)(ws + WS_XG) : nullptr, A->in[I_GMIX] + ln * D, (const float*)(ws + WS_MOD) + (size_t)ln * BATCH * 6144 + 1024, (unsigned long long*)(ws + WS_SS) + (size_t)(2 * l + 2) * M, nullptr};
            pg8::gemm_phase<pg8::EpiResid<false>, true>(lds, g, S, E);
        }
        GB();
    }
    { const CAS Args* A = kargs(); final_norm_phase((const bf16_t*)(A->ws + WS_XG), A->out, A->in[I_GFIN], (int)gridDim.x); }
#undef GB
}

extern "C" void kernel_launch(void* const* d_in, const int* in_sizes, int n_in, void* d_out, int out_size, void* d_ws, size_t ws_size, hipStream_t stream) {
    static int grid = 0;
    if (grid == 0) {
        if (n_in != 23 || out_size != M * D || ws_size < WS_END) { fprintf(stderr, "kernel_launch: unexpected shapes (n_in %d out %d ws %zu)\n", n_in, out_size, ws_size); grid = -1; return; }
        int dev = 0, cus = 0, per_cu = 0;
        if (hipGetDevice(&dev) != hipSuccess || hipDeviceGetAttribute(&cus, hipDeviceAttributeMultiprocessorCount, dev) != hipSuccess) { grid = -1; return; }
        if (hipFuncSetAttribute((const void*)trunk_fwd, hipFuncAttributeMaxDynamicSharedMemorySize, LDS_BYTES) != hipSuccess) { fprintf(stderr, "kernel_launch: hipFuncSetAttribute failed\n"); grid = -1; return; }
        if (hipOccupancyMaxActiveBlocksPerMultiprocessor(&per_cu, (const void*)trunk_fwd, NTHR, LDS_BYTES) != hipSuccess || per_cu < 1) { fprintf(stderr, "kernel_launch: occupancy query says %d\n", per_cu); }
        (void)hipGetLastError();
        grid = cus;
    }
    if (grid < 0) return;
    (void)hipMemsetAsync((char*)d_ws + WS_CTL, 0, CTL_ZERO_BYTES, stream);
    Args a{};
    for (int i = 0; i < 23; ++i) a.in[i] = (const float*)d_in[i];
    a.out = (float*)d_out; a.ws = (unsigned char*)d_ws;
    hipLaunchKernelGGL(trunk_fwd, dim3(grid), dim3(NTHR), LDS_BYTES, stream, a);
    const hipError_t le = hipPeekAtLastError();
    if (le != hipSuccess) fprintf(stderr, "kernel_launch: launch failed: %s\n", hipGetErrorName(le));
}
```

```cpp
#include <hip/hip_runtime.h>
#include <cstdio>
#include <cstdint>


#define GAS __attribute__((address_space(1)))
#define LAS __attribute__((address_space(3)))
typedef unsigned short bf16_t;
typedef short bf16x8 __attribute__((ext_vector_type(8)));
typedef short s16x4 __attribute__((ext_vector_type(4)));
typedef float f32x4 __attribute__((ext_vector_type(4)));
typedef float f32x2 __attribute__((ext_vector_type(2)));
typedef float f32x16 __attribute__((ext_vector_type(16)));
typedef unsigned u32x4 __attribute__((ext_vector_type(4)));
typedef unsigned u32x2 __attribute__((ext_vector_type(2)));
typedef int i32x4 __attribute__((ext_vector_type(4)));
typedef int i32x8 __attribute__((ext_vector_type(8)));

constexpr int D = 1024, BATCH = 16, SEQ = 2048, M = BATCH * SEQ, DEPTH = 4;
constexpr int NH = 16, HD = 64, RK = 256, IH = 8, IDIM = 64, TOPK = 256;
constexpr int KVH = 2, GQ = 8, WIN = 128, NBUCK = 32, DFF = 2816;
constexpr int A_IN = 1864, B_IN = 1280;
constexpr float EPS = 1e-6f;
constexpr float NEGF = -1e30f;
constexpr int NWAVES = 8, NTHR = 512;

constexpr size_t MiB = 1u << 20;
constexpr size_t WS_CTL = 0, CTL_ZERO_BYTES = 4 * MiB;
constexpr size_t WS_SS = 1 * MiB;
constexpr size_t WS_W = 4 * MiB;
constexpr size_t W_LAYER = 17301504;
constexpr size_t W13_OFF = 0, W2_OFF = 11 * MiB;
constexpr size_t WS_WA = WS_W + 4 * W_LAYER;
constexpr size_t WA_STRIDE = 10 * MiB, WINA_OFF = 0, WQA_OFF = 4 * MiB, WUV_OFF = 6 * MiB, WOUTA_OFF = 8 * MiB;
constexpr size_t WS_WB = WS_WA + 2 * WA_STRIDE;
constexpr size_t WB_STRIDE = 4718592, WINB_OFF = 0, WOUTB_OFF = 2621440;
constexpr size_t WS_MOD = 100 * MiB;
constexpr size_t WS_SHW = WS_MOD + 1536 * 1024;
constexpr size_t SHW_A = 0, SHW_B = 2 * 16 * 2048 * 4, SHW_F = SHW_B + 2 * 16 * 1280 * 4;
constexpr size_t WS_XG = 104 * MiB;
constexpr size_t WS_BIG = 104 * MiB;
constexpr size_t WS_HFF = 168 * MiB;
constexpr size_t WS_QO = 360 * MiB;
constexpr size_t WS_CKV = 424 * MiB;
constexpr size_t WS_QI = 440 * MiB;
constexpr size_t WS_KIN = 472 * MiB;
constexpr size_t WS_WI = 476 * MiB;
constexpr size_t WS_SEL = 477 * MiB;
constexpr size_t WS_CKV8 = 486 * MiB;
constexpr size_t WS_QKV = 360 * MiB;
constexpr size_t WS_OB = 440 * MiB;
constexpr size_t WS_W8 = 344 * MiB;
constexpr size_t W8_BATCH = (size_t)2 * 2816 * 1024;
constexpr size_t WS_CW = 504 * MiB;
constexpr size_t WS_END = 512 * MiB;

constexpr int RING_BYTES = 131072;
constexpr int LDS_MISC_OFF = 155648;
constexpr int LDS_BYTES = 156672;

extern __shared__ __attribute__((aligned(16))) unsigned char lds_raw[];
constexpr int LDS_WAVE_TAB = LDS_MISC_OFF + 256;
__device__ __forceinline__ int lane_now() { int l; asm volatile("v_mbcnt_lo_u32_b32 %0, -1, 0\n\tv_mbcnt_hi_u32_b32 %0, -1, %0" : "=v"(l)); return l; }
__device__ __forceinline__ unsigned hw_slot() { return (unsigned)__builtin_amdgcn_s_getreg((5 << 11) | 4) & 63u; }
__device__ __forceinline__ int wave_now() { return __builtin_amdgcn_readfirstlane((int)*(volatile LAS unsigned*)((LAS unsigned char*)lds_raw + LDS_WAVE_TAB + 4 * hw_slot())); }
__device__ __forceinline__ int tid_now() { return wave_now() * 64 + lane_now(); }
#define RLX_AGENT __ATOMIC_RELAXED, __HIP_MEMORY_SCOPE_AGENT
__device__ __forceinline__ unsigned cvt_pk_bf16(float lo, float hi) { unsigned r; asm volatile("v_cvt_pk_bf16_f32 %0, %1, %2" : "=v"(r) : "v"(lo), "v"(hi)); return r; }
typedef _Float16 h16x2 __attribute__((ext_vector_type(2)));
typedef _Float16 h16x8 __attribute__((ext_vector_type(8)));
__device__ __forceinline__ unsigned cvt_pk_f16(float lo, float hi) { return __builtin_bit_cast(unsigned, __builtin_convertvector((f32x2){lo, hi}, h16x2)); }
__device__ __forceinline__ f32x2 unpk_f16(unsigned u) { return __builtin_convertvector(__builtin_bit_cast(h16x2, u), f32x2); }
__device__ __forceinline__ float bf2f(bf16_t b) { return __uint_as_float(((unsigned)b) << 16); }
__device__ __forceinline__ float half_sum_f(float v);
__device__ __forceinline__ float rows_sum(float x);
__device__ __forceinline__ float wave_sum(float v) {
    v = half_sum_f(v);
    const u32x2 r = __builtin_amdgcn_permlane32_swap(__float_as_uint(v), __float_as_uint(v), false, false);
    return __uint_as_float(r.x) + __uint_as_float(r.y);
}
__device__ __forceinline__ float fast_exp(float x) { return __builtin_amdgcn_exp2f(x * 1.4426950408889634f); }
__device__ __forceinline__ float silu_f(float x) { return x * __builtin_amdgcn_rcpf(1.0f + fast_exp(-x)); }
__device__ __forceinline__ int t5_bucket(int d) {
    if (d < 16) return d;
    int b = 16;
    b += (d >= 19); b += (d >= 21); b += (d >= 24); b += (d >= 27); b += (d >= 31); b += (d >= 35); b += (d >= 40); b += (d >= 46);
    b += (d >= 52); b += (d >= 59); b += (d >= 67); b += (d >= 77); b += (d >= 87); b += (d >= 99); b += (d >= 113);
    return b;
}

#define XB_TMO      128
#define XB_XCNT(j)  (256  + 64 * (j))
#define XB_XSUB(j)  (1280 + 64 * (j))
#define XB_XGEN(j)  (2304 + 64 * (j))
#define XB_TOP      3328
#define XB_TOPGEN   3392
#define XCD_BAR_WORDS 3456
#define XB_SPIN_CAP (1u << 22)

__device__ __forceinline__ unsigned xb_ld(unsigned* p)              { return __hip_atomic_load(p, __ATOMIC_RELAXED, __HIP_MEMORY_SCOPE_AGENT); }
__device__ __forceinline__ unsigned xb_add(unsigned* p, unsigned v) { return __hip_atomic_fetch_add(p, v, __ATOMIC_RELAXED, __HIP_MEMORY_SCOPE_AGENT); }
__device__ __forceinline__ unsigned xb_xcc_id() { return (unsigned)__builtin_amdgcn_s_getreg((3 << 11) | 20) & 0xFu; }
#define XB_SPIN(cond, bar) do { unsigned _sp = 0; while (cond) { __builtin_amdgcn_s_sleep(1); \
    if ((++_sp & 255u) == 0u) { if (xb_ld(&(bar)[XB_TMO])) break; if (_sp > XB_SPIN_CAP) { atomicAdd(&(bar)[XB_TMO], 1u); break; } } } } while (0)

struct XcdBarrier { unsigned* bar; unsigned x; volatile LAS unsigned* st; };

__device__ __forceinline__ XcdBarrier xcd_barrier_post(unsigned* bar, volatile LAS unsigned* st) {
    XcdBarrier b; b.bar = bar; b.x = xb_xcc_id(); b.st = st;
    if (threadIdx.x == 0) (void)xb_add(&bar[XB_XCNT(b.x)], 1u);
    return b;
}
__device__ __forceinline__ void xcd_barrier_complete(unsigned* bar, unsigned x, unsigned& nloc, unsigned& nx) {
    const unsigned G = gridDim.x * gridDim.y * gridDim.z;
    unsigned sum, cnt, mine, sp = 0u;
    for (;;) {
        sum = 0u; cnt = 0u; mine = 0u;
#pragma unroll
        for (unsigned j = 0; j < 16; ++j) { const unsigned c = xb_ld(&bar[XB_XCNT(j)]); sum += c; cnt += (c > 0u) ? 1u : 0u; mine = (j == x) ? c : mine; }
        if (sum == G) break;
        __builtin_amdgcn_s_sleep(1);
        if ((++sp & 255u) == 0u) { if (xb_ld(&bar[XB_TMO])) break; if (sp > XB_SPIN_CAP) { atomicAdd(&bar[XB_TMO], 1u); break; } }
    }
    nloc = mine > 0u ? mine : 1u; nx = cnt > 0u ? cnt : 1u;
}
__device__ __forceinline__ void xcd_barrier(const XcdBarrier& b) {
    asm volatile("s_waitcnt vmcnt(0)" ::: "memory");
    __syncthreads();
    if (tid_now() == 0) {
        unsigned* bar = b.bar;
        __builtin_amdgcn_s_waitcnt(0);
        unsigned nloc = b.st[0], nx = b.st[1];
        if (nloc == 0u) { xcd_barrier_complete(bar, b.x, nloc, nx); b.st[0] = nloc; b.st[1] = nx; }
        const unsigned old = xb_add(&bar[XB_XSUB(b.x)], 1u);
        const unsigned gen = old / nloc;
        if (old + 1u == (gen + 1u) * nloc) {
            __builtin_amdgcn_fence(__ATOMIC_RELEASE, "agent");
            asm volatile("s_waitcnt vmcnt(0)" ::: "memory");
            const unsigned og = xb_add(&bar[XB_TOP], 1u);
            const unsigned tg = og / nx;
            if (og + 1u == (tg + 1u) * nx) xb_add(&bar[XB_TOPGEN], 1u);
            else XB_SPIN(xb_ld(&bar[XB_TOPGEN]) == tg, bar);
            __builtin_amdgcn_fence(__ATOMIC_ACQUIRE, "agent");
            xb_add(&bar[XB_XGEN(b.x)], 1u);
            asm volatile("s_waitcnt vmcnt(0)" ::: "memory");
        } else {
            XB_SPIN(xb_ld(&bar[XB_XGEN(b.x)]) == gen, bar);
            __builtin_amdgcn_fence(__ATOMIC_ACQUIRE, "agent");
            asm volatile("s_waitcnt vmcnt(0)" ::: "memory");
        }
    }
    __syncthreads();
}

namespace pg8 {
constexpr int BM = 256, BK = 64, HALF = 128, HTB = HALF * BK * 2, STAGE_BYTES = 8 * HTB, NXCD = 8, WGM = 8;
__host__ __device__ __forceinline__ int lds_byte(int r, int c) { const int st = (r >> 4) * 2 + (c >> 5), rr = r & 15, cc = c & 31, ob = rr * 64 + cc * 2; return st * 1024 + (ob ^ (((ob >> 9) & 1) << 5)); }
__host__ __device__ __forceinline__ void stage_rc(int b, int& R, int& C) { const int st = b / 1024, sb = b % 1024, swz = sb ^ (((sb >> 9) & 1) << 5); R = (st >> 1) * 16 + swz / 64; C = (st & 1) * 32 + (swz % 64) / 2; }
__host__ __device__ __forceinline__ int perm32(int rho) { const int n = rho >> 4, i = rho & 15; return 8 * (i >> 2) + 4 * n + (i & 3); }

struct Unit { int pm, pn; };
struct Gemm { const bf16_t* A; const bf16_t* Bt; int lda, ldb, K, a_shift, a_mul; unsigned bb; };

struct StaticOrder {
    int nM, nN, nwg, G, c;
    __device__ void init(int M_, int N_, int G_, int c_) { nM = M_ / BM; nN = N_ / BM; nwg = nM * nN; G = G_; c = c_; }
    __device__ bool next(int i, Unit& u) const {
        const long L = (long)i * G + c; if (L >= nwg) return false;
        int wgid = (int)L; { const int q = nwg / NXCD, r = nwg % NXCD, xcd = wgid % NXCD, off = wgid / NXCD; wgid = (xcd < r ? xcd * (q + 1) : r * (q + 1) + (xcd - r) * q) + off; }
        const int nig = WGM * nN, gid = wgid / nig, fm = gid * WGM, gsz = (nM - fm) < WGM ? (nM - fm) : WGM;
        u.pm = fm + ((wgid % nig) % gsz); u.pn = (wgid % nig) / gsz; return true;
    }
};

template <class Epi, bool ALIGN_EPI, int MODE = 0>
__device__ __forceinline__ void gemm_phase(LAS unsigned char* lds, const Gemm g, const StaticOrder& S, const Epi& E) {
    int tid = tid_now();
    const int wid = __builtin_amdgcn_readfirstlane(tid >> 6), lane = tid & 63, wr = wid >> 2, wc = wid & 3, fr = lane & 15, fq = lane >> 4;
    const int K = g.K, nt = K / BK;
    unsigned voffA[2], voffB[2];
#pragma unroll
    for (int i = 0; i < 2; ++i) { int R, C; stage_rc(tid * 16 + i * 8192, R, C); const int Rb = Epi::PERM ? ((R & ~31) + perm32(R & 31)) : R;
        voffA[i] = (unsigned)(R * g.lda + C) * 2u; voffB[i] = (unsigned)(Rb * g.ldb + C) * 2u; }
    const size_t kstep = (size_t)(BK * 2);
    const size_t hstepA = (size_t)HALF * g.lda * 2, hstepB = (size_t)HALF * g.ldb * 2;
    const unsigned ldsw = (unsigned)wid * 1024u;
    const int aoff = lds_byte(wr * 64 + fr, fq * 8), boff = lds_byte(wc * 32 + fr, fq * 8);
#define PG8_SA(b, h) (((b) * 2 + (h)) * HTB)
#define PG8_SB(b, h) ((4 + (b) * 2 + (h)) * HTB)
#define PG8_STAGE(bufoff, gbase, voff) do { const char* _gb = (const char*)(gbase); if constexpr (MODE == 2) asm volatile("" : "+s"(_gb));     \
        _Pragma("unroll") for (int _i = 0; _i < 2; ++_i) \
        __builtin_amdgcn_global_load_lds((const unsigned*)(_gb + (voff)[_i]), (LAS unsigned*)(lds + (bufoff) + ldsw + _i * 8192), 16, 0, 0); } while (0)
#define PG8_LDA(dst, b, h) do { _Pragma("unroll") for (int m = 0; m < 4; ++m) _Pragma("unroll") for (int k = 0; k < 2; ++k) dst[m][k] = *(const LAS bf16x8*)(lds + PG8_SA(b, h) + aoff + m * 2048 + k * 1024); } while (0)
#define PG8_LDB(dst, b, h) do { _Pragma("unroll") for (int n = 0; n < 2; ++n) _Pragma("unroll") for (int k = 0; k < 2; ++k) dst[n][k] = *(const LAS bf16x8*)(lds + PG8_SB(b, h) + boff + n * 2048 + k * 1024); } while (0)
#define PG8_CAT(x0, x1) __builtin_shufflevector(__builtin_bit_cast(i32x4, x0), __builtin_bit_cast(i32x4, x1), 0, 1, 2, 3, 4, 5, 6, 7)
#define PG8_MMA(ai, bj, At, Bt) do { __builtin_amdgcn_s_setprio(1); _Pragma("unroll") for (int m = 0; m < 4; ++m) _Pragma("unroll") for (int n = 0; n < 2; ++n) { \
        if constexpr (MODE == 2) acc[ai][bj][m][n] = __builtin_amdgcn_mfma_scale_f32_16x16x128_f8f6f4(PG8_CAT(Bt[n][0], Bt[n][1]), PG8_CAT(At[m][0], At[m][1]), acc[ai][bj][m][n], 0, 0, 0, 0, 0, 0); \
        else { _Pragma("unroll") for (int k = 0; k < 2; ++k) { \
          if constexpr (MODE == 1) acc[ai][bj][m][n] = __builtin_bit_cast(f32x4, __builtin_amdgcn_mfma_i32_16x16x64_i8(__builtin_bit_cast(i32x4, Bt[n][k]), __builtin_bit_cast(i32x4, At[m][k]), __builtin_bit_cast(i32x4, acc[ai][bj][m][n]), 0, 0, 0)); \
          else if constexpr (MODE == 3) acc[ai][bj][m][n] = __builtin_amdgcn_mfma_f32_16x16x32_f16(__builtin_bit_cast(h16x8, Bt[n][k]), __builtin_bit_cast(h16x8, At[m][k]), acc[ai][bj][m][n], 0, 0, 0); \
          else acc[ai][bj][m][n] = __builtin_amdgcn_mfma_f32_16x16x32_bf16(Bt[n][k], At[m][k], acc[ai][bj][m][n], 0, 0, 0); } } } __builtin_amdgcn_s_setprio(0); } while (0)
#define PG8_WAIT_V(n) asm volatile("s_waitcnt vmcnt(" #n ")" ::: "memory")
#define PG8_WAIT_L(n) asm volatile("s_waitcnt lgkmcnt(" #n ")" ::: "memory")
#define PG8_BAR __builtin_amdgcn_s_barrier()
#define PG8_SCHED __builtin_amdgcn_sched_barrier(0)
#define PG8_ABASE(u) ((const char*)g.A + ((size_t)(u).pm * BM * g.lda + (size_t)((u).pn >> g.a_shift) * g.a_mul) * 2)
#define PG8_BBASE(u) ((const char*)g.Bt + (size_t)(u).pn * BM * g.ldb * 2 + (size_t)((u).pm >> 3) * g.bb)
    Unit cur, nxt; int ui = 0;
    if (!S.next(0, cur)) return;
    f32x4 acc[2][2][4][2];
#pragma unroll
    for (int a = 0; a < 2; ++a)
#pragma unroll
        for (int b = 0; b < 2; ++b)
#pragma unroll
            for (int m = 0; m < 4; ++m)
#pragma unroll
                for (int n = 0; n < 2; ++n) acc[a][b][m][n] = (f32x4){0.f, 0.f, 0.f, 0.f};
    bf16x8 At[4][2], B0[2][2], B1[2][2];
    const char* cA = PG8_ABASE(cur); const char* cB = PG8_BBASE(cur);
    PG8_STAGE(PG8_SB(0, 0), cB, voffB); PG8_STAGE(PG8_SB(0, 1), cB + hstepB, voffB); PG8_STAGE(PG8_SA(0, 0), cA, voffA); PG8_STAGE(PG8_SA(0, 1), cA + hstepA, voffA);
    if (wr == 1) PG8_BAR;
    PG8_WAIT_V(2); PG8_BAR;
    PG8_STAGE(PG8_SB(1, 0), cB + kstep, voffB); PG8_STAGE(PG8_SA(1, 0), cA + kstep, voffA); PG8_STAGE(PG8_SB(1, 1), cB + hstepB + kstep, voffB);
    PG8_WAIT_V(6); PG8_BAR;
    for (;;) {
        const bool has_next = S.next(ui + 1, nxt);
        const char* nA = has_next ? PG8_ABASE(nxt) : cA; const char* nB = has_next ? PG8_BBASE(nxt) : cB;
        for (int t = 0; t < nt; t += 2) {
            const bool last = (t == nt - 2);
            if constexpr (Epi::PREFETCH) { if (last) E.prefetch(lds + STAGE_BYTES, cur, wid, lane_now()); }
            const char* a1 = cA + (size_t)(t + 1) * kstep;
            const char* a2 = last ? nA : cA + (size_t)(t + 2) * kstep; const char* b2 = last ? nB : cB + (size_t)(t + 2) * kstep;
            const char* a3 = a2 + kstep; const char* b3 = b2 + kstep;
            PG8_LDB(B0, 0, 0); PG8_LDB(B1, 0, 1); PG8_SCHED; PG8_LDA(At, 0, 0); PG8_STAGE(PG8_SA(1, 1), a1 + hstepA, voffA);
            PG8_WAIT_V(8); PG8_WAIT_L(0); PG8_BAR; PG8_MMA(0, 0, At, B0); PG8_MMA(0, 1, At, B1); PG8_BAR; PG8_SCHED;
            PG8_LDA(At, 0, 1); PG8_STAGE(PG8_SB(0, 0), b2, voffB); PG8_STAGE(PG8_SB(0, 1), b2 + hstepB, voffB); PG8_STAGE(PG8_SA(0, 0), a2, voffA);
            PG8_WAIT_V(8); PG8_WAIT_L(0); PG8_BAR; PG8_MMA(1, 0, At, B0); PG8_MMA(1, 1, At, B1); PG8_BAR; PG8_SCHED;
            PG8_LDB(B0, 1, 0); PG8_LDB(B1, 1, 1); PG8_SCHED; PG8_LDA(At, 1, 0); PG8_STAGE(PG8_SA(0, 1), a2 + hstepA, voffA);
            PG8_WAIT_V(8); PG8_WAIT_L(0); PG8_BAR; PG8_MMA(0, 0, At, B0); PG8_MMA(0, 1, At, B1); PG8_BAR; PG8_SCHED;
            PG8_LDA(At, 1, 1); PG8_STAGE(PG8_SB(1, 0), b3, voffB); PG8_STAGE(PG8_SB(1, 1), b3 + hstepB, voffB); PG8_STAGE(PG8_SA(1, 0), a3, voffA);
            PG8_WAIT_V(8); PG8_WAIT_L(0); PG8_BAR; PG8_MMA(1, 0, At, B0); PG8_MMA(1, 1, At, B1); PG8_BAR; PG8_SCHED;
        }
        if constexpr (ALIGN_EPI) { if (wr == 0) PG8_BAR; }
        { const int l2 = lane_now();
          if constexpr (Epi::PREFETCH) E(acc, cur, wr, wc, l2 & 15, l2 >> 4, lds + STAGE_BYTES); else E(acc, cur, wr, wc, l2 & 15, l2 >> 4); }
        if (!has_next) break;
#pragma unroll
        for (int a = 0; a < 2; ++a)
#pragma unroll
            for (int b = 0; b < 2; ++b)
#pragma unroll
                for (int m = 0; m < 4; ++m)
#pragma unroll
                    for (int n = 0; n < 2; ++n) acc[a][b][m][n] = (f32x4){0.f, 0.f, 0.f, 0.f};
        cur = nxt; cA = nA; cB = nB; ++ui;
        if constexpr (ALIGN_EPI) { if (wr == 1) PG8_BAR; }
    }
    PG8_WAIT_V(0);
    if constexpr (!ALIGN_EPI) { if (wr == 0) PG8_BAR; }
    PG8_BAR;
#undef PG8_SA
#undef PG8_SB
#undef PG8_STAGE
#undef PG8_LDA
#undef PG8_LDB
#undef PG8_MMA
#undef PG8_CAT
#undef PG8_WAIT_V
#undef PG8_WAIT_L
#undef PG8_BAR
#undef PG8_SCHED
#undef PG8_ABASE
#undef PG8_BBASE
}

template <bool NORM> struct EpiBf16Plain {
    static constexpr bool PERM = true, PREFETCH = NORM;
    bf16_t* O; int ldc; const float* shw; int shw_stride; const unsigned long long* SS;
    __device__ __forceinline__ void prefetch(LAS unsigned char* aux, const Unit& u, int wid, int lane) const {
        if (wid < 2) __builtin_amdgcn_global_load_lds((const unsigned*)((const char*)(SS + (size_t)u.pm * BM) + wid * 1024 + lane * 16), (LAS unsigned*)(aux + wid * 1024), 16, 0, 0);
        else if (wid == 2) __builtin_amdgcn_global_load_lds((const unsigned*)((const char*)(shw + (size_t)(u.pm >> 3) * shw_stride + u.pn * BM) + lane * 16), (LAS unsigned*)(aux + 2048), 16, 0, 0);
    }
    __device__ __forceinline__ void operator()(const f32x4 (&acc)[2][2][4][2], const Unit& u, int wr, int wc, int fr, int fq, const LAS unsigned char* aux = nullptr) const {
        const int row0 = u.pm * BM + wr * 64 + fr, col0 = u.pn * BM + wc * 32 + 8 * fq;
        f32x4 bv[2][2];
#pragma unroll
        for (int bj = 0; bj < 2; ++bj)
#pragma unroll
            for (int n = 0; n < 2; ++n) bv[bj][n] = NORM ? *(const LAS f32x4*)((const LAS float*)(aux + 2048) + wc * 32 + 8 * fq + bj * HALF + 4 * n) : (f32x4){0.f, 0.f, 0.f, 0.f};
        const LAS unsigned long long* ssl = (const LAS unsigned long long*)aux + wr * 64 + fr;
#pragma unroll
        for (int ai = 0; ai < 2; ++ai)
#pragma unroll
            for (int m = 0; m < 4; ++m) { const int row = row0 + ai * HALF + m * 16; bf16_t* rowp = O + (size_t)row * ldc + col0;
                float rs = 1.0f; if (NORM) rs = 1.0f / sqrtf((float)ssl[ai * HALF + m * 16] * (1.0f / (16777216.0f * D)) + EPS);
#pragma unroll
                for (int bj = 0; bj < 2; ++bj) { const f32x4 v0 = acc[ai][bj][m][0] * rs + bv[bj][0], v1 = acc[ai][bj][m][1] * rs + bv[bj][1];
                    u32x4 w; w.x = cvt_pk_bf16(v0[0], v0[1]); w.y = cvt_pk_bf16(v0[2], v0[3]); w.z = cvt_pk_bf16(v1[0], v1[1]); w.w = cvt_pk_bf16(v1[2], v1[3]);
                    *(u32x4*)(rowp + bj * HALF) = w; } }
    }
};
struct EpiFp8 {
    static constexpr bool PERM = true, PREFETCH = false;
    unsigned char* O; int ldc;
    __device__ __forceinline__ void operator()(const f32x4 (&acc)[2][2][4][2], const Unit& u, int wr, int wc, int fr, int fq) const {
        const int row0 = u.pm * BM + wr * 64 + fr, col0 = u.pn * BM + wc * 32 + 8 * fq;
#pragma unroll
        for (int ai = 0; ai < 2; ++ai)
#pragma unroll
            for (int m = 0; m < 4; ++m) { unsigned char* rowp = O + (size_t)(row0 + ai * HALF + m * 16) * ldc + col0;
#pragma unroll
                for (int bj = 0; bj < 2; ++bj) { const f32x4 v0 = acc[ai][bj][m][0], v1 = acc[ai][bj][m][1];
                    int w0 = 0, w1 = 0;
                    w0 = __builtin_amdgcn_cvt_pk_fp8_f32(v0[0], v0[1], w0, false); w0 = __builtin_amdgcn_cvt_pk_fp8_f32(v0[2], v0[3], w0, true);
                    w1 = __builtin_amdgcn_cvt_pk_fp8_f32(v1[0], v1[1], w1, false); w1 = __builtin_amdgcn_cvt_pk_fp8_f32(v1[2], v1[3], w1, true);
                    u32x2 w; w.x = (unsigned)w0; w.y = (unsigned)w1; *(u32x2*)(rowp + bj * HALF) = w; }
                asm volatile("" ::: "memory"); }
    }
};
struct EpiInA {
    static constexpr bool PERM = true, PREFETCH = true;
    bf16_t* Q; bf16_t* CKV; bf16_t* QI; bf16_t* KIN; float* WI; const float* kg; const float* kb; const float* shw; const unsigned long long* SS;
    __device__ __forceinline__ void prefetch(LAS unsigned char* aux, const Unit& u, int wid, int lane) const {
        if (wid < 2) __builtin_amdgcn_global_load_lds((const unsigned*)((const char*)(SS + (size_t)u.pm * BM) + wid * 1024 + lane * 16), (LAS unsigned*)(aux + wid * 1024), 16, 0, 0);
        else if (wid == 2) __builtin_amdgcn_global_load_lds((const unsigned*)((const char*)(shw + (size_t)(u.pm >> 3) * 2048 + u.pn * BM) + lane * 16), (LAS unsigned*)(aux + 2048), 16, 0, 0);
    }
    __device__ __forceinline__ void operator()(f32x4 (&acc)[2][2][4][2], const Unit& u, int wr, int wc, int fr, int fq, const LAS unsigned char* aux) const {
        const int row0 = u.pm * BM + wr * 64 + fr, cl = wc * 32 + 8 * fq;
        {
            const LAS float* sp = (const LAS float*)(aux + 2048) + cl;
            const LAS unsigned long long* ssl = (const LAS unsigned long long*)aux + wr * 64 + fr;
            f32x4 bv[2][2];
#pragma unroll
            for (int bj = 0; bj < 2; ++bj)
#pragma unroll
                for (int n = 0; n < 2; ++n) bv[bj][n] = *(const LAS f32x4*)(sp + bj * HALF + 4 * n);
#pragma unroll
            for (int ai = 0; ai < 2; ++ai)
#pragma unroll
                for (int m = 0; m < 4; ++m) { const float rs = 1.0f / sqrtf((float)ssl[ai * HALF + m * 16] * (1.0f / (16777216.0f * D)) + EPS);
#pragma unroll
                    for (int bj = 0; bj < 2; ++bj)
#pragma unroll
                        for (int n = 0; n < 2; ++n) acc[ai][bj][m][n] = acc[ai][bj][m][n] * rs + bv[bj][n]; }
        }
        if (u.pn < 7) {
            bf16_t* base; int ldc, c0;
            if (u.pn < 4) { base = Q; ldc = 1024; c0 = u.pn * 256; } else if (u.pn == 4) { base = CKV; ldc = 256; c0 = 0; } else { base = QI; ldc = 512; c0 = (u.pn - 5) * 256; }
#pragma unroll
            for (int ai = 0; ai < 2; ++ai)
#pragma unroll
                for (int m = 0; m < 4; ++m) { bf16_t* rowp = base + (size_t)(row0 + ai * HALF + m * 16) * ldc + c0 + cl;
#pragma unroll
                    for (int bj = 0; bj < 2; ++bj) { const f32x4 v0 = acc[ai][bj][m][0], v1 = acc[ai][bj][m][1];
                        u32x4 w;
                        if (u.pn >= 5) { w.x = cvt_pk_f16(v0[0], v0[1]); w.y = cvt_pk_f16(v0[2], v0[3]); w.z = cvt_pk_f16(v1[0], v1[1]); w.w = cvt_pk_f16(v1[2], v1[3]); }
                        else { w.x = cvt_pk_bf16(v0[0], v0[1]); w.y = cvt_pk_bf16(v0[2], v0[3]); w.z = cvt_pk_bf16(v1[0], v1[1]); w.w = cvt_pk_bf16(v1[2], v1[3]); }
                        *(u32x4*)(rowp + bj * HALF) = w; } }
        } else if (wc == 0) {
            f32x4 gv[2][2], bv[2][2];
#pragma unroll
            for (int bj = 0; bj < 2; ++bj)
#pragma unroll
                for (int n = 0; n < 2; ++n) { gv[bj][n] = *(const f32x4*)(kg + 32 * bj + 8 * fq + 4 * n); bv[bj][n] = *(const f32x4*)(kb + 32 * bj + 8 * fq + 4 * n); }
#pragma unroll
            for (int ai = 0; ai < 2; ++ai)
#pragma unroll
                for (int m = 0; m < 4; ++m) {
                    float s = 0.f;
#pragma unroll
                    for (int bj = 0; bj < 2; ++bj)
#pragma unroll
                        for (int n = 0; n < 2; ++n) { const f32x4 x = acc[ai][bj][m][n]; s += (x[0] + x[1]) + (x[2] + x[3]); }
                    s = rows_sum(s);
                    const float mu = s * (1.0f / 64.0f); float q = 0.f;
#pragma unroll
                    for (int bj = 0; bj < 2; ++bj)
#pragma unroll
                        for (int n = 0; n < 2; ++n) { const f32x4 d = acc[ai][bj][m][n] - mu; q += (d[0] * d[0] + d[1] * d[1]) + (d[2] * d[2] + d[3] * d[3]); }
                    q = rows_sum(q);
                    const float rs = 1.0f / sqrtf(q * (1.0f / 64.0f) + EPS);
                    bf16_t* rowp = KIN + (size_t)(row0 + ai * HALF + m * 16) * 64 + 8 * fq;
#pragma unroll
                    for (int bj = 0; bj < 2; ++bj) { const f32x4 v0 = (acc[ai][bj][m][0] - mu) * rs * gv[bj][0] + bv[bj][0], v1 = (acc[ai][bj][m][1] - mu) * rs * gv[bj][1] + bv[bj][1];
                        u32x4 w; w.x = cvt_pk_f16(v0[0], v0[1]); w.y = cvt_pk_f16(v0[2], v0[3]); w.z = cvt_pk_f16(v1[0], v1[1]); w.w = cvt_pk_f16(v1[2], v1[3]);
                        *(u32x4*)(rowp + bj * 32) = w; }
                }
        } else if (wc == 1 && fq == 0) {
            const float sc = 0.04419417382415922f;
#pragma unroll
            for (int ai = 0; ai < 2; ++ai)
#pragma unroll
                for (int m = 0; m < 4; ++m) { float* rowp = WI + (size_t)(row0 + ai * HALF + m * 16) * 8;
                    *(f32x4*)(rowp) = acc[ai][0][m][0] * sc; *(f32x4*)(rowp + 4) = acc[ai][0][m][1] * sc; }
        }
    }
};
constexpr float Q8_CLIP = 4.75f;
__device__ __forceinline__ unsigned q8_bits(float v) { return __float_as_uint(__builtin_amdgcn_fmed3f(v, -127.0f, 127.0f) + 12582912.0f); }
__device__ __forceinline__ unsigned q8_pack(unsigned a, unsigned b, unsigned c, unsigned d) { return __builtin_amdgcn_perm(b, a, 0x0c0c0400u) | __builtin_amdgcn_perm(d, c, 0x04000c0cu); }
template <bool Q8> struct EpiResid {
    static constexpr bool PERM = true, PREFETCH = true;
    const bf16_t* xin_b; bf16_t* xout_b;
    const float* gate; const float* bias;
    static constexpr float asc = Q8 ? 1.0f / 4096.0f : 1.0f;
    bf16_t* XG; const float* gn; const float* scn; unsigned long long* SSo; const unsigned long long* SSq;
    __device__ __forceinline__ void prefetch(LAS unsigned char* aux, const Unit& u, int wid, int lane) const {
        const int b = u.pm >> 3; const char* src = nullptr;
        if (wid == 0) src = (const char*)(gate + (size_t)b * 6144 + u.pn * BM);
        else if (wid == 1) src = bias ? (const char*)(bias + u.pn * BM) : nullptr;
        else if constexpr (Q8) { if (wid == 4 || wid == 5) src = (const char*)(SSq + (size_t)u.pm * BM) + (wid - 4) * 1024; }
        else { if (wid == 2) src = XG ? (const char*)(gn + u.pn * BM) : nullptr;
               else if (wid == 3) src = XG ? (const char*)(scn + (size_t)b * 6144 + u.pn * BM) : nullptr; }
        if (src) __builtin_amdgcn_global_load_lds((const unsigned*)(src + lane * 16), (LAS unsigned*)(aux + wid * 1024), 16, 0, 0);
    }
    __device__ __forceinline__ void operator()(const f32x4 (&acc)[2][2][4][2], const Unit& u, int wr, int wc, int fr, int fq, const LAS unsigned char* aux) const {
        const int row0 = u.pm * BM + wr * 64 + fr, col0 = u.pn * BM + wc * 32 + 8 * fq, b = u.pm >> 3;
        const LAS unsigned long long* sql = (const LAS unsigned long long*)(aux + 4096) + wr * 64 + fr;
        const LAS float* lv = (const LAS float*)aux + wc * 32 + 8 * fq;
        float ssum[2][4];
#pragma unroll
        for (int ai = 0; ai < 2; ++ai)
#pragma unroll
            for (int m = 0; m < 4; ++m) ssum[ai][m] = 0.f;
#pragma unroll
        for (int bj = 0; bj < 2; ++bj) {
            const int c = col0 + bj * HALF;
            const LAS float* lp = lv + bj * HALF;
            const f32x4 gv0 = *(const LAS f32x4*)(lp), gv1 = *(const LAS f32x4*)(lp + 4);
            f32x4 bv0 = (f32x4){0.f, 0.f, 0.f, 0.f}, bv1 = bv0, gm0 = bv0, gm1 = bv0;
            if (bias) { bv0 = *(const LAS f32x4*)(lp + 256); bv1 = *(const LAS f32x4*)(lp + 256 + 4); }
            if (!Q8 && XG) { gm0 = *(const LAS f32x4*)(lp + 512) * (*(const LAS f32x4*)(lp + 768) + 1.0f); gm1 = *(const LAS f32x4*)(lp + 512 + 4) * (*(const LAS f32x4*)(lp + 768 + 4) + 1.0f); }
#pragma unroll
            for (int ai = 0; ai < 2; ++ai)
#pragma unroll
                for (int m = 0; m < 4; ++m) { const size_t off = (size_t)(row0 + ai * HALF + m * 16) * D + c;
                    const u32x4 xv = *(const u32x4*)(xin_b + off);
                    const f32x2 xa = unpk_f16(xv.x), xb = unpk_f16(xv.y), xc = unpk_f16(xv.z), xd = unpk_f16(xv.w);
                    const f32x4 xi0 = (f32x4){xa.x, xa.y, xb.x, xb.y}, xi1 = (f32x4){xc.x, xc.y, xd.x, xd.y};
                    const f32x4 xo0 = xi0 + gv0 * (acc[ai][bj][m][0] * asc + bv0), xo1 = xi1 + gv1 * (acc[ai][bj][m][1] * asc + bv1);
                    { u32x4 w; w.x = cvt_pk_f16(xo0[0], xo0[1]); w.y = cvt_pk_f16(xo0[2], xo0[3]); w.z = cvt_pk_f16(xo1[0], xo1[1]); w.w = cvt_pk_f16(xo1[2], xo1[3]); *(u32x4*)(xout_b + off) = w; }
                    if (XG) {
                        ssum[ai][m] += ((xo0[0] * xo0[0] + xo0[1] * xo0[1]) + (xo0[2] * xo0[2] + xo0[3] * xo0[3])) + ((xo1[0] * xo1[0] + xo1[1] * xo1[1]) + (xo1[2] * xo1[2] + xo1[3] * xo1[3]));
                        if constexpr (Q8) {
                            const float qs = (127.0f / Q8_CLIP) / sqrtf((float)sql[ai * HALF + m * 16] * (1.0f / (16777216.0f * D)) + EPS);
                            u32x2 w; w.x = q8_pack(q8_bits(xo0[0] * qs), q8_bits(xo0[1] * qs), q8_bits(xo0[2] * qs), q8_bits(xo0[3] * qs));
                            w.y = q8_pack(q8_bits(xo1[0] * qs), q8_bits(xo1[1] * qs), q8_bits(xo1[2] * qs), q8_bits(xo1[3] * qs));
                            *(u32x2*)((unsigned char*)XG + off) = w;
                        } else {
                        const f32x4 y0 = xo0 * gm0, y1 = xo1 * gm1;
                        u32x4 w; w.x = cvt_pk_f16(y0[0], y0[1]); w.y = cvt_pk_f16(y0[2], y0[3]); w.z = cvt_pk_f16(y1[0], y1[1]); w.w = cvt_pk_f16(y1[2], y1[3]);
                        *(u32x4*)(XG + off) = w; } }
                    if (m & 1) asm volatile("" ::: "memory"); }
        }
        if (XG) {
#pragma unroll
            for (int ai = 0; ai < 2; ++ai)
#pragma unroll
                for (int m = 0; m < 4; ++m) { float q = ssum[ai][m]; q = rows_sum(q);
                    if (fq == 0) atomicAdd(SSo + row0 + ai * HALF + m * 16, (unsigned long long)(q * 16777216.0f)); }
        }
    }
};
struct EpiSwiGLU {
    static constexpr bool PERM = true, PREFETCH = true;
    bf16_t* H; const float* shw; const unsigned long long* SS; const float* CW; const unsigned long long* SSq;
    __device__ __forceinline__ void prefetch(LAS unsigned char* aux, const Unit& u, int wid, int lane) const {
        if (wid < 2) __builtin_amdgcn_global_load_lds((const unsigned*)((const char*)(SS + (size_t)u.pm * BM) + wid * 1024 + lane * 16), (LAS unsigned*)(aux + wid * 1024), 16, 0, 0);
        else if (wid == 2) __builtin_amdgcn_global_load_lds((const unsigned*)((const char*)(shw + (size_t)(u.pm >> 3) * (2 * DFF) + u.pn * BM) + lane * 16), (LAS unsigned*)(aux + 2048), 16, 0, 0);
        else if (wid == 3) __builtin_amdgcn_global_load_lds((const unsigned*)((const char*)(CW + (size_t)(u.pm >> 3) * (2 * DFF) + u.pn * BM) + lane * 16), (LAS unsigned*)(aux + 3072), 16, 0, 0);
        else if (wid < 6) __builtin_amdgcn_global_load_lds((const unsigned*)((const char*)(SSq + (size_t)u.pm * BM) + (wid - 4) * 1024 + lane * 16), (LAS unsigned*)(aux + wid * 1024), 16, 0, 0);
    }
    __device__ __forceinline__ void operator()(const f32x4 (&acc)[2][2][4][2], const Unit& u, int wr, int wc, int fr, int fq, const LAS unsigned char* aux) const {
        const int row0 = u.pm * BM + wr * 64 + fr, f0 = u.pn * 128 + wc * 32 + 8 * fq;
        f32x4 bv[2][2], cv[2][2];
        { const LAS float* sp = (const LAS float*)(aux + 2048) + wc * 32 + 8 * fq;
#pragma unroll
          for (int bj = 0; bj < 2; ++bj)
#pragma unroll
              for (int n = 0; n < 2; ++n) { bv[bj][n] = *(const LAS f32x4*)(sp + bj * HALF + 4 * n); cv[bj][n] = *(const LAS f32x4*)(sp + 256 + bj * HALF + 4 * n); } }
        const LAS unsigned long long* ssl = (const LAS unsigned long long*)aux + wr * 64 + fr;
        const LAS unsigned long long* sql = (const LAS unsigned long long*)(aux + 4096) + wr * 64 + fr;
#pragma unroll
        for (int ai = 0; ai < 2; ++ai)
#pragma unroll
            for (int m = 0; m < 4; ++m) { bf16_t* rowp = H + (size_t)(row0 + ai * HALF + m * 16) * DFF + f0;
                const float rs = (Q8_CLIP / 127.0f) * sqrtf((float)sql[ai * HALF + m * 16] * (1.0f / (16777216.0f * D)) + EPS) / sqrtf((float)ssl[ai * HALF + m * 16] * (1.0f / (16777216.0f * D)) + EPS);
                float o[8];
#pragma unroll
                for (int n = 0; n < 2; ++n)
#pragma unroll
                    for (int e = 0; e < 4; ++e) { const float a0 = (float)__float_as_int(acc[ai][0][m][n][e]) * rs, a1 = (float)__float_as_int(acc[ai][1][m][n][e]) * rs;
                        o[4 * n + e] = silu_f(a0 * cv[0][n][e] + bv[0][n][e]) * (a1 * cv[1][n][e] + bv[1][n][e]); }
                u32x4 w; w.x = cvt_pk_bf16(o[0], o[1]); w.y = cvt_pk_bf16(o[2], o[3]); w.z = cvt_pk_bf16(o[4], o[5]); w.w = cvt_pk_bf16(o[6], o[7]);
                *(u32x4*)(rowp) = w; }
    }
};
}

struct Ptrs {
    const float* in[23]; float* out; unsigned char* ws;
};
enum { I_X = 0, I_C, I_RELB, I_WADA, I_BADA, I_GMIX, I_GFFN, I_AWIN, I_AKVG, I_AWUK, I_AWUV, I_AIKG, I_AIKB, I_AWOUT, I_BWIN, I_BBIN, I_BSINK, I_BWOUT, I_BBOUT, I_W1, I_W3, I_W2, I_GFIN };

__device__ __forceinline__ void conv_task(const Ptrs& P, int t, int lane) {
    int kind, rb, ks, Kd; bf16_t* dst; const float* s0 = nullptr; const float* s1 = nullptr; const float* gk = nullptr; int ld = 0; bool f8 = false, h16 = false;
    if (t < 2112) { const int l = t / 528, r = t % 528; unsigned char* wl = P.ws + WS_W + (size_t)l * W_LAYER;
        if (r < 352) { kind = 1; rb = r >> 2; ks = r & 3; Kd = 1024; dst = (bf16_t*)(wl + W13_OFF); s0 = P.in[I_W1] + (size_t)l * D * DFF; s1 = P.in[I_W3] + (size_t)l * D * DFF; ld = DFF; }
        else { const int r2 = r - 352; kind = 0; rb = r2 / 11; ks = r2 % 11; Kd = DFF; dst = (bf16_t*)(wl + W2_OFF); s0 = P.in[I_W2] + (size_t)l * DFF * D; ld = D; }
    } else { const int t2 = t - 2112, j = t2 / 464, r = t2 % 464; unsigned char* wa = P.ws + WS_WA + (size_t)j * WA_STRIDE; unsigned char* wb = P.ws + WS_WB + (size_t)j * WB_STRIDE;
        if (r < 128) { kind = 2; rb = r >> 2; ks = r & 3; Kd = 1024; dst = (bf16_t*)(wa + WINA_OFF); s0 = P.in[I_AWIN] + (size_t)j * D * A_IN; ld = A_IN; h16 = true; }
        else if (r < 192) { kind = 3; rb = r - 128; ks = 0; Kd = 256; dst = (bf16_t*)(wa + WQA_OFF); s0 = P.in[I_AWUK] + (size_t)j * NH * RK * HD; gk = P.in[I_AKVG] + j * RK; }
        else if (r < 256) { const int r2 = r - 192; kind = 4; rb = r2 >> 2; ks = r2 & 3; Kd = 1024; dst = (bf16_t*)(wa + WUV_OFF); s0 = P.in[I_AWUV] + (size_t)j * NH * RK * HD; gk = P.in[I_AKVG] + j * RK; }
        else if (r < 320) { const int r2 = r - 256; kind = 0; rb = r2 >> 2; ks = r2 & 3; Kd = 1024; dst = (bf16_t*)(wa + WOUTA_OFF); s0 = P.in[I_AWOUT] + (size_t)j * D * D; ld = D; f8 = true; }
        else if (r < 400) { const int r2 = r - 320; kind = 0; rb = r2 >> 2; ks = r2 & 3; Kd = 1024; dst = (bf16_t*)(wb + WINB_OFF); s0 = P.in[I_BWIN] + (size_t)j * D * B_IN; ld = B_IN; h16 = true; }
        else { const int r2 = r - 400; kind = 0; rb = r2 >> 2; ks = r2 & 3; Kd = 1024; dst = (bf16_t*)(wb + WOUTB_OFF); s0 = P.in[I_BWOUT] + (size_t)j * D * D; ld = D; f8 = true; }
    }
    const int n = rb * 64 + lane, k0 = ks * 256;
    bf16_t* drow = dst + (size_t)n * Kd + k0;
    if (kind <= 2) {
        const float* src = s0; int col = n;
        if (kind == 1) { const int c = n & 255, f = (n >> 8) * 128 + (c & 127); src = (c < 128) ? s0 : s1; col = f; }
        if (kind == 2) { if (n >= 1792) { const int c = n - 1792; col = c < 32 ? 1792 + c : (c < 40 ? 1856 + (c - 32) : ((c >= 128 && c < 160) ? 1824 + (c - 128) : -1)); } }
        const float* sp = src + (size_t)k0 * ld + (col < 0 ? 0 : col);
        for (int kc = 0; kc < 32; ++kc) {
            float v[8];
#pragma unroll
            for (int e = 0; e < 8; ++e) v[e] = sp[(size_t)(kc * 8 + e) * ld];
            if (col < 0) {
#pragma unroll
                for (int e = 0; e < 8; ++e) v[e] = 0.f; }
            if (f8) {
#pragma unroll
                for (int e = 0; e < 8; ++e) v[e] = __builtin_amdgcn_fmed3f(v[e] * 256.0f, -448.0f, 448.0f);
                int w0 = 0, w1 = 0;
                w0 = __builtin_amdgcn_cvt_pk_fp8_f32(v[0], v[1], w0, false); w0 = __builtin_amdgcn_cvt_pk_fp8_f32(v[2], v[3], w0, true);
                w1 = __builtin_amdgcn_cvt_pk_fp8_f32(v[4], v[5], w1, false); w1 = __builtin_amdgcn_cvt_pk_fp8_f32(v[6], v[7], w1, true);
                u32x2 w; w.x = (unsigned)w0; w.y = (unsigned)w1; *(u32x2*)((unsigned char*)dst + (size_t)n * Kd + k0 + kc * 8) = w;
            } else if (h16) {
            u32x4 w; w.x = cvt_pk_f16(v[0], v[1]); w.y = cvt_pk_f16(v[2], v[3]); w.z = cvt_pk_f16(v[4], v[5]); w.w = cvt_pk_f16(v[6], v[7]);
            *(u32x4*)(drow + kc * 8) = w;
            } else {
            u32x4 w; w.x = cvt_pk_bf16(v[0], v[1]); w.y = cvt_pk_bf16(v[2], v[3]); w.z = cvt_pk_bf16(v[4], v[5]); w.w = cvt_pk_bf16(v[6], v[7]);
            *(u32x4*)(drow + kc * 8) = w; }
        }
    } else if (kind == 3) {
        const int h = n >> 8, r = n & 255; const float gs = gk[r] * 8.0f;       const float* sp = s0 + ((size_t)h * RK + r) * HD;
        for (int kc = 0; kc < 32; ++kc) { const int k = kc * 8; float v[8];
            if ((k >> 6) == (h & 3)) {
#pragma unroll
                for (int e = 0; e < 8; ++e) v[e] = sp[(k & 63) + e] * gs;
            } else {
#pragma unroll
                for (int e = 0; e < 8; ++e) v[e] = 0.f; }
            u32x4 w; w.x = cvt_pk_bf16(v[0], v[1]); w.y = cvt_pk_bf16(v[2], v[3]); w.z = cvt_pk_bf16(v[4], v[5]); w.w = cvt_pk_bf16(v[6], v[7]);
            *(u32x4*)(drow + kc * 8) = w; }
    } else {
        const int hh = (n >> 6) & 3, d = n & 63, h = n >> 6;
        for (int kc = 0; kc < 32; ++kc) { const int k = k0 + kc * 8; float v[8];
            if ((k >> 8) == hh) {
#pragma unroll
                for (int e = 0; e < 8; ++e) { const int r = (k & 255) + e; v[e] = s0[((size_t)h * RK + r) * HD + d] * gk[r] * 16.0f; }
            } else {
#pragma unroll
                for (int e = 0; e < 8; ++e) v[e] = 0.f; }
            u32x4 w; w.x = cvt_pk_bf16(v[0], v[1]); w.y = cvt_pk_bf16(v[2], v[3]); w.z = cvt_pk_bf16(v[4], v[5]); w.w = cvt_pk_bf16(v[6], v[7]);
            *(u32x4*)(drow + kc * 8) = w; }
    }
}
constexpr int N_CONV_TASKS = 3040;

__device__ __forceinline__ void p0_prologue(const Ptrs& P, LAS unsigned char* lds, int G) {
    int tid = tid_now();
    const int lane = tid & 63, wave = __builtin_amdgcn_readfirstlane(tid >> 6);
    const int gw = blockIdx.x * NWAVES + wave, NGW = G * NWAVES;
    for (int t = gw; t < N_CONV_TASKS; t += NGW) conv_task(P, t, lane);
    LAS float* cs = (LAS float*)lds;
    LAS float* red = (LAS float*)(lds + 65536);
    for (int i = tid; i < BATCH * D; i += NTHR) { const int b = i >> 10, k = i & 1023; cs[k * 16 + b] = silu_f(P.in[I_C][i]); }
    __syncthreads();
    float* mod = (float*)(P.ws + WS_MOD);
    for (int task = blockIdx.x; task < 4 * 96; task += G) {
        const int l = task / 96, j0 = (task % 96) * 64, col = tid & 63, ksl = tid >> 6;
        const float* wp = P.in[I_WADA] + ((size_t)l * D + ksl * 128) * 6144 + j0 + col;
        float a[16];
#pragma unroll
        for (int b = 0; b < 16; ++b) a[b] = 0.f;
        for (int k = 0; k < 128; ++k) { const float w = wp[(size_t)k * 6144]; const LAS f32x4* c4 = (const LAS f32x4*)(cs + (ksl * 128 + k) * 16);
#pragma unroll
            for (int q = 0; q < 4; ++q) { const f32x4 c = c4[q];
#pragma unroll
                for (int e = 0; e < 4; ++e) a[4 * q + e] += w * c[e]; } }
#pragma unroll
        for (int b = 0; b < 16; ++b) red[(ksl * 64 + col) * 16 + b] = a[b];
        __syncthreads();
        for (int o = tid; o < 1024; o += NTHR) { const int c2 = o >> 4, b = o & 15; float s = 0.f;
#pragma unroll
            for (int q = 0; q < 8; ++q) s += red[(q * 64 + c2) * 16 + b];
            mod[((size_t)l * BATCH + b) * 6144 + j0 + c2] = s + P.in[I_BADA][l * 6144 + j0 + c2]; }
        __syncthreads();
    }
}

__device__ __forceinline__ void pre_phase(const Ptrs& P, LAS unsigned char* lds, int G) {
    int tid = tid_now();
    const int lane = tid & 63, wave = __builtin_amdgcn_readfirstlane(tid >> 6);
    const float* mod = (const float*)(P.ws + WS_MOD);
    {
        const int grp = blockIdx.x & 7, l = grp >> 1, kind = grp & 1, j = l >> 1;
        const float* shsrc = mod + (size_t)l * BATCH * 6144 + (kind ? 3072 : 0);
        constexpr int SP = 2064;
        for (int i = tid; i < BATCH * D / 2; i += NTHR) { const int b = i >> 9, k2 = (i & 511) * 2;
            const float a0 = shsrc[(size_t)b * 6144 + k2], a1 = shsrc[(size_t)b * 6144 + k2 + 1];
            *(LAS unsigned*)(lds + b * SP + k2 * 2) = kind ? cvt_pk_bf16(a0, a1) : cvt_pk_f16(a0, a1); }
        __syncthreads();
        const bf16_t* W; int nrows; float* dst; const float* bias = nullptr;
        if (kind) { W = (const bf16_t*)(P.ws + WS_W + (size_t)l * W_LAYER + W13_OFF); nrows = 2 * DFF; dst = (float*)(P.ws + WS_SHW + SHW_F) + (size_t)l * BATCH * 2 * DFF; }
        else if ((l & 1) == 0) { W = (const bf16_t*)(P.ws + WS_WA + (size_t)j * WA_STRIDE + WINA_OFF); nrows = 2048; dst = (float*)(P.ws + WS_SHW + SHW_A) + (size_t)j * BATCH * 2048; }
        else { W = (const bf16_t*)(P.ws + WS_WB + (size_t)j * WB_STRIDE + WINB_OFF); nrows = B_IN; dst = (float*)(P.ws + WS_SHW + SHW_B) + (size_t)j * BATCH * B_IN; bias = P.in[I_BBIN] + j * B_IN; }
        const int nblk = nrows >> 4, wq = (blockIdx.x >> 3) * NWAVES + wave, nwq = (G >> 3) * NWAVES;
        const int nn = lane & 15, g = lane >> 4;
        for (int blk = wq; blk < nblk; blk += nwq) {
            f32x4 acc = (f32x4){0.f, 0.f, 0.f, 0.f};
            const bf16_t* wp = W + (size_t)(blk * 16 + nn) * D + 8 * g;
#pragma unroll 8
            for (int ks = 0; ks < 32; ++ks) { const bf16x8 a = *(const LAS bf16x8*)(lds + nn * SP + (32 * ks + 8 * g) * 2); const bf16x8 bw = *(const bf16x8*)(wp + 32 * ks);
                acc = kind ? __builtin_amdgcn_mfma_f32_16x16x32_bf16(a, bw, acc, 0, 0, 0) : __builtin_amdgcn_mfma_f32_16x16x32_f16(__builtin_bit_cast(h16x8, a), __builtin_bit_cast(h16x8, bw), acc, 0, 0, 0); }
            const int n = blk * 16 + nn; const float bb = bias ? bias[n] : 0.f;
#pragma unroll
            for (int i = 0; i < 4; ++i) dst[(size_t)(4 * g + i) * nrows + n] = acc[i] + bb;
        }
    }
    {
        const int gw = blockIdx.x * NWAVES + wave, NGW = G * NWAVES;
        const float* x = P.in[I_X]; const float* gmix = P.in[I_GMIX]; bf16_t* XG = (bf16_t*)(P.ws + WS_XG); unsigned long long* SS0 = (unsigned long long*)(P.ws + WS_SS);
        for (int row = gw; row < M; row += NGW) {
            const int b = row >> 11;
            const f32x4* xr = (const f32x4*)(x + (size_t)row * D) + lane;
            f32x4 v[4]; float sq = 0.f;
#pragma unroll
            for (int jj = 0; jj < 4; ++jj) { v[jj] = xr[64 * jj]; sq += (v[jj][0] * v[jj][0] + v[jj][1] * v[jj][1]) + (v[jj][2] * v[jj][2] + v[jj][3] * v[jj][3]); }
            const float ss = wave_sum(sq);
            if (lane == 0) SS0[row] = (unsigned long long)(ss * 16777216.0f);
            const float* mb = mod + (size_t)b * 6144;
            u32x2* o8 = (u32x2*)(XG + (size_t)row * D) + lane; u32x2* x8 = (u32x2*)((bf16_t*)P.out + (size_t)row * D) + lane;
#pragma unroll
            for (int jj = 0; jj < 4; ++jj) { const int c = 4 * lane + 256 * jj;
                const f32x4 y = v[jj] * *(const f32x4*)(gmix + c) * (*(const f32x4*)(mb + 1024 + c) + 1.0f);
                u32x2 w; w.x = cvt_pk_f16(y[0], y[1]); w.y = cvt_pk_f16(y[2], y[3]); o8[64 * jj] = w;
                u32x2 xw; xw.x = cvt_pk_f16(v[jj][0], v[jj][1]); xw.y = cvt_pk_f16(v[jj][2], v[jj][3]); x8[64 * jj] = xw; }
        }
    }
}
__device__ __forceinline__ float half_max(float x);
__device__ __forceinline__ float wave_max(float x) {
    const float h = half_max(x);
    const u32x2 r = __builtin_amdgcn_permlane32_swap(__float_as_uint(h), __float_as_uint(h), false, false);
    return fmaxf(__uint_as_float(r.x), __uint_as_float(r.y));
}
__device__ __forceinline__ void w8_build(const bf16_t* W13, const float* gffn, const float* scn, unsigned char* W8, float* CW, LAS unsigned char* lds, int G) {
    int tid = tid_now();
    const int lane = tid & 63, wave = __builtin_amdgcn_readfirstlane(tid >> 6);
    LAS float* mL = (LAS float*)lds;
    for (int i = tid; i < BATCH * D / 4; i += NTHR) { const int b = i >> 8, k4 = (i & 255) * 4;
        *(LAS f32x4*)(mL + b * D + k4) = *(const f32x4*)(gffn + k4) * (*(const f32x4*)(scn + (size_t)b * 6144 + k4) + 1.0f); }
    __syncthreads();
    const int gw = blockIdx.x * NWAVES + wave, NGW = G * NWAVES;
    for (int n = gw; n < 2 * DFF; n += NGW) {
        const u32x2* wrow = (const u32x2*)(W13 + (size_t)n * D) + lane;
        float w[16];
#pragma unroll
        for (int j = 0; j < 4; ++j) { const u32x2 p = wrow[64 * j];
            w[4 * j] = __uint_as_float(p.x << 16); w[4 * j + 1] = __uint_as_float(p.x & 0xffff0000u); w[4 * j + 2] = __uint_as_float(p.y << 16); w[4 * j + 3] = __uint_as_float(p.y & 0xffff0000u); }
        unsigned* orow = (unsigned*)(W8 + (size_t)n * D) + lane;
#pragma unroll 2
        for (int b = 0; b < BATCH; ++b) {
            float v[16]; float mx = 0.f;
#pragma unroll
            for (int j = 0; j < 4; ++j) { const f32x4 mm = *(const LAS f32x4*)(mL + b * D + 256 * j + 4 * lane);
#pragma unroll
                for (int e = 0; e < 4; ++e) { v[4 * j + e] = w[4 * j + e] * mm[e]; mx = fmaxf(mx, fabsf(v[4 * j + e])); } }
            mx = fmaxf(wave_max(mx), 1e-30f);
            const float inv = 127.0f / mx;
#pragma unroll
            for (int j = 0; j < 4; ++j)
                orow[(size_t)b * (W8_BATCH / 4) + 64 * j] = pg8::q8_pack(pg8::q8_bits(v[4 * j] * inv), pg8::q8_bits(v[4 * j + 1] * inv), pg8::q8_bits(v[4 * j + 2] * inv), pg8::q8_bits(v[4 * j + 3] * inv));
            if (lane == 0) CW[(size_t)b * (2 * DFF) + n] = mx * (1.0f / 127.0f);
        }
    }
    __syncthreads();
}
__device__ __forceinline__ void final_norm_phase(const bf16_t* x, float* out, const float* g, int G) {
    int tid = tid_now();
    const int lane = tid & 63, wave = __builtin_amdgcn_readfirstlane(tid >> 6);
    const int gw = blockIdx.x * NWAVES + wave, NGW = G * NWAVES;
    for (int row = gw; row < M; row += NGW) {
        const u32x2* xr = (const u32x2*)(x + (size_t)row * D) + lane; f32x4* orow = (f32x4*)(out + (size_t)row * D) + lane;
        f32x4 v[4]; float s = 0.f;
#pragma unroll
        for (int j = 0; j < 4; ++j) { const u32x2 p = xr[64 * j];
            { const f32x2 pa = unpk_f16(p.x), pb = unpk_f16(p.y); v[j] = (f32x4){pa.x, pa.y, pb.x, pb.y}; }
            s += (v[j][0] * v[j][0] + v[j][1] * v[j][1]) + (v[j][2] * v[j][2] + v[j][3] * v[j][3]); }
        const float rstd = 1.0f / sqrtf(wave_sum(s) * (1.0f / D) + EPS);
#pragma unroll
        for (int j = 0; j < 4; ++j) { const f32x4 gg = *(const f32x4*)(g + 4 * lane + 256 * j); orow[64 * j] = v[j] * rstd * gg; }
    }
}

__device__ __forceinline__ unsigned f2key(float f) { const unsigned u = __float_as_uint(f); return (u & 0x80000000u) ? ~u : (u | 0x80000000u); }
__device__ __forceinline__ float key2f(unsigned k) { return __uint_as_float((k & 0x80000000u) ? (k & 0x7fffffffu) : ~k); }
__device__ __forceinline__ float half_max(float x) {
    int u = __float_as_int(x);
    u = __float_as_int(fmaxf(__int_as_float(u), __int_as_float(__builtin_amdgcn_update_dpp(u, u, 0x128, 0xf, 0xf, false))));
    u = __float_as_int(fmaxf(__int_as_float(u), __int_as_float(__builtin_amdgcn_update_dpp(u, u, 0x124, 0xf, 0xf, false))));
    u = __float_as_int(fmaxf(__int_as_float(u), __int_as_float(__builtin_amdgcn_update_dpp(u, u, 0x122, 0xf, 0xf, false))));
    u = __float_as_int(fmaxf(__int_as_float(u), __int_as_float(__builtin_amdgcn_update_dpp(u, u, 0x121, 0xf, 0xf, false))));
    const u32x2 r = __builtin_amdgcn_permlane16_swap((unsigned)u, (unsigned)u, false, false);
    return fmaxf(__uint_as_float(r.x), __uint_as_float(r.y));
}
__device__ __forceinline__ float half_sum_f(float v) {
    v += __int_as_float(__builtin_amdgcn_update_dpp(__float_as_int(v), __float_as_int(v), 0x128, 0xf, 0xf, false));
    v += __int_as_float(__builtin_amdgcn_update_dpp(__float_as_int(v), __float_as_int(v), 0x124, 0xf, 0xf, false));
    v += __int_as_float(__builtin_amdgcn_update_dpp(__float_as_int(v), __float_as_int(v), 0x122, 0xf, 0xf, false));
    v += __int_as_float(__builtin_amdgcn_update_dpp(__float_as_int(v), __float_as_int(v), 0x121, 0xf, 0xf, false));
    const u32x2 r = __builtin_amdgcn_permlane16_swap(__float_as_uint(v), __float_as_uint(v), false, false);
    return __uint_as_float(r.x) + __uint_as_float(r.y);
}
__device__ __forceinline__ f32x2 pk_gt(f32x2 x, f32x2 big, f32x2 nfbig) { f32x2 d; asm("v_pk_fma_f32 %0, %1, %2, %3 clamp" : "=v"(d) : "v"(x), "v"(big), "v"(nfbig)); return d; }
__device__ __forceinline__ int half_sum(int v) {
    v += __builtin_amdgcn_update_dpp(v, v, 0x128, 0xf, 0xf, false);
    v += __builtin_amdgcn_update_dpp(v, v, 0x124, 0xf, 0xf, false);
    v += __builtin_amdgcn_update_dpp(v, v, 0x122, 0xf, 0xf, false);
    v += __builtin_amdgcn_update_dpp(v, v, 0x121, 0xf, 0xf, false);
    const u32x2 r = __builtin_amdgcn_permlane16_swap((unsigned)v, (unsigned)v, false, false);
    return (int)(r.x + r.y);
}
typedef float f32x32 __attribute__((ext_vector_type(32)));
__device__ __forceinline__ void idx_task(const bf16_t* QI, const bf16_t* KIN, const float* WI, unsigned* SEL, LAS unsigned char* lds, int b, int tg, int lane, int wave, bool active, int nrounds) {
    asm volatile("" : "+v"(lane));
    const int t0 = tg * 4, h = lane >> 5, r = lane & 31;
    const int qsel = 2 * (r >> 4) + ((r >> 2) & 1), hd = (r & 3) + 4 * ((r >> 3) & 1);
    const size_t rowb = (size_t)b * SEQ;
    bf16x8 aq[4];
#pragma unroll
    for (int ks = 0; ks < 4; ++ks) aq[ks] = *(const bf16x8*)(QI + (rowb + t0 + qsel) * 512 + hd * 64 + ks * 16 + h * 8);
    float wlo[8], whi[8];
    { const f32x4 a0 = *(const f32x4*)(WI + (rowb + t0 + h) * 8), a1 = *(const f32x4*)(WI + (rowb + t0 + h) * 8 + 4);
      const f32x4 b0 = *(const f32x4*)(WI + (rowb + t0 + 2 + h) * 8), b1 = *(const f32x4*)(WI + (rowb + t0 + 2 + h) * 8 + 4);
#pragma unroll
      for (int e = 0; e < 4; ++e) { wlo[e] = a0[e]; wlo[4 + e] = a1[e]; whi[e] = b0[e]; whi[4 + e] = b1[e]; } }
    f32x32 sA0, sA1, sB0, sB1;
#pragma unroll
    for (int i = 0; i < 32; ++i) { sA0[i] = NEGF; sA1[i] = NEGF; sB0[i] = NEGF; sB1[i] = NEGF; }
    const int ktmax = (t0 + 3) >> 5, tlo = t0 + h, thi = t0 + 2 + h;
    const unsigned lb = (unsigned)(size_t)lds;
    const int sw = (r >> 1) & 7;
#define IDX_LDS4(R0, R1, R2, R3) asm volatile("ds_read_b128 %0, %4\n\tds_read_b128 %1, %5\n\tds_read_b128 %2, %6\n\tds_read_b128 %3, %7" \
                                             : "=&v"(R0), "=&v"(R1), "=&v"(R2), "=&v"(R3) : "v"(a0), "v"(a1), "v"(a2), "v"(a3) : "memory")
#define IDX_TILE(KTL, KEY0, SA, SB, C0, C1, C2, C3, N0, N1, N2, N3) \
        { \
            a0 += 4096u; a1 += 4096u; a2 += 4096u; a3 += 4096u; \
            IDX_LDS4(N0, N1, N2, N3);                          \
            asm volatile("s_waitcnt lgkmcnt(4)" : "+v"(C0), "+v"(C1), "+v"(C2), "+v"(C3) :: "memory");     \
            f32x16 acc; \
            _Pragma("unroll") for (int i = 0; i < 16; ++i) acc[i] = 0.f; \
            acc = __builtin_amdgcn_mfma_f32_32x32x16_f16(__builtin_bit_cast(h16x8, aq[0]), __builtin_bit_cast(h16x8, C0), acc, 0, 0, 0); acc = __builtin_amdgcn_mfma_f32_32x32x16_f16(__builtin_bit_cast(h16x8, aq[1]), __builtin_bit_cast(h16x8, C1), acc, 0, 0, 0); \
            acc = __builtin_amdgcn_mfma_f32_32x32x16_f16(__builtin_bit_cast(h16x8, aq[2]), __builtin_bit_cast(h16x8, C2), acc, 0, 0, 0); acc = __builtin_amdgcn_mfma_f32_32x32x16_f16(__builtin_bit_cast(h16x8, aq[3]), __builtin_bit_cast(h16x8, C3), acc, 0, 0, 0); \
            f32x2 p0 = (f32x2){0.f, 0.f}, p1 = (f32x2){0.f, 0.f};            \
            _Pragma("unroll") for (int i = 0; i < 4; ++i) { \
                const f32x2 r0 = (f32x2){__builtin_amdgcn_fmed3f(acc[2 * i], 0.f, 3.0e38f), __builtin_amdgcn_fmed3f(acc[2 * i + 1], 0.f, 3.0e38f)}; \
                const f32x2 r1 = (f32x2){__builtin_amdgcn_fmed3f(acc[8 + 2 * i], 0.f, 3.0e38f), __builtin_amdgcn_fmed3f(acc[9 + 2 * i], 0.f, 3.0e38f)}; \
                p0 = __builtin_elementwise_fma((f32x2){wlo[2 * i], wlo[2 * i + 1]}, r0, p0); p1 = __builtin_elementwise_fma((f32x2){whi[2 * i], whi[2 * i + 1]}, r1, p1); } \
            const float s0 = p0.x + p0.y, s1 = p1.x + p1.y; \
            const int key = (KEY0) + r; \
            SA[KTL] = key <= tlo ? s0 : NEGF; SB[KTL] = key <= thi ? s1 : NEGF; \
        }
    bf16x8 ta0, ta1, ta2, ta3, tb0, tb1, tb2, tb3;
#pragma unroll
    for (int rnd = 0; rnd < 2; ++rnd) {
        if (rnd >= nrounds) break;
        __syncthreads();
        {
            const int rl = lane >> 3, pp = lane & 7;
#pragma unroll 4
            for (int j = 0; j < 16; ++j) { const int pi = wave * 16 + j, row = 8 * pi + rl;
                const bf16_t* src = KIN + (rowb + 1024 * rnd + row) * 64 + 8 * (pp ^ ((row >> 1) & 7));
                __builtin_amdgcn_global_load_lds((const unsigned*)src, (LAS unsigned*)(lds + 1024 * pi), 16, 0, 0); }
        }
        asm volatile("s_waitcnt vmcnt(0)" ::: "memory");
        __syncthreads();
        const int ntl = ktmax - 32 * rnd + 1;
        if (active && ntl > 0) {
            const int npair = ((ntl < 32 ? ntl : 32) + 1) >> 1;
            unsigned a0 = lb + (unsigned)r * 128u + 16u * (unsigned)((0 + h) ^ sw), a1 = lb + (unsigned)r * 128u + 16u * (unsigned)((2 + h) ^ sw);
            unsigned a2 = lb + (unsigned)r * 128u + 16u * (unsigned)((4 + h) ^ sw), a3 = lb + (unsigned)r * 128u + 16u * (unsigned)((6 + h) ^ sw);
            IDX_LDS4(ta0, ta1, ta2, ta3);
#pragma nounroll
            for (int kp = 0; kp < npair; ++kp) {
                if (rnd == 0) { IDX_TILE(2 * kp, 64 * kp, sA0, sB0, ta0, ta1, ta2, ta3, tb0, tb1, tb2, tb3)
                                IDX_TILE(2 * kp + 1, 64 * kp + 32, sA0, sB0, tb0, tb1, tb2, tb3, ta0, ta1, ta2, ta3) }
                else          { IDX_TILE(2 * kp, 1024 + 64 * kp, sA1, sB1, ta0, ta1, ta2, ta3, tb0, tb1, tb2, tb3)
                                IDX_TILE(2 * kp + 1, 1024 + 64 * kp + 32, sA1, sB1, tb0, tb1, tb2, tb3, ta0, ta1, ta2, ta3) }
            }
            asm volatile("s_waitcnt lgkmcnt(0)" : "+v"(ta0), "+v"(ta1), "+v"(ta2), "+v"(ta3), "+v"(tb0), "+v"(tb1), "+v"(tb2), "+v"(tb3) :: "memory");
        }
    }
#undef IDX_TILE
#undef IDX_LDS4
    if (!active) return;
    const int nt0 = ktmax < 31 ? ktmax + 1 : 32, nt1 = ktmax - 31;
    float mxA = NEGF, mxB = NEGF, mnA = -NEGF, mnB = -NEGF;
#pragma nounroll
    for (int kt = 0; kt < nt0; ++kt) { const float a = sA0[kt], bb = sB0[kt];
        mxA = fmaxf(mxA, a); mxB = fmaxf(mxB, bb); mnA = fminf(mnA, a > -1e29f ? a : -NEGF); mnB = fminf(mnB, bb > -1e29f ? bb : -NEGF); }
#pragma nounroll
    for (int kt = 0; kt < nt1; ++kt) { const float a = sA1[kt], bb = sB1[kt];
        mxA = fmaxf(mxA, a); mxB = fmaxf(mxB, bb); mnA = fminf(mnA, a > -1e29f ? a : -NEGF); mnB = fminf(mnB, bb > -1e29f ? bb : -NEGF); }
    mxA = half_max(mxA); mxB = half_max(mxB); mnA = -half_max(-mnA); mnB = -half_max(-mnB);
    const int Ka = tlo + 1 < TOPK ? tlo + 1 : TOPK, Kb = thi + 1 < TOPK ? thi + 1 : TOPK;
    float loA = mnA - (fabsf(mnA) * 1e-6f + 1e-30f), hiA = mxA, loB = mnB - (fabsf(mnB) * 1e-6f + 1e-30f), hiB = mxB;
    float cloA = (float)(tlo + 1), chiA = 0.0f, cloB = (float)(thi + 1), chiB = 0.0f;
    float TA = -1e29f, TB = -1e29f; bool doneA = (tlo + 1 <= TOPK), doneB = (thi + 1 <= TOPK);
    const int nblk = (ktmax >> 3) + 1;
    const float BIG = 1099511627776.0f;
#define SA2(i) ((i) < 32 ? (f32x2){sA0[(i) & 31], sA0[((i) & 31) + 1]} : (f32x2){sA1[(i) & 31], sA1[((i) & 31) + 1]})
#define SB2(i) ((i) < 32 ? (f32x2){sB0[(i) & 31], sB0[((i) & 31) + 1]} : (f32x2){sB1[(i) & 31], sB1[((i) & 31) + 1]})
#pragma nounroll
    for (int it = 0; it < 48; ++it) {
        if (__ballot(!doneA || !doneB) == 0ull) break;
        const bool bis = (it % 3) == 2;
        const float wA = hiA - loA, wB = hiB - loB;
        float rA = bis ? 0.5f : (cloA - (float)Ka + 0.5f) / (cloA - chiA), rB = bis ? 0.5f : (cloB - (float)Kb + 0.5f) / (cloB - chiB);
        rA = fminf(fmaxf(rA, 0.03f), 0.97f); rB = fminf(fmaxf(rB, 0.03f), 0.97f);
        const float midA = loA + wA * rA, midB = loB + wB * rB;
        const float fA = doneA ? TA : midA, fB = doneB ? TB : midB;
        const f32x2 bigp = (f32x2){BIG, BIG}, nfA = (f32x2){-fA * BIG, -fA * BIG}, nfB = (f32x2){-fB * BIG, -fB * BIG};
        f32x2 cA2 = (f32x2){0.f, 0.f}, cB2 = (f32x2){0.f, 0.f};
#pragma unroll
        for (int blk = 0; blk < 8; ++blk) {
            if (blk < nblk) {
#pragma unroll
                for (int e = 0; e < 4; ++e) { cA2 += pk_gt(SA2(8 * blk + 2 * e), bigp, nfA); cB2 += pk_gt(SB2(8 * blk + 2 * e), bigp, nfB); }
            }
        }
        const int cA = (int)half_sum_f(cA2.x + cA2.y), cB = (int)half_sum_f(cB2.x + cB2.y);
        const bool stuckA = !(midA > loA && midA < hiA), stuckB = !(midB > loB && midB < hiB);
        if (!doneA) { if (cA == Ka) { TA = fA; doneA = true; } else if (stuckA) { TA = loA; doneA = true; } else if (cA > Ka) { loA = midA; cloA = (float)cA; } else { hiA = midA; chiA = (float)cA; } }
        if (!doneB) { if (cB == Kb) { TB = fB; doneB = true; } else if (stuckB) { TB = loB; doneB = true; } else if (cB > Kb) { loB = midB; cloB = (float)cB; } else { hiB = midB; chiB = (float)cB; } }
    }
#undef SA2
#undef SB2
    if (!doneA) TA = loA;
    if (!doneB) TB = loB;
    unsigned w0 = 0u, w1 = 0u, w2 = 0u, w3 = 0u;
#pragma nounroll
    for (int kt = 0; kt < nt0; ++kt) { const unsigned long long ma = __ballot(sA0[kt] > TA), mb = __ballot(sB0[kt] > TB);
        if (lane == kt) { w0 = (unsigned)ma; w1 = (unsigned)(ma >> 32); w2 = (unsigned)mb; w3 = (unsigned)(mb >> 32); } }
#pragma nounroll
    for (int kt = 0; kt < nt1; ++kt) { const unsigned long long ma = __ballot(sA1[kt] > TA), mb = __ballot(sB1[kt] > TB);
        if (lane == 32 + kt) { w0 = (unsigned)ma; w1 = (unsigned)(ma >> 32); w2 = (unsigned)mb; w3 = (unsigned)(mb >> 32); } }
    SEL[(rowb + t0 + 0) * 64 + lane] = w0; SEL[(rowb + t0 + 1) * 64 + lane] = w1; SEL[(rowb + t0 + 2) * 64 + lane] = w2; SEL[(rowb + t0 + 3) * 64 + lane] = w3;
}

#define ATT_F(r) (((r) & 3) | ((((r) >> 3) & 3) << 2))
#define TRB8(OFS, r0, r1, r2, r3, r4, r5, r6, r7, a0, a1, a2, a3, a4, a5, a6, a7) \
    asm volatile("ds_read_b64_tr_b16 %0, %8 offset:" OFS "\n\tds_read_b64_tr_b16 %1, %9 offset:" OFS "\n\tds_read_b64_tr_b16 %2, %10 offset:" OFS "\n\tds_read_b64_tr_b16 %3, %11 offset:" OFS "\n\t" \
                 "ds_read_b64_tr_b16 %4, %12 offset:" OFS "\n\tds_read_b64_tr_b16 %5, %13 offset:" OFS "\n\tds_read_b64_tr_b16 %6, %14 offset:" OFS "\n\tds_read_b64_tr_b16 %7, %15 offset:" OFS "\n\ts_waitcnt lgkmcnt(0)" \
                 : "=&v"(r0), "=&v"(r1), "=&v"(r2), "=&v"(r3), "=&v"(r4), "=&v"(r5), "=&v"(r6), "=&v"(r7) \
                 : "v"(a0), "v"(a1), "v"(a2), "v"(a3), "v"(a4), "v"(a5), "v"(a6), "v"(a7) : "memory")
#define RDK8(OFS, r, a) \
    asm volatile("ds_read_b64 %0, %8 offset:" OFS "\n\tds_read_b64 %1, %9 offset:" OFS "\n\tds_read_b64 %2, %10 offset:" OFS "\n\tds_read_b64 %3, %11 offset:" OFS "\n\t" \
                 "ds_read_b64 %4, %12 offset:" OFS "\n\tds_read_b64 %5, %13 offset:" OFS "\n\tds_read_b64 %6, %14 offset:" OFS "\n\tds_read_b64 %7, %15 offset:" OFS "\n\ts_waitcnt lgkmcnt(0)" \
                 : "=&v"(r[0]), "=&v"(r[1]), "=&v"(r[2]), "=&v"(r[3]), "=&v"(r[4]), "=&v"(r[5]), "=&v"(r[6]), "=&v"(r[7]) \
                 : "v"(a[0]), "v"(a[1]), "v"(a[2]), "v"(a[3]), "v"(a[4]), "v"(a[5]), "v"(a[6]), "v"(a[7]) : "memory")
__device__ __forceinline__ float rows_max(float x) {
    unsigned u = __float_as_uint(x);
    u32x2 r = __builtin_amdgcn_permlane16_swap(u, u, false, false);
    u = __float_as_uint(fmaxf(__uint_as_float(r.x), __uint_as_float(r.y)));
    r = __builtin_amdgcn_permlane32_swap(u, u, false, false);
    return fmaxf(__uint_as_float(r.x), __uint_as_float(r.y));
}
__device__ __forceinline__ float rows_sum(float x) {
    unsigned u = __float_as_uint(x);
    u32x2 r = __builtin_amdgcn_permlane16_swap(u, u, false, false);
    u = __float_as_uint(__uint_as_float(r.x) + __uint_as_float(r.y));
    r = __builtin_amdgcn_permlane32_swap(u, u, false, false);
    return __uint_as_float(r.x) + __uint_as_float(r.y);
}

__device__ __forceinline__ int att_build_list(LAS unsigned* list, const LAS unsigned* btab, unsigned w, int t, int lane) {
    const int pc = __popc(w); int incl = pc;
#pragma unroll
    for (int o = 1; o < 64; o <<= 1) { const int v = __builtin_amdgcn_ds_bpermute(((lane - o) & 63) << 2, incl); if (lane >= o) incl += v; }
    const int total = __builtin_amdgcn_readlane(incl, 63); const int cnt = total < TOPK ? total : TOPK;
    int off = incl - pc;
    while (w) { const int bit = __builtin_ctz(w); w &= w - 1u;
        if (off < TOPK) { const int idx = 32 * lane + bit; int dd = t - idx; dd = dd < 0 ? 0 : (dd > 128 ? 128 : dd); list[off] = (unsigned)idx | (btab[dd] << 16); }
        ++off; }
    for (int sl = cnt + lane; sl < ((cnt + 31) & ~31); sl += 64) list[sl] = 0u;
    return cnt;
}
__device__ __forceinline__ void att_gather32(const unsigned char* CKV8b, const LAS unsigned* list32, LAS unsigned char* slot, int lane) {
    const LAS unsigned* lp = list32 + (lane >> 4);
    unsigned idx[8];
#pragma unroll
    for (int i = 0; i < 8; ++i) idx[i] = lp[4 * i] & 0xffffu;
#pragma unroll
    for (int i = 0; i < 8; ++i) {
        const int rr = 4 * i + (lane >> 4);
        const unsigned char* src = CKV8b + (size_t)idx[i] * RK + 16 * ((lane & 15) ^ ATT_F(rr));
        __builtin_amdgcn_global_load_lds((const unsigned*)src, (LAS unsigned*)(slot + 1024 * i), 16, 0, 0);
    }
}

#define ATT_T(q) (((q) & 2047) ^ (((q) >> 11) ? 255 : 0))
__device__ __forceinline__ void att_wave(const unsigned char* CKV8, const unsigned* SEL, unsigned char* BIG, LAS unsigned char* kvbuf, LAS unsigned* lists, const LAS float* relb, const LAS unsigned* btab,
                                         int xcd, int wx, int nwx, int lane) {
    asm volatile("" : "+v"(lane));
    const int hq = lane & 15, g = lane >> 4;
    const int nq = (2 * SEQ - wx + nwx - 1) / nwx;
    if (nq <= 0) return;
    const unsigned kvb = (unsigned)(size_t)kvbuf;
    unsigned qa[8];
#pragma unroll
    for (int ks = 0; ks < 8; ++ks) qa[ks] = kvb + (unsigned)(8 * (hq >> 2) + (hq & 3)) * 256u + 16u * (unsigned)((2 * ks + (g >> 1)) ^ ATT_F(8 * (hq >> 2) + (hq & 3))) + 8u * (unsigned)(g & 1);
    const int trow = 8 * g + (hq >> 1);
    unsigned ta[16];
#pragma unroll
    for (int nt = 0; nt < 16; ++nt) ta[nt] = kvb + (unsigned)trow * 256u + 16u * (unsigned)(nt ^ ATT_F(trow)) + 8u * (unsigned)(hq & 1);

    int q = wx, b = 2 * xcd + (q >> 11), t = ATT_T(q);
    size_t row = (size_t)b * SEQ + t;
    unsigned wsel = SEL[row * 64 + lane];
    int cnt = att_build_list(lists, btab, wsel, t, lane);
    unsigned wnext = 0u;
    if (nq > 1) { const int q1 = wx + nwx; wnext = SEL[((size_t)(2 * xcd + (q1 >> 11)) * SEQ + ATT_T(q1)) * 64 + lane]; }
    long bq[8];
    { const unsigned char* qp = BIG + row * 8192 + hq * 256 + 8 * g;
#pragma unroll
      for (int ks = 0; ks < 8; ++ks) bq[ks] = *(const long*)(qp + 32 * ks); }
    int par = 0;
    asm volatile("s_waitcnt lgkmcnt(0)" ::: "memory");
    att_gather32(CKV8 + (size_t)b * SEQ * RK, lists, kvbuf, lane);
    for (int k = 0; k < nq; ++k) {
        const int cur = k & 1;
        LAS unsigned* list = lists + cur * 256;
        const bool has_next = (k + 1 < nq);
        const int qn = q + nwx, bn = 2 * xcd + (qn >> 11), tn = ATT_T(qn);
        const size_t rown = (size_t)bn * SEQ + tn;
        int cntn = 0;
        if (has_next) { cntn = att_build_list(lists + (cur ^ 1) * 256, btab, wnext, tn, lane);
            if (k + 2 < nq) { const int q2 = qn + nwx; wnext = SEL[((size_t)(2 * xcd + (q2 >> 11)) * SEQ + ATT_T(q2)) * 64 + lane]; } }
        f32x4 O[16];
#pragma unroll
        for (int nt = 0; nt < 16; ++nt) O[nt] = (f32x4){0.f, 0.f, 0.f, 0.f};
        float mref = NEGF, lsum = 0.f;
        const int nsub = (cnt + 31) >> 5;
        for (int sc = 0; sc < nsub; ++sc) {
            const bool lastc = (sc + 1 == nsub);
            float bias[8];
#pragma unroll
            for (int T = 0; T < 2; ++T) { const u32x4 mt = *(const LAS u32x4*)(list + 32 * sc + 8 * g + 4 * T);
#pragma unroll
                for (int i = 0; i < 4; ++i) bias[4 * T + i] = relb[(mt[i] >> 16) * 16 + hq]; }
            if (!lastc) { att_gather32(CKV8 + (size_t)b * SEQ * RK, list + 32 * (sc + 1), kvbuf + (par ^ 1) * 8192, lane); asm volatile("s_waitcnt vmcnt(8)" ::: "memory"); }
            else if (has_next) { att_gather32(CKV8 + (size_t)bn * SEQ * RK, lists + (cur ^ 1) * 256, kvbuf + (par ^ 1) * 8192, lane); asm volatile("s_waitcnt vmcnt(8)" ::: "memory"); }
            else { asm volatile("s_waitcnt vmcnt(0)" ::: "memory"); }
            f32x4 st0 = (f32x4){0.f, 0.f, 0.f, 0.f}, st1 = st0;
            { long kr[8];
              RDK8("0", kr, qa);
#pragma unroll
              for (int ks = 0; ks < 8; ++ks) st0 = __builtin_amdgcn_mfma_f32_16x16x32_fp8_fp8(kr[ks], bq[ks], st0, 0, 0, 0);
              RDK8("1024", kr, qa);
#pragma unroll
              for (int ks = 0; ks < 8; ++ks) st1 = __builtin_amdgcn_mfma_f32_16x16x32_fp8_fp8(kr[ks], bq[ks], st1, 0, 0, 0); }
            if (lastc && has_next) { const unsigned char* qp = BIG + rown * 8192 + hq * 256 + 8 * g;
#pragma unroll
                for (int ks = 0; ks < 8; ++ks) bq[ks] = *(const long*)(qp + 32 * ks); }
            float lg[8]; float cmax;
#pragma unroll
            for (int i = 0; i < 4; ++i) { lg[i] = st0[i] * (1.0f / 64.0f) + bias[i]; lg[4 + i] = st1[i] * (1.0f / 64.0f) + bias[4 + i]; }
            if (32 * sc + 32 > cnt) {
#pragma unroll
                for (int i = 0; i < 4; ++i) { const int s0 = 32 * sc + 8 * g + i; lg[i] = (s0 < cnt) ? lg[i] : NEGF; lg[4 + i] = (s0 + 4 < cnt) ? lg[4 + i] : NEGF; } }
            cmax = fmaxf(fmaxf(fmaxf(lg[0], lg[1]), fmaxf(lg[2], lg[3])), fmaxf(fmaxf(lg[4], lg[5]), fmaxf(lg[6], lg[7])));
            cmax = rows_max(cmax);
            if (__ballot(cmax > mref + 3.0f) != 0ull) {
                const float mnew = fmaxf(mref, cmax), scl = fast_exp(mref - mnew);
                lsum *= scl;
#pragma unroll
                for (int nt = 0; nt < 16; ++nt) O[nt] = O[nt] * scl;
                mref = mnew;
            }
            float p[8];
#pragma unroll
            for (int i = 0; i < 8; ++i) { p[i] = fast_exp(lg[i] - mref); lsum += p[i]; }
            int pw0 = 0, pw1 = 0;
            pw0 = __builtin_amdgcn_cvt_pk_fp8_f32(p[0] * 16.0f, p[1] * 16.0f, pw0, false); pw0 = __builtin_amdgcn_cvt_pk_fp8_f32(p[2] * 16.0f, p[3] * 16.0f, pw0, true);
            pw1 = __builtin_amdgcn_cvt_pk_fp8_f32(p[4] * 16.0f, p[5] * 16.0f, pw1, false); pw1 = __builtin_amdgcn_cvt_pk_fp8_f32(p[6] * 16.0f, p[7] * 16.0f, pw1, true);
            const long pk = (long)(((unsigned long long)(unsigned)pw1 << 32) | (unsigned long long)(unsigned)pw0);
            {
#define TR8B(r, a, o) asm volatile("ds_read_b64_tr_b8 %0, %8\n\tds_read_b64_tr_b8 %1, %9\n\tds_read_b64_tr_b8 %2, %10\n\tds_read_b64_tr_b8 %3, %11\n\t" \
                                   "ds_read_b64_tr_b8 %4, %12\n\tds_read_b64_tr_b8 %5, %13\n\tds_read_b64_tr_b8 %6, %14\n\tds_read_b64_tr_b8 %7, %15\n\ts_waitcnt lgkmcnt(0)" \
                                   : "=&v"(r[0]), "=&v"(r[1]), "=&v"(r[2]), "=&v"(r[3]), "=&v"(r[4]), "=&v"(r[5]), "=&v"(r[6]), "=&v"(r[7]) \
                                   : "v"(a[o + 0]), "v"(a[o + 1]), "v"(a[o + 2]), "v"(a[o + 3]), "v"(a[o + 4]), "v"(a[o + 5]), "v"(a[o + 6]), "v"(a[o + 7]) : "memory")
                long kt[8];
                TR8B(kt, ta, 0);
#pragma unroll
                for (int e = 0; e < 8; ++e) O[e] = __builtin_amdgcn_mfma_f32_16x16x32_fp8_fp8(kt[e], pk, O[e], 0, 0, 0);
                TR8B(kt, ta, 8);
#pragma unroll
                for (int e = 0; e < 8; ++e) O[8 + e] = __builtin_amdgcn_mfma_f32_16x16x32_fp8_fp8(kt[e], pk, O[8 + e], 0, 0, 0);
#undef TR8B
            }
            par ^= 1;
#pragma unroll
            for (int e = 0; e < 8; ++e) { qa[e] ^= 8192u; ta[e] ^= 8192u; ta[8 + e] ^= 8192u; }
        }
        lsum = rows_sum(lsum);
        const float inv = 1.0f / (16.0f * lsum);
        bf16_t* op = (bf16_t*)(BIG + row * 8192) + hq * 256 + 4 * g;
#pragma unroll
        for (int nt = 0; nt < 16; ++nt) { const f32x4 o = O[nt] * inv; u32x2 wv; wv.x = cvt_pk_bf16(o[0], o[1]); wv.y = cvt_pk_bf16(o[2], o[3]); *(u32x2*)(op + 16 * nt) = wv; }
        q = qn; b = bn; t = tn; row = rown; cnt = cntn;
    }
}

constexpr int SW_KP = 144, SW_VP = 520;
constexpr int SW_K_OFF = 0, SW_V_OFF = 256 * SW_KP, SW_TB_OFF = SW_V_OFF + 64 * SW_VP;
__device__ __forceinline__ void swa_phase(const bf16_t* QKV, bf16_t* OB, const float* relb, const float* sinks, LAS unsigned char* lds, int G) {
    int tid = tid_now();
    const int lane = tid & 63, wave = __builtin_amdgcn_readfirstlane(tid >> 6);
    const int h = lane >> 5, n = lane & 31;
    LAS float* tb = (LAS float*)(lds + SW_TB_OFF);
    for (int u = blockIdx.x; u < BATCH * 16 * KVH; u += G) {
        const int b = u >> 5, nb = (u >> 1) & 15, kvh = u & 1;
        const size_t rowb = (size_t)b * SEQ;
        __syncthreads();
#pragma unroll
        for (int e = 0; e < 4; ++e) { const int id = tid + NTHR * e, j = id >> 3, ch = id & 7; const int pos = (nb - 1) * WIN + j;
            u32x4 kv = (u32x4){0u, 0u, 0u, 0u}, vv = (u32x4){0u, 0u, 0u, 0u};
            if (pos >= 0) { const bf16_t* sp = QKV + (rowb + pos) * B_IN + 1024 + kvh * 64 + ch * 8; kv = *(const u32x4*)sp; vv = *(const u32x4*)(sp + 128); }
            *(LAS u32x4*)(lds + SW_K_OFF + j * SW_KP + ch * 16) = kv;
            LAS bf16_t* vt = (LAS bf16_t*)(lds + SW_V_OFF + (ch * 8) * SW_VP + j * 2);
#pragma unroll
            for (int q = 0; q < 4; ++q) { vt[(2 * q) * (SW_VP / 2)] = (bf16_t)(vv[q] & 0xffffu); vt[(2 * q + 1) * (SW_VP / 2)] = (bf16_t)(vv[q] >> 16); } }
        for (int i = tid; i < GQ * WIN; i += NTHR) { const int gg = i >> 7, dist = i & 127; tb[i] = relb[t5_bucket(dist) * NH + kvh * GQ + gg]; }
        __syncthreads();
        const int qh = kvh * GQ + wave; const float sink = sinks[qh];
        for (int rt = 0; rt < 4; ++rt) {
            const size_t qrow = rowb + nb * WIN + 32 * rt + n;
            bf16x8 bq[4];
#pragma unroll
            for (int ks = 0; ks < 4; ++ks) bq[ks] = *(const bf16x8*)(QKV + qrow * B_IN + qh * 64 + 16 * ks + 8 * h);
            f32x16 s[5];
#pragma unroll
            for (int ct = 0; ct < 5; ++ct) {
#pragma unroll
                for (int i = 0; i < 16; ++i) s[ct][i] = 0.f;
#pragma unroll
                for (int ks = 0; ks < 4; ++ks) { const bf16x8 a = *(const LAS bf16x8*)(lds + SW_K_OFF + (32 * (rt + ct) + n) * SW_KP + (2 * ks + h) * 16);
                    s[ct] = __builtin_amdgcn_mfma_f32_32x32x16_bf16(a, bq[ks], s[ct], 0, 0, 0); } }
            const int qi = 32 * rt + n;
            float mx = NEGF;
#pragma unroll
            for (int ct = 0; ct < 5; ++ct)
#pragma unroll
                for (int i = 0; i < 16; ++i) { const int j = 32 * (rt + ct) + (i & 3) + 8 * (i >> 2) + 4 * h; const int dist = qi + WIN - j;
                    const bool ok = (dist >= 0) && (dist < WIN) && (nb > 0 || j >= WIN);
                    const float v = ok ? s[ct][i] * 0.125f + tb[wave * WIN + (dist & 127)] : NEGF; s[ct][i] = v; mx = fmaxf(mx, v); }
            { const u32x2 r_ = __builtin_amdgcn_permlane32_swap(__float_as_uint(mx), __float_as_uint(mx), false, false); mx = fmaxf(__uint_as_float(r_.x), __uint_as_float(r_.y)); } mx = fmaxf(mx, sink);
            float sum = 0.f;
#pragma unroll
            for (int ct = 0; ct < 5; ++ct)
#pragma unroll
                for (int i = 0; i < 16; ++i) { const float p = fast_exp(s[ct][i] - mx); s[ct][i] = p; sum += p; }
            { const u32x2 r_ = __builtin_amdgcn_permlane32_swap(__float_as_uint(sum), __float_as_uint(sum), false, false); sum = __uint_as_float(r_.x) + __uint_as_float(r_.y); } sum += fast_exp(sink - mx);
            f32x16 o[2];
#pragma unroll
            for (int dt = 0; dt < 2; ++dt)
#pragma unroll
                for (int i = 0; i < 16; ++i) o[dt][i] = 0.f;
#pragma unroll
            for (int ct = 0; ct < 5; ++ct)
#pragma unroll
                for (int s2 = 0; s2 < 2; ++s2) {
                    u32x4 pw; pw.x = cvt_pk_bf16(s[ct][8 * s2 + 0], s[ct][8 * s2 + 1]); pw.y = cvt_pk_bf16(s[ct][8 * s2 + 2], s[ct][8 * s2 + 3]);
                    pw.z = cvt_pk_bf16(s[ct][8 * s2 + 4], s[ct][8 * s2 + 5]); pw.w = cvt_pk_bf16(s[ct][8 * s2 + 6], s[ct][8 * s2 + 7]);
                    const bf16x8 pb = __builtin_bit_cast(bf16x8, pw);
#pragma unroll
                    for (int dt = 0; dt < 2; ++dt) { const LAS unsigned char* vp = lds + SW_V_OFF + (32 * dt + n) * SW_VP + (32 * (rt + ct) + 16 * s2 + 4 * h) * 2;
                        const u32x2 v0 = *(const LAS u32x2*)vp, v1 = *(const LAS u32x2*)(vp + 16);
                        u32x4 va; va.x = v0.x; va.y = v0.y; va.z = v1.x; va.w = v1.y;
                        o[dt] = __builtin_amdgcn_mfma_f32_32x32x16_bf16(__builtin_bit_cast(bf16x8, va), pb, o[dt], 0, 0, 0); }
                }
            const float inv = 16.0f / sum;
            unsigned char* op = (unsigned char*)OB + qrow * D + qh * 64 + 4 * h;
#pragma unroll
            for (int dt = 0; dt < 2; ++dt)
#pragma unroll
                for (int i4 = 0; i4 < 4; ++i4) { int wv = 0;
                    wv = __builtin_amdgcn_cvt_pk_fp8_f32(__builtin_amdgcn_fmed3f(o[dt][4 * i4] * inv, -448.f, 448.f), __builtin_amdgcn_fmed3f(o[dt][4 * i4 + 1] * inv, -448.f, 448.f), wv, false);
                    wv = __builtin_amdgcn_cvt_pk_fp8_f32(__builtin_amdgcn_fmed3f(o[dt][4 * i4 + 2] * inv, -448.f, 448.f), __builtin_amdgcn_fmed3f(o[dt][4 * i4 + 3] * inv, -448.f, 448.f), wv, true);
                    *(unsigned*)(op + 32 * dt + 8 * i4) = (unsigned)wv; }
        }
    }
}

struct Args { const float* in[23]; float* out; unsigned char* ws; };
#define CAS __attribute__((address_space(4)))
__device__ __forceinline__ const CAS Args* kargs() { const CAS Args* p = (const CAS Args*)__builtin_amdgcn_kernarg_segment_ptr(); asm volatile("" : "+s"(p)); return p; }

__global__ void __launch_bounds__(NTHR, 2) trunk_fwd(Args args_by_value) {
    LAS unsigned char* lds = (LAS unsigned char*)lds_raw;
    const int tid = threadIdx.x;
    volatile LAS unsigned* MISC = (volatile LAS unsigned*)(lds + LDS_MISC_OFF);
    for (int u = tid; u < (LDS_BYTES - LDS_MISC_OFF) / 4; u += NTHR) MISC[u] = 0u;
    __syncthreads();
    if ((tid & 63) == 0) MISC[64 + hw_slot()] = (unsigned)(tid >> 6);
    { const CAS Args* A = kargs(); (void)xcd_barrier_post((unsigned*)(A->ws + WS_CTL) + 4096, MISC + 8);
      if (tid == 0) { const unsigned x = xb_xcc_id(); MISC[16] = x; MISC[17] = xb_add((unsigned*)(A->ws + WS_CTL) + 8192 + 64 * x, 1u); } }
#define XCD_RANK(xcd, rank) do { const CAS Args* A_ = kargs(); const unsigned* cw_ = (const unsigned*)(A_->ws + WS_CTL) + 4096; bool ok_ = (gridDim.x & 7) == 0; \
        for (int j_ = 0; j_ < 16; ++j_) { const unsigned c_ = __hip_atomic_load(cw_ + XB_XCNT(j_), __ATOMIC_RELAXED, __HIP_MEMORY_SCOPE_AGENT); ok_ = ok_ && (c_ == (j_ < 8 ? gridDim.x >> 3 : 0u)); } \
        const unsigned hx_ = MISC[16], hr_ = MISC[17]; ok_ = ok_ && hx_ < 8u && hr_ < (gridDim.x >> 3); \
        xcd = ok_ ? (int)hx_ : (int)(blockIdx.x & 7); rank = ok_ ? (int)hr_ : (int)(blockIdx.x >> 3); } while (0)
#define GB() do { const CAS Args* A_ = kargs(); XcdBarrier b_; b_.bar = (unsigned*)(A_->ws + WS_CTL) + 4096; b_.x = xb_xcc_id(); b_.st = MISC + 8; xcd_barrier(b_); } while (0)

    { const CAS Args* A = kargs(); Ptrs P;
#pragma unroll
      for (int i = 0; i < 23; ++i) P.in[i] = A->in[i];
      P.out = A->out; P.ws = A->ws;
      p0_prologue(P, lds, (int)gridDim.x); }
    GB();
    { const CAS Args* A = kargs(); Ptrs P;
#pragma unroll
      for (int i = 0; i < 23; ++i) P.in[i] = A->in[i];
      P.out = A->out; P.ws = A->ws;
      pre_phase(P, lds, (int)gridDim.x); }
    GB();

    for (int l = 0; l < DEPTH; ++l) {
        const bool isA = (l & 1) == 0;
        {
            const CAS Args* A = kargs(); const int G = gridDim.x, j = l >> 1; unsigned char* ws = A->ws;
            const unsigned long long* SS = (const unsigned long long*)(ws + WS_SS) + (size_t)(2 * l) * M;
            if (isA) {
                unsigned char* wa = ws + WS_WA + (size_t)j * WA_STRIDE;
                pg8::Gemm g{(const bf16_t*)(ws + WS_XG), (const bf16_t*)(wa + WINA_OFF), D, D, D, 0, 0}; pg8::StaticOrder S; S.init(M, 2048, G, (int)blockIdx.x);
                pg8::EpiInA E{(bf16_t*)(ws + WS_QO), (bf16_t*)(ws + WS_CKV), (bf16_t*)(ws + WS_QI), (bf16_t*)(ws + WS_KIN), (float*)(ws + WS_WI), A->in[I_AIKG] + j * IDIM, A->in[I_AIKB] + j * IDIM,
                                (const float*)(ws + WS_SHW + SHW_A) + (size_t)j * BATCH * 2048, SS};
                pg8::gemm_phase<pg8::EpiInA, true, 3>(lds, g, S, E);
            } else {
                unsigned char* wb = ws + WS_WB + (size_t)j * WB_STRIDE;
                pg8::Gemm g{(const bf16_t*)(ws + WS_XG), (const bf16_t*)(wb + WINB_OFF), D, D, D, 0, 0}; pg8::StaticOrder S; S.init(M, B_IN, G, (int)blockIdx.x);
                pg8::EpiBf16Plain<true> E{(bf16_t*)(ws + WS_QKV), B_IN, (const float*)(ws + WS_SHW + SHW_B) + (size_t)j * BATCH * B_IN, B_IN, SS};
                pg8::gemm_phase<pg8::EpiBf16Plain<true>, true, 3>(lds, g, S, E);
            }
        }
        GB();
        if (isA) {
            { const CAS Args* A = kargs(); const int G = gridDim.x, j = l >> 1; unsigned char* ws = A->ws;
              unsigned char* wa = ws + WS_WA + (size_t)j * WA_STRIDE;
              pg8::Gemm g{(const bf16_t*)(ws + WS_QO), (const bf16_t*)(wa + WQA_OFF), D, 256, 256, 2, 256}; pg8::StaticOrder S; S.init(M, 4096, G, (int)blockIdx.x);
              pg8::EpiFp8 E{ws + WS_BIG, 8192};
              pg8::gemm_phase<pg8::EpiFp8, true>(lds, g, S, E); }
            { const CAS Args* A = kargs(); const int G = gridDim.x; unsigned char* ws = A->ws;
              const int tid2 = tid_now();
              const int lane = tid2 & 63, wave = __builtin_amdgcn_readfirstlane(tid2 >> 6);
              const bf16_t* CKV = (const bf16_t*)(ws + WS_CKV); unsigned* CKV8 = (unsigned*)(ws + WS_CKV8);
              const int gw = blockIdx.x * NWAVES + wave, NGW = G * NWAVES;
              for (int row = gw; row < M; row += NGW) {
                  const u32x2 v = *((const u32x2*)(CKV + (size_t)row * RK) + lane);
                  const float a0 = __uint_as_float(v.x << 16), a1 = __uint_as_float(v.x & 0xffff0000u), a2 = __uint_as_float(v.y << 16), a3 = __uint_as_float(v.y & 0xffff0000u);
                  const float ss = wave_sum((a0 * a0 + a1 * a1) + (a2 * a2 + a3 * a3));
                  const float rs = 1.0f / sqrtf(ss * (1.0f / RK) + EPS);
                  int w = 0; w = __builtin_amdgcn_cvt_pk_fp8_f32(a0 * rs, a1 * rs, w, false); w = __builtin_amdgcn_cvt_pk_fp8_f32(a2 * rs, a3 * rs, w, true);
                  CKV8[(size_t)row * (RK / 4) + lane] = (unsigned)w;
              } }
            { const CAS Args* A = kargs(); const int G = gridDim.x; unsigned char* ws = A->ws;
              const int tid2 = tid_now();
              const int lane = tid2 & 63, wave = __builtin_amdgcn_readfirstlane(tid2 >> 6);
              int xcd, rank; XCD_RANK(xcd, rank); xcd = __builtin_amdgcn_readfirstlane(xcd); rank = __builtin_amdgcn_readfirstlane(rank);
              const int wx = rank * NWAVES + wave, nwx = (G >> 3) * NWAVES;
              const int nsteps = (1024 + nwx - 1) / nwx;
              for (int st = 0; st < nsteps; ++st) {
                  const int q = wx + st * nwx; const bool active = q < 1024;
                  const int qc = active ? q : (rank * NWAVES + st * nwx < 1024 ? rank * NWAVES + st * nwx : 1023);
                  const int bl = qc >> 9, u = qc & 255, hiq = (qc >> 8) & 1, b = 2 * xcd + bl;
                  const int tg = hiq ? 511 - u : u;
                  idx_task((const bf16_t*)(ws + WS_QI), (const bf16_t*)(ws + WS_KIN), (const float*)(ws + WS_WI), (unsigned*)(ws + WS_SEL), lds, b, tg, lane, wave, active, hiq ? 2 : 1);
              }
              __syncthreads(); }
        } else {
            const CAS Args* A = kargs(); const int G = gridDim.x, j = l >> 1; unsigned char* ws = A->ws;
            swa_phase((const bf16_t*)(ws + WS_QKV), (bf16_t*)(ws + WS_OB), A->in[I_RELB], A->in[I_BSINK] + j * NH, lds, G);
        }
        GB();
        if (isA) {
            { const CAS Args* A = kargs(); const int G = gridDim.x; unsigned char* ws = A->ws;
              const int tid2 = tid_now();
              const int lane = tid2 & 63, wave = __builtin_amdgcn_readfirstlane(tid2 >> 6);
              LAS float* relb = (LAS float*)(lds + 147456);
              LAS unsigned* btab = (LAS unsigned*)(lds + 147456 + 2048);
              for (int i = tid2; i < NBUCK * NH; i += NTHR) relb[i] = A->in[I_RELB][i];
              for (int i = tid2; i < 132; i += NTHR) btab[i] = (unsigned)t5_bucket(i);
              __syncthreads();
              int xcd, rank; XCD_RANK(xcd, rank); xcd = __builtin_amdgcn_readfirstlane(xcd); rank = __builtin_amdgcn_readfirstlane(rank);
              const int wx = rank * NWAVES + wave, nwx = (G >> 3) * NWAVES;
              att_wave(ws + WS_CKV8, (const unsigned*)(ws + WS_SEL), ws + WS_BIG, lds + wave * 16384, (LAS unsigned*)(lds + 131072 + wave * 2048), relb, btab, xcd, wx, nwx, lane); }
            GB();
            { const CAS Args* A = kargs(); const int G = gridDim.x, j = l >> 1; unsigned char* ws = A->ws;
              unsigned char* wa = ws + WS_WA + (size_t)j * WA_STRIDE;
              pg8::Gemm g{(const bf16_t*)(ws + WS_BIG), (const bf16_t*)(wa + WUV_OFF), 4096, D, D, 0, 1024}; pg8::StaticOrder S; S.init(M, D, G, (int)blockIdx.x);
              pg8::EpiFp8 E{ws + WS_OB, D};
              pg8::gemm_phase<pg8::EpiFp8, true>(lds, g, S, E); }
            GB();
        }
        {
            const CAS Args* A = kargs(); const int G = gridDim.x, j = l >> 1; unsigned char* ws = A->ws;
            const float* modl = (const float*)(ws + WS_MOD) + (size_t)l * BATCH * 6144;
            const bf16_t* Ain = (const bf16_t*)(ws + WS_OB);
            const bf16_t* Bw = (const bf16_t*)(isA ? ws + WS_WA + (size_t)j * WA_STRIDE + WOUTA_OFF : ws + WS_WB + (size_t)j * WB_STRIDE + WOUTB_OFF);
            w8_build((const bf16_t*)(ws + WS_W + (size_t)l * W_LAYER + W13_OFF), A->in[I_GFFN] + l * D, modl + 4096, ws + WS_W8, (float*)(ws + WS_CW), lds, G);
            pg8::Gemm g{Ain, Bw, D / 2, D / 2, D / 2, 0, 0, 0}; pg8::StaticOrder S; S.init(M, D, G, (int)blockIdx.x);
            pg8::EpiResid<true> E{(const bf16_t*)A->out, (bf16_t*)A->out, modl + 2048, isA ? nullptr : A->in[I_BBOUT] + j * D,
                            (bf16_t*)(ws + WS_XG), nullptr, nullptr, (unsigned long long*)(ws + WS_SS) + (size_t)(2 * l + 1) * M, (const unsigned long long*)(ws + WS_SS) + (size_t)(2 * l) * M};
            pg8::gemm_phase<pg8::EpiResid<true>, true, 2>(lds, g, S, E);
        }
        GB();
        {
            const CAS Args* A = kargs(); const int G = gridDim.x; unsigned char* ws = A->ws;
            unsigned char* wl = ws + WS_W + (size_t)l * W_LAYER;
            pg8::Gemm g{(const bf16_t*)(ws + WS_XG), (const bf16_t*)(ws + WS_W8), D / 2, D / 2, D / 2, 0, 0, (unsigned)W8_BATCH}; pg8::StaticOrder S; S.init(M, 2 * DFF, G, (int)blockIdx.x);
            pg8::EpiSwiGLU E{(bf16_t*)(ws + WS_HFF), (const float*)(ws + WS_SHW + SHW_F) + (size_t)l * BATCH * 2 * DFF, (const unsigned long long*)(ws + WS_SS) + (size_t)(2 * l + 1) * M,
                             (const float*)(ws + WS_CW), (const unsigned long long*)(ws + WS_SS) + (size_t)(2 * l) * M};
            pg8::gemm_phase<pg8::EpiSwiGLU, true, 1>(lds, g, S, E);
        }
        GB();
        {
            const CAS Args* A = kargs(); const int G = gridDim.x; unsigned char* ws = A->ws;
            unsigned char* wl = ws + WS_W + (size_t)l * W_LAYER;
            const float* modl = (const float*)(ws + WS_MOD) + (size_t)l * BATCH * 6144;
            const int ln = l + 1 < DEPTH ? l + 1 : l;
            pg8::Gemm g{(const bf16_t*)(ws + WS_HFF), (const bf16_t*)(wl + W2_OFF), DFF, DFF, DFF, 0, 0}; pg8::StaticOrder S; S.init(M, D, G, (int)blockIdx.x);
            const bool lastl = (l + 1 == DEPTH);
            pg8::EpiResid<false> E{(const bf16_t*)A->out, lastl ? (bf16_t*)(ws + WS_XG) : (bf16_t*)A->out, modl + 5120, nullptr,
                            l + 1 < DEPTH ? (bf16_t*)(ws + WS_XG) : nullptr, A->in[I_GMIX] + ln * D, (const float*)(ws + WS_MOD) + (size_t)ln * BATCH * 6144 + 1024, (unsigned long long*)(ws + WS_SS) + (size_t)(2 * l + 2) * M, nullptr};
            pg8::gemm_phase<pg8::EpiResid<false>, true>(lds, g, S, E);
        }
        GB();
    }
    { const CAS Args* A = kargs(); final_norm_phase((const bf16_t*)(A->ws + WS_XG), A->out, A->in[I_GFIN], (int)gridDim.x); }
#undef GB
}

extern "C" void kernel_launch(void* const* d_in, const int* in_sizes, int n_in, void* d_out, int out_size, void* d_ws, size_t ws_size, hipStream_t stream) {
    static int grid = 0;
    if (grid == 0) {
        if (n_in != 23 || out_size != M * D || ws_size < WS_END) { fprintf(stderr, "kernel_launch: unexpected shapes (n_in %d out %d ws %zu)\n", n_in, out_size, ws_size); grid = -1; return; }
        int dev = 0, cus = 0, per_cu = 0;
        if (hipGetDevice(&dev) != hipSuccess || hipDeviceGetAttribute(&cus, hipDeviceAttributeMultiprocessorCount, dev) != hipSuccess) { grid = -1; return; }
        if (hipFuncSetAttribute((const void*)trunk_fwd, hipFuncAttributeMaxDynamicSharedMemorySize, LDS_BYTES) != hipSuccess) { fprintf(stderr, "kernel_launch: hipFuncSetAttribute failed\n"); grid = -1; return; }
        if (hipOccupancyMaxActiveBlocksPerMultiprocessor(&per_cu, (const void*)trunk_fwd, NTHR, LDS_BYTES) != hipSuccess || per_cu < 1) { fprintf(stderr, "kernel_launch: occupancy query says %d\n", per_cu); }
        (void)hipGetLastError();
        grid = cus;
    }
    if (grid < 0) return;
    (void)hipMemsetAsync((char*)d_ws + WS_CTL, 0, CTL_ZERO_BYTES, stream);
    Args a{};
    for (int i = 0; i < 23; ++i) a.in[i] = (const float*)d_in[i];
    a.out = (float*)d_out; a.ws = (unsigned char*)d_ws;
    hipLaunchKernelGGL(trunk_fwd, dim3(grid), dim3(NTHR), LDS_BYTES, stream, a);
    const hipError_t le = hipPeekAtLastError();
    if (le != hipSuccess) fprintf(stderr, "kernel_launch: launch failed: %s\n", hipGetErrorName(le));
}
```

```cpp
#include <hip/hip_runtime.h>
#include <cstdio>
#include <cstdint>


#define GAS __attribute__((address_space(1)))
#define LAS __attribute__((address_space(3)))
typedef unsigned short bf16_t;
typedef short bf16x8 __attribute__((ext_vector_type(8)));
typedef short s16x4 __attribute__((ext_vector_type(4)));
typedef float f32x4 __attribute__((ext_vector_type(4)));
typedef float f32x2 __attribute__((ext_vector_type(2)));
typedef float f32x16 __attribute__((ext_vector_type(16)));
typedef unsigned u32x4 __attribute__((ext_vector_type(4)));
typedef unsigned u32x2 __attribute__((ext_vector_type(2)));
typedef int i32x4 __attribute__((ext_vector_type(4)));
typedef int i32x8 __attribute__((ext_vector_type(8)));

constexpr int D = 1024, BATCH = 16, SEQ = 2048, M = BATCH * SEQ, DEPTH = 4;
constexpr int NH = 16, HD = 64, RK = 256, IH = 8, IDIM = 64, TOPK = 256;
constexpr int KVH = 2, GQ = 8, WIN = 128, NBUCK = 32, DFF = 2816;
constexpr int A_IN = 1864, B_IN = 1280;
constexpr float EPS = 1e-6f;
constexpr float NEGF = -1e30f;
constexpr int NWAVES = 8, NTHR = 512;

constexpr size_t MiB = 1u << 20;
constexpr size_t WS_CTL = 0, CTL_ZERO_BYTES = 4 * MiB;
constexpr size_t WS_SS = 1 * MiB;
constexpr size_t WS_W = 4 * MiB;
constexpr size_t W_LAYER = 17301504;
constexpr size_t W13_OFF = 0, W2_OFF = 11 * MiB;
constexpr size_t WS_WA = WS_W + 4 * W_LAYER;
constexpr size_t WA_STRIDE = 10 * MiB, WINA_OFF = 0, WQA_OFF = 4 * MiB, WUV_OFF = 6 * MiB, WOUTA_OFF = 8 * MiB;
constexpr size_t WS_WB = WS_WA + 2 * WA_STRIDE;
constexpr size_t WB_STRIDE = 4718592, WINB_OFF = 0, WOUTB_OFF = 2621440;
constexpr size_t WS_MOD = 100 * MiB;
constexpr size_t WS_SHW = WS_MOD + 1536 * 1024;
constexpr size_t SHW_A = 0, SHW_B = 2 * 16 * 2048 * 4, SHW_F = SHW_B + 2 * 16 * 1280 * 4;
constexpr size_t WS_XG = 104 * MiB;
constexpr size_t WS_BIG = 104 * MiB;
constexpr size_t WS_HFF = 168 * MiB;
constexpr size_t WS_QO = 360 * MiB;
constexpr size_t WS_CKV = 424 * MiB;
constexpr size_t WS_QI = 440 * MiB;
constexpr size_t WS_KIN = 472 * MiB;
constexpr size_t WS_WI = 476 * MiB;
constexpr size_t WS_SEL = 477 * MiB;
constexpr size_t WS_CKV8 = 486 * MiB;
constexpr size_t WS_QKV = 360 * MiB;
constexpr size_t WS_OB = 440 * MiB;
constexpr size_t WS_W8 = 344 * MiB;
constexpr size_t W8_BATCH = (size_t)2 * 2816 * 1024;
constexpr size_t WS_CW = 504 * MiB;
constexpr size_t WS_END = 512 * MiB;

constexpr int RING_BYTES = 131072;
constexpr int LDS_MISC_OFF = 155648;
constexpr int LDS_BYTES = 156672;

extern __shared__ __attribute__((aligned(16))) unsigned char lds_raw[];
constexpr int LDS_WAVE_TAB = LDS_MISC_OFF + 256;
__device__ __forceinline__ int lane_now() { int l; asm volatile("v_mbcnt_lo_u32_b32 %0, -1, 0\n\tv_mbcnt_hi_u32_b32 %0, -1, %0" : "=v"(l)); return l; }
__device__ __forceinline__ unsigned hw_slot() { return (unsigned)__builtin_amdgcn_s_getreg((5 << 11) | 4) & 63u; }
__device__ __forceinline__ int wave_now() { return __builtin_amdgcn_readfirstlane((int)*(volatile LAS unsigned*)((LAS unsigned char*)lds_raw + LDS_WAVE_TAB + 4 * hw_slot())); }
__device__ __forceinline__ int tid_now() { return wave_now() * 64 + lane_now(); }
#define RLX_AGENT __ATOMIC_RELAXED, __HIP_MEMORY_SCOPE_AGENT
__device__ __forceinline__ unsigned cvt_pk_bf16(float lo, float hi) { unsigned r; asm volatile("v_cvt_pk_bf16_f32 %0, %1, %2" : "=v"(r) : "v"(lo), "v"(hi)); return r; }
typedef _Float16 h16x2 __attribute__((ext_vector_type(2)));
typedef _Float16 h16x8 __attribute__((ext_vector_type(8)));
__device__ __forceinline__ unsigned cvt_pk_f16(float lo, float hi) { return __builtin_bit_cast(unsigned, __builtin_convertvector((f32x2){lo, hi}, h16x2)); }
__device__ __forceinline__ f32x2 unpk_f16(unsigned u) { return __builtin_convertvector(__builtin_bit_cast(h16x2, u), f32x2); }
__device__ __forceinline__ float bf2f(bf16_t b) { return __uint_as_float(((unsigned)b) << 16); }
__device__ __forceinline__ float half_sum_f(float v);
__device__ __forceinline__ float rows_sum(float x);
__device__ __forceinline__ float wave_sum(float v) {
    v = half_sum_f(v);
    const u32x2 r = __builtin_amdgcn_permlane32_swap(__float_as_uint(v), __float_as_uint(v), false, false);
    return __uint_as_float(r.x) + __uint_as_float(r.y);
}
__device__ __forceinline__ float fast_exp(float x) { return __builtin_amdgcn_exp2f(x * 1.4426950408889634f); }
__device__ __forceinline__ float silu_f(float x) { return x * __builtin_amdgcn_rcpf(1.0f + fast_exp(-x)); }
__device__ __forceinline__ int t5_bucket(int d) {
    if (d < 16) return d;
    int b = 16;
    b += (d >= 19); b += (d >= 21); b += (d >= 24); b += (d >= 27); b += (d >= 31); b += (d >= 35); b += (d >= 40); b += (d >= 46);
    b += (d >= 52); b += (d >= 59); b += (d >= 67); b += (d >= 77); b += (d >= 87); b += (d >= 99); b += (d >= 113);
    return b;
}

#define XB_TMO      128
#define XB_XCNT(j)  (256  + 64 * (j))
#define XB_XSUB(j)  (1280 + 64 * (j))
#define XB_XGEN(j)  (2304 + 64 * (j))
#define XB_TOP      3328
#define XB_TOPGEN   3392
#define XCD_BAR_WORDS 3456
#define XB_SPIN_CAP (1u << 22)

__device__ __forceinline__ unsigned xb_ld(unsigned* p)              { return __hip_atomic_load(p, __ATOMIC_RELAXED, __HIP_MEMORY_SCOPE_AGENT); }
__device__ __forceinline__ unsigned xb_add(unsigned* p, unsigned v) { return __hip_atomic_fetch_add(p, v, __ATOMIC_RELAXED, __HIP_MEMORY_SCOPE_AGENT); }
__device__ __forceinline__ unsigned xb_xcc_id() { return (unsigned)__builtin_amdgcn_s_getreg((3 << 11) | 20) & 0xFu; }
#define XB_SPIN(cond, bar) do { unsigned _sp = 0; while (cond) { __builtin_amdgcn_s_sleep(1); \
    if ((++_sp & 255u) == 0u) { if (xb_ld(&(bar)[XB_TMO])) break; if (_sp > XB_SPIN_CAP) { atomicAdd(&(bar)[XB_TMO], 1u); break; } } } } while (0)

struct XcdBarrier { unsigned* bar; unsigned x; volatile LAS unsigned* st; };

__device__ __forceinline__ XcdBarrier xcd_barrier_post(unsigned* bar, volatile LAS unsigned* st) {
    XcdBarrier b; b.bar = bar; b.x = xb_xcc_id(); b.st = st;
    if (threadIdx.x == 0) (void)xb_add(&bar[XB_XCNT(b.x)], 1u);
    return b;
}
__device__ __forceinline__ void xcd_barrier_complete(unsigned* bar, unsigned x, unsigned& nloc, unsigned& nx) {
    const unsigned G = gridDim.x * gridDim.y * gridDim.z;
    unsigned sum, cnt, mine, sp = 0u;
    for (;;) {
        sum = 0u; cnt = 0u; mine = 0u;
#pragma unroll
        for (unsigned j = 0; j < 16; ++j) { const unsigned c = xb_ld(&bar[XB_XCNT(j)]); sum += c; cnt += (c > 0u) ? 1u : 0u; mine = (j == x) ? c : mine; }
        if (sum == G) break;
        __builtin_amdgcn_s_sleep(1);
        if ((++sp & 255u) == 0u) { if (xb_ld(&bar[XB_TMO])) break; if (sp > XB_SPIN_CAP) { atomicAdd(&bar[XB_TMO], 1u); break; } }
    }
    nloc = mine > 0u ? mine : 1u; nx = cnt > 0u ? cnt : 1u;
}
__device__ __forceinline__ void xcd_barrier(const XcdBarrier& b) {
    asm volatile("s_waitcnt vmcnt(0)" ::: "memory");
    __syncthreads();
    if (tid_now() == 0) {
        unsigned* bar = b.bar;
        __builtin_amdgcn_s_waitcnt(0);
        unsigned nloc = b.st[0], nx = b.st[1];
        if (nloc == 0u) { xcd_barrier_complete(bar, b.x, nloc, nx); b.st[0] = nloc; b.st[1] = nx; }
        const unsigned old = xb_add(&bar[XB_XSUB(b.x)], 1u);
        const unsigned gen = old / nloc;
        if (old + 1u == (gen + 1u) * nloc) {
            __builtin_amdgcn_fence(__ATOMIC_RELEASE, "agent");
            asm volatile("s_waitcnt vmcnt(0)" ::: "memory");
            const unsigned og = xb_add(&bar[XB_TOP], 1u);
            const unsigned tg = og / nx;
            if (og + 1u == (tg + 1u) * nx) xb_add(&bar[XB_TOPGEN], 1u);
            else XB_SPIN(xb_ld(&bar[XB_TOPGEN]) == tg, bar);
            __builtin_amdgcn_fence(__ATOMIC_ACQUIRE, "agent");
            xb_add(&bar[XB_XGEN(b.x)], 1u);
            asm volatile("s_waitcnt vmcnt(0)" ::: "memory");
        } else {
            XB_SPIN(xb_ld(&bar[XB_XGEN(b.x)]) == gen, bar);
            __builtin_amdgcn_fence(__ATOMIC_ACQUIRE, "agent");
            asm volatile("s_waitcnt vmcnt(0)" ::: "memory");
        }
    }
    __syncthreads();
}

namespace pg8 {
constexpr int BM = 256, BK = 64, HALF = 128, HTB = HALF * BK * 2, STAGE_BYTES = 8 * HTB, NXCD = 8, WGM = 8;
__host__ __device__ __forceinline__ int lds_byte(int r, int c) { const int st = (r >> 4) * 2 + (c >> 5), rr = r & 15, cc = c & 31, ob = rr * 64 + cc * 2; return st * 1024 + (ob ^ (((ob >> 9) & 1) << 5)); }
__host__ __device__ __forceinline__ void stage_rc(int b, int& R, int& C) { const int st = b / 1024, sb = b % 1024, swz = sb ^ (((sb >> 9) & 1) << 5); R = (st >> 1) * 16 + swz / 64; C = (st & 1) * 32 + (swz % 64) / 2; }
__host__ __device__ __forceinline__ int perm32(int rho) { const int n = rho >> 4, i = rho & 15; return 8 * (i >> 2) + 4 * n + (i & 3); }

struct Unit { int pm, pn; };
struct Gemm { const bf16_t* A; const bf16_t* Bt; int lda, ldb, K, a_shift, a_mul; unsigned bb; };

struct StaticOrder {
    int nM, nN, nwg, G, c;
    __device__ void init(int M_, int N_, int G_, int c_) { nM = M_ / BM; nN = N_ / BM; nwg = nM * nN; G = G_; c = c_; }
    __device__ bool next(int i, Unit& u) const {
        const long L = (long)i * G + c; if (L >= nwg) return false;
        int wgid = (int)L; { const int q = nwg / NXCD, r = nwg % NXCD, xcd = wgid % NXCD, off = wgid / NXCD; wgid = (xcd < r ? xcd * (q + 1) : r * (q + 1) + (xcd - r) * q) + off; }
        const int nig = WGM * nN, gid = wgid / nig, fm = gid * WGM, gsz = (nM - fm) < WGM ? (nM - fm) : WGM;
        u.pm = fm + ((wgid % nig) % gsz); u.pn = (wgid % nig) / gsz; return true;
    }
};

template <class Epi, bool ALIGN_EPI, int MODE = 0>
__device__ __forceinline__ void gemm_phase(LAS unsigned char* lds, const Gemm g, const StaticOrder& S, const Epi& E) {
    int tid = tid_now();
    const int wid = __builtin_amdgcn_readfirstlane(tid >> 6), lane = tid & 63, wr = wid >> 2, wc = wid & 3, fr = lane & 15, fq = lane >> 4;
    const int K = g.K, nt = K / BK;
    unsigned voffA[2], voffB[2];
#pragma unroll
    for (int i = 0; i < 2; ++i) { int R, C; stage_rc(tid * 16 + i * 8192, R, C); const int Rb = Epi::PERM ? ((R & ~31) + perm32(R & 31)) : R;
        voffA[i] = (unsigned)(R * g.lda + C) * 2u; voffB[i] = (unsigned)(Rb * g.ldb + C) * 2u; }
    const size_t kstep = (size_t)(BK * 2);
    const size_t hstepA = (size_t)HALF * g.lda * 2, hstepB = (size_t)HALF * g.ldb * 2;
    const unsigned ldsw = (unsigned)wid * 1024u;
    const int aoff = lds_byte(wr * 64 + fr, fq * 8), boff = lds_byte(wc * 32 + fr, fq * 8);
#define PG8_SA(b, h) (((b) * 2 + (h)) * HTB)
#define PG8_SB(b, h) ((4 + (b) * 2 + (h)) * HTB)
#define PG8_STAGE(bufoff, gbase, voff) do { const char* _gb = (const char*)(gbase); if constexpr (MODE == 2) asm volatile("" : "+s"(_gb));     \
        _Pragma("unroll") for (int _i = 0; _i < 2; ++_i) \
        __builtin_amdgcn_global_load_lds((const unsigned*)(_gb + (voff)[_i]), (LAS unsigned*)(lds + (bufoff) + ldsw + _i * 8192), 16, 0, 0); } while (0)
#define PG8_LDA(dst, b, h) do { _Pragma("unroll") for (int m = 0; m < 4; ++m) _Pragma("unroll") for (int k = 0; k < 2; ++k) dst[m][k] = *(const LAS bf16x8*)(lds + PG8_SA(b, h) + aoff + m * 2048 + k * 1024); } while (0)
#define PG8_LDB(dst, b, h) do { _Pragma("unroll") for (int n = 0; n < 2; ++n) _Pragma("unroll") for (int k = 0; k < 2; ++k) dst[n][k] = *(const LAS bf16x8*)(lds + PG8_SB(b, h) + boff + n * 2048 + k * 1024); } while (0)
#define PG8_CAT(x0, x1) __builtin_shufflevector(__builtin_bit_cast(i32x4, x0), __builtin_bit_cast(i32x4, x1), 0, 1, 2, 3, 4, 5, 6, 7)
#define PG8_MMA(ai, bj, At, Bt) do { __builtin_amdgcn_s_setprio(1); _Pragma("unroll") for (int m = 0; m < 4; ++m) _Pragma("unroll") for (int n = 0; n < 2; ++n) { \
        if constexpr (MODE == 2) acc[ai][bj][m][n] = __builtin_amdgcn_mfma_scale_f32_16x16x128_f8f6f4(PG8_CAT(Bt[n][0], Bt[n][1]), PG8_CAT(At[m][0], At[m][1]), acc[ai][bj][m][n], 0, 0, 0, 0, 0, 0); \
        else { _Pragma("unroll") for (int k = 0; k < 2; ++k) { \
          if constexpr (MODE == 1) acc[ai][bj][m][n] = __builtin_bit_cast(f32x4, __builtin_amdgcn_mfma_i32_16x16x64_i8(__builtin_bit_cast(i32x4, Bt[n][k]), __builtin_bit_cast(i32x4, At[m][k]), __builtin_bit_cast(i32x4, acc[ai][bj][m][n]), 0, 0, 0)); \
          else if constexpr (MODE == 3) acc[ai][bj][m][n] = __builtin_amdgcn_mfma_f32_16x16x32_f16(__builtin_bit_cast(h16x8, Bt[n][k]), __builtin_bit_cast(h16x8, At[m][k]), acc[ai][bj][m][n], 0, 0, 0); \
          else acc[ai][bj][m][n] = __builtin_amdgcn_mfma_f32_16x16x32_bf16(Bt[n][k], At[m][k], acc[ai][bj][m][n], 0, 0, 0); } } } __builtin_amdgcn_s_setprio(0); } while (0)
#define PG8_WAIT_V(n) asm volatile("s_waitcnt vmcnt(" #n ")" ::: "memory")
#define PG8_WAIT_L(n) asm volatile("s_waitcnt lgkmcnt(" #n ")" ::: "memory")
#define PG8_BAR __builtin_amdgcn_s_barrier()
#define PG8_SCHED __builtin_amdgcn_sched_barrier(0)
#define PG8_ABASE(u) ((const char*)g.A + ((size_t)(u).pm * BM * g.lda + (size_t)((u).pn >> g.a_shift) * g.a_mul) * 2)
#define PG8_BBASE(u) ((const char*)g.Bt + (size_t)(u).pn * BM * g.ldb * 2 + (size_t)((u).pm >> 3) * g.bb)
    Unit cur, nxt; int ui = 0;
    if (!S.next(0, cur)) return;
    f32x4 acc[2][2][4][2];
#pragma unroll
    for (int a = 0; a < 2; ++a)
#pragma unroll
        for (int b = 0; b < 2; ++b)
#pragma unroll
            for (int m = 0; m < 4; ++m)
#pragma unroll
                for (int n = 0; n < 2; ++n) acc[a][b][m][n] = (f32x4){0.f, 0.f, 0.f, 0.f};
    bf16x8 At[4][2], B0[2][2], B1[2][2];
    const char* cA = PG8_ABASE(cur); const char* cB = PG8_BBASE(cur);
    PG8_STAGE(PG8_SB(0, 0), cB, voffB); PG8_STAGE(PG8_SB(0, 1), cB + hstepB, voffB); PG8_STAGE(PG8_SA(0, 0), cA, voffA); PG8_STAGE(PG8_SA(0, 1), cA + hstepA, voffA);
    if (wr == 1) PG8_BAR;
    PG8_WAIT_V(2); PG8_BAR;
    PG8_STAGE(PG8_SB(1, 0), cB + kstep, voffB); PG8_STAGE(PG8_SA(1, 0), cA + kstep, voffA); PG8_STAGE(PG8_SB(1, 1), cB + hstepB + kstep, voffB);
    PG8_WAIT_V(6); PG8_BAR;
    for (;;) {
        const bool has_next = S.next(ui + 1, nxt);
        const char* nA = has_next ? PG8_ABASE(nxt) : cA; const char* nB = has_next ? PG8_BBASE(nxt) : cB;
        for (int t = 0; t < nt; t += 2) {
            const bool last = (t == nt - 2);
            if constexpr (Epi::PREFETCH) { if (last) E.prefetch(lds + STAGE_BYTES, cur, wid, lane_now()); }
            const char* a1 = cA + (size_t)(t + 1) * kstep;
            const char* a2 = last ? nA : cA + (size_t)(t + 2) * kstep; const char* b2 = last ? nB : cB + (size_t)(t + 2) * kstep;
            const char* a3 = a2 + kstep; const char* b3 = b2 + kstep;
            PG8_LDB(B0, 0, 0); PG8_LDB(B1, 0, 1); PG8_SCHED; PG8_LDA(At, 0, 0); PG8_STAGE(PG8_SA(1, 1), a1 + hstepA, voffA);
            PG8_WAIT_V(8); PG8_WAIT_L(0); PG8_BAR; PG8_MMA(0, 0, At, B0); PG8_MMA(0, 1, At, B1); PG8_BAR; PG8_SCHED;
            PG8_LDA(At, 0, 1); PG8_STAGE(PG8_SB(0, 0), b2, voffB); PG8_STAGE(PG8_SB(0, 1), b2 + hstepB, voffB); PG8_STAGE(PG8_SA(0, 0), a2, voffA);
            PG8_WAIT_V(8); PG8_WAIT_L(0); PG8_BAR; PG8_MMA(1, 0, At, B0); PG8_MMA(1, 1, At, B1); PG8_BAR; PG8_SCHED;
            PG8_LDB(B0, 1, 0); PG8_LDB(B1, 1, 1); PG8_SCHED; PG8_LDA(At, 1, 0); PG8_STAGE(PG8_SA(0, 1), a2 + hstepA, voffA);
            PG8_WAIT_V(8); PG8_WAIT_L(0); PG8_BAR; PG8_MMA(0, 0, At, B0); PG8_MMA(0, 1, At, B1); PG8_BAR; PG8_SCHED;
            PG8_LDA(At, 1, 1); PG8_STAGE(PG8_SB(1, 0), b3, voffB); PG8_STAGE(PG8_SB(1, 1), b3 + hstepB, voffB); PG8_STAGE(PG8_SA(1, 0), a3, voffA);
            PG8_WAIT_V(8); PG8_WAIT_L(0); PG8_BAR; PG8_MMA(1, 0, At, B0); PG8_MMA(1, 1, At, B1); PG8_BAR; PG8_SCHED;
        }
        if constexpr (ALIGN_EPI) { if (wr == 0) PG8_BAR; }
        { const int l2 = lane_now();
          if constexpr (Epi::PREFETCH) E(acc, cur, wr, wc, l2 & 15, l2 >> 4, lds + STAGE_BYTES); else E(acc, cur, wr, wc, l2 & 15, l2 >> 4); }
        if (!has_next) break;
#pragma unroll
        for (int a = 0; a < 2; ++a)
#pragma unroll
            for (int b = 0; b < 2; ++b)
#pragma unroll
                for (int m = 0; m < 4; ++m)
#pragma unroll
                    for (int n = 0; n < 2; ++n) acc[a][b][m][n] = (f32x4){0.f, 0.f, 0.f, 0.f};
        cur = nxt; cA = nA; cB = nB; ++ui;
        if constexpr (ALIGN_EPI) { if (wr == 1) PG8_BAR; }
    }
    PG8_WAIT_V(0);
    if constexpr (!ALIGN_EPI) { if (wr == 0) PG8_BAR; }
    PG8_BAR;
#undef PG8_SA
#undef PG8_SB
#undef PG8_STAGE
#undef PG8_LDA
#undef PG8_LDB
#undef PG8_MMA
#undef PG8_CAT
#undef PG8_WAIT_V
#undef PG8_WAIT_L
#undef PG8_BAR
#undef PG8_SCHED
#undef PG8_ABASE
#undef PG8_BBASE
}

template <bool NORM> struct EpiBf16Plain {
    static constexpr bool PERM = true, PREFETCH = NORM;
    bf16_t* O; int ldc; const float* shw; int shw_stride; const unsigned long long* SS;
    __device__ __forceinline__ void prefetch(LAS unsigned char* aux, const Unit& u, int wid, int lane) const {
        if (wid < 2) __builtin_amdgcn_global_load_lds((const unsigned*)((const char*)(SS + (size_t)u.pm * BM) + wid * 1024 + lane * 16), (LAS unsigned*)(aux + wid * 1024), 16, 0, 0);
        else if (wid == 2) __builtin_amdgcn_global_load_lds((const unsigned*)((const char*)(shw + (size_t)(u.pm >> 3) * shw_stride + u.pn * BM) + lane * 16), (LAS unsigned*)(aux + 2048), 16, 0, 0);
    }
    __device__ __forceinline__ void operator()(const f32x4 (&acc)[2][2][4][2], const Unit& u, int wr, int wc, int fr, int fq, const LAS unsigned char* aux = nullptr) const {
        const int row0 = u.pm * BM + wr * 64 + fr, col0 = u.pn * BM + wc * 32 + 8 * fq;
        f32x4 bv[2][2];
#pragma unroll
        for (int bj = 0; bj < 2; ++bj)
#pragma unroll
            for (int n = 0; n < 2; ++n) bv[bj][n] = NORM ? *(const LAS f32x4*)((const LAS float*)(aux + 2048) + wc * 32 + 8 * fq + bj * HALF + 4 * n) : (f32x4){0.f, 0.f, 0.f, 0.f};
        const LAS unsigned long long* ssl = (const LAS unsigned long long*)aux + wr * 64 + fr;
#pragma unroll
        for (int ai = 0; ai < 2; ++ai)
#pragma unroll
            for (int m = 0; m < 4; ++m) { const int row = row0 + ai * HALF + m * 16; bf16_t* rowp = O + (size_t)row * ldc + col0;
                float rs = 1.0f; if (NORM) rs = 1.0f / sqrtf((float)ssl[ai * HALF + m * 16] * (1.0f / (16777216.0f * D)) + EPS);
#pragma unroll
                for (int bj = 0; bj < 2; ++bj) { const f32x4 v0 = acc[ai][bj][m][0] * rs + bv[bj][0], v1 = acc[ai][bj][m][1] * rs + bv[bj][1];
                    u32x4 w; w.x = cvt_pk_bf16(v0[0], v0[1]); w.y = cvt_pk_bf16(v0[2], v0[3]); w.z = cvt_pk_bf16(v1[0], v1[1]); w.w = cvt_pk_bf16(v1[2], v1[3]);
                    *(u32x4*)(rowp + bj * HALF) = w; } }
    }
};
struct EpiFp8 {
    static constexpr bool PERM = true, PREFETCH = false;
    unsigned char* O; int ldc;
    __device__ __forceinline__ void operator()(const f32x4 (&acc)[2][2][4][2], const Unit& u, int wr, int wc, int fr, int fq) const {
        const int row0 = u.pm * BM + wr * 64 + fr, col0 = u.pn * BM + wc * 32 + 8 * fq;
#pragma unroll
        for (int ai = 0; ai < 2; ++ai)
#pragma unroll
            for (int m = 0; m < 4; ++m) { unsigned char* rowp = O + (size_t)(row0 + ai * HALF + m * 16) * ldc + col0;
#pragma unroll
                for (int bj = 0; bj < 2; ++bj) { const f32x4 v0 = acc[ai][bj][m][0], v1 = acc[ai][bj][m][1];
                    int w0 = 0, w1 = 0;
                    w0 = __builtin_amdgcn_cvt_pk_fp8_f32(v0[0], v0[1], w0, false); w0 = __builtin_amdgcn_cvt_pk_fp8_f32(v0[2], v0[3], w0, true);
                    w1 = __builtin_amdgcn_cvt_pk_fp8_f32(v1[0], v1[1], w1, false); w1 = __builtin_amdgcn_cvt_pk_fp8_f32(v1[2], v1[3], w1, true);
                    u32x2 w; w.x = (unsigned)w0; w.y = (unsigned)w1; *(u32x2*)(rowp + bj * HALF) = w; }
                asm volatile("" ::: "memory"); }
    }
};
struct EpiInA {
    static constexpr bool PERM = true, PREFETCH = true;
    bf16_t* Q; bf16_t* CKV; bf16_t* QI; bf16_t* KIN; float* WI; const float* kg; const float* kb; const float* shw; const unsigned long long* SS;
    __device__ __forceinline__ void prefetch(LAS unsigned char* aux, const Unit& u, int wid, int lane) const {
        if (wid < 2) __builtin_amdgcn_global_load_lds((const unsigned*)((const char*)(SS + (size_t)u.pm * BM) + wid * 1024 + lane * 16), (LAS unsigned*)(aux + wid * 1024), 16, 0, 0);
        else if (wid == 2) __builtin_amdgcn_global_load_lds((const unsigned*)((const char*)(shw + (size_t)(u.pm >> 3) * 2048 + u.pn * BM) + lane * 16), (LAS unsigned*)(aux + 2048), 16, 0, 0);
    }
    __device__ __forceinline__ void operator()(f32x4 (&acc)[2][2][4][2], const Unit& u, int wr, int wc, int fr, int fq, const LAS unsigned char* aux) const {
        const int row0 = u.pm * BM + wr * 64 + fr, cl = wc * 32 + 8 * fq;
        {
            const LAS float* sp = (const LAS float*)(aux + 2048) + cl;
            const LAS unsigned long long* ssl = (const LAS unsigned long long*)aux + wr * 64 + fr;
            f32x4 bv[2][2];
#pragma unroll
            for (int bj = 0; bj < 2; ++bj)
#pragma unroll
                for (int n = 0; n < 2; ++n) bv[bj][n] = *(const LAS f32x4*)(sp + bj * HALF + 4 * n);
#pragma unroll
            for (int ai = 0; ai < 2; ++ai)
#pragma unroll
                for (int m = 0; m < 4; ++m) { const float rs = 1.0f / sqrtf((float)ssl[ai * HALF + m * 16] * (1.0f / (16777216.0f * D)) + EPS);
#pragma unroll
                    for (int bj = 0; bj < 2; ++bj)
#pragma unroll
                        for (int n = 0; n < 2; ++n) acc[ai][bj][m][n] = acc[ai][bj][m][n] * rs + bv[bj][n]; }
        }
        if (u.pn < 7) {
            bf16_t* base; int ldc, c0;
            if (u.pn < 4) { base = Q; ldc = 1024; c0 = u.pn * 256; } else if (u.pn == 4) { base = CKV; ldc = 256; c0 = 0; } else { base = QI; ldc = 512; c0 = (u.pn - 5) * 256; }
#pragma unroll
            for (int ai = 0; ai < 2; ++ai)
#pragma unroll
                for (int m = 0; m < 4; ++m) { bf16_t* rowp = base + (size_t)(row0 + ai * HALF + m * 16) * ldc + c0 + cl;
#pragma unroll
                    for (int bj = 0; bj < 2; ++bj) { const f32x4 v0 = acc[ai][bj][m][0], v1 = acc[ai][bj][m][1];
                        u32x4 w;
                        if (u.pn >= 5) { w.x = cvt_pk_f16(v0[0], v0[1]); w.y = cvt_pk_f16(v0[2], v0[3]); w.z = cvt_pk_f16(v1[0], v1[1]); w.w = cvt_pk_f16(v1[2], v1[3]); }
                        else { w.x = cvt_pk_bf16(v0[0], v0[1]); w.y = cvt_pk_bf16(v0[2], v0[3]); w.z = cvt_pk_bf16(v1[0], v1[1]); w.w = cvt_pk_bf16(v1[2], v1[3]); }
                        *(u32x4*)(rowp + bj * HALF) = w; } }
        } else if (wc == 0) {
            f32x4 gv[2][2], bv[2][2];
#pragma unroll
            for (int bj = 0; bj < 2; ++bj)
#pragma unroll
                for (int n = 0; n < 2; ++n) { gv[bj][n] = *(const f32x4*)(kg + 32 * bj + 8 * fq + 4 * n); bv[bj][n] = *(const f32x4*)(kb + 32 * bj + 8 * fq + 4 * n); }
#pragma unroll
            for (int ai = 0; ai < 2; ++ai)
#pragma unroll
                for (int m = 0; m < 4; ++m) {
                    float s = 0.f;
#pragma unroll
                    for (int bj = 0; bj < 2; ++bj)
#pragma unroll
                        for (int n = 0; n < 2; ++n) { const f32x4 x = acc[ai][bj][m][n]; s += (x[0] + x[1]) + (x[2] + x[3]); }
                    s = rows_sum(s);
                    const float mu = s * (1.0f / 64.0f); float q = 0.f;
#pragma unroll
                    for (int bj = 0; bj < 2; ++bj)
#pragma unroll
                        for (int n = 0; n < 2; ++n) { const f32x4 d = acc[ai][bj][m][n] - mu; q += (d[0] * d[0] + d[1] * d[1]) + (d[2] * d[2] + d[3] * d[3]); }
                    q = rows_sum(q);
                    const float rs = 1.0f / sqrtf(q * (1.0f / 64.0f) + EPS);
                    bf16_t* rowp = KIN + (size_t)(row0 + ai * HALF + m * 16) * 64 + 8 * fq;
#pragma unroll
                    for (int bj = 0; bj < 2; ++bj) { const f32x4 v0 = (acc[ai][bj][m][0] - mu) * rs * gv[bj][0] + bv[bj][0], v1 = (acc[ai][bj][m][1] - mu) * rs * gv[bj][1] + bv[bj][1];
                        u32x4 w; w.x = cvt_pk_f16(v0[0], v0[1]); w.y = cvt_pk_f16(v0[2], v0[3]); w.z = cvt_pk_f16(v1[0], v1[1]); w.w = cvt_pk_f16(v1[2], v1[3]);
                        *(u32x4*)(rowp + bj * 32) = w; }
                }
        } else if (wc == 1 && fq == 0) {
            const float sc = 0.04419417382415922f;
#pragma unroll
            for (int ai = 0; ai < 2; ++ai)
#pragma unroll
                for (int m = 0; m < 4; ++m) { float* rowp = WI + (size_t)(row0 + ai * HALF + m * 16) * 8;
                    *(f32x4*)(rowp) = acc[ai][0][m][0] * sc; *(f32x4*)(rowp + 4) = acc[ai][0][m][1] * sc; }
        }
    }
};
constexpr float Q8_CLIP = 4.75f;
__device__ __forceinline__ unsigned q8_bits(float v) { return __float_as_uint(__builtin_amdgcn_fmed3f(v, -127.0f, 127.0f) + 12582912.0f); }
__device__ __forceinline__ unsigned q8_pack(unsigned a, unsigned b, unsigned c, unsigned d) { return __builtin_amdgcn_perm(b, a, 0x0c0c0400u) | __builtin_amdgcn_perm(d, c, 0x04000c0cu); }
template <bool Q8> struct EpiResid {
    static constexpr bool PERM = true, PREFETCH = true;
    const bf16_t* xin_b; bf16_t* xout_b;
    const float* gate; const float* bias;
    static constexpr float asc = Q8 ? 1.0f / 4096.0f : 1.0f;
    bf16_t* XG; const float* gn; const float* scn; unsigned long long* SSo; const unsigned long long* SSq;
    __device__ __forceinline__ void prefetch(LAS unsigned char* aux, const Unit& u, int wid, int lane) const {
        const int b = u.pm >> 3; const char* src = nullptr;
        if (wid == 0) src = (const char*)(gate + (size_t)b * 6144 + u.pn * BM);
        else if (wid == 1) src = bias ? (const char*)(bias + u.pn * BM) : nullptr;
        else if constexpr (Q8) { if (wid == 4 || wid == 5) src = (const char*)(SSq + (size_t)u.pm * BM) + (wid - 4) * 1024; }
        else { if (wid == 2) src = XG ? (const char*)(gn + u.pn * BM) : nullptr;
               else if (wid == 3) src = XG ? (const char*)(scn + (size_t)b * 6144 + u.pn * BM) : nullptr; }
        if (src) __builtin_amdgcn_global_load_lds((const unsigned*)(src + lane * 16), (LAS unsigned*)(aux + wid * 1024), 16, 0, 0);
    }
    __device__ __forceinline__ void operator()(const f32x4 (&acc)[2][2][4][2], const Unit& u, int wr, int wc, int fr, int fq, const LAS unsigned char* aux) const {
        const int row0 = u.pm * BM + wr * 64 + fr, col0 = u.pn * BM + wc * 32 + 8 * fq, b = u.pm >> 3;
        const LAS unsigned long long* sql = (const LAS unsigned long long*)(aux + 4096) + wr * 64 + fr;
        const LAS float* lv = (const LAS float*)aux + wc * 32 + 8 * fq;
        float ssum[2][4];
#pragma unroll
        for (int ai = 0; ai < 2; ++ai)
#pragma unroll
            for (int m = 0; m < 4; ++m) ssum[ai][m] = 0.f;
#pragma unroll
        for (int bj = 0; bj < 2; ++bj) {
            const int c = col0 + bj * HALF;
            const LAS float* lp = lv + bj * HALF;
            const f32x4 gv0 = *(const LAS f32x4*)(lp), gv1 = *(const LAS f32x4*)(lp + 4);
            f32x4 bv0 = (f32x4){0.f, 0.f, 0.f, 0.f}, bv1 = bv0, gm0 = bv0, gm1 = bv0;
            if (bias) { bv0 = *(const LAS f32x4*)(lp + 256); bv1 = *(const LAS f32x4*)(lp + 256 + 4); }
            if (!Q8 && XG) { gm0 = *(const LAS f32x4*)(lp + 512) * (*(const LAS f32x4*)(lp + 768) + 1.0f); gm1 = *(const LAS f32x4*)(lp + 512 + 4) * (*(const LAS f32x4*)(lp + 768 + 4) + 1.0f); }
#pragma unroll
            for (int ai = 0; ai < 2; ++ai)
#pragma unroll
                for (int m = 0; m < 4; ++m) { const size_t off = (size_t)(row0 + ai * HALF + m * 16) * D + c;
                    const u32x4 xv = *(const u32x4*)(xin_b + off);
                    const f32x2 xa = unpk_f16(xv.x), xb = unpk_f16(xv.y), xc = unpk_f16(xv.z), xd = unpk_f16(xv.w);
                    const f32x4 xi0 = (f32x4){xa.x, xa.y, xb.x, xb.y}, xi1 = (f32x4){xc.x, xc.y, xd.x, xd.y};
                    const f32x4 xo0 = xi0 + gv0 * (acc[ai][bj][m][0] * asc + bv0), xo1 = xi1 + gv1 * (acc[ai][bj][m][1] * asc + bv1);
                    { u32x4 w; w.x = cvt_pk_f16(xo0[0], xo0[1]); w.y = cvt_pk_f16(xo0[2], xo0[3]); w.z = cvt_pk_f16(xo1[0], xo1[1]); w.w = cvt_pk_f16(xo1[2], xo1[3]); *(u32x4*)(xout_b + off) = w; }
                    if (XG) {
                        ssum[ai][m] += ((xo0[0] * xo0[0] + xo0[1] * xo0[1]) + (xo0[2] * xo0[2] + xo0[3] * xo0[3])) + ((xo1[0] * xo1[0] + xo1[1] * xo1[1]) + (xo1[2] * xo1[2] + xo1[3] * xo1[3]));
                        if constexpr (Q8) {
                            const float qs = (127.0f / Q8_CLIP) / sqrtf((float)sql[ai * HALF + m * 16] * (1.0f / (16777216.0f * D)) + EPS);
                            u32x2 w; w.x = q8_pack(q8_bits(xo0[0] * qs), q8_bits(xo0[1] * qs), q8_bits(xo0[2] * qs), q8_bits(xo0[3] * qs));
                            w.y = q8_pack(q8_bits(xo1[0] * qs), q8_bits(xo1[1] * qs), q8_bits(xo1[2] * qs), q8_bits(xo1[3] * qs));
                            *(u32x2*)((unsigned char*)XG + off) = w;
                        } else {
                        const f32x4 y0 = xo0 * gm0, y1 = xo1 * gm1;
                        u32x4 w; w.x = cvt_pk_f16(y0[0], y0[1]); w.y = cvt_pk_f16(y0[2], y0[3]); w.z = cvt_pk_f16(y1[0], y1[1]); w.w = cvt_pk_f16(y1[2], y1[3]);
                        *(u32x4*)(XG + off) = w; } }
                    if (m & 1) asm volatile("" ::: "memory"); }
        }
        if (XG) {
#pragma unroll
            for (int ai = 0; ai < 2; ++ai)
#pragma unroll
                for (int m = 0; m < 4; ++m) { float q = ssum[ai][m]; q = rows_sum(q);
                    if (fq == 0) atomicAdd(SSo + row0 + ai * HALF + m * 16, (unsigned long long)(q * 16777216.0f)); }
        }
    }
};
struct EpiSwiGLU {
    static constexpr bool PERM = true, PREFETCH = true;
    bf16_t* H; const float* shw; const unsigned long long* SS; const float* CW; const unsigned long long* SSq;
    __device__ __forceinline__ void prefetch(LAS unsigned char* aux, const Unit& u, int wid, int lane) const {
        if (wid < 2) __builtin_amdgcn_global_load_lds((const unsigned*)((const char*)(SS + (size_t)u.pm * BM) + wid * 1024 + lane * 16), (LAS unsigned*)(aux + wid * 1024), 16, 0, 0);
        else if (wid == 2) __builtin_amdgcn_global_load_lds((const unsigned*)((const char*)(shw + (size_t)(u.pm >> 3) * (2 * DFF) + u.pn * BM) + lane * 16), (LAS unsigned*)(aux + 2048), 16, 0, 0);
        else if (wid == 3) __builtin_amdgcn_global_load_lds((const unsigned*)((const char*)(CW + (size_t)(u.pm >> 3) * (2 * DFF) + u.pn * BM) + lane * 16), (LAS unsigned*)(aux + 3072), 16, 0, 0);
        else if (wid < 6) __builtin_amdgcn_global_load_lds((const unsigned*)((const char*)(SSq + (size_t)u.pm * BM) + (wid - 4) * 1024 + lane * 16), (LAS unsigned*)(aux + wid * 1024), 16, 0, 0);
    }
    __device__ __forceinline__ void operator()(const f32x4 (&acc)[2][2][4][2], const Unit& u, int wr, int wc, int fr, int fq, const LAS unsigned char* aux) const {
        const int row0 = u.pm * BM + wr * 64 + fr, f0 = u.pn * 128 + wc * 32 + 8 * fq;
        f32x4 bv[2][2], cv[2][2];
        { const LAS float* sp = (const LAS float*)(aux + 2048) + wc * 32 + 8 * fq;
#pragma unroll
          for (int bj = 0; bj < 2; ++bj)
#pragma unroll
              for (int n = 0; n < 2; ++n) { bv[bj][n] = *(const LAS f32x4*)(sp + bj * HALF + 4 * n); cv[bj][n] = *(const LAS f32x4*)(sp + 256 + bj * HALF + 4 * n); } }
        const LAS unsigned long long* ssl = (const LAS unsigned long long*)aux + wr * 64 + fr;
        const LAS unsigned long long* sql = (const LAS unsigned long long*)(aux + 4096) + wr * 64 + fr;
#pragma unroll
        for (int ai = 0; ai < 2; ++ai)
#pragma unroll
            for (int m = 0; m < 4; ++m) { bf16_t* rowp = H + (size_t)(row0 + ai * HALF + m * 16) * DFF + f0;
                const float rs = (Q8_CLIP / 127.0f) * sqrtf((float)sql[ai * HALF + m * 16] * (1.0f / (16777216.0f * D)) + EPS) / sqrtf((float)ssl[ai * HALF + m * 16] * (1.0f / (16777216.0f * D)) + EPS);
                float o[8];
#pragma unroll
                for (int n = 0; n < 2; ++n)
#pragma unroll
                    for (int e = 0; e < 4; ++e) { const float a0 = (float)__float_as_int(acc[ai][0][m][n][e]) * rs, a1 = (float)__float_as_int(acc[ai][1][m][n][e]) * rs;
                        o[4 * n + e] = silu_f(a0 * cv[0][n][e] + bv[0][n][e]) * (a1 * cv[1][n][e] + bv[1][n][e]); }
                u32x4 w; w.x = cvt_pk_bf16(o[0], o[1]); w.y = cvt_pk_bf16(o[2], o[3]); w.z = cvt_pk_bf16(o[4], o[5]); w.w = cvt_pk_bf16(o[6], o[7]);
                *(u32x4*)(rowp) = w; }
    }
};
}

struct Ptrs {
    const float* in[23]; float* out; unsigned char* ws;
};
enum { I_X = 0, I_C, I_RELB, I_WADA, I_BADA, I_GMIX, I_GFFN, I_AWIN, I_AKVG, I_AWUK, I_AWUV, I_AIKG, I_AIKB, I_AWOUT, I_BWIN, I_BBIN, I_BSINK, I_BWOUT, I_BBOUT, I_W1, I_W3, I_W2, I_GFIN };

__device__ __forceinline__ void conv_task(const Ptrs& P, int th, int lane) {
    const int t = th >> 1, half = th & 1;
    int kind, rb, ks, Kd; bf16_t* dst; const float* s0 = nullptr; const float* s1 = nullptr; const float* gk = nullptr; int ld = 0; bool f8 = false, h16 = false;
    if (t < 2112) { const int l = t / 528, r = t % 528; unsigned char* wl = P.ws + WS_W + (size_t)l * W_LAYER;
        if (r < 352) { kind = 1; rb = r >> 2; ks = r & 3; Kd = 1024; dst = (bf16_t*)(wl + W13_OFF); s0 = P.in[I_W1] + (size_t)l * D * DFF; s1 = P.in[I_W3] + (size_t)l * D * DFF; ld = DFF; }
        else { const int r2 = r - 352; kind = 0; rb = r2 / 11; ks = r2 % 11; Kd = DFF; dst = (bf16_t*)(wl + W2_OFF); s0 = P.in[I_W2] + (size_t)l * DFF * D; ld = D; }
    } else { const int t2 = t - 2112, j = t2 / 464, r = t2 % 464; unsigned char* wa = P.ws + WS_WA + (size_t)j * WA_STRIDE; unsigned char* wb = P.ws + WS_WB + (size_t)j * WB_STRIDE;
        if (r < 128) { kind = 2; rb = r >> 2; ks = r & 3; Kd = 1024; dst = (bf16_t*)(wa + WINA_OFF); s0 = P.in[I_AWIN] + (size_t)j * D * A_IN; ld = A_IN; h16 = true; }
        else if (r < 192) { kind = 3; rb = r - 128; ks = 0; Kd = 128; dst = (bf16_t*)(wa + WQA_OFF); s0 = P.in[I_AWUK] + (size_t)j * NH * RK * HD; gk = P.in[I_AKVG] + j * RK; }
        else if (r < 256) { const int r2 = r - 192; kind = 4; rb = r2 >> 2; ks = r2 & 3; Kd = 1024; dst = (bf16_t*)(wa + WUV_OFF); s0 = P.in[I_AWUV] + (size_t)j * NH * RK * HD; gk = P.in[I_AKVG] + j * RK; }
        else if (r < 320) { const int r2 = r - 256; kind = 0; rb = r2 >> 2; ks = r2 & 3; Kd = 1024; dst = (bf16_t*)(wa + WOUTA_OFF); s0 = P.in[I_AWOUT] + (size_t)j * D * D; ld = D; f8 = true; }
        else if (r < 400) { const int r2 = r - 320; kind = 0; rb = r2 >> 2; ks = r2 & 3; Kd = 1024; dst = (bf16_t*)(wb + WINB_OFF); s0 = P.in[I_BWIN] + (size_t)j * D * B_IN; ld = B_IN; h16 = true; }
        else { const int r2 = r - 400; kind = 0; rb = r2 >> 2; ks = r2 & 3; Kd = 1024; dst = (bf16_t*)(wb + WOUTB_OFF); s0 = P.in[I_BWOUT] + (size_t)j * D * D; ld = D; f8 = true; }
    }
    const int n = rb * 64 + lane, k0 = ks * 256;
    bf16_t* drow = dst + (size_t)n * Kd + k0;
    if (kind <= 2) {
        const float* src = s0; int col = n;
        if (kind == 1) { const int c = n & 255, f = (n >> 8) * 128 + (c & 127); src = (c < 128) ? s0 : s1; col = f; }
        if (kind == 2) { if (n >= 1792) { const int c = n - 1792; col = c < 32 ? 1792 + c : (c < 40 ? 1856 + (c - 32) : ((c >= 128 && c < 160) ? 1824 + (c - 128) : -1)); } }
        const float* sp = src + (size_t)k0 * ld + (col < 0 ? 0 : col);
        for (int kq = 4 * half; kq < 4 * half + 4; ++kq) {
          float vv[4][8];
#pragma unroll
          for (int i = 0; i < 4; ++i)
#pragma unroll
            for (int e = 0; e < 8; ++e) vv[i][e] = sp[(size_t)((kq * 4 + i) * 8 + e) * ld];
          asm volatile("" ::: "memory");
#pragma unroll
          for (int i = 0; i < 4; ++i) { const int kc = kq * 4 + i;
            float v[8];
#pragma unroll
            for (int e = 0; e < 8; ++e) v[e] = vv[i][e];
            if (col < 0) {
#pragma unroll
                for (int e = 0; e < 8; ++e) v[e] = 0.f; }
            if (f8) {
#pragma unroll
                for (int e = 0; e < 8; ++e) v[e] = __builtin_amdgcn_fmed3f(v[e] * 256.0f, -448.0f, 448.0f);
                int w0 = 0, w1 = 0;
                w0 = __builtin_amdgcn_cvt_pk_fp8_f32(v[0], v[1], w0, false); w0 = __builtin_amdgcn_cvt_pk_fp8_f32(v[2], v[3], w0, true);
                w1 = __builtin_amdgcn_cvt_pk_fp8_f32(v[4], v[5], w1, false); w1 = __builtin_amdgcn_cvt_pk_fp8_f32(v[6], v[7], w1, true);
                u32x2 w; w.x = (unsigned)w0; w.y = (unsigned)w1; *(u32x2*)((unsigned char*)dst + (size_t)n * Kd + k0 + kc * 8) = w;
            } else if (h16) {
            u32x4 w; w.x = cvt_pk_f16(v[0], v[1]); w.y = cvt_pk_f16(v[2], v[3]); w.z = cvt_pk_f16(v[4], v[5]); w.w = cvt_pk_f16(v[6], v[7]);
            *(u32x4*)(drow + kc * 8) = w;
            } else {
            u32x4 w; w.x = cvt_pk_bf16(v[0], v[1]); w.y = cvt_pk_bf16(v[2], v[3]); w.z = cvt_pk_bf16(v[4], v[5]); w.w = cvt_pk_bf16(v[6], v[7]);
            *(u32x4*)(drow + kc * 8) = w; }
        } }
    } else if (kind == 3) {
        const int h = n >> 8, r = n & 255; const float gs = gk[r] * 8.0f;       const float* sp = s0 + ((size_t)h * RK + r) * HD;
        for (int kc = 0; kc < (half ? 0 : 16); ++kc) { const int k = kc * 8; float v[8];
            if ((k >> 6) == (h & 1)) {
#pragma unroll
                for (int e = 0; e < 8; ++e) v[e] = sp[(k & 63) + e] * gs;
            } else {
#pragma unroll
                for (int e = 0; e < 8; ++e) v[e] = 0.f; }
            u32x4 w; w.x = cvt_pk_bf16(v[0], v[1]); w.y = cvt_pk_bf16(v[2], v[3]); w.z = cvt_pk_bf16(v[4], v[5]); w.w = cvt_pk_bf16(v[6], v[7]);
            *(u32x4*)(drow + kc * 8) = w; }
    } else {
        const int hh = (n >> 6) & 3, d = n & 63, h = n >> 6;
        for (int kc = 16 * half; kc < 16 * half + 16; ++kc) { const int k = k0 + kc * 8; float v[8];
            if ((k >> 8) == hh) {
#pragma unroll
                for (int e = 0; e < 8; ++e) { const int r = (k & 255) + e; v[e] = s0[((size_t)h * RK + r) * HD + d] * gk[r] * 16.0f; }
            } else {
#pragma unroll
                for (int e = 0; e < 8; ++e) v[e] = 0.f; }
            u32x4 w; w.x = cvt_pk_bf16(v[0], v[1]); w.y = cvt_pk_bf16(v[2], v[3]); w.z = cvt_pk_bf16(v[4], v[5]); w.w = cvt_pk_bf16(v[6], v[7]);
            *(u32x4*)(drow + kc * 8) = w; }
    }
}
constexpr int N_CONV_TASKS = 6080;

__device__ __forceinline__ void p0_prologue(const Ptrs& P, LAS unsigned char* lds, int G) {
    int tid = tid_now();
    const int lane = tid & 63, wave = __builtin_amdgcn_readfirstlane(tid >> 6);
    const int gw = blockIdx.x * NWAVES + wave, NGW = G * NWAVES;
    for (int t = gw; t < N_CONV_TASKS; t += NGW) conv_task(P, t, lane);
    LAS float* cs = (LAS float*)lds;
    LAS float* red = (LAS float*)(lds + 65536);
    for (int i = tid; i < BATCH * D; i += NTHR) { const int b = i >> 10, k = i & 1023; cs[k * 16 + b] = silu_f(P.in[I_C][i]); }
    __syncthreads();
    float* mod = (float*)(P.ws + WS_MOD);
    for (int task = blockIdx.x; task < 4 * 96; task += G) {
        const int l = task / 96, j0 = (task % 96) * 64, col = tid & 63, ksl = tid >> 6;
        const float* wp = P.in[I_WADA] + ((size_t)l * D + ksl * 128) * 6144 + j0 + col;
        float a[16];
#pragma unroll
        for (int b = 0; b < 16; ++b) a[b] = 0.f;
        for (int k = 0; k < 128; ++k) { const float w = wp[(size_t)k * 6144]; const LAS f32x4* c4 = (const LAS f32x4*)(cs + (ksl * 128 + k) * 16);
#pragma unroll
            for (int q = 0; q < 4; ++q) { const f32x4 c = c4[q];
#pragma unroll
                for (int e = 0; e < 4; ++e) a[4 * q + e] += w * c[e]; } }
#pragma unroll
        for (int b = 0; b < 16; ++b) red[(ksl * 64 + col) * 16 + b] = a[b];
        __syncthreads();
        for (int o = tid; o < 1024; o += NTHR) { const int c2 = o >> 4, b = o & 15; float s = 0.f;
#pragma unroll
            for (int q = 0; q < 8; ++q) s += red[(q * 64 + c2) * 16 + b];
            mod[((size_t)l * BATCH + b) * 6144 + j0 + c2] = s + P.in[I_BADA][l * 6144 + j0 + c2]; }
        __syncthreads();
    }
}

__device__ __forceinline__ void pre_phase(const Ptrs& P, LAS unsigned char* lds, int G) {
    int tid = tid_now();
    const int lane = tid & 63, wave = __builtin_amdgcn_readfirstlane(tid >> 6);
    const float* mod = (const float*)(P.ws + WS_MOD);
    {
        const int grp = blockIdx.x & 7, l = grp >> 1, kind = grp & 1, j = l >> 1;
        const float* shsrc = mod + (size_t)l * BATCH * 6144 + (kind ? 3072 : 0);
        constexpr int SP = 2064;
        for (int i = tid; i < BATCH * D / 2; i += NTHR) { const int b = i >> 9, k2 = (i & 511) * 2;
            const float a0 = shsrc[(size_t)b * 6144 + k2], a1 = shsrc[(size_t)b * 6144 + k2 + 1];
            *(LAS unsigned*)(lds + b * SP + k2 * 2) = kind ? cvt_pk_bf16(a0, a1) : cvt_pk_f16(a0, a1); }
        __syncthreads();
        const bf16_t* W; int nrows; float* dst; const float* bias = nullptr;
        if (kind) { W = (const bf16_t*)(P.ws + WS_W + (size_t)l * W_LAYER + W13_OFF); nrows = 2 * DFF; dst = (float*)(P.ws + WS_SHW + SHW_F) + (size_t)l * BATCH * 2 * DFF; }
        else if ((l & 1) == 0) { W = (const bf16_t*)(P.ws + WS_WA + (size_t)j * WA_STRIDE + WINA_OFF); nrows = 2048; dst = (float*)(P.ws + WS_SHW + SHW_A) + (size_t)j * BATCH * 2048; }
        else { W = (const bf16_t*)(P.ws + WS_WB + (size_t)j * WB_STRIDE + WINB_OFF); nrows = B_IN; dst = (float*)(P.ws + WS_SHW + SHW_B) + (size_t)j * BATCH * B_IN; bias = P.in[I_BBIN] + j * B_IN; }
        const int nblk = nrows >> 4, wq = (blockIdx.x >> 3) * NWAVES + wave, nwq = (G >> 3) * NWAVES;
        const int nn = lane & 15, g = lane >> 4;
        for (int blk = wq; blk < nblk; blk += nwq) {
            f32x4 acc = (f32x4){0.f, 0.f, 0.f, 0.f};
            const bf16_t* wp = W + (size_t)(blk * 16 + nn) * D + 8 * g;
#pragma unroll 8
            for (int ks = 0; ks < 32; ++ks) { const bf16x8 a = *(const LAS bf16x8*)(lds + nn * SP + (32 * ks + 8 * g) * 2); const bf16x8 bw = *(const bf16x8*)(wp + 32 * ks);
                acc = kind ? __builtin_amdgcn_mfma_f32_16x16x32_bf16(a, bw, acc, 0, 0, 0) : __builtin_amdgcn_mfma_f32_16x16x32_f16(__builtin_bit_cast(h16x8, a), __builtin_bit_cast(h16x8, bw), acc, 0, 0, 0); }
            const int n = blk * 16 + nn; const float bb = bias ? bias[n] : 0.f;
#pragma unroll
            for (int i = 0; i < 4; ++i) dst[(size_t)(4 * g + i) * nrows + n] = acc[i] + bb;
        }
    }
    {
        const int gw = blockIdx.x * NWAVES + wave, NGW = G * NWAVES;
        const float* x = P.in[I_X]; const float* gmix = P.in[I_GMIX]; bf16_t* XG = (bf16_t*)(P.ws + WS_XG); unsigned long long* SS0 = (unsigned long long*)(P.ws + WS_SS);
        for (int row = gw; row < M; row += NGW) {
            const int b = row >> 11;
            const f32x4* xr = (const f32x4*)(x + (size_t)row * D) + lane;
            f32x4 v[4]; float sq = 0.f;
#pragma unroll
            for (int jj = 0; jj < 4; ++jj) { v[jj] = xr[64 * jj]; sq += (v[jj][0] * v[jj][0] + v[jj][1] * v[jj][1]) + (v[jj][2] * v[jj][2] + v[jj][3] * v[jj][3]); }
            const float ss = wave_sum(sq);
            if (lane == 0) SS0[row] = (unsigned long long)(ss * 16777216.0f);
            const float* mb = mod + (size_t)b * 6144;
            u32x2* o8 = (u32x2*)(XG + (size_t)row * D) + lane; u32x2* x8 = (u32x2*)((bf16_t*)P.out + (size_t)row * D) + lane;
#pragma unroll
            for (int jj = 0; jj < 4; ++jj) { const int c = 4 * lane + 256 * jj;
                const f32x4 y = v[jj] * *(const f32x4*)(gmix + c) * (*(const f32x4*)(mb + 1024 + c) + 1.0f);
                u32x2 w; w.x = cvt_pk_f16(y[0], y[1]); w.y = cvt_pk_f16(y[2], y[3]); o8[64 * jj] = w;
                u32x2 xw; xw.x = cvt_pk_f16(v[jj][0], v[jj][1]); xw.y = cvt_pk_f16(v[jj][2], v[jj][3]); x8[64 * jj] = xw; }
        }
    }
}
__device__ __forceinline__ float half_max(float x);
__device__ __forceinline__ float wave_max(float x) {
    const float h = half_max(x);
    const u32x2 r = __builtin_amdgcn_permlane32_swap(__float_as_uint(h), __float_as_uint(h), false, false);
    return fmaxf(__uint_as_float(r.x), __uint_as_float(r.y));
}
__device__ __forceinline__ void w8_build(const bf16_t* W13, const float* gffn, const float* scn, unsigned char* W8, float* CW, LAS unsigned char* lds, int G) {
    int tid = tid_now();
    const int lane = tid & 63, wave = __builtin_amdgcn_readfirstlane(tid >> 6);
    LAS float* mL = (LAS float*)lds;
    for (int i = tid; i < BATCH * D / 4; i += NTHR) { const int b = i >> 8, k4 = (i & 255) * 4;
        *(LAS f32x4*)(mL + b * D + k4) = *(const f32x4*)(gffn + k4) * (*(const f32x4*)(scn + (size_t)b * 6144 + k4) + 1.0f); }
    __syncthreads();
    const int gw = blockIdx.x * NWAVES + wave, NGW = G * NWAVES;
    for (int n = gw; n < 2 * DFF; n += NGW) {
        const u32x2* wrow = (const u32x2*)(W13 + (size_t)n * D) + lane;
        float w[16];
#pragma unroll
        for (int j = 0; j < 4; ++j) { const u32x2 p = wrow[64 * j];
            w[4 * j] = __uint_as_float(p.x << 16); w[4 * j + 1] = __uint_as_float(p.x & 0xffff0000u); w[4 * j + 2] = __uint_as_float(p.y << 16); w[4 * j + 3] = __uint_as_float(p.y & 0xffff0000u); }
        unsigned* orow = (unsigned*)(W8 + (size_t)n * D) + lane;
#pragma unroll 2
        for (int b = 0; b < BATCH; ++b) {
            float v[16]; float mx = 0.f;
#pragma unroll
            for (int j = 0; j < 4; ++j) { const f32x4 mm = *(const LAS f32x4*)(mL + b * D + 256 * j + 4 * lane);
#pragma unroll
                for (int e = 0; e < 4; ++e) v[4 * j + e] = w[4 * j + e] * mm[e];
                mx = fmaxf(fmaxf(mx, fmaxf(fabsf(v[4 * j]), fabsf(v[4 * j + 1]))), fmaxf(fabsf(v[4 * j + 2]), fabsf(v[4 * j + 3]))); }
            mx = fmaxf(wave_max(mx), 1e-30f);
            const float inv = 127.0f / mx;
#pragma unroll
            for (int j = 0; j < 4; ++j)
                orow[(size_t)b * (W8_BATCH / 4) + 64 * j] = pg8::q8_pack(__float_as_uint(fmaf(v[4 * j], inv, 12582912.0f)), __float_as_uint(fmaf(v[4 * j + 1], inv, 12582912.0f)),
                                                                          __float_as_uint(fmaf(v[4 * j + 2], inv, 12582912.0f)), __float_as_uint(fmaf(v[4 * j + 3], inv, 12582912.0f)));
            if (lane == 0) CW[(size_t)b * (2 * DFF) + n] = mx * (1.0f / 127.0f);
        }
    }
    __syncthreads();
}
__device__ __forceinline__ void final_norm_phase(const bf16_t* x, float* out, const float* g, int G) {
    int tid = tid_now();
    const int lane = tid & 63, wave = __builtin_amdgcn_readfirstlane(tid >> 6);
    const int gw = blockIdx.x * NWAVES + wave, NGW = G * NWAVES;
    for (int row = gw; row < M; row += NGW) {
        const u32x2* xr = (const u32x2*)(x + (size_t)row * D) + lane; f32x4* orow = (f32x4*)(out + (size_t)row * D) + lane;
        f32x4 v[4]; float s = 0.f;
#pragma unroll
        for (int j = 0; j < 4; ++j) { const u32x2 p = xr[64 * j];
            { const f32x2 pa = unpk_f16(p.x), pb = unpk_f16(p.y); v[j] = (f32x4){pa.x, pa.y, pb.x, pb.y}; }
            s += (v[j][0] * v[j][0] + v[j][1] * v[j][1]) + (v[j][2] * v[j][2] + v[j][3] * v[j][3]); }
        const float rstd = 1.0f / sqrtf(wave_sum(s) * (1.0f / D) + EPS);
#pragma unroll
        for (int j = 0; j < 4; ++j) { const f32x4 gg = *(const f32x4*)(g + 4 * lane + 256 * j); orow[64 * j] = v[j] * rstd * gg; }
    }
}

__device__ __forceinline__ unsigned f2key(float f) { const unsigned u = __float_as_uint(f); return (u & 0x80000000u) ? ~u : (u | 0x80000000u); }
__device__ __forceinline__ float key2f(unsigned k) { return __uint_as_float((k & 0x80000000u) ? (k & 0x7fffffffu) : ~k); }
__device__ __forceinline__ float half_max(float x) {
    int u = __float_as_int(x);
    u = __float_as_int(fmaxf(__int_as_float(u), __int_as_float(__builtin_amdgcn_update_dpp(u, u, 0x128, 0xf, 0xf, false))));
    u = __float_as_int(fmaxf(__int_as_float(u), __int_as_float(__builtin_amdgcn_update_dpp(u, u, 0x124, 0xf, 0xf, false))));
    u = __float_as_int(fmaxf(__int_as_float(u), __int_as_float(__builtin_amdgcn_update_dpp(u, u, 0x122, 0xf, 0xf, false))));
    u = __float_as_int(fmaxf(__int_as_float(u), __int_as_float(__builtin_amdgcn_update_dpp(u, u, 0x121, 0xf, 0xf, false))));
    const u32x2 r = __builtin_amdgcn_permlane16_swap((unsigned)u, (unsigned)u, false, false);
    return fmaxf(__uint_as_float(r.x), __uint_as_float(r.y));
}
__device__ __forceinline__ float half_sum_f(float v) {
    v += __int_as_float(__builtin_amdgcn_update_dpp(__float_as_int(v), __float_as_int(v), 0x128, 0xf, 0xf, false));
    v += __int_as_float(__builtin_amdgcn_update_dpp(__float_as_int(v), __float_as_int(v), 0x124, 0xf, 0xf, false));
    v += __int_as_float(__builtin_amdgcn_update_dpp(__float_as_int(v), __float_as_int(v), 0x122, 0xf, 0xf, false));
    v += __int_as_float(__builtin_amdgcn_update_dpp(__float_as_int(v), __float_as_int(v), 0x121, 0xf, 0xf, false));
    const u32x2 r = __builtin_amdgcn_permlane16_swap(__float_as_uint(v), __float_as_uint(v), false, false);
    return __uint_as_float(r.x) + __uint_as_float(r.y);
}
__device__ __forceinline__ f32x2 pk_gt(f32x2 x, f32x2 big, f32x2 nfbig) { f32x2 d; asm("v_pk_fma_f32 %0, %1, %2, %3 clamp" : "=v"(d) : "v"(x), "v"(big), "v"(nfbig)); return d; }
__device__ __forceinline__ int half_sum(int v) {
    v += __builtin_amdgcn_update_dpp(v, v, 0x128, 0xf, 0xf, false);
    v += __builtin_amdgcn_update_dpp(v, v, 0x124, 0xf, 0xf, false);
    v += __builtin_amdgcn_update_dpp(v, v, 0x122, 0xf, 0xf, false);
    v += __builtin_amdgcn_update_dpp(v, v, 0x121, 0xf, 0xf, false);
    const u32x2 r = __builtin_amdgcn_permlane16_swap((unsigned)v, (unsigned)v, false, false);
    return (int)(r.x + r.y);
}
typedef float f32x32 __attribute__((ext_vector_type(32)));
__device__ __forceinline__ void idx_task(const bf16_t* QI, const bf16_t* KIN, const float* WI, unsigned* SEL, LAS unsigned char* lds, int b, int tg, int lane, int wave, bool active, int nrounds) {
    asm volatile("" : "+v"(lane));
    const int t0 = tg * 4, h = lane >> 5, r = lane & 31;
    const int qsel = 2 * (r >> 4) + ((r >> 2) & 1), hd = (r & 3) + 4 * ((r >> 3) & 1);
    const size_t rowb = (size_t)b * SEQ;
    bf16x8 aq[4];
#pragma unroll
    for (int ks = 0; ks < 4; ++ks) aq[ks] = *(const bf16x8*)(QI + (rowb + t0 + qsel) * 512 + hd * 64 + ks * 16 + h * 8);
    float wlo[8], whi[8];
    { const f32x4 a0 = *(const f32x4*)(WI + (rowb + t0 + h) * 8), a1 = *(const f32x4*)(WI + (rowb + t0 + h) * 8 + 4);
      const f32x4 b0 = *(const f32x4*)(WI + (rowb + t0 + 2 + h) * 8), b1 = *(const f32x4*)(WI + (rowb + t0 + 2 + h) * 8 + 4);
#pragma unroll
      for (int e = 0; e < 4; ++e) { wlo[e] = a0[e]; wlo[4 + e] = a1[e]; whi[e] = b0[e]; whi[4 + e] = b1[e]; } }
    f32x32 sA0, sA1, sB0, sB1;
#pragma unroll
    for (int i = 0; i < 32; ++i) { sA0[i] = NEGF; sA1[i] = NEGF; sB0[i] = NEGF; sB1[i] = NEGF; }
    const int ktmax = (t0 + 3) >> 5, tlo = t0 + h, thi = t0 + 2 + h;
    const unsigned lb = (unsigned)(size_t)lds;
    const int sw = (r >> 1) & 7;
#define IDX_LDS4(R0, R1, R2, R3) asm volatile("ds_read_b128 %0, %4\n\tds_read_b128 %1, %5\n\tds_read_b128 %2, %6\n\tds_read_b128 %3, %7" \
                                             : "=&v"(R0), "=&v"(R1), "=&v"(R2), "=&v"(R3) : "v"(a0), "v"(a1), "v"(a2), "v"(a3) : "memory")
#define IDX_TILE(KTL, KEY0, SA, SB, C0, C1, C2, C3, N0, N1, N2, N3) \
        { \
            a0 += 4096u; a1 += 4096u; a2 += 4096u; a3 += 4096u; \
            IDX_LDS4(N0, N1, N2, N3);                          \
            asm volatile("s_waitcnt lgkmcnt(4)" : "+v"(C0), "+v"(C1), "+v"(C2), "+v"(C3) :: "memory");     \
            f32x16 acc; \
            _Pragma("unroll") for (int i = 0; i < 16; ++i) acc[i] = 0.f; \
            acc = __builtin_amdgcn_mfma_f32_32x32x16_f16(__builtin_bit_cast(h16x8, aq[0]), __builtin_bit_cast(h16x8, C0), acc, 0, 0, 0); acc = __builtin_amdgcn_mfma_f32_32x32x16_f16(__builtin_bit_cast(h16x8, aq[1]), __builtin_bit_cast(h16x8, C1), acc, 0, 0, 0); \
            acc = __builtin_amdgcn_mfma_f32_32x32x16_f16(__builtin_bit_cast(h16x8, aq[2]), __builtin_bit_cast(h16x8, C2), acc, 0, 0, 0); acc = __builtin_amdgcn_mfma_f32_32x32x16_f16(__builtin_bit_cast(h16x8, aq[3]), __builtin_bit_cast(h16x8, C3), acc, 0, 0, 0); \
            f32x2 p0 = (f32x2){0.f, 0.f}, p1 = (f32x2){0.f, 0.f};            \
            _Pragma("unroll") for (int i = 0; i < 4; ++i) { \
                const f32x2 r0 = (f32x2){__builtin_amdgcn_fmed3f(acc[2 * i], 0.f, 3.0e38f), __builtin_amdgcn_fmed3f(acc[2 * i + 1], 0.f, 3.0e38f)}; \
                const f32x2 r1 = (f32x2){__builtin_amdgcn_fmed3f(acc[8 + 2 * i], 0.f, 3.0e38f), __builtin_amdgcn_fmed3f(acc[9 + 2 * i], 0.f, 3.0e38f)}; \
                p0 = __builtin_elementwise_fma((f32x2){wlo[2 * i], wlo[2 * i + 1]}, r0, p0); p1 = __builtin_elementwise_fma((f32x2){whi[2 * i], whi[2 * i + 1]}, r1, p1); } \
            const float s0 = p0.x + p0.y, s1 = p1.x + p1.y; \
            const int key = (KEY0) + r; \
            SA[KTL] = key <= tlo ? s0 : NEGF; SB[KTL] = key <= thi ? s1 : NEGF; \
        }
    bf16x8 ta0, ta1, ta2, ta3, tb0, tb1, tb2, tb3;
#pragma unroll
    for (int rnd = 0; rnd < 2; ++rnd) {
        if (rnd >= nrounds) break;
        __syncthreads();
        {
            const int rl = lane >> 3, pp = lane & 7;
#pragma unroll 4
            for (int j = 0; j < 16; ++j) { const int pi = wave * 16 + j, row = 8 * pi + rl;
                const bf16_t* src = KIN + (rowb + 1024 * rnd + row) * 64 + 8 * (pp ^ ((row >> 1) & 7));
                __builtin_amdgcn_global_load_lds((const unsigned*)src, (LAS unsigned*)(lds + 1024 * pi), 16, 0, 0); }
        }
        asm volatile("s_waitcnt vmcnt(0)" ::: "memory");
        __syncthreads();
        const int ntl = ktmax - 32 * rnd + 1;
        if (active && ntl > 0) {
            const int npair = ((ntl < 32 ? ntl : 32) + 1) >> 1;
            unsigned a0 = lb + (unsigned)r * 128u + 16u * (unsigned)((0 + h) ^ sw), a1 = lb + (unsigned)r * 128u + 16u * (unsigned)((2 + h) ^ sw);
            unsigned a2 = lb + (unsigned)r * 128u + 16u * (unsigned)((4 + h) ^ sw), a3 = lb + (unsigned)r * 128u + 16u * (unsigned)((6 + h) ^ sw);
            IDX_LDS4(ta0, ta1, ta2, ta3);
#pragma nounroll
            for (int kp = 0; kp < npair; ++kp) {
                if (rnd == 0) { IDX_TILE(2 * kp, 64 * kp, sA0, sB0, ta0, ta1, ta2, ta3, tb0, tb1, tb2, tb3)
                                IDX_TILE(2 * kp + 1, 64 * kp + 32, sA0, sB0, tb0, tb1, tb2, tb3, ta0, ta1, ta2, ta3) }
                else          { IDX_TILE(2 * kp, 1024 + 64 * kp, sA1, sB1, ta0, ta1, ta2, ta3, tb0, tb1, tb2, tb3)
                                IDX_TILE(2 * kp + 1, 1024 + 64 * kp + 32, sA1, sB1, tb0, tb1, tb2, tb3, ta0, ta1, ta2, ta3) }
            }
            asm volatile("s_waitcnt lgkmcnt(0)" : "+v"(ta0), "+v"(ta1), "+v"(ta2), "+v"(ta3), "+v"(tb0), "+v"(tb1), "+v"(tb2), "+v"(tb3) :: "memory");
        }
    }
#undef IDX_TILE
#undef IDX_LDS4
    if (!active) return;
    const int nt0 = ktmax < 31 ? ktmax + 1 : 32, nt1 = ktmax - 31;
    float mxA = NEGF, mxB = NEGF, mnA = -NEGF, mnB = -NEGF;
#pragma nounroll
    for (int kt = 0; kt < nt0; ++kt) { const float a = sA0[kt], bb = sB0[kt];
        mxA = fmaxf(mxA, a); mxB = fmaxf(mxB, bb); mnA = fminf(mnA, a > -1e29f ? a : -NEGF); mnB = fminf(mnB, bb > -1e29f ? bb : -NEGF); }
#pragma nounroll
    for (int kt = 0; kt < nt1; ++kt) { const float a = sA1[kt], bb = sB1[kt];
        mxA = fmaxf(mxA, a); mxB = fmaxf(mxB, bb); mnA = fminf(mnA, a > -1e29f ? a : -NEGF); mnB = fminf(mnB, bb > -1e29f ? bb : -NEGF); }
    mxA = half_max(mxA); mxB = half_max(mxB); mnA = -half_max(-mnA); mnB = -half_max(-mnB);
    const int Ka = tlo + 1 < TOPK ? tlo + 1 : TOPK, Kb = thi + 1 < TOPK ? thi + 1 : TOPK;
    float loA = mnA - (fabsf(mnA) * 1e-6f + 1e-30f), hiA = mxA, loB = mnB - (fabsf(mnB) * 1e-6f + 1e-30f), hiB = mxB;
    float cloA = (float)(tlo + 1), chiA = 0.0f, cloB = (float)(thi + 1), chiB = 0.0f;
    float TA = -1e29f, TB = -1e29f; bool doneA = (tlo + 1 <= TOPK), doneB = (thi + 1 <= TOPK);
    const int nblk = (ktmax >> 3) + 1;
    const float BIG = 1099511627776.0f;
#define SA2(i) ((i) < 32 ? (f32x2){sA0[(i) & 31], sA0[((i) & 31) + 1]} : (f32x2){sA1[(i) & 31], sA1[((i) & 31) + 1]})
#define SB2(i) ((i) < 32 ? (f32x2){sB0[(i) & 31], sB0[((i) & 31) + 1]} : (f32x2){sB1[(i) & 31], sB1[((i) & 31) + 1]})
#pragma nounroll
    for (int it = 0; it < 48; ++it) {
        if (__ballot(!doneA || !doneB) == 0ull) break;
        const bool bis = (it % 3) == 2;
        const float wA = hiA - loA, wB = hiB - loB;
        float rA = bis ? 0.5f : (cloA - (float)Ka + 0.5f) / (cloA - chiA), rB = bis ? 0.5f : (cloB - (float)Kb + 0.5f) / (cloB - chiB);
        rA = fminf(fmaxf(rA, 0.03f), 0.97f); rB = fminf(fmaxf(rB, 0.03f), 0.97f);
        const float midA = loA + wA * rA, midB = loB + wB * rB;
        const float fA = doneA ? TA : midA, fB = doneB ? TB : midB;
        const f32x2 bigp = (f32x2){BIG, BIG}, nfA = (f32x2){-fA * BIG, -fA * BIG}, nfB = (f32x2){-fB * BIG, -fB * BIG};
        f32x2 cA2 = (f32x2){0.f, 0.f}, cB2 = (f32x2){0.f, 0.f};
#pragma unroll
        for (int blk = 0; blk < 8; ++blk) {
            if (blk < nblk) {
#pragma unroll
                for (int e = 0; e < 4; ++e) { cA2 += pk_gt(SA2(8 * blk + 2 * e), bigp, nfA); cB2 += pk_gt(SB2(8 * blk + 2 * e), bigp, nfB); }
            }
        }
        const int cA = (int)half_sum_f(cA2.x + cA2.y), cB = (int)half_sum_f(cB2.x + cB2.y);
        const bool stuckA = !(midA > loA && midA < hiA), stuckB = !(midB > loB && midB < hiB);
        if (!doneA) { if (cA == Ka) { TA = fA; doneA = true; } else if (stuckA) { TA = loA; doneA = true; } else if (cA > Ka) { loA = midA; cloA = (float)cA; } else { hiA = midA; chiA = (float)cA; } }
        if (!doneB) { if (cB == Kb) { TB = fB; doneB = true; } else if (stuckB) { TB = loB; doneB = true; } else if (cB > Kb) { loB = midB; cloB = (float)cB; } else { hiB = midB; chiB = (float)cB; } }
    }
#undef SA2
#undef SB2
    if (!doneA) TA = loA;
    if (!doneB) TB = loB;
    unsigned w0 = 0u, w1 = 0u, w2 = 0u, w3 = 0u;
#pragma nounroll
    for (int kt = 0; kt < nt0; ++kt) { const unsigned long long ma = __ballot(sA0[kt] > TA), mb = __ballot(sB0[kt] > TB);
        if (lane == kt) { w0 = (unsigned)ma; w1 = (unsigned)(ma >> 32); w2 = (unsigned)mb; w3 = (unsigned)(mb >> 32); } }
#pragma nounroll
    for (int kt = 0; kt < nt1; ++kt) { const unsigned long long ma = __ballot(sA1[kt] > TA), mb = __ballot(sB1[kt] > TB);
        if (lane == 32 + kt) { w0 = (unsigned)ma; w1 = (unsigned)(ma >> 32); w2 = (unsigned)mb; w3 = (unsigned)(mb >> 32); } }
    SEL[(rowb + t0 + 0) * 64 + lane] = w0; SEL[(rowb + t0 + 1) * 64 + lane] = w1; SEL[(rowb + t0 + 2) * 64 + lane] = w2; SEL[(rowb + t0 + 3) * 64 + lane] = w3;
}

#define ATT_F(r) (((r) & 3) | ((((r) >> 3) & 3) << 2))
#define TRB8(OFS, r0, r1, r2, r3, r4, r5, r6, r7, a0, a1, a2, a3, a4, a5, a6, a7) \
    asm volatile("ds_read_b64_tr_b16 %0, %8 offset:" OFS "\n\tds_read_b64_tr_b16 %1, %9 offset:" OFS "\n\tds_read_b64_tr_b16 %2, %10 offset:" OFS "\n\tds_read_b64_tr_b16 %3, %11 offset:" OFS "\n\t" \
                 "ds_read_b64_tr_b16 %4, %12 offset:" OFS "\n\tds_read_b64_tr_b16 %5, %13 offset:" OFS "\n\tds_read_b64_tr_b16 %6, %14 offset:" OFS "\n\tds_read_b64_tr_b16 %7, %15 offset:" OFS "\n\ts_waitcnt lgkmcnt(0)" \
                 : "=&v"(r0), "=&v"(r1), "=&v"(r2), "=&v"(r3), "=&v"(r4), "=&v"(r5), "=&v"(r6), "=&v"(r7) \
                 : "v"(a0), "v"(a1), "v"(a2), "v"(a3), "v"(a4), "v"(a5), "v"(a6), "v"(a7) : "memory")
#define RDK8(OFS, r, a) \
    asm volatile("ds_read_b64 %0, %8 offset:" OFS "\n\tds_read_b64 %1, %9 offset:" OFS "\n\tds_read_b64 %2, %10 offset:" OFS "\n\tds_read_b64 %3, %11 offset:" OFS "\n\t" \
                 "ds_read_b64 %4, %12 offset:" OFS "\n\tds_read_b64 %5, %13 offset:" OFS "\n\tds_read_b64 %6, %14 offset:" OFS "\n\tds_read_b64 %7, %15 offset:" OFS "\n\ts_waitcnt lgkmcnt(0)" \
                 : "=&v"(r[0]), "=&v"(r[1]), "=&v"(r[2]), "=&v"(r[3]), "=&v"(r[4]), "=&v"(r[5]), "=&v"(r[6]), "=&v"(r[7]) \
                 : "v"(a[0]), "v"(a[1]), "v"(a[2]), "v"(a[3]), "v"(a[4]), "v"(a[5]), "v"(a[6]), "v"(a[7]) : "memory")
__device__ __forceinline__ float rows_max(float x) {
    unsigned u = __float_as_uint(x);
    u32x2 r = __builtin_amdgcn_permlane16_swap(u, u, false, false);
    u = __float_as_uint(fmaxf(__uint_as_float(r.x), __uint_as_float(r.y)));
    r = __builtin_amdgcn_permlane32_swap(u, u, false, false);
    return fmaxf(__uint_as_float(r.x), __uint_as_float(r.y));
}
__device__ __forceinline__ float rows_sum(float x) {
    unsigned u = __float_as_uint(x);
    u32x2 r = __builtin_amdgcn_permlane16_swap(u, u, false, false);
    u = __float_as_uint(__uint_as_float(r.x) + __uint_as_float(r.y));
    r = __builtin_amdgcn_permlane32_swap(u, u, false, false);
    return __uint_as_float(r.x) + __uint_as_float(r.y);
}

__device__ __forceinline__ int att_build_list(LAS unsigned* list, const LAS unsigned* btab, unsigned w, int t, int lane) {
    const int pc = __popc(w); int incl = pc;
#pragma unroll
    for (int o = 1; o < 64; o <<= 1) { const int v = __builtin_amdgcn_ds_bpermute(((lane - o) & 63) << 2, incl); if (lane >= o) incl += v; }
    const int total = __builtin_amdgcn_readlane(incl, 63); const int cnt = total < TOPK ? total : TOPK;
    int off = incl - pc;
    while (w) { const int bit = __builtin_ctz(w); w &= w - 1u;
        if (off < TOPK) { const int idx = 32 * lane + bit; int dd = t - idx; dd = dd < 0 ? 0 : (dd > 128 ? 128 : dd); list[off] = (unsigned)idx | (btab[dd] << 16); }
        ++off; }
    for (int sl = cnt + lane; sl < ((cnt + 31) & ~31); sl += 64) list[sl] = 0u;
    return cnt;
}
__device__ __forceinline__ void att_gather32(const unsigned char* CKV8b, const LAS unsigned* list32, LAS unsigned char* slot, int lane) {
    const LAS unsigned* lp = list32 + (lane >> 4);
    unsigned idx[8];
#pragma unroll
    for (int i = 0; i < 8; ++i) idx[i] = lp[4 * i] & 0xffffu;
#pragma unroll
    for (int i = 0; i < 8; ++i) {
        const int rr = 4 * i + (lane >> 4);
        const unsigned char* src = CKV8b + (size_t)idx[i] * RK + 16 * ((lane & 15) ^ ATT_F(rr));
        __builtin_amdgcn_global_load_lds((const unsigned*)src, (LAS unsigned*)(slot + 1024 * i), 16, 0, 0);
    }
}

#define ATT_T(q) (((q) & 2047) ^ (((q) >> 11) ? 255 : 0))
__device__ __forceinline__ void att_wave(const unsigned char* CKV8, const unsigned* SEL, unsigned char* BIG, LAS unsigned char* kvbuf, LAS unsigned* lists, const LAS float* relb, const LAS unsigned* btab,
                                         int xcd, int wx, int nwx, int lane) {
    asm volatile("" : "+v"(lane));
    const int hq = lane & 15, g = lane >> 4;
    const int nq = (2 * SEQ - wx + nwx - 1) / nwx;
    if (nq <= 0) return;
    const unsigned kvb = (unsigned)(size_t)kvbuf;
    unsigned qa[8];
#pragma unroll
    for (int ks = 0; ks < 8; ++ks) qa[ks] = kvb + (unsigned)(8 * (hq >> 2) + (hq & 3)) * 256u + 16u * (unsigned)((2 * ks + (g >> 1)) ^ ATT_F(8 * (hq >> 2) + (hq & 3))) + 8u * (unsigned)(g & 1);
    const int trow = 8 * g + (hq >> 1);
    unsigned ta[16];
#pragma unroll
    for (int nt = 0; nt < 16; ++nt) ta[nt] = kvb + (unsigned)trow * 256u + 16u * (unsigned)(nt ^ ATT_F(trow)) + 8u * (unsigned)(hq & 1);

    int q = wx, b = 2 * xcd + (q >> 11), t = ATT_T(q);
    size_t row = (size_t)b * SEQ + t;
    unsigned wsel = SEL[row * 64 + lane];
    int cnt = att_build_list(lists, btab, wsel, t, lane);
    unsigned wnext = 0u;
    if (nq > 1) { const int q1 = wx + nwx; wnext = SEL[((size_t)(2 * xcd + (q1 >> 11)) * SEQ + ATT_T(q1)) * 64 + lane]; }
    long bq[8];
    { const unsigned char* qp = BIG + row * 8192 + hq * 256 + 8 * g;
#pragma unroll
      for (int ks = 0; ks < 8; ++ks) bq[ks] = *(const long*)(qp + 32 * ks); }
    int par = 0;
    asm volatile("s_waitcnt lgkmcnt(0)" ::: "memory");
    att_gather32(CKV8 + (size_t)b * SEQ * RK, lists, kvbuf, lane);
    for (int k = 0; k < nq; ++k) {
        const int cur = k & 1;
        LAS unsigned* list = lists + cur * 256;
        const bool has_next = (k + 1 < nq);
        const int qn = q + nwx, bn = 2 * xcd + (qn >> 11), tn = ATT_T(qn);
        const size_t rown = (size_t)bn * SEQ + tn;
        int cntn = 0;
        if (has_next) { cntn = att_build_list(lists + (cur ^ 1) * 256, btab, wnext, tn, lane);
            if (k + 2 < nq) { const int q2 = qn + nwx; wnext = SEL[((size_t)(2 * xcd + (q2 >> 11)) * SEQ + ATT_T(q2)) * 64 + lane]; } }
        f32x4 O[16];
#pragma unroll
        for (int nt = 0; nt < 16; ++nt) O[nt] = (f32x4){0.f, 0.f, 0.f, 0.f};
        float mref = NEGF, lsum = 0.f;
        const int nsub = (cnt + 31) >> 5;
        for (int sc = 0; sc < nsub; ++sc) {
            const bool lastc = (sc + 1 == nsub);
            float bias[8];
#pragma unroll
            for (int T = 0; T < 2; ++T) { const u32x4 mt = *(const LAS u32x4*)(list + 32 * sc + 8 * g + 4 * T);
#pragma unroll
                for (int i = 0; i < 4; ++i) bias[4 * T + i] = relb[(mt[i] >> 16) * 16 + hq]; }
            if (!lastc) { att_gather32(CKV8 + (size_t)b * SEQ * RK, list + 32 * (sc + 1), kvbuf + (par ^ 1) * 8192, lane); asm volatile("s_waitcnt vmcnt(8)" ::: "memory"); }
            else if (has_next) { att_gather32(CKV8 + (size_t)bn * SEQ * RK, lists + (cur ^ 1) * 256, kvbuf + (par ^ 1) * 8192, lane); asm volatile("s_waitcnt vmcnt(8)" ::: "memory"); }
            else { asm volatile("s_waitcnt vmcnt(0)" ::: "memory"); }
            f32x4 st0 = (f32x4){0.f, 0.f, 0.f, 0.f}, st1 = st0;
            { long kr[8];
              RDK8("0", kr, qa);
#pragma unroll
              for (int ks = 0; ks < 8; ++ks) st0 = __builtin_amdgcn_mfma_f32_16x16x32_fp8_fp8(kr[ks], bq[ks], st0, 0, 0, 0);
              RDK8("1024", kr, qa);
#pragma unroll
              for (int ks = 0; ks < 8; ++ks) st1 = __builtin_amdgcn_mfma_f32_16x16x32_fp8_fp8(kr[ks], bq[ks], st1, 0, 0, 0); }
            if (lastc && has_next) { const unsigned char* qp = BIG + rown * 8192 + hq * 256 + 8 * g;
#pragma unroll
                for (int ks = 0; ks < 8; ++ks) bq[ks] = *(const long*)(qp + 32 * ks); }
            float lg[8]; float cmax;
#pragma unroll
            for (int i = 0; i < 4; ++i) { lg[i] = st0[i] * (1.0f / 64.0f) + bias[i]; lg[4 + i] = st1[i] * (1.0f / 64.0f) + bias[4 + i]; }
            if (32 * sc + 32 > cnt) {
#pragma unroll
                for (int i = 0; i < 4; ++i) { const int s0 = 32 * sc + 8 * g + i; lg[i] = (s0 < cnt) ? lg[i] : NEGF; lg[4 + i] = (s0 + 4 < cnt) ? lg[4 + i] : NEGF; } }
            cmax = fmaxf(fmaxf(fmaxf(lg[0], lg[1]), fmaxf(lg[2], lg[3])), fmaxf(fmaxf(lg[4], lg[5]), fmaxf(lg[6], lg[7])));
            cmax = rows_max(cmax);
            if (__ballot(cmax > mref + 3.0f) != 0ull) {
                const float mnew = fmaxf(mref, cmax), scl = fast_exp(mref - mnew);
                lsum *= scl;
#pragma unroll
                for (int nt = 0; nt < 16; ++nt) O[nt] = O[nt] * scl;
                mref = mnew;
            }
            float p[8];
#pragma unroll
            for (int i = 0; i < 8; ++i) { p[i] = fast_exp(lg[i] - mref); lsum += p[i]; }
            int pw0 = 0, pw1 = 0;
            pw0 = __builtin_amdgcn_cvt_pk_fp8_f32(p[0] * 16.0f, p[1] * 16.0f, pw0, false); pw0 = __builtin_amdgcn_cvt_pk_fp8_f32(p[2] * 16.0f, p[3] * 16.0f, pw0, true);
            pw1 = __builtin_amdgcn_cvt_pk_fp8_f32(p[4] * 16.0f, p[5] * 16.0f, pw1, false); pw1 = __builtin_amdgcn_cvt_pk_fp8_f32(p[6] * 16.0f, p[7] * 16.0f, pw1, true);
            const long pk = (long)(((unsigned long long)(unsigned)pw1 << 32) | (unsigned long long)(unsigned)pw0);
            {
#define TR8B(r, a, o) asm volatile("ds_read_b64_tr_b8 %0, %8\n\tds_read_b64_tr_b8 %1, %9\n\tds_read_b64_tr_b8 %2, %10\n\tds_read_b64_tr_b8 %3, %11\n\t" \
                                   "ds_read_b64_tr_b8 %4, %12\n\tds_read_b64_tr_b8 %5, %13\n\tds_read_b64_tr_b8 %6, %14\n\tds_read_b64_tr_b8 %7, %15\n\ts_waitcnt lgkmcnt(0)" \
                                   : "=&v"(r[0]), "=&v"(r[1]), "=&v"(r[2]), "=&v"(r[3]), "=&v"(r[4]), "=&v"(r[5]), "=&v"(r[6]), "=&v"(r[7]) \
                                   : "v"(a[o + 0]), "v"(a[o + 1]), "v"(a[o + 2]), "v"(a[o + 3]), "v"(a[o + 4]), "v"(a[o + 5]), "v"(a[o + 6]), "v"(a[o + 7]) : "memory")
                long kt[8];
                TR8B(kt, ta, 0);
#pragma unroll
                for (int e = 0; e < 8; ++e) O[e] = __builtin_amdgcn_mfma_f32_16x16x32_fp8_fp8(kt[e], pk, O[e], 0, 0, 0);
                TR8B(kt, ta, 8);
#pragma unroll
                for (int e = 0; e < 8; ++e) O[8 + e] = __builtin_amdgcn_mfma_f32_16x16x32_fp8_fp8(kt[e], pk, O[8 + e], 0, 0, 0);
#undef TR8B
            }
            par ^= 1;
#pragma unroll
            for (int e = 0; e < 8; ++e) { qa[e] ^= 8192u; ta[e] ^= 8192u; ta[8 + e] ^= 8192u; }
        }
        lsum = rows_sum(lsum);
        const float inv = 1.0f / (16.0f * lsum);
        bf16_t* op = (bf16_t*)(BIG + row * 8192) + hq * 256 + 4 * g;
#pragma unroll
        for (int nt = 0; nt < 16; ++nt) { const f32x4 o = O[nt] * inv; u32x2 wv; wv.x = cvt_pk_bf16(o[0], o[1]); wv.y = cvt_pk_bf16(o[2], o[3]); *(u32x2*)(op + 16 * nt) = wv; }
        q = qn; b = bn; t = tn; row = rown; cnt = cntn;
    }
}

constexpr int SW_KP = 144, SW_VP = 520;
constexpr int SW_K_OFF = 0, SW_V_OFF = 256 * SW_KP, SW_TB_OFF = SW_V_OFF + 64 * SW_VP;
__device__ __forceinline__ void swa_phase(const bf16_t* QKV, bf16_t* OB, const float* relb, const float* sinks, LAS unsigned char* lds, int G) {
    int tid = tid_now();
    const int lane = tid & 63, wave = __builtin_amdgcn_readfirstlane(tid >> 6);
    const int h = lane >> 5, n = lane & 31;
    LAS float* tb = (LAS float*)(lds + SW_TB_OFF);
    for (int u = blockIdx.x; u < BATCH * 16 * KVH; u += G) {
        const int b = u >> 5, nb = (u >> 1) & 15, kvh = u & 1;
        const size_t rowb = (size_t)b * SEQ;
        __syncthreads();
#pragma unroll
        for (int e = 0; e < 4; ++e) { const int id = tid + NTHR * e, j = id >> 3, ch = id & 7; const int pos = (nb - 1) * WIN + j;
            u32x4 kv = (u32x4){0u, 0u, 0u, 0u}, vv = (u32x4){0u, 0u, 0u, 0u};
            if (pos >= 0) { const bf16_t* sp = QKV + (rowb + pos) * B_IN + 1024 + kvh * 64 + ch * 8; kv = *(const u32x4*)sp; vv = *(const u32x4*)(sp + 128); }
            *(LAS u32x4*)(lds + SW_K_OFF + j * SW_KP + ch * 16) = kv;
            LAS bf16_t* vt = (LAS bf16_t*)(lds + SW_V_OFF + (ch * 8) * SW_VP + j * 2);
#pragma unroll
            for (int q = 0; q < 4; ++q) { vt[(2 * q) * (SW_VP / 2)] = (bf16_t)(vv[q] & 0xffffu); vt[(2 * q + 1) * (SW_VP / 2)] = (bf16_t)(vv[q] >> 16); } }
        for (int i = tid; i < GQ * WIN; i += NTHR) { const int gg = i >> 7, dist = i & 127; tb[i] = relb[t5_bucket(dist) * NH + kvh * GQ + gg]; }
        __syncthreads();
        const int qh = kvh * GQ + wave; const float sink = sinks[qh];
        for (int rt = 0; rt < 4; ++rt) {
            const size_t qrow = rowb + nb * WIN + 32 * rt + n;
            bf16x8 bq[4];
#pragma unroll
            for (int ks = 0; ks < 4; ++ks) bq[ks] = *(const bf16x8*)(QKV + qrow * B_IN + qh * 64 + 16 * ks + 8 * h);
            f32x16 s[5];
#pragma unroll
            for (int ct = 0; ct < 5; ++ct) {
#pragma unroll
                for (int i = 0; i < 16; ++i) s[ct][i] = 0.f;
#pragma unroll
                for (int ks = 0; ks < 4; ++ks) { const bf16x8 a = *(const LAS bf16x8*)(lds + SW_K_OFF + (32 * (rt + ct) + n) * SW_KP + (2 * ks + h) * 16);
                    s[ct] = __builtin_amdgcn_mfma_f32_32x32x16_bf16(a, bq[ks], s[ct], 0, 0, 0); } }
            const int qi = 32 * rt + n;
            float mx = NEGF;
#pragma unroll
            for (int ct = 0; ct < 5; ++ct)
#pragma unroll
                for (int i = 0; i < 16; ++i) { const int j = 32 * (rt + ct) + (i & 3) + 8 * (i >> 2) + 4 * h; const int dist = qi + WIN - j;
                    const bool ok = (dist >= 0) && (dist < WIN) && (nb > 0 || j >= WIN);
                    const float v = ok ? s[ct][i] * 0.125f + tb[wave * WIN + (dist & 127)] : NEGF; s[ct][i] = v; mx = fmaxf(mx, v); }
            { const u32x2 r_ = __builtin_amdgcn_permlane32_swap(__float_as_uint(mx), __float_as_uint(mx), false, false); mx = fmaxf(__uint_as_float(r_.x), __uint_as_float(r_.y)); } mx = fmaxf(mx, sink);
            float sum = 0.f;
#pragma unroll
            for (int ct = 0; ct < 5; ++ct)
#pragma unroll
                for (int i = 0; i < 16; ++i) { const float p = fast_exp(s[ct][i] - mx); s[ct][i] = p; sum += p; }
            { const u32x2 r_ = __builtin_amdgcn_permlane32_swap(__float_as_uint(sum), __float_as_uint(sum), false, false); sum = __uint_as_float(r_.x) + __uint_as_float(r_.y); } sum += fast_exp(sink - mx);
            f32x16 o[2];
#pragma unroll
            for (int dt = 0; dt < 2; ++dt)
#pragma unroll
                for (int i = 0; i < 16; ++i) o[dt][i] = 0.f;
#pragma unroll
            for (int ct = 0; ct < 5; ++ct)
#pragma unroll
                for (int s2 = 0; s2 < 2; ++s2) {
                    u32x4 pw; pw.x = cvt_pk_bf16(s[ct][8 * s2 + 0], s[ct][8 * s2 + 1]); pw.y = cvt_pk_bf16(s[ct][8 * s2 + 2], s[ct][8 * s2 + 3]);
                    pw.z = cvt_pk_bf16(s[ct][8 * s2 + 4], s[ct][8 * s2 + 5]); pw.w = cvt_pk_bf16(s[ct][8 * s2 + 6], s[ct][8 * s2 + 7]);
                    const bf16x8 pb = __builtin_bit_cast(bf16x8, pw);
#pragma unroll
                    for (int dt = 0; dt < 2; ++dt) { const LAS unsigned char* vp = lds + SW_V_OFF + (32 * dt + n) * SW_VP + (32 * (rt + ct) + 16 * s2 + 4 * h) * 2;
                        const u32x2 v0 = *(const LAS u32x2*)vp, v1 = *(const LAS u32x2*)(vp + 16);
                        u32x4 va; va.x = v0.x; va.y = v0.y; va.z = v1.x; va.w = v1.y;
                        o[dt] = __builtin_amdgcn_mfma_f32_32x32x16_bf16(__builtin_bit_cast(bf16x8, va), pb, o[dt], 0, 0, 0); }
                }
            const float inv = 16.0f / sum;
            unsigned char* op = (unsigned char*)OB + qrow * D + qh * 64 + 4 * h;
#pragma unroll
            for (int dt = 0; dt < 2; ++dt)
#pragma unroll
                for (int i4 = 0; i4 < 4; ++i4) { int wv = 0;
                    wv = __builtin_amdgcn_cvt_pk_fp8_f32(__builtin_amdgcn_fmed3f(o[dt][4 * i4] * inv, -448.f, 448.f), __builtin_amdgcn_fmed3f(o[dt][4 * i4 + 1] * inv, -448.f, 448.f), wv, false);
                    wv = __builtin_amdgcn_cvt_pk_fp8_f32(__builtin_amdgcn_fmed3f(o[dt][4 * i4 + 2] * inv, -448.f, 448.f), __builtin_amdgcn_fmed3f(o[dt][4 * i4 + 3] * inv, -448.f, 448.f), wv, true);
                    *(unsigned*)(op + 32 * dt + 8 * i4) = (unsigned)wv; }
        }
    }
}

struct Args { const float* in[23]; float* out; unsigned char* ws; };
#define CAS __attribute__((address_space(4)))
__device__ __forceinline__ const CAS Args* kargs() { const CAS Args* p = (const CAS Args*)__builtin_amdgcn_kernarg_segment_ptr(); asm volatile("" : "+s"(p)); return p; }

__global__ void __launch_bounds__(NTHR, 2) trunk_fwd(Args args_by_value) {
    LAS unsigned char* lds = (LAS unsigned char*)lds_raw;
    const int tid = threadIdx.x;
    volatile LAS unsigned* MISC = (volatile LAS unsigned*)(lds + LDS_MISC_OFF);
    for (int u = tid; u < (LDS_BYTES - LDS_MISC_OFF) / 4; u += NTHR) MISC[u] = 0u;
    __syncthreads();
    if ((tid & 63) == 0) MISC[64 + hw_slot()] = (unsigned)(tid >> 6);
    { const CAS Args* A = kargs(); (void)xcd_barrier_post((unsigned*)(A->ws + WS_CTL) + 4096, MISC + 8);
      if (tid == 0) { const unsigned x = xb_xcc_id(); MISC[16] = x; MISC[17] = xb_add((unsigned*)(A->ws + WS_CTL) + 8192 + 64 * x, 1u); } }
#define XCD_RANK(xcd, rank) do { const CAS Args* A_ = kargs(); const unsigned* cw_ = (const unsigned*)(A_->ws + WS_CTL) + 4096; bool ok_ = (gridDim.x & 7) == 0; \
        for (int j_ = 0; j_ < 16; ++j_) { const unsigned c_ = __hip_atomic_load(cw_ + XB_XCNT(j_), __ATOMIC_RELAXED, __HIP_MEMORY_SCOPE_AGENT); ok_ = ok_ && (c_ == (j_ < 8 ? gridDim.x >> 3 : 0u)); } \
        const unsigned hx_ = MISC[16], hr_ = MISC[17]; ok_ = ok_ && hx_ < 8u && hr_ < (gridDim.x >> 3); \
        xcd = ok_ ? (int)hx_ : (int)(blockIdx.x & 7); rank = ok_ ? (int)hr_ : (int)(blockIdx.x >> 3); } while (0)
#define GB() do { const CAS Args* A_ = kargs(); XcdBarrier b_; b_.bar = (unsigned*)(A_->ws + WS_CTL) + 4096; b_.x = xb_xcc_id(); b_.st = MISC + 8; xcd_barrier(b_); } while (0)

    { const CAS Args* A = kargs(); Ptrs P;
#pragma unroll
      for (int i = 0; i < 23; ++i) P.in[i] = A->in[i];
      P.out = A->out; P.ws = A->ws;
      p0_prologue(P, lds, (int)gridDim.x); }
    GB();
    { const CAS Args* A = kargs(); Ptrs P;
#pragma unroll
      for (int i = 0; i < 23; ++i) P.in[i] = A->in[i];
      P.out = A->out; P.ws = A->ws;
      pre_phase(P, lds, (int)gridDim.x); }
    GB();

    for (int l = 0; l < DEPTH; ++l) {
        const bool isA = (l & 1) == 0;
        {
            const CAS Args* A = kargs(); const int G = gridDim.x, j = l >> 1; unsigned char* ws = A->ws;
            const unsigned long long* SS = (const unsigned long long*)(ws + WS_SS) + (size_t)(2 * l) * M;
            if (isA) {
                unsigned char* wa = ws + WS_WA + (size_t)j * WA_STRIDE;
                pg8::Gemm g{(const bf16_t*)(ws + WS_XG), (const bf16_t*)(wa + WINA_OFF), D, D, D, 0, 0}; pg8::StaticOrder S; S.init(M, 2048, G, (int)blockIdx.x);
                pg8::EpiInA E{(bf16_t*)(ws + WS_QO), (bf16_t*)(ws + WS_CKV), (bf16_t*)(ws + WS_QI), (bf16_t*)(ws + WS_KIN), (float*)(ws + WS_WI), A->in[I_AIKG] + j * IDIM, A->in[I_AIKB] + j * IDIM,
                                (const float*)(ws + WS_SHW + SHW_A) + (size_t)j * BATCH * 2048, SS};
                pg8::gemm_phase<pg8::EpiInA, true, 3>(lds, g, S, E);
            } else {
                unsigned char* wb = ws + WS_WB + (size_t)j * WB_STRIDE;
                pg8::Gemm g{(const bf16_t*)(ws + WS_XG), (const bf16_t*)(wb + WINB_OFF), D, D, D, 0, 0}; pg8::StaticOrder S; S.init(M, B_IN, G, (int)blockIdx.x);
                pg8::EpiBf16Plain<true> E{(bf16_t*)(ws + WS_QKV), B_IN, (const float*)(ws + WS_SHW + SHW_B) + (size_t)j * BATCH * B_IN, B_IN, SS};
                pg8::gemm_phase<pg8::EpiBf16Plain<true>, true, 3>(lds, g, S, E);
            }
        }
        GB();
        if (isA) {
            { const CAS Args* A = kargs(); const int G = gridDim.x, j = l >> 1; unsigned char* ws = A->ws;
              unsigned char* wa = ws + WS_WA + (size_t)j * WA_STRIDE;
              pg8::Gemm g{(const bf16_t*)(ws + WS_QO), (const bf16_t*)(wa + WQA_OFF), D, 128, 128, 1, 128}; pg8::StaticOrder S; S.init(M, 4096, G, (int)blockIdx.x);
              pg8::EpiFp8 E{ws + WS_BIG, 8192};
              pg8::gemm_phase<pg8::EpiFp8, true>(lds, g, S, E); }
            { const CAS Args* A = kargs(); const int G = gridDim.x; unsigned char* ws = A->ws;
              const int tid2 = tid_now();
              const int lane = tid2 & 63, wave = __builtin_amdgcn_readfirstlane(tid2 >> 6);
              const bf16_t* CKV = (const bf16_t*)(ws + WS_CKV); unsigned* CKV8 = (unsigned*)(ws + WS_CKV8);
              const int gw = blockIdx.x * NWAVES + wave, NGW = G * NWAVES;
              for (int row = gw; row < M; row += NGW) {
                  const u32x2 v = *((const u32x2*)(CKV + (size_t)row * RK) + lane);
                  const float a0 = __uint_as_float(v.x << 16), a1 = __uint_as_float(v.x & 0xffff0000u), a2 = __uint_as_float(v.y << 16), a3 = __uint_as_float(v.y & 0xffff0000u);
                  const float ss = wave_sum((a0 * a0 + a1 * a1) + (a2 * a2 + a3 * a3));
                  const float rs = 1.0f / sqrtf(ss * (1.0f / RK) + EPS);
                  int w = 0; w = __builtin_amdgcn_cvt_pk_fp8_f32(a0 * rs, a1 * rs, w, false); w = __builtin_amdgcn_cvt_pk_fp8_f32(a2 * rs, a3 * rs, w, true);
                  CKV8[(size_t)row * (RK / 4) + lane] = (unsigned)w;
              } }
            { const CAS Args* A = kargs(); const int G = gridDim.x; unsigned char* ws = A->ws;
              const int tid2 = tid_now();
              const int lane = tid2 & 63, wave = __builtin_amdgcn_readfirstlane(tid2 >> 6);
              int xcd, rank; XCD_RANK(xcd, rank); xcd = __builtin_amdgcn_readfirstlane(xcd); rank = __builtin_amdgcn_readfirstlane(rank);
              const int wx = rank * NWAVES + wave, nwx = (G >> 3) * NWAVES;
              const int nsteps = (1024 + nwx - 1) / nwx;
              for (int st = 0; st < nsteps; ++st) {
                  const int q = wx + st * nwx; const bool active = q < 1024;
                  const int qc = active ? q : (rank * NWAVES + st * nwx < 1024 ? rank * NWAVES + st * nwx : 1023);
                  const int bl = qc >> 9, u = qc & 255, hiq = (qc >> 8) & 1, b = 2 * xcd + bl;
                  const int tg = hiq ? 511 - u : u;
                  idx_task((const bf16_t*)(ws + WS_QI), (const bf16_t*)(ws + WS_KIN), (const float*)(ws + WS_WI), (unsigned*)(ws + WS_SEL), lds, b, tg, lane, wave, active, hiq ? 2 : 1);
              }
              __syncthreads(); }
        } else {
            const CAS Args* A = kargs(); const int G = gridDim.x, j = l >> 1; unsigned char* ws = A->ws;
            swa_phase((const bf16_t*)(ws + WS_QKV), (bf16_t*)(ws + WS_OB), A->in[I_RELB], A->in[I_BSINK] + j * NH, lds, G);
        }
        GB();
        if (isA) {
            { const CAS Args* A = kargs(); const int G = gridDim.x; unsigned char* ws = A->ws;
              const int tid2 = tid_now();
              const int lane = tid2 & 63, wave = __builtin_amdgcn_readfirstlane(tid2 >> 6);
              LAS float* relb = (LAS float*)(lds + 147456);
              LAS unsigned* btab = (LAS unsigned*)(lds + 147456 + 2048);
              for (int i = tid2; i < NBUCK * NH; i += NTHR) relb[i] = A->in[I_RELB][i];
              for (int i = tid2; i < 132; i += NTHR) btab[i] = (unsigned)t5_bucket(i);
              __syncthreads();
              int xcd, rank; XCD_RANK(xcd, rank); xcd = __builtin_amdgcn_readfirstlane(xcd); rank = __builtin_amdgcn_readfirstlane(rank);
              const int wx = rank * NWAVES + wave, nwx = (G >> 3) * NWAVES;
              att_wave(ws + WS_CKV8, (const unsigned*)(ws + WS_SEL), ws + WS_BIG, lds + wave * 16384, (LAS unsigned*)(lds + 131072 + wave * 2048), relb, btab, xcd, wx, nwx, lane); }
            GB();
            { const CAS Args* A = kargs(); const int G = gridDim.x, j = l >> 1; unsigned char* ws = A->ws;
              unsigned char* wa = ws + WS_WA + (size_t)j * WA_STRIDE;
              pg8::Gemm g{(const bf16_t*)(ws + WS_BIG), (const bf16_t*)(wa + WUV_OFF), 4096, D, D, 0, 1024}; pg8::StaticOrder S; S.init(M, D, G, (int)blockIdx.x);
              pg8::EpiFp8 E{ws + WS_OB, D};
              pg8::gemm_phase<pg8::EpiFp8, true>(lds, g, S, E); }
            GB();
        }
        {
            const CAS Args* A = kargs(); const int G = gridDim.x, j = l >> 1; unsigned char* ws = A->ws;
            const float* modl = (const float*)(ws + WS_MOD) + (size_t)l * BATCH * 6144;
            const bf16_t* Ain = (const bf16_t*)(ws + WS_OB);
            const bf16_t* Bw = (const bf16_t*)(isA ? ws + WS_WA + (size_t)j * WA_STRIDE + WOUTA_OFF : ws + WS_WB + (size_t)j * WB_STRIDE + WOUTB_OFF);
            w8_build((const bf16_t*)(ws + WS_W + (size_t)l * W_LAYER + W13_OFF), A->in[I_GFFN] + l * D, modl + 4096, ws + WS_W8, (float*)(ws + WS_CW), lds, G);
            pg8::Gemm g{Ain, Bw, D / 2, D / 2, D / 2, 0, 0, 0}; pg8::StaticOrder S; S.init(M, D, G, (int)blockIdx.x);
            pg8::EpiResid<true> E{(const bf16_t*)A->out, (bf16_t*)A->out, modl + 2048, isA ? nullptr : A->in[I_BBOUT] + j * D,
                            (bf16_t*)(ws + WS_XG), nullptr, nullptr, (unsigned long long*)(ws + WS_SS) + (size_t)(2 * l + 1) * M, (const unsigned long long*)(ws + WS_SS) + (size_t)(2 * l) * M};
            pg8::gemm_phase<pg8::EpiResid<true>, true, 2>(lds, g, S, E);
        }
        GB();
        {
            const CAS Args* A = kargs(); const int G = gridDim.x; unsigned char* ws = A->ws;
            unsigned char* wl = ws + WS_W + (size_t)l * W_LAYER;
            pg8::Gemm g{(const bf16_t*)(ws + WS_XG), (const bf16_t*)(ws + WS_W8), D / 2, D / 2, D / 2, 0, 0, (unsigned)W8_BATCH}; pg8::StaticOrder S; S.init(M, 2 * DFF, G, (int)blockIdx.x);
            pg8::EpiSwiGLU E{(bf16_t*)(ws + WS_HFF), (const float*)(ws + WS_SHW + SHW_F) + (size_t)l * BATCH * 2 * DFF, (const unsigned long long*)(ws + WS_SS) + (size_t)(2 * l + 1) * M,
                             (const float*)(ws + WS_CW), (const unsigned long long*)(ws + WS_SS) + (size_t)(2 * l) * M};
            pg8::gemm_phase<pg8::EpiSwiGLU, true, 1>(lds, g, S, E);
        }
        GB();
        {
            const CAS Args* A = kargs(); const int G = gridDim.x; unsigned char* ws = A->ws;
            unsigned char* wl = ws + WS_W + (size_t)l * W_LAYER;
            const float* modl = (const float*)(ws + WS_MOD) + (size_t)l * BATCH * 6144;
            const int ln = l + 1 < DEPTH ? l + 1 : l;
            pg8::Gemm g{(const bf16_t*)(ws + WS_HFF), (const bf16_t*)(wl + W2_OFF), DFF, DFF, DFF, 0, 0}; pg8::StaticOrder S; S.init(M, D, G, (int)blockIdx.x);
            const bool lastl = (l + 1 == DEPTH);
            pg8::EpiResid<false> E{(const bf16_t*)A->out, lastl ? (bf16_t*)(ws + WS_XG) : (bf16_t*)A->out, modl + 5120, nullptr,
                            l + 1 < DEPTH ? (bf16_t*)(ws + WS_XG) : nullptr, A->in[I_GMIX] + ln * D, (const float*)(ws + WS_MOD) + (size_t)ln * BATCH * 6144 + 1024, (unsigned long long*)(ws + WS_SS) + (size_t)(2 * l + 2) * M, nullptr};
            pg8::gemm_phase<pg8::EpiResid<false>, true>(lds, g, S, E);
        }
        GB();
    }
    { const CAS Args* A = kargs(); final_norm_phase((const bf16_t*)(A->ws + WS_XG), A->out, A->in[I_GFIN], (int)gridDim.x); }
#undef GB
}

extern "C" void kernel_launch(void* const* d_in, const int* in_sizes, int n_in, void* d_out, int out_size, void* d_ws, size_t ws_size, hipStream_t stream) {
    static int grid = 0;
    if (grid == 0) {
        if (n_in != 23 || out_size != M * D || ws_size < WS_END) { fprintf(stderr, "kernel_launch: unexpected shapes (n_in %d out %d ws %zu)\n", n_in, out_size, ws_size); grid = -1; return; }
        int dev = 0, cus = 0, per_cu = 0;
        if (hipGetDevice(&dev) != hipSuccess || hipDeviceGetAttribute(&cus, hipDeviceAttributeMultiprocessorCount, dev) != hipSuccess) { grid = -1; return; }
        if (hipFuncSetAttribute((const void*)trunk_fwd, hipFuncAttributeMaxDynamicSharedMemorySize, LDS_BYTES) != hipSuccess) { fprintf(stderr, "kernel_launch: hipFuncSetAttribute failed\n"); grid = -1; return; }
        if (hipOccupancyMaxActiveBlocksPerMultiprocessor(&per_cu, (const void*)trunk_fwd, NTHR, LDS_BYTES) != hipSuccess || per_cu < 1) { fprintf(stderr, "kernel_launch: occupancy query says %d\n", per_cu); }
        (void)hipGetLastError();
        grid = cus;
    }
    if (grid < 0) return;
    (void)hipMemsetAsync((char*)d_ws + WS_CTL, 0, CTL_ZERO_BYTES, stream);
    Args a{};
    for (int i = 0; i < 23; ++i) a.in[i] = (const float*)d_in[i];
    a.out = (float*)d_out; a.ws = (unsigned char*)d_ws;
    hipLaunchKernelGGL(trunk_fwd, dim3(grid), dim3(NTHR), LDS_BYTES, stream, a);
    const hipError_t le = hipPeekAtLastError();
    if (le != hipSuccess) fprintf(stderr, "kernel_launch: launch failed: %s\n", hipGetErrorName(le));
}
```

```cpp
#include <hip/hip_runtime.h>
#include <cstdio>
#include <cstdint>


#define GAS __attribute__((address_space(1)))
#define LAS __attribute__((address_space(3)))
typedef unsigned short bf16_t;
typedef short bf16x8 __attribute__((ext_vector_type(8)));
typedef short s16x4 __attribute__((ext_vector_type(4)));
typedef float f32x4 __attribute__((ext_vector_type(4)));
typedef float f32x2 __attribute__((ext_vector_type(2)));
typedef float f32x16 __attribute__((ext_vector_type(16)));
typedef unsigned u32x4 __attribute__((ext_vector_type(4)));
typedef unsigned u32x2 __attribute__((ext_vector_type(2)));
typedef int i32x4 __attribute__((ext_vector_type(4)));
typedef int i32x8 __attribute__((ext_vector_type(8)));

constexpr int D = 1024, BATCH = 16, SEQ = 2048, M = BATCH * SEQ, DEPTH = 4;
constexpr int NH = 16, HD = 64, RK = 256, IH = 8, IDIM = 64, TOPK = 256;
constexpr int KVH = 2, GQ = 8, WIN = 128, NBUCK = 32, DFF = 2816;
constexpr int A_IN = 1864, B_IN = 1280;
constexpr float EPS = 1e-6f;
constexpr float NEGF = -1e30f;
constexpr int NWAVES = 8, NTHR = 512;

constexpr size_t MiB = 1u << 20;
constexpr size_t WS_CTL = 0, CTL_ZERO_BYTES = 4 * MiB;
constexpr size_t WS_SS = 1 * MiB;
constexpr size_t WS_W = 4 * MiB;
constexpr size_t W_LAYER = 17301504;
constexpr size_t W13_OFF = 0, W2_OFF = 11 * MiB;
constexpr size_t WS_WA = WS_W + 4 * W_LAYER;
constexpr size_t WA_STRIDE = 10 * MiB, WINA_OFF = 0, WQA_OFF = 4 * MiB, WUV_OFF = 6 * MiB, WOUTA_OFF = 8 * MiB;
constexpr size_t WS_WB = WS_WA + 2 * WA_STRIDE;
constexpr size_t WB_STRIDE = 4718592, WINB_OFF = 0, WOUTB_OFF = 2621440;
constexpr size_t WS_MOD = 100 * MiB;
constexpr size_t WS_SHW = WS_MOD + 1536 * 1024;
constexpr size_t SHW_A = 0, SHW_B = 2 * 16 * 2048 * 4, SHW_F = SHW_B + 2 * 16 * 1280 * 4;
constexpr size_t WS_XG = 104 * MiB;
constexpr size_t WS_BIG = 104 * MiB;
constexpr size_t WS_HFF = 168 * MiB;
constexpr size_t WS_QO = 360 * MiB;
constexpr size_t WS_CKV = 424 * MiB;
constexpr size_t WS_QI = 440 * MiB;
constexpr size_t WS_KIN = 472 * MiB;
constexpr size_t WS_WI = 476 * MiB;
constexpr size_t WS_SEL = 477 * MiB;
constexpr size_t WS_CKV8 = 486 * MiB;
constexpr size_t WS_QKV = 360 * MiB;
constexpr size_t WS_OB = 440 * MiB;
constexpr size_t WS_W8 = 344 * MiB;
constexpr size_t W8_BATCH = (size_t)2 * 2816 * 1024;
constexpr size_t WS_CW = 504 * MiB;
constexpr size_t WS_W8B = 136 * MiB;
constexpr size_t WS_CWB = WS_CW + 512 * 1024;
constexpr size_t WS_END = 512 * MiB;

constexpr int RING_BYTES = 131072;
constexpr int LDS_MISC_OFF = 155648;
constexpr int LDS_BYTES = 156672;

extern __shared__ __attribute__((aligned(16))) unsigned char lds_raw[];
constexpr int LDS_WAVE_TAB = LDS_MISC_OFF + 256;
__device__ __forceinline__ int lane_now() { int l; asm volatile("v_mbcnt_lo_u32_b32 %0, -1, 0\n\tv_mbcnt_hi_u32_b32 %0, -1, %0" : "=v"(l)); return l; }
__device__ __forceinline__ unsigned hw_slot() { return (unsigned)__builtin_amdgcn_s_getreg((5 << 11) | 4) & 63u; }
__device__ __forceinline__ int wave_now() { return __builtin_amdgcn_readfirstlane((int)*(volatile LAS unsigned*)((LAS unsigned char*)lds_raw + LDS_WAVE_TAB + 4 * hw_slot())); }
__device__ __forceinline__ int tid_now() { return wave_now() * 64 + lane_now(); }
#define RLX_AGENT __ATOMIC_RELAXED, __HIP_MEMORY_SCOPE_AGENT
__device__ __forceinline__ unsigned cvt_pk_bf16(float lo, float hi) { unsigned r; asm volatile("v_cvt_pk_bf16_f32 %0, %1, %2" : "=v"(r) : "v"(lo), "v"(hi)); return r; }
typedef _Float16 h16x2 __attribute__((ext_vector_type(2)));
typedef _Float16 h16x8 __attribute__((ext_vector_type(8)));
__device__ __forceinline__ unsigned cvt_pk_f16(float lo, float hi) { return __builtin_bit_cast(unsigned, __builtin_convertvector((f32x2){lo, hi}, h16x2)); }
__device__ __forceinline__ f32x2 unpk_f16(unsigned u) { return __builtin_convertvector(__builtin_bit_cast(h16x2, u), f32x2); }
__device__ __forceinline__ float bf2f(bf16_t b) { return __uint_as_float(((unsigned)b) << 16); }
__device__ __forceinline__ float half_sum_f(float v);
__device__ __forceinline__ float rows_sum(float x);
__device__ __forceinline__ float wave_sum(float v) {
    v = half_sum_f(v);
    const u32x2 r = __builtin_amdgcn_permlane32_swap(__float_as_uint(v), __float_as_uint(v), false, false);
    return __uint_as_float(r.x) + __uint_as_float(r.y);
}
__device__ __forceinline__ float fast_exp(float x) { return __builtin_amdgcn_exp2f(x * 1.4426950408889634f); }
__device__ __forceinline__ float silu_f(float x) { return x * __builtin_amdgcn_rcpf(1.0f + fast_exp(-x)); }
__device__ __forceinline__ int t5_bucket(int d) {
    if (d < 16) return d;
    int b = 16;
    b += (d >= 19); b += (d >= 21); b += (d >= 24); b += (d >= 27); b += (d >= 31); b += (d >= 35); b += (d >= 40); b += (d >= 46);
    b += (d >= 52); b += (d >= 59); b += (d >= 67); b += (d >= 77); b += (d >= 87); b += (d >= 99); b += (d >= 113);
    return b;
}

#define XB_TMO      128
#define XB_XCNT(j)  (256  + 64 * (j))
#define XB_XSUB(j)  (1280 + 64 * (j))
#define XB_XGEN(j)  (2304 + 64 * (j))
#define XB_TOP      3328
#define XB_TOPGEN   3392
#define XCD_BAR_WORDS 3456
#define XB_SPIN_CAP (1u << 22)

__device__ __forceinline__ unsigned xb_ld(unsigned* p)              { return __hip_atomic_load(p, __ATOMIC_RELAXED, __HIP_MEMORY_SCOPE_AGENT); }
__device__ __forceinline__ unsigned xb_add(unsigned* p, unsigned v) { return __hip_atomic_fetch_add(p, v, __ATOMIC_RELAXED, __HIP_MEMORY_SCOPE_AGENT); }
__device__ __forceinline__ unsigned xb_xcc_id() { return (unsigned)__builtin_amdgcn_s_getreg((3 << 11) | 20) & 0xFu; }
#define XB_SPIN(cond, bar) do { unsigned _sp = 0; while (cond) { __builtin_amdgcn_s_sleep(1); \
    if ((++_sp & 255u) == 0u) { if (xb_ld(&(bar)[XB_TMO])) break; if (_sp > XB_SPIN_CAP) { atomicAdd(&(bar)[XB_TMO], 1u); break; } } } } while (0)

struct XcdBarrier { unsigned* bar; unsigned x; volatile LAS unsigned* st; };

__device__ __forceinline__ XcdBarrier xcd_barrier_post(unsigned* bar, volatile LAS unsigned* st) {
    XcdBarrier b; b.bar = bar; b.x = xb_xcc_id(); b.st = st;
    if (threadIdx.x == 0) (void)xb_add(&bar[XB_XCNT(b.x)], 1u);
    return b;
}
__device__ __forceinline__ void xcd_barrier_complete(unsigned* bar, unsigned x, unsigned& nloc, unsigned& nx) {
    const unsigned G = gridDim.x * gridDim.y * gridDim.z;
    unsigned sum, cnt, mine, sp = 0u;
    for (;;) {
        sum = 0u; cnt = 0u; mine = 0u;
#pragma unroll
        for (unsigned j = 0; j < 16; ++j) { const unsigned c = xb_ld(&bar[XB_XCNT(j)]); sum += c; cnt += (c > 0u) ? 1u : 0u; mine = (j == x) ? c : mine; }
        if (sum == G) break;
        __builtin_amdgcn_s_sleep(1);
        if ((++sp & 255u) == 0u) { if (xb_ld(&bar[XB_TMO])) break; if (sp > XB_SPIN_CAP) { atomicAdd(&bar[XB_TMO], 1u); break; } }
    }
    nloc = mine > 0u ? mine : 1u; nx = cnt > 0u ? cnt : 1u;
}
__device__ __forceinline__ void xcd_barrier(const XcdBarrier& b) {
    asm volatile("s_waitcnt vmcnt(0)" ::: "memory");
    __syncthreads();
    if (tid_now() == 0) {
        unsigned* bar = b.bar;
        __builtin_amdgcn_s_waitcnt(0);
        unsigned nloc = b.st[0], nx = b.st[1];
        if (nloc == 0u) { xcd_barrier_complete(bar, b.x, nloc, nx); b.st[0] = nloc; b.st[1] = nx; }
        const unsigned old = xb_add(&bar[XB_XSUB(b.x)], 1u);
        const unsigned gen = old / nloc;
        if (old + 1u == (gen + 1u) * nloc) {
            __builtin_amdgcn_fence(__ATOMIC_RELEASE, "agent");
            asm volatile("s_waitcnt vmcnt(0)" ::: "memory");
            const unsigned og = xb_add(&bar[XB_TOP], 1u);
            const unsigned tg = og / nx;
            if (og + 1u == (tg + 1u) * nx) xb_add(&bar[XB_TOPGEN], 1u);
            else XB_SPIN(xb_ld(&bar[XB_TOPGEN]) == tg, bar);
            __builtin_amdgcn_fence(__ATOMIC_ACQUIRE, "agent");
            xb_add(&bar[XB_XGEN(b.x)], 1u);
            asm volatile("s_waitcnt vmcnt(0)" ::: "memory");
        } else {
            XB_SPIN(xb_ld(&bar[XB_XGEN(b.x)]) == gen, bar);
            __builtin_amdgcn_fence(__ATOMIC_ACQUIRE, "agent");
            asm volatile("s_waitcnt vmcnt(0)" ::: "memory");
        }
    }
    __syncthreads();
}

namespace pg8 {
constexpr int BM = 256, BK = 64, HALF = 128, HTB = HALF * BK * 2, STAGE_BYTES = 8 * HTB, NXCD = 8, WGM = 8;
__host__ __device__ __forceinline__ int lds_byte(int r, int c) { const int st = (r >> 4) * 2 + (c >> 5), rr = r & 15, cc = c & 31, ob = rr * 64 + cc * 2; return st * 1024 + (ob ^ (((ob >> 9) & 1) << 5)); }
__host__ __device__ __forceinline__ void stage_rc(int b, int& R, int& C) { const int st = b / 1024, sb = b % 1024, swz = sb ^ (((sb >> 9) & 1) << 5); R = (st >> 1) * 16 + swz / 64; C = (st & 1) * 32 + (swz % 64) / 2; }
__host__ __device__ __forceinline__ int perm32(int rho) { const int n = rho >> 4, i = rho & 15; return 8 * (i >> 2) + 4 * n + (i & 3); }

struct Unit { int pm, pn; };
struct Gemm { const bf16_t* A; const bf16_t* Bt; int lda, ldb, K, a_shift, a_mul; unsigned bb; };

struct StaticOrder {
    int nM, nN, nwg, G, c;
    __device__ void init(int M_, int N_, int G_, int c_) { nM = M_ / BM; nN = N_ / BM; nwg = nM * nN; G = G_; c = c_; }
    __device__ bool next(int i, Unit& u) const {
        const long L = (long)i * G + c; if (L >= nwg) return false;
        int wgid = (int)L; { const int q = nwg / NXCD, r = nwg % NXCD, xcd = wgid % NXCD, off = wgid / NXCD; wgid = (xcd < r ? xcd * (q + 1) : r * (q + 1) + (xcd - r) * q) + off; }
        const int nig = WGM * nN, gid = wgid / nig, fm = gid * WGM, gsz = (nM - fm) < WGM ? (nM - fm) : WGM;
        u.pm = fm + ((wgid % nig) % gsz); u.pn = (wgid % nig) / gsz; return true;
    }
};

template <class Epi, bool ALIGN_EPI, int MODE = 0>
__device__ __forceinline__ void gemm_phase(LAS unsigned char* lds, const Gemm g, const StaticOrder& S, const Epi& E) {
    int tid = tid_now();
    const int wid = __builtin_amdgcn_readfirstlane(tid >> 6), lane = tid & 63, wr = wid >> 2, wc = wid & 3, fr = lane & 15, fq = lane >> 4;
    const int K = g.K, nt = K / BK;
    unsigned voffA[2], voffB[2];
#pragma unroll
    for (int i = 0; i < 2; ++i) { int R, C; stage_rc(tid * 16 + i * 8192, R, C); const int Rb = Epi::PERM ? ((R & ~31) + perm32(R & 31)) : R;
        voffA[i] = (unsigned)(R * g.lda + C) * 2u; voffB[i] = (unsigned)(Rb * g.ldb + C) * 2u; }
    const size_t kstep = (size_t)(BK * 2);
    const size_t hstepA = (size_t)HALF * g.lda * 2, hstepB = (size_t)HALF * g.ldb * 2;
    const unsigned ldsw = (unsigned)wid * 1024u;
    const int aoff = lds_byte(wr * 64 + fr, fq * 8), boff = lds_byte(wc * 32 + fr, fq * 8);
#define PG8_SA(b, h) (((b) * 2 + (h)) * HTB)
#define PG8_SB(b, h) ((4 + (b) * 2 + (h)) * HTB)
#define PG8_STAGE(bufoff, gbase, voff) do { const char* _gb = (const char*)(gbase); if constexpr (MODE == 2) asm volatile("" : "+s"(_gb));     \
        _Pragma("unroll") for (int _i = 0; _i < 2; ++_i) \
        __builtin_amdgcn_global_load_lds((const unsigned*)(_gb + (voff)[_i]), (LAS unsigned*)(lds + (bufoff) + ldsw + _i * 8192), 16, 0, 0); } while (0)
#define PG8_LDA(dst, b, h) do { _Pragma("unroll") for (int m = 0; m < 4; ++m) _Pragma("unroll") for (int k = 0; k < 2; ++k) dst[m][k] = *(const LAS bf16x8*)(lds + PG8_SA(b, h) + aoff + m * 2048 + k * 1024); } while (0)
#define PG8_LDB(dst, b, h) do { _Pragma("unroll") for (int n = 0; n < 2; ++n) _Pragma("unroll") for (int k = 0; k < 2; ++k) dst[n][k] = *(const LAS bf16x8*)(lds + PG8_SB(b, h) + boff + n * 2048 + k * 1024); } while (0)
#define PG8_CAT(x0, x1) __builtin_shufflevector(__builtin_bit_cast(i32x4, x0), __builtin_bit_cast(i32x4, x1), 0, 1, 2, 3, 4, 5, 6, 7)
#define PG8_MMA(ai, bj, At, Bt) do { __builtin_amdgcn_s_setprio(1); _Pragma("unroll") for (int m = 0; m < 4; ++m) _Pragma("unroll") for (int n = 0; n < 2; ++n) { \
        if constexpr (MODE == 2) acc[ai][bj][m][n] = __builtin_amdgcn_mfma_scale_f32_16x16x128_f8f6f4(PG8_CAT(Bt[n][0], Bt[n][1]), PG8_CAT(At[m][0], At[m][1]), acc[ai][bj][m][n], 0, 0, 0, 0, 0, 0); \
        else { _Pragma("unroll") for (int k = 0; k < 2; ++k) { \
          if constexpr (MODE == 1) acc[ai][bj][m][n] = __builtin_bit_cast(f32x4, __builtin_amdgcn_mfma_i32_16x16x64_i8(__builtin_bit_cast(i32x4, Bt[n][k]), __builtin_bit_cast(i32x4, At[m][k]), __builtin_bit_cast(i32x4, acc[ai][bj][m][n]), 0, 0, 0)); \
          else if constexpr (MODE == 3) acc[ai][bj][m][n] = __builtin_amdgcn_mfma_f32_16x16x32_f16(__builtin_bit_cast(h16x8, Bt[n][k]), __builtin_bit_cast(h16x8, At[m][k]), acc[ai][bj][m][n], 0, 0, 0); \
          else acc[ai][bj][m][n] = __builtin_amdgcn_mfma_f32_16x16x32_bf16(Bt[n][k], At[m][k], acc[ai][bj][m][n], 0, 0, 0); } } } __builtin_amdgcn_s_setprio(0); } while (0)
#define PG8_WAIT_V(n) asm volatile("s_waitcnt vmcnt(" #n ")" ::: "memory")
#define PG8_WAIT_L(n) asm volatile("s_waitcnt lgkmcnt(" #n ")" ::: "memory")
#define PG8_BAR __builtin_amdgcn_s_barrier()
#define PG8_SCHED __builtin_amdgcn_sched_barrier(0)
#define PG8_ABASE(u) ((const char*)g.A + ((size_t)(u).pm * BM * g.lda + (size_t)((u).pn >> g.a_shift) * g.a_mul) * 2)
#define PG8_BBASE(u) ((const char*)g.Bt + (size_t)(u).pn * BM * g.ldb * 2 + (size_t)((u).pm >> 3) * g.bb)
    Unit cur, nxt; int ui = 0;
    if (!S.next(0, cur)) return;
    f32x4 acc[2][2][4][2];
#pragma unroll
    for (int a = 0; a < 2; ++a)
#pragma unroll
        for (int b = 0; b < 2; ++b)
#pragma unroll
            for (int m = 0; m < 4; ++m)
#pragma unroll
                for (int n = 0; n < 2; ++n) acc[a][b][m][n] = (f32x4){0.f, 0.f, 0.f, 0.f};
    bf16x8 At[4][2], B0[2][2], B1[2][2];
    const char* cA = PG8_ABASE(cur); const char* cB = PG8_BBASE(cur);
    PG8_STAGE(PG8_SB(0, 0), cB, voffB); PG8_STAGE(PG8_SB(0, 1), cB + hstepB, voffB); PG8_STAGE(PG8_SA(0, 0), cA, voffA); PG8_STAGE(PG8_SA(0, 1), cA + hstepA, voffA);
    if (wr == 1) PG8_BAR;
    PG8_WAIT_V(2); PG8_BAR;
    PG8_STAGE(PG8_SB(1, 0), cB + kstep, voffB); PG8_STAGE(PG8_SA(1, 0), cA + kstep, voffA); PG8_STAGE(PG8_SB(1, 1), cB + hstepB + kstep, voffB);
    PG8_WAIT_V(6); PG8_BAR;
    for (;;) {
        const bool has_next = S.next(ui + 1, nxt);
        const char* nA = has_next ? PG8_ABASE(nxt) : cA; const char* nB = has_next ? PG8_BBASE(nxt) : cB;
        for (int t = 0; t < nt; t += 2) {
            const bool last = (t == nt - 2);
            if constexpr (Epi::PREFETCH) { if (last) E.prefetch(lds + STAGE_BYTES, cur, wid, lane_now()); }
            const char* a1 = cA + (size_t)(t + 1) * kstep;
            const char* a2 = last ? nA : cA + (size_t)(t + 2) * kstep; const char* b2 = last ? nB : cB + (size_t)(t + 2) * kstep;
            const char* a3 = a2 + kstep; const char* b3 = b2 + kstep;
            PG8_LDB(B0, 0, 0); PG8_LDB(B1, 0, 1); PG8_SCHED; PG8_LDA(At, 0, 0); PG8_STAGE(PG8_SA(1, 1), a1 + hstepA, voffA);
            PG8_WAIT_V(8); PG8_WAIT_L(0); PG8_BAR; PG8_MMA(0, 0, At, B0); PG8_MMA(0, 1, At, B1); PG8_BAR; PG8_SCHED;
            PG8_LDA(At, 0, 1); PG8_STAGE(PG8_SB(0, 0), b2, voffB); PG8_STAGE(PG8_SB(0, 1), b2 + hstepB, voffB); PG8_STAGE(PG8_SA(0, 0), a2, voffA);
            PG8_WAIT_V(8); PG8_WAIT_L(0); PG8_BAR; PG8_MMA(1, 0, At, B0); PG8_MMA(1, 1, At, B1); PG8_BAR; PG8_SCHED;
            PG8_LDB(B0, 1, 0); PG8_LDB(B1, 1, 1); PG8_SCHED; PG8_LDA(At, 1, 0); PG8_STAGE(PG8_SA(0, 1), a2 + hstepA, voffA);
            PG8_WAIT_V(8); PG8_WAIT_L(0); PG8_BAR; PG8_MMA(0, 0, At, B0); PG8_MMA(0, 1, At, B1); PG8_BAR; PG8_SCHED;
            PG8_LDA(At, 1, 1); PG8_STAGE(PG8_SB(1, 0), b3, voffB); PG8_STAGE(PG8_SB(1, 1), b3 + hstepB, voffB); PG8_STAGE(PG8_SA(1, 0), a3, voffA);
            PG8_WAIT_V(8); PG8_WAIT_L(0); PG8_BAR; PG8_MMA(1, 0, At, B0); PG8_MMA(1, 1, At, B1); PG8_BAR; PG8_SCHED;
        }
        if constexpr (ALIGN_EPI) { if (wr == 0) PG8_BAR; }
        { const int l2 = lane_now();
          if constexpr (Epi::PREFETCH) E(acc, cur, wr, wc, l2 & 15, l2 >> 4, lds + STAGE_BYTES); else E(acc, cur, wr, wc, l2 & 15, l2 >> 4); }
        if (!has_next) break;
#pragma unroll
        for (int a = 0; a < 2; ++a)
#pragma unroll
            for (int b = 0; b < 2; ++b)
#pragma unroll
                for (int m = 0; m < 4; ++m)
#pragma unroll
                    for (int n = 0; n < 2; ++n) acc[a][b][m][n] = (f32x4){0.f, 0.f, 0.f, 0.f};
        cur = nxt; cA = nA; cB = nB; ++ui;
        if constexpr (ALIGN_EPI) { if (wr == 1) PG8_BAR; }
    }
    PG8_WAIT_V(0);
    if constexpr (!ALIGN_EPI) { if (wr == 0) PG8_BAR; }
    PG8_BAR;
#undef PG8_SA
#undef PG8_SB
#undef PG8_STAGE
#undef PG8_LDA
#undef PG8_LDB
#undef PG8_MMA
#undef PG8_CAT
#undef PG8_WAIT_V
#undef PG8_WAIT_L
#undef PG8_BAR
#undef PG8_SCHED
#undef PG8_ABASE
#undef PG8_BBASE
}

constexpr float Q8_CLIP = 4.75f;
__device__ __forceinline__ unsigned q8_bits(float v) { return __float_as_uint(__builtin_amdgcn_fmed3f(v, -127.0f, 127.0f) + 12582912.0f); }
__device__ __forceinline__ unsigned q8_pack(unsigned a, unsigned b, unsigned c, unsigned d) { return __builtin_amdgcn_perm(b, a, 0x0c0c0400u) | __builtin_amdgcn_perm(d, c, 0x04000c0cu); }
template <bool NORM, bool I8 = false> struct EpiBf16Plain {
    static constexpr bool PERM = true, PREFETCH = NORM;
    bf16_t* O; int ldc; const float* shw; int shw_stride; const unsigned long long* SS; const float* CW; const unsigned long long* SSq;
    __device__ __forceinline__ void prefetch(LAS unsigned char* aux, const Unit& u, int wid, int lane) const {
        if (wid < 2) __builtin_amdgcn_global_load_lds((const unsigned*)((const char*)(SS + (size_t)u.pm * BM) + wid * 1024 + lane * 16), (LAS unsigned*)(aux + wid * 1024), 16, 0, 0);
        else if (wid == 2) __builtin_amdgcn_global_load_lds((const unsigned*)((const char*)(shw + (size_t)(u.pm >> 3) * shw_stride + u.pn * BM) + lane * 16), (LAS unsigned*)(aux + 2048), 16, 0, 0);
        else if constexpr (I8) {
            if (wid == 3) __builtin_amdgcn_global_load_lds((const unsigned*)((const char*)(CW + (size_t)(u.pm >> 3) * shw_stride + u.pn * BM) + lane * 16), (LAS unsigned*)(aux + 3072), 16, 0, 0);
            else if (wid < 6) __builtin_amdgcn_global_load_lds((const unsigned*)((const char*)(SSq + (size_t)u.pm * BM) + (wid - 4) * 1024 + lane * 16), (LAS unsigned*)(aux + wid * 1024), 16, 0, 0);
        }
    }
    __device__ __forceinline__ void operator()(const f32x4 (&acc)[2][2][4][2], const Unit& u, int wr, int wc, int fr, int fq, const LAS unsigned char* aux = nullptr) const {
        const int row0 = u.pm * BM + wr * 64 + fr, col0 = u.pn * BM + wc * 32 + 8 * fq;
        f32x4 bv[2][2], cv[2][2];
#pragma unroll
        for (int bj = 0; bj < 2; ++bj)
#pragma unroll
            for (int n = 0; n < 2; ++n) { bv[bj][n] = NORM ? *(const LAS f32x4*)((const LAS float*)(aux + 2048) + wc * 32 + 8 * fq + bj * HALF + 4 * n) : (f32x4){0.f, 0.f, 0.f, 0.f};
                cv[bj][n] = I8 ? *(const LAS f32x4*)((const LAS float*)(aux + 3072) + wc * 32 + 8 * fq + bj * HALF + 4 * n) : (f32x4){1.f, 1.f, 1.f, 1.f}; }
        const LAS unsigned long long* ssl = (const LAS unsigned long long*)aux + wr * 64 + fr;
        const LAS unsigned long long* sql = (const LAS unsigned long long*)(aux + 4096) + wr * 64 + fr;
#pragma unroll
        for (int ai = 0; ai < 2; ++ai)
#pragma unroll
            for (int m = 0; m < 4; ++m) { const int row = row0 + ai * HALF + m * 16; bf16_t* rowp = O + (size_t)row * ldc + col0;
                float rs = 1.0f; if (NORM) rs = 1.0f / sqrtf((float)ssl[ai * HALF + m * 16] * (1.0f / (16777216.0f * D)) + EPS);
                if (I8) rs *= (Q8_CLIP / 127.0f) * sqrtf((float)sql[ai * HALF + m * 16] * (1.0f / (16777216.0f * D)) + EPS);
#pragma unroll
                for (int bj = 0; bj < 2; ++bj) { f32x4 a0 = acc[ai][bj][m][0], a1 = acc[ai][bj][m][1];
                    if (I8) {
#pragma unroll
                        for (int e = 0; e < 4; ++e) { a0[e] = (float)__float_as_int(a0[e]) * cv[bj][0][e]; a1[e] = (float)__float_as_int(a1[e]) * cv[bj][1][e]; } }
                    const f32x4 v0 = a0 * rs + bv[bj][0], v1 = a1 * rs + bv[bj][1];
                    u32x4 w; w.x = cvt_pk_bf16(v0[0], v0[1]); w.y = cvt_pk_bf16(v0[2], v0[3]); w.z = cvt_pk_bf16(v1[0], v1[1]); w.w = cvt_pk_bf16(v1[2], v1[3]);
                    *(u32x4*)(rowp + bj * HALF) = w; } }
    }
};
struct EpiFp8 {
    static constexpr bool PERM = true, PREFETCH = false;
    unsigned char* O; int ldc;
    __device__ __forceinline__ void operator()(const f32x4 (&acc)[2][2][4][2], const Unit& u, int wr, int wc, int fr, int fq) const {
        const int row0 = u.pm * BM + wr * 64 + fr, col0 = u.pn * BM + wc * 32 + 8 * fq;
#pragma unroll
        for (int ai = 0; ai < 2; ++ai)
#pragma unroll
            for (int m = 0; m < 4; ++m) { unsigned char* rowp = O + (size_t)(row0 + ai * HALF + m * 16) * ldc + col0;
#pragma unroll
                for (int bj = 0; bj < 2; ++bj) { const f32x4 v0 = acc[ai][bj][m][0], v1 = acc[ai][bj][m][1];
                    int w0 = 0, w1 = 0;
                    w0 = __builtin_amdgcn_cvt_pk_fp8_f32(v0[0], v0[1], w0, false); w0 = __builtin_amdgcn_cvt_pk_fp8_f32(v0[2], v0[3], w0, true);
                    w1 = __builtin_amdgcn_cvt_pk_fp8_f32(v1[0], v1[1], w1, false); w1 = __builtin_amdgcn_cvt_pk_fp8_f32(v1[2], v1[3], w1, true);
                    u32x2 w; w.x = (unsigned)w0; w.y = (unsigned)w1; *(u32x2*)(rowp + bj * HALF) = w; }
                asm volatile("" ::: "memory"); }
    }
};
struct EpiInA {
    static constexpr bool PERM = true, PREFETCH = true;
    bf16_t* Q; bf16_t* CKV; bf16_t* QI; bf16_t* KIN; float* WI; const float* kg; const float* kb; const float* shw; const unsigned long long* SS;
    __device__ __forceinline__ void prefetch(LAS unsigned char* aux, const Unit& u, int wid, int lane) const {
        if (wid < 2) __builtin_amdgcn_global_load_lds((const unsigned*)((const char*)(SS + (size_t)u.pm * BM) + wid * 1024 + lane * 16), (LAS unsigned*)(aux + wid * 1024), 16, 0, 0);
        else if (wid == 2) __builtin_amdgcn_global_load_lds((const unsigned*)((const char*)(shw + (size_t)(u.pm >> 3) * 2048 + u.pn * BM) + lane * 16), (LAS unsigned*)(aux + 2048), 16, 0, 0);
    }
    __device__ __forceinline__ void operator()(f32x4 (&acc)[2][2][4][2], const Unit& u, int wr, int wc, int fr, int fq, const LAS unsigned char* aux) const {
        const int row0 = u.pm * BM + wr * 64 + fr, cl = wc * 32 + 8 * fq;
        {
            const LAS float* sp = (const LAS float*)(aux + 2048) + cl;
            const LAS unsigned long long* ssl = (const LAS unsigned long long*)aux + wr * 64 + fr;
            f32x4 bv[2][2];
#pragma unroll
            for (int bj = 0; bj < 2; ++bj)
#pragma unroll
                for (int n = 0; n < 2; ++n) bv[bj][n] = *(const LAS f32x4*)(sp + bj * HALF + 4 * n);
#pragma unroll
            for (int ai = 0; ai < 2; ++ai)
#pragma unroll
                for (int m = 0; m < 4; ++m) { const float rs = 1.0f / sqrtf((float)ssl[ai * HALF + m * 16] * (1.0f / (16777216.0f * D)) + EPS);
#pragma unroll
                    for (int bj = 0; bj < 2; ++bj)
#pragma unroll
                        for (int n = 0; n < 2; ++n) acc[ai][bj][m][n] = acc[ai][bj][m][n] * rs + bv[bj][n]; }
        }
        if (u.pn < 7) {
            bf16_t* base; int ldc, c0;
            if (u.pn < 4) { base = Q; ldc = 1024; c0 = u.pn * 256; } else if (u.pn == 4) { base = CKV; ldc = 256; c0 = 0; } else { base = QI; ldc = 512; c0 = (u.pn - 5) * 256; }
#pragma unroll
            for (int ai = 0; ai < 2; ++ai)
#pragma unroll
                for (int m = 0; m < 4; ++m) { bf16_t* rowp = base + (size_t)(row0 + ai * HALF + m * 16) * ldc + c0 + cl;
#pragma unroll
                    for (int bj = 0; bj < 2; ++bj) { const f32x4 v0 = acc[ai][bj][m][0], v1 = acc[ai][bj][m][1];
                        u32x4 w;
                        if (u.pn >= 5) { w.x = cvt_pk_f16(v0[0], v0[1]); w.y = cvt_pk_f16(v0[2], v0[3]); w.z = cvt_pk_f16(v1[0], v1[1]); w.w = cvt_pk_f16(v1[2], v1[3]); }
                        else { w.x = cvt_pk_bf16(v0[0], v0[1]); w.y = cvt_pk_bf16(v0[2], v0[3]); w.z = cvt_pk_bf16(v1[0], v1[1]); w.w = cvt_pk_bf16(v1[2], v1[3]); }
                        *(u32x4*)(rowp + bj * HALF) = w; } }
        } else if (wc == 0) {
            f32x4 gv[2][2], bv[2][2];
#pragma unroll
            for (int bj = 0; bj < 2; ++bj)
#pragma unroll
                for (int n = 0; n < 2; ++n) { gv[bj][n] = *(const f32x4*)(kg + 32 * bj + 8 * fq + 4 * n); bv[bj][n] = *(const f32x4*)(kb + 32 * bj + 8 * fq + 4 * n); }
#pragma unroll
            for (int ai = 0; ai < 2; ++ai)
#pragma unroll
                for (int m = 0; m < 4; ++m) {
                    float s = 0.f;
#pragma unroll
                    for (int bj = 0; bj < 2; ++bj)
#pragma unroll
                        for (int n = 0; n < 2; ++n) { const f32x4 x = acc[ai][bj][m][n]; s += (x[0] + x[1]) + (x[2] + x[3]); }
                    s = rows_sum(s);
                    const float mu = s * (1.0f / 64.0f); float q = 0.f;
#pragma unroll
                    for (int bj = 0; bj < 2; ++bj)
#pragma unroll
                        for (int n = 0; n < 2; ++n) { const f32x4 d = acc[ai][bj][m][n] - mu; q += (d[0] * d[0] + d[1] * d[1]) + (d[2] * d[2] + d[3] * d[3]); }
                    q = rows_sum(q);
                    const float rs = 1.0f / sqrtf(q * (1.0f / 64.0f) + EPS);
                    bf16_t* rowp = KIN + (size_t)(row0 + ai * HALF + m * 16) * 64 + 8 * fq;
#pragma unroll
                    for (int bj = 0; bj < 2; ++bj) { const f32x4 v0 = (acc[ai][bj][m][0] - mu) * rs * gv[bj][0] + bv[bj][0], v1 = (acc[ai][bj][m][1] - mu) * rs * gv[bj][1] + bv[bj][1];
                        u32x4 w; w.x = cvt_pk_f16(v0[0], v0[1]); w.y = cvt_pk_f16(v0[2], v0[3]); w.z = cvt_pk_f16(v1[0], v1[1]); w.w = cvt_pk_f16(v1[2], v1[3]);
                        *(u32x4*)(rowp + bj * 32) = w; }
                }
        } else if (wc == 1 && fq == 0) {
            const float sc = 0.04419417382415922f;
#pragma unroll
            for (int ai = 0; ai < 2; ++ai)
#pragma unroll
                for (int m = 0; m < 4; ++m) { float* rowp = WI + (size_t)(row0 + ai * HALF + m * 16) * 8;
                    *(f32x4*)(rowp) = acc[ai][0][m][0] * sc; *(f32x4*)(rowp + 4) = acc[ai][0][m][1] * sc; }
        }
    }
};
template <bool Q8, bool FP8ACC> struct EpiResid {
    static constexpr bool PERM = true, PREFETCH = true;
    const bf16_t* xin_b; bf16_t* xout_b;
    const float* gate; const float* bias;
    static constexpr float asc = FP8ACC ? 1.0f / 4096.0f : 1.0f;
    bf16_t* XG; const float* gn; const float* scn; unsigned long long* SSo; const unsigned long long* SSq;
    __device__ __forceinline__ void prefetch(LAS unsigned char* aux, const Unit& u, int wid, int lane) const {
        const int b = u.pm >> 3; const char* src = nullptr;
        if (wid == 0) src = (const char*)(gate + (size_t)b * 6144 + u.pn * BM);
        else if (wid == 1) src = bias ? (const char*)(bias + u.pn * BM) : nullptr;
        else if constexpr (Q8) { if (wid == 4 || wid == 5) src = (const char*)(SSq + (size_t)u.pm * BM) + (wid - 4) * 1024; }
        else { if (wid == 2) src = XG ? (const char*)(gn + u.pn * BM) : nullptr;
               else if (wid == 3) src = XG ? (const char*)(scn + (size_t)b * 6144 + u.pn * BM) : nullptr; }
        if (src) __builtin_amdgcn_global_load_lds((const unsigned*)(src + lane * 16), (LAS unsigned*)(aux + wid * 1024), 16, 0, 0);
    }
    __device__ __forceinline__ void operator()(const f32x4 (&acc)[2][2][4][2], const Unit& u, int wr, int wc, int fr, int fq, const LAS unsigned char* aux) const {
        const int row0 = u.pm * BM + wr * 64 + fr, col0 = u.pn * BM + wc * 32 + 8 * fq, b = u.pm >> 3;
        const LAS unsigned long long* sql = (const LAS unsigned long long*)(aux + 4096) + wr * 64 + fr;
        const LAS float* lv = (const LAS float*)aux + wc * 32 + 8 * fq;
        float ssum[2][4];
#pragma unroll
        for (int ai = 0; ai < 2; ++ai)
#pragma unroll
            for (int m = 0; m < 4; ++m) ssum[ai][m] = 0.f;
#pragma unroll
        for (int bj = 0; bj < 2; ++bj) {
            const int c = col0 + bj * HALF;
            const LAS float* lp = lv + bj * HALF;
            const f32x4 gv0 = *(const LAS f32x4*)(lp), gv1 = *(const LAS f32x4*)(lp + 4);
            f32x4 bv0 = (f32x4){0.f, 0.f, 0.f, 0.f}, bv1 = bv0, gm0 = bv0, gm1 = bv0;
            if (bias) { bv0 = *(const LAS f32x4*)(lp + 256); bv1 = *(const LAS f32x4*)(lp + 256 + 4); }
            if (!Q8 && XG) { gm0 = *(const LAS f32x4*)(lp + 512) * (*(const LAS f32x4*)(lp + 768) + 1.0f); gm1 = *(const LAS f32x4*)(lp + 512 + 4) * (*(const LAS f32x4*)(lp + 768 + 4) + 1.0f); }
#pragma unroll
            for (int ai = 0; ai < 2; ++ai)
#pragma unroll
                for (int m = 0; m < 4; ++m) { const size_t off = (size_t)(row0 + ai * HALF + m * 16) * D + c;
                    const u32x4 xv = *(const u32x4*)(xin_b + off);
                    const f32x2 xa = unpk_f16(xv.x), xb = unpk_f16(xv.y), xc = unpk_f16(xv.z), xd = unpk_f16(xv.w);
                    const f32x4 xi0 = (f32x4){xa.x, xa.y, xb.x, xb.y}, xi1 = (f32x4){xc.x, xc.y, xd.x, xd.y};
                    const f32x4 xo0 = xi0 + gv0 * (acc[ai][bj][m][0] * asc + bv0), xo1 = xi1 + gv1 * (acc[ai][bj][m][1] * asc + bv1);
                    { u32x4 w; w.x = cvt_pk_f16(xo0[0], xo0[1]); w.y = cvt_pk_f16(xo0[2], xo0[3]); w.z = cvt_pk_f16(xo1[0], xo1[1]); w.w = cvt_pk_f16(xo1[2], xo1[3]); *(u32x4*)(xout_b + off) = w; }
                    if (XG) {
                        ssum[ai][m] += ((xo0[0] * xo0[0] + xo0[1] * xo0[1]) + (xo0[2] * xo0[2] + xo0[3] * xo0[3])) + ((xo1[0] * xo1[0] + xo1[1] * xo1[1]) + (xo1[2] * xo1[2] + xo1[3] * xo1[3]));
                        if constexpr (Q8) {
                            const float qs = (127.0f / Q8_CLIP) / sqrtf((float)sql[ai * HALF + m * 16] * (1.0f / (16777216.0f * D)) + EPS);
                            u32x2 w; w.x = q8_pack(q8_bits(xo0[0] * qs), q8_bits(xo0[1] * qs), q8_bits(xo0[2] * qs), q8_bits(xo0[3] * qs));
                            w.y = q8_pack(q8_bits(xo1[0] * qs), q8_bits(xo1[1] * qs), q8_bits(xo1[2] * qs), q8_bits(xo1[3] * qs));
                            *(u32x2*)((unsigned char*)XG + off) = w;
                        } else {
                        const f32x4 y0 = xo0 * gm0, y1 = xo1 * gm1;
                        u32x4 w; w.x = cvt_pk_f16(y0[0], y0[1]); w.y = cvt_pk_f16(y0[2], y0[3]); w.z = cvt_pk_f16(y1[0], y1[1]); w.w = cvt_pk_f16(y1[2], y1[3]);
                        *(u32x4*)(XG + off) = w; } }
                    if (m & 1) asm volatile("" ::: "memory"); }
        }
        if (XG) {
#pragma unroll
            for (int ai = 0; ai < 2; ++ai)
#pragma unroll
                for (int m = 0; m < 4; ++m) { float q = ssum[ai][m]; q = rows_sum(q);
                    if (fq == 0) atomicAdd(SSo + row0 + ai * HALF + m * 16, (unsigned long long)(q * 16777216.0f)); }
        }
    }
};
struct EpiSwiGLU {
    static constexpr bool PERM = true, PREFETCH = true;
    bf16_t* H; const float* shw; const unsigned long long* SS; const float* CW; const unsigned long long* SSq;
    __device__ __forceinline__ void prefetch(LAS unsigned char* aux, const Unit& u, int wid, int lane) const {
        if (wid < 2) __builtin_amdgcn_global_load_lds((const unsigned*)((const char*)(SS + (size_t)u.pm * BM) + wid * 1024 + lane * 16), (LAS unsigned*)(aux + wid * 1024), 16, 0, 0);
        else if (wid == 2) __builtin_amdgcn_global_load_lds((const unsigned*)((const char*)(shw + (size_t)(u.pm >> 3) * (2 * DFF) + u.pn * BM) + lane * 16), (LAS unsigned*)(aux + 2048), 16, 0, 0);
        else if (wid == 3) __builtin_amdgcn_global_load_lds((const unsigned*)((const char*)(CW + (size_t)(u.pm >> 3) * (2 * DFF) + u.pn * BM) + lane * 16), (LAS unsigned*)(aux + 3072), 16, 0, 0);
        else if (wid < 6) __builtin_amdgcn_global_load_lds((const unsigned*)((const char*)(SSq + (size_t)u.pm * BM) + (wid - 4) * 1024 + lane * 16), (LAS unsigned*)(aux + wid * 1024), 16, 0, 0);
    }
    __device__ __forceinline__ void operator()(const f32x4 (&acc)[2][2][4][2], const Unit& u, int wr, int wc, int fr, int fq, const LAS unsigned char* aux) const {
        const int row0 = u.pm * BM + wr * 64 + fr, f0 = u.pn * 128 + wc * 32 + 8 * fq;
        f32x4 bv[2][2], cv[2][2];
        { const LAS float* sp = (const LAS float*)(aux + 2048) + wc * 32 + 8 * fq;
#pragma unroll
          for (int bj = 0; bj < 2; ++bj)
#pragma unroll
              for (int n = 0; n < 2; ++n) { bv[bj][n] = *(const LAS f32x4*)(sp + bj * HALF + 4 * n); cv[bj][n] = *(const LAS f32x4*)(sp + 256 + bj * HALF + 4 * n); } }
        const LAS unsigned long long* ssl = (const LAS unsigned long long*)aux + wr * 64 + fr;
        const LAS unsigned long long* sql = (const LAS unsigned long long*)(aux + 4096) + wr * 64 + fr;
#pragma unroll
        for (int ai = 0; ai < 2; ++ai)
#pragma unroll
            for (int m = 0; m < 4; ++m) { bf16_t* rowp = H + (size_t)(row0 + ai * HALF + m * 16) * DFF + f0;
                const float rs = (Q8_CLIP / 127.0f) * sqrtf((float)sql[ai * HALF + m * 16] * (1.0f / (16777216.0f * D)) + EPS) / sqrtf((float)ssl[ai * HALF + m * 16] * (1.0f / (16777216.0f * D)) + EPS);
                float o[8];
#pragma unroll
                for (int n = 0; n < 2; ++n)
#pragma unroll
                    for (int e = 0; e < 4; ++e) { const float a0 = (float)__float_as_int(acc[ai][0][m][n][e]) * rs, a1 = (float)__float_as_int(acc[ai][1][m][n][e]) * rs;
                        o[4 * n + e] = silu_f(a0 * cv[0][n][e] + bv[0][n][e]) * (a1 * cv[1][n][e] + bv[1][n][e]); }
                u32x4 w; w.x = cvt_pk_bf16(o[0], o[1]); w.y = cvt_pk_bf16(o[2], o[3]); w.z = cvt_pk_bf16(o[4], o[5]); w.w = cvt_pk_bf16(o[6], o[7]);
                *(u32x4*)(rowp) = w; }
    }
};
}

struct Ptrs {
    const float* in[23]; float* out; unsigned char* ws;
};
enum { I_X = 0, I_C, I_RELB, I_WADA, I_BADA, I_GMIX, I_GFFN, I_AWIN, I_AKVG, I_AWUK, I_AWUV, I_AIKG, I_AIKB, I_AWOUT, I_BWIN, I_BBIN, I_BSINK, I_BWOUT, I_BBOUT, I_W1, I_W3, I_W2, I_GFIN };

__device__ __forceinline__ void conv_task(const Ptrs& P, int th, int lane) {
    const int t = th >> 1, half = th & 1;
    int kind, rb, ks, Kd; bf16_t* dst; const float* s0 = nullptr; const float* s1 = nullptr; const float* gk = nullptr; int ld = 0; bool f8 = false, h16 = false;
    if (t < 2112) { const int l = t / 528, r = t % 528; unsigned char* wl = P.ws + WS_W + (size_t)l * W_LAYER;
        if (r < 352) { kind = 1; rb = r >> 2; ks = r & 3; Kd = 1024; dst = (bf16_t*)(wl + W13_OFF); s0 = P.in[I_W1] + (size_t)l * D * DFF; s1 = P.in[I_W3] + (size_t)l * D * DFF; ld = DFF; }
        else { const int r2 = r - 352; kind = 0; rb = r2 / 11; ks = r2 % 11; Kd = DFF; dst = (bf16_t*)(wl + W2_OFF); s0 = P.in[I_W2] + (size_t)l * DFF * D; ld = D; }
    } else { const int t2 = t - 2112, j = t2 / 464, r = t2 % 464; unsigned char* wa = P.ws + WS_WA + (size_t)j * WA_STRIDE; unsigned char* wb = P.ws + WS_WB + (size_t)j * WB_STRIDE;
        if (r < 128) { kind = 2; rb = r >> 2; ks = r & 3; Kd = 1024; dst = (bf16_t*)(wa + WINA_OFF); s0 = P.in[I_AWIN] + (size_t)j * D * A_IN; ld = A_IN; h16 = true; }
        else if (r < 192) { kind = 3; rb = r - 128; ks = 0; Kd = 128; dst = (bf16_t*)(wa + WQA_OFF); s0 = P.in[I_AWUK] + (size_t)j * NH * RK * HD; gk = P.in[I_AKVG] + j * RK; }
        else if (r < 256) { const int r2 = r - 192; kind = 4; rb = r2 >> 2; ks = r2 & 3; Kd = 1024; dst = (bf16_t*)(wa + WUV_OFF); s0 = P.in[I_AWUV] + (size_t)j * NH * RK * HD; gk = P.in[I_AKVG] + j * RK; }
        else if (r < 320) { const int r2 = r - 256; kind = 0; rb = r2 >> 2; ks = r2 & 3; Kd = 1024; dst = (bf16_t*)(wa + WOUTA_OFF); s0 = P.in[I_AWOUT] + (size_t)j * D * D; ld = D; f8 = true; }
        else if (r < 400) { const int r2 = r - 320; kind = 0; rb = r2 >> 2; ks = r2 & 3; Kd = 1024; dst = (bf16_t*)(wb + WINB_OFF); s0 = P.in[I_BWIN] + (size_t)j * D * B_IN; ld = B_IN; h16 = true; }
        else { const int r2 = r - 400; kind = 0; rb = r2 >> 2; ks = r2 & 3; Kd = 1024; dst = (bf16_t*)(wb + WOUTB_OFF); s0 = P.in[I_BWOUT] + (size_t)j * D * D; ld = D; f8 = true; }
    }
    const int n = rb * 64 + lane, k0 = ks * 256;
    bf16_t* drow = dst + (size_t)n * Kd + k0;
    if (kind <= 2) {
        const float* src = s0; int col = n;
        if (kind == 1) { const int c = n & 255, f = (n >> 8) * 128 + (c & 127); src = (c < 128) ? s0 : s1; col = f; }
        if (kind == 2) { if (n >= 1792) { const int c = n - 1792; col = c < 32 ? 1792 + c : (c < 40 ? 1856 + (c - 32) : ((c >= 128 && c < 160) ? 1824 + (c - 128) : -1)); } }
        const float* sp = src + (size_t)k0 * ld + (col < 0 ? 0 : col);
        for (int kq = 4 * half; kq < 4 * half + 4; ++kq) {
          float vv[4][8];
#pragma unroll
          for (int i = 0; i < 4; ++i)
#pragma unroll
            for (int e = 0; e < 8; ++e) vv[i][e] = sp[(size_t)((kq * 4 + i) * 8 + e) * ld];
          asm volatile("" ::: "memory");
#pragma unroll
          for (int i = 0; i < 4; ++i) { const int kc = kq * 4 + i;
            float v[8];
#pragma unroll
            for (int e = 0; e < 8; ++e) v[e] = vv[i][e];
            if (col < 0) {
#pragma unroll
                for (int e = 0; e < 8; ++e) v[e] = 0.f; }
            if (f8) {
#pragma unroll
                for (int e = 0; e < 8; ++e) v[e] = __builtin_amdgcn_fmed3f(v[e] * 256.0f, -448.0f, 448.0f);
                int w0 = 0, w1 = 0;
                w0 = __builtin_amdgcn_cvt_pk_fp8_f32(v[0], v[1], w0, false); w0 = __builtin_amdgcn_cvt_pk_fp8_f32(v[2], v[3], w0, true);
                w1 = __builtin_amdgcn_cvt_pk_fp8_f32(v[4], v[5], w1, false); w1 = __builtin_amdgcn_cvt_pk_fp8_f32(v[6], v[7], w1, true);
                u32x2 w; w.x = (unsigned)w0; w.y = (unsigned)w1; *(u32x2*)((unsigned char*)dst + (size_t)n * Kd + k0 + kc * 8) = w;
            } else if (h16) {
            u32x4 w; w.x = cvt_pk_f16(v[0], v[1]); w.y = cvt_pk_f16(v[2], v[3]); w.z = cvt_pk_f16(v[4], v[5]); w.w = cvt_pk_f16(v[6], v[7]);
            *(u32x4*)(drow + kc * 8) = w;
            } else {
            u32x4 w; w.x = cvt_pk_bf16(v[0], v[1]); w.y = cvt_pk_bf16(v[2], v[3]); w.z = cvt_pk_bf16(v[4], v[5]); w.w = cvt_pk_bf16(v[6], v[7]);
            *(u32x4*)(drow + kc * 8) = w; }
        } }
    } else if (kind == 3) {
        const int h = n >> 8, r = n & 255; const float gs = gk[r] * 8.0f;       const float* sp = s0 + ((size_t)h * RK + r) * HD;
        for (int kc = 0; kc < (half ? 0 : 16); ++kc) { const int k = kc * 8; float v[8];
            if ((k >> 6) == (h & 1)) {
#pragma unroll
                for (int e = 0; e < 8; ++e) v[e] = sp[(k & 63) + e] * gs;
            } else {
#pragma unroll
                for (int e = 0; e < 8; ++e) v[e] = 0.f; }
            u32x4 w; w.x = cvt_pk_bf16(v[0], v[1]); w.y = cvt_pk_bf16(v[2], v[3]); w.z = cvt_pk_bf16(v[4], v[5]); w.w = cvt_pk_bf16(v[6], v[7]);
            *(u32x4*)(drow + kc * 8) = w; }
    } else {
        const int hh = (n >> 6) & 3, d = n & 63, h = n >> 6;
        for (int kc = 16 * half; kc < 16 * half + 16; ++kc) { const int k = k0 + kc * 8; float v[8];
            if ((k >> 8) == hh) {
#pragma unroll
                for (int e = 0; e < 8; ++e) { const int r = (k & 255) + e; v[e] = s0[((size_t)h * RK + r) * HD + d] * gk[r] * 16.0f; }
            } else {
#pragma unroll
                for (int e = 0; e < 8; ++e) v[e] = 0.f; }
            u32x4 w; w.x = cvt_pk_bf16(v[0], v[1]); w.y = cvt_pk_bf16(v[2], v[3]); w.z = cvt_pk_bf16(v[4], v[5]); w.w = cvt_pk_bf16(v[6], v[7]);
            *(u32x4*)(drow + kc * 8) = w; }
    }
}
constexpr int N_CONV_TASKS = 6080;

__device__ __forceinline__ void p0_prologue(const Ptrs& P, LAS unsigned char* lds, int G) {
    int tid = tid_now();
    const int lane = tid & 63, wave = __builtin_amdgcn_readfirstlane(tid >> 6);
    const int gw = blockIdx.x * NWAVES + wave, NGW = G * NWAVES;
    for (int t = gw; t < N_CONV_TASKS; t += NGW) conv_task(P, t, lane);
    LAS float* cs = (LAS float*)lds;
    LAS float* red = (LAS float*)(lds + 65536);
    for (int i = tid; i < BATCH * D; i += NTHR) { const int b = i >> 10, k = i & 1023; cs[k * 16 + b] = silu_f(P.in[I_C][i]); }
    __syncthreads();
    float* mod = (float*)(P.ws + WS_MOD);
    for (int task = blockIdx.x; task < 4 * 96; task += G) {
        const int l = task / 96, j0 = (task % 96) * 64, col = tid & 63, ksl = tid >> 6;
        const float* wp = P.in[I_WADA] + ((size_t)l * D + ksl * 128) * 6144 + j0 + col;
        float a[16];
#pragma unroll
        for (int b = 0; b < 16; ++b) a[b] = 0.f;
        for (int k = 0; k < 128; ++k) { const float w = wp[(size_t)k * 6144]; const LAS f32x4* c4 = (const LAS f32x4*)(cs + (ksl * 128 + k) * 16);
#pragma unroll
            for (int q = 0; q < 4; ++q) { const f32x4 c = c4[q];
#pragma unroll
                for (int e = 0; e < 4; ++e) a[4 * q + e] += w * c[e]; } }
#pragma unroll
        for (int b = 0; b < 16; ++b) red[(ksl * 64 + col) * 16 + b] = a[b];
        __syncthreads();
        for (int o = tid; o < 1024; o += NTHR) { const int c2 = o >> 4, b = o & 15; float s = 0.f;
#pragma unroll
            for (int q = 0; q < 8; ++q) s += red[(q * 64 + c2) * 16 + b];
            mod[((size_t)l * BATCH + b) * 6144 + j0 + c2] = s + P.in[I_BADA][l * 6144 + j0 + c2]; }
        __syncthreads();
    }
}

__device__ __forceinline__ void pre_phase(const Ptrs& P, LAS unsigned char* lds, int G) {
    int tid = tid_now();
    const int lane = tid & 63, wave = __builtin_amdgcn_readfirstlane(tid >> 6);
    const float* mod = (const float*)(P.ws + WS_MOD);
    {
        const int grp = blockIdx.x & 7, l = grp >> 1, kind = grp & 1, j = l >> 1;
        const float* shsrc = mod + (size_t)l * BATCH * 6144 + (kind ? 3072 : 0);
        constexpr int SP = 2064;
        for (int i = tid; i < BATCH * D / 2; i += NTHR) { const int b = i >> 9, k2 = (i & 511) * 2;
            const float a0 = shsrc[(size_t)b * 6144 + k2], a1 = shsrc[(size_t)b * 6144 + k2 + 1];
            *(LAS unsigned*)(lds + b * SP + k2 * 2) = kind ? cvt_pk_bf16(a0, a1) : cvt_pk_f16(a0, a1); }
        __syncthreads();
        const bf16_t* W; int nrows; float* dst; const float* bias = nullptr;
        if (kind) { W = (const bf16_t*)(P.ws + WS_W + (size_t)l * W_LAYER + W13_OFF); nrows = 2 * DFF; dst = (float*)(P.ws + WS_SHW + SHW_F) + (size_t)l * BATCH * 2 * DFF; }
        else if ((l & 1) == 0) { W = (const bf16_t*)(P.ws + WS_WA + (size_t)j * WA_STRIDE + WINA_OFF); nrows = 2048; dst = (float*)(P.ws + WS_SHW + SHW_A) + (size_t)j * BATCH * 2048; }
        else { W = (const bf16_t*)(P.ws + WS_WB + (size_t)j * WB_STRIDE + WINB_OFF); nrows = B_IN; dst = (float*)(P.ws + WS_SHW + SHW_B) + (size_t)j * BATCH * B_IN; bias = P.in[I_BBIN] + j * B_IN; }
        const int nblk = nrows >> 4, wq = (blockIdx.x >> 3) * NWAVES + wave, nwq = (G >> 3) * NWAVES;
        const int nn = lane & 15, g = lane >> 4;
        for (int blk = wq; blk < nblk; blk += nwq) {
            f32x4 acc = (f32x4){0.f, 0.f, 0.f, 0.f};
            const bf16_t* wp = W + (size_t)(blk * 16 + nn) * D + 8 * g;
#pragma unroll 8
            for (int ks = 0; ks < 32; ++ks) { const bf16x8 a = *(const LAS bf16x8*)(lds + nn * SP + (32 * ks + 8 * g) * 2); const bf16x8 bw = *(const bf16x8*)(wp + 32 * ks);
                acc = kind ? __builtin_amdgcn_mfma_f32_16x16x32_bf16(a, bw, acc, 0, 0, 0) : __builtin_amdgcn_mfma_f32_16x16x32_f16(__builtin_bit_cast(h16x8, a), __builtin_bit_cast(h16x8, bw), acc, 0, 0, 0); }
            const int n = blk * 16 + nn; const float bb = bias ? bias[n] : 0.f;
#pragma unroll
            for (int i = 0; i < 4; ++i) dst[(size_t)(4 * g + i) * nrows + n] = acc[i] + bb;
        }
    }
    {
        const int gw = blockIdx.x * NWAVES + wave, NGW = G * NWAVES;
        const float* x = P.in[I_X]; const float* gmix = P.in[I_GMIX]; bf16_t* XG = (bf16_t*)(P.ws + WS_XG); unsigned long long* SS0 = (unsigned long long*)(P.ws + WS_SS);
        for (int row = gw; row < M; row += NGW) {
            const int b = row >> 11;
            const f32x4* xr = (const f32x4*)(x + (size_t)row * D) + lane;
            f32x4 v[4]; float sq = 0.f;
#pragma unroll
            for (int jj = 0; jj < 4; ++jj) { v[jj] = xr[64 * jj]; sq += (v[jj][0] * v[jj][0] + v[jj][1] * v[jj][1]) + (v[jj][2] * v[jj][2] + v[jj][3] * v[jj][3]); }
            const float ss = wave_sum(sq);
            if (lane == 0) SS0[row] = (unsigned long long)(ss * 16777216.0f);
            const float* mb = mod + (size_t)b * 6144;
            u32x2* o8 = (u32x2*)(XG + (size_t)row * D) + lane; u32x2* x8 = (u32x2*)((bf16_t*)P.out + (size_t)row * D) + lane;
#pragma unroll
            for (int jj = 0; jj < 4; ++jj) { const int c = 4 * lane + 256 * jj;
                const f32x4 y = v[jj] * *(const f32x4*)(gmix + c) * (*(const f32x4*)(mb + 1024 + c) + 1.0f);
                u32x2 w; w.x = cvt_pk_f16(y[0], y[1]); w.y = cvt_pk_f16(y[2], y[3]); o8[64 * jj] = w;
                u32x2 xw; xw.x = cvt_pk_f16(v[jj][0], v[jj][1]); xw.y = cvt_pk_f16(v[jj][2], v[jj][3]); x8[64 * jj] = xw; }
        }
    }
}
__device__ __forceinline__ float half_max(float x);
__device__ __forceinline__ float wave_max(float x) {
    const float h = half_max(x);
    const u32x2 r = __builtin_amdgcn_permlane32_swap(__float_as_uint(h), __float_as_uint(h), false, false);
    return fmaxf(__uint_as_float(r.x), __uint_as_float(r.y));
}
template <bool F16>
__device__ __forceinline__ void w8_build(const bf16_t* W13, int nrows, const float* gffn, const float* scn, unsigned char* W8, float* CW, LAS unsigned char* lds, int G) {
    int tid = tid_now();
    const int lane = tid & 63, wave = __builtin_amdgcn_readfirstlane(tid >> 6);
    LAS float* mL = (LAS float*)lds;
    for (int i = tid; i < BATCH * D / 4; i += NTHR) { const int b = i >> 8, k4 = (i & 255) * 4;
        *(LAS f32x4*)(mL + b * D + k4) = *(const f32x4*)(gffn + k4) * (*(const f32x4*)(scn + (size_t)b * 6144 + k4) + 1.0f); }
    __syncthreads();
    const int gw = blockIdx.x * NWAVES + wave, NGW = G * NWAVES;
    const size_t bstride = (size_t)nrows * D;
    for (int n = gw; n < nrows; n += NGW) {
        const u32x2* wrow = (const u32x2*)(W13 + (size_t)n * D) + lane;
        float w[16];
#pragma unroll
        for (int j = 0; j < 4; ++j) { const u32x2 p = wrow[64 * j];
            if (F16) { const f32x2 pa = unpk_f16(p.x), pb = unpk_f16(p.y); w[4 * j] = pa.x; w[4 * j + 1] = pa.y; w[4 * j + 2] = pb.x; w[4 * j + 3] = pb.y; }
            else { w[4 * j] = __uint_as_float(p.x << 16); w[4 * j + 1] = __uint_as_float(p.x & 0xffff0000u); w[4 * j + 2] = __uint_as_float(p.y << 16); w[4 * j + 3] = __uint_as_float(p.y & 0xffff0000u); } }
        unsigned* orow = (unsigned*)(W8 + (size_t)n * D) + lane;
#pragma unroll 2
        for (int b = 0; b < BATCH; ++b) {
            float v[16]; float mx = 0.f;
#pragma unroll
            for (int j = 0; j < 4; ++j) { const f32x4 mm = *(const LAS f32x4*)(mL + b * D + 256 * j + 4 * lane);
#pragma unroll
                for (int e = 0; e < 4; ++e) v[4 * j + e] = w[4 * j + e] * mm[e];
                mx = fmaxf(fmaxf(mx, fmaxf(fabsf(v[4 * j]), fabsf(v[4 * j + 1]))), fmaxf(fabsf(v[4 * j + 2]), fabsf(v[4 * j + 3]))); }
            mx = fmaxf(wave_max(mx), 1e-30f);
            const float inv = 127.0f / mx;
#pragma unroll
            for (int j = 0; j < 4; ++j)
                orow[(size_t)b * (bstride / 4) + 64 * j] = pg8::q8_pack(__float_as_uint(fmaf(v[4 * j], inv, 12582912.0f)), __float_as_uint(fmaf(v[4 * j + 1], inv, 12582912.0f)),
                                                                          __float_as_uint(fmaf(v[4 * j + 2], inv, 12582912.0f)), __float_as_uint(fmaf(v[4 * j + 3], inv, 12582912.0f)));
            if (lane == 0) CW[(size_t)b * nrows + n] = mx * (1.0f / 127.0f);
        }
    }
    __syncthreads();
}
__device__ __forceinline__ void final_norm_phase(const bf16_t* x, float* out, const float* g, int G) {
    int tid = tid_now();
    const int lane = tid & 63, wave = __builtin_amdgcn_readfirstlane(tid >> 6);
    const int gw = blockIdx.x * NWAVES + wave, NGW = G * NWAVES;
    for (int row = gw; row < M; row += NGW) {
        const u32x2* xr = (const u32x2*)(x + (size_t)row * D) + lane; f32x4* orow = (f32x4*)(out + (size_t)row * D) + lane;
        f32x4 v[4]; float s = 0.f;
#pragma unroll
        for (int j = 0; j < 4; ++j) { const u32x2 p = xr[64 * j];
            { const f32x2 pa = unpk_f16(p.x), pb = unpk_f16(p.y); v[j] = (f32x4){pa.x, pa.y, pb.x, pb.y}; }
            s += (v[j][0] * v[j][0] + v[j][1] * v[j][1]) + (v[j][2] * v[j][2] + v[j][3] * v[j][3]); }
        const float rstd = 1.0f / sqrtf(wave_sum(s) * (1.0f / D) + EPS);
#pragma unroll
        for (int j = 0; j < 4; ++j) { const f32x4 gg = *(const f32x4*)(g + 4 * lane + 256 * j); orow[64 * j] = v[j] * rstd * gg; }
    }
}

__device__ __forceinline__ unsigned f2key(float f) { const unsigned u = __float_as_uint(f); return (u & 0x80000000u) ? ~u : (u | 0x80000000u); }
__device__ __forceinline__ float key2f(unsigned k) { return __uint_as_float((k & 0x80000000u) ? (k & 0x7fffffffu) : ~k); }
__device__ __forceinline__ float half_max(float x) {
    int u = __float_as_int(x);
    u = __float_as_int(fmaxf(__int_as_float(u), __int_as_float(__builtin_amdgcn_update_dpp(u, u, 0x128, 0xf, 0xf, false))));
    u = __float_as_int(fmaxf(__int_as_float(u), __int_as_float(__builtin_amdgcn_update_dpp(u, u, 0x124, 0xf, 0xf, false))));
    u = __float_as_int(fmaxf(__int_as_float(u), __int_as_float(__builtin_amdgcn_update_dpp(u, u, 0x122, 0xf, 0xf, false))));
    u = __float_as_int(fmaxf(__int_as_float(u), __int_as_float(__builtin_amdgcn_update_dpp(u, u, 0x121, 0xf, 0xf, false))));
    const u32x2 r = __builtin_amdgcn_permlane16_swap((unsigned)u, (unsigned)u, false, false);
    return fmaxf(__uint_as_float(r.x), __uint_as_float(r.y));
}
__device__ __forceinline__ float half_sum_f(float v) {
    v += __int_as_float(__builtin_amdgcn_update_dpp(__float_as_int(v), __float_as_int(v), 0x128, 0xf, 0xf, false));
    v += __int_as_float(__builtin_amdgcn_update_dpp(__float_as_int(v), __float_as_int(v), 0x124, 0xf, 0xf, false));
    v += __int_as_float(__builtin_amdgcn_update_dpp(__float_as_int(v), __float_as_int(v), 0x122, 0xf, 0xf, false));
    v += __int_as_float(__builtin_amdgcn_update_dpp(__float_as_int(v), __float_as_int(v), 0x121, 0xf, 0xf, false));
    const u32x2 r = __builtin_amdgcn_permlane16_swap(__float_as_uint(v), __float_as_uint(v), false, false);
    return __uint_as_float(r.x) + __uint_as_float(r.y);
}
__device__ __forceinline__ f32x2 pk_gt(f32x2 x, f32x2 big, f32x2 nfbig) { f32x2 d; asm("v_pk_fma_f32 %0, %1, %2, %3 clamp" : "=v"(d) : "v"(x), "v"(big), "v"(nfbig)); return d; }
__device__ __forceinline__ int half_sum(int v) {
    v += __builtin_amdgcn_update_dpp(v, v, 0x128, 0xf, 0xf, false);
    v += __builtin_amdgcn_update_dpp(v, v, 0x124, 0xf, 0xf, false);
    v += __builtin_amdgcn_update_dpp(v, v, 0x122, 0xf, 0xf, false);
    v += __builtin_amdgcn_update_dpp(v, v, 0x121, 0xf, 0xf, false);
    const u32x2 r = __builtin_amdgcn_permlane16_swap((unsigned)v, (unsigned)v, false, false);
    return (int)(r.x + r.y);
}
typedef float f32x32 __attribute__((ext_vector_type(32)));
__device__ __forceinline__ void idx_task(const bf16_t* QI, const bf16_t* KIN, const float* WI, unsigned* SEL, LAS unsigned char* lds, int b, int tg, int lane, int wave, bool active, int nrounds) {
    asm volatile("" : "+v"(lane));
    const int t0 = tg * 4, h = lane >> 5, r = lane & 31;
    const int qsel = 2 * (r >> 4) + ((r >> 2) & 1), hd = (r & 3) + 4 * ((r >> 3) & 1);
    const size_t rowb = (size_t)b * SEQ;
    bf16x8 aq[4];
#pragma unroll
    for (int ks = 0; ks < 4; ++ks) aq[ks] = *(const bf16x8*)(QI + (rowb + t0 + qsel) * 512 + hd * 64 + ks * 16 + h * 8);
    float wlo[8], whi[8];
    { const f32x4 a0 = *(const f32x4*)(WI + (rowb + t0 + h) * 8), a1 = *(const f32x4*)(WI + (rowb + t0 + h) * 8 + 4);
      const f32x4 b0 = *(const f32x4*)(WI + (rowb + t0 + 2 + h) * 8), b1 = *(const f32x4*)(WI + (rowb + t0 + 2 + h) * 8 + 4);
#pragma unroll
      for (int e = 0; e < 4; ++e) { wlo[e] = a0[e]; wlo[4 + e] = a1[e]; whi[e] = b0[e]; whi[4 + e] = b1[e]; } }
    f32x32 sA0, sA1, sB0, sB1;
#pragma unroll
    for (int i = 0; i < 32; ++i) { sA0[i] = NEGF; sA1[i] = NEGF; sB0[i] = NEGF; sB1[i] = NEGF; }
    const int ktmax = (t0 + 3) >> 5, tlo = t0 + h, thi = t0 + 2 + h;
    const unsigned lb = (unsigned)(size_t)lds;
    const int sw = (r >> 1) & 7;
#define IDX_LDS4(R0, R1, R2, R3) asm volatile("ds_read_b128 %0, %4\n\tds_read_b128 %1, %5\n\tds_read_b128 %2, %6\n\tds_read_b128 %3, %7" \
                                             : "=&v"(R0), "=&v"(R1), "=&v"(R2), "=&v"(R3) : "v"(a0), "v"(a1), "v"(a2), "v"(a3) : "memory")
#define IDX_TILE(KTL, KEY0, SA, SB, C0, C1, C2, C3, N0, N1, N2, N3) \
        { \
            a0 += 4096u; a1 += 4096u; a2 += 4096u; a3 += 4096u; \
            IDX_LDS4(N0, N1, N2, N3);                          \
            asm volatile("s_waitcnt lgkmcnt(4)" : "+v"(C0), "+v"(C1), "+v"(C2), "+v"(C3) :: "memory");     \
            f32x16 acc; \
            _Pragma("unroll") for (int i = 0; i < 16; ++i) acc[i] = 0.f; \
            acc = __builtin_amdgcn_mfma_f32_32x32x16_f16(__builtin_bit_cast(h16x8, aq[0]), __builtin_bit_cast(h16x8, C0), acc, 0, 0, 0); acc = __builtin_amdgcn_mfma_f32_32x32x16_f16(__builtin_bit_cast(h16x8, aq[1]), __builtin_bit_cast(h16x8, C1), acc, 0, 0, 0); \
            acc = __builtin_amdgcn_mfma_f32_32x32x16_f16(__builtin_bit_cast(h16x8, aq[2]), __builtin_bit_cast(h16x8, C2), acc, 0, 0, 0); acc = __builtin_amdgcn_mfma_f32_32x32x16_f16(__builtin_bit_cast(h16x8, aq[3]), __builtin_bit_cast(h16x8, C3), acc, 0, 0, 0); \
            f32x2 p0 = (f32x2){0.f, 0.f}, p1 = (f32x2){0.f, 0.f};            \
            _Pragma("unroll") for (int i = 0; i < 4; ++i) { \
                const f32x2 r0 = (f32x2){__builtin_amdgcn_fmed3f(acc[2 * i], 0.f, 3.0e38f), __builtin_amdgcn_fmed3f(acc[2 * i + 1], 0.f, 3.0e38f)}; \
                const f32x2 r1 = (f32x2){__builtin_amdgcn_fmed3f(acc[8 + 2 * i], 0.f, 3.0e38f), __builtin_amdgcn_fmed3f(acc[9 + 2 * i], 0.f, 3.0e38f)}; \
                p0 = __builtin_elementwise_fma((f32x2){wlo[2 * i], wlo[2 * i + 1]}, r0, p0); p1 = __builtin_elementwise_fma((f32x2){whi[2 * i], whi[2 * i + 1]}, r1, p1); } \
            const float s0 = p0.x + p0.y, s1 = p1.x + p1.y; \
            const int key = (KEY0) + r; \
            SA[KTL] = key <= tlo ? s0 : NEGF; SB[KTL] = key <= thi ? s1 : NEGF; \
        }
    bf16x8 ta0, ta1, ta2, ta3, tb0, tb1, tb2, tb3;
#pragma unroll
    for (int rnd = 0; rnd < 2; ++rnd) {
        if (rnd >= nrounds) break;
        __syncthreads();
        {
            const int rl = lane >> 3, pp = lane & 7;
#pragma unroll 4
            for (int j = 0; j < 16; ++j) { const int pi = wave * 16 + j, row = 8 * pi + rl;
                const bf16_t* src = KIN + (rowb + 1024 * rnd + row) * 64 + 8 * (pp ^ ((row >> 1) & 7));
                __builtin_amdgcn_global_load_lds((const unsigned*)src, (LAS unsigned*)(lds + 1024 * pi), 16, 0, 0); }
        }
        asm volatile("s_waitcnt vmcnt(0)" ::: "memory");
        __syncthreads();
        const int ntl = ktmax - 32 * rnd + 1;
        if (active && ntl > 0) {
            const int npair = ((ntl < 32 ? ntl : 32) + 1) >> 1;
            unsigned a0 = lb + (unsigned)r * 128u + 16u * (unsigned)((0 + h) ^ sw), a1 = lb + (unsigned)r * 128u + 16u * (unsigned)((2 + h) ^ sw);
            unsigned a2 = lb + (unsigned)r * 128u + 16u * (unsigned)((4 + h) ^ sw), a3 = lb + (unsigned)r * 128u + 16u * (unsigned)((6 + h) ^ sw);
            IDX_LDS4(ta0, ta1, ta2, ta3);
#pragma nounroll
            for (int kp = 0; kp < npair; ++kp) {
                if (rnd == 0) { IDX_TILE(2 * kp, 64 * kp, sA0, sB0, ta0, ta1, ta2, ta3, tb0, tb1, tb2, tb3)
                                IDX_TILE(2 * kp + 1, 64 * kp + 32, sA0, sB0, tb0, tb1, tb2, tb3, ta0, ta1, ta2, ta3) }
                else          { IDX_TILE(2 * kp, 1024 + 64 * kp, sA1, sB1, ta0, ta1, ta2, ta3, tb0, tb1, tb2, tb3)
                                IDX_TILE(2 * kp + 1, 1024 + 64 * kp + 32, sA1, sB1, tb0, tb1, tb2, tb3, ta0, ta1, ta2, ta3) }
            }
            asm volatile("s_waitcnt lgkmcnt(0)" : "+v"(ta0), "+v"(ta1), "+v"(ta2), "+v"(ta3), "+v"(tb0), "+v"(tb1), "+v"(tb2), "+v"(tb3) :: "memory");
        }
    }
#undef IDX_TILE
#undef IDX_LDS4
    if (!active) return;
    const int nt0 = ktmax < 31 ? ktmax + 1 : 32, nt1 = ktmax - 31;
    float mxA = NEGF, mxB = NEGF, mnA = -NEGF, mnB = -NEGF;
#pragma nounroll
    for (int kt = 0; kt < nt0; ++kt) { const float a = sA0[kt], bb = sB0[kt];
        mxA = fmaxf(mxA, a); mxB = fmaxf(mxB, bb); mnA = fminf(mnA, a > -1e29f ? a : -NEGF); mnB = fminf(mnB, bb > -1e29f ? bb : -NEGF); }
#pragma nounroll
    for (int kt = 0; kt < nt1; ++kt) { const float a = sA1[kt], bb = sB1[kt];
        mxA = fmaxf(mxA, a); mxB = fmaxf(mxB, bb); mnA = fminf(mnA, a > -1e29f ? a : -NEGF); mnB = fminf(mnB, bb > -1e29f ? bb : -NEGF); }
    mxA = half_max(mxA); mxB = half_max(mxB); mnA = -half_max(-mnA); mnB = -half_max(-mnB);
    const int Ka = tlo + 1 < TOPK ? tlo + 1 : TOPK, Kb = thi + 1 < TOPK ? thi + 1 : TOPK;
    float loA = mnA - (fabsf(mnA) * 1e-6f + 1e-30f), hiA = mxA, loB = mnB - (fabsf(mnB) * 1e-6f + 1e-30f), hiB = mxB;
    float cloA = (float)(tlo + 1), chiA = 0.0f, cloB = (float)(thi + 1), chiB = 0.0f;
    float TA = -1e29f, TB = -1e29f; bool doneA = (tlo + 1 <= TOPK), doneB = (thi + 1 <= TOPK);
    const int nblk = (ktmax >> 3) + 1;
    const float BIG = 1099511627776.0f;
#define SA2(i) ((i) < 32 ? (f32x2){sA0[(i) & 31], sA0[((i) & 31) + 1]} : (f32x2){sA1[(i) & 31], sA1[((i) & 31) + 1]})
#define SB2(i) ((i) < 32 ? (f32x2){sB0[(i) & 31], sB0[((i) & 31) + 1]} : (f32x2){sB1[(i) & 31], sB1[((i) & 31) + 1]})
#pragma nounroll
    for (int it = 0; it < 48; ++it) {
        if (__ballot(!doneA || !doneB) == 0ull) break;
        const bool bis = (it % 3) == 2;
        const float wA = hiA - loA, wB = hiB - loB;
        float rA = bis ? 0.5f : (cloA - (float)Ka + 0.5f) / (cloA - chiA), rB = bis ? 0.5f : (cloB - (float)Kb + 0.5f) / (cloB - chiB);
        rA = fminf(fmaxf(rA, 0.03f), 0.97f); rB = fminf(fmaxf(rB, 0.03f), 0.97f);
        const float midA = loA + wA * rA, midB = loB + wB * rB;
        const float fA = doneA ? TA : midA, fB = doneB ? TB : midB;
        const f32x2 bigp = (f32x2){BIG, BIG}, nfA = (f32x2){-fA * BIG, -fA * BIG}, nfB = (f32x2){-fB * BIG, -fB * BIG};
        f32x2 cA2 = (f32x2){0.f, 0.f}, cB2 = (f32x2){0.f, 0.f};
#pragma unroll
        for (int blk = 0; blk < 8; ++blk) {
            if (blk < nblk) {
#pragma unroll
                for (int e = 0; e < 4; ++e) { cA2 += pk_gt(SA2(8 * blk + 2 * e), bigp, nfA); cB2 += pk_gt(SB2(8 * blk + 2 * e), bigp, nfB); }
            }
        }
        const int cA = (int)half_sum_f(cA2.x + cA2.y), cB = (int)half_sum_f(cB2.x + cB2.y);
        const bool stuckA = !(midA > loA && midA < hiA), stuckB = !(midB > loB && midB < hiB);
        if (!doneA) { if (cA == Ka) { TA = fA; doneA = true; } else if (stuckA) { TA = loA; doneA = true; } else if (cA > Ka) { loA = midA; cloA = (float)cA; } else { hiA = midA; chiA = (float)cA; } }
        if (!doneB) { if (cB == Kb) { TB = fB; doneB = true; } else if (stuckB) { TB = loB; doneB = true; } else if (cB > Kb) { loB = midB; cloB = (float)cB; } else { hiB = midB; chiB = (float)cB; } }
    }
#undef SA2
#undef SB2
    if (!doneA) TA = loA;
    if (!doneB) TB = loB;
    unsigned w0 = 0u, w1 = 0u, w2 = 0u, w3 = 0u;
#pragma nounroll
    for (int kt = 0; kt < nt0; ++kt) { const unsigned long long ma = __ballot(sA0[kt] > TA), mb = __ballot(sB0[kt] > TB);
        if (lane == kt) { w0 = (unsigned)ma; w1 = (unsigned)(ma >> 32); w2 = (unsigned)mb; w3 = (unsigned)(mb >> 32); } }
#pragma nounroll
    for (int kt = 0; kt < nt1; ++kt) { const unsigned long long ma = __ballot(sA1[kt] > TA), mb = __ballot(sB1[kt] > TB);
        if (lane == 32 + kt) { w0 = (unsigned)ma; w1 = (unsigned)(ma >> 32); w2 = (unsigned)mb; w3 = (unsigned)(mb >> 32); } }
    SEL[(rowb + t0 + 0) * 64 + lane] = w0; SEL[(rowb + t0 + 1) * 64 + lane] = w1; SEL[(rowb + t0 + 2) * 64 + lane] = w2; SEL[(rowb + t0 + 3) * 64 + lane] = w3;
}

#define ATT_F(r) (((r) & 3) | ((((r) >> 3) & 3) << 2))
#define TRB8(OFS, r0, r1, r2, r3, r4, r5, r6, r7, a0, a1, a2, a3, a4, a5, a6, a7) \
    asm volatile("ds_read_b64_tr_b16 %0, %8 offset:" OFS "\n\tds_read_b64_tr_b16 %1, %9 offset:" OFS "\n\tds_read_b64_tr_b16 %2, %10 offset:" OFS "\n\tds_read_b64_tr_b16 %3, %11 offset:" OFS "\n\t" \
                 "ds_read_b64_tr_b16 %4, %12 offset:" OFS "\n\tds_read_b64_tr_b16 %5, %13 offset:" OFS "\n\tds_read_b64_tr_b16 %6, %14 offset:" OFS "\n\tds_read_b64_tr_b16 %7, %15 offset:" OFS "\n\ts_waitcnt lgkmcnt(0)" \
                 : "=&v"(r0), "=&v"(r1), "=&v"(r2), "=&v"(r3), "=&v"(r4), "=&v"(r5), "=&v"(r6), "=&v"(r7) \
                 : "v"(a0), "v"(a1), "v"(a2), "v"(a3), "v"(a4), "v"(a5), "v"(a6), "v"(a7) : "memory")
#define RDK8(OFS, r, a) \
    asm volatile("ds_read_b64 %0, %8 offset:" OFS "\n\tds_read_b64 %1, %9 offset:" OFS "\n\tds_read_b64 %2, %10 offset:" OFS "\n\tds_read_b64 %3, %11 offset:" OFS "\n\t" \
                 "ds_read_b64 %4, %12 offset:" OFS "\n\tds_read_b64 %5, %13 offset:" OFS "\n\tds_read_b64 %6, %14 offset:" OFS "\n\tds_read_b64 %7, %15 offset:" OFS "\n\ts_waitcnt lgkmcnt(0)" \
                 : "=&v"(r[0]), "=&v"(r[1]), "=&v"(r[2]), "=&v"(r[3]), "=&v"(r[4]), "=&v"(r[5]), "=&v"(r[6]), "=&v"(r[7]) \
                 : "v"(a[0]), "v"(a[1]), "v"(a[2]), "v"(a[3]), "v"(a[4]), "v"(a[5]), "v"(a[6]), "v"(a[7]) : "memory")
__device__ __forceinline__ float rows_max(float x) {
    unsigned u = __float_as_uint(x);
    u32x2 r = __builtin_amdgcn_permlane16_swap(u, u, false, false);
    u = __float_as_uint(fmaxf(__uint_as_float(r.x), __uint_as_float(r.y)));
    r = __builtin_amdgcn_permlane32_swap(u, u, false, false);
    return fmaxf(__uint_as_float(r.x), __uint_as_float(r.y));
}
__device__ __forceinline__ float rows_sum(float x) {
    unsigned u = __float_as_uint(x);
    u32x2 r = __builtin_amdgcn_permlane16_swap(u, u, false, false);
    u = __float_as_uint(__uint_as_float(r.x) + __uint_as_float(r.y));
    r = __builtin_amdgcn_permlane32_swap(u, u, false, false);
    return __uint_as_float(r.x) + __uint_as_float(r.y);
}

__device__ __forceinline__ int att_build_list(LAS unsigned* list, const LAS unsigned* btab, unsigned w, int t, int lane) {
    const int pc = __popc(w); int incl = pc;
#pragma unroll
    for (int o = 1; o < 64; o <<= 1) { const int v = __builtin_amdgcn_ds_bpermute(((lane - o) & 63) << 2, incl); if (lane >= o) incl += v; }
    const int total = __builtin_amdgcn_readlane(incl, 63); const int cnt = total < TOPK ? total : TOPK;
    int off = incl - pc;
    while (w) { const int bit = __builtin_ctz(w); w &= w - 1u;
        if (off < TOPK) { const int idx = 32 * lane + bit; int dd = t - idx; dd = dd < 0 ? 0 : (dd > 128 ? 128 : dd); list[off] = (unsigned)idx | (btab[dd] << 16); }
        ++off; }
    for (int sl = cnt + lane; sl < ((cnt + 31) & ~31); sl += 64) list[sl] = 0u;
    return cnt;
}
__device__ __forceinline__ void att_gather32(const unsigned char* CKV8b, const LAS unsigned* list32, LAS unsigned char* slot, int lane) {
    const LAS unsigned* lp = list32 + (lane >> 4);
    unsigned idx[8];
#pragma unroll
    for (int i = 0; i < 8; ++i) idx[i] = lp[4 * i] & 0xffffu;
#pragma unroll
    for (int i = 0; i < 8; ++i) {
        const int rr = 4 * i + (lane >> 4);
        const unsigned char* src = CKV8b + (size_t)idx[i] * RK + 16 * ((lane & 15) ^ ATT_F(rr));
        __builtin_amdgcn_global_load_lds((const unsigned*)src, (LAS unsigned*)(slot + 1024 * i), 16, 0, 0);
    }
}

#define ATT_T(q) (((q) & 2047) ^ (((q) >> 11) ? 255 : 0))
__device__ __forceinline__ void att_wave(const unsigned char* CKV8, const unsigned* SEL, unsigned char* BIG, LAS unsigned char* kvbuf, LAS unsigned* lists, const LAS float* relb, const LAS unsigned* btab,
                                         int xcd, int wx, int nwx, int lane) {
    asm volatile("" : "+v"(lane));
    const int hq = lane & 15, g = lane >> 4;
    const int nq = (2 * SEQ - wx + nwx - 1) / nwx;
    if (nq <= 0) return;
    const unsigned kvb = (unsigned)(size_t)kvbuf;
    unsigned qa[8];
#pragma unroll
    for (int ks = 0; ks < 8; ++ks) qa[ks] = kvb + (unsigned)(8 * (hq >> 2) + (hq & 3)) * 256u + 16u * (unsigned)((2 * ks + (g >> 1)) ^ ATT_F(8 * (hq >> 2) + (hq & 3))) + 8u * (unsigned)(g & 1);
    const int trow = 8 * g + (hq >> 1);
    unsigned ta[16];
#pragma unroll
    for (int nt = 0; nt < 16; ++nt) ta[nt] = kvb + (unsigned)trow * 256u + 16u * (unsigned)(nt ^ ATT_F(trow)) + 8u * (unsigned)(hq & 1);

    int q = wx, b = 2 * xcd + (q >> 11), t = ATT_T(q);
    size_t row = (size_t)b * SEQ + t;
    unsigned wsel = SEL[row * 64 + lane];
    int cnt = att_build_list(lists, btab, wsel, t, lane);
    unsigned wnext = 0u;
    if (nq > 1) { const int q1 = wx + nwx; wnext = SEL[((size_t)(2 * xcd + (q1 >> 11)) * SEQ + ATT_T(q1)) * 64 + lane]; }
    long bq[8];
    { const unsigned char* qp = BIG + row * 8192 + hq * 256 + 8 * g;
#pragma unroll
      for (int ks = 0; ks < 8; ++ks) bq[ks] = *(const long*)(qp + 32 * ks); }
    int par = 0;
    asm volatile("s_waitcnt lgkmcnt(0)" ::: "memory");
    att_gather32(CKV8 + (size_t)b * SEQ * RK, lists, kvbuf, lane);
    for (int k = 0; k < nq; ++k) {
        const int cur = k & 1;
        LAS unsigned* list = lists + cur * 256;
        const bool has_next = (k + 1 < nq);
        const int qn = q + nwx, bn = 2 * xcd + (qn >> 11), tn = ATT_T(qn);
        const size_t rown = (size_t)bn * SEQ + tn;
        int cntn = 0;
        if (has_next) { cntn = att_build_list(lists + (cur ^ 1) * 256, btab, wnext, tn, lane);
            if (k + 2 < nq) { const int q2 = qn + nwx; wnext = SEL[((size_t)(2 * xcd + (q2 >> 11)) * SEQ + ATT_T(q2)) * 64 + lane]; } }
        f32x4 O[16];
#pragma unroll
        for (int nt = 0; nt < 16; ++nt) O[nt] = (f32x4){0.f, 0.f, 0.f, 0.f};
        float mref = NEGF, lsum = 0.f;
        const int nsub = (cnt + 31) >> 5;
        for (int sc = 0; sc < nsub; ++sc) {
            const bool lastc = (sc + 1 == nsub);
            float bias[8];
#pragma unroll
            for (int T = 0; T < 2; ++T) { const u32x4 mt = *(const LAS u32x4*)(list + 32 * sc + 8 * g + 4 * T);
#pragma unroll
                for (int i = 0; i < 4; ++i) bias[4 * T + i] = relb[(mt[i] >> 16) * 16 + hq]; }
            if (!lastc) { att_gather32(CKV8 + (size_t)b * SEQ * RK, list + 32 * (sc + 1), kvbuf + (par ^ 1) * 8192, lane); asm volatile("s_waitcnt vmcnt(8)" ::: "memory"); }
            else if (has_next) { att_gather32(CKV8 + (size_t)bn * SEQ * RK, lists + (cur ^ 1) * 256, kvbuf + (par ^ 1) * 8192, lane); asm volatile("s_waitcnt vmcnt(8)" ::: "memory"); }
            else { asm volatile("s_waitcnt vmcnt(0)" ::: "memory"); }
            f32x4 st0 = (f32x4){0.f, 0.f, 0.f, 0.f}, st1 = st0;
            { long kr[8];
              RDK8("0", kr, qa);
#pragma unroll
              for (int ks = 0; ks < 8; ++ks) st0 = __builtin_amdgcn_mfma_f32_16x16x32_fp8_fp8(kr[ks], bq[ks], st0, 0, 0, 0);
              RDK8("1024", kr, qa);
#pragma unroll
              for (int ks = 0; ks < 8; ++ks) st1 = __builtin_amdgcn_mfma_f32_16x16x32_fp8_fp8(kr[ks], bq[ks], st1, 0, 0, 0); }
            if (lastc && has_next) { const unsigned char* qp = BIG + rown * 8192 + hq * 256 + 8 * g;
#pragma unroll
                for (int ks = 0; ks < 8; ++ks) bq[ks] = *(const long*)(qp + 32 * ks); }
            float lg[8]; float cmax;
#pragma unroll
            for (int i = 0; i < 4; ++i) { lg[i] = st0[i] * (1.0f / 64.0f) + bias[i]; lg[4 + i] = st1[i] * (1.0f / 64.0f) + bias[4 + i]; }
            if (32 * sc + 32 > cnt) {
#pragma unroll
                for (int i = 0; i < 4; ++i) { const int s0 = 32 * sc + 8 * g + i; lg[i] = (s0 < cnt) ? lg[i] : NEGF; lg[4 + i] = (s0 + 4 < cnt) ? lg[4 + i] : NEGF; } }
            cmax = fmaxf(fmaxf(fmaxf(lg[0], lg[1]), fmaxf(lg[2], lg[3])), fmaxf(fmaxf(lg[4], lg[5]), fmaxf(lg[6], lg[7])));
            cmax = rows_max(cmax);
            if (__ballot(cmax > mref + 3.0f) != 0ull) {
                const float mnew = fmaxf(mref, cmax), scl = fast_exp(mref - mnew);
                lsum *= scl;
#pragma unroll
                for (int nt = 0; nt < 16; ++nt) O[nt] = O[nt] * scl;
                mref = mnew;
            }
            float p[8];
#pragma unroll
            for (int i = 0; i < 8; ++i) { p[i] = fast_exp(lg[i] - mref); lsum += p[i]; }
            int pw0 = 0, pw1 = 0;
            pw0 = __builtin_amdgcn_cvt_pk_fp8_f32(p[0] * 16.0f, p[1] * 16.0f, pw0, false); pw0 = __builtin_amdgcn_cvt_pk_fp8_f32(p[2] * 16.0f, p[3] * 16.0f, pw0, true);
            pw1 = __builtin_amdgcn_cvt_pk_fp8_f32(p[4] * 16.0f, p[5] * 16.0f, pw1, false); pw1 = __builtin_amdgcn_cvt_pk_fp8_f32(p[6] * 16.0f, p[7] * 16.0f, pw1, true);
            const long pk = (long)(((unsigned long long)(unsigned)pw1 << 32) | (unsigned long long)(unsigned)pw0);
            {
#define TR8B(r, a, o) asm volatile("ds_read_b64_tr_b8 %0, %8\n\tds_read_b64_tr_b8 %1, %9\n\tds_read_b64_tr_b8 %2, %10\n\tds_read_b64_tr_b8 %3, %11\n\t" \
                                   "ds_read_b64_tr_b8 %4, %12\n\tds_read_b64_tr_b8 %5, %13\n\tds_read_b64_tr_b8 %6, %14\n\tds_read_b64_tr_b8 %7, %15\n\ts_waitcnt lgkmcnt(0)" \
                                   : "=&v"(r[0]), "=&v"(r[1]), "=&v"(r[2]), "=&v"(r[3]), "=&v"(r[4]), "=&v"(r[5]), "=&v"(r[6]), "=&v"(r[7]) \
                                   : "v"(a[o + 0]), "v"(a[o + 1]), "v"(a[o + 2]), "v"(a[o + 3]), "v"(a[o + 4]), "v"(a[o + 5]), "v"(a[o + 6]), "v"(a[o + 7]) : "memory")
                long kt[8];
                TR8B(kt, ta, 0);
#pragma unroll
                for (int e = 0; e < 8; ++e) O[e] = __builtin_amdgcn_mfma_f32_16x16x32_fp8_fp8(kt[e], pk, O[e], 0, 0, 0);
                TR8B(kt, ta, 8);
#pragma unroll
                for (int e = 0; e < 8; ++e) O[8 + e] = __builtin_amdgcn_mfma_f32_16x16x32_fp8_fp8(kt[e], pk, O[8 + e], 0, 0, 0);
#undef TR8B
            }
            par ^= 1;
#pragma unroll
            for (int e = 0; e < 8; ++e) { qa[e] ^= 8192u; ta[e] ^= 8192u; ta[8 + e] ^= 8192u; }
        }
        lsum = rows_sum(lsum);
        const float inv = 1.0f / (16.0f * lsum);
        bf16_t* op = (bf16_t*)(BIG + row * 8192) + hq * 256 + 4 * g;
#pragma unroll
        for (int nt = 0; nt < 16; ++nt) { const f32x4 o = O[nt] * inv; u32x2 wv; wv.x = cvt_pk_bf16(o[0], o[1]); wv.y = cvt_pk_bf16(o[2], o[3]); *(u32x2*)(op + 16 * nt) = wv; }
        q = qn; b = bn; t = tn; row = rown; cnt = cntn;
    }
}

constexpr int SW_KP = 144, SW_VP = 520;
constexpr int SW_K_OFF = 0, SW_V_OFF = 256 * SW_KP, SW_TB_OFF = SW_V_OFF + 64 * SW_VP;
__device__ __forceinline__ void swa_phase(const bf16_t* QKV, bf16_t* OB, const float* relb, const float* sinks, LAS unsigned char* lds, int G) {
    int tid = tid_now();
    const int lane = tid & 63, wave = __builtin_amdgcn_readfirstlane(tid >> 6);
    const int h = lane >> 5, n = lane & 31;
    LAS float* tb = (LAS float*)(lds + SW_TB_OFF);
    for (int u = blockIdx.x; u < BATCH * 16 * KVH; u += G) {
        const int b = u >> 5, nb = (u >> 1) & 15, kvh = u & 1;
        const size_t rowb = (size_t)b * SEQ;
        __syncthreads();
#pragma unroll
        for (int e = 0; e < 4; ++e) { const int id = tid + NTHR * e, j = id >> 3, ch = id & 7; const int pos = (nb - 1) * WIN + j;
            u32x4 kv = (u32x4){0u, 0u, 0u, 0u}, vv = (u32x4){0u, 0u, 0u, 0u};
            if (pos >= 0) { const bf16_t* sp = QKV + (rowb + pos) * B_IN + 1024 + kvh * 64 + ch * 8; kv = *(const u32x4*)sp; vv = *(const u32x4*)(sp + 128); }
            *(LAS u32x4*)(lds + SW_K_OFF + j * SW_KP + ch * 16) = kv;
            LAS bf16_t* vt = (LAS bf16_t*)(lds + SW_V_OFF + (ch * 8) * SW_VP + j * 2);
#pragma unroll
            for (int q = 0; q < 4; ++q) { vt[(2 * q) * (SW_VP / 2)] = (bf16_t)(vv[q] & 0xffffu); vt[(2 * q + 1) * (SW_VP / 2)] = (bf16_t)(vv[q] >> 16); } }
        for (int i = tid; i < GQ * WIN; i += NTHR) { const int gg = i >> 7, dist = i & 127; tb[i] = relb[t5_bucket(dist) * NH + kvh * GQ + gg]; }
        __syncthreads();
        const int qh = kvh * GQ + wave; const float sink = sinks[qh];
        for (int rt = 0; rt < 4; ++rt) {
            const size_t qrow = rowb + nb * WIN + 32 * rt + n;
            bf16x8 bq[4];
#pragma unroll
            for (int ks = 0; ks < 4; ++ks) bq[ks] = *(const bf16x8*)(QKV + qrow * B_IN + qh * 64 + 16 * ks + 8 * h);
            f32x16 s[5];
#pragma unroll
            for (int ct = 0; ct < 5; ++ct) {
#pragma unroll
                for (int i = 0; i < 16; ++i) s[ct][i] = 0.f;
#pragma unroll
                for (int ks = 0; ks < 4; ++ks) { const bf16x8 a = *(const LAS bf16x8*)(lds + SW_K_OFF + (32 * (rt + ct) + n) * SW_KP + (2 * ks + h) * 16);
                    s[ct] = __builtin_amdgcn_mfma_f32_32x32x16_bf16(a, bq[ks], s[ct], 0, 0, 0); } }
            const int qi = 32 * rt + n;
            float mx = NEGF;
#pragma unroll
            for (int ct = 0; ct < 5; ++ct)
#pragma unroll
                for (int i = 0; i < 16; ++i) { const int j = 32 * (rt + ct) + (i & 3) + 8 * (i >> 2) + 4 * h; const int dist = qi + WIN - j;
                    const bool ok = (dist >= 0) && (dist < WIN) && (nb > 0 || j >= WIN);
                    const float v = ok ? s[ct][i] * 0.125f + tb[wave * WIN + (dist & 127)] : NEGF; s[ct][i] = v; mx = fmaxf(mx, v); }
            { const u32x2 r_ = __builtin_amdgcn_permlane32_swap(__float_as_uint(mx), __float_as_uint(mx), false, false); mx = fmaxf(__uint_as_float(r_.x), __uint_as_float(r_.y)); } mx = fmaxf(mx, sink);
            float sum = 0.f;
#pragma unroll
            for (int ct = 0; ct < 5; ++ct)
#pragma unroll
                for (int i = 0; i < 16; ++i) { const float p = fast_exp(s[ct][i] - mx); s[ct][i] = p; sum += p; }
            { const u32x2 r_ = __builtin_amdgcn_permlane32_swap(__float_as_uint(sum), __float_as_uint(sum), false, false); sum = __uint_as_float(r_.x) + __uint_as_float(r_.y); } sum += fast_exp(sink - mx);
            f32x16 o[2];
#pragma unroll
            for (int dt = 0; dt < 2; ++dt)
#pragma unroll
                for (int i = 0; i < 16; ++i) o[dt][i] = 0.f;
#pragma unroll
            for (int ct = 0; ct < 5; ++ct)
#pragma unroll
                for (int s2 = 0; s2 < 2; ++s2) {
                    u32x4 pw; pw.x = cvt_pk_bf16(s[ct][8 * s2 + 0], s[ct][8 * s2 + 1]); pw.y = cvt_pk_bf16(s[ct][8 * s2 + 2], s[ct][8 * s2 + 3]);
                    pw.z = cvt_pk_bf16(s[ct][8 * s2 + 4], s[ct][8 * s2 + 5]); pw.w = cvt_pk_bf16(s[ct][8 * s2 + 6], s[ct][8 * s2 + 7]);
                    const bf16x8 pb = __builtin_bit_cast(bf16x8, pw);
#pragma unroll
                    for (int dt = 0; dt < 2; ++dt) { const LAS unsigned char* vp = lds + SW_V_OFF + (32 * dt + n) * SW_VP + (32 * (rt + ct) + 16 * s2 + 4 * h) * 2;
                        const u32x2 v0 = *(const LAS u32x2*)vp, v1 = *(const LAS u32x2*)(vp + 16);
                        u32x4 va; va.x = v0.x; va.y = v0.y; va.z = v1.x; va.w = v1.y;
                        o[dt] = __builtin_amdgcn_mfma_f32_32x32x16_bf16(__builtin_bit_cast(bf16x8, va), pb, o[dt], 0, 0, 0); }
                }
            const float inv = 16.0f / sum;
            unsigned char* op = (unsigned char*)OB + qrow * D + qh * 64 + 4 * h;
#pragma unroll
            for (int dt = 0; dt < 2; ++dt)
#pragma unroll
                for (int i4 = 0; i4 < 4; ++i4) { int wv = 0;
                    wv = __builtin_amdgcn_cvt_pk_fp8_f32(__builtin_amdgcn_fmed3f(o[dt][4 * i4] * inv, -448.f, 448.f), __builtin_amdgcn_fmed3f(o[dt][4 * i4 + 1] * inv, -448.f, 448.f), wv, false);
                    wv = __builtin_amdgcn_cvt_pk_fp8_f32(__builtin_amdgcn_fmed3f(o[dt][4 * i4 + 2] * inv, -448.f, 448.f), __builtin_amdgcn_fmed3f(o[dt][4 * i4 + 3] * inv, -448.f, 448.f), wv, true);
                    *(unsigned*)(op + 32 * dt + 8 * i4) = (unsigned)wv; }
        }
    }
}

struct Args { const float* in[23]; float* out; unsigned char* ws; };
#define CAS __attribute__((address_space(4)))
__device__ __forceinline__ const CAS Args* kargs() { const CAS Args* p = (const CAS Args*)__builtin_amdgcn_kernarg_segment_ptr(); asm volatile("" : "+s"(p)); return p; }

__global__ void __launch_bounds__(NTHR, 2) trunk_fwd(Args args_by_value) {
    LAS unsigned char* lds = (LAS unsigned char*)lds_raw;
    const int tid = threadIdx.x;
    volatile LAS unsigned* MISC = (volatile LAS unsigned*)(lds + LDS_MISC_OFF);
    for (int u = tid; u < (LDS_BYTES - LDS_MISC_OFF) / 4; u += NTHR) MISC[u] = 0u;
    __syncthreads();
    if ((tid & 63) == 0) MISC[64 + hw_slot()] = (unsigned)(tid >> 6);
    { const CAS Args* A = kargs(); (void)xcd_barrier_post((unsigned*)(A->ws + WS_CTL) + 4096, MISC + 8);
      if (tid == 0) { const unsigned x = xb_xcc_id(); MISC[16] = x; MISC[17] = xb_add((unsigned*)(A->ws + WS_CTL) + 8192 + 64 * x, 1u); } }
#define XCD_RANK(xcd, rank) do { const CAS Args* A_ = kargs(); const unsigned* cw_ = (const unsigned*)(A_->ws + WS_CTL) + 4096; bool ok_ = (gridDim.x & 7) == 0; \
        for (int j_ = 0; j_ < 16; ++j_) { const unsigned c_ = __hip_atomic_load(cw_ + XB_XCNT(j_), __ATOMIC_RELAXED, __HIP_MEMORY_SCOPE_AGENT); ok_ = ok_ && (c_ == (j_ < 8 ? gridDim.x >> 3 : 0u)); } \
        const unsigned hx_ = MISC[16], hr_ = MISC[17]; ok_ = ok_ && hx_ < 8u && hr_ < (gridDim.x >> 3); \
        xcd = ok_ ? (int)hx_ : (int)(blockIdx.x & 7); rank = ok_ ? (int)hr_ : (int)(blockIdx.x >> 3); } while (0)
#define GB() do { const CAS Args* A_ = kargs(); XcdBarrier b_; b_.bar = (unsigned*)(A_->ws + WS_CTL) + 4096; b_.x = xb_xcc_id(); b_.st = MISC + 8; xcd_barrier(b_); } while (0)

    { const CAS Args* A = kargs(); Ptrs P;
#pragma unroll
      for (int i = 0; i < 23; ++i) P.in[i] = A->in[i];
      P.out = A->out; P.ws = A->ws;
      p0_prologue(P, lds, (int)gridDim.x); }
    GB();
    { const CAS Args* A = kargs(); Ptrs P;
#pragma unroll
      for (int i = 0; i < 23; ++i) P.in[i] = A->in[i];
      P.out = A->out; P.ws = A->ws;
      pre_phase(P, lds, (int)gridDim.x); }
    GB();

    for (int l = 0; l < DEPTH; ++l) {
        const bool isA = (l & 1) == 0;
        {
            const CAS Args* A = kargs(); const int G = gridDim.x, j = l >> 1; unsigned char* ws = A->ws;
            const unsigned long long* SS = (const unsigned long long*)(ws + WS_SS) + (size_t)(2 * l) * M;
            if (isA) {
                unsigned char* wa = ws + WS_WA + (size_t)j * WA_STRIDE;
                pg8::Gemm g{(const bf16_t*)(ws + WS_XG), (const bf16_t*)(wa + WINA_OFF), D, D, D, 0, 0}; pg8::StaticOrder S; S.init(M, 2048, G, (int)blockIdx.x);
                pg8::EpiInA E{(bf16_t*)(ws + WS_QO), (bf16_t*)(ws + WS_CKV), (bf16_t*)(ws + WS_QI), (bf16_t*)(ws + WS_KIN), (float*)(ws + WS_WI), A->in[I_AIKG] + j * IDIM, A->in[I_AIKB] + j * IDIM,
                                (const float*)(ws + WS_SHW + SHW_A) + (size_t)j * BATCH * 2048, SS};
                pg8::gemm_phase<pg8::EpiInA, true, 3>(lds, g, S, E);
            } else {
                unsigned char* wb = ws + WS_WB + (size_t)j * WB_STRIDE;
                (void)wb;
                pg8::Gemm g{(const bf16_t*)(ws + WS_XG), (const bf16_t*)(ws + WS_W8B), D / 2, D / 2, D / 2, 0, 0, (unsigned)(B_IN * D)}; pg8::StaticOrder S; S.init(M, B_IN, G, (int)blockIdx.x);
                pg8::EpiBf16Plain<true, true> E{(bf16_t*)(ws + WS_QKV), B_IN, (const float*)(ws + WS_SHW + SHW_B) + (size_t)j * BATCH * B_IN, B_IN, SS,
                                                (const float*)(ws + WS_CWB), (const unsigned long long*)(ws + WS_SS) + (size_t)(2 * l - 1) * M};
                pg8::gemm_phase<pg8::EpiBf16Plain<true, true>, true, 1>(lds, g, S, E);
            }
        }
        GB();
        if (isA) {
            { const CAS Args* A = kargs(); const int G = gridDim.x, j = l >> 1; unsigned char* ws = A->ws;
              unsigned char* wa = ws + WS_WA + (size_t)j * WA_STRIDE;
              pg8::Gemm g{(const bf16_t*)(ws + WS_QO), (const bf16_t*)(wa + WQA_OFF), D, 128, 128, 1, 128}; pg8::StaticOrder S; S.init(M, 4096, G, (int)blockIdx.x);
              pg8::EpiFp8 E{ws + WS_BIG, 8192};
              pg8::gemm_phase<pg8::EpiFp8, true>(lds, g, S, E); }
            { const CAS Args* A = kargs(); const int G = gridDim.x; unsigned char* ws = A->ws;
              const int tid2 = tid_now();
              const int lane = tid2 & 63, wave = __builtin_amdgcn_readfirstlane(tid2 >> 6);
              const bf16_t* CKV = (const bf16_t*)(ws + WS_CKV); unsigned* CKV8 = (unsigned*)(ws + WS_CKV8);
              const int gw = blockIdx.x * NWAVES + wave, NGW = G * NWAVES;
              for (int row = gw; row < M; row += NGW) {
                  const u32x2 v = *((const u32x2*)(CKV + (size_t)row * RK) + lane);
                  const float a0 = __uint_as_float(v.x << 16), a1 = __uint_as_float(v.x & 0xffff0000u), a2 = __uint_as_float(v.y << 16), a3 = __uint_as_float(v.y & 0xffff0000u);
                  const float ss = wave_sum((a0 * a0 + a1 * a1) + (a2 * a2 + a3 * a3));
                  const float rs = 1.0f / sqrtf(ss * (1.0f / RK) + EPS);
                  int w = 0; w = __builtin_amdgcn_cvt_pk_fp8_f32(a0 * rs, a1 * rs, w, false); w = __builtin_amdgcn_cvt_pk_fp8_f32(a2 * rs, a3 * rs, w, true);
                  CKV8[(size_t)row * (RK / 4) + lane] = (unsigned)w;
              } }
            { const CAS Args* A = kargs(); const int G = gridDim.x; unsigned char* ws = A->ws;
              const int tid2 = tid_now();
              const int lane = tid2 & 63, wave = __builtin_amdgcn_readfirstlane(tid2 >> 6);
              int xcd, rank; XCD_RANK(xcd, rank); xcd = __builtin_amdgcn_readfirstlane(xcd); rank = __builtin_amdgcn_readfirstlane(rank);
              const int wx = rank * NWAVES + wave, nwx = (G >> 3) * NWAVES;
              const int nsteps = (1024 + nwx - 1) / nwx;
              for (int st = 0; st < nsteps; ++st) {
                  const int q = wx + st * nwx; const bool active = q < 1024;
                  const int qc = active ? q : (rank * NWAVES + st * nwx < 1024 ? rank * NWAVES + st * nwx : 1023);
                  const int bl = qc >> 9, u = qc & 255, hiq = (qc >> 8) & 1, b = 2 * xcd + bl;
                  const int tg = hiq ? 511 - u : u;
                  idx_task((const bf16_t*)(ws + WS_QI), (const bf16_t*)(ws + WS_KIN), (const float*)(ws + WS_WI), (unsigned*)(ws + WS_SEL), lds, b, tg, lane, wave, active, hiq ? 2 : 1);
              }
              __syncthreads(); }
        } else {
            const CAS Args* A = kargs(); const int G = gridDim.x, j = l >> 1; unsigned char* ws = A->ws;
            swa_phase((const bf16_t*)(ws + WS_QKV), (bf16_t*)(ws + WS_OB), A->in[I_RELB], A->in[I_BSINK] + j * NH, lds, G);
        }
        GB();
        if (isA) {
            { const CAS Args* A = kargs(); const int G = gridDim.x; unsigned char* ws = A->ws;
              const int tid2 = tid_now();
              const int lane = tid2 & 63, wave = __builtin_amdgcn_readfirstlane(tid2 >> 6);
              LAS float* relb = (LAS float*)(lds + 147456);
              LAS unsigned* btab = (LAS unsigned*)(lds + 147456 + 2048);
              for (int i = tid2; i < NBUCK * NH; i += NTHR) relb[i] = A->in[I_RELB][i];
              for (int i = tid2; i < 132; i += NTHR) btab[i] = (unsigned)t5_bucket(i);
              __syncthreads();
              int xcd, rank; XCD_RANK(xcd, rank); xcd = __builtin_amdgcn_readfirstlane(xcd); rank = __builtin_amdgcn_readfirstlane(rank);
              const int wx = rank * NWAVES + wave, nwx = (G >> 3) * NWAVES;
              att_wave(ws + WS_CKV8, (const unsigned*)(ws + WS_SEL), ws + WS_BIG, lds + wave * 16384, (LAS unsigned*)(lds + 131072 + wave * 2048), relb, btab, xcd, wx, nwx, lane); }
            GB();
            { const CAS Args* A = kargs(); const int G = gridDim.x, j = l >> 1; unsigned char* ws = A->ws;
              unsigned char* wa = ws + WS_WA + (size_t)j * WA_STRIDE;
              pg8::Gemm g{(const bf16_t*)(ws + WS_BIG), (const bf16_t*)(wa + WUV_OFF), 4096, D, D, 0, 1024}; pg8::StaticOrder S; S.init(M, D, G, (int)blockIdx.x);
              pg8::EpiFp8 E{ws + WS_OB, D};
              pg8::gemm_phase<pg8::EpiFp8, true>(lds, g, S, E); }
            GB();
        }
        {
            const CAS Args* A = kargs(); const int G = gridDim.x, j = l >> 1; unsigned char* ws = A->ws;
            const float* modl = (const float*)(ws + WS_MOD) + (size_t)l * BATCH * 6144;
            const bf16_t* Ain = (const bf16_t*)(ws + WS_OB);
            const bf16_t* Bw = (const bf16_t*)(isA ? ws + WS_WA + (size_t)j * WA_STRIDE + WOUTA_OFF : ws + WS_WB + (size_t)j * WB_STRIDE + WOUTB_OFF);
            w8_build<false>((const bf16_t*)(ws + WS_W + (size_t)l * W_LAYER + W13_OFF), 2 * DFF, A->in[I_GFFN] + l * D, modl + 4096, ws + WS_W8, (float*)(ws + WS_CW), lds, G);
            pg8::Gemm g{Ain, Bw, D / 2, D / 2, D / 2, 0, 0, 0}; pg8::StaticOrder S; S.init(M, D, G, (int)blockIdx.x);
            pg8::EpiResid<true, true> E{(const bf16_t*)A->out, (bf16_t*)A->out, modl + 2048, isA ? nullptr : A->in[I_BBOUT] + j * D,
                            (bf16_t*)(ws + WS_XG), nullptr, nullptr, (unsigned long long*)(ws + WS_SS) + (size_t)(2 * l + 1) * M, (const unsigned long long*)(ws + WS_SS) + (size_t)(2 * l) * M};
            pg8::gemm_phase<pg8::EpiResid<true, true>, true, 2>(lds, g, S, E);
        }
        GB();
        {
            const CAS Args* A = kargs(); const int G = gridDim.x; unsigned char* ws = A->ws;
            unsigned char* wl = ws + WS_W + (size_t)l * W_LAYER;
            pg8::Gemm g{(const bf16_t*)(ws + WS_XG), (const bf16_t*)(ws + WS_W8), D / 2, D / 2, D / 2, 0, 0, (unsigned)W8_BATCH}; pg8::StaticOrder S; S.init(M, 2 * DFF, G, (int)blockIdx.x);
            pg8::EpiSwiGLU E{(bf16_t*)(ws + WS_HFF), (const float*)(ws + WS_SHW + SHW_F) + (size_t)l * BATCH * 2 * DFF, (const unsigned long long*)(ws + WS_SS) + (size_t)(2 * l + 1) * M,
                             (const float*)(ws + WS_CW), (const unsigned long long*)(ws + WS_SS) + (size_t)(2 * l) * M};
            pg8::gemm_phase<pg8::EpiSwiGLU, true, 1>(lds, g, S, E);
        }
        GB();
        {
            const CAS Args* A = kargs(); const int G = gridDim.x; unsigned char* ws = A->ws;
            unsigned char* wl = ws + WS_W + (size_t)l * W_LAYER;
            const float* modl = (const float*)(ws + WS_MOD) + (size_t)l * BATCH * 6144;
            const int ln = l + 1 < DEPTH ? l + 1 : l;
            pg8::Gemm g{(const bf16_t*)(ws + WS_HFF), (const bf16_t*)(wl + W2_OFF), DFF, DFF, DFF, 0, 0}; pg8::StaticOrder S; S.init(M, D, G, (int)blockIdx.x);
            const bool lastl = (l + 1 == DEPTH);
            if (!lastl && ((l + 1) & 1)) {
                const int jn = (l + 1) >> 1;
                w8_build<true>((const bf16_t*)(ws + WS_WB + (size_t)jn * WB_STRIDE + WINB_OFF), B_IN, A->in[I_GMIX] + ln * D, (const float*)(ws + WS_MOD) + (size_t)ln * BATCH * 6144 + 1024, ws + WS_W8B, (float*)(ws + WS_CWB), lds, G);
                pg8::EpiResid<true, false> E{(const bf16_t*)A->out, (bf16_t*)A->out, modl + 5120, nullptr,
                                (bf16_t*)(ws + WS_XG), nullptr, nullptr, (unsigned long long*)(ws + WS_SS) + (size_t)(2 * l + 2) * M, (const unsigned long long*)(ws + WS_SS) + (size_t)(2 * l + 1) * M};
                pg8::gemm_phase<pg8::EpiResid<true, false>, true>(lds, g, S, E);
            } else {
                pg8::EpiResid<false, false> E{(const bf16_t*)A->out, lastl ? (bf16_t*)(ws + WS_XG) : (bf16_t*)A->out, modl + 5120, nullptr,
                                l + 1 < DEPTH ? (bf16_t*)(ws + WS_XG) : nullptr, A->in[I_GMIX] + ln * D, (const float*)(ws + WS_MOD) + (size_t)ln * BATCH * 6144 + 1024, (unsigned long long*)(ws + WS_SS) + (size_t)(2 * l + 2) * M, nullptr};
                pg8::gemm_phase<pg8::EpiResid<false, false>, true>(lds, g, S, E);
            }
        }
        GB();
    }
    { const CAS Args* A = kargs(); final_norm_phase((const bf16_t*)(A->ws + WS_XG), A->out, A->in[I_GFIN], (int)gridDim.x); }
#undef GB
}

extern "C" void kernel_launch(void* const* d_in, const int* in_sizes, int n_in, void* d_out, int out_size, void* d_ws, size_t ws_size, hipStream_t stream) {
    static int grid = 0;
    if (grid == 0) {
        if (n_in != 23 || out_size != M * D || ws_size < WS_END) { fprintf(stderr, "kernel_launch: unexpected shapes (n_in %d out %d ws %zu)\n", n_in, out_size, ws_size); grid = -1; return; }
        int dev = 0, cus = 0, per_cu = 0;
        if (hipGetDevice(&dev) != hipSuccess || hipDeviceGetAttribute(&cus, hipDeviceAttributeMultiprocessorCount, dev) != hipSuccess) { grid = -1; return; }
        if (hipFuncSetAttribute((const void*)trunk_fwd, hipFuncAttributeMaxDynamicSharedMemorySize, LDS_BYTES) != hipSuccess) { fprintf(stderr, "kernel_launch: hipFuncSetAttribute failed\n"); grid = -1; return; }
        if (hipOccupancyMaxActiveBlocksPerMultiprocessor(&per_cu, (const void*)trunk_fwd, NTHR, LDS_BYTES) != hipSuccess || per_cu < 1) { fprintf(stderr, "kernel_launch: occupancy query says %d\n", per_cu); }
        (void)hipGetLastError();
        grid = cus;
    }
    if (grid < 0) return;
    (void)hipMemsetAsync((char*)d_ws + WS_CTL, 0, CTL_ZERO_BYTES, stream);
    Args a{};
    for (int i = 0; i < 23; ++i) a.in[i] = (const float*)d_in[i];
    a.out = (float*)d_out; a.ws = (unsigned char*)d_ws;
    hipLaunchKernelGGL(trunk_fwd, dim3(grid), dim3(NTHR), LDS_BYTES, stream, a);
    const hipError_t le = hipPeekAtLastError();
    if (le != hipSuccess) fprintf(stderr, "kernel_launch: launch failed: %s\n", hipGetErrorName(le));
}
```

```cpp
#include <hip/hip_runtime.h>
#include <cstdio>
#include <cstdint>


#define GAS __attribute__((address_space(1)))
#define LAS __attribute__((address_space(3)))
typedef unsigned short bf16_t;
typedef short bf16x8 __attribute__((ext_vector_type(8)));
typedef short s16x4 __attribute__((ext_vector_type(4)));
typedef float f32x4 __attribute__((ext_vector_type(4)));
typedef float f32x2 __attribute__((ext_vector_type(2)));
typedef float f32x16 __attribute__((ext_vector_type(16)));
typedef unsigned u32x4 __attribute__((ext_vector_type(4)));
typedef unsigned u32x2 __attribute__((ext_vector_type(2)));
typedef int i32x4 __attribute__((ext_vector_type(4)));
typedef int i32x8 __attribute__((ext_vector_type(8)));

constexpr int D = 1024, BATCH = 16, SEQ = 2048, M = BATCH * SEQ, DEPTH = 4;
constexpr int NH = 16, HD = 64, RK = 256, IH = 8, IDIM = 64, TOPK = 256;
constexpr int KVH = 2, GQ = 8, WIN = 128, NBUCK = 32, DFF = 2816;
constexpr int A_IN = 1864, B_IN = 1280;
constexpr float EPS = 1e-6f;
constexpr float NEGF = -1e30f;
constexpr int NWAVES = 8, NTHR = 512;

constexpr size_t MiB = 1u << 20;
constexpr size_t WS_CTL = 0, CTL_ZERO_BYTES = 4 * MiB;
constexpr size_t WS_SS = 1 * MiB;
constexpr size_t WS_W = 4 * MiB;
constexpr size_t W_LAYER = 17301504;
constexpr size_t W13_OFF = 0, W2_OFF = 11 * MiB;
constexpr size_t WS_WA = WS_W + 4 * W_LAYER;
constexpr size_t WA_STRIDE = 10 * MiB, WINA_OFF = 0, WQA_OFF = 4 * MiB, WUV_OFF = 6 * MiB, WOUTA_OFF = 8 * MiB;
constexpr size_t WS_WB = WS_WA + 2 * WA_STRIDE;
constexpr size_t WB_STRIDE = 4718592, WINB_OFF = 0, WOUTB_OFF = 2621440;
constexpr size_t WS_MOD = 100 * MiB;
constexpr size_t WS_SHW = WS_MOD + 1536 * 1024;
constexpr size_t SHW_A = 0, SHW_B = 2 * 16 * 2048 * 4, SHW_F = SHW_B + 2 * 16 * 1280 * 4;
constexpr size_t WS_XG = 104 * MiB;
constexpr size_t WS_BIG = 104 * MiB;
constexpr size_t WS_HFF = 168 * MiB;
constexpr size_t WS_QO = 360 * MiB;
constexpr size_t WS_CKV = 424 * MiB;
constexpr size_t WS_QI = 440 * MiB;
constexpr size_t WS_KIN = 472 * MiB;
constexpr size_t WS_WI = 476 * MiB;
constexpr size_t WS_SEL = 477 * MiB;
constexpr size_t WS_CKV8 = 486 * MiB;
constexpr size_t WS_QKV = 360 * MiB;
constexpr size_t WS_OB = 440 * MiB;
constexpr size_t WS_W8 = 344 * MiB;
constexpr size_t W8_BATCH = (size_t)2 * 2816 * 1024;
constexpr size_t WS_CW = 504 * MiB;
constexpr size_t WS_W8B = 136 * MiB;
constexpr size_t WS_CWB = WS_CW + 512 * 1024;
constexpr size_t WS_END = 512 * MiB;

constexpr int RING_BYTES = 131072;
constexpr int LDS_MISC_OFF = 155648;
constexpr int LDS_BYTES = 156672;

extern __shared__ __attribute__((aligned(16))) unsigned char lds_raw[];
constexpr int LDS_WAVE_TAB = LDS_MISC_OFF + 256;
__device__ __forceinline__ int lane_now() { int l; asm volatile("v_mbcnt_lo_u32_b32 %0, -1, 0\n\tv_mbcnt_hi_u32_b32 %0, -1, %0" : "=v"(l)); return l; }
__device__ __forceinline__ unsigned hw_slot() { return (unsigned)__builtin_amdgcn_s_getreg((5 << 11) | 4) & 63u; }
__device__ __forceinline__ int wave_now() { return __builtin_amdgcn_readfirstlane((int)*(volatile LAS unsigned*)((LAS unsigned char*)lds_raw + LDS_WAVE_TAB + 4 * hw_slot())); }
__device__ __forceinline__ int tid_now() { return wave_now() * 64 + lane_now(); }
#define RLX_AGENT __ATOMIC_RELAXED, __HIP_MEMORY_SCOPE_AGENT
__device__ __forceinline__ unsigned cvt_pk_bf16(float lo, float hi) { unsigned r; asm volatile("v_cvt_pk_bf16_f32 %0, %1, %2" : "=v"(r) : "v"(lo), "v"(hi)); return r; }
typedef _Float16 h16x2 __attribute__((ext_vector_type(2)));
typedef _Float16 h16x8 __attribute__((ext_vector_type(8)));
__device__ __forceinline__ unsigned cvt_pk_f16(float lo, float hi) { return __builtin_bit_cast(unsigned, __builtin_convertvector((f32x2){lo, hi}, h16x2)); }
__device__ __forceinline__ f32x2 unpk_f16(unsigned u) { return __builtin_convertvector(__builtin_bit_cast(h16x2, u), f32x2); }
__device__ __forceinline__ float bf2f(bf16_t b) { return __uint_as_float(((unsigned)b) << 16); }
__device__ __forceinline__ float half_sum_f(float v);
__device__ __forceinline__ float rows_sum(float x);
__device__ __forceinline__ float wave_sum(float v) {
    v = half_sum_f(v);
    const u32x2 r = __builtin_amdgcn_permlane32_swap(__float_as_uint(v), __float_as_uint(v), false, false);
    return __uint_as_float(r.x) + __uint_as_float(r.y);
}
__device__ __forceinline__ float fast_exp(float x) { return __builtin_amdgcn_exp2f(x * 1.4426950408889634f); }
__device__ __forceinline__ float silu_f(float x) { return x * __builtin_amdgcn_rcpf(1.0f + fast_exp(-x)); }
__device__ __forceinline__ int t5_bucket(int d) {
    if (d < 16) return d;
    int b = 16;
    b += (d >= 19); b += (d >= 21); b += (d >= 24); b += (d >= 27); b += (d >= 31); b += (d >= 35); b += (d >= 40); b += (d >= 46);
    b += (d >= 52); b += (d >= 59); b += (d >= 67); b += (d >= 77); b += (d >= 87); b += (d >= 99); b += (d >= 113);
    return b;
}

#define XB_TMO      128
#define XB_XCNT(j)  (256  + 64 * (j))
#define XB_XSUB(j)  (1280 + 64 * (j))
#define XB_XGEN(j)  (2304 + 64 * (j))
#define XB_TOP      3328
#define XB_TOPGEN   3392
#define XCD_BAR_WORDS 3456
#define XB_SPIN_CAP (1u << 22)

__device__ __forceinline__ unsigned xb_ld(unsigned* p)              { return __hip_atomic_load(p, __ATOMIC_RELAXED, __HIP_MEMORY_SCOPE_AGENT); }
__device__ __forceinline__ unsigned xb_add(unsigned* p, unsigned v) { return __hip_atomic_fetch_add(p, v, __ATOMIC_RELAXED, __HIP_MEMORY_SCOPE_AGENT); }
__device__ __forceinline__ unsigned xb_xcc_id() { return (unsigned)__builtin_amdgcn_s_getreg((3 << 11) | 20) & 0xFu; }
#define XB_SPIN(cond, bar) do { unsigned _sp = 0; while (cond) { __builtin_amdgcn_s_sleep(1); \
    if ((++_sp & 255u) == 0u) { if (xb_ld(&(bar)[XB_TMO])) break; if (_sp > XB_SPIN_CAP) { atomicAdd(&(bar)[XB_TMO], 1u); break; } } } } while (0)

struct XcdBarrier { unsigned* bar; unsigned x; volatile LAS unsigned* st; };

__device__ __forceinline__ XcdBarrier xcd_barrier_post(unsigned* bar, volatile LAS unsigned* st) {
    XcdBarrier b; b.bar = bar; b.x = xb_xcc_id(); b.st = st;
    if (threadIdx.x == 0) (void)xb_add(&bar[XB_XCNT(b.x)], 1u);
    return b;
}
__device__ __forceinline__ void xcd_barrier_complete(unsigned* bar, unsigned x, unsigned& nloc, unsigned& nx) {
    const unsigned G = gridDim.x * gridDim.y * gridDim.z;
    unsigned sum, cnt, mine, sp = 0u;
    for (;;) {
        sum = 0u; cnt = 0u; mine = 0u;
#pragma unroll
        for (unsigned j = 0; j < 16; ++j) { const unsigned c = xb_ld(&bar[XB_XCNT(j)]); sum += c; cnt += (c > 0u) ? 1u : 0u; mine = (j == x) ? c : mine; }
        if (sum == G) break;
        __builtin_amdgcn_s_sleep(1);
        if ((++sp & 255u) == 0u) { if (xb_ld(&bar[XB_TMO])) break; if (sp > XB_SPIN_CAP) { atomicAdd(&bar[XB_TMO], 1u); break; } }
    }
    nloc = mine > 0u ? mine : 1u; nx = cnt > 0u ? cnt : 1u;
}
__device__ __forceinline__ void xcd_barrier(const XcdBarrier& b) {
    asm volatile("s_waitcnt vmcnt(0)" ::: "memory");
    __syncthreads();
    if (tid_now() == 0) {
        unsigned* bar = b.bar;
        __builtin_amdgcn_s_waitcnt(0);
        unsigned nloc = b.st[0], nx = b.st[1];
        if (nloc == 0u) { xcd_barrier_complete(bar, b.x, nloc, nx); b.st[0] = nloc; b.st[1] = nx; }
        const unsigned old = xb_add(&bar[XB_XSUB(b.x)], 1u);
        const unsigned gen = old / nloc;
        if (old + 1u == (gen + 1u) * nloc) {
            __builtin_amdgcn_fence(__ATOMIC_RELEASE, "agent");
            asm volatile("s_waitcnt vmcnt(0)" ::: "memory");
            const unsigned og = xb_add(&bar[XB_TOP], 1u);
            const unsigned tg = og / nx;
            if (og + 1u == (tg + 1u) * nx) xb_add(&bar[XB_TOPGEN], 1u);
            else XB_SPIN(xb_ld(&bar[XB_TOPGEN]) == tg, bar);
            __builtin_amdgcn_fence(__ATOMIC_ACQUIRE, "agent");
            xb_add(&bar[XB_XGEN(b.x)], 1u);
            asm volatile("s_waitcnt vmcnt(0)" ::: "memory");
        } else {
            XB_SPIN(xb_ld(&bar[XB_XGEN(b.x)]) == gen, bar);
            __builtin_amdgcn_fence(__ATOMIC_ACQUIRE, "agent");
            asm volatile("s_waitcnt vmcnt(0)" ::: "memory");
        }
    }
    __syncthreads();
}

namespace pg8 {
constexpr int BM = 256, BK = 64, HALF = 128, HTB = HALF * BK * 2, STAGE_BYTES = 8 * HTB, NXCD = 8, WGM = 8;
__host__ __device__ __forceinline__ int lds_byte(int r, int c) { const int st = (r >> 4) * 2 + (c >> 5), rr = r & 15, cc = c & 31, ob = rr * 64 + cc * 2; return st * 1024 + (ob ^ (((ob >> 9) & 1) << 5)); }
__host__ __device__ __forceinline__ void stage_rc(int b, int& R, int& C) { const int st = b / 1024, sb = b % 1024, swz = sb ^ (((sb >> 9) & 1) << 5); R = (st >> 1) * 16 + swz / 64; C = (st & 1) * 32 + (swz % 64) / 2; }
__host__ __device__ __forceinline__ int perm32(int rho) { const int n = rho >> 4, i = rho & 15; return 8 * (i >> 2) + 4 * n + (i & 3); }

struct Unit { int pm, pn; };
struct Gemm { const bf16_t* A; const bf16_t* Bt; int lda, ldb, K, a_shift, a_mul; unsigned bb; };

struct StaticOrder {
    int nM, nN, nwg, G, c;
    __device__ void init(int M_, int N_, int G_, int c_) { nM = M_ / BM; nN = N_ / BM; nwg = nM * nN; G = G_; c = c_; }
    __device__ bool next(int i, Unit& u) const {
        const long L = (long)i * G + c; if (L >= nwg) return false;
        int wgid = (int)L; { const int q = nwg / NXCD, r = nwg % NXCD, xcd = wgid % NXCD, off = wgid / NXCD; wgid = (xcd < r ? xcd * (q + 1) : r * (q + 1) + (xcd - r) * q) + off; }
        const int nig = WGM * nN, gid = wgid / nig, fm = gid * WGM, gsz = (nM - fm) < WGM ? (nM - fm) : WGM;
        u.pm = fm + ((wgid % nig) % gsz); u.pn = (wgid % nig) / gsz; return true;
    }
};

template <class Epi, bool ALIGN_EPI, int MODE = 0>
__device__ __forceinline__ void gemm_phase(LAS unsigned char* lds, const Gemm g, const StaticOrder& S, const Epi& E) {
    int tid = tid_now();
    const int wid = __builtin_amdgcn_readfirstlane(tid >> 6), lane = tid & 63, wr = wid >> 2, wc = wid & 3, fr = lane & 15, fq = lane >> 4;
    const int K = g.K, nt = K / BK;
    unsigned voffA[2], voffB[2];
#pragma unroll
    for (int i = 0; i < 2; ++i) { int R, C; stage_rc(tid * 16 + i * 8192, R, C); const int Rb = Epi::PERM ? ((R & ~31) + perm32(R & 31)) : R;
        voffA[i] = (unsigned)(R * g.lda + C) * 2u; voffB[i] = (unsigned)(Rb * g.ldb + C) * 2u; }
    const size_t kstep = (size_t)(BK * 2);
    const size_t hstepA = (size_t)HALF * g.lda * 2, hstepB = (size_t)HALF * g.ldb * 2;
    const unsigned ldsw = (unsigned)wid * 1024u;
    const int aoff = lds_byte(wr * 64 + fr, fq * 8), boff = lds_byte(wc * 32 + fr, fq * 8);
#define PG8_SA(b, h) (((b) * 2 + (h)) * HTB)
#define PG8_SB(b, h) ((4 + (b) * 2 + (h)) * HTB)
#define PG8_STAGE(bufoff, gbase, voff) do { const char* _gb = (const char*)(gbase); if constexpr (MODE == 2) asm volatile("" : "+s"(_gb));     \
        _Pragma("unroll") for (int _i = 0; _i < 2; ++_i) \
        __builtin_amdgcn_global_load_lds((const unsigned*)(_gb + (voff)[_i]), (LAS unsigned*)(lds + (bufoff) + ldsw + _i * 8192), 16, 0, 0); } while (0)
#define PG8_LDA(dst, b, h) do { _Pragma("unroll") for (int m = 0; m < 4; ++m) _Pragma("unroll") for (int k = 0; k < 2; ++k) dst[m][k] = *(const LAS bf16x8*)(lds + PG8_SA(b, h) + aoff + m * 2048 + k * 1024); } while (0)
#define PG8_LDB(dst, b, h) do { _Pragma("unroll") for (int n = 0; n < 2; ++n) _Pragma("unroll") for (int k = 0; k < 2; ++k) dst[n][k] = *(const LAS bf16x8*)(lds + PG8_SB(b, h) + boff + n * 2048 + k * 1024); } while (0)
#define PG8_CAT(x0, x1) __builtin_shufflevector(__builtin_bit_cast(i32x4, x0), __builtin_bit_cast(i32x4, x1), 0, 1, 2, 3, 4, 5, 6, 7)
#define PG8_MMA(ai, bj, At, Bt) do { __builtin_amdgcn_s_setprio(1); _Pragma("unroll") for (int m = 0; m < 4; ++m) _Pragma("unroll") for (int n = 0; n < 2; ++n) { \
        if constexpr (MODE == 2) acc[ai][bj][m][n] = __builtin_amdgcn_mfma_scale_f32_16x16x128_f8f6f4(PG8_CAT(Bt[n][0], Bt[n][1]), PG8_CAT(At[m][0], At[m][1]), acc[ai][bj][m][n], 0, 0, 0, 0, 0, 0); \
        else { _Pragma("unroll") for (int k = 0; k < 2; ++k) { \
          if constexpr (MODE == 1) acc[ai][bj][m][n] = __builtin_bit_cast(f32x4, __builtin_amdgcn_mfma_i32_16x16x64_i8(__builtin_bit_cast(i32x4, Bt[n][k]), __builtin_bit_cast(i32x4, At[m][k]), __builtin_bit_cast(i32x4, acc[ai][bj][m][n]), 0, 0, 0)); \
          else if constexpr (MODE == 3) acc[ai][bj][m][n] = __builtin_amdgcn_mfma_f32_16x16x32_f16(__builtin_bit_cast(h16x8, Bt[n][k]), __builtin_bit_cast(h16x8, At[m][k]), acc[ai][bj][m][n], 0, 0, 0); \
          else acc[ai][bj][m][n] = __builtin_amdgcn_mfma_f32_16x16x32_bf16(Bt[n][k], At[m][k], acc[ai][bj][m][n], 0, 0, 0); } } } __builtin_amdgcn_s_setprio(0); } while (0)
#define PG8_WAIT_V(n) asm volatile("s_waitcnt vmcnt(" #n ")" ::: "memory")
#define PG8_WAIT_L(n) asm volatile("s_waitcnt lgkmcnt(" #n ")" ::: "memory")
#define PG8_BAR __builtin_amdgcn_s_barrier()
#define PG8_SCHED __builtin_amdgcn_sched_barrier(0)
#define PG8_ABASE(u) ((const char*)g.A + ((size_t)(u).pm * BM * g.lda + (size_t)((u).pn >> g.a_shift) * g.a_mul) * 2)
#define PG8_BBASE(u) ((const char*)g.Bt + (size_t)(u).pn * BM * g.ldb * 2 + (size_t)((u).pm >> 3) * g.bb)
    Unit cur, nxt; int ui = 0;
    if (!S.next(0, cur)) return;
    f32x4 acc[2][2][4][2];
#pragma unroll
    for (int a = 0; a < 2; ++a)
#pragma unroll
        for (int b = 0; b < 2; ++b)
#pragma unroll
            for (int m = 0; m < 4; ++m)
#pragma unroll
                for (int n = 0; n < 2; ++n) acc[a][b][m][n] = (f32x4){0.f, 0.f, 0.f, 0.f};
    bf16x8 At[4][2], B0[2][2], B1[2][2];
    const char* cA = PG8_ABASE(cur); const char* cB = PG8_BBASE(cur);
    PG8_STAGE(PG8_SB(0, 0), cB, voffB); PG8_STAGE(PG8_SB(0, 1), cB + hstepB, voffB); PG8_STAGE(PG8_SA(0, 0), cA, voffA); PG8_STAGE(PG8_SA(0, 1), cA + hstepA, voffA);
    if (wr == 1) PG8_BAR;
    PG8_WAIT_V(2); PG8_BAR;
    PG8_STAGE(PG8_SB(1, 0), cB + kstep, voffB); PG8_STAGE(PG8_SA(1, 0), cA + kstep, voffA); PG8_STAGE(PG8_SB(1, 1), cB + hstepB + kstep, voffB);
    PG8_WAIT_V(6); PG8_BAR;
    for (;;) {
        const bool has_next = S.next(ui + 1, nxt);
        const char* nA = has_next ? PG8_ABASE(nxt) : cA; const char* nB = has_next ? PG8_BBASE(nxt) : cB;
        for (int t = 0; t < nt; t += 2) {
            const bool last = (t == nt - 2);
            if constexpr (Epi::PREFETCH) { if (last) E.prefetch(lds + STAGE_BYTES, cur, wid, lane_now()); }
            const char* a1 = cA + (size_t)(t + 1) * kstep;
            const char* a2 = last ? nA : cA + (size_t)(t + 2) * kstep; const char* b2 = last ? nB : cB + (size_t)(t + 2) * kstep;
            const char* a3 = a2 + kstep; const char* b3 = b2 + kstep;
            PG8_LDB(B0, 0, 0); PG8_LDB(B1, 0, 1); PG8_SCHED; PG8_LDA(At, 0, 0); PG8_STAGE(PG8_SA(1, 1), a1 + hstepA, voffA);
            PG8_WAIT_V(8); PG8_WAIT_L(0); PG8_BAR; PG8_MMA(0, 0, At, B0); PG8_MMA(0, 1, At, B1); PG8_BAR; PG8_SCHED;
            PG8_LDA(At, 0, 1); PG8_STAGE(PG8_SB(0, 0), b2, voffB); PG8_STAGE(PG8_SB(0, 1), b2 + hstepB, voffB); PG8_STAGE(PG8_SA(0, 0), a2, voffA);
            PG8_WAIT_V(8); PG8_WAIT_L(0); PG8_BAR; PG8_MMA(1, 0, At, B0); PG8_MMA(1, 1, At, B1); PG8_BAR; PG8_SCHED;
            PG8_LDB(B0, 1, 0); PG8_LDB(B1, 1, 1); PG8_SCHED; PG8_LDA(At, 1, 0); PG8_STAGE(PG8_SA(0, 1), a2 + hstepA, voffA);
            PG8_WAIT_V(8); PG8_WAIT_L(0); PG8_BAR; PG8_MMA(0, 0, At, B0); PG8_MMA(0, 1, At, B1); PG8_BAR; PG8_SCHED;
            PG8_LDA(At, 1, 1); PG8_STAGE(PG8_SB(1, 0), b3, voffB); PG8_STAGE(PG8_SB(1, 1), b3 + hstepB, voffB); PG8_STAGE(PG8_SA(1, 0), a3, voffA);
            PG8_WAIT_V(8); PG8_WAIT_L(0); PG8_BAR; PG8_MMA(1, 0, At, B0); PG8_MMA(1, 1, At, B1); PG8_BAR; PG8_SCHED;
        }
        if constexpr (ALIGN_EPI) { if (wr == 0) PG8_BAR; }
        { const int l2 = lane_now();
          if constexpr (Epi::PREFETCH) E(acc, cur, wr, wc, l2 & 15, l2 >> 4, lds + STAGE_BYTES); else E(acc, cur, wr, wc, l2 & 15, l2 >> 4); }
        if (!has_next) break;
#pragma unroll
        for (int a = 0; a < 2; ++a)
#pragma unroll
            for (int b = 0; b < 2; ++b)
#pragma unroll
                for (int m = 0; m < 4; ++m)
#pragma unroll
                    for (int n = 0; n < 2; ++n) acc[a][b][m][n] = (f32x4){0.f, 0.f, 0.f, 0.f};
        cur = nxt; cA = nA; cB = nB; ++ui;
        if constexpr (ALIGN_EPI) { if (wr == 1) PG8_BAR; }
    }
    PG8_WAIT_V(0);
    if constexpr (!ALIGN_EPI) { if (wr == 0) PG8_BAR; }
    PG8_BAR;
#undef PG8_SA
#undef PG8_SB
#undef PG8_STAGE
#undef PG8_LDA
#undef PG8_LDB
#undef PG8_MMA
#undef PG8_CAT
#undef PG8_WAIT_V
#undef PG8_WAIT_L
#undef PG8_BAR
#undef PG8_SCHED
#undef PG8_ABASE
#undef PG8_BBASE
}

constexpr float Q8_CLIP = 4.75f;
__device__ __forceinline__ unsigned q8_bits(float v) { return __float_as_uint(__builtin_amdgcn_fmed3f(v, -127.0f, 127.0f) + 12582912.0f); }
__device__ __forceinline__ unsigned q8_pack(unsigned a, unsigned b, unsigned c, unsigned d) { return __builtin_amdgcn_perm(b, a, 0x0c0c0400u) | __builtin_amdgcn_perm(d, c, 0x04000c0cu); }
template <bool NORM, bool I8 = false> struct EpiBf16Plain {
    static constexpr bool PERM = true, PREFETCH = NORM;
    bf16_t* O; int ldc; const float* shw; int shw_stride; const unsigned long long* SS; const float* CW; const unsigned long long* SSq;
    __device__ __forceinline__ void prefetch(LAS unsigned char* aux, const Unit& u, int wid, int lane) const {
        if (wid < 2) __builtin_amdgcn_global_load_lds((const unsigned*)((const char*)(SS + (size_t)u.pm * BM) + wid * 1024 + lane * 16), (LAS unsigned*)(aux + wid * 1024), 16, 0, 0);
        else if (wid == 2) __builtin_amdgcn_global_load_lds((const unsigned*)((const char*)(shw + (size_t)(u.pm >> 3) * shw_stride + u.pn * BM) + lane * 16), (LAS unsigned*)(aux + 2048), 16, 0, 0);
        else if constexpr (I8) {
            if (wid == 3) __builtin_amdgcn_global_load_lds((const unsigned*)((const char*)(CW + (size_t)(u.pm >> 3) * shw_stride + u.pn * BM) + lane * 16), (LAS unsigned*)(aux + 3072), 16, 0, 0);
            else if (wid < 6) __builtin_amdgcn_global_load_lds((const unsigned*)((const char*)(SSq + (size_t)u.pm * BM) + (wid - 4) * 1024 + lane * 16), (LAS unsigned*)(aux + wid * 1024), 16, 0, 0);
        }
    }
    __device__ __forceinline__ void operator()(const f32x4 (&acc)[2][2][4][2], const Unit& u, int wr, int wc, int fr, int fq, const LAS unsigned char* aux = nullptr) const {
        const int row0 = u.pm * BM + wr * 64 + fr, col0 = u.pn * BM + wc * 32 + 8 * fq;
        f32x4 bv[2][2], cv[2][2];
#pragma unroll
        for (int bj = 0; bj < 2; ++bj)
#pragma unroll
            for (int n = 0; n < 2; ++n) { bv[bj][n] = NORM ? *(const LAS f32x4*)((const LAS float*)(aux + 2048) + wc * 32 + 8 * fq + bj * HALF + 4 * n) : (f32x4){0.f, 0.f, 0.f, 0.f};
                cv[bj][n] = I8 ? *(const LAS f32x4*)((const LAS float*)(aux + 3072) + wc * 32 + 8 * fq + bj * HALF + 4 * n) : (f32x4){1.f, 1.f, 1.f, 1.f}; }
        const LAS unsigned long long* ssl = (const LAS unsigned long long*)aux + wr * 64 + fr;
        const LAS unsigned long long* sql = (const LAS unsigned long long*)(aux + 4096) + wr * 64 + fr;
#pragma unroll
        for (int ai = 0; ai < 2; ++ai)
#pragma unroll
            for (int m = 0; m < 4; ++m) { const int row = row0 + ai * HALF + m * 16; bf16_t* rowp = O + (size_t)row * ldc + col0;
                float rs = 1.0f; if (NORM) rs = 1.0f / sqrtf((float)ssl[ai * HALF + m * 16] * (1.0f / (16777216.0f * D)) + EPS);
                if (I8) rs *= (Q8_CLIP / 127.0f) * sqrtf((float)sql[ai * HALF + m * 16] * (1.0f / (16777216.0f * D)) + EPS);
#pragma unroll
                for (int bj = 0; bj < 2; ++bj) { f32x4 a0 = acc[ai][bj][m][0], a1 = acc[ai][bj][m][1];
                    if (I8) {
#pragma unroll
                        for (int e = 0; e < 4; ++e) { a0[e] = (float)__float_as_int(a0[e]) * cv[bj][0][e]; a1[e] = (float)__float_as_int(a1[e]) * cv[bj][1][e]; } }
                    const f32x4 v0 = a0 * rs + bv[bj][0], v1 = a1 * rs + bv[bj][1];
                    u32x4 w; w.x = cvt_pk_bf16(v0[0], v0[1]); w.y = cvt_pk_bf16(v0[2], v0[3]); w.z = cvt_pk_bf16(v1[0], v1[1]); w.w = cvt_pk_bf16(v1[2], v1[3]);
                    *(u32x4*)(rowp + bj * HALF) = w; } }
    }
};
struct EpiFp8 {
    static constexpr bool PERM = true, PREFETCH = false;
    unsigned char* O; int ldc;
    __device__ __forceinline__ void operator()(const f32x4 (&acc)[2][2][4][2], const Unit& u, int wr, int wc, int fr, int fq) const {
        const int row0 = u.pm * BM + wr * 64 + fr, col0 = u.pn * BM + wc * 32 + 8 * fq;
#pragma unroll
        for (int ai = 0; ai < 2; ++ai)
#pragma unroll
            for (int m = 0; m < 4; ++m) { unsigned char* rowp = O + (size_t)(row0 + ai * HALF + m * 16) * ldc + col0;
#pragma unroll
                for (int bj = 0; bj < 2; ++bj) { const f32x4 v0 = acc[ai][bj][m][0], v1 = acc[ai][bj][m][1];
                    int w0 = 0, w1 = 0;
                    w0 = __builtin_amdgcn_cvt_pk_fp8_f32(v0[0], v0[1], w0, false); w0 = __builtin_amdgcn_cvt_pk_fp8_f32(v0[2], v0[3], w0, true);
                    w1 = __builtin_amdgcn_cvt_pk_fp8_f32(v1[0], v1[1], w1, false); w1 = __builtin_amdgcn_cvt_pk_fp8_f32(v1[2], v1[3], w1, true);
                    u32x2 w; w.x = (unsigned)w0; w.y = (unsigned)w1; *(u32x2*)(rowp + bj * HALF) = w; }
                asm volatile("" ::: "memory"); }
    }
};
struct EpiInA {
    static constexpr bool PERM = true, PREFETCH = true;
    bf16_t* Q; bf16_t* CKV; bf16_t* QI; bf16_t* KIN; float* WI; const float* kg; const float* kb; const float* shw; const unsigned long long* SS;
    __device__ __forceinline__ void prefetch(LAS unsigned char* aux, const Unit& u, int wid, int lane) const {
        if (wid < 2) __builtin_amdgcn_global_load_lds((const unsigned*)((const char*)(SS + (size_t)u.pm * BM) + wid * 1024 + lane * 16), (LAS unsigned*)(aux + wid * 1024), 16, 0, 0);
        else if (wid == 2) __builtin_amdgcn_global_load_lds((const unsigned*)((const char*)(shw + (size_t)(u.pm >> 3) * 2048 + u.pn * BM) + lane * 16), (LAS unsigned*)(aux + 2048), 16, 0, 0);
    }
    __device__ __forceinline__ void operator()(f32x4 (&acc)[2][2][4][2], const Unit& u, int wr, int wc, int fr, int fq, const LAS unsigned char* aux) const {
        const int row0 = u.pm * BM + wr * 64 + fr, cl = wc * 32 + 8 * fq;
        {
            const LAS float* sp = (const LAS float*)(aux + 2048) + cl;
            const LAS unsigned long long* ssl = (const LAS unsigned long long*)aux + wr * 64 + fr;
            f32x4 bv[2][2];
#pragma unroll
            for (int bj = 0; bj < 2; ++bj)
#pragma unroll
                for (int n = 0; n < 2; ++n) bv[bj][n] = *(const LAS f32x4*)(sp + bj * HALF + 4 * n);
#pragma unroll
            for (int ai = 0; ai < 2; ++ai)
#pragma unroll
                for (int m = 0; m < 4; ++m) { const float rs = 1.0f / sqrtf((float)ssl[ai * HALF + m * 16] * (1.0f / (16777216.0f * D)) + EPS);
#pragma unroll
                    for (int bj = 0; bj < 2; ++bj)
#pragma unroll
                        for (int n = 0; n < 2; ++n) acc[ai][bj][m][n] = acc[ai][bj][m][n] * rs + bv[bj][n]; }
        }
        if (u.pn < 7) {
            bf16_t* base; int ldc, c0;
            if (u.pn < 4) { base = Q; ldc = 1024; c0 = u.pn * 256; } else if (u.pn == 4) { base = CKV; ldc = 256; c0 = 0; } else { base = QI; ldc = 512; c0 = (u.pn - 5) * 256; }
#pragma unroll
            for (int ai = 0; ai < 2; ++ai)
#pragma unroll
                for (int m = 0; m < 4; ++m) { bf16_t* rowp = base + (size_t)(row0 + ai * HALF + m * 16) * ldc + c0 + cl;
#pragma unroll
                    for (int bj = 0; bj < 2; ++bj) { const f32x4 v0 = acc[ai][bj][m][0], v1 = acc[ai][bj][m][1];
                        u32x4 w;
                        if (u.pn >= 5) { w.x = cvt_pk_f16(v0[0], v0[1]); w.y = cvt_pk_f16(v0[2], v0[3]); w.z = cvt_pk_f16(v1[0], v1[1]); w.w = cvt_pk_f16(v1[2], v1[3]); }
                        else { w.x = cvt_pk_bf16(v0[0], v0[1]); w.y = cvt_pk_bf16(v0[2], v0[3]); w.z = cvt_pk_bf16(v1[0], v1[1]); w.w = cvt_pk_bf16(v1[2], v1[3]); }
                        *(u32x4*)(rowp + bj * HALF) = w; } }
        } else if (wc == 0) {
            f32x4 gv[2][2], bv[2][2];
#pragma unroll
            for (int bj = 0; bj < 2; ++bj)
#pragma unroll
                for (int n = 0; n < 2; ++n) { gv[bj][n] = *(const f32x4*)(kg + 32 * bj + 8 * fq + 4 * n); bv[bj][n] = *(const f32x4*)(kb + 32 * bj + 8 * fq + 4 * n); }
#pragma unroll
            for (int ai = 0; ai < 2; ++ai)
#pragma unroll
                for (int m = 0; m < 4; ++m) {
                    float s = 0.f;
#pragma unroll
                    for (int bj = 0; bj < 2; ++bj)
#pragma unroll
                        for (int n = 0; n < 2; ++n) { const f32x4 x = acc[ai][bj][m][n]; s += (x[0] + x[1]) + (x[2] + x[3]); }
                    s = rows_sum(s);
                    const float mu = s * (1.0f / 64.0f); float q = 0.f;
#pragma unroll
                    for (int bj = 0; bj < 2; ++bj)
#pragma unroll
                        for (int n = 0; n < 2; ++n) { const f32x4 d = acc[ai][bj][m][n] - mu; q += (d[0] * d[0] + d[1] * d[1]) + (d[2] * d[2] + d[3] * d[3]); }
                    q = rows_sum(q);
                    const float rs = 1.0f / sqrtf(q * (1.0f / 64.0f) + EPS);
                    bf16_t* rowp = KIN + (size_t)(row0 + ai * HALF + m * 16) * 64 + 8 * fq;
#pragma unroll
                    for (int bj = 0; bj < 2; ++bj) { const f32x4 v0 = (acc[ai][bj][m][0] - mu) * rs * gv[bj][0] + bv[bj][0], v1 = (acc[ai][bj][m][1] - mu) * rs * gv[bj][1] + bv[bj][1];
                        u32x4 w; w.x = cvt_pk_f16(v0[0], v0[1]); w.y = cvt_pk_f16(v0[2], v0[3]); w.z = cvt_pk_f16(v1[0], v1[1]); w.w = cvt_pk_f16(v1[2], v1[3]);
                        *(u32x4*)(rowp + bj * 32) = w; }
                }
        } else if (wc == 1 && fq == 0) {
            const float sc = 0.04419417382415922f;
#pragma unroll
            for (int ai = 0; ai < 2; ++ai)
#pragma unroll
                for (int m = 0; m < 4; ++m) { float* rowp = WI + (size_t)(row0 + ai * HALF + m * 16) * 8;
                    *(f32x4*)(rowp) = acc[ai][0][m][0] * sc; *(f32x4*)(rowp + 4) = acc[ai][0][m][1] * sc; }
        }
    }
};
template <bool Q8, bool FP8ACC> struct EpiResid {
    static constexpr bool PERM = true, PREFETCH = true;
    const bf16_t* xin_b; bf16_t* xout_b;
    const float* gate; const float* bias;
    static constexpr float asc = FP8ACC ? 1.0f / 4096.0f : 1.0f;
    bf16_t* XG; const float* gn; const float* scn; unsigned long long* SSo; const unsigned long long* SSq;
    __device__ __forceinline__ void prefetch(LAS unsigned char* aux, const Unit& u, int wid, int lane) const {
        const int b = u.pm >> 3; const char* src = nullptr;
        if (wid == 0) src = (const char*)(gate + (size_t)b * 6144 + u.pn * BM);
        else if (wid == 1) src = bias ? (const char*)(bias + u.pn * BM) : nullptr;
        else if constexpr (Q8) { if (wid == 4 || wid == 5) src = (const char*)(SSq + (size_t)u.pm * BM) + (wid - 4) * 1024; }
        else { if (wid == 2) src = XG ? (const char*)(gn + u.pn * BM) : nullptr;
               else if (wid == 3) src = XG ? (const char*)(scn + (size_t)b * 6144 + u.pn * BM) : nullptr; }
        if (src) __builtin_amdgcn_global_load_lds((const unsigned*)(src + lane * 16), (LAS unsigned*)(aux + wid * 1024), 16, 0, 0);
    }
    __device__ __forceinline__ void operator()(const f32x4 (&acc)[2][2][4][2], const Unit& u, int wr, int wc, int fr, int fq, const LAS unsigned char* aux) const {
        const int row0 = u.pm * BM + wr * 64 + fr, col0 = u.pn * BM + wc * 32 + 8 * fq, b = u.pm >> 3;
        const LAS unsigned long long* sql = (const LAS unsigned long long*)(aux + 4096) + wr * 64 + fr;
        const LAS float* lv = (const LAS float*)aux + wc * 32 + 8 * fq;
        float ssum[2][4];
#pragma unroll
        for (int ai = 0; ai < 2; ++ai)
#pragma unroll
            for (int m = 0; m < 4; ++m) ssum[ai][m] = 0.f;
#pragma unroll
        for (int bj = 0; bj < 2; ++bj) {
            const int c = col0 + bj * HALF;
            const LAS float* lp = lv + bj * HALF;
            const f32x4 gv0 = *(const LAS f32x4*)(lp), gv1 = *(const LAS f32x4*)(lp + 4);
            f32x4 bv0 = (f32x4){0.f, 0.f, 0.f, 0.f}, bv1 = bv0, gm0 = bv0, gm1 = bv0;
            if (bias) { bv0 = *(const LAS f32x4*)(lp + 256); bv1 = *(const LAS f32x4*)(lp + 256 + 4); }
            if (!Q8 && XG) { gm0 = *(const LAS f32x4*)(lp + 512) * (*(const LAS f32x4*)(lp + 768) + 1.0f); gm1 = *(const LAS f32x4*)(lp + 512 + 4) * (*(const LAS f32x4*)(lp + 768 + 4) + 1.0f); }
#pragma unroll
            for (int ai = 0; ai < 2; ++ai)
#pragma unroll
                for (int m = 0; m < 4; ++m) { const size_t off = (size_t)(row0 + ai * HALF + m * 16) * D + c;
                    const u32x4 xv = *(const u32x4*)(xin_b + off);
                    const f32x2 xa = unpk_f16(xv.x), xb = unpk_f16(xv.y), xc = unpk_f16(xv.z), xd = unpk_f16(xv.w);
                    const f32x4 xi0 = (f32x4){xa.x, xa.y, xb.x, xb.y}, xi1 = (f32x4){xc.x, xc.y, xd.x, xd.y};
                    const f32x4 xo0 = xi0 + gv0 * (acc[ai][bj][m][0] * asc + bv0), xo1 = xi1 + gv1 * (acc[ai][bj][m][1] * asc + bv1);
                    { u32x4 w; w.x = cvt_pk_f16(xo0[0], xo0[1]); w.y = cvt_pk_f16(xo0[2], xo0[3]); w.z = cvt_pk_f16(xo1[0], xo1[1]); w.w = cvt_pk_f16(xo1[2], xo1[3]); *(u32x4*)(xout_b + off) = w; }
                    if (XG) {
                        ssum[ai][m] += ((xo0[0] * xo0[0] + xo0[1] * xo0[1]) + (xo0[2] * xo0[2] + xo0[3] * xo0[3])) + ((xo1[0] * xo1[0] + xo1[1] * xo1[1]) + (xo1[2] * xo1[2] + xo1[3] * xo1[3]));
                        if constexpr (Q8) {
                            const float qs = (127.0f / Q8_CLIP) / sqrtf((float)sql[ai * HALF + m * 16] * (1.0f / (16777216.0f * D)) + EPS);
                            u32x2 w; w.x = q8_pack(q8_bits(xo0[0] * qs), q8_bits(xo0[1] * qs), q8_bits(xo0[2] * qs), q8_bits(xo0[3] * qs));
                            w.y = q8_pack(q8_bits(xo1[0] * qs), q8_bits(xo1[1] * qs), q8_bits(xo1[2] * qs), q8_bits(xo1[3] * qs));
                            *(u32x2*)((unsigned char*)XG + off) = w;
                        } else {
                        const f32x4 y0 = xo0 * gm0, y1 = xo1 * gm1;
                        u32x4 w; w.x = cvt_pk_f16(y0[0], y0[1]); w.y = cvt_pk_f16(y0[2], y0[3]); w.z = cvt_pk_f16(y1[0], y1[1]); w.w = cvt_pk_f16(y1[2], y1[3]);
                        *(u32x4*)(XG + off) = w; } }
                    if (m & 1) asm volatile("" ::: "memory"); }
        }
        if (XG) {
#pragma unroll
            for (int ai = 0; ai < 2; ++ai)
#pragma unroll
                for (int m = 0; m < 4; ++m) { float q = ssum[ai][m]; q = rows_sum(q);
                    if (fq == 0) atomicAdd(SSo + row0 + ai * HALF + m * 16, (unsigned long long)(q * 16777216.0f)); }
        }
    }
};
struct EpiSwiGLU {
    static constexpr bool PERM = true, PREFETCH = true;
    bf16_t* H; const float* shw; const unsigned long long* SS; const float* CW; const unsigned long long* SSq;
    __device__ __forceinline__ void prefetch(LAS unsigned char* aux, const Unit& u, int wid, int lane) const {
        if (wid < 2) __builtin_amdgcn_global_load_lds((const unsigned*)((const char*)(SS + (size_t)u.pm * BM) + wid * 1024 + lane * 16), (LAS unsigned*)(aux + wid * 1024), 16, 0, 0);
        else if (wid == 2) __builtin_amdgcn_global_load_lds((const unsigned*)((const char*)(shw + (size_t)(u.pm >> 3) * (2 * DFF) + u.pn * BM) + lane * 16), (LAS unsigned*)(aux + 2048), 16, 0, 0);
        else if (wid == 3) __builtin_amdgcn_global_load_lds((const unsigned*)((const char*)(CW + (size_t)(u.pm >> 3) * (2 * DFF) + u.pn * BM) + lane * 16), (LAS unsigned*)(aux + 3072), 16, 0, 0);
        else if (wid < 6) __builtin_amdgcn_global_load_lds((const unsigned*)((const char*)(SSq + (size_t)u.pm * BM) + (wid - 4) * 1024 + lane * 16), (LAS unsigned*)(aux + wid * 1024), 16, 0, 0);
    }
    __device__ __forceinline__ void operator()(const f32x4 (&acc)[2][2][4][2], const Unit& u, int wr, int wc, int fr, int fq, const LAS unsigned char* aux) const {
        const int row0 = u.pm * BM + wr * 64 + fr, f0 = u.pn * 128 + wc * 32 + 8 * fq;
        f32x4 bv[2][2], cv[2][2];
        { const LAS float* sp = (const LAS float*)(aux + 2048) + wc * 32 + 8 * fq;
#pragma unroll
          for (int bj = 0; bj < 2; ++bj)
#pragma unroll
              for (int n = 0; n < 2; ++n) { bv[bj][n] = *(const LAS f32x4*)(sp + bj * HALF + 4 * n); cv[bj][n] = *(const LAS f32x4*)(sp + 256 + bj * HALF + 4 * n); } }
        const LAS unsigned long long* ssl = (const LAS unsigned long long*)aux + wr * 64 + fr;
        const LAS unsigned long long* sql = (const LAS unsigned long long*)(aux + 4096) + wr * 64 + fr;
#pragma unroll
        for (int ai = 0; ai < 2; ++ai)
#pragma unroll
            for (int m = 0; m < 4; ++m) { bf16_t* rowp = H + (size_t)(row0 + ai * HALF + m * 16) * DFF + f0;
                const float rs = (Q8_CLIP / 127.0f) * sqrtf((float)sql[ai * HALF + m * 16] * (1.0f / (16777216.0f * D)) + EPS) / sqrtf((float)ssl[ai * HALF + m * 16] * (1.0f / (16777216.0f * D)) + EPS);
                float o[8];
#pragma unroll
                for (int n = 0; n < 2; ++n)
#pragma unroll
                    for (int e = 0; e < 4; ++e) { const float a0 = (float)__float_as_int(acc[ai][0][m][n][e]) * rs, a1 = (float)__float_as_int(acc[ai][1][m][n][e]) * rs;
                        o[4 * n + e] = silu_f(a0 * cv[0][n][e] + bv[0][n][e]) * (a1 * cv[1][n][e] + bv[1][n][e]); }
                u32x4 w; w.x = cvt_pk_bf16(o[0], o[1]); w.y = cvt_pk_bf16(o[2], o[3]); w.z = cvt_pk_bf16(o[4], o[5]); w.w = cvt_pk_bf16(o[6], o[7]);
                *(u32x4*)(rowp) = w; }
    }
};
}

struct Ptrs {
    const float* in[23]; float* out; unsigned char* ws;
};
enum { I_X = 0, I_C, I_RELB, I_WADA, I_BADA, I_GMIX, I_GFFN, I_AWIN, I_AKVG, I_AWUK, I_AWUV, I_AIKG, I_AIKB, I_AWOUT, I_BWIN, I_BBIN, I_BSINK, I_BWOUT, I_BBOUT, I_W1, I_W3, I_W2, I_GFIN };

__device__ __forceinline__ void conv_task(const Ptrs& P, int th, int lane) {
    const int t = th >> 1, half = th & 1;
    int kind, rb, ks, Kd; bf16_t* dst; const float* s0 = nullptr; const float* s1 = nullptr; const float* gk = nullptr; int ld = 0; bool f8 = false, h16 = false;
    if (t < 2112) { const int l = t / 528, r = t % 528; unsigned char* wl = P.ws + WS_W + (size_t)l * W_LAYER;
        if (r < 352) { kind = 1; rb = r >> 2; ks = r & 3; Kd = 1024; dst = (bf16_t*)(wl + W13_OFF); s0 = P.in[I_W1] + (size_t)l * D * DFF; s1 = P.in[I_W3] + (size_t)l * D * DFF; ld = DFF; }
        else { const int r2 = r - 352; kind = 0; rb = r2 / 11; ks = r2 % 11; Kd = DFF; dst = (bf16_t*)(wl + W2_OFF); s0 = P.in[I_W2] + (size_t)l * DFF * D; ld = D; }
    } else { const int t2 = t - 2112, j = t2 / 464, r = t2 % 464; unsigned char* wa = P.ws + WS_WA + (size_t)j * WA_STRIDE; unsigned char* wb = P.ws + WS_WB + (size_t)j * WB_STRIDE;
        if (r < 128) { kind = 2; rb = r >> 2; ks = r & 3; Kd = 1024; dst = (bf16_t*)(wa + WINA_OFF); s0 = P.in[I_AWIN] + (size_t)j * D * A_IN; ld = A_IN; h16 = true; }
        else if (r < 192) { kind = 3; rb = r - 128; ks = 0; Kd = 128; dst = (bf16_t*)(wa + WQA_OFF); s0 = P.in[I_AWUK] + (size_t)j * NH * RK * HD; gk = P.in[I_AKVG] + j * RK; }
        else if (r < 256) { const int r2 = r - 192; kind = 4; rb = r2 >> 2; ks = r2 & 3; Kd = 1024; dst = (bf16_t*)(wa + WUV_OFF); s0 = P.in[I_AWUV] + (size_t)j * NH * RK * HD; gk = P.in[I_AKVG] + j * RK; }
        else if (r < 320) { const int r2 = r - 256; kind = 0; rb = r2 >> 2; ks = r2 & 3; Kd = 1024; dst = (bf16_t*)(wa + WOUTA_OFF); s0 = P.in[I_AWOUT] + (size_t)j * D * D; ld = D; f8 = true; }
        else if (r < 400) { const int r2 = r - 320; kind = 0; rb = r2 >> 2; ks = r2 & 3; Kd = 1024; dst = (bf16_t*)(wb + WINB_OFF); s0 = P.in[I_BWIN] + (size_t)j * D * B_IN; ld = B_IN; h16 = true; }
        else { const int r2 = r - 400; kind = 0; rb = r2 >> 2; ks = r2 & 3; Kd = 1024; dst = (bf16_t*)(wb + WOUTB_OFF); s0 = P.in[I_BWOUT] + (size_t)j * D * D; ld = D; f8 = true; }
    }
    const int n = rb * 64 + lane, k0 = ks * 256;
    bf16_t* drow = dst + (size_t)n * Kd + k0;
    if (kind <= 2) {
        const float* src = s0; int col = n;
        if (kind == 1) { const int c = n & 255, f = (n >> 8) * 128 + (c & 127); src = (c < 128) ? s0 : s1; col = f; }
        if (kind == 2) { if (n >= 1792) { const int c = n - 1792; col = c < 32 ? 1792 + c : (c < 40 ? 1856 + (c - 32) : ((c >= 128 && c < 160) ? 1824 + (c - 128) : -1)); } }
        const float* sp = src + (size_t)k0 * ld + (col < 0 ? 0 : col);
        for (int kq = 4 * half; kq < 4 * half + 4; ++kq) {
          float vv[4][8];
#pragma unroll
          for (int i = 0; i < 4; ++i)
#pragma unroll
            for (int e = 0; e < 8; ++e) vv[i][e] = sp[(size_t)((kq * 4 + i) * 8 + e) * ld];
          asm volatile("" ::: "memory");
#pragma unroll
          for (int i = 0; i < 4; ++i) { const int kc = kq * 4 + i;
            float v[8];
#pragma unroll
            for (int e = 0; e < 8; ++e) v[e] = vv[i][e];
            if (col < 0) {
#pragma unroll
                for (int e = 0; e < 8; ++e) v[e] = 0.f; }
            if (f8) {
#pragma unroll
                for (int e = 0; e < 8; ++e) v[e] = __builtin_amdgcn_fmed3f(v[e] * 256.0f, -448.0f, 448.0f);
                int w0 = 0, w1 = 0;
                w0 = __builtin_amdgcn_cvt_pk_fp8_f32(v[0], v[1], w0, false); w0 = __builtin_amdgcn_cvt_pk_fp8_f32(v[2], v[3], w0, true);
                w1 = __builtin_amdgcn_cvt_pk_fp8_f32(v[4], v[5], w1, false); w1 = __builtin_amdgcn_cvt_pk_fp8_f32(v[6], v[7], w1, true);
                u32x2 w; w.x = (unsigned)w0; w.y = (unsigned)w1; *(u32x2*)((unsigned char*)dst + (size_t)n * Kd + k0 + kc * 8) = w;
            } else if (h16) {
            u32x4 w; w.x = cvt_pk_f16(v[0], v[1]); w.y = cvt_pk_f16(v[2], v[3]); w.z = cvt_pk_f16(v[4], v[5]); w.w = cvt_pk_f16(v[6], v[7]);
            *(u32x4*)(drow + kc * 8) = w;
            } else {
            u32x4 w; w.x = cvt_pk_bf16(v[0], v[1]); w.y = cvt_pk_bf16(v[2], v[3]); w.z = cvt_pk_bf16(v[4], v[5]); w.w = cvt_pk_bf16(v[6], v[7]);
            *(u32x4*)(drow + kc * 8) = w; }
        } }
    } else if (kind == 3) {
        const int h = n >> 8, r = n & 255; const float gs = gk[r] * 8.0f;       const float* sp = s0 + ((size_t)h * RK + r) * HD;
        for (int kc = 0; kc < (half ? 0 : 16); ++kc) { const int k = kc * 8; float v[8];
            if ((k >> 6) == (h & 1)) {
#pragma unroll
                for (int e = 0; e < 8; ++e) v[e] = sp[(k & 63) + e] * gs;
            } else {
#pragma unroll
                for (int e = 0; e < 8; ++e) v[e] = 0.f; }
            u32x4 w; w.x = cvt_pk_bf16(v[0], v[1]); w.y = cvt_pk_bf16(v[2], v[3]); w.z = cvt_pk_bf16(v[4], v[5]); w.w = cvt_pk_bf16(v[6], v[7]);
            *(u32x4*)(drow + kc * 8) = w; }
    } else {
        const int hh = (n >> 6) & 3, d = n & 63, h = n >> 6;
        for (int kc = 16 * half; kc < 16 * half + 16; ++kc) { const int k = k0 + kc * 8; float v[8];
            if ((k >> 8) == hh) {
#pragma unroll
                for (int e = 0; e < 8; ++e) { const int r = (k & 255) + e; v[e] = s0[((size_t)h * RK + r) * HD + d] * gk[r] * 16.0f; }
            } else {
#pragma unroll
                for (int e = 0; e < 8; ++e) v[e] = 0.f; }
            u32x4 w; w.x = cvt_pk_bf16(v[0], v[1]); w.y = cvt_pk_bf16(v[2], v[3]); w.z = cvt_pk_bf16(v[4], v[5]); w.w = cvt_pk_bf16(v[6], v[7]);
            *(u32x4*)(drow + kc * 8) = w; }
    }
}
constexpr int N_CONV_TASKS = 6080;

__device__ __forceinline__ void p0_prologue(const Ptrs& P, LAS unsigned char* lds, int G) {
    int tid = tid_now();
    const int lane = tid & 63, wave = __builtin_amdgcn_readfirstlane(tid >> 6);
    const int gw = blockIdx.x * NWAVES + wave, NGW = G * NWAVES;
    for (int t = gw; t < N_CONV_TASKS; t += NGW) conv_task(P, t, lane);
    LAS float* cs = (LAS float*)lds;
    LAS float* red = (LAS float*)(lds + 65536);
    for (int i = tid; i < BATCH * D; i += NTHR) { const int b = i >> 10, k = i & 1023; cs[k * 16 + b] = silu_f(P.in[I_C][i]); }
    __syncthreads();
    float* mod = (float*)(P.ws + WS_MOD);
    for (int task = blockIdx.x; task < 4 * 96; task += G) {
        const int l = task / 96, j0 = (task % 96) * 64, col = tid & 63, ksl = tid >> 6;
        const float* wp = P.in[I_WADA] + ((size_t)l * D + ksl * 128) * 6144 + j0 + col;
        float a[16];
#pragma unroll
        for (int b = 0; b < 16; ++b) a[b] = 0.f;
        for (int k = 0; k < 128; ++k) { const float w = wp[(size_t)k * 6144]; const LAS f32x4* c4 = (const LAS f32x4*)(cs + (ksl * 128 + k) * 16);
#pragma unroll
            for (int q = 0; q < 4; ++q) { const f32x4 c = c4[q];
#pragma unroll
                for (int e = 0; e < 4; ++e) a[4 * q + e] += w * c[e]; } }
#pragma unroll
        for (int b = 0; b < 16; ++b) red[(ksl * 64 + col) * 16 + b] = a[b];
        __syncthreads();
        for (int o = tid; o < 1024; o += NTHR) { const int c2 = o >> 4, b = o & 15; float s = 0.f;
#pragma unroll
            for (int q = 0; q < 8; ++q) s += red[(q * 64 + c2) * 16 + b];
            mod[((size_t)l * BATCH + b) * 6144 + j0 + c2] = s + P.in[I_BADA][l * 6144 + j0 + c2]; }
        __syncthreads();
    }
}

__device__ __forceinline__ void pre_phase(const Ptrs& P, LAS unsigned char* lds, int G) {
    int tid = tid_now();
    const int lane = tid & 63, wave = __builtin_amdgcn_readfirstlane(tid >> 6);
    const float* mod = (const float*)(P.ws + WS_MOD);
    {
        const int grp = blockIdx.x & 7, l = grp >> 1, kind = grp & 1, j = l >> 1;
        const float* shsrc = mod + (size_t)l * BATCH * 6144 + (kind ? 3072 : 0);
        constexpr int SP = 2064;
        for (int i = tid; i < BATCH * D / 2; i += NTHR) { const int b = i >> 9, k2 = (i & 511) * 2;
            const float a0 = shsrc[(size_t)b * 6144 + k2], a1 = shsrc[(size_t)b * 6144 + k2 + 1];
            *(LAS unsigned*)(lds + b * SP + k2 * 2) = kind ? cvt_pk_bf16(a0, a1) : cvt_pk_f16(a0, a1); }
        __syncthreads();
        const bf16_t* W; int nrows; float* dst; const float* bias = nullptr;
        if (kind) { W = (const bf16_t*)(P.ws + WS_W + (size_t)l * W_LAYER + W13_OFF); nrows = 2 * DFF; dst = (float*)(P.ws + WS_SHW + SHW_F) + (size_t)l * BATCH * 2 * DFF; }
        else if ((l & 1) == 0) { W = (const bf16_t*)(P.ws + WS_WA + (size_t)j * WA_STRIDE + WINA_OFF); nrows = 2048; dst = (float*)(P.ws + WS_SHW + SHW_A) + (size_t)j * BATCH * 2048; }
        else { W = (const bf16_t*)(P.ws + WS_WB + (size_t)j * WB_STRIDE + WINB_OFF); nrows = B_IN; dst = (float*)(P.ws + WS_SHW + SHW_B) + (size_t)j * BATCH * B_IN; bias = P.in[I_BBIN] + j * B_IN; }
        const int nblk = nrows >> 4, wq = (blockIdx.x >> 3) * NWAVES + wave, nwq = (G >> 3) * NWAVES;
        const int nn = lane & 15, g = lane >> 4;
        for (int blk = wq; blk < nblk; blk += nwq) {
            f32x4 acc = (f32x4){0.f, 0.f, 0.f, 0.f};
            const bf16_t* wp = W + (size_t)(blk * 16 + nn) * D + 8 * g;
#pragma unroll 8
            for (int ks = 0; ks < 32; ++ks) { const bf16x8 a = *(const LAS bf16x8*)(lds + nn * SP + (32 * ks + 8 * g) * 2); const bf16x8 bw = *(const bf16x8*)(wp + 32 * ks);
                acc = kind ? __builtin_amdgcn_mfma_f32_16x16x32_bf16(a, bw, acc, 0, 0, 0) : __builtin_amdgcn_mfma_f32_16x16x32_f16(__builtin_bit_cast(h16x8, a), __builtin_bit_cast(h16x8, bw), acc, 0, 0, 0); }
            const int n = blk * 16 + nn; const float bb = bias ? bias[n] : 0.f;
#pragma unroll
            for (int i = 0; i < 4; ++i) dst[(size_t)(4 * g + i) * nrows + n] = acc[i] + bb;
        }
    }
    {
        const int gw = blockIdx.x * NWAVES + wave, NGW = G * NWAVES;
        const float* x = P.in[I_X]; const float* gmix = P.in[I_GMIX]; bf16_t* XG = (bf16_t*)(P.ws + WS_XG); unsigned long long* SS0 = (unsigned long long*)(P.ws + WS_SS);
        for (int row = gw; row < M; row += NGW) {
            const int b = row >> 11;
            const f32x4* xr = (const f32x4*)(x + (size_t)row * D) + lane;
            f32x4 v[4]; float sq = 0.f;
#pragma unroll
            for (int jj = 0; jj < 4; ++jj) { v[jj] = xr[64 * jj]; sq += (v[jj][0] * v[jj][0] + v[jj][1] * v[jj][1]) + (v[jj][2] * v[jj][2] + v[jj][3] * v[jj][3]); }
            const float ss = wave_sum(sq);
            if (lane == 0) SS0[row] = (unsigned long long)(ss * 16777216.0f);
            const float* mb = mod + (size_t)b * 6144;
            u32x2* o8 = (u32x2*)(XG + (size_t)row * D) + lane; u32x2* x8 = (u32x2*)((bf16_t*)P.out + (size_t)row * D) + lane;
#pragma unroll
            for (int jj = 0; jj < 4; ++jj) { const int c = 4 * lane + 256 * jj;
                const f32x4 y = v[jj] * *(const f32x4*)(gmix + c) * (*(const f32x4*)(mb + 1024 + c) + 1.0f);
                u32x2 w; w.x = cvt_pk_f16(y[0], y[1]); w.y = cvt_pk_f16(y[2], y[3]); o8[64 * jj] = w;
                u32x2 xw; xw.x = cvt_pk_f16(v[jj][0], v[jj][1]); xw.y = cvt_pk_f16(v[jj][2], v[jj][3]); x8[64 * jj] = xw; }
        }
    }
}
__device__ __forceinline__ float half_max(float x);
__device__ __forceinline__ float wave_max(float x) {
    const float h = half_max(x);
    const u32x2 r = __builtin_amdgcn_permlane32_swap(__float_as_uint(h), __float_as_uint(h), false, false);
    return fmaxf(__uint_as_float(r.x), __uint_as_float(r.y));
}
template <bool F16>
__device__ __forceinline__ void w8_build(const bf16_t* W13, int nrows, const float* gffn, const float* scn, unsigned char* W8, float* CW, LAS unsigned char* lds, int G) {
    int tid = tid_now();
    const int lane = tid & 63, wave = __builtin_amdgcn_readfirstlane(tid >> 6);
    LAS float* mL = (LAS float*)lds;
    for (int i = tid; i < BATCH * D / 4; i += NTHR) { const int b = i >> 8, k4 = (i & 255) * 4;
        *(LAS f32x4*)(mL + b * D + k4) = *(const f32x4*)(gffn + k4) * (*(const f32x4*)(scn + (size_t)b * 6144 + k4) + 1.0f); }
    __syncthreads();
    const int gw = blockIdx.x * NWAVES + wave, NGW = G * NWAVES;
    const size_t bstride = (size_t)nrows * D;
    for (int n = gw; n < nrows; n += NGW) {
        const u32x2* wrow = (const u32x2*)(W13 + (size_t)n * D) + lane;
        float w[16];
#pragma unroll
        for (int j = 0; j < 4; ++j) { const u32x2 p = wrow[64 * j];
            if (F16) { const f32x2 pa = unpk_f16(p.x), pb = unpk_f16(p.y); w[4 * j] = pa.x; w[4 * j + 1] = pa.y; w[4 * j + 2] = pb.x; w[4 * j + 3] = pb.y; }
            else { w[4 * j] = __uint_as_float(p.x << 16); w[4 * j + 1] = __uint_as_float(p.x & 0xffff0000u); w[4 * j + 2] = __uint_as_float(p.y << 16); w[4 * j + 3] = __uint_as_float(p.y & 0xffff0000u); } }
        unsigned* orow = (unsigned*)(W8 + (size_t)n * D) + lane;
#pragma unroll 2
        for (int b = 0; b < BATCH; ++b) {
            float v[16]; float mx = 0.f;
#pragma unroll
            for (int j = 0; j < 4; ++j) { const f32x4 mm = *(const LAS f32x4*)(mL + b * D + 256 * j + 4 * lane);
#pragma unroll
                for (int e = 0; e < 4; ++e) v[4 * j + e] = w[4 * j + e] * mm[e];
                mx = fmaxf(fmaxf(mx, fmaxf(fabsf(v[4 * j]), fabsf(v[4 * j + 1]))), fmaxf(fabsf(v[4 * j + 2]), fabsf(v[4 * j + 3]))); }
            mx = fmaxf(wave_max(mx), 1e-30f);
            const float inv = 127.0f / mx;
#pragma unroll
            for (int j = 0; j < 4; ++j)
                orow[(size_t)b * (bstride / 4) + 64 * j] = pg8::q8_pack(__float_as_uint(fmaf(v[4 * j], inv, 12582912.0f)), __float_as_uint(fmaf(v[4 * j + 1], inv, 12582912.0f)),
                                                                          __float_as_uint(fmaf(v[4 * j + 2], inv, 12582912.0f)), __float_as_uint(fmaf(v[4 * j + 3], inv, 12582912.0f)));
            if (lane == 0) CW[(size_t)b * nrows + n] = mx * (1.0f / 127.0f);
        }
    }
    __syncthreads();
}
__device__ __forceinline__ void final_norm_phase(const bf16_t* x, float* out, const float* g, int G) {
    int tid = tid_now();
    const int lane = tid & 63, wave = __builtin_amdgcn_readfirstlane(tid >> 6);
    const int gw = blockIdx.x * NWAVES + wave, NGW = G * NWAVES;
    for (int row = gw; row < M; row += NGW) {
        const u32x2* xr = (const u32x2*)(x + (size_t)row * D) + lane; f32x4* orow = (f32x4*)(out + (size_t)row * D) + lane;
        f32x4 v[4]; float s = 0.f;
#pragma unroll
        for (int j = 0; j < 4; ++j) { const u32x2 p = xr[64 * j];
            { const f32x2 pa = unpk_f16(p.x), pb = unpk_f16(p.y); v[j] = (f32x4){pa.x, pa.y, pb.x, pb.y}; }
            s += (v[j][0] * v[j][0] + v[j][1] * v[j][1]) + (v[j][2] * v[j][2] + v[j][3] * v[j][3]); }
        const float rstd = 1.0f / sqrtf(wave_sum(s) * (1.0f / D) + EPS);
#pragma unroll
        for (int j = 0; j < 4; ++j) { const f32x4 gg = *(const f32x4*)(g + 4 * lane + 256 * j); orow[64 * j] = v[j] * rstd * gg; }
    }
}

__device__ __forceinline__ unsigned f2key(float f) { const unsigned u = __float_as_uint(f); return (u & 0x80000000u) ? ~u : (u | 0x80000000u); }
__device__ __forceinline__ float key2f(unsigned k) { return __uint_as_float((k & 0x80000000u) ? (k & 0x7fffffffu) : ~k); }
__device__ __forceinline__ float half_max(float x) {
    int u = __float_as_int(x);
    u = __float_as_int(fmaxf(__int_as_float(u), __int_as_float(__builtin_amdgcn_update_dpp(u, u, 0x128, 0xf, 0xf, false))));
    u = __float_as_int(fmaxf(__int_as_float(u), __int_as_float(__builtin_amdgcn_update_dpp(u, u, 0x124, 0xf, 0xf, false))));
    u = __float_as_int(fmaxf(__int_as_float(u), __int_as_float(__builtin_amdgcn_update_dpp(u, u, 0x122, 0xf, 0xf, false))));
    u = __float_as_int(fmaxf(__int_as_float(u), __int_as_float(__builtin_amdgcn_update_dpp(u, u, 0x121, 0xf, 0xf, false))));
    const u32x2 r = __builtin_amdgcn_permlane16_swap((unsigned)u, (unsigned)u, false, false);
    return fmaxf(__uint_as_float(r.x), __uint_as_float(r.y));
}
__device__ __forceinline__ float half_sum_f(float v) {
    v += __int_as_float(__builtin_amdgcn_update_dpp(__float_as_int(v), __float_as_int(v), 0x128, 0xf, 0xf, false));
    v += __int_as_float(__builtin_amdgcn_update_dpp(__float_as_int(v), __float_as_int(v), 0x124, 0xf, 0xf, false));
    v += __int_as_float(__builtin_amdgcn_update_dpp(__float_as_int(v), __float_as_int(v), 0x122, 0xf, 0xf, false));
    v += __int_as_float(__builtin_amdgcn_update_dpp(__float_as_int(v), __float_as_int(v), 0x121, 0xf, 0xf, false));
    const u32x2 r = __builtin_amdgcn_permlane16_swap(__float_as_uint(v), __float_as_uint(v), false, false);
    return __uint_as_float(r.x) + __uint_as_float(r.y);
}
__device__ __forceinline__ f32x2 pk_gt(f32x2 x, f32x2 big, f32x2 nfbig) { f32x2 d; asm("v_pk_fma_f32 %0, %1, %2, %3 clamp" : "=v"(d) : "v"(x), "v"(big), "v"(nfbig)); return d; }
__device__ __forceinline__ int half_sum(int v) {
    v += __builtin_amdgcn_update_dpp(v, v, 0x128, 0xf, 0xf, false);
    v += __builtin_amdgcn_update_dpp(v, v, 0x124, 0xf, 0xf, false);
    v += __builtin_amdgcn_update_dpp(v, v, 0x122, 0xf, 0xf, false);
    v += __builtin_amdgcn_update_dpp(v, v, 0x121, 0xf, 0xf, false);
    const u32x2 r = __builtin_amdgcn_permlane16_swap((unsigned)v, (unsigned)v, false, false);
    return (int)(r.x + r.y);
}
typedef float f32x32 __attribute__((ext_vector_type(32)));
__device__ __forceinline__ void idx_task(const bf16_t* QI, const bf16_t* KIN, const float* WI, unsigned* SEL, LAS unsigned char* lds, int b, int tg, int lane, int wave, bool active, int nrounds) {
    asm volatile("" : "+v"(lane));
    const int t0 = tg * 4, h = lane >> 5, r = lane & 31;
    const int qsel = 2 * (r >> 4) + ((r >> 2) & 1), hd = (r & 3) + 4 * ((r >> 3) & 1);
    const size_t rowb = (size_t)b * SEQ;
    bf16x8 aq[4];
#pragma unroll
    for (int ks = 0; ks < 4; ++ks) aq[ks] = *(const bf16x8*)(QI + (rowb + t0 + qsel) * 512 + hd * 64 + ks * 16 + h * 8);
    float wlo[8], whi[8];
    { const f32x4 a0 = *(const f32x4*)(WI + (rowb + t0 + h) * 8), a1 = *(const f32x4*)(WI + (rowb + t0 + h) * 8 + 4);
      const f32x4 b0 = *(const f32x4*)(WI + (rowb + t0 + 2 + h) * 8), b1 = *(const f32x4*)(WI + (rowb + t0 + 2 + h) * 8 + 4);
#pragma unroll
      for (int e = 0; e < 4; ++e) { wlo[e] = a0[e]; wlo[4 + e] = a1[e]; whi[e] = b0[e]; whi[4 + e] = b1[e]; } }
    f32x32 sA0, sA1, sB0, sB1;
#pragma unroll
    for (int i = 0; i < 32; ++i) { sA0[i] = NEGF; sA1[i] = NEGF; sB0[i] = NEGF; sB1[i] = NEGF; }
    const int ktmax = (t0 + 3) >> 5, tlo = t0 + h, thi = t0 + 2 + h;
    const unsigned lb = (unsigned)(size_t)lds;
    const int sw = (r >> 1) & 7;
#define IDX_LDS4(R0, R1, R2, R3) asm volatile("ds_read_b128 %0, %4\n\tds_read_b128 %1, %5\n\tds_read_b128 %2, %6\n\tds_read_b128 %3, %7" \
                                             : "=&v"(R0), "=&v"(R1), "=&v"(R2), "=&v"(R3) : "v"(a0), "v"(a1), "v"(a2), "v"(a3) : "memory")
#define IDX_TILE(KTL, KEY0, SA, SB, C0, C1, C2, C3, N0, N1, N2, N3) \
        { \
            a0 += 4096u; a1 += 4096u; a2 += 4096u; a3 += 4096u; \
            IDX_LDS4(N0, N1, N2, N3);                          \
            asm volatile("s_waitcnt lgkmcnt(4)" : "+v"(C0), "+v"(C1), "+v"(C2), "+v"(C3) :: "memory");     \
            f32x16 acc; \
            _Pragma("unroll") for (int i = 0; i < 16; ++i) acc[i] = 0.f; \
            acc = __builtin_amdgcn_mfma_f32_32x32x16_f16(__builtin_bit_cast(h16x8, aq[0]), __builtin_bit_cast(h16x8, C0), acc, 0, 0, 0); acc = __builtin_amdgcn_mfma_f32_32x32x16_f16(__builtin_bit_cast(h16x8, aq[1]), __builtin_bit_cast(h16x8, C1), acc, 0, 0, 0); \
            acc = __builtin_amdgcn_mfma_f32_32x32x16_f16(__builtin_bit_cast(h16x8, aq[2]), __builtin_bit_cast(h16x8, C2), acc, 0, 0, 0); acc = __builtin_amdgcn_mfma_f32_32x32x16_f16(__builtin_bit_cast(h16x8, aq[3]), __builtin_bit_cast(h16x8, C3), acc, 0, 0, 0); \
            f32x2 p0 = (f32x2){0.f, 0.f}, p1 = (f32x2){0.f, 0.f};            \
            _Pragma("unroll") for (int i = 0; i < 4; ++i) { \
                const f32x2 r0 = (f32x2){__builtin_amdgcn_fmed3f(acc[2 * i], 0.f, 3.0e38f), __builtin_amdgcn_fmed3f(acc[2 * i + 1], 0.f, 3.0e38f)}; \
                const f32x2 r1 = (f32x2){__builtin_amdgcn_fmed3f(acc[8 + 2 * i], 0.f, 3.0e38f), __builtin_amdgcn_fmed3f(acc[9 + 2 * i], 0.f, 3.0e38f)}; \
                p0 = __builtin_elementwise_fma((f32x2){wlo[2 * i], wlo[2 * i + 1]}, r0, p0); p1 = __builtin_elementwise_fma((f32x2){whi[2 * i], whi[2 * i + 1]}, r1, p1); } \
            const float s0 = p0.x + p0.y, s1 = p1.x + p1.y; \
            const int key = (KEY0) + r; \
            SA[KTL] = key <= tlo ? s0 : NEGF; SB[KTL] = key <= thi ? s1 : NEGF; \
        }
    bf16x8 ta0, ta1, ta2, ta3, tb0, tb1, tb2, tb3;
#pragma unroll
    for (int rnd = 0; rnd < 2; ++rnd) {
        if (rnd >= nrounds) break;
        __syncthreads();
        {
            const int rl = lane >> 3, pp = lane & 7;
#pragma unroll 4
            for (int j = 0; j < 16; ++j) { const int pi = wave * 16 + j, row = 8 * pi + rl;
                const bf16_t* src = KIN + (rowb + 1024 * rnd + row) * 64 + 8 * (pp ^ ((row >> 1) & 7));
                __builtin_amdgcn_global_load_lds((const unsigned*)src, (LAS unsigned*)(lds + 1024 * pi), 16, 0, 0); }
        }
        asm volatile("s_waitcnt vmcnt(0)" ::: "memory");
        __syncthreads();
        const int ntl = ktmax - 32 * rnd + 1;
        if (active && ntl > 0) {
            const int npair = ((ntl < 32 ? ntl : 32) + 1) >> 1;
            unsigned a0 = lb + (unsigned)r * 128u + 16u * (unsigned)((0 + h) ^ sw), a1 = lb + (unsigned)r * 128u + 16u * (unsigned)((2 + h) ^ sw);
            unsigned a2 = lb + (unsigned)r * 128u + 16u * (unsigned)((4 + h) ^ sw), a3 = lb + (unsigned)r * 128u + 16u * (unsigned)((6 + h) ^ sw);
            IDX_LDS4(ta0, ta1, ta2, ta3);
#pragma nounroll
            for (int kp = 0; kp < npair; ++kp) {
                if (rnd == 0) { IDX_TILE(2 * kp, 64 * kp, sA0, sB0, ta0, ta1, ta2, ta3, tb0, tb1, tb2, tb3)
                                IDX_TILE(2 * kp + 1, 64 * kp + 32, sA0, sB0, tb0, tb1, tb2, tb3, ta0, ta1, ta2, ta3) }
                else          { IDX_TILE(2 * kp, 1024 + 64 * kp, sA1, sB1, ta0, ta1, ta2, ta3, tb0, tb1, tb2, tb3)
                                IDX_TILE(2 * kp + 1, 1024 + 64 * kp + 32, sA1, sB1, tb0, tb1, tb2, tb3, ta0, ta1, ta2, ta3) }
            }
            asm volatile("s_waitcnt lgkmcnt(0)" : "+v"(ta0), "+v"(ta1), "+v"(ta2), "+v"(ta3), "+v"(tb0), "+v"(tb1), "+v"(tb2), "+v"(tb3) :: "memory");
        }
    }
#undef IDX_TILE
#undef IDX_LDS4
    if (!active) return;
    const int nt0 = ktmax < 31 ? ktmax + 1 : 32, nt1 = ktmax - 31;
    float mxA = NEGF, mxB = NEGF, mnA = -NEGF, mnB = -NEGF;
#pragma nounroll
    for (int kt = 0; kt < nt0; ++kt) { const float a = sA0[kt], bb = sB0[kt];
        mxA = fmaxf(mxA, a); mxB = fmaxf(mxB, bb); mnA = fminf(mnA, a > -1e29f ? a : -NEGF); mnB = fminf(mnB, bb > -1e29f ? bb : -NEGF); }
#pragma nounroll
    for (int kt = 0; kt < nt1; ++kt) { const float a = sA1[kt], bb = sB1[kt];
        mxA = fmaxf(mxA, a); mxB = fmaxf(mxB, bb); mnA = fminf(mnA, a > -1e29f ? a : -NEGF); mnB = fminf(mnB, bb > -1e29f ? bb : -NEGF); }
    mxA = half_max(mxA); mxB = half_max(mxB); mnA = -half_max(-mnA); mnB = -half_max(-mnB);
    const int Ka = tlo + 1 < TOPK ? tlo + 1 : TOPK, Kb = thi + 1 < TOPK ? thi + 1 : TOPK;
    float loA = mnA - (fabsf(mnA) * 1e-6f + 1e-30f), hiA = mxA, loB = mnB - (fabsf(mnB) * 1e-6f + 1e-30f), hiB = mxB;
    float cloA = (float)(tlo + 1), chiA = 0.0f, cloB = (float)(thi + 1), chiB = 0.0f;
    float TA = -1e29f, TB = -1e29f; bool doneA = (tlo + 1 <= TOPK), doneB = (thi + 1 <= TOPK);
    const int nblk = (ktmax >> 3) + 1;
    const float BIG = 1099511627776.0f;
#define SA2(i) ((i) < 32 ? (f32x2){sA0[(i) & 31], sA0[((i) & 31) + 1]} : (f32x2){sA1[(i) & 31], sA1[((i) & 31) + 1]})
#define SB2(i) ((i) < 32 ? (f32x2){sB0[(i) & 31], sB0[((i) & 31) + 1]} : (f32x2){sB1[(i) & 31], sB1[((i) & 31) + 1]})
#pragma nounroll
    for (int it = 0; it < 48; ++it) {
        if (__ballot(!doneA || !doneB) == 0ull) break;
        const bool bis = (it % 3) == 2;
        const float wA = hiA - loA, wB = hiB - loB;
        float rA = bis ? 0.5f : (cloA - (float)Ka + 0.5f) / (cloA - chiA), rB = bis ? 0.5f : (cloB - (float)Kb + 0.5f) / (cloB - chiB);
        rA = fminf(fmaxf(rA, 0.03f), 0.97f); rB = fminf(fmaxf(rB, 0.03f), 0.97f);
        const float midA = loA + wA * rA, midB = loB + wB * rB;
        const float fA = doneA ? TA : midA, fB = doneB ? TB : midB;
        const f32x2 bigp = (f32x2){BIG, BIG}, nfA = (f32x2){-fA * BIG, -fA * BIG}, nfB = (f32x2){-fB * BIG, -fB * BIG};
        f32x2 cA2 = (f32x2){0.f, 0.f}, cB2 = (f32x2){0.f, 0.f};
#pragma unroll
        for (int blk = 0; blk < 8; ++blk) {
            if (blk < nblk) {
#pragma unroll
                for (int e = 0; e < 4; ++e) { cA2 += pk_gt(SA2(8 * blk + 2 * e), bigp, nfA); cB2 += pk_gt(SB2(8 * blk + 2 * e), bigp, nfB); }
            }
        }
        const int cA = (int)half_sum_f(cA2.x + cA2.y), cB = (int)half_sum_f(cB2.x + cB2.y);
        const bool stuckA = !(midA > loA && midA < hiA), stuckB = !(midB > loB && midB < hiB);
        if (!doneA) { if (cA == Ka) { TA = fA; doneA = true; } else if (stuckA) { TA = loA; doneA = true; } else if (cA > Ka) { loA = midA; cloA = (float)cA; } else { hiA = midA; chiA = (float)cA; } }
        if (!doneB) { if (cB == Kb) { TB = fB; doneB = true; } else if (stuckB) { TB = loB; doneB = true; } else if (cB > Kb) { loB = midB; cloB = (float)cB; } else { hiB = midB; chiB = (float)cB; } }
    }
#undef SA2
#undef SB2
    if (!doneA) TA = loA;
    if (!doneB) TB = loB;
    unsigned w0 = 0u, w1 = 0u, w2 = 0u, w3 = 0u;
#pragma nounroll
    for (int kt = 0; kt < nt0; ++kt) { const unsigned long long ma = __ballot(sA0[kt] > TA), mb = __ballot(sB0[kt] > TB);
        if (lane == kt) { w0 = (unsigned)ma; w1 = (unsigned)(ma >> 32); w2 = (unsigned)mb; w3 = (unsigned)(mb >> 32); } }
#pragma nounroll
    for (int kt = 0; kt < nt1; ++kt) { const unsigned long long ma = __ballot(sA1[kt] > TA), mb = __ballot(sB1[kt] > TB);
        if (lane == 32 + kt) { w0 = (unsigned)ma; w1 = (unsigned)(ma >> 32); w2 = (unsigned)mb; w3 = (unsigned)(mb >> 32); } }
    SEL[(rowb + t0 + 0) * 64 + lane] = w0; SEL[(rowb + t0 + 1) * 64 + lane] = w1; SEL[(rowb + t0 + 2) * 64 + lane] = w2; SEL[(rowb + t0 + 3) * 64 + lane] = w3;
}

#define ATT_F(r) (((r) & 3) | ((((r) >> 3) & 3) << 2))
#define TRB8(OFS, r0, r1, r2, r3, r4, r5, r6, r7, a0, a1, a2, a3, a4, a5, a6, a7) \
    asm volatile("ds_read_b64_tr_b16 %0, %8 offset:" OFS "\n\tds_read_b64_tr_b16 %1, %9 offset:" OFS "\n\tds_read_b64_tr_b16 %2, %10 offset:" OFS "\n\tds_read_b64_tr_b16 %3, %11 offset:" OFS "\n\t" \
                 "ds_read_b64_tr_b16 %4, %12 offset:" OFS "\n\tds_read_b64_tr_b16 %5, %13 offset:" OFS "\n\tds_read_b64_tr_b16 %6, %14 offset:" OFS "\n\tds_read_b64_tr_b16 %7, %15 offset:" OFS "\n\ts_waitcnt lgkmcnt(0)" \
                 : "=&v"(r0), "=&v"(r1), "=&v"(r2), "=&v"(r3), "=&v"(r4), "=&v"(r5), "=&v"(r6), "=&v"(r7) \
                 : "v"(a0), "v"(a1), "v"(a2), "v"(a3), "v"(a4), "v"(a5), "v"(a6), "v"(a7) : "memory")
#define RDK8(OFS, r, a) \
    asm volatile("ds_read_b64 %0, %8 offset:" OFS "\n\tds_read_b64 %1, %9 offset:" OFS "\n\tds_read_b64 %2, %10 offset:" OFS "\n\tds_read_b64 %3, %11 offset:" OFS "\n\t" \
                 "ds_read_b64 %4, %12 offset:" OFS "\n\tds_read_b64 %5, %13 offset:" OFS "\n\tds_read_b64 %6, %14 offset:" OFS "\n\tds_read_b64 %7, %15 offset:" OFS "\n\ts_waitcnt lgkmcnt(0)" \
                 : "=&v"(r[0]), "=&v"(r[1]), "=&v"(r[2]), "=&v"(r[3]), "=&v"(r[4]), "=&v"(r[5]), "=&v"(r[6]), "=&v"(r[7]) \
                 : "v"(a[0]), "v"(a[1]), "v"(a[2]), "v"(a[3]), "v"(a[4]), "v"(a[5]), "v"(a[6]), "v"(a[7]) : "memory")
__device__ __forceinline__ float rows_max(float x) {
    unsigned u = __float_as_uint(x);
    u32x2 r = __builtin_amdgcn_permlane16_swap(u, u, false, false);
    u = __float_as_uint(fmaxf(__uint_as_float(r.x), __uint_as_float(r.y)));
    r = __builtin_amdgcn_permlane32_swap(u, u, false, false);
    return fmaxf(__uint_as_float(r.x), __uint_as_float(r.y));
}
__device__ __forceinline__ float rows_sum(float x) {
    unsigned u = __float_as_uint(x);
    u32x2 r = __builtin_amdgcn_permlane16_swap(u, u, false, false);
    u = __float_as_uint(__uint_as_float(r.x) + __uint_as_float(r.y));
    r = __builtin_amdgcn_permlane32_swap(u, u, false, false);
    return __uint_as_float(r.x) + __uint_as_float(r.y);
}

__device__ __forceinline__ int att_build_list(LAS unsigned* list, const LAS unsigned* btab, unsigned w, int t, int lane) {
    const int pc = __popc(w); int incl = pc;
#pragma unroll
    for (int o = 1; o < 64; o <<= 1) { const int v = __builtin_amdgcn_ds_bpermute(((lane - o) & 63) << 2, incl); if (lane >= o) incl += v; }
    const int total = __builtin_amdgcn_readlane(incl, 63); const int cnt = total < TOPK ? total : TOPK;
    int off = incl - pc;
    while (w) { const int bit = __builtin_ctz(w); w &= w - 1u;
        if (off < TOPK) { const int idx = 32 * lane + bit; int dd = t - idx; dd = dd < 0 ? 0 : (dd > 128 ? 128 : dd); list[off] = ((unsigned)idx << 8) | (btab[dd] << 24); }
        ++off; }
    for (int sl = cnt + lane; sl < ((cnt + 63) & ~63); sl += 64) list[sl] = 0u;
    return cnt;
}
__device__ __forceinline__ void att_gather32(const unsigned char* CKV8b, const LAS unsigned* list32, LAS unsigned char* slot, int lane) {
    const LAS unsigned* lp = list32 + (lane >> 4);
    unsigned off[8];
#pragma unroll
    for (int i = 0; i < 8; ++i) off[i] = lp[4 * i] & 0xffffffu;
    asm volatile("" : "+s"(CKV8b));
#pragma unroll
    for (int i = 0; i < 8; ++i) {
        const int rr = 4 * i + (lane >> 4);
        __builtin_amdgcn_global_load_lds((const unsigned*)(CKV8b + (off[i] + 16u * (unsigned)((lane & 15) ^ ATT_F(rr)))), (LAS unsigned*)(slot + 1024 * i), 16, 0, 0);
    }
}

#define ATT_T(q) (((q) & 2047) ^ (((q) >> 11) ? 255 : 0))
__device__ __forceinline__ void att_wave(const unsigned char* CKV8, const unsigned* SEL, unsigned char* BIG, LAS unsigned char* kvbuf, LAS unsigned* lists, const LAS float* relb, const LAS unsigned* btab,
                                         int xcd, int wx, int nwx, int lane) {
    asm volatile("" : "+v"(lane));
    const int hq = lane & 15, g = lane >> 4;
    const int nq = (2 * SEQ - wx + nwx - 1) / nwx;
    if (nq <= 0) return;
    const unsigned kvb = (unsigned)(size_t)kvbuf;
    unsigned qa[8];
#pragma unroll
    for (int ks = 0; ks < 8; ++ks) qa[ks] = kvb + (unsigned)(8 * (hq >> 2) + (hq & 3)) * 256u + 16u * (unsigned)((2 * ks + (g >> 1)) ^ ATT_F(8 * (hq >> 2) + (hq & 3))) + 8u * (unsigned)(g & 1);
    const int trow = 8 * g + (hq >> 1);
    unsigned ta[16];
#pragma unroll
    for (int nt = 0; nt < 16; ++nt) ta[nt] = kvb + (unsigned)trow * 256u + 16u * (unsigned)(nt ^ ATT_F(trow)) + 8u * (unsigned)(hq & 1);

    int q = wx, b = 2 * xcd + (q >> 11), t = ATT_T(q);
    size_t row = (size_t)b * SEQ + t;
    unsigned wsel = SEL[row * 64 + lane];
    int cnt = att_build_list(lists, btab, wsel, t, lane);
    unsigned wnext = 0u;
    if (nq > 1) { const int q1 = wx + nwx; wnext = SEL[((size_t)(2 * xcd + (q1 >> 11)) * SEQ + ATT_T(q1)) * 64 + lane]; }
    long bq[8];
    { const unsigned char* qp = BIG + row * 8192 + hq * 256 + 8 * g;
#pragma unroll
      for (int ks = 0; ks < 8; ++ks) bq[ks] = *(const long*)(qp + 32 * ks); }
    asm volatile("s_waitcnt lgkmcnt(0)" ::: "memory");
    att_gather32(CKV8 + (size_t)b * SEQ * RK, lists, kvbuf, lane);
#define TR8B(r, a, o, OFS) asm volatile("ds_read_b64_tr_b8 %0, %8 offset:" OFS "\n\tds_read_b64_tr_b8 %1, %9 offset:" OFS "\n\tds_read_b64_tr_b8 %2, %10 offset:" OFS "\n\tds_read_b64_tr_b8 %3, %11 offset:" OFS "\n\t" \
                                   "ds_read_b64_tr_b8 %4, %12 offset:" OFS "\n\tds_read_b64_tr_b8 %5, %13 offset:" OFS "\n\tds_read_b64_tr_b8 %6, %14 offset:" OFS "\n\tds_read_b64_tr_b8 %7, %15 offset:" OFS "\n\ts_waitcnt lgkmcnt(0)" \
                                   : "=&v"(r[0]), "=&v"(r[1]), "=&v"(r[2]), "=&v"(r[3]), "=&v"(r[4]), "=&v"(r[5]), "=&v"(r[6]), "=&v"(r[7]) \
                                   : "v"(a[o + 0]), "v"(a[o + 1]), "v"(a[o + 2]), "v"(a[o + 3]), "v"(a[o + 4]), "v"(a[o + 5]), "v"(a[o + 6]), "v"(a[o + 7]) : "memory")
#define ATT_SUB(QO0, QO1, NEXT_OFF, CAN_BE_LAST) { \
            const bool lastc = CAN_BE_LAST && (sc + 1 == nsub); \
            float bias[8]; \
            _Pragma("unroll") for (int T = 0; T < 2; ++T) { const u32x4 mt = *(const LAS u32x4*)(list + 32 * sc + 8 * g + 4 * T); \
                _Pragma("unroll") for (int i = 0; i < 4; ++i) bias[4 * T + i] = relb[(mt[i] >> 24) * 16 + hq]; } \
            if (!lastc) { att_gather32(CKV8 + (size_t)b * SEQ * RK, list + 32 * (sc + 1), kvbuf + NEXT_OFF, lane); asm volatile("s_waitcnt vmcnt(8)" ::: "memory"); } \
            else if (has_next) { att_gather32(CKV8 + (size_t)bn * SEQ * RK, lists + (cur ^ 1) * 256, kvbuf + NEXT_OFF, lane); asm volatile("s_waitcnt vmcnt(8)" ::: "memory"); } \
            else { asm volatile("s_waitcnt vmcnt(0)" ::: "memory"); } \
            f32x4 st0 = (f32x4){0.f, 0.f, 0.f, 0.f}, st1 = st0; \
            { long kr[8]; \
              RDK8(QO0, kr, qa); \
              _Pragma("unroll") for (int ks = 0; ks < 8; ++ks) st0 = __builtin_amdgcn_mfma_f32_16x16x32_fp8_fp8(kr[ks], bq[ks], st0, 0, 0, 0); \
              RDK8(QO1, kr, qa); \
              _Pragma("unroll") for (int ks = 0; ks < 8; ++ks) st1 = __builtin_amdgcn_mfma_f32_16x16x32_fp8_fp8(kr[ks], bq[ks], st1, 0, 0, 0); } \
            if (lastc && has_next) { const unsigned char* qp = BIG + rown * 8192 + hq * 256 + 8 * g; \
                _Pragma("unroll") for (int ks = 0; ks < 8; ++ks) bq[ks] = *(const long*)(qp + 32 * ks); } \
            float lg[8]; float cmax; \
            _Pragma("unroll") for (int i = 0; i < 4; ++i) { lg[i] = st0[i] * (1.0f / 64.0f) + bias[i]; lg[4 + i] = st1[i] * (1.0f / 64.0f) + bias[4 + i]; } \
            if (32 * sc + 32 > cnt) { \
                _Pragma("unroll") for (int i = 0; i < 4; ++i) { const int s0 = 32 * sc + 8 * g + i; lg[i] = (s0 < cnt) ? lg[i] : NEGF; lg[4 + i] = (s0 + 4 < cnt) ? lg[4 + i] : NEGF; } } \
            cmax = fmaxf(fmaxf(fmaxf(lg[0], lg[1]), fmaxf(lg[2], lg[3])), fmaxf(fmaxf(lg[4], lg[5]), fmaxf(lg[6], lg[7]))); \
            cmax = rows_max(cmax); \
            if (__ballot(cmax > mref + 3.0f) != 0ull) { \
                const float mnew = fmaxf(mref, cmax), scl = fast_exp(mref - mnew); \
                lsum *= scl; \
                _Pragma("unroll") for (int nt = 0; nt < 16; ++nt) O[nt] = O[nt] * scl; \
                mref = mnew; \
            } \
            float p[8]; \
            _Pragma("unroll") for (int i = 0; i < 8; ++i) { p[i] = fast_exp(lg[i] - mref); lsum += p[i]; } \
            int pw0 = 0, pw1 = 0; \
            pw0 = __builtin_amdgcn_cvt_pk_fp8_f32(p[0] * 16.0f, p[1] * 16.0f, pw0, false); pw0 = __builtin_amdgcn_cvt_pk_fp8_f32(p[2] * 16.0f, p[3] * 16.0f, pw0, true); \
            pw1 = __builtin_amdgcn_cvt_pk_fp8_f32(p[4] * 16.0f, p[5] * 16.0f, pw1, false); pw1 = __builtin_amdgcn_cvt_pk_fp8_f32(p[6] * 16.0f, p[7] * 16.0f, pw1, true); \
            const long pk = (long)(((unsigned long long)(unsigned)pw1 << 32) | (unsigned long long)(unsigned)pw0); \
            { long kt[8]; \
              TR8B(kt, ta, 0, QO0); \
              _Pragma("unroll") for (int e = 0; e < 8; ++e) O[e] = __builtin_amdgcn_mfma_f32_16x16x32_fp8_fp8(kt[e], pk, O[e], 0, 0, 0); \
              TR8B(kt, ta, 8, QO0); \
              _Pragma("unroll") for (int e = 0; e < 8; ++e) O[8 + e] = __builtin_amdgcn_mfma_f32_16x16x32_fp8_fp8(kt[e], pk, O[8 + e], 0, 0, 0); } \
            ++sc; }
    for (int k = 0; k < nq; ++k) {
        const int cur = k & 1;
        LAS unsigned* list = lists + cur * 256;
        const bool has_next = (k + 1 < nq);
        const int qn = q + nwx, bn = 2 * xcd + (qn >> 11), tn = ATT_T(qn);
        const size_t rown = (size_t)bn * SEQ + tn;
        int cntn = 0;
        if (has_next) { cntn = att_build_list(lists + (cur ^ 1) * 256, btab, wnext, tn, lane);
            if (k + 2 < nq) { const int q2 = qn + nwx; wnext = SEL[((size_t)(2 * xcd + (q2 >> 11)) * SEQ + ATT_T(q2)) * 64 + lane]; } }
        f32x4 O[16];
#pragma unroll
        for (int nt = 0; nt < 16; ++nt) O[nt] = (f32x4){0.f, 0.f, 0.f, 0.f};
        float mref = NEGF, lsum = 0.f;
        const int nsub = 2 * ((cnt + 63) >> 6);
        for (int sc = 0; sc < nsub;) {
            ATT_SUB("0", "1024", 8192, false)
            ATT_SUB("8192", "9216", 0, true)
        }
        lsum = rows_sum(lsum);
        const float inv = 1.0f / (16.0f * lsum);
        { LAS unsigned char* ob = kvbuf + 8192;
#pragma unroll
          for (int nt = 0; nt < 16; ++nt) { const f32x4 o = O[nt] * inv; u32x2 wv; wv.x = cvt_pk_bf16(o[0], o[1]); wv.y = cvt_pk_bf16(o[2], o[3]);
              *(LAS u32x2*)(ob + hq * 512 + 16 * ((2 * nt + (g >> 1)) ^ hq) + 8 * (g & 1)) = wv; }
          unsigned char* orow = BIG + row * 8192 + lane * 16;
#pragma unroll
          for (int j = 0; j < 8; ++j) { const int h = 2 * j + (lane >> 5); const u32x4 v = *(const LAS u32x4*)(ob + h * 512 + 16 * ((lane & 31) ^ h)); *(u32x4*)(orow + j * 1024) = v; }
          asm volatile("s_waitcnt lgkmcnt(0)" ::: "memory"); }
        q = qn; b = bn; t = tn; row = rown; cnt = cntn;
    }
#undef ATT_SUB
#undef TR8B
}

constexpr int SW_KP = 144, SW_VP = 520;
constexpr int SW_K_OFF = 0, SW_V_OFF = 256 * SW_KP, SW_TB_OFF = SW_V_OFF + 64 * SW_VP;
__device__ __forceinline__ void swa_phase(const bf16_t* QKV, bf16_t* OB, const float* relb, const float* sinks, LAS unsigned char* lds, int G) {
    int tid = tid_now();
    const int lane = tid & 63, wave = __builtin_amdgcn_readfirstlane(tid >> 6);
    const int h = lane >> 5, n = lane & 31;
    LAS float* tb = (LAS float*)(lds + SW_TB_OFF);
    for (int u = blockIdx.x; u < BATCH * 16 * KVH; u += G) {
        const int b = u >> 5, nb = (u >> 1) & 15, kvh = u & 1;
        const size_t rowb = (size_t)b * SEQ;
        __syncthreads();
#pragma unroll
        for (int e = 0; e < 4; ++e) { const int id = tid + NTHR * e, j = id >> 3, ch = id & 7; const int pos = (nb - 1) * WIN + j;
            u32x4 kv = (u32x4){0u, 0u, 0u, 0u}, vv = (u32x4){0u, 0u, 0u, 0u};
            if (pos >= 0) { const bf16_t* sp = QKV + (rowb + pos) * B_IN + 1024 + kvh * 64 + ch * 8; kv = *(const u32x4*)sp; vv = *(const u32x4*)(sp + 128); }
            *(LAS u32x4*)(lds + SW_K_OFF + j * SW_KP + ch * 16) = kv;
            LAS bf16_t* vt = (LAS bf16_t*)(lds + SW_V_OFF + (ch * 8) * SW_VP + j * 2);
#pragma unroll
            for (int q = 0; q < 4; ++q) { vt[(2 * q) * (SW_VP / 2)] = (bf16_t)(vv[q] & 0xffffu); vt[(2 * q + 1) * (SW_VP / 2)] = (bf16_t)(vv[q] >> 16); } }
        for (int i = tid; i < GQ * WIN; i += NTHR) { const int gg = i >> 7, dist = i & 127; tb[i] = relb[t5_bucket(dist) * NH + kvh * GQ + gg]; }
        __syncthreads();
        const int qh = kvh * GQ + wave; const float sink = sinks[qh];
        for (int rt = 0; rt < 4; ++rt) {
            const size_t qrow = rowb + nb * WIN + 32 * rt + n;
            bf16x8 bq[4];
#pragma unroll
            for (int ks = 0; ks < 4; ++ks) bq[ks] = *(const bf16x8*)(QKV + qrow * B_IN + qh * 64 + 16 * ks + 8 * h);
            f32x16 s[5];
#pragma unroll
            for (int ct = 0; ct < 5; ++ct) {
#pragma unroll
                for (int i = 0; i < 16; ++i) s[ct][i] = 0.f;
#pragma unroll
                for (int ks = 0; ks < 4; ++ks) { const bf16x8 a = *(const LAS bf16x8*)(lds + SW_K_OFF + (32 * (rt + ct) + n) * SW_KP + (2 * ks + h) * 16);
                    s[ct] = __builtin_amdgcn_mfma_f32_32x32x16_bf16(a, bq[ks], s[ct], 0, 0, 0); } }
            const int qi = 32 * rt + n;
            float mx = NEGF;
#pragma unroll
            for (int ct = 0; ct < 5; ++ct)
#pragma unroll
                for (int i = 0; i < 16; ++i) { const int j = 32 * (rt + ct) + (i & 3) + 8 * (i >> 2) + 4 * h; const int dist = qi + WIN - j;
                    const bool ok = (dist >= 0) && (dist < WIN) && (nb > 0 || j >= WIN);
                    const float v = ok ? s[ct][i] * 0.125f + tb[wave * WIN + (dist & 127)] : NEGF; s[ct][i] = v; mx = fmaxf(mx, v); }
            { const u32x2 r_ = __builtin_amdgcn_permlane32_swap(__float_as_uint(mx), __float_as_uint(mx), false, false); mx = fmaxf(__uint_as_float(r_.x), __uint_as_float(r_.y)); } mx = fmaxf(mx, sink);
            float sum = 0.f;
#pragma unroll
            for (int ct = 0; ct < 5; ++ct)
#pragma unroll
                for (int i = 0; i < 16; ++i) { const float p = fast_exp(s[ct][i] - mx); s[ct][i] = p; sum += p; }
            { const u32x2 r_ = __builtin_amdgcn_permlane32_swap(__float_as_uint(sum), __float_as_uint(sum), false, false); sum = __uint_as_float(r_.x) + __uint_as_float(r_.y); } sum += fast_exp(sink - mx);
            f32x16 o[2];
#pragma unroll
            for (int dt = 0; dt < 2; ++dt)
#pragma unroll
                for (int i = 0; i < 16; ++i) o[dt][i] = 0.f;
#pragma unroll
            for (int ct = 0; ct < 5; ++ct)
#pragma unroll
                for (int s2 = 0; s2 < 2; ++s2) {
                    u32x4 pw; pw.x = cvt_pk_bf16(s[ct][8 * s2 + 0], s[ct][8 * s2 + 1]); pw.y = cvt_pk_bf16(s[ct][8 * s2 + 2], s[ct][8 * s2 + 3]);
                    pw.z = cvt_pk_bf16(s[ct][8 * s2 + 4], s[ct][8 * s2 + 5]); pw.w = cvt_pk_bf16(s[ct][8 * s2 + 6], s[ct][8 * s2 + 7]);
                    const bf16x8 pb = __builtin_bit_cast(bf16x8, pw);
#pragma unroll
                    for (int dt = 0; dt < 2; ++dt) { const LAS unsigned char* vp = lds + SW_V_OFF + (32 * dt + n) * SW_VP + (32 * (rt + ct) + 16 * s2 + 4 * h) * 2;
                        const u32x2 v0 = *(const LAS u32x2*)vp, v1 = *(const LAS u32x2*)(vp + 16);
                        u32x4 va; va.x = v0.x; va.y = v0.y; va.z = v1.x; va.w = v1.y;
                        o[dt] = __builtin_amdgcn_mfma_f32_32x32x16_bf16(__builtin_bit_cast(bf16x8, va), pb, o[dt], 0, 0, 0); }
                }
            const float inv = 16.0f / sum;
            unsigned pc[2][4];
#pragma unroll
            for (int dt = 0; dt < 2; ++dt)
#pragma unroll
                for (int i4 = 0; i4 < 4; ++i4) { int wv = 0;
                    wv = __builtin_amdgcn_cvt_pk_fp8_f32(__builtin_amdgcn_fmed3f(o[dt][4 * i4] * inv, -448.f, 448.f), __builtin_amdgcn_fmed3f(o[dt][4 * i4 + 1] * inv, -448.f, 448.f), wv, false);
                    wv = __builtin_amdgcn_cvt_pk_fp8_f32(__builtin_amdgcn_fmed3f(o[dt][4 * i4 + 2] * inv, -448.f, 448.f), __builtin_amdgcn_fmed3f(o[dt][4 * i4 + 3] * inv, -448.f, 448.f), wv, true);
                    pc[dt][i4] = (unsigned)wv; }
            u32x4 w0, w1;
            { const u32x2 a = __builtin_amdgcn_permlane32_swap(pc[0][0], pc[1][0], false, false), b2 = __builtin_amdgcn_permlane32_swap(pc[0][1], pc[1][1], false, false);
              const u32x2 c = __builtin_amdgcn_permlane32_swap(pc[0][2], pc[1][2], false, false), d = __builtin_amdgcn_permlane32_swap(pc[0][3], pc[1][3], false, false);
              w0.x = a.x; w0.y = a.y; w0.z = b2.x; w0.w = b2.y; w1.x = c.x; w1.y = c.y; w1.z = d.x; w1.w = d.y; }
            unsigned char* op = (unsigned char*)OB + qrow * D + qh * 64 + 32 * h;
            *(u32x4*)op = w0; *(u32x4*)(op + 16) = w1;
        }
    }
}

struct Args { const float* in[23]; float* out; unsigned char* ws; };
#define CAS __attribute__((address_space(4)))
__device__ __forceinline__ const CAS Args* kargs() { const CAS Args* p = (const CAS Args*)__builtin_amdgcn_kernarg_segment_ptr(); asm volatile("" : "+s"(p)); return p; }

__global__ void __launch_bounds__(NTHR, 2) trunk_fwd(Args args_by_value) {
    LAS unsigned char* lds = (LAS unsigned char*)lds_raw;
    const int tid = threadIdx.x;
    volatile LAS unsigned* MISC = (volatile LAS unsigned*)(lds + LDS_MISC_OFF);
    for (int u = tid; u < (LDS_BYTES - LDS_MISC_OFF) / 4; u += NTHR) MISC[u] = 0u;
    __syncthreads();
    if ((tid & 63) == 0) MISC[64 + hw_slot()] = (unsigned)(tid >> 6);
    { const CAS Args* A = kargs(); (void)xcd_barrier_post((unsigned*)(A->ws + WS_CTL) + 4096, MISC + 8);
      if (tid == 0) { const unsigned x = xb_xcc_id(); MISC[16] = x; MISC[17] = xb_add((unsigned*)(A->ws + WS_CTL) + 8192 + 64 * x, 1u); } }
#define XCD_RANK(xcd, rank) do { const CAS Args* A_ = kargs(); const unsigned* cw_ = (const unsigned*)(A_->ws + WS_CTL) + 4096; bool ok_ = (gridDim.x & 7) == 0; \
        for (int j_ = 0; j_ < 16; ++j_) { const unsigned c_ = __hip_atomic_load(cw_ + XB_XCNT(j_), __ATOMIC_RELAXED, __HIP_MEMORY_SCOPE_AGENT); ok_ = ok_ && (c_ == (j_ < 8 ? gridDim.x >> 3 : 0u)); } \
        const unsigned hx_ = MISC[16], hr_ = MISC[17]; ok_ = ok_ && hx_ < 8u && hr_ < (gridDim.x >> 3); \
        xcd = ok_ ? (int)hx_ : (int)(blockIdx.x & 7); rank = ok_ ? (int)hr_ : (int)(blockIdx.x >> 3); } while (0)
#define GB() do { const CAS Args* A_ = kargs(); XcdBarrier b_; b_.bar = (unsigned*)(A_->ws + WS_CTL) + 4096; b_.x = xb_xcc_id(); b_.st = MISC + 8; xcd_barrier(b_); } while (0)

    { const CAS Args* A = kargs(); Ptrs P;
#pragma unroll
      for (int i = 0; i < 23; ++i) P.in[i] = A->in[i];
      P.out = A->out; P.ws = A->ws;
      p0_prologue(P, lds, (int)gridDim.x); }
    GB();
    { const CAS Args* A = kargs(); Ptrs P;
#pragma unroll
      for (int i = 0; i < 23; ++i) P.in[i] = A->in[i];
      P.out = A->out; P.ws = A->ws;
      pre_phase(P, lds, (int)gridDim.x); }
    GB();

    for (int l = 0; l < DEPTH; ++l) {
        const bool isA = (l & 1) == 0;
        {
            const CAS Args* A = kargs(); const int G = gridDim.x, j = l >> 1; unsigned char* ws = A->ws;
            const unsigned long long* SS = (const unsigned long long*)(ws + WS_SS) + (size_t)(2 * l) * M;
            if (isA) {
                unsigned char* wa = ws + WS_WA + (size_t)j * WA_STRIDE;
                pg8::Gemm g{(const bf16_t*)(ws + WS_XG), (const bf16_t*)(wa + WINA_OFF), D, D, D, 0, 0}; pg8::StaticOrder S; S.init(M, 2048, G, (int)blockIdx.x);
                pg8::EpiInA E{(bf16_t*)(ws + WS_QO), (bf16_t*)(ws + WS_CKV), (bf16_t*)(ws + WS_QI), (bf16_t*)(ws + WS_KIN), (float*)(ws + WS_WI), A->in[I_AIKG] + j * IDIM, A->in[I_AIKB] + j * IDIM,
                                (const float*)(ws + WS_SHW + SHW_A) + (size_t)j * BATCH * 2048, SS};
                pg8::gemm_phase<pg8::EpiInA, true, 3>(lds, g, S, E);
            } else {
                unsigned char* wb = ws + WS_WB + (size_t)j * WB_STRIDE;
                (void)wb;
                pg8::Gemm g{(const bf16_t*)(ws + WS_XG), (const bf16_t*)(ws + WS_W8B), D / 2, D / 2, D / 2, 0, 0, (unsigned)(B_IN * D)}; pg8::StaticOrder S; S.init(M, B_IN, G, (int)blockIdx.x);
                pg8::EpiBf16Plain<true, true> E{(bf16_t*)(ws + WS_QKV), B_IN, (const float*)(ws + WS_SHW + SHW_B) + (size_t)j * BATCH * B_IN, B_IN, SS,
                                                (const float*)(ws + WS_CWB), (const unsigned long long*)(ws + WS_SS) + (size_t)(2 * l - 1) * M};
                pg8::gemm_phase<pg8::EpiBf16Plain<true, true>, true, 1>(lds, g, S, E);
            }
        }
        GB();
        if (isA) {
            { const CAS Args* A = kargs(); const int G = gridDim.x, j = l >> 1; unsigned char* ws = A->ws;
              unsigned char* wa = ws + WS_WA + (size_t)j * WA_STRIDE;
              pg8::Gemm g{(const bf16_t*)(ws + WS_QO), (const bf16_t*)(wa + WQA_OFF), D, 128, 128, 1, 128}; pg8::StaticOrder S; S.init(M, 4096, G, (int)blockIdx.x);
              pg8::EpiFp8 E{ws + WS_BIG, 8192};
              pg8::gemm_phase<pg8::EpiFp8, true>(lds, g, S, E); }
            { const CAS Args* A = kargs(); const int G = gridDim.x; unsigned char* ws = A->ws;
              const int tid2 = tid_now();
              const int lane = tid2 & 63, wave = __builtin_amdgcn_readfirstlane(tid2 >> 6);
              const bf16_t* CKV = (const bf16_t*)(ws + WS_CKV); unsigned* CKV8 = (unsigned*)(ws + WS_CKV8);
              const int gw = blockIdx.x * NWAVES + wave, NGW = G * NWAVES;
              for (int row = gw; row < M; row += NGW) {
                  const u32x2 v = *((const u32x2*)(CKV + (size_t)row * RK) + lane);
                  const float a0 = __uint_as_float(v.x << 16), a1 = __uint_as_float(v.x & 0xffff0000u), a2 = __uint_as_float(v.y << 16), a3 = __uint_as_float(v.y & 0xffff0000u);
                  const float ss = wave_sum((a0 * a0 + a1 * a1) + (a2 * a2 + a3 * a3));
                  const float rs = 1.0f / sqrtf(ss * (1.0f / RK) + EPS);
                  int w = 0; w = __builtin_amdgcn_cvt_pk_fp8_f32(a0 * rs, a1 * rs, w, false); w = __builtin_amdgcn_cvt_pk_fp8_f32(a2 * rs, a3 * rs, w, true);
                  CKV8[(size_t)row * (RK / 4) + lane] = (unsigned)w;
              } }
            { const CAS Args* A = kargs(); const int G = gridDim.x; unsigned char* ws = A->ws;
              const int tid2 = tid_now();
              const int lane = tid2 & 63, wave = __builtin_amdgcn_readfirstlane(tid2 >> 6);
              int xcd, rank; XCD_RANK(xcd, rank); xcd = __builtin_amdgcn_readfirstlane(xcd); rank = __builtin_amdgcn_readfirstlane(rank);
              const int wx = rank * NWAVES + wave, nwx = (G >> 3) * NWAVES;
              const int nsteps = (1024 + nwx - 1) / nwx;
              for (int st = 0; st < nsteps; ++st) {
                  const int q = wx + st * nwx; const bool active = q < 1024;
                  const int qc = active ? q : (rank * NWAVES + st * nwx < 1024 ? rank * NWAVES + st * nwx : 1023);
                  const int bl = qc >> 9, u = qc & 255, hiq = (qc >> 8) & 1, b = 2 * xcd + bl;
                  const int tg = hiq ? 511 - u : u;
                  idx_task((const bf16_t*)(ws + WS_QI), (const bf16_t*)(ws + WS_KIN), (const float*)(ws + WS_WI), (unsigned*)(ws + WS_SEL), lds, b, tg, lane, wave, active, hiq ? 2 : 1);
              }
              __syncthreads(); }
        } else {
            const CAS Args* A = kargs(); const int G = gridDim.x, j = l >> 1; unsigned char* ws = A->ws;
            swa_phase((const bf16_t*)(ws + WS_QKV), (bf16_t*)(ws + WS_OB), A->in[I_RELB], A->in[I_BSINK] + j * NH, lds, G);
        }
        GB();
        if (isA) {
            { const CAS Args* A = kargs(); const int G = gridDim.x; unsigned char* ws = A->ws;
              const int tid2 = tid_now();
              const int lane = tid2 & 63, wave = __builtin_amdgcn_readfirstlane(tid2 >> 6);
              LAS float* relb = (LAS float*)(lds + 147456);
              LAS unsigned* btab = (LAS unsigned*)(lds + 147456 + 2048);
              for (int i = tid2; i < NBUCK * NH; i += NTHR) relb[i] = A->in[I_RELB][i];
              for (int i = tid2; i < 132; i += NTHR) btab[i] = (unsigned)t5_bucket(i);
              __syncthreads();
              int xcd, rank; XCD_RANK(xcd, rank); xcd = __builtin_amdgcn_readfirstlane(xcd); rank = __builtin_amdgcn_readfirstlane(rank);
              const int wx = rank * NWAVES + wave, nwx = (G >> 3) * NWAVES;
              att_wave(ws + WS_CKV8, (const unsigned*)(ws + WS_SEL), ws + WS_BIG, lds + wave * 16384, (LAS unsigned*)(lds + 131072 + wave * 2048), relb, btab, xcd, wx, nwx, lane); }
            GB();
            { const CAS Args* A = kargs(); const int G = gridDim.x, j = l >> 1; unsigned char* ws = A->ws;
              unsigned char* wa = ws + WS_WA + (size_t)j * WA_STRIDE;
              pg8::Gemm g{(const bf16_t*)(ws + WS_BIG), (const bf16_t*)(wa + WUV_OFF), 4096, D, D, 0, 1024}; pg8::StaticOrder S; S.init(M, D, G, (int)blockIdx.x);
              pg8::EpiFp8 E{ws + WS_OB, D};
              pg8::gemm_phase<pg8::EpiFp8, true>(lds, g, S, E); }
            GB();
        }
        {
            const CAS Args* A = kargs(); const int G = gridDim.x, j = l >> 1; unsigned char* ws = A->ws;
            const float* modl = (const float*)(ws + WS_MOD) + (size_t)l * BATCH * 6144;
            const bf16_t* Ain = (const bf16_t*)(ws + WS_OB);
            const bf16_t* Bw = (const bf16_t*)(isA ? ws + WS_WA + (size_t)j * WA_STRIDE + WOUTA_OFF : ws + WS_WB + (size_t)j * WB_STRIDE + WOUTB_OFF);
            w8_build<false>((const bf16_t*)(ws + WS_W + (size_t)l * W_LAYER + W13_OFF), 2 * DFF, A->in[I_GFFN] + l * D, modl + 4096, ws + WS_W8, (float*)(ws + WS_CW), lds, G);
            pg8::Gemm g{Ain, Bw, D / 2, D / 2, D / 2, 0, 0, 0}; pg8::StaticOrder S; S.init(M, D, G, (int)blockIdx.x);
            pg8::EpiResid<true, true> E{(const bf16_t*)A->out, (bf16_t*)A->out, modl + 2048, isA ? nullptr : A->in[I_BBOUT] + j * D,
                            (bf16_t*)(ws + WS_XG), nullptr, nullptr, (unsigned long long*)(ws + WS_SS) + (size_t)(2 * l + 1) * M, (const unsigned long long*)(ws + WS_SS) + (size_t)(2 * l) * M};
            pg8::gemm_phase<pg8::EpiResid<true, true>, true, 2>(lds, g, S, E);
        }
        GB();
        {
            const CAS Args* A = kargs(); const int G = gridDim.x; unsigned char* ws = A->ws;
            unsigned char* wl = ws + WS_W + (size_t)l * W_LAYER;
            pg8::Gemm g{(const bf16_t*)(ws + WS_XG), (const bf16_t*)(ws + WS_W8), D / 2, D / 2, D / 2, 0, 0, (unsigned)W8_BATCH}; pg8::StaticOrder S; S.init(M, 2 * DFF, G, (int)blockIdx.x);
            pg8::EpiSwiGLU E{(bf16_t*)(ws + WS_HFF), (const float*)(ws + WS_SHW + SHW_F) + (size_t)l * BATCH * 2 * DFF, (const unsigned long long*)(ws + WS_SS) + (size_t)(2 * l + 1) * M,
                             (const float*)(ws + WS_CW), (const unsigned long long*)(ws + WS_SS) + (size_t)(2 * l) * M};
            pg8::gemm_phase<pg8::EpiSwiGLU, true, 1>(lds, g, S, E);
        }
        GB();
        {
            const CAS Args* A = kargs(); const int G = gridDim.x; unsigned char* ws = A->ws;
            unsigned char* wl = ws + WS_W + (size_t)l * W_LAYER;
            const float* modl = (const float*)(ws + WS_MOD) + (size_t)l * BATCH * 6144;
            const int ln = l + 1 < DEPTH ? l + 1 : l;
            pg8::Gemm g{(const bf16_t*)(ws + WS_HFF), (const bf16_t*)(wl + W2_OFF), DFF, DFF, DFF, 0, 0}; pg8::StaticOrder S; S.init(M, D, G, (int)blockIdx.x);
            const bool lastl = (l + 1 == DEPTH);
            if (!lastl && ((l + 1) & 1)) {
                const int jn = (l + 1) >> 1;
                w8_build<true>((const bf16_t*)(ws + WS_WB + (size_t)jn * WB_STRIDE + WINB_OFF), B_IN, A->in[I_GMIX] + ln * D, (const float*)(ws + WS_MOD) + (size_t)ln * BATCH * 6144 + 1024, ws + WS_W8B, (float*)(ws + WS_CWB), lds, G);
                pg8::EpiResid<true, false> E{(const bf16_t*)A->out, (bf16_t*)A->out, modl + 5120, nullptr,
                                (bf16_t*)(ws + WS_XG), nullptr, nullptr, (unsigned long long*)(ws + WS_SS) + (size_t)(2 * l + 2) * M, (const unsigned long long*)(ws + WS_SS) + (size_t)(2 * l + 1) * M};
                pg8::gemm_phase<pg8::EpiResid<true, false>, true>(lds, g, S, E);
            } else {
                pg8::EpiResid<false, false> E{(const bf16_t*)A->out, lastl ? (bf16_t*)(ws + WS_XG) : (bf16_t*)A->out, modl + 5120, nullptr,
                                l + 1 < DEPTH ? (bf16_t*)(ws + WS_XG) : nullptr, A->in[I_GMIX] + ln * D, (const float*)(ws + WS_MOD) + (size_t)ln * BATCH * 6144 + 1024, (unsigned long long*)(ws + WS_SS) + (size_t)(2 * l + 2) * M, nullptr};
                pg8::gemm_phase<pg8::EpiResid<false, false>, true>(lds, g, S, E);
            }
        }
        GB();
    }
    { const CAS Args* A = kargs(); final_norm_phase((const bf16_t*)(A->ws + WS_XG), A->out, A->in[I_GFIN], (int)gridDim.x); }
#undef GB
}

extern "C" void kernel_launch(void* const* d_in, const int* in_sizes, int n_in, void* d_out, int out_size, void* d_ws, size_t ws_size, hipStream_t stream) {
    static int grid = 0;
    if (grid == 0) {
        if (n_in != 23 || out_size != M * D || ws_size < WS_END) { fprintf(stderr, "kernel_launch: unexpected shapes (n_in %d out %d ws %zu)\n", n_in, out_size, ws_size); grid = -1; return; }
        int dev = 0, cus = 0, per_cu = 0;
        if (hipGetDevice(&dev) != hipSuccess || hipDeviceGetAttribute(&cus, hipDeviceAttributeMultiprocessorCount, dev) != hipSuccess) { grid = -1; return; }
        if (hipFuncSetAttribute((const void*)trunk_fwd, hipFuncAttributeMaxDynamicSharedMemorySize, LDS_BYTES) != hipSuccess) { fprintf(stderr, "kernel_launch: hipFuncSetAttribute failed\n"); grid = -1; return; }
        if (hipOccupancyMaxActiveBlocksPerMultiprocessor(&per_cu, (const void*)trunk_fwd, NTHR, LDS_BYTES) != hipSuccess || per_cu < 1) { fprintf(stderr, "kernel_launch: occupancy query says %d\n", per_cu); }
        (void)hipGetLastError();
        grid = cus;
    }
    if (grid < 0) return;
    (void)hipMemsetAsync((char*)d_ws + WS_CTL, 0, CTL_ZERO_BYTES, stream);
    Args a{};
    for (int i = 0; i < 23; ++i) a.in[i] = (const float*)d_in[i];
    a.out = (float*)d_out; a.ws = (unsigned char*)d_ws;
    hipLaunchKernelGGL(trunk_fwd, dim3(grid), dim3(NTHR), LDS_BYTES, stream, a);
    const hipError_t le = hipPeekAtLastError();
    if (le != hipSuccess) fprintf(stderr, "kernel_launch: launch failed: %s\n", hipGetErrorName(le));
}
```

```cpp
#include <hip/hip_runtime.h>
#include <cstdio>
#include <cstdint>


#define GAS __attribute__((address_space(1)))
#define LAS __attribute__((address_space(3)))
typedef unsigned short bf16_t;
typedef short bf16x8 __attribute__((ext_vector_type(8)));
typedef short s16x4 __attribute__((ext_vector_type(4)));
typedef float f32x4 __attribute__((ext_vector_type(4)));
typedef float f32x2 __attribute__((ext_vector_type(2)));
typedef float f32x16 __attribute__((ext_vector_type(16)));
typedef unsigned u32x4 __attribute__((ext_vector_type(4)));
typedef unsigned u32x2 __attribute__((ext_vector_type(2)));
typedef int i32x4 __attribute__((ext_vector_type(4)));
typedef int i32x8 __attribute__((ext_vector_type(8)));

constexpr int D = 1024, BATCH = 16, SEQ = 2048, M = BATCH * SEQ, DEPTH = 4;
constexpr int NH = 16, HD = 64, RK = 256, IH = 8, IDIM = 64, TOPK = 256;
constexpr int KVH = 2, GQ = 8, WIN = 128, NBUCK = 32, DFF = 2816;
constexpr int A_IN = 1864, B_IN = 1280;
constexpr float EPS = 1e-6f;
constexpr float NEGF = -1e30f;
constexpr int NWAVES = 8, NTHR = 512;

constexpr size_t MiB = 1u << 20;
constexpr size_t WS_CTL = 0, CTL_ZERO_BYTES = 4 * MiB;
constexpr size_t WS_SS = 1 * MiB;
constexpr size_t WS_W = 4 * MiB;
constexpr size_t W_LAYER = 17301504;
constexpr size_t W13_OFF = 0, W2_OFF = 11 * MiB;
constexpr size_t WS_WA = WS_W + 4 * W_LAYER;
constexpr size_t WA_STRIDE = 10 * MiB, WINA_OFF = 0, WQA_OFF = 4 * MiB, WUV_OFF = 6 * MiB, WOUTA_OFF = 8 * MiB;
constexpr size_t WS_WB = WS_WA + 2 * WA_STRIDE;
constexpr size_t WB_STRIDE = 4718592, WINB_OFF = 0, WOUTB_OFF = 2621440;
constexpr size_t WS_MOD = 100 * MiB;
constexpr size_t WS_SHW = WS_MOD + 1536 * 1024;
constexpr size_t SHW_A = 0, SHW_B = 2 * 16 * 2048 * 4, SHW_F = SHW_B + 2 * 16 * 1280 * 4;
constexpr size_t WS_XG = 104 * MiB;
constexpr size_t WS_BIG = 104 * MiB;
constexpr size_t WS_HFF = 168 * MiB;
constexpr size_t WS_QO = 360 * MiB;
constexpr size_t WS_CKV = 424 * MiB;
constexpr size_t WS_QI = 440 * MiB;
constexpr size_t WS_KIN = 472 * MiB;
constexpr size_t WS_WI = 476 * MiB;
constexpr size_t WS_SEL = 477 * MiB;
constexpr size_t WS_CKV8 = 486 * MiB;
constexpr size_t WS_QKV = 360 * MiB;
constexpr size_t WS_OB = 440 * MiB;
constexpr size_t WS_W8 = 344 * MiB;
constexpr size_t W8_BATCH = (size_t)2 * 2816 * 1024;
constexpr size_t WS_CW = 504 * MiB;
constexpr size_t WS_W8B = 136 * MiB;
constexpr size_t WS_CWB = WS_CW + 512 * 1024;
constexpr size_t WS_END = 512 * MiB;

constexpr int RING_BYTES = 131072;
constexpr int LDS_MISC_OFF = 155648;
constexpr int LDS_BYTES = 156672;

extern __shared__ __attribute__((aligned(16))) unsigned char lds_raw[];
constexpr int LDS_WAVE_TAB = LDS_MISC_OFF + 256;
__device__ __forceinline__ int lane_now() { int l; asm volatile("v_mbcnt_lo_u32_b32 %0, -1, 0\n\tv_mbcnt_hi_u32_b32 %0, -1, %0" : "=v"(l)); return l; }
__device__ __forceinline__ unsigned hw_slot() { return (unsigned)__builtin_amdgcn_s_getreg((5 << 11) | 4) & 63u; }
__device__ __forceinline__ int wave_now() { return __builtin_amdgcn_readfirstlane((int)*(volatile LAS unsigned*)((LAS unsigned char*)lds_raw + LDS_WAVE_TAB + 4 * hw_slot())); }
__device__ __forceinline__ int tid_now() { return wave_now() * 64 + lane_now(); }
#define RLX_AGENT __ATOMIC_RELAXED, __HIP_MEMORY_SCOPE_AGENT
__device__ __forceinline__ unsigned cvt_pk_bf16(float lo, float hi) { unsigned r; asm volatile("v_cvt_pk_bf16_f32 %0, %1, %2" : "=v"(r) : "v"(lo), "v"(hi)); return r; }
#define NT_STORE(ptr, val) __builtin_nontemporal_store((val), (ptr))
typedef _Float16 h16x2 __attribute__((ext_vector_type(2)));
typedef _Float16 h16x8 __attribute__((ext_vector_type(8)));
__device__ __forceinline__ unsigned cvt_pk_f16(float lo, float hi) { return __builtin_bit_cast(unsigned, __builtin_convertvector((f32x2){lo, hi}, h16x2)); }
__device__ __forceinline__ f32x2 unpk_f16(unsigned u) { return __builtin_convertvector(__builtin_bit_cast(h16x2, u), f32x2); }
__device__ __forceinline__ float bf2f(bf16_t b) { return __uint_as_float(((unsigned)b) << 16); }
__device__ __forceinline__ float half_sum_f(float v);
__device__ __forceinline__ float rows_sum(float x);
__device__ __forceinline__ float wave_sum(float v) {
    v = half_sum_f(v);
    const u32x2 r = __builtin_amdgcn_permlane32_swap(__float_as_uint(v), __float_as_uint(v), false, false);
    return __uint_as_float(r.x) + __uint_as_float(r.y);
}
__device__ __forceinline__ float fast_exp(float x) { return __builtin_amdgcn_exp2f(x * 1.4426950408889634f); }
__device__ __forceinline__ float silu_f(float x) { return x * __builtin_amdgcn_rcpf(1.0f + fast_exp(-x)); }
__device__ __forceinline__ int t5_bucket(int d) {
    if (d < 16) return d;
    int b = 16;
    b += (d >= 19); b += (d >= 21); b += (d >= 24); b += (d >= 27); b += (d >= 31); b += (d >= 35); b += (d >= 40); b += (d >= 46);
    b += (d >= 52); b += (d >= 59); b += (d >= 67); b += (d >= 77); b += (d >= 87); b += (d >= 99); b += (d >= 113);
    return b;
}

#define XB_TMO      128
#define XB_XCNT(j)  (256  + 64 * (j))
#define XB_XSUB(j)  (1280 + 64 * (j))
#define XB_XGEN(j)  (2304 + 64 * (j))
#define XB_TOP      3328
#define XB_TOPGEN   3392
#define XCD_BAR_WORDS 3456
#define XB_SPIN_CAP (1u << 22)

__device__ __forceinline__ unsigned xb_ld(unsigned* p)              { return __hip_atomic_load(p, __ATOMIC_RELAXED, __HIP_MEMORY_SCOPE_AGENT); }
__device__ __forceinline__ unsigned xb_add(unsigned* p, unsigned v) { return __hip_atomic_fetch_add(p, v, __ATOMIC_RELAXED, __HIP_MEMORY_SCOPE_AGENT); }
__device__ __forceinline__ unsigned xb_xcc_id() { return (unsigned)__builtin_amdgcn_s_getreg((3 << 11) | 20) & 0xFu; }
#define XB_SPIN(cond, bar) do { unsigned _sp = 0; while (cond) { __builtin_amdgcn_s_sleep(1); \
    if ((++_sp & 255u) == 0u) { if (xb_ld(&(bar)[XB_TMO])) break; if (_sp > XB_SPIN_CAP) { atomicAdd(&(bar)[XB_TMO], 1u); break; } } } } while (0)

struct XcdBarrier { unsigned* bar; unsigned x; volatile LAS unsigned* st; };

__device__ __forceinline__ XcdBarrier xcd_barrier_post(unsigned* bar, volatile LAS unsigned* st) {
    XcdBarrier b; b.bar = bar; b.x = xb_xcc_id(); b.st = st;
    if (threadIdx.x == 0) (void)xb_add(&bar[XB_XCNT(b.x)], 1u);
    return b;
}
__device__ __forceinline__ void xcd_barrier_complete(unsigned* bar, unsigned x, unsigned& nloc, unsigned& nx) {
    const unsigned G = gridDim.x * gridDim.y * gridDim.z;
    unsigned sum, cnt, mine, sp = 0u;
    for (;;) {
        sum = 0u; cnt = 0u; mine = 0u;
#pragma unroll
        for (unsigned j = 0; j < 16; ++j) { const unsigned c = xb_ld(&bar[XB_XCNT(j)]); sum += c; cnt += (c > 0u) ? 1u : 0u; mine = (j == x) ? c : mine; }
        if (sum == G) break;
        __builtin_amdgcn_s_sleep(1);
        if ((++sp & 255u) == 0u) { if (xb_ld(&bar[XB_TMO])) break; if (sp > XB_SPIN_CAP) { atomicAdd(&bar[XB_TMO], 1u); break; } }
    }
    nloc = mine > 0u ? mine : 1u; nx = cnt > 0u ? cnt : 1u;
}
__device__ __forceinline__ void xcd_barrier(const XcdBarrier& b) {
    asm volatile("s_waitcnt vmcnt(0)" ::: "memory");
    __syncthreads();
    if (tid_now() == 0) {
        unsigned* bar = b.bar;
        __builtin_amdgcn_s_waitcnt(0);
        unsigned nloc = b.st[0], nx = b.st[1];
        if (nloc == 0u) { xcd_barrier_complete(bar, b.x, nloc, nx); b.st[0] = nloc; b.st[1] = nx; }
        const unsigned old = xb_add(&bar[XB_XSUB(b.x)], 1u);
        const unsigned gen = old / nloc;
        if (old + 1u == (gen + 1u) * nloc) {
            __builtin_amdgcn_fence(__ATOMIC_RELEASE, "agent");
            asm volatile("s_waitcnt vmcnt(0)" ::: "memory");
            const unsigned og = xb_add(&bar[XB_TOP], 1u);
            const unsigned tg = og / nx;
            if (og + 1u == (tg + 1u) * nx) xb_add(&bar[XB_TOPGEN], 1u);
            else XB_SPIN(xb_ld(&bar[XB_TOPGEN]) == tg, bar);
            __builtin_amdgcn_fence(__ATOMIC_ACQUIRE, "agent");
            xb_add(&bar[XB_XGEN(b.x)], 1u);
            asm volatile("s_waitcnt vmcnt(0)" ::: "memory");
        } else {
            XB_SPIN(xb_ld(&bar[XB_XGEN(b.x)]) == gen, bar);
            __builtin_amdgcn_fence(__ATOMIC_ACQUIRE, "agent");
            asm volatile("s_waitcnt vmcnt(0)" ::: "memory");
        }
    }
    __syncthreads();
}

namespace pg8 {
constexpr int BM = 256, BK = 64, HALF = 128, HTB = HALF * BK * 2, STAGE_BYTES = 8 * HTB, NXCD = 8, WGM = 8;
__host__ __device__ __forceinline__ int lds_byte(int r, int c) { const int st = (r >> 4) * 2 + (c >> 5), rr = r & 15, cc = c & 31, ob = rr * 64 + cc * 2; return st * 1024 + (ob ^ (((ob >> 9) & 1) << 5)); }
__host__ __device__ __forceinline__ void stage_rc(int b, int& R, int& C) { const int st = b / 1024, sb = b % 1024, swz = sb ^ (((sb >> 9) & 1) << 5); R = (st >> 1) * 16 + swz / 64; C = (st & 1) * 32 + (swz % 64) / 2; }
__host__ __device__ __forceinline__ int perm32(int rho) { const int n = rho >> 4, i = rho & 15; return 8 * (i >> 2) + 4 * n + (i & 3); }

struct Unit { int pm, pn; };
struct Gemm { const bf16_t* A; const bf16_t* Bt; int lda, ldb, K, a_shift, a_mul; unsigned bb; };

struct StaticOrder {
    int nM, nN, nwg, G, c;
    __device__ void init(int M_, int N_, int G_, int c_) { nM = M_ / BM; nN = N_ / BM; nwg = nM * nN; G = G_; c = c_; }
    __device__ bool next(int i, Unit& u) const {
        const long L = (long)i * G + c; if (L >= nwg) return false;
        int wgid = (int)L; { const int q = nwg / NXCD, r = nwg % NXCD, xcd = wgid % NXCD, off = wgid / NXCD; wgid = (xcd < r ? xcd * (q + 1) : r * (q + 1) + (xcd - r) * q) + off; }
        const int nig = WGM * nN, gid = wgid / nig, fm = gid * WGM, gsz = (nM - fm) < WGM ? (nM - fm) : WGM;
        u.pm = fm + ((wgid % nig) % gsz); u.pn = (wgid % nig) / gsz; return true;
    }
};

template <class Epi, bool ALIGN_EPI, int MODE = 0, bool PAIR = false>
__device__ __forceinline__ void gemm_phase(LAS unsigned char* lds, const Gemm g, const StaticOrder& S, const Epi& E) {
    int tid = tid_now();
    const int wid = __builtin_amdgcn_readfirstlane(tid >> 6), lane = tid & 63, wr = wid >> 2, wc = wid & 3, fr = lane & 15, fq = lane >> 4;
    const int K = g.K, nt = K / BK;
    unsigned voffA[2], voffB[2];
#pragma unroll
    for (int i = 0; i < 2; ++i) { int R, C; stage_rc(tid * 16 + i * 8192, R, C); const int Rb = Epi::PERM16 ? (64 * (R >> 5) + 16 * ((R & 15) >> 2) + 4 * ((R >> 4) & 1) + (R & 3)) : Epi::PERM ? ((R & ~31) + perm32(R & 31)) : R;
        voffA[i] = (unsigned)(R * g.lda + C) * 2u; voffB[i] = (unsigned)(Rb * g.ldb + C) * 2u; }
    const size_t kstep = (size_t)(BK * 2);
    const size_t hstepA = (size_t)HALF * g.lda * 2, hstepB = (size_t)(Epi::PERM16 ? 8 : HALF) * g.ldb * 2;
    const unsigned ldsw = (unsigned)wid * 1024u;
    const int aoff = lds_byte(wr * 64 + fr, fq * 8), boff = lds_byte(wc * 32 + fr, fq * 8);
#define PG8_SA(b, h) (((b) * 2 + (h)) * HTB)
#define PG8_SB(b, h) ((4 + (b) * 2 + (h)) * HTB)
#define PG8_STAGE(bufoff, gbase, voff) do { const char* _gb = (const char*)(gbase); asm volatile("" : "+s"(_gb));     \
        _Pragma("unroll") for (int _i = 0; _i < 2; ++_i) \
        __builtin_amdgcn_global_load_lds((const unsigned*)(_gb + (voff)[_i]), (LAS unsigned*)(lds + (bufoff) + ldsw + _i * 8192), 16, 0, 0); } while (0)
#define PG8_LDA(dst, b, h) do { _Pragma("unroll") for (int m = 0; m < 4; ++m) _Pragma("unroll") for (int k = 0; k < 2; ++k) dst[m][k] = *(const LAS bf16x8*)(lds + PG8_SA(b, h) + aoff + m * 2048 + k * 1024); } while (0)
#define PG8_LDB(dst, b, h) do { _Pragma("unroll") for (int n = 0; n < 2; ++n) _Pragma("unroll") for (int k = 0; k < 2; ++k) dst[n][k] = *(const LAS bf16x8*)(lds + PG8_SB(b, h) + boff + n * 2048 + k * 1024); } while (0)
#define PG8_CAT(x0, x1) __builtin_shufflevector(__builtin_bit_cast(i32x4, x0), __builtin_bit_cast(i32x4, x1), 0, 1, 2, 3, 4, 5, 6, 7)
#define PG8_MMA(ai, bj, At, Bt) do { __builtin_amdgcn_s_setprio(1); _Pragma("unroll") for (int m = 0; m < 4; ++m) _Pragma("unroll") for (int n = 0; n < 2; ++n) { \
        if constexpr (MODE == 2) acc[ai][bj][m][n] = __builtin_amdgcn_mfma_scale_f32_16x16x128_f8f6f4(PG8_CAT(Bt[n][0], Bt[n][1]), PG8_CAT(At[m][0], At[m][1]), acc[ai][bj][m][n], 0, 0, 0, 0, 0, 0); \
        else { _Pragma("unroll") for (int k = 0; k < 2; ++k) { \
          if constexpr (MODE == 1) acc[ai][bj][m][n] = __builtin_bit_cast(f32x4, __builtin_amdgcn_mfma_i32_16x16x64_i8(__builtin_bit_cast(i32x4, Bt[n][k]), __builtin_bit_cast(i32x4, At[m][k]), __builtin_bit_cast(i32x4, acc[ai][bj][m][n]), 0, 0, 0)); \
          else if constexpr (MODE == 3) acc[ai][bj][m][n] = __builtin_amdgcn_mfma_f32_16x16x32_f16(__builtin_bit_cast(h16x8, Bt[n][k]), __builtin_bit_cast(h16x8, At[m][k]), acc[ai][bj][m][n], 0, 0, 0); \
          else acc[ai][bj][m][n] = __builtin_amdgcn_mfma_f32_16x16x32_bf16(Bt[n][k], At[m][k], acc[ai][bj][m][n], 0, 0, 0); } } } __builtin_amdgcn_s_setprio(0); } while (0)
#define PG8_WAIT_V(n) asm volatile("s_waitcnt vmcnt(" #n ")" ::: "memory")
#define PG8_WAIT_L(n) asm volatile("s_waitcnt lgkmcnt(" #n ")" ::: "memory")
#define PG8_BAR __builtin_amdgcn_s_barrier()
#define PG8_SCHED __builtin_amdgcn_sched_barrier(0)
#define PG8_ABASE(u) ((const char*)g.A + ((size_t)(u).pm * BM * g.lda + (size_t)((u).pn >> g.a_shift) * g.a_mul) * 2)
#define PG8_BBASE(u) ((const char*)g.Bt + (size_t)(u).pn * BM * g.ldb * 2 + (size_t)((u).pm >> 3) * g.bb)
    Unit cur, nxt; int ui = 0;
    if (!S.next(0, cur)) return;
    f32x4 acc[2][2][4][2];
#pragma unroll
    for (int a = 0; a < 2; ++a)
#pragma unroll
        for (int b = 0; b < 2; ++b)
#pragma unroll
            for (int m = 0; m < 4; ++m)
#pragma unroll
                for (int n = 0; n < 2; ++n) acc[a][b][m][n] = (f32x4){0.f, 0.f, 0.f, 0.f};
    bf16x8 At[4][2], B0[2][2], B1[2][2];
    const char* cA = PG8_ABASE(cur); const char* cB = PG8_BBASE(cur);
    PG8_STAGE(PG8_SB(0, 0), cB, voffB); PG8_STAGE(PG8_SB(0, 1), cB + hstepB, voffB); PG8_STAGE(PG8_SA(0, 0), cA, voffA); PG8_STAGE(PG8_SA(0, 1), cA + hstepA, voffA);
    if (wr == 1) PG8_BAR;
    PG8_WAIT_V(2); PG8_BAR;
    PG8_STAGE(PG8_SB(1, 0), cB + kstep, voffB); PG8_STAGE(PG8_SA(1, 0), cA + kstep, voffA); PG8_STAGE(PG8_SB(1, 1), cB + hstepB + kstep, voffB);
    PG8_WAIT_V(6); PG8_BAR;
    for (;;) {
        const bool has_next = S.next(ui + 1, nxt);
        const char* nA = has_next ? PG8_ABASE(nxt) : cA; const char* nB = has_next ? PG8_BBASE(nxt) : cB;
        for (int t = 0; t < nt; t += 2) {
            const bool last = (t == nt - 2);
            if constexpr (Epi::PREFETCH) { if (last) E.prefetch(lds + STAGE_BYTES, cur, wid, lane_now()); }
            const char* a1 = cA + (size_t)(t + 1) * kstep;
            const char* a2 = last ? nA : cA + (size_t)(t + 2) * kstep; const char* b2 = last ? nB : cB + (size_t)(t + 2) * kstep;
            const char* a3 = a2 + kstep; const char* b3 = b2 + kstep;
            PG8_LDB(B0, 0, 0); PG8_LDB(B1, 0, 1); PG8_SCHED; PG8_LDA(At, 0, 0); PG8_STAGE(PG8_SA(1, 1), a1 + hstepA, voffA);
            PG8_WAIT_V(8); PG8_WAIT_L(0); PG8_BAR; PG8_MMA(0, 0, At, B0); PG8_MMA(0, 1, At, B1); PG8_BAR; PG8_SCHED;
            PG8_LDA(At, 0, 1); PG8_STAGE(PG8_SB(0, 0), b2, voffB); PG8_STAGE(PG8_SB(0, 1), b2 + hstepB, voffB); PG8_STAGE(PG8_SA(0, 0), a2, voffA);
            PG8_WAIT_V(8); PG8_WAIT_L(0); PG8_BAR; PG8_MMA(1, 0, At, B0); PG8_MMA(1, 1, At, B1); PG8_BAR; PG8_SCHED;
            if constexpr (PAIR) { const int l3 = lane_now(); Unit u0 = cur; u0.pn = 2 * cur.pn; E(acc, u0, wr, wc, l3 & 15, l3 >> 4);
                _Pragma("unroll") for (int a = 0; a < 2; ++a) _Pragma("unroll") for (int b = 0; b < 2; ++b) _Pragma("unroll") for (int m = 0; m < 4; ++m) _Pragma("unroll") for (int n = 0; n < 2; ++n) acc[a][b][m][n] = (f32x4){0.f, 0.f, 0.f, 0.f}; }
            PG8_LDB(B0, 1, 0); PG8_LDB(B1, 1, 1); PG8_SCHED; PG8_LDA(At, 1, 0); PG8_STAGE(PG8_SA(0, 1), a2 + hstepA, voffA);
            PG8_WAIT_V(8); PG8_WAIT_L(0); PG8_BAR; PG8_MMA(0, 0, At, B0); PG8_MMA(0, 1, At, B1); PG8_BAR; PG8_SCHED;
            PG8_LDA(At, 1, 1); PG8_STAGE(PG8_SB(1, 0), b3, voffB); PG8_STAGE(PG8_SB(1, 1), b3 + hstepB, voffB); PG8_STAGE(PG8_SA(1, 0), a3, voffA);
            PG8_WAIT_V(8); PG8_WAIT_L(0); PG8_BAR; PG8_MMA(1, 0, At, B0); PG8_MMA(1, 1, At, B1); PG8_BAR; PG8_SCHED;
        }
        if constexpr (ALIGN_EPI) { if (wr == 0) PG8_BAR; }
        { const int l2 = lane_now();
          if constexpr (PAIR) { Unit u1 = cur; u1.pn = 2 * cur.pn + 1; E(acc, u1, wr, wc, l2 & 15, l2 >> 4); }
          else if constexpr (Epi::PREFETCH) E(acc, cur, wr, wc, l2 & 15, l2 >> 4, lds + STAGE_BYTES); else E(acc, cur, wr, wc, l2 & 15, l2 >> 4); }
        if (!has_next) break;
#pragma unroll
        for (int a = 0; a < 2; ++a)
#pragma unroll
            for (int b = 0; b < 2; ++b)
#pragma unroll
                for (int m = 0; m < 4; ++m)
#pragma unroll
                    for (int n = 0; n < 2; ++n) acc[a][b][m][n] = (f32x4){0.f, 0.f, 0.f, 0.f};
        cur = nxt; cA = nA; cB = nB; ++ui;
        if constexpr (ALIGN_EPI) { if (wr == 1) PG8_BAR; }
    }
    PG8_WAIT_V(0);
    if constexpr (!ALIGN_EPI) { if (wr == 0) PG8_BAR; }
    PG8_BAR;
#undef PG8_SA
#undef PG8_SB
#undef PG8_STAGE
#undef PG8_LDA
#undef PG8_LDB
#undef PG8_MMA
#undef PG8_CAT
#undef PG8_WAIT_V
#undef PG8_WAIT_L
#undef PG8_BAR
#undef PG8_SCHED
#undef PG8_ABASE
#undef PG8_BBASE
}

__device__ __forceinline__ float ss_ms(unsigned long long v) { return ((float)(unsigned)(v >> 32) * 4294967296.0f + (float)(unsigned)v) * (1.0f / (16777216.0f * D)); }
__device__ __forceinline__ float frsq(float x) { return __builtin_amdgcn_rsqf(x); }
__device__ __forceinline__ float fsqrt(float x) { return __builtin_amdgcn_sqrtf(x); }
constexpr float Q8_CLIP = 4.25f;
__device__ __forceinline__ unsigned q8_bits(float v) { return __float_as_uint(__builtin_amdgcn_fmed3f(v + 12582912.0f, 12582785.0f, 12583039.0f)); }
__device__ __forceinline__ unsigned q8_bits_s(float x, float sc) { return __float_as_uint(__builtin_amdgcn_fmed3f(fmaf(x, sc, 12582912.0f), 12582785.0f, 12583039.0f)); }
__device__ __forceinline__ unsigned q8_pack(unsigned a, unsigned b, unsigned c, unsigned d) { return __builtin_amdgcn_perm(b, a, 0x0c0c0400u) | __builtin_amdgcn_perm(d, c, 0x04000c0cu); }
template <bool NORM, bool I8 = false> struct EpiBf16Plain {
    static constexpr bool PERM = true, PERM16 = true, PREFETCH = NORM;
    bf16_t* O; int ldc; const float* shw; int shw_stride; const unsigned long long* SS; const float* CW; const unsigned long long* SSq;
    __device__ __forceinline__ void prefetch(LAS unsigned char* aux, const Unit& u, int wid, int lane) const {
        if (wid < 2) __builtin_amdgcn_global_load_lds((const unsigned*)((const char*)(SS + (size_t)u.pm * BM) + wid * 1024 + lane * 16), (LAS unsigned*)(aux + wid * 1024), 16, 0, 0);
        else if (wid == 2) __builtin_amdgcn_global_load_lds((const unsigned*)((const char*)(shw + (size_t)(u.pm >> 3) * shw_stride + u.pn * BM) + lane * 16), (LAS unsigned*)(aux + 2048), 16, 0, 0);
        else if constexpr (I8) {
            if (wid == 3) __builtin_amdgcn_global_load_lds((const unsigned*)((const char*)(CW + (size_t)(u.pm >> 3) * shw_stride + u.pn * BM) + lane * 16), (LAS unsigned*)(aux + 3072), 16, 0, 0);
            else if (wid < 6) __builtin_amdgcn_global_load_lds((const unsigned*)((const char*)(SSq + (size_t)u.pm * BM) + (wid - 4) * 1024 + lane * 16), (LAS unsigned*)(aux + wid * 1024), 16, 0, 0);
        }
    }
    __device__ __forceinline__ void operator()(const f32x4 (&acc)[2][2][4][2], const Unit& u, int wr, int wc, int fr, int fq, const LAS unsigned char* aux = nullptr) const {
        const int row0 = u.pm * BM + wr * 64 + fr, col0 = u.pn * BM + wc * 64 + 16 * fq;
        f32x4 bv[2][2], cv[2][2];
#pragma unroll
        for (int bj = 0; bj < 2; ++bj)
#pragma unroll
            for (int n = 0; n < 2; ++n) { bv[bj][n] = NORM ? *(const LAS f32x4*)((const LAS float*)(aux + 2048) + wc * 64 + 16 * fq + bj * 8 + 4 * n) : (f32x4){0.f, 0.f, 0.f, 0.f};
                cv[bj][n] = I8 ? *(const LAS f32x4*)((const LAS float*)(aux + 3072) + wc * 64 + 16 * fq + bj * 8 + 4 * n) : (f32x4){1.f, 1.f, 1.f, 1.f}; }
        const LAS unsigned long long* ssl = (const LAS unsigned long long*)aux + wr * 64 + fr;
        const LAS unsigned long long* sql = (const LAS unsigned long long*)(aux + 4096) + wr * 64 + fr;
#pragma unroll
        for (int ai = 0; ai < 2; ++ai)
#pragma unroll
            for (int m = 0; m < 4; ++m) { const int row = row0 + ai * HALF + m * 16; bf16_t* rowp = O + (size_t)row * ldc + col0;
                float rs = 1.0f; if (NORM) rs = frsq(ss_ms(ssl[ai * HALF + m * 16]) + EPS);
                if (I8) rs *= (Q8_CLIP / 127.0f) * fsqrt(ss_ms(sql[ai * HALF + m * 16]) + EPS);
#pragma unroll
                for (int bj = 0; bj < 2; ++bj) { f32x4 a0 = acc[ai][bj][m][0], a1 = acc[ai][bj][m][1];
                    if (I8) {
#pragma unroll
                        for (int e = 0; e < 4; ++e) { a0[e] = (float)__float_as_int(a0[e]) * cv[bj][0][e]; a1[e] = (float)__float_as_int(a1[e]) * cv[bj][1][e]; } }
                    const f32x4 v0 = a0 * rs + bv[bj][0], v1 = a1 * rs + bv[bj][1];
                    u32x4 w; w.x = cvt_pk_bf16(v0[0], v0[1]); w.y = cvt_pk_bf16(v0[2], v0[3]); w.z = cvt_pk_bf16(v1[0], v1[1]); w.w = cvt_pk_bf16(v1[2], v1[3]);
                    NT_STORE((u32x4*)(rowp + bj * 8), w); } }
    }
};
struct EpiFp8 {
    static constexpr bool PERM = true, PERM16 = true, PREFETCH = false;
    unsigned char* O; int ldc;
    __device__ __forceinline__ void operator()(const f32x4 (&acc)[2][2][4][2], const Unit& u, int wr, int wc, int fr, int fq) const {
        const int row0 = u.pm * BM + wr * 64 + fr, col0 = u.pn * BM + wc * 64 + 16 * fq;
#pragma unroll
        for (int ai = 0; ai < 2; ++ai)
#pragma unroll
            for (int m = 0; m < 4; ++m) { unsigned char* rowp = O + (size_t)(row0 + ai * HALF + m * 16) * ldc + col0;
                int w[4];
#pragma unroll
                for (int bj = 0; bj < 2; ++bj)
#pragma unroll
                    for (int n = 0; n < 2; ++n) { const f32x4 v = acc[ai][bj][m][n]; int x = 0;
                        x = __builtin_amdgcn_cvt_pk_fp8_f32(v[0], v[1], x, false); x = __builtin_amdgcn_cvt_pk_fp8_f32(v[2], v[3], x, true); w[2 * bj + n] = x; }
                u32x4 wv; wv.x = (unsigned)w[0]; wv.y = (unsigned)w[1]; wv.z = (unsigned)w[2]; wv.w = (unsigned)w[3]; NT_STORE((u32x4*)rowp, wv);
                if (m & 1) asm volatile("" ::: "memory"); }
    }
};
struct EpiInA {
    static constexpr bool PERM = true, PERM16 = true, PREFETCH = true;
    bf16_t* Q; bf16_t* CKV; bf16_t* QI; bf16_t* KIN; float* WI; const float* kg; const float* kb; const float* shw; const unsigned long long* SS;
    __device__ __forceinline__ void prefetch(LAS unsigned char* aux, const Unit& u, int wid, int lane) const {
        if (wid < 2) __builtin_amdgcn_global_load_lds((const unsigned*)((const char*)(SS + (size_t)u.pm * BM) + wid * 1024 + lane * 16), (LAS unsigned*)(aux + wid * 1024), 16, 0, 0);
        else if (wid == 2) __builtin_amdgcn_global_load_lds((const unsigned*)((const char*)(shw + (size_t)(u.pm >> 3) * 2048 + u.pn * BM) + lane * 16), (LAS unsigned*)(aux + 2048), 16, 0, 0);
    }
    __device__ __forceinline__ void operator()(f32x4 (&acc)[2][2][4][2], const Unit& u, int wr, int wc, int fr, int fq, const LAS unsigned char* aux) const {
        const int row0 = u.pm * BM + wr * 64 + fr, cl = wc * 64 + 16 * fq;
        {
            const LAS float* sp = (const LAS float*)(aux + 2048) + cl;
            const LAS unsigned long long* ssl = (const LAS unsigned long long*)aux + wr * 64 + fr;
            f32x4 bv[2][2];
#pragma unroll
            for (int bj = 0; bj < 2; ++bj)
#pragma unroll
                for (int n = 0; n < 2; ++n) bv[bj][n] = *(const LAS f32x4*)(sp + bj * 8 + 4 * n);
#pragma unroll
            for (int ai = 0; ai < 2; ++ai)
#pragma unroll
                for (int m = 0; m < 4; ++m) { const float rs = frsq(ss_ms(ssl[ai * HALF + m * 16]) + EPS);
#pragma unroll
                    for (int bj = 0; bj < 2; ++bj)
#pragma unroll
                        for (int n = 0; n < 2; ++n) acc[ai][bj][m][n] = acc[ai][bj][m][n] * rs + bv[bj][n]; }
        }
        if (u.pn < 7) {
            bf16_t* base; int ldc, c0;
            if (u.pn < 4) { base = Q; ldc = 1024; c0 = u.pn * 256; } else if (u.pn == 4) { base = CKV; ldc = 256; c0 = 0; } else { base = QI; ldc = 512; c0 = (u.pn - 5) * 256; }
#pragma unroll
            for (int ai = 0; ai < 2; ++ai)
#pragma unroll
                for (int m = 0; m < 4; ++m) { bf16_t* rowp = base + (size_t)(row0 + ai * HALF + m * 16) * ldc + c0 + cl;
#pragma unroll
                    for (int bj = 0; bj < 2; ++bj) { const f32x4 v0 = acc[ai][bj][m][0], v1 = acc[ai][bj][m][1];
                        u32x4 w;
                        if (u.pn >= 5) { w.x = cvt_pk_f16(v0[0], v0[1]); w.y = cvt_pk_f16(v0[2], v0[3]); w.z = cvt_pk_f16(v1[0], v1[1]); w.w = cvt_pk_f16(v1[2], v1[3]); }
                        else { w.x = cvt_pk_bf16(v0[0], v0[1]); w.y = cvt_pk_bf16(v0[2], v0[3]); w.z = cvt_pk_bf16(v1[0], v1[1]); w.w = cvt_pk_bf16(v1[2], v1[3]); }
                        NT_STORE((u32x4*)(rowp + bj * 8), w); } }
        } else if (wc == 0) {
            f32x4 gv[2][2], bv[2][2];
#pragma unroll
            for (int bj = 0; bj < 2; ++bj)
#pragma unroll
                for (int n = 0; n < 2; ++n) { gv[bj][n] = *(const f32x4*)(kg + 16 * fq + 8 * bj + 4 * n); bv[bj][n] = *(const f32x4*)(kb + 16 * fq + 8 * bj + 4 * n); }
#pragma unroll
            for (int ai = 0; ai < 2; ++ai)
#pragma unroll
                for (int m = 0; m < 4; ++m) {
                    float s = 0.f;
#pragma unroll
                    for (int bj = 0; bj < 2; ++bj)
#pragma unroll
                        for (int n = 0; n < 2; ++n) { const f32x4 x = acc[ai][bj][m][n]; s += (x[0] + x[1]) + (x[2] + x[3]); }
                    s = rows_sum(s);
                    const float mu = s * (1.0f / 64.0f); float q = 0.f;
#pragma unroll
                    for (int bj = 0; bj < 2; ++bj)
#pragma unroll
                        for (int n = 0; n < 2; ++n) { const f32x4 d = acc[ai][bj][m][n] - mu; q += (d[0] * d[0] + d[1] * d[1]) + (d[2] * d[2] + d[3] * d[3]); }
                    q = rows_sum(q);
                    const float rs = frsq(q * (1.0f / 64.0f) + EPS);
                    bf16_t* rowp = KIN + (size_t)(row0 + ai * HALF + m * 16) * 64 + 16 * fq;
#pragma unroll
                    for (int bj = 0; bj < 2; ++bj) { const f32x4 v0 = (acc[ai][bj][m][0] - mu) * rs * gv[bj][0] + bv[bj][0], v1 = (acc[ai][bj][m][1] - mu) * rs * gv[bj][1] + bv[bj][1];
                        u32x4 w; w.x = cvt_pk_f16(v0[0], v0[1]); w.y = cvt_pk_f16(v0[2], v0[3]); w.z = cvt_pk_f16(v1[0], v1[1]); w.w = cvt_pk_f16(v1[2], v1[3]);
                        NT_STORE((u32x4*)(rowp + bj * 8), w); }
                }
        } else if (wc == 1 && fq == 0) {
            const float sc = 0.04419417382415922f;
#pragma unroll
            for (int ai = 0; ai < 2; ++ai)
#pragma unroll
                for (int m = 0; m < 4; ++m) { float* rowp = WI + (size_t)(row0 + ai * HALF + m * 16) * 8;
                    *(f32x4*)(rowp) = acc[ai][0][m][0] * sc; *(f32x4*)(rowp + 4) = acc[ai][0][m][1] * sc; }
        }
    }
};
template <bool Q8, bool FP8ACC> struct EpiResid {
    static constexpr bool PERM = true, PERM16 = true, PREFETCH = true;
    const bf16_t* xin_b; bf16_t* xout_b;
    const float* gate; const float* bias;
    static constexpr float asc = FP8ACC ? 1.0f / 4096.0f : 1.0f;
    bf16_t* XG; const float* gn; const float* scn; unsigned long long* SSo; const unsigned long long* SSq;
    __device__ __forceinline__ void prefetch(LAS unsigned char* aux, const Unit& u, int wid, int lane) const {
        const int b = u.pm >> 3; const char* src = nullptr;
        if (wid == 0) src = (const char*)(gate + (size_t)b * 6144 + u.pn * BM);
        else if (wid == 1) src = bias ? (const char*)(bias + u.pn * BM) : nullptr;
        else if constexpr (Q8) { if (wid == 4 || wid == 5) src = (const char*)(SSq + (size_t)u.pm * BM) + (wid - 4) * 1024; }
        else { if (wid == 2) src = XG ? (const char*)(gn + u.pn * BM) : nullptr;
               else if (wid == 3) src = XG ? (const char*)(scn + (size_t)b * 6144 + u.pn * BM) : nullptr; }
        if (src) __builtin_amdgcn_global_load_lds((const unsigned*)(src + lane * 16), (LAS unsigned*)(aux + wid * 1024), 16, 0, 0);
    }
    __device__ __forceinline__ void operator()(const f32x4 (&acc)[2][2][4][2], const Unit& u, int wr, int wc, int fr, int fq, const LAS unsigned char* aux) const {
        const int row0 = u.pm * BM + wr * 64 + fr, col0 = u.pn * BM + wc * 64 + 16 * fq;
        const LAS unsigned long long* sql = (const LAS unsigned long long*)(aux + 4096) + wr * 64 + fr;
        const LAS float* lv = (const LAS float*)aux + wc * 64 + 16 * fq;
        float ssum[2][4];
#pragma unroll
        for (int ai = 0; ai < 2; ++ai)
#pragma unroll
            for (int m = 0; m < 4; ++m) ssum[ai][m] = 0.f;
        f32x4 ga[2][2], gb[2][2], gm[2][2];
#pragma unroll
        for (int bj = 0; bj < 2; ++bj) {
            const LAS float* lp = lv + 8 * bj;
            const f32x4 gv0 = *(const LAS f32x4*)(lp), gv1 = *(const LAS f32x4*)(lp + 4);
            f32x4 bv0 = (f32x4){0.f, 0.f, 0.f, 0.f}, bv1 = bv0;
            if (bias) { bv0 = *(const LAS f32x4*)(lp + 256); bv1 = *(const LAS f32x4*)(lp + 256 + 4); }
            ga[bj][0] = gv0 * asc; ga[bj][1] = gv1 * asc; gb[bj][0] = gv0 * bv0; gb[bj][1] = gv1 * bv1;
            gm[bj][0] = bv0 * 0.f; gm[bj][1] = gm[bj][0];
            if (!Q8 && XG) { gm[bj][0] = *(const LAS f32x4*)(lp + 512) * (*(const LAS f32x4*)(lp + 768) + 1.0f); gm[bj][1] = *(const LAS f32x4*)(lp + 512 + 4) * (*(const LAS f32x4*)(lp + 768 + 4) + 1.0f); }
        }
#pragma unroll
        for (int ai = 0; ai < 2; ++ai)
#pragma unroll
            for (int m = 0; m < 4; ++m) { const size_t off = (size_t)(row0 + ai * HALF + m * 16) * D + col0;
                const u32x4 xv0 = *(const u32x4*)(xin_b + off), xv1 = *(const u32x4*)(xin_b + off + 8);
                float qs = 0.f; if (Q8) qs = (127.0f / Q8_CLIP) * frsq(ss_ms(sql[ai * HALF + m * 16]) + EPS);
                u32x4 w8;
#pragma unroll
                for (int bj = 0; bj < 2; ++bj) { const u32x4 xv = bj ? xv1 : xv0;
                    const f32x2 xa = unpk_f16(xv.x), xb = unpk_f16(xv.y), xc = unpk_f16(xv.z), xd = unpk_f16(xv.w);
                    const f32x4 xi0 = (f32x4){xa.x, xa.y, xb.x, xb.y}, xi1 = (f32x4){xc.x, xc.y, xd.x, xd.y};
                    const f32x4 xo0 = (xi0 + gb[bj][0]) + ga[bj][0] * acc[ai][bj][m][0], xo1 = (xi1 + gb[bj][1]) + ga[bj][1] * acc[ai][bj][m][1];
                    { u32x4 w; w.x = cvt_pk_f16(xo0[0], xo0[1]); w.y = cvt_pk_f16(xo0[2], xo0[3]); w.z = cvt_pk_f16(xo1[0], xo1[1]); w.w = cvt_pk_f16(xo1[2], xo1[3]); NT_STORE((u32x4*)(xout_b + off + 8 * bj), w); }
                    if (XG) {
                        { f32x2 s2 = (f32x2){ssum[ai][m], 0.f};
                          s2 = __builtin_elementwise_fma((f32x2){xo0[0], xo0[1]}, (f32x2){xo0[0], xo0[1]}, s2); s2 = __builtin_elementwise_fma((f32x2){xo0[2], xo0[3]}, (f32x2){xo0[2], xo0[3]}, s2);
                          s2 = __builtin_elementwise_fma((f32x2){xo1[0], xo1[1]}, (f32x2){xo1[0], xo1[1]}, s2); s2 = __builtin_elementwise_fma((f32x2){xo1[2], xo1[3]}, (f32x2){xo1[2], xo1[3]}, s2);
                          ssum[ai][m] = s2.x + s2.y; }
                        if constexpr (Q8) {
                            const unsigned q0 = q8_pack(q8_bits_s(xo0[0], qs), q8_bits_s(xo0[1], qs), q8_bits_s(xo0[2], qs), q8_bits_s(xo0[3], qs));
                            const unsigned q1 = q8_pack(q8_bits_s(xo1[0], qs), q8_bits_s(xo1[1], qs), q8_bits_s(xo1[2], qs), q8_bits_s(xo1[3], qs));
                            if (bj == 0) { w8.x = q0; w8.y = q1; } else { w8.z = q0; w8.w = q1; }
                        } else {
                        const f32x4 y0 = xo0 * gm[bj][0], y1 = xo1 * gm[bj][1];
                        u32x4 w; w.x = cvt_pk_f16(y0[0], y0[1]); w.y = cvt_pk_f16(y0[2], y0[3]); w.z = cvt_pk_f16(y1[0], y1[1]); w.w = cvt_pk_f16(y1[2], y1[3]);
                        NT_STORE((u32x4*)(XG + off + 8 * bj), w); } } }
                if (Q8 && XG) NT_STORE((u32x4*)((unsigned char*)XG + off), w8);
                if (m & 1) asm volatile("" ::: "memory"); }
        if (XG) {
#pragma unroll
            for (int ai = 0; ai < 2; ++ai)
#pragma unroll
                for (int m = 0; m < 4; ++m) { float q = ssum[ai][m]; q = rows_sum(q);
                    if (fq == 0) atomicAdd(SSo + row0 + ai * HALF + m * 16, (unsigned long long)(q * 16777216.0f)); }
        }
    }
};
struct EpiSwiGLU {
    static constexpr bool PERM = true, PERM16 = false, PREFETCH = true;
    bf16_t* H; const float* shw; const unsigned long long* SS; const float* CW; const unsigned long long* SSq;
    __device__ __forceinline__ void prefetch(LAS unsigned char* aux, const Unit& u, int wid, int lane) const {
        if (wid < 2) __builtin_amdgcn_global_load_lds((const unsigned*)((const char*)(SS + (size_t)u.pm * BM) + wid * 1024 + lane * 16), (LAS unsigned*)(aux + wid * 1024), 16, 0, 0);
        else if (wid == 2) __builtin_amdgcn_global_load_lds((const unsigned*)((const char*)(shw + (size_t)(u.pm >> 3) * (2 * DFF) + u.pn * BM) + lane * 16), (LAS unsigned*)(aux + 2048), 16, 0, 0);
        else if (wid == 3) __builtin_amdgcn_global_load_lds((const unsigned*)((const char*)(CW + (size_t)(u.pm >> 3) * (2 * DFF) + u.pn * BM) + lane * 16), (LAS unsigned*)(aux + 3072), 16, 0, 0);
        else if (wid < 6) __builtin_amdgcn_global_load_lds((const unsigned*)((const char*)(SSq + (size_t)u.pm * BM) + (wid - 4) * 1024 + lane * 16), (LAS unsigned*)(aux + wid * 1024), 16, 0, 0);
    }
    __device__ __forceinline__ void operator()(const f32x4 (&acc)[2][2][4][2], const Unit& u, int wr, int wc, int fr, int fq, const LAS unsigned char* aux) const {
        const int row0 = u.pm * BM + wr * 64 + fr, f0 = u.pn * 128 + wc * 32 + 8 * fq;
        f32x2 bg[4], cg[4], bu[4], cu[4];
        { const LAS float* sp = (const LAS float*)(aux + 2048) + wc * 32 + 8 * fq;
#pragma unroll
          for (int n = 0; n < 2; ++n) { const f32x4 b0 = *(const LAS f32x4*)(sp + 4 * n) * -1.4426950408889634f, c0 = *(const LAS f32x4*)(sp + 256 + 4 * n) * -1.4426950408889634f;
              const f32x4 b1 = *(const LAS f32x4*)(sp + HALF + 4 * n) * -0.6931471805599453f, c1 = *(const LAS f32x4*)(sp + 256 + HALF + 4 * n) * -0.6931471805599453f;
              bg[2 * n] = (f32x2){b0[0], b0[1]}; bg[2 * n + 1] = (f32x2){b0[2], b0[3]}; cg[2 * n] = (f32x2){c0[0], c0[1]}; cg[2 * n + 1] = (f32x2){c0[2], c0[3]};
              bu[2 * n] = (f32x2){b1[0], b1[1]}; bu[2 * n + 1] = (f32x2){b1[2], b1[3]}; cu[2 * n] = (f32x2){c1[0], c1[1]}; cu[2 * n + 1] = (f32x2){c1[2], c1[3]}; } }
        const LAS unsigned long long* ssl = (const LAS unsigned long long*)aux + wr * 64 + fr;
        const LAS unsigned long long* sql = (const LAS unsigned long long*)(aux + 4096) + wr * 64 + fr;
#pragma unroll
        for (int ai = 0; ai < 2; ++ai)
#pragma unroll
            for (int m = 0; m < 4; ++m) { bf16_t* rowp = H + (size_t)(row0 + ai * HALF + m * 16) * DFF + f0;
                const float rs = (Q8_CLIP / 127.0f) * fsqrt(ss_ms(sql[ai * HALF + m * 16]) + EPS) * frsq(ss_ms(ssl[ai * HALF + m * 16]) + EPS);
                const f32x2 rs2 = (f32x2){rs, rs};
                f32x2 g2[4], u2[4], r2[4];
#pragma unroll
                for (int p = 0; p < 4; ++p) { const int n = p >> 1, e = 2 * (p & 1);
                    const f32x2 t0 = (f32x2){(float)__float_as_int(acc[ai][0][m][n][e]), (float)__float_as_int(acc[ai][0][m][n][e + 1])};
                    const f32x2 t1 = (f32x2){(float)__float_as_int(acc[ai][1][m][n][e]), (float)__float_as_int(acc[ai][1][m][n][e + 1])};
                    g2[p] = __builtin_elementwise_fma(t0 * rs2, cg[p], bg[p]); u2[p] = __builtin_elementwise_fma(t1 * rs2, cu[p], bu[p]); }
#pragma unroll
                for (int p = 0; p < 4; ++p) r2[p] = (f32x2){__builtin_amdgcn_exp2f(g2[p].x), __builtin_amdgcn_exp2f(g2[p].y)} + (f32x2){1.0f, 1.0f};
#pragma unroll
                for (int p = 0; p < 4; ++p) r2[p] = (f32x2){__builtin_amdgcn_rcpf(r2[p].x), __builtin_amdgcn_rcpf(r2[p].y)};
                float o[8];
#pragma unroll
                for (int p = 0; p < 4; ++p) { const f32x2 o2 = (g2[p] * r2[p]) * u2[p]; o[2 * p] = o2.x; o[2 * p + 1] = o2.y; }
                u32x4 w; w.x = cvt_pk_bf16(o[0], o[1]); w.y = cvt_pk_bf16(o[2], o[3]); w.z = cvt_pk_bf16(o[4], o[5]); w.w = cvt_pk_bf16(o[6], o[7]);
                __builtin_nontemporal_store(w, (u32x4*)(rowp)); }
    }
};
}

struct Ptrs {
    const float* in[23]; float* out; unsigned char* ws;
};
enum { I_X = 0, I_C, I_RELB, I_WADA, I_BADA, I_GMIX, I_GFFN, I_AWIN, I_AKVG, I_AWUK, I_AWUV, I_AIKG, I_AIKB, I_AWOUT, I_BWIN, I_BBIN, I_BSINK, I_BWOUT, I_BBOUT, I_W1, I_W3, I_W2, I_GFIN };

__device__ __forceinline__ void conv_task(const Ptrs& P, int th, int lane) {
    const int t = th >> 1, half = th & 1;
    int kind, rb, ks, Kd; bf16_t* dst; const float* s0 = nullptr; const float* s1 = nullptr; const float* gk = nullptr; int ld = 0; bool f8 = false, h16 = false;
    if (t < 2112) { const int l = t / 528, r = t % 528; unsigned char* wl = P.ws + WS_W + (size_t)l * W_LAYER;
        if (r < 352) { kind = 1; rb = r >> 2; ks = r & 3; Kd = 1024; dst = (bf16_t*)(wl + W13_OFF); s0 = P.in[I_W1] + (size_t)l * D * DFF; s1 = P.in[I_W3] + (size_t)l * D * DFF; ld = DFF; }
        else { const int r2 = r - 352; kind = 0; rb = r2 / 11; ks = r2 % 11; Kd = DFF; dst = (bf16_t*)(wl + W2_OFF); s0 = P.in[I_W2] + (size_t)l * DFF * D; ld = D; }
    } else { const int t2 = t - 2112, j = t2 / 464, r = t2 % 464; unsigned char* wa = P.ws + WS_WA + (size_t)j * WA_STRIDE; unsigned char* wb = P.ws + WS_WB + (size_t)j * WB_STRIDE;
        if (r < 128) { kind = 2; rb = r >> 2; ks = r & 3; Kd = 1024; dst = (bf16_t*)(wa + WINA_OFF); s0 = P.in[I_AWIN] + (size_t)j * D * A_IN; ld = A_IN; h16 = true; }
        else if (r < 192) { kind = 3; rb = r - 128; ks = 0; Kd = 128; dst = (bf16_t*)(wa + WQA_OFF); s0 = P.in[I_AWUK] + (size_t)j * NH * RK * HD; gk = P.in[I_AKVG] + j * RK; }
        else if (r < 256) { const int r2 = r - 192; kind = 4; rb = r2 >> 2; ks = r2 & 3; Kd = 1024; dst = (bf16_t*)(wa + WUV_OFF); s0 = P.in[I_AWUV] + (size_t)j * NH * RK * HD; gk = P.in[I_AKVG] + j * RK; }
        else if (r < 320) { const int r2 = r - 256; kind = 0; rb = r2 >> 2; ks = r2 & 3; Kd = 1024; dst = (bf16_t*)(wa + WOUTA_OFF); s0 = P.in[I_AWOUT] + (size_t)j * D * D; ld = D; f8 = true; }
        else if (r < 400) { const int r2 = r - 320; kind = 0; rb = r2 >> 2; ks = r2 & 3; Kd = 1024; dst = (bf16_t*)(wb + WINB_OFF); s0 = P.in[I_BWIN] + (size_t)j * D * B_IN; ld = B_IN; h16 = true; }
        else { const int r2 = r - 400; kind = 0; rb = r2 >> 2; ks = r2 & 3; Kd = 1024; dst = (bf16_t*)(wb + WOUTB_OFF); s0 = P.in[I_BWOUT] + (size_t)j * D * D; ld = D; f8 = true; }
    }
    const int n = rb * 64 + lane, k0 = ks * 256;
    bf16_t* drow = dst + (size_t)n * Kd + k0;
    if (kind <= 2) {
        const float* src = s0; int col = n;
        if (kind == 1) { const int c = n & 255, f = (n >> 8) * 128 + (c & 127); src = (c < 128) ? s0 : s1; col = f; }
        if (kind == 2) { if (n >= 1792) { const int c = n - 1792; col = c < 64 ? 1792 + c : (c < 72 ? 1856 + (c - 64) : -1); } }
        const float* sp = src + (size_t)k0 * ld + (col < 0 ? 0 : col);
        for (int kq = 4 * half; kq < 4 * half + 4; ++kq) {
          float vv[4][8];
#pragma unroll
          for (int i = 0; i < 4; ++i)
#pragma unroll
            for (int e = 0; e < 8; ++e) vv[i][e] = sp[(size_t)((kq * 4 + i) * 8 + e) * ld];
          asm volatile("" ::: "memory");
#pragma unroll
          for (int i = 0; i < 4; ++i) { const int kc = kq * 4 + i;
            float v[8];
#pragma unroll
            for (int e = 0; e < 8; ++e) v[e] = vv[i][e];
            if (col < 0) {
#pragma unroll
                for (int e = 0; e < 8; ++e) v[e] = 0.f; }
            if (f8) {
#pragma unroll
                for (int e = 0; e < 8; ++e) v[e] = __builtin_amdgcn_fmed3f(v[e] * 256.0f, -448.0f, 448.0f);
                int w0 = 0, w1 = 0;
                w0 = __builtin_amdgcn_cvt_pk_fp8_f32(v[0], v[1], w0, false); w0 = __builtin_amdgcn_cvt_pk_fp8_f32(v[2], v[3], w0, true);
                w1 = __builtin_amdgcn_cvt_pk_fp8_f32(v[4], v[5], w1, false); w1 = __builtin_amdgcn_cvt_pk_fp8_f32(v[6], v[7], w1, true);
                u32x2 w; w.x = (unsigned)w0; w.y = (unsigned)w1; *(u32x2*)((unsigned char*)dst + (size_t)n * Kd + k0 + kc * 8) = w;
            } else if (h16) {
            u32x4 w; w.x = cvt_pk_f16(v[0], v[1]); w.y = cvt_pk_f16(v[2], v[3]); w.z = cvt_pk_f16(v[4], v[5]); w.w = cvt_pk_f16(v[6], v[7]);
            *(u32x4*)(drow + kc * 8) = w;
            } else {
            u32x4 w; w.x = cvt_pk_bf16(v[0], v[1]); w.y = cvt_pk_bf16(v[2], v[3]); w.z = cvt_pk_bf16(v[4], v[5]); w.w = cvt_pk_bf16(v[6], v[7]);
            *(u32x4*)(drow + kc * 8) = w; }
        } }
    } else if (kind == 3) {
        const int h = n >> 8, r = n & 255; const float gs = gk[r] * 8.0f;       const float* sp = s0 + ((size_t)h * RK + r) * HD;
        for (int kc = 0; kc < ((half || n >= 2048) ? 0 : 16); ++kc) { const int k = kc * 8; float v[8];
            if (true) { const float* sp2 = s0 + ((size_t)(2 * h + (k >> 6)) * RK + r) * HD;
#pragma unroll
                for (int e = 0; e < 8; ++e) v[e] = sp2[(k & 63) + e] * gs;
            } else {
#pragma unroll
                for (int e = 0; e < 8; ++e) v[e] = 0.f; }
            u32x4 w; w.x = cvt_pk_bf16(v[0], v[1]); w.y = cvt_pk_bf16(v[2], v[3]); w.z = cvt_pk_bf16(v[4], v[5]); w.w = cvt_pk_bf16(v[6], v[7]);
            *(u32x4*)(drow + kc * 8) = w; }
    } else {
        const int hh = (n >> 6) & 3, d = n & 63, h = n >> 6;
        for (int kc = 16 * half; kc < 16 * half + 16; ++kc) { const int k = k0 + kc * 8; float v[8];
            if ((k >> 8) == hh) {
#pragma unroll
                for (int e = 0; e < 8; ++e) { const int r = (k & 255) + e; v[e] = s0[((size_t)h * RK + r) * HD + d] * gk[r] * 16.0f; }
            } else {
#pragma unroll
                for (int e = 0; e < 8; ++e) v[e] = 0.f; }
            u32x4 w; w.x = cvt_pk_bf16(v[0], v[1]); w.y = cvt_pk_bf16(v[2], v[3]); w.z = cvt_pk_bf16(v[4], v[5]); w.w = cvt_pk_bf16(v[6], v[7]);
            *(u32x4*)(drow + kc * 8) = w; }
    }
}
constexpr int N_CONV_TASKS = 6080;

__device__ __forceinline__ void p0_prologue(const Ptrs& P, LAS unsigned char* lds, int G) {
    int tid = tid_now();
    const int lane = tid & 63, wave = __builtin_amdgcn_readfirstlane(tid >> 6);
    const int gw = blockIdx.x * NWAVES + wave, NGW = G * NWAVES;
    for (int t = gw; t < N_CONV_TASKS; t += NGW) conv_task(P, t, lane);
    LAS float* cs = (LAS float*)lds;
    LAS float* red = (LAS float*)(lds + 65536);
    for (int i = tid; i < BATCH * D; i += NTHR) { const int b = i >> 10, k = i & 1023; cs[k * 16 + b] = silu_f(P.in[I_C][i]); }
    __syncthreads();
    float* mod = (float*)(P.ws + WS_MOD);
    for (int task = blockIdx.x; task < 4 * 96; task += G) {
        const int l = task / 96, j0 = (task % 96) * 64, col = tid & 63, ksl = tid >> 6;
        const float* wp = P.in[I_WADA] + ((size_t)l * D + ksl * 128) * 6144 + j0 + col;
        float a[16];
#pragma unroll
        for (int b = 0; b < 16; ++b) a[b] = 0.f;
        for (int k = 0; k < 128; ++k) { const float w = wp[(size_t)k * 6144]; const LAS f32x4* c4 = (const LAS f32x4*)(cs + (ksl * 128 + k) * 16);
#pragma unroll
            for (int q = 0; q < 4; ++q) { const f32x4 c = c4[q];
#pragma unroll
                for (int e = 0; e < 4; ++e) a[4 * q + e] += w * c[e]; } }
#pragma unroll
        for (int b = 0; b < 16; ++b) red[(ksl * 64 + col) * 16 + b] = a[b];
        __syncthreads();
        for (int o = tid; o < 1024; o += NTHR) { const int c2 = o >> 4, b = o & 15; float s = 0.f;
#pragma unroll
            for (int q = 0; q < 8; ++q) s += red[(q * 64 + c2) * 16 + b];
            mod[((size_t)l * BATCH + b) * 6144 + j0 + c2] = s + P.in[I_BADA][l * 6144 + j0 + c2]; }
        __syncthreads();
    }
}

__device__ __forceinline__ void pre_phase(const Ptrs& P, LAS unsigned char* lds, int G) {
    int tid = tid_now();
    const int lane = tid & 63, wave = __builtin_amdgcn_readfirstlane(tid >> 6);
    const float* mod = (const float*)(P.ws + WS_MOD);
    {
        const int grp = blockIdx.x & 7, l = grp >> 1, kind = grp & 1, j = l >> 1;
        const float* shsrc = mod + (size_t)l * BATCH * 6144 + (kind ? 3072 : 0);
        constexpr int SP = 2064;
        for (int i = tid; i < BATCH * D / 2; i += NTHR) { const int b = i >> 9, k2 = (i & 511) * 2;
            const float a0 = shsrc[(size_t)b * 6144 + k2], a1 = shsrc[(size_t)b * 6144 + k2 + 1];
            *(LAS unsigned*)(lds + b * SP + k2 * 2) = kind ? cvt_pk_bf16(a0, a1) : cvt_pk_f16(a0, a1); }
        __syncthreads();
        const bf16_t* W; int nrows; float* dst; const float* bias = nullptr;
        if (kind) { W = (const bf16_t*)(P.ws + WS_W + (size_t)l * W_LAYER + W13_OFF); nrows = 2 * DFF; dst = (float*)(P.ws + WS_SHW + SHW_F) + (size_t)l * BATCH * 2 * DFF; }
        else if ((l & 1) == 0) { W = (const bf16_t*)(P.ws + WS_WA + (size_t)j * WA_STRIDE + WINA_OFF); nrows = 2048; dst = (float*)(P.ws + WS_SHW + SHW_A) + (size_t)j * BATCH * 2048; }
        else { W = (const bf16_t*)(P.ws + WS_WB + (size_t)j * WB_STRIDE + WINB_OFF); nrows = B_IN; dst = (float*)(P.ws + WS_SHW + SHW_B) + (size_t)j * BATCH * B_IN; bias = P.in[I_BBIN] + j * B_IN; }
        const int nblk = nrows >> 4, wq = (blockIdx.x >> 3) * NWAVES + wave, nwq = (G >> 3) * NWAVES;
        const int nn = lane & 15, g = lane >> 4;
        for (int blk = wq; blk < nblk; blk += nwq) {
            f32x4 acc = (f32x4){0.f, 0.f, 0.f, 0.f};
            const bf16_t* wp = W + (size_t)(blk * 16 + nn) * D + 8 * g;
#pragma unroll 8
            for (int ks = 0; ks < 32; ++ks) { const bf16x8 a = *(const LAS bf16x8*)(lds + nn * SP + (32 * ks + 8 * g) * 2); const bf16x8 bw = *(const bf16x8*)(wp + 32 * ks);
                acc = kind ? __builtin_amdgcn_mfma_f32_16x16x32_bf16(a, bw, acc, 0, 0, 0) : __builtin_amdgcn_mfma_f32_16x16x32_f16(__builtin_bit_cast(h16x8, a), __builtin_bit_cast(h16x8, bw), acc, 0, 0, 0); }
            const int n = blk * 16 + nn; const float bb = bias ? bias[n] : 0.f;
#pragma unroll
            for (int i = 0; i < 4; ++i) dst[(size_t)(4 * g + i) * nrows + n] = acc[i] + bb;
        }
    }
    {
        const int gw = blockIdx.x * NWAVES + wave, NGW = G * NWAVES;
        const float* x = P.in[I_X]; const float* gmix = P.in[I_GMIX]; bf16_t* XG = (bf16_t*)(P.ws + WS_XG); unsigned long long* SS0 = (unsigned long long*)(P.ws + WS_SS);
        for (int row = gw; row < M; row += NGW) {
            const int b = row >> 11;
            const f32x4* xr = (const f32x4*)(x + (size_t)row * D) + lane;
            f32x4 v[4]; float sq = 0.f;
#pragma unroll
            for (int jj = 0; jj < 4; ++jj) { v[jj] = xr[64 * jj]; sq += (v[jj][0] * v[jj][0] + v[jj][1] * v[jj][1]) + (v[jj][2] * v[jj][2] + v[jj][3] * v[jj][3]); }
            const float ss = wave_sum(sq);
            if (lane == 0) SS0[row] = (unsigned long long)(ss * 16777216.0f);
            const float* mb = mod + (size_t)b * 6144;
            u32x2* o8 = (u32x2*)(XG + (size_t)row * D) + lane; u32x2* x8 = (u32x2*)((bf16_t*)P.out + (size_t)row * D) + lane;
#pragma unroll
            for (int jj = 0; jj < 4; ++jj) { const int c = 4 * lane + 256 * jj;
                const f32x4 y = v[jj] * *(const f32x4*)(gmix + c) * (*(const f32x4*)(mb + 1024 + c) + 1.0f);
                u32x2 w; w.x = cvt_pk_f16(y[0], y[1]); w.y = cvt_pk_f16(y[2], y[3]); NT_STORE(o8 + 64 * jj, w);
                u32x2 xw; xw.x = cvt_pk_f16(v[jj][0], v[jj][1]); xw.y = cvt_pk_f16(v[jj][2], v[jj][3]); NT_STORE(x8 + 64 * jj, xw); }
        }
    }
}
__device__ __forceinline__ float half_max(float x);
__device__ __forceinline__ float wave_max(float x) {
    const float h = half_max(x);
    const u32x2 r = __builtin_amdgcn_permlane32_swap(__float_as_uint(h), __float_as_uint(h), false, false);
    return fmaxf(__uint_as_float(r.x), __uint_as_float(r.y));
}
template <bool F16>
__device__ __forceinline__ void w8_build(const bf16_t* W13, int nrows, const float* gffn, const float* scn, unsigned char* W8, float* CW, LAS unsigned char* lds, int G) {
    int tid = tid_now();
    const int lane = tid & 63, wave = __builtin_amdgcn_readfirstlane(tid >> 6);
    LAS float* mL = (LAS float*)lds;
    for (int i = tid; i < BATCH * D / 4; i += NTHR) { const int b = i >> 8, k4 = (i & 255) * 4;
        *(LAS f32x4*)(mL + b * D + k4) = *(const f32x4*)(gffn + k4) * (*(const f32x4*)(scn + (size_t)b * 6144 + k4) + 1.0f); }
    __syncthreads();
    const int gw = blockIdx.x * NWAVES + wave, NGW = G * NWAVES;
    const size_t bstride = (size_t)nrows * D;
    for (int n = gw; n < nrows; n += NGW) {
        const u32x2* wrow = (const u32x2*)(W13 + (size_t)n * D) + lane;
        float w[16];
#pragma unroll
        for (int j = 0; j < 4; ++j) { const u32x2 p = wrow[64 * j];
            if (F16) { const f32x2 pa = unpk_f16(p.x), pb = unpk_f16(p.y); w[4 * j] = pa.x; w[4 * j + 1] = pa.y; w[4 * j + 2] = pb.x; w[4 * j + 3] = pb.y; }
            else { w[4 * j] = __uint_as_float(p.x << 16); w[4 * j + 1] = __uint_as_float(p.x & 0xffff0000u); w[4 * j + 2] = __uint_as_float(p.y << 16); w[4 * j + 3] = __uint_as_float(p.y & 0xffff0000u); } }
        unsigned* orow = (unsigned*)(W8 + (size_t)n * D) + lane;
#pragma unroll 2
        for (int b = 0; b < BATCH; ++b) {
            float v[16]; float mx = 0.f;
#pragma unroll
            for (int j = 0; j < 4; ++j) { const f32x4 mm = *(const LAS f32x4*)(mL + b * D + 256 * j + 4 * lane);
#pragma unroll
                for (int e = 0; e < 4; ++e) v[4 * j + e] = w[4 * j + e] * mm[e];
                mx = fmaxf(fmaxf(mx, fmaxf(fabsf(v[4 * j]), fabsf(v[4 * j + 1]))), fmaxf(fabsf(v[4 * j + 2]), fabsf(v[4 * j + 3]))); }
            mx = fmaxf(wave_max(mx), 1e-30f);
            const float inv = 127.0f / mx;
#pragma unroll
            for (int j = 0; j < 4; ++j)
                NT_STORE(orow + (size_t)b * (bstride / 4) + 64 * j, pg8::q8_pack(__float_as_uint(fmaf(v[4 * j], inv, 12582912.0f)), __float_as_uint(fmaf(v[4 * j + 1], inv, 12582912.0f)),
                                                                          __float_as_uint(fmaf(v[4 * j + 2], inv, 12582912.0f)), __float_as_uint(fmaf(v[4 * j + 3], inv, 12582912.0f))));
            if (lane == 0) CW[(size_t)b * nrows + n] = mx * (1.0f / 127.0f);
        }
    }
    __syncthreads();
}
__device__ __forceinline__ void final_norm_phase(const bf16_t* x, float* out, const float* g, int G) {
    int tid = tid_now();
    const int lane = tid & 63, wave = __builtin_amdgcn_readfirstlane(tid >> 6);
    const int gw = blockIdx.x * NWAVES + wave, NGW = G * NWAVES;
    for (int row = gw; row < M; row += NGW) {
        const u32x2* xr = (const u32x2*)(x + (size_t)row * D) + lane; f32x4* orow = (f32x4*)(out + (size_t)row * D) + lane;
        f32x4 v[4]; float s = 0.f;
#pragma unroll
        for (int j = 0; j < 4; ++j) { const u32x2 p = xr[64 * j];
            { const f32x2 pa = unpk_f16(p.x), pb = unpk_f16(p.y); v[j] = (f32x4){pa.x, pa.y, pb.x, pb.y}; }
            s += (v[j][0] * v[j][0] + v[j][1] * v[j][1]) + (v[j][2] * v[j][2] + v[j][3] * v[j][3]); }
        const float rstd = 1.0f / sqrtf(wave_sum(s) * (1.0f / D) + EPS);
#pragma unroll
        for (int j = 0; j < 4; ++j) { const f32x4 gg = *(const f32x4*)(g + 4 * lane + 256 * j); NT_STORE(orow + 64 * j, v[j] * rstd * gg); }
    }
}

__device__ __forceinline__ unsigned f2key(float f) { const unsigned u = __float_as_uint(f); return (u & 0x80000000u) ? ~u : (u | 0x80000000u); }
__device__ __forceinline__ float key2f(unsigned k) { return __uint_as_float((k & 0x80000000u) ? (k & 0x7fffffffu) : ~k); }
__device__ __forceinline__ float half_max(float x) {
    int u = __float_as_int(x);
    u = __float_as_int(fmaxf(__int_as_float(u), __int_as_float(__builtin_amdgcn_update_dpp(u, u, 0x128, 0xf, 0xf, false))));
    u = __float_as_int(fmaxf(__int_as_float(u), __int_as_float(__builtin_amdgcn_update_dpp(u, u, 0x124, 0xf, 0xf, false))));
    u = __float_as_int(fmaxf(__int_as_float(u), __int_as_float(__builtin_amdgcn_update_dpp(u, u, 0x122, 0xf, 0xf, false))));
    u = __float_as_int(fmaxf(__int_as_float(u), __int_as_float(__builtin_amdgcn_update_dpp(u, u, 0x121, 0xf, 0xf, false))));
    const u32x2 r = __builtin_amdgcn_permlane16_swap((unsigned)u, (unsigned)u, false, false);
    return fmaxf(__uint_as_float(r.x), __uint_as_float(r.y));
}
__device__ __forceinline__ float half_sum_f(float v) {
    v += __int_as_float(__builtin_amdgcn_update_dpp(__float_as_int(v), __float_as_int(v), 0x128, 0xf, 0xf, false));
    v += __int_as_float(__builtin_amdgcn_update_dpp(__float_as_int(v), __float_as_int(v), 0x124, 0xf, 0xf, false));
    v += __int_as_float(__builtin_amdgcn_update_dpp(__float_as_int(v), __float_as_int(v), 0x122, 0xf, 0xf, false));
    v += __int_as_float(__builtin_amdgcn_update_dpp(__float_as_int(v), __float_as_int(v), 0x121, 0xf, 0xf, false));
    const u32x2 r = __builtin_amdgcn_permlane16_swap(__float_as_uint(v), __float_as_uint(v), false, false);
    return __uint_as_float(r.x) + __uint_as_float(r.y);
}
__device__ __forceinline__ f32x2 pk_gt(f32x2 x, f32x2 big, f32x2 nfbig) { f32x2 d; asm("v_pk_fma_f32 %0, %1, %2, %3 clamp" : "=v"(d) : "v"(x), "v"(big), "v"(nfbig)); return d; }
__device__ __forceinline__ int half_sum(int v) {
    v += __builtin_amdgcn_update_dpp(v, v, 0x128, 0xf, 0xf, false);
    v += __builtin_amdgcn_update_dpp(v, v, 0x124, 0xf, 0xf, false);
    v += __builtin_amdgcn_update_dpp(v, v, 0x122, 0xf, 0xf, false);
    v += __builtin_amdgcn_update_dpp(v, v, 0x121, 0xf, 0xf, false);
    const u32x2 r = __builtin_amdgcn_permlane16_swap((unsigned)v, (unsigned)v, false, false);
    return (int)(r.x + r.y);
}
typedef float f32x32 __attribute__((ext_vector_type(32)));
__device__ __forceinline__ void idx_task(const bf16_t* QI, const bf16_t* KIN, const float* WI, unsigned* SEL, LAS unsigned char* lds, int b, int tg, int lane, int wave, bool active, int kneed) {
    asm volatile("" : "+v"(lane));
    const int t0 = tg * 4, h = lane >> 5, r = lane & 31;
    const int qsel = 2 * (r >> 4) + ((r >> 2) & 1), hd = (r & 3) + 4 * ((r >> 3) & 1);
    const size_t rowb = (size_t)b * SEQ;
    bf16x8 aq[4];
#pragma unroll
    for (int ks = 0; ks < 4; ++ks) aq[ks] = *(const bf16x8*)(QI + (rowb + t0 + qsel) * 512 + hd * 64 + ks * 16 + h * 8);
    float wlo[8], whi[8];
    { const f32x4 a0 = *(const f32x4*)(WI + (rowb + t0 + h) * 8), a1 = *(const f32x4*)(WI + (rowb + t0 + h) * 8 + 4);
      const f32x4 b0 = *(const f32x4*)(WI + (rowb + t0 + 2 + h) * 8), b1 = *(const f32x4*)(WI + (rowb + t0 + 2 + h) * 8 + 4);
#pragma unroll
      for (int e = 0; e < 4; ++e) { wlo[e] = a0[e]; wlo[4 + e] = a1[e]; whi[e] = b0[e]; whi[4 + e] = b1[e]; } }
    f32x32 sA0, sA1, sB0, sB1;
#pragma unroll
    for (int i = 0; i < 32; ++i) { sA0[i] = NEGF; sA1[i] = NEGF; sB0[i] = NEGF; sB1[i] = NEGF; }
    const int ktmax = (t0 + 3) >> 5, tlo = t0 + h, thi = t0 + 2 + h;
    const unsigned lb = (unsigned)(size_t)lds;
    const int sw = (r >> 1) & 7;
#define IDX_LDS4(R0, R1, R2, R3) asm volatile("ds_read_b128 %0, %4\n\tds_read_b128 %1, %5\n\tds_read_b128 %2, %6\n\tds_read_b128 %3, %7" \
                                             : "=&v"(R0), "=&v"(R1), "=&v"(R2), "=&v"(R3) : "v"(a0), "v"(a1), "v"(a2), "v"(a3) : "memory")
#define IDX_TILE(KTL, KEY0, SA, SB, C0, C1, C2, C3, N0, N1, N2, N3) \
        { \
            a0 += 4096u; a1 += 4096u; a2 += 4096u; a3 += 4096u; \
            IDX_LDS4(N0, N1, N2, N3);                          \
            asm volatile("s_waitcnt lgkmcnt(4)" : "+v"(C0), "+v"(C1), "+v"(C2), "+v"(C3) :: "memory");     \
            f32x16 acc; \
            _Pragma("unroll") for (int i = 0; i < 16; ++i) acc[i] = 0.f; \
            acc = __builtin_amdgcn_mfma_f32_32x32x16_f16(__builtin_bit_cast(h16x8, aq[0]), __builtin_bit_cast(h16x8, C0), acc, 0, 0, 0); acc = __builtin_amdgcn_mfma_f32_32x32x16_f16(__builtin_bit_cast(h16x8, aq[1]), __builtin_bit_cast(h16x8, C1), acc, 0, 0, 0); \
            acc = __builtin_amdgcn_mfma_f32_32x32x16_f16(__builtin_bit_cast(h16x8, aq[2]), __builtin_bit_cast(h16x8, C2), acc, 0, 0, 0); acc = __builtin_amdgcn_mfma_f32_32x32x16_f16(__builtin_bit_cast(h16x8, aq[3]), __builtin_bit_cast(h16x8, C3), acc, 0, 0, 0); \
            f32x2 p0 = (f32x2){0.f, 0.f}, p1 = (f32x2){0.f, 0.f};            \
            _Pragma("unroll") for (int i = 0; i < 4; ++i) { \
                const f32x2 r0 = (f32x2){__builtin_amdgcn_fmed3f(acc[2 * i], 0.f, 3.0e38f), __builtin_amdgcn_fmed3f(acc[2 * i + 1], 0.f, 3.0e38f)}; \
                const f32x2 r1 = (f32x2){__builtin_amdgcn_fmed3f(acc[8 + 2 * i], 0.f, 3.0e38f), __builtin_amdgcn_fmed3f(acc[9 + 2 * i], 0.f, 3.0e38f)}; \
                p0 = __builtin_elementwise_fma((f32x2){wlo[2 * i], wlo[2 * i + 1]}, r0, p0); p1 = __builtin_elementwise_fma((f32x2){whi[2 * i], whi[2 * i + 1]}, r1, p1); } \
            const float s0 = p0.x + p0.y, s1 = p1.x + p1.y; \
            const int key = (KEY0) + r; \
            SA[KTL] = key <= tlo ? s0 : NEGF; SB[KTL] = key <= thi ? s1 : NEGF; \
        }
    bf16x8 ta0, ta1, ta2, ta3, tb0, tb1, tb2, tb3;
#pragma unroll
    for (int rnd = 0; rnd < 2; ++rnd) {
        if (1024 * rnd >= kneed) break;
        __syncthreads();
        {
            const int rl = lane >> 3, pp = lane & 7;
#pragma unroll 4
            for (int j = 0; j < 16; ++j) { const int pi = j * 8 + wave, row = 8 * pi + rl;
                if (1024 * rnd + 8 * pi >= kneed) continue;
                const bf16_t* src = KIN + (rowb + 1024 * rnd + row) * 64 + 8 * (pp ^ ((row >> 1) & 7));
                __builtin_amdgcn_global_load_lds((const unsigned*)src, (LAS unsigned*)(lds + 1024 * pi), 16, 0, 0); }
        }
        asm volatile("s_waitcnt vmcnt(0)" ::: "memory");
        __syncthreads();
        const int ntl = ktmax - 32 * rnd + 1;
        if (active && ntl > 0) {
            const int npair = ((ntl < 32 ? ntl : 32) + 1) >> 1;
            unsigned a0 = lb + (unsigned)r * 128u + 16u * (unsigned)((0 + h) ^ sw), a1 = lb + (unsigned)r * 128u + 16u * (unsigned)((2 + h) ^ sw);
            unsigned a2 = lb + (unsigned)r * 128u + 16u * (unsigned)((4 + h) ^ sw), a3 = lb + (unsigned)r * 128u + 16u * (unsigned)((6 + h) ^ sw);
            IDX_LDS4(ta0, ta1, ta2, ta3);
#pragma nounroll
            for (int kp = 0; kp < npair; ++kp) {
                if (rnd == 0) { IDX_TILE(2 * kp, 64 * kp, sA0, sB0, ta0, ta1, ta2, ta3, tb0, tb1, tb2, tb3)
                                IDX_TILE(2 * kp + 1, 64 * kp + 32, sA0, sB0, tb0, tb1, tb2, tb3, ta0, ta1, ta2, ta3) }
                else          { IDX_TILE(2 * kp, 1024 + 64 * kp, sA1, sB1, ta0, ta1, ta2, ta3, tb0, tb1, tb2, tb3)
                                IDX_TILE(2 * kp + 1, 1024 + 64 * kp + 32, sA1, sB1, tb0, tb1, tb2, tb3, ta0, ta1, ta2, ta3) }
            }
            asm volatile("s_waitcnt lgkmcnt(0)" : "+v"(ta0), "+v"(ta1), "+v"(ta2), "+v"(ta3), "+v"(tb0), "+v"(tb1), "+v"(tb2), "+v"(tb3) :: "memory");
        }
    }
#undef IDX_TILE
#undef IDX_LDS4
    if (!active) return;
    const int nt0 = ktmax < 31 ? ktmax + 1 : 32, nt1 = ktmax - 31;
    float mxA = NEGF, mxB = NEGF, mnA = -NEGF, mnB = -NEGF;
#pragma nounroll
    for (int kt = 0; kt < nt0; ++kt) { const float a = sA0[kt], bb = sB0[kt];
        mxA = fmaxf(mxA, a); mxB = fmaxf(mxB, bb); mnA = fminf(mnA, a > -1e29f ? a : -NEGF); mnB = fminf(mnB, bb > -1e29f ? bb : -NEGF); }
#pragma nounroll
    for (int kt = 0; kt < nt1; ++kt) { const float a = sA1[kt], bb = sB1[kt];
        mxA = fmaxf(mxA, a); mxB = fmaxf(mxB, bb); mnA = fminf(mnA, a > -1e29f ? a : -NEGF); mnB = fminf(mnB, bb > -1e29f ? bb : -NEGF); }
    mxA = half_max(mxA); mxB = half_max(mxB); mnA = -half_max(-mnA); mnB = -half_max(-mnB);
    const int Ka = tlo + 1 < TOPK ? tlo + 1 : TOPK, Kb = thi + 1 < TOPK ? thi + 1 : TOPK;
    float loA = mnA - (fabsf(mnA) * 1e-6f + 1e-30f), hiA = mxA, loB = mnB - (fabsf(mnB) * 1e-6f + 1e-30f), hiB = mxB;
    float cloA = (float)(tlo + 1), chiA = 0.0f, cloB = (float)(thi + 1), chiB = 0.0f;
    float TA = -1e29f, TB = -1e29f; bool doneA = (tlo + 1 <= TOPK), doneB = (thi + 1 <= TOPK);
    const int nblk = (ktmax >> 3) + 1;
    const float BIG = 1099511627776.0f;
#define SA2(i) ((i) < 32 ? (f32x2){sA0[(i) & 31], sA0[((i) & 31) + 1]} : (f32x2){sA1[(i) & 31], sA1[((i) & 31) + 1]})
#define SB2(i) ((i) < 32 ? (f32x2){sB0[(i) & 31], sB0[((i) & 31) + 1]} : (f32x2){sB1[(i) & 31], sB1[((i) & 31) + 1]})
#pragma nounroll
    for (int it = 0; it < 48; ++it) {
        if (__ballot(!doneA || !doneB) == 0ull) break;
        const bool bis = (it % 3) == 2;
        const float wA = hiA - loA, wB = hiB - loB;
        float rA = bis ? 0.5f : (cloA - (float)Ka + 0.5f) * __builtin_amdgcn_rcpf(cloA - chiA + 1.0f), rB = bis ? 0.5f : (cloB - (float)Kb + 0.5f) * __builtin_amdgcn_rcpf(cloB - chiB + 1.0f);
        rA = fminf(fmaxf(rA, 0.03f), 0.97f); rB = fminf(fmaxf(rB, 0.03f), 0.97f);
        const float midA = loA + wA * rA, midB = loB + wB * rB;
        const float fA = doneA ? TA : midA, fB = doneB ? TB : midB;
        const f32x2 bigp = (f32x2){BIG, BIG}, nfA = (f32x2){-fA * BIG, -fA * BIG}, nfB = (f32x2){-fB * BIG, -fB * BIG};
        f32x2 cA2 = (f32x2){0.f, 0.f}, cB2 = (f32x2){0.f, 0.f};
#pragma unroll
        for (int blk = 0; blk < 8; ++blk) {
            if (blk < nblk) {
#pragma unroll
                for (int e = 0; e < 4; ++e) { cA2 += pk_gt(SA2(8 * blk + 2 * e), bigp, nfA); cB2 += pk_gt(SB2(8 * blk + 2 * e), bigp, nfB); }
            }
        }
        const int cA = (int)half_sum_f(cA2.x + cA2.y), cB = (int)half_sum_f(cB2.x + cB2.y);
        const bool stuckA = !(midA > loA && midA < hiA), stuckB = !(midB > loB && midB < hiB);
        if (!doneA) { if (cA == Ka) { TA = fA; doneA = true; } else if (stuckA) { TA = loA; doneA = true; } else if (cA > Ka) { loA = midA; cloA = (float)cA; } else { hiA = midA; chiA = (float)cA; } }
        if (!doneB) { if (cB == Kb) { TB = fB; doneB = true; } else if (stuckB) { TB = loB; doneB = true; } else if (cB > Kb) { loB = midB; cloB = (float)cB; } else { hiB = midB; chiB = (float)cB; } }
    }
#undef SA2
#undef SB2
    if (!doneA) TA = loA;
    if (!doneB) TB = loB;
    unsigned w0 = 0u, w1 = 0u, w2 = 0u, w3 = 0u;
#pragma nounroll
    for (int kt = 0; kt < nt0; ++kt) { const unsigned long long ma = __ballot(sA0[kt] > TA), mb = __ballot(sB0[kt] > TB);
        if (lane == kt) { w0 = (unsigned)ma; w1 = (unsigned)(ma >> 32); w2 = (unsigned)mb; w3 = (unsigned)(mb >> 32); } }
#pragma nounroll
    for (int kt = 0; kt < nt1; ++kt) { const unsigned long long ma = __ballot(sA1[kt] > TA), mb = __ballot(sB1[kt] > TB);
        if (lane == 32 + kt) { w0 = (unsigned)ma; w1 = (unsigned)(ma >> 32); w2 = (unsigned)mb; w3 = (unsigned)(mb >> 32); } }
    SEL[(rowb + t0 + 0) * 64 + lane] = w0; SEL[(rowb + t0 + 1) * 64 + lane] = w1; SEL[(rowb + t0 + 2) * 64 + lane] = w2; SEL[(rowb + t0 + 3) * 64 + lane] = w3;
}

#define ATT_F(r) (((r) & 3) | ((((r) >> 3) & 3) << 2))
#define TRB8(OFS, r0, r1, r2, r3, r4, r5, r6, r7, a0, a1, a2, a3, a4, a5, a6, a7) \
    asm volatile("ds_read_b64_tr_b16 %0, %8 offset:" OFS "\n\tds_read_b64_tr_b16 %1, %9 offset:" OFS "\n\tds_read_b64_tr_b16 %2, %10 offset:" OFS "\n\tds_read_b64_tr_b16 %3, %11 offset:" OFS "\n\t" \
                 "ds_read_b64_tr_b16 %4, %12 offset:" OFS "\n\tds_read_b64_tr_b16 %5, %13 offset:" OFS "\n\tds_read_b64_tr_b16 %6, %14 offset:" OFS "\n\tds_read_b64_tr_b16 %7, %15 offset:" OFS "\n\ts_waitcnt lgkmcnt(0)" \
                 : "=&v"(r0), "=&v"(r1), "=&v"(r2), "=&v"(r3), "=&v"(r4), "=&v"(r5), "=&v"(r6), "=&v"(r7) \
                 : "v"(a0), "v"(a1), "v"(a2), "v"(a3), "v"(a4), "v"(a5), "v"(a6), "v"(a7) : "memory")
#define RDK8(OFS, r, a) \
    asm volatile("ds_read_b64 %0, %8 offset:" OFS "\n\tds_read_b64 %1, %9 offset:" OFS "\n\tds_read_b64 %2, %10 offset:" OFS "\n\tds_read_b64 %3, %11 offset:" OFS "\n\t" \
                 "ds_read_b64 %4, %12 offset:" OFS "\n\tds_read_b64 %5, %13 offset:" OFS "\n\tds_read_b64 %6, %14 offset:" OFS "\n\tds_read_b64 %7, %15 offset:" OFS "\n\ts_waitcnt lgkmcnt(0)" \
                 : "=&v"(r[0]), "=&v"(r[1]), "=&v"(r[2]), "=&v"(r[3]), "=&v"(r[4]), "=&v"(r[5]), "=&v"(r[6]), "=&v"(r[7]) \
                 : "v"(a[0]), "v"(a[1]), "v"(a[2]), "v"(a[3]), "v"(a[4]), "v"(a[5]), "v"(a[6]), "v"(a[7]) : "memory")
__device__ __forceinline__ float rows_max(float x) {
    unsigned u = __float_as_uint(x);
    u32x2 r = __builtin_amdgcn_permlane16_swap(u, u, false, false);
    u = __float_as_uint(fmaxf(__uint_as_float(r.x), __uint_as_float(r.y)));
    r = __builtin_amdgcn_permlane32_swap(u, u, false, false);
    return fmaxf(__uint_as_float(r.x), __uint_as_float(r.y));
}
__device__ __forceinline__ float rows_sum(float x) {
    unsigned u = __float_as_uint(x);
    u32x2 r = __builtin_amdgcn_permlane16_swap(u, u, false, false);
    u = __float_as_uint(__uint_as_float(r.x) + __uint_as_float(r.y));
    r = __builtin_amdgcn_permlane32_swap(u, u, false, false);
    return __uint_as_float(r.x) + __uint_as_float(r.y);
}

__device__ __forceinline__ int att_build_list(LAS unsigned* list, const LAS unsigned* btab, unsigned w, int t, int lane) {
    const int pc = __popc(w); int incl = pc;
    incl += __builtin_amdgcn_update_dpp(0, incl, 0x111, 0xf, 0xf, true);
    incl += __builtin_amdgcn_update_dpp(0, incl, 0x112, 0xf, 0xf, true);
    incl += __builtin_amdgcn_update_dpp(0, incl, 0x114, 0xf, 0xf, true);
    incl += __builtin_amdgcn_update_dpp(0, incl, 0x118, 0xf, 0xf, true);
    { const int r0 = __builtin_amdgcn_readlane(incl, 15), r1 = __builtin_amdgcn_readlane(incl, 31), r2 = __builtin_amdgcn_readlane(incl, 47);
      incl += (lane >= 16 ? r0 : 0) + (lane >= 32 ? r1 : 0) + (lane >= 48 ? r2 : 0); }
    const int total = __builtin_amdgcn_readlane(incl, 63); const int cnt = total < TOPK ? total : TOPK;
    int off = incl - pc;
    while (w) { const int bit = __builtin_ctz(w); w &= w - 1u;
        if (off < TOPK) { const int idx = 32 * lane + bit; int dd = t - idx; dd = dd < 0 ? 0 : (dd > 128 ? 128 : dd); list[off] = ((unsigned)idx << 8) | (btab[dd] << 24); }
        ++off; }
    for (int sl = cnt + lane; sl < ((cnt + 63) & ~63); sl += 64) list[sl] = 0u;
    return cnt;
}
__device__ __forceinline__ void att_gather32(const unsigned char* CKV8b, const LAS unsigned* list32, LAS unsigned char* slot, int lane) {
    const LAS unsigned* lp = list32 + (lane >> 4);
    unsigned off[8];
#pragma unroll
    for (int i = 0; i < 8; ++i) off[i] = lp[4 * i] & 0xffffffu;
    asm volatile("" : "+s"(CKV8b));
#pragma unroll
    for (int i = 0; i < 8; ++i) {
        const int rr = 4 * i + (lane >> 4);
        __builtin_amdgcn_global_load_lds((const unsigned*)(CKV8b + (off[i] + 16u * (unsigned)((lane & 15) ^ ATT_F(rr)))), (LAS unsigned*)(slot + 1024 * i), 16, 0, 0);
    }
}

#define ATT_T(q) (((q) & 2047) ^ (((q) >> 11) ? 255 : 0))
__device__ __forceinline__ void att_wave(const unsigned char* CKV8, const unsigned* SEL, unsigned char* BIG, LAS unsigned char* kvbuf, LAS unsigned* lists, const LAS float* relb, const LAS unsigned* btab,
                                         int xcd, int wx, int nwx, int lane) {
    asm volatile("" : "+v"(lane));
    const int hq = lane & 15, g = lane >> 4;
    const int nq = (2 * SEQ - wx + nwx - 1) / nwx;
    if (nq <= 0) return;
    const unsigned kvb = (unsigned)(size_t)kvbuf;
    unsigned qa[8];
#pragma unroll
    for (int ks = 0; ks < 8; ++ks) qa[ks] = kvb + (unsigned)(8 * (hq >> 2) + (hq & 3)) * 256u + 16u * (unsigned)((2 * ks + (g >> 1)) ^ ATT_F(8 * (hq >> 2) + (hq & 3))) + 8u * (unsigned)(g & 1);
    const int trow = 8 * g + (hq >> 1);
    unsigned ta[16];
#pragma unroll
    for (int nt = 0; nt < 16; ++nt) ta[nt] = kvb + (unsigned)trow * 256u + 16u * (unsigned)(nt ^ ATT_F(trow)) + 8u * (unsigned)(hq & 1);

    int q = wx, b = 2 * xcd + (q >> 11), t = ATT_T(q);
    size_t row = (size_t)b * SEQ + t;
    unsigned wsel = SEL[row * 64 + lane];
    int cnt = att_build_list(lists, btab, wsel, t, lane);
    unsigned wnext = 0u;
    if (nq > 1) { const int q1 = wx + nwx; wnext = SEL[((size_t)(2 * xcd + (q1 >> 11)) * SEQ + ATT_T(q1)) * 64 + lane]; }
    long bq[8];
    u32x4 Lq[4];
#define ATT_QLOAD(ROW) { const unsigned char* qp_ = BIG + (ROW) * 8192 + hq * 256 + 16 * g; \
        _Pragma("unroll") for (int i = 0; i < 4; ++i) Lq[i] = *(const u32x4*)(qp_ + 64 * i); }
#define ATT_QSWAP() { _Pragma("unroll") for (int i = 0; i < 4; ++i) { \
        const u32x2 s0_ = __builtin_amdgcn_permlane16_swap(Lq[i].x, Lq[i].z, false, false), s1_ = __builtin_amdgcn_permlane16_swap(Lq[i].y, Lq[i].w, false, false); \
        const u32x2 t0_ = __builtin_amdgcn_permlane32_swap(s0_.x, s0_.y, false, false), t1_ = __builtin_amdgcn_permlane32_swap(s1_.x, s1_.y, false, false); \
        bq[2 * i] = (long)(((unsigned long long)t1_.x << 32) | (unsigned long long)t0_.x); bq[2 * i + 1] = (long)(((unsigned long long)t1_.y << 32) | (unsigned long long)t0_.y); } }
    ATT_QLOAD(row)
    ATT_QSWAP()
    asm volatile("s_waitcnt lgkmcnt(0)" ::: "memory");
    att_gather32(CKV8 + (size_t)b * SEQ * RK, lists, kvbuf, lane);
#define TR8B(r, a, o, OFS) asm volatile("ds_read_b64_tr_b8 %0, %8 offset:" OFS "\n\tds_read_b64_tr_b8 %1, %9 offset:" OFS "\n\tds_read_b64_tr_b8 %2, %10 offset:" OFS "\n\tds_read_b64_tr_b8 %3, %11 offset:" OFS "\n\t" \
                                   "ds_read_b64_tr_b8 %4, %12 offset:" OFS "\n\tds_read_b64_tr_b8 %5, %13 offset:" OFS "\n\tds_read_b64_tr_b8 %6, %14 offset:" OFS "\n\tds_read_b64_tr_b8 %7, %15 offset:" OFS "\n\ts_waitcnt lgkmcnt(0)" \
                                   : "=&v"(r[0]), "=&v"(r[1]), "=&v"(r[2]), "=&v"(r[3]), "=&v"(r[4]), "=&v"(r[5]), "=&v"(r[6]), "=&v"(r[7]) \
                                   : "v"(a[o + 0]), "v"(a[o + 1]), "v"(a[o + 2]), "v"(a[o + 3]), "v"(a[o + 4]), "v"(a[o + 5]), "v"(a[o + 6]), "v"(a[o + 7]) : "memory")
#define ATT_SUB(QO0, QO1, NEXT_OFF, CAN_BE_LAST) { \
            const bool lastc = CAN_BE_LAST && (sc + 1 == nsub); \
            float bias[8]; \
            _Pragma("unroll") for (int T = 0; T < 2; ++T) { const u32x4 mt = *(const LAS u32x4*)(list + 32 * sc + 8 * g + 4 * T); \
                _Pragma("unroll") for (int i = 0; i < 4; ++i) bias[4 * T + i] = relb[(mt[i] >> 24) * 16 + hq]; } \
            if (!lastc) { att_gather32(CKV8 + (size_t)b * SEQ * RK, list + 32 * (sc + 1), kvbuf + NEXT_OFF, lane); asm volatile("s_waitcnt vmcnt(8)" ::: "memory"); } \
            else if (has_next) { att_gather32(CKV8 + (size_t)bn * SEQ * RK, lists + (cur ^ 1) * 256, kvbuf + NEXT_OFF, lane); asm volatile("s_waitcnt vmcnt(8)" ::: "memory"); } \
            else { asm volatile("s_waitcnt vmcnt(0)" ::: "memory"); } \
            f32x4 st0 = (f32x4){0.f, 0.f, 0.f, 0.f}, st1 = st0; \
            { long kr[8]; \
              RDK8(QO0, kr, qa); \
              _Pragma("unroll") for (int ks = 0; ks < 8; ++ks) st0 = __builtin_amdgcn_mfma_f32_16x16x32_fp8_fp8(kr[ks], bq[ks], st0, 0, 0, 0); \
              RDK8(QO1, kr, qa); \
              _Pragma("unroll") for (int ks = 0; ks < 8; ++ks) st1 = __builtin_amdgcn_mfma_f32_16x16x32_fp8_fp8(kr[ks], bq[ks], st1, 0, 0, 0); } \
            if (lastc && has_next) ATT_QLOAD(rown)        \
            float lg[8]; float cmax; \
            _Pragma("unroll") for (int i = 0; i < 4; ++i) { lg[i] = st0[i] * (1.0f / 64.0f) + bias[i]; lg[4 + i] = st1[i] * (1.0f / 64.0f) + bias[4 + i]; } \
            if (32 * sc + 32 > cnt) { \
                _Pragma("unroll") for (int i = 0; i < 4; ++i) { const int s0 = 32 * sc + 8 * g + i; lg[i] = (s0 < cnt) ? lg[i] : NEGF; lg[4 + i] = (s0 + 4 < cnt) ? lg[4 + i] : NEGF; } } \
            cmax = fmaxf(fmaxf(fmaxf(lg[0], lg[1]), fmaxf(lg[2], lg[3])), fmaxf(fmaxf(lg[4], lg[5]), fmaxf(lg[6], lg[7]))); \
            cmax = rows_max(cmax); \
            if (__ballot(cmax > mref + 3.0f) != 0ull) { \
                const float mnew = fmaxf(mref, cmax), scl = fast_exp(mref - mnew); \
                lsum *= scl; \
                _Pragma("unroll") for (int nt = 0; nt < 16; ++nt) O[nt] = O[nt] * scl; \
                mref = mnew; \
            } \
            float p[8]; \
            _Pragma("unroll") for (int i = 0; i < 8; ++i) { p[i] = fast_exp(lg[i] - mref); lsum += p[i]; } \
            int pw0 = 0, pw1 = 0; \
            pw0 = __builtin_amdgcn_cvt_pk_fp8_f32(p[0] * 16.0f, p[1] * 16.0f, pw0, false); pw0 = __builtin_amdgcn_cvt_pk_fp8_f32(p[2] * 16.0f, p[3] * 16.0f, pw0, true); \
            pw1 = __builtin_amdgcn_cvt_pk_fp8_f32(p[4] * 16.0f, p[5] * 16.0f, pw1, false); pw1 = __builtin_amdgcn_cvt_pk_fp8_f32(p[6] * 16.0f, p[7] * 16.0f, pw1, true); \
            const long pk = (long)(((unsigned long long)(unsigned)pw1 << 32) | (unsigned long long)(unsigned)pw0); \
            { long kt[8]; \
              TR8B(kt, ta, 0, QO0); \
              _Pragma("unroll") for (int e = 0; e < 8; ++e) O[e] = __builtin_amdgcn_mfma_f32_16x16x32_fp8_fp8(kt[e], pk, O[e], 0, 0, 0); \
              TR8B(kt, ta, 8, QO0); \
              _Pragma("unroll") for (int e = 0; e < 8; ++e) O[8 + e] = __builtin_amdgcn_mfma_f32_16x16x32_fp8_fp8(kt[e], pk, O[8 + e], 0, 0, 0); } \
            ++sc; }
    for (int k = 0; k < nq; ++k) {
        const int cur = k & 1;
        LAS unsigned* list = lists + cur * 256;
        const bool has_next = (k + 1 < nq);
        const int qn = q + nwx, bn = 2 * xcd + (qn >> 11), tn = ATT_T(qn);
        const size_t rown = (size_t)bn * SEQ + tn;
        int cntn = 0;
        if (has_next) { cntn = att_build_list(lists + (cur ^ 1) * 256, btab, wnext, tn, lane);
            if (k + 2 < nq) { const int q2 = qn + nwx; wnext = SEL[((size_t)(2 * xcd + (q2 >> 11)) * SEQ + ATT_T(q2)) * 64 + lane]; } }
        f32x4 O[16];
#pragma unroll
        for (int nt = 0; nt < 16; ++nt) O[nt] = (f32x4){0.f, 0.f, 0.f, 0.f};
        float mref = NEGF, lsum = 0.f;
        const int nsub = 2 * ((cnt + 63) >> 6);
        for (int sc = 0; sc < nsub;) {
            ATT_SUB("0", "1024", 8192, false)
            ATT_SUB("8192", "9216", 0, true)
        }
        lsum = rows_sum(lsum);
        const float inv = 1.0f / (16.0f * lsum);
        { LAS unsigned char* ob = kvbuf + 8192;
#pragma unroll
          for (int nt = 0; nt < 16; ++nt) { const f32x4 o = O[nt] * inv; u32x2 wv; wv.x = cvt_pk_bf16(o[0], o[1]); wv.y = cvt_pk_bf16(o[2], o[3]);
              *(LAS u32x2*)(ob + hq * 512 + 16 * ((2 * nt + (g >> 1)) ^ hq) + 8 * (g & 1)) = wv; }
          unsigned char* orow = BIG + row * 8192 + lane * 16;
#pragma unroll
          for (int j = 0; j < 8; ++j) { const int h = 2 * j + (lane >> 5); const u32x4 v = *(const LAS u32x4*)(ob + h * 512 + 16 * ((lane & 31) ^ h)); NT_STORE((u32x4*)(orow + j * 1024), v); }
          asm volatile("s_waitcnt lgkmcnt(0)" ::: "memory"); }
        if (has_next) ATT_QSWAP()
        q = qn; b = bn; t = tn; row = rown; cnt = cntn;
    }
#undef ATT_SUB
#undef ATT_QLOAD
#undef ATT_QSWAP
#undef TR8B
}

constexpr int SW_KP = 144, SW_VP = 520;
constexpr int SW_K_OFF = 0, SW_V_OFF = 256 * SW_KP, SW_TB_OFF = SW_V_OFF + 64 * SW_VP;
__device__ __forceinline__ void swa_phase(const bf16_t* QKV, bf16_t* OB, const float* relb, const float* sinks, LAS unsigned char* lds, int G) {
    int tid = tid_now();
    const int lane = tid & 63, wave = __builtin_amdgcn_readfirstlane(tid >> 6);
    const int h = lane >> 5, n = lane & 31;
    LAS float* tb = (LAS float*)(lds + SW_TB_OFF);
    for (int u = blockIdx.x; u < BATCH * 16 * KVH; u += G) {
        const int b = u >> 5, nb = (u >> 1) & 15, kvh = u & 1;
        const size_t rowb = (size_t)b * SEQ;
        __syncthreads();
#pragma unroll
        for (int e = 0; e < 4; ++e) { const int id = tid + NTHR * e, j = id >> 3, ch = id & 7; const int pos = (nb - 1) * WIN + j;
            u32x4 kv = (u32x4){0u, 0u, 0u, 0u}, vv = (u32x4){0u, 0u, 0u, 0u};
            if (pos >= 0) { const bf16_t* sp = QKV + (rowb + pos) * B_IN + 1024 + kvh * 64 + ch * 8; kv = *(const u32x4*)sp; vv = *(const u32x4*)(sp + 128); }
            *(LAS u32x4*)(lds + SW_K_OFF + j * SW_KP + ch * 16) = kv;
            LAS bf16_t* vt = (LAS bf16_t*)(lds + SW_V_OFF + (ch * 8) * SW_VP + j * 2);
#pragma unroll
            for (int q = 0; q < 4; ++q) { vt[(2 * q) * (SW_VP / 2)] = (bf16_t)(vv[q] & 0xffffu); vt[(2 * q + 1) * (SW_VP / 2)] = (bf16_t)(vv[q] >> 16); } }
        for (int i = tid; i < GQ * 192; i += NTHR) { const int gg = i / 192, x = i - gg * 192; int dist = x - 31; dist = dist < 0 ? 0 : (dist > 127 ? 127 : dist);
            tb[i] = relb[t5_bucket(dist) * NH + kvh * GQ + gg] * 1.4426950408889634f; }
        __syncthreads();
        const int qh = kvh * GQ + wave; const float sink = sinks[qh];
        for (int rt = 0; rt < 4; ++rt) {
            const size_t qrow = rowb + nb * WIN + 32 * rt + n;
            bf16x8 bq[4];
#pragma unroll
            for (int ks = 0; ks < 4; ++ks) bq[ks] = *(const bf16x8*)(QKV + qrow * B_IN + qh * 64 + 16 * ks + 8 * h);
            f32x16 s[5];
#pragma unroll
            for (int ct = 0; ct < 5; ++ct) {
#pragma unroll
                for (int i = 0; i < 16; ++i) s[ct][i] = 0.f;
#pragma unroll
                for (int ks = 0; ks < 4; ++ks) { const bf16x8 a = *(const LAS bf16x8*)(lds + SW_K_OFF + (32 * (rt + ct) + n) * SW_KP + (2 * ks + h) * 16);
                    s[ct] = __builtin_amdgcn_mfma_f32_32x32x16_bf16(a, bq[ks], s[ct], 0, 0, 0); } }
            const int nm = n - 4 * h;
            const LAS float* tbl = tb + wave * 192 + (n + 4 - 4 * h);
            const float SC = 0.125f * 1.4426950408889634f, sinkl = sink * 1.4426950408889634f;
            float mx = NEGF;
#pragma unroll
            for (int ct = 0; ct < 5; ++ct) {
                if (nb == 0 && rt + ct < 4) {
#pragma unroll
                    for (int i = 0; i < 16; ++i) s[ct][i] = NEGF;
                } else {
#pragma unroll
                    for (int i = 0; i < 16; ++i) { const int joff = (i & 3) + 8 * (i >> 2);
                        float v = fmaf(s[ct][i], SC, tbl[155 - 32 * ct - joff]);
                        if (ct == 0) v = (nm < joff) ? v : NEGF;
                        if (ct == 4) v = (nm >= joff) ? v : NEGF;
                        s[ct][i] = v; mx = fmaxf(mx, v); }
                }
            }
            { const u32x2 r_ = __builtin_amdgcn_permlane32_swap(__float_as_uint(mx), __float_as_uint(mx), false, false); mx = fmaxf(__uint_as_float(r_.x), __uint_as_float(r_.y)); } mx = fmaxf(mx, sinkl);
            float sum;
            { f32x2 sum2 = (f32x2){0.f, 0.f}; const f32x2 nmx2 = (f32x2){-mx, -mx};
#pragma unroll
              for (int ct = 0; ct < 5; ++ct)
#pragma unroll
                for (int i = 0; i < 16; i += 2) { const f32x2 x2 = (f32x2){s[ct][i], s[ct][i + 1]} + nmx2;
                    const f32x2 p2 = (f32x2){__builtin_amdgcn_exp2f(x2.x), __builtin_amdgcn_exp2f(x2.y)}; s[ct][i] = p2.x; s[ct][i + 1] = p2.y; sum2 += p2; }
              sum = sum2.x + sum2.y; }
            { const u32x2 r_ = __builtin_amdgcn_permlane32_swap(__float_as_uint(sum), __float_as_uint(sum), false, false); sum = __uint_as_float(r_.x) + __uint_as_float(r_.y); } sum += __builtin_amdgcn_exp2f(sinkl - mx);
            f32x16 o[2];
#pragma unroll
            for (int dt = 0; dt < 2; ++dt)
#pragma unroll
                for (int i = 0; i < 16; ++i) o[dt][i] = 0.f;
#pragma unroll
            for (int ct = 0; ct < 5; ++ct)
#pragma unroll
                for (int s2 = 0; s2 < 2; ++s2) {
                    u32x4 pw; pw.x = cvt_pk_bf16(s[ct][8 * s2 + 0], s[ct][8 * s2 + 1]); pw.y = cvt_pk_bf16(s[ct][8 * s2 + 2], s[ct][8 * s2 + 3]);
                    pw.z = cvt_pk_bf16(s[ct][8 * s2 + 4], s[ct][8 * s2 + 5]); pw.w = cvt_pk_bf16(s[ct][8 * s2 + 6], s[ct][8 * s2 + 7]);
                    const bf16x8 pb = __builtin_bit_cast(bf16x8, pw);
#pragma unroll
                    for (int dt = 0; dt < 2; ++dt) { const LAS unsigned char* vp = lds + SW_V_OFF + (32 * dt + n) * SW_VP + (32 * (rt + ct) + 16 * s2 + 4 * h) * 2;
                        const u32x2 v0 = *(const LAS u32x2*)vp, v1 = *(const LAS u32x2*)(vp + 16);
                        u32x4 va; va.x = v0.x; va.y = v0.y; va.z = v1.x; va.w = v1.y;
                        o[dt] = __builtin_amdgcn_mfma_f32_32x32x16_bf16(__builtin_bit_cast(bf16x8, va), pb, o[dt], 0, 0, 0); }
                }
            const float inv = 16.0f / sum;
            unsigned pc[2][4];
#pragma unroll
            for (int dt = 0; dt < 2; ++dt)
#pragma unroll
                for (int i4 = 0; i4 < 4; ++i4) { int wv = 0;
                    wv = __builtin_amdgcn_cvt_pk_fp8_f32(__builtin_amdgcn_fmed3f(o[dt][4 * i4] * inv, -448.f, 448.f), __builtin_amdgcn_fmed3f(o[dt][4 * i4 + 1] * inv, -448.f, 448.f), wv, false);
                    wv = __builtin_amdgcn_cvt_pk_fp8_f32(__builtin_amdgcn_fmed3f(o[dt][4 * i4 + 2] * inv, -448.f, 448.f), __builtin_amdgcn_fmed3f(o[dt][4 * i4 + 3] * inv, -448.f, 448.f), wv, true);
                    pc[dt][i4] = (unsigned)wv; }
            u32x4 w0, w1;
            { const u32x2 a = __builtin_amdgcn_permlane32_swap(pc[0][0], pc[1][0], false, false), b2 = __builtin_amdgcn_permlane32_swap(pc[0][1], pc[1][1], false, false);
              const u32x2 c = __builtin_amdgcn_permlane32_swap(pc[0][2], pc[1][2], false, false), d = __builtin_amdgcn_permlane32_swap(pc[0][3], pc[1][3], false, false);
              w0.x = a.x; w0.y = a.y; w0.z = b2.x; w0.w = b2.y; w1.x = c.x; w1.y = c.y; w1.z = d.x; w1.w = d.y; }
            unsigned char* op = (unsigned char*)OB + qrow * D + qh * 64 + 32 * h;
            NT_STORE((u32x4*)op, w0); NT_STORE((u32x4*)(op + 16), w1);
        }
    }
}

struct Args { const float* in[23]; float* out; unsigned char* ws; };
#define CAS __attribute__((address_space(4)))
__device__ __forceinline__ const CAS Args* kargs() { const CAS Args* p = (const CAS Args*)__builtin_amdgcn_kernarg_segment_ptr(); asm volatile("" : "+s"(p)); return p; }

__global__ void __launch_bounds__(NTHR, 2) trunk_fwd(Args args_by_value) {
    LAS unsigned char* lds = (LAS unsigned char*)lds_raw;
    const int tid = threadIdx.x;
    volatile LAS unsigned* MISC = (volatile LAS unsigned*)(lds + LDS_MISC_OFF);
    for (int u = tid; u < (LDS_BYTES - LDS_MISC_OFF) / 4; u += NTHR) MISC[u] = 0u;
    __syncthreads();
    if ((tid & 63) == 0) MISC[64 + hw_slot()] = (unsigned)(tid >> 6);
    { const CAS Args* A = kargs(); (void)xcd_barrier_post((unsigned*)(A->ws + WS_CTL) + 4096, MISC + 8);
      if (tid == 0) { const unsigned x = xb_xcc_id(); MISC[16] = x; MISC[17] = xb_add((unsigned*)(A->ws + WS_CTL) + 8192 + 64 * x, 1u); } }
#define XCD_RANK(xcd, rank) do { const CAS Args* A_ = kargs(); const unsigned* cw_ = (const unsigned*)(A_->ws + WS_CTL) + 4096; bool ok_ = (gridDim.x & 7) == 0; \
        for (int j_ = 0; j_ < 16; ++j_) { const unsigned c_ = __hip_atomic_load(cw_ + XB_XCNT(j_), __ATOMIC_RELAXED, __HIP_MEMORY_SCOPE_AGENT); ok_ = ok_ && (c_ == (j_ < 8 ? gridDim.x >> 3 : 0u)); } \
        const unsigned hx_ = MISC[16], hr_ = MISC[17]; ok_ = ok_ && hx_ < 8u && hr_ < (gridDim.x >> 3); \
        xcd = ok_ ? (int)hx_ : (int)(blockIdx.x & 7); rank = ok_ ? (int)hr_ : (int)(blockIdx.x >> 3); } while (0)
#define GB() do { const CAS Args* A_ = kargs(); XcdBarrier b_; b_.bar = (unsigned*)(A_->ws + WS_CTL) + 4096; b_.x = xb_xcc_id(); b_.st = MISC + 8; xcd_barrier(b_); } while (0)

    { const CAS Args* A = kargs(); Ptrs P;
#pragma unroll
      for (int i = 0; i < 23; ++i) P.in[i] = A->in[i];
      P.out = A->out; P.ws = A->ws;
      p0_prologue(P, lds, (int)gridDim.x); }
    GB();
    { const CAS Args* A = kargs(); Ptrs P;
#pragma unroll
      for (int i = 0; i < 23; ++i) P.in[i] = A->in[i];
      P.out = A->out; P.ws = A->ws;
      pre_phase(P, lds, (int)gridDim.x); }
    GB();

    for (int l = 0; l < DEPTH; ++l) {
        const bool isA = (l & 1) == 0;
        {
            const CAS Args* A = kargs(); const int G = gridDim.x, j = l >> 1; unsigned char* ws = A->ws;
            const unsigned long long* SS = (const unsigned long long*)(ws + WS_SS) + (size_t)(2 * l) * M;
            if (isA) {
                unsigned char* wa = ws + WS_WA + (size_t)j * WA_STRIDE;
                pg8::Gemm g{(const bf16_t*)(ws + WS_XG), (const bf16_t*)(wa + WINA_OFF), D, D, D, 0, 0}; pg8::StaticOrder S; S.init(M, 2048, G, (int)blockIdx.x);
                pg8::EpiInA E{(bf16_t*)(ws + WS_QO), (bf16_t*)(ws + WS_CKV), (bf16_t*)(ws + WS_QI), (bf16_t*)(ws + WS_KIN), (float*)(ws + WS_WI), A->in[I_AIKG] + j * IDIM, A->in[I_AIKB] + j * IDIM,
                                (const float*)(ws + WS_SHW + SHW_A) + (size_t)j * BATCH * 2048, SS};
                pg8::gemm_phase<pg8::EpiInA, true, 3>(lds, g, S, E);
            } else {
                unsigned char* wb = ws + WS_WB + (size_t)j * WB_STRIDE;
                (void)wb;
                pg8::Gemm g{(const bf16_t*)(ws + WS_XG), (const bf16_t*)(ws + WS_W8B), D / 2, D / 2, D / 2, 0, 0, (unsigned)(B_IN * D)}; pg8::StaticOrder S; S.init(M, B_IN, G, (int)blockIdx.x);
                pg8::EpiBf16Plain<true, true> E{(bf16_t*)(ws + WS_QKV), B_IN, (const float*)(ws + WS_SHW + SHW_B) + (size_t)j * BATCH * B_IN, B_IN, SS,
                                                (const float*)(ws + WS_CWB), (const unsigned long long*)(ws + WS_SS) + (size_t)(2 * l - 1) * M};
                pg8::gemm_phase<pg8::EpiBf16Plain<true, true>, true, 1>(lds, g, S, E);
            }
        }
        GB();
        if (isA) {
            { const CAS Args* A = kargs(); const int G = gridDim.x, j = l >> 1; unsigned char* ws = A->ws;
              unsigned char* wa = ws + WS_WA + (size_t)j * WA_STRIDE;
              pg8::Gemm g{(const bf16_t*)(ws + WS_QO), (const bf16_t*)(wa + WQA_OFF), D, 128, 128, 0, 128}; pg8::StaticOrder S; S.init(M, 2048, G, (int)blockIdx.x);
              pg8::EpiFp8 E{ws + WS_BIG, 8192};
              pg8::gemm_phase<pg8::EpiFp8, false, 0, true>(lds, g, S, E); }
            { const CAS Args* A = kargs(); const int G = gridDim.x; unsigned char* ws = A->ws;
              const int tid2 = tid_now();
              const int lane = tid2 & 63, wave = __builtin_amdgcn_readfirstlane(tid2 >> 6);
              const bf16_t* CKV = (const bf16_t*)(ws + WS_CKV); unsigned* CKV8 = (unsigned*)(ws + WS_CKV8);
              const int gw = blockIdx.x * NWAVES + wave, NGW = G * NWAVES;
              for (int row = gw; row < M; row += NGW) {
                  const u32x2 v = *((const u32x2*)(CKV + (size_t)row * RK) + lane);
                  const float a0 = __uint_as_float(v.x << 16), a1 = __uint_as_float(v.x & 0xffff0000u), a2 = __uint_as_float(v.y << 16), a3 = __uint_as_float(v.y & 0xffff0000u);
                  const float ss = wave_sum((a0 * a0 + a1 * a1) + (a2 * a2 + a3 * a3));
                  const float rs = 1.0f / sqrtf(ss * (1.0f / RK) + EPS);
                  int w = 0; w = __builtin_amdgcn_cvt_pk_fp8_f32(a0 * rs, a1 * rs, w, false); w = __builtin_amdgcn_cvt_pk_fp8_f32(a2 * rs, a3 * rs, w, true);
                  NT_STORE(CKV8 + (size_t)row * (RK / 4) + lane, (unsigned)w);
              } }
            { const CAS Args* A = kargs(); const int G = gridDim.x; unsigned char* ws = A->ws;
              const int tid2 = tid_now();
              const int lane = tid2 & 63, wave = __builtin_amdgcn_readfirstlane(tid2 >> 6);
              int xcd, rank; XCD_RANK(xcd, rank); xcd = __builtin_amdgcn_readfirstlane(xcd); rank = __builtin_amdgcn_readfirstlane(rank);
              const int wx = rank * NWAVES + wave, nwx = (G >> 3) * NWAVES;
              const int nsteps = (1024 + nwx - 1) / nwx;
              for (int st = 0; st < nsteps; ++st) {
                  const int q = wx + st * nwx; const bool active = q < 1024;
                  const int qc = active ? q : (rank * NWAVES + st * nwx < 1024 ? rank * NWAVES + st * nwx : 1023);
                  const int bl = qc >> 9, u = qc & 255, hiq = (qc >> 8) & 1, b = 2 * xcd + bl;
                  const int tg = hiq ? 511 - u : u;
                  idx_task((const bf16_t*)(ws + WS_QI), (const bf16_t*)(ws + WS_KIN), (const float*)(ws + WS_WI), (unsigned*)(ws + WS_SEL), lds, b, tg, lane, wave, active, 4 * (hiq ? 511 - (u & ~7) : (u | 7)) + 4);
              }
              __syncthreads(); }
        } else {
            const CAS Args* A = kargs(); const int G = gridDim.x, j = l >> 1; unsigned char* ws = A->ws;
            swa_phase((const bf16_t*)(ws + WS_QKV), (bf16_t*)(ws + WS_OB), A->in[I_RELB], A->in[I_BSINK] + j * NH, lds, G);
        }
        GB();
        if (isA) {
            { const CAS Args* A = kargs(); const int G = gridDim.x; unsigned char* ws = A->ws;
              const int tid2 = tid_now();
              const int lane = tid2 & 63, wave = __builtin_amdgcn_readfirstlane(tid2 >> 6);
              LAS float* relb = (LAS float*)(lds + 147456);
              LAS unsigned* btab = (LAS unsigned*)(lds + 147456 + 2048);
              for (int i = tid2; i < NBUCK * NH; i += NTHR) relb[i] = A->in[I_RELB][i];
              for (int i = tid2; i < 132; i += NTHR) btab[i] = (unsigned)t5_bucket(i);
              __syncthreads();
              int xcd, rank; XCD_RANK(xcd, rank); xcd = __builtin_amdgcn_readfirstlane(xcd); rank = __builtin_amdgcn_readfirstlane(rank);
              const int wx = rank * NWAVES + wave, nwx = (G >> 3) * NWAVES;
              att_wave(ws + WS_CKV8, (const unsigned*)(ws + WS_SEL), ws + WS_BIG, lds + wave * 16384, (LAS unsigned*)(lds + 131072 + wave * 2048), relb, btab, xcd, wx, nwx, lane); }
            GB();
            { const CAS Args* A = kargs(); const int G = gridDim.x, j = l >> 1; unsigned char* ws = A->ws;
              unsigned char* wa = ws + WS_WA + (size_t)j * WA_STRIDE;
              pg8::Gemm g{(const bf16_t*)(ws + WS_BIG), (const bf16_t*)(wa + WUV_OFF), 4096, D, D, 0, 1024}; pg8::StaticOrder S; S.init(M, D, G, (int)blockIdx.x);
              pg8::EpiFp8 E{ws + WS_OB, D};
              pg8::gemm_phase<pg8::EpiFp8, false>(lds, g, S, E); }
            GB();
        }
        {
            const CAS Args* A = kargs(); const int G = gridDim.x, j = l >> 1; unsigned char* ws = A->ws;
            const float* modl = (const float*)(ws + WS_MOD) + (size_t)l * BATCH * 6144;
            const bf16_t* Ain = (const bf16_t*)(ws + WS_OB);
            const bf16_t* Bw = (const bf16_t*)(isA ? ws + WS_WA + (size_t)j * WA_STRIDE + WOUTA_OFF : ws + WS_WB + (size_t)j * WB_STRIDE + WOUTB_OFF);
            w8_build<false>((const bf16_t*)(ws + WS_W + (size_t)l * W_LAYER + W13_OFF), 2 * DFF, A->in[I_GFFN] + l * D, modl + 4096, ws + WS_W8, (float*)(ws + WS_CW), lds, G);
            pg8::Gemm g{Ain, Bw, D / 2, D / 2, D / 2, 0, 0, 0}; pg8::StaticOrder S; S.init(M, D, G, (int)blockIdx.x);
            pg8::EpiResid<true, true> E{(const bf16_t*)A->out, (bf16_t*)A->out, modl + 2048, isA ? nullptr : A->in[I_BBOUT] + j * D,
                            (bf16_t*)(ws + WS_XG), nullptr, nullptr, (unsigned long long*)(ws + WS_SS) + (size_t)(2 * l + 1) * M, (const unsigned long long*)(ws + WS_SS) + (size_t)(2 * l) * M};
            pg8::gemm_phase<pg8::EpiResid<true, true>, true, 2>(lds, g, S, E);
        }
        GB();
        {
            const CAS Args* A = kargs(); const int G = gridDim.x; unsigned char* ws = A->ws;
            unsigned char* wl = ws + WS_W + (size_t)l * W_LAYER;
            pg8::Gemm g{(const bf16_t*)(ws + WS_XG), (const bf16_t*)(ws + WS_W8), D / 2, D / 2, D / 2, 0, 0, (unsigned)W8_BATCH}; pg8::StaticOrder S; S.init(M, 2 * DFF, G, (int)blockIdx.x);
            pg8::EpiSwiGLU E{(bf16_t*)(ws + WS_HFF), (const float*)(ws + WS_SHW + SHW_F) + (size_t)l * BATCH * 2 * DFF, (const unsigned long long*)(ws + WS_SS) + (size_t)(2 * l + 1) * M,
                             (const float*)(ws + WS_CW), (const unsigned long long*)(ws + WS_SS) + (size_t)(2 * l) * M};
            pg8::gemm_phase<pg8::EpiSwiGLU, true, 1>(lds, g, S, E);
        }
        GB();
        {
            const CAS Args* A = kargs(); const int G = gridDim.x; unsigned char* ws = A->ws;
            unsigned char* wl = ws + WS_W + (size_t)l * W_LAYER;
            const float* modl = (const float*)(ws + WS_MOD) + (size_t)l * BATCH * 6144;
            const int ln = l + 1 < DEPTH ? l + 1 : l;
            pg8::Gemm g{(const bf16_t*)(ws + WS_HFF), (const bf16_t*)(wl + W2_OFF), DFF, DFF, DFF, 0, 0}; pg8::StaticOrder S; S.init(M, D, G, (int)blockIdx.x);
            const bool lastl = (l + 1 == DEPTH);
            if (!lastl && ((l + 1) & 1)) {
                const int jn = (l + 1) >> 1;
                w8_build<true>((const bf16_t*)(ws + WS_WB + (size_t)jn * WB_STRIDE + WINB_OFF), B_IN, A->in[I_GMIX] + ln * D, (const float*)(ws + WS_MOD) + (size_t)ln * BATCH * 6144 + 1024, ws + WS_W8B, (float*)(ws + WS_CWB), lds, G);
                pg8::EpiResid<true, false> E{(const bf16_t*)A->out, (bf16_t*)A->out, modl + 5120, nullptr,
                                (bf16_t*)(ws + WS_XG), nullptr, nullptr, (unsigned long long*)(ws + WS_SS) + (size_t)(2 * l + 2) * M, (const unsigned long long*)(ws + WS_SS) + (size_t)(2 * l + 1) * M};
                pg8::gemm_phase<pg8::EpiResid<true, false>, true>(lds, g, S, E);
            } else {
                pg8::EpiResid<false, false> E{(const bf16_t*)A->out, lastl ? (bf16_t*)(ws + WS_XG) : (bf16_t*)A->out, modl + 5120, nullptr,
                                l + 1 < DEPTH ? (bf16_t*)(ws + WS_XG) : nullptr, A->in[I_GMIX] + ln * D, (const float*)(ws + WS_MOD) + (size_t)ln * BATCH * 6144 + 1024, (unsigned long long*)(ws + WS_SS) + (size_t)(2 * l + 2) * M, nullptr};
                pg8::gemm_phase<pg8::EpiResid<false, false>, true>(lds, g, S, E);
            }
        }
        GB();
    }
    { const CAS Args* A = kargs(); final_norm_phase((const bf16_t*)(A->ws + WS_XG), A->out, A->in[I_GFIN], (int)gridDim.x); }
#undef GB
}

extern "C" void kernel_launch(void* const* d_in, const int* in_sizes, int n_in, void* d_out, int out_size, void* d_ws, size_t ws_size, hipStream_t stream) {
    static int grid = 0;
    if (grid == 0) {
        if (n_in != 23 || out_size != M * D || ws_size < WS_END) { fprintf(stderr, "kernel_launch: unexpected shapes (n_in %d out %d ws %zu)\n", n_in, out_size, ws_size); grid = -1; return; }
        int dev = 0, cus = 0, per_cu = 0;
        if (hipGetDevice(&dev) != hipSuccess || hipDeviceGetAttribute(&cus, hipDeviceAttributeMultiprocessorCount, dev) != hipSuccess) { grid = -1; return; }
        if (hipFuncSetAttribute((const void*)trunk_fwd, hipFuncAttributeMaxDynamicSharedMemorySize, LDS_BYTES) != hipSuccess) { fprintf(stderr, "kernel_launch: hipFuncSetAttribute failed\n"); grid = -1; return; }
        if (hipOccupancyMaxActiveBlocksPerMultiprocessor(&per_cu, (const void*)trunk_fwd, NTHR, LDS_BYTES) != hipSuccess || per_cu < 1) { fprintf(stderr, "kernel_launch: occupancy query says %d\n", per_cu); }
        (void)hipGetLastError();
        grid = cus;
    }
    if (grid < 0) return;
    (void)hipMemsetAsync((char*)d_ws + WS_CTL, 0, CTL_ZERO_BYTES, stream);
    Args a{};
    for (int i = 0; i < 23; ++i) a.in[i] = (const float*)d_in[i];
    a.out = (float*)d_out; a.ws = (unsigned char*)d_ws;
    hipLaunchKernelGGL(trunk_fwd, dim3(grid), dim3(NTHR), LDS_BYTES, stream, a);
    const hipError_t le = hipPeekAtLastError();
    if (le != hipSuccess) fprintf(stderr, "kernel_launch: launch failed: %s\n", hipGetErrorName(le));
}
```

```cpp
#include <hip/hip_runtime.h>
#include <cstdio>
#include <cstdint>


#define GAS __attribute__((address_space(1)))
#define LAS __attribute__((address_space(3)))
typedef unsigned short bf16_t;
typedef short bf16x8 __attribute__((ext_vector_type(8)));
typedef short s16x4 __attribute__((ext_vector_type(4)));
typedef float f32x4 __attribute__((ext_vector_type(4)));
typedef float f32x2 __attribute__((ext_vector_type(2)));
typedef float f32x16 __attribute__((ext_vector_type(16)));
typedef unsigned u32x4 __attribute__((ext_vector_type(4)));
typedef unsigned u32x2 __attribute__((ext_vector_type(2)));
typedef int i32x4 __attribute__((ext_vector_type(4)));
typedef int i32x8 __attribute__((ext_vector_type(8)));

constexpr int D = 1024, BATCH = 16, SEQ = 2048, M = BATCH * SEQ, DEPTH = 4;
constexpr int NH = 16, HD = 64, RK = 256, IH = 8, IDIM = 64, TOPK = 256;
constexpr int KVH = 2, GQ = 8, WIN = 128, NBUCK = 32, DFF = 2816;
constexpr int A_IN = 1864, B_IN = 1280;
constexpr float EPS = 1e-6f;
constexpr float NEGF = -1e30f;
constexpr int NWAVES = 8, NTHR = 512;

constexpr size_t MiB = 1u << 20;
constexpr size_t WS_CTL = 0, CTL_ZERO_BYTES = 4 * MiB;
constexpr size_t WS_SS = 1 * MiB;
constexpr size_t WS_W = 4 * MiB;
constexpr size_t W_LAYER = 17301504;
constexpr size_t W13_OFF = 0, W2_OFF = 11 * MiB;
constexpr size_t WS_WA = WS_W + 4 * W_LAYER;
constexpr size_t WA_STRIDE = 10 * MiB, WINA_OFF = 0, WQA_OFF = 4 * MiB, WUV_OFF = 6 * MiB, WOUTA_OFF = 8 * MiB;
constexpr size_t WS_WB = WS_WA + 2 * WA_STRIDE;
constexpr size_t WB_STRIDE = 4718592, WINB_OFF = 0, WOUTB_OFF = 2621440;
constexpr size_t WS_MOD = 100 * MiB;
constexpr size_t WS_SHW = WS_MOD + 1536 * 1024;
constexpr size_t SHW_A = 0, SHW_B = 2 * 16 * 2048 * 4, SHW_F = SHW_B + 2 * 16 * 1280 * 4;
constexpr size_t WS_XG = 104 * MiB;
constexpr size_t WS_BIG = 104 * MiB;
constexpr size_t WS_HFF = 168 * MiB;
constexpr size_t WS_QO = 360 * MiB;
constexpr size_t WS_CKV = 424 * MiB;
constexpr size_t WS_QI = 440 * MiB;
constexpr size_t WS_KIN = 472 * MiB;
constexpr size_t WS_WI = 476 * MiB;
constexpr size_t WS_SEL = 477 * MiB;
constexpr size_t WS_CKV8 = 486 * MiB;
constexpr size_t WS_QKV = 360 * MiB;
constexpr size_t WS_OB = 440 * MiB;
constexpr size_t WS_W8 = 344 * MiB;
constexpr size_t W8_BATCH = (size_t)2 * 2816 * 1024;
constexpr size_t WS_CW = 504 * MiB;
constexpr size_t WS_W8B = 136 * MiB;
constexpr size_t WS_CWB = WS_CW + 512 * 1024;
constexpr size_t WS_END = 512 * MiB;

constexpr int RING_BYTES = 131072;
constexpr int LDS_MISC_OFF = 155648;
constexpr int LDS_BYTES = 156672;

extern __shared__ __attribute__((aligned(16))) unsigned char lds_raw[];
constexpr int LDS_WAVE_TAB = LDS_MISC_OFF + 256;
__device__ __forceinline__ int lane_now() { int l; asm volatile("v_mbcnt_lo_u32_b32 %0, -1, 0\n\tv_mbcnt_hi_u32_b32 %0, -1, %0" : "=v"(l)); return l; }
__device__ __forceinline__ unsigned hw_slot() { return (unsigned)__builtin_amdgcn_s_getreg((5 << 11) | 4) & 63u; }
__device__ __forceinline__ int wave_now() { return __builtin_amdgcn_readfirstlane((int)*(volatile LAS unsigned*)((LAS unsigned char*)lds_raw + LDS_WAVE_TAB + 4 * hw_slot())); }
__device__ __forceinline__ int tid_now() { return wave_now() * 64 + lane_now(); }
#define RLX_AGENT __ATOMIC_RELAXED, __HIP_MEMORY_SCOPE_AGENT
__device__ __forceinline__ unsigned cvt_pk_bf16(float lo, float hi) { unsigned r; asm volatile("v_cvt_pk_bf16_f32 %0, %1, %2" : "=v"(r) : "v"(lo), "v"(hi)); return r; }
#define NT_STORE(ptr, val) __builtin_nontemporal_store((val), (ptr))
typedef _Float16 h16x2 __attribute__((ext_vector_type(2)));
typedef _Float16 h16x8 __attribute__((ext_vector_type(8)));
__device__ __forceinline__ unsigned cvt_pk_f16(float lo, float hi) { return __builtin_bit_cast(unsigned, __builtin_convertvector((f32x2){lo, hi}, h16x2)); }
__device__ __forceinline__ f32x2 unpk_f16(unsigned u) { return __builtin_convertvector(__builtin_bit_cast(h16x2, u), f32x2); }
__device__ __forceinline__ float bf2f(bf16_t b) { return __uint_as_float(((unsigned)b) << 16); }
__device__ __forceinline__ float half_sum_f(float v);
__device__ __forceinline__ float rows_sum(float x);
__device__ __forceinline__ float wave_sum(float v) {
    v = half_sum_f(v);
    const u32x2 r = __builtin_amdgcn_permlane32_swap(__float_as_uint(v), __float_as_uint(v), false, false);
    return __uint_as_float(r.x) + __uint_as_float(r.y);
}
__device__ __forceinline__ float fast_exp(float x) { return __builtin_amdgcn_exp2f(x * 1.4426950408889634f); }
__device__ __forceinline__ float silu_f(float x) { return x * __builtin_amdgcn_rcpf(1.0f + fast_exp(-x)); }
__device__ __forceinline__ int t5_bucket(int d) {
    if (d < 16) return d;
    int b = 16;
    b += (d >= 19); b += (d >= 21); b += (d >= 24); b += (d >= 27); b += (d >= 31); b += (d >= 35); b += (d >= 40); b += (d >= 46);
    b += (d >= 52); b += (d >= 59); b += (d >= 67); b += (d >= 77); b += (d >= 87); b += (d >= 99); b += (d >= 113);
    return b;
}

#define XB_TMO      128
#define XB_XCNT(j)  (256  + 64 * (j))
#define XB_XSUB(j)  (1280 + 64 * (j))
#define XB_XGEN(j)  (2304 + 64 * (j))
#define XB_TOP      3328
#define XB_TOPGEN   3392
#define XCD_BAR_WORDS 3456
#define XB_SPIN_CAP (1u << 22)

__device__ __forceinline__ unsigned xb_ld(unsigned* p)              { return __hip_atomic_load(p, __ATOMIC_RELAXED, __HIP_MEMORY_SCOPE_AGENT); }
__device__ __forceinline__ unsigned xb_add(unsigned* p, unsigned v) { return __hip_atomic_fetch_add(p, v, __ATOMIC_RELAXED, __HIP_MEMORY_SCOPE_AGENT); }
__device__ __forceinline__ unsigned xb_xcc_id() { return (unsigned)__builtin_amdgcn_s_getreg((3 << 11) | 20) & 0xFu; }
#define XB_SPIN(cond, bar) do { unsigned _sp = 0; while (cond) { __builtin_amdgcn_s_sleep(1); \
    if ((++_sp & 255u) == 0u) { if (xb_ld(&(bar)[XB_TMO])) break; if (_sp > XB_SPIN_CAP) { atomicAdd(&(bar)[XB_TMO], 1u); break; } } } } while (0)

struct XcdBarrier { unsigned* bar; unsigned x; volatile LAS unsigned* st; };

__device__ __forceinline__ XcdBarrier xcd_barrier_post(unsigned* bar, volatile LAS unsigned* st) {
    XcdBarrier b; b.bar = bar; b.x = xb_xcc_id(); b.st = st;
    if (threadIdx.x == 0) (void)xb_add(&bar[XB_XCNT(b.x)], 1u);
    return b;
}
__device__ __forceinline__ void xcd_barrier_complete(unsigned* bar, unsigned x, unsigned& nloc, unsigned& nx) {
    const unsigned G = gridDim.x * gridDim.y * gridDim.z;
    unsigned sum, cnt, mine, sp = 0u;
    for (;;) {
        sum = 0u; cnt = 0u; mine = 0u;
#pragma unroll
        for (unsigned j = 0; j < 16; ++j) { const unsigned c = xb_ld(&bar[XB_XCNT(j)]); sum += c; cnt += (c > 0u) ? 1u : 0u; mine = (j == x) ? c : mine; }
        if (sum == G) break;
        __builtin_amdgcn_s_sleep(1);
        if ((++sp & 255u) == 0u) { if (xb_ld(&bar[XB_TMO])) break; if (sp > XB_SPIN_CAP) { atomicAdd(&bar[XB_TMO], 1u); break; } }
    }
    nloc = mine > 0u ? mine : 1u; nx = cnt > 0u ? cnt : 1u;
}
__device__ __forceinline__ void xcd_barrier(const XcdBarrier& b) {
    asm volatile("s_waitcnt vmcnt(0)" ::: "memory");
    __syncthreads();
    if (tid_now() == 0) {
        unsigned* bar = b.bar;
        __builtin_amdgcn_s_waitcnt(0);
        unsigned nloc = b.st[0], nx = b.st[1];
        if (nloc == 0u) { xcd_barrier_complete(bar, b.x, nloc, nx); b.st[0] = nloc; b.st[1] = nx; }
        const unsigned old = xb_add(&bar[XB_XSUB(b.x)], 1u);
        const unsigned gen = old / nloc;
        if (old + 1u == (gen + 1u) * nloc) {
            __builtin_amdgcn_fence(__ATOMIC_RELEASE, "agent");
            asm volatile("s_waitcnt vmcnt(0)" ::: "memory");
            const unsigned og = xb_add(&bar[XB_TOP], 1u);
            const unsigned tg = og / nx;
            if (og + 1u == (tg + 1u) * nx) xb_add(&bar[XB_TOPGEN], 1u);
            else XB_SPIN(xb_ld(&bar[XB_TOPGEN]) == tg, bar);
            __builtin_amdgcn_fence(__ATOMIC_ACQUIRE, "agent");
            xb_add(&bar[XB_XGEN(b.x)], 1u);
            asm volatile("s_waitcnt vmcnt(0)" ::: "memory");
        } else {
            XB_SPIN(xb_ld(&bar[XB_XGEN(b.x)]) == gen, bar);
            __builtin_amdgcn_fence(__ATOMIC_ACQUIRE, "agent");
            asm volatile("s_waitcnt vmcnt(0)" ::: "memory");
        }
    }
    __syncthreads();
}

namespace pg8 {
constexpr int BM = 256, BK = 64, HALF = 128, HTB = HALF * BK * 2, STAGE_BYTES = 8 * HTB, NXCD = 8, WGM = 8;
__host__ __device__ __forceinline__ int lds_byte(int r, int c) { const int st = (r >> 4) * 2 + (c >> 5), rr = r & 15, cc = c & 31, ob = rr * 64 + cc * 2; return st * 1024 + (ob ^ (((ob >> 9) & 1) << 5)); }
__host__ __device__ __forceinline__ void stage_rc(int b, int& R, int& C) { const int st = b / 1024, sb = b % 1024, swz = sb ^ (((sb >> 9) & 1) << 5); R = (st >> 1) * 16 + swz / 64; C = (st & 1) * 32 + (swz % 64) / 2; }
__host__ __device__ __forceinline__ int perm32(int rho) { const int n = rho >> 4, i = rho & 15; return 8 * (i >> 2) + 4 * n + (i & 3); }

struct Unit { int pm, pn; };
struct Gemm { const bf16_t* A; const bf16_t* Bt; int lda, ldb, K, a_shift, a_mul; unsigned bb; };

struct StaticOrder {
    int nM, nN, nwg, G, c;
    __device__ void init(int M_, int N_, int G_, int c_) { nM = M_ / BM; nN = N_ / BM; nwg = nM * nN; G = G_; c = c_; }
    __device__ bool next(int i, Unit& u) const {
        const long L = (long)i * G + c; if (L >= nwg) return false;
        int wgid = (int)L; { const int q = nwg / NXCD, r = nwg % NXCD, xcd = wgid % NXCD, off = wgid / NXCD; wgid = (xcd < r ? xcd * (q + 1) : r * (q + 1) + (xcd - r) * q) + off; }
        const int nig = WGM * nN, gid = wgid / nig, fm = gid * WGM, gsz = (nM - fm) < WGM ? (nM - fm) : WGM;
        u.pm = fm + ((wgid % nig) % gsz); u.pn = (wgid % nig) / gsz; return true;
    }
};

template <class Epi, bool ALIGN_EPI, int MODE = 0, bool PAIR = false>
__device__ __forceinline__ void gemm_phase(LAS unsigned char* lds, const Gemm g, const StaticOrder& S, const Epi& E) {
    int tid = tid_now();
    const int wid = __builtin_amdgcn_readfirstlane(tid >> 6), lane = tid & 63, wr = wid >> 2, wc = wid & 3, fr = lane & 15, fq = lane >> 4;
    const int K = g.K, nt = K / BK;
    unsigned voffA[2], voffB[2];
#pragma unroll
    for (int i = 0; i < 2; ++i) { int R, C; stage_rc(tid * 16 + i * 8192, R, C); const int Rb = Epi::PERM16 ? (64 * (R >> 5) + 16 * ((R & 15) >> 2) + 4 * ((R >> 4) & 1) + (R & 3)) : Epi::PERM ? ((R & ~31) + perm32(R & 31)) : R;
        voffA[i] = (unsigned)(R * g.lda + C) * 2u; voffB[i] = (unsigned)(Rb * g.ldb + C) * 2u; }
    const size_t kstep = (size_t)(BK * 2);
    const size_t hstepA = (size_t)HALF * g.lda * 2, hstepB = (size_t)(Epi::PERM16 ? 8 : HALF) * g.ldb * 2;
    const unsigned ldsw = (unsigned)wid * 1024u;
    const int aoff = lds_byte(wr * 64 + fr, fq * 8), boff = lds_byte(wc * 32 + fr, fq * 8);
#define PG8_SA(b, h) (((b) * 2 + (h)) * HTB)
#define PG8_SB(b, h) ((4 + (b) * 2 + (h)) * HTB)
#define PG8_STAGE(bufoff, gbase, voff) do { const char* _gb = (const char*)(gbase); asm volatile("" : "+s"(_gb));     \
        _Pragma("unroll") for (int _i = 0; _i < 2; ++_i) \
        __builtin_amdgcn_global_load_lds((const unsigned*)(_gb + (voff)[_i]), (LAS unsigned*)(lds + (bufoff) + ldsw + _i * 8192), 16, 0, 0); } while (0)
#define PG8_LDA(dst, b, h) do { _Pragma("unroll") for (int m = 0; m < 4; ++m) _Pragma("unroll") for (int k = 0; k < 2; ++k) dst[m][k] = *(const LAS bf16x8*)(lds + PG8_SA(b, h) + aoff + m * 2048 + k * 1024); } while (0)
#define PG8_LDB(dst, b, h) do { _Pragma("unroll") for (int n = 0; n < 2; ++n) _Pragma("unroll") for (int k = 0; k < 2; ++k) dst[n][k] = *(const LAS bf16x8*)(lds + PG8_SB(b, h) + boff + n * 2048 + k * 1024); } while (0)
#define PG8_CAT(x0, x1) __builtin_shufflevector(__builtin_bit_cast(i32x4, x0), __builtin_bit_cast(i32x4, x1), 0, 1, 2, 3, 4, 5, 6, 7)
#define PG8_MMA(ai, bj, At, Bt) do { __builtin_amdgcn_s_setprio(1); _Pragma("unroll") for (int m = 0; m < 4; ++m) _Pragma("unroll") for (int n = 0; n < 2; ++n) { \
        if constexpr (MODE == 2) acc[ai][bj][m][n] = __builtin_amdgcn_mfma_scale_f32_16x16x128_f8f6f4(PG8_CAT(Bt[n][0], Bt[n][1]), PG8_CAT(At[m][0], At[m][1]), acc[ai][bj][m][n], 0, 0, 0, 0, 0, 0); \
        else { _Pragma("unroll") for (int k = 0; k < 2; ++k) { \
          if constexpr (MODE == 1) acc[ai][bj][m][n] = __builtin_bit_cast(f32x4, __builtin_amdgcn_mfma_i32_16x16x64_i8(__builtin_bit_cast(i32x4, Bt[n][k]), __builtin_bit_cast(i32x4, At[m][k]), __builtin_bit_cast(i32x4, acc[ai][bj][m][n]), 0, 0, 0)); \
          else if constexpr (MODE == 3) acc[ai][bj][m][n] = __builtin_amdgcn_mfma_f32_16x16x32_f16(__builtin_bit_cast(h16x8, Bt[n][k]), __builtin_bit_cast(h16x8, At[m][k]), acc[ai][bj][m][n], 0, 0, 0); \
          else acc[ai][bj][m][n] = __builtin_amdgcn_mfma_f32_16x16x32_bf16(Bt[n][k], At[m][k], acc[ai][bj][m][n], 0, 0, 0); } } } __builtin_amdgcn_s_setprio(0); } while (0)
#define PG8_WAIT_V(n) asm volatile("s_waitcnt vmcnt(" #n ")" ::: "memory")
#define PG8_WAIT_L(n) asm volatile("s_waitcnt lgkmcnt(" #n ")" ::: "memory")
#define PG8_BAR __builtin_amdgcn_s_barrier()
#define PG8_SCHED __builtin_amdgcn_sched_barrier(0)
#define PG8_ABASE(u) ((const char*)g.A + ((size_t)(u).pm * BM * g.lda + (size_t)((u).pn >> g.a_shift) * g.a_mul) * 2)
#define PG8_BBASE(u) ((const char*)g.Bt + (size_t)(u).pn * BM * g.ldb * 2 + (size_t)((u).pm >> 3) * g.bb)
    Unit cur, nxt; int ui = 0;
    if (!S.next(0, cur)) return;
    f32x4 acc[2][2][4][2];
#pragma unroll
    for (int a = 0; a < 2; ++a)
#pragma unroll
        for (int b = 0; b < 2; ++b)
#pragma unroll
            for (int m = 0; m < 4; ++m)
#pragma unroll
                for (int n = 0; n < 2; ++n) acc[a][b][m][n] = (f32x4){0.f, 0.f, 0.f, 0.f};
    bf16x8 At[4][2], B0[2][2], B1[2][2];
    const char* cA = PG8_ABASE(cur); const char* cB = PG8_BBASE(cur);
    PG8_STAGE(PG8_SB(0, 0), cB, voffB); PG8_STAGE(PG8_SB(0, 1), cB + hstepB, voffB); PG8_STAGE(PG8_SA(0, 0), cA, voffA); PG8_STAGE(PG8_SA(0, 1), cA + hstepA, voffA);
    if (wr == 1) PG8_BAR;
    PG8_WAIT_V(2); PG8_BAR;
    PG8_STAGE(PG8_SB(1, 0), cB + kstep, voffB); PG8_STAGE(PG8_SA(1, 0), cA + kstep, voffA); PG8_STAGE(PG8_SB(1, 1), cB + hstepB + kstep, voffB);
    PG8_WAIT_V(6); PG8_BAR;
    for (;;) {
        const bool has_next = S.next(ui + 1, nxt);
        const char* nA = has_next ? PG8_ABASE(nxt) : cA; const char* nB = has_next ? PG8_BBASE(nxt) : cB;
        for (int t = 0; t < nt; t += 2) {
            const bool last = (t == nt - 2);
            if constexpr (Epi::PREFETCH) { if (last) E.prefetch(lds + STAGE_BYTES, cur, wid, lane_now()); }
            const char* a1 = cA + (size_t)(t + 1) * kstep;
            const char* a2 = last ? nA : cA + (size_t)(t + 2) * kstep; const char* b2 = last ? nB : cB + (size_t)(t + 2) * kstep;
            const char* a3 = a2 + kstep; const char* b3 = b2 + kstep;
            PG8_LDB(B0, 0, 0); PG8_LDB(B1, 0, 1); PG8_SCHED; PG8_LDA(At, 0, 0); PG8_STAGE(PG8_SA(1, 1), a1 + hstepA, voffA);
            PG8_WAIT_V(8); PG8_WAIT_L(0); PG8_BAR; PG8_MMA(0, 0, At, B0); PG8_MMA(0, 1, At, B1); PG8_BAR; PG8_SCHED;
            PG8_LDA(At, 0, 1); PG8_STAGE(PG8_SB(0, 0), b2, voffB); PG8_STAGE(PG8_SB(0, 1), b2 + hstepB, voffB); PG8_STAGE(PG8_SA(0, 0), a2, voffA);
            PG8_WAIT_V(8); PG8_WAIT_L(0); PG8_BAR; PG8_MMA(1, 0, At, B0); PG8_MMA(1, 1, At, B1); PG8_BAR; PG8_SCHED;
            if constexpr (PAIR) { const int l3 = lane_now(); Unit u0 = cur; u0.pn = 2 * cur.pn; E(acc, u0, wr, wc, l3 & 15, l3 >> 4);
                _Pragma("unroll") for (int a = 0; a < 2; ++a) _Pragma("unroll") for (int b = 0; b < 2; ++b) _Pragma("unroll") for (int m = 0; m < 4; ++m) _Pragma("unroll") for (int n = 0; n < 2; ++n) acc[a][b][m][n] = (f32x4){0.f, 0.f, 0.f, 0.f}; }
            PG8_LDB(B0, 1, 0); PG8_LDB(B1, 1, 1); PG8_SCHED; PG8_LDA(At, 1, 0); PG8_STAGE(PG8_SA(0, 1), a2 + hstepA, voffA);
            PG8_WAIT_V(8); PG8_WAIT_L(0); PG8_BAR; PG8_MMA(0, 0, At, B0); PG8_MMA(0, 1, At, B1); PG8_BAR; PG8_SCHED;
            PG8_LDA(At, 1, 1); PG8_STAGE(PG8_SB(1, 0), b3, voffB); PG8_STAGE(PG8_SB(1, 1), b3 + hstepB, voffB); PG8_STAGE(PG8_SA(1, 0), a3, voffA);
            PG8_WAIT_V(8); PG8_WAIT_L(0); PG8_BAR; PG8_MMA(1, 0, At, B0); PG8_MMA(1, 1, At, B1); PG8_BAR; PG8_SCHED;
        }
        if constexpr (ALIGN_EPI) { if (wr == 0) PG8_BAR; }
        { const int l2 = lane_now();
          if constexpr (PAIR) { Unit u1 = cur; u1.pn = 2 * cur.pn + 1; E(acc, u1, wr, wc, l2 & 15, l2 >> 4); }
          else if constexpr (Epi::PREFETCH) E(acc, cur, wr, wc, l2 & 15, l2 >> 4, lds + STAGE_BYTES); else E(acc, cur, wr, wc, l2 & 15, l2 >> 4); }
        if (!has_next) break;
#pragma unroll
        for (int a = 0; a < 2; ++a)
#pragma unroll
            for (int b = 0; b < 2; ++b)
#pragma unroll
                for (int m = 0; m < 4; ++m)
#pragma unroll
                    for (int n = 0; n < 2; ++n) acc[a][b][m][n] = (f32x4){0.f, 0.f, 0.f, 0.f};
        cur = nxt; cA = nA; cB = nB; ++ui;
        if constexpr (ALIGN_EPI) { if (wr == 1) PG8_BAR; }
    }
    PG8_WAIT_V(0);
    if constexpr (!ALIGN_EPI) { if (wr == 0) PG8_BAR; }
    PG8_BAR;
#undef PG8_SA
#undef PG8_SB
#undef PG8_STAGE
#undef PG8_LDA
#undef PG8_LDB
#undef PG8_MMA
#undef PG8_CAT
#undef PG8_WAIT_V
#undef PG8_WAIT_L
#undef PG8_BAR
#undef PG8_SCHED
#undef PG8_ABASE
#undef PG8_BBASE
}

__device__ __forceinline__ float ss_ms(unsigned long long v) { return ((float)(unsigned)(v >> 32) * 4294967296.0f + (float)(unsigned)v) * (1.0f / (16777216.0f * D)); }
__device__ __forceinline__ float frsq(float x) { return __builtin_amdgcn_rsqf(x); }
__device__ __forceinline__ float fsqrt(float x) { return __builtin_amdgcn_sqrtf(x); }
constexpr float Q8_CLIP = 4.25f;
__device__ __forceinline__ unsigned q8_bits(float v) { return __float_as_uint(__builtin_amdgcn_fmed3f(v + 12582912.0f, 12582785.0f, 12583039.0f)); }
__device__ __forceinline__ unsigned q8_bits_s(float x, float sc) { return __float_as_uint(__builtin_amdgcn_fmed3f(fmaf(x, sc, 12582912.0f), 12582785.0f, 12583039.0f)); }
__device__ __forceinline__ unsigned q8_pack(unsigned a, unsigned b, unsigned c, unsigned d) { return __builtin_amdgcn_perm(b, a, 0x0c0c0400u) | __builtin_amdgcn_perm(d, c, 0x04000c0cu); }
template <bool NORM, bool I8 = false> struct EpiBf16Plain {
    static constexpr bool PERM = true, PERM16 = true, PREFETCH = NORM;
    bf16_t* O; int ldc; const float* shw; int shw_stride; const unsigned long long* SS; const float* CW; const unsigned long long* SSq;
    __device__ __forceinline__ void prefetch(LAS unsigned char* aux, const Unit& u, int wid, int lane) const {
        if (wid < 2) __builtin_amdgcn_global_load_lds((const unsigned*)((const char*)(SS + (size_t)u.pm * BM) + wid * 1024 + lane * 16), (LAS unsigned*)(aux + wid * 1024), 16, 0, 0);
        else if (wid == 2) __builtin_amdgcn_global_load_lds((const unsigned*)((const char*)(shw + (size_t)(u.pm >> 3) * shw_stride + u.pn * BM) + lane * 16), (LAS unsigned*)(aux + 2048), 16, 0, 0);
        else if constexpr (I8) {
            if (wid == 3) __builtin_amdgcn_global_load_lds((const unsigned*)((const char*)(CW + (size_t)(u.pm >> 3) * shw_stride + u.pn * BM) + lane * 16), (LAS unsigned*)(aux + 3072), 16, 0, 0);
            else if (wid < 6) __builtin_amdgcn_global_load_lds((const unsigned*)((const char*)(SSq + (size_t)u.pm * BM) + (wid - 4) * 1024 + lane * 16), (LAS unsigned*)(aux + wid * 1024), 16, 0, 0);
        }
    }
    __device__ __forceinline__ void operator()(const f32x4 (&acc)[2][2][4][2], const Unit& u, int wr, int wc, int fr, int fq, const LAS unsigned char* aux = nullptr) const {
        const int row0 = u.pm * BM + wr * 64 + fr, col0 = u.pn * BM + wc * 64 + 16 * fq;
        f32x4 bv[2][2], cv[2][2];
#pragma unroll
        for (int bj = 0; bj < 2; ++bj)
#pragma unroll
            for (int n = 0; n < 2; ++n) { bv[bj][n] = NORM ? *(const LAS f32x4*)((const LAS float*)(aux + 2048) + wc * 64 + 16 * fq + bj * 8 + 4 * n) : (f32x4){0.f, 0.f, 0.f, 0.f};
                cv[bj][n] = I8 ? *(const LAS f32x4*)((const LAS float*)(aux + 3072) + wc * 64 + 16 * fq + bj * 8 + 4 * n) : (f32x4){1.f, 1.f, 1.f, 1.f}; }
        const LAS unsigned long long* ssl = (const LAS unsigned long long*)aux + wr * 64 + fr;
        const LAS unsigned long long* sql = (const LAS unsigned long long*)(aux + 4096) + wr * 64 + fr;
#pragma unroll
        for (int ai = 0; ai < 2; ++ai)
#pragma unroll
            for (int m = 0; m < 4; ++m) { const int row = row0 + ai * HALF + m * 16; bf16_t* rowp = O + (size_t)row * ldc + col0;
                float rs = 1.0f; if (NORM) rs = frsq(ss_ms(ssl[ai * HALF + m * 16]) + EPS);
                if (I8) rs *= (Q8_CLIP / 127.0f) * fsqrt(ss_ms(sql[ai * HALF + m * 16]) + EPS);
#pragma unroll
                for (int bj = 0; bj < 2; ++bj) { f32x4 a0 = acc[ai][bj][m][0], a1 = acc[ai][bj][m][1];
                    if (I8) {
#pragma unroll
                        for (int e = 0; e < 4; ++e) { a0[e] = (float)__float_as_int(a0[e]) * cv[bj][0][e]; a1[e] = (float)__float_as_int(a1[e]) * cv[bj][1][e]; } }
                    const f32x4 v0 = a0 * rs + bv[bj][0], v1 = a1 * rs + bv[bj][1];
                    u32x4 w; w.x = cvt_pk_bf16(v0[0], v0[1]); w.y = cvt_pk_bf16(v0[2], v0[3]); w.z = cvt_pk_bf16(v1[0], v1[1]); w.w = cvt_pk_bf16(v1[2], v1[3]);
                    *(u32x4*)(rowp + bj * 8) = w; } }
    }
};
struct EpiFp8 {
    static constexpr bool PERM = true, PERM16 = true, PREFETCH = false;
    unsigned char* O; int ldc;
    __device__ __forceinline__ void operator()(const f32x4 (&acc)[2][2][4][2], const Unit& u, int wr, int wc, int fr, int fq) const {
        const int row0 = u.pm * BM + wr * 64 + fr, col0 = u.pn * BM + wc * 64 + 16 * fq;
#pragma unroll
        for (int ai = 0; ai < 2; ++ai)
#pragma unroll
            for (int m = 0; m < 4; ++m) { unsigned char* rowp = O + (size_t)(row0 + ai * HALF + m * 16) * ldc + col0;
                int w[4];
#pragma unroll
                for (int bj = 0; bj < 2; ++bj)
#pragma unroll
                    for (int n = 0; n < 2; ++n) { const f32x4 v = acc[ai][bj][m][n]; int x = 0;
                        x = __builtin_amdgcn_cvt_pk_fp8_f32(v[0], v[1], x, false); x = __builtin_amdgcn_cvt_pk_fp8_f32(v[2], v[3], x, true); w[2 * bj + n] = x; }
                u32x4 wv; wv.x = (unsigned)w[0]; wv.y = (unsigned)w[1]; wv.z = (unsigned)w[2]; wv.w = (unsigned)w[3]; *(u32x4*)rowp = wv;
                if (m & 1) asm volatile("" ::: "memory"); }
    }
};
struct EpiInA {
    static constexpr bool PERM = true, PERM16 = true, PREFETCH = true;
    bf16_t* Q; bf16_t* CKV; bf16_t* QI; bf16_t* KIN; float* WI; const float* kg; const float* kb; const float* shw; const unsigned long long* SS;
    __device__ __forceinline__ void prefetch(LAS unsigned char* aux, const Unit& u, int wid, int lane) const {
        if (wid < 2) __builtin_amdgcn_global_load_lds((const unsigned*)((const char*)(SS + (size_t)u.pm * BM) + wid * 1024 + lane * 16), (LAS unsigned*)(aux + wid * 1024), 16, 0, 0);
        else if (wid == 2) __builtin_amdgcn_global_load_lds((const unsigned*)((const char*)(shw + (size_t)(u.pm >> 3) * 2048 + u.pn * BM) + lane * 16), (LAS unsigned*)(aux + 2048), 16, 0, 0);
    }
    __device__ __forceinline__ void operator()(f32x4 (&acc)[2][2][4][2], const Unit& u, int wr, int wc, int fr, int fq, const LAS unsigned char* aux) const {
        const int row0 = u.pm * BM + wr * 64 + fr, cl = wc * 64 + 16 * fq;
        {
            const LAS float* sp = (const LAS float*)(aux + 2048) + cl;
            const LAS unsigned long long* ssl = (const LAS unsigned long long*)aux + wr * 64 + fr;
            f32x4 bv[2][2];
#pragma unroll
            for (int bj = 0; bj < 2; ++bj)
#pragma unroll
                for (int n = 0; n < 2; ++n) bv[bj][n] = *(const LAS f32x4*)(sp + bj * 8 + 4 * n);
#pragma unroll
            for (int ai = 0; ai < 2; ++ai)
#pragma unroll
                for (int m = 0; m < 4; ++m) { const float rs = frsq(ss_ms(ssl[ai * HALF + m * 16]) + EPS);
#pragma unroll
                    for (int bj = 0; bj < 2; ++bj)
#pragma unroll
                        for (int n = 0; n < 2; ++n) acc[ai][bj][m][n] = acc[ai][bj][m][n] * rs + bv[bj][n]; }
        }
        if (u.pn < 7) {
            bf16_t* base; int ldc, c0;
            if (u.pn < 4) { base = Q; ldc = 1024; c0 = u.pn * 256; } else if (u.pn == 4) { base = CKV; ldc = 256; c0 = 0; } else { base = QI; ldc = 512; c0 = (u.pn - 5) * 256; }
#pragma unroll
            for (int ai = 0; ai < 2; ++ai)
#pragma unroll
                for (int m = 0; m < 4; ++m) { bf16_t* rowp = base + (size_t)(row0 + ai * HALF + m * 16) * ldc + c0 + cl;
#pragma unroll
                    for (int bj = 0; bj < 2; ++bj) { const f32x4 v0 = acc[ai][bj][m][0], v1 = acc[ai][bj][m][1];
                        u32x4 w;
                        if (u.pn >= 5) { w.x = cvt_pk_f16(v0[0], v0[1]); w.y = cvt_pk_f16(v0[2], v0[3]); w.z = cvt_pk_f16(v1[0], v1[1]); w.w = cvt_pk_f16(v1[2], v1[3]); }
                        else { w.x = cvt_pk_bf16(v0[0], v0[1]); w.y = cvt_pk_bf16(v0[2], v0[3]); w.z = cvt_pk_bf16(v1[0], v1[1]); w.w = cvt_pk_bf16(v1[2], v1[3]); }
                        *(u32x4*)(rowp + bj * 8) = w; } }
        } else if (wc == 0) {
            f32x4 gv[2][2], bv[2][2];
#pragma unroll
            for (int bj = 0; bj < 2; ++bj)
#pragma unroll
                for (int n = 0; n < 2; ++n) { gv[bj][n] = *(const f32x4*)(kg + 16 * fq + 8 * bj + 4 * n); bv[bj][n] = *(const f32x4*)(kb + 16 * fq + 8 * bj + 4 * n); }
#pragma unroll
            for (int ai = 0; ai < 2; ++ai)
#pragma unroll
                for (int m = 0; m < 4; ++m) {
                    float s = 0.f;
#pragma unroll
                    for (int bj = 0; bj < 2; ++bj)
#pragma unroll
                        for (int n = 0; n < 2; ++n) { const f32x4 x = acc[ai][bj][m][n]; s += (x[0] + x[1]) + (x[2] + x[3]); }
                    s = rows_sum(s);
                    const float mu = s * (1.0f / 64.0f); float q = 0.f;
#pragma unroll
                    for (int bj = 0; bj < 2; ++bj)
#pragma unroll
                        for (int n = 0; n < 2; ++n) { const f32x4 d = acc[ai][bj][m][n] - mu; q += (d[0] * d[0] + d[1] * d[1]) + (d[2] * d[2] + d[3] * d[3]); }
                    q = rows_sum(q);
                    const float rs = frsq(q * (1.0f / 64.0f) + EPS);
                    bf16_t* rowp = KIN + (size_t)(row0 + ai * HALF + m * 16) * 64 + 16 * fq;
#pragma unroll
                    for (int bj = 0; bj < 2; ++bj) { const f32x4 v0 = (acc[ai][bj][m][0] - mu) * rs * gv[bj][0] + bv[bj][0], v1 = (acc[ai][bj][m][1] - mu) * rs * gv[bj][1] + bv[bj][1];
                        u32x4 w; w.x = cvt_pk_f16(v0[0], v0[1]); w.y = cvt_pk_f16(v0[2], v0[3]); w.z = cvt_pk_f16(v1[0], v1[1]); w.w = cvt_pk_f16(v1[2], v1[3]);
                        *(u32x4*)(rowp + bj * 8) = w; }
                }
        } else if (wc == 1 && fq == 0) {
            const float sc = 0.04419417382415922f;
#pragma unroll
            for (int ai = 0; ai < 2; ++ai)
#pragma unroll
                for (int m = 0; m < 4; ++m) { float* rowp = WI + (size_t)(row0 + ai * HALF + m * 16) * 8;
                    *(f32x4*)(rowp) = acc[ai][0][m][0] * sc; *(f32x4*)(rowp + 4) = acc[ai][0][m][1] * sc; }
        }
    }
};
template <bool Q8, bool FP8ACC> struct EpiResid {
    static constexpr bool PERM = true, PERM16 = true, PREFETCH = true;
    const bf16_t* xin_b; bf16_t* xout_b;
    const float* gate; const float* bias;
    static constexpr float asc = FP8ACC ? 1.0f / 4096.0f : 1.0f;
    bf16_t* XG; const float* gn; const float* scn; unsigned long long* SSo; const unsigned long long* SSq;
    __device__ __forceinline__ void prefetch(LAS unsigned char* aux, const Unit& u, int wid, int lane) const {
        const int b = u.pm >> 3; const char* src = nullptr;
        if (wid == 0) src = (const char*)(gate + (size_t)b * 6144 + u.pn * BM);
        else if (wid == 1) src = bias ? (const char*)(bias + u.pn * BM) : nullptr;
        else if constexpr (Q8) { if (wid == 4 || wid == 5) src = (const char*)(SSq + (size_t)u.pm * BM) + (wid - 4) * 1024; }
        else { if (wid == 2) src = XG ? (const char*)(gn + u.pn * BM) : nullptr;
               else if (wid == 3) src = XG ? (const char*)(scn + (size_t)b * 6144 + u.pn * BM) : nullptr; }
        if (src) __builtin_amdgcn_global_load_lds((const unsigned*)(src + lane * 16), (LAS unsigned*)(aux + wid * 1024), 16, 0, 0);
    }
    __device__ __forceinline__ void operator()(const f32x4 (&acc)[2][2][4][2], const Unit& u, int wr, int wc, int fr, int fq, const LAS unsigned char* aux) const {
        const int row0 = u.pm * BM + wr * 64 + fr, col0 = u.pn * BM + wc * 64 + 16 * fq;
        const LAS unsigned long long* sql = (const LAS unsigned long long*)(aux + 4096) + wr * 64 + fr;
        const LAS float* lv = (const LAS float*)aux + wc * 64 + 16 * fq;
        float ssum[2][4];
#pragma unroll
        for (int ai = 0; ai < 2; ++ai)
#pragma unroll
            for (int m = 0; m < 4; ++m) ssum[ai][m] = 0.f;
        f32x4 ga[2][2], gb[2][2], gm[2][2];
#pragma unroll
        for (int bj = 0; bj < 2; ++bj) {
            const LAS float* lp = lv + 8 * bj;
            const f32x4 gv0 = *(const LAS f32x4*)(lp), gv1 = *(const LAS f32x4*)(lp + 4);
            f32x4 bv0 = (f32x4){0.f, 0.f, 0.f, 0.f}, bv1 = bv0;
            if (bias) { bv0 = *(const LAS f32x4*)(lp + 256); bv1 = *(const LAS f32x4*)(lp + 256 + 4); }
            ga[bj][0] = gv0 * asc; ga[bj][1] = gv1 * asc; gb[bj][0] = gv0 * bv0; gb[bj][1] = gv1 * bv1;
            gm[bj][0] = bv0 * 0.f; gm[bj][1] = gm[bj][0];
            if (!Q8 && XG) { gm[bj][0] = *(const LAS f32x4*)(lp + 512) * (*(const LAS f32x4*)(lp + 768) + 1.0f); gm[bj][1] = *(const LAS f32x4*)(lp + 512 + 4) * (*(const LAS f32x4*)(lp + 768 + 4) + 1.0f); }
        }
#pragma unroll
        for (int ai = 0; ai < 2; ++ai)
#pragma unroll
            for (int m = 0; m < 4; ++m) { const size_t off = (size_t)(row0 + ai * HALF + m * 16) * D + col0;
                const u32x4 xv0 = *(const u32x4*)(xin_b + off), xv1 = *(const u32x4*)(xin_b + off + 8);
                float qs = 0.f; if (Q8) qs = (127.0f / Q8_CLIP) * frsq(ss_ms(sql[ai * HALF + m * 16]) + EPS);
                u32x4 w8;
#pragma unroll
                for (int bj = 0; bj < 2; ++bj) { const u32x4 xv = bj ? xv1 : xv0;
                    const f32x2 xa = unpk_f16(xv.x), xb = unpk_f16(xv.y), xc = unpk_f16(xv.z), xd = unpk_f16(xv.w);
                    const f32x4 xi0 = (f32x4){xa.x, xa.y, xb.x, xb.y}, xi1 = (f32x4){xc.x, xc.y, xd.x, xd.y};
                    const f32x4 xo0 = (xi0 + gb[bj][0]) + ga[bj][0] * acc[ai][bj][m][0], xo1 = (xi1 + gb[bj][1]) + ga[bj][1] * acc[ai][bj][m][1];
                    { u32x4 w; w.x = cvt_pk_f16(xo0[0], xo0[1]); w.y = cvt_pk_f16(xo0[2], xo0[3]); w.z = cvt_pk_f16(xo1[0], xo1[1]); w.w = cvt_pk_f16(xo1[2], xo1[3]); *(u32x4*)(xout_b + off + 8 * bj) = w; }
                    if (XG) {
                        { f32x2 s2 = (f32x2){ssum[ai][m], 0.f};
                          s2 = __builtin_elementwise_fma((f32x2){xo0[0], xo0[1]}, (f32x2){xo0[0], xo0[1]}, s2); s2 = __builtin_elementwise_fma((f32x2){xo0[2], xo0[3]}, (f32x2){xo0[2], xo0[3]}, s2);
                          s2 = __builtin_elementwise_fma((f32x2){xo1[0], xo1[1]}, (f32x2){xo1[0], xo1[1]}, s2); s2 = __builtin_elementwise_fma((f32x2){xo1[2], xo1[3]}, (f32x2){xo1[2], xo1[3]}, s2);
                          ssum[ai][m] = s2.x + s2.y; }
                        if constexpr (Q8) {
                            const unsigned q0 = q8_pack(q8_bits_s(xo0[0], qs), q8_bits_s(xo0[1], qs), q8_bits_s(xo0[2], qs), q8_bits_s(xo0[3], qs));
                            const unsigned q1 = q8_pack(q8_bits_s(xo1[0], qs), q8_bits_s(xo1[1], qs), q8_bits_s(xo1[2], qs), q8_bits_s(xo1[3], qs));
                            if (bj == 0) { w8.x = q0; w8.y = q1; } else { w8.z = q0; w8.w = q1; }
                        } else {
                        const f32x4 y0 = xo0 * gm[bj][0], y1 = xo1 * gm[bj][1];
                        u32x4 w; w.x = cvt_pk_f16(y0[0], y0[1]); w.y = cvt_pk_f16(y0[2], y0[3]); w.z = cvt_pk_f16(y1[0], y1[1]); w.w = cvt_pk_f16(y1[2], y1[3]);
                        *(u32x4*)(XG + off + 8 * bj) = w; } } }
                if (Q8 && XG) *(u32x4*)((unsigned char*)XG + off) = w8;
                if (m & 1) asm volatile("" ::: "memory"); }
        if (XG) {
#pragma unroll
            for (int ai = 0; ai < 2; ++ai)
#pragma unroll
                for (int m = 0; m < 4; ++m) { float q = ssum[ai][m]; q = rows_sum(q);
                    if (fq == 0) atomicAdd(SSo + row0 + ai * HALF + m * 16, (unsigned long long)(q * 16777216.0f)); }
        }
    }
};
struct EpiSwiGLU {
    static constexpr bool PERM = true, PERM16 = false, PREFETCH = true;
    bf16_t* H; const float* shw; const unsigned long long* SS; const float* CW; const unsigned long long* SSq;
    __device__ __forceinline__ void prefetch(LAS unsigned char* aux, const Unit& u, int wid, int lane) const {
        if (wid < 2) __builtin_amdgcn_global_load_lds((const unsigned*)((const char*)(SS + (size_t)u.pm * BM) + wid * 1024 + lane * 16), (LAS unsigned*)(aux + wid * 1024), 16, 0, 0);
        else if (wid == 2) __builtin_amdgcn_global_load_lds((const unsigned*)((const char*)(shw + (size_t)(u.pm >> 3) * (2 * DFF) + u.pn * BM) + lane * 16), (LAS unsigned*)(aux + 2048), 16, 0, 0);
        else if (wid == 3) __builtin_amdgcn_global_load_lds((const unsigned*)((const char*)(CW + (size_t)(u.pm >> 3) * (2 * DFF) + u.pn * BM) + lane * 16), (LAS unsigned*)(aux + 3072), 16, 0, 0);
        else if (wid < 6) __builtin_amdgcn_global_load_lds((const unsigned*)((const char*)(SSq + (size_t)u.pm * BM) + (wid - 4) * 1024 + lane * 16), (LAS unsigned*)(aux + wid * 1024), 16, 0, 0);
    }
    __device__ __forceinline__ void operator()(const f32x4 (&acc)[2][2][4][2], const Unit& u, int wr, int wc, int fr, int fq, const LAS unsigned char* aux) const {
        const int row0 = u.pm * BM + wr * 64 + fr, f0 = u.pn * 128 + wc * 32 + 8 * fq;
        f32x2 bg[4], cg[4], bu[4], cu[4];
        { const LAS float* sp = (const LAS float*)(aux + 2048) + wc * 32 + 8 * fq;
#pragma unroll
          for (int n = 0; n < 2; ++n) { const f32x4 b0 = *(const LAS f32x4*)(sp + 4 * n) * -1.4426950408889634f, c0 = *(const LAS f32x4*)(sp + 256 + 4 * n) * -1.4426950408889634f;
              const f32x4 b1 = *(const LAS f32x4*)(sp + HALF + 4 * n) * -0.6931471805599453f, c1 = *(const LAS f32x4*)(sp + 256 + HALF + 4 * n) * -0.6931471805599453f;
              bg[2 * n] = (f32x2){b0[0], b0[1]}; bg[2 * n + 1] = (f32x2){b0[2], b0[3]}; cg[2 * n] = (f32x2){c0[0], c0[1]}; cg[2 * n + 1] = (f32x2){c0[2], c0[3]};
              bu[2 * n] = (f32x2){b1[0], b1[1]}; bu[2 * n + 1] = (f32x2){b1[2], b1[3]}; cu[2 * n] = (f32x2){c1[0], c1[1]}; cu[2 * n + 1] = (f32x2){c1[2], c1[3]}; } }
        const LAS unsigned long long* ssl = (const LAS unsigned long long*)aux + wr * 64 + fr;
        const LAS unsigned long long* sql = (const LAS unsigned long long*)(aux + 4096) + wr * 64 + fr;
#pragma unroll
        for (int ai = 0; ai < 2; ++ai)
#pragma unroll
            for (int m = 0; m < 4; ++m) { bf16_t* rowp = H + (size_t)(row0 + ai * HALF + m * 16) * DFF + f0;
                const float rs = (Q8_CLIP / 127.0f) * fsqrt(ss_ms(sql[ai * HALF + m * 16]) + EPS) * frsq(ss_ms(ssl[ai * HALF + m * 16]) + EPS);
                const f32x2 rs2 = (f32x2){rs, rs};
                f32x2 g2[4], u2[4], r2[4];
#pragma unroll
                for (int p = 0; p < 4; ++p) { const int n = p >> 1, e = 2 * (p & 1);
                    const f32x2 t0 = (f32x2){(float)__float_as_int(acc[ai][0][m][n][e]), (float)__float_as_int(acc[ai][0][m][n][e + 1])};
                    const f32x2 t1 = (f32x2){(float)__float_as_int(acc[ai][1][m][n][e]), (float)__float_as_int(acc[ai][1][m][n][e + 1])};
                    g2[p] = __builtin_elementwise_fma(t0 * rs2, cg[p], bg[p]); u2[p] = __builtin_elementwise_fma(t1 * rs2, cu[p], bu[p]); }
#pragma unroll
                for (int p = 0; p < 4; ++p) r2[p] = (f32x2){__builtin_amdgcn_exp2f(g2[p].x), __builtin_amdgcn_exp2f(g2[p].y)} + (f32x2){1.0f, 1.0f};
#pragma unroll
                for (int p = 0; p < 4; ++p) r2[p] = (f32x2){__builtin_amdgcn_rcpf(r2[p].x), __builtin_amdgcn_rcpf(r2[p].y)};
                float o[8];
#pragma unroll
                for (int p = 0; p < 4; ++p) { const f32x2 o2 = (g2[p] * r2[p]) * u2[p]; o[2 * p] = o2.x; o[2 * p + 1] = o2.y; }
                u32x4 w; w.x = cvt_pk_bf16(o[0], o[1]); w.y = cvt_pk_bf16(o[2], o[3]); w.z = cvt_pk_bf16(o[4], o[5]); w.w = cvt_pk_bf16(o[6], o[7]);
                __builtin_nontemporal_store(w, (u32x4*)(rowp)); }
    }
};
}

struct Ptrs {
    const float* in[23]; float* out; unsigned char* ws;
};
enum { I_X = 0, I_C, I_RELB, I_WADA, I_BADA, I_GMIX, I_GFFN, I_AWIN, I_AKVG, I_AWUK, I_AWUV, I_AIKG, I_AIKB, I_AWOUT, I_BWIN, I_BBIN, I_BSINK, I_BWOUT, I_BBOUT, I_W1, I_W3, I_W2, I_GFIN };

__device__ __forceinline__ void conv_task(const Ptrs& P, int th, int lane) {
    const int t = th >> 1, half = th & 1;
    int kind, rb, ks, Kd; bf16_t* dst; const float* s0 = nullptr; const float* s1 = nullptr; const float* gk = nullptr; int ld = 0; bool f8 = false, h16 = false;
    if (t < 2112) { const int l = t / 528, r = t % 528; unsigned char* wl = P.ws + WS_W + (size_t)l * W_LAYER;
        if (r < 352) { kind = 1; rb = r >> 2; ks = r & 3; Kd = 1024; dst = (bf16_t*)(wl + W13_OFF); s0 = P.in[I_W1] + (size_t)l * D * DFF; s1 = P.in[I_W3] + (size_t)l * D * DFF; ld = DFF; }
        else { const int r2 = r - 352; kind = 0; rb = r2 / 11; ks = r2 % 11; Kd = DFF; dst = (bf16_t*)(wl + W2_OFF); s0 = P.in[I_W2] + (size_t)l * DFF * D; ld = D; }
    } else { const int t2 = t - 2112, j = t2 / 464, r = t2 % 464; unsigned char* wa = P.ws + WS_WA + (size_t)j * WA_STRIDE; unsigned char* wb = P.ws + WS_WB + (size_t)j * WB_STRIDE;
        if (r < 128) { kind = 2; rb = r >> 2; ks = r & 3; Kd = 1024; dst = (bf16_t*)(wa + WINA_OFF); s0 = P.in[I_AWIN] + (size_t)j * D * A_IN; ld = A_IN; h16 = true; }
        else if (r < 192) { kind = 3; rb = r - 128; ks = 0; Kd = 128; dst = (bf16_t*)(wa + WQA_OFF); s0 = P.in[I_AWUK] + (size_t)j * NH * RK * HD; gk = P.in[I_AKVG] + j * RK; }
        else if (r < 256) { const int r2 = r - 192; kind = 4; rb = r2 >> 2; ks = r2 & 3; Kd = 1024; dst = (bf16_t*)(wa + WUV_OFF); s0 = P.in[I_AWUV] + (size_t)j * NH * RK * HD; gk = P.in[I_AKVG] + j * RK; }
        else if (r < 320) { const int r2 = r - 256; kind = 0; rb = r2 >> 2; ks = r2 & 3; Kd = 1024; dst = (bf16_t*)(wa + WOUTA_OFF); s0 = P.in[I_AWOUT] + (size_t)j * D * D; ld = D; f8 = true; }
        else if (r < 400) { const int r2 = r - 320; kind = 0; rb = r2 >> 2; ks = r2 & 3; Kd = 1024; dst = (bf16_t*)(wb + WINB_OFF); s0 = P.in[I_BWIN] + (size_t)j * D * B_IN; ld = B_IN; h16 = true; }
        else { const int r2 = r - 400; kind = 0; rb = r2 >> 2; ks = r2 & 3; Kd = 1024; dst = (bf16_t*)(wb + WOUTB_OFF); s0 = P.in[I_BWOUT] + (size_t)j * D * D; ld = D; f8 = true; }
    }
    const int n = rb * 64 + lane, k0 = ks * 256;
    bf16_t* drow = dst + (size_t)n * Kd + k0;
    if (kind <= 2) {
        const float* src = s0; int col = n;
        if (kind == 1) { const int c = n & 255, f = (n >> 8) * 128 + (c & 127); src = (c < 128) ? s0 : s1; col = f; }
        if (kind == 2) { if (n >= 1792) { const int c = n - 1792; col = c < 64 ? 1792 + c : (c < 72 ? 1856 + (c - 64) : -1); } }
        const float* sp = src + (size_t)k0 * ld + (col < 0 ? 0 : col);
        for (int kq = 4 * half; kq < 4 * half + 4; ++kq) {
          float vv[4][8];
#pragma unroll
          for (int i = 0; i < 4; ++i)
#pragma unroll
            for (int e = 0; e < 8; ++e) vv[i][e] = sp[(size_t)((kq * 4 + i) * 8 + e) * ld];
          asm volatile("" ::: "memory");
#pragma unroll
          for (int i = 0; i < 4; ++i) { const int kc = kq * 4 + i;
            float v[8];
#pragma unroll
            for (int e = 0; e < 8; ++e) v[e] = vv[i][e];
            if (col < 0) {
#pragma unroll
                for (int e = 0; e < 8; ++e) v[e] = 0.f; }
            if (f8) {
#pragma unroll
                for (int e = 0; e < 8; ++e) v[e] = __builtin_amdgcn_fmed3f(v[e] * 256.0f, -448.0f, 448.0f);
                int w0 = 0, w1 = 0;
                w0 = __builtin_amdgcn_cvt_pk_fp8_f32(v[0], v[1], w0, false); w0 = __builtin_amdgcn_cvt_pk_fp8_f32(v[2], v[3], w0, true);
                w1 = __builtin_amdgcn_cvt_pk_fp8_f32(v[4], v[5], w1, false); w1 = __builtin_amdgcn_cvt_pk_fp8_f32(v[6], v[7], w1, true);
                u32x2 w; w.x = (unsigned)w0; w.y = (unsigned)w1; *(u32x2*)((unsigned char*)dst + (size_t)n * Kd + k0 + kc * 8) = w;
            } else if (h16) {
            u32x4 w; w.x = cvt_pk_f16(v[0], v[1]); w.y = cvt_pk_f16(v[2], v[3]); w.z = cvt_pk_f16(v[4], v[5]); w.w = cvt_pk_f16(v[6], v[7]);
            *(u32x4*)(drow + kc * 8) = w;
            } else {
            u32x4 w; w.x = cvt_pk_bf16(v[0], v[1]); w.y = cvt_pk_bf16(v[2], v[3]); w.z = cvt_pk_bf16(v[4], v[5]); w.w = cvt_pk_bf16(v[6], v[7]);
            *(u32x4*)(drow + kc * 8) = w; }
        } }
    } else if (kind == 3) {
        const int h = n >> 8, r = n & 255; const float gs = gk[r] * 8.0f;       const float* sp = s0 + ((size_t)h * RK + r) * HD;
        for (int kc = 0; kc < ((half || n >= 2048) ? 0 : 16); ++kc) { const int k = kc * 8; float v[8];
            if (true) { const float* sp2 = s0 + ((size_t)(2 * h + (k >> 6)) * RK + r) * HD;
#pragma unroll
                for (int e = 0; e < 8; ++e) v[e] = sp2[(k & 63) + e] * gs;
            } else {
#pragma unroll
                for (int e = 0; e < 8; ++e) v[e] = 0.f; }
            u32x4 w; w.x = cvt_pk_bf16(v[0], v[1]); w.y = cvt_pk_bf16(v[2], v[3]); w.z = cvt_pk_bf16(v[4], v[5]); w.w = cvt_pk_bf16(v[6], v[7]);
            *(u32x4*)(drow + kc * 8) = w; }
    } else {
        const int hh = (n >> 6) & 3, d = n & 63, h = n >> 6;
        for (int kc = 16 * half; kc < 16 * half + 16; ++kc) { const int k = k0 + kc * 8; float v[8];
            if ((k >> 8) == hh) {
#pragma unroll
                for (int e = 0; e < 8; ++e) { const int r = (k & 255) + e; v[e] = s0[((size_t)h * RK + r) * HD + d] * gk[r] * 16.0f; }
            } else {
#pragma unroll
                for (int e = 0; e < 8; ++e) v[e] = 0.f; }
            u32x4 w; w.x = cvt_pk_bf16(v[0], v[1]); w.y = cvt_pk_bf16(v[2], v[3]); w.z = cvt_pk_bf16(v[4], v[5]); w.w = cvt_pk_bf16(v[6], v[7]);
            *(u32x4*)(drow + kc * 8) = w; }
    }
}
constexpr int N_CONV_TASKS = 6080;

__device__ __forceinline__ void p0_prologue(const Ptrs& P, LAS unsigned char* lds, int G) {
    int tid = tid_now();
    const int lane = tid & 63, wave = __builtin_amdgcn_readfirstlane(tid >> 6);
    const int gw = blockIdx.x * NWAVES + wave, NGW = G * NWAVES;
    for (int t = gw; t < N_CONV_TASKS; t += NGW) conv_task(P, t, lane);
    LAS float* cs = (LAS float*)lds;
    LAS float* red = (LAS float*)(lds + 65536);
    for (int i = tid; i < BATCH * D; i += NTHR) { const int b = i >> 10, k = i & 1023; cs[k * 16 + b] = silu_f(P.in[I_C][i]); }
    __syncthreads();
    float* mod = (float*)(P.ws + WS_MOD);
    for (int task = blockIdx.x; task < 4 * 96; task += G) {
        const int l = task / 96, j0 = (task % 96) * 64, col = tid & 63, ksl = tid >> 6;
        const float* wp = P.in[I_WADA] + ((size_t)l * D + ksl * 128) * 6144 + j0 + col;
        float a[16];
#pragma unroll
        for (int b = 0; b < 16; ++b) a[b] = 0.f;
        for (int k = 0; k < 128; ++k) { const float w = wp[(size_t)k * 6144]; const LAS f32x4* c4 = (const LAS f32x4*)(cs + (ksl * 128 + k) * 16);
#pragma unroll
            for (int q = 0; q < 4; ++q) { const f32x4 c = c4[q];
#pragma unroll
                for (int e = 0; e < 4; ++e) a[4 * q + e] += w * c[e]; } }
#pragma unroll
        for (int b = 0; b < 16; ++b) red[(ksl * 64 + col) * 16 + b] = a[b];
        __syncthreads();
        for (int o = tid; o < 1024; o += NTHR) { const int c2 = o >> 4, b = o & 15; float s = 0.f;
#pragma unroll
            for (int q = 0; q < 8; ++q) s += red[(q * 64 + c2) * 16 + b];
            mod[((size_t)l * BATCH + b) * 6144 + j0 + c2] = s + P.in[I_BADA][l * 6144 + j0 + c2]; }
        __syncthreads();
    }
}

__device__ __forceinline__ void pre_phase(const Ptrs& P, LAS unsigned char* lds, int G) {
    int tid = tid_now();
    const int lane = tid & 63, wave = __builtin_amdgcn_readfirstlane(tid >> 6);
    const float* mod = (const float*)(P.ws + WS_MOD);
    {
        const int grp = blockIdx.x & 7, l = grp >> 1, kind = grp & 1, j = l >> 1;
        const float* shsrc = mod + (size_t)l * BATCH * 6144 + (kind ? 3072 : 0);
        constexpr int SP = 2064;
        for (int i = tid; i < BATCH * D / 2; i += NTHR) { const int b = i >> 9, k2 = (i & 511) * 2;
            const float a0 = shsrc[(size_t)b * 6144 + k2], a1 = shsrc[(size_t)b * 6144 + k2 + 1];
            *(LAS unsigned*)(lds + b * SP + k2 * 2) = kind ? cvt_pk_bf16(a0, a1) : cvt_pk_f16(a0, a1); }
        __syncthreads();
        const bf16_t* W; int nrows; float* dst; const float* bias = nullptr;
        if (kind) { W = (const bf16_t*)(P.ws + WS_W + (size_t)l * W_LAYER + W13_OFF); nrows = 2 * DFF; dst = (float*)(P.ws + WS_SHW + SHW_F) + (size_t)l * BATCH * 2 * DFF; }
        else if ((l & 1) == 0) { W = (const bf16_t*)(P.ws + WS_WA + (size_t)j * WA_STRIDE + WINA_OFF); nrows = 2048; dst = (float*)(P.ws + WS_SHW + SHW_A) + (size_t)j * BATCH * 2048; }
        else { W = (const bf16_t*)(P.ws + WS_WB + (size_t)j * WB_STRIDE + WINB_OFF); nrows = B_IN; dst = (float*)(P.ws + WS_SHW + SHW_B) + (size_t)j * BATCH * B_IN; bias = P.in[I_BBIN] + j * B_IN; }
        const int nblk = nrows >> 4, wq = (blockIdx.x >> 3) * NWAVES + wave, nwq = (G >> 3) * NWAVES;
        const int nn = lane & 15, g = lane >> 4;
        for (int blk = wq; blk < nblk; blk += nwq) {
            f32x4 acc = (f32x4){0.f, 0.f, 0.f, 0.f};
            const bf16_t* wp = W + (size_t)(blk * 16 + nn) * D + 8 * g;
#pragma unroll 8
            for (int ks = 0; ks < 32; ++ks) { const bf16x8 a = *(const LAS bf16x8*)(lds + nn * SP + (32 * ks + 8 * g) * 2); const bf16x8 bw = *(const bf16x8*)(wp + 32 * ks);
                acc = kind ? __builtin_amdgcn_mfma_f32_16x16x32_bf16(a, bw, acc, 0, 0, 0) : __builtin_amdgcn_mfma_f32_16x16x32_f16(__builtin_bit_cast(h16x8, a), __builtin_bit_cast(h16x8, bw), acc, 0, 0, 0); }
            const int n = blk * 16 + nn; const float bb = bias ? bias[n] : 0.f;
#pragma unroll
            for (int i = 0; i < 4; ++i) dst[(size_t)(4 * g + i) * nrows + n] = acc[i] + bb;
        }
    }
    {
        const int gw = blockIdx.x * NWAVES + wave, NGW = G * NWAVES;
        const float* x = P.in[I_X]; const float* gmix = P.in[I_GMIX]; bf16_t* XG = (bf16_t*)(P.ws + WS_XG); unsigned long long* SS0 = (unsigned long long*)(P.ws + WS_SS);
        for (int row = gw; row < M; row += NGW) {
            const int b = row >> 11;
            const f32x4* xr = (const f32x4*)(x + (size_t)row * D) + lane;
            f32x4 v[4]; float sq = 0.f;
#pragma unroll
            for (int jj = 0; jj < 4; ++jj) { v[jj] = xr[64 * jj]; sq += (v[jj][0] * v[jj][0] + v[jj][1] * v[jj][1]) + (v[jj][2] * v[jj][2] + v[jj][3] * v[jj][3]); }
            const float ss = wave_sum(sq);
            if (lane == 0) SS0[row] = (unsigned long long)(ss * 16777216.0f);
            const float* mb = mod + (size_t)b * 6144;
            u32x2* o8 = (u32x2*)(XG + (size_t)row * D) + lane; u32x2* x8 = (u32x2*)((bf16_t*)P.out + (size_t)row * D) + lane;
#pragma unroll
            for (int jj = 0; jj < 4; ++jj) { const int c = 4 * lane + 256 * jj;
                const f32x4 y = v[jj] * *(const f32x4*)(gmix + c) * (*(const f32x4*)(mb + 1024 + c) + 1.0f);
                u32x2 w; w.x = cvt_pk_f16(y[0], y[1]); w.y = cvt_pk_f16(y[2], y[3]); o8[64 * jj] = w;
                u32x2 xw; xw.x = cvt_pk_f16(v[jj][0], v[jj][1]); xw.y = cvt_pk_f16(v[jj][2], v[jj][3]); x8[64 * jj] = xw; }
        }
    }
}
__device__ __forceinline__ float half_max(float x);
__device__ __forceinline__ float wave_max(float x) {
    const float h = half_max(x);
    const u32x2 r = __builtin_amdgcn_permlane32_swap(__float_as_uint(h), __float_as_uint(h), false, false);
    return fmaxf(__uint_as_float(r.x), __uint_as_float(r.y));
}
template <bool F16>
__device__ __forceinline__ void w8_build(const bf16_t* W13, int nrows, const float* gffn, const float* scn, unsigned char* W8, float* CW, LAS unsigned char* lds, int G) {
    int tid = tid_now();
    const int lane = tid & 63, wave = __builtin_amdgcn_readfirstlane(tid >> 6);
    LAS float* mL = (LAS float*)lds;
    for (int i = tid; i < BATCH * D / 4; i += NTHR) { const int b = i >> 8, k4 = (i & 255) * 4;
        *(LAS f32x4*)(mL + b * D + k4) = *(const f32x4*)(gffn + k4) * (*(const f32x4*)(scn + (size_t)b * 6144 + k4) + 1.0f); }
    __syncthreads();
    const int gw = blockIdx.x * NWAVES + wave, NGW = G * NWAVES;
    const size_t bstride = (size_t)nrows * D;
    for (int n = gw; n < nrows; n += NGW) {
        const u32x2* wrow = (const u32x2*)(W13 + (size_t)n * D) + lane;
        float w[16];
#pragma unroll
        for (int j = 0; j < 4; ++j) { const u32x2 p = wrow[64 * j];
            if (F16) { const f32x2 pa = unpk_f16(p.x), pb = unpk_f16(p.y); w[4 * j] = pa.x; w[4 * j + 1] = pa.y; w[4 * j + 2] = pb.x; w[4 * j + 3] = pb.y; }
            else { w[4 * j] = __uint_as_float(p.x << 16); w[4 * j + 1] = __uint_as_float(p.x & 0xffff0000u); w[4 * j + 2] = __uint_as_float(p.y << 16); w[4 * j + 3] = __uint_as_float(p.y & 0xffff0000u); } }
        unsigned* orow = (unsigned*)(W8 + (size_t)n * D) + lane;
#pragma unroll 2
        for (int b = 0; b < BATCH; ++b) {
            float v[16]; float mx = 0.f;
#pragma unroll
            for (int j = 0; j < 4; ++j) { const f32x4 mm = *(const LAS f32x4*)(mL + b * D + 256 * j + 4 * lane);
#pragma unroll
                for (int e = 0; e < 4; ++e) v[4 * j + e] = w[4 * j + e] * mm[e];
                mx = fmaxf(fmaxf(mx, fmaxf(fabsf(v[4 * j]), fabsf(v[4 * j + 1]))), fmaxf(fabsf(v[4 * j + 2]), fabsf(v[4 * j + 3]))); }
            mx = fmaxf(wave_max(mx), 1e-30f);
            const float inv = 127.0f / mx;
#pragma unroll
            for (int j = 0; j < 4; ++j)
                orow[(size_t)b * (bstride / 4) + 64 * j] = pg8::q8_pack(__float_as_uint(fmaf(v[4 * j], inv, 12582912.0f)), __float_as_uint(fmaf(v[4 * j + 1], inv, 12582912.0f)),
                                                                          __float_as_uint(fmaf(v[4 * j + 2], inv, 12582912.0f)), __float_as_uint(fmaf(v[4 * j + 3], inv, 12582912.0f)));
            if (lane == 0) CW[(size_t)b * nrows + n] = mx * (1.0f / 127.0f);
        }
    }
    __syncthreads();
}
__device__ __forceinline__ void final_norm_phase(const bf16_t* x, float* out, const float* g, int G) {
    int tid = tid_now();
    const int lane = tid & 63, wave = __builtin_amdgcn_readfirstlane(tid >> 6);
    const int gw = blockIdx.x * NWAVES + wave, NGW = G * NWAVES;
    for (int row = gw; row < M; row += NGW) {
        const u32x2* xr = (const u32x2*)(x + (size_t)row * D) + lane; f32x4* orow = (f32x4*)(out + (size_t)row * D) + lane;
        f32x4 v[4]; float s = 0.f;
#pragma unroll
        for (int j = 0; j < 4; ++j) { const u32x2 p = xr[64 * j];
            { const f32x2 pa = unpk_f16(p.x), pb = unpk_f16(p.y); v[j] = (f32x4){pa.x, pa.y, pb.x, pb.y}; }
            s += (v[j][0] * v[j][0] + v[j][1] * v[j][1]) + (v[j][2] * v[j][2] + v[j][3] * v[j][3]); }
        const float rstd = 1.0f / sqrtf(wave_sum(s) * (1.0f / D) + EPS);
#pragma unroll
        for (int j = 0; j < 4; ++j) { const f32x4 gg = *(const f32x4*)(g + 4 * lane + 256 * j); NT_STORE(orow + 64 * j, v[j] * rstd * gg); }
    }
}

__device__ __forceinline__ unsigned f2key(float f) { const unsigned u = __float_as_uint(f); return (u & 0x80000000u) ? ~u : (u | 0x80000000u); }
__device__ __forceinline__ float key2f(unsigned k) { return __uint_as_float((k & 0x80000000u) ? (k & 0x7fffffffu) : ~k); }
__device__ __forceinline__ float half_max(float x) {
    int u = __float_as_int(x);
    u = __float_as_int(fmaxf(__int_as_float(u), __int_as_float(__builtin_amdgcn_update_dpp(u, u, 0x128, 0xf, 0xf, false))));
    u = __float_as_int(fmaxf(__int_as_float(u), __int_as_float(__builtin_amdgcn_update_dpp(u, u, 0x124, 0xf, 0xf, false))));
    u = __float_as_int(fmaxf(__int_as_float(u), __int_as_float(__builtin_amdgcn_update_dpp(u, u, 0x122, 0xf, 0xf, false))));
    u = __float_as_int(fmaxf(__int_as_float(u), __int_as_float(__builtin_amdgcn_update_dpp(u, u, 0x121, 0xf, 0xf, false))));
    const u32x2 r = __builtin_amdgcn_permlane16_swap((unsigned)u, (unsigned)u, false, false);
    return fmaxf(__uint_as_float(r.x), __uint_as_float(r.y));
}
__device__ __forceinline__ float half_sum_f(float v) {
    v += __int_as_float(__builtin_amdgcn_update_dpp(__float_as_int(v), __float_as_int(v), 0x128, 0xf, 0xf, false));
    v += __int_as_float(__builtin_amdgcn_update_dpp(__float_as_int(v), __float_as_int(v), 0x124, 0xf, 0xf, false));
    v += __int_as_float(__builtin_amdgcn_update_dpp(__float_as_int(v), __float_as_int(v), 0x122, 0xf, 0xf, false));
    v += __int_as_float(__builtin_amdgcn_update_dpp(__float_as_int(v), __float_as_int(v), 0x121, 0xf, 0xf, false));
    const u32x2 r = __builtin_amdgcn_permlane16_swap(__float_as_uint(v), __float_as_uint(v), false, false);
    return __uint_as_float(r.x) + __uint_as_float(r.y);
}
__device__ __forceinline__ f32x2 pk_gt(f32x2 x, f32x2 big, f32x2 nfbig) { f32x2 d; asm("v_pk_fma_f32 %0, %1, %2, %3 clamp" : "=v"(d) : "v"(x), "v"(big), "v"(nfbig)); return d; }
__device__ __forceinline__ int half_sum(int v) {
    v += __builtin_amdgcn_update_dpp(v, v, 0x128, 0xf, 0xf, false);
    v += __builtin_amdgcn_update_dpp(v, v, 0x124, 0xf, 0xf, false);
    v += __builtin_amdgcn_update_dpp(v, v, 0x122, 0xf, 0xf, false);
    v += __builtin_amdgcn_update_dpp(v, v, 0x121, 0xf, 0xf, false);
    const u32x2 r = __builtin_amdgcn_permlane16_swap((unsigned)v, (unsigned)v, false, false);
    return (int)(r.x + r.y);
}
typedef float f32x32 __attribute__((ext_vector_type(32)));
__device__ __forceinline__ void idx_task(const bf16_t* QI, const bf16_t* KIN, const float* WI, unsigned* SEL, LAS unsigned char* lds, int b, int tg, int lane, int wave, bool active, int kneed) {
    asm volatile("" : "+v"(lane));
    const int t0 = tg * 4, h = lane >> 5, r = lane & 31;
    const int qsel = 2 * (r >> 4) + ((r >> 2) & 1), hd = (r & 3) + 4 * ((r >> 3) & 1);
    const size_t rowb = (size_t)b * SEQ;
    bf16x8 aq[4];
#pragma unroll
    for (int ks = 0; ks < 4; ++ks) aq[ks] = *(const bf16x8*)(QI + (rowb + t0 + qsel) * 512 + hd * 64 + ks * 16 + h * 8);
    float wlo[8], whi[8];
    { const f32x4 a0 = *(const f32x4*)(WI + (rowb + t0 + h) * 8), a1 = *(const f32x4*)(WI + (rowb + t0 + h) * 8 + 4);
      const f32x4 b0 = *(const f32x4*)(WI + (rowb + t0 + 2 + h) * 8), b1 = *(const f32x4*)(WI + (rowb + t0 + 2 + h) * 8 + 4);
#pragma unroll
      for (int e = 0; e < 4; ++e) { wlo[e] = a0[e]; wlo[4 + e] = a1[e]; whi[e] = b0[e]; whi[4 + e] = b1[e]; } }
    f32x32 sA0, sA1, sB0, sB1;
#pragma unroll
    for (int i = 0; i < 32; ++i) { sA0[i] = NEGF; sA1[i] = NEGF; sB0[i] = NEGF; sB1[i] = NEGF; }
    const int ktmax = (t0 + 3) >> 5, tlo = t0 + h, thi = t0 + 2 + h;
    const unsigned lb = (unsigned)(size_t)lds;
    const int sw = (r >> 1) & 7;
#define IDX_LDS4(R0, R1, R2, R3) asm volatile("ds_read_b128 %0, %4\n\tds_read_b128 %1, %5\n\tds_read_b128 %2, %6\n\tds_read_b128 %3, %7" \
                                             : "=&v"(R0), "=&v"(R1), "=&v"(R2), "=&v"(R3) : "v"(a0), "v"(a1), "v"(a2), "v"(a3) : "memory")
#define IDX_TILE(KTL, KEY0, SA, SB, C0, C1, C2, C3, N0, N1, N2, N3) \
        { \
            a0 += 4096u; a1 += 4096u; a2 += 4096u; a3 += 4096u; \
            IDX_LDS4(N0, N1, N2, N3);                          \
            asm volatile("s_waitcnt lgkmcnt(4)" : "+v"(C0), "+v"(C1), "+v"(C2), "+v"(C3) :: "memory");     \
            f32x16 acc; \
            _Pragma("unroll") for (int i = 0; i < 16; ++i) acc[i] = 0.f; \
            acc = __builtin_amdgcn_mfma_f32_32x32x16_f16(__builtin_bit_cast(h16x8, aq[0]), __builtin_bit_cast(h16x8, C0), acc, 0, 0, 0); acc = __builtin_amdgcn_mfma_f32_32x32x16_f16(__builtin_bit_cast(h16x8, aq[1]), __builtin_bit_cast(h16x8, C1), acc, 0, 0, 0); \
            acc = __builtin_amdgcn_mfma_f32_32x32x16_f16(__builtin_bit_cast(h16x8, aq[2]), __builtin_bit_cast(h16x8, C2), acc, 0, 0, 0); acc = __builtin_amdgcn_mfma_f32_32x32x16_f16(__builtin_bit_cast(h16x8, aq[3]), __builtin_bit_cast(h16x8, C3), acc, 0, 0, 0); \
            f32x2 p0 = (f32x2){0.f, 0.f}, p1 = (f32x2){0.f, 0.f};            \
            _Pragma("unroll") for (int i = 0; i < 4; ++i) { \
                const f32x2 r0 = (f32x2){__builtin_amdgcn_fmed3f(acc[2 * i], 0.f, 3.0e38f), __builtin_amdgcn_fmed3f(acc[2 * i + 1], 0.f, 3.0e38f)}; \
                const f32x2 r1 = (f32x2){__builtin_amdgcn_fmed3f(acc[8 + 2 * i], 0.f, 3.0e38f), __builtin_amdgcn_fmed3f(acc[9 + 2 * i], 0.f, 3.0e38f)}; \
                p0 = __builtin_elementwise_fma((f32x2){wlo[2 * i], wlo[2 * i + 1]}, r0, p0); p1 = __builtin_elementwise_fma((f32x2){whi[2 * i], whi[2 * i + 1]}, r1, p1); } \
            const float s0 = p0.x + p0.y, s1 = p1.x + p1.y; \
            const int key = (KEY0) + r; \
            SA[KTL] = key <= tlo ? s0 : NEGF; SB[KTL] = key <= thi ? s1 : NEGF; \
        }
    bf16x8 ta0, ta1, ta2, ta3, tb0, tb1, tb2, tb3;
#pragma unroll
    for (int rnd = 0; rnd < 2; ++rnd) {
        if (1024 * rnd >= kneed) break;
        __syncthreads();
        {
            const int rl = lane >> 3, pp = lane & 7;
#pragma unroll 4
            for (int j = 0; j < 16; ++j) { const int pi = j * 8 + wave, row = 8 * pi + rl;
                if (1024 * rnd + 8 * pi >= kneed) continue;
                const bf16_t* src = KIN + (rowb + 1024 * rnd + row) * 64 + 8 * (pp ^ ((row >> 1) & 7));
                __builtin_amdgcn_global_load_lds((const unsigned*)src, (LAS unsigned*)(lds + 1024 * pi), 16, 0, 0); }
        }
        asm volatile("s_waitcnt vmcnt(0)" ::: "memory");
        __syncthreads();
        const int ntl = ktmax - 32 * rnd + 1;
        if (active && ntl > 0) {
            const int npair = ((ntl < 32 ? ntl : 32) + 1) >> 1;
            unsigned a0 = lb + (unsigned)r * 128u + 16u * (unsigned)((0 + h) ^ sw), a1 = lb + (unsigned)r * 128u + 16u * (unsigned)((2 + h) ^ sw);
            unsigned a2 = lb + (unsigned)r * 128u + 16u * (unsigned)((4 + h) ^ sw), a3 = lb + (unsigned)r * 128u + 16u * (unsigned)((6 + h) ^ sw);
            IDX_LDS4(ta0, ta1, ta2, ta3);
#pragma nounroll
            for (int kp = 0; kp < npair; ++kp) {
                if (rnd == 0) { IDX_TILE(2 * kp, 64 * kp, sA0, sB0, ta0, ta1, ta2, ta3, tb0, tb1, tb2, tb3)
                                IDX_TILE(2 * kp + 1, 64 * kp + 32, sA0, sB0, tb0, tb1, tb2, tb3, ta0, ta1, ta2, ta3) }
                else          { IDX_TILE(2 * kp, 1024 + 64 * kp, sA1, sB1, ta0, ta1, ta2, ta3, tb0, tb1, tb2, tb3)
                                IDX_TILE(2 * kp + 1, 1024 + 64 * kp + 32, sA1, sB1, tb0, tb1, tb2, tb3, ta0, ta1, ta2, ta3) }
            }
            asm volatile("s_waitcnt lgkmcnt(0)" : "+v"(ta0), "+v"(ta1), "+v"(ta2), "+v"(ta3), "+v"(tb0), "+v"(tb1), "+v"(tb2), "+v"(tb3) :: "memory");
        }
    }
#undef IDX_TILE
#undef IDX_LDS4
    if (!active) return;
    const int nt0 = ktmax < 31 ? ktmax + 1 : 32, nt1 = ktmax - 31;
    float mxA = NEGF, mxB = NEGF, mnA = -NEGF, mnB = -NEGF;
#pragma nounroll
    for (int kt = 0; kt < nt0; ++kt) { const float a = sA0[kt], bb = sB0[kt];
        mxA = fmaxf(mxA, a); mxB = fmaxf(mxB, bb); mnA = fminf(mnA, a > -1e29f ? a : -NEGF); mnB = fminf(mnB, bb > -1e29f ? bb : -NEGF); }
#pragma nounroll
    for (int kt = 0; kt < nt1; ++kt) { const float a = sA1[kt], bb = sB1[kt];
        mxA = fmaxf(mxA, a); mxB = fmaxf(mxB, bb); mnA = fminf(mnA, a > -1e29f ? a : -NEGF); mnB = fminf(mnB, bb > -1e29f ? bb : -NEGF); }
    mxA = half_max(mxA); mxB = half_max(mxB); mnA = -half_max(-mnA); mnB = -half_max(-mnB);
    const int Ka = tlo + 1 < TOPK ? tlo + 1 : TOPK, Kb = thi + 1 < TOPK ? thi + 1 : TOPK;
    float loA = mnA - (fabsf(mnA) * 1e-6f + 1e-30f), hiA = mxA, loB = mnB - (fabsf(mnB) * 1e-6f + 1e-30f), hiB = mxB;
    float cloA = (float)(tlo + 1), chiA = 0.0f, cloB = (float)(thi + 1), chiB = 0.0f;
    float TA = -1e29f, TB = -1e29f; bool doneA = (tlo + 1 <= TOPK), doneB = (thi + 1 <= TOPK);
    const int nblk = (ktmax >> 3) + 1;
    const float BIG = 1099511627776.0f;
#define SA2(i) ((i) < 32 ? (f32x2){sA0[(i) & 31], sA0[((i) & 31) + 1]} : (f32x2){sA1[(i) & 31], sA1[((i) & 31) + 1]})
#define SB2(i) ((i) < 32 ? (f32x2){sB0[(i) & 31], sB0[((i) & 31) + 1]} : (f32x2){sB1[(i) & 31], sB1[((i) & 31) + 1]})
#pragma nounroll
    for (int it = 0; it < 48; ++it) {
        if (__ballot(!doneA || !doneB) == 0ull) break;
        const bool bis = (it % 3) == 2;
        const float wA = hiA - loA, wB = hiB - loB;
        float rA = bis ? 0.5f : (cloA - (float)Ka + 0.5f) * __builtin_amdgcn_rcpf(cloA - chiA + 1.0f), rB = bis ? 0.5f : (cloB - (float)Kb + 0.5f) * __builtin_amdgcn_rcpf(cloB - chiB + 1.0f);
        rA = fminf(fmaxf(rA, 0.03f), 0.97f); rB = fminf(fmaxf(rB, 0.03f), 0.97f);
        const float midA = loA + wA * rA, midB = loB + wB * rB;
        const float fA = doneA ? TA : midA, fB = doneB ? TB : midB;
        const f32x2 bigp = (f32x2){BIG, BIG}, nfA = (f32x2){-fA * BIG, -fA * BIG}, nfB = (f32x2){-fB * BIG, -fB * BIG};
        f32x2 cA2 = (f32x2){0.f, 0.f}, cB2 = (f32x2){0.f, 0.f};
#pragma unroll
        for (int blk = 0; blk < 8; ++blk) {
            if (blk < nblk) {
#pragma unroll
                for (int e = 0; e < 4; ++e) { cA2 += pk_gt(SA2(8 * blk + 2 * e), bigp, nfA); cB2 += pk_gt(SB2(8 * blk + 2 * e), bigp, nfB); }
            }
        }
        const int cA = (int)half_sum_f(cA2.x + cA2.y), cB = (int)half_sum_f(cB2.x + cB2.y);
        const bool stuckA = !(midA > loA && midA < hiA), stuckB = !(midB > loB && midB < hiB);
        if (!doneA) { if (cA == Ka) { TA = fA; doneA = true; } else if (stuckA) { TA = loA; doneA = true; } else if (cA > Ka) { loA = midA; cloA = (float)cA; } else { hiA = midA; chiA = (float)cA; } }
        if (!doneB) { if (cB == Kb) { TB = fB; doneB = true; } else if (stuckB) { TB = loB; doneB = true; } else if (cB > Kb) { loB = midB; cloB = (float)cB; } else { hiB = midB; chiB = (float)cB; } }
    }
#undef SA2
#undef SB2
    if (!doneA) TA = loA;
    if (!doneB) TB = loB;
    unsigned w0 = 0u, w1 = 0u, w2 = 0u, w3 = 0u;
#pragma nounroll
    for (int kt = 0; kt < nt0; ++kt) { const unsigned long long ma = __ballot(sA0[kt] > TA), mb = __ballot(sB0[kt] > TB);
        if (lane == kt) { w0 = (unsigned)ma; w1 = (unsigned)(ma >> 32); w2 = (unsigned)mb; w3 = (unsigned)(mb >> 32); } }
#pragma nounroll
    for (int kt = 0; kt < nt1; ++kt) { const unsigned long long ma = __ballot(sA1[kt] > TA), mb = __ballot(sB1[kt] > TB);
        if (lane == 32 + kt) { w0 = (unsigned)ma; w1 = (unsigned)(ma >> 32); w2 = (unsigned)mb; w3 = (unsigned)(mb >> 32); } }
    SEL[(rowb + t0 + 0) * 64 + lane] = w0; SEL[(rowb + t0 + 1) * 64 + lane] = w1; SEL[(rowb + t0 + 2) * 64 + lane] = w2; SEL[(rowb + t0 + 3) * 64 + lane] = w3;
}

#define ATT_F(r) (((r) & 3) | ((((r) >> 3) & 3) << 2))
#define TRB8(OFS, r0, r1, r2, r3, r4, r5, r6, r7, a0, a1, a2, a3, a4, a5, a6, a7) \
    asm volatile("ds_read_b64_tr_b16 %0, %8 offset:" OFS "\n\tds_read_b64_tr_b16 %1, %9 offset:" OFS "\n\tds_read_b64_tr_b16 %2, %10 offset:" OFS "\n\tds_read_b64_tr_b16 %3, %11 offset:" OFS "\n\t" \
                 "ds_read_b64_tr_b16 %4, %12 offset:" OFS "\n\tds_read_b64_tr_b16 %5, %13 offset:" OFS "\n\tds_read_b64_tr_b16 %6, %14 offset:" OFS "\n\tds_read_b64_tr_b16 %7, %15 offset:" OFS "\n\ts_waitcnt lgkmcnt(0)" \
                 : "=&v"(r0), "=&v"(r1), "=&v"(r2), "=&v"(r3), "=&v"(r4), "=&v"(r5), "=&v"(r6), "=&v"(r7) \
                 : "v"(a0), "v"(a1), "v"(a2), "v"(a3), "v"(a4), "v"(a5), "v"(a6), "v"(a7) : "memory")
#define RDK8(OFS, r, a) \
    asm volatile("ds_read_b64 %0, %8 offset:" OFS "\n\tds_read_b64 %1, %9 offset:" OFS "\n\tds_read_b64 %2, %10 offset:" OFS "\n\tds_read_b64 %3, %11 offset:" OFS "\n\t" \
                 "ds_read_b64 %4, %12 offset:" OFS "\n\tds_read_b64 %5, %13 offset:" OFS "\n\tds_read_b64 %6, %14 offset:" OFS "\n\tds_read_b64 %7, %15 offset:" OFS "\n\ts_waitcnt lgkmcnt(0)" \
                 : "=&v"(r[0]), "=&v"(r[1]), "=&v"(r[2]), "=&v"(r[3]), "=&v"(r[4]), "=&v"(r[5]), "=&v"(r[6]), "=&v"(r[7]) \
                 : "v"(a[0]), "v"(a[1]), "v"(a[2]), "v"(a[3]), "v"(a[4]), "v"(a[5]), "v"(a[6]), "v"(a[7]) : "memory")
__device__ __forceinline__ float rows_max(float x) {
    unsigned u = __float_as_uint(x);
    u32x2 r = __builtin_amdgcn_permlane16_swap(u, u, false, false);
    u = __float_as_uint(fmaxf(__uint_as_float(r.x), __uint_as_float(r.y)));
    r = __builtin_amdgcn_permlane32_swap(u, u, false, false);
    return fmaxf(__uint_as_float(r.x), __uint_as_float(r.y));
}
__device__ __forceinline__ float rows_sum(float x) {
    unsigned u = __float_as_uint(x);
    u32x2 r = __builtin_amdgcn_permlane16_swap(u, u, false, false);
    u = __float_as_uint(__uint_as_float(r.x) + __uint_as_float(r.y));
    r = __builtin_amdgcn_permlane32_swap(u, u, false, false);
    return __uint_as_float(r.x) + __uint_as_float(r.y);
}

__device__ __forceinline__ int att_build_list(LAS unsigned* list, const LAS unsigned* btab, unsigned w, int t, int lane) {
    const int pc = __popc(w); int incl = pc;
    incl += __builtin_amdgcn_update_dpp(0, incl, 0x111, 0xf, 0xf, true);
    incl += __builtin_amdgcn_update_dpp(0, incl, 0x112, 0xf, 0xf, true);
    incl += __builtin_amdgcn_update_dpp(0, incl, 0x114, 0xf, 0xf, true);
    incl += __builtin_amdgcn_update_dpp(0, incl, 0x118, 0xf, 0xf, true);
    { const int r0 = __builtin_amdgcn_readlane(incl, 15), r1 = __builtin_amdgcn_readlane(incl, 31), r2 = __builtin_amdgcn_readlane(incl, 47);
      incl += (lane >= 16 ? r0 : 0) + (lane >= 32 ? r1 : 0) + (lane >= 48 ? r2 : 0); }
    const int total = __builtin_amdgcn_readlane(incl, 63); const int cnt = total < TOPK ? total : TOPK;
    int off = incl - pc;
    while (w) { const int bit = __builtin_ctz(w); w &= w - 1u;
        if (off < TOPK) { const int idx = 32 * lane + bit; int dd = t - idx; dd = dd < 0 ? 0 : (dd > 128 ? 128 : dd); list[off] = ((unsigned)idx << 8) | (btab[dd] << 24); }
        ++off; }
    for (int sl = cnt + lane; sl < ((cnt + 63) & ~63); sl += 64) list[sl] = 0u;
    return cnt;
}
__device__ __forceinline__ void att_gather32(const unsigned char* CKV8b, const LAS unsigned* list32, LAS unsigned char* slot, int lane) {
    const LAS unsigned* lp = list32 + (lane >> 4);
    unsigned off[8];
#pragma unroll
    for (int i = 0; i < 8; ++i) off[i] = lp[4 * i] & 0xffffffu;
    asm volatile("" : "+s"(CKV8b));
#pragma unroll
    for (int i = 0; i < 8; ++i) {
        const int rr = 4 * i + (lane >> 4);
        __builtin_amdgcn_global_load_lds((const unsigned*)(CKV8b + (off[i] + 16u * (unsigned)((lane & 15) ^ ATT_F(rr)))), (LAS unsigned*)(slot + 1024 * i), 16, 0, 0);
    }
}

#define ATT_T(q) (((q) & 2047) ^ (((q) >> 11) ? 255 : 0))
__device__ __forceinline__ void att_wave(const unsigned char* CKV8, const unsigned* SEL, unsigned char* BIG, LAS unsigned char* kvbuf, LAS unsigned* lists, const LAS float* relb, const LAS unsigned* btab,
                                         int xcd, int wx, int nwx, int lane) {
    asm volatile("" : "+v"(lane));
    const int hq = lane & 15, g = lane >> 4;
    const int nq = (2 * SEQ - wx + nwx - 1) / nwx;
    if (nq <= 0) return;
    const unsigned kvb = (unsigned)(size_t)kvbuf;
    unsigned qa[8];
#pragma unroll
    for (int ks = 0; ks < 8; ++ks) qa[ks] = kvb + (unsigned)(8 * (hq >> 2) + (hq & 3)) * 256u + 16u * (unsigned)((2 * ks + (g >> 1)) ^ ATT_F(8 * (hq >> 2) + (hq & 3))) + 8u * (unsigned)(g & 1);
    const int trow = 8 * g + (hq >> 1);
    unsigned ta[16];
#pragma unroll
    for (int nt = 0; nt < 16; ++nt) ta[nt] = kvb + (unsigned)trow * 256u + 16u * (unsigned)(nt ^ ATT_F(trow)) + 8u * (unsigned)(hq & 1);

    int q = wx, b = 2 * xcd + (q >> 11), t = ATT_T(q);
    size_t row = (size_t)b * SEQ + t;
    unsigned wsel = SEL[row * 64 + lane];
    int cnt = att_build_list(lists, btab, wsel, t, lane);
    unsigned wnext = 0u;
    if (nq > 1) { const int q1 = wx + nwx; wnext = SEL[((size_t)(2 * xcd + (q1 >> 11)) * SEQ + ATT_T(q1)) * 64 + lane]; }
    long bq[8];
    u32x4 Lq[4];
#define ATT_QLOAD(ROW) { const unsigned char* qp_ = BIG + (ROW) * 8192 + hq * 256 + 16 * g; \
        _Pragma("unroll") for (int i = 0; i < 4; ++i) Lq[i] = *(const u32x4*)(qp_ + 64 * i); }
#define ATT_QSWAP() { _Pragma("unroll") for (int i = 0; i < 4; ++i) { \
        const u32x2 s0_ = __builtin_amdgcn_permlane16_swap(Lq[i].x, Lq[i].z, false, false), s1_ = __builtin_amdgcn_permlane16_swap(Lq[i].y, Lq[i].w, false, false); \
        const u32x2 t0_ = __builtin_amdgcn_permlane32_swap(s0_.x, s0_.y, false, false), t1_ = __builtin_amdgcn_permlane32_swap(s1_.x, s1_.y, false, false); \
        bq[2 * i] = (long)(((unsigned long long)t1_.x << 32) | (unsigned long long)t0_.x); bq[2 * i + 1] = (long)(((unsigned long long)t1_.y << 32) | (unsigned long long)t0_.y); } }
    ATT_QLOAD(row)
    ATT_QSWAP()
    asm volatile("s_waitcnt lgkmcnt(0)" ::: "memory");
    att_gather32(CKV8 + (size_t)b * SEQ * RK, lists, kvbuf, lane);
#define TR8B(r, a, o, OFS) asm volatile("ds_read_b64_tr_b8 %0, %8 offset:" OFS "\n\tds_read_b64_tr_b8 %1, %9 offset:" OFS "\n\tds_read_b64_tr_b8 %2, %10 offset:" OFS "\n\tds_read_b64_tr_b8 %3, %11 offset:" OFS "\n\t" \
                                   "ds_read_b64_tr_b8 %4, %12 offset:" OFS "\n\tds_read_b64_tr_b8 %5, %13 offset:" OFS "\n\tds_read_b64_tr_b8 %6, %14 offset:" OFS "\n\tds_read_b64_tr_b8 %7, %15 offset:" OFS "\n\ts_waitcnt lgkmcnt(0)" \
                                   : "=&v"(r[0]), "=&v"(r[1]), "=&v"(r[2]), "=&v"(r[3]), "=&v"(r[4]), "=&v"(r[5]), "=&v"(r[6]), "=&v"(r[7]) \
                                   : "v"(a[o + 0]), "v"(a[o + 1]), "v"(a[o + 2]), "v"(a[o + 3]), "v"(a[o + 4]), "v"(a[o + 5]), "v"(a[o + 6]), "v"(a[o + 7]) : "memory")
#define ATT_SUB(QO0, QO1, NEXT_OFF, CAN_BE_LAST) { \
            const bool lastc = CAN_BE_LAST && (sc + 1 == nsub); \
            float bias[8]; \
            _Pragma("unroll") for (int T = 0; T < 2; ++T) { const u32x4 mt = *(const LAS u32x4*)(list + 32 * sc + 8 * g + 4 * T); \
                _Pragma("unroll") for (int i = 0; i < 4; ++i) bias[4 * T + i] = relb[(mt[i] >> 24) * 16 + hq]; } \
            if (!lastc) { att_gather32(CKV8 + (size_t)b * SEQ * RK, list + 32 * (sc + 1), kvbuf + NEXT_OFF, lane); asm volatile("s_waitcnt vmcnt(8)" ::: "memory"); } \
            else if (has_next) { att_gather32(CKV8 + (size_t)bn * SEQ * RK, lists + (cur ^ 1) * 256, kvbuf + NEXT_OFF, lane); asm volatile("s_waitcnt vmcnt(8)" ::: "memory"); } \
            else { asm volatile("s_waitcnt vmcnt(0)" ::: "memory"); } \
            f32x4 st0 = (f32x4){0.f, 0.f, 0.f, 0.f}, st1 = st0; \
            { long kr[8]; \
              RDK8(QO0, kr, qa); \
              _Pragma("unroll") for (int ks = 0; ks < 8; ++ks) st0 = __builtin_amdgcn_mfma_f32_16x16x32_fp8_fp8(kr[ks], bq[ks], st0, 0, 0, 0); \
              RDK8(QO1, kr, qa); \
              _Pragma("unroll") for (int ks = 0; ks < 8; ++ks) st1 = __builtin_amdgcn_mfma_f32_16x16x32_fp8_fp8(kr[ks], bq[ks], st1, 0, 0, 0); } \
            if (lastc && has_next) ATT_QLOAD(rown)        \
            float lg[8]; float cmax; \
            _Pragma("unroll") for (int i = 0; i < 4; ++i) { lg[i] = st0[i] * (1.0f / 64.0f) + bias[i]; lg[4 + i] = st1[i] * (1.0f / 64.0f) + bias[4 + i]; } \
            if (32 * sc + 32 > cnt) { \
                _Pragma("unroll") for (int i = 0; i < 4; ++i) { const int s0 = 32 * sc + 8 * g + i; lg[i] = (s0 < cnt) ? lg[i] : NEGF; lg[4 + i] = (s0 + 4 < cnt) ? lg[4 + i] : NEGF; } } \
            cmax = fmaxf(fmaxf(fmaxf(lg[0], lg[1]), fmaxf(lg[2], lg[3])), fmaxf(fmaxf(lg[4], lg[5]), fmaxf(lg[6], lg[7]))); \
            cmax = rows_max(cmax); \
            if (__ballot(cmax > mref + 3.0f) != 0ull) { \
                const float mnew = fmaxf(mref, cmax), scl = fast_exp(mref - mnew); \
                lsum *= scl; \
                _Pragma("unroll") for (int nt = 0; nt < 16; ++nt) O[nt] = O[nt] * scl; \
                mref = mnew; \
            } \
            float p[8]; \
            _Pragma("unroll") for (int i = 0; i < 8; ++i) { p[i] = fast_exp(lg[i] - mref); lsum += p[i]; } \
            int pw0 = 0, pw1 = 0; \
            pw0 = __builtin_amdgcn_cvt_pk_fp8_f32(p[0] * 16.0f, p[1] * 16.0f, pw0, false); pw0 = __builtin_amdgcn_cvt_pk_fp8_f32(p[2] * 16.0f, p[3] * 16.0f, pw0, true); \
            pw1 = __builtin_amdgcn_cvt_pk_fp8_f32(p[4] * 16.0f, p[5] * 16.0f, pw1, false); pw1 = __builtin_amdgcn_cvt_pk_fp8_f32(p[6] * 16.0f, p[7] * 16.0f, pw1, true); \
            const long pk = (long)(((unsigned long long)(unsigned)pw1 << 32) | (unsigned long long)(unsigned)pw0); \
            { long kt[8]; \
              TR8B(kt, ta, 0, QO0); \
              _Pragma("unroll") for (int e = 0; e < 8; ++e) O[e] = __builtin_amdgcn_mfma_f32_16x16x32_fp8_fp8(kt[e], pk, O[e], 0, 0, 0); \
              TR8B(kt, ta, 8, QO0); \
              _Pragma("unroll") for (int e = 0; e < 8; ++e) O[8 + e] = __builtin_amdgcn_mfma_f32_16x16x32_fp8_fp8(kt[e], pk, O[8 + e], 0, 0, 0); } \
            ++sc; }
    for (int k = 0; k < nq; ++k) {
        const int cur = k & 1;
        LAS unsigned* list = lists + cur * 256;
        const bool has_next = (k + 1 < nq);
        const int qn = q + nwx, bn = 2 * xcd + (qn >> 11), tn = ATT_T(qn);
        const size_t rown = (size_t)bn * SEQ + tn;
        int cntn = 0;
        if (has_next) { cntn = att_build_list(lists + (cur ^ 1) * 256, btab, wnext, tn, lane);
            if (k + 2 < nq) { const int q2 = qn + nwx; wnext = SEL[((size_t)(2 * xcd + (q2 >> 11)) * SEQ + ATT_T(q2)) * 64 + lane]; } }
        f32x4 O[16];
#pragma unroll
        for (int nt = 0; nt < 16; ++nt) O[nt] = (f32x4){0.f, 0.f, 0.f, 0.f};
        float mref = NEGF, lsum = 0.f;
        const int nsub = 2 * ((cnt + 63) >> 6);
        for (int sc = 0; sc < nsub;) {
            ATT_SUB("0", "1024", 8192, false)
            ATT_SUB("8192", "9216", 0, true)
        }
        lsum = rows_sum(lsum);
        const float inv = 1.0f / (16.0f * lsum);
        { LAS unsigned char* ob = kvbuf + 8192;
#pragma unroll
          for (int nt = 0; nt < 16; ++nt) { const f32x4 o = O[nt] * inv; u32x2 wv; wv.x = cvt_pk_bf16(o[0], o[1]); wv.y = cvt_pk_bf16(o[2], o[3]);
              *(LAS u32x2*)(ob + hq * 512 + 16 * ((2 * nt + (g >> 1)) ^ hq) + 8 * (g & 1)) = wv; }
          unsigned char* orow = BIG + row * 8192 + lane * 16;
#pragma unroll
          for (int j = 0; j < 8; ++j) { const int h = 2 * j + (lane >> 5); const u32x4 v = *(const LAS u32x4*)(ob + h * 512 + 16 * ((lane & 31) ^ h)); NT_STORE((u32x4*)(orow + j * 1024), v); }
          asm volatile("s_waitcnt lgkmcnt(0)" ::: "memory"); }
        if (has_next) ATT_QSWAP()
        q = qn; b = bn; t = tn; row = rown; cnt = cntn;
    }
#undef ATT_SUB
#undef ATT_QLOAD
#undef ATT_QSWAP
#undef TR8B
}

constexpr int SW_KP = 144, SW_VP = 520;
constexpr int SW_K_OFF = 0, SW_V_OFF = 256 * SW_KP, SW_TB_OFF = SW_V_OFF + 64 * SW_VP;
__device__ __forceinline__ void swa_phase(const bf16_t* QKV, bf16_t* OB, const float* relb, const float* sinks, LAS unsigned char* lds, int G) {
    int tid = tid_now();
    const int lane = tid & 63, wave = __builtin_amdgcn_readfirstlane(tid >> 6);
    const int h = lane >> 5, n = lane & 31;
    LAS float* tb = (LAS float*)(lds + SW_TB_OFF);
    for (int u = blockIdx.x; u < BATCH * 16 * KVH; u += G) {
        const int b = u >> 5, nb = (u >> 1) & 15, kvh = u & 1;
        const size_t rowb = (size_t)b * SEQ;
        __syncthreads();
#pragma unroll
        for (int e = 0; e < 4; ++e) { const int id = tid + NTHR * e, j = id >> 3, ch = id & 7; const int pos = (nb - 1) * WIN + j;
            u32x4 kv = (u32x4){0u, 0u, 0u, 0u}, vv = (u32x4){0u, 0u, 0u, 0u};
            if (pos >= 0) { const bf16_t* sp = QKV + (rowb + pos) * B_IN + 1024 + kvh * 64 + ch * 8; kv = *(const u32x4*)sp; vv = *(const u32x4*)(sp + 128); }
            *(LAS u32x4*)(lds + SW_K_OFF + j * SW_KP + ch * 16) = kv;
            LAS bf16_t* vt = (LAS bf16_t*)(lds + SW_V_OFF + (ch * 8) * SW_VP + j * 2);
#pragma unroll
            for (int q = 0; q < 4; ++q) { vt[(2 * q) * (SW_VP / 2)] = (bf16_t)(vv[q] & 0xffffu); vt[(2 * q + 1) * (SW_VP / 2)] = (bf16_t)(vv[q] >> 16); } }
        for (int i = tid; i < GQ * 192; i += NTHR) { const int gg = i / 192, x = i - gg * 192; int dist = x - 31; dist = dist < 0 ? 0 : (dist > 127 ? 127 : dist);
            tb[i] = relb[t5_bucket(dist) * NH + kvh * GQ + gg] * 1.4426950408889634f; }
        __syncthreads();
        const int qh = kvh * GQ + wave; const float sink = sinks[qh];
        for (int rt = 0; rt < 4; ++rt) {
            const size_t qrow = rowb + nb * WIN + 32 * rt + n;
            bf16x8 bq[4];
#pragma unroll
            for (int ks = 0; ks < 4; ++ks) bq[ks] = *(const bf16x8*)(QKV + qrow * B_IN + qh * 64 + 16 * ks + 8 * h);
            f32x16 s[5];
#pragma unroll
            for (int ct = 0; ct < 5; ++ct) {
#pragma unroll
                for (int i = 0; i < 16; ++i) s[ct][i] = 0.f;
#pragma unroll
                for (int ks = 0; ks < 4; ++ks) { const bf16x8 a = *(const LAS bf16x8*)(lds + SW_K_OFF + (32 * (rt + ct) + n) * SW_KP + (2 * ks + h) * 16);
                    s[ct] = __builtin_amdgcn_mfma_f32_32x32x16_bf16(a, bq[ks], s[ct], 0, 0, 0); } }
            const int nm = n - 4 * h;
            const LAS float* tbl = tb + wave * 192 + (n + 4 - 4 * h);
            const float SC = 0.125f * 1.4426950408889634f, sinkl = sink * 1.4426950408889634f;
            float mx = NEGF;
#pragma unroll
            for (int ct = 0; ct < 5; ++ct) {
                if (nb == 0 && rt + ct < 4) {
#pragma unroll
                    for (int i = 0; i < 16; ++i) s[ct][i] = NEGF;
                } else {
#pragma unroll
                    for (int i = 0; i < 16; ++i) { const int joff = (i & 3) + 8 * (i >> 2);
                        float v = fmaf(s[ct][i], SC, tbl[155 - 32 * ct - joff]);
                        if (ct == 0) v = (nm < joff) ? v : NEGF;
                        if (ct == 4) v = (nm >= joff) ? v : NEGF;
                        s[ct][i] = v; mx = fmaxf(mx, v); }
                }
            }
            { const u32x2 r_ = __builtin_amdgcn_permlane32_swap(__float_as_uint(mx), __float_as_uint(mx), false, false); mx = fmaxf(__uint_as_float(r_.x), __uint_as_float(r_.y)); } mx = fmaxf(mx, sinkl);
            float sum;
            { f32x2 sum2 = (f32x2){0.f, 0.f}; const f32x2 nmx2 = (f32x2){-mx, -mx};
#pragma unroll
              for (int ct = 0; ct < 5; ++ct)
#pragma unroll
                for (int i = 0; i < 16; i += 2) { const f32x2 x2 = (f32x2){s[ct][i], s[ct][i + 1]} + nmx2;
                    const f32x2 p2 = (f32x2){__builtin_amdgcn_exp2f(x2.x), __builtin_amdgcn_exp2f(x2.y)}; s[ct][i] = p2.x; s[ct][i + 1] = p2.y; sum2 += p2; }
              sum = sum2.x + sum2.y; }
            { const u32x2 r_ = __builtin_amdgcn_permlane32_swap(__float_as_uint(sum), __float_as_uint(sum), false, false); sum = __uint_as_float(r_.x) + __uint_as_float(r_.y); } sum += __builtin_amdgcn_exp2f(sinkl - mx);
            f32x16 o[2];
#pragma unroll
            for (int dt = 0; dt < 2; ++dt)
#pragma unroll
                for (int i = 0; i < 16; ++i) o[dt][i] = 0.f;
#pragma unroll
            for (int ct = 0; ct < 5; ++ct)
#pragma unroll
                for (int s2 = 0; s2 < 2; ++s2) {
                    u32x4 pw; pw.x = cvt_pk_bf16(s[ct][8 * s2 + 0], s[ct][8 * s2 + 1]); pw.y = cvt_pk_bf16(s[ct][8 * s2 + 2], s[ct][8 * s2 + 3]);
                    pw.z = cvt_pk_bf16(s[ct][8 * s2 + 4], s[ct][8 * s2 + 5]); pw.w = cvt_pk_bf16(s[ct][8 * s2 + 6], s[ct][8 * s2 + 7]);
                    const bf16x8 pb = __builtin_bit_cast(bf16x8, pw);
#pragma unroll
                    for (int dt = 0; dt < 2; ++dt) { const LAS unsigned char* vp = lds + SW_V_OFF + (32 * dt + n) * SW_VP + (32 * (rt + ct) + 16 * s2 + 4 * h) * 2;
                        const u32x2 v0 = *(const LAS u32x2*)vp, v1 = *(const LAS u32x2*)(vp + 16);
                        u32x4 va; va.x = v0.x; va.y = v0.y; va.z = v1.x; va.w = v1.y;
                        o[dt] = __builtin_amdgcn_mfma_f32_32x32x16_bf16(__builtin_bit_cast(bf16x8, va), pb, o[dt], 0, 0, 0); }
                }
            const float inv = 16.0f / sum;
            unsigned pc[2][4];
#pragma unroll
            for (int dt = 0; dt < 2; ++dt)
#pragma unroll
                for (int i4 = 0; i4 < 4; ++i4) { int wv = 0;
                    wv = __builtin_amdgcn_cvt_pk_fp8_f32(__builtin_amdgcn_fmed3f(o[dt][4 * i4] * inv, -448.f, 448.f), __builtin_amdgcn_fmed3f(o[dt][4 * i4 + 1] * inv, -448.f, 448.f), wv, false);
                    wv = __builtin_amdgcn_cvt_pk_fp8_f32(__builtin_amdgcn_fmed3f(o[dt][4 * i4 + 2] * inv, -448.f, 448.f), __builtin_amdgcn_fmed3f(o[dt][4 * i4 + 3] * inv, -448.f, 448.f), wv, true);
                    pc[dt][i4] = (unsigned)wv; }
            u32x4 w0, w1;
            { const u32x2 a = __builtin_amdgcn_permlane32_swap(pc[0][0], pc[1][0], false, false), b2 = __builtin_amdgcn_permlane32_swap(pc[0][1], pc[1][1], false, false);
              const u32x2 c = __builtin_amdgcn_permlane32_swap(pc[0][2], pc[1][2], false, false), d = __builtin_amdgcn_permlane32_swap(pc[0][3], pc[1][3], false, false);
              w0.x = a.x; w0.y = a.y; w0.z = b2.x; w0.w = b2.y; w1.x = c.x; w1.y = c.y; w1.z = d.x; w1.w = d.y; }
            unsigned char* op = (unsigned char*)OB + qrow * D + qh * 64 + 32 * h;
            *(u32x4*)op = w0; *(u32x4*)(op + 16) = w1;
        }
    }
}

struct Args { const float* in[23]; float* out; unsigned char* ws; };
#define CAS __attribute__((address_space(4)))
__device__ __forceinline__ const CAS Args* kargs() { const CAS Args* p = (const CAS Args*)__builtin_amdgcn_kernarg_segment_ptr(); asm volatile("" : "+s"(p)); return p; }

__global__ void __launch_bounds__(NTHR, 2) trunk_fwd(Args args_by_value) {
    LAS unsigned char* lds = (LAS unsigned char*)lds_raw;
    const int tid = threadIdx.x;
    volatile LAS unsigned* MISC = (volatile LAS unsigned*)(lds + LDS_MISC_OFF);
    for (int u = tid; u < (LDS_BYTES - LDS_MISC_OFF) / 4; u += NTHR) MISC[u] = 0u;
    __syncthreads();
    if ((tid & 63) == 0) MISC[64 + hw_slot()] = (unsigned)(tid >> 6);
    { const CAS Args* A = kargs(); (void)xcd_barrier_post((unsigned*)(A->ws + WS_CTL) + 4096, MISC + 8);
      if (tid == 0) { const unsigned x = xb_xcc_id(); MISC[16] = x; MISC[17] = xb_add((unsigned*)(A->ws + WS_CTL) + 8192 + 64 * x, 1u); } }
#define XCD_RANK(xcd, rank) do { const CAS Args* A_ = kargs(); const unsigned* cw_ = (const unsigned*)(A_->ws + WS_CTL) + 4096; bool ok_ = (gridDim.x & 7) == 0; \
        for (int j_ = 0; j_ < 16; ++j_) { const unsigned c_ = __hip_atomic_load(cw_ + XB_XCNT(j_), __ATOMIC_RELAXED, __HIP_MEMORY_SCOPE_AGENT); ok_ = ok_ && (c_ == (j_ < 8 ? gridDim.x >> 3 : 0u)); } \
        const unsigned hx_ = MISC[16], hr_ = MISC[17]; ok_ = ok_ && hx_ < 8u && hr_ < (gridDim.x >> 3); \
        xcd = ok_ ? (int)hx_ : (int)(blockIdx.x & 7); rank = ok_ ? (int)hr_ : (int)(blockIdx.x >> 3); } while (0)
#define GB() do { const CAS Args* A_ = kargs(); XcdBarrier b_; b_.bar = (unsigned*)(A_->ws + WS_CTL) + 4096; b_.x = xb_xcc_id(); b_.st = MISC + 8; xcd_barrier(b_); } while (0)

    { const CAS Args* A = kargs(); Ptrs P;
#pragma unroll
      for (int i = 0; i < 23; ++i) P.in[i] = A->in[i];
      P.out = A->out; P.ws = A->ws;
      p0_prologue(P, lds, (int)gridDim.x); }
    GB();
    { const CAS Args* A = kargs(); Ptrs P;
#pragma unroll
      for (int i = 0; i < 23; ++i) P.in[i] = A->in[i];
      P.out = A->out; P.ws = A->ws;
      pre_phase(P, lds, (int)gridDim.x); }
    GB();

    for (int l = 0; l < DEPTH; ++l) {
        const bool isA = (l & 1) == 0;
        {
            const CAS Args* A = kargs(); const int G = gridDim.x, j = l >> 1; unsigned char* ws = A->ws;
            const unsigned long long* SS = (const unsigned long long*)(ws + WS_SS) + (size_t)(2 * l) * M;
            if (isA) {
                unsigned char* wa = ws + WS_WA + (size_t)j * WA_STRIDE;
                pg8::Gemm g{(const bf16_t*)(ws + WS_XG), (const bf16_t*)(wa + WINA_OFF), D, D, D, 0, 0}; pg8::StaticOrder S; S.init(M, 2048, G, (int)blockIdx.x);
                pg8::EpiInA E{(bf16_t*)(ws + WS_QO), (bf16_t*)(ws + WS_CKV), (bf16_t*)(ws + WS_QI), (bf16_t*)(ws + WS_KIN), (float*)(ws + WS_WI), A->in[I_AIKG] + j * IDIM, A->in[I_AIKB] + j * IDIM,
                                (const float*)(ws + WS_SHW + SHW_A) + (size_t)j * BATCH * 2048, SS};
                pg8::gemm_phase<pg8::EpiInA, true, 3>(lds, g, S, E);
            } else {
                unsigned char* wb = ws + WS_WB + (size_t)j * WB_STRIDE;
                (void)wb;
                pg8::Gemm g{(const bf16_t*)(ws + WS_XG), (const bf16_t*)(ws + WS_W8B), D / 2, D / 2, D / 2, 0, 0, (unsigned)(B_IN * D)}; pg8::StaticOrder S; S.init(M, B_IN, G, (int)blockIdx.x);
                pg8::EpiBf16Plain<true, true> E{(bf16_t*)(ws + WS_QKV), B_IN, (const float*)(ws + WS_SHW + SHW_B) + (size_t)j * BATCH * B_IN, B_IN, SS,
                                                (const float*)(ws + WS_CWB), (const unsigned long long*)(ws + WS_SS) + (size_t)(2 * l - 1) * M};
                pg8::gemm_phase<pg8::EpiBf16Plain<true, true>, true, 1>(lds, g, S, E);
            }
        }
        GB();
        if (isA) {
            { const CAS Args* A = kargs(); const int G = gridDim.x, j = l >> 1; unsigned char* ws = A->ws;
              unsigned char* wa = ws + WS_WA + (size_t)j * WA_STRIDE;
              pg8::Gemm g{(const bf16_t*)(ws + WS_QO), (const bf16_t*)(wa + WQA_OFF), D, 128, 128, 0, 128}; pg8::StaticOrder S; S.init(M, 2048, G, (int)blockIdx.x);
              pg8::EpiFp8 E{ws + WS_BIG, 8192};
              pg8::gemm_phase<pg8::EpiFp8, false, 0, true>(lds, g, S, E); }
            { const CAS Args* A = kargs(); const int G = gridDim.x; unsigned char* ws = A->ws;
              const int tid2 = tid_now();
              const int lane = tid2 & 63, wave = __builtin_amdgcn_readfirstlane(tid2 >> 6);
              const bf16_t* CKV = (const bf16_t*)(ws + WS_CKV); unsigned* CKV8 = (unsigned*)(ws + WS_CKV8);
              const int gw = blockIdx.x * NWAVES + wave, NGW = G * NWAVES;
              for (int row = gw; row < M; row += NGW) {
                  const u32x2 v = *((const u32x2*)(CKV + (size_t)row * RK) + lane);
                  const float a0 = __uint_as_float(v.x << 16), a1 = __uint_as_float(v.x & 0xffff0000u), a2 = __uint_as_float(v.y << 16), a3 = __uint_as_float(v.y & 0xffff0000u);
                  const float ss = wave_sum((a0 * a0 + a1 * a1) + (a2 * a2 + a3 * a3));
                  const float rs = 1.0f / sqrtf(ss * (1.0f / RK) + EPS);
                  int w = 0; w = __builtin_amdgcn_cvt_pk_fp8_f32(a0 * rs, a1 * rs, w, false); w = __builtin_amdgcn_cvt_pk_fp8_f32(a2 * rs, a3 * rs, w, true);
                  CKV8[(size_t)row * (RK / 4) + lane] = (unsigned)w;
              } }
            { const CAS Args* A = kargs(); const int G = gridDim.x; unsigned char* ws = A->ws;
              const int tid2 = tid_now();
              const int lane = tid2 & 63, wave = __builtin_amdgcn_readfirstlane(tid2 >> 6);
              int xcd, rank; XCD_RANK(xcd, rank); xcd = __builtin_amdgcn_readfirstlane(xcd); rank = __builtin_amdgcn_readfirstlane(rank);
              const int wx = rank * NWAVES + wave, nwx = (G >> 3) * NWAVES;
              const int nsteps = (1024 + nwx - 1) / nwx;
              for (int st = 0; st < nsteps; ++st) {
                  const int q = wx + st * nwx; const bool active = q < 1024;
                  const int qc = active ? q : (rank * NWAVES + st * nwx < 1024 ? rank * NWAVES + st * nwx : 1023);
                  const int bl = qc >> 9, u = qc & 255, hiq = (qc >> 8) & 1, b = 2 * xcd + bl;
                  const int tg = hiq ? 511 - u : u;
                  idx_task((const bf16_t*)(ws + WS_QI), (const bf16_t*)(ws + WS_KIN), (const float*)(ws + WS_WI), (unsigned*)(ws + WS_SEL), lds, b, tg, lane, wave, active, 4 * (hiq ? 511 - (u & ~7) : (u | 7)) + 4);
              }
              __syncthreads(); }
        } else {
            const CAS Args* A = kargs(); const int G = gridDim.x, j = l >> 1; unsigned char* ws = A->ws;
            swa_phase((const bf16_t*)(ws + WS_QKV), (bf16_t*)(ws + WS_OB), A->in[I_RELB], A->in[I_BSINK] + j * NH, lds, G);
        }
        GB();
        if (isA) {
            { const CAS Args* A = kargs(); const int G = gridDim.x; unsigned char* ws = A->ws;
              const int tid2 = tid_now();
              const int lane = tid2 & 63, wave = __builtin_amdgcn_readfirstlane(tid2 >> 6);
              LAS float* relb = (LAS float*)(lds + 147456);
              LAS unsigned* btab = (LAS unsigned*)(lds + 147456 + 2048);
              for (int i = tid2; i < NBUCK * NH; i += NTHR) relb[i] = A->in[I_RELB][i];
              for (int i = tid2; i < 132; i += NTHR) btab[i] = (unsigned)t5_bucket(i);
              __syncthreads();
              int xcd, rank; XCD_RANK(xcd, rank); xcd = __builtin_amdgcn_readfirstlane(xcd); rank = __builtin_amdgcn_readfirstlane(rank);
              const int wx = rank * NWAVES + wave, nwx = (G >> 3) * NWAVES;
              att_wave(ws + WS_CKV8, (const unsigned*)(ws + WS_SEL), ws + WS_BIG, lds + wave * 16384, (LAS unsigned*)(lds + 131072 + wave * 2048), relb, btab, xcd, wx, nwx, lane); }
            GB();
            { const CAS Args* A = kargs(); const int G = gridDim.x, j = l >> 1; unsigned char* ws = A->ws;
              unsigned char* wa = ws + WS_WA + (size_t)j * WA_STRIDE;
              pg8::Gemm g{(const bf16_t*)(ws + WS_BIG), (const bf16_t*)(wa + WUV_OFF), 4096, D, D, 0, 1024}; pg8::StaticOrder S; S.init(M, D, G, (int)blockIdx.x);
              pg8::EpiFp8 E{ws + WS_OB, D};
              pg8::gemm_phase<pg8::EpiFp8, false>(lds, g, S, E); }
            GB();
        }
        {
            const CAS Args* A = kargs(); const int G = gridDim.x, j = l >> 1; unsigned char* ws = A->ws;
            const float* modl = (const float*)(ws + WS_MOD) + (size_t)l * BATCH * 6144;
            const bf16_t* Ain = (const bf16_t*)(ws + WS_OB);
            const bf16_t* Bw = (const bf16_t*)(isA ? ws + WS_WA + (size_t)j * WA_STRIDE + WOUTA_OFF : ws + WS_WB + (size_t)j * WB_STRIDE + WOUTB_OFF);
            w8_build<false>((const bf16_t*)(ws + WS_W + (size_t)l * W_LAYER + W13_OFF), 2 * DFF, A->in[I_GFFN] + l * D, modl + 4096, ws + WS_W8, (float*)(ws + WS_CW), lds, G);
            pg8::Gemm g{Ain, Bw, D / 2, D / 2, D / 2, 0, 0, 0}; pg8::StaticOrder S; S.init(M, D, G, (int)blockIdx.x);
            pg8::EpiResid<true, true> E{(const bf16_t*)A->out, (bf16_t*)A->out, modl + 2048, isA ? nullptr : A->in[I_BBOUT] + j * D,
                            (bf16_t*)(ws + WS_XG), nullptr, nullptr, (unsigned long long*)(ws + WS_SS) + (size_t)(2 * l + 1) * M, (const unsigned long long*)(ws + WS_SS) + (size_t)(2 * l) * M};
            pg8::gemm_phase<pg8::EpiResid<true, true>, true, 2>(lds, g, S, E);
        }
        GB();
        {
            const CAS Args* A = kargs(); const int G = gridDim.x; unsigned char* ws = A->ws;
            unsigned char* wl = ws + WS_W + (size_t)l * W_LAYER;
            pg8::Gemm g{(const bf16_t*)(ws + WS_XG), (const bf16_t*)(ws + WS_W8), D / 2, D / 2, D / 2, 0, 0, (unsigned)W8_BATCH}; pg8::StaticOrder S; S.init(M, 2 * DFF, G, (int)blockIdx.x);
            pg8::EpiSwiGLU E{(bf16_t*)(ws + WS_HFF), (const float*)(ws + WS_SHW + SHW_F) + (size_t)l * BATCH * 2 * DFF, (const unsigned long long*)(ws + WS_SS) + (size_t)(2 * l + 1) * M,
                             (const float*)(ws + WS_CW), (const unsigned long long*)(ws + WS_SS) + (size_t)(2 * l) * M};
            pg8::gemm_phase<pg8::EpiSwiGLU, true, 1>(lds, g, S, E);
        }
        GB();
        {
            const CAS Args* A = kargs(); const int G = gridDim.x; unsigned char* ws = A->ws;
            unsigned char* wl = ws + WS_W + (size_t)l * W_LAYER;
            const float* modl = (const float*)(ws + WS_MOD) + (size_t)l * BATCH * 6144;
            const int ln = l + 1 < DEPTH ? l + 1 : l;
            pg8::Gemm g{(const bf16_t*)(ws + WS_HFF), (const bf16_t*)(wl + W2_OFF), DFF, DFF, DFF, 0, 0}; pg8::StaticOrder S; S.init(M, D, G, (int)blockIdx.x);
            const bool lastl = (l + 1 == DEPTH);
            if (!lastl && ((l + 1) & 1)) {
                const int jn = (l + 1) >> 1;
                w8_build<true>((const bf16_t*)(ws + WS_WB + (size_t)jn * WB_STRIDE + WINB_OFF), B_IN, A->in[I_GMIX] + ln * D, (const float*)(ws + WS_MOD) + (size_t)ln * BATCH * 6144 + 1024, ws + WS_W8B, (float*)(ws + WS_CWB), lds, G);
                pg8::EpiResid<true, false> E{(const bf16_t*)A->out, (bf16_t*)A->out, modl + 5120, nullptr,
                                (bf16_t*)(ws + WS_XG), nullptr, nullptr, (unsigned long long*)(ws + WS_SS) + (size_t)(2 * l + 2) * M, (const unsigned long long*)(ws + WS_SS) + (size_t)(2 * l + 1) * M};
                pg8::gemm_phase<pg8::EpiResid<true, false>, true>(lds, g, S, E);
            } else {
                pg8::EpiResid<false, false> E{(const bf16_t*)A->out, lastl ? (bf16_t*)(ws + WS_XG) : (bf16_t*)A->out, modl + 5120, nullptr,
                                l + 1 < DEPTH ? (bf16_t*)(ws + WS_XG) : nullptr, A->in[I_GMIX] + ln * D, (const float*)(ws + WS_MOD) + (size_t)ln * BATCH * 6144 + 1024, (unsigned long long*)(ws + WS_SS) + (size_t)(2 * l + 2) * M, nullptr};
                pg8::gemm_phase<pg8::EpiResid<false, false>, true>(lds, g, S, E);
            }
        }
        GB();
    }
    { const CAS Args* A = kargs(); final_norm_phase((const bf16_t*)(A->ws + WS_XG), A->out, A->in[I_GFIN], (int)gridDim.x); }
#undef GB
}

extern "C" void kernel_launch(void* const* d_in, const int* in_sizes, int n_in, void* d_out, int out_size, void* d_ws, size_t ws_size, hipStream_t stream) {
    static int grid = 0;
    if (grid == 0) {
        if (n_in != 23 || out_size != M * D || ws_size < WS_END) { fprintf(stderr, "kernel_launch: unexpected shapes (n_in %d out %d ws %zu)\n", n_in, out_size, ws_size); grid = -1; return; }
        int dev = 0, cus = 0, per_cu = 0;
        if (hipGetDevice(&dev) != hipSuccess || hipDeviceGetAttribute(&cus, hipDeviceAttributeMultiprocessorCount, dev) != hipSuccess) { grid = -1; return; }
        if (hipFuncSetAttribute((const void*)trunk_fwd, hipFuncAttributeMaxDynamicSharedMemorySize, LDS_BYTES) != hipSuccess) { fprintf(stderr, "kernel_launch: hipFuncSetAttribute failed\n"); grid = -1; return; }
        if (hipOccupancyMaxActiveBlocksPerMultiprocessor(&per_cu, (const void*)trunk_fwd, NTHR, LDS_BYTES) != hipSuccess || per_cu < 1) { fprintf(stderr, "kernel_launch: occupancy query says %d\n", per_cu); }
        (void)hipGetLastError();
        grid = cus;
    }
    if (grid < 0) return;
    (void)hipMemsetAsync((char*)d_ws + WS_CTL, 0, CTL_ZERO_BYTES, stream);
    Args a{};
    for (int i = 0; i < 23; ++i) a.in[i] = (const float*)d_in[i];
    a.out = (float*)d_out; a.ws = (unsigned char*)d_ws;
    hipLaunchKernelGGL(trunk_fwd, dim3(grid), dim3(NTHR), LDS_BYTES, stream, a);
    const hipError_t le = hipPeekAtLastError();
    if (le != hipSuccess) fprintf(stderr, "kernel_launch: launch failed: %s\n", hipGetErrorName(le));
}
```

```cpp
#include <hip/hip_runtime.h>
#include <cstdio>
#include <cstdint>


#define GAS __attribute__((address_space(1)))
#define LAS __attribute__((address_space(3)))
typedef unsigned short bf16_t;
typedef short bf16x8 __attribute__((ext_vector_type(8)));
typedef short s16x4 __attribute__((ext_vector_type(4)));
typedef float f32x4 __attribute__((ext_vector_type(4)));
typedef float f32x2 __attribute__((ext_vector_type(2)));
typedef float f32x16 __attribute__((ext_vector_type(16)));
typedef unsigned u32x4 __attribute__((ext_vector_type(4)));
typedef unsigned u32x2 __attribute__((ext_vector_type(2)));
typedef int i32x4 __attribute__((ext_vector_type(4)));
typedef int i32x8 __attribute__((ext_vector_type(8)));

constexpr int D = 1024, BATCH = 16, SEQ = 2048, M = BATCH * SEQ, DEPTH = 4;
constexpr int NH = 16, HD = 64, RK = 256, IH = 8, IDIM = 64, TOPK = 256;
constexpr int KVH = 2, GQ = 8, WIN = 128, NBUCK = 32, DFF = 2816;
constexpr int A_IN = 1864, B_IN = 1280;
constexpr float EPS = 1e-6f;
constexpr float NEGF = -1e30f;
constexpr int NWAVES = 8, NTHR = 512;

constexpr size_t MiB = 1u << 20;
constexpr size_t WS_CTL = 0, CTL_ZERO_BYTES = 4 * MiB;
constexpr size_t WS_SS = 1 * MiB;
constexpr size_t WS_W = 4 * MiB;
constexpr size_t W_LAYER = 17301504;
constexpr size_t W13_OFF = 0, W2_OFF = 11 * MiB;
constexpr size_t WS_WA = WS_W + 4 * W_LAYER;
constexpr size_t WA_STRIDE = 10 * MiB, WINA_OFF = 0, WQA_OFF = 4 * MiB, WINQ8_OFF = 5 * MiB, WUV_OFF = 6 * MiB, WOUTA_OFF = 8 * MiB;
constexpr size_t WS_WB = WS_WA + 2 * WA_STRIDE;
constexpr size_t WB_STRIDE = 4718592, WINB_OFF = 0, WOUTB_OFF = 2621440;
constexpr size_t WS_MOD = 100 * MiB;
constexpr size_t WS_SHW = WS_MOD + 1536 * 1024;
constexpr size_t SHW_A = 0, SHW_B = 2 * 16 * 2048 * 4, SHW_F = SHW_B + 2 * 16 * 1280 * 4;
constexpr size_t WS_XG = 104 * MiB;
constexpr size_t OUT_XGQ = 64 * MiB;
constexpr size_t WS_BIG = 104 * MiB;
constexpr size_t WS_HFF = 168 * MiB;
constexpr size_t WS_QO = 360 * MiB;
constexpr size_t WS_CKV = 424 * MiB;
constexpr size_t WS_QI = 440 * MiB;
constexpr size_t WS_KIN = 472 * MiB;
constexpr size_t WS_WI = 476 * MiB;
constexpr size_t WS_SEL = 477 * MiB;
constexpr size_t WS_CKV8 = 486 * MiB;
constexpr size_t WS_QKV = 360 * MiB;
constexpr size_t WS_OB = 440 * MiB;
constexpr size_t WS_W8 = 344 * MiB;
constexpr size_t W8_BATCH = (size_t)2 * 2816 * 1024;
constexpr size_t WS_CW = 504 * MiB;
constexpr size_t WS_W8B = 136 * MiB;
constexpr size_t WS_CWB = WS_CW + 512 * 1024;
constexpr size_t WS_END = 512 * MiB;

constexpr int RING_BYTES = 131072;
constexpr int LDS_MISC_OFF = 155648;
constexpr int LDS_BYTES = 156672;

extern __shared__ __attribute__((aligned(16))) unsigned char lds_raw[];
constexpr int LDS_WAVE_TAB = LDS_MISC_OFF + 256;
__device__ __forceinline__ int lane_now() { int l; asm volatile("v_mbcnt_lo_u32_b32 %0, -1, 0\n\tv_mbcnt_hi_u32_b32 %0, -1, %0" : "=v"(l)); return l; }
__device__ __forceinline__ unsigned hw_slot() { return (unsigned)__builtin_amdgcn_s_getreg((5 << 11) | 4) & 63u; }
__device__ __forceinline__ int wave_now() { return __builtin_amdgcn_readfirstlane((int)*(volatile LAS unsigned*)((LAS unsigned char*)lds_raw + LDS_WAVE_TAB + 4 * hw_slot())); }
__device__ __forceinline__ int tid_now() { return wave_now() * 64 + lane_now(); }
#define RLX_AGENT __ATOMIC_RELAXED, __HIP_MEMORY_SCOPE_AGENT
__device__ __forceinline__ unsigned cvt_pk_bf16(float lo, float hi) { unsigned r; asm volatile("v_cvt_pk_bf16_f32 %0, %1, %2" : "=v"(r) : "v"(lo), "v"(hi)); return r; }
typedef _Float16 h16x2 __attribute__((ext_vector_type(2)));
typedef _Float16 h16x8 __attribute__((ext_vector_type(8)));
__device__ __forceinline__ unsigned cvt_pk_f16(float lo, float hi) { return __builtin_bit_cast(unsigned, __builtin_convertvector((f32x2){lo, hi}, h16x2)); }
__device__ __forceinline__ f32x2 unpk_f16(unsigned u) { return __builtin_convertvector(__builtin_bit_cast(h16x2, u), f32x2); }
__device__ __forceinline__ float bf2f(bf16_t b) { return __uint_as_float(((unsigned)b) << 16); }
__device__ __forceinline__ float half_sum_f(float v);
__device__ __forceinline__ float rows_sum(float x);
__device__ __forceinline__ float wave_sum(float v) {
    v = half_sum_f(v);
    const u32x2 r = __builtin_amdgcn_permlane32_swap(__float_as_uint(v), __float_as_uint(v), false, false);
    return __uint_as_float(r.x) + __uint_as_float(r.y);
}
__device__ __forceinline__ float fast_exp(float x) { return __builtin_amdgcn_exp2f(x * 1.4426950408889634f); }
__device__ __forceinline__ float silu_f(float x) { return x * __builtin_amdgcn_rcpf(1.0f + fast_exp(-x)); }
__device__ __forceinline__ int t5_bucket(int d) {
    if (d < 16) return d;
    int b = 16;
    b += (d >= 19); b += (d >= 21); b += (d >= 24); b += (d >= 27); b += (d >= 31); b += (d >= 35); b += (d >= 40); b += (d >= 46);
    b += (d >= 52); b += (d >= 59); b += (d >= 67); b += (d >= 77); b += (d >= 87); b += (d >= 99); b += (d >= 113);
    return b;
}

#define XB_TMO      128
#define XB_XCNT(j)  (256  + 64 * (j))
#define XB_XSUB(j)  (1280 + 64 * (j))
#define XB_XGEN(j)  (2304 + 64 * (j))
#define XB_TOP      3328
#define XB_TOPGEN   3392
#define XCD_BAR_WORDS 3456
#define XB_SPIN_CAP (1u << 22)

__device__ __forceinline__ unsigned xb_ld(unsigned* p)              { return __hip_atomic_load(p, __ATOMIC_RELAXED, __HIP_MEMORY_SCOPE_AGENT); }
__device__ __forceinline__ unsigned xb_add(unsigned* p, unsigned v) { return __hip_atomic_fetch_add(p, v, __ATOMIC_RELAXED, __HIP_MEMORY_SCOPE_AGENT); }
__device__ __forceinline__ unsigned xb_xcc_id() { return (unsigned)__builtin_amdgcn_s_getreg((3 << 11) | 20) & 0xFu; }
#define XB_SPIN(cond, bar) do { unsigned _sp = 0; while (cond) { __builtin_amdgcn_s_sleep(1); \
    if ((++_sp & 255u) == 0u) { if (xb_ld(&(bar)[XB_TMO])) break; if (_sp > XB_SPIN_CAP) { atomicAdd(&(bar)[XB_TMO], 1u); break; } } } } while (0)

struct XcdBarrier { unsigned* bar; unsigned x; volatile LAS unsigned* st; };

__device__ __forceinline__ XcdBarrier xcd_barrier_post(unsigned* bar, volatile LAS unsigned* st) {
    XcdBarrier b; b.bar = bar; b.x = xb_xcc_id(); b.st = st;
    if (threadIdx.x == 0) (void)xb_add(&bar[XB_XCNT(b.x)], 1u);
    return b;
}
__device__ __forceinline__ void xcd_barrier_complete(unsigned* bar, unsigned x, unsigned& nloc, unsigned& nx) {
    const unsigned G = gridDim.x * gridDim.y * gridDim.z;
    unsigned sum, cnt, mine, sp = 0u;
    for (;;) {
        sum = 0u; cnt = 0u; mine = 0u;
#pragma unroll
        for (unsigned j = 0; j < 16; ++j) { const unsigned c = xb_ld(&bar[XB_XCNT(j)]); sum += c; cnt += (c > 0u) ? 1u : 0u; mine = (j == x) ? c : mine; }
        if (sum == G) break;
        __builtin_amdgcn_s_sleep(1);
        if ((++sp & 255u) == 0u) { if (xb_ld(&bar[XB_TMO])) break; if (sp > XB_SPIN_CAP) { atomicAdd(&bar[XB_TMO], 1u); break; } }
    }
    nloc = mine > 0u ? mine : 1u; nx = cnt > 0u ? cnt : 1u;
}
__device__ __forceinline__ void xcd_barrier(const XcdBarrier& b) {
    asm volatile("s_waitcnt vmcnt(0)" ::: "memory");
    __syncthreads();
    if (tid_now() == 0) {
        unsigned* bar = b.bar;
        __builtin_amdgcn_s_waitcnt(0);
        unsigned nloc = b.st[0], nx = b.st[1];
        if (nloc == 0u) { xcd_barrier_complete(bar, b.x, nloc, nx); b.st[0] = nloc; b.st[1] = nx; }
        const unsigned old = xb_add(&bar[XB_XSUB(b.x)], 1u);
        const unsigned gen = old / nloc;
        if (old + 1u == (gen + 1u) * nloc) {
            __builtin_amdgcn_fence(__ATOMIC_RELEASE, "agent");
            asm volatile("s_waitcnt vmcnt(0)" ::: "memory");
            const unsigned og = xb_add(&bar[XB_TOP], 1u);
            const unsigned tg = og / nx;
            if (og + 1u == (tg + 1u) * nx) xb_add(&bar[XB_TOPGEN], 1u);
            else XB_SPIN(xb_ld(&bar[XB_TOPGEN]) == tg, bar);
            __builtin_amdgcn_fence(__ATOMIC_ACQUIRE, "agent");
            xb_add(&bar[XB_XGEN(b.x)], 1u);
            asm volatile("s_waitcnt vmcnt(0)" ::: "memory");
        } else {
            XB_SPIN(xb_ld(&bar[XB_XGEN(b.x)]) == gen, bar);
            __builtin_amdgcn_fence(__ATOMIC_ACQUIRE, "agent");
            asm volatile("s_waitcnt vmcnt(0)" ::: "memory");
        }
    }
    __syncthreads();
}

namespace pg8 {
constexpr int BM = 256, BK = 64, HALF = 128, HTB = HALF * BK * 2, STAGE_BYTES = 8 * HTB, NXCD = 8, WGM = 8;
__host__ __device__ __forceinline__ int lds_byte(int r, int c) { const int st = (r >> 4) * 2 + (c >> 5), rr = r & 15, cc = c & 31, ob = rr * 64 + cc * 2; return st * 1024 + (ob ^ (((ob >> 9) & 1) << 5)); }
__host__ __device__ __forceinline__ void stage_rc(int b, int& R, int& C) { const int st = b / 1024, sb = b % 1024, swz = sb ^ (((sb >> 9) & 1) << 5); R = (st >> 1) * 16 + swz / 64; C = (st & 1) * 32 + (swz % 64) / 2; }
__host__ __device__ __forceinline__ int perm32(int rho) { const int n = rho >> 4, i = rho & 15; return 8 * (i >> 2) + 4 * n + (i & 3); }

struct Unit { int pm, pn; };
struct Gemm { const bf16_t* A; const bf16_t* Bt; int lda, ldb, K, a_shift, a_mul; unsigned bb; int a_tiled; };

struct StaticOrder {
    int nM, nN, nwg, G, c;
    __device__ void init(int M_, int N_, int G_, int c_) { nM = M_ / BM; nN = N_ / BM; nwg = nM * nN; G = G_; c = c_; }
    __device__ bool next(int i, Unit& u) const {
        const long L = (long)i * G + c; if (L >= nwg) return false;
        int wgid = (int)L; { const int q = nwg / NXCD, r = nwg % NXCD, xcd = wgid % NXCD, off = wgid / NXCD; wgid = (xcd < r ? xcd * (q + 1) : r * (q + 1) + (xcd - r) * q) + off; }
        const int nig = WGM * nN, gid = wgid / nig, fm = gid * WGM, gsz = (nM - fm) < WGM ? (nM - fm) : WGM;
        u.pm = fm + ((wgid % nig) % gsz); u.pn = (wgid % nig) / gsz; return true;
    }
};

template <class Epi, bool ALIGN_EPI, int MODE = 0, bool PAIR = false>
__device__ __forceinline__ void gemm_phase(LAS unsigned char* lds, const Gemm g, const StaticOrder& S, const Epi& E) {
    int tid = tid_now();
    const int wid = __builtin_amdgcn_readfirstlane(tid >> 6), lane = tid & 63, wr = wid >> 2, wc = wid & 3, fr = lane & 15, fq = lane >> 4;
    const int K = g.K, nt = K / BK;
    unsigned voffA[2], voffB[2];
#pragma unroll
    for (int i = 0; i < 2; ++i) { int R, C; stage_rc(tid * 16 + i * 8192, R, C); const int Rb = Epi::PERM16 ? (64 * (R >> 5) + 16 * ((R & 15) >> 2) + 4 * ((R >> 4) & 1) + (R & 3)) : Epi::PERM ? ((R & ~31) + perm32(R & 31)) : R;
        voffA[i] = g.a_tiled ? (unsigned)((C >> 5) * (BM * 32) + R * 32 + (C & 31)) * 2u : (unsigned)(R * g.lda + C) * 2u; voffB[i] = (unsigned)(Rb * g.ldb + C) * 2u; }
    const size_t kstep = (size_t)(BK * 2), kstepA = g.a_tiled ? (size_t)(BM * BK * 2) : kstep;
    const size_t hstepA = (size_t)HALF * (g.a_tiled ? 32 : g.lda) * 2, hstepB = (size_t)(Epi::PERM16 ? 8 : HALF) * g.ldb * 2;
    const unsigned ldsw = (unsigned)wid * 1024u;
    const int aoff = lds_byte(wr * 64 + fr, fq * 8), boff = lds_byte(wc * 32 + fr, fq * 8);
#define PG8_SA(b, h) (((b) * 2 + (h)) * HTB)
#define PG8_SB(b, h) ((4 + (b) * 2 + (h)) * HTB)
#define PG8_STAGE(bufoff, gbase, voff) do { const char* _gb = (const char*)(gbase); asm volatile("" : "+s"(_gb));     \
        _Pragma("unroll") for (int _i = 0; _i < 2; ++_i) \
        __builtin_amdgcn_global_load_lds((const unsigned*)(_gb + (voff)[_i]), (LAS unsigned*)(lds + (bufoff) + ldsw + _i * 8192), 16, 0, 0); } while (0)
#define PG8_LDA(dst, b, h) do { _Pragma("unroll") for (int m = 0; m < 4; ++m) _Pragma("unroll") for (int k = 0; k < 2; ++k) dst[m][k] = *(const LAS bf16x8*)(lds + PG8_SA(b, h) + aoff + m * 2048 + k * 1024); } while (0)
#define PG8_LDB(dst, b, h) do { _Pragma("unroll") for (int n = 0; n < 2; ++n) _Pragma("unroll") for (int k = 0; k < 2; ++k) dst[n][k] = *(const LAS bf16x8*)(lds + PG8_SB(b, h) + boff + n * 2048 + k * 1024); } while (0)
#define PG8_CAT(x0, x1) __builtin_shufflevector(__builtin_bit_cast(i32x4, x0), __builtin_bit_cast(i32x4, x1), 0, 1, 2, 3, 4, 5, 6, 7)
#define PG8_MMA(ai, bj, At, Bt) do { __builtin_amdgcn_s_setprio(1); _Pragma("unroll") for (int m = 0; m < 4; ++m) _Pragma("unroll") for (int n = 0; n < 2; ++n) { \
        if constexpr (MODE == 2) acc[ai][bj][m][n] = __builtin_amdgcn_mfma_scale_f32_16x16x128_f8f6f4(PG8_CAT(Bt[n][0], Bt[n][1]), PG8_CAT(At[m][0], At[m][1]), acc[ai][bj][m][n], 0, 0, 0, 0, 0, 0); \
        else { _Pragma("unroll") for (int k = 0; k < 2; ++k) { \
          if constexpr (MODE == 1) acc[ai][bj][m][n] = __builtin_bit_cast(f32x4, __builtin_amdgcn_mfma_i32_16x16x64_i8(__builtin_bit_cast(i32x4, Bt[n][k]), __builtin_bit_cast(i32x4, At[m][k]), __builtin_bit_cast(i32x4, acc[ai][bj][m][n]), 0, 0, 0)); \
          else if constexpr (MODE == 3) acc[ai][bj][m][n] = __builtin_amdgcn_mfma_f32_16x16x32_f16(__builtin_bit_cast(h16x8, Bt[n][k]), __builtin_bit_cast(h16x8, At[m][k]), acc[ai][bj][m][n], 0, 0, 0); \
          else acc[ai][bj][m][n] = __builtin_amdgcn_mfma_f32_16x16x32_bf16(Bt[n][k], At[m][k], acc[ai][bj][m][n], 0, 0, 0); } } } __builtin_amdgcn_s_setprio(0); } while (0)
#define PG8_WAIT_V(n) asm volatile("s_waitcnt vmcnt(" #n ")" ::: "memory")
#define PG8_WAIT_L(n) asm volatile("s_waitcnt lgkmcnt(" #n ")" ::: "memory")
#define PG8_BAR __builtin_amdgcn_s_barrier()
#define PG8_SCHED __builtin_amdgcn_sched_barrier(0)
#define PG8_ABASE(u) ((const char*)g.A + ((size_t)(u).pm * BM * g.lda + (size_t)((u).pn >> g.a_shift) * g.a_mul) * 2)
#define PG8_BBASE(u) ((const char*)g.Bt + (size_t)(u).pn * BM * g.ldb * 2 + (size_t)((u).pm >> 3) * g.bb)
    Unit cur, nxt; int ui = 0;
    if (!S.next(0, cur)) return;
    f32x4 acc[2][2][4][2];
#pragma unroll
    for (int a = 0; a < 2; ++a)
#pragma unroll
        for (int b = 0; b < 2; ++b)
#pragma unroll
            for (int m = 0; m < 4; ++m)
#pragma unroll
                for (int n = 0; n < 2; ++n) acc[a][b][m][n] = (f32x4){0.f, 0.f, 0.f, 0.f};
    bf16x8 At[4][2], B0[2][2], B1[2][2];
    const char* cA = PG8_ABASE(cur); const char* cB = PG8_BBASE(cur);
    PG8_STAGE(PG8_SB(0, 0), cB, voffB); PG8_STAGE(PG8_SB(0, 1), cB + hstepB, voffB); PG8_STAGE(PG8_SA(0, 0), cA, voffA); PG8_STAGE(PG8_SA(0, 1), cA + hstepA, voffA);
    if (wr == 1) PG8_BAR;
    PG8_WAIT_V(2); PG8_BAR;
    PG8_STAGE(PG8_SB(1, 0), cB + kstep, voffB); PG8_STAGE(PG8_SA(1, 0), cA + kstepA, voffA); PG8_STAGE(PG8_SB(1, 1), cB + hstepB + kstep, voffB);
    PG8_WAIT_V(6); PG8_BAR;
    for (;;) {
        const bool has_next = S.next(ui + 1, nxt);
        const char* nA = has_next ? PG8_ABASE(nxt) : cA; const char* nB = has_next ? PG8_BBASE(nxt) : cB;
        for (int t = 0; t < nt; t += 2) {
            const bool last = (t == nt - 2);
            if constexpr (Epi::PREFETCH) { if (last) E.prefetch(lds + STAGE_BYTES, cur, wid, lane_now()); }
            const char* a1 = cA + (size_t)(t + 1) * kstepA;
            const char* a2 = last ? nA : cA + (size_t)(t + 2) * kstepA; const char* b2 = last ? nB : cB + (size_t)(t + 2) * kstep;
            const char* a3 = a2 + kstepA; const char* b3 = b2 + kstep;
            PG8_LDB(B0, 0, 0); PG8_LDB(B1, 0, 1); PG8_SCHED; PG8_LDA(At, 0, 0); PG8_STAGE(PG8_SA(1, 1), a1 + hstepA, voffA);
            PG8_WAIT_V(8); PG8_WAIT_L(0); PG8_BAR; PG8_MMA(0, 0, At, B0); PG8_MMA(0, 1, At, B1); PG8_BAR; PG8_SCHED;
            PG8_LDA(At, 0, 1); PG8_STAGE(PG8_SB(0, 0), b2, voffB); PG8_STAGE(PG8_SB(0, 1), b2 + hstepB, voffB); PG8_STAGE(PG8_SA(0, 0), a2, voffA);
            PG8_WAIT_V(8); PG8_WAIT_L(0); PG8_BAR; PG8_MMA(1, 0, At, B0); PG8_MMA(1, 1, At, B1); PG8_BAR; PG8_SCHED;
            if constexpr (PAIR) { const int l3 = lane_now(); Unit u0 = cur; u0.pn = 2 * cur.pn; E(acc, u0, wr, wc, l3 & 15, l3 >> 4);
                _Pragma("unroll") for (int a = 0; a < 2; ++a) _Pragma("unroll") for (int b = 0; b < 2; ++b) _Pragma("unroll") for (int m = 0; m < 4; ++m) _Pragma("unroll") for (int n = 0; n < 2; ++n) acc[a][b][m][n] = (f32x4){0.f, 0.f, 0.f, 0.f}; }
            PG8_LDB(B0, 1, 0); PG8_LDB(B1, 1, 1); PG8_SCHED; PG8_LDA(At, 1, 0); PG8_STAGE(PG8_SA(0, 1), a2 + hstepA, voffA);
            PG8_WAIT_V(8); PG8_WAIT_L(0); PG8_BAR; PG8_MMA(0, 0, At, B0); PG8_MMA(0, 1, At, B1); PG8_BAR; PG8_SCHED;
            PG8_LDA(At, 1, 1); PG8_STAGE(PG8_SB(1, 0), b3, voffB); PG8_STAGE(PG8_SB(1, 1), b3 + hstepB, voffB); PG8_STAGE(PG8_SA(1, 0), a3, voffA);
            PG8_WAIT_V(8); PG8_WAIT_L(0); PG8_BAR; PG8_MMA(1, 0, At, B0); PG8_MMA(1, 1, At, B1); PG8_BAR; PG8_SCHED;
        }
        if constexpr (ALIGN_EPI) { if (wr == 0) PG8_BAR; }
        { const int l2 = lane_now();
          if constexpr (PAIR) { Unit u1 = cur; u1.pn = 2 * cur.pn + 1; E(acc, u1, wr, wc, l2 & 15, l2 >> 4); }
          else if constexpr (Epi::PREFETCH) E(acc, cur, wr, wc, l2 & 15, l2 >> 4, lds + STAGE_BYTES); else E(acc, cur, wr, wc, l2 & 15, l2 >> 4); }
        if (!has_next) break;
#pragma unroll
        for (int a = 0; a < 2; ++a)
#pragma unroll
            for (int b = 0; b < 2; ++b)
#pragma unroll
                for (int m = 0; m < 4; ++m)
#pragma unroll
                    for (int n = 0; n < 2; ++n) acc[a][b][m][n] = (f32x4){0.f, 0.f, 0.f, 0.f};
        cur = nxt; cA = nA; cB = nB; ++ui;
        if constexpr (ALIGN_EPI) { if (wr == 1) PG8_BAR; }
    }
    PG8_WAIT_V(0);
    if constexpr (!ALIGN_EPI) { if (wr == 0) PG8_BAR; }
    PG8_BAR;
#undef PG8_SA
#undef PG8_SB
#undef PG8_STAGE
#undef PG8_LDA
#undef PG8_LDB
#undef PG8_MMA
#undef PG8_CAT
#undef PG8_WAIT_V
#undef PG8_WAIT_L
#undef PG8_BAR
#undef PG8_SCHED
#undef PG8_ABASE
#undef PG8_BBASE
}

__device__ __forceinline__ float ss_ms(unsigned long long v) { unsigned hi = (unsigned)(v >> 32); asm("" : "+v"(hi));
    return ((float)hi * 4294967296.0f + (float)(unsigned)v) * (1.0f / (16777216.0f * D)); }
__device__ __forceinline__ float frsq(float x) { return __builtin_amdgcn_rsqf(x); }
__device__ __forceinline__ float fsqrt(float x) { return __builtin_amdgcn_sqrtf(x); }
constexpr float Q8_CLIP = 4.25f;
__device__ __forceinline__ unsigned q8_bits(float v) { return __float_as_uint(__builtin_amdgcn_fmed3f(v + 12582912.0f, 12582785.0f, 12583039.0f)); }
__device__ __forceinline__ unsigned q8_bits_s(float x, float sc) { return __float_as_uint(__builtin_amdgcn_fmed3f(fmaf(x, sc, 12582912.0f), 12582785.0f, 12583039.0f)); }
__device__ __forceinline__ unsigned q8_pack(unsigned a, unsigned b, unsigned c, unsigned d) { return __builtin_amdgcn_perm(b, a, 0x0c0c0400u) | __builtin_amdgcn_perm(d, c, 0x04000c0cu); }
template <bool NORM, bool I8 = false, bool F8 = false> struct EpiBf16Plain {
    static constexpr bool PERM = true, PERM16 = true, PREFETCH = NORM;
    bf16_t* O; int ldc; const float* shw; int shw_stride; const unsigned long long* SS; const float* CW; const unsigned long long* SSq;
    __device__ __forceinline__ void prefetch(LAS unsigned char* aux, const Unit& u, int wid, int lane) const {
        if (wid < 2) __builtin_amdgcn_global_load_lds((const unsigned*)((const char*)(SS + (size_t)u.pm * BM) + wid * 1024 + lane * 16), (LAS unsigned*)(aux + wid * 1024), 16, 0, 0);
        else if (wid == 2) __builtin_amdgcn_global_load_lds((const unsigned*)((const char*)(shw + (size_t)(u.pm >> 3) * shw_stride + u.pn * BM) + lane * 16), (LAS unsigned*)(aux + 2048), 16, 0, 0);
        else if constexpr (I8) {
            if (wid == 3) __builtin_amdgcn_global_load_lds((const unsigned*)((const char*)(CW + (size_t)(u.pm >> 3) * shw_stride + u.pn * BM) + lane * 16), (LAS unsigned*)(aux + 3072), 16, 0, 0);
            else if (wid < 6) __builtin_amdgcn_global_load_lds((const unsigned*)((const char*)(SSq + (size_t)u.pm * BM) + (wid - 4) * 1024 + lane * 16), (LAS unsigned*)(aux + wid * 1024), 16, 0, 0);
        }
    }
    __device__ __forceinline__ void operator()(const f32x4 (&acc)[2][2][4][2], const Unit& u, int wr, int wc, int fr, int fq, const LAS unsigned char* aux = nullptr) const {
        const int row0 = u.pm * BM + wr * 64 + fr, col0 = u.pn * BM + wc * 64 + 16 * fq;
        f32x4 bv[2][2], cv[2][2];
#pragma unroll
        for (int bj = 0; bj < 2; ++bj)
#pragma unroll
            for (int n = 0; n < 2; ++n) { bv[bj][n] = NORM ? *(const LAS f32x4*)((const LAS float*)(aux + 2048) + wc * 64 + 16 * fq + bj * 8 + 4 * n) : (f32x4){0.f, 0.f, 0.f, 0.f};
                cv[bj][n] = I8 ? *(const LAS f32x4*)((const LAS float*)(aux + 3072) + wc * 64 + 16 * fq + bj * 8 + 4 * n) : (f32x4){1.f, 1.f, 1.f, 1.f}; }
        const LAS unsigned long long* ssl = (const LAS unsigned long long*)aux + wr * 64 + fr;
        const LAS unsigned long long* sql = (const LAS unsigned long long*)(aux + 4096) + wr * 64 + fr;
#pragma unroll
        for (int ai = 0; ai < 2; ++ai)
#pragma unroll
            for (int m = 0; m < 4; ++m) { const int row = row0 + ai * HALF + m * 16; bf16_t* rowp = O + (size_t)row * ldc + col0;
                float rs = 1.0f; if (NORM) rs = frsq(ss_ms(ssl[ai * HALF + m * 16]) + EPS);
                if (I8) rs *= (Q8_CLIP / 127.0f) * fsqrt(ss_ms(sql[ai * HALF + m * 16]) + EPS);
                if (F8) rs *= (1.0f / 2048.0f);
#pragma unroll
                for (int bj = 0; bj < 2; ++bj) { f32x4 a0 = acc[ai][bj][m][0], a1 = acc[ai][bj][m][1];
                    if (I8) {
#pragma unroll
                        for (int e = 0; e < 4; ++e) { a0[e] = (float)__float_as_int(a0[e]) * cv[bj][0][e]; a1[e] = (float)__float_as_int(a1[e]) * cv[bj][1][e]; } }
                    const f32x4 v0 = a0 * rs + bv[bj][0], v1 = a1 * rs + bv[bj][1];
                    u32x4 w; w.x = cvt_pk_bf16(v0[0], v0[1]); w.y = cvt_pk_bf16(v0[2], v0[3]); w.z = cvt_pk_bf16(v1[0], v1[1]); w.w = cvt_pk_bf16(v1[2], v1[3]);
                    *(u32x4*)(rowp + bj * 8) = w; } }
    }
};
template <bool SC256>
struct EpiFp8T {
    static constexpr bool PERM = true, PERM16 = true, PREFETCH = false;
    unsigned char* O; int ldc;
    __device__ __forceinline__ void operator()(const f32x4 (&acc)[2][2][4][2], const Unit& u, int wr, int wc, int fr, int fq) const {
        const int row0 = u.pm * BM + wr * 64 + fr, col0 = u.pn * BM + wc * 64 + 16 * fq;
#pragma unroll
        for (int ai = 0; ai < 2; ++ai)
#pragma unroll
            for (int m = 0; m < 4; ++m) { unsigned char* rowp;
                if constexpr (SC256) rowp = O + (size_t)(u.pm * 8 + u.pn * 2) * (2 * BM * 64) + (unsigned)(wc * (BM * 64) + (wr * 64 + fr + ai * HALF + m * 16) * 64 + 16 * fq);
                else rowp = O + (size_t)(row0 + ai * HALF + m * 16) * ldc + col0;
                int w[4];
#pragma unroll
                for (int bj = 0; bj < 2; ++bj)
#pragma unroll
                    for (int n = 0; n < 2; ++n) { f32x4 v = acc[ai][bj][m][n]; int x = 0;
                        if constexpr (SC256) v = v * (1.0f / 256.0f);
                        x = __builtin_amdgcn_cvt_pk_fp8_f32(v[0], v[1], x, false); x = __builtin_amdgcn_cvt_pk_fp8_f32(v[2], v[3], x, true); w[2 * bj + n] = x; }
                u32x4 wv; wv.x = (unsigned)w[0]; wv.y = (unsigned)w[1]; wv.z = (unsigned)w[2]; wv.w = (unsigned)w[3]; *(u32x4*)rowp = wv;
                if (m & 1) asm volatile("" ::: "memory"); }
    }
};
typedef EpiFp8T<false> EpiFp8;
struct EpiInA {
    static constexpr bool PERM = true, PERM16 = true, PREFETCH = true;
    static constexpr int PN0 = 4;
    bf16_t* CKV; bf16_t* QI; bf16_t* KIN; float* WI; const float* kg; const float* kb; const float* shw; const unsigned long long* SS;
    __device__ __forceinline__ void prefetch(LAS unsigned char* aux, const Unit& u, int wid, int lane) const {
        if (wid < 2) __builtin_amdgcn_global_load_lds((const unsigned*)((const char*)(SS + (size_t)u.pm * BM) + wid * 1024 + lane * 16), (LAS unsigned*)(aux + wid * 1024), 16, 0, 0);
        else if (wid == 2) __builtin_amdgcn_global_load_lds((const unsigned*)((const char*)(shw + (size_t)(u.pm >> 3) * 2048 + (u.pn + PN0) * BM) + lane * 16), (LAS unsigned*)(aux + 2048), 16, 0, 0);
    }
    __device__ __forceinline__ void operator()(f32x4 (&acc)[2][2][4][2], const Unit& u, int wr, int wc, int fr, int fq, const LAS unsigned char* aux) const {
        const int pn = u.pn + PN0;
        const int row0 = u.pm * BM + wr * 64 + fr, cl = wc * 64 + 16 * fq;
        {
            const LAS float* sp = (const LAS float*)(aux + 2048) + cl;
            const LAS unsigned long long* ssl = (const LAS unsigned long long*)aux + wr * 64 + fr;
            f32x4 bv[2][2];
#pragma unroll
            for (int bj = 0; bj < 2; ++bj)
#pragma unroll
                for (int n = 0; n < 2; ++n) bv[bj][n] = *(const LAS f32x4*)(sp + bj * 8 + 4 * n);
#pragma unroll
            for (int ai = 0; ai < 2; ++ai)
#pragma unroll
                for (int m = 0; m < 4; ++m) { const float rs = frsq(ss_ms(ssl[ai * HALF + m * 16]) + EPS);
#pragma unroll
                    for (int bj = 0; bj < 2; ++bj)
#pragma unroll
                        for (int n = 0; n < 2; ++n) acc[ai][bj][m][n] = acc[ai][bj][m][n] * rs + bv[bj][n]; }
        }
        if (pn < 7) {
            bf16_t* base; int ldc, c0;
            if (pn == 4) { base = CKV; ldc = 256; c0 = 0; } else { base = QI; ldc = 512; c0 = (pn - 5) * 256; }
#pragma unroll
            for (int ai = 0; ai < 2; ++ai)
#pragma unroll
                for (int m = 0; m < 4; ++m) { bf16_t* rowp = base + (size_t)(row0 + ai * HALF + m * 16) * ldc + c0 + cl;
#pragma unroll
                    for (int bj = 0; bj < 2; ++bj) { const f32x4 v0 = acc[ai][bj][m][0], v1 = acc[ai][bj][m][1];
                        u32x4 w;
                        if (pn >= 5) { w.x = cvt_pk_f16(v0[0], v0[1]); w.y = cvt_pk_f16(v0[2], v0[3]); w.z = cvt_pk_f16(v1[0], v1[1]); w.w = cvt_pk_f16(v1[2], v1[3]); }
                        else { w.x = cvt_pk_bf16(v0[0], v0[1]); w.y = cvt_pk_bf16(v0[2], v0[3]); w.z = cvt_pk_bf16(v1[0], v1[1]); w.w = cvt_pk_bf16(v1[2], v1[3]); }
                        *(u32x4*)(rowp + bj * 8) = w; } }
        } else if (wc == 0) {
            f32x4 gv[2][2], bv[2][2];
#pragma unroll
            for (int bj = 0; bj < 2; ++bj)
#pragma unroll
                for (int n = 0; n < 2; ++n) { gv[bj][n] = *(const f32x4*)(kg + 16 * fq + 8 * bj + 4 * n); bv[bj][n] = *(const f32x4*)(kb + 16 * fq + 8 * bj + 4 * n); }
#pragma unroll
            for (int ai = 0; ai < 2; ++ai)
#pragma unroll
                for (int m = 0; m < 4; ++m) {
                    float s = 0.f;
#pragma unroll
                    for (int bj = 0; bj < 2; ++bj)
#pragma unroll
                        for (int n = 0; n < 2; ++n) { const f32x4 x = acc[ai][bj][m][n]; s += (x[0] + x[1]) + (x[2] + x[3]); }
                    s = rows_sum(s);
                    const float mu = s * (1.0f / 64.0f); float q = 0.f;
#pragma unroll
                    for (int bj = 0; bj < 2; ++bj)
#pragma unroll
                        for (int n = 0; n < 2; ++n) { const f32x4 d = acc[ai][bj][m][n] - mu; q += (d[0] * d[0] + d[1] * d[1]) + (d[2] * d[2] + d[3] * d[3]); }
                    q = rows_sum(q);
                    const float rs = frsq(q * (1.0f / 64.0f) + EPS);
                    bf16_t* rowp = KIN + (size_t)(row0 + ai * HALF + m * 16) * 64 + 16 * fq;
#pragma unroll
                    for (int bj = 0; bj < 2; ++bj) { const f32x4 v0 = (acc[ai][bj][m][0] - mu) * rs * gv[bj][0] + bv[bj][0], v1 = (acc[ai][bj][m][1] - mu) * rs * gv[bj][1] + bv[bj][1];
                        u32x4 w; w.x = cvt_pk_f16(v0[0], v0[1]); w.y = cvt_pk_f16(v0[2], v0[3]); w.z = cvt_pk_f16(v1[0], v1[1]); w.w = cvt_pk_f16(v1[2], v1[3]);
                        *(u32x4*)(rowp + bj * 8) = w; }
                }
        } else if (wc == 1 && fq == 0) {
            const float sc = 0.04419417382415922f;
#pragma unroll
            for (int ai = 0; ai < 2; ++ai)
#pragma unroll
                for (int m = 0; m < 4; ++m) { float* rowp = WI + (size_t)(row0 + ai * HALF + m * 16) * 8;
                    *(f32x4*)(rowp) = acc[ai][0][m][0] * sc; *(f32x4*)(rowp + 4) = acc[ai][0][m][1] * sc; }
        }
    }
};
template <bool Q8, bool FP8ACC> struct EpiResid {
    static constexpr bool PERM = true, PERM16 = true, PREFETCH = true;
    const bf16_t* xin_b; bf16_t* xout_b;
    const float* gate; const float* bias;
    static constexpr float asc = FP8ACC ? 1.0f / 4096.0f : 1.0f;
    bf16_t* XG; const float* gn; const float* scn; unsigned long long* SSo; const unsigned long long* SSq;
    unsigned char* XGq;
    __device__ __forceinline__ void prefetch(LAS unsigned char* aux, const Unit& u, int wid, int lane) const {
        const int b = u.pm >> 3; const char* src = nullptr;
        if (wid == 0) src = (const char*)(gate + (size_t)b * 6144 + u.pn * BM);
        else if (wid == 1) src = bias ? (const char*)(bias + u.pn * BM) : nullptr;
        else if constexpr (Q8) { if (wid == 4 || wid == 5) src = (const char*)(SSq + (size_t)u.pm * BM) + (wid - 4) * 1024; }
        else { if (wid == 2) src = XG ? (const char*)(gn + u.pn * BM) : nullptr;
               else if (wid == 3) src = XG ? (const char*)(scn + (size_t)b * 6144 + u.pn * BM) : nullptr; }
        if (src) __builtin_amdgcn_global_load_lds((const unsigned*)(src + lane * 16), (LAS unsigned*)(aux + wid * 1024), 16, 0, 0);
    }
    __device__ __forceinline__ void operator()(const f32x4 (&acc)[2][2][4][2], const Unit& u, int wr, int wc, int fr, int fq, const LAS unsigned char* aux) const {
        const int row0 = u.pm * BM + wr * 64 + fr, col0 = u.pn * BM + wc * 64 + 16 * fq;
        const LAS unsigned long long* sql = (const LAS unsigned long long*)(aux + 4096) + wr * 64 + fr;
        const LAS float* lv = (const LAS float*)aux + wc * 64 + 16 * fq;
        float ssum[2][4];
#pragma unroll
        for (int ai = 0; ai < 2; ++ai)
#pragma unroll
            for (int m = 0; m < 4; ++m) ssum[ai][m] = 0.f;
        f32x4 ga[2][2], gb[2][2], gm[2][2];
#pragma unroll
        for (int bj = 0; bj < 2; ++bj) {
            const LAS float* lp = lv + 8 * bj;
            const f32x4 gv0 = *(const LAS f32x4*)(lp), gv1 = *(const LAS f32x4*)(lp + 4);
            f32x4 bv0 = (f32x4){0.f, 0.f, 0.f, 0.f}, bv1 = bv0;
            if (bias) { bv0 = *(const LAS f32x4*)(lp + 256); bv1 = *(const LAS f32x4*)(lp + 256 + 4); }
            ga[bj][0] = gv0 * asc; ga[bj][1] = gv1 * asc; gb[bj][0] = gv0 * bv0; gb[bj][1] = gv1 * bv1;
            gm[bj][0] = bv0 * 0.f; gm[bj][1] = gm[bj][0];
            if (!Q8 && XG) { gm[bj][0] = *(const LAS f32x4*)(lp + 512) * (*(const LAS f32x4*)(lp + 768) + 1.0f); gm[bj][1] = *(const LAS f32x4*)(lp + 512 + 4) * (*(const LAS f32x4*)(lp + 768 + 4) + 1.0f); }
        }
#pragma unroll
        for (int ai = 0; ai < 2; ++ai)
#pragma unroll
            for (int m = 0; m < 4; ++m) { const size_t off = (size_t)(row0 + ai * HALF + m * 16) * D + col0;
                const u32x4 xv0 = *(const u32x4*)(xin_b + off), xv1 = *(const u32x4*)(xin_b + off + 8);
                float qs = 0.f; if (Q8) qs = (127.0f / Q8_CLIP) * frsq(ss_ms(sql[ai * HALF + m * 16]) + EPS);
                u32x4 w8;
#pragma unroll
                for (int bj = 0; bj < 2; ++bj) { const u32x4 xv = bj ? xv1 : xv0;
                    const f32x2 xa = unpk_f16(xv.x), xb = unpk_f16(xv.y), xc = unpk_f16(xv.z), xd = unpk_f16(xv.w);
                    const f32x4 xi0 = (f32x4){xa.x, xa.y, xb.x, xb.y}, xi1 = (f32x4){xc.x, xc.y, xd.x, xd.y};
                    const f32x4 xo0 = (xi0 + gb[bj][0]) + ga[bj][0] * acc[ai][bj][m][0], xo1 = (xi1 + gb[bj][1]) + ga[bj][1] * acc[ai][bj][m][1];
                    { u32x4 w; w.x = cvt_pk_f16(xo0[0], xo0[1]); w.y = cvt_pk_f16(xo0[2], xo0[3]); w.z = cvt_pk_f16(xo1[0], xo1[1]); w.w = cvt_pk_f16(xo1[2], xo1[3]); __builtin_nontemporal_store(w, (u32x4*)(xout_b + off + 8 * bj)); }
                    if (XG) {
                        { f32x2 s2 = (f32x2){ssum[ai][m], 0.f};
                          s2 = __builtin_elementwise_fma((f32x2){xo0[0], xo0[1]}, (f32x2){xo0[0], xo0[1]}, s2); s2 = __builtin_elementwise_fma((f32x2){xo0[2], xo0[3]}, (f32x2){xo0[2], xo0[3]}, s2);
                          s2 = __builtin_elementwise_fma((f32x2){xo1[0], xo1[1]}, (f32x2){xo1[0], xo1[1]}, s2); s2 = __builtin_elementwise_fma((f32x2){xo1[2], xo1[3]}, (f32x2){xo1[2], xo1[3]}, s2);
                          ssum[ai][m] = s2.x + s2.y; }
                        if constexpr (Q8) {
                            const unsigned q0 = q8_pack(q8_bits_s(xo0[0], qs), q8_bits_s(xo0[1], qs), q8_bits_s(xo0[2], qs), q8_bits_s(xo0[3], qs));
                            const unsigned q1 = q8_pack(q8_bits_s(xo1[0], qs), q8_bits_s(xo1[1], qs), q8_bits_s(xo1[2], qs), q8_bits_s(xo1[3], qs));
                            if (bj == 0) { w8.x = q0; w8.y = q1; } else { w8.z = q0; w8.w = q1; }
                        } else {
                        const f32x4 y0 = xo0 * gm[bj][0], y1 = xo1 * gm[bj][1];
                        u32x4 w; w.x = cvt_pk_f16(y0[0], y0[1]); w.y = cvt_pk_f16(y0[2], y0[3]); w.z = cvt_pk_f16(y1[0], y1[1]); w.w = cvt_pk_f16(y1[2], y1[3]);
                        *(u32x4*)(XG + off + 8 * bj) = w;
                        if (XGq) { const f32x4 z0 = y0 * 8.0f, z1 = y1 * 8.0f; int q0 = 0, q1 = 0;
                            q0 = __builtin_amdgcn_cvt_pk_fp8_f32(z0[0], z0[1], q0, false); q0 = __builtin_amdgcn_cvt_pk_fp8_f32(z0[2], z0[3], q0, true);
                            q1 = __builtin_amdgcn_cvt_pk_fp8_f32(z1[0], z1[1], q1, false); q1 = __builtin_amdgcn_cvt_pk_fp8_f32(z1[2], z1[3], q1, true);
                            if (bj == 0) { w8.x = (unsigned)q0; w8.y = (unsigned)q1; } else { w8.z = (unsigned)q0; w8.w = (unsigned)q1; } } } } }
                if (Q8 && XG) *(u32x4*)((unsigned char*)XG + off) = w8;
                if (!Q8 && XG && XGq) *(u32x4*)(XGq + off) = w8;
                if (m & 1) asm volatile("" ::: "memory"); }
        if (XG) {
#pragma unroll
            for (int ai = 0; ai < 2; ++ai)
#pragma unroll
                for (int m = 0; m < 4; ++m) { float q = ssum[ai][m]; q = rows_sum(q);
                    if (fq == 0) atomicAdd(SSo + row0 + ai * HALF + m * 16, (unsigned long long)(q * 16777216.0f)); }
        }
    }
};
struct EpiSwiGLU {
    static constexpr bool PERM = true, PERM16 = false, PREFETCH = true;
    bf16_t* H; const float* shw; const unsigned long long* SS; const float* CW; const unsigned long long* SSq;
    __device__ __forceinline__ void prefetch(LAS unsigned char* aux, const Unit& u, int wid, int lane) const {
        if (wid < 2) __builtin_amdgcn_global_load_lds((const unsigned*)((const char*)(SS + (size_t)u.pm * BM) + wid * 1024 + lane * 16), (LAS unsigned*)(aux + wid * 1024), 16, 0, 0);
        else if (wid == 2) __builtin_amdgcn_global_load_lds((const unsigned*)((const char*)(shw + (size_t)(u.pm >> 3) * (2 * DFF) + u.pn * BM) + lane * 16), (LAS unsigned*)(aux + 2048), 16, 0, 0);
        else if (wid == 3) __builtin_amdgcn_global_load_lds((const unsigned*)((const char*)(CW + (size_t)(u.pm >> 3) * (2 * DFF) + u.pn * BM) + lane * 16), (LAS unsigned*)(aux + 3072), 16, 0, 0);
        else if (wid < 6) __builtin_amdgcn_global_load_lds((const unsigned*)((const char*)(SSq + (size_t)u.pm * BM) + (wid - 4) * 1024 + lane * 16), (LAS unsigned*)(aux + wid * 1024), 16, 0, 0);
    }
    __device__ __forceinline__ void operator()(const f32x4 (&acc)[2][2][4][2], const Unit& u, int wr, int wc, int fr, int fq, const LAS unsigned char* aux) const {
        const int row0 = u.pm * BM + wr * 64 + fr, f0 = u.pn * 128 + wc * 32 + 8 * fq;
        f32x2 bg[4], cg[4], bu[4], cu[4];
        { const LAS float* sp = (const LAS float*)(aux + 2048) + wc * 32 + 8 * fq;
#pragma unroll
          for (int n = 0; n < 2; ++n) { const f32x4 b0 = *(const LAS f32x4*)(sp + 4 * n) * -1.4426950408889634f, c0 = *(const LAS f32x4*)(sp + 256 + 4 * n) * -1.4426950408889634f;
              const f32x4 b1 = *(const LAS f32x4*)(sp + HALF + 4 * n) * -0.6931471805599453f, c1 = *(const LAS f32x4*)(sp + 256 + HALF + 4 * n) * -0.6931471805599453f;
              bg[2 * n] = (f32x2){b0[0], b0[1]}; bg[2 * n + 1] = (f32x2){b0[2], b0[3]}; cg[2 * n] = (f32x2){c0[0], c0[1]}; cg[2 * n + 1] = (f32x2){c0[2], c0[3]};
              bu[2 * n] = (f32x2){b1[0], b1[1]}; bu[2 * n + 1] = (f32x2){b1[2], b1[3]}; cu[2 * n] = (f32x2){c1[0], c1[1]}; cu[2 * n + 1] = (f32x2){c1[2], c1[3]}; } }
        const LAS unsigned long long* ssl = (const LAS unsigned long long*)aux + wr * 64 + fr;
        const LAS unsigned long long* sql = (const LAS unsigned long long*)(aux + 4096) + wr * 64 + fr;
#pragma unroll
        for (int ai = 0; ai < 2; ++ai)
#pragma unroll
            for (int m = 0; m < 4; ++m) { bf16_t* rowp = H + (size_t)(u.pm * (DFF / 64) + (f0 >> 6)) * (BM * 64) + ((f0 >> 5) & 1) * (BM * 32) + (wr * 64 + fr + ai * HALF + m * 16) * 32 + (f0 & 31);
                const float rs = (Q8_CLIP / 127.0f) * fsqrt(ss_ms(sql[ai * HALF + m * 16]) + EPS) * frsq(ss_ms(ssl[ai * HALF + m * 16]) + EPS);
                const f32x2 rs2 = (f32x2){rs, rs};
                f32x2 g2[4], u2[4], r2[4];
#pragma unroll
                for (int p = 0; p < 4; ++p) { const int n = p >> 1, e = 2 * (p & 1);
                    const f32x2 t0 = (f32x2){(float)__float_as_int(acc[ai][0][m][n][e]), (float)__float_as_int(acc[ai][0][m][n][e + 1])};
                    const f32x2 t1 = (f32x2){(float)__float_as_int(acc[ai][1][m][n][e]), (float)__float_as_int(acc[ai][1][m][n][e + 1])};
                    g2[p] = __builtin_elementwise_fma(t0 * rs2, cg[p], bg[p]); u2[p] = __builtin_elementwise_fma(t1 * rs2, cu[p], bu[p]); }
#pragma unroll
                for (int p = 0; p < 4; ++p) r2[p] = (f32x2){__builtin_amdgcn_exp2f(g2[p].x), __builtin_amdgcn_exp2f(g2[p].y)} + (f32x2){1.0f, 1.0f};
#pragma unroll
                for (int p = 0; p < 4; ++p) r2[p] = (f32x2){__builtin_amdgcn_rcpf(r2[p].x), __builtin_amdgcn_rcpf(r2[p].y)};
                float o[8];
#pragma unroll
                for (int p = 0; p < 4; ++p) { const f32x2 o2 = (g2[p] * r2[p]) * u2[p]; o[2 * p] = o2.x; o[2 * p + 1] = o2.y; }
                u32x4 w; w.x = cvt_pk_bf16(o[0], o[1]); w.y = cvt_pk_bf16(o[2], o[3]); w.z = cvt_pk_bf16(o[4], o[5]); w.w = cvt_pk_bf16(o[6], o[7]);
                __builtin_nontemporal_store(w, (u32x4*)(rowp)); }
    }
};
}

struct Ptrs {
    const float* in[23]; float* out; unsigned char* ws;
};
enum { I_X = 0, I_C, I_RELB, I_WADA, I_BADA, I_GMIX, I_GFFN, I_AWIN, I_AKVG, I_AWUK, I_AWUV, I_AIKG, I_AIKB, I_AWOUT, I_BWIN, I_BBIN, I_BSINK, I_BWOUT, I_BBOUT, I_W1, I_W3, I_W2, I_GFIN };

__device__ __forceinline__ void conv_task(const Ptrs& P, int th, int lane) {
    const int t = th >> 1, half = th & 1;
    int kind, rb, ks, Kd; bf16_t* dst; const float* s0 = nullptr; const float* s1 = nullptr; const float* gk = nullptr; int ld = 0; bool f8 = false, h16 = false;
    if (t < 2112) { const int l = t / 528, r = t % 528; unsigned char* wl = P.ws + WS_W + (size_t)l * W_LAYER;
        if (r < 352) { kind = 1; rb = r >> 2; ks = r & 3; Kd = 1024; dst = (bf16_t*)(wl + W13_OFF); s0 = P.in[I_W1] + (size_t)l * D * DFF; s1 = P.in[I_W3] + (size_t)l * D * DFF; ld = DFF; }
        else { const int r2 = r - 352; kind = 0; rb = r2 / 11; ks = r2 % 11; Kd = DFF; dst = (bf16_t*)(wl + W2_OFF); s0 = P.in[I_W2] + (size_t)l * DFF * D; ld = D; }
    } else { const int t2 = t - 2112, j = t2 / 464, r = t2 % 464; unsigned char* wa = P.ws + WS_WA + (size_t)j * WA_STRIDE; unsigned char* wb = P.ws + WS_WB + (size_t)j * WB_STRIDE;
        if (r < 128) { kind = 2; rb = r >> 2; ks = r & 3; Kd = 1024; dst = (bf16_t*)(wa + WINA_OFF); s0 = P.in[I_AWIN] + (size_t)j * D * A_IN; ld = A_IN; h16 = true; }
        else if (r < 192) { kind = 3; rb = r - 128; ks = 0; Kd = 128; dst = (bf16_t*)(wa + WQA_OFF); s0 = P.in[I_AWUK] + (size_t)j * NH * RK * HD; gk = P.in[I_AKVG] + j * RK; }
        else if (r < 256) { const int r2 = r - 192; kind = 4; rb = r2 >> 2; ks = r2 & 3; Kd = 1024; dst = (bf16_t*)(wa + WUV_OFF); s0 = P.in[I_AWUV] + (size_t)j * NH * RK * HD; gk = P.in[I_AKVG] + j * RK; }
        else if (r < 320) { const int r2 = r - 256; kind = 0; rb = r2 >> 2; ks = r2 & 3; Kd = 1024; dst = (bf16_t*)(wa + WOUTA_OFF); s0 = P.in[I_AWOUT] + (size_t)j * D * D; ld = D; f8 = true; }
        else if (r < 400) { const int r2 = r - 320; kind = 0; rb = r2 >> 2; ks = r2 & 3; Kd = 1024; dst = (bf16_t*)(wb + WINB_OFF); s0 = P.in[I_BWIN] + (size_t)j * D * B_IN; ld = B_IN; h16 = true; }
        else { const int r2 = r - 400; kind = 0; rb = r2 >> 2; ks = r2 & 3; Kd = 1024; dst = (bf16_t*)(wb + WOUTB_OFF); s0 = P.in[I_BWOUT] + (size_t)j * D * D; ld = D; f8 = true; }
    }
    const int n = rb * 64 + lane, k0 = ks * 256;
    bf16_t* drow = dst + (size_t)n * Kd + k0;
    if (kind <= 2) {
        const float* src = s0; int col = n;
        if (kind == 1) { const int c = n & 255, f = (n >> 8) * 128 + (c & 127); src = (c < 128) ? s0 : s1; col = f; }
        if (kind == 2) { if (n >= 1792) { const int c = n - 1792; col = c < 64 ? 1792 + c : (c < 72 ? 1856 + (c - 64) : -1); } }
        const float* sp = src + (size_t)k0 * ld + (col < 0 ? 0 : col);
        for (int kq = 4 * half; kq < 4 * half + 4; ++kq) {
          float vv[4][8];
#pragma unroll
          for (int i = 0; i < 4; ++i)
#pragma unroll
            for (int e = 0; e < 8; ++e) vv[i][e] = __builtin_nontemporal_load(sp + (size_t)((kq * 4 + i) * 8 + e) * ld);
          asm volatile("" ::: "memory");
#pragma unroll
          for (int i = 0; i < 4; ++i) { const int kc = kq * 4 + i;
            float v[8];
#pragma unroll
            for (int e = 0; e < 8; ++e) v[e] = vv[i][e];
            if (col < 0) {
#pragma unroll
                for (int e = 0; e < 8; ++e) v[e] = 0.f; }
            if (f8) {
#pragma unroll
                for (int e = 0; e < 8; ++e) v[e] = __builtin_amdgcn_fmed3f(v[e] * 256.0f, -448.0f, 448.0f);
                int w0 = 0, w1 = 0;
                w0 = __builtin_amdgcn_cvt_pk_fp8_f32(v[0], v[1], w0, false); w0 = __builtin_amdgcn_cvt_pk_fp8_f32(v[2], v[3], w0, true);
                w1 = __builtin_amdgcn_cvt_pk_fp8_f32(v[4], v[5], w1, false); w1 = __builtin_amdgcn_cvt_pk_fp8_f32(v[6], v[7], w1, true);
                u32x2 w; w.x = (unsigned)w0; w.y = (unsigned)w1; *(u32x2*)((unsigned char*)dst + (size_t)n * Kd + k0 + kc * 8) = w;
            } else if (h16) {
            u32x4 w; w.x = cvt_pk_f16(v[0], v[1]); w.y = cvt_pk_f16(v[2], v[3]); w.z = cvt_pk_f16(v[4], v[5]); w.w = cvt_pk_f16(v[6], v[7]);
            *(u32x4*)(drow + kc * 8) = w;
            if (kind == 2 && n < 1024) {
#pragma unroll
                for (int e = 0; e < 8; ++e) v[e] = __builtin_amdgcn_fmed3f(v[e] * 256.0f, -448.0f, 448.0f);
                int w0 = 0, w1 = 0;
                w0 = __builtin_amdgcn_cvt_pk_fp8_f32(v[0], v[1], w0, false); w0 = __builtin_amdgcn_cvt_pk_fp8_f32(v[2], v[3], w0, true);
                w1 = __builtin_amdgcn_cvt_pk_fp8_f32(v[4], v[5], w1, false); w1 = __builtin_amdgcn_cvt_pk_fp8_f32(v[6], v[7], w1, true);
                u32x2 w2; w2.x = (unsigned)w0; w2.y = (unsigned)w1; *(u32x2*)((unsigned char*)dst + WINQ8_OFF + (size_t)n * 1024 + k0 + kc * 8) = w2; }
            } else {
            u32x4 w; w.x = cvt_pk_bf16(v[0], v[1]); w.y = cvt_pk_bf16(v[2], v[3]); w.z = cvt_pk_bf16(v[4], v[5]); w.w = cvt_pk_bf16(v[6], v[7]);
            *(u32x4*)(drow + kc * 8) = w; }
        } }
    } else if (kind == 3) {
        const int h = n >> 8, r = n & 255; const float gs = gk[r] * 8.0f;       const float* sp = s0 + ((size_t)h * RK + r) * HD;
        for (int kc0 = 0; kc0 < ((half || n >= 2048) ? 0 : 16); kc0 += 4) { float v4[4][8];
#pragma unroll
            for (int c = 0; c < 4; ++c) { const int k = (kc0 + c) * 8; const float* sp2 = s0 + ((size_t)(2 * h + (k >> 6)) * RK + r) * HD;
#pragma unroll
                for (int e = 0; e < 8; ++e) v4[c][e] = __builtin_nontemporal_load(sp2 + (k & 63) + e); }
#pragma unroll
            for (int c = 0; c < 4; ++c) { const int kc = kc0 + c; float v[8];
#pragma unroll
                for (int e = 0; e < 8; ++e) v[e] = v4[c][e] * gs;
                u32x4 w; w.x = cvt_pk_bf16(v[0], v[1]); w.y = cvt_pk_bf16(v[2], v[3]); w.z = cvt_pk_bf16(v[4], v[5]); w.w = cvt_pk_bf16(v[6], v[7]);
                *(u32x4*)(drow + kc * 8) = w; } }
    } else {
        const int hh = (n >> 6) & 3, d = n & 63, h = n >> 6;
        for (int kc0 = 16 * half; kc0 < 16 * half + 16; kc0 += 4) { float v4[4][8], g4[4][8];
#pragma unroll
          for (int c = 0; c < 4; ++c) { const int k = k0 + (kc0 + c) * 8;
#pragma unroll
            for (int e = 0; e < 8; ++e) { v4[c][e] = 0.f; g4[c][e] = 0.f; }
            if ((k >> 8) == hh) {
#pragma unroll
                for (int e = 0; e < 8; ++e) { const int r = (k & 255) + e; v4[c][e] = __builtin_nontemporal_load(s0 + ((size_t)h * RK + r) * HD + d); g4[c][e] = gk[r]; } } }
#pragma unroll
          for (int c = 0; c < 4; ++c) { const int kc = kc0 + c; const int k = k0 + kc * 8; float v[8];
#pragma unroll
            for (int e = 0; e < 8; ++e) v[e] = __builtin_amdgcn_fmed3f(v4[c][e] * g4[c][e] * 256.0f, -448.0f, 448.0f);
            int w0 = 0, w1 = 0;
            w0 = __builtin_amdgcn_cvt_pk_fp8_f32(v[0], v[1], w0, false); w0 = __builtin_amdgcn_cvt_pk_fp8_f32(v[2], v[3], w0, true);
            w1 = __builtin_amdgcn_cvt_pk_fp8_f32(v[4], v[5], w1, false); w1 = __builtin_amdgcn_cvt_pk_fp8_f32(v[6], v[7], w1, true);
            u32x2 w; w.x = (unsigned)w0; w.y = (unsigned)w1; *(u32x2*)((unsigned char*)dst + (size_t)n * Kd + k) = w; } }
    }
}
constexpr int N_CONV_TASKS = 6080;

__device__ __forceinline__ void p0_prologue(const Ptrs& P, LAS unsigned char* lds, int G) {
    int tid = tid_now();
    const int lane = tid & 63, wave = __builtin_amdgcn_readfirstlane(tid >> 6);
    const int gw = blockIdx.x * NWAVES + wave, NGW = G * NWAVES;
    for (int t = gw; t < N_CONV_TASKS; t += NGW) conv_task(P, t, lane);
    LAS float* cs = (LAS float*)lds;
    LAS float* red = (LAS float*)(lds + 65536);
    { float cv[BATCH * D / NTHR];
#pragma unroll
      for (int it = 0; it < BATCH * D / NTHR; ++it) cv[it] = P.in[I_C][tid + it * NTHR];
#pragma unroll
      for (int it = 0; it < BATCH * D / NTHR; ++it) { const int i = tid + it * NTHR, b = i >> 10, k = i & 1023; cs[k * 16 + b] = silu_f(cv[it]); } }
    __syncthreads();
    float* mod = (float*)(P.ws + WS_MOD);
    for (int task = blockIdx.x; task < 4 * 96; task += G) {
        const int l = task / 96, j0 = (task % 96) * 64, col = tid & 63, ksl = tid >> 6;
        const float* wp = P.in[I_WADA] + ((size_t)l * D + ksl * 128) * 6144 + j0 + col;
        float a[16];
#pragma unroll
        for (int b = 0; b < 16; ++b) a[b] = 0.f;
#pragma unroll 1
        for (int k0 = 0; k0 < 128; k0 += 16) { float wv[16];
#pragma unroll
            for (int u = 0; u < 16; ++u) wv[u] = __builtin_nontemporal_load(wp + (size_t)(k0 + u) * 6144);
#pragma unroll
            for (int u = 0; u < 16; ++u) { const float w = wv[u]; const LAS f32x4* c4 = (const LAS f32x4*)(cs + (ksl * 128 + k0 + u) * 16);
#pragma unroll
                for (int q = 0; q < 4; ++q) { const f32x4 c = c4[q];
#pragma unroll
                    for (int e = 0; e < 4; ++e) a[4 * q + e] += w * c[e]; } } }
#pragma unroll
        for (int b = 0; b < 16; ++b) red[(ksl * 64 + col) * 16 + b] = a[b];
        __syncthreads();
        for (int o = tid; o < 1024; o += NTHR) { const int c2 = o >> 4, b = o & 15; float s = 0.f;
#pragma unroll
            for (int q = 0; q < 8; ++q) s += red[(q * 64 + c2) * 16 + b];
            mod[((size_t)l * BATCH + b) * 6144 + j0 + c2] = s + P.in[I_BADA][l * 6144 + j0 + c2]; }
        __syncthreads();
    }
}

__device__ __forceinline__ void pre_phase(const Ptrs& P, LAS unsigned char* lds, int G) {
    int tid = tid_now();
    const int lane = tid & 63, wave = __builtin_amdgcn_readfirstlane(tid >> 6);
    const float* mod = (const float*)(P.ws + WS_MOD);
    {
        const int grp = blockIdx.x & 7, l = grp >> 1, kind = grp & 1, j = l >> 1;
        const float* shsrc = mod + (size_t)l * BATCH * 6144 + (kind ? 3072 : 0);
        constexpr int SP = 2064;
        { f32x2 sv[BATCH * D / 2 / NTHR];
#pragma unroll
          for (int it = 0; it < BATCH * D / 2 / NTHR; ++it) { const int i = tid + it * NTHR, b = i >> 9, k2 = (i & 511) * 2; sv[it] = *(const f32x2*)(shsrc + (size_t)b * 6144 + k2); }
#pragma unroll
          for (int it = 0; it < BATCH * D / 2 / NTHR; ++it) { const int i = tid + it * NTHR, b = i >> 9, k2 = (i & 511) * 2;
            *(LAS unsigned*)(lds + b * SP + k2 * 2) = kind ? cvt_pk_bf16(sv[it].x, sv[it].y) : cvt_pk_f16(sv[it].x, sv[it].y); } }
        __syncthreads();
        const bf16_t* W; int nrows; float* dst; const float* bias = nullptr;
        if (kind) { W = (const bf16_t*)(P.ws + WS_W + (size_t)l * W_LAYER + W13_OFF); nrows = 2 * DFF; dst = (float*)(P.ws + WS_SHW + SHW_F) + (size_t)l * BATCH * 2 * DFF; }
        else if ((l & 1) == 0) { W = (const bf16_t*)(P.ws + WS_WA + (size_t)j * WA_STRIDE + WINA_OFF); nrows = 2048; dst = (float*)(P.ws + WS_SHW + SHW_A) + (size_t)j * BATCH * 2048; }
        else { W = (const bf16_t*)(P.ws + WS_WB + (size_t)j * WB_STRIDE + WINB_OFF); nrows = B_IN; dst = (float*)(P.ws + WS_SHW + SHW_B) + (size_t)j * BATCH * B_IN; bias = P.in[I_BBIN] + j * B_IN; }
        const int nblk = nrows >> 4, wq = (blockIdx.x >> 3) * NWAVES + wave, nwq = (G >> 3) * NWAVES;
        const int nn = lane & 15, g = lane >> 4;
        for (int blk = wq; blk < nblk; blk += nwq) {
            f32x4 acc = (f32x4){0.f, 0.f, 0.f, 0.f};
            const bf16_t* wp = W + (size_t)(blk * 16 + nn) * D + 8 * g;
#pragma unroll 8
            for (int ks = 0; ks < 32; ++ks) { const bf16x8 a = *(const LAS bf16x8*)(lds + nn * SP + (32 * ks + 8 * g) * 2); const bf16x8 bw = *(const bf16x8*)(wp + 32 * ks);
                acc = kind ? __builtin_amdgcn_mfma_f32_16x16x32_bf16(a, bw, acc, 0, 0, 0) : __builtin_amdgcn_mfma_f32_16x16x32_f16(__builtin_bit_cast(h16x8, a), __builtin_bit_cast(h16x8, bw), acc, 0, 0, 0); }
            const int n = blk * 16 + nn; const float bb = bias ? bias[n] : 0.f;
#pragma unroll
            for (int i = 0; i < 4; ++i) dst[(size_t)(4 * g + i) * nrows + n] = acc[i] + bb;
        }
    }
    {
        const int gw = blockIdx.x * NWAVES + wave, NGW = G * NWAVES;
        const float* x = P.in[I_X]; const float* gmix = P.in[I_GMIX]; bf16_t* XG = (bf16_t*)(P.ws + WS_XG); unsigned long long* SS0 = (unsigned long long*)(P.ws + WS_SS);
        for (int row0 = gw; row0 < M; row0 += 4 * NGW) {
          f32x4 vr[4][4];
#pragma unroll
          for (int i = 0; i < 4; ++i) { const int row = row0 + i * NGW; const f32x4* xr = (const f32x4*)(x + (size_t)(row < M ? row : row0) * D) + lane;
#pragma unroll
              for (int jj = 0; jj < 4; ++jj) vr[i][jj] = __builtin_nontemporal_load(xr + 64 * jj); }
          asm volatile("" ::: "memory");
#pragma unroll
          for (int i = 0; i < 4; ++i) { const int row = row0 + i * NGW; if (row >= M) break;
            const int b = row >> 11;
            f32x4 v[4]; float sq = 0.f;
#pragma unroll
            for (int jj = 0; jj < 4; ++jj) { v[jj] = vr[i][jj]; sq += (v[jj][0] * v[jj][0] + v[jj][1] * v[jj][1]) + (v[jj][2] * v[jj][2] + v[jj][3] * v[jj][3]); }
            const float ss = wave_sum(sq);
            if (lane == 0) SS0[row] = (unsigned long long)(ss * 16777216.0f);
            const float* mb = mod + (size_t)b * 6144;
            u32x2* o8 = (u32x2*)(XG + (size_t)row * D) + lane; u32x2* x8 = (u32x2*)((bf16_t*)P.out + (size_t)row * D) + lane;
#pragma unroll
            for (int jj = 0; jj < 4; ++jj) { const int c = 4 * lane + 256 * jj;
                const f32x4 y = v[jj] * *(const f32x4*)(gmix + c) * (*(const f32x4*)(mb + 1024 + c) + 1.0f);
                u32x2 w; w.x = cvt_pk_f16(y[0], y[1]); w.y = cvt_pk_f16(y[2], y[3]); o8[64 * jj] = w;
                { int q = 0; q = __builtin_amdgcn_cvt_pk_fp8_f32(y[0] * 8.0f, y[1] * 8.0f, q, false); q = __builtin_amdgcn_cvt_pk_fp8_f32(y[2] * 8.0f, y[3] * 8.0f, q, true);
                  ((unsigned*)((unsigned char*)P.out + OUT_XGQ + (size_t)row * D))[lane + 64 * jj] = (unsigned)q; }
                u32x2 xw; xw.x = cvt_pk_f16(v[jj][0], v[jj][1]); xw.y = cvt_pk_f16(v[jj][2], v[jj][3]); __builtin_nontemporal_store(xw, x8 + 64 * jj); }
          }
        }
    }
}
__device__ __forceinline__ float half_max(float x);
__device__ __forceinline__ float wave_max(float x) {
    const float h = half_max(x);
    const u32x2 r = __builtin_amdgcn_permlane32_swap(__float_as_uint(h), __float_as_uint(h), false, false);
    return fmaxf(__uint_as_float(r.x), __uint_as_float(r.y));
}
template <bool F16>
__device__ __forceinline__ void w8_build(const bf16_t* W13, int nrows, const float* gffn, const float* scn, unsigned char* W8, float* CW, LAS unsigned char* lds, int G) {
    int tid = tid_now();
    const int lane = tid & 63, wave = __builtin_amdgcn_readfirstlane(tid >> 6);
    LAS float* mL = (LAS float*)lds;
    const int gw = blockIdx.x * NWAVES + wave, NGW = G * NWAVES;
    u32x2 pre[3][4];
#define W8_ROWS(N0) { _Pragma("unroll") for (int r = 0; r < 3; ++r) { const int n_ = (N0) + r * NGW; const u32x2* wrow = (const u32x2*)(W13 + (size_t)(n_ < nrows ? n_ : 0) * D) + lane; \
        _Pragma("unroll") for (int j = 0; j < 4; ++j) pre[r][j] = wrow[64 * j]; } }
    W8_ROWS(gw)
    { const int k4 = (tid & 255) * 4; const f32x4 gv = *(const f32x4*)(gffn + k4); f32x4 sv[BATCH * D / 4 / NTHR];
#pragma unroll
      for (int it = 0; it < BATCH * D / 4 / NTHR; ++it) { const int b = (tid + it * NTHR) >> 8; sv[it] = *(const f32x4*)(scn + (size_t)b * 6144 + k4); }
#pragma unroll
      for (int it = 0; it < BATCH * D / 4 / NTHR; ++it) { const int b = (tid + it * NTHR) >> 8; *(LAS f32x4*)(mL + b * D + k4) = gv * (sv[it] + 1.0f); } }
    __syncthreads();
    const size_t bstride = (size_t)nrows * D;
    for (int n0 = gw; n0 < nrows; n0 += 3 * NGW) {
      if (n0 != gw) W8_ROWS(n0)
#pragma unroll
      for (int r = 0; r < 3; ++r) { const int n = n0 + r * NGW;
        if (n >= nrows) break;
        float w[16];
#pragma unroll
        for (int j = 0; j < 4; ++j) { const u32x2 p = pre[r][j];
            if (F16) { const f32x2 pa = unpk_f16(p.x), pb = unpk_f16(p.y); w[4 * j] = pa.x; w[4 * j + 1] = pa.y; w[4 * j + 2] = pb.x; w[4 * j + 3] = pb.y; }
            else { w[4 * j] = __uint_as_float(p.x << 16); w[4 * j + 1] = __uint_as_float(p.x & 0xffff0000u); w[4 * j + 2] = __uint_as_float(p.y << 16); w[4 * j + 3] = __uint_as_float(p.y & 0xffff0000u); } }
        unsigned* orow = (unsigned*)(W8 + (size_t)n * D) + lane;
#pragma unroll 2
        for (int b = 0; b < BATCH; ++b) {
            f32x2 v2[8]; float mx = 0.f;
#pragma unroll
            for (int j = 0; j < 4; ++j) { const f32x4 mm = *(const LAS f32x4*)(mL + b * D + 256 * j + 4 * lane);
                v2[2 * j] = (f32x2){w[4 * j], w[4 * j + 1]} * (f32x2){mm[0], mm[1]}; v2[2 * j + 1] = (f32x2){w[4 * j + 2], w[4 * j + 3]} * (f32x2){mm[2], mm[3]};
                mx = fmaxf(fmaxf(mx, fabsf(v2[2 * j].x)), fabsf(v2[2 * j].y)); mx = fmaxf(fmaxf(mx, fabsf(v2[2 * j + 1].x)), fabsf(v2[2 * j + 1].y)); }
            mx = fmaxf(wave_max(mx), 1e-30f);
            const float inv = 127.0f * __builtin_amdgcn_rcpf(mx);
            const f32x2 inv2 = (f32x2){inv, inv}, mg2 = (f32x2){12582912.0f, 12582912.0f};
#pragma unroll
            for (int j = 0; j < 4; ++j) { const f32x2 q0 = __builtin_elementwise_fma(v2[2 * j], inv2, mg2), q1 = __builtin_elementwise_fma(v2[2 * j + 1], inv2, mg2);
                orow[(size_t)b * (bstride / 4) + 64 * j] = pg8::q8_pack(__float_as_uint(q0.x), __float_as_uint(q0.y), __float_as_uint(q1.x), __float_as_uint(q1.y)); }
            if (lane == 0) CW[(size_t)b * nrows + n] = mx * (1.0f / 127.0f);
        }
      }
    }
#undef W8_ROWS
    __syncthreads();
}
__device__ __forceinline__ void final_norm_phase(const bf16_t* x, float* out, const float* g, int G) {
    int tid = tid_now();
    const int lane = tid & 63, wave = __builtin_amdgcn_readfirstlane(tid >> 6);
    const int gw = blockIdx.x * NWAVES + wave, NGW = G * NWAVES;
    f32x4 gg[4];
#pragma unroll
    for (int j = 0; j < 4; ++j) gg[j] = *(const f32x4*)(g + 4 * lane + 256 * j);
    for (int row0 = gw; row0 < M; row0 += 4 * NGW) {
        u32x2 pr[4][4];
#pragma unroll
        for (int i = 0; i < 4; ++i) { const int row = row0 + i * NGW; const u32x2* xr = (const u32x2*)(x + (size_t)(row < M ? row : row0) * D) + lane;
#pragma unroll
            for (int j = 0; j < 4; ++j) pr[i][j] = __builtin_nontemporal_load(xr + 64 * j); }
        asm volatile("" ::: "memory");
#pragma unroll
        for (int i = 0; i < 4; ++i) { const int row = row0 + i * NGW; f32x4* orow = (f32x4*)(out + (size_t)row * D) + lane;
            f32x4 v[4]; float s = 0.f;
#pragma unroll
            for (int j = 0; j < 4; ++j) { const u32x2 p = pr[i][j];
                { const f32x2 pa = unpk_f16(p.x), pb = unpk_f16(p.y); v[j] = (f32x4){pa.x, pa.y, pb.x, pb.y}; }
                s += (v[j][0] * v[j][0] + v[j][1] * v[j][1]) + (v[j][2] * v[j][2] + v[j][3] * v[j][3]); }
            const float rstd = 1.0f / sqrtf(wave_sum(s) * (1.0f / D) + EPS);
            if (row < M) {
#pragma unroll
                for (int j = 0; j < 4; ++j) orow[64 * j] = v[j] * rstd * gg[j]; } }
    }
}

__device__ __forceinline__ unsigned f2key(float f) { const unsigned u = __float_as_uint(f); return (u & 0x80000000u) ? ~u : (u | 0x80000000u); }
__device__ __forceinline__ float key2f(unsigned k) { return __uint_as_float((k & 0x80000000u) ? (k & 0x7fffffffu) : ~k); }
__device__ __forceinline__ float half_max(float x) {
    int u = __float_as_int(x);
    u = __float_as_int(fmaxf(__int_as_float(u), __int_as_float(__builtin_amdgcn_update_dpp(u, u, 0x128, 0xf, 0xf, false))));
    u = __float_as_int(fmaxf(__int_as_float(u), __int_as_float(__builtin_amdgcn_update_dpp(u, u, 0x124, 0xf, 0xf, false))));
    u = __float_as_int(fmaxf(__int_as_float(u), __int_as_float(__builtin_amdgcn_update_dpp(u, u, 0x122, 0xf, 0xf, false))));
    u = __float_as_int(fmaxf(__int_as_float(u), __int_as_float(__builtin_amdgcn_update_dpp(u, u, 0x121, 0xf, 0xf, false))));
    const u32x2 r = __builtin_amdgcn_permlane16_swap((unsigned)u, (unsigned)u, false, false);
    return fmaxf(__uint_as_float(r.x), __uint_as_float(r.y));
}
__device__ __forceinline__ float half_sum_f(float v) {
    v += __int_as_float(__builtin_amdgcn_update_dpp(__float_as_int(v), __float_as_int(v), 0x128, 0xf, 0xf, false));
    v += __int_as_float(__builtin_amdgcn_update_dpp(__float_as_int(v), __float_as_int(v), 0x124, 0xf, 0xf, false));
    v += __int_as_float(__builtin_amdgcn_update_dpp(__float_as_int(v), __float_as_int(v), 0x122, 0xf, 0xf, false));
    v += __int_as_float(__builtin_amdgcn_update_dpp(__float_as_int(v), __float_as_int(v), 0x121, 0xf, 0xf, false));
    const u32x2 r = __builtin_amdgcn_permlane16_swap(__float_as_uint(v), __float_as_uint(v), false, false);
    return __uint_as_float(r.x) + __uint_as_float(r.y);
}
__device__ __forceinline__ f32x2 pk_gt(f32x2 x, f32x2 big, f32x2 nfbig) { f32x2 d; asm("v_pk_fma_f32 %0, %1, %2, %3 clamp" : "=v"(d) : "v"(x), "v"(big), "v"(nfbig)); return d; }
__device__ __forceinline__ int half_sum(int v) {
    v += __builtin_amdgcn_update_dpp(v, v, 0x128, 0xf, 0xf, false);
    v += __builtin_amdgcn_update_dpp(v, v, 0x124, 0xf, 0xf, false);
    v += __builtin_amdgcn_update_dpp(v, v, 0x122, 0xf, 0xf, false);
    v += __builtin_amdgcn_update_dpp(v, v, 0x121, 0xf, 0xf, false);
    const u32x2 r = __builtin_amdgcn_permlane16_swap((unsigned)v, (unsigned)v, false, false);
    return (int)(r.x + r.y);
}
typedef float f32x32 __attribute__((ext_vector_type(32)));
__device__ __forceinline__ void idx_task(const bf16_t* QI, const bf16_t* KIN, const float* WI, unsigned* SEL, LAS unsigned char* lds, int b, int tg, int lane, int wave, bool active, int kneed,
                                         bool pre, bool has_next, int b_next, int kneed_next) {
    asm volatile("" : "+v"(lane));
    const int t0 = tg * 4, h = lane >> 5, r = lane & 31;
    const int qsel = 2 * (r >> 4) + ((r >> 2) & 1), hd = (r & 3) + 4 * ((r >> 3) & 1);
    const size_t rowb = (size_t)b * SEQ;
    bf16x8 aq[4];
#pragma unroll
    for (int ks = 0; ks < 4; ++ks) aq[ks] = *(const bf16x8*)(QI + (rowb + t0 + qsel) * 512 + hd * 64 + ks * 16 + h * 8);
    float wlo[8], whi[8];
    { const f32x4 a0 = *(const f32x4*)(WI + (rowb + t0 + h) * 8), a1 = *(const f32x4*)(WI + (rowb + t0 + h) * 8 + 4);
      const f32x4 b0 = *(const f32x4*)(WI + (rowb + t0 + 2 + h) * 8), b1 = *(const f32x4*)(WI + (rowb + t0 + 2 + h) * 8 + 4);
#pragma unroll
      for (int e = 0; e < 4; ++e) { wlo[e] = a0[e]; wlo[4 + e] = a1[e]; whi[e] = b0[e]; whi[4 + e] = b1[e]; } }
    f32x32 sA0, sA1, sB0, sB1;
#pragma unroll
    for (int i = 0; i < 32; ++i) { sA0[i] = NEGF; sA1[i] = NEGF; sB0[i] = NEGF; sB1[i] = NEGF; }
    const int ktmax = (t0 + 3) >> 5, tlo = t0 + h, thi = t0 + 2 + h;
    const unsigned lb = (unsigned)(size_t)lds;
    const int sw = (r >> 1) & 7;
#define IDX_LDS4(R0, R1, R2, R3) asm volatile("ds_read_b128 %0, %4\n\tds_read_b128 %1, %5\n\tds_read_b128 %2, %6\n\tds_read_b128 %3, %7" \
                                             : "=&v"(R0), "=&v"(R1), "=&v"(R2), "=&v"(R3) : "v"(a0), "v"(a1), "v"(a2), "v"(a3) : "memory")
#define IDX_TILE(KTL, KEY0, SA, SB, C0, C1, C2, C3, N0, N1, N2, N3) \
        { \
            a0 += 4096u; a1 += 4096u; a2 += 4096u; a3 += 4096u; \
            IDX_LDS4(N0, N1, N2, N3);                          \
            asm volatile("s_waitcnt lgkmcnt(4)" : "+v"(C0), "+v"(C1), "+v"(C2), "+v"(C3) :: "memory");     \
            f32x16 acc; \
            _Pragma("unroll") for (int i = 0; i < 16; ++i) acc[i] = 0.f; \
            acc = __builtin_amdgcn_mfma_f32_32x32x16_f16(__builtin_bit_cast(h16x8, aq[0]), __builtin_bit_cast(h16x8, C0), acc, 0, 0, 0); acc = __builtin_amdgcn_mfma_f32_32x32x16_f16(__builtin_bit_cast(h16x8, aq[1]), __builtin_bit_cast(h16x8, C1), acc, 0, 0, 0); \
            acc = __builtin_amdgcn_mfma_f32_32x32x16_f16(__builtin_bit_cast(h16x8, aq[2]), __builtin_bit_cast(h16x8, C2), acc, 0, 0, 0); acc = __builtin_amdgcn_mfma_f32_32x32x16_f16(__builtin_bit_cast(h16x8, aq[3]), __builtin_bit_cast(h16x8, C3), acc, 0, 0, 0); \
            f32x2 p0 = (f32x2){0.f, 0.f}, p1 = (f32x2){0.f, 0.f};            \
            _Pragma("unroll") for (int i = 0; i < 4; ++i) { \
                const f32x2 r0 = (f32x2){__builtin_amdgcn_fmed3f(acc[2 * i], 0.f, 3.0e38f), __builtin_amdgcn_fmed3f(acc[2 * i + 1], 0.f, 3.0e38f)}; \
                const f32x2 r1 = (f32x2){__builtin_amdgcn_fmed3f(acc[8 + 2 * i], 0.f, 3.0e38f), __builtin_amdgcn_fmed3f(acc[9 + 2 * i], 0.f, 3.0e38f)}; \
                p0 = __builtin_elementwise_fma((f32x2){wlo[2 * i], wlo[2 * i + 1]}, r0, p0); p1 = __builtin_elementwise_fma((f32x2){whi[2 * i], whi[2 * i + 1]}, r1, p1); } \
            const float s0 = p0.x + p0.y, s1 = p1.x + p1.y; \
            const int key = (KEY0) + r; \
            SA[KTL] = key <= tlo ? s0 : NEGF; SB[KTL] = key <= thi ? s1 : NEGF; \
        }
    bf16x8 ta0, ta1, ta2, ta3, tb0, tb1, tb2, tb3;
#pragma unroll
    for (int rnd = 0; rnd < 2; ++rnd) {
        if (1024 * rnd >= kneed) break;
#define IDX_STAGE_RND(ROWB, RND, KNEED) { const int rl = lane >> 3, pp = lane & 7; \
            _Pragma("unroll 4") for (int j = 0; j < 16; ++j) { const int pi = j * 8 + wave, row = 8 * pi + rl;            \
                if (1024 * (RND) + 8 * pi >= (KNEED)) continue;         \
                const bf16_t* src = KIN + ((ROWB) + 1024 * (RND) + row) * 64 + 8 * (pp ^ ((row >> 1) & 7)); \
                __builtin_amdgcn_global_load_lds((const unsigned*)src, (LAS unsigned*)(lds + 1024 * pi), 16, 0, 0); } }
        if (!(rnd == 0 && pre)) {
            __syncthreads();
            IDX_STAGE_RND(rowb, rnd, kneed)
        }
        asm volatile("s_waitcnt vmcnt(0)" ::: "memory");
        __syncthreads();
        const int ntl = ktmax - 32 * rnd + 1;
        if (active && ntl > 0) {
            const int npair = ((ntl < 32 ? ntl : 32) + 1) >> 1;
            unsigned a0 = lb + (unsigned)r * 128u + 16u * (unsigned)((0 + h) ^ sw), a1 = lb + (unsigned)r * 128u + 16u * (unsigned)((2 + h) ^ sw);
            unsigned a2 = lb + (unsigned)r * 128u + 16u * (unsigned)((4 + h) ^ sw), a3 = lb + (unsigned)r * 128u + 16u * (unsigned)((6 + h) ^ sw);
            IDX_LDS4(ta0, ta1, ta2, ta3);
#pragma nounroll
            for (int kp = 0; kp < npair; ++kp) {
                if (rnd == 0) { IDX_TILE(2 * kp, 64 * kp, sA0, sB0, ta0, ta1, ta2, ta3, tb0, tb1, tb2, tb3)
                                IDX_TILE(2 * kp + 1, 64 * kp + 32, sA0, sB0, tb0, tb1, tb2, tb3, ta0, ta1, ta2, ta3) }
                else          { IDX_TILE(2 * kp, 1024 + 64 * kp, sA1, sB1, ta0, ta1, ta2, ta3, tb0, tb1, tb2, tb3)
                                IDX_TILE(2 * kp + 1, 1024 + 64 * kp + 32, sA1, sB1, tb0, tb1, tb2, tb3, ta0, ta1, ta2, ta3) }
            }
            asm volatile("s_waitcnt lgkmcnt(0)" : "+v"(ta0), "+v"(ta1), "+v"(ta2), "+v"(ta3), "+v"(tb0), "+v"(tb1), "+v"(tb2), "+v"(tb3) :: "memory");
        }
    }
#undef IDX_TILE
#undef IDX_LDS4
    if (has_next) {
        __syncthreads();
        IDX_STAGE_RND((size_t)b_next * SEQ, 0, kneed_next)
    }
#undef IDX_STAGE_RND
    if (!active) return;
    const int nt0 = ktmax < 31 ? ktmax + 1 : 32, nt1 = ktmax - 31;
    float mxA = NEGF, mxB = NEGF, mnA = -NEGF, mnB = -NEGF;
    float smA = 0.f, smB = 0.f, sqA = 0.f, sqB = 0.f;
#pragma nounroll
    for (int kt = 0; kt < nt0; ++kt) { const float a = sA0[kt], bb = sB0[kt]; const float az = a > -1e29f ? a : 0.f, bz = bb > -1e29f ? bb : 0.f;
        smA += az; smB += bz; sqA = fmaf(az, az, sqA); sqB = fmaf(bz, bz, sqB);
        mxA = fmaxf(mxA, a); mxB = fmaxf(mxB, bb); mnA = fminf(mnA, a > -1e29f ? a : -NEGF); mnB = fminf(mnB, bb > -1e29f ? bb : -NEGF); }
#pragma nounroll
    for (int kt = 0; kt < nt1; ++kt) { const float a = sA1[kt], bb = sB1[kt]; const float az = a > -1e29f ? a : 0.f, bz = bb > -1e29f ? bb : 0.f;
        smA += az; smB += bz; sqA = fmaf(az, az, sqA); sqB = fmaf(bz, bz, sqB);
        mxA = fmaxf(mxA, a); mxB = fmaxf(mxB, bb); mnA = fminf(mnA, a > -1e29f ? a : -NEGF); mnB = fminf(mnB, bb > -1e29f ? bb : -NEGF); }
    mxA = half_max(mxA); mxB = half_max(mxB); mnA = -half_max(-mnA); mnB = -half_max(-mnB);
    float T1A, idA, T1B, idB;
    { const float nA = (float)(tlo + 1), nB = (float)(thi + 1);
      const float muA = half_sum_f(smA) * __builtin_amdgcn_rcpf(nA), muB = half_sum_f(smB) * __builtin_amdgcn_rcpf(nB);
      const float sdA = sqrtf(fmaxf(half_sum_f(sqA) * __builtin_amdgcn_rcpf(nA) - muA * muA, 1e-20f)), sdB = sqrtf(fmaxf(half_sum_f(sqB) * __builtin_amdgcn_rcpf(nB) - muB * muB, 1e-20f));
      const float qA = fminf((float)TOPK * __builtin_amdgcn_rcpf(nA), 1.0f), qB = fminf((float)TOPK * __builtin_amdgcn_rcpf(nB), 1.0f);
      const float tA = sqrtf(-2.0f * __logf(fmaxf(fminf(qA, 1.0f - qA), 1e-6f))), tB = sqrtf(-2.0f * __logf(fmaxf(fminf(qB, 1.0f - qB), 1e-6f)));
      float zA = tA - (2.515517f + tA * (0.802853f + 0.010328f * tA)) * __builtin_amdgcn_rcpf(1.0f + tA * (1.432788f + tA * (0.189269f + 0.001308f * tA)));
      float zB = tB - (2.515517f + tB * (0.802853f + 0.010328f * tB)) * __builtin_amdgcn_rcpf(1.0f + tB * (1.432788f + tB * (0.189269f + 0.001308f * tB)));
      zA = qA > 0.5f ? -zA : zA; zB = qB > 0.5f ? -zB : zB;
      T1A = muA + zA * sdA; T1B = muB + zB * sdB;
      idA = sdA * 2.5066283f * __expf(0.5f * zA * zA) * __builtin_amdgcn_rcpf(nA); idB = sdB * 2.5066283f * __expf(0.5f * zB * zB) * __builtin_amdgcn_rcpf(nB); }
    const int Ka = tlo + 1 < TOPK ? tlo + 1 : TOPK, Kb = thi + 1 < TOPK ? thi + 1 : TOPK;
    float loA = mnA - (fabsf(mnA) * 1e-6f + 1e-30f), hiA = mxA, loB = mnB - (fabsf(mnB) * 1e-6f + 1e-30f), hiB = mxB;
    float cloA = (float)(tlo + 1), chiA = 0.0f, cloB = (float)(thi + 1), chiB = 0.0f;
    float TA = -1e29f, TB = -1e29f; bool doneA = (tlo + 1 <= TOPK), doneB = (thi + 1 <= TOPK);
    const int nblk = (ktmax >> 3) + 1;
    const float BIG = 1099511627776.0f;
#define SA2(i) ((i) < 32 ? (f32x2){sA0[(i) & 31], sA0[((i) & 31) + 1]} : (f32x2){sA1[(i) & 31], sA1[((i) & 31) + 1]})
#define SB2(i) ((i) < 32 ? (f32x2){sB0[(i) & 31], sB0[((i) & 31) + 1]} : (f32x2){sB1[(i) & 31], sB1[((i) & 31) + 1]})
#pragma nounroll
    for (int it = 0; it < 48; ++it) {
        if (__ballot(!doneA || !doneB) == 0ull) break;
        const bool bis = (it % 3) == 2;
        const float wA = hiA - loA, wB = hiB - loB;
        float rA = bis ? 0.5f : (cloA - (float)Ka + 0.5f) * __builtin_amdgcn_rcpf(cloA - chiA + 1.0f), rB = bis ? 0.5f : (cloB - (float)Kb + 0.5f) * __builtin_amdgcn_rcpf(cloB - chiB + 1.0f);
        rA = fminf(fmaxf(rA, 0.03f), 0.97f); rB = fminf(fmaxf(rB, 0.03f), 0.97f);
        float midA = loA + wA * rA, midB = loB + wB * rB;
        if (it < 2) {
            const float gA = it == 0 ? T1A : T1A + (((loA == T1A) ? cloA : chiA) - (float)Ka) * idA, gB = it == 0 ? T1B : T1B + (((loB == T1B) ? cloB : chiB) - (float)Kb) * idB;
            midA = (gA > loA + 0.03f * wA && gA < hiA - 0.03f * wA) ? gA : midA; midB = (gB > loB + 0.03f * wB && gB < hiB - 0.03f * wB) ? gB : midB;
        }
        const float fA = doneA ? TA : midA, fB = doneB ? TB : midB;
        const f32x2 bigp = (f32x2){BIG, BIG}, nfA = (f32x2){-fA * BIG, -fA * BIG}, nfB = (f32x2){-fB * BIG, -fB * BIG};
        f32x2 cA2 = (f32x2){0.f, 0.f}, cB2 = (f32x2){0.f, 0.f};
#pragma unroll
        for (int blk = 0; blk < 8; ++blk) {
            if (blk < nblk) {
#pragma unroll
                for (int e = 0; e < 4; ++e) { cA2 += pk_gt(SA2(8 * blk + 2 * e), bigp, nfA); cB2 += pk_gt(SB2(8 * blk + 2 * e), bigp, nfB); }
            }
        }
        const int cA = (int)half_sum_f(cA2.x + cA2.y), cB = (int)half_sum_f(cB2.x + cB2.y);
        const bool stuckA = !(midA > loA && midA < hiA), stuckB = !(midB > loB && midB < hiB);
        if (!doneA) { if (cA == Ka) { TA = fA; doneA = true; } else if (stuckA) { TA = loA; doneA = true; } else if (cA > Ka) { loA = midA; cloA = (float)cA; } else { hiA = midA; chiA = (float)cA; } }
        if (!doneB) { if (cB == Kb) { TB = fB; doneB = true; } else if (stuckB) { TB = loB; doneB = true; } else if (cB > Kb) { loB = midB; cloB = (float)cB; } else { hiB = midB; chiB = (float)cB; } }
    }
#undef SA2
#undef SB2
    if (!doneA) TA = loA;
    if (!doneB) TB = loB;
    unsigned w0 = 0u, w1 = 0u, w2 = 0u, w3 = 0u;
#pragma nounroll
    for (int kt = 0; kt < nt0; ++kt) { const unsigned long long ma = __ballot(sA0[kt] > TA), mb = __ballot(sB0[kt] > TB);
        if (lane == kt) { w0 = (unsigned)ma; w1 = (unsigned)(ma >> 32); w2 = (unsigned)mb; w3 = (unsigned)(mb >> 32); } }
#pragma nounroll
    for (int kt = 0; kt < nt1; ++kt) { const unsigned long long ma = __ballot(sA1[kt] > TA), mb = __ballot(sB1[kt] > TB);
        if (lane == 32 + kt) { w0 = (unsigned)ma; w1 = (unsigned)(ma >> 32); w2 = (unsigned)mb; w3 = (unsigned)(mb >> 32); } }
    SEL[(rowb + t0 + 0) * 64 + lane] = w0; SEL[(rowb + t0 + 1) * 64 + lane] = w1; SEL[(rowb + t0 + 2) * 64 + lane] = w2; SEL[(rowb + t0 + 3) * 64 + lane] = w3;
}

#define ATT_F(r) (((r) & 3) | ((((r) >> 3) & 3) << 2))
#define TRB8(OFS, r0, r1, r2, r3, r4, r5, r6, r7, a0, a1, a2, a3, a4, a5, a6, a7) \
    asm volatile("ds_read_b64_tr_b16 %0, %8 offset:" OFS "\n\tds_read_b64_tr_b16 %1, %9 offset:" OFS "\n\tds_read_b64_tr_b16 %2, %10 offset:" OFS "\n\tds_read_b64_tr_b16 %3, %11 offset:" OFS "\n\t" \
                 "ds_read_b64_tr_b16 %4, %12 offset:" OFS "\n\tds_read_b64_tr_b16 %5, %13 offset:" OFS "\n\tds_read_b64_tr_b16 %6, %14 offset:" OFS "\n\tds_read_b64_tr_b16 %7, %15 offset:" OFS "\n\ts_waitcnt lgkmcnt(0)" \
                 : "=&v"(r0), "=&v"(r1), "=&v"(r2), "=&v"(r3), "=&v"(r4), "=&v"(r5), "=&v"(r6), "=&v"(r7) \
                 : "v"(a0), "v"(a1), "v"(a2), "v"(a3), "v"(a4), "v"(a5), "v"(a6), "v"(a7) : "memory")
#define RDK8(OFS, r, a) \
    asm volatile("ds_read_b64 %0, %8 offset:" OFS "\n\tds_read_b64 %1, %9 offset:" OFS "\n\tds_read_b64 %2, %10 offset:" OFS "\n\tds_read_b64 %3, %11 offset:" OFS "\n\t" \
                 "ds_read_b64 %4, %12 offset:" OFS "\n\tds_read_b64 %5, %13 offset:" OFS "\n\tds_read_b64 %6, %14 offset:" OFS "\n\tds_read_b64 %7, %15 offset:" OFS "\n\ts_waitcnt lgkmcnt(0)" \
                 : "=&v"(r[0]), "=&v"(r[1]), "=&v"(r[2]), "=&v"(r[3]), "=&v"(r[4]), "=&v"(r[5]), "=&v"(r[6]), "=&v"(r[7]) \
                 : "v"(a[0]), "v"(a[1]), "v"(a[2]), "v"(a[3]), "v"(a[4]), "v"(a[5]), "v"(a[6]), "v"(a[7]) : "memory")
__device__ __forceinline__ float rows_max(float x) {
    unsigned u = __float_as_uint(x);
    u32x2 r = __builtin_amdgcn_permlane16_swap(u, u, false, false);
    u = __float_as_uint(fmaxf(__uint_as_float(r.x), __uint_as_float(r.y)));
    r = __builtin_amdgcn_permlane32_swap(u, u, false, false);
    return fmaxf(__uint_as_float(r.x), __uint_as_float(r.y));
}
__device__ __forceinline__ float rows_sum(float x) {
    unsigned u = __float_as_uint(x);
    u32x2 r = __builtin_amdgcn_permlane16_swap(u, u, false, false);
    u = __float_as_uint(__uint_as_float(r.x) + __uint_as_float(r.y));
    r = __builtin_amdgcn_permlane32_swap(u, u, false, false);
    return __uint_as_float(r.x) + __uint_as_float(r.y);
}

__device__ __forceinline__ int att_build_list(LAS unsigned* list, const LAS unsigned* btab, unsigned w, int t, int lane) {
    const int pc = __popc(w); int incl = pc;
    incl += __builtin_amdgcn_update_dpp(0, incl, 0x111, 0xf, 0xf, true);
    incl += __builtin_amdgcn_update_dpp(0, incl, 0x112, 0xf, 0xf, true);
    incl += __builtin_amdgcn_update_dpp(0, incl, 0x114, 0xf, 0xf, true);
    incl += __builtin_amdgcn_update_dpp(0, incl, 0x118, 0xf, 0xf, true);
    { const int r0 = __builtin_amdgcn_readlane(incl, 15), r1 = __builtin_amdgcn_readlane(incl, 31), r2 = __builtin_amdgcn_readlane(incl, 47);
      incl += (lane >= 16 ? r0 : 0) + (lane >= 32 ? r1 : 0) + (lane >= 48 ? r2 : 0); }
    const int total = __builtin_amdgcn_readlane(incl, 63); const int cnt = total < TOPK ? total : TOPK;
    int off = incl - pc;
    while (w) { const int bit = __builtin_ctz(w); w &= w - 1u;
        if (off < TOPK) { const int idx = 32 * lane + bit; int dd = t - idx; dd = dd < 0 ? 0 : (dd > 128 ? 128 : dd); list[off] = ((unsigned)idx << 8) | (btab[dd] << 24); }
        ++off; }
    for (int sl = cnt + lane; sl < ((cnt + 63) & ~63); sl += 64) list[sl] = 0u;
    return cnt;
}
__device__ __forceinline__ void att_gather32(const unsigned char* CKV8b, const LAS unsigned* list32, LAS unsigned char* slot, int lane) {
    const LAS unsigned* lp = list32 + (lane >> 4);
    unsigned off[8];
#pragma unroll
    for (int i = 0; i < 8; ++i) off[i] = lp[4 * i] & 0xffffffu;
    asm volatile("" : "+s"(CKV8b));
#pragma unroll
    for (int i = 0; i < 8; ++i) {
        const int rr = 4 * i + (lane >> 4);
        __builtin_amdgcn_global_load_lds((const unsigned*)(CKV8b + (off[i] + 16u * (unsigned)((lane & 15) ^ ATT_F(rr)))), (LAS unsigned*)(slot + 1024 * i), 16, 0, 0);
    }
}

#define ATT_T(q) (((q) & 2047) ^ (((q) >> 11) ? 255 : 0))
__device__ __forceinline__ void att_wave(const unsigned char* CKV8, const unsigned* SEL, unsigned char* BIG, LAS unsigned char* kvbuf, LAS unsigned* lists, const LAS float* relb, const LAS unsigned* btab,
                                         int xcd, int wx, int nwx, int lane) {
    asm volatile("" : "+v"(lane));
    const int hq = lane & 15, g = lane >> 4;
    const int nq = (2 * SEQ - wx + nwx - 1) / nwx;
    if (nq <= 0) return;
    const unsigned kvb = (unsigned)(size_t)kvbuf;
    unsigned qa[8];
#pragma unroll
    for (int ks = 0; ks < 8; ++ks) qa[ks] = kvb + (unsigned)(8 * (hq >> 2) + (hq & 3)) * 256u + 16u * (unsigned)((2 * ks + (g >> 1)) ^ ATT_F(8 * (hq >> 2) + (hq & 3))) + 8u * (unsigned)(g & 1);
    const int trow = 8 * g + (hq >> 1);
    unsigned ta[16];
#pragma unroll
    for (int nt = 0; nt < 16; ++nt) ta[nt] = kvb + (unsigned)trow * 256u + 16u * (unsigned)(nt ^ ATT_F(trow)) + 8u * (unsigned)(hq & 1);

    int q = wx, b = 2 * xcd + (q >> 11), t = ATT_T(q);
    size_t row = (size_t)b * SEQ + t;
    unsigned wsel = SEL[row * 64 + lane];
    int cnt = att_build_list(lists, btab, wsel, t, lane);
    unsigned wnext = 0u;
    if (nq > 1) { const int q1 = wx + nwx; wnext = SEL[((size_t)(2 * xcd + (q1 >> 11)) * SEQ + ATT_T(q1)) * 64 + lane]; }
    long bq[8];
    u32x4 Lq[4];
#define ATT_QLOAD(ROW) { const unsigned char* qp_ = BIG + (ROW) * 8192 + hq * 256 + 16 * g; \
        _Pragma("unroll") for (int i = 0; i < 4; ++i) Lq[i] = *(const u32x4*)(qp_ + 64 * i); }
#define ATT_QSWAP() { _Pragma("unroll") for (int i = 0; i < 4; ++i) { \
        const u32x2 s0_ = __builtin_amdgcn_permlane16_swap(Lq[i].x, Lq[i].z, false, false), s1_ = __builtin_amdgcn_permlane16_swap(Lq[i].y, Lq[i].w, false, false); \
        const u32x2 t0_ = __builtin_amdgcn_permlane32_swap(s0_.x, s0_.y, false, false), t1_ = __builtin_amdgcn_permlane32_swap(s1_.x, s1_.y, false, false); \
        bq[2 * i] = (long)(((unsigned long long)t1_.x << 32) | (unsigned long long)t0_.x); bq[2 * i + 1] = (long)(((unsigned long long)t1_.y << 32) | (unsigned long long)t0_.y); } }
    ATT_QLOAD(row)
    ATT_QSWAP()
    asm volatile("s_waitcnt lgkmcnt(0)" ::: "memory");
    att_gather32(CKV8 + (size_t)b * SEQ * RK, lists, kvbuf, lane);
#define TR8B(r, a, o, OFS) asm volatile("ds_read_b64_tr_b8 %0, %8 offset:" OFS "\n\tds_read_b64_tr_b8 %1, %9 offset:" OFS "\n\tds_read_b64_tr_b8 %2, %10 offset:" OFS "\n\tds_read_b64_tr_b8 %3, %11 offset:" OFS "\n\t" \
                                   "ds_read_b64_tr_b8 %4, %12 offset:" OFS "\n\tds_read_b64_tr_b8 %5, %13 offset:" OFS "\n\tds_read_b64_tr_b8 %6, %14 offset:" OFS "\n\tds_read_b64_tr_b8 %7, %15 offset:" OFS "\n\ts_waitcnt lgkmcnt(0)" \
                                   : "=&v"(r[0]), "=&v"(r[1]), "=&v"(r[2]), "=&v"(r[3]), "=&v"(r[4]), "=&v"(r[5]), "=&v"(r[6]), "=&v"(r[7]) \
                                   : "v"(a[o + 0]), "v"(a[o + 1]), "v"(a[o + 2]), "v"(a[o + 3]), "v"(a[o + 4]), "v"(a[o + 5]), "v"(a[o + 6]), "v"(a[o + 7]) : "memory")
#define ATT_SUB(QO0, QO1, NEXT_OFF, CAN_BE_LAST) { \
            const bool lastc = CAN_BE_LAST && (sc + 1 == nsub); \
            float bias[8]; \
            _Pragma("unroll") for (int T = 0; T < 2; ++T) { const u32x4 mt = *(const LAS u32x4*)(list + 32 * sc + 8 * g + 4 * T); \
                _Pragma("unroll") for (int i = 0; i < 4; ++i) bias[4 * T + i] = relb[(mt[i] >> 24) * 16 + hq]; } \
            if (!lastc) { att_gather32(CKV8 + (size_t)b * SEQ * RK, list + 32 * (sc + 1), kvbuf + NEXT_OFF, lane); asm volatile("s_waitcnt vmcnt(8)" ::: "memory"); } \
            else if (has_next) { att_gather32(CKV8 + (size_t)bn * SEQ * RK, lists + (cur ^ 1) * 256, kvbuf + NEXT_OFF, lane); asm volatile("s_waitcnt vmcnt(8)" ::: "memory"); } \
            else { asm volatile("s_waitcnt vmcnt(0)" ::: "memory"); } \
            f32x4 st0 = (f32x4){0.f, 0.f, 0.f, 0.f}, st1 = st0; \
            { long kr[8]; \
              RDK8(QO0, kr, qa); \
              _Pragma("unroll") for (int ks = 0; ks < 8; ++ks) st0 = __builtin_amdgcn_mfma_f32_16x16x32_fp8_fp8(kr[ks], bq[ks], st0, 0, 0, 0); \
              RDK8(QO1, kr, qa); \
              _Pragma("unroll") for (int ks = 0; ks < 8; ++ks) st1 = __builtin_amdgcn_mfma_f32_16x16x32_fp8_fp8(kr[ks], bq[ks], st1, 0, 0, 0); } \
            if (lastc && has_next) ATT_QLOAD(rown)        \
            float lg[8]; float cmax; \
            _Pragma("unroll") for (int i = 0; i < 4; ++i) { lg[i] = st0[i] * (1.0f / 64.0f) + bias[i]; lg[4 + i] = st1[i] * (1.0f / 64.0f) + bias[4 + i]; } \
            if (32 * sc + 32 > cnt) { \
                _Pragma("unroll") for (int i = 0; i < 4; ++i) { const int s0 = 32 * sc + 8 * g + i; lg[i] = (s0 < cnt) ? lg[i] : NEGF; lg[4 + i] = (s0 + 4 < cnt) ? lg[4 + i] : NEGF; } } \
            cmax = fmaxf(fmaxf(fmaxf(lg[0], lg[1]), fmaxf(lg[2], lg[3])), fmaxf(fmaxf(lg[4], lg[5]), fmaxf(lg[6], lg[7]))); \
            cmax = rows_max(cmax); \
            if (__ballot(cmax > mref + 3.0f) != 0ull) { \
                const float mnew = fmaxf(mref, cmax), scl = fast_exp(mref - mnew); \
                lsum *= scl; \
                _Pragma("unroll") for (int nt = 0; nt < 16; ++nt) O[nt] = O[nt] * scl; \
                mref = mnew; \
            } \
            float p[8]; \
            _Pragma("unroll") for (int i = 0; i < 8; ++i) { p[i] = fast_exp(lg[i] - mref); lsum += p[i]; } \
            int pw0 = 0, pw1 = 0; \
            pw0 = __builtin_amdgcn_cvt_pk_fp8_f32(p[0] * 16.0f, p[1] * 16.0f, pw0, false); pw0 = __builtin_amdgcn_cvt_pk_fp8_f32(p[2] * 16.0f, p[3] * 16.0f, pw0, true); \
            pw1 = __builtin_amdgcn_cvt_pk_fp8_f32(p[4] * 16.0f, p[5] * 16.0f, pw1, false); pw1 = __builtin_amdgcn_cvt_pk_fp8_f32(p[6] * 16.0f, p[7] * 16.0f, pw1, true); \
            const long pk = (long)(((unsigned long long)(unsigned)pw1 << 32) | (unsigned long long)(unsigned)pw0); \
            { long kt[8]; \
              TR8B(kt, ta, 0, QO0); \
              _Pragma("unroll") for (int e = 0; e < 8; ++e) O[e] = __builtin_amdgcn_mfma_f32_16x16x32_fp8_fp8(kt[e], pk, O[e], 0, 0, 0); \
              TR8B(kt, ta, 8, QO0); \
              _Pragma("unroll") for (int e = 0; e < 8; ++e) O[8 + e] = __builtin_amdgcn_mfma_f32_16x16x32_fp8_fp8(kt[e], pk, O[8 + e], 0, 0, 0); } \
            ++sc; }
    for (int k = 0; k < nq; ++k) {
        const int cur = k & 1;
        LAS unsigned* list = lists + cur * 256;
        const bool has_next = (k + 1 < nq);
        const int qn = q + nwx, bn = 2 * xcd + (qn >> 11), tn = ATT_T(qn);
        const size_t rown = (size_t)bn * SEQ + tn;
        int cntn = 0;
        if (has_next) { cntn = att_build_list(lists + (cur ^ 1) * 256, btab, wnext, tn, lane);
            if (k + 2 < nq) { const int q2 = qn + nwx; wnext = SEL[((size_t)(2 * xcd + (q2 >> 11)) * SEQ + ATT_T(q2)) * 64 + lane]; } }
        f32x4 O[16];
#pragma unroll
        for (int nt = 0; nt < 16; ++nt) O[nt] = (f32x4){0.f, 0.f, 0.f, 0.f};
        float mref = NEGF, lsum = 0.f;
        const int nsub = 2 * ((cnt + 63) >> 6);
        for (int sc = 0; sc < nsub;) {
            ATT_SUB("0", "1024", 8192, false)
            ATT_SUB("8192", "9216", 0, true)
        }
        lsum = rows_sum(lsum);
        const float inv = 1.0f / lsum;
        { LAS unsigned char* ob = kvbuf + 8192;
#pragma unroll
          for (int nt = 0; nt < 16; ++nt) { const f32x4 o = O[nt] * inv; int wv = 0; wv = __builtin_amdgcn_cvt_pk_fp8_f32(o[0], o[1], wv, false); wv = __builtin_amdgcn_cvt_pk_fp8_f32(o[2], o[3], wv, true);
              *(LAS unsigned*)(ob + hq * 256 + 16 * (nt ^ hq) + 4 * g) = (unsigned)wv; }
          unsigned char* orow = BIG + row * 8192 + lane * 16;
#pragma unroll
          for (int j = 0; j < 4; ++j) { const int h = 4 * j + (lane >> 4); const u32x4 v = *(const LAS u32x4*)(ob + h * 256 + 16 * ((lane & 15) ^ h)); *(u32x4*)(orow + j * 1024) = v; }
          asm volatile("s_waitcnt lgkmcnt(0)" ::: "memory"); }
        if (has_next) ATT_QSWAP()
        q = qn; b = bn; t = tn; row = rown; cnt = cntn;
    }
#undef ATT_SUB
#undef ATT_QLOAD
#undef ATT_QSWAP
#undef TR8B
}

constexpr int SW_KP = 144, SW_VP = 520;
constexpr int SW_K_OFF = 0, SW_V_OFF = 256 * SW_KP, SW_TB_OFF = SW_V_OFF + 64 * SW_VP;
__device__ __forceinline__ void swa_phase(const bf16_t* QKV, bf16_t* OB, const float* relb, const float* sinks, LAS unsigned char* lds, int G) {
    int tid = tid_now();
    const int lane = tid & 63, wave = __builtin_amdgcn_readfirstlane(tid >> 6);
    const int h = lane >> 5, n = lane & 31;
    LAS float* tb = (LAS float*)(lds + SW_TB_OFF);
    for (int u = blockIdx.x; u < BATCH * 16 * KVH; u += G) {
        const int b = u >> 5, nb = (u >> 1) & 15, kvh = u & 1;
        const size_t rowb = (size_t)b * SEQ;
        __syncthreads();
#pragma unroll
        for (int e = 0; e < 4; ++e) { const int id = tid + NTHR * e, j = id >> 3, ch = id & 7; const int pos = (nb - 1) * WIN + j;
            u32x4 kv = (u32x4){0u, 0u, 0u, 0u}, vv = (u32x4){0u, 0u, 0u, 0u};
            if (pos >= 0) { const bf16_t* sp = QKV + (rowb + pos) * B_IN + 1024 + kvh * 64 + ch * 8; kv = *(const u32x4*)sp; vv = *(const u32x4*)(sp + 128); }
            *(LAS u32x4*)(lds + SW_K_OFF + j * SW_KP + ch * 16) = kv;
            LAS bf16_t* vt = (LAS bf16_t*)(lds + SW_V_OFF + (ch * 8) * SW_VP + j * 2);
#pragma unroll
            for (int q = 0; q < 4; ++q) { vt[(2 * q) * (SW_VP / 2)] = (bf16_t)(vv[q] & 0xffffu); vt[(2 * q + 1) * (SW_VP / 2)] = (bf16_t)(vv[q] >> 16); } }
        for (int i = tid; i < GQ * 192; i += NTHR) { const int gg = i / 192, x = i - gg * 192; int dist = x - 31; dist = dist < 0 ? 0 : (dist > 127 ? 127 : dist);
            tb[i] = relb[t5_bucket(dist) * NH + kvh * GQ + gg] * 1.4426950408889634f; }
        __syncthreads();
        const int qh = kvh * GQ + wave; const float sink = sinks[qh];
        bf16x8 bqn[4];
#pragma unroll
        for (int ks = 0; ks < 4; ++ks) bqn[ks] = *(const bf16x8*)(QKV + (rowb + nb * WIN + n) * B_IN + qh * 64 + 16 * ks + 8 * h);
        for (int rt = 0; rt < 4; ++rt) {
            const size_t qrow = rowb + nb * WIN + 32 * rt + n;
            bf16x8 bq[4];
#pragma unroll
            for (int ks = 0; ks < 4; ++ks) bq[ks] = bqn[ks];
            { const size_t qrown = rowb + nb * WIN + 32 * (rt < 3 ? rt + 1 : rt) + n;
#pragma unroll
              for (int ks = 0; ks < 4; ++ks) bqn[ks] = *(const bf16x8*)(QKV + qrown * B_IN + qh * 64 + 16 * ks + 8 * h); }
            f32x16 s[5];
#pragma unroll
            for (int ct = 0; ct < 5; ++ct) {
#pragma unroll
                for (int i = 0; i < 16; ++i) s[ct][i] = 0.f;
#pragma unroll
                for (int ks = 0; ks < 4; ++ks) { const bf16x8 a = *(const LAS bf16x8*)(lds + SW_K_OFF + (32 * (rt + ct) + n) * SW_KP + (2 * ks + h) * 16);
                    s[ct] = __builtin_amdgcn_mfma_f32_32x32x16_bf16(a, bq[ks], s[ct], 0, 0, 0); } }
            const int nm = n - 4 * h;
            const LAS float* tbl = tb + wave * 192 + (n + 4 - 4 * h);
            const float SC = 0.125f * 1.4426950408889634f, sinkl = sink * 1.4426950408889634f;
            float mx = NEGF;
#pragma unroll
            for (int ct = 0; ct < 5; ++ct) {
                if (nb == 0 && rt + ct < 4) {
#pragma unroll
                    for (int i = 0; i < 16; ++i) s[ct][i] = NEGF;
                } else {
#pragma unroll
                    for (int i = 0; i < 16; ++i) { const int joff = (i & 3) + 8 * (i >> 2);
                        float v = fmaf(s[ct][i], SC, tbl[155 - 32 * ct - joff]);
                        if (ct == 0) v = (nm < joff) ? v : NEGF;
                        if (ct == 4) v = (nm >= joff) ? v : NEGF;
                        s[ct][i] = v; mx = fmaxf(mx, v); }
                }
            }
            { const u32x2 r_ = __builtin_amdgcn_permlane32_swap(__float_as_uint(mx), __float_as_uint(mx), false, false); mx = fmaxf(__uint_as_float(r_.x), __uint_as_float(r_.y)); } mx = fmaxf(mx, sinkl);
            float sum;
            { f32x2 sum2 = (f32x2){0.f, 0.f}; const f32x2 nmx2 = (f32x2){-mx, -mx};
#pragma unroll
              for (int ct = 0; ct < 5; ++ct)
#pragma unroll
                for (int i = 0; i < 16; i += 2) { const f32x2 x2 = (f32x2){s[ct][i], s[ct][i + 1]} + nmx2;
                    const f32x2 p2 = (f32x2){__builtin_amdgcn_exp2f(x2.x), __builtin_amdgcn_exp2f(x2.y)}; s[ct][i] = p2.x; s[ct][i + 1] = p2.y; sum2 += p2; }
              sum = sum2.x + sum2.y; }
            { const u32x2 r_ = __builtin_amdgcn_permlane32_swap(__float_as_uint(sum), __float_as_uint(sum), false, false); sum = __uint_as_float(r_.x) + __uint_as_float(r_.y); } sum += __builtin_amdgcn_exp2f(sinkl - mx);
            f32x16 o[2];
#pragma unroll
            for (int dt = 0; dt < 2; ++dt)
#pragma unroll
                for (int i = 0; i < 16; ++i) o[dt][i] = 0.f;
#pragma unroll
            for (int ct = 0; ct < 5; ++ct)
#pragma unroll
                for (int s2 = 0; s2 < 2; ++s2) {
                    u32x4 pw; pw.x = cvt_pk_bf16(s[ct][8 * s2 + 0], s[ct][8 * s2 + 1]); pw.y = cvt_pk_bf16(s[ct][8 * s2 + 2], s[ct][8 * s2 + 3]);
                    pw.z = cvt_pk_bf16(s[ct][8 * s2 + 4], s[ct][8 * s2 + 5]); pw.w = cvt_pk_bf16(s[ct][8 * s2 + 6], s[ct][8 * s2 + 7]);
                    const bf16x8 pb = __builtin_bit_cast(bf16x8, pw);
#pragma unroll
                    for (int dt = 0; dt < 2; ++dt) { const LAS unsigned char* vp = lds + SW_V_OFF + (32 * dt + n) * SW_VP + (32 * (rt + ct) + 16 * s2 + 4 * h) * 2;
                        const u32x2 v0 = *(const LAS u32x2*)vp, v1 = *(const LAS u32x2*)(vp + 16);
                        u32x4 va; va.x = v0.x; va.y = v0.y; va.z = v1.x; va.w = v1.y;
                        o[dt] = __builtin_amdgcn_mfma_f32_32x32x16_bf16(__builtin_bit_cast(bf16x8, va), pb, o[dt], 0, 0, 0); }
                }
            const float inv = 16.0f / sum;
            unsigned pc[2][4];
#pragma unroll
            for (int dt = 0; dt < 2; ++dt)
#pragma unroll
                for (int i4 = 0; i4 < 4; ++i4) { int wv = 0;
                    wv = __builtin_amdgcn_cvt_pk_fp8_f32(__builtin_amdgcn_fmed3f(o[dt][4 * i4] * inv, -448.f, 448.f), __builtin_amdgcn_fmed3f(o[dt][4 * i4 + 1] * inv, -448.f, 448.f), wv, false);
                    wv = __builtin_amdgcn_cvt_pk_fp8_f32(__builtin_amdgcn_fmed3f(o[dt][4 * i4 + 2] * inv, -448.f, 448.f), __builtin_amdgcn_fmed3f(o[dt][4 * i4 + 3] * inv, -448.f, 448.f), wv, true);
                    pc[dt][i4] = (unsigned)wv; }
            u32x4 w0, w1;
            { const u32x2 a = __builtin_amdgcn_permlane32_swap(pc[0][0], pc[1][0], false, false), b2 = __builtin_amdgcn_permlane32_swap(pc[0][1], pc[1][1], false, false);
              const u32x2 c = __builtin_amdgcn_permlane32_swap(pc[0][2], pc[1][2], false, false), d = __builtin_amdgcn_permlane32_swap(pc[0][3], pc[1][3], false, false);
              w0.x = a.x; w0.y = a.y; w0.z = b2.x; w0.w = b2.y; w1.x = c.x; w1.y = c.y; w1.z = d.x; w1.w = d.y; }
            unsigned char* op = (unsigned char*)OB + ((size_t)((qrow >> 8) * 8 + (qh >> 1)) * 2 + (qh & 1)) * (256 * 64) + (qrow & 255) * 64 + 32 * h;
            *(u32x4*)op = w0; *(u32x4*)(op + 16) = w1;
        }
    }
}

struct Args { const float* in[23]; float* out; unsigned char* ws; };
#define CAS __attribute__((address_space(4)))
__device__ __forceinline__ const CAS Args* kargs() { const CAS Args* p = (const CAS Args*)__builtin_amdgcn_kernarg_segment_ptr(); asm volatile("" : "+s"(p)); return p; }

__global__ void __launch_bounds__(NTHR, 2) trunk_fwd(Args args_by_value) {
    LAS unsigned char* lds = (LAS unsigned char*)lds_raw;
    const int tid = threadIdx.x;
    volatile LAS unsigned* MISC = (volatile LAS unsigned*)(lds + LDS_MISC_OFF);
    for (int u = tid; u < (LDS_BYTES - LDS_MISC_OFF) / 4; u += NTHR) MISC[u] = 0u;
    __syncthreads();
    if ((tid & 63) == 0) MISC[64 + hw_slot()] = (unsigned)(tid >> 6);
    { const CAS Args* A = kargs(); (void)xcd_barrier_post((unsigned*)(A->ws + WS_CTL) + 4096, MISC + 8);
      if (tid == 0) { const unsigned x = xb_xcc_id(); MISC[16] = x; MISC[17] = xb_add((unsigned*)(A->ws + WS_CTL) + 8192 + 64 * x, 1u); } }
#define XCD_RANK(xcd, rank) do { const CAS Args* A_ = kargs(); const unsigned* cw_ = (const unsigned*)(A_->ws + WS_CTL) + 4096; bool ok_ = (gridDim.x & 7) == 0; \
        for (int j_ = 0; j_ < 16; ++j_) { const unsigned c_ = __hip_atomic_load(cw_ + XB_XCNT(j_), __ATOMIC_RELAXED, __HIP_MEMORY_SCOPE_AGENT); ok_ = ok_ && (c_ == (j_ < 8 ? gridDim.x >> 3 : 0u)); } \
        const unsigned hx_ = MISC[16], hr_ = MISC[17]; ok_ = ok_ && hx_ < 8u && hr_ < (gridDim.x >> 3); \
        xcd = ok_ ? (int)hx_ : (int)(blockIdx.x & 7); rank = ok_ ? (int)hr_ : (int)(blockIdx.x >> 3); } while (0)
#define GB() do { const CAS Args* A_ = kargs(); XcdBarrier b_; b_.bar = (unsigned*)(A_->ws + WS_CTL) + 4096; b_.x = xb_xcc_id(); b_.st = MISC + 8; xcd_barrier(b_); } while (0)

    { const CAS Args* A = kargs(); Ptrs P;
#pragma unroll
      for (int i = 0; i < 23; ++i) P.in[i] = A->in[i];
      P.out = A->out; P.ws = A->ws;
      p0_prologue(P, lds, (int)gridDim.x); }
    GB();
    { const CAS Args* A = kargs(); Ptrs P;
#pragma unroll
      for (int i = 0; i < 23; ++i) P.in[i] = A->in[i];
      P.out = A->out; P.ws = A->ws;
      pre_phase(P, lds, (int)gridDim.x); }
    GB();

    for (int l = 0; l < DEPTH; ++l) {
        const bool isA = (l & 1) == 0;
        {
            const CAS Args* A = kargs(); const int G = gridDim.x, j = l >> 1; unsigned char* ws = A->ws;
            const unsigned long long* SS = (const unsigned long long*)(ws + WS_SS) + (size_t)(2 * l) * M;
            if (isA) {
                unsigned char* wa = ws + WS_WA + (size_t)j * WA_STRIDE;
                {
                    pg8::Gemm g{(const bf16_t*)((const unsigned char*)A->out + OUT_XGQ), (const bf16_t*)(wa + WINQ8_OFF), D / 2, D / 2, D / 2, 0, 0, 0}; pg8::StaticOrder S; S.init(M, 1024, G, (int)blockIdx.x);
                    pg8::EpiBf16Plain<true, false, true> E{(bf16_t*)(ws + WS_QO), 1024, (const float*)(ws + WS_SHW + SHW_A) + (size_t)j * BATCH * 2048, 2048, SS, nullptr, nullptr};
                    pg8::gemm_phase<pg8::EpiBf16Plain<true, false, true>, true, 2>(lds, g, S, E); }
                __syncthreads();
                {
                    pg8::Gemm g{(const bf16_t*)(ws + WS_XG), (const bf16_t*)(wa + WINA_OFF) + (size_t)1024 * D, D, D, D, 0, 0}; pg8::StaticOrder S; S.init(M, 1024, G, (int)blockIdx.x);
                    pg8::EpiInA E{(bf16_t*)(ws + WS_CKV), (bf16_t*)(ws + WS_QI), (bf16_t*)(ws + WS_KIN), (float*)(ws + WS_WI), A->in[I_AIKG] + j * IDIM, A->in[I_AIKB] + j * IDIM,
                                    (const float*)(ws + WS_SHW + SHW_A) + (size_t)j * BATCH * 2048, SS};
                    pg8::gemm_phase<pg8::EpiInA, true, 3>(lds, g, S, E); }
            } else {
                unsigned char* wb = ws + WS_WB + (size_t)j * WB_STRIDE;
                (void)wb;
                pg8::Gemm g{(const bf16_t*)(ws + WS_XG), (const bf16_t*)(ws + WS_W8B), D / 2, D / 2, D / 2, 0, 0, (unsigned)(B_IN * D)}; pg8::StaticOrder S; S.init(M, B_IN, G, (int)blockIdx.x);
                pg8::EpiBf16Plain<true, true> E{(bf16_t*)(ws + WS_QKV), B_IN, (const float*)(ws + WS_SHW + SHW_B) + (size_t)j * BATCH * B_IN, B_IN, SS,
                                                (const float*)(ws + WS_CWB), (const unsigned long long*)(ws + WS_SS) + (size_t)(2 * l - 1) * M};
                pg8::gemm_phase<pg8::EpiBf16Plain<true, true>, true, 1>(lds, g, S, E);
            }
        }
        GB();
        if (isA) {
            { const CAS Args* A = kargs(); const int G = gridDim.x, j = l >> 1; unsigned char* ws = A->ws;
              unsigned char* wa = ws + WS_WA + (size_t)j * WA_STRIDE;
              pg8::Gemm g{(const bf16_t*)(ws + WS_QO), (const bf16_t*)(wa + WQA_OFF), D, 128, 128, 0, 128}; pg8::StaticOrder S; S.init(M, 2048, G, (int)blockIdx.x);
              pg8::EpiFp8 E{ws + WS_BIG, 8192};
              pg8::gemm_phase<pg8::EpiFp8, false, 0, true>(lds, g, S, E); }
            { const CAS Args* A = kargs(); const int G = gridDim.x; unsigned char* ws = A->ws;
              const int tid2 = tid_now();
              const int lane = tid2 & 63, wave = __builtin_amdgcn_readfirstlane(tid2 >> 6);
              const bf16_t* CKV = (const bf16_t*)(ws + WS_CKV); unsigned* CKV8 = (unsigned*)(ws + WS_CKV8);
              const int gw = blockIdx.x * NWAVES + wave, NGW = G * NWAVES;
              for (int row0 = gw; row0 < M; row0 += 8 * NGW) {
                  u32x2 vr[8];
#pragma unroll
                  for (int i = 0; i < 8; ++i) { const int row = row0 + i * NGW; vr[i] = __builtin_nontemporal_load((const u32x2*)(CKV + (size_t)(row < M ? row : row0) * RK) + lane); }
                  asm volatile("" ::: "memory");
#pragma unroll
                  for (int i = 0; i < 8; ++i) { const int row = row0 + i * NGW; const u32x2 v = vr[i];
                      const float a0 = __uint_as_float(v.x << 16), a1 = __uint_as_float(v.x & 0xffff0000u), a2 = __uint_as_float(v.y << 16), a3 = __uint_as_float(v.y & 0xffff0000u);
                      const float ss = wave_sum((a0 * a0 + a1 * a1) + (a2 * a2 + a3 * a3));
                      const float rs = 1.0f / sqrtf(ss * (1.0f / RK) + EPS);
                      int w = 0; w = __builtin_amdgcn_cvt_pk_fp8_f32(a0 * rs, a1 * rs, w, false); w = __builtin_amdgcn_cvt_pk_fp8_f32(a2 * rs, a3 * rs, w, true);
                      if (row < M) CKV8[(size_t)row * (RK / 4) + lane] = (unsigned)w; }
              } }
            { const CAS Args* A = kargs(); const int G = gridDim.x; unsigned char* ws = A->ws;
              const int tid2 = tid_now();
              const int lane = tid2 & 63, wave = __builtin_amdgcn_readfirstlane(tid2 >> 6);
              int xcd, rank; XCD_RANK(xcd, rank); xcd = __builtin_amdgcn_readfirstlane(xcd); rank = __builtin_amdgcn_readfirstlane(rank);
              const int wx = rank * NWAVES + wave, nwx = (G >> 3) * NWAVES;
              const int nsteps = (1024 + nwx - 1) / nwx;
              for (int st = 0; st < nsteps; ++st) {
                  const int q = wx + st * nwx; const bool active = q < 1024;
                  const int qc = active ? q : (rank * NWAVES + st * nwx < 1024 ? rank * NWAVES + st * nwx : 1023);
                  const int bl = qc >> 9, u = qc & 255, hiq = (qc >> 8) & 1, b = 2 * xcd + bl;
                  const int tg = hiq ? 511 - u : u;
                  int bn = 0, kn = 0; const bool hn = st + 1 < nsteps;
                  if (hn) { const int q2 = q + nwx, qc2 = q2 < 1024 ? q2 : (rank * NWAVES + (st + 1) * nwx < 1024 ? rank * NWAVES + (st + 1) * nwx : 1023); const int u2 = qc2 & 255, hiq2 = (qc2 >> 8) & 1;
                            bn = 2 * xcd + (qc2 >> 9); kn = 4 * (hiq2 ? 511 - (u2 & ~7) : (u2 | 7)) + 4; }
                  idx_task((const bf16_t*)(ws + WS_QI), (const bf16_t*)(ws + WS_KIN), (const float*)(ws + WS_WI), (unsigned*)(ws + WS_SEL), lds, b, tg, lane, wave, active, 4 * (hiq ? 511 - (u & ~7) : (u | 7)) + 4,
                           st > 0, hn, bn, kn);
              }
              __syncthreads(); }
        } else {
            const CAS Args* A = kargs(); const int G = gridDim.x, j = l >> 1; unsigned char* ws = A->ws;
            swa_phase((const bf16_t*)(ws + WS_QKV), (bf16_t*)(ws + WS_OB), A->in[I_RELB], A->in[I_BSINK] + j * NH, lds, G);
        }
        GB();
        if (isA) {
            { const CAS Args* A = kargs(); const int G = gridDim.x; unsigned char* ws = A->ws;
              const int tid2 = tid_now();
              const int lane = tid2 & 63, wave = __builtin_amdgcn_readfirstlane(tid2 >> 6);
              LAS float* relb = (LAS float*)(lds + 147456);
              LAS unsigned* btab = (LAS unsigned*)(lds + 147456 + 2048);
              for (int i = tid2; i < NBUCK * NH; i += NTHR) relb[i] = A->in[I_RELB][i];
              for (int i = tid2; i < 132; i += NTHR) btab[i] = (unsigned)t5_bucket(i);
              __syncthreads();
              int xcd, rank; XCD_RANK(xcd, rank); xcd = __builtin_amdgcn_readfirstlane(xcd); rank = __builtin_amdgcn_readfirstlane(rank);
              const int wx = rank * NWAVES + wave, nwx = (G >> 3) * NWAVES;
              att_wave(ws + WS_CKV8, (const unsigned*)(ws + WS_SEL), ws + WS_BIG, lds + wave * 16384, (LAS unsigned*)(lds + 131072 + wave * 2048), relb, btab, xcd, wx, nwx, lane); }
            GB();
            { const CAS Args* A = kargs(); const int G = gridDim.x, j = l >> 1; unsigned char* ws = A->ws;
              unsigned char* wa = ws + WS_WA + (size_t)j * WA_STRIDE;
              pg8::Gemm g{(const bf16_t*)(ws + WS_BIG), (const bf16_t*)(wa + WUV_OFF), 4096, D / 2, D / 2, 0, 512}; pg8::StaticOrder S; S.init(M, D, G, (int)blockIdx.x);
              pg8::EpiFp8T<true> E{ws + WS_OB, D};
              pg8::gemm_phase<pg8::EpiFp8T<true>, false, 2>(lds, g, S, E); }
            GB();
        }
        {
            const CAS Args* A = kargs(); const int G = gridDim.x, j = l >> 1; unsigned char* ws = A->ws;
            const float* modl = (const float*)(ws + WS_MOD) + (size_t)l * BATCH * 6144;
            const bf16_t* Ain = (const bf16_t*)(ws + WS_OB);
            const bf16_t* Bw = (const bf16_t*)(isA ? ws + WS_WA + (size_t)j * WA_STRIDE + WOUTA_OFF : ws + WS_WB + (size_t)j * WB_STRIDE + WOUTB_OFF);
            w8_build<false>((const bf16_t*)(ws + WS_W + (size_t)l * W_LAYER + W13_OFF), 2 * DFF, A->in[I_GFFN] + l * D, modl + 4096, ws + WS_W8, (float*)(ws + WS_CW), lds, G);
            pg8::Gemm g{Ain, Bw, D / 2, D / 2, D / 2, 0, 0, 0, 1}; pg8::StaticOrder S; S.init(M, D, G, (int)blockIdx.x);
            pg8::EpiResid<true, true> E{(const bf16_t*)A->out, (bf16_t*)A->out, modl + 2048, isA ? nullptr : A->in[I_BBOUT] + j * D,
                            (bf16_t*)(ws + WS_XG), nullptr, nullptr, (unsigned long long*)(ws + WS_SS) + (size_t)(2 * l + 1) * M, (const unsigned long long*)(ws + WS_SS) + (size_t)(2 * l) * M};
            pg8::gemm_phase<pg8::EpiResid<true, true>, true, 2>(lds, g, S, E);
        }
        GB();
        {
            const CAS Args* A = kargs(); const int G = gridDim.x; unsigned char* ws = A->ws;
            unsigned char* wl = ws + WS_W + (size_t)l * W_LAYER;
            pg8::Gemm g{(const bf16_t*)(ws + WS_XG), (const bf16_t*)(ws + WS_W8), D / 2, D / 2, D / 2, 0, 0, (unsigned)W8_BATCH}; pg8::StaticOrder S; S.init(M, 2 * DFF, G, (int)blockIdx.x);
            pg8::EpiSwiGLU E{(bf16_t*)(ws + WS_HFF), (const float*)(ws + WS_SHW + SHW_F) + (size_t)l * BATCH * 2 * DFF, (const unsigned long long*)(ws + WS_SS) + (size_t)(2 * l + 1) * M,
                             (const float*)(ws + WS_CW), (const unsigned long long*)(ws + WS_SS) + (size_t)(2 * l) * M};
            pg8::gemm_phase<pg8::EpiSwiGLU, true, 1>(lds, g, S, E);
        }
        GB();
        {
            const CAS Args* A = kargs(); const int G = gridDim.x; unsigned char* ws = A->ws;
            unsigned char* wl = ws + WS_W + (size_t)l * W_LAYER;
            const float* modl = (const float*)(ws + WS_MOD) + (size_t)l * BATCH * 6144;
            const int ln = l + 1 < DEPTH ? l + 1 : l;
            pg8::Gemm g{(const bf16_t*)(ws + WS_HFF), (const bf16_t*)(wl + W2_OFF), DFF, DFF, DFF, 0, 0, 0, 1};        pg8::StaticOrder S; S.init(M, D, G, (int)blockIdx.x);
            const bool lastl = (l + 1 == DEPTH);
            if (!lastl && ((l + 1) & 1)) {
                const int jn = (l + 1) >> 1;
                w8_build<true>((const bf16_t*)(ws + WS_WB + (size_t)jn * WB_STRIDE + WINB_OFF), B_IN, A->in[I_GMIX] + ln * D, (const float*)(ws + WS_MOD) + (size_t)ln * BATCH * 6144 + 1024, ws + WS_W8B, (float*)(ws + WS_CWB), lds, G);
                pg8::EpiResid<true, false> E{(const bf16_t*)A->out, (bf16_t*)A->out, modl + 5120, nullptr,
                                (bf16_t*)(ws + WS_XG), nullptr, nullptr, (unsigned long long*)(ws + WS_SS) + (size_t)(2 * l + 2) * M, (const unsigned long long*)(ws + WS_SS) + (size_t)(2 * l + 1) * M};
                pg8::gemm_phase<pg8::EpiResid<true, false>, true>(lds, g, S, E);
            } else {
                pg8::EpiResid<false, false> E{(const bf16_t*)A->out, lastl ? (bf16_t*)(ws + WS_XG) : (bf16_t*)A->out, modl + 5120, nullptr,
                                l + 1 < DEPTH ? (bf16_t*)(ws + WS_XG) : nullptr, A->in[I_GMIX] + ln * D, (const float*)(ws + WS_MOD) + (size_t)ln * BATCH * 6144 + 1024, (unsigned long long*)(ws + WS_SS) + (size_t)(2 * l + 2) * M, nullptr,
                                l + 1 < DEPTH ? (unsigned char*)A->out + OUT_XGQ : nullptr};
                pg8::gemm_phase<pg8::EpiResid<false, false>, true>(lds, g, S, E);
            }
        }
        GB();
    }
    { const CAS Args* A = kargs(); final_norm_phase((const bf16_t*)(A->ws + WS_XG), A->out, A->in[I_GFIN], (int)gridDim.x); }
#undef GB
}

extern "C" void kernel_launch(void* const* d_in, const int* in_sizes, int n_in, void* d_out, int out_size, void* d_ws, size_t ws_size, hipStream_t stream) {
    static int grid = 0;
    if (grid == 0) {
        if (n_in != 23 || out_size != M * D || ws_size < WS_END) { fprintf(stderr, "kernel_launch: unexpected shapes (n_in %d out %d ws %zu)\n", n_in, out_size, ws_size); grid = -1; return; }
        int dev = 0, cus = 0, per_cu = 0;
        if (hipGetDevice(&dev) != hipSuccess || hipDeviceGetAttribute(&cus, hipDeviceAttributeMultiprocessorCount, dev) != hipSuccess) { grid = -1; return; }
        if (hipFuncSetAttribute((const void*)trunk_fwd, hipFuncAttributeMaxDynamicSharedMemorySize, LDS_BYTES) != hipSuccess) { fprintf(stderr, "kernel_launch: hipFuncSetAttribute failed\n"); grid = -1; return; }
        if (hipOccupancyMaxActiveBlocksPerMultiprocessor(&per_cu, (const void*)trunk_fwd, NTHR, LDS_BYTES) != hipSuccess || per_cu < 1) { fprintf(stderr, "kernel_launch: occupancy query says %d\n", per_cu); }
        (void)hipGetLastError();
        grid = cus;
    }
    if (grid < 0) return;
    (void)hipMemsetAsync((char*)d_ws + WS_CTL, 0, CTL_ZERO_BYTES, stream);
    Args a{};
    for (int i = 0; i < 23; ++i) a.in[i] = (const float*)d_in[i];
    a.out = (float*)d_out; a.ws = (unsigned char*)d_ws;
    hipLaunchKernelGGL(trunk_fwd, dim3(grid), dim3(NTHR), LDS_BYTES, stream, a);
    const hipError_t le = hipPeekAtLastError();
    if (le != hipSuccess) fprintf(stderr, "kernel_launch: launch failed: %s\n", hipGetErrorName(le));
}
```
